# Optimizing an MI355X kernel written in HIP

```python
import jax, jax.numpy as jnp
from jax import lax
import numpy as np

D_MODEL = 2048
BATCH = 2
SEQ = 16384
DEPTH = 1

CHUNK = 64
EPS = 1e-6

GLA_HEADS = 4
GLA_WIDTH = D_MODEL // 2
GLA_DV = GLA_WIDTH // GLA_HEADS
GLA_DK = GLA_DV // 2
GLA_QK = GLA_HEADS * GLA_DK
GLA_GATE_RANK = 16
GLA_TAU = 16.0

MLSTM_HEADS = 4
MLSTM_WIDTH = D_MODEL - GLA_WIDTH
MLSTM_DV = MLSTM_WIDTH // MLSTM_HEADS
MLSTM_DK = MLSTM_DV // 2
MLSTM_QK = MLSTM_HEADS * MLSTM_DK
CONV_WIDTH = 4

IN_SPLITS = (GLA_QK, GLA_QK, GLA_WIDTH, GLA_WIDTH, GLA_GATE_RANK,
             MLSTM_QK, MLSTM_QK, MLSTM_WIDTH, MLSTM_WIDTH, MLSTM_HEADS, MLSTM_HEADS)
IN_COLS = sum(IN_SPLITS)

PEER_HEADS = 8
N_KEYS = 128
N_EXPERTS = N_KEYS * N_KEYS
PEER_QDIM = 256
PEER_TOPK = 16
PEER_BLOCK = 128

PLE_DIM = 256

kernel_name = "hybrid_gla_mlstm_peer_ple"


def rmsnorm(x, g):
    xf = x.astype(jnp.float32)
    y = xf * lax.rsqrt(jnp.mean(xf * xf, axis=-1, keepdims=True) + EPS)
    return (y * g.astype(jnp.float32)).astype(x.dtype)


def head_rmsnorm(h, g, n_heads):
    b, s, w = h.shape
    hh = h.reshape(b, s, n_heads, w // n_heads)
    hh = hh * lax.rsqrt(jnp.mean(hh * hh, axis=-1, keepdims=True) + EPS)
    return hh.reshape(b, s, w) * g.astype(jnp.float32)


def split_cols(proj):
    out, start = [], 0
    for n in IN_SPLITS:
        out.append(proj[..., start:start + n])
        start += n
    return out


def to_chunks(t, n_heads):
    b, s, w = t.shape
    t = t.reshape(b, s // CHUNK, CHUNK, n_heads, w // n_heads)
    return t.transpose(1, 0, 3, 2, 4).astype(jnp.float32)


def from_chunks(t):
    nc, b, h, l, d = t.shape
    return t.transpose(1, 0, 3, 2, 4).reshape(b, nc * l, h * d)


def gates_to_chunks(t):
    b, s, h = t.shape
    return t.reshape(b, s // CHUNK, CHUNK, h).transpose(1, 0, 3, 2).astype(jnp.float32)


def causal_dwconv(x, w, bias):
    out = lax.conv_general_dilated(
        x, w[:, None, :].astype(x.dtype), window_strides=(1,),
        padding=[(CONV_WIDTH - 1, 0)],
        dimension_numbers=('NWC', 'WIO', 'NWC'),
        feature_group_count=x.shape[-1])
    return out + bias.astype(x.dtype)


def gla_chunked(q, k, v, log_a):
    mask = jnp.tril(jnp.ones((CHUNK, CHUNK), dtype=bool))
    nb, nh = q.shape[1], q.shape[2]

    def step(state, inp):
        qc, kc, vc, gc = inp
        b = jnp.cumsum(gc, axis=2)
        diff = b[:, :, :, None, :] - b[:, :, None, :, :]
        decay = jnp.exp(jnp.where(mask[:, :, None], diff, -jnp.inf))
        scores = jnp.sum(qc[:, :, :, None, :] * kc[:, :, None, :, :] * decay, axis=-1)
        o = scores @ vc + jnp.einsum('bhid,bhdv->bhiv', qc * jnp.exp(b), state)
        b_last = b[:, :, -1, :]
        k_dec = kc * jnp.exp(b_last[:, :, None, :] - b)
        state = jnp.exp(b_last)[..., None] * state + jnp.einsum('bhjd,bhjv->bhdv', k_dec, vc)
        return state, o

    s0 = jnp.zeros((nb, nh, GLA_DK, GLA_DV), jnp.float32)
    _, o = lax.scan(step, s0, (q, k, v, log_a))
    return o


def mlstm_chunked(q, k, v, ig, logf):
    mask = jnp.tril(jnp.ones((CHUNK, CHUNK), dtype=bool))
    nb, nh = q.shape[1], q.shape[2]

    def step(carry, inp):
        c_st, n_st, m_st = carry
        qc, kc, vc, ic, fc = inp
        f_cum = jnp.cumsum(fc, axis=-1)
        dmat = jnp.where(mask, f_cum[..., :, None] - f_cum[..., None, :] + ic[..., None, :], -jnp.inf)
        inter = f_cum + m_st[..., None]
        m_row = jnp.maximum(jnp.max(dmat, axis=-1), inter)
        w = jnp.exp(dmat - m_row[..., None])
        s = jnp.einsum('bhid,bhjd->bhij', qc, kc) * w
        w_inter = jnp.exp(inter - m_row)
        num = s @ vc + w_inter[..., None] * jnp.einsum('bhid,bhdv->bhiv', qc, c_st)
        den = jnp.sum(s, axis=-1) + w_inter * jnp.einsum('bhid,bhd->bhi', qc, n_st)
        h = num / jnp.maximum(jnp.abs(den), jnp.exp(-m_row))[..., None]
        f_last = f_cum[..., -1]
        wlog = f_last[..., None] - f_cum + ic
        m_new = jnp.maximum(f_last + m_st, jnp.max(wlog, axis=-1))
        wk = jnp.exp(wlog - m_new[..., None])
        carry_dec = jnp.exp(f_last + m_st - m_new)
        c_st = carry_dec[..., None, None] * c_st + jnp.einsum('bhj,bhjd,bhjv->bhdv', wk, kc, vc)
        n_st = carry_dec[..., None] * n_st + jnp.einsum('bhj,bhjd->bhd', wk, kc)
        return (c_st, n_st, m_new), h

    init = (jnp.zeros((nb, nh, MLSTM_DK, MLSTM_DV), jnp.float32),
            jnp.zeros((nb, nh, MLSTM_DK), jnp.float32),
            jnp.zeros((nb, nh), jnp.float32))
    _, h = lax.scan(step, init, (q, k, v, ig, logf))
    return h


def token_mixers(xn, w_in, gla_gate_up, gla_gate_bias, gla_norm, conv_w, conv_b,
                 igate_bias, fgate_bias, mlstm_norm, w_out):
    gq, gk, gv, gg, glr, mq, mk, mv, mo, mi, mf = split_cols(xn @ w_in)
    log_a = jax.nn.log_sigmoid((glr @ gla_gate_up + gla_gate_bias).astype(jnp.float32)) / GLA_TAU
    o_gla = gla_chunked(to_chunks(gq, GLA_HEADS) * (GLA_DK ** -0.5), to_chunks(gk, GLA_HEADS),
                        to_chunks(gv, GLA_HEADS), to_chunks(log_a, GLA_HEADS))
    y_gla = head_rmsnorm(from_chunks(o_gla), gla_norm, GLA_HEADS) * jax.nn.silu(gg.astype(jnp.float32))
    qk = jax.nn.silu(causal_dwconv(jnp.concatenate([mq, mk], axis=-1), conv_w, conv_b))
    mq_c, mk_c = qk[..., :MLSTM_QK], qk[..., MLSTM_QK:]
    ig = gates_to_chunks(mi + igate_bias)
    logf = jax.nn.log_sigmoid(gates_to_chunks(mf + fgate_bias))
    h = mlstm_chunked(to_chunks(mq_c, MLSTM_HEADS), to_chunks(mk_c, MLSTM_HEADS) * (MLSTM_DK ** -0.5),
                      to_chunks(mv, MLSTM_HEADS), ig, logf)
    y_m = jax.nn.sigmoid(mo.astype(jnp.float32)) * head_rmsnorm(from_chunks(h), mlstm_norm, MLSTM_HEADS)
    y = jnp.concatenate([y_gla, y_m], axis=-1).astype(xn.dtype)
    return y @ w_out


def peer_ffn(xn, w_query, sub_keys, expert_u, expert_v):
    b, s, d = xn.shape
    xt = xn.reshape(-1, PEER_BLOCK, d)

    def block(xb):
        q = (xb @ w_query).reshape(PEER_BLOCK, PEER_HEADS, 2, PEER_QDIM // 2).astype(jnp.float32)
        sc = jnp.einsum('thpd,hpkd->thpk', q, sub_keys.astype(jnp.float32))
        sv, si = lax.top_k(sc, PEER_TOPK)
        cand = (sv[:, :, 0, :, None] + sv[:, :, 1, None, :]).reshape(PEER_BLOCK, PEER_HEADS, PEER_TOPK * PEER_TOPK)
        cidx = (si[:, :, 0, :, None] * N_KEYS + si[:, :, 1, None, :]).reshape(PEER_BLOCK, PEER_HEADS, PEER_TOPK * PEER_TOPK)
        top_s, pos = lax.top_k(cand, PEER_TOPK)
        idx = jnp.take_along_axis(cidx, pos, axis=-1)
        g = jax.nn.softmax(top_s, axis=-1)
        a = jax.nn.gelu(jnp.einsum('thkd,td->thk', expert_u[idx], xb).astype(jnp.float32))
        return jnp.einsum('thk,thkd->td', (g * a).astype(xb.dtype), expert_v[idx])

    return lax.map(block, xt).reshape(b, s, d)


def setup_inputs(seed: int = 0) -> dict:
    key = jax.random.key(seed)
    ks = jax.random.split(key, 24)
    f32 = jnp.float32

    def nrm(k, shape, scale):
        return jax.random.normal(k, shape, f32) * scale

    def gain(k, shape):
        return 1.0 + 0.02 * jax.random.normal(k, shape, f32)

    return {
        "x": nrm(ks[0], (BATCH, SEQ, D_MODEL), 1.0),
        "p": nrm(ks[1], (DEPTH, BATCH, SEQ, PLE_DIM), 1.0),
        "norm_mix": gain(ks[2], (DEPTH, D_MODEL)),
        "w_in": nrm(ks[3], (DEPTH, D_MODEL, IN_COLS), D_MODEL ** -0.5),
        "gla_gate_up": nrm(ks[4], (DEPTH, GLA_GATE_RANK, GLA_QK), GLA_GATE_RANK ** -0.5),
        "gla_gate_bias": nrm(ks[5], (DEPTH, GLA_QK), 0.1),
        "gla_norm": gain(ks[6], (DEPTH, GLA_WIDTH)),
        "mlstm_conv_w": nrm(ks[7], (DEPTH, CONV_WIDTH, 2 * MLSTM_QK), CONV_WIDTH ** -0.5),
        "mlstm_conv_b": nrm(ks[8], (DEPTH, 2 * MLSTM_QK), 0.02),
        "mlstm_igate_bias": nrm(ks[9], (DEPTH, MLSTM_HEADS), 0.1),
        "mlstm_fgate_bias": 3.0 + 3.0 * jax.random.uniform(ks[10], (DEPTH, MLSTM_HEADS), f32),
        "mlstm_norm": gain(ks[11], (DEPTH, MLSTM_WIDTH)),
        "w_out": nrm(ks[12], (DEPTH, GLA_WIDTH + MLSTM_WIDTH, D_MODEL), (GLA_WIDTH + MLSTM_WIDTH) ** -0.5),
        "norm_ffn": gain(ks[13], (DEPTH, D_MODEL)),
        "peer_query": nrm(ks[14], (DEPTH, D_MODEL, PEER_HEADS * PEER_QDIM), D_MODEL ** -0.5),
        "peer_sub_keys": nrm(ks[15], (DEPTH, PEER_HEADS, 2, N_KEYS, PEER_QDIM // 2), (PEER_QDIM // 2) ** -0.5),
        "peer_u": nrm(ks[16], (DEPTH, N_EXPERTS, D_MODEL), D_MODEL ** -0.5),
        "peer_v": nrm(ks[17], (DEPTH, N_EXPERTS, D_MODEL), 0.5),
        "norm_ple": gain(ks[18], (DEPTH, D_MODEL)),
        "w_ple": nrm(ks[19], (DEPTH, PLE_DIM, D_MODEL), PLE_DIM ** -0.5),
        "w_ple_gate": nrm(ks[20], (DEPTH, D_MODEL, D_MODEL), D_MODEL ** -0.5),
        "norm_final": gain(ks[21], (D_MODEL,)),
    }


def reference(x, p, norm_mix, w_in, gla_gate_up, gla_gate_bias, gla_norm, mlstm_conv_w,
              mlstm_conv_b, mlstm_igate_bias, mlstm_fgate_bias, mlstm_norm, w_out, norm_ffn,
              peer_query, peer_sub_keys, peer_u, peer_v, norm_ple, w_ple, w_ple_gate, norm_final):
    h = x
    for i in range(DEPTH):
        h = h + token_mixers(rmsnorm(h, norm_mix[i]), w_in[i], gla_gate_up[i], gla_gate_bias[i],
                             gla_norm[i], mlstm_conv_w[i], mlstm_conv_b[i], mlstm_igate_bias[i],
                             mlstm_fgate_bias[i], mlstm_norm[i], w_out[i])
        h = h + peer_ffn(rmsnorm(h, norm_ffn[i]), peer_query[i], peer_sub_keys[i], peer_u[i], peer_v[i])
        gate = jax.nn.sigmoid(rmsnorm(h, norm_ple[i]) @ w_ple_gate[i])
        h = h + gate * (p[i] @ w_ple[i])
    return rmsnorm(h, norm_final)
```

```cpp
#include <hip/hip_runtime.h>
#include <hip/hip_cooperative_groups.h>
#include <cstdio>
#include <cstdint>
namespace cg = cooperative_groups;

#ifndef ONE_LAUNCH
#define ONE_LAUNCH 0
#endif

typedef unsigned short bf16_t;
constexpr int T = 32768, SEQ = 16384, D = 2048;
constexpr int NPROJ = 4352;
constexpr int C_GQ = 0, C_GK = 512, C_GG = 1024, C_MQ = 2048, C_MK = 2560, C_MO = 3072, C_SM = 4096;
constexpr float EPS = 1e-6f;
constexpr size_t MiB = 1ull << 20;
constexpr size_t OFF_XB = 0, OFF_Y = 0, OFF_PL = 0;
constexpr size_t OFF_PROJ = 128 * MiB, OFF_H1B = 128 * MiB, OFF_H2B = 256 * MiB;
constexpr size_t OFF_VT = 400 * MiB, OFF_SC = 400 * MiB;
constexpr size_t OFF_UB = 528 * MiB, OFF_VB = 592 * MiB;
constexpr size_t OFF_WIN = 656 * MiB, OFF_WOUT = 681 * MiB, OFF_WQ = 689 * MiB, OFF_WG = 697 * MiB, OFF_WPLE = 705 * MiB;
constexpr size_t OFF_PB = 706 * MiB, OFF_EIDX = 722 * MiB, OFF_EG = 738 * MiB, OFF_MISC = 754 * MiB;
constexpr size_t WS_NEED = 760 * MiB;

struct Params {
  const float *x, *p, *norm_mix, *w_in, *gate_up, *gate_bias, *gla_norm, *conv_w, *conv_b, *ig_bias, *fg_bias, *mlstm_norm,
      *w_out, *norm_ffn, *peer_query, *sub_keys, *peer_u, *peer_v, *norm_ple, *w_ple, *w_ple_gate, *norm_final;
  float* out;
  unsigned char* ws;
};

__device__ __forceinline__ float bf2f(bf16_t b) { return __uint_as_float(((unsigned)b) << 16); }
__device__ __forceinline__ bf16_t f2bf(float f) { unsigned u = __float_as_uint(f); u += 0x7FFFu + ((u >> 16) & 1u); return (bf16_t)(u >> 16); }
__device__ __forceinline__ unsigned pack2(float lo, float hi) { return (unsigned)f2bf(lo) | ((unsigned)f2bf(hi) << 16); }
__device__ __forceinline__ float lo_f(unsigned u) { return __uint_as_float(u << 16); }
__device__ __forceinline__ float hi_f(unsigned u) { return __uint_as_float(u & 0xffff0000u); }
__device__ __forceinline__ float wave_sum(float v) {
#pragma unroll
  for (int o = 32; o >= 1; o >>= 1) v += __shfl_xor(v, o);
  return v;
}
__device__ __forceinline__ float sigmoidf_(float x) { return 1.f / (1.f + __expf(-x)); }
__device__ __forceinline__ float siluf_(float x) { return x / (1.f + __expf(-x)); }
__device__ __forceinline__ float logsigmoidf_(float x) { return fminf(x, 0.f) - log1pf(__expf(-fabsf(x))); }
__device__ __forceinline__ float gelu_tanh(float x) { const float u = 0.7978845608028654f * (x + 0.044715f * x * x * x); return 0.5f * x * (1.f + tanhf(u)); }
__device__ __forceinline__ void unpack8(const uint4 q, float* f) {
  f[0] = lo_f(q.x); f[1] = hi_f(q.x); f[2] = lo_f(q.y); f[3] = hi_f(q.y); f[4] = lo_f(q.z); f[5] = hi_f(q.z); f[6] = lo_f(q.w); f[7] = hi_f(q.w);
}
__device__ __forceinline__ uint4 pack8(const float* f) { return make_uint4(pack2(f[0], f[1]), pack2(f[2], f[3]), pack2(f[4], f[5]), pack2(f[6], f[7])); }

struct WS {
  bf16_t *xb, *y, *pl, *proj, *h1b, *h2b, *vT, *sc, *ub, *vb, *win, *wout, *wq, *wg, *wple, *pb;
  int* eidx; float* eg; float *rstd1, *ssq2, *rstd3, *ssq4;
};
__device__ __forceinline__ WS make_ws(unsigned char* ws) {
  WS w;
  w.xb = (bf16_t*)(ws + OFF_XB); w.y = (bf16_t*)(ws + OFF_Y); w.pl = (bf16_t*)(ws + OFF_PL); w.proj = (bf16_t*)(ws + OFF_PROJ);
  w.h1b = (bf16_t*)(ws + OFF_H1B); w.h2b = (bf16_t*)(ws + OFF_H2B); w.vT = (bf16_t*)(ws + OFF_VT); w.sc = (bf16_t*)(ws + OFF_SC);
  w.ub = (bf16_t*)(ws + OFF_UB); w.vb = (bf16_t*)(ws + OFF_VB); w.win = (bf16_t*)(ws + OFF_WIN); w.wout = (bf16_t*)(ws + OFF_WOUT);
  w.wq = (bf16_t*)(ws + OFF_WQ); w.wg = (bf16_t*)(ws + OFF_WG); w.wple = (bf16_t*)(ws + OFF_WPLE); w.pb = (bf16_t*)(ws + OFF_PB);
  w.eidx = (int*)(ws + OFF_EIDX); w.eg = (float*)(ws + OFF_EG);
  float* m = (float*)(ws + OFF_MISC); w.rstd1 = m; w.ssq2 = m + T; w.rstd3 = m + 2 * T; w.ssq4 = m + 3 * T;
  return w;
}

__device__ void prep_x(const Params& p, const WS& w, int bid, int nb) {
  const int wave = threadIdx.x >> 6, lane = threadIdx.x & 63;
  for (int row = bid * 8 + wave; row < T; row += nb * 8) {
    const float4* src = (const float4*)(p.x + (size_t)row * D);
    uint2* dst = (uint2*)(w.xb + (size_t)row * D);
    float ss = 0.f;
#pragma unroll
    for (int i = 0; i < 8; ++i) { const float4 v = src[i * 64 + lane]; ss += v.x * v.x + v.y * v.y + v.z * v.z + v.w * v.w; dst[i * 64 + lane] = make_uint2(pack2(v.x, v.y), pack2(v.z, v.w)); }
    ss = wave_sum(ss);
    if (lane == 0) w.rstd1[row] = rsqrtf(ss * (1.f / D) + EPS);
  }
}
__device__ void cvt_rows(const float* src, bf16_t* dst, size_t n, const float* gain, int ncols, int bid, int nb) {
  const size_t n4 = n / 4;
  for (size_t i = (size_t)bid * 512 + threadIdx.x; i < n4; i += (size_t)nb * 512) {
    float4 v = ((const float4*)src)[i];
    if (gain) { const float4 g = *(const float4*)(gain + (int)((i * 4) % (size_t)ncols)); v.x *= g.x; v.y *= g.y; v.z *= g.z; v.w *= g.w; }
    ((uint2*)dst)[i] = make_uint2(pack2(v.x, v.y), pack2(v.z, v.w));
  }
}
template <class CM>
__device__ void transpose_w(const float* src, int K, int ldsrc, bf16_t* dst, int Ndst, const float* gain, CM cm, float* lds, int bid, int nb) {
  const int tid = threadIdx.x, tk = K / 64, ntile = (Ndst / 64) * tk;
  for (int tile = bid; tile < ntile; tile += nb) {
    const int n0 = (tile / tk) * 64, k0 = (tile % tk) * 64;
    const int nc = tid & 63, sc = cm(n0 + nc);
#pragma unroll
    for (int i = 0; i < 8; ++i) { const int kr = (tid >> 6) + 8 * i; float v = 0.f; if (sc >= 0) { v = src[(size_t)(k0 + kr) * ldsrc + sc]; if (gain) v *= gain[k0 + kr]; } lds[kr * 65 + nc] = v; }
    __syncthreads();
    { const int nr = tid >> 3, ks = (tid & 7) * 8; float f[8];
#pragma unroll
      for (int j = 0; j < 8; ++j) f[j] = lds[(ks + j) * 65 + nr];
      *(uint4*)(dst + (size_t)(n0 + nr) * K + k0 + ks) = pack8(f); }
    __syncthreads();
  }
}
struct CmIdent { __device__ int operator()(int n) const { return n; } };
struct CmWin {
  __device__ int operator()(int n) const {
    if (n < 1024) return n;
    if (n < 2048) return 2048 + (n - 1024);
    if (n < 2560) return 3088 + (n - 2048);
    if (n < 3072) return 3600 + (n - 2560);
    if (n < 4096) return 5136 + (n - 3072);
    if (n < 4352) { const int i = n - 4096; if (i < 16) return 3072 + i; if (i < 20) return 6160 + (i - 16); if (i < 24) return 6164 + (i - 20); return -1; }
    const int j = n - 4352; if (j < 1024) return 1024 + j;
    return 4112 + (j - 1024);
  }
};
__device__ void prep_wq(const Params& p, const WS& w, float* lds, int bid, int nb) {
  const int tid = threadIdx.x;
  float* SKs = lds;
  float* WQs = lds + 128 * 132;
  for (int item = bid; item < 16 * 32; item += nb) {
    const int hp = item >> 5, k0 = (item & 31) * 64;
#pragma unroll
    for (int i = 0; i < 8; ++i) { const int e4 = tid + 512 * i, key = e4 >> 5, d4 = (e4 & 31) * 4; *(float4*)(SKs + key * 132 + d4) = *(const float4*)(p.sub_keys + (size_t)hp * 16384 + key * 128 + d4); }
#pragma unroll
    for (int i = 0; i < 4; ++i) { const int e4 = tid + 512 * i, kr = e4 >> 5, d4 = (e4 & 31) * 4; float4 v = *(const float4*)(p.peer_query + (size_t)(k0 + kr) * 2048 + hp * 128 + d4); const float g = p.norm_ffn[k0 + kr]; v.x *= g; v.y *= g; v.z *= g; v.w *= g; *(float4*)(WQs + kr * 132 + d4) = v; }
    __syncthreads();
    const int k = tid & 63, kg = tid >> 6;
    float acc[16];
#pragma unroll
    for (int j = 0; j < 16; ++j) acc[j] = 0.f;
    for (int d4 = 0; d4 < 32; ++d4) {
      const float4 a = *(const float4*)(WQs + k * 132 + d4 * 4);
#pragma unroll
      for (int j = 0; j < 16; ++j) { const float4 s = *(const float4*)(SKs + (kg * 16 + j) * 132 + d4 * 4); acc[j] += a.x * s.x + a.y * s.y + a.z * s.z + a.w * s.w; }
    }
#pragma unroll
    for (int j = 0; j < 16; ++j) w.wq[(size_t)(hp * 128 + kg * 16 + j) * 2048 + k0 + k] = f2bf(acc[j]);
    __syncthreads();
  }
}
__device__ void phase_prep(const Params& p, const WS& w, float* lds, int bid, int nb) {
  prep_x(p, w, bid, nb);
  cvt_rows(p.p, w.pb, (size_t)T * 256, nullptr, 256, bid, nb);
  cvt_rows(p.peer_u, w.ub, (size_t)16384 * 2048, p.norm_ffn, 2048, bid, nb);
  cvt_rows(p.peer_v, w.vb, (size_t)16384 * 2048, nullptr, 2048, bid, nb);
  transpose_w(p.w_in, 2048, 6168, w.win, 6400, p.norm_mix, CmWin(), lds, bid, nb);
  transpose_w(p.w_out, 2048, 2048, w.wout, 2048, nullptr, CmIdent(), lds, bid, nb);
  transpose_w(p.w_ple_gate, 2048, 2048, w.wg, 2048, p.norm_ple, CmIdent(), lds, bid, nb);
  transpose_w(p.w_ple, 256, 2048, w.wple, 2048, nullptr, CmIdent(), lds, bid, nb);
  prep_wq(p, w, lds, bid, nb);
  for (int i = bid * 512 + threadIdx.x; i < T; i += nb * 512) { w.ssq2[i] = 0.f; w.ssq4[i] = 0.f; }
}

struct EpiProjN { bf16_t* out; const float* rstd; static constexpr bool ROWSUM = false;
  __device__ __forceinline__ float store8(int r, int c, const float* v) const { const float s = rstd[r]; float f[8];
#pragma unroll
    for (int j = 0; j < 8; ++j) f[j] = v[j] * s;
    *(uint4*)(out + (size_t)r * NPROJ + c) = pack8(f); return 0.f; }
  __device__ __forceinline__ void rowsum(int, float) const {} };
struct EpiProjT { bf16_t* out; const float* rstd; static constexpr bool ROWSUM = false;
  __device__ __forceinline__ float store8(int r, int c, const float* v) const { const float4 s0 = *(const float4*)(rstd + c), s1 = *(const float4*)(rstd + c + 4); float f[8];
    f[0] = v[0] * s0.x; f[1] = v[1] * s0.y; f[2] = v[2] * s0.z; f[3] = v[3] * s0.w; f[4] = v[4] * s1.x; f[5] = v[5] * s1.y; f[6] = v[6] * s1.z; f[7] = v[7] * s1.w;
    *(uint4*)(out + (size_t)r * T + c) = pack8(f); return 0.f; }
  __device__ __forceinline__ void rowsum(int, float) const {} };
struct EpiOut { const float* x; bf16_t* h1b; float* ssq; static constexpr bool ROWSUM = true;
  __device__ __forceinline__ float store8(int r, int c, const float* v) const { const float4 x0 = *(const float4*)(x + (size_t)r * D + c), x1 = *(const float4*)(x + (size_t)r * D + c + 4); float f[8];
    f[0] = v[0] + x0.x; f[1] = v[1] + x0.y; f[2] = v[2] + x0.z; f[3] = v[3] + x0.w; f[4] = v[4] + x1.x; f[5] = v[5] + x1.y; f[6] = v[6] + x1.z; f[7] = v[7] + x1.w;
    float s = 0.f;
#pragma unroll
    for (int j = 0; j < 8; ++j) s += f[j] * f[j];
    *(uint4*)(h1b + (size_t)r * D + c) = pack8(f); return s; }
  __device__ __forceinline__ void rowsum(int r, float s) const { atomicAdd(ssq + r, s); } };
struct EpiScore { bf16_t* sc; const float* ssq; static constexpr bool ROWSUM = false;
  __device__ __forceinline__ float store8(int r, int c, const float* v) const { const float s = rsqrtf(ssq[r] * (1.f / D) + EPS); float f[8];
#pragma unroll
    for (int j = 0; j < 8; ++j) f[j] = v[j] * s;
    *(uint4*)(sc + (size_t)r * D + c) = pack8(f); return 0.f; }
  __device__ __forceinline__ void rowsum(int, float) const {} };
struct EpiPl { bf16_t* pl; static constexpr bool ROWSUM = false;
  __device__ __forceinline__ float store8(int r, int c, const float* v) const { *(uint4*)(pl + (size_t)r * D + c) = pack8(v); return 0.f; }
  __device__ __forceinline__ void rowsum(int, float) const {} };
struct EpiGate { const bf16_t* h2b; const bf16_t* pl; const float* rstd3; float* out; float* ssq; static constexpr bool ROWSUM = true;
  __device__ __forceinline__ float store8(int r, int c, const float* v) const { const float rs = rstd3[r]; float h[8], q[8], f[8];
    unpack8(*(const uint4*)(h2b + (size_t)r * D + c), h); unpack8(*(const uint4*)(pl + (size_t)r * D + c), q);
    float s = 0.f;
#pragma unroll
    for (int j = 0; j < 8; ++j) { f[j] = h[j] + sigmoidf_(v[j] * rs) * q[j]; s += f[j] * f[j]; }
    *(float4*)(out + (size_t)r * D + c) = make_float4(f[0], f[1], f[2], f[3]); *(float4*)(out + (size_t)r * D + c + 4) = make_float4(f[4], f[5], f[6], f[7]); return s; }
  __device__ __forceinline__ void rowsum(int r, float s) const { atomicAdd(ssq + r, s); } };

template <class Epi>
__device__ void gemm_naive(const bf16_t* A, const bf16_t* Bt, int M, int N, int K, const Epi& E, float* lds, int bid, int nb) {
  const int tid = threadIdx.x, ty = tid >> 4, tx = tid & 15;
  float* As = lds;
  float* Bs = lds + 32 * 132;
  const int nM = M / 128, nN = N / 128;
  for (int tile = bid; tile < nM * nN; tile += nb) {
    const int m0 = (tile % nM) * 128, n0 = (tile / nM) * 128;
    float acc[4][8];
#pragma unroll
    for (int i = 0; i < 4; ++i)
#pragma unroll
      for (int j = 0; j < 8; ++j) acc[i][j] = 0.f;
    const int lr = tid >> 2, lk = (tid & 3) * 8;
    for (int k0 = 0; k0 < K; k0 += 32) {
      const uint4 av = *(const uint4*)(A + (size_t)(m0 + lr) * K + k0 + lk);
      const uint4 bv = *(const uint4*)(Bt + (size_t)(n0 + lr) * K + k0 + lk);
      float af[8], bf[8]; unpack8(av, af); unpack8(bv, bf);
      __syncthreads();
#pragma unroll
      for (int j = 0; j < 8; ++j) { As[(lk + j) * 132 + lr] = af[j]; Bs[(lk + j) * 132 + lr] = bf[j]; }
      __syncthreads();
#pragma unroll 8
      for (int kk = 0; kk < 32; ++kk) {
        const float4 a = *(const float4*)(As + kk * 132 + ty * 4);
        const float4 b0 = *(const float4*)(Bs + kk * 132 + tx * 8), b1 = *(const float4*)(Bs + kk * 132 + tx * 8 + 4);
        const float aa[4] = {a.x, a.y, a.z, a.w}; const float bb[8] = {b0.x, b0.y, b0.z, b0.w, b1.x, b1.y, b1.z, b1.w};
#pragma unroll
        for (int i = 0; i < 4; ++i)
#pragma unroll
          for (int j = 0; j < 8; ++j) acc[i][j] += aa[i] * bb[j];
      }
    }
#pragma unroll
    for (int i = 0; i < 4; ++i) {
      const int r = m0 + ty * 4 + i;
      float s = E.store8(r, n0 + tx * 8, acc[i]);
      if (Epi::ROWSUM) { s += __shfl_xor(s, 1); s += __shfl_xor(s, 2); s += __shfl_xor(s, 4); s += __shfl_xor(s, 8); if (tx == 0) E.rowsum(r, s); }
    }
  }
}

__device__ void gla_naive(const Params& p, const WS& w, int b, int h, float* lds) {
  constexpr int CH = 16;
  const int tid = threadIdx.x, dv = tid & 255, half = tid >> 8, wave = tid >> 6, lane = tid & 63;
  float* qf = lds; float* kf = qf + CH * 128; float* af = kf + CH * 128; float* vf = af + CH * 128; float* op = vf + CH * 256;
  float S[64];
#pragma unroll
  for (int i = 0; i < 64; ++i) S[i] = 0.f;
  const int gd = tid & 127;
  float gu[16];
#pragma unroll
  for (int r = 0; r < 16; ++r) gu[r] = p.gate_up[r * 512 + h * 128 + gd];
  const float gb = p.gate_bias[h * 128 + gd];
  const float qscale = 0.08838834764831845f;
  for (int t0 = 0; t0 < SEQ; t0 += CH) {
    const size_t tb = (size_t)b * SEQ + t0;
    { const int tok = tid >> 5, d4 = (tid & 31) * 4;
      const uint2 qv = *(const uint2*)(w.proj + (tb + tok) * NPROJ + C_GQ + h * 128 + d4);
      const uint2 kv = *(const uint2*)(w.proj + (tb + tok) * NPROJ + C_GK + h * 128 + d4);
      *(float4*)(qf + tok * 128 + d4) = make_float4(lo_f(qv.x) * qscale, hi_f(qv.x) * qscale, lo_f(qv.y) * qscale, hi_f(qv.y) * qscale);
      *(float4*)(kf + tok * 128 + d4) = make_float4(lo_f(kv.x), hi_f(kv.x), lo_f(kv.y), hi_f(kv.y)); }
    { const int dvv = tid & 255, tk8 = (tid >> 8) * 8; float f[8];
      unpack8(*(const uint4*)(w.vT + (size_t)(h * 256 + dvv) * T + tb + tk8), f);
#pragma unroll
      for (int j = 0; j < 8; ++j) vf[(tk8 + j) * 256 + dvv] = f[j]; }
#pragma unroll
    for (int i = 0; i < 4; ++i) { const int tok = (tid >> 7) * 4 + i; float z = gb; float gl[16];
      unpack8(*(const uint4*)(w.proj + (tb + tok) * NPROJ + C_SM), gl); unpack8(*(const uint4*)(w.proj + (tb + tok) * NPROJ + C_SM + 8), gl + 8);
#pragma unroll
      for (int r = 0; r < 16; ++r) z += gl[r] * gu[r];
      af[tok * 128 + gd] = __expf(logsigmoidf_(z) * (1.f / 16.f)); }
    __syncthreads();
    for (int tok = 0; tok < CH; ++tok) {
      const float vv = vf[tok * 256 + dv]; float acc = 0.f;
#pragma unroll
      for (int i4 = 0; i4 < 16; ++i4) {
        const float4 a = *(const float4*)(af + tok * 128 + half * 64 + i4 * 4), k = *(const float4*)(kf + tok * 128 + half * 64 + i4 * 4), q = *(const float4*)(qf + tok * 128 + half * 64 + i4 * 4);
        S[i4 * 4 + 0] = a.x * S[i4 * 4 + 0] + k.x * vv; acc += q.x * S[i4 * 4 + 0];
        S[i4 * 4 + 1] = a.y * S[i4 * 4 + 1] + k.y * vv; acc += q.y * S[i4 * 4 + 1];
        S[i4 * 4 + 2] = a.z * S[i4 * 4 + 2] + k.z * vv; acc += q.z * S[i4 * 4 + 2];
        S[i4 * 4 + 3] = a.w * S[i4 * 4 + 3] + k.w * vv; acc += q.w * S[i4 * 4 + 3];
      }
      op[(half * CH + tok) * 256 + dv] = acc;
    }
    __syncthreads();
#pragma unroll
    for (int i = 0; i < 2; ++i) { const int tok = wave * 2 + i;
      const float4 o0 = *(const float4*)(op + tok * 256 + lane * 4), o1 = *(const float4*)(op + (CH + tok) * 256 + lane * 4);
      const float o[4] = {o0.x + o1.x, o0.y + o1.y, o0.z + o1.z, o0.w + o1.w};
      float ss = wave_sum(o[0] * o[0] + o[1] * o[1] + o[2] * o[2] + o[3] * o[3]);
      const float rs = rsqrtf(ss * (1.f / 256.f) + EPS);
      const uint2 gg = *(const uint2*)(w.proj + (tb + tok) * NPROJ + C_GG + h * 256 + lane * 4);
      const float4 gn = *(const float4*)(p.gla_norm + h * 256 + lane * 4);
      const float y0 = o[0] * rs * gn.x * siluf_(lo_f(gg.x)), y1 = o[1] * rs * gn.y * siluf_(hi_f(gg.x)), y2 = o[2] * rs * gn.z * siluf_(lo_f(gg.y)), y3 = o[3] * rs * gn.w * siluf_(hi_f(gg.y));
      *(uint2*)(w.y + (tb + tok) * D + h * 256 + lane * 4) = make_uint2(pack2(y0, y1), pack2(y2, y3)); }
    __syncthreads();
  }
}
__device__ void mlstm_naive(const Params& p, const WS& w, int b, int h, float* lds) {
  constexpr int CH = 16;
  const int tid = threadIdx.x, dv = tid & 255, half = tid >> 8, wave = tid >> 6, lane = tid & 63;
  float* qf = lds; float* kf = qf + CH * 128; float* vf = kf + CH * 128; float* op = vf + CH * 256; float* dn = op + 2 * CH * 256; float* gt = dn + 2 * CH * 256;
  float C[64], n[4];
#pragma unroll
  for (int i = 0; i < 64; ++i) C[i] = 0.f;
#pragma unroll
  for (int i = 0; i < 4; ++i) n[i] = 0.f;
  const int nd = half * 64 + (dv & 15) * 4;
  const float kscale = 0.08838834764831845f;
  const float ib = p.ig_bias[h], fb = p.fg_bias[h];
  for (int t0 = 0; t0 < SEQ; t0 += CH) {
    const size_t tb = (size_t)b * SEQ + t0;
    { const int tok = tid >> 5, d4 = (tid & 31) * 4;
      float qa[4], ka[4];
#pragma unroll
      for (int c = 0; c < 4; ++c) { qa[c] = p.conv_b[h * 128 + d4 + c]; ka[c] = p.conv_b[512 + h * 128 + d4 + c]; }
#pragma unroll
      for (int wi = 0; wi < 4; ++wi) { const int ts = t0 + tok - 3 + wi;
        if (ts >= 0) { const size_t tr = (size_t)b * SEQ + ts;
          const uint2 qv = *(const uint2*)(w.proj + tr * NPROJ + C_MQ + h * 128 + d4), kv = *(const uint2*)(w.proj + tr * NPROJ + C_MK + h * 128 + d4);
          const float4 cq = *(const float4*)(p.conv_w + wi * 1024 + h * 128 + d4), ck = *(const float4*)(p.conv_w + wi * 1024 + 512 + h * 128 + d4);
          qa[0] += cq.x * lo_f(qv.x); qa[1] += cq.y * hi_f(qv.x); qa[2] += cq.z * lo_f(qv.y); qa[3] += cq.w * hi_f(qv.y);
          ka[0] += ck.x * lo_f(kv.x); ka[1] += ck.y * hi_f(kv.x); ka[2] += ck.z * lo_f(kv.y); ka[3] += ck.w * hi_f(kv.y); } }
      *(float4*)(qf + tok * 128 + d4) = make_float4(siluf_(qa[0]), siluf_(qa[1]), siluf_(qa[2]), siluf_(qa[3]));
      *(float4*)(kf + tok * 128 + d4) = make_float4(siluf_(ka[0]) * kscale, siluf_(ka[1]) * kscale, siluf_(ka[2]) * kscale, siluf_(ka[3]) * kscale); }
    { const int dvv = tid & 255, tk8 = (tid >> 8) * 8; float f[8];
      unpack8(*(const uint4*)(w.vT + (size_t)(1024 + h * 256 + dvv) * T + tb + tk8), f);
#pragma unroll
      for (int j = 0; j < 8; ++j) vf[(tk8 + j) * 256 + dvv] = f[j]; }
    if (tid < CH) { const float mi = bf2f(w.proj[(tb + tid) * NPROJ + C_SM + 16 + h]), mf = bf2f(w.proj[(tb + tid) * NPROJ + C_SM + 20 + h]);
      gt[tid * 2] = __expf(mi + ib); gt[tid * 2 + 1] = sigmoidf_(mf + fb); }
    __syncthreads();
    for (int tok = 0; tok < CH; ++tok) {
      const float vv = vf[tok * 256 + dv], ig = gt[tok * 2], fg = gt[tok * 2 + 1]; float num = 0.f, den = 0.f;
#pragma unroll
      for (int i4 = 0; i4 < 16; ++i4) {
        const float4 k = *(const float4*)(kf + tok * 128 + half * 64 + i4 * 4), q = *(const float4*)(qf + tok * 128 + half * 64 + i4 * 4);
        const float kk[4] = {k.x * ig, k.y * ig, k.z * ig, k.w * ig}; const float qq[4] = {q.x, q.y, q.z, q.w};
#pragma unroll
        for (int c = 0; c < 4; ++c) { C[i4 * 4 + c] = fg * C[i4 * 4 + c] + kk[c] * vv; num += qq[c] * C[i4 * 4 + c]; }
      }
      { const float4 k = *(const float4*)(kf + tok * 128 + nd), q = *(const float4*)(qf + tok * 128 + nd);
        n[0] = fg * n[0] + k.x * ig; n[1] = fg * n[1] + k.y * ig; n[2] = fg * n[2] + k.z * ig; n[3] = fg * n[3] + k.w * ig;
        den = q.x * n[0] + q.y * n[1] + q.z * n[2] + q.w * n[3];
        den += __shfl_xor(den, 1); den += __shfl_xor(den, 2); den += __shfl_xor(den, 4); den += __shfl_xor(den, 8); }
      op[(half * CH + tok) * 256 + dv] = num; if (dv == 0) dn[half * CH + tok] = den;
    }
    __syncthreads();
#pragma unroll
    for (int i = 0; i < 2; ++i) { const int tok = wave * 2 + i;
      const float4 o0 = *(const float4*)(op + tok * 256 + lane * 4), o1 = *(const float4*)(op + (CH + tok) * 256 + lane * 4);
      const float den = dn[tok] + dn[CH + tok];
      const float inv = 1.f / fmaxf(fabsf(den), 1.f);
      const float o[4] = {(o0.x + o1.x) * inv, (o0.y + o1.y) * inv, (o0.z + o1.z) * inv, (o0.w + o1.w) * inv};
      float ss = wave_sum(o[0] * o[0] + o[1] * o[1] + o[2] * o[2] + o[3] * o[3]);
      const float rs = rsqrtf(ss * (1.f / 256.f) + EPS);
      const uint2 mo = *(const uint2*)(w.proj + (tb + tok) * NPROJ + C_MO + h * 256 + lane * 4);
      const float4 gn = *(const float4*)(p.mlstm_norm + h * 256 + lane * 4);
      const float y0 = o[0] * rs * gn.x * sigmoidf_(lo_f(mo.x)), y1 = o[1] * rs * gn.y * sigmoidf_(hi_f(mo.x)), y2 = o[2] * rs * gn.z * sigmoidf_(lo_f(mo.y)), y3 = o[3] * rs * gn.w * sigmoidf_(hi_f(mo.y));
      *(uint2*)(w.y + (tb + tok) * D + 1024 + h * 256 + lane * 4) = make_uint2(pack2(y0, y1), pack2(y2, y3)); }
    __syncthreads();
  }
}
__device__ void phase_mixer_naive(const Params& p, const WS& w, float* lds, int bid, int nb) {
  for (int item = bid; item < 16; item += nb) {
    if (item < 8) gla_naive(p, w, item >> 2, item & 3, lds); else mlstm_naive(p, w, (item - 8) >> 2, item & 3, lds);
    __syncthreads();
  }
}

__device__ __forceinline__ unsigned sort16(unsigned b) { return (b & 0x8000u) ? (~b & 0xffffu) : (b | 0x8000u); }
__device__ __forceinline__ float unsort16(unsigned k) { const unsigned b = (k & 0x8000u) ? (k & 0x7fffu) : (~k & 0xffffu); return __uint_as_float(b << 16); }
__device__ __forceinline__ unsigned sort32(float f) { const unsigned u = __float_as_uint(f); return (u & 0x80000000u) ? ~u : (u | 0x80000000u); }
__device__ __forceinline__ float unsort32(unsigned k) { const unsigned u = (k & 0x80000000u) ? (k & 0x7fffffffu) : ~k; return __uint_as_float(u); }
__device__ void phase_topk(const Params& p, const WS& w, int bid, int nb) {
  for (int th = bid * 512 + threadIdx.x; th < T * 8; th += nb * 512) {
    const int t = th >> 3, h = th & 7;
    const uint4* s = (const uint4*)(w.sc + (size_t)t * D + h * 256);
    unsigned l[2][16];
#pragma unroll
    for (int pp = 0; pp < 2; ++pp) {
#pragma unroll
      for (int i = 0; i < 16; ++i) l[pp][i] = 0u;
      for (int q = 0; q < 16; ++q) {
        const uint4 v = s[pp * 16 + q]; const unsigned wds[4] = {v.x, v.y, v.z, v.w};
#pragma unroll
        for (int e = 0; e < 8; ++e) {
          const unsigned b = (e & 1) ? (wds[e >> 1] >> 16) : (wds[e >> 1] & 0xffffu);
          unsigned x = (sort16(b) << 16) | (unsigned)(q * 8 + e);
#pragma unroll
          for (int i = 0; i < 16; ++i) { const unsigned hi = max(l[pp][i], x); x = min(l[pp][i], x); l[pp][i] = hi; }
        }
      }
    }
    unsigned long long lc[16];
#pragma unroll
    for (int i = 0; i < 16; ++i) lc[i] = 0ull;
#pragma unroll
    for (int i = 0; i < 16; ++i)
#pragma unroll
      for (int j = 0; j < 16; ++j) if ((i + 1) * (j + 1) <= 16) {
        const float sv = unsort16(l[0][i] >> 16) + unsort16(l[1][j] >> 16);
        unsigned long long x = ((unsigned long long)sort32(sv) << 32) | (unsigned long long)((l[0][i] & 0xffffu) * 128u + (l[1][j] & 0xffffu));
#pragma unroll
        for (int k = 0; k < 16; ++k) { const bool gt = x > lc[k]; const unsigned long long hi = gt ? x : lc[k]; x = gt ? lc[k] : x; lc[k] = hi; }
      }
    const float mx = unsort32((unsigned)(lc[0] >> 32));
    float e[16], sum = 0.f;
#pragma unroll
    for (int k = 0; k < 16; ++k) { e[k] = __expf(unsort32((unsigned)(lc[k] >> 32)) - mx); sum += e[k]; }
    const float inv = 1.f / sum;
    int* ei = w.eidx + (size_t)t * 128 + h * 16; float* eg = w.eg + (size_t)t * 128 + h * 16;
#pragma unroll
    for (int k4 = 0; k4 < 4; ++k4) {
      *(int4*)(ei + k4 * 4) = make_int4((int)(lc[k4 * 4] & 0xffffffffu), (int)(lc[k4 * 4 + 1] & 0xffffffffu), (int)(lc[k4 * 4 + 2] & 0xffffffffu), (int)(lc[k4 * 4 + 3] & 0xffffffffu));
      *(float4*)(eg + k4 * 4) = make_float4(e[k4 * 4] * inv, e[k4 * 4 + 1] * inv, e[k4 * 4 + 2] * inv, e[k4 * 4 + 3] * inv);
    }
  }
}
__device__ void phase_peer(const Params& p, const WS& w, int bid, int nb) {
  const int wave = threadIdx.x >> 6, lane = threadIdx.x & 63;
  for (int t = bid * 8 + wave; t < T; t += nb * 8) {
    float hr[32], out[32];
#pragma unroll
    for (int i = 0; i < 4; ++i) unpack8(*(const uint4*)(w.h1b + (size_t)t * D + i * 512 + lane * 8), hr + i * 8);
#pragma unroll
    for (int i = 0; i < 32; ++i) out[i] = 0.f;
    const float rs2 = rsqrtf(w.ssq2[t] * (1.f / D) + EPS);
    for (int h = 0; h < 8; ++h) {
      const int idxv = w.eidx[(size_t)t * 128 + h * 16 + (lane & 15)]; const float gv = w.eg[(size_t)t * 128 + h * 16 + (lane & 15)];
#pragma unroll 4
      for (int k = 0; k < 16; ++k) {
        const int e = __shfl(idxv, k); const float g = __shfl(gv, k);
        const bf16_t* ur = w.ub + (size_t)e * D; const bf16_t* vr = w.vb + (size_t)e * D;
        float s = 0.f;
#pragma unroll
        for (int i = 0; i < 4; ++i) { float f[8]; unpack8(*(const uint4*)(ur + i * 512 + lane * 8), f);
#pragma unroll
          for (int j = 0; j < 8; ++j) s += f[j] * hr[i * 8 + j]; }
        s = wave_sum(s);
        const float wgt = g * gelu_tanh(s * rs2);
#pragma unroll
        for (int i = 0; i < 4; ++i) { float f[8]; unpack8(*(const uint4*)(vr + i * 512 + lane * 8), f);
#pragma unroll
          for (int j = 0; j < 8; ++j) out[i * 8 + j] += wgt * f[j]; }
      }
    }
    float ss = 0.f;
#pragma unroll
    for (int i = 0; i < 32; ++i) { out[i] += hr[i]; ss += out[i] * out[i]; }
    ss = wave_sum(ss);
#pragma unroll
    for (int i = 0; i < 4; ++i) *(uint4*)(w.h2b + (size_t)t * D + i * 512 + lane * 8) = pack8(out + i * 8);
    if (lane == 0) w.rstd3[t] = rsqrtf(ss * (1.f / D) + EPS);
  }
}
__device__ void phase_final(const Params& p, const WS& w, int bid, int nb) {
  const int wave = threadIdx.x >> 6, lane = threadIdx.x & 63;
  for (int row = bid * 8 + wave; row < T; row += nb * 8) {
    float4* o = (float4*)(p.out + (size_t)row * D);
    const float rs = rsqrtf(w.ssq4[row] * (1.f / D) + EPS);
#pragma unroll
    for (int i = 0; i < 8; ++i) { float4 v = o[i * 64 + lane]; const float4 g = *(const float4*)(p.norm_final + (i * 64 + lane) * 4); v.x *= rs * g.x; v.y *= rs * g.y; v.z *= rs * g.z; v.w *= rs * g.w; o[i * 64 + lane] = v; }
  }
}

constexpr int NPHASE = 10;
template <int PH>
__device__ __forceinline__ void run_phase(const Params& p, float* lds, int bid, int nb) {
  const WS w = make_ws(p.ws);
  if (PH == 0) phase_prep(p, w, lds, bid, nb);
  if (PH == 1) { gemm_naive(w.xb, w.win, T, NPROJ, D, EpiProjN{w.proj, w.rstd1}, lds, bid, nb);
                 gemm_naive(w.win + (size_t)NPROJ * D, w.xb, 2048, T, D, EpiProjT{w.vT, w.rstd1}, lds, bid, nb); }
  if (PH == 2) phase_mixer_naive(p, w, lds, bid, nb);
  if (PH == 3) gemm_naive(w.y, w.wout, T, D, D, EpiOut{p.x, w.h1b, w.ssq2}, lds, bid, nb);
  if (PH == 4) gemm_naive(w.h1b, w.wq, T, D, D, EpiScore{w.sc, w.ssq2}, lds, bid, nb);
  if (PH == 5) { phase_topk(p, w, bid, nb); gemm_naive(w.pb, w.wple, T, D, 256, EpiPl{w.pl}, lds, bid, nb); }
  if (PH == 6) phase_peer(p, w, bid, nb);
  if (PH == 7) gemm_naive(w.h2b, w.wg, T, D, D, EpiGate{w.h2b, w.pl, w.rstd3, p.out, w.ssq4}, lds, bid, nb);
  if (PH == 8) phase_final(p, w, bid, nb);
}

extern __shared__ __attribute__((aligned(16))) unsigned char dyn_lds[];

#if ONE_LAUNCH
__global__ void __launch_bounds__(512, 2) mega(Params p) {
  cg::grid_group grid = cg::this_grid();
  float* lds = (float*)dyn_lds; const int bid = blockIdx.x, nb = gridDim.x;
  run_phase<0>(p, lds, bid, nb); grid.sync();
  run_phase<1>(p, lds, bid, nb); grid.sync();
  run_phase<2>(p, lds, bid, nb); grid.sync();
  run_phase<3>(p, lds, bid, nb); grid.sync();
  run_phase<4>(p, lds, bid, nb); grid.sync();
  run_phase<5>(p, lds, bid, nb); grid.sync();
  run_phase<6>(p, lds, bid, nb); grid.sync();
  run_phase<7>(p, lds, bid, nb); grid.sync();
  run_phase<8>(p, lds, bid, nb);
}
#else
template <int PH> __global__ void __launch_bounds__(512, 2) k_phase(Params p) { run_phase<PH>(p, (float*)dyn_lds, blockIdx.x, gridDim.x); }
#endif

constexpr size_t kDynLds = 131072;

extern "C" void kernel_launch(void* const* d_in, const int* in_sizes, int n_in, void* d_out, int out_size, void* d_ws, size_t ws_size, hipStream_t stream) {
  if (n_in != 22 || out_size != T * D || ws_size < WS_NEED) { fprintf(stderr, "kernel_launch: unexpected shapes (n_in %d out %d ws %zu)\n", n_in, out_size, ws_size); return; }
  Params p{};
  const float** f = (const float**)&p;
  for (int i = 0; i < 22; ++i) f[i] = (const float*)d_in[i];
  p.out = (float*)d_out; p.ws = (unsigned char*)d_ws;
#if ONE_LAUNCH
  static int grid_blocks = 0;
  if (!grid_blocks) {
    int dev = 0, cus = 0, per_cu = 0;
    (void)hipGetDevice(&dev); (void)hipDeviceGetAttribute(&cus, hipDeviceAttributeMultiprocessorCount, dev);
    (void)hipFuncSetAttribute((const void*)mega, hipFuncAttributeMaxDynamicSharedMemorySize, (int)kDynLds);
    (void)hipOccupancyMaxActiveBlocksPerMultiprocessor(&per_cu, mega, 512, kDynLds);
    if (per_cu < 1) { fprintf(stderr, "occupancy query says 0 blocks/CU\n"); per_cu = 1; }
    grid_blocks = cus;
  }
  void* args[] = {&p};
  hipError_t e = hipLaunchCooperativeKernel((void*)mega, dim3(grid_blocks), dim3(512), args, kDynLds, stream);
  if (e != hipSuccess) fprintf(stderr, "cooperative launch failed: %s (grid %d)\n", hipGetErrorString(e), grid_blocks);
#else
  static bool attr = false;
  const int G = 256;
#define LAUNCH(PH) do { if (!attr) (void)hipFuncSetAttribute((const void*)k_phase<PH>, hipFuncAttributeMaxDynamicSharedMemorySize, (int)kDynLds); \
    hipLaunchKernelGGL(k_phase<PH>, dim3(G), dim3(512), kDynLds, stream, p); } while (0)
  LAUNCH(0); LAUNCH(1); LAUNCH(2); LAUNCH(3); LAUNCH(4); LAUNCH(5); LAUNCH(6); LAUNCH(7); LAUNCH(8);
  attr = true;
#undef LAUNCH
#endif
}
```

```cpp
#include <hip/hip_runtime.h>
#include <hip/hip_cooperative_groups.h>
#include <cstdio>
#include <cstdint>
namespace cg = cooperative_groups;

#ifndef ONE_LAUNCH
#define ONE_LAUNCH 1
#endif

typedef unsigned short bf16_t;
constexpr int T = 32768, SEQ = 16384, D = 2048;
constexpr int NPROJ = 4352;
constexpr int C_GQ = 0, C_GK = 512, C_GG = 1024, C_MQ = 2048, C_MK = 2560, C_MO = 3072, C_SM = 4096;
constexpr float EPS = 1e-6f;
constexpr size_t MiB = 1ull << 20;
constexpr size_t OFF_XB = 0, OFF_Y = 0, OFF_PL = 0;
constexpr size_t OFF_PROJ = 128 * MiB, OFF_H1B = 128 * MiB, OFF_H2B = 256 * MiB;
constexpr size_t OFF_VT = 400 * MiB, OFF_SC = 400 * MiB;
constexpr size_t OFF_UB = 528 * MiB, OFF_VB = 592 * MiB;
constexpr size_t OFF_WIN = 656 * MiB, OFF_WOUT = 681 * MiB, OFF_WQ = 689 * MiB, OFF_WG = 697 * MiB, OFF_WPLE = 705 * MiB;
constexpr size_t OFF_PB = 706 * MiB, OFF_EIDX = 722 * MiB, OFF_EG = 738 * MiB, OFF_MISC = 754 * MiB;
constexpr size_t WS_NEED = 760 * MiB;

struct Params {
  const float *x, *p, *norm_mix, *w_in, *gate_up, *gate_bias, *gla_norm, *conv_w, *conv_b, *ig_bias, *fg_bias, *mlstm_norm,
      *w_out, *norm_ffn, *peer_query, *sub_keys, *peer_u, *peer_v, *norm_ple, *w_ple, *w_ple_gate, *norm_final;
  float* out;
  unsigned char* ws;
};

__device__ __forceinline__ float bf2f(bf16_t b) { return __uint_as_float(((unsigned)b) << 16); }
__device__ __forceinline__ bf16_t f2bf(float f) { unsigned u = __float_as_uint(f); u += 0x7FFFu + ((u >> 16) & 1u); return (bf16_t)(u >> 16); }
__device__ __forceinline__ unsigned pack2(float lo, float hi) { return (unsigned)f2bf(lo) | ((unsigned)f2bf(hi) << 16); }
__device__ __forceinline__ float lo_f(unsigned u) { return __uint_as_float(u << 16); }
__device__ __forceinline__ float hi_f(unsigned u) { return __uint_as_float(u & 0xffff0000u); }
__device__ __forceinline__ float wave_sum(float v) {
#pragma unroll
  for (int o = 32; o >= 1; o >>= 1) v += __shfl_xor(v, o);
  return v;
}
__device__ __forceinline__ float sigmoidf_(float x) { return 1.f / (1.f + __expf(-x)); }
__device__ __forceinline__ float siluf_(float x) { return x / (1.f + __expf(-x)); }
__device__ __forceinline__ float logsigmoidf_(float x) { return fminf(x, 0.f) - log1pf(__expf(-fabsf(x))); }
__device__ __forceinline__ float gelu_tanh(float x) { const float u = 0.7978845608028654f * (x + 0.044715f * x * x * x); return 0.5f * x * (1.f + tanhf(u)); }
__device__ __forceinline__ void unpack8(const uint4 q, float* f) {
  f[0] = lo_f(q.x); f[1] = hi_f(q.x); f[2] = lo_f(q.y); f[3] = hi_f(q.y); f[4] = lo_f(q.z); f[5] = hi_f(q.z); f[6] = lo_f(q.w); f[7] = hi_f(q.w);
}
__device__ __forceinline__ uint4 pack8(const float* f) { return make_uint4(pack2(f[0], f[1]), pack2(f[2], f[3]), pack2(f[4], f[5]), pack2(f[6], f[7])); }

struct WS {
  bf16_t *xb, *y, *pl, *proj, *h1b, *h2b, *vT, *sc, *ub, *vb, *win, *wout, *wq, *wg, *wple, *pb;
  int* eidx; float* eg; float *rstd1, *ssq2, *rstd3, *ssq4;
};
__device__ __forceinline__ WS make_ws(unsigned char* ws) {
  WS w;
  w.xb = (bf16_t*)(ws + OFF_XB); w.y = (bf16_t*)(ws + OFF_Y); w.pl = (bf16_t*)(ws + OFF_PL); w.proj = (bf16_t*)(ws + OFF_PROJ);
  w.h1b = (bf16_t*)(ws + OFF_H1B); w.h2b = (bf16_t*)(ws + OFF_H2B); w.vT = (bf16_t*)(ws + OFF_VT); w.sc = (bf16_t*)(ws + OFF_SC);
  w.ub = (bf16_t*)(ws + OFF_UB); w.vb = (bf16_t*)(ws + OFF_VB); w.win = (bf16_t*)(ws + OFF_WIN); w.wout = (bf16_t*)(ws + OFF_WOUT);
  w.wq = (bf16_t*)(ws + OFF_WQ); w.wg = (bf16_t*)(ws + OFF_WG); w.wple = (bf16_t*)(ws + OFF_WPLE); w.pb = (bf16_t*)(ws + OFF_PB);
  w.eidx = (int*)(ws + OFF_EIDX); w.eg = (float*)(ws + OFF_EG);
  float* m = (float*)(ws + OFF_MISC); w.rstd1 = m; w.ssq2 = m + T; w.rstd3 = m + 2 * T; w.ssq4 = m + 3 * T;
  return w;
}

__device__ void prep_x(const Params& p, const WS& w, int bid, int nb) {
  const int wave = threadIdx.x >> 6, lane = threadIdx.x & 63;
  for (int row = bid * 8 + wave; row < T; row += nb * 8) {
    const float4* src = (const float4*)(p.x + (size_t)row * D);
    uint2* dst = (uint2*)(w.xb + (size_t)row * D);
    float ss = 0.f;
#pragma unroll
    for (int i = 0; i < 8; ++i) { const float4 v = src[i * 64 + lane]; ss += v.x * v.x + v.y * v.y + v.z * v.z + v.w * v.w; dst[i * 64 + lane] = make_uint2(pack2(v.x, v.y), pack2(v.z, v.w)); }
    ss = wave_sum(ss);
    if (lane == 0) w.rstd1[row] = rsqrtf(ss * (1.f / D) + EPS);
  }
}
__device__ void cvt_rows(const float* src, bf16_t* dst, size_t n, const float* gain, int ncols, int bid, int nb) {
  const size_t n4 = n / 4;
  for (size_t i = (size_t)bid * 512 + threadIdx.x; i < n4; i += (size_t)nb * 512) {
    float4 v = ((const float4*)src)[i];
    if (gain) { const float4 g = *(const float4*)(gain + (int)((i * 4) % (size_t)ncols)); v.x *= g.x; v.y *= g.y; v.z *= g.z; v.w *= g.w; }
    ((uint2*)dst)[i] = make_uint2(pack2(v.x, v.y), pack2(v.z, v.w));
  }
}
template <class CM>
__device__ void transpose_w(const float* src, int K, int ldsrc, bf16_t* dst, int Ndst, const float* gain, CM cm, float* lds, int bid, int nb) {
  const int tid = threadIdx.x, tk = K / 64, ntile = (Ndst / 64) * tk;
  for (int tile = bid; tile < ntile; tile += nb) {
    const int n0 = (tile / tk) * 64, k0 = (tile % tk) * 64;
    const int nc = tid & 63, sc = cm(n0 + nc);
#pragma unroll
    for (int i = 0; i < 8; ++i) { const int kr = (tid >> 6) + 8 * i; float v = 0.f; if (sc >= 0) { v = src[(size_t)(k0 + kr) * ldsrc + sc]; if (gain) v *= gain[k0 + kr]; } lds[kr * 65 + nc] = v; }
    __syncthreads();
    { const int nr = tid >> 3, ks = (tid & 7) * 8; float f[8];
#pragma unroll
      for (int j = 0; j < 8; ++j) f[j] = lds[(ks + j) * 65 + nr];
      *(uint4*)(dst + (size_t)(n0 + nr) * K + k0 + ks) = pack8(f); }
    __syncthreads();
  }
}
struct CmIdent { __device__ int operator()(int n) const { return n; } };
struct CmWin {
  __device__ int operator()(int n) const {
    if (n < 1024) return n;
    if (n < 2048) return 2048 + (n - 1024);
    if (n < 2560) return 3088 + (n - 2048);
    if (n < 3072) return 3600 + (n - 2560);
    if (n < 4096) return 5136 + (n - 3072);
    if (n < 4352) { const int i = n - 4096; if (i < 16) return 3072 + i; if (i < 20) return 6160 + (i - 16); if (i < 24) return 6164 + (i - 20); return -1; }
    const int j = n - 4352; if (j < 1024) return 1024 + j;
    return 4112 + (j - 1024);
  }
};
__device__ void prep_wq(const Params& p, const WS& w, float* lds, int bid, int nb) {
  const int tid = threadIdx.x;
  float* SKs = lds;
  float* WQs = lds + 128 * 132;
  for (int item = bid; item < 16 * 32; item += nb) {
    const int hp = item >> 5, k0 = (item & 31) * 64;
#pragma unroll
    for (int i = 0; i < 8; ++i) { const int e4 = tid + 512 * i, key = e4 >> 5, d4 = (e4 & 31) * 4; *(float4*)(SKs + key * 132 + d4) = *(const float4*)(p.sub_keys + (size_t)hp * 16384 + key * 128 + d4); }
#pragma unroll
    for (int i = 0; i < 4; ++i) { const int e4 = tid + 512 * i, kr = e4 >> 5, d4 = (e4 & 31) * 4; float4 v = *(const float4*)(p.peer_query + (size_t)(k0 + kr) * 2048 + hp * 128 + d4); const float g = p.norm_ffn[k0 + kr]; v.x *= g; v.y *= g; v.z *= g; v.w *= g; *(float4*)(WQs + kr * 132 + d4) = v; }
    __syncthreads();
    const int k = tid & 63, kg = tid >> 6;
    float acc[16];
#pragma unroll
    for (int j = 0; j < 16; ++j) acc[j] = 0.f;
    for (int d4 = 0; d4 < 32; ++d4) {
      const float4 a = *(const float4*)(WQs + k * 132 + d4 * 4);
#pragma unroll
      for (int j = 0; j < 16; ++j) { const float4 s = *(const float4*)(SKs + (kg * 16 + j) * 132 + d4 * 4); acc[j] += a.x * s.x + a.y * s.y + a.z * s.z + a.w * s.w; }
    }
#pragma unroll
    for (int j = 0; j < 16; ++j) w.wq[(size_t)(hp * 128 + kg * 16 + j) * 2048 + k0 + k] = f2bf(acc[j]);
    __syncthreads();
  }
}
__device__ void phase_prep(const Params& p, const WS& w, float* lds, int bid, int nb) {
  prep_x(p, w, bid, nb);
  cvt_rows(p.p, w.pb, (size_t)T * 256, nullptr, 256, bid, nb);
  cvt_rows(p.peer_u, w.ub, (size_t)16384 * 2048, p.norm_ffn, 2048, bid, nb);
  cvt_rows(p.peer_v, w.vb, (size_t)16384 * 2048, nullptr, 2048, bid, nb);
  transpose_w(p.w_in, 2048, 6168, w.win, 6400, p.norm_mix, CmWin(), lds, bid, nb);
  transpose_w(p.w_out, 2048, 2048, w.wout, 2048, nullptr, CmIdent(), lds, bid, nb);
  transpose_w(p.w_ple_gate, 2048, 2048, w.wg, 2048, p.norm_ple, CmIdent(), lds, bid, nb);
  transpose_w(p.w_ple, 256, 2048, w.wple, 2048, nullptr, CmIdent(), lds, bid, nb);
  prep_wq(p, w, lds, bid, nb);
  for (int i = bid * 512 + threadIdx.x; i < T; i += nb * 512) { w.ssq2[i] = 0.f; w.ssq4[i] = 0.f; }
}

struct EpiProjN { bf16_t* out; const float* rstd; static constexpr bool ROWSUM = false;
  __device__ __forceinline__ float store8(int r, int c, const float* v) const { const float s = rstd[r]; float f[8];
#pragma unroll
    for (int j = 0; j < 8; ++j) f[j] = v[j] * s;
    *(uint4*)(out + (size_t)r * NPROJ + c) = pack8(f); return 0.f; }
  __device__ __forceinline__ void rowsum(int, float) const {} };
struct EpiProjT { bf16_t* out; const float* rstd; static constexpr bool ROWSUM = false;
  __device__ __forceinline__ float store8(int r, int c, const float* v) const { const float4 s0 = *(const float4*)(rstd + c), s1 = *(const float4*)(rstd + c + 4); float f[8];
    f[0] = v[0] * s0.x; f[1] = v[1] * s0.y; f[2] = v[2] * s0.z; f[3] = v[3] * s0.w; f[4] = v[4] * s1.x; f[5] = v[5] * s1.y; f[6] = v[6] * s1.z; f[7] = v[7] * s1.w;
    *(uint4*)(out + (size_t)r * T + c) = pack8(f); return 0.f; }
  __device__ __forceinline__ void rowsum(int, float) const {} };
struct EpiOut { const float* x; bf16_t* h1b; float* ssq; static constexpr bool ROWSUM = true;
  __device__ __forceinline__ float store8(int r, int c, const float* v) const { const float4 x0 = *(const float4*)(x + (size_t)r * D + c), x1 = *(const float4*)(x + (size_t)r * D + c + 4); float f[8];
    f[0] = v[0] + x0.x; f[1] = v[1] + x0.y; f[2] = v[2] + x0.z; f[3] = v[3] + x0.w; f[4] = v[4] + x1.x; f[5] = v[5] + x1.y; f[6] = v[6] + x1.z; f[7] = v[7] + x1.w;
    float s = 0.f;
#pragma unroll
    for (int j = 0; j < 8; ++j) s += f[j] * f[j];
    *(uint4*)(h1b + (size_t)r * D + c) = pack8(f); return s; }
  __device__ __forceinline__ void rowsum(int r, float s) const { atomicAdd(ssq + r, s); } };
struct EpiScore { bf16_t* sc; const float* ssq; static constexpr bool ROWSUM = false;
  __device__ __forceinline__ float store8(int r, int c, const float* v) const { const float s = rsqrtf(ssq[r] * (1.f / D) + EPS); float f[8];
#pragma unroll
    for (int j = 0; j < 8; ++j) f[j] = v[j] * s;
    *(uint4*)(sc + (size_t)r * D + c) = pack8(f); return 0.f; }
  __device__ __forceinline__ void rowsum(int, float) const {} };
struct EpiPl { bf16_t* pl; static constexpr bool ROWSUM = false;
  __device__ __forceinline__ float store8(int r, int c, const float* v) const { *(uint4*)(pl + (size_t)r * D + c) = pack8(v); return 0.f; }
  __device__ __forceinline__ void rowsum(int, float) const {} };
struct EpiGate { const bf16_t* h2b; const bf16_t* pl; const float* rstd3; float* out; float* ssq; static constexpr bool ROWSUM = true;
  __device__ __forceinline__ float store8(int r, int c, const float* v) const { const float rs = rstd3[r]; float h[8], q[8], f[8];
    unpack8(*(const uint4*)(h2b + (size_t)r * D + c), h); unpack8(*(const uint4*)(pl + (size_t)r * D + c), q);
    float s = 0.f;
#pragma unroll
    for (int j = 0; j < 8; ++j) { f[j] = h[j] + sigmoidf_(v[j] * rs) * q[j]; s += f[j] * f[j]; }
    *(float4*)(out + (size_t)r * D + c) = make_float4(f[0], f[1], f[2], f[3]); *(float4*)(out + (size_t)r * D + c + 4) = make_float4(f[4], f[5], f[6], f[7]); return s; }
  __device__ __forceinline__ void rowsum(int r, float s) const { atomicAdd(ssq + r, s); } };

template <class Epi>
__device__ void gemm_naive(const bf16_t* A, const bf16_t* Bt, int M, int N, int K, const Epi& E, float* lds, int bid, int nb) {
  const int tid = threadIdx.x, ty = tid >> 4, tx = tid & 15;
  float* As = lds;
  float* Bs = lds + 32 * 132;
  const int nM = M / 128, nN = N / 128;
  for (int tile = bid; tile < nM * nN; tile += nb) {
    const int m0 = (tile % nM) * 128, n0 = (tile / nM) * 128;
    float acc[4][8];
#pragma unroll
    for (int i = 0; i < 4; ++i)
#pragma unroll
      for (int j = 0; j < 8; ++j) acc[i][j] = 0.f;
    const int lr = tid >> 2, lk = (tid & 3) * 8;
    for (int k0 = 0; k0 < K; k0 += 32) {
      const uint4 av = *(const uint4*)(A + (size_t)(m0 + lr) * K + k0 + lk);
      const uint4 bv = *(const uint4*)(Bt + (size_t)(n0 + lr) * K + k0 + lk);
      float af[8], bf[8]; unpack8(av, af); unpack8(bv, bf);
      __syncthreads();
#pragma unroll
      for (int j = 0; j < 8; ++j) { As[(lk + j) * 132 + lr] = af[j]; Bs[(lk + j) * 132 + lr] = bf[j]; }
      __syncthreads();
#pragma unroll 8
      for (int kk = 0; kk < 32; ++kk) {
        const float4 a = *(const float4*)(As + kk * 132 + ty * 4);
        const float4 b0 = *(const float4*)(Bs + kk * 132 + tx * 8), b1 = *(const float4*)(Bs + kk * 132 + tx * 8 + 4);
        const float aa[4] = {a.x, a.y, a.z, a.w}; const float bb[8] = {b0.x, b0.y, b0.z, b0.w, b1.x, b1.y, b1.z, b1.w};
#pragma unroll
        for (int i = 0; i < 4; ++i)
#pragma unroll
          for (int j = 0; j < 8; ++j) acc[i][j] += aa[i] * bb[j];
      }
    }
#pragma unroll
    for (int i = 0; i < 4; ++i) {
      const int r = m0 + ty * 4 + i;
      float s = E.store8(r, n0 + tx * 8, acc[i]);
      if (Epi::ROWSUM) { s += __shfl_xor(s, 1); s += __shfl_xor(s, 2); s += __shfl_xor(s, 4); s += __shfl_xor(s, 8); if (tx == 0) E.rowsum(r, s); }
    }
  }
}

__device__ void gla_naive(const Params& p, const WS& w, int b, int h, float* lds) {
  constexpr int CH = 16;
  const int tid = threadIdx.x, dv = tid & 255, half = tid >> 8, wave = tid >> 6, lane = tid & 63;
  float* qf = lds; float* kf = qf + CH * 128; float* af = kf + CH * 128; float* vf = af + CH * 128; float* op = vf + CH * 256;
  float S[64];
#pragma unroll
  for (int i = 0; i < 64; ++i) S[i] = 0.f;
  const int gd = tid & 127;
  float gu[16];
#pragma unroll
  for (int r = 0; r < 16; ++r) gu[r] = p.gate_up[r * 512 + h * 128 + gd];
  const float gb = p.gate_bias[h * 128 + gd];
  const float qscale = 0.08838834764831845f;
  for (int t0 = 0; t0 < SEQ; t0 += CH) {
    const size_t tb = (size_t)b * SEQ + t0;
    { const int tok = tid >> 5, d4 = (tid & 31) * 4;
      const uint2 qv = *(const uint2*)(w.proj + (tb + tok) * NPROJ + C_GQ + h * 128 + d4);
      const uint2 kv = *(const uint2*)(w.proj + (tb + tok) * NPROJ + C_GK + h * 128 + d4);
      *(float4*)(qf + tok * 128 + d4) = make_float4(lo_f(qv.x) * qscale, hi_f(qv.x) * qscale, lo_f(qv.y) * qscale, hi_f(qv.y) * qscale);
      *(float4*)(kf + tok * 128 + d4) = make_float4(lo_f(kv.x), hi_f(kv.x), lo_f(kv.y), hi_f(kv.y)); }
    { const int dvv = tid & 255, tk8 = (tid >> 8) * 8; float f[8];
      unpack8(*(const uint4*)(w.vT + (size_t)(h * 256 + dvv) * T + tb + tk8), f);
#pragma unroll
      for (int j = 0; j < 8; ++j) vf[(tk8 + j) * 256 + dvv] = f[j]; }
#pragma unroll
    for (int i = 0; i < 4; ++i) { const int tok = (tid >> 7) * 4 + i; float z = gb; float gl[16];
      unpack8(*(const uint4*)(w.proj + (tb + tok) * NPROJ + C_SM), gl); unpack8(*(const uint4*)(w.proj + (tb + tok) * NPROJ + C_SM + 8), gl + 8);
#pragma unroll
      for (int r = 0; r < 16; ++r) z += gl[r] * gu[r];
      af[tok * 128 + gd] = __expf(logsigmoidf_(z) * (1.f / 16.f)); }
    __syncthreads();
    for (int tok = 0; tok < CH; ++tok) {
      const float vv = vf[tok * 256 + dv]; float acc = 0.f;
#pragma unroll
      for (int i4 = 0; i4 < 16; ++i4) {
        const float4 a = *(const float4*)(af + tok * 128 + half * 64 + i4 * 4), k = *(const float4*)(kf + tok * 128 + half * 64 + i4 * 4), q = *(const float4*)(qf + tok * 128 + half * 64 + i4 * 4);
        S[i4 * 4 + 0] = a.x * S[i4 * 4 + 0] + k.x * vv; acc += q.x * S[i4 * 4 + 0];
        S[i4 * 4 + 1] = a.y * S[i4 * 4 + 1] + k.y * vv; acc += q.y * S[i4 * 4 + 1];
        S[i4 * 4 + 2] = a.z * S[i4 * 4 + 2] + k.z * vv; acc += q.z * S[i4 * 4 + 2];
        S[i4 * 4 + 3] = a.w * S[i4 * 4 + 3] + k.w * vv; acc += q.w * S[i4 * 4 + 3];
      }
      op[(half * CH + tok) * 256 + dv] = acc;
    }
    __syncthreads();
#pragma unroll
    for (int i = 0; i < 2; ++i) { const int tok = wave * 2 + i;
      const float4 o0 = *(const float4*)(op + tok * 256 + lane * 4), o1 = *(const float4*)(op + (CH + tok) * 256 + lane * 4);
      const float o[4] = {o0.x + o1.x, o0.y + o1.y, o0.z + o1.z, o0.w + o1.w};
      float ss = wave_sum(o[0] * o[0] + o[1] * o[1] + o[2] * o[2] + o[3] * o[3]);
      const float rs = rsqrtf(ss * (1.f / 256.f) + EPS);
      const uint2 gg = *(const uint2*)(w.proj + (tb + tok) * NPROJ + C_GG + h * 256 + lane * 4);
      const float4 gn = *(const float4*)(p.gla_norm + h * 256 + lane * 4);
      const float y0 = o[0] * rs * gn.x * siluf_(lo_f(gg.x)), y1 = o[1] * rs * gn.y * siluf_(hi_f(gg.x)), y2 = o[2] * rs * gn.z * siluf_(lo_f(gg.y)), y3 = o[3] * rs * gn.w * siluf_(hi_f(gg.y));
      *(uint2*)(w.y + (tb + tok) * D + h * 256 + lane * 4) = make_uint2(pack2(y0, y1), pack2(y2, y3)); }
    __syncthreads();
  }
}
__device__ void mlstm_naive(const Params& p, const WS& w, int b, int h, float* lds) {
  constexpr int CH = 16;
  const int tid = threadIdx.x, dv = tid & 255, half = tid >> 8, wave = tid >> 6, lane = tid & 63;
  float* qf = lds; float* kf = qf + CH * 128; float* vf = kf + CH * 128; float* op = vf + CH * 256; float* dn = op + 2 * CH * 256; float* gt = dn + 2 * CH * 256;
  float C[64], n[4];
#pragma unroll
  for (int i = 0; i < 64; ++i) C[i] = 0.f;
#pragma unroll
  for (int i = 0; i < 4; ++i) n[i] = 0.f;
  const int nd = half * 64 + (dv & 15) * 4;
  const float kscale = 0.08838834764831845f;
  const float ib = p.ig_bias[h], fb = p.fg_bias[h];
  for (int t0 = 0; t0 < SEQ; t0 += CH) {
    const size_t tb = (size_t)b * SEQ + t0;
    { const int tok = tid >> 5, d4 = (tid & 31) * 4;
      float qa[4], ka[4];
#pragma unroll
      for (int c = 0; c < 4; ++c) { qa[c] = p.conv_b[h * 128 + d4 + c]; ka[c] = p.conv_b[512 + h * 128 + d4 + c]; }
#pragma unroll
      for (int wi = 0; wi < 4; ++wi) { const int ts = t0 + tok - 3 + wi;
        if (ts >= 0) { const size_t tr = (size_t)b * SEQ + ts;
          const uint2 qv = *(const uint2*)(w.proj + tr * NPROJ + C_MQ + h * 128 + d4), kv = *(const uint2*)(w.proj + tr * NPROJ + C_MK + h * 128 + d4);
          const float4 cq = *(const float4*)(p.conv_w + wi * 1024 + h * 128 + d4), ck = *(const float4*)(p.conv_w + wi * 1024 + 512 + h * 128 + d4);
          qa[0] += cq.x * lo_f(qv.x); qa[1] += cq.y * hi_f(qv.x); qa[2] += cq.z * lo_f(qv.y); qa[3] += cq.w * hi_f(qv.y);
          ka[0] += ck.x * lo_f(kv.x); ka[1] += ck.y * hi_f(kv.x); ka[2] += ck.z * lo_f(kv.y); ka[3] += ck.w * hi_f(kv.y); } }
      *(float4*)(qf + tok * 128 + d4) = make_float4(siluf_(qa[0]), siluf_(qa[1]), siluf_(qa[2]), siluf_(qa[3]));
      *(float4*)(kf + tok * 128 + d4) = make_float4(siluf_(ka[0]) * kscale, siluf_(ka[1]) * kscale, siluf_(ka[2]) * kscale, siluf_(ka[3]) * kscale); }
    { const int dvv = tid & 255, tk8 = (tid >> 8) * 8; float f[8];
      unpack8(*(const uint4*)(w.vT + (size_t)(1024 + h * 256 + dvv) * T + tb + tk8), f);
#pragma unroll
      for (int j = 0; j < 8; ++j) vf[(tk8 + j) * 256 + dvv] = f[j]; }
    if (tid < CH) { const float mi = bf2f(w.proj[(tb + tid) * NPROJ + C_SM + 16 + h]), mf = bf2f(w.proj[(tb + tid) * NPROJ + C_SM + 20 + h]);
      gt[tid * 2] = __expf(mi + ib); gt[tid * 2 + 1] = sigmoidf_(mf + fb); }
    __syncthreads();
    for (int tok = 0; tok < CH; ++tok) {
      const float vv = vf[tok * 256 + dv], ig = gt[tok * 2], fg = gt[tok * 2 + 1]; float num = 0.f, den = 0.f;
#pragma unroll
      for (int i4 = 0; i4 < 16; ++i4) {
        const float4 k = *(const float4*)(kf + tok * 128 + half * 64 + i4 * 4), q = *(const float4*)(qf + tok * 128 + half * 64 + i4 * 4);
        const float kk[4] = {k.x * ig, k.y * ig, k.z * ig, k.w * ig}; const float qq[4] = {q.x, q.y, q.z, q.w};
#pragma unroll
        for (int c = 0; c < 4; ++c) { C[i4 * 4 + c] = fg * C[i4 * 4 + c] + kk[c] * vv; num += qq[c] * C[i4 * 4 + c]; }
      }
      { const float4 k = *(const float4*)(kf + tok * 128 + nd), q = *(const float4*)(qf + tok * 128 + nd);
        n[0] = fg * n[0] + k.x * ig; n[1] = fg * n[1] + k.y * ig; n[2] = fg * n[2] + k.z * ig; n[3] = fg * n[3] + k.w * ig;
        den = q.x * n[0] + q.y * n[1] + q.z * n[2] + q.w * n[3];
        den += __shfl_xor(den, 1); den += __shfl_xor(den, 2); den += __shfl_xor(den, 4); den += __shfl_xor(den, 8); }
      op[(half * CH + tok) * 256 + dv] = num; if (dv == 0) dn[half * CH + tok] = den;
    }
    __syncthreads();
#pragma unroll
    for (int i = 0; i < 2; ++i) { const int tok = wave * 2 + i;
      const float4 o0 = *(const float4*)(op + tok * 256 + lane * 4), o1 = *(const float4*)(op + (CH + tok) * 256 + lane * 4);
      const float den = dn[tok] + dn[CH + tok];
      const float inv = 1.f / fmaxf(fabsf(den), 1.f);
      const float o[4] = {(o0.x + o1.x) * inv, (o0.y + o1.y) * inv, (o0.z + o1.z) * inv, (o0.w + o1.w) * inv};
      float ss = wave_sum(o[0] * o[0] + o[1] * o[1] + o[2] * o[2] + o[3] * o[3]);
      const float rs = rsqrtf(ss * (1.f / 256.f) + EPS);
      const uint2 mo = *(const uint2*)(w.proj + (tb + tok) * NPROJ + C_MO + h * 256 + lane * 4);
      const float4 gn = *(const float4*)(p.mlstm_norm + h * 256 + lane * 4);
      const float y0 = o[0] * rs * gn.x * sigmoidf_(lo_f(mo.x)), y1 = o[1] * rs * gn.y * sigmoidf_(hi_f(mo.x)), y2 = o[2] * rs * gn.z * sigmoidf_(lo_f(mo.y)), y3 = o[3] * rs * gn.w * sigmoidf_(hi_f(mo.y));
      *(uint2*)(w.y + (tb + tok) * D + 1024 + h * 256 + lane * 4) = make_uint2(pack2(y0, y1), pack2(y2, y3)); }
    __syncthreads();
  }
}
__device__ void phase_mixer_naive(const Params& p, const WS& w, float* lds, int bid, int nb) {
  for (int item = bid; item < 16; item += nb) {
    if (item < 8) gla_naive(p, w, item >> 2, item & 3, lds); else mlstm_naive(p, w, (item - 8) >> 2, item & 3, lds);
    __syncthreads();
  }
}

__device__ __forceinline__ unsigned sort16(unsigned b) { return (b & 0x8000u) ? (~b & 0xffffu) : (b | 0x8000u); }
__device__ __forceinline__ float unsort16(unsigned k) { const unsigned b = (k & 0x8000u) ? (k & 0x7fffu) : (~k & 0xffffu); return __uint_as_float(b << 16); }
__device__ __forceinline__ unsigned sort32(float f) { const unsigned u = __float_as_uint(f); return (u & 0x80000000u) ? ~u : (u | 0x80000000u); }
__device__ __forceinline__ float unsort32(unsigned k) { const unsigned u = (k & 0x80000000u) ? (k & 0x7fffffffu) : ~k; return __uint_as_float(u); }
__device__ void phase_topk(const Params& p, const WS& w, int bid, int nb) {
  for (int th = bid * 512 + threadIdx.x; th < T * 8; th += nb * 512) {
    const int t = th >> 3, h = th & 7;
    const uint4* s = (const uint4*)(w.sc + (size_t)t * D + h * 256);
    unsigned l[2][16];
#pragma unroll
    for (int pp = 0; pp < 2; ++pp) {
#pragma unroll
      for (int i = 0; i < 16; ++i) l[pp][i] = 0u;
      for (int q = 0; q < 16; ++q) {
        const uint4 v = s[pp * 16 + q]; const unsigned wds[4] = {v.x, v.y, v.z, v.w};
#pragma unroll
        for (int e = 0; e < 8; ++e) {
          const unsigned b = (e & 1) ? (wds[e >> 1] >> 16) : (wds[e >> 1] & 0xffffu);
          unsigned x = (sort16(b) << 16) | (unsigned)(q * 8 + e);
#pragma unroll
          for (int i = 0; i < 16; ++i) { const unsigned hi = max(l[pp][i], x); x = min(l[pp][i], x); l[pp][i] = hi; }
        }
      }
    }
    unsigned long long lc[16];
#pragma unroll
    for (int i = 0; i < 16; ++i) lc[i] = 0ull;
#pragma unroll
    for (int i = 0; i < 16; ++i)
#pragma unroll
      for (int j = 0; j < 16; ++j) if ((i + 1) * (j + 1) <= 16) {
        const float sv = unsort16(l[0][i] >> 16) + unsort16(l[1][j] >> 16);
        unsigned long long x = ((unsigned long long)sort32(sv) << 32) | (unsigned long long)((l[0][i] & 0xffffu) * 128u + (l[1][j] & 0xffffu));
#pragma unroll
        for (int k = 0; k < 16; ++k) { const bool gt = x > lc[k]; const unsigned long long hi = gt ? x : lc[k]; x = gt ? lc[k] : x; lc[k] = hi; }
      }
    const float mx = unsort32((unsigned)(lc[0] >> 32));
    float e[16], sum = 0.f;
#pragma unroll
    for (int k = 0; k < 16; ++k) { e[k] = __expf(unsort32((unsigned)(lc[k] >> 32)) - mx); sum += e[k]; }
    const float inv = 1.f / sum;
    int* ei = w.eidx + (size_t)t * 128 + h * 16; float* eg = w.eg + (size_t)t * 128 + h * 16;
#pragma unroll
    for (int k4 = 0; k4 < 4; ++k4) {
      *(int4*)(ei + k4 * 4) = make_int4((int)(lc[k4 * 4] & 0xffffffffu), (int)(lc[k4 * 4 + 1] & 0xffffffffu), (int)(lc[k4 * 4 + 2] & 0xffffffffu), (int)(lc[k4 * 4 + 3] & 0xffffffffu));
      *(float4*)(eg + k4 * 4) = make_float4(e[k4 * 4] * inv, e[k4 * 4 + 1] * inv, e[k4 * 4 + 2] * inv, e[k4 * 4 + 3] * inv);
    }
  }
}
__device__ void phase_peer(const Params& p, const WS& w, int bid, int nb) {
  const int wave = threadIdx.x >> 6, lane = threadIdx.x & 63;
  for (int t = bid * 8 + wave; t < T; t += nb * 8) {
    float hr[32], out[32];
#pragma unroll
    for (int i = 0; i < 4; ++i) unpack8(*(const uint4*)(w.h1b + (size_t)t * D + i * 512 + lane * 8), hr + i * 8);
#pragma unroll
    for (int i = 0; i < 32; ++i) out[i] = 0.f;
    const float rs2 = rsqrtf(w.ssq2[t] * (1.f / D) + EPS);
    for (int h = 0; h < 8; ++h) {
      const int idxv = w.eidx[(size_t)t * 128 + h * 16 + (lane & 15)]; const float gv = w.eg[(size_t)t * 128 + h * 16 + (lane & 15)];
#pragma unroll 4
      for (int k = 0; k < 16; ++k) {
        const int e = __shfl(idxv, k); const float g = __shfl(gv, k);
        const bf16_t* ur = w.ub + (size_t)e * D; const bf16_t* vr = w.vb + (size_t)e * D;
        float s = 0.f;
#pragma unroll
        for (int i = 0; i < 4; ++i) { float f[8]; unpack8(*(const uint4*)(ur + i * 512 + lane * 8), f);
#pragma unroll
          for (int j = 0; j < 8; ++j) s += f[j] * hr[i * 8 + j]; }
        s = wave_sum(s);
        const float wgt = g * gelu_tanh(s * rs2);
#pragma unroll
        for (int i = 0; i < 4; ++i) { float f[8]; unpack8(*(const uint4*)(vr + i * 512 + lane * 8), f);
#pragma unroll
          for (int j = 0; j < 8; ++j) out[i * 8 + j] += wgt * f[j]; }
      }
    }
    float ss = 0.f;
#pragma unroll
    for (int i = 0; i < 32; ++i) { out[i] += hr[i]; ss += out[i] * out[i]; }
    ss = wave_sum(ss);
#pragma unroll
    for (int i = 0; i < 4; ++i) *(uint4*)(w.h2b + (size_t)t * D + i * 512 + lane * 8) = pack8(out + i * 8);
    if (lane == 0) w.rstd3[t] = rsqrtf(ss * (1.f / D) + EPS);
  }
}
__device__ void phase_final(const Params& p, const WS& w, int bid, int nb) {
  const int wave = threadIdx.x >> 6, lane = threadIdx.x & 63;
  for (int row = bid * 8 + wave; row < T; row += nb * 8) {
    float4* o = (float4*)(p.out + (size_t)row * D);
    const float rs = rsqrtf(w.ssq4[row] * (1.f / D) + EPS);
#pragma unroll
    for (int i = 0; i < 8; ++i) { float4 v = o[i * 64 + lane]; const float4 g = *(const float4*)(p.norm_final + (i * 64 + lane) * 4); v.x *= rs * g.x; v.y *= rs * g.y; v.z *= rs * g.z; v.w *= rs * g.w; o[i * 64 + lane] = v; }
  }
}

constexpr int NPHASE = 10;
template <int PH>
__device__ __forceinline__ void run_phase(const Params& p, float* lds, int bid, int nb) {
  const WS w = make_ws(p.ws);
  if (PH == 0) phase_prep(p, w, lds, bid, nb);
  if (PH == 1) { gemm_naive(w.xb, w.win, T, NPROJ, D, EpiProjN{w.proj, w.rstd1}, lds, bid, nb);
                 gemm_naive(w.win + (size_t)NPROJ * D, w.xb, 2048, T, D, EpiProjT{w.vT, w.rstd1}, lds, bid, nb); }
  if (PH == 2) phase_mixer_naive(p, w, lds, bid, nb);
  if (PH == 3) gemm_naive(w.y, w.wout, T, D, D, EpiOut{p.x, w.h1b, w.ssq2}, lds, bid, nb);
  if (PH == 4) gemm_naive(w.h1b, w.wq, T, D, D, EpiScore{w.sc, w.ssq2}, lds, bid, nb);
  if (PH == 5) { phase_topk(p, w, bid, nb); gemm_naive(w.pb, w.wple, T, D, 256, EpiPl{w.pl}, lds, bid, nb); }
  if (PH == 6) phase_peer(p, w, bid, nb);
  if (PH == 7) gemm_naive(w.h2b, w.wg, T, D, D, EpiGate{w.h2b, w.pl, w.rstd3, p.out, w.ssq4}, lds, bid, nb);
  if (PH == 8) phase_final(p, w, bid, nb);
}

extern __shared__ __attribute__((aligned(16))) unsigned char dyn_lds[];

#if ONE_LAUNCH
__global__ void __launch_bounds__(512, 2) mega(Params p) {
  cg::grid_group grid = cg::this_grid();
  float* lds = (float*)dyn_lds; const int bid = blockIdx.x, nb = gridDim.x;
  run_phase<0>(p, lds, bid, nb); grid.sync();
  run_phase<1>(p, lds, bid, nb); grid.sync();
  run_phase<2>(p, lds, bid, nb); grid.sync();
  run_phase<3>(p, lds, bid, nb); grid.sync();
  run_phase<4>(p, lds, bid, nb); grid.sync();
  run_phase<5>(p, lds, bid, nb); grid.sync();
  run_phase<6>(p, lds, bid, nb); grid.sync();
  run_phase<7>(p, lds, bid, nb); grid.sync();
  run_phase<8>(p, lds, bid, nb);
}
#else
template <int PH> __global__ void __launch_bounds__(512, 2) k_phase(Params p) { run_phase<PH>(p, (float*)dyn_lds, blockIdx.x, gridDim.x); }
#endif

constexpr size_t kDynLds = 131072;

extern "C" void kernel_launch(void* const* d_in, const int* in_sizes, int n_in, void* d_out, int out_size, void* d_ws, size_t ws_size, hipStream_t stream) {
  if (n_in != 22 || out_size != T * D || ws_size < WS_NEED) { fprintf(stderr, "kernel_launch: unexpected shapes (n_in %d out %d ws %zu)\n", n_in, out_size, ws_size); return; }
  Params p{};
  const float** f = (const float**)&p;
  for (int i = 0; i < 22; ++i) f[i] = (const float*)d_in[i];
  p.out = (float*)d_out; p.ws = (unsigned char*)d_ws;
#if ONE_LAUNCH
  static int grid_blocks = 0;
  if (!grid_blocks) {
    int dev = 0, cus = 0, per_cu = 0;
    (void)hipGetDevice(&dev); (void)hipDeviceGetAttribute(&cus, hipDeviceAttributeMultiprocessorCount, dev);
    (void)hipFuncSetAttribute((const void*)mega, hipFuncAttributeMaxDynamicSharedMemorySize, (int)kDynLds);
    (void)hipOccupancyMaxActiveBlocksPerMultiprocessor(&per_cu, mega, 512, kDynLds);
    if (per_cu < 1) { fprintf(stderr, "occupancy query says 0 blocks/CU\n"); per_cu = 1; }
    grid_blocks = cus;
  }
  void* args[] = {&p};
  hipError_t e = hipLaunchCooperativeKernel((void*)mega, dim3(grid_blocks), dim3(512), args, kDynLds, stream);
  if (e != hipSuccess) fprintf(stderr, "cooperative launch failed: %s (grid %d)\n", hipGetErrorString(e), grid_blocks);
#else
  static bool attr = false;
  const int G = 256;
#define LAUNCH(PH) do { if (!attr) (void)hipFuncSetAttribute((const void*)k_phase<PH>, hipFuncAttributeMaxDynamicSharedMemorySize, (int)kDynLds); \
    hipLaunchKernelGGL(k_phase<PH>, dim3(G), dim3(512), kDynLds, stream, p); } while (0)
  LAUNCH(0); LAUNCH(1); LAUNCH(2); LAUNCH(3); LAUNCH(4); LAUNCH(5); LAUNCH(6); LAUNCH(7); LAUNCH(8);
  attr = true;
#undef LAUNCH
#endif
}
```

```cpp
#include <hip/hip_runtime.h>
#include <hip/hip_cooperative_groups.h>
#include <cstdio>
#include <cstdint>
namespace cg = cooperative_groups;

#ifndef ONE_LAUNCH
#define ONE_LAUNCH 1
#endif

typedef unsigned short bf16_t;
constexpr int T = 32768, SEQ = 16384, D = 2048;
constexpr int NPROJ = 4352;
constexpr int C_GQ = 0, C_GK = 512, C_GG = 1024, C_MQ = 2048, C_MK = 2560, C_MO = 3072, C_SM = 4096;
constexpr float EPS = 1e-6f;
constexpr size_t MiB = 1ull << 20;
constexpr size_t OFF_XB = 0, OFF_Y = 0, OFF_PL = 0;
constexpr size_t OFF_PROJ = 128 * MiB, OFF_H1B = 128 * MiB, OFF_H2B = 256 * MiB;
constexpr size_t OFF_VT = 400 * MiB, OFF_SC = 400 * MiB;
constexpr size_t OFF_UB = 528 * MiB, OFF_VB = 592 * MiB;
constexpr size_t OFF_WIN = 656 * MiB, OFF_WOUT = 681 * MiB, OFF_WQ = 689 * MiB, OFF_WG = 697 * MiB, OFF_WPLE = 705 * MiB;
constexpr size_t OFF_PB = 706 * MiB, OFF_EIDX = 722 * MiB, OFF_EG = 738 * MiB, OFF_MISC = 754 * MiB;
constexpr size_t WS_NEED = 760 * MiB;

struct Params {
  const float *x, *p, *norm_mix, *w_in, *gate_up, *gate_bias, *gla_norm, *conv_w, *conv_b, *ig_bias, *fg_bias, *mlstm_norm,
      *w_out, *norm_ffn, *peer_query, *sub_keys, *peer_u, *peer_v, *norm_ple, *w_ple, *w_ple_gate, *norm_final;
  float* out;
  unsigned char* ws;
};

__device__ __forceinline__ float bf2f(bf16_t b) { return __uint_as_float(((unsigned)b) << 16); }
__device__ __forceinline__ bf16_t f2bf(float f) { unsigned u = __float_as_uint(f); u += 0x7FFFu + ((u >> 16) & 1u); return (bf16_t)(u >> 16); }
__device__ __forceinline__ unsigned pack2(float lo, float hi) { return (unsigned)f2bf(lo) | ((unsigned)f2bf(hi) << 16); }
__device__ __forceinline__ float lo_f(unsigned u) { return __uint_as_float(u << 16); }
__device__ __forceinline__ float hi_f(unsigned u) { return __uint_as_float(u & 0xffff0000u); }
__device__ __forceinline__ float wave_sum(float v) {
#pragma unroll
  for (int o = 32; o >= 1; o >>= 1) v += __shfl_xor(v, o);
  return v;
}
__device__ __forceinline__ int tidx() { int t = threadIdx.x; asm volatile("" : "+v"(t)); return t; }
__device__ __forceinline__ float sigmoidf_(float x) { return 1.f / (1.f + __expf(-x)); }
__device__ __forceinline__ float siluf_(float x) { return x / (1.f + __expf(-x)); }
__device__ __forceinline__ float logsigmoidf_(float x) { return fminf(x, 0.f) - log1pf(__expf(-fabsf(x))); }
__device__ __forceinline__ float gelu_tanh(float x) { const float u = 0.7978845608028654f * (x + 0.044715f * x * x * x); return 0.5f * x * (1.f + tanhf(u)); }
__device__ __forceinline__ void unpack8(const uint4 q, float* f) {
  f[0] = lo_f(q.x); f[1] = hi_f(q.x); f[2] = lo_f(q.y); f[3] = hi_f(q.y); f[4] = lo_f(q.z); f[5] = hi_f(q.z); f[6] = lo_f(q.w); f[7] = hi_f(q.w);
}
__device__ __forceinline__ uint4 pack8(const float* f) { return make_uint4(pack2(f[0], f[1]), pack2(f[2], f[3]), pack2(f[4], f[5]), pack2(f[6], f[7])); }

struct WS {
  bf16_t *xb, *y, *pl, *proj, *h1b, *h2b, *vT, *sc, *ub, *vb, *win, *wout, *wq, *wg, *wple, *pb;
  int* eidx; float* eg; float *rstd1, *ssq2, *rstd3, *ssq4;
};
__device__ __forceinline__ WS make_ws(unsigned char* ws) {
  WS w;
  w.xb = (bf16_t*)(ws + OFF_XB); w.y = (bf16_t*)(ws + OFF_Y); w.pl = (bf16_t*)(ws + OFF_PL); w.proj = (bf16_t*)(ws + OFF_PROJ);
  w.h1b = (bf16_t*)(ws + OFF_H1B); w.h2b = (bf16_t*)(ws + OFF_H2B); w.vT = (bf16_t*)(ws + OFF_VT); w.sc = (bf16_t*)(ws + OFF_SC);
  w.ub = (bf16_t*)(ws + OFF_UB); w.vb = (bf16_t*)(ws + OFF_VB); w.win = (bf16_t*)(ws + OFF_WIN); w.wout = (bf16_t*)(ws + OFF_WOUT);
  w.wq = (bf16_t*)(ws + OFF_WQ); w.wg = (bf16_t*)(ws + OFF_WG); w.wple = (bf16_t*)(ws + OFF_WPLE); w.pb = (bf16_t*)(ws + OFF_PB);
  w.eidx = (int*)(ws + OFF_EIDX); w.eg = (float*)(ws + OFF_EG);
  float* m = (float*)(ws + OFF_MISC); w.rstd1 = m; w.ssq2 = m + T; w.rstd3 = m + 2 * T; w.ssq4 = m + 3 * T;
  return w;
}

__device__ void prep_x(const Params& p, const WS& w, int bid, int nb) {
  const int wave = tidx() >> 6, lane = tidx() & 63;
  for (int row = bid * 8 + wave; row < T; row += nb * 8) {
    const float4* src = (const float4*)(p.x + (size_t)row * D);
    uint2* dst = (uint2*)(w.xb + (size_t)row * D);
    float ss = 0.f;
#pragma unroll
    for (int i = 0; i < 8; ++i) { const float4 v = src[i * 64 + lane]; ss += v.x * v.x + v.y * v.y + v.z * v.z + v.w * v.w; dst[i * 64 + lane] = make_uint2(pack2(v.x, v.y), pack2(v.z, v.w)); }
    ss = wave_sum(ss);
    if (lane == 0) w.rstd1[row] = rsqrtf(ss * (1.f / D) + EPS);
  }
}
__device__ void cvt_rows(const float* src, bf16_t* dst, size_t n, const float* gain, int ncols, int bid, int nb) {
  const size_t n4 = n / 4;
  for (size_t i = (size_t)bid * 512 + tidx(); i < n4; i += (size_t)nb * 512) {
    float4 v = ((const float4*)src)[i];
    if (gain) { const float4 g = *(const float4*)(gain + (int)((i * 4) % (size_t)ncols)); v.x *= g.x; v.y *= g.y; v.z *= g.z; v.w *= g.w; }
    ((uint2*)dst)[i] = make_uint2(pack2(v.x, v.y), pack2(v.z, v.w));
  }
}
template <class CM>
__device__ void transpose_w(const float* src, int K, int ldsrc, bf16_t* dst, int Ndst, const float* gain, CM cm, float* lds, int bid, int nb) {
  const int tid = tidx(), tk = K / 64, ntile = (Ndst / 64) * tk;
  for (int tile = bid; tile < ntile; tile += nb) {
    const int n0 = (tile / tk) * 64, k0 = (tile % tk) * 64;
    const int nc = tid & 63, sc = cm(n0 + nc);
#pragma unroll
    for (int i = 0; i < 8; ++i) { const int kr = (tid >> 6) + 8 * i; float v = 0.f; if (sc >= 0) { v = src[(size_t)(k0 + kr) * ldsrc + sc]; if (gain) v *= gain[k0 + kr]; } lds[kr * 65 + nc] = v; }
    __syncthreads();
    { const int nr = tid >> 3, ks = (tid & 7) * 8; float f[8];
#pragma unroll
      for (int j = 0; j < 8; ++j) f[j] = lds[(ks + j) * 65 + nr];
      *(uint4*)(dst + (size_t)(n0 + nr) * K + k0 + ks) = pack8(f); }
    __syncthreads();
  }
}
struct CmIdent { __device__ int operator()(int n) const { return n; } };
struct CmWin {
  __device__ int operator()(int n) const {
    if (n < 1024) return n;
    if (n < 2048) return 2048 + (n - 1024);
    if (n < 2560) return 3088 + (n - 2048);
    if (n < 3072) return 3600 + (n - 2560);
    if (n < 4096) return 5136 + (n - 3072);
    if (n < 4352) { const int i = n - 4096; if (i < 16) return 3072 + i; if (i < 20) return 6160 + (i - 16); if (i < 24) return 6164 + (i - 20); return -1; }
    const int j = n - 4352; if (j < 1024) return 1024 + j;
    return 4112 + (j - 1024);
  }
};
__device__ void prep_wq(const Params& p, const WS& w, float* lds, int bid, int nb) {
  const int tid = tidx();
  float* SKs = lds;
  float* WQs = lds + 128 * 132;
  for (int item = bid; item < 16 * 32; item += nb) {
    const int hp = item >> 5, k0 = (item & 31) * 64;
#pragma unroll
    for (int i = 0; i < 8; ++i) { const int e4 = tid + 512 * i, key = e4 >> 5, d4 = (e4 & 31) * 4; *(float4*)(SKs + key * 132 + d4) = *(const float4*)(p.sub_keys + (size_t)hp * 16384 + key * 128 + d4); }
#pragma unroll
    for (int i = 0; i < 4; ++i) { const int e4 = tid + 512 * i, kr = e4 >> 5, d4 = (e4 & 31) * 4; float4 v = *(const float4*)(p.peer_query + (size_t)(k0 + kr) * 2048 + hp * 128 + d4); const float g = p.norm_ffn[k0 + kr]; v.x *= g; v.y *= g; v.z *= g; v.w *= g; *(float4*)(WQs + kr * 132 + d4) = v; }
    __syncthreads();
    const int k = tid & 63, kg = tid >> 6;
    float acc[16];
#pragma unroll
    for (int j = 0; j < 16; ++j) acc[j] = 0.f;
    for (int d4 = 0; d4 < 32; ++d4) {
      const float4 a = *(const float4*)(WQs + k * 132 + d4 * 4);
#pragma unroll
      for (int j = 0; j < 16; ++j) { const float4 s = *(const float4*)(SKs + (kg * 16 + j) * 132 + d4 * 4); acc[j] += a.x * s.x + a.y * s.y + a.z * s.z + a.w * s.w; }
    }
#pragma unroll
    for (int j = 0; j < 16; ++j) w.wq[(size_t)(hp * 128 + kg * 16 + j) * 2048 + k0 + k] = f2bf(acc[j]);
    __syncthreads();
  }
}
__device__ void phase_prep(const Params& p, const WS& w, float* lds, int bid, int nb) {
  prep_x(p, w, bid, nb);
  cvt_rows(p.p, w.pb, (size_t)T * 256, nullptr, 256, bid, nb);
  cvt_rows(p.peer_u, w.ub, (size_t)16384 * 2048, p.norm_ffn, 2048, bid, nb);
  cvt_rows(p.peer_v, w.vb, (size_t)16384 * 2048, nullptr, 2048, bid, nb);
  transpose_w(p.w_in, 2048, 6168, w.win, 6400, p.norm_mix, CmWin(), lds, bid, nb);
  transpose_w(p.w_out, 2048, 2048, w.wout, 2048, nullptr, CmIdent(), lds, bid, nb);
  transpose_w(p.w_ple_gate, 2048, 2048, w.wg, 2048, p.norm_ple, CmIdent(), lds, bid, nb);
  transpose_w(p.w_ple, 256, 2048, w.wple, 2048, nullptr, CmIdent(), lds, bid, nb);
  prep_wq(p, w, lds, bid, nb);
  for (int i = bid * 512 + tidx(); i < T; i += nb * 512) { w.ssq2[i] = 0.f; w.ssq4[i] = 0.f; }
}

struct EpiProjN { bf16_t* out; const float* rstd; static constexpr bool ROWSUM = false;
  __device__ __forceinline__ float store8(int r, int c, const float* v) const { const float s = rstd[r]; float f[8];
#pragma unroll
    for (int j = 0; j < 8; ++j) f[j] = v[j] * s;
    *(uint4*)(out + (size_t)r * NPROJ + c) = pack8(f); return 0.f; }
  __device__ __forceinline__ void rowsum(int, float) const {} };
struct EpiProjT { bf16_t* out; const float* rstd; static constexpr bool ROWSUM = false;
  __device__ __forceinline__ float store8(int r, int c, const float* v) const { const float4 s0 = *(const float4*)(rstd + c), s1 = *(const float4*)(rstd + c + 4); float f[8];
    f[0] = v[0] * s0.x; f[1] = v[1] * s0.y; f[2] = v[2] * s0.z; f[3] = v[3] * s0.w; f[4] = v[4] * s1.x; f[5] = v[5] * s1.y; f[6] = v[6] * s1.z; f[7] = v[7] * s1.w;
    *(uint4*)(out + (size_t)r * T + c) = pack8(f); return 0.f; }
  __device__ __forceinline__ void rowsum(int, float) const {} };
struct EpiOut { const float* x; bf16_t* h1b; float* ssq; static constexpr bool ROWSUM = true;
  __device__ __forceinline__ float store8(int r, int c, const float* v) const { const float4 x0 = *(const float4*)(x + (size_t)r * D + c), x1 = *(const float4*)(x + (size_t)r * D + c + 4); float f[8];
    f[0] = v[0] + x0.x; f[1] = v[1] + x0.y; f[2] = v[2] + x0.z; f[3] = v[3] + x0.w; f[4] = v[4] + x1.x; f[5] = v[5] + x1.y; f[6] = v[6] + x1.z; f[7] = v[7] + x1.w;
    float s = 0.f;
#pragma unroll
    for (int j = 0; j < 8; ++j) s += f[j] * f[j];
    *(uint4*)(h1b + (size_t)r * D + c) = pack8(f); return s; }
  __device__ __forceinline__ void rowsum(int r, float s) const { atomicAdd(ssq + r, s); } };
struct EpiScore { bf16_t* sc; const float* ssq; static constexpr bool ROWSUM = false;
  __device__ __forceinline__ float store8(int r, int c, const float* v) const { const float s = rsqrtf(ssq[r] * (1.f / D) + EPS); float f[8];
#pragma unroll
    for (int j = 0; j < 8; ++j) f[j] = v[j] * s;
    *(uint4*)(sc + (size_t)r * D + c) = pack8(f); return 0.f; }
  __device__ __forceinline__ void rowsum(int, float) const {} };
struct EpiPl { bf16_t* pl; static constexpr bool ROWSUM = false;
  __device__ __forceinline__ float store8(int r, int c, const float* v) const { *(uint4*)(pl + (size_t)r * D + c) = pack8(v); return 0.f; }
  __device__ __forceinline__ void rowsum(int, float) const {} };
struct EpiGate { const bf16_t* h2b; const bf16_t* pl; const float* rstd3; float* out; float* ssq; static constexpr bool ROWSUM = true;
  __device__ __forceinline__ float store8(int r, int c, const float* v) const { const float rs = rstd3[r]; float h[8], q[8], f[8];
    unpack8(*(const uint4*)(h2b + (size_t)r * D + c), h); unpack8(*(const uint4*)(pl + (size_t)r * D + c), q);
    float s = 0.f;
#pragma unroll
    for (int j = 0; j < 8; ++j) { f[j] = h[j] + sigmoidf_(v[j] * rs) * q[j]; s += f[j] * f[j]; }
    *(float4*)(out + (size_t)r * D + c) = make_float4(f[0], f[1], f[2], f[3]); *(float4*)(out + (size_t)r * D + c + 4) = make_float4(f[4], f[5], f[6], f[7]); return s; }
  __device__ __forceinline__ void rowsum(int r, float s) const { atomicAdd(ssq + r, s); } };

template <class Epi>
__device__ void gemm_naive(const bf16_t* A, const bf16_t* Bt, int M, int N, int K, const Epi& E, float* lds, int bid, int nb) {
  const int tid = tidx(), ty = tid >> 4, tx = tid & 15;
  float* As = lds;
  float* Bs = lds + 32 * 132;
  const int nM = M / 128, nN = N / 128;
  for (int tile = bid; tile < nM * nN; tile += nb) {
    const int m0 = (tile % nM) * 128, n0 = (tile / nM) * 128;
    float acc[4][8];
#pragma unroll
    for (int i = 0; i < 4; ++i)
#pragma unroll
      for (int j = 0; j < 8; ++j) acc[i][j] = 0.f;
    const int lr = tid >> 2, lk = (tid & 3) * 8;
    for (int k0 = 0; k0 < K; k0 += 32) {
      const uint4 av = *(const uint4*)(A + (size_t)(m0 + lr) * K + k0 + lk);
      const uint4 bv = *(const uint4*)(Bt + (size_t)(n0 + lr) * K + k0 + lk);
      float af[8], bf[8]; unpack8(av, af); unpack8(bv, bf);
      __syncthreads();
#pragma unroll
      for (int j = 0; j < 8; ++j) { As[(lk + j) * 132 + lr] = af[j]; Bs[(lk + j) * 132 + lr] = bf[j]; }
      __syncthreads();
#pragma unroll 8
      for (int kk = 0; kk < 32; ++kk) {
        const float4 a = *(const float4*)(As + kk * 132 + ty * 4);
        const float4 b0 = *(const float4*)(Bs + kk * 132 + tx * 8), b1 = *(const float4*)(Bs + kk * 132 + tx * 8 + 4);
        const float aa[4] = {a.x, a.y, a.z, a.w}; const float bb[8] = {b0.x, b0.y, b0.z, b0.w, b1.x, b1.y, b1.z, b1.w};
#pragma unroll
        for (int i = 0; i < 4; ++i)
#pragma unroll
          for (int j = 0; j < 8; ++j) acc[i][j] += aa[i] * bb[j];
      }
    }
#pragma unroll
    for (int i = 0; i < 4; ++i) {
      const int r = m0 + ty * 4 + i;
      float s = E.store8(r, n0 + tx * 8, acc[i]);
      if (Epi::ROWSUM) { s += __shfl_xor(s, 1); s += __shfl_xor(s, 2); s += __shfl_xor(s, 4); s += __shfl_xor(s, 8); if (tx == 0) E.rowsum(r, s); }
    }
  }
}


namespace pg8 {
#define PG8_LAS __attribute__((address_space(3)))
typedef short bf16x8 __attribute__((ext_vector_type(8)));
typedef float f32x4 __attribute__((ext_vector_type(4)));
constexpr int BM = 256, BK = 64, HALF = 128, HTB = HALF * BK * 2, STAGE_BYTES = 8 * HTB, NXCD = 8, WGM = 8;
__host__ __device__ __forceinline__ int lds_byte(int r, int c) { const int st = (r >> 4) * 2 + (c >> 5), rr = r & 15, cc = c & 31, ob = rr * 64 + cc * 2; return st * 1024 + (ob ^ (((ob >> 9) & 1) << 5)); }
__host__ __device__ __forceinline__ void stage_rc(int b, int& R, int& C) { const int st = b / 1024, sb = b % 1024, swz = sb ^ (((sb >> 9) & 1) << 5); R = (st >> 1) * 16 + swz / 64; C = (st & 1) * 32 + (swz % 64) / 2; }
__host__ __device__ __forceinline__ int perm32(int rho) { const int n = rho >> 4, i = rho & 15; return 8 * (i >> 2) + 4 * n + (i & 3); }
struct Unit { int pm, pn; };
struct Gemm { const bf16_t* A; const bf16_t* Bt; int M, N, K; };
struct StaticOrder {
    int nM, nN, nwg, G, c;
    __host__ __device__ void init(int M, int N, int G_, int c_) { nM = M / BM; nN = N / BM; nwg = nM * nN; G = G_; c = c_; }
    __host__ __device__ bool next(int i, Unit& u) const {
        const long L = (long)i * G + c; if (L >= nwg) return false;
        int wgid = (int)L; { const int q = nwg / NXCD, r = nwg % NXCD, xcd = wgid % NXCD, off = wgid / NXCD; wgid = (xcd < r ? xcd * (q + 1) : r * (q + 1) + (xcd - r) * q) + off; }
        const int nig = WGM * nN, gid = wgid / nig, fm = gid * WGM, gsz = (nM - fm) < WGM ? (nM - fm) : WGM;
        u.pm = fm + ((wgid % nig) % gsz); u.pn = (wgid % nig) / gsz; return true;
    }
    __device__ __forceinline__ void a_ready(const Unit&) const {}
    __device__ __forceinline__ void done(const Unit&) const {}
};
template <class E8> struct EpiA {
    static constexpr bool PERM = true, AFTER_DRAIN = false;
    E8 e;
    __device__ __forceinline__ void operator()(const f32x4 (&acc)[2][2][4][2], const Unit& u, int wr, int wc, int fr, int fq) const {
        const int row0 = u.pm * BM + wr * 64 + fr, col0 = u.pn * BM + wc * 32 + 8 * fq;
#pragma unroll
        for (int ai = 0; ai < 2; ++ai)
#pragma unroll
            for (int m = 0; m < 4; ++m) { const int r = row0 + ai * HALF + m * 16; float s = 0.f;
#pragma unroll
                for (int bj = 0; bj < 2; ++bj) { const float v[8] = {acc[ai][bj][m][0][0], acc[ai][bj][m][0][1], acc[ai][bj][m][0][2], acc[ai][bj][m][0][3], acc[ai][bj][m][1][0], acc[ai][bj][m][1][1], acc[ai][bj][m][1][2], acc[ai][bj][m][1][3]};
                    s += e.store8(r, col0 + bj * HALF, v); }
                if (E8::ROWSUM) { s += __shfl_xor(s, 16); s += __shfl_xor(s, 32); if (fq == 0) e.rowsum(r, s); } }
    }
    __device__ __forceinline__ void fused(f32x4 (&)[2][2][4][2], const Unit&, int, int, int, int, PG8_LAS unsigned char*, int, int) const {}
};
template <class Epi, class Sched, bool ALIGN_EPI = false, bool SP2 = false>
__device__ __forceinline__ void gemm_phase(PG8_LAS unsigned char* lds, const Gemm g, const Sched& S, const Epi& E) {
    int tid_ = threadIdx.x; asm volatile("" : "+v"(tid_));
    const int tid = tid_, wid = __builtin_amdgcn_readfirstlane(tid >> 6), lane = tid & 63, wr = wid >> 2, wc = wid & 3, fr = lane & 15, fq = lane >> 4;
    const int K = g.K, nt = K / BK;
    unsigned voffA[2], voffB[2];
#pragma unroll
    for (int i = 0; i < 2; ++i) { int R, C; stage_rc(tid * 16 + i * 8192, R, C); const int Rb = Epi::PERM ? ((R & ~31) + perm32(R & 31)) : R;
        voffA[i] = (unsigned)(R * K + C) * 2u; voffB[i] = (unsigned)(Rb * K + C) * 2u; }
    const size_t kstep = (size_t)(BK * 2);
    const size_t hstep = (size_t)HALF * K * 2;
    const size_t tstep = 2 * hstep;
    const unsigned ldsw = (unsigned)wid * 1024u;
    const int aoff = lds_byte(wr * 64 + fr, fq * 8), boff = lds_byte(wc * 32 + fr, fq * 8);
#define PG8_SA(b, h) (((b) * 2 + (h)) * HTB)
#define PG8_SB(b, h) ((4 + (b) * 2 + (h)) * HTB)
#define PG8_STAGE(bufoff, gbase, voff) do { _Pragma("unroll") for (int _i = 0; _i < 2; ++_i) \
        __builtin_amdgcn_global_load_lds((const unsigned*)((const char*)(gbase) + (voff)[_i]), (PG8_LAS unsigned*)(lds + (bufoff) + ldsw + _i * 8192), 16, 0, 0); } while (0)
#define PG8_LDA(dst, b, h) do { _Pragma("unroll") for (int m = 0; m < 4; ++m) _Pragma("unroll") for (int k = 0; k < 2; ++k) dst[m][k] = *(const PG8_LAS bf16x8*)(lds + PG8_SA(b, h) + aoff + m * 2048 + k * 1024); } while (0)
#define PG8_LDB(dst, b, h) do { _Pragma("unroll") for (int n = 0; n < 2; ++n) _Pragma("unroll") for (int k = 0; k < 2; ++k) dst[n][k] = *(const PG8_LAS bf16x8*)(lds + PG8_SB(b, h) + boff + n * 2048 + k * 1024); } while (0)
#define PG8_MMA(ai, bj, At, Bt) do { __builtin_amdgcn_s_setprio(1); _Pragma("unroll") for (int m = 0; m < 4; ++m) _Pragma("unroll") for (int n = 0; n < 2; ++n) _Pragma("unroll") for (int k = 0; k < 2; ++k) \
        acc[ai][bj][m][n] = __builtin_amdgcn_mfma_f32_16x16x32_bf16(Bt[n][k], At[m][k], acc[ai][bj][m][n], 0, 0, 0); __builtin_amdgcn_s_setprio(0); } while (0)
#define PG8_WAIT_V(n) asm volatile("s_waitcnt vmcnt(" #n ")" ::: "memory")
#define PG8_WAIT_L(n) asm volatile("s_waitcnt lgkmcnt(" #n ")" ::: "memory")
#define PG8_BAR __builtin_amdgcn_s_barrier()
#define PG8_SCHED __builtin_amdgcn_sched_barrier(0)
    Unit cur, nxt; int ui = 0;
    if (!S.next(0, cur)) return;
    f32x4 acc[2][2][4][2];
#pragma unroll
    for (int a = 0; a < 2; ++a)
#pragma unroll
        for (int b = 0; b < 2; ++b)
#pragma unroll
            for (int m = 0; m < 4; ++m)
#pragma unroll
                for (int n = 0; n < 2; ++n) acc[a][b][m][n] = (f32x4){0.f, 0.f, 0.f, 0.f};
    bf16x8 At[4][2], B0[2][2], B1[2][2];
    const char* cA = (const char*)g.A + (size_t)cur.pm * tstep; const char* cB = (const char*)g.Bt + (size_t)cur.pn * tstep;
    S.a_ready(cur);
    if constexpr (SP2) {
        PG8_STAGE(PG8_SB(0, 0), cB, voffB); PG8_STAGE(PG8_SB(0, 1), cB + hstep, voffB); PG8_STAGE(PG8_SA(0, 0), cA, voffA); PG8_STAGE(PG8_SA(0, 1), cA + hstep, voffA);
        if (wr == 1) PG8_BAR;
        PG8_WAIT_V(2); PG8_BAR;
        PG8_STAGE(PG8_SB(1, 0), cB + kstep, voffB); PG8_STAGE(PG8_SA(1, 0), cA + kstep, voffA); PG8_STAGE(PG8_SB(1, 1), cB + hstep + kstep, voffB);
        PG8_WAIT_V(6); PG8_BAR;
    } else {
        PG8_STAGE(PG8_SB(0, 0), cB, voffB); PG8_STAGE(PG8_SA(0, 0), cA, voffA); PG8_STAGE(PG8_SB(0, 1), cB + hstep, voffB); PG8_STAGE(PG8_SA(0, 1), cA + hstep, voffA);
        if (wr == 1) PG8_BAR;
        PG8_WAIT_V(4); PG8_BAR;
        PG8_STAGE(PG8_SB(1, 0), cB + kstep, voffB); PG8_STAGE(PG8_SA(1, 0), cA + kstep, voffA); PG8_STAGE(PG8_SB(1, 1), cB + hstep + kstep, voffB);
        PG8_WAIT_V(6); PG8_BAR;
    }
    for (;;) {
        const bool has_next = S.next(ui + 1, nxt);
        const char* nA = has_next ? (const char*)g.A + (size_t)nxt.pm * tstep : cA; const char* nB = has_next ? (const char*)g.Bt + (size_t)nxt.pn * tstep : cB;
        for (int t = 0; t < nt; t += 2) {
            const bool last = (t == nt - 2);
            const char* a1 = cA + (size_t)(t + 1) * kstep;
            const char* a2 = last ? nA : cA + (size_t)(t + 2) * kstep; const char* b2 = last ? nB : cB + (size_t)(t + 2) * kstep;
            const char* a3 = a2 + kstep; const char* b3 = b2 + kstep;
            if (last && has_next) S.a_ready(nxt);
            if constexpr (SP2) {
            PG8_LDB(B0, 0, 0); PG8_LDB(B1, 0, 1); PG8_SCHED; PG8_LDA(At, 0, 0); PG8_STAGE(PG8_SA(1, 1), a1 + hstep, voffA);
            PG8_WAIT_V(8); PG8_WAIT_L(0); PG8_BAR; PG8_MMA(0, 0, At, B0); PG8_MMA(0, 1, At, B1); PG8_BAR; PG8_SCHED;
            PG8_LDA(At, 0, 1); PG8_STAGE(PG8_SB(0, 0), b2, voffB); PG8_STAGE(PG8_SB(0, 1), b2 + hstep, voffB); PG8_STAGE(PG8_SA(0, 0), a2, voffA);
            PG8_WAIT_V(8); PG8_WAIT_L(0); PG8_BAR; PG8_MMA(1, 0, At, B0); PG8_MMA(1, 1, At, B1); PG8_BAR; PG8_SCHED;
            PG8_LDB(B0, 1, 0); PG8_LDB(B1, 1, 1); PG8_SCHED; PG8_LDA(At, 1, 0); PG8_STAGE(PG8_SA(0, 1), a2 + hstep, voffA);
            PG8_WAIT_V(8); PG8_WAIT_L(0); PG8_BAR; PG8_MMA(0, 0, At, B0); PG8_MMA(0, 1, At, B1); PG8_BAR; PG8_SCHED;
            PG8_LDA(At, 1, 1); PG8_STAGE(PG8_SB(1, 0), b3, voffB); PG8_STAGE(PG8_SB(1, 1), b3 + hstep, voffB); PG8_STAGE(PG8_SA(1, 0), a3, voffA);
            PG8_WAIT_V(8); PG8_WAIT_L(0); PG8_BAR; PG8_MMA(1, 0, At, B0); PG8_MMA(1, 1, At, B1); PG8_BAR; PG8_SCHED;
            } else {
            PG8_LDB(B0, 0, 0); PG8_SCHED; PG8_LDA(At, 0, 0); PG8_STAGE(PG8_SA(1, 1), a1 + hstep, voffA);
            PG8_WAIT_L(8); PG8_BAR; PG8_WAIT_L(0); PG8_MMA(0, 0, At, B0); PG8_BAR; PG8_SCHED;
            PG8_LDB(B1, 0, 1); PG8_STAGE(PG8_SB(0, 0), b2, voffB);
            PG8_BAR; PG8_WAIT_L(0); PG8_MMA(0, 1, At, B1); PG8_BAR;
            PG8_LDA(At, 0, 1); PG8_STAGE(PG8_SA(0, 0), a2, voffA);
            PG8_BAR; PG8_WAIT_L(0); PG8_MMA(1, 0, At, B0); PG8_BAR; PG8_SCHED;
            PG8_STAGE(PG8_SB(0, 1), b2 + hstep, voffB);
            PG8_WAIT_V(6); PG8_BAR; PG8_MMA(1, 1, At, B1); PG8_BAR;
            PG8_LDB(B0, 1, 0); PG8_SCHED; PG8_LDA(At, 1, 0); PG8_STAGE(PG8_SA(0, 1), a2 + hstep, voffA);
            PG8_WAIT_L(8); PG8_BAR; PG8_WAIT_L(0); PG8_MMA(0, 0, At, B0); PG8_BAR; PG8_SCHED;
            PG8_LDB(B1, 1, 1); PG8_STAGE(PG8_SB(1, 0), b3, voffB);
            PG8_BAR; PG8_WAIT_L(0); PG8_MMA(0, 1, At, B1); PG8_BAR;
            PG8_LDA(At, 1, 1); PG8_STAGE(PG8_SA(1, 0), a3, voffA);
            PG8_BAR; PG8_WAIT_L(0); PG8_MMA(1, 0, At, B0); PG8_BAR; PG8_SCHED;
            PG8_STAGE(PG8_SB(1, 1), b3 + hstep, voffB);
            PG8_WAIT_V(6); PG8_BAR; PG8_MMA(1, 1, At, B1); PG8_BAR;
            }
        }
        if constexpr (ALIGN_EPI) { if (wr == 0) PG8_BAR; }
        if constexpr (!Epi::AFTER_DRAIN) { E(acc, cur, wr, wc, fr, fq); S.done(cur); }
        if (!has_next) break;
#pragma unroll
        for (int a = 0; a < 2; ++a)
#pragma unroll
            for (int b = 0; b < 2; ++b)
#pragma unroll
                for (int m = 0; m < 4; ++m)
#pragma unroll
                    for (int n = 0; n < 2; ++n) acc[a][b][m][n] = (f32x4){0.f, 0.f, 0.f, 0.f};
        cur = nxt; cA = nA; cB = nB; ++ui;
        if constexpr (ALIGN_EPI) { if (wr == 1) PG8_BAR; }
    }
    PG8_WAIT_V(0);
    if constexpr (!ALIGN_EPI) { if (wr == 0) PG8_BAR; }
    PG8_BAR;
    if constexpr (Epi::AFTER_DRAIN) { E.fused(acc, cur, wr, wc, fr, fq, lds, wid, lane); S.done(cur); }
#undef PG8_SA
#undef PG8_SB
#undef PG8_STAGE
#undef PG8_LDA
#undef PG8_LDB
#undef PG8_MMA
#undef PG8_WAIT_V
#undef PG8_WAIT_L
#undef PG8_BAR
#undef PG8_SCHED
}
}

#ifndef FAST_GEMM
#define FAST_GEMM 1
#endif
template <class E8>
__device__ __forceinline__ void gemm_any(const bf16_t* A, const bf16_t* Bt, int M, int N, int K, const E8& E, float* lds, int bid, int nb) {
#if FAST_GEMM
  pg8::Gemm g{A, Bt, M, N, K}; pg8::StaticOrder S; S.init(M, N, nb, bid);
  pg8::EpiA<E8> EA{E};
  pg8::gemm_phase<pg8::EpiA<E8>, pg8::StaticOrder, true, true>((PG8_LAS unsigned char*)lds, g, S, EA);
#else
  gemm_naive(A, Bt, M, N, K, E, lds, bid, nb);
#endif
}

__device__ void gla_naive(const Params& p, const WS& w, int b, int h, float* lds) {
  constexpr int CH = 16;
  const int tid = tidx(), dv = tid & 255, half = tid >> 8, wave = tid >> 6, lane = tid & 63;
  float* qf = lds; float* kf = qf + CH * 128; float* af = kf + CH * 128; float* vf = af + CH * 128; float* op = vf + CH * 256;
  float S[64];
#pragma unroll
  for (int i = 0; i < 64; ++i) S[i] = 0.f;
  const int gd = tid & 127;
  float gu[16];
#pragma unroll
  for (int r = 0; r < 16; ++r) gu[r] = p.gate_up[r * 512 + h * 128 + gd];
  const float gb = p.gate_bias[h * 128 + gd];
  const float qscale = 0.08838834764831845f;
  for (int t0 = 0; t0 < SEQ; t0 += CH) {
    const size_t tb = (size_t)b * SEQ + t0;
    { const int tok = tid >> 5, d4 = (tid & 31) * 4;
      const uint2 qv = *(const uint2*)(w.proj + (tb + tok) * NPROJ + C_GQ + h * 128 + d4);
      const uint2 kv = *(const uint2*)(w.proj + (tb + tok) * NPROJ + C_GK + h * 128 + d4);
      *(float4*)(qf + tok * 128 + d4) = make_float4(lo_f(qv.x) * qscale, hi_f(qv.x) * qscale, lo_f(qv.y) * qscale, hi_f(qv.y) * qscale);
      *(float4*)(kf + tok * 128 + d4) = make_float4(lo_f(kv.x), hi_f(kv.x), lo_f(kv.y), hi_f(kv.y)); }
    { const int dvv = tid & 255, tk8 = (tid >> 8) * 8; float f[8];
      unpack8(*(const uint4*)(w.vT + (size_t)(h * 256 + dvv) * T + tb + tk8), f);
#pragma unroll
      for (int j = 0; j < 8; ++j) vf[(tk8 + j) * 256 + dvv] = f[j]; }
#pragma unroll
    for (int i = 0; i < 4; ++i) { const int tok = (tid >> 7) * 4 + i; float z = gb; float gl[16];
      unpack8(*(const uint4*)(w.proj + (tb + tok) * NPROJ + C_SM), gl); unpack8(*(const uint4*)(w.proj + (tb + tok) * NPROJ + C_SM + 8), gl + 8);
#pragma unroll
      for (int r = 0; r < 16; ++r) z += gl[r] * gu[r];
      af[tok * 128 + gd] = __expf(logsigmoidf_(z) * (1.f / 16.f)); }
    __syncthreads();
    for (int tok = 0; tok < CH; ++tok) {
      const float vv = vf[tok * 256 + dv]; float acc = 0.f;
#pragma unroll
      for (int i4 = 0; i4 < 16; ++i4) {
        const float4 a = *(const float4*)(af + tok * 128 + half * 64 + i4 * 4), k = *(const float4*)(kf + tok * 128 + half * 64 + i4 * 4), q = *(const float4*)(qf + tok * 128 + half * 64 + i4 * 4);
        S[i4 * 4 + 0] = a.x * S[i4 * 4 + 0] + k.x * vv; acc += q.x * S[i4 * 4 + 0];
        S[i4 * 4 + 1] = a.y * S[i4 * 4 + 1] + k.y * vv; acc += q.y * S[i4 * 4 + 1];
        S[i4 * 4 + 2] = a.z * S[i4 * 4 + 2] + k.z * vv; acc += q.z * S[i4 * 4 + 2];
        S[i4 * 4 + 3] = a.w * S[i4 * 4 + 3] + k.w * vv; acc += q.w * S[i4 * 4 + 3];
      }
      op[(half * CH + tok) * 256 + dv] = acc;
    }
    __syncthreads();
#pragma unroll
    for (int i = 0; i < 2; ++i) { const int tok = wave * 2 + i;
      const float4 o0 = *(const float4*)(op + tok * 256 + lane * 4), o1 = *(const float4*)(op + (CH + tok) * 256 + lane * 4);
      const float o[4] = {o0.x + o1.x, o0.y + o1.y, o0.z + o1.z, o0.w + o1.w};
      float ss = wave_sum(o[0] * o[0] + o[1] * o[1] + o[2] * o[2] + o[3] * o[3]);
      const float rs = rsqrtf(ss * (1.f / 256.f) + EPS);
      const uint2 gg = *(const uint2*)(w.proj + (tb + tok) * NPROJ + C_GG + h * 256 + lane * 4);
      const float4 gn = *(const float4*)(p.gla_norm + h * 256 + lane * 4);
      const float y0 = o[0] * rs * gn.x * siluf_(lo_f(gg.x)), y1 = o[1] * rs * gn.y * siluf_(hi_f(gg.x)), y2 = o[2] * rs * gn.z * siluf_(lo_f(gg.y)), y3 = o[3] * rs * gn.w * siluf_(hi_f(gg.y));
      *(uint2*)(w.y + (tb + tok) * D + h * 256 + lane * 4) = make_uint2(pack2(y0, y1), pack2(y2, y3)); }
    __syncthreads();
  }
}
__device__ void mlstm_naive(const Params& p, const WS& w, int b, int h, float* lds) {
  constexpr int CH = 16;
  const int tid = tidx(), dv = tid & 255, half = tid >> 8, wave = tid >> 6, lane = tid & 63;
  float* qf = lds; float* kf = qf + CH * 128; float* vf = kf + CH * 128; float* op = vf + CH * 256; float* dn = op + 2 * CH * 256; float* gt = dn + 2 * CH * 256;
  float C[64], n[4];
#pragma unroll
  for (int i = 0; i < 64; ++i) C[i] = 0.f;
#pragma unroll
  for (int i = 0; i < 4; ++i) n[i] = 0.f;
  const int nd = half * 64 + (dv & 15) * 4;
  const float kscale = 0.08838834764831845f;
  const float ib = p.ig_bias[h], fb = p.fg_bias[h];
  for (int t0 = 0; t0 < SEQ; t0 += CH) {
    const size_t tb = (size_t)b * SEQ + t0;
    { const int tok = tid >> 5, d4 = (tid & 31) * 4;
      float qa[4], ka[4];
#pragma unroll
      for (int c = 0; c < 4; ++c) { qa[c] = p.conv_b[h * 128 + d4 + c]; ka[c] = p.conv_b[512 + h * 128 + d4 + c]; }
#pragma unroll
      for (int wi = 0; wi < 4; ++wi) { const int ts = t0 + tok - 3 + wi;
        if (ts >= 0) { const size_t tr = (size_t)b * SEQ + ts;
          const uint2 qv = *(const uint2*)(w.proj + tr * NPROJ + C_MQ + h * 128 + d4), kv = *(const uint2*)(w.proj + tr * NPROJ + C_MK + h * 128 + d4);
          const float4 cq = *(const float4*)(p.conv_w + wi * 1024 + h * 128 + d4), ck = *(const float4*)(p.conv_w + wi * 1024 + 512 + h * 128 + d4);
          qa[0] += cq.x * lo_f(qv.x); qa[1] += cq.y * hi_f(qv.x); qa[2] += cq.z * lo_f(qv.y); qa[3] += cq.w * hi_f(qv.y);
          ka[0] += ck.x * lo_f(kv.x); ka[1] += ck.y * hi_f(kv.x); ka[2] += ck.z * lo_f(kv.y); ka[3] += ck.w * hi_f(kv.y); } }
      *(float4*)(qf + tok * 128 + d4) = make_float4(siluf_(qa[0]), siluf_(qa[1]), siluf_(qa[2]), siluf_(qa[3]));
      *(float4*)(kf + tok * 128 + d4) = make_float4(siluf_(ka[0]) * kscale, siluf_(ka[1]) * kscale, siluf_(ka[2]) * kscale, siluf_(ka[3]) * kscale); }
    { const int dvv = tid & 255, tk8 = (tid >> 8) * 8; float f[8];
      unpack8(*(const uint4*)(w.vT + (size_t)(1024 + h * 256 + dvv) * T + tb + tk8), f);
#pragma unroll
      for (int j = 0; j < 8; ++j) vf[(tk8 + j) * 256 + dvv] = f[j]; }
    if (tid < CH) { const float mi = bf2f(w.proj[(tb + tid) * NPROJ + C_SM + 16 + h]), mf = bf2f(w.proj[(tb + tid) * NPROJ + C_SM + 20 + h]);
      gt[tid * 2] = __expf(mi + ib); gt[tid * 2 + 1] = sigmoidf_(mf + fb); }
    __syncthreads();
    for (int tok = 0; tok < CH; ++tok) {
      const float vv = vf[tok * 256 + dv], ig = gt[tok * 2], fg = gt[tok * 2 + 1]; float num = 0.f, den = 0.f;
#pragma unroll
      for (int i4 = 0; i4 < 16; ++i4) {
        const float4 k = *(const float4*)(kf + tok * 128 + half * 64 + i4 * 4), q = *(const float4*)(qf + tok * 128 + half * 64 + i4 * 4);
        const float kk[4] = {k.x * ig, k.y * ig, k.z * ig, k.w * ig}; const float qq[4] = {q.x, q.y, q.z, q.w};
#pragma unroll
        for (int c = 0; c < 4; ++c) { C[i4 * 4 + c] = fg * C[i4 * 4 + c] + kk[c] * vv; num += qq[c] * C[i4 * 4 + c]; }
      }
      { const float4 k = *(const float4*)(kf + tok * 128 + nd), q = *(const float4*)(qf + tok * 128 + nd);
        n[0] = fg * n[0] + k.x * ig; n[1] = fg * n[1] + k.y * ig; n[2] = fg * n[2] + k.z * ig; n[3] = fg * n[3] + k.w * ig;
        den = q.x * n[0] + q.y * n[1] + q.z * n[2] + q.w * n[3];
        den += __shfl_xor(den, 1); den += __shfl_xor(den, 2); den += __shfl_xor(den, 4); den += __shfl_xor(den, 8); }
      op[(half * CH + tok) * 256 + dv] = num; if (dv == 0) dn[half * CH + tok] = den;
    }
    __syncthreads();
#pragma unroll
    for (int i = 0; i < 2; ++i) { const int tok = wave * 2 + i;
      const float4 o0 = *(const float4*)(op + tok * 256 + lane * 4), o1 = *(const float4*)(op + (CH + tok) * 256 + lane * 4);
      const float den = dn[tok] + dn[CH + tok];
      const float inv = 1.f / fmaxf(fabsf(den), 1.f);
      const float o[4] = {(o0.x + o1.x) * inv, (o0.y + o1.y) * inv, (o0.z + o1.z) * inv, (o0.w + o1.w) * inv};
      float ss = wave_sum(o[0] * o[0] + o[1] * o[1] + o[2] * o[2] + o[3] * o[3]);
      const float rs = rsqrtf(ss * (1.f / 256.f) + EPS);
      const uint2 mo = *(const uint2*)(w.proj + (tb + tok) * NPROJ + C_MO + h * 256 + lane * 4);
      const float4 gn = *(const float4*)(p.mlstm_norm + h * 256 + lane * 4);
      const float y0 = o[0] * rs * gn.x * sigmoidf_(lo_f(mo.x)), y1 = o[1] * rs * gn.y * sigmoidf_(hi_f(mo.x)), y2 = o[2] * rs * gn.z * sigmoidf_(lo_f(mo.y)), y3 = o[3] * rs * gn.w * sigmoidf_(hi_f(mo.y));
      *(uint2*)(w.y + (tb + tok) * D + 1024 + h * 256 + lane * 4) = make_uint2(pack2(y0, y1), pack2(y2, y3)); }
    __syncthreads();
  }
}
__device__ void phase_mixer_naive(const Params& p, const WS& w, float* lds, int bid, int nb) {
  for (int item = bid; item < 16; item += nb) {
    if (item < 8) gla_naive(p, w, item >> 2, item & 3, lds); else mlstm_naive(p, w, (item - 8) >> 2, item & 3, lds);
    __syncthreads();
  }
}

__device__ __forceinline__ unsigned sort16(unsigned b) { return (b & 0x8000u) ? (~b & 0xffffu) : (b | 0x8000u); }
__device__ __forceinline__ float unsort16(unsigned k) { const unsigned b = (k & 0x8000u) ? (k & 0x7fffu) : (~k & 0xffffu); return __uint_as_float(b << 16); }
__device__ __forceinline__ unsigned sort32(float f) { const unsigned u = __float_as_uint(f); return (u & 0x80000000u) ? ~u : (u | 0x80000000u); }
__device__ __forceinline__ float unsort32(unsigned k) { const unsigned u = (k & 0x80000000u) ? (k & 0x7fffffffu) : ~k; return __uint_as_float(u); }
__device__ void phase_topk(const Params& p, const WS& w, int bid, int nb) {
  for (int th = bid * 512 + tidx(); th < T * 8; th += nb * 512) {
    const int t = th >> 3, h = th & 7;
    const uint4* s = (const uint4*)(w.sc + (size_t)t * D + h * 256);
    unsigned l[2][16];
#pragma unroll
    for (int pp = 0; pp < 2; ++pp) {
#pragma unroll
      for (int i = 0; i < 16; ++i) l[pp][i] = 0u;
      for (int q = 0; q < 16; ++q) {
        const uint4 v = s[pp * 16 + q]; const unsigned wds[4] = {v.x, v.y, v.z, v.w};
#pragma unroll
        for (int e = 0; e < 8; ++e) {
          const unsigned b = (e & 1) ? (wds[e >> 1] >> 16) : (wds[e >> 1] & 0xffffu);
          unsigned x = (sort16(b) << 16) | (unsigned)(q * 8 + e);
#pragma unroll
          for (int i = 0; i < 16; ++i) { const unsigned hi = max(l[pp][i], x); x = min(l[pp][i], x); l[pp][i] = hi; }
        }
      }
    }
    unsigned long long lc[16];
#pragma unroll
    for (int i = 0; i < 16; ++i) lc[i] = 0ull;
#pragma unroll
    for (int i = 0; i < 16; ++i)
#pragma unroll
      for (int j = 0; j < 16; ++j) if ((i + 1) * (j + 1) <= 16) {
        const float sv = unsort16(l[0][i] >> 16) + unsort16(l[1][j] >> 16);
        unsigned long long x = ((unsigned long long)sort32(sv) << 32) | (unsigned long long)((l[0][i] & 0xffffu) * 128u + (l[1][j] & 0xffffu));
#pragma unroll
        for (int k = 0; k < 16; ++k) { const bool gt = x > lc[k]; const unsigned long long hi = gt ? x : lc[k]; x = gt ? lc[k] : x; lc[k] = hi; }
      }
    const float mx = unsort32((unsigned)(lc[0] >> 32));
    float e[16], sum = 0.f;
#pragma unroll
    for (int k = 0; k < 16; ++k) { e[k] = __expf(unsort32((unsigned)(lc[k] >> 32)) - mx); sum += e[k]; }
    const float inv = 1.f / sum;
    int* ei = w.eidx + (size_t)t * 128 + h * 16; float* eg = w.eg + (size_t)t * 128 + h * 16;
#pragma unroll
    for (int k4 = 0; k4 < 4; ++k4) {
      *(int4*)(ei + k4 * 4) = make_int4((int)(lc[k4 * 4] & 0xffffffffu), (int)(lc[k4 * 4 + 1] & 0xffffffffu), (int)(lc[k4 * 4 + 2] & 0xffffffffu), (int)(lc[k4 * 4 + 3] & 0xffffffffu));
      *(float4*)(eg + k4 * 4) = make_float4(e[k4 * 4] * inv, e[k4 * 4 + 1] * inv, e[k4 * 4 + 2] * inv, e[k4 * 4 + 3] * inv);
    }
  }
}
__device__ void phase_peer(const Params& p, const WS& w, int bid, int nb) {
  const int wave = tidx() >> 6, lane = tidx() & 63;
  for (int t = bid * 8 + wave; t < T; t += nb * 8) {
    float hr[32], out[32];
#pragma unroll
    for (int i = 0; i < 4; ++i) unpack8(*(const uint4*)(w.h1b + (size_t)t * D + i * 512 + lane * 8), hr + i * 8);
#pragma unroll
    for (int i = 0; i < 32; ++i) out[i] = 0.f;
    const float rs2 = rsqrtf(w.ssq2[t] * (1.f / D) + EPS);
    for (int h = 0; h < 8; ++h) {
      const int idxv = w.eidx[(size_t)t * 128 + h * 16 + (lane & 15)]; const float gv = w.eg[(size_t)t * 128 + h * 16 + (lane & 15)];
#pragma unroll 4
      for (int k = 0; k < 16; ++k) {
        const int e = __shfl(idxv, k); const float g = __shfl(gv, k);
        const bf16_t* ur = w.ub + (size_t)e * D; const bf16_t* vr = w.vb + (size_t)e * D;
        float s = 0.f;
#pragma unroll
        for (int i = 0; i < 4; ++i) { float f[8]; unpack8(*(const uint4*)(ur + i * 512 + lane * 8), f);
#pragma unroll
          for (int j = 0; j < 8; ++j) s += f[j] * hr[i * 8 + j]; }
        s = wave_sum(s);
        const float wgt = g * gelu_tanh(s * rs2);
#pragma unroll
        for (int i = 0; i < 4; ++i) { float f[8]; unpack8(*(const uint4*)(vr + i * 512 + lane * 8), f);
#pragma unroll
          for (int j = 0; j < 8; ++j) out[i * 8 + j] += wgt * f[j]; }
      }
    }
    float ss = 0.f;
#pragma unroll
    for (int i = 0; i < 32; ++i) { out[i] += hr[i]; ss += out[i] * out[i]; }
    ss = wave_sum(ss);
#pragma unroll
    for (int i = 0; i < 4; ++i) *(uint4*)(w.h2b + (size_t)t * D + i * 512 + lane * 8) = pack8(out + i * 8);
    if (lane == 0) w.rstd3[t] = rsqrtf(ss * (1.f / D) + EPS);
  }
}
__device__ void phase_final(const Params& p, const WS& w, int bid, int nb) {
  const int wave = tidx() >> 6, lane = tidx() & 63;
  for (int row = bid * 8 + wave; row < T; row += nb * 8) {
    float4* o = (float4*)(p.out + (size_t)row * D);
    const float rs = rsqrtf(w.ssq4[row] * (1.f / D) + EPS);
#pragma unroll
    for (int i = 0; i < 8; ++i) { float4 v = o[i * 64 + lane]; const float4 g = *(const float4*)(p.norm_final + (i * 64 + lane) * 4); v.x *= rs * g.x; v.y *= rs * g.y; v.z *= rs * g.z; v.w *= rs * g.w; o[i * 64 + lane] = v; }
  }
}

constexpr int NPHASE = 10;
template <int PH>
__device__ __forceinline__ void run_phase(const Params& p, float* lds, int bid, int nb) {
  const WS w = make_ws(p.ws);
  if (PH == 0) phase_prep(p, w, lds, bid, nb);
  if (PH == 1) { gemm_any(w.xb, w.win, T, NPROJ, D, EpiProjN{w.proj, w.rstd1}, lds, bid, nb);
                 gemm_any(w.win + (size_t)NPROJ * D, w.xb, 2048, T, D, EpiProjT{w.vT, w.rstd1}, lds, bid, nb); }
  if (PH == 2) phase_mixer_naive(p, w, lds, bid, nb);
  if (PH == 3) gemm_any(w.y, w.wout, T, D, D, EpiOut{p.x, w.h1b, w.ssq2}, lds, bid, nb);
  if (PH == 4) gemm_any(w.h1b, w.wq, T, D, D, EpiScore{w.sc, w.ssq2}, lds, bid, nb);
  if (PH == 5) { phase_topk(p, w, bid, nb); gemm_any(w.pb, w.wple, T, D, 256, EpiPl{w.pl}, lds, bid, nb); }
  if (PH == 6) phase_peer(p, w, bid, nb);
  if (PH == 7) gemm_any(w.h2b, w.wg, T, D, D, EpiGate{w.h2b, w.pl, w.rstd3, p.out, w.ssq4}, lds, bid, nb);
  if (PH == 8) phase_final(p, w, bid, nb);
}

extern __shared__ __attribute__((aligned(16))) unsigned char dyn_lds[];

#if ONE_LAUNCH
__global__ void __launch_bounds__(512, 2) mega(Params p) {
  cg::grid_group grid = cg::this_grid();
  float* lds = (float*)dyn_lds; const int bid = blockIdx.x, nb = gridDim.x;
  run_phase<0>(p, lds, bid, nb); grid.sync();
  run_phase<1>(p, lds, bid, nb); grid.sync();
  run_phase<2>(p, lds, bid, nb); grid.sync();
  run_phase<3>(p, lds, bid, nb); grid.sync();
  run_phase<4>(p, lds, bid, nb); grid.sync();
  run_phase<5>(p, lds, bid, nb); grid.sync();
  run_phase<6>(p, lds, bid, nb); grid.sync();
  run_phase<7>(p, lds, bid, nb); grid.sync();
  run_phase<8>(p, lds, bid, nb);
}
#else
template <int PH> __global__ void __launch_bounds__(512, 2) k_phase(Params p) { run_phase<PH>(p, (float*)dyn_lds, blockIdx.x, gridDim.x); }
#endif

constexpr size_t kDynLds = 131072;

extern "C" void kernel_launch(void* const* d_in, const int* in_sizes, int n_in, void* d_out, int out_size, void* d_ws, size_t ws_size, hipStream_t stream) {
  if (n_in != 22 || out_size != T * D || ws_size < WS_NEED) { fprintf(stderr, "kernel_launch: unexpected shapes (n_in %d out %d ws %zu)\n", n_in, out_size, ws_size); return; }
  Params p{};
  const float** f = (const float**)&p;
  for (int i = 0; i < 22; ++i) f[i] = (const float*)d_in[i];
  p.out = (float*)d_out; p.ws = (unsigned char*)d_ws;
#if ONE_LAUNCH
  static int grid_blocks = 0;
  if (!grid_blocks) {
    int dev = 0, cus = 0, per_cu = 0;
    (void)hipGetDevice(&dev); (void)hipDeviceGetAttribute(&cus, hipDeviceAttributeMultiprocessorCount, dev);
    (void)hipFuncSetAttribute((const void*)mega, hipFuncAttributeMaxDynamicSharedMemorySize, (int)kDynLds);
    (void)hipOccupancyMaxActiveBlocksPerMultiprocessor(&per_cu, mega, 512, kDynLds);
    if (per_cu < 1) { fprintf(stderr, "occupancy query says 0 blocks/CU\n"); per_cu = 1; }
    grid_blocks = cus;
  }
  void* args[] = {&p};
  hipError_t e = hipLaunchCooperativeKernel((void*)mega, dim3(grid_blocks), dim3(512), args, kDynLds, stream);
  if (e != hipSuccess) fprintf(stderr, "cooperative launch failed: %s (grid %d)\n", hipGetErrorString(e), grid_blocks);
#else
  static bool attr = false;
  const int G = 256;
#define LAUNCH(PH) do { if (!attr) (void)hipFuncSetAttribute((const void*)k_phase<PH>, hipFuncAttributeMaxDynamicSharedMemorySize, (int)kDynLds); \
    hipLaunchKernelGGL(k_phase<PH>, dim3(G), dim3(512), kDynLds, stream, p); } while (0)
  LAUNCH(0); LAUNCH(1); LAUNCH(2); LAUNCH(3); LAUNCH(4); LAUNCH(5); LAUNCH(6); LAUNCH(7); LAUNCH(8);
  attr = true;
#undef LAUNCH
#endif
}
```

```cpp
#include <hip/hip_runtime.h>
#include <hip/hip_cooperative_groups.h>
#include <cstdio>
#include <cstdint>
namespace cg = cooperative_groups;

#ifndef ONE_LAUNCH
#define ONE_LAUNCH 1
#endif

typedef unsigned short bf16_t;
constexpr int T = 32768, SEQ = 16384, D = 2048;
constexpr int NPROJ = 4352;
constexpr int C_GQ = 0, C_GK = 512, C_GG = 1024, C_MQ = 2048, C_MK = 2560, C_MO = 3072, C_SM = 4096;
constexpr float EPS = 1e-6f;
constexpr size_t MiB = 1ull << 20;
constexpr size_t OFF_XB = 0, OFF_Y = 0, OFF_PL = 0;
constexpr size_t OFF_PROJ = 128 * MiB, OFF_H1B = 128 * MiB, OFF_H2B = 256 * MiB;
constexpr size_t OFF_VT = 400 * MiB, OFF_SC = 400 * MiB;
constexpr size_t OFF_UB = 528 * MiB, OFF_VB = 592 * MiB;
constexpr size_t OFF_WIN = 656 * MiB, OFF_WOUT = 681 * MiB, OFF_WQ = 689 * MiB, OFF_WG = 697 * MiB, OFF_WPLE = 705 * MiB;
constexpr size_t OFF_PB = 706 * MiB, OFF_EIDX = 722 * MiB, OFF_EG = 738 * MiB, OFF_MISC = 754 * MiB;
constexpr size_t OFF_GDEC = 755 * MiB, OFF_MN = 756 * MiB, OFF_MDEC = 757 * MiB;
constexpr size_t WS_NEED = 760 * MiB;

struct Params {
  const float *x, *p, *norm_mix, *w_in, *gate_up, *gate_bias, *gla_norm, *conv_w, *conv_b, *ig_bias, *fg_bias, *mlstm_norm,
      *w_out, *norm_ffn, *peer_query, *sub_keys, *peer_u, *peer_v, *norm_ple, *w_ple, *w_ple_gate, *norm_final;
  float* out;
  unsigned char* ws;
};

__device__ __forceinline__ float bf2f(bf16_t b) { return __uint_as_float(((unsigned)b) << 16); }
__device__ __forceinline__ bf16_t f2bf(float f) { unsigned u = __float_as_uint(f); u += 0x7FFFu + ((u >> 16) & 1u); return (bf16_t)(u >> 16); }
__device__ __forceinline__ unsigned pack2(float lo, float hi) { return (unsigned)f2bf(lo) | ((unsigned)f2bf(hi) << 16); }
__device__ __forceinline__ float lo_f(unsigned u) { return __uint_as_float(u << 16); }
__device__ __forceinline__ float hi_f(unsigned u) { return __uint_as_float(u & 0xffff0000u); }
__device__ __forceinline__ float wave_sum(float v) {
#pragma unroll
  for (int o = 32; o >= 1; o >>= 1) v += __shfl_xor(v, o);
  return v;
}
__device__ __forceinline__ int tidx() { int t = threadIdx.x; asm volatile("" : "+v"(t)); return t; }
__device__ __forceinline__ float sigmoidf_(float x) { return 1.f / (1.f + __expf(-x)); }
__device__ __forceinline__ float siluf_(float x) { return x / (1.f + __expf(-x)); }
__device__ __forceinline__ float logsigmoidf_(float x) { return fminf(x, 0.f) - log1pf(__expf(-fabsf(x))); }
__device__ __forceinline__ float gelu_tanh(float x) { const float u = 0.7978845608028654f * (x + 0.044715f * x * x * x); return 0.5f * x * (1.f + tanhf(u)); }
__device__ __forceinline__ void unpack8(const uint4 q, float* f) {
  f[0] = lo_f(q.x); f[1] = hi_f(q.x); f[2] = lo_f(q.y); f[3] = hi_f(q.y); f[4] = lo_f(q.z); f[5] = hi_f(q.z); f[6] = lo_f(q.w); f[7] = hi_f(q.w);
}
__device__ __forceinline__ uint4 pack8(const float* f) { return make_uint4(pack2(f[0], f[1]), pack2(f[2], f[3]), pack2(f[4], f[5]), pack2(f[6], f[7])); }

struct WS {
  bf16_t *xb, *y, *pl, *proj, *h1b, *h2b, *vT, *sc, *ub, *vb, *win, *wout, *wq, *wg, *wple, *pb;
  int* eidx; float* eg; float *rstd1, *ssq2, *rstd3, *ssq4, *gdec, *mn, *mdec;
};
__device__ __forceinline__ WS make_ws(unsigned char* ws) {
  WS w;
  w.xb = (bf16_t*)(ws + OFF_XB); w.y = (bf16_t*)(ws + OFF_Y); w.pl = (bf16_t*)(ws + OFF_PL); w.proj = (bf16_t*)(ws + OFF_PROJ);
  w.h1b = (bf16_t*)(ws + OFF_H1B); w.h2b = (bf16_t*)(ws + OFF_H2B); w.vT = (bf16_t*)(ws + OFF_VT); w.sc = (bf16_t*)(ws + OFF_SC);
  w.ub = (bf16_t*)(ws + OFF_UB); w.vb = (bf16_t*)(ws + OFF_VB); w.win = (bf16_t*)(ws + OFF_WIN); w.wout = (bf16_t*)(ws + OFF_WOUT);
  w.wq = (bf16_t*)(ws + OFF_WQ); w.wg = (bf16_t*)(ws + OFF_WG); w.wple = (bf16_t*)(ws + OFF_WPLE); w.pb = (bf16_t*)(ws + OFF_PB);
  w.eidx = (int*)(ws + OFF_EIDX); w.eg = (float*)(ws + OFF_EG);
  float* m = (float*)(ws + OFF_MISC); w.rstd1 = m; w.ssq2 = m + T; w.rstd3 = m + 2 * T; w.ssq4 = m + 3 * T;
  w.gdec = (float*)(ws + OFF_GDEC); w.mn = (float*)(ws + OFF_MN); w.mdec = (float*)(ws + OFF_MDEC);
  return w;
}

__device__ void prep_x(const Params& p, const WS& w, int bid, int nb) {
  const int wave = tidx() >> 6, lane = tidx() & 63;
  for (int row = bid * 8 + wave; row < T; row += nb * 8) {
    const float4* src = (const float4*)(p.x + (size_t)row * D);
    uint2* dst = (uint2*)(w.xb + (size_t)row * D);
    float ss = 0.f;
#pragma unroll
    for (int i = 0; i < 8; ++i) { const float4 v = src[i * 64 + lane]; ss += v.x * v.x + v.y * v.y + v.z * v.z + v.w * v.w; dst[i * 64 + lane] = make_uint2(pack2(v.x, v.y), pack2(v.z, v.w)); }
    ss = wave_sum(ss);
    if (lane == 0) w.rstd1[row] = rsqrtf(ss * (1.f / D) + EPS);
  }
}
__device__ void cvt_rows(const float* src, bf16_t* dst, size_t n, const float* gain, int ncols, int bid, int nb) {
  const size_t n4 = n / 4;
  for (size_t i = (size_t)bid * 512 + tidx(); i < n4; i += (size_t)nb * 512) {
    float4 v = ((const float4*)src)[i];
    if (gain) { const float4 g = *(const float4*)(gain + (int)((i * 4) % (size_t)ncols)); v.x *= g.x; v.y *= g.y; v.z *= g.z; v.w *= g.w; }
    ((uint2*)dst)[i] = make_uint2(pack2(v.x, v.y), pack2(v.z, v.w));
  }
}
template <class CM>
__device__ void transpose_w(const float* src, int K, int ldsrc, bf16_t* dst, int Ndst, const float* gain, CM cm, float* lds, int bid, int nb) {
  const int tid = tidx(), tk = K / 64, ntile = (Ndst / 64) * tk;
  for (int tile = bid; tile < ntile; tile += nb) {
    const int n0 = (tile / tk) * 64, k0 = (tile % tk) * 64;
    const int nc = tid & 63, sc = cm(n0 + nc);
#pragma unroll
    for (int i = 0; i < 8; ++i) { const int kr = (tid >> 6) + 8 * i; float v = 0.f; if (sc >= 0) { v = src[(size_t)(k0 + kr) * ldsrc + sc]; if (gain) v *= gain[k0 + kr]; } lds[kr * 65 + nc] = v; }
    __syncthreads();
    { const int nr = tid >> 3, ks = (tid & 7) * 8; float f[8];
#pragma unroll
      for (int j = 0; j < 8; ++j) f[j] = lds[(ks + j) * 65 + nr];
      *(uint4*)(dst + (size_t)(n0 + nr) * K + k0 + ks) = pack8(f); }
    __syncthreads();
  }
}
struct CmIdent { __device__ int operator()(int n) const { return n; } };
struct CmWin {
  __device__ int operator()(int n) const {
    if (n < 1024) return n;
    if (n < 2048) return 2048 + (n - 1024);
    if (n < 2560) return 3088 + (n - 2048);
    if (n < 3072) return 3600 + (n - 2560);
    if (n < 4096) return 5136 + (n - 3072);
    if (n < 4352) { const int i = n - 4096; if (i < 16) return 3072 + i; if (i < 20) return 6160 + (i - 16); if (i < 24) return 6164 + (i - 20); return -1; }
    const int j = n - 4352; if (j < 1024) return 1024 + j;
    return 4112 + (j - 1024);
  }
};
__device__ void prep_wq(const Params& p, const WS& w, float* lds, int bid, int nb) {
  const int tid = tidx();
  float* SKs = lds;
  float* WQs = lds + 128 * 132;
  for (int item = bid; item < 16 * 32; item += nb) {
    const int hp = item >> 5, k0 = (item & 31) * 64;
#pragma unroll
    for (int i = 0; i < 8; ++i) { const int e4 = tid + 512 * i, key = e4 >> 5, d4 = (e4 & 31) * 4; *(float4*)(SKs + key * 132 + d4) = *(const float4*)(p.sub_keys + (size_t)hp * 16384 + key * 128 + d4); }
#pragma unroll
    for (int i = 0; i < 4; ++i) { const int e4 = tid + 512 * i, kr = e4 >> 5, d4 = (e4 & 31) * 4; float4 v = *(const float4*)(p.peer_query + (size_t)(k0 + kr) * 2048 + hp * 128 + d4); const float g = p.norm_ffn[k0 + kr]; v.x *= g; v.y *= g; v.z *= g; v.w *= g; *(float4*)(WQs + kr * 132 + d4) = v; }
    __syncthreads();
    const int k = tid & 63, kg = tid >> 6;
    float acc[16];
#pragma unroll
    for (int j = 0; j < 16; ++j) acc[j] = 0.f;
    for (int d4 = 0; d4 < 32; ++d4) {
      const float4 a = *(const float4*)(WQs + k * 132 + d4 * 4);
#pragma unroll
      for (int j = 0; j < 16; ++j) { const float4 s = *(const float4*)(SKs + (kg * 16 + j) * 132 + d4 * 4); acc[j] += a.x * s.x + a.y * s.y + a.z * s.z + a.w * s.w; }
    }
#pragma unroll
    for (int j = 0; j < 16; ++j) w.wq[(size_t)(hp * 128 + kg * 16 + j) * 2048 + k0 + k] = f2bf(acc[j]);
    __syncthreads();
  }
}
__device__ void phase_prep(const Params& p, const WS& w, float* lds, int bid, int nb) {
  prep_x(p, w, bid, nb);
  cvt_rows(p.p, w.pb, (size_t)T * 256, nullptr, 256, bid, nb);
  cvt_rows(p.peer_u, w.ub, (size_t)16384 * 2048, p.norm_ffn, 2048, bid, nb);
  cvt_rows(p.peer_v, w.vb, (size_t)16384 * 2048, nullptr, 2048, bid, nb);
  transpose_w(p.w_in, 2048, 6168, w.win, 6400, p.norm_mix, CmWin(), lds, bid, nb);
  transpose_w(p.w_out, 2048, 2048, w.wout, 2048, nullptr, CmIdent(), lds, bid, nb);
  transpose_w(p.w_ple_gate, 2048, 2048, w.wg, 2048, p.norm_ple, CmIdent(), lds, bid, nb);
  transpose_w(p.w_ple, 256, 2048, w.wple, 2048, nullptr, CmIdent(), lds, bid, nb);
  prep_wq(p, w, lds, bid, nb);
  for (int i = bid * 512 + tidx(); i < T; i += nb * 512) { w.ssq2[i] = 0.f; w.ssq4[i] = 0.f; }
}

struct EpiProjN { bf16_t* out; const float* rstd; static constexpr bool ROWSUM = false;
  __device__ __forceinline__ float store8(int r, int c, const float* v) const { const float s = rstd[r]; float f[8];
#pragma unroll
    for (int j = 0; j < 8; ++j) f[j] = v[j] * s;
    *(uint4*)(out + (size_t)r * NPROJ + c) = pack8(f); return 0.f; }
  __device__ __forceinline__ void rowsum(int, float) const {} };
struct EpiProjT { bf16_t* out; const float* rstd; static constexpr bool ROWSUM = false;
  __device__ __forceinline__ float store8(int r, int c, const float* v) const { const float4 s0 = *(const float4*)(rstd + c), s1 = *(const float4*)(rstd + c + 4); float f[8];
    f[0] = v[0] * s0.x; f[1] = v[1] * s0.y; f[2] = v[2] * s0.z; f[3] = v[3] * s0.w; f[4] = v[4] * s1.x; f[5] = v[5] * s1.y; f[6] = v[6] * s1.z; f[7] = v[7] * s1.w;
    *(uint4*)(out + (size_t)r * T + c) = pack8(f); return 0.f; }
  __device__ __forceinline__ void rowsum(int, float) const {} };
struct EpiOut { const float* x; bf16_t* h1b; float* ssq; static constexpr bool ROWSUM = true;
  __device__ __forceinline__ float store8(int r, int c, const float* v) const { const float4 x0 = *(const float4*)(x + (size_t)r * D + c), x1 = *(const float4*)(x + (size_t)r * D + c + 4); float f[8];
    f[0] = v[0] + x0.x; f[1] = v[1] + x0.y; f[2] = v[2] + x0.z; f[3] = v[3] + x0.w; f[4] = v[4] + x1.x; f[5] = v[5] + x1.y; f[6] = v[6] + x1.z; f[7] = v[7] + x1.w;
    float s = 0.f;
#pragma unroll
    for (int j = 0; j < 8; ++j) s += f[j] * f[j];
    *(uint4*)(h1b + (size_t)r * D + c) = pack8(f); return s; }
  __device__ __forceinline__ void rowsum(int r, float s) const { atomicAdd(ssq + r, s); } };
struct EpiScore { bf16_t* sc; const float* ssq; static constexpr bool ROWSUM = false;
  __device__ __forceinline__ float store8(int r, int c, const float* v) const { const float s = rsqrtf(ssq[r] * (1.f / D) + EPS); float f[8];
#pragma unroll
    for (int j = 0; j < 8; ++j) f[j] = v[j] * s;
    *(uint4*)(sc + (size_t)r * D + c) = pack8(f); return 0.f; }
  __device__ __forceinline__ void rowsum(int, float) const {} };
struct EpiPl { bf16_t* pl; static constexpr bool ROWSUM = false;
  __device__ __forceinline__ float store8(int r, int c, const float* v) const { *(uint4*)(pl + (size_t)r * D + c) = pack8(v); return 0.f; }
  __device__ __forceinline__ void rowsum(int, float) const {} };
struct EpiGate { const bf16_t* h2b; const bf16_t* pl; const float* rstd3; float* out; float* ssq; static constexpr bool ROWSUM = true;
  __device__ __forceinline__ float store8(int r, int c, const float* v) const { const float rs = rstd3[r]; float h[8], q[8], f[8];
    unpack8(*(const uint4*)(h2b + (size_t)r * D + c), h); unpack8(*(const uint4*)(pl + (size_t)r * D + c), q);
    float s = 0.f;
#pragma unroll
    for (int j = 0; j < 8; ++j) { f[j] = h[j] + sigmoidf_(v[j] * rs) * q[j]; s += f[j] * f[j]; }
    *(float4*)(out + (size_t)r * D + c) = make_float4(f[0], f[1], f[2], f[3]); *(float4*)(out + (size_t)r * D + c + 4) = make_float4(f[4], f[5], f[6], f[7]); return s; }
  __device__ __forceinline__ void rowsum(int r, float s) const { atomicAdd(ssq + r, s); } };

template <class Epi>
__device__ void gemm_naive(const bf16_t* A, const bf16_t* Bt, int M, int N, int K, const Epi& E, float* lds, int bid, int nb) {
  const int tid = tidx(), ty = tid >> 4, tx = tid & 15;
  float* As = lds;
  float* Bs = lds + 32 * 132;
  const int nM = M / 128, nN = N / 128;
  for (int tile = bid; tile < nM * nN; tile += nb) {
    const int m0 = (tile % nM) * 128, n0 = (tile / nM) * 128;
    float acc[4][8];
#pragma unroll
    for (int i = 0; i < 4; ++i)
#pragma unroll
      for (int j = 0; j < 8; ++j) acc[i][j] = 0.f;
    const int lr = tid >> 2, lk = (tid & 3) * 8;
    for (int k0 = 0; k0 < K; k0 += 32) {
      const uint4 av = *(const uint4*)(A + (size_t)(m0 + lr) * K + k0 + lk);
      const uint4 bv = *(const uint4*)(Bt + (size_t)(n0 + lr) * K + k0 + lk);
      float af[8], bf[8]; unpack8(av, af); unpack8(bv, bf);
      __syncthreads();
#pragma unroll
      for (int j = 0; j < 8; ++j) { As[(lk + j) * 132 + lr] = af[j]; Bs[(lk + j) * 132 + lr] = bf[j]; }
      __syncthreads();
#pragma unroll 8
      for (int kk = 0; kk < 32; ++kk) {
        const float4 a = *(const float4*)(As + kk * 132 + ty * 4);
        const float4 b0 = *(const float4*)(Bs + kk * 132 + tx * 8), b1 = *(const float4*)(Bs + kk * 132 + tx * 8 + 4);
        const float aa[4] = {a.x, a.y, a.z, a.w}; const float bb[8] = {b0.x, b0.y, b0.z, b0.w, b1.x, b1.y, b1.z, b1.w};
#pragma unroll
        for (int i = 0; i < 4; ++i)
#pragma unroll
          for (int j = 0; j < 8; ++j) acc[i][j] += aa[i] * bb[j];
      }
    }
#pragma unroll
    for (int i = 0; i < 4; ++i) {
      const int r = m0 + ty * 4 + i;
      float s = E.store8(r, n0 + tx * 8, acc[i]);
      if (Epi::ROWSUM) { s += __shfl_xor(s, 1); s += __shfl_xor(s, 2); s += __shfl_xor(s, 4); s += __shfl_xor(s, 8); if (tx == 0) E.rowsum(r, s); }
    }
  }
}


namespace pg8 {
#define PG8_LAS __attribute__((address_space(3)))
typedef short bf16x8 __attribute__((ext_vector_type(8)));
typedef float f32x4 __attribute__((ext_vector_type(4)));
constexpr int BM = 256, BK = 64, HALF = 128, HTB = HALF * BK * 2, STAGE_BYTES = 8 * HTB, NXCD = 8, WGM = 8;
__host__ __device__ __forceinline__ int lds_byte(int r, int c) { const int st = (r >> 4) * 2 + (c >> 5), rr = r & 15, cc = c & 31, ob = rr * 64 + cc * 2; return st * 1024 + (ob ^ (((ob >> 9) & 1) << 5)); }
__host__ __device__ __forceinline__ void stage_rc(int b, int& R, int& C) { const int st = b / 1024, sb = b % 1024, swz = sb ^ (((sb >> 9) & 1) << 5); R = (st >> 1) * 16 + swz / 64; C = (st & 1) * 32 + (swz % 64) / 2; }
__host__ __device__ __forceinline__ int perm32(int rho) { const int n = rho >> 4, i = rho & 15; return 8 * (i >> 2) + 4 * n + (i & 3); }
struct Unit { int pm, pn; };
struct Gemm { const bf16_t* A; const bf16_t* Bt; int M, N, K; };
struct StaticOrder {
    int nM, nN, nwg, G, c;
    __host__ __device__ void init(int M, int N, int G_, int c_) { nM = M / BM; nN = N / BM; nwg = nM * nN; G = G_; c = c_; }
    __host__ __device__ bool next(int i, Unit& u) const {
        const long L = (long)i * G + c; if (L >= nwg) return false;
        int wgid = (int)L; { const int q = nwg / NXCD, r = nwg % NXCD, xcd = wgid % NXCD, off = wgid / NXCD; wgid = (xcd < r ? xcd * (q + 1) : r * (q + 1) + (xcd - r) * q) + off; }
        const int nig = WGM * nN, gid = wgid / nig, fm = gid * WGM, gsz = (nM - fm) < WGM ? (nM - fm) : WGM;
        u.pm = fm + ((wgid % nig) % gsz); u.pn = (wgid % nig) / gsz; return true;
    }
    __device__ __forceinline__ void a_ready(const Unit&) const {}
    __device__ __forceinline__ void done(const Unit&) const {}
};
template <class E8> struct EpiA {
    static constexpr bool PERM = true, AFTER_DRAIN = false;
    E8 e;
    __device__ __forceinline__ void operator()(const f32x4 (&acc)[2][2][4][2], const Unit& u, int wr, int wc, int fr, int fq) const {
        const int row0 = u.pm * BM + wr * 64 + fr, col0 = u.pn * BM + wc * 32 + 8 * fq;
#pragma unroll
        for (int ai = 0; ai < 2; ++ai)
#pragma unroll
            for (int m = 0; m < 4; ++m) { const int r = row0 + ai * HALF + m * 16; float s = 0.f;
#pragma unroll
                for (int bj = 0; bj < 2; ++bj) { const float v[8] = {acc[ai][bj][m][0][0], acc[ai][bj][m][0][1], acc[ai][bj][m][0][2], acc[ai][bj][m][0][3], acc[ai][bj][m][1][0], acc[ai][bj][m][1][1], acc[ai][bj][m][1][2], acc[ai][bj][m][1][3]};
                    s += e.store8(r, col0 + bj * HALF, v); }
                if (E8::ROWSUM) { s += __shfl_xor(s, 16); s += __shfl_xor(s, 32); if (fq == 0) e.rowsum(r, s); } }
    }
    __device__ __forceinline__ void fused(f32x4 (&)[2][2][4][2], const Unit&, int, int, int, int, PG8_LAS unsigned char*, int, int) const {}
};
template <class Epi, class Sched, bool ALIGN_EPI = false, bool SP2 = false>
__device__ __forceinline__ void gemm_phase(PG8_LAS unsigned char* lds, const Gemm g, const Sched& S, const Epi& E) {
    int tid_ = threadIdx.x; asm volatile("" : "+v"(tid_));
    const int tid = tid_, wid = __builtin_amdgcn_readfirstlane(tid >> 6), lane = tid & 63, wr = wid >> 2, wc = wid & 3, fr = lane & 15, fq = lane >> 4;
    const int K = g.K, nt = K / BK;
    unsigned voffA[2], voffB[2];
#pragma unroll
    for (int i = 0; i < 2; ++i) { int R, C; stage_rc(tid * 16 + i * 8192, R, C); const int Rb = Epi::PERM ? ((R & ~31) + perm32(R & 31)) : R;
        voffA[i] = (unsigned)(R * K + C) * 2u; voffB[i] = (unsigned)(Rb * K + C) * 2u; }
    const size_t kstep = (size_t)(BK * 2);
    const size_t hstep = (size_t)HALF * K * 2;
    const size_t tstep = 2 * hstep;
    const unsigned ldsw = (unsigned)wid * 1024u;
    const int aoff = lds_byte(wr * 64 + fr, fq * 8), boff = lds_byte(wc * 32 + fr, fq * 8);
#define PG8_SA(b, h) (((b) * 2 + (h)) * HTB)
#define PG8_SB(b, h) ((4 + (b) * 2 + (h)) * HTB)
#define PG8_STAGE(bufoff, gbase, voff) do { _Pragma("unroll") for (int _i = 0; _i < 2; ++_i) \
        __builtin_amdgcn_global_load_lds((const unsigned*)((const char*)(gbase) + (voff)[_i]), (PG8_LAS unsigned*)(lds + (bufoff) + ldsw + _i * 8192), 16, 0, 0); } while (0)
#define PG8_LDA(dst, b, h) do { _Pragma("unroll") for (int m = 0; m < 4; ++m) _Pragma("unroll") for (int k = 0; k < 2; ++k) dst[m][k] = *(const PG8_LAS bf16x8*)(lds + PG8_SA(b, h) + aoff + m * 2048 + k * 1024); } while (0)
#define PG8_LDB(dst, b, h) do { _Pragma("unroll") for (int n = 0; n < 2; ++n) _Pragma("unroll") for (int k = 0; k < 2; ++k) dst[n][k] = *(const PG8_LAS bf16x8*)(lds + PG8_SB(b, h) + boff + n * 2048 + k * 1024); } while (0)
#define PG8_MMA(ai, bj, At, Bt) do { __builtin_amdgcn_s_setprio(1); _Pragma("unroll") for (int m = 0; m < 4; ++m) _Pragma("unroll") for (int n = 0; n < 2; ++n) _Pragma("unroll") for (int k = 0; k < 2; ++k) \
        acc[ai][bj][m][n] = __builtin_amdgcn_mfma_f32_16x16x32_bf16(Bt[n][k], At[m][k], acc[ai][bj][m][n], 0, 0, 0); __builtin_amdgcn_s_setprio(0); } while (0)
#define PG8_WAIT_V(n) asm volatile("s_waitcnt vmcnt(" #n ")" ::: "memory")
#define PG8_WAIT_L(n) asm volatile("s_waitcnt lgkmcnt(" #n ")" ::: "memory")
#define PG8_BAR __builtin_amdgcn_s_barrier()
#define PG8_SCHED __builtin_amdgcn_sched_barrier(0)
    Unit cur, nxt; int ui = 0;
    if (!S.next(0, cur)) return;
    f32x4 acc[2][2][4][2];
#pragma unroll
    for (int a = 0; a < 2; ++a)
#pragma unroll
        for (int b = 0; b < 2; ++b)
#pragma unroll
            for (int m = 0; m < 4; ++m)
#pragma unroll
                for (int n = 0; n < 2; ++n) acc[a][b][m][n] = (f32x4){0.f, 0.f, 0.f, 0.f};
    bf16x8 At[4][2], B0[2][2], B1[2][2];
    const char* cA = (const char*)g.A + (size_t)cur.pm * tstep; const char* cB = (const char*)g.Bt + (size_t)cur.pn * tstep;
    S.a_ready(cur);
    if constexpr (SP2) {
        PG8_STAGE(PG8_SB(0, 0), cB, voffB); PG8_STAGE(PG8_SB(0, 1), cB + hstep, voffB); PG8_STAGE(PG8_SA(0, 0), cA, voffA); PG8_STAGE(PG8_SA(0, 1), cA + hstep, voffA);
        if (wr == 1) PG8_BAR;
        PG8_WAIT_V(2); PG8_BAR;
        PG8_STAGE(PG8_SB(1, 0), cB + kstep, voffB); PG8_STAGE(PG8_SA(1, 0), cA + kstep, voffA); PG8_STAGE(PG8_SB(1, 1), cB + hstep + kstep, voffB);
        PG8_WAIT_V(6); PG8_BAR;
    } else {
        PG8_STAGE(PG8_SB(0, 0), cB, voffB); PG8_STAGE(PG8_SA(0, 0), cA, voffA); PG8_STAGE(PG8_SB(0, 1), cB + hstep, voffB); PG8_STAGE(PG8_SA(0, 1), cA + hstep, voffA);
        if (wr == 1) PG8_BAR;
        PG8_WAIT_V(4); PG8_BAR;
        PG8_STAGE(PG8_SB(1, 0), cB + kstep, voffB); PG8_STAGE(PG8_SA(1, 0), cA + kstep, voffA); PG8_STAGE(PG8_SB(1, 1), cB + hstep + kstep, voffB);
        PG8_WAIT_V(6); PG8_BAR;
    }
    for (;;) {
        const bool has_next = S.next(ui + 1, nxt);
        const char* nA = has_next ? (const char*)g.A + (size_t)nxt.pm * tstep : cA; const char* nB = has_next ? (const char*)g.Bt + (size_t)nxt.pn * tstep : cB;
        for (int t = 0; t < nt; t += 2) {
            const bool last = (t == nt - 2);
            const char* a1 = cA + (size_t)(t + 1) * kstep;
            const char* a2 = last ? nA : cA + (size_t)(t + 2) * kstep; const char* b2 = last ? nB : cB + (size_t)(t + 2) * kstep;
            const char* a3 = a2 + kstep; const char* b3 = b2 + kstep;
            if (last && has_next) S.a_ready(nxt);
            if constexpr (SP2) {
            PG8_LDB(B0, 0, 0); PG8_LDB(B1, 0, 1); PG8_SCHED; PG8_LDA(At, 0, 0); PG8_STAGE(PG8_SA(1, 1), a1 + hstep, voffA);
            PG8_WAIT_V(8); PG8_WAIT_L(0); PG8_BAR; PG8_MMA(0, 0, At, B0); PG8_MMA(0, 1, At, B1); PG8_BAR; PG8_SCHED;
            PG8_LDA(At, 0, 1); PG8_STAGE(PG8_SB(0, 0), b2, voffB); PG8_STAGE(PG8_SB(0, 1), b2 + hstep, voffB); PG8_STAGE(PG8_SA(0, 0), a2, voffA);
            PG8_WAIT_V(8); PG8_WAIT_L(0); PG8_BAR; PG8_MMA(1, 0, At, B0); PG8_MMA(1, 1, At, B1); PG8_BAR; PG8_SCHED;
            PG8_LDB(B0, 1, 0); PG8_LDB(B1, 1, 1); PG8_SCHED; PG8_LDA(At, 1, 0); PG8_STAGE(PG8_SA(0, 1), a2 + hstep, voffA);
            PG8_WAIT_V(8); PG8_WAIT_L(0); PG8_BAR; PG8_MMA(0, 0, At, B0); PG8_MMA(0, 1, At, B1); PG8_BAR; PG8_SCHED;
            PG8_LDA(At, 1, 1); PG8_STAGE(PG8_SB(1, 0), b3, voffB); PG8_STAGE(PG8_SB(1, 1), b3 + hstep, voffB); PG8_STAGE(PG8_SA(1, 0), a3, voffA);
            PG8_WAIT_V(8); PG8_WAIT_L(0); PG8_BAR; PG8_MMA(1, 0, At, B0); PG8_MMA(1, 1, At, B1); PG8_BAR; PG8_SCHED;
            } else {
            PG8_LDB(B0, 0, 0); PG8_SCHED; PG8_LDA(At, 0, 0); PG8_STAGE(PG8_SA(1, 1), a1 + hstep, voffA);
            PG8_WAIT_L(8); PG8_BAR; PG8_WAIT_L(0); PG8_MMA(0, 0, At, B0); PG8_BAR; PG8_SCHED;
            PG8_LDB(B1, 0, 1); PG8_STAGE(PG8_SB(0, 0), b2, voffB);
            PG8_BAR; PG8_WAIT_L(0); PG8_MMA(0, 1, At, B1); PG8_BAR;
            PG8_LDA(At, 0, 1); PG8_STAGE(PG8_SA(0, 0), a2, voffA);
            PG8_BAR; PG8_WAIT_L(0); PG8_MMA(1, 0, At, B0); PG8_BAR; PG8_SCHED;
            PG8_STAGE(PG8_SB(0, 1), b2 + hstep, voffB);
            PG8_WAIT_V(6); PG8_BAR; PG8_MMA(1, 1, At, B1); PG8_BAR;
            PG8_LDB(B0, 1, 0); PG8_SCHED; PG8_LDA(At, 1, 0); PG8_STAGE(PG8_SA(0, 1), a2 + hstep, voffA);
            PG8_WAIT_L(8); PG8_BAR; PG8_WAIT_L(0); PG8_MMA(0, 0, At, B0); PG8_BAR; PG8_SCHED;
            PG8_LDB(B1, 1, 1); PG8_STAGE(PG8_SB(1, 0), b3, voffB);
            PG8_BAR; PG8_WAIT_L(0); PG8_MMA(0, 1, At, B1); PG8_BAR;
            PG8_LDA(At, 1, 1); PG8_STAGE(PG8_SA(1, 0), a3, voffA);
            PG8_BAR; PG8_WAIT_L(0); PG8_MMA(1, 0, At, B0); PG8_BAR; PG8_SCHED;
            PG8_STAGE(PG8_SB(1, 1), b3 + hstep, voffB);
            PG8_WAIT_V(6); PG8_BAR; PG8_MMA(1, 1, At, B1); PG8_BAR;
            }
        }
        if constexpr (ALIGN_EPI) { if (wr == 0) PG8_BAR; }
        if constexpr (!Epi::AFTER_DRAIN) { E(acc, cur, wr, wc, fr, fq); S.done(cur); }
        if (!has_next) break;
#pragma unroll
        for (int a = 0; a < 2; ++a)
#pragma unroll
            for (int b = 0; b < 2; ++b)
#pragma unroll
                for (int m = 0; m < 4; ++m)
#pragma unroll
                    for (int n = 0; n < 2; ++n) acc[a][b][m][n] = (f32x4){0.f, 0.f, 0.f, 0.f};
        cur = nxt; cA = nA; cB = nB; ++ui;
        if constexpr (ALIGN_EPI) { if (wr == 1) PG8_BAR; }
    }
    PG8_WAIT_V(0);
    if constexpr (!ALIGN_EPI) { if (wr == 0) PG8_BAR; }
    PG8_BAR;
    if constexpr (Epi::AFTER_DRAIN) { E.fused(acc, cur, wr, wc, fr, fq, lds, wid, lane); S.done(cur); }
#undef PG8_SA
#undef PG8_SB
#undef PG8_STAGE
#undef PG8_LDA
#undef PG8_LDB
#undef PG8_MMA
#undef PG8_WAIT_V
#undef PG8_WAIT_L
#undef PG8_BAR
#undef PG8_SCHED
}
}

#ifndef FAST_GEMM
#define FAST_GEMM 1
#endif
template <class E8>
__device__ __forceinline__ void gemm_any(const bf16_t* A, const bf16_t* Bt, int M, int N, int K, const E8& E, float* lds, int bid, int nb) {
#if FAST_GEMM
  pg8::Gemm g{A, Bt, M, N, K}; pg8::StaticOrder S; S.init(M, N, nb, bid);
  pg8::EpiA<E8> EA{E};
  pg8::gemm_phase<pg8::EpiA<E8>, pg8::StaticOrder, true, true>((PG8_LAS unsigned char*)lds, g, S, EA);
#else
  gemm_naive(A, Bt, M, N, K, E, lds, bid, nb);
#endif
}

__device__ void gla_naive(const Params& p, const WS& w, int b, int h, float* lds) {
  constexpr int CH = 16;
  const int tid = tidx(), dv = tid & 255, half = tid >> 8, wave = tid >> 6, lane = tid & 63;
  float* qf = lds; float* kf = qf + CH * 128; float* af = kf + CH * 128; float* vf = af + CH * 128; float* op = vf + CH * 256;
  float S[64];
#pragma unroll
  for (int i = 0; i < 64; ++i) S[i] = 0.f;
  const int gd = tid & 127;
  float gu[16];
#pragma unroll
  for (int r = 0; r < 16; ++r) gu[r] = p.gate_up[r * 512 + h * 128 + gd];
  const float gb = p.gate_bias[h * 128 + gd];
  const float qscale = 0.08838834764831845f;
  for (int t0 = 0; t0 < SEQ; t0 += CH) {
    const size_t tb = (size_t)b * SEQ + t0;
    { const int tok = tid >> 5, d4 = (tid & 31) * 4;
      const uint2 qv = *(const uint2*)(w.proj + (tb + tok) * NPROJ + C_GQ + h * 128 + d4);
      const uint2 kv = *(const uint2*)(w.proj + (tb + tok) * NPROJ + C_GK + h * 128 + d4);
      *(float4*)(qf + tok * 128 + d4) = make_float4(lo_f(qv.x) * qscale, hi_f(qv.x) * qscale, lo_f(qv.y) * qscale, hi_f(qv.y) * qscale);
      *(float4*)(kf + tok * 128 + d4) = make_float4(lo_f(kv.x), hi_f(kv.x), lo_f(kv.y), hi_f(kv.y)); }
    { const int dvv = tid & 255, tk8 = (tid >> 8) * 8; float f[8];
      unpack8(*(const uint4*)(w.vT + (size_t)(h * 256 + dvv) * T + tb + tk8), f);
#pragma unroll
      for (int j = 0; j < 8; ++j) vf[(tk8 + j) * 256 + dvv] = f[j]; }
#pragma unroll
    for (int i = 0; i < 4; ++i) { const int tok = (tid >> 7) * 4 + i; float z = gb; float gl[16];
      unpack8(*(const uint4*)(w.proj + (tb + tok) * NPROJ + C_SM), gl); unpack8(*(const uint4*)(w.proj + (tb + tok) * NPROJ + C_SM + 8), gl + 8);
#pragma unroll
      for (int r = 0; r < 16; ++r) z += gl[r] * gu[r];
      af[tok * 128 + gd] = __expf(logsigmoidf_(z) * (1.f / 16.f)); }
    __syncthreads();
    for (int tok = 0; tok < CH; ++tok) {
      const float vv = vf[tok * 256 + dv]; float acc = 0.f;
#pragma unroll
      for (int i4 = 0; i4 < 16; ++i4) {
        const float4 a = *(const float4*)(af + tok * 128 + half * 64 + i4 * 4), k = *(const float4*)(kf + tok * 128 + half * 64 + i4 * 4), q = *(const float4*)(qf + tok * 128 + half * 64 + i4 * 4);
        S[i4 * 4 + 0] = a.x * S[i4 * 4 + 0] + k.x * vv; acc += q.x * S[i4 * 4 + 0];
        S[i4 * 4 + 1] = a.y * S[i4 * 4 + 1] + k.y * vv; acc += q.y * S[i4 * 4 + 1];
        S[i4 * 4 + 2] = a.z * S[i4 * 4 + 2] + k.z * vv; acc += q.z * S[i4 * 4 + 2];
        S[i4 * 4 + 3] = a.w * S[i4 * 4 + 3] + k.w * vv; acc += q.w * S[i4 * 4 + 3];
      }
      op[(half * CH + tok) * 256 + dv] = acc;
    }
    __syncthreads();
#pragma unroll
    for (int i = 0; i < 2; ++i) { const int tok = wave * 2 + i;
      const float4 o0 = *(const float4*)(op + tok * 256 + lane * 4), o1 = *(const float4*)(op + (CH + tok) * 256 + lane * 4);
      const float o[4] = {o0.x + o1.x, o0.y + o1.y, o0.z + o1.z, o0.w + o1.w};
      float ss = wave_sum(o[0] * o[0] + o[1] * o[1] + o[2] * o[2] + o[3] * o[3]);
      const float rs = rsqrtf(ss * (1.f / 256.f) + EPS);
      const uint2 gg = *(const uint2*)(w.proj + (tb + tok) * NPROJ + C_GG + h * 256 + lane * 4);
      const float4 gn = *(const float4*)(p.gla_norm + h * 256 + lane * 4);
      const float y0 = o[0] * rs * gn.x * siluf_(lo_f(gg.x)), y1 = o[1] * rs * gn.y * siluf_(hi_f(gg.x)), y2 = o[2] * rs * gn.z * siluf_(lo_f(gg.y)), y3 = o[3] * rs * gn.w * siluf_(hi_f(gg.y));
      *(uint2*)(w.y + (tb + tok) * D + h * 256 + lane * 4) = make_uint2(pack2(y0, y1), pack2(y2, y3)); }
    __syncthreads();
  }
}
__device__ void mlstm_naive(const Params& p, const WS& w, int b, int h, float* lds) {
  constexpr int CH = 16;
  const int tid = tidx(), dv = tid & 255, half = tid >> 8, wave = tid >> 6, lane = tid & 63;
  float* qf = lds; float* kf = qf + CH * 128; float* vf = kf + CH * 128; float* op = vf + CH * 256; float* dn = op + 2 * CH * 256; float* gt = dn + 2 * CH * 256;
  float C[64], n[4];
#pragma unroll
  for (int i = 0; i < 64; ++i) C[i] = 0.f;
#pragma unroll
  for (int i = 0; i < 4; ++i) n[i] = 0.f;
  const int nd = half * 64 + (dv & 15) * 4;
  const float kscale = 0.08838834764831845f;
  const float ib = p.ig_bias[h], fb = p.fg_bias[h];
  for (int t0 = 0; t0 < SEQ; t0 += CH) {
    const size_t tb = (size_t)b * SEQ + t0;
    { const int tok = tid >> 5, d4 = (tid & 31) * 4;
      float qa[4], ka[4];
#pragma unroll
      for (int c = 0; c < 4; ++c) { qa[c] = p.conv_b[h * 128 + d4 + c]; ka[c] = p.conv_b[512 + h * 128 + d4 + c]; }
#pragma unroll
      for (int wi = 0; wi < 4; ++wi) { const int ts = t0 + tok - 3 + wi;
        if (ts >= 0) { const size_t tr = (size_t)b * SEQ + ts;
          const uint2 qv = *(const uint2*)(w.proj + tr * NPROJ + C_MQ + h * 128 + d4), kv = *(const uint2*)(w.proj + tr * NPROJ + C_MK + h * 128 + d4);
          const float4 cq = *(const float4*)(p.conv_w + wi * 1024 + h * 128 + d4), ck = *(const float4*)(p.conv_w + wi * 1024 + 512 + h * 128 + d4);
          qa[0] += cq.x * lo_f(qv.x); qa[1] += cq.y * hi_f(qv.x); qa[2] += cq.z * lo_f(qv.y); qa[3] += cq.w * hi_f(qv.y);
          ka[0] += ck.x * lo_f(kv.x); ka[1] += ck.y * hi_f(kv.x); ka[2] += ck.z * lo_f(kv.y); ka[3] += ck.w * hi_f(kv.y); } }
      *(float4*)(qf + tok * 128 + d4) = make_float4(siluf_(qa[0]), siluf_(qa[1]), siluf_(qa[2]), siluf_(qa[3]));
      *(float4*)(kf + tok * 128 + d4) = make_float4(siluf_(ka[0]) * kscale, siluf_(ka[1]) * kscale, siluf_(ka[2]) * kscale, siluf_(ka[3]) * kscale); }
    { const int dvv = tid & 255, tk8 = (tid >> 8) * 8; float f[8];
      unpack8(*(const uint4*)(w.vT + (size_t)(1024 + h * 256 + dvv) * T + tb + tk8), f);
#pragma unroll
      for (int j = 0; j < 8; ++j) vf[(tk8 + j) * 256 + dvv] = f[j]; }
    if (tid < CH) { const float mi = bf2f(w.proj[(tb + tid) * NPROJ + C_SM + 16 + h]), mf = bf2f(w.proj[(tb + tid) * NPROJ + C_SM + 20 + h]);
      gt[tid * 2] = __expf(mi + ib); gt[tid * 2 + 1] = sigmoidf_(mf + fb); }
    __syncthreads();
    for (int tok = 0; tok < CH; ++tok) {
      const float vv = vf[tok * 256 + dv], ig = gt[tok * 2], fg = gt[tok * 2 + 1]; float num = 0.f, den = 0.f;
#pragma unroll
      for (int i4 = 0; i4 < 16; ++i4) {
        const float4 k = *(const float4*)(kf + tok * 128 + half * 64 + i4 * 4), q = *(const float4*)(qf + tok * 128 + half * 64 + i4 * 4);
        const float kk[4] = {k.x * ig, k.y * ig, k.z * ig, k.w * ig}; const float qq[4] = {q.x, q.y, q.z, q.w};
#pragma unroll
        for (int c = 0; c < 4; ++c) { C[i4 * 4 + c] = fg * C[i4 * 4 + c] + kk[c] * vv; num += qq[c] * C[i4 * 4 + c]; }
      }
      { const float4 k = *(const float4*)(kf + tok * 128 + nd), q = *(const float4*)(qf + tok * 128 + nd);
        n[0] = fg * n[0] + k.x * ig; n[1] = fg * n[1] + k.y * ig; n[2] = fg * n[2] + k.z * ig; n[3] = fg * n[3] + k.w * ig;
        den = q.x * n[0] + q.y * n[1] + q.z * n[2] + q.w * n[3];
        den += __shfl_xor(den, 1); den += __shfl_xor(den, 2); den += __shfl_xor(den, 4); den += __shfl_xor(den, 8); }
      op[(half * CH + tok) * 256 + dv] = num; if (dv == 0) dn[half * CH + tok] = den;
    }
    __syncthreads();
#pragma unroll
    for (int i = 0; i < 2; ++i) { const int tok = wave * 2 + i;
      const float4 o0 = *(const float4*)(op + tok * 256 + lane * 4), o1 = *(const float4*)(op + (CH + tok) * 256 + lane * 4);
      const float den = dn[tok] + dn[CH + tok];
      const float inv = 1.f / fmaxf(fabsf(den), 1.f);
      const float o[4] = {(o0.x + o1.x) * inv, (o0.y + o1.y) * inv, (o0.z + o1.z) * inv, (o0.w + o1.w) * inv};
      float ss = wave_sum(o[0] * o[0] + o[1] * o[1] + o[2] * o[2] + o[3] * o[3]);
      const float rs = rsqrtf(ss * (1.f / 256.f) + EPS);
      const uint2 mo = *(const uint2*)(w.proj + (tb + tok) * NPROJ + C_MO + h * 256 + lane * 4);
      const float4 gn = *(const float4*)(p.mlstm_norm + h * 256 + lane * 4);
      const float y0 = o[0] * rs * gn.x * sigmoidf_(lo_f(mo.x)), y1 = o[1] * rs * gn.y * sigmoidf_(hi_f(mo.x)), y2 = o[2] * rs * gn.z * sigmoidf_(lo_f(mo.y)), y3 = o[3] * rs * gn.w * sigmoidf_(hi_f(mo.y));
      *(uint2*)(w.y + (tb + tok) * D + 1024 + h * 256 + lane * 4) = make_uint2(pack2(y0, y1), pack2(y2, y3)); }
    __syncthreads();
  }
}
__device__ void phase_mixer_naive(const Params& p, const WS& w, float* lds, int bid, int nb) {
  for (int item = bid; item < 16; item += nb) {
    if (item < 8) gla_naive(p, w, item >> 2, item & 3, lds); else mlstm_naive(p, w, (item - 8) >> 2, item & 3, lds);
    __syncthreads();
  }
}


typedef short bf16x8 __attribute__((ext_vector_type(8)));
typedef float f32x4 __attribute__((ext_vector_type(4)));
#define MFMA16(a, b, c) __builtin_amdgcn_mfma_f32_16x16x32_bf16(a, b, c, 0, 0, 0)
constexpr int L_GLR = 0, L_TOT = 4096, L_F = 6144, L_DEN = 6656, L_PART = 6912, L_QS = 9216, L_KS = 26624, L_P = 44032, L_NL = 53248, L_KDT = 9216;
constexpr int QS_LD = 136, P_LD = 72, KDT_LD = 72;

__device__ __forceinline__ void gla_gates(const Params& p, const WS& w, int h, size_t tb, unsigned char* ldsb, int tid, float* bv, float& blast) {
  float* glrs = (float*)(ldsb + L_GLR); float* tot = (float*)(ldsb + L_TOT);
  const int d = tid & 127, tg = tid >> 7;
  if (tid < 128) { float f[8]; unpack8(*(const uint4*)(w.proj + (tb + (tid >> 1)) * NPROJ + C_SM + (tid & 1) * 8), f);
#pragma unroll
    for (int j = 0; j < 8; ++j) glrs[(tid >> 1) * 16 + (tid & 1) * 8 + j] = f[j]; }
  float gu[16];
#pragma unroll
  for (int r = 0; r < 16; ++r) gu[r] = p.gate_up[r * 512 + h * 128 + d];
  const float gb = p.gate_bias[h * 128 + d];
  __syncthreads();
  float run = 0.f;
#pragma unroll
  for (int i = 0; i < 16; ++i) { const float* gl = glrs + (tg * 16 + i) * 16; float z = gb;
#pragma unroll
    for (int r4 = 0; r4 < 4; ++r4) { const float4 g4 = *(const float4*)(gl + r4 * 4); z += g4.x * gu[r4 * 4] + g4.y * gu[r4 * 4 + 1] + g4.z * gu[r4 * 4 + 2] + g4.w * gu[r4 * 4 + 3]; }
    run += logsigmoidf_(z) * (1.f / 16.f); bv[i] = run; }
  tot[tg * 128 + d] = run;
  __syncthreads();
  float off = 0.f; blast = 0.f;
#pragma unroll
  for (int g = 0; g < 4; ++g) { const float t = tot[g * 128 + d]; blast += t; if (g < tg) off += t; }
#pragma unroll
  for (int i = 0; i < 16; ++i) bv[i] += off;
}
__device__ __forceinline__ void mlstm_gates(const Params& p, const WS& w, int h, size_t tb, unsigned char* ldsb, int tid) {
  float* Fl = (float*)(ldsb + L_F);
  if (tid < 64) { const float mi = bf2f(w.proj[(tb + tid) * NPROJ + C_SM + 16 + h]), mf = bf2f(w.proj[(tb + tid) * NPROJ + C_SM + 20 + h]);
    float f = logsigmoidf_(mf + p.fg_bias[h]);
#pragma unroll
    for (int o = 1; o < 64; o <<= 1) { const float t = __shfl_up(f, o); if (tid >= o) f += t; }
    Fl[tid] = f; Fl[64 + tid] = mi + p.ig_bias[h]; }
  __syncthreads();
}
__device__ __forceinline__ void mlstm_conv16(const Params& p, const WS& w, int col, int cch, int b, int c, int tg, float scale, float* out) {
  float win[19];
  const int s0 = c * 64 + tg * 16 - 3;
#pragma unroll
  for (int m = 0; m < 19; ++m) { const int sp = s0 + m; win[m] = (sp >= 0) ? bf2f(w.proj[((size_t)b * SEQ + sp) * NPROJ + col]) : 0.f; }
  const float c0 = p.conv_w[cch], c1 = p.conv_w[1024 + cch], c2 = p.conv_w[2048 + cch], c3 = p.conv_w[3072 + cch], cb = p.conv_b[cch];
#pragma unroll
  for (int i = 0; i < 16; ++i) out[i] = siluf_(cb + c0 * win[i] + c1 * win[i + 1] + c2 * win[i + 2] + c3 * win[i + 3]) * scale;
}

template <int KIND>
__device__ void mix_local(const Params& p, const WS& w, int b, int h, int c, int item, unsigned char* ldsb) {
  const int tid = tidx(), lane = tid & 63, wave = tid >> 6, fr = lane & 15, fq = lane >> 4, d = tid & 127, tg = tid >> 7;
  const size_t tb = (size_t)b * SEQ + (size_t)c * 64;
  float* tot = (float*)(ldsb + L_TOT); const float* Fl = (const float*)(ldsb + L_F);
  bf16_t* kdT = (bf16_t*)(ldsb + L_KDT);
  float wgt[16], kv[16];
  if (KIND == 0) {
    float bv[16], blast; gla_gates(p, w, h, tb, ldsb, tid, bv, blast);
#pragma unroll
    for (int i = 0; i < 16; ++i) { wgt[i] = __expf(blast - bv[i]); kv[i] = bf2f(w.proj[(tb + tg * 16 + i) * NPROJ + C_GK + h * 128 + d]); }
    if (tg == 0) w.gdec[(size_t)item * 128 + d] = __expf(blast);
  } else {
    mlstm_gates(p, w, h, tb, ldsb, tid);
    const float flast = Fl[63];
#pragma unroll
    for (int i = 0; i < 16; ++i) wgt[i] = __expf(flast - Fl[tg * 16 + i] + Fl[64 + tg * 16 + i]);
    mlstm_conv16(p, w, C_MK + h * 128 + d, 512 + h * 128 + d, b, c, tg, 0.08838834764831845f, kv);
    if (tid == 0) w.mdec[item - 2048] = __expf(flast);
  }
  float un = 0.f; float kd[16];
#pragma unroll
  for (int i = 0; i < 16; ++i) { kd[i] = kv[i] * wgt[i]; un += kd[i]; }
  *(uint4*)(kdT + d * KDT_LD + tg * 16) = pack8(kd); *(uint4*)(kdT + d * KDT_LD + tg * 16 + 8) = pack8(kd + 8);
  if (KIND == 1) tot[tg * 128 + d] = un;
  __syncthreads();
  if (KIND == 1 && tg == 0) w.mn[(size_t)(item - 2048) * 128 + d] = tot[d] + tot[128 + d] + tot[256 + d] + tot[384 + d];
  const bf16_t* vrow = w.vT + (size_t)(KIND * 1024 + h * 256 + wave * 32 + fr) * T + tb + fq * 8;
  f32x4 acc[2][8];
#pragma unroll
  for (int yt = 0; yt < 2; ++yt)
#pragma unroll
    for (int xt = 0; xt < 8; ++xt) acc[yt][xt] = (f32x4){0.f, 0.f, 0.f, 0.f};
#pragma unroll
  for (int ks = 0; ks < 2; ++ks) {
    const bf16x8 y0 = *(const bf16x8*)(vrow + ks * 32), y1 = *(const bf16x8*)(vrow + (size_t)16 * T + ks * 32);
#pragma unroll
    for (int xt = 0; xt < 8; ++xt) { const bf16x8 xk = *(const bf16x8*)(kdT + (xt * 16 + fr) * KDT_LD + ks * 32 + fq * 8);
      acc[0][xt] = MFMA16(xk, y0, acc[0][xt]); acc[1][xt] = MFMA16(xk, y1, acc[1][xt]); }
  }
  bf16_t* S = (bf16_t*)p.out + (size_t)item * 32768;
#pragma unroll
  for (int yt = 0; yt < 2; ++yt)
#pragma unroll
    for (int xt = 0; xt < 8; ++xt) *(uint2*)(S + (wave * 32 + yt * 16 + fr) * 128 + xt * 16 + 4 * fq) = make_uint2(pack2(acc[yt][xt][0], acc[yt][xt][1]), pack2(acc[yt][xt][2], acc[yt][xt][3]));
  __syncthreads();
}

__device__ void mix_scan(const Params& p, const WS& w, int bid, int nb) {
  bf16_t* sbuf = (bf16_t*)p.out;
  for (int g = bid * 512 + tidx(); g < 16 * 8192; g += nb * 512) {
    const int combo = g >> 13, e = (g & 8191) * 4, dk = e & 127;
    bf16_t* base = sbuf + (size_t)combo * 256 * 32768 + e;
    float S0 = 0.f, S1 = 0.f, S2 = 0.f, S3 = 0.f;
    for (int c0 = 0; c0 < 256; c0 += 8) {
      uint2 u[8]; float4 dc[8];
#pragma unroll
      for (int k = 0; k < 8; ++k) { u[k] = *(const uint2*)(base + (size_t)(c0 + k) * 32768);
        if (combo < 8) dc[k] = *(const float4*)(w.gdec + (size_t)(combo * 256 + c0 + k) * 128 + dk);
        else { const float m = w.mdec[(combo - 8) * 256 + c0 + k]; dc[k] = make_float4(m, m, m, m); } }
#pragma unroll
      for (int k = 0; k < 8; ++k) { *(uint2*)(base + (size_t)(c0 + k) * 32768) = make_uint2(pack2(S0, S1), pack2(S2, S3));
        S0 = dc[k].x * S0 + lo_f(u[k].x); S1 = dc[k].y * S1 + hi_f(u[k].x); S2 = dc[k].z * S2 + lo_f(u[k].y); S3 = dc[k].w * S3 + hi_f(u[k].y); }
    }
  }
  for (int g = bid * 512 + tidx(); g < 8 * 128; g += nb * 512) {
    const int cb = g >> 7, d = g & 127; float n = 0.f;
    for (int c = 0; c < 256; ++c) { float* q = w.mn + (size_t)(cb * 256 + c) * 128 + d; const float u = *q; *q = n; n = w.mdec[cb * 256 + c] * n + u; }
  }
}

template <int KIND>
__device__ void mix_out(const Params& p, const WS& w, int b, int h, int c, int item, unsigned char* ldsb) {
  const int tid = tidx(), lane = tid & 63, wave = tid >> 6, fr = lane & 15, fq = lane >> 4, d = tid & 127, tg = tid >> 7;
  const size_t tb = (size_t)b * SEQ + (size_t)c * 64;
  const float* Fl = (const float*)(ldsb + L_F); float* denl = (float*)(ldsb + L_DEN); float* part = (float*)(ldsb + L_PART); float* nl = (float*)(ldsb + L_NL);
  bf16_t* qs = (bf16_t*)(ldsb + L_QS); bf16_t* ks = (bf16_t*)(ldsb + L_KS); bf16_t* P = (bf16_t*)(ldsb + L_P);
  {
    float qm[16], km[16], qv[16], kv[16];
    if (KIND == 0) {
      float bv[16], blast; gla_gates(p, w, h, tb, ldsb, tid, bv, blast);
#pragma unroll
      for (int i = 0; i < 16; ++i) { qm[i] = 0.08838834764831845f * __expf(bv[i]); km[i] = __expf(-bv[i]);
        qv[i] = bf2f(w.proj[(tb + tg * 16 + i) * NPROJ + C_GQ + h * 128 + d]); kv[i] = bf2f(w.proj[(tb + tg * 16 + i) * NPROJ + C_GK + h * 128 + d]); }
    } else {
      mlstm_gates(p, w, h, tb, ldsb, tid);
#pragma unroll
      for (int i = 0; i < 16; ++i) { const float F = Fl[tg * 16 + i]; qm[i] = __expf(F); km[i] = __expf(Fl[64 + tg * 16 + i] - F); }
      mlstm_conv16(p, w, C_MQ + h * 128 + d, h * 128 + d, b, c, tg, 1.f, qv);
      mlstm_conv16(p, w, C_MK + h * 128 + d, 512 + h * 128 + d, b, c, tg, 0.08838834764831845f, kv);
      if (tid < 128) nl[tid] = w.mn[(size_t)(item - 2048) * 128 + tid];
    }
#pragma unroll
    for (int i = 0; i < 16; ++i) { qs[(tg * 16 + i) * QS_LD + d] = f2bf(qv[i] * qm[i]); ks[(tg * 16 + i) * QS_LD + d] = f2bf(kv[i] * km[i]); }
  }
  __syncthreads();
#pragma unroll
  for (int q = 0; q < 2; ++q) { const int tt = wave * 2 + q, jt = tt >> 2, it = tt & 3; f32x4 a = (f32x4){0.f, 0.f, 0.f, 0.f};
#pragma unroll
    for (int k4 = 0; k4 < 4; ++k4) { const bf16x8 xk = *(const bf16x8*)(ks + (jt * 16 + fr) * QS_LD + k4 * 32 + fq * 8), yq = *(const bf16x8*)(qs + (it * 16 + fr) * QS_LD + k4 * 32 + fq * 8); a = MFMA16(xk, yq, a); }
    const int i = it * 16 + fr, j0 = jt * 16 + 4 * fq;
    const float v0 = (j0 <= i) ? a[0] : 0.f, v1 = (j0 + 1 <= i) ? a[1] : 0.f, v2 = (j0 + 2 <= i) ? a[2] : 0.f, v3 = (j0 + 3 <= i) ? a[3] : 0.f;
    *(uint2*)(P + i * P_LD + j0) = make_uint2(pack2(v0, v1), pack2(v2, v3)); }
  __syncthreads();
  if (KIND == 1) { const int i = tid >> 3, pt = tid & 7; float f[8]; float s = 0.f;
    unpack8(*(const uint4*)(P + i * P_LD + pt * 8), f);
#pragma unroll
    for (int j = 0; j < 8; ++j) s += f[j];
#pragma unroll
    for (int hh = 0; hh < 2; ++hh) { unpack8(*(const uint4*)(qs + i * QS_LD + pt * 16 + hh * 8), f);
#pragma unroll
      for (int j = 0; j < 8; ++j) s += f[j] * nl[pt * 16 + hh * 8 + j]; }
    s += __shfl_xor(s, 1); s += __shfl_xor(s, 2); s += __shfl_xor(s, 4);
    if (pt == 0) denl[i] = s; }
  f32x4 acc[2][4];
#pragma unroll
  for (int xt = 0; xt < 2; ++xt)
#pragma unroll
    for (int yt = 0; yt < 4; ++yt) acc[xt][yt] = (f32x4){0.f, 0.f, 0.f, 0.f};
  { const bf16_t* vrow = w.vT + (size_t)(KIND * 1024 + h * 256 + wave * 32 + fr) * T + tb + fq * 8;
#pragma unroll
    for (int k2 = 0; k2 < 2; ++k2) { const bf16x8 x0 = *(const bf16x8*)(vrow + k2 * 32), x1 = *(const bf16x8*)(vrow + (size_t)16 * T + k2 * 32);
#pragma unroll
      for (int yt = 0; yt < 4; ++yt) { const bf16x8 yp = *(const bf16x8*)(P + (yt * 16 + fr) * P_LD + k2 * 32 + fq * 8); acc[0][yt] = MFMA16(x0, yp, acc[0][yt]); acc[1][yt] = MFMA16(x1, yp, acc[1][yt]); } }
    const bf16_t* srow = (const bf16_t*)p.out + (size_t)item * 32768 + (wave * 32 + fr) * 128 + fq * 8;
#pragma unroll
    for (int k4 = 0; k4 < 4; ++k4) { const bf16x8 x0 = *(const bf16x8*)(srow + k4 * 32), x1 = *(const bf16x8*)(srow + 16 * 128 + k4 * 32);
#pragma unroll
      for (int yt = 0; yt < 4; ++yt) { const bf16x8 yq = *(const bf16x8*)(qs + (yt * 16 + fr) * QS_LD + k4 * 32 + fq * 8); acc[0][yt] = MFMA16(x0, yq, acc[0][yt]); acc[1][yt] = MFMA16(x1, yq, acc[1][yt]); } } }
  if (KIND == 1) __syncthreads();
#pragma unroll
  for (int yt = 0; yt < 4; ++yt) { float s = 0.f;
    if (KIND == 1) { const float inv = 1.f / fmaxf(fabsf(denl[yt * 16 + fr]), 1.f); acc[0][yt] *= inv; acc[1][yt] *= inv; }
#pragma unroll
    for (int xt = 0; xt < 2; ++xt)
#pragma unroll
      for (int r = 0; r < 4; ++r) s += acc[xt][yt][r] * acc[xt][yt][r];
    s += __shfl_xor(s, 16); s += __shfl_xor(s, 32);
    if (fq == 0) part[wave * 64 + yt * 16 + fr] = s; }
  __syncthreads();
  const float* gain = (KIND == 0 ? p.gla_norm : p.mlstm_norm) + h * 256;
#pragma unroll
  for (int yt = 0; yt < 4; ++yt) { const int i = yt * 16 + fr; float t = 0.f;
#pragma unroll
    for (int ww = 0; ww < 8; ++ww) t += part[ww * 64 + i];
    const float rs = rsqrtf(t * (1.f / 256.f) + EPS);
#pragma unroll
    for (int xt = 0; xt < 2; ++xt) { const int dv = wave * 32 + xt * 16 + 4 * fq;
      const uint2 gt = *(const uint2*)(w.proj + (tb + i) * NPROJ + (KIND == 0 ? C_GG : C_MO) + h * 256 + dv);
      const float4 gn = *(const float4*)(gain + dv);
      const float g0 = lo_f(gt.x), g1 = hi_f(gt.x), g2 = lo_f(gt.y), g3 = hi_f(gt.y);
      const float a0 = KIND == 0 ? siluf_(g0) : sigmoidf_(g0), a1 = KIND == 0 ? siluf_(g1) : sigmoidf_(g1), a2 = KIND == 0 ? siluf_(g2) : sigmoidf_(g2), a3 = KIND == 0 ? siluf_(g3) : sigmoidf_(g3);
      *(uint2*)(w.y + (tb + i) * D + KIND * 1024 + h * 256 + dv) = make_uint2(pack2(acc[xt][yt][0] * rs * gn.x * a0, acc[xt][yt][1] * rs * gn.y * a1), pack2(acc[xt][yt][2] * rs * gn.z * a2, acc[xt][yt][3] * rs * gn.w * a3)); } }
  __syncthreads();
}
template <int WHICH>
__device__ void phase_mix_items(const Params& p, const WS& w, unsigned char* ldsb, int bid, int nb) {
  for (int item = bid; item < 4096; item += nb) {
    const int kind = item >> 11, b = (item >> 10) & 1, h = (item >> 8) & 3, c = item & 255;
    if (WHICH == 0) { if (kind == 0) mix_local<0>(p, w, b, h, c, item, ldsb); else mix_local<1>(p, w, b, h, c, item, ldsb); }
    else { if (kind == 0) mix_out<0>(p, w, b, h, c, item, ldsb); else mix_out<1>(p, w, b, h, c, item, ldsb); }
  }
}

__device__ __forceinline__ unsigned sort16(unsigned b) { return (b & 0x8000u) ? (~b & 0xffffu) : (b | 0x8000u); }
__device__ __forceinline__ float unsort16(unsigned k) { const unsigned b = (k & 0x8000u) ? (k & 0x7fffu) : (~k & 0xffffu); return __uint_as_float(b << 16); }
__device__ __forceinline__ unsigned sort32(float f) { const unsigned u = __float_as_uint(f); return (u & 0x80000000u) ? ~u : (u | 0x80000000u); }
__device__ __forceinline__ float unsort32(unsigned k) { const unsigned u = (k & 0x80000000u) ? (k & 0x7fffffffu) : ~k; return __uint_as_float(u); }
__device__ void phase_topk(const Params& p, const WS& w, int bid, int nb) {
  for (int th = bid * 512 + tidx(); th < T * 8; th += nb * 512) {
    const int t = th >> 3, h = th & 7;
    const uint4* s = (const uint4*)(w.sc + (size_t)t * D + h * 256);
    unsigned l[2][16];
#pragma unroll
    for (int pp = 0; pp < 2; ++pp) {
#pragma unroll
      for (int i = 0; i < 16; ++i) l[pp][i] = 0u;
      for (int q = 0; q < 16; ++q) {
        const uint4 v = s[pp * 16 + q]; const unsigned wds[4] = {v.x, v.y, v.z, v.w};
#pragma unroll
        for (int e = 0; e < 8; ++e) {
          const unsigned b = (e & 1) ? (wds[e >> 1] >> 16) : (wds[e >> 1] & 0xffffu);
          unsigned x = (sort16(b) << 16) | (unsigned)(q * 8 + e);
#pragma unroll
          for (int i = 0; i < 16; ++i) { const unsigned hi = max(l[pp][i], x); x = min(l[pp][i], x); l[pp][i] = hi; }
        }
      }
    }
    unsigned long long lc[16];
#pragma unroll
    for (int i = 0; i < 16; ++i) lc[i] = 0ull;
#pragma unroll
    for (int i = 0; i < 16; ++i)
#pragma unroll
      for (int j = 0; j < 16; ++j) if ((i + 1) * (j + 1) <= 16) {
        const float sv = unsort16(l[0][i] >> 16) + unsort16(l[1][j] >> 16);
        unsigned long long x = ((unsigned long long)sort32(sv) << 32) | (unsigned long long)((l[0][i] & 0xffffu) * 128u + (l[1][j] & 0xffffu));
#pragma unroll
        for (int k = 0; k < 16; ++k) { const bool gt = x > lc[k]; const unsigned long long hi = gt ? x : lc[k]; x = gt ? lc[k] : x; lc[k] = hi; }
      }
    const float mx = unsort32((unsigned)(lc[0] >> 32));
    float e[16], sum = 0.f;
#pragma unroll
    for (int k = 0; k < 16; ++k) { e[k] = __expf(unsort32((unsigned)(lc[k] >> 32)) - mx); sum += e[k]; }
    const float inv = 1.f / sum;
    int* ei = w.eidx + (size_t)t * 128 + h * 16; float* eg = w.eg + (size_t)t * 128 + h * 16;
#pragma unroll
    for (int k4 = 0; k4 < 4; ++k4) {
      *(int4*)(ei + k4 * 4) = make_int4((int)(lc[k4 * 4] & 0xffffffffu), (int)(lc[k4 * 4 + 1] & 0xffffffffu), (int)(lc[k4 * 4 + 2] & 0xffffffffu), (int)(lc[k4 * 4 + 3] & 0xffffffffu));
      *(float4*)(eg + k4 * 4) = make_float4(e[k4 * 4] * inv, e[k4 * 4 + 1] * inv, e[k4 * 4 + 2] * inv, e[k4 * 4 + 3] * inv);
    }
  }
}
__device__ void phase_peer(const Params& p, const WS& w, int bid, int nb) {
  const int wave = tidx() >> 6, lane = tidx() & 63;
  for (int t = bid * 8 + wave; t < T; t += nb * 8) {
    float hr[32], out[32];
#pragma unroll
    for (int i = 0; i < 4; ++i) unpack8(*(const uint4*)(w.h1b + (size_t)t * D + i * 512 + lane * 8), hr + i * 8);
#pragma unroll
    for (int i = 0; i < 32; ++i) out[i] = 0.f;
    const float rs2 = rsqrtf(w.ssq2[t] * (1.f / D) + EPS);
    for (int h = 0; h < 8; ++h) {
      const int idxv = w.eidx[(size_t)t * 128 + h * 16 + (lane & 15)]; const float gv = w.eg[(size_t)t * 128 + h * 16 + (lane & 15)];
#pragma unroll 4
      for (int k = 0; k < 16; ++k) {
        const int e = __shfl(idxv, k); const float g = __shfl(gv, k);
        const bf16_t* ur = w.ub + (size_t)e * D; const bf16_t* vr = w.vb + (size_t)e * D;
        float s = 0.f;
#pragma unroll
        for (int i = 0; i < 4; ++i) { float f[8]; unpack8(*(const uint4*)(ur + i * 512 + lane * 8), f);
#pragma unroll
          for (int j = 0; j < 8; ++j) s += f[j] * hr[i * 8 + j]; }
        s = wave_sum(s);
        const float wgt = g * gelu_tanh(s * rs2);
#pragma unroll
        for (int i = 0; i < 4; ++i) { float f[8]; unpack8(*(const uint4*)(vr + i * 512 + lane * 8), f);
#pragma unroll
          for (int j = 0; j < 8; ++j) out[i * 8 + j] += wgt * f[j]; }
      }
    }
    float ss = 0.f;
#pragma unroll
    for (int i = 0; i < 32; ++i) { out[i] += hr[i]; ss += out[i] * out[i]; }
    ss = wave_sum(ss);
#pragma unroll
    for (int i = 0; i < 4; ++i) *(uint4*)(w.h2b + (size_t)t * D + i * 512 + lane * 8) = pack8(out + i * 8);
    if (lane == 0) w.rstd3[t] = rsqrtf(ss * (1.f / D) + EPS);
  }
}
__device__ void phase_final(const Params& p, const WS& w, int bid, int nb) {
  const int wave = tidx() >> 6, lane = tidx() & 63;
  for (int row = bid * 8 + wave; row < T; row += nb * 8) {
    float4* o = (float4*)(p.out + (size_t)row * D);
    const float rs = rsqrtf(w.ssq4[row] * (1.f / D) + EPS);
#pragma unroll
    for (int i = 0; i < 8; ++i) { float4 v = o[i * 64 + lane]; const float4 g = *(const float4*)(p.norm_final + (i * 64 + lane) * 4); v.x *= rs * g.x; v.y *= rs * g.y; v.z *= rs * g.z; v.w *= rs * g.w; o[i * 64 + lane] = v; }
  }
}

constexpr int NPHASE = 10;
#ifndef FAST_MIX
#define FAST_MIX 1
#endif
template <int PH>
__device__ __forceinline__ void run_phase(const Params& p, float* lds, int bid, int nb) {
  const WS w = make_ws(p.ws);
  if (PH == 0) phase_prep(p, w, lds, bid, nb);
  if (PH == 1) { gemm_any(w.xb, w.win, T, NPROJ, D, EpiProjN{w.proj, w.rstd1}, lds, bid, nb);
                 gemm_any(w.win + (size_t)NPROJ * D, w.xb, 2048, T, D, EpiProjT{w.vT, w.rstd1}, lds, bid, nb); }
#if FAST_MIX
  if (PH == 2) phase_mix_items<0>(p, w, (unsigned char*)lds, bid, nb);
  if (PH == 3) mix_scan(p, w, bid, nb);
  if (PH == 4) phase_mix_items<1>(p, w, (unsigned char*)lds, bid, nb);
#else
  if (PH == 2) phase_mixer_naive(p, w, lds, bid, nb);
#endif
  if (PH == 5) gemm_any(w.y, w.wout, T, D, D, EpiOut{p.x, w.h1b, w.ssq2}, lds, bid, nb);
  if (PH == 6) gemm_any(w.h1b, w.wq, T, D, D, EpiScore{w.sc, w.ssq2}, lds, bid, nb);
  if (PH == 7) { phase_topk(p, w, bid, nb); gemm_any(w.pb, w.wple, T, D, 256, EpiPl{w.pl}, lds, bid, nb); }
  if (PH == 8) phase_peer(p, w, bid, nb);
  if (PH == 9) gemm_any(w.h2b, w.wg, T, D, D, EpiGate{w.h2b, w.pl, w.rstd3, p.out, w.ssq4}, lds, bid, nb);
  if (PH == 10) phase_final(p, w, bid, nb);
}

extern __shared__ __attribute__((aligned(16))) unsigned char dyn_lds[];

#if ONE_LAUNCH
__global__ void __launch_bounds__(512, 2) mega(Params p) {
  cg::grid_group grid = cg::this_grid();
  float* lds = (float*)dyn_lds; const int bid = blockIdx.x, nb = gridDim.x;
  run_phase<0>(p, lds, bid, nb); grid.sync();
  run_phase<1>(p, lds, bid, nb); grid.sync();
  run_phase<2>(p, lds, bid, nb); grid.sync();
#if FAST_MIX
  run_phase<3>(p, lds, bid, nb); grid.sync();
  run_phase<4>(p, lds, bid, nb); grid.sync();
#endif
  run_phase<5>(p, lds, bid, nb); grid.sync();
  run_phase<6>(p, lds, bid, nb); grid.sync();
  run_phase<7>(p, lds, bid, nb); grid.sync();
  run_phase<8>(p, lds, bid, nb); grid.sync();
  run_phase<9>(p, lds, bid, nb); grid.sync();
  run_phase<10>(p, lds, bid, nb);
}
#else
template <int PH> __global__ void __launch_bounds__(512, 2) k_phase(Params p) { run_phase<PH>(p, (float*)dyn_lds, blockIdx.x, gridDim.x); }
#endif

constexpr size_t kDynLds = 131072;

extern "C" void kernel_launch(void* const* d_in, const int* in_sizes, int n_in, void* d_out, int out_size, void* d_ws, size_t ws_size, hipStream_t stream) {
  if (n_in != 22 || out_size != T * D || ws_size < WS_NEED) { fprintf(stderr, "kernel_launch: unexpected shapes (n_in %d out %d ws %zu)\n", n_in, out_size, ws_size); return; }
  Params p{};
  const float** f = (const float**)&p;
  for (int i = 0; i < 22; ++i) f[i] = (const float*)d_in[i];
  p.out = (float*)d_out; p.ws = (unsigned char*)d_ws;
#if ONE_LAUNCH
  static int grid_blocks = 0;
  if (!grid_blocks) {
    int dev = 0, cus = 0, per_cu = 0;
    (void)hipGetDevice(&dev); (void)hipDeviceGetAttribute(&cus, hipDeviceAttributeMultiprocessorCount, dev);
    (void)hipFuncSetAttribute((const void*)mega, hipFuncAttributeMaxDynamicSharedMemorySize, (int)kDynLds);
    (void)hipOccupancyMaxActiveBlocksPerMultiprocessor(&per_cu, mega, 512, kDynLds);
    if (per_cu < 1) { fprintf(stderr, "occupancy query says 0 blocks/CU\n"); per_cu = 1; }
    grid_blocks = cus;
  }
  void* args[] = {&p};
  hipError_t e = hipLaunchCooperativeKernel((void*)mega, dim3(grid_blocks), dim3(512), args, kDynLds, stream);
  if (e != hipSuccess) fprintf(stderr, "cooperative launch failed: %s (grid %d)\n", hipGetErrorString(e), grid_blocks);
#else
  static bool attr = false;
  const int G = 256;
#define LAUNCH(PH) do { if (!attr) (void)hipFuncSetAttribute((const void*)k_phase<PH>, hipFuncAttributeMaxDynamicSharedMemorySize, (int)kDynLds); \
    hipLaunchKernelGGL(k_phase<PH>, dim3(G), dim3(512), kDynLds, stream, p); } while (0)
  LAUNCH(0); LAUNCH(1); LAUNCH(2); LAUNCH(3); LAUNCH(4); LAUNCH(5); LAUNCH(6); LAUNCH(7); LAUNCH(8); LAUNCH(9); LAUNCH(10);
  attr = true;
#undef LAUNCH
#endif
}
```

```cpp
#include <hip/hip_runtime.h>
#include <hip/hip_cooperative_groups.h>
#include <cstdio>
#include <cstdint>
namespace cg = cooperative_groups;

#ifndef ONE_LAUNCH
#define ONE_LAUNCH 1
#endif

typedef unsigned short bf16_t;
constexpr int T = 32768, SEQ = 16384, D = 2048;
constexpr int NPROJ = 4352;
constexpr int C_GQ = 0, C_GK = 512, C_GG = 1024, C_MQ = 2048, C_MK = 2560, C_MO = 3072, C_SM = 4096;
constexpr float EPS = 1e-6f;
constexpr size_t MiB = 1ull << 20;
constexpr size_t OFF_XB = 0, OFF_Y = 0, OFF_PL = 0;
constexpr size_t OFF_PROJ = 128 * MiB, OFF_H1B = 128 * MiB, OFF_H2B = 256 * MiB;
constexpr size_t OFF_VT = 400 * MiB, OFF_SC = 400 * MiB;
constexpr size_t OFF_UB = 528 * MiB, OFF_VB = 592 * MiB;
constexpr size_t OFF_WIN = 656 * MiB, OFF_WOUT = 681 * MiB, OFF_WQ = 689 * MiB, OFF_WG = 697 * MiB, OFF_WPLE = 705 * MiB;
constexpr size_t OFF_PB = 706 * MiB, OFF_EIDX = 722 * MiB, OFF_EG = 738 * MiB, OFF_MISC = 754 * MiB;
constexpr size_t OFF_GDEC = 755 * MiB, OFF_MN = 756 * MiB, OFF_MDEC = 757 * MiB, OFF_ESC = 758 * MiB;
constexpr size_t WS_NEED = 760 * MiB;

struct Params {
  const float *x, *p, *norm_mix, *w_in, *gate_up, *gate_bias, *gla_norm, *conv_w, *conv_b, *ig_bias, *fg_bias, *mlstm_norm,
      *w_out, *norm_ffn, *peer_query, *sub_keys, *peer_u, *peer_v, *norm_ple, *w_ple, *w_ple_gate, *norm_final;
  float* out;
  unsigned char* ws;
};

__device__ __forceinline__ float bf2f(bf16_t b) { return __uint_as_float(((unsigned)b) << 16); }
__device__ __forceinline__ bf16_t f2bf(float f) { unsigned u = __float_as_uint(f); u += 0x7FFFu + ((u >> 16) & 1u); return (bf16_t)(u >> 16); }
__device__ __forceinline__ unsigned pack2(float lo, float hi) { return (unsigned)f2bf(lo) | ((unsigned)f2bf(hi) << 16); }
__device__ __forceinline__ float lo_f(unsigned u) { return __uint_as_float(u << 16); }
__device__ __forceinline__ float hi_f(unsigned u) { return __uint_as_float(u & 0xffff0000u); }
__device__ __forceinline__ float wave_sum(float v) {
#pragma unroll
  for (int o = 32; o >= 1; o >>= 1) v += __shfl_xor(v, o);
  return v;
}
__device__ __forceinline__ int tidx() { int t = threadIdx.x; asm volatile("" : "+v"(t)); return t; }
__device__ __forceinline__ float sigmoidf_(float x) { return 1.f / (1.f + __expf(-x)); }
__device__ __forceinline__ float siluf_(float x) { return x / (1.f + __expf(-x)); }
__device__ __forceinline__ float logsigmoidf_(float x) { return fminf(x, 0.f) - log1pf(__expf(-fabsf(x))); }
__device__ __forceinline__ float gelu_tanh(float x) { const float u = 0.7978845608028654f * (x + 0.044715f * x * x * x); return 0.5f * x * (1.f + tanhf(u)); }
__device__ __forceinline__ void unpack8(const uint4 q, float* f) {
  f[0] = lo_f(q.x); f[1] = hi_f(q.x); f[2] = lo_f(q.y); f[3] = hi_f(q.y); f[4] = lo_f(q.z); f[5] = hi_f(q.z); f[6] = lo_f(q.w); f[7] = hi_f(q.w);
}
__device__ __forceinline__ uint4 pack8(const float* f) { return make_uint4(pack2(f[0], f[1]), pack2(f[2], f[3]), pack2(f[4], f[5]), pack2(f[6], f[7])); }

struct WS {
  bf16_t *xb, *y, *pl, *proj, *h1b, *h2b, *vT, *sc, *ub, *vb, *win, *wout, *wq, *wg, *wple, *pb;
  int* eidx; float* eg; float *rstd1, *ssq2, *rstd3, *ssq4, *gdec, *mn, *mdec, *usc, *vsc;
  unsigned char *u8, *v8;
};
__device__ __forceinline__ WS make_ws(unsigned char* ws) {
  WS w;
  w.xb = (bf16_t*)(ws + OFF_XB); w.y = (bf16_t*)(ws + OFF_Y); w.pl = (bf16_t*)(ws + OFF_PL); w.proj = (bf16_t*)(ws + OFF_PROJ);
  w.h1b = (bf16_t*)(ws + OFF_H1B); w.h2b = (bf16_t*)(ws + OFF_H2B); w.vT = (bf16_t*)(ws + OFF_VT); w.sc = (bf16_t*)(ws + OFF_SC);
  w.ub = (bf16_t*)(ws + OFF_UB); w.vb = (bf16_t*)(ws + OFF_VB); w.win = (bf16_t*)(ws + OFF_WIN); w.wout = (bf16_t*)(ws + OFF_WOUT);
  w.wq = (bf16_t*)(ws + OFF_WQ); w.wg = (bf16_t*)(ws + OFF_WG); w.wple = (bf16_t*)(ws + OFF_WPLE); w.pb = (bf16_t*)(ws + OFF_PB);
  w.eidx = (int*)(ws + OFF_EIDX); w.eg = (float*)(ws + OFF_EG);
  float* m = (float*)(ws + OFF_MISC); w.rstd1 = m; w.ssq2 = m + T; w.rstd3 = m + 2 * T; w.ssq4 = m + 3 * T;
  w.gdec = (float*)(ws + OFF_GDEC); w.mn = (float*)(ws + OFF_MN); w.mdec = (float*)(ws + OFF_MDEC);
  w.usc = (float*)(ws + OFF_ESC); w.vsc = w.usc + 16384; w.u8 = ws + OFF_UB; w.v8 = ws + OFF_VB;
  return w;
}

__device__ void prep_x(const Params& p, const WS& w, int bid, int nb) {
  const int wave = tidx() >> 6, lane = tidx() & 63;
  for (int row = bid * 8 + wave; row < T; row += nb * 8) {
    const float4* src = (const float4*)(p.x + (size_t)row * D);
    uint2* dst = (uint2*)(w.xb + (size_t)row * D);
    float ss = 0.f;
#pragma unroll
    for (int i = 0; i < 8; ++i) { const float4 v = src[i * 64 + lane]; ss += v.x * v.x + v.y * v.y + v.z * v.z + v.w * v.w; dst[i * 64 + lane] = make_uint2(pack2(v.x, v.y), pack2(v.z, v.w)); }
    ss = wave_sum(ss);
    if (lane == 0) w.rstd1[row] = rsqrtf(ss * (1.f / D) + EPS);
  }
}
__device__ void cvt_rows(const float* src, bf16_t* dst, size_t n, const float* gain, int ncols, int bid, int nb) {
  const size_t n4 = n / 4;
  for (size_t i = (size_t)bid * 512 + tidx(); i < n4; i += (size_t)nb * 512) {
    float4 v = ((const float4*)src)[i];
    if (gain) { const float4 g = *(const float4*)(gain + (int)((i * 4) % (size_t)ncols)); v.x *= g.x; v.y *= g.y; v.z *= g.z; v.w *= g.w; }
    ((uint2*)dst)[i] = make_uint2(pack2(v.x, v.y), pack2(v.z, v.w));
  }
}
template <class CM>
__device__ void transpose_w(const float* src, int K, int ldsrc, bf16_t* dst, int Ndst, const float* gain, CM cm, float* lds, int bid, int nb) {
  const int tid = tidx(), tk = K / 64, ntile = (Ndst / 64) * tk;
  for (int tile = bid; tile < ntile; tile += nb) {
    const int n0 = (tile / tk) * 64, k0 = (tile % tk) * 64;
    const int nc = tid & 63, sc = cm(n0 + nc);
#pragma unroll
    for (int i = 0; i < 8; ++i) { const int kr = (tid >> 6) + 8 * i; float v = 0.f; if (sc >= 0) { v = src[(size_t)(k0 + kr) * ldsrc + sc]; if (gain) v *= gain[k0 + kr]; } lds[kr * 65 + nc] = v; }
    __syncthreads();
    { const int nr = tid >> 3, ks = (tid & 7) * 8; float f[8];
#pragma unroll
      for (int j = 0; j < 8; ++j) f[j] = lds[(ks + j) * 65 + nr];
      *(uint4*)(dst + (size_t)(n0 + nr) * K + k0 + ks) = pack8(f); }
    __syncthreads();
  }
}
struct CmIdent { __device__ int operator()(int n) const { return n; } };
struct CmWin {
  __device__ int operator()(int n) const {
    if (n < 1024) return n;
    if (n < 2048) return 2048 + (n - 1024);
    if (n < 2560) return 3088 + (n - 2048);
    if (n < 3072) return 3600 + (n - 2560);
    if (n < 4096) return 5136 + (n - 3072);
    if (n < 4352) { const int i = n - 4096; if (i < 16) return 3072 + i; if (i < 20) return 6160 + (i - 16); if (i < 24) return 6164 + (i - 20); return -1; }
    const int j = n - 4352; if (j < 1024) return 1024 + j;
    return 4112 + (j - 1024);
  }
};
__device__ void prep_wq(const Params& p, const WS& w, float* lds, int bid, int nb) {
  const int tid = tidx();
  float* SKs = lds;
  float* WQs = lds + 128 * 132;
  for (int item = bid; item < 16 * 32; item += nb) {
    const int hp = item >> 5, k0 = (item & 31) * 64;
#pragma unroll
    for (int i = 0; i < 8; ++i) { const int e4 = tid + 512 * i, key = e4 >> 5, d4 = (e4 & 31) * 4; *(float4*)(SKs + key * 132 + d4) = *(const float4*)(p.sub_keys + (size_t)hp * 16384 + key * 128 + d4); }
#pragma unroll
    for (int i = 0; i < 4; ++i) { const int e4 = tid + 512 * i, kr = e4 >> 5, d4 = (e4 & 31) * 4; float4 v = *(const float4*)(p.peer_query + (size_t)(k0 + kr) * 2048 + hp * 128 + d4); const float g = p.norm_ffn[k0 + kr]; v.x *= g; v.y *= g; v.z *= g; v.w *= g; *(float4*)(WQs + kr * 132 + d4) = v; }
    __syncthreads();
    const int k = tid & 63, kg = tid >> 6;
    float acc[16];
#pragma unroll
    for (int j = 0; j < 16; ++j) acc[j] = 0.f;
    for (int d4 = 0; d4 < 32; ++d4) {
      const float4 a = *(const float4*)(WQs + k * 132 + d4 * 4);
#pragma unroll
      for (int j = 0; j < 16; ++j) { const float4 s = *(const float4*)(SKs + (kg * 16 + j) * 132 + d4 * 4); acc[j] += a.x * s.x + a.y * s.y + a.z * s.z + a.w * s.w; }
    }
#pragma unroll
    for (int j = 0; j < 16; ++j) w.wq[(size_t)(hp * 128 + kg * 16 + j) * 2048 + k0 + k] = f2bf(acc[j]);
    __syncthreads();
  }
}

__device__ void quant_rows(const float* src, const float* gain, unsigned char* dst, float* scale, int bid, int nb) {
  const int tid = tidx(), wave = tid >> 6, lane = tid & 63;
  for (int row = bid * 8 + wave; row < 16384; row += nb * 8) {
    float f[32]; float mx = 0.f;
#pragma unroll
    for (int i = 0; i < 2; ++i)
#pragma unroll
      for (int q = 0; q < 4; ++q) { float4 v = *(const float4*)(src + (size_t)row * 2048 + i * 1024 + lane * 16 + q * 4);
        if (gain) { const float4 g = *(const float4*)(gain + i * 1024 + lane * 16 + q * 4); v.x *= g.x; v.y *= g.y; v.z *= g.z; v.w *= g.w; }
        f[i * 16 + q * 4] = v.x; f[i * 16 + q * 4 + 1] = v.y; f[i * 16 + q * 4 + 2] = v.z; f[i * 16 + q * 4 + 3] = v.w;
        mx = fmaxf(mx, fmaxf(fmaxf(fabsf(v.x), fabsf(v.y)), fmaxf(fabsf(v.z), fabsf(v.w)))); }
#pragma unroll
    for (int o = 32; o >= 1; o >>= 1) mx = fmaxf(mx, __shfl_xor(mx, o));
    const float sc = fmaxf(mx, 1e-30f) * (1.f / 127.f), inv = 1.f / sc;
#pragma unroll
    for (int i = 0; i < 2; ++i) { unsigned wd[4];
#pragma unroll
      for (int q = 0; q < 4; ++q) { unsigned x = 0;
#pragma unroll
        for (int j = 0; j < 4; ++j) { const int v = (int)rintf(f[i * 16 + q * 4 + j] * inv) + 128; x |= (unsigned)v << (8 * j); }
        wd[q] = x; }
      *(uint4*)(dst + (size_t)row * 2048 + i * 1024 + lane * 16) = make_uint4(wd[0], wd[1], wd[2], wd[3]); }
    if (lane == 0) scale[row] = sc;
  }
}
__device__ void phase_prep(const Params& p, const WS& w, float* lds, int bid, int nb) {
  prep_x(p, w, bid, nb);
  cvt_rows(p.p, w.pb, (size_t)T * 256, nullptr, 256, bid, nb);
  quant_rows(p.peer_u, p.norm_ffn, w.u8, w.usc, bid, nb);
  quant_rows(p.peer_v, nullptr, w.v8, w.vsc, bid, nb);
  transpose_w(p.w_in, 2048, 6168, w.win, 6400, p.norm_mix, CmWin(), lds, bid, nb);
  transpose_w(p.w_out, 2048, 2048, w.wout, 2048, nullptr, CmIdent(), lds, bid, nb);
  transpose_w(p.w_ple_gate, 2048, 2048, w.wg, 2048, p.norm_ple, CmIdent(), lds, bid, nb);
  transpose_w(p.w_ple, 256, 2048, w.wple, 2048, nullptr, CmIdent(), lds, bid, nb);
  prep_wq(p, w, lds, bid, nb);
  for (int i = bid * 512 + tidx(); i < T; i += nb * 512) { w.ssq2[i] = 0.f; w.ssq4[i] = 0.f; }
}

struct EpiProjN { bf16_t* out; const float* rstd; static constexpr bool ROWSUM = false;
  __device__ __forceinline__ float store8(int r, int c, const float* v) const { const float s = rstd[r]; float f[8];
#pragma unroll
    for (int j = 0; j < 8; ++j) f[j] = v[j] * s;
    *(uint4*)(out + (size_t)r * NPROJ + c) = pack8(f); return 0.f; }
  __device__ __forceinline__ void rowsum(int, float) const {} };
struct EpiProjT { bf16_t* out; const float* rstd; static constexpr bool ROWSUM = false;
  __device__ __forceinline__ float store8(int r, int c, const float* v) const { const float4 s0 = *(const float4*)(rstd + c), s1 = *(const float4*)(rstd + c + 4); float f[8];
    f[0] = v[0] * s0.x; f[1] = v[1] * s0.y; f[2] = v[2] * s0.z; f[3] = v[3] * s0.w; f[4] = v[4] * s1.x; f[5] = v[5] * s1.y; f[6] = v[6] * s1.z; f[7] = v[7] * s1.w;
    *(uint4*)(out + (size_t)r * T + c) = pack8(f); return 0.f; }
  __device__ __forceinline__ void rowsum(int, float) const {} };
struct EpiOut { const float* x; bf16_t* h1b; float* ssq; static constexpr bool ROWSUM = true;
  __device__ __forceinline__ float store8(int r, int c, const float* v) const { const float4 x0 = *(const float4*)(x + (size_t)r * D + c), x1 = *(const float4*)(x + (size_t)r * D + c + 4); float f[8];
    f[0] = v[0] + x0.x; f[1] = v[1] + x0.y; f[2] = v[2] + x0.z; f[3] = v[3] + x0.w; f[4] = v[4] + x1.x; f[5] = v[5] + x1.y; f[6] = v[6] + x1.z; f[7] = v[7] + x1.w;
    float s = 0.f;
#pragma unroll
    for (int j = 0; j < 8; ++j) s += f[j] * f[j];
    *(uint4*)(h1b + (size_t)r * D + c) = pack8(f); return s; }
  __device__ __forceinline__ void rowsum(int r, float s) const { atomicAdd(ssq + r, s); } };
struct EpiScore { bf16_t* sc; const float* ssq; static constexpr bool ROWSUM = false;
  __device__ __forceinline__ float store8(int r, int c, const float* v) const { const float s = rsqrtf(ssq[r] * (1.f / D) + EPS); float f[8];
#pragma unroll
    for (int j = 0; j < 8; ++j) f[j] = v[j] * s;
    *(uint4*)(sc + (size_t)r * D + c) = pack8(f); return 0.f; }
  __device__ __forceinline__ void rowsum(int, float) const {} };
struct EpiPl { bf16_t* pl; static constexpr bool ROWSUM = false;
  __device__ __forceinline__ float store8(int r, int c, const float* v) const { *(uint4*)(pl + (size_t)r * D + c) = pack8(v); return 0.f; }
  __device__ __forceinline__ void rowsum(int, float) const {} };
struct EpiGate { const bf16_t* h2b; const bf16_t* pl; const float* rstd3; float* out; float* ssq; static constexpr bool ROWSUM = true;
  __device__ __forceinline__ float store8(int r, int c, const float* v) const { const float rs = rstd3[r]; float h[8], q[8], f[8];
    unpack8(*(const uint4*)(h2b + (size_t)r * D + c), h); unpack8(*(const uint4*)(pl + (size_t)r * D + c), q);
    float s = 0.f;
#pragma unroll
    for (int j = 0; j < 8; ++j) { f[j] = h[j] + sigmoidf_(v[j] * rs) * q[j]; s += f[j] * f[j]; }
    *(float4*)(out + (size_t)r * D + c) = make_float4(f[0], f[1], f[2], f[3]); *(float4*)(out + (size_t)r * D + c + 4) = make_float4(f[4], f[5], f[6], f[7]); return s; }
  __device__ __forceinline__ void rowsum(int r, float s) const { atomicAdd(ssq + r, s); } };

template <class Epi>
__device__ void gemm_naive(const bf16_t* A, const bf16_t* Bt, int M, int N, int K, const Epi& E, float* lds, int bid, int nb) {
  const int tid = tidx(), ty = tid >> 4, tx = tid & 15;
  float* As = lds;
  float* Bs = lds + 32 * 132;
  const int nM = M / 128, nN = N / 128;
  for (int tile = bid; tile < nM * nN; tile += nb) {
    const int m0 = (tile % nM) * 128, n0 = (tile / nM) * 128;
    float acc[4][8];
#pragma unroll
    for (int i = 0; i < 4; ++i)
#pragma unroll
      for (int j = 0; j < 8; ++j) acc[i][j] = 0.f;
    const int lr = tid >> 2, lk = (tid & 3) * 8;
    for (int k0 = 0; k0 < K; k0 += 32) {
      const uint4 av = *(const uint4*)(A + (size_t)(m0 + lr) * K + k0 + lk);
      const uint4 bv = *(const uint4*)(Bt + (size_t)(n0 + lr) * K + k0 + lk);
      float af[8], bf[8]; unpack8(av, af); unpack8(bv, bf);
      __syncthreads();
#pragma unroll
      for (int j = 0; j < 8; ++j) { As[(lk + j) * 132 + lr] = af[j]; Bs[(lk + j) * 132 + lr] = bf[j]; }
      __syncthreads();
#pragma unroll 8
      for (int kk = 0; kk < 32; ++kk) {
        const float4 a = *(const float4*)(As + kk * 132 + ty * 4);
        const float4 b0 = *(const float4*)(Bs + kk * 132 + tx * 8), b1 = *(const float4*)(Bs + kk * 132 + tx * 8 + 4);
        const float aa[4] = {a.x, a.y, a.z, a.w}; const float bb[8] = {b0.x, b0.y, b0.z, b0.w, b1.x, b1.y, b1.z, b1.w};
#pragma unroll
        for (int i = 0; i < 4; ++i)
#pragma unroll
          for (int j = 0; j < 8; ++j) acc[i][j] += aa[i] * bb[j];
      }
    }
#pragma unroll
    for (int i = 0; i < 4; ++i) {
      const int r = m0 + ty * 4 + i;
      float s = E.store8(r, n0 + tx * 8, acc[i]);
      if (Epi::ROWSUM) { s += __shfl_xor(s, 1); s += __shfl_xor(s, 2); s += __shfl_xor(s, 4); s += __shfl_xor(s, 8); if (tx == 0) E.rowsum(r, s); }
    }
  }
}


namespace pg8 {
#define PG8_LAS __attribute__((address_space(3)))
typedef short bf16x8 __attribute__((ext_vector_type(8)));
typedef float f32x4 __attribute__((ext_vector_type(4)));
constexpr int BM = 256, BK = 64, HALF = 128, HTB = HALF * BK * 2, STAGE_BYTES = 8 * HTB, NXCD = 8, WGM = 8;
__host__ __device__ __forceinline__ int lds_byte(int r, int c) { const int st = (r >> 4) * 2 + (c >> 5), rr = r & 15, cc = c & 31, ob = rr * 64 + cc * 2; return st * 1024 + (ob ^ (((ob >> 9) & 1) << 5)); }
__host__ __device__ __forceinline__ void stage_rc(int b, int& R, int& C) { const int st = b / 1024, sb = b % 1024, swz = sb ^ (((sb >> 9) & 1) << 5); R = (st >> 1) * 16 + swz / 64; C = (st & 1) * 32 + (swz % 64) / 2; }
__host__ __device__ __forceinline__ int perm32(int rho) { const int n = rho >> 4, i = rho & 15; return 8 * (i >> 2) + 4 * n + (i & 3); }
struct Unit { int pm, pn; };
struct Gemm { const bf16_t* A; const bf16_t* Bt; int M, N, K; };
struct StaticOrder {
    int nM, nN, nwg, G, c;
    __host__ __device__ void init(int M, int N, int G_, int c_) { nM = M / BM; nN = N / BM; nwg = nM * nN; G = G_; c = c_; }
    __host__ __device__ bool next(int i, Unit& u) const {
        const long L = (long)i * G + c; if (L >= nwg) return false;
        int wgid = (int)L; { const int q = nwg / NXCD, r = nwg % NXCD, xcd = wgid % NXCD, off = wgid / NXCD; wgid = (xcd < r ? xcd * (q + 1) : r * (q + 1) + (xcd - r) * q) + off; }
        const int nig = WGM * nN, gid = wgid / nig, fm = gid * WGM, gsz = (nM - fm) < WGM ? (nM - fm) : WGM;
        u.pm = fm + ((wgid % nig) % gsz); u.pn = (wgid % nig) / gsz; return true;
    }
    __device__ __forceinline__ void a_ready(const Unit&) const {}
    __device__ __forceinline__ void done(const Unit&) const {}
};
template <class E8> struct EpiA {
    static constexpr bool PERM = true, AFTER_DRAIN = false;
    E8 e;
    __device__ __forceinline__ void operator()(const f32x4 (&acc)[2][2][4][2], const Unit& u, int wr, int wc, int fr, int fq) const {
        const int row0 = u.pm * BM + wr * 64 + fr, col0 = u.pn * BM + wc * 32 + 8 * fq;
#pragma unroll
        for (int ai = 0; ai < 2; ++ai)
#pragma unroll
            for (int m = 0; m < 4; ++m) { const int r = row0 + ai * HALF + m * 16; float s = 0.f;
#pragma unroll
                for (int bj = 0; bj < 2; ++bj) { const float v[8] = {acc[ai][bj][m][0][0], acc[ai][bj][m][0][1], acc[ai][bj][m][0][2], acc[ai][bj][m][0][3], acc[ai][bj][m][1][0], acc[ai][bj][m][1][1], acc[ai][bj][m][1][2], acc[ai][bj][m][1][3]};
                    s += e.store8(r, col0 + bj * HALF, v); }
                if (E8::ROWSUM) { s += __shfl_xor(s, 16); s += __shfl_xor(s, 32); if (fq == 0) e.rowsum(r, s); } }
    }
    __device__ __forceinline__ void fused(f32x4 (&)[2][2][4][2], const Unit&, int, int, int, int, PG8_LAS unsigned char*, int, int) const {}
};
template <class Epi, class Sched, bool ALIGN_EPI = false, bool SP2 = false>
__device__ __forceinline__ void gemm_phase(PG8_LAS unsigned char* lds, const Gemm g, const Sched& S, const Epi& E) {
    int tid_ = threadIdx.x; asm volatile("" : "+v"(tid_));
    const int tid = tid_, wid = __builtin_amdgcn_readfirstlane(tid >> 6), lane = tid & 63, wr = wid >> 2, wc = wid & 3, fr = lane & 15, fq = lane >> 4;
    const int K = g.K, nt = K / BK;
    unsigned voffA[2], voffB[2];
#pragma unroll
    for (int i = 0; i < 2; ++i) { int R, C; stage_rc(tid * 16 + i * 8192, R, C); const int Rb = Epi::PERM ? ((R & ~31) + perm32(R & 31)) : R;
        voffA[i] = (unsigned)(R * K + C) * 2u; voffB[i] = (unsigned)(Rb * K + C) * 2u; }
    const size_t kstep = (size_t)(BK * 2);
    const size_t hstep = (size_t)HALF * K * 2;
    const size_t tstep = 2 * hstep;
    const unsigned ldsw = (unsigned)wid * 1024u;
    const int aoff = lds_byte(wr * 64 + fr, fq * 8), boff = lds_byte(wc * 32 + fr, fq * 8);
#define PG8_SA(b, h) (((b) * 2 + (h)) * HTB)
#define PG8_SB(b, h) ((4 + (b) * 2 + (h)) * HTB)
#define PG8_STAGE(bufoff, gbase, voff) do { _Pragma("unroll") for (int _i = 0; _i < 2; ++_i) \
        __builtin_amdgcn_global_load_lds((const unsigned*)((const char*)(gbase) + (voff)[_i]), (PG8_LAS unsigned*)(lds + (bufoff) + ldsw + _i * 8192), 16, 0, 0); } while (0)
#define PG8_LDA(dst, b, h) do { _Pragma("unroll") for (int m = 0; m < 4; ++m) _Pragma("unroll") for (int k = 0; k < 2; ++k) dst[m][k] = *(const PG8_LAS bf16x8*)(lds + PG8_SA(b, h) + aoff + m * 2048 + k * 1024); } while (0)
#define PG8_LDB(dst, b, h) do { _Pragma("unroll") for (int n = 0; n < 2; ++n) _Pragma("unroll") for (int k = 0; k < 2; ++k) dst[n][k] = *(const PG8_LAS bf16x8*)(lds + PG8_SB(b, h) + boff + n * 2048 + k * 1024); } while (0)
#define PG8_MMA(ai, bj, At, Bt) do { __builtin_amdgcn_s_setprio(1); _Pragma("unroll") for (int m = 0; m < 4; ++m) _Pragma("unroll") for (int n = 0; n < 2; ++n) _Pragma("unroll") for (int k = 0; k < 2; ++k) \
        acc[ai][bj][m][n] = __builtin_amdgcn_mfma_f32_16x16x32_bf16(Bt[n][k], At[m][k], acc[ai][bj][m][n], 0, 0, 0); __builtin_amdgcn_s_setprio(0); } while (0)
#define PG8_WAIT_V(n) asm volatile("s_waitcnt vmcnt(" #n ")" ::: "memory")
#define PG8_WAIT_L(n) asm volatile("s_waitcnt lgkmcnt(" #n ")" ::: "memory")
#define PG8_BAR __builtin_amdgcn_s_barrier()
#define PG8_SCHED __builtin_amdgcn_sched_barrier(0)
    Unit cur, nxt; int ui = 0;
    if (!S.next(0, cur)) return;
    f32x4 acc[2][2][4][2];
#pragma unroll
    for (int a = 0; a < 2; ++a)
#pragma unroll
        for (int b = 0; b < 2; ++b)
#pragma unroll
            for (int m = 0; m < 4; ++m)
#pragma unroll
                for (int n = 0; n < 2; ++n) acc[a][b][m][n] = (f32x4){0.f, 0.f, 0.f, 0.f};
    bf16x8 At[4][2], B0[2][2], B1[2][2];
    const char* cA = (const char*)g.A + (size_t)cur.pm * tstep; const char* cB = (const char*)g.Bt + (size_t)cur.pn * tstep;
    S.a_ready(cur);
    if constexpr (SP2) {
        PG8_STAGE(PG8_SB(0, 0), cB, voffB); PG8_STAGE(PG8_SB(0, 1), cB + hstep, voffB); PG8_STAGE(PG8_SA(0, 0), cA, voffA); PG8_STAGE(PG8_SA(0, 1), cA + hstep, voffA);
        if (wr == 1) PG8_BAR;
        PG8_WAIT_V(2); PG8_BAR;
        PG8_STAGE(PG8_SB(1, 0), cB + kstep, voffB); PG8_STAGE(PG8_SA(1, 0), cA + kstep, voffA); PG8_STAGE(PG8_SB(1, 1), cB + hstep + kstep, voffB);
        PG8_WAIT_V(6); PG8_BAR;
    } else {
        PG8_STAGE(PG8_SB(0, 0), cB, voffB); PG8_STAGE(PG8_SA(0, 0), cA, voffA); PG8_STAGE(PG8_SB(0, 1), cB + hstep, voffB); PG8_STAGE(PG8_SA(0, 1), cA + hstep, voffA);
        if (wr == 1) PG8_BAR;
        PG8_WAIT_V(4); PG8_BAR;
        PG8_STAGE(PG8_SB(1, 0), cB + kstep, voffB); PG8_STAGE(PG8_SA(1, 0), cA + kstep, voffA); PG8_STAGE(PG8_SB(1, 1), cB + hstep + kstep, voffB);
        PG8_WAIT_V(6); PG8_BAR;
    }
    for (;;) {
        const bool has_next = S.next(ui + 1, nxt);
        const char* nA = has_next ? (const char*)g.A + (size_t)nxt.pm * tstep : cA; const char* nB = has_next ? (const char*)g.Bt + (size_t)nxt.pn * tstep : cB;
        for (int t = 0; t < nt; t += 2) {
            const bool last = (t == nt - 2);
            const char* a1 = cA + (size_t)(t + 1) * kstep;
            const char* a2 = last ? nA : cA + (size_t)(t + 2) * kstep; const char* b2 = last ? nB : cB + (size_t)(t + 2) * kstep;
            const char* a3 = a2 + kstep; const char* b3 = b2 + kstep;
            if (last && has_next) S.a_ready(nxt);
            if constexpr (SP2) {
            PG8_LDB(B0, 0, 0); PG8_LDB(B1, 0, 1); PG8_SCHED; PG8_LDA(At, 0, 0); PG8_STAGE(PG8_SA(1, 1), a1 + hstep, voffA);
            PG8_WAIT_V(8); PG8_WAIT_L(0); PG8_BAR; PG8_MMA(0, 0, At, B0); PG8_MMA(0, 1, At, B1); PG8_BAR; PG8_SCHED;
            PG8_LDA(At, 0, 1); PG8_STAGE(PG8_SB(0, 0), b2, voffB); PG8_STAGE(PG8_SB(0, 1), b2 + hstep, voffB); PG8_STAGE(PG8_SA(0, 0), a2, voffA);
            PG8_WAIT_V(8); PG8_WAIT_L(0); PG8_BAR; PG8_MMA(1, 0, At, B0); PG8_MMA(1, 1, At, B1); PG8_BAR; PG8_SCHED;
            PG8_LDB(B0, 1, 0); PG8_LDB(B1, 1, 1); PG8_SCHED; PG8_LDA(At, 1, 0); PG8_STAGE(PG8_SA(0, 1), a2 + hstep, voffA);
            PG8_WAIT_V(8); PG8_WAIT_L(0); PG8_BAR; PG8_MMA(0, 0, At, B0); PG8_MMA(0, 1, At, B1); PG8_BAR; PG8_SCHED;
            PG8_LDA(At, 1, 1); PG8_STAGE(PG8_SB(1, 0), b3, voffB); PG8_STAGE(PG8_SB(1, 1), b3 + hstep, voffB); PG8_STAGE(PG8_SA(1, 0), a3, voffA);
            PG8_WAIT_V(8); PG8_WAIT_L(0); PG8_BAR; PG8_MMA(1, 0, At, B0); PG8_MMA(1, 1, At, B1); PG8_BAR; PG8_SCHED;
            } else {
            PG8_LDB(B0, 0, 0); PG8_SCHED; PG8_LDA(At, 0, 0); PG8_STAGE(PG8_SA(1, 1), a1 + hstep, voffA);
            PG8_WAIT_L(8); PG8_BAR; PG8_WAIT_L(0); PG8_MMA(0, 0, At, B0); PG8_BAR; PG8_SCHED;
            PG8_LDB(B1, 0, 1); PG8_STAGE(PG8_SB(0, 0), b2, voffB);
            PG8_BAR; PG8_WAIT_L(0); PG8_MMA(0, 1, At, B1); PG8_BAR;
            PG8_LDA(At, 0, 1); PG8_STAGE(PG8_SA(0, 0), a2, voffA);
            PG8_BAR; PG8_WAIT_L(0); PG8_MMA(1, 0, At, B0); PG8_BAR; PG8_SCHED;
            PG8_STAGE(PG8_SB(0, 1), b2 + hstep, voffB);
            PG8_WAIT_V(6); PG8_BAR; PG8_MMA(1, 1, At, B1); PG8_BAR;
            PG8_LDB(B0, 1, 0); PG8_SCHED; PG8_LDA(At, 1, 0); PG8_STAGE(PG8_SA(0, 1), a2 + hstep, voffA);
            PG8_WAIT_L(8); PG8_BAR; PG8_WAIT_L(0); PG8_MMA(0, 0, At, B0); PG8_BAR; PG8_SCHED;
            PG8_LDB(B1, 1, 1); PG8_STAGE(PG8_SB(1, 0), b3, voffB);
            PG8_BAR; PG8_WAIT_L(0); PG8_MMA(0, 1, At, B1); PG8_BAR;
            PG8_LDA(At, 1, 1); PG8_STAGE(PG8_SA(1, 0), a3, voffA);
            PG8_BAR; PG8_WAIT_L(0); PG8_MMA(1, 0, At, B0); PG8_BAR; PG8_SCHED;
            PG8_STAGE(PG8_SB(1, 1), b3 + hstep, voffB);
            PG8_WAIT_V(6); PG8_BAR; PG8_MMA(1, 1, At, B1); PG8_BAR;
            }
        }
        if constexpr (ALIGN_EPI) { if (wr == 0) PG8_BAR; }
        if constexpr (!Epi::AFTER_DRAIN) { E(acc, cur, wr, wc, fr, fq); S.done(cur); }
        if (!has_next) break;
#pragma unroll
        for (int a = 0; a < 2; ++a)
#pragma unroll
            for (int b = 0; b < 2; ++b)
#pragma unroll
                for (int m = 0; m < 4; ++m)
#pragma unroll
                    for (int n = 0; n < 2; ++n) acc[a][b][m][n] = (f32x4){0.f, 0.f, 0.f, 0.f};
        cur = nxt; cA = nA; cB = nB; ++ui;
        if constexpr (ALIGN_EPI) { if (wr == 1) PG8_BAR; }
    }
    PG8_WAIT_V(0);
    if constexpr (!ALIGN_EPI) { if (wr == 0) PG8_BAR; }
    PG8_BAR;
    if constexpr (Epi::AFTER_DRAIN) { E.fused(acc, cur, wr, wc, fr, fq, lds, wid, lane); S.done(cur); }
#undef PG8_SA
#undef PG8_SB
#undef PG8_STAGE
#undef PG8_LDA
#undef PG8_LDB
#undef PG8_MMA
#undef PG8_WAIT_V
#undef PG8_WAIT_L
#undef PG8_BAR
#undef PG8_SCHED
}
}

#ifndef FAST_GEMM
#define FAST_GEMM 1
#endif
template <class E8>
__device__ __forceinline__ void gemm_any(const bf16_t* A, const bf16_t* Bt, int M, int N, int K, const E8& E, float* lds, int bid, int nb) {
#if FAST_GEMM
  pg8::Gemm g{A, Bt, M, N, K}; pg8::StaticOrder S; S.init(M, N, nb, bid);
  pg8::EpiA<E8> EA{E};
  pg8::gemm_phase<pg8::EpiA<E8>, pg8::StaticOrder, true, true>((PG8_LAS unsigned char*)lds, g, S, EA);
#else
  gemm_naive(A, Bt, M, N, K, E, lds, bid, nb);
#endif
}

__device__ void gla_naive(const Params& p, const WS& w, int b, int h, float* lds) {
  constexpr int CH = 16;
  const int tid = tidx(), dv = tid & 255, half = tid >> 8, wave = tid >> 6, lane = tid & 63;
  float* qf = lds; float* kf = qf + CH * 128; float* af = kf + CH * 128; float* vf = af + CH * 128; float* op = vf + CH * 256;
  float S[64];
#pragma unroll
  for (int i = 0; i < 64; ++i) S[i] = 0.f;
  const int gd = tid & 127;
  float gu[16];
#pragma unroll
  for (int r = 0; r < 16; ++r) gu[r] = p.gate_up[r * 512 + h * 128 + gd];
  const float gb = p.gate_bias[h * 128 + gd];
  const float qscale = 0.08838834764831845f;
  for (int t0 = 0; t0 < SEQ; t0 += CH) {
    const size_t tb = (size_t)b * SEQ + t0;
    { const int tok = tid >> 5, d4 = (tid & 31) * 4;
      const uint2 qv = *(const uint2*)(w.proj + (tb + tok) * NPROJ + C_GQ + h * 128 + d4);
      const uint2 kv = *(const uint2*)(w.proj + (tb + tok) * NPROJ + C_GK + h * 128 + d4);
      *(float4*)(qf + tok * 128 + d4) = make_float4(lo_f(qv.x) * qscale, hi_f(qv.x) * qscale, lo_f(qv.y) * qscale, hi_f(qv.y) * qscale);
      *(float4*)(kf + tok * 128 + d4) = make_float4(lo_f(kv.x), hi_f(kv.x), lo_f(kv.y), hi_f(kv.y)); }
    { const int dvv = tid & 255, tk8 = (tid >> 8) * 8; float f[8];
      unpack8(*(const uint4*)(w.vT + (size_t)(h * 256 + dvv) * T + tb + tk8), f);
#pragma unroll
      for (int j = 0; j < 8; ++j) vf[(tk8 + j) * 256 + dvv] = f[j]; }
#pragma unroll
    for (int i = 0; i < 4; ++i) { const int tok = (tid >> 7) * 4 + i; float z = gb; float gl[16];
      unpack8(*(const uint4*)(w.proj + (tb + tok) * NPROJ + C_SM), gl); unpack8(*(const uint4*)(w.proj + (tb + tok) * NPROJ + C_SM + 8), gl + 8);
#pragma unroll
      for (int r = 0; r < 16; ++r) z += gl[r] * gu[r];
      af[tok * 128 + gd] = __expf(logsigmoidf_(z) * (1.f / 16.f)); }
    __syncthreads();
    for (int tok = 0; tok < CH; ++tok) {
      const float vv = vf[tok * 256 + dv]; float acc = 0.f;
#pragma unroll
      for (int i4 = 0; i4 < 16; ++i4) {
        const float4 a = *(const float4*)(af + tok * 128 + half * 64 + i4 * 4), k = *(const float4*)(kf + tok * 128 + half * 64 + i4 * 4), q = *(const float4*)(qf + tok * 128 + half * 64 + i4 * 4);
        S[i4 * 4 + 0] = a.x * S[i4 * 4 + 0] + k.x * vv; acc += q.x * S[i4 * 4 + 0];
        S[i4 * 4 + 1] = a.y * S[i4 * 4 + 1] + k.y * vv; acc += q.y * S[i4 * 4 + 1];
        S[i4 * 4 + 2] = a.z * S[i4 * 4 + 2] + k.z * vv; acc += q.z * S[i4 * 4 + 2];
        S[i4 * 4 + 3] = a.w * S[i4 * 4 + 3] + k.w * vv; acc += q.w * S[i4 * 4 + 3];
      }
      op[(half * CH + tok) * 256 + dv] = acc;
    }
    __syncthreads();
#pragma unroll
    for (int i = 0; i < 2; ++i) { const int tok = wave * 2 + i;
      const float4 o0 = *(const float4*)(op + tok * 256 + lane * 4), o1 = *(const float4*)(op + (CH + tok) * 256 + lane * 4);
      const float o[4] = {o0.x + o1.x, o0.y + o1.y, o0.z + o1.z, o0.w + o1.w};
      float ss = wave_sum(o[0] * o[0] + o[1] * o[1] + o[2] * o[2] + o[3] * o[3]);
      const float rs = rsqrtf(ss * (1.f / 256.f) + EPS);
      const uint2 gg = *(const uint2*)(w.proj + (tb + tok) * NPROJ + C_GG + h * 256 + lane * 4);
      const float4 gn = *(const float4*)(p.gla_norm + h * 256 + lane * 4);
      const float y0 = o[0] * rs * gn.x * siluf_(lo_f(gg.x)), y1 = o[1] * rs * gn.y * siluf_(hi_f(gg.x)), y2 = o[2] * rs * gn.z * siluf_(lo_f(gg.y)), y3 = o[3] * rs * gn.w * siluf_(hi_f(gg.y));
      *(uint2*)(w.y + (tb + tok) * D + h * 256 + lane * 4) = make_uint2(pack2(y0, y1), pack2(y2, y3)); }
    __syncthreads();
  }
}
__device__ void mlstm_naive(const Params& p, const WS& w, int b, int h, float* lds) {
  constexpr int CH = 16;
  const int tid = tidx(), dv = tid & 255, half = tid >> 8, wave = tid >> 6, lane = tid & 63;
  float* qf = lds; float* kf = qf + CH * 128; float* vf = kf + CH * 128; float* op = vf + CH * 256; float* dn = op + 2 * CH * 256; float* gt = dn + 2 * CH * 256;
  float C[64], n[4];
#pragma unroll
  for (int i = 0; i < 64; ++i) C[i] = 0.f;
#pragma unroll
  for (int i = 0; i < 4; ++i) n[i] = 0.f;
  const int nd = half * 64 + (dv & 15) * 4;
  const float kscale = 0.08838834764831845f;
  const float ib = p.ig_bias[h], fb = p.fg_bias[h];
  for (int t0 = 0; t0 < SEQ; t0 += CH) {
    const size_t tb = (size_t)b * SEQ + t0;
    { const int tok = tid >> 5, d4 = (tid & 31) * 4;
      float qa[4], ka[4];
#pragma unroll
      for (int c = 0; c < 4; ++c) { qa[c] = p.conv_b[h * 128 + d4 + c]; ka[c] = p.conv_b[512 + h * 128 + d4 + c]; }
#pragma unroll
      for (int wi = 0; wi < 4; ++wi) { const int ts = t0 + tok - 3 + wi;
        if (ts >= 0) { const size_t tr = (size_t)b * SEQ + ts;
          const uint2 qv = *(const uint2*)(w.proj + tr * NPROJ + C_MQ + h * 128 + d4), kv = *(const uint2*)(w.proj + tr * NPROJ + C_MK + h * 128 + d4);
          const float4 cq = *(const float4*)(p.conv_w + wi * 1024 + h * 128 + d4), ck = *(const float4*)(p.conv_w + wi * 1024 + 512 + h * 128 + d4);
          qa[0] += cq.x * lo_f(qv.x); qa[1] += cq.y * hi_f(qv.x); qa[2] += cq.z * lo_f(qv.y); qa[3] += cq.w * hi_f(qv.y);
          ka[0] += ck.x * lo_f(kv.x); ka[1] += ck.y * hi_f(kv.x); ka[2] += ck.z * lo_f(kv.y); ka[3] += ck.w * hi_f(kv.y); } }
      *(float4*)(qf + tok * 128 + d4) = make_float4(siluf_(qa[0]), siluf_(qa[1]), siluf_(qa[2]), siluf_(qa[3]));
      *(float4*)(kf + tok * 128 + d4) = make_float4(siluf_(ka[0]) * kscale, siluf_(ka[1]) * kscale, siluf_(ka[2]) * kscale, siluf_(ka[3]) * kscale); }
    { const int dvv = tid & 255, tk8 = (tid >> 8) * 8; float f[8];
      unpack8(*(const uint4*)(w.vT + (size_t)(1024 + h * 256 + dvv) * T + tb + tk8), f);
#pragma unroll
      for (int j = 0; j < 8; ++j) vf[(tk8 + j) * 256 + dvv] = f[j]; }
    if (tid < CH) { const float mi = bf2f(w.proj[(tb + tid) * NPROJ + C_SM + 16 + h]), mf = bf2f(w.proj[(tb + tid) * NPROJ + C_SM + 20 + h]);
      gt[tid * 2] = __expf(mi + ib); gt[tid * 2 + 1] = sigmoidf_(mf + fb); }
    __syncthreads();
    for (int tok = 0; tok < CH; ++tok) {
      const float vv = vf[tok * 256 + dv], ig = gt[tok * 2], fg = gt[tok * 2 + 1]; float num = 0.f, den = 0.f;
#pragma unroll
      for (int i4 = 0; i4 < 16; ++i4) {
        const float4 k = *(const float4*)(kf + tok * 128 + half * 64 + i4 * 4), q = *(const float4*)(qf + tok * 128 + half * 64 + i4 * 4);
        const float kk[4] = {k.x * ig, k.y * ig, k.z * ig, k.w * ig}; const float qq[4] = {q.x, q.y, q.z, q.w};
#pragma unroll
        for (int c = 0; c < 4; ++c) { C[i4 * 4 + c] = fg * C[i4 * 4 + c] + kk[c] * vv; num += qq[c] * C[i4 * 4 + c]; }
      }
      { const float4 k = *(const float4*)(kf + tok * 128 + nd), q = *(const float4*)(qf + tok * 128 + nd);
        n[0] = fg * n[0] + k.x * ig; n[1] = fg * n[1] + k.y * ig; n[2] = fg * n[2] + k.z * ig; n[3] = fg * n[3] + k.w * ig;
        den = q.x * n[0] + q.y * n[1] + q.z * n[2] + q.w * n[3];
        den += __shfl_xor(den, 1); den += __shfl_xor(den, 2); den += __shfl_xor(den, 4); den += __shfl_xor(den, 8); }
      op[(half * CH + tok) * 256 + dv] = num; if (dv == 0) dn[half * CH + tok] = den;
    }
    __syncthreads();
#pragma unroll
    for (int i = 0; i < 2; ++i) { const int tok = wave * 2 + i;
      const float4 o0 = *(const float4*)(op + tok * 256 + lane * 4), o1 = *(const float4*)(op + (CH + tok) * 256 + lane * 4);
      const float den = dn[tok] + dn[CH + tok];
      const float inv = 1.f / fmaxf(fabsf(den), 1.f);
      const float o[4] = {(o0.x + o1.x) * inv, (o0.y + o1.y) * inv, (o0.z + o1.z) * inv, (o0.w + o1.w) * inv};
      float ss = wave_sum(o[0] * o[0] + o[1] * o[1] + o[2] * o[2] + o[3] * o[3]);
      const float rs = rsqrtf(ss * (1.f / 256.f) + EPS);
      const uint2 mo = *(const uint2*)(w.proj + (tb + tok) * NPROJ + C_MO + h * 256 + lane * 4);
      const float4 gn = *(const float4*)(p.mlstm_norm + h * 256 + lane * 4);
      const float y0 = o[0] * rs * gn.x * sigmoidf_(lo_f(mo.x)), y1 = o[1] * rs * gn.y * sigmoidf_(hi_f(mo.x)), y2 = o[2] * rs * gn.z * sigmoidf_(lo_f(mo.y)), y3 = o[3] * rs * gn.w * sigmoidf_(hi_f(mo.y));
      *(uint2*)(w.y + (tb + tok) * D + 1024 + h * 256 + lane * 4) = make_uint2(pack2(y0, y1), pack2(y2, y3)); }
    __syncthreads();
  }
}
__device__ void phase_mixer_naive(const Params& p, const WS& w, float* lds, int bid, int nb) {
  for (int item = bid; item < 16; item += nb) {
    if (item < 8) gla_naive(p, w, item >> 2, item & 3, lds); else mlstm_naive(p, w, (item - 8) >> 2, item & 3, lds);
    __syncthreads();
  }
}


typedef short bf16x8 __attribute__((ext_vector_type(8)));
typedef float f32x4 __attribute__((ext_vector_type(4)));
#define MFMA16(a, b, c) __builtin_amdgcn_mfma_f32_16x16x32_bf16(a, b, c, 0, 0, 0)
constexpr int L_GLR = 0, L_TOT = 4096, L_F = 6144, L_DEN = 6656, L_PART = 6912, L_QS = 9216, L_KS = 26624, L_P = 44032, L_NL = 53248, L_KDT = 9216;
constexpr int QS_LD = 136, P_LD = 72, KDT_LD = 72;

__device__ __forceinline__ void gla_gates(const Params& p, const WS& w, int h, size_t tb, unsigned char* ldsb, int tid, float* bv, float& blast) {
  float* glrs = (float*)(ldsb + L_GLR); float* tot = (float*)(ldsb + L_TOT);
  const int d = tid & 127, tg = tid >> 7;
  if (tid < 128) { float f[8]; unpack8(*(const uint4*)(w.proj + (tb + (tid >> 1)) * NPROJ + C_SM + (tid & 1) * 8), f);
#pragma unroll
    for (int j = 0; j < 8; ++j) glrs[(tid >> 1) * 16 + (tid & 1) * 8 + j] = f[j]; }
  float gu[16];
#pragma unroll
  for (int r = 0; r < 16; ++r) gu[r] = p.gate_up[r * 512 + h * 128 + d];
  const float gb = p.gate_bias[h * 128 + d];
  __syncthreads();
  float run = 0.f;
#pragma unroll
  for (int i = 0; i < 16; ++i) { const float* gl = glrs + (tg * 16 + i) * 16; float z = gb;
#pragma unroll
    for (int r4 = 0; r4 < 4; ++r4) { const float4 g4 = *(const float4*)(gl + r4 * 4); z += g4.x * gu[r4 * 4] + g4.y * gu[r4 * 4 + 1] + g4.z * gu[r4 * 4 + 2] + g4.w * gu[r4 * 4 + 3]; }
    run += logsigmoidf_(z) * (1.f / 16.f); bv[i] = run; }
  tot[tg * 128 + d] = run;
  __syncthreads();
  float off = 0.f; blast = 0.f;
#pragma unroll
  for (int g = 0; g < 4; ++g) { const float t = tot[g * 128 + d]; blast += t; if (g < tg) off += t; }
#pragma unroll
  for (int i = 0; i < 16; ++i) bv[i] += off;
}
__device__ __forceinline__ void mlstm_gates(const Params& p, const WS& w, int h, size_t tb, unsigned char* ldsb, int tid) {
  float* Fl = (float*)(ldsb + L_F);
  if (tid < 64) { const float mi = bf2f(w.proj[(tb + tid) * NPROJ + C_SM + 16 + h]), mf = bf2f(w.proj[(tb + tid) * NPROJ + C_SM + 20 + h]);
    float f = logsigmoidf_(mf + p.fg_bias[h]);
#pragma unroll
    for (int o = 1; o < 64; o <<= 1) { const float t = __shfl_up(f, o); if (tid >= o) f += t; }
    Fl[tid] = f; Fl[64 + tid] = mi + p.ig_bias[h]; }
  __syncthreads();
}
__device__ __forceinline__ void mlstm_conv16(const Params& p, const WS& w, int col, int cch, int b, int c, int tg, float scale, float* out) {
  float win[19];
  const int s0 = c * 64 + tg * 16 - 3;
#pragma unroll
  for (int m = 0; m < 19; ++m) { const int sp = s0 + m; win[m] = (sp >= 0) ? bf2f(w.proj[((size_t)b * SEQ + sp) * NPROJ + col]) : 0.f; }
  const float c0 = p.conv_w[cch], c1 = p.conv_w[1024 + cch], c2 = p.conv_w[2048 + cch], c3 = p.conv_w[3072 + cch], cb = p.conv_b[cch];
#pragma unroll
  for (int i = 0; i < 16; ++i) out[i] = siluf_(cb + c0 * win[i] + c1 * win[i + 1] + c2 * win[i + 2] + c3 * win[i + 3]) * scale;
}

template <int KIND>
__device__ void mix_local(const Params& p, const WS& w, int b, int h, int c, int item, unsigned char* ldsb) {
  const int tid = tidx(), lane = tid & 63, wave = tid >> 6, fr = lane & 15, fq = lane >> 4, d = tid & 127, tg = tid >> 7;
  const size_t tb = (size_t)b * SEQ + (size_t)c * 64;
  float* tot = (float*)(ldsb + L_TOT); const float* Fl = (const float*)(ldsb + L_F);
  bf16_t* kdT = (bf16_t*)(ldsb + L_KDT);
  float wgt[16], kv[16];
  if (KIND == 0) {
    float bv[16], blast; gla_gates(p, w, h, tb, ldsb, tid, bv, blast);
#pragma unroll
    for (int i = 0; i < 16; ++i) { wgt[i] = __expf(blast - bv[i]); kv[i] = bf2f(w.proj[(tb + tg * 16 + i) * NPROJ + C_GK + h * 128 + d]); }
    if (tg == 0) w.gdec[(size_t)item * 128 + d] = __expf(blast);
  } else {
    mlstm_gates(p, w, h, tb, ldsb, tid);
    const float flast = Fl[63];
#pragma unroll
    for (int i = 0; i < 16; ++i) wgt[i] = __expf(flast - Fl[tg * 16 + i] + Fl[64 + tg * 16 + i]);
    mlstm_conv16(p, w, C_MK + h * 128 + d, 512 + h * 128 + d, b, c, tg, 0.08838834764831845f, kv);
    if (tid == 0) w.mdec[item - 2048] = __expf(flast);
  }
  float un = 0.f; float kd[16];
#pragma unroll
  for (int i = 0; i < 16; ++i) { kd[i] = kv[i] * wgt[i]; un += kd[i]; }
  *(uint4*)(kdT + d * KDT_LD + tg * 16) = pack8(kd); *(uint4*)(kdT + d * KDT_LD + tg * 16 + 8) = pack8(kd + 8);
  if (KIND == 1) tot[tg * 128 + d] = un;
  __syncthreads();
  if (KIND == 1 && tg == 0) w.mn[(size_t)(item - 2048) * 128 + d] = tot[d] + tot[128 + d] + tot[256 + d] + tot[384 + d];
  const bf16_t* vrow = w.vT + (size_t)(KIND * 1024 + h * 256 + wave * 32 + fr) * T + tb + fq * 8;
  f32x4 acc[2][8];
#pragma unroll
  for (int yt = 0; yt < 2; ++yt)
#pragma unroll
    for (int xt = 0; xt < 8; ++xt) acc[yt][xt] = (f32x4){0.f, 0.f, 0.f, 0.f};
#pragma unroll
  for (int ks = 0; ks < 2; ++ks) {
    const bf16x8 y0 = *(const bf16x8*)(vrow + ks * 32), y1 = *(const bf16x8*)(vrow + (size_t)16 * T + ks * 32);
#pragma unroll
    for (int xt = 0; xt < 8; ++xt) { const bf16x8 xk = *(const bf16x8*)(kdT + (xt * 16 + fr) * KDT_LD + ks * 32 + fq * 8);
      acc[0][xt] = MFMA16(xk, y0, acc[0][xt]); acc[1][xt] = MFMA16(xk, y1, acc[1][xt]); }
  }
  bf16_t* S = (bf16_t*)p.out + (size_t)item * 32768;
#pragma unroll
  for (int yt = 0; yt < 2; ++yt)
#pragma unroll
    for (int xt = 0; xt < 8; ++xt) *(uint2*)(S + (wave * 32 + yt * 16 + fr) * 128 + xt * 16 + 4 * fq) = make_uint2(pack2(acc[yt][xt][0], acc[yt][xt][1]), pack2(acc[yt][xt][2], acc[yt][xt][3]));
  __syncthreads();
}

__device__ void mix_scan(const Params& p, const WS& w, int bid, int nb) {
  bf16_t* sbuf = (bf16_t*)p.out;
  for (int g = bid * 512 + tidx(); g < 16 * 8192; g += nb * 512) {
    const int combo = g >> 13, e = (g & 8191) * 4, dk = e & 127;
    bf16_t* base = sbuf + (size_t)combo * 256 * 32768 + e;
    float S0 = 0.f, S1 = 0.f, S2 = 0.f, S3 = 0.f;
    for (int c0 = 0; c0 < 256; c0 += 8) {
      uint2 u[8]; float4 dc[8];
#pragma unroll
      for (int k = 0; k < 8; ++k) { u[k] = *(const uint2*)(base + (size_t)(c0 + k) * 32768);
        if (combo < 8) dc[k] = *(const float4*)(w.gdec + (size_t)(combo * 256 + c0 + k) * 128 + dk);
        else { const float m = w.mdec[(combo - 8) * 256 + c0 + k]; dc[k] = make_float4(m, m, m, m); } }
#pragma unroll
      for (int k = 0; k < 8; ++k) { *(uint2*)(base + (size_t)(c0 + k) * 32768) = make_uint2(pack2(S0, S1), pack2(S2, S3));
        S0 = dc[k].x * S0 + lo_f(u[k].x); S1 = dc[k].y * S1 + hi_f(u[k].x); S2 = dc[k].z * S2 + lo_f(u[k].y); S3 = dc[k].w * S3 + hi_f(u[k].y); }
    }
  }
  for (int g = bid * 512 + tidx(); g < 8 * 128; g += nb * 512) {
    const int cb = g >> 7, d = g & 127; float n = 0.f;
    for (int c = 0; c < 256; ++c) { float* q = w.mn + (size_t)(cb * 256 + c) * 128 + d; const float u = *q; *q = n; n = w.mdec[cb * 256 + c] * n + u; }
  }
}

template <int KIND>
__device__ void mix_out(const Params& p, const WS& w, int b, int h, int c, int item, unsigned char* ldsb) {
  const int tid = tidx(), lane = tid & 63, wave = tid >> 6, fr = lane & 15, fq = lane >> 4, d = tid & 127, tg = tid >> 7;
  const size_t tb = (size_t)b * SEQ + (size_t)c * 64;
  const float* Fl = (const float*)(ldsb + L_F); float* denl = (float*)(ldsb + L_DEN); float* part = (float*)(ldsb + L_PART); float* nl = (float*)(ldsb + L_NL);
  bf16_t* qs = (bf16_t*)(ldsb + L_QS); bf16_t* ks = (bf16_t*)(ldsb + L_KS); bf16_t* P = (bf16_t*)(ldsb + L_P);
  {
    float qm[16], km[16], qv[16], kv[16];
    if (KIND == 0) {
      float bv[16], blast; gla_gates(p, w, h, tb, ldsb, tid, bv, blast);
#pragma unroll
      for (int i = 0; i < 16; ++i) { qm[i] = 0.08838834764831845f * __expf(bv[i]); km[i] = __expf(-bv[i]);
        qv[i] = bf2f(w.proj[(tb + tg * 16 + i) * NPROJ + C_GQ + h * 128 + d]); kv[i] = bf2f(w.proj[(tb + tg * 16 + i) * NPROJ + C_GK + h * 128 + d]); }
    } else {
      mlstm_gates(p, w, h, tb, ldsb, tid);
#pragma unroll
      for (int i = 0; i < 16; ++i) { const float F = Fl[tg * 16 + i]; qm[i] = __expf(F); km[i] = __expf(Fl[64 + tg * 16 + i] - F); }
      mlstm_conv16(p, w, C_MQ + h * 128 + d, h * 128 + d, b, c, tg, 1.f, qv);
      mlstm_conv16(p, w, C_MK + h * 128 + d, 512 + h * 128 + d, b, c, tg, 0.08838834764831845f, kv);
      if (tid < 128) nl[tid] = w.mn[(size_t)(item - 2048) * 128 + tid];
    }
#pragma unroll
    for (int i = 0; i < 16; ++i) { qs[(tg * 16 + i) * QS_LD + d] = f2bf(qv[i] * qm[i]); ks[(tg * 16 + i) * QS_LD + d] = f2bf(kv[i] * km[i]); }
  }
  __syncthreads();
#pragma unroll
  for (int q = 0; q < 2; ++q) { const int tt = wave * 2 + q, jt = tt >> 2, it = tt & 3; f32x4 a = (f32x4){0.f, 0.f, 0.f, 0.f};
#pragma unroll
    for (int k4 = 0; k4 < 4; ++k4) { const bf16x8 xk = *(const bf16x8*)(ks + (jt * 16 + fr) * QS_LD + k4 * 32 + fq * 8), yq = *(const bf16x8*)(qs + (it * 16 + fr) * QS_LD + k4 * 32 + fq * 8); a = MFMA16(xk, yq, a); }
    const int i = it * 16 + fr, j0 = jt * 16 + 4 * fq;
    const float v0 = (j0 <= i) ? a[0] : 0.f, v1 = (j0 + 1 <= i) ? a[1] : 0.f, v2 = (j0 + 2 <= i) ? a[2] : 0.f, v3 = (j0 + 3 <= i) ? a[3] : 0.f;
    *(uint2*)(P + i * P_LD + j0) = make_uint2(pack2(v0, v1), pack2(v2, v3)); }
  __syncthreads();
  if (KIND == 1) { const int i = tid >> 3, pt = tid & 7; float f[8]; float s = 0.f;
    unpack8(*(const uint4*)(P + i * P_LD + pt * 8), f);
#pragma unroll
    for (int j = 0; j < 8; ++j) s += f[j];
#pragma unroll
    for (int hh = 0; hh < 2; ++hh) { unpack8(*(const uint4*)(qs + i * QS_LD + pt * 16 + hh * 8), f);
#pragma unroll
      for (int j = 0; j < 8; ++j) s += f[j] * nl[pt * 16 + hh * 8 + j]; }
    s += __shfl_xor(s, 1); s += __shfl_xor(s, 2); s += __shfl_xor(s, 4);
    if (pt == 0) denl[i] = s; }
  f32x4 acc[2][4];
#pragma unroll
  for (int xt = 0; xt < 2; ++xt)
#pragma unroll
    for (int yt = 0; yt < 4; ++yt) acc[xt][yt] = (f32x4){0.f, 0.f, 0.f, 0.f};
  { const bf16_t* vrow = w.vT + (size_t)(KIND * 1024 + h * 256 + wave * 32 + fr) * T + tb + fq * 8;
#pragma unroll
    for (int k2 = 0; k2 < 2; ++k2) { const bf16x8 x0 = *(const bf16x8*)(vrow + k2 * 32), x1 = *(const bf16x8*)(vrow + (size_t)16 * T + k2 * 32);
#pragma unroll
      for (int yt = 0; yt < 4; ++yt) { const bf16x8 yp = *(const bf16x8*)(P + (yt * 16 + fr) * P_LD + k2 * 32 + fq * 8); acc[0][yt] = MFMA16(x0, yp, acc[0][yt]); acc[1][yt] = MFMA16(x1, yp, acc[1][yt]); } }
    const bf16_t* srow = (const bf16_t*)p.out + (size_t)item * 32768 + (wave * 32 + fr) * 128 + fq * 8;
#pragma unroll
    for (int k4 = 0; k4 < 4; ++k4) { const bf16x8 x0 = *(const bf16x8*)(srow + k4 * 32), x1 = *(const bf16x8*)(srow + 16 * 128 + k4 * 32);
#pragma unroll
      for (int yt = 0; yt < 4; ++yt) { const bf16x8 yq = *(const bf16x8*)(qs + (yt * 16 + fr) * QS_LD + k4 * 32 + fq * 8); acc[0][yt] = MFMA16(x0, yq, acc[0][yt]); acc[1][yt] = MFMA16(x1, yq, acc[1][yt]); } } }
  if (KIND == 1) __syncthreads();
#pragma unroll
  for (int yt = 0; yt < 4; ++yt) { float s = 0.f;
    if (KIND == 1) { const float inv = 1.f / fmaxf(fabsf(denl[yt * 16 + fr]), 1.f); acc[0][yt] *= inv; acc[1][yt] *= inv; }
#pragma unroll
    for (int xt = 0; xt < 2; ++xt)
#pragma unroll
      for (int r = 0; r < 4; ++r) s += acc[xt][yt][r] * acc[xt][yt][r];
    s += __shfl_xor(s, 16); s += __shfl_xor(s, 32);
    if (fq == 0) part[wave * 64 + yt * 16 + fr] = s; }
  __syncthreads();
  const float* gain = (KIND == 0 ? p.gla_norm : p.mlstm_norm) + h * 256;
#pragma unroll
  for (int yt = 0; yt < 4; ++yt) { const int i = yt * 16 + fr; float t = 0.f;
#pragma unroll
    for (int ww = 0; ww < 8; ++ww) t += part[ww * 64 + i];
    const float rs = rsqrtf(t * (1.f / 256.f) + EPS);
#pragma unroll
    for (int xt = 0; xt < 2; ++xt) { const int dv = wave * 32 + xt * 16 + 4 * fq;
      const uint2 gt = *(const uint2*)(w.proj + (tb + i) * NPROJ + (KIND == 0 ? C_GG : C_MO) + h * 256 + dv);
      const float4 gn = *(const float4*)(gain + dv);
      const float g0 = lo_f(gt.x), g1 = hi_f(gt.x), g2 = lo_f(gt.y), g3 = hi_f(gt.y);
      const float a0 = KIND == 0 ? siluf_(g0) : sigmoidf_(g0), a1 = KIND == 0 ? siluf_(g1) : sigmoidf_(g1), a2 = KIND == 0 ? siluf_(g2) : sigmoidf_(g2), a3 = KIND == 0 ? siluf_(g3) : sigmoidf_(g3);
      *(uint2*)(w.y + (tb + i) * D + KIND * 1024 + h * 256 + dv) = make_uint2(pack2(acc[xt][yt][0] * rs * gn.x * a0, acc[xt][yt][1] * rs * gn.y * a1), pack2(acc[xt][yt][2] * rs * gn.z * a2, acc[xt][yt][3] * rs * gn.w * a3)); } }
  __syncthreads();
}
template <int WHICH>
__device__ void phase_mix_items(const Params& p, const WS& w, unsigned char* ldsb, int bid, int nb) {
  for (int item = bid; item < 4096; item += nb) {
    const int kind = item >> 11, b = (item >> 10) & 1, h = (item >> 8) & 3, c = item & 255;
    if (WHICH == 0) { if (kind == 0) mix_local<0>(p, w, b, h, c, item, ldsb); else mix_local<1>(p, w, b, h, c, item, ldsb); }
    else { if (kind == 0) mix_out<0>(p, w, b, h, c, item, ldsb); else mix_out<1>(p, w, b, h, c, item, ldsb); }
  }
}

__device__ __forceinline__ unsigned sort16(unsigned b) { return (b & 0x8000u) ? (~b & 0xffffu) : (b | 0x8000u); }
__device__ __forceinline__ float unsort16(unsigned k) { const unsigned b = (k & 0x8000u) ? (k & 0x7fffu) : (~k & 0xffffu); return __uint_as_float(b << 16); }
__device__ __forceinline__ unsigned sort32(float f) { const unsigned u = __float_as_uint(f); return (u & 0x80000000u) ? ~u : (u | 0x80000000u); }
__device__ __forceinline__ float unsort32(unsigned k) { const unsigned u = (k & 0x80000000u) ? (k & 0x7fffffffu) : ~k; return __uint_as_float(u); }
__device__ void phase_topk(const Params& p, const WS& w, int bid, int nb) {
  for (int th = bid * 512 + tidx(); th < T * 8; th += nb * 512) {
    const int t = th >> 3, h = th & 7;
    const uint4* s = (const uint4*)(w.sc + (size_t)t * D + h * 256);
    unsigned l[2][16];
#pragma unroll
    for (int pp = 0; pp < 2; ++pp) {
#pragma unroll
      for (int i = 0; i < 16; ++i) l[pp][i] = 0u;
      for (int q = 0; q < 16; ++q) {
        const uint4 v = s[pp * 16 + q]; const unsigned wds[4] = {v.x, v.y, v.z, v.w};
#pragma unroll
        for (int e = 0; e < 8; ++e) {
          const unsigned b = (e & 1) ? (wds[e >> 1] >> 16) : (wds[e >> 1] & 0xffffu);
          unsigned x = (sort16(b) << 16) | (unsigned)(q * 8 + e);
#pragma unroll
          for (int i = 0; i < 16; ++i) { const unsigned hi = max(l[pp][i], x); x = min(l[pp][i], x); l[pp][i] = hi; }
        }
      }
    }
    unsigned long long lc[16];
#pragma unroll
    for (int i = 0; i < 16; ++i) lc[i] = 0ull;
#pragma unroll
    for (int i = 0; i < 16; ++i)
#pragma unroll
      for (int j = 0; j < 16; ++j) if ((i + 1) * (j + 1) <= 16) {
        const float sv = unsort16(l[0][i] >> 16) + unsort16(l[1][j] >> 16);
        unsigned long long x = ((unsigned long long)sort32(sv) << 32) | (unsigned long long)((l[0][i] & 0xffffu) * 128u + (l[1][j] & 0xffffu));
#pragma unroll
        for (int k = 0; k < 16; ++k) { const bool gt = x > lc[k]; const unsigned long long hi = gt ? x : lc[k]; x = gt ? lc[k] : x; lc[k] = hi; }
      }
    const float mx = unsort32((unsigned)(lc[0] >> 32));
    float e[16], sum = 0.f;
#pragma unroll
    for (int k = 0; k < 16; ++k) { e[k] = __expf(unsort32((unsigned)(lc[k] >> 32)) - mx); sum += e[k]; }
    const float inv = 1.f / sum;
    int* ei = w.eidx + (size_t)t * 128 + h * 16; float* eg = w.eg + (size_t)t * 128 + h * 16;
#pragma unroll
    for (int k4 = 0; k4 < 4; ++k4) {
      *(int4*)(ei + k4 * 4) = make_int4((int)(lc[k4 * 4] & 0xffffffffu), (int)(lc[k4 * 4 + 1] & 0xffffffffu), (int)(lc[k4 * 4 + 2] & 0xffffffffu), (int)(lc[k4 * 4 + 3] & 0xffffffffu));
      *(float4*)(eg + k4 * 4) = make_float4(e[k4 * 4] * inv, e[k4 * 4 + 1] * inv, e[k4 * 4 + 2] * inv, e[k4 * 4 + 3] * inv);
    }
  }
}
__device__ __forceinline__ void ub16(const uint4 q, float* f) {
  const unsigned wd[4] = {q.x, q.y, q.z, q.w};
#pragma unroll
  for (int k = 0; k < 4; ++k) { f[k * 4] = (float)(wd[k] & 0xffu); f[k * 4 + 1] = (float)((wd[k] >> 8) & 0xffu); f[k * 4 + 2] = (float)((wd[k] >> 16) & 0xffu); f[k * 4 + 3] = (float)(wd[k] >> 24); }
}
__device__ void phase_peer(const Params& p, const WS& w, int bid, int nb) {
  const int tid = tidx(), wave = tid >> 6, lane = tid & 63;
  for (int t = bid * 8 + wave; t < T; t += nb * 8) {
    float hr[32], out[32];
#pragma unroll
    for (int i = 0; i < 2; ++i) { unpack8(*(const uint4*)(w.h1b + (size_t)t * D + i * 1024 + lane * 16), hr + i * 16); unpack8(*(const uint4*)(w.h1b + (size_t)t * D + i * 1024 + lane * 16 + 8), hr + i * 16 + 8); }
    float hs = 0.f;
#pragma unroll
    for (int i = 0; i < 32; ++i) { out[i] = 0.f; hs += hr[i]; }
    hs = wave_sum(hs) * 128.f;
    float wsum = 0.f;
    const float rs2 = rsqrtf(w.ssq2[t] * (1.f / D) + EPS);
    for (int h = 0; h < 8; ++h) {
      const int idxv = w.eidx[(size_t)t * 128 + h * 16 + (lane & 15)];
      const float gv = w.eg[(size_t)t * 128 + h * 16 + (lane & 15)] , suv = w.usc[idxv] * rs2, svv = w.vsc[idxv];
#pragma unroll 4
      for (int k = 0; k < 16; ++k) {
        const int e = __shfl(idxv, k); const float g = __shfl(gv, k), su = __shfl(suv, k), sv = __shfl(svv, k);
        const unsigned char* ur = w.u8 + (size_t)e * D + lane * 16; const unsigned char* vr = w.v8 + (size_t)e * D + lane * 16;
        const uint4 u0 = *(const uint4*)ur, u1 = *(const uint4*)(ur + 1024), v0 = *(const uint4*)vr, v1 = *(const uint4*)(vr + 1024);
        float f[16]; float s = 0.f;
        ub16(u0, f);
#pragma unroll
        for (int j = 0; j < 16; ++j) s += f[j] * hr[j];
        ub16(u1, f);
#pragma unroll
        for (int j = 0; j < 16; ++j) s += f[j] * hr[16 + j];
        s = wave_sum(s);
        const float wgt = g * gelu_tanh((s - hs) * su) * sv;
        wsum += wgt;
        ub16(v0, f);
#pragma unroll
        for (int j = 0; j < 16; ++j) out[j] += wgt * f[j];
        ub16(v1, f);
#pragma unroll
        for (int j = 0; j < 16; ++j) out[16 + j] += wgt * f[j];
      }
    }
    float ss = 0.f; const float off = 128.f * wsum;
#pragma unroll
    for (int i = 0; i < 32; ++i) { out[i] += hr[i] - off; ss += out[i] * out[i]; }
    ss = wave_sum(ss);
#pragma unroll
    for (int i = 0; i < 2; ++i) { *(uint4*)(w.h2b + (size_t)t * D + i * 1024 + lane * 16) = pack8(out + i * 16); *(uint4*)(w.h2b + (size_t)t * D + i * 1024 + lane * 16 + 8) = pack8(out + i * 16 + 8); }
    if (lane == 0) w.rstd3[t] = rsqrtf(ss * (1.f / D) + EPS);
  }
}
__device__ void phase_final(const Params& p, const WS& w, int bid, int nb) {
  const int wave = tidx() >> 6, lane = tidx() & 63;
  for (int row = bid * 8 + wave; row < T; row += nb * 8) {
    float4* o = (float4*)(p.out + (size_t)row * D);
    const float rs = rsqrtf(w.ssq4[row] * (1.f / D) + EPS);
#pragma unroll
    for (int i = 0; i < 8; ++i) { float4 v = o[i * 64 + lane]; const float4 g = *(const float4*)(p.norm_final + (i * 64 + lane) * 4); v.x *= rs * g.x; v.y *= rs * g.y; v.z *= rs * g.z; v.w *= rs * g.w; o[i * 64 + lane] = v; }
  }
}

constexpr int NPHASE = 10;
#ifndef FAST_MIX
#define FAST_MIX 1
#endif
template <int PH>
__device__ __forceinline__ void run_phase(const Params& p, float* lds, int bid, int nb) {
  const WS w = make_ws(p.ws);
  if (PH == 0) phase_prep(p, w, lds, bid, nb);
  if (PH == 1) { gemm_any(w.xb, w.win, T, NPROJ, D, EpiProjN{w.proj, w.rstd1}, lds, bid, nb);
                 gemm_any(w.win + (size_t)NPROJ * D, w.xb, 2048, T, D, EpiProjT{w.vT, w.rstd1}, lds, bid, nb); }
#if FAST_MIX
  if (PH == 2) phase_mix_items<0>(p, w, (unsigned char*)lds, bid, nb);
  if (PH == 3) mix_scan(p, w, bid, nb);
  if (PH == 4) phase_mix_items<1>(p, w, (unsigned char*)lds, bid, nb);
#else
  if (PH == 2) phase_mixer_naive(p, w, lds, bid, nb);
#endif
  if (PH == 5) gemm_any(w.y, w.wout, T, D, D, EpiOut{p.x, w.h1b, w.ssq2}, lds, bid, nb);
  if (PH == 6) gemm_any(w.h1b, w.wq, T, D, D, EpiScore{w.sc, w.ssq2}, lds, bid, nb);
  if (PH == 7) { phase_topk(p, w, bid, nb); gemm_any(w.pb, w.wple, T, D, 256, EpiPl{w.pl}, lds, bid, nb); }
  if (PH == 8) phase_peer(p, w, bid, nb);
  if (PH == 9) gemm_any(w.h2b, w.wg, T, D, D, EpiGate{w.h2b, w.pl, w.rstd3, p.out, w.ssq4}, lds, bid, nb);
  if (PH == 10) phase_final(p, w, bid, nb);
}

extern __shared__ __attribute__((aligned(16))) unsigned char dyn_lds[];

#if ONE_LAUNCH
__global__ void __launch_bounds__(512, 2) mega(Params p) {
  cg::grid_group grid = cg::this_grid();
  float* lds = (float*)dyn_lds; const int bid = blockIdx.x, nb = gridDim.x;
#ifndef DUP_PHASE
#define DUP_PHASE -1
#endif
#define RUNP(k) do { run_phase<k>(p, lds, bid, nb); if (DUP_PHASE == (k)) { grid.sync(); run_phase<k>(p, lds, bid, nb); } } while (0)
  RUNP(0); grid.sync();
  RUNP(1); grid.sync();
  RUNP(2); grid.sync();
#if FAST_MIX
  RUNP(3); grid.sync();
  RUNP(4); grid.sync();
#endif
  RUNP(5); grid.sync();
  RUNP(6); grid.sync();
  RUNP(7); grid.sync();
  RUNP(8); grid.sync();
  RUNP(9); grid.sync();
  RUNP(10);
#undef RUNP
}
#else
template <int PH> __global__ void __launch_bounds__(512, 2) k_phase(Params p) { run_phase<PH>(p, (float*)dyn_lds, blockIdx.x, gridDim.x); }
#endif

constexpr size_t kDynLds = 131072;

extern "C" void kernel_launch(void* const* d_in, const int* in_sizes, int n_in, void* d_out, int out_size, void* d_ws, size_t ws_size, hipStream_t stream) {
  if (n_in != 22 || out_size != T * D || ws_size < WS_NEED) { fprintf(stderr, "kernel_launch: unexpected shapes (n_in %d out %d ws %zu)\n", n_in, out_size, ws_size); return; }
  Params p{};
  const float** f = (const float**)&p;
  for (int i = 0; i < 22; ++i) f[i] = (const float*)d_in[i];
  p.out = (float*)d_out; p.ws = (unsigned char*)d_ws;
#if ONE_LAUNCH
  static int grid_blocks = 0;
  if (!grid_blocks) {
    int dev = 0, cus = 0, per_cu = 0;
    (void)hipGetDevice(&dev); (void)hipDeviceGetAttribute(&cus, hipDeviceAttributeMultiprocessorCount, dev);
    (void)hipFuncSetAttribute((const void*)mega, hipFuncAttributeMaxDynamicSharedMemorySize, (int)kDynLds);
    (void)hipOccupancyMaxActiveBlocksPerMultiprocessor(&per_cu, mega, 512, kDynLds);
    if (per_cu < 1) { fprintf(stderr, "occupancy query says 0 blocks/CU\n"); per_cu = 1; }
    grid_blocks = cus;
  }
  void* args[] = {&p};
  hipError_t e = hipLaunchCooperativeKernel((void*)mega, dim3(grid_blocks), dim3(512), args, kDynLds, stream);
  if (e != hipSuccess) fprintf(stderr, "cooperative launch failed: %s (grid %d)\n", hipGetErrorString(e), grid_blocks);
#else
  static bool attr = false;
  const int G = 256;
#define LAUNCH(PH) do { if (!attr) (void)hipFuncSetAttribute((const void*)k_phase<PH>, hipFuncAttributeMaxDynamicSharedMemorySize, (int)kDynLds); \
    hipLaunchKernelGGL(k_phase<PH>, dim3(G), dim3(512), kDynLds, stream, p); } while (0)
  LAUNCH(0); LAUNCH(1); LAUNCH(2); LAUNCH(3); LAUNCH(4); LAUNCH(5); LAUNCH(6); LAUNCH(7); LAUNCH(8); LAUNCH(9); LAUNCH(10);
  attr = true;
#undef LAUNCH
#endif
}
```

```cpp
#include <hip/hip_runtime.h>
#include <hip/hip_cooperative_groups.h>
#include <cstdio>
#include <cstdint>
namespace cg = cooperative_groups;

#ifndef ONE_LAUNCH
#define ONE_LAUNCH 1
#endif

typedef unsigned short bf16_t;
constexpr int T = 32768, SEQ = 16384, D = 2048;
constexpr int NPROJ = 4352;
constexpr int C_GQ = 0, C_GK = 512, C_GG = 1024, C_MQ = 2048, C_MK = 2560, C_MO = 3072, C_SM = 4096;
constexpr float EPS = 1e-6f;
constexpr size_t MiB = 1ull << 20;
constexpr size_t OFF_XB = 0, OFF_Y = 0, OFF_PL = 0;
constexpr size_t OFF_PROJ = 128 * MiB, OFF_H1B = 128 * MiB, OFF_H2B = 256 * MiB;
constexpr size_t OFF_VT = 400 * MiB, OFF_SC = 400 * MiB;
constexpr size_t OFF_UB = 528 * MiB, OFF_VB = 592 * MiB;
constexpr size_t OFF_WIN = 656 * MiB, OFF_WOUT = 681 * MiB, OFF_WQ = 689 * MiB, OFF_WG = 697 * MiB, OFF_WPLE = 705 * MiB;
constexpr size_t OFF_PB = 706 * MiB, OFF_EIDX = 722 * MiB, OFF_EG = 738 * MiB, OFF_MISC = 754 * MiB;
constexpr size_t OFF_GDEC = 755 * MiB, OFF_MN = 756 * MiB, OFF_MDEC = 757 * MiB, OFF_ESC = 758 * MiB;
constexpr size_t WS_NEED = 760 * MiB;

struct Params {
  const float *x, *p, *norm_mix, *w_in, *gate_up, *gate_bias, *gla_norm, *conv_w, *conv_b, *ig_bias, *fg_bias, *mlstm_norm,
      *w_out, *norm_ffn, *peer_query, *sub_keys, *peer_u, *peer_v, *norm_ple, *w_ple, *w_ple_gate, *norm_final;
  float* out;
  unsigned char* ws;
};

__device__ __forceinline__ float bf2f(bf16_t b) { return __uint_as_float(((unsigned)b) << 16); }
__device__ __forceinline__ bf16_t f2bf(float f) { unsigned u = __float_as_uint(f); u += 0x7FFFu + ((u >> 16) & 1u); return (bf16_t)(u >> 16); }
__device__ __forceinline__ unsigned pack2(float lo, float hi) { return (unsigned)f2bf(lo) | ((unsigned)f2bf(hi) << 16); }
__device__ __forceinline__ float lo_f(unsigned u) { return __uint_as_float(u << 16); }
__device__ __forceinline__ float hi_f(unsigned u) { return __uint_as_float(u & 0xffff0000u); }
__device__ __forceinline__ float wave_sum(float v) {
#pragma unroll
  for (int o = 32; o >= 1; o >>= 1) v += __shfl_xor(v, o);
  return v;
}
__device__ __forceinline__ int tidx() { int t = threadIdx.x; asm volatile("" : "+v"(t)); return t; }
__device__ __forceinline__ float sigmoidf_(float x) { return 1.f / (1.f + __expf(-x)); }
__device__ __forceinline__ float siluf_(float x) { return x / (1.f + __expf(-x)); }
__device__ __forceinline__ float logsigmoidf_(float x) { return fminf(x, 0.f) - log1pf(__expf(-fabsf(x))); }
__device__ __forceinline__ float gelu_tanh(float x) { const float u = 0.7978845608028654f * (x + 0.044715f * x * x * x); return 0.5f * x * (1.f + tanhf(u)); }
__device__ __forceinline__ void unpack8(const uint4 q, float* f) {
  f[0] = lo_f(q.x); f[1] = hi_f(q.x); f[2] = lo_f(q.y); f[3] = hi_f(q.y); f[4] = lo_f(q.z); f[5] = hi_f(q.z); f[6] = lo_f(q.w); f[7] = hi_f(q.w);
}
__device__ __forceinline__ uint4 pack8(const float* f) { return make_uint4(pack2(f[0], f[1]), pack2(f[2], f[3]), pack2(f[4], f[5]), pack2(f[6], f[7])); }

struct WS {
  bf16_t *xb, *y, *pl, *proj, *h1b, *h2b, *vT, *sc, *ub, *vb, *win, *wout, *wq, *wg, *wple, *pb;
  int* eidx; float* eg; float *rstd1, *ssq2, *rstd3, *ssq4, *gdec, *mn, *mdec, *usc, *vsc;
  unsigned char *u8, *v8;
};
__device__ __forceinline__ WS make_ws(unsigned char* ws) {
  WS w;
  w.xb = (bf16_t*)(ws + OFF_XB); w.y = (bf16_t*)(ws + OFF_Y); w.pl = (bf16_t*)(ws + OFF_PL); w.proj = (bf16_t*)(ws + OFF_PROJ);
  w.h1b = (bf16_t*)(ws + OFF_H1B); w.h2b = (bf16_t*)(ws + OFF_H2B); w.vT = (bf16_t*)(ws + OFF_VT); w.sc = (bf16_t*)(ws + OFF_SC);
  w.ub = (bf16_t*)(ws + OFF_UB); w.vb = (bf16_t*)(ws + OFF_VB); w.win = (bf16_t*)(ws + OFF_WIN); w.wout = (bf16_t*)(ws + OFF_WOUT);
  w.wq = (bf16_t*)(ws + OFF_WQ); w.wg = (bf16_t*)(ws + OFF_WG); w.wple = (bf16_t*)(ws + OFF_WPLE); w.pb = (bf16_t*)(ws + OFF_PB);
  w.eidx = (int*)(ws + OFF_EIDX); w.eg = (float*)(ws + OFF_EG);
  float* m = (float*)(ws + OFF_MISC); w.rstd1 = m; w.ssq2 = m + T; w.rstd3 = m + 2 * T; w.ssq4 = m + 3 * T;
  w.gdec = (float*)(ws + OFF_GDEC); w.mn = (float*)(ws + OFF_MN); w.mdec = (float*)(ws + OFF_MDEC);
  w.usc = (float*)(ws + OFF_ESC); w.vsc = w.usc + 16384; w.u8 = ws + OFF_UB; w.v8 = ws + OFF_VB;
  return w;
}

__device__ void prep_x(const Params& p, const WS& w, int bid, int nb) {
  const int wave = tidx() >> 6, lane = tidx() & 63;
  for (int row = bid * 8 + wave; row < T; row += nb * 8) {
    const float4* src = (const float4*)(p.x + (size_t)row * D);
    uint2* dst = (uint2*)(w.xb + (size_t)row * D);
    float ss = 0.f;
#pragma unroll
    for (int i = 0; i < 8; ++i) { const float4 v = src[i * 64 + lane]; ss += v.x * v.x + v.y * v.y + v.z * v.z + v.w * v.w; dst[i * 64 + lane] = make_uint2(pack2(v.x, v.y), pack2(v.z, v.w)); }
    ss = wave_sum(ss);
    if (lane == 0) w.rstd1[row] = rsqrtf(ss * (1.f / D) + EPS);
  }
}
__device__ void cvt_rows(const float* src, bf16_t* dst, size_t n, const float* gain, int ncols, int bid, int nb) {
  const size_t n4 = n / 4;
  for (size_t i = (size_t)bid * 512 + tidx(); i < n4; i += (size_t)nb * 512) {
    float4 v = ((const float4*)src)[i];
    if (gain) { const float4 g = *(const float4*)(gain + (int)((i * 4) % (size_t)ncols)); v.x *= g.x; v.y *= g.y; v.z *= g.z; v.w *= g.w; }
    ((uint2*)dst)[i] = make_uint2(pack2(v.x, v.y), pack2(v.z, v.w));
  }
}
template <class CM>
__device__ void transpose_w(const float* src, int K, int ldsrc, bf16_t* dst, int Ndst, const float* gain, CM cm, float* lds, int bid, int nb) {
  const int tid = tidx(), tk = K / 64, ntile = (Ndst / 64) * tk;
  for (int tile = bid; tile < ntile; tile += nb) {
    const int n0 = (tile / tk) * 64, k0 = (tile % tk) * 64;
    const int nc = tid & 63, sc = cm(n0 + nc);
#pragma unroll
    for (int i = 0; i < 8; ++i) { const int kr = (tid >> 6) + 8 * i; float v = 0.f; if (sc >= 0) { v = src[(size_t)(k0 + kr) * ldsrc + sc]; if (gain) v *= gain[k0 + kr]; } lds[kr * 65 + nc] = v; }
    __syncthreads();
    { const int nr = tid >> 3, ks = (tid & 7) * 8; float f[8];
#pragma unroll
      for (int j = 0; j < 8; ++j) f[j] = lds[(ks + j) * 65 + nr];
      *(uint4*)(dst + (size_t)(n0 + nr) * K + k0 + ks) = pack8(f); }
    __syncthreads();
  }
}
struct CmIdent { __device__ int operator()(int n) const { return n; } };
struct CmWin {
  __device__ int operator()(int n) const {
    if (n < 1024) return n;
    if (n < 2048) return 2048 + (n - 1024);
    if (n < 2560) return 3088 + (n - 2048);
    if (n < 3072) return 3600 + (n - 2560);
    if (n < 4096) return 5136 + (n - 3072);
    if (n < 4352) { const int i = n - 4096; if (i < 16) return 3072 + i; if (i < 20) return 6160 + (i - 16); if (i < 24) return 6164 + (i - 20); return -1; }
    const int j = n - 4352; if (j < 1024) return 1024 + j;
    return 4112 + (j - 1024);
  }
};
__device__ void prep_wq(const Params& p, const WS& w, float* lds, int bid, int nb) {
  const int tid = tidx();
  float* SKs = lds;
  float* WQs = lds + 128 * 132;
  for (int item = bid; item < 16 * 32; item += nb) {
    const int hp = item >> 5, k0 = (item & 31) * 64;
#pragma unroll
    for (int i = 0; i < 8; ++i) { const int e4 = tid + 512 * i, key = e4 >> 5, d4 = (e4 & 31) * 4; *(float4*)(SKs + key * 132 + d4) = *(const float4*)(p.sub_keys + (size_t)hp * 16384 + key * 128 + d4); }
#pragma unroll
    for (int i = 0; i < 4; ++i) { const int e4 = tid + 512 * i, kr = e4 >> 5, d4 = (e4 & 31) * 4; float4 v = *(const float4*)(p.peer_query + (size_t)(k0 + kr) * 2048 + hp * 128 + d4); const float g = p.norm_ffn[k0 + kr]; v.x *= g; v.y *= g; v.z *= g; v.w *= g; *(float4*)(WQs + kr * 132 + d4) = v; }
    __syncthreads();
    const int k = tid & 63, kg = tid >> 6;
    float acc[16];
#pragma unroll
    for (int j = 0; j < 16; ++j) acc[j] = 0.f;
    for (int d4 = 0; d4 < 32; ++d4) {
      const float4 a = *(const float4*)(WQs + k * 132 + d4 * 4);
#pragma unroll
      for (int j = 0; j < 16; ++j) { const float4 s = *(const float4*)(SKs + (kg * 16 + j) * 132 + d4 * 4); acc[j] += a.x * s.x + a.y * s.y + a.z * s.z + a.w * s.w; }
    }
#pragma unroll
    for (int j = 0; j < 16; ++j) w.wq[(size_t)(hp * 128 + kg * 16 + j) * 2048 + k0 + k] = f2bf(acc[j]);
    __syncthreads();
  }
}

__device__ void quant_rows(const float* src, const float* gain, unsigned char* dst, float* scale, int bid, int nb) {
  const int tid = tidx(), wave = tid >> 6, lane = tid & 63;
  for (int row = bid * 8 + wave; row < 16384; row += nb * 8) {
    float f[32]; float mx = 0.f;
#pragma unroll
    for (int i = 0; i < 2; ++i)
#pragma unroll
      for (int q = 0; q < 4; ++q) { float4 v = *(const float4*)(src + (size_t)row * 2048 + i * 1024 + lane * 16 + q * 4);
        if (gain) { const float4 g = *(const float4*)(gain + i * 1024 + lane * 16 + q * 4); v.x *= g.x; v.y *= g.y; v.z *= g.z; v.w *= g.w; }
        f[i * 16 + q * 4] = v.x; f[i * 16 + q * 4 + 1] = v.y; f[i * 16 + q * 4 + 2] = v.z; f[i * 16 + q * 4 + 3] = v.w;
        mx = fmaxf(mx, fmaxf(fmaxf(fabsf(v.x), fabsf(v.y)), fmaxf(fabsf(v.z), fabsf(v.w)))); }
#pragma unroll
    for (int o = 32; o >= 1; o >>= 1) mx = fmaxf(mx, __shfl_xor(mx, o));
    const float sc = fmaxf(mx, 1e-30f) * (1.f / 127.f), inv = 1.f / sc;
#pragma unroll
    for (int i = 0; i < 2; ++i) { unsigned wd[4];
#pragma unroll
      for (int q = 0; q < 4; ++q) { unsigned x = 0;
#pragma unroll
        for (int j = 0; j < 4; ++j) { const int v = (int)rintf(f[i * 16 + q * 4 + j] * inv) + 128; x |= (unsigned)v << (8 * j); }
        wd[q] = x; }
      *(uint4*)(dst + (size_t)row * 2048 + i * 1024 + lane * 16) = make_uint4(wd[0], wd[1], wd[2], wd[3]); }
    if (lane == 0) scale[row] = sc;
  }
}
__device__ void phase_prep(const Params& p, const WS& w, float* lds, int bid, int nb) {
  prep_x(p, w, bid, nb);
  cvt_rows(p.p, w.pb, (size_t)T * 256, nullptr, 256, bid, nb);
  quant_rows(p.peer_u, p.norm_ffn, w.u8, w.usc, bid, nb);
  quant_rows(p.peer_v, nullptr, w.v8, w.vsc, bid, nb);
  transpose_w(p.w_in, 2048, 6168, w.win, 6400, p.norm_mix, CmWin(), lds, bid, nb);
  transpose_w(p.w_out, 2048, 2048, w.wout, 2048, nullptr, CmIdent(), lds, bid, nb);
  transpose_w(p.w_ple_gate, 2048, 2048, w.wg, 2048, p.norm_ple, CmIdent(), lds, bid, nb);
  transpose_w(p.w_ple, 256, 2048, w.wple, 2048, nullptr, CmIdent(), lds, bid, nb);
  prep_wq(p, w, lds, bid, nb);
  for (int i = bid * 512 + tidx(); i < T; i += nb * 512) { w.ssq2[i] = 0.f; w.ssq4[i] = 0.f; }
}

struct EpiProjN { bf16_t* out; const float* rstd; static constexpr bool ROWSUM = false;
  __device__ __forceinline__ float store8(int r, int c, const float* v) const { const float s = rstd[r]; float f[8];
#pragma unroll
    for (int j = 0; j < 8; ++j) f[j] = v[j] * s;
    *(uint4*)(out + (size_t)r * NPROJ + c) = pack8(f); return 0.f; }
  __device__ __forceinline__ void rowsum(int, float) const {} };
struct EpiProjT { bf16_t* out; const float* rstd; static constexpr bool ROWSUM = false;
  __device__ __forceinline__ float store8(int r, int c, const float* v) const { const float4 s0 = *(const float4*)(rstd + c), s1 = *(const float4*)(rstd + c + 4); float f[8];
    f[0] = v[0] * s0.x; f[1] = v[1] * s0.y; f[2] = v[2] * s0.z; f[3] = v[3] * s0.w; f[4] = v[4] * s1.x; f[5] = v[5] * s1.y; f[6] = v[6] * s1.z; f[7] = v[7] * s1.w;
    *(uint4*)(out + (size_t)r * T + c) = pack8(f); return 0.f; }
  __device__ __forceinline__ void rowsum(int, float) const {} };
struct EpiOut { const float* x; bf16_t* h1b; float* ssq; static constexpr bool ROWSUM = true;
  __device__ __forceinline__ float store8(int r, int c, const float* v) const { const float4 x0 = *(const float4*)(x + (size_t)r * D + c), x1 = *(const float4*)(x + (size_t)r * D + c + 4); float f[8];
    f[0] = v[0] + x0.x; f[1] = v[1] + x0.y; f[2] = v[2] + x0.z; f[3] = v[3] + x0.w; f[4] = v[4] + x1.x; f[5] = v[5] + x1.y; f[6] = v[6] + x1.z; f[7] = v[7] + x1.w;
    float s = 0.f;
#pragma unroll
    for (int j = 0; j < 8; ++j) s += f[j] * f[j];
    *(uint4*)(h1b + (size_t)r * D + c) = pack8(f); return s; }
  __device__ __forceinline__ void rowsum(int r, float s) const { atomicAdd(ssq + r, s); } };
struct EpiScore { bf16_t* sc; const float* ssq; static constexpr bool ROWSUM = false;
  __device__ __forceinline__ float store8(int r, int c, const float* v) const { const float s = rsqrtf(ssq[r] * (1.f / D) + EPS); float f[8];
#pragma unroll
    for (int j = 0; j < 8; ++j) f[j] = v[j] * s;
    *(uint4*)(sc + (size_t)r * D + c) = pack8(f); return 0.f; }
  __device__ __forceinline__ void rowsum(int, float) const {} };
struct EpiPl { bf16_t* pl; static constexpr bool ROWSUM = false;
  __device__ __forceinline__ float store8(int r, int c, const float* v) const { *(uint4*)(pl + (size_t)r * D + c) = pack8(v); return 0.f; }
  __device__ __forceinline__ void rowsum(int, float) const {} };
struct EpiGate { const bf16_t* h2b; const bf16_t* pl; const float* rstd3; float* out; float* ssq; static constexpr bool ROWSUM = true;
  __device__ __forceinline__ float store8(int r, int c, const float* v) const { const float rs = rstd3[r]; float h[8], q[8], f[8];
    unpack8(*(const uint4*)(h2b + (size_t)r * D + c), h); unpack8(*(const uint4*)(pl + (size_t)r * D + c), q);
    float s = 0.f;
#pragma unroll
    for (int j = 0; j < 8; ++j) { f[j] = h[j] + sigmoidf_(v[j] * rs) * q[j]; s += f[j] * f[j]; }
    *(float4*)(out + (size_t)r * D + c) = make_float4(f[0], f[1], f[2], f[3]); *(float4*)(out + (size_t)r * D + c + 4) = make_float4(f[4], f[5], f[6], f[7]); return s; }
  __device__ __forceinline__ void rowsum(int r, float s) const { atomicAdd(ssq + r, s); } };

template <class Epi>
__device__ void gemm_naive(const bf16_t* A, const bf16_t* Bt, int M, int N, int K, const Epi& E, float* lds, int bid, int nb) {
  const int tid = tidx(), ty = tid >> 4, tx = tid & 15;
  float* As = lds;
  float* Bs = lds + 32 * 132;
  const int nM = M / 128, nN = N / 128;
  for (int tile = bid; tile < nM * nN; tile += nb) {
    const int m0 = (tile % nM) * 128, n0 = (tile / nM) * 128;
    float acc[4][8];
#pragma unroll
    for (int i = 0; i < 4; ++i)
#pragma unroll
      for (int j = 0; j < 8; ++j) acc[i][j] = 0.f;
    const int lr = tid >> 2, lk = (tid & 3) * 8;
    for (int k0 = 0; k0 < K; k0 += 32) {
      const uint4 av = *(const uint4*)(A + (size_t)(m0 + lr) * K + k0 + lk);
      const uint4 bv = *(const uint4*)(Bt + (size_t)(n0 + lr) * K + k0 + lk);
      float af[8], bf[8]; unpack8(av, af); unpack8(bv, bf);
      __syncthreads();
#pragma unroll
      for (int j = 0; j < 8; ++j) { As[(lk + j) * 132 + lr] = af[j]; Bs[(lk + j) * 132 + lr] = bf[j]; }
      __syncthreads();
#pragma unroll 8
      for (int kk = 0; kk < 32; ++kk) {
        const float4 a = *(const float4*)(As + kk * 132 + ty * 4);
        const float4 b0 = *(const float4*)(Bs + kk * 132 + tx * 8), b1 = *(const float4*)(Bs + kk * 132 + tx * 8 + 4);
        const float aa[4] = {a.x, a.y, a.z, a.w}; const float bb[8] = {b0.x, b0.y, b0.z, b0.w, b1.x, b1.y, b1.z, b1.w};
#pragma unroll
        for (int i = 0; i < 4; ++i)
#pragma unroll
          for (int j = 0; j < 8; ++j) acc[i][j] += aa[i] * bb[j];
      }
    }
#pragma unroll
    for (int i = 0; i < 4; ++i) {
      const int r = m0 + ty * 4 + i;
      float s = E.store8(r, n0 + tx * 8, acc[i]);
      if (Epi::ROWSUM) { s += __shfl_xor(s, 1); s += __shfl_xor(s, 2); s += __shfl_xor(s, 4); s += __shfl_xor(s, 8); if (tx == 0) E.rowsum(r, s); }
    }
  }
}


namespace pg8 {
#define PG8_LAS __attribute__((address_space(3)))
typedef short bf16x8 __attribute__((ext_vector_type(8)));
typedef float f32x4 __attribute__((ext_vector_type(4)));
constexpr int BM = 256, BK = 64, HALF = 128, HTB = HALF * BK * 2, STAGE_BYTES = 8 * HTB, NXCD = 8, WGM = 8;
__host__ __device__ __forceinline__ int lds_byte(int r, int c) { const int st = (r >> 4) * 2 + (c >> 5), rr = r & 15, cc = c & 31, ob = rr * 64 + cc * 2; return st * 1024 + (ob ^ (((ob >> 9) & 1) << 5)); }
__host__ __device__ __forceinline__ void stage_rc(int b, int& R, int& C) { const int st = b / 1024, sb = b % 1024, swz = sb ^ (((sb >> 9) & 1) << 5); R = (st >> 1) * 16 + swz / 64; C = (st & 1) * 32 + (swz % 64) / 2; }
__host__ __device__ __forceinline__ int perm32(int rho) { const int n = rho >> 4, i = rho & 15; return 8 * (i >> 2) + 4 * n + (i & 3); }
struct Unit { int pm, pn; };
struct Gemm { const bf16_t* A; const bf16_t* Bt; int M, N, K; };
struct StaticOrder {
    int nM, nN, nwg, G, c;
    __host__ __device__ void init(int M, int N, int G_, int c_) { nM = M / BM; nN = N / BM; nwg = nM * nN; G = G_; c = c_; }
    __host__ __device__ bool next(int i, Unit& u) const {
        const long L = (long)i * G + c; if (L >= nwg) return false;
        int wgid = (int)L; { const int q = nwg / NXCD, r = nwg % NXCD, xcd = wgid % NXCD, off = wgid / NXCD; wgid = (xcd < r ? xcd * (q + 1) : r * (q + 1) + (xcd - r) * q) + off; }
        const int nig = WGM * nN, gid = wgid / nig, fm = gid * WGM, gsz = (nM - fm) < WGM ? (nM - fm) : WGM;
        u.pm = fm + ((wgid % nig) % gsz); u.pn = (wgid % nig) / gsz; return true;
    }
    __device__ __forceinline__ void a_ready(const Unit&) const {}
    __device__ __forceinline__ void done(const Unit&) const {}
};
template <class E8> struct EpiA {
    static constexpr bool PERM = true, AFTER_DRAIN = false;
    E8 e;
    __device__ __forceinline__ void operator()(const f32x4 (&acc)[2][2][4][2], const Unit& u, int wr, int wc, int fr, int fq) const {
        const int row0 = u.pm * BM + wr * 64 + fr, col0 = u.pn * BM + wc * 32 + 8 * fq;
#pragma unroll
        for (int ai = 0; ai < 2; ++ai)
#pragma unroll
            for (int m = 0; m < 4; ++m) { const int r = row0 + ai * HALF + m * 16; float s = 0.f;
#pragma unroll
                for (int bj = 0; bj < 2; ++bj) { const float v[8] = {acc[ai][bj][m][0][0], acc[ai][bj][m][0][1], acc[ai][bj][m][0][2], acc[ai][bj][m][0][3], acc[ai][bj][m][1][0], acc[ai][bj][m][1][1], acc[ai][bj][m][1][2], acc[ai][bj][m][1][3]};
                    s += e.store8(r, col0 + bj * HALF, v); }
                if (E8::ROWSUM) { s += __shfl_xor(s, 16); s += __shfl_xor(s, 32); if (fq == 0) e.rowsum(r, s); } }
    }
    __device__ __forceinline__ void fused(f32x4 (&)[2][2][4][2], const Unit&, int, int, int, int, PG8_LAS unsigned char*, int, int) const {}
};
template <class Epi, class Sched, bool ALIGN_EPI = false, bool SP2 = false>
__device__ __forceinline__ void gemm_phase(PG8_LAS unsigned char* lds, const Gemm g, const Sched& S, const Epi& E) {
    int tid_ = threadIdx.x; asm volatile("" : "+v"(tid_));
    const int tid = tid_, wid = __builtin_amdgcn_readfirstlane(tid >> 6), lane = tid & 63, wr = wid >> 2, wc = wid & 3, fr = lane & 15, fq = lane >> 4;
    const int K = g.K, nt = K / BK;
    unsigned voffA[2], voffB[2];
#pragma unroll
    for (int i = 0; i < 2; ++i) { int R, C; stage_rc(tid * 16 + i * 8192, R, C); const int Rb = Epi::PERM ? ((R & ~31) + perm32(R & 31)) : R;
        voffA[i] = (unsigned)(R * K + C) * 2u; voffB[i] = (unsigned)(Rb * K + C) * 2u; }
    const size_t kstep = (size_t)(BK * 2);
    const size_t hstep = (size_t)HALF * K * 2;
    const size_t tstep = 2 * hstep;
    const unsigned ldsw = (unsigned)wid * 1024u;
    const int aoff = lds_byte(wr * 64 + fr, fq * 8), boff = lds_byte(wc * 32 + fr, fq * 8);
#define PG8_SA(b, h) (((b) * 2 + (h)) * HTB)
#define PG8_SB(b, h) ((4 + (b) * 2 + (h)) * HTB)
#define PG8_STAGE(bufoff, gbase, voff) do { _Pragma("unroll") for (int _i = 0; _i < 2; ++_i) \
        __builtin_amdgcn_global_load_lds((const unsigned*)((const char*)(gbase) + (voff)[_i]), (PG8_LAS unsigned*)(lds + (bufoff) + ldsw + _i * 8192), 16, 0, 0); } while (0)
#define PG8_LDA(dst, b, h) do { _Pragma("unroll") for (int m = 0; m < 4; ++m) _Pragma("unroll") for (int k = 0; k < 2; ++k) dst[m][k] = *(const PG8_LAS bf16x8*)(lds + PG8_SA(b, h) + aoff + m * 2048 + k * 1024); } while (0)
#define PG8_LDB(dst, b, h) do { _Pragma("unroll") for (int n = 0; n < 2; ++n) _Pragma("unroll") for (int k = 0; k < 2; ++k) dst[n][k] = *(const PG8_LAS bf16x8*)(lds + PG8_SB(b, h) + boff + n * 2048 + k * 1024); } while (0)
#define PG8_MMA(ai, bj, At, Bt) do { __builtin_amdgcn_s_setprio(1); _Pragma("unroll") for (int m = 0; m < 4; ++m) _Pragma("unroll") for (int n = 0; n < 2; ++n) _Pragma("unroll") for (int k = 0; k < 2; ++k) \
        acc[ai][bj][m][n] = __builtin_amdgcn_mfma_f32_16x16x32_bf16(Bt[n][k], At[m][k], acc[ai][bj][m][n], 0, 0, 0); __builtin_amdgcn_s_setprio(0); } while (0)
#define PG8_WAIT_V(n) asm volatile("s_waitcnt vmcnt(" #n ")" ::: "memory")
#define PG8_WAIT_L(n) asm volatile("s_waitcnt lgkmcnt(" #n ")" ::: "memory")
#define PG8_BAR __builtin_amdgcn_s_barrier()
#define PG8_SCHED __builtin_amdgcn_sched_barrier(0)
    Unit cur, nxt; int ui = 0;
    if (!S.next(0, cur)) return;
    f32x4 acc[2][2][4][2];
#pragma unroll
    for (int a = 0; a < 2; ++a)
#pragma unroll
        for (int b = 0; b < 2; ++b)
#pragma unroll
            for (int m = 0; m < 4; ++m)
#pragma unroll
                for (int n = 0; n < 2; ++n) acc[a][b][m][n] = (f32x4){0.f, 0.f, 0.f, 0.f};
    bf16x8 At[4][2], B0[2][2], B1[2][2];
    const char* cA = (const char*)g.A + (size_t)cur.pm * tstep; const char* cB = (const char*)g.Bt + (size_t)cur.pn * tstep;
    S.a_ready(cur);
    if constexpr (SP2) {
        PG8_STAGE(PG8_SB(0, 0), cB, voffB); PG8_STAGE(PG8_SB(0, 1), cB + hstep, voffB); PG8_STAGE(PG8_SA(0, 0), cA, voffA); PG8_STAGE(PG8_SA(0, 1), cA + hstep, voffA);
        if (wr == 1) PG8_BAR;
        PG8_WAIT_V(2); PG8_BAR;
        PG8_STAGE(PG8_SB(1, 0), cB + kstep, voffB); PG8_STAGE(PG8_SA(1, 0), cA + kstep, voffA); PG8_STAGE(PG8_SB(1, 1), cB + hstep + kstep, voffB);
        PG8_WAIT_V(6); PG8_BAR;
    } else {
        PG8_STAGE(PG8_SB(0, 0), cB, voffB); PG8_STAGE(PG8_SA(0, 0), cA, voffA); PG8_STAGE(PG8_SB(0, 1), cB + hstep, voffB); PG8_STAGE(PG8_SA(0, 1), cA + hstep, voffA);
        if (wr == 1) PG8_BAR;
        PG8_WAIT_V(4); PG8_BAR;
        PG8_STAGE(PG8_SB(1, 0), cB + kstep, voffB); PG8_STAGE(PG8_SA(1, 0), cA + kstep, voffA); PG8_STAGE(PG8_SB(1, 1), cB + hstep + kstep, voffB);
        PG8_WAIT_V(6); PG8_BAR;
    }
    for (;;) {
        const bool has_next = S.next(ui + 1, nxt);
        const char* nA = has_next ? (const char*)g.A + (size_t)nxt.pm * tstep : cA; const char* nB = has_next ? (const char*)g.Bt + (size_t)nxt.pn * tstep : cB;
        for (int t = 0; t < nt; t += 2) {
            const bool last = (t == nt - 2);
            const char* a1 = cA + (size_t)(t + 1) * kstep;
            const char* a2 = last ? nA : cA + (size_t)(t + 2) * kstep; const char* b2 = last ? nB : cB + (size_t)(t + 2) * kstep;
            const char* a3 = a2 + kstep; const char* b3 = b2 + kstep;
            if (last && has_next) S.a_ready(nxt);
            if constexpr (SP2) {
            PG8_LDB(B0, 0, 0); PG8_LDB(B1, 0, 1); PG8_SCHED; PG8_LDA(At, 0, 0); PG8_STAGE(PG8_SA(1, 1), a1 + hstep, voffA);
            PG8_WAIT_V(8); PG8_WAIT_L(0); PG8_BAR; PG8_MMA(0, 0, At, B0); PG8_MMA(0, 1, At, B1); PG8_BAR; PG8_SCHED;
            PG8_LDA(At, 0, 1); PG8_STAGE(PG8_SB(0, 0), b2, voffB); PG8_STAGE(PG8_SB(0, 1), b2 + hstep, voffB); PG8_STAGE(PG8_SA(0, 0), a2, voffA);
            PG8_WAIT_V(8); PG8_WAIT_L(0); PG8_BAR; PG8_MMA(1, 0, At, B0); PG8_MMA(1, 1, At, B1); PG8_BAR; PG8_SCHED;
            PG8_LDB(B0, 1, 0); PG8_LDB(B1, 1, 1); PG8_SCHED; PG8_LDA(At, 1, 0); PG8_STAGE(PG8_SA(0, 1), a2 + hstep, voffA);
            PG8_WAIT_V(8); PG8_WAIT_L(0); PG8_BAR; PG8_MMA(0, 0, At, B0); PG8_MMA(0, 1, At, B1); PG8_BAR; PG8_SCHED;
            PG8_LDA(At, 1, 1); PG8_STAGE(PG8_SB(1, 0), b3, voffB); PG8_STAGE(PG8_SB(1, 1), b3 + hstep, voffB); PG8_STAGE(PG8_SA(1, 0), a3, voffA);
            PG8_WAIT_V(8); PG8_WAIT_L(0); PG8_BAR; PG8_MMA(1, 0, At, B0); PG8_MMA(1, 1, At, B1); PG8_BAR; PG8_SCHED;
            } else {
            PG8_LDB(B0, 0, 0); PG8_SCHED; PG8_LDA(At, 0, 0); PG8_STAGE(PG8_SA(1, 1), a1 + hstep, voffA);
            PG8_WAIT_L(8); PG8_BAR; PG8_WAIT_L(0); PG8_MMA(0, 0, At, B0); PG8_BAR; PG8_SCHED;
            PG8_LDB(B1, 0, 1); PG8_STAGE(PG8_SB(0, 0), b2, voffB);
            PG8_BAR; PG8_WAIT_L(0); PG8_MMA(0, 1, At, B1); PG8_BAR;
            PG8_LDA(At, 0, 1); PG8_STAGE(PG8_SA(0, 0), a2, voffA);
            PG8_BAR; PG8_WAIT_L(0); PG8_MMA(1, 0, At, B0); PG8_BAR; PG8_SCHED;
            PG8_STAGE(PG8_SB(0, 1), b2 + hstep, voffB);
            PG8_WAIT_V(6); PG8_BAR; PG8_MMA(1, 1, At, B1); PG8_BAR;
            PG8_LDB(B0, 1, 0); PG8_SCHED; PG8_LDA(At, 1, 0); PG8_STAGE(PG8_SA(0, 1), a2 + hstep, voffA);
            PG8_WAIT_L(8); PG8_BAR; PG8_WAIT_L(0); PG8_MMA(0, 0, At, B0); PG8_BAR; PG8_SCHED;
            PG8_LDB(B1, 1, 1); PG8_STAGE(PG8_SB(1, 0), b3, voffB);
            PG8_BAR; PG8_WAIT_L(0); PG8_MMA(0, 1, At, B1); PG8_BAR;
            PG8_LDA(At, 1, 1); PG8_STAGE(PG8_SA(1, 0), a3, voffA);
            PG8_BAR; PG8_WAIT_L(0); PG8_MMA(1, 0, At, B0); PG8_BAR; PG8_SCHED;
            PG8_STAGE(PG8_SB(1, 1), b3 + hstep, voffB);
            PG8_WAIT_V(6); PG8_BAR; PG8_MMA(1, 1, At, B1); PG8_BAR;
            }
        }
        if constexpr (ALIGN_EPI) { if (wr == 0) PG8_BAR; }
        if constexpr (!Epi::AFTER_DRAIN) { E(acc, cur, wr, wc, fr, fq); S.done(cur); }
        if (!has_next) break;
#pragma unroll
        for (int a = 0; a < 2; ++a)
#pragma unroll
            for (int b = 0; b < 2; ++b)
#pragma unroll
                for (int m = 0; m < 4; ++m)
#pragma unroll
                    for (int n = 0; n < 2; ++n) acc[a][b][m][n] = (f32x4){0.f, 0.f, 0.f, 0.f};
        cur = nxt; cA = nA; cB = nB; ++ui;
        if constexpr (ALIGN_EPI) { if (wr == 1) PG8_BAR; }
    }
    PG8_WAIT_V(0);
    if constexpr (!ALIGN_EPI) { if (wr == 0) PG8_BAR; }
    PG8_BAR;
    if constexpr (Epi::AFTER_DRAIN) { E.fused(acc, cur, wr, wc, fr, fq, lds, wid, lane); S.done(cur); }
#undef PG8_SA
#undef PG8_SB
#undef PG8_STAGE
#undef PG8_LDA
#undef PG8_LDB
#undef PG8_MMA
#undef PG8_WAIT_V
#undef PG8_WAIT_L
#undef PG8_BAR
#undef PG8_SCHED
}
}

#ifndef FAST_GEMM
#define FAST_GEMM 1
#endif
template <class E8>
__device__ __forceinline__ void gemm_any(const bf16_t* A, const bf16_t* Bt, int M, int N, int K, const E8& E, float* lds, int bid, int nb) {
#if FAST_GEMM
  pg8::Gemm g{A, Bt, M, N, K}; pg8::StaticOrder S; S.init(M, N, nb, bid);
  pg8::EpiA<E8> EA{E};
  pg8::gemm_phase<pg8::EpiA<E8>, pg8::StaticOrder, true, true>((PG8_LAS unsigned char*)lds, g, S, EA);
#else
  gemm_naive(A, Bt, M, N, K, E, lds, bid, nb);
#endif
}

__device__ void gla_naive(const Params& p, const WS& w, int b, int h, float* lds) {
  constexpr int CH = 16;
  const int tid = tidx(), dv = tid & 255, half = tid >> 8, wave = tid >> 6, lane = tid & 63;
  float* qf = lds; float* kf = qf + CH * 128; float* af = kf + CH * 128; float* vf = af + CH * 128; float* op = vf + CH * 256;
  float S[64];
#pragma unroll
  for (int i = 0; i < 64; ++i) S[i] = 0.f;
  const int gd = tid & 127;
  float gu[16];
#pragma unroll
  for (int r = 0; r < 16; ++r) gu[r] = p.gate_up[r * 512 + h * 128 + gd];
  const float gb = p.gate_bias[h * 128 + gd];
  const float qscale = 0.08838834764831845f;
  for (int t0 = 0; t0 < SEQ; t0 += CH) {
    const size_t tb = (size_t)b * SEQ + t0;
    { const int tok = tid >> 5, d4 = (tid & 31) * 4;
      const uint2 qv = *(const uint2*)(w.proj + (tb + tok) * NPROJ + C_GQ + h * 128 + d4);
      const uint2 kv = *(const uint2*)(w.proj + (tb + tok) * NPROJ + C_GK + h * 128 + d4);
      *(float4*)(qf + tok * 128 + d4) = make_float4(lo_f(qv.x) * qscale, hi_f(qv.x) * qscale, lo_f(qv.y) * qscale, hi_f(qv.y) * qscale);
      *(float4*)(kf + tok * 128 + d4) = make_float4(lo_f(kv.x), hi_f(kv.x), lo_f(kv.y), hi_f(kv.y)); }
    { const int dvv = tid & 255, tk8 = (tid >> 8) * 8; float f[8];
      unpack8(*(const uint4*)(w.vT + (size_t)(h * 256 + dvv) * T + tb + tk8), f);
#pragma unroll
      for (int j = 0; j < 8; ++j) vf[(tk8 + j) * 256 + dvv] = f[j]; }
#pragma unroll
    for (int i = 0; i < 4; ++i) { const int tok = (tid >> 7) * 4 + i; float z = gb; float gl[16];
      unpack8(*(const uint4*)(w.proj + (tb + tok) * NPROJ + C_SM), gl); unpack8(*(const uint4*)(w.proj + (tb + tok) * NPROJ + C_SM + 8), gl + 8);
#pragma unroll
      for (int r = 0; r < 16; ++r) z += gl[r] * gu[r];
      af[tok * 128 + gd] = __expf(logsigmoidf_(z) * (1.f / 16.f)); }
    __syncthreads();
    for (int tok = 0; tok < CH; ++tok) {
      const float vv = vf[tok * 256 + dv]; float acc = 0.f;
#pragma unroll
      for (int i4 = 0; i4 < 16; ++i4) {
        const float4 a = *(const float4*)(af + tok * 128 + half * 64 + i4 * 4), k = *(const float4*)(kf + tok * 128 + half * 64 + i4 * 4), q = *(const float4*)(qf + tok * 128 + half * 64 + i4 * 4);
        S[i4 * 4 + 0] = a.x * S[i4 * 4 + 0] + k.x * vv; acc += q.x * S[i4 * 4 + 0];
        S[i4 * 4 + 1] = a.y * S[i4 * 4 + 1] + k.y * vv; acc += q.y * S[i4 * 4 + 1];
        S[i4 * 4 + 2] = a.z * S[i4 * 4 + 2] + k.z * vv; acc += q.z * S[i4 * 4 + 2];
        S[i4 * 4 + 3] = a.w * S[i4 * 4 + 3] + k.w * vv; acc += q.w * S[i4 * 4 + 3];
      }
      op[(half * CH + tok) * 256 + dv] = acc;
    }
    __syncthreads();
#pragma unroll
    for (int i = 0; i < 2; ++i) { const int tok = wave * 2 + i;
      const float4 o0 = *(const float4*)(op + tok * 256 + lane * 4), o1 = *(const float4*)(op + (CH + tok) * 256 + lane * 4);
      const float o[4] = {o0.x + o1.x, o0.y + o1.y, o0.z + o1.z, o0.w + o1.w};
      float ss = wave_sum(o[0] * o[0] + o[1] * o[1] + o[2] * o[2] + o[3] * o[3]);
      const float rs = rsqrtf(ss * (1.f / 256.f) + EPS);
      const uint2 gg = *(const uint2*)(w.proj + (tb + tok) * NPROJ + C_GG + h * 256 + lane * 4);
      const float4 gn = *(const float4*)(p.gla_norm + h * 256 + lane * 4);
      const float y0 = o[0] * rs * gn.x * siluf_(lo_f(gg.x)), y1 = o[1] * rs * gn.y * siluf_(hi_f(gg.x)), y2 = o[2] * rs * gn.z * siluf_(lo_f(gg.y)), y3 = o[3] * rs * gn.w * siluf_(hi_f(gg.y));
      *(uint2*)(w.y + (tb + tok) * D + h * 256 + lane * 4) = make_uint2(pack2(y0, y1), pack2(y2, y3)); }
    __syncthreads();
  }
}
__device__ void mlstm_naive(const Params& p, const WS& w, int b, int h, float* lds) {
  constexpr int CH = 16;
  const int tid = tidx(), dv = tid & 255, half = tid >> 8, wave = tid >> 6, lane = tid & 63;
  float* qf = lds; float* kf = qf + CH * 128; float* vf = kf + CH * 128; float* op = vf + CH * 256; float* dn = op + 2 * CH * 256; float* gt = dn + 2 * CH * 256;
  float C[64], n[4];
#pragma unroll
  for (int i = 0; i < 64; ++i) C[i] = 0.f;
#pragma unroll
  for (int i = 0; i < 4; ++i) n[i] = 0.f;
  const int nd = half * 64 + (dv & 15) * 4;
  const float kscale = 0.08838834764831845f;
  const float ib = p.ig_bias[h], fb = p.fg_bias[h];
  for (int t0 = 0; t0 < SEQ; t0 += CH) {
    const size_t tb = (size_t)b * SEQ + t0;
    { const int tok = tid >> 5, d4 = (tid & 31) * 4;
      float qa[4], ka[4];
#pragma unroll
      for (int c = 0; c < 4; ++c) { qa[c] = p.conv_b[h * 128 + d4 + c]; ka[c] = p.conv_b[512 + h * 128 + d4 + c]; }
#pragma unroll
      for (int wi = 0; wi < 4; ++wi) { const int ts = t0 + tok - 3 + wi;
        if (ts >= 0) { const size_t tr = (size_t)b * SEQ + ts;
          const uint2 qv = *(const uint2*)(w.proj + tr * NPROJ + C_MQ + h * 128 + d4), kv = *(const uint2*)(w.proj + tr * NPROJ + C_MK + h * 128 + d4);
          const float4 cq = *(const float4*)(p.conv_w + wi * 1024 + h * 128 + d4), ck = *(const float4*)(p.conv_w + wi * 1024 + 512 + h * 128 + d4);
          qa[0] += cq.x * lo_f(qv.x); qa[1] += cq.y * hi_f(qv.x); qa[2] += cq.z * lo_f(qv.y); qa[3] += cq.w * hi_f(qv.y);
          ka[0] += ck.x * lo_f(kv.x); ka[1] += ck.y * hi_f(kv.x); ka[2] += ck.z * lo_f(kv.y); ka[3] += ck.w * hi_f(kv.y); } }
      *(float4*)(qf + tok * 128 + d4) = make_float4(siluf_(qa[0]), siluf_(qa[1]), siluf_(qa[2]), siluf_(qa[3]));
      *(float4*)(kf + tok * 128 + d4) = make_float4(siluf_(ka[0]) * kscale, siluf_(ka[1]) * kscale, siluf_(ka[2]) * kscale, siluf_(ka[3]) * kscale); }
    { const int dvv = tid & 255, tk8 = (tid >> 8) * 8; float f[8];
      unpack8(*(const uint4*)(w.vT + (size_t)(1024 + h * 256 + dvv) * T + tb + tk8), f);
#pragma unroll
      for (int j = 0; j < 8; ++j) vf[(tk8 + j) * 256 + dvv] = f[j]; }
    if (tid < CH) { const float mi = bf2f(w.proj[(tb + tid) * NPROJ + C_SM + 16 + h]), mf = bf2f(w.proj[(tb + tid) * NPROJ + C_SM + 20 + h]);
      gt[tid * 2] = __expf(mi + ib); gt[tid * 2 + 1] = sigmoidf_(mf + fb); }
    __syncthreads();
    for (int tok = 0; tok < CH; ++tok) {
      const float vv = vf[tok * 256 + dv], ig = gt[tok * 2], fg = gt[tok * 2 + 1]; float num = 0.f, den = 0.f;
#pragma unroll
      for (int i4 = 0; i4 < 16; ++i4) {
        const float4 k = *(const float4*)(kf + tok * 128 + half * 64 + i4 * 4), q = *(const float4*)(qf + tok * 128 + half * 64 + i4 * 4);
        const float kk[4] = {k.x * ig, k.y * ig, k.z * ig, k.w * ig}; const float qq[4] = {q.x, q.y, q.z, q.w};
#pragma unroll
        for (int c = 0; c < 4; ++c) { C[i4 * 4 + c] = fg * C[i4 * 4 + c] + kk[c] * vv; num += qq[c] * C[i4 * 4 + c]; }
      }
      { const float4 k = *(const float4*)(kf + tok * 128 + nd), q = *(const float4*)(qf + tok * 128 + nd);
        n[0] = fg * n[0] + k.x * ig; n[1] = fg * n[1] + k.y * ig; n[2] = fg * n[2] + k.z * ig; n[3] = fg * n[3] + k.w * ig;
        den = q.x * n[0] + q.y * n[1] + q.z * n[2] + q.w * n[3];
        den += __shfl_xor(den, 1); den += __shfl_xor(den, 2); den += __shfl_xor(den, 4); den += __shfl_xor(den, 8); }
      op[(half * CH + tok) * 256 + dv] = num; if (dv == 0) dn[half * CH + tok] = den;
    }
    __syncthreads();
#pragma unroll
    for (int i = 0; i < 2; ++i) { const int tok = wave * 2 + i;
      const float4 o0 = *(const float4*)(op + tok * 256 + lane * 4), o1 = *(const float4*)(op + (CH + tok) * 256 + lane * 4);
      const float den = dn[tok] + dn[CH + tok];
      const float inv = 1.f / fmaxf(fabsf(den), 1.f);
      const float o[4] = {(o0.x + o1.x) * inv, (o0.y + o1.y) * inv, (o0.z + o1.z) * inv, (o0.w + o1.w) * inv};
      float ss = wave_sum(o[0] * o[0] + o[1] * o[1] + o[2] * o[2] + o[3] * o[3]);
      const float rs = rsqrtf(ss * (1.f / 256.f) + EPS);
      const uint2 mo = *(const uint2*)(w.proj + (tb + tok) * NPROJ + C_MO + h * 256 + lane * 4);
      const float4 gn = *(const float4*)(p.mlstm_norm + h * 256 + lane * 4);
      const float y0 = o[0] * rs * gn.x * sigmoidf_(lo_f(mo.x)), y1 = o[1] * rs * gn.y * sigmoidf_(hi_f(mo.x)), y2 = o[2] * rs * gn.z * sigmoidf_(lo_f(mo.y)), y3 = o[3] * rs * gn.w * sigmoidf_(hi_f(mo.y));
      *(uint2*)(w.y + (tb + tok) * D + 1024 + h * 256 + lane * 4) = make_uint2(pack2(y0, y1), pack2(y2, y3)); }
    __syncthreads();
  }
}
__device__ void phase_mixer_naive(const Params& p, const WS& w, float* lds, int bid, int nb) {
  for (int item = bid; item < 16; item += nb) {
    if (item < 8) gla_naive(p, w, item >> 2, item & 3, lds); else mlstm_naive(p, w, (item - 8) >> 2, item & 3, lds);
    __syncthreads();
  }
}


typedef short bf16x8 __attribute__((ext_vector_type(8)));
typedef float f32x4 __attribute__((ext_vector_type(4)));
#define MFMA16(a, b, c) __builtin_amdgcn_mfma_f32_16x16x32_bf16(a, b, c, 0, 0, 0)
constexpr int L_GLR = 0, L_TOT = 4096, L_F = 6144, L_DEN = 6656, L_PART = 6912, L_QS = 9216, L_KS = 26624, L_P = 44032, L_NL = 53248, L_KDT = 9216;
constexpr int QS_LD = 136, P_LD = 72, KDT_LD = 72;

__device__ __forceinline__ void gla_gates(const Params& p, const WS& w, int h, size_t tb, unsigned char* ldsb, int tid, float* bv, float& blast) {
  float* glrs = (float*)(ldsb + L_GLR); float* tot = (float*)(ldsb + L_TOT);
  const int d = tid & 127, tg = tid >> 7;
  if (tid < 128) { float f[8]; unpack8(*(const uint4*)(w.proj + (tb + (tid >> 1)) * NPROJ + C_SM + (tid & 1) * 8), f);
#pragma unroll
    for (int j = 0; j < 8; ++j) glrs[(tid >> 1) * 16 + (tid & 1) * 8 + j] = f[j]; }
  float gu[16];
#pragma unroll
  for (int r = 0; r < 16; ++r) gu[r] = p.gate_up[r * 512 + h * 128 + d];
  const float gb = p.gate_bias[h * 128 + d];
  __syncthreads();
  float run = 0.f;
#pragma unroll
  for (int i = 0; i < 16; ++i) { const float* gl = glrs + (tg * 16 + i) * 16; float z = gb;
#pragma unroll
    for (int r4 = 0; r4 < 4; ++r4) { const float4 g4 = *(const float4*)(gl + r4 * 4); z += g4.x * gu[r4 * 4] + g4.y * gu[r4 * 4 + 1] + g4.z * gu[r4 * 4 + 2] + g4.w * gu[r4 * 4 + 3]; }
    run += logsigmoidf_(z) * (1.f / 16.f); bv[i] = run; }
  tot[tg * 128 + d] = run;
  __syncthreads();
  float off = 0.f; blast = 0.f;
#pragma unroll
  for (int g = 0; g < 4; ++g) { const float t = tot[g * 128 + d]; blast += t; if (g < tg) off += t; }
#pragma unroll
  for (int i = 0; i < 16; ++i) bv[i] += off;
}
__device__ __forceinline__ void mlstm_gates(const Params& p, const WS& w, int h, size_t tb, unsigned char* ldsb, int tid) {
  float* Fl = (float*)(ldsb + L_F);
  if (tid < 64) { const float mi = bf2f(w.proj[(tb + tid) * NPROJ + C_SM + 16 + h]), mf = bf2f(w.proj[(tb + tid) * NPROJ + C_SM + 20 + h]);
    float f = logsigmoidf_(mf + p.fg_bias[h]);
#pragma unroll
    for (int o = 1; o < 64; o <<= 1) { const float t = __shfl_up(f, o); if (tid >= o) f += t; }
    Fl[tid] = f; Fl[64 + tid] = mi + p.ig_bias[h]; }
  __syncthreads();
}
__device__ __forceinline__ void mlstm_conv16(const Params& p, const WS& w, int col, int cch, int b, int c, int tg, float scale, float* out) {
  float win[19];
  const int s0 = c * 64 + tg * 16 - 3;
#pragma unroll
  for (int m = 0; m < 19; ++m) { const int sp = s0 + m; win[m] = (sp >= 0) ? bf2f(w.proj[((size_t)b * SEQ + sp) * NPROJ + col]) : 0.f; }
  const float c0 = p.conv_w[cch], c1 = p.conv_w[1024 + cch], c2 = p.conv_w[2048 + cch], c3 = p.conv_w[3072 + cch], cb = p.conv_b[cch];
#pragma unroll
  for (int i = 0; i < 16; ++i) out[i] = siluf_(cb + c0 * win[i] + c1 * win[i + 1] + c2 * win[i + 2] + c3 * win[i + 3]) * scale;
}

template <int KIND>
__device__ void mix_local(const Params& p, const WS& w, int b, int h, int c, int item, unsigned char* ldsb) {
  const int tid = tidx(), lane = tid & 63, wave = tid >> 6, fr = lane & 15, fq = lane >> 4, d = tid & 127, tg = tid >> 7;
  const size_t tb = (size_t)b * SEQ + (size_t)c * 64;
  float* tot = (float*)(ldsb + L_TOT); const float* Fl = (const float*)(ldsb + L_F);
  bf16_t* kdT = (bf16_t*)(ldsb + L_KDT);
  float wgt[16], kv[16];
  if (KIND == 0) {
    float bv[16], blast; gla_gates(p, w, h, tb, ldsb, tid, bv, blast);
#pragma unroll
    for (int i = 0; i < 16; ++i) { wgt[i] = __expf(blast - bv[i]); kv[i] = bf2f(w.proj[(tb + tg * 16 + i) * NPROJ + C_GK + h * 128 + d]); }
    if (tg == 0) w.gdec[(size_t)item * 128 + d] = __expf(blast);
  } else {
    mlstm_gates(p, w, h, tb, ldsb, tid);
    const float flast = Fl[63];
#pragma unroll
    for (int i = 0; i < 16; ++i) wgt[i] = __expf(flast - Fl[tg * 16 + i] + Fl[64 + tg * 16 + i]);
    mlstm_conv16(p, w, C_MK + h * 128 + d, 512 + h * 128 + d, b, c, tg, 0.08838834764831845f, kv);
    if (tid == 0) w.mdec[item - 2048] = __expf(flast);
  }
  float un = 0.f; float kd[16];
#pragma unroll
  for (int i = 0; i < 16; ++i) { kd[i] = kv[i] * wgt[i]; un += kd[i]; }
  *(uint4*)(kdT + d * KDT_LD + tg * 16) = pack8(kd); *(uint4*)(kdT + d * KDT_LD + tg * 16 + 8) = pack8(kd + 8);
  if (KIND == 1) tot[tg * 128 + d] = un;
  __syncthreads();
  if (KIND == 1 && tg == 0) w.mn[(size_t)(item - 2048) * 128 + d] = tot[d] + tot[128 + d] + tot[256 + d] + tot[384 + d];
  const bf16_t* vrow = w.vT + (size_t)(KIND * 1024 + h * 256 + wave * 32 + fr) * T + tb + fq * 8;
  f32x4 acc[2][8];
#pragma unroll
  for (int yt = 0; yt < 2; ++yt)
#pragma unroll
    for (int xt = 0; xt < 8; ++xt) acc[yt][xt] = (f32x4){0.f, 0.f, 0.f, 0.f};
#pragma unroll
  for (int ks = 0; ks < 2; ++ks) {
    const bf16x8 y0 = *(const bf16x8*)(vrow + ks * 32), y1 = *(const bf16x8*)(vrow + (size_t)16 * T + ks * 32);
#pragma unroll
    for (int xt = 0; xt < 8; ++xt) { const bf16x8 xk = *(const bf16x8*)(kdT + (xt * 16 + fr) * KDT_LD + ks * 32 + fq * 8);
      acc[0][xt] = MFMA16(xk, y0, acc[0][xt]); acc[1][xt] = MFMA16(xk, y1, acc[1][xt]); }
  }
  bf16_t* S = (bf16_t*)p.out + (size_t)item * 32768;
#pragma unroll
  for (int yt = 0; yt < 2; ++yt)
#pragma unroll
    for (int xt = 0; xt < 8; ++xt) *(uint2*)(S + (wave * 32 + yt * 16 + fr) * 128 + xt * 16 + 4 * fq) = make_uint2(pack2(acc[yt][xt][0], acc[yt][xt][1]), pack2(acc[yt][xt][2], acc[yt][xt][3]));
  __syncthreads();
}

__device__ void mix_scan(const Params& p, const WS& w, int bid, int nb) {
  bf16_t* sbuf = (bf16_t*)p.out;
  for (int g = bid * 512 + tidx(); g < 16 * 8192; g += nb * 512) {
    const int combo = g >> 13, e = (g & 8191) * 4, dk = e & 127;
    bf16_t* base = sbuf + (size_t)combo * 256 * 32768 + e;
    float S0 = 0.f, S1 = 0.f, S2 = 0.f, S3 = 0.f;
    for (int c0 = 0; c0 < 256; c0 += 8) {
      uint2 u[8]; float4 dc[8];
#pragma unroll
      for (int k = 0; k < 8; ++k) { u[k] = *(const uint2*)(base + (size_t)(c0 + k) * 32768);
        if (combo < 8) dc[k] = *(const float4*)(w.gdec + (size_t)(combo * 256 + c0 + k) * 128 + dk);
        else { const float m = w.mdec[(combo - 8) * 256 + c0 + k]; dc[k] = make_float4(m, m, m, m); } }
#pragma unroll
      for (int k = 0; k < 8; ++k) { *(uint2*)(base + (size_t)(c0 + k) * 32768) = make_uint2(pack2(S0, S1), pack2(S2, S3));
        S0 = dc[k].x * S0 + lo_f(u[k].x); S1 = dc[k].y * S1 + hi_f(u[k].x); S2 = dc[k].z * S2 + lo_f(u[k].y); S3 = dc[k].w * S3 + hi_f(u[k].y); }
    }
  }
  for (int g = bid * 512 + tidx(); g < 8 * 128; g += nb * 512) {
    const int cb = g >> 7, d = g & 127; float n = 0.f;
    for (int c = 0; c < 256; ++c) { float* q = w.mn + (size_t)(cb * 256 + c) * 128 + d; const float u = *q; *q = n; n = w.mdec[cb * 256 + c] * n + u; }
  }
}

template <int KIND>
__device__ void mix_out(const Params& p, const WS& w, int b, int h, int c, int item, unsigned char* ldsb) {
  const int tid = tidx(), lane = tid & 63, wave = tid >> 6, fr = lane & 15, fq = lane >> 4, d = tid & 127, tg = tid >> 7;
  const size_t tb = (size_t)b * SEQ + (size_t)c * 64;
  const float* Fl = (const float*)(ldsb + L_F); float* denl = (float*)(ldsb + L_DEN); float* part = (float*)(ldsb + L_PART); float* nl = (float*)(ldsb + L_NL);
  bf16_t* qs = (bf16_t*)(ldsb + L_QS); bf16_t* ks = (bf16_t*)(ldsb + L_KS); bf16_t* P = (bf16_t*)(ldsb + L_P);
  {
    float qm[16], km[16], qv[16], kv[16];
    if (KIND == 0) {
      float bv[16], blast; gla_gates(p, w, h, tb, ldsb, tid, bv, blast);
#pragma unroll
      for (int i = 0; i < 16; ++i) { qm[i] = 0.08838834764831845f * __expf(bv[i]); km[i] = __expf(-bv[i]);
        qv[i] = bf2f(w.proj[(tb + tg * 16 + i) * NPROJ + C_GQ + h * 128 + d]); kv[i] = bf2f(w.proj[(tb + tg * 16 + i) * NPROJ + C_GK + h * 128 + d]); }
    } else {
      mlstm_gates(p, w, h, tb, ldsb, tid);
#pragma unroll
      for (int i = 0; i < 16; ++i) { const float F = Fl[tg * 16 + i]; qm[i] = __expf(F); km[i] = __expf(Fl[64 + tg * 16 + i] - F); }
      mlstm_conv16(p, w, C_MQ + h * 128 + d, h * 128 + d, b, c, tg, 1.f, qv);
      mlstm_conv16(p, w, C_MK + h * 128 + d, 512 + h * 128 + d, b, c, tg, 0.08838834764831845f, kv);
      if (tid < 128) nl[tid] = w.mn[(size_t)(item - 2048) * 128 + tid];
    }
#pragma unroll
    for (int i = 0; i < 16; ++i) { qs[(tg * 16 + i) * QS_LD + d] = f2bf(qv[i] * qm[i]); ks[(tg * 16 + i) * QS_LD + d] = f2bf(kv[i] * km[i]); }
  }
  __syncthreads();
#pragma unroll
  for (int q = 0; q < 2; ++q) { const int tt = wave * 2 + q, jt = tt >> 2, it = tt & 3; f32x4 a = (f32x4){0.f, 0.f, 0.f, 0.f};
#pragma unroll
    for (int k4 = 0; k4 < 4; ++k4) { const bf16x8 xk = *(const bf16x8*)(ks + (jt * 16 + fr) * QS_LD + k4 * 32 + fq * 8), yq = *(const bf16x8*)(qs + (it * 16 + fr) * QS_LD + k4 * 32 + fq * 8); a = MFMA16(xk, yq, a); }
    const int i = it * 16 + fr, j0 = jt * 16 + 4 * fq;
    const float v0 = (j0 <= i) ? a[0] : 0.f, v1 = (j0 + 1 <= i) ? a[1] : 0.f, v2 = (j0 + 2 <= i) ? a[2] : 0.f, v3 = (j0 + 3 <= i) ? a[3] : 0.f;
    *(uint2*)(P + i * P_LD + j0) = make_uint2(pack2(v0, v1), pack2(v2, v3)); }
  __syncthreads();
  if (KIND == 1) { const int i = tid >> 3, pt = tid & 7; float f[8]; float s = 0.f;
    unpack8(*(const uint4*)(P + i * P_LD + pt * 8), f);
#pragma unroll
    for (int j = 0; j < 8; ++j) s += f[j];
#pragma unroll
    for (int hh = 0; hh < 2; ++hh) { unpack8(*(const uint4*)(qs + i * QS_LD + pt * 16 + hh * 8), f);
#pragma unroll
      for (int j = 0; j < 8; ++j) s += f[j] * nl[pt * 16 + hh * 8 + j]; }
    s += __shfl_xor(s, 1); s += __shfl_xor(s, 2); s += __shfl_xor(s, 4);
    if (pt == 0) denl[i] = s; }
  f32x4 acc[2][4];
#pragma unroll
  for (int xt = 0; xt < 2; ++xt)
#pragma unroll
    for (int yt = 0; yt < 4; ++yt) acc[xt][yt] = (f32x4){0.f, 0.f, 0.f, 0.f};
  { const bf16_t* vrow = w.vT + (size_t)(KIND * 1024 + h * 256 + wave * 32 + fr) * T + tb + fq * 8;
#pragma unroll
    for (int k2 = 0; k2 < 2; ++k2) { const bf16x8 x0 = *(const bf16x8*)(vrow + k2 * 32), x1 = *(const bf16x8*)(vrow + (size_t)16 * T + k2 * 32);
#pragma unroll
      for (int yt = 0; yt < 4; ++yt) { const bf16x8 yp = *(const bf16x8*)(P + (yt * 16 + fr) * P_LD + k2 * 32 + fq * 8); acc[0][yt] = MFMA16(x0, yp, acc[0][yt]); acc[1][yt] = MFMA16(x1, yp, acc[1][yt]); } }
    const bf16_t* srow = (const bf16_t*)p.out + (size_t)item * 32768 + (wave * 32 + fr) * 128 + fq * 8;
#pragma unroll
    for (int k4 = 0; k4 < 4; ++k4) { const bf16x8 x0 = *(const bf16x8*)(srow + k4 * 32), x1 = *(const bf16x8*)(srow + 16 * 128 + k4 * 32);
#pragma unroll
      for (int yt = 0; yt < 4; ++yt) { const bf16x8 yq = *(const bf16x8*)(qs + (yt * 16 + fr) * QS_LD + k4 * 32 + fq * 8); acc[0][yt] = MFMA16(x0, yq, acc[0][yt]); acc[1][yt] = MFMA16(x1, yq, acc[1][yt]); } } }
  if (KIND == 1) __syncthreads();
#pragma unroll
  for (int yt = 0; yt < 4; ++yt) { float s = 0.f;
    if (KIND == 1) { const float inv = 1.f / fmaxf(fabsf(denl[yt * 16 + fr]), 1.f); acc[0][yt] *= inv; acc[1][yt] *= inv; }
#pragma unroll
    for (int xt = 0; xt < 2; ++xt)
#pragma unroll
      for (int r = 0; r < 4; ++r) s += acc[xt][yt][r] * acc[xt][yt][r];
    s += __shfl_xor(s, 16); s += __shfl_xor(s, 32);
    if (fq == 0) part[wave * 64 + yt * 16 + fr] = s; }
  __syncthreads();
  const float* gain = (KIND == 0 ? p.gla_norm : p.mlstm_norm) + h * 256;
#pragma unroll
  for (int yt = 0; yt < 4; ++yt) { const int i = yt * 16 + fr; float t = 0.f;
#pragma unroll
    for (int ww = 0; ww < 8; ++ww) t += part[ww * 64 + i];
    const float rs = rsqrtf(t * (1.f / 256.f) + EPS);
#pragma unroll
    for (int xt = 0; xt < 2; ++xt) { const int dv = wave * 32 + xt * 16 + 4 * fq;
      const uint2 gt = *(const uint2*)(w.proj + (tb + i) * NPROJ + (KIND == 0 ? C_GG : C_MO) + h * 256 + dv);
      const float4 gn = *(const float4*)(gain + dv);
      const float g0 = lo_f(gt.x), g1 = hi_f(gt.x), g2 = lo_f(gt.y), g3 = hi_f(gt.y);
      const float a0 = KIND == 0 ? siluf_(g0) : sigmoidf_(g0), a1 = KIND == 0 ? siluf_(g1) : sigmoidf_(g1), a2 = KIND == 0 ? siluf_(g2) : sigmoidf_(g2), a3 = KIND == 0 ? siluf_(g3) : sigmoidf_(g3);
      *(uint2*)(w.y + (tb + i) * D + KIND * 1024 + h * 256 + dv) = make_uint2(pack2(acc[xt][yt][0] * rs * gn.x * a0, acc[xt][yt][1] * rs * gn.y * a1), pack2(acc[xt][yt][2] * rs * gn.z * a2, acc[xt][yt][3] * rs * gn.w * a3)); } }
  __syncthreads();
}
template <int WHICH>
__device__ void phase_mix_items(const Params& p, const WS& w, unsigned char* ldsb, int bid, int nb) {
  for (int item = bid; item < 4096; item += nb) {
    const int kind = item >> 11, b = (item >> 10) & 1, h = (item >> 8) & 3, c = item & 255;
    if (WHICH == 0) { if (kind == 0) mix_local<0>(p, w, b, h, c, item, ldsb); else mix_local<1>(p, w, b, h, c, item, ldsb); }
    else { if (kind == 0) mix_out<0>(p, w, b, h, c, item, ldsb); else mix_out<1>(p, w, b, h, c, item, ldsb); }
  }
}

__device__ __forceinline__ unsigned sort16(unsigned b) { return (b & 0x8000u) ? (~b & 0xffffu) : (b | 0x8000u); }
__device__ __forceinline__ float unsort16(unsigned k) { const unsigned b = (k & 0x8000u) ? (k & 0x7fffu) : (~k & 0xffffu); return __uint_as_float(b << 16); }
__device__ __forceinline__ unsigned sort32(float f) { const unsigned u = __float_as_uint(f); return (u & 0x80000000u) ? ~u : (u | 0x80000000u); }
__device__ __forceinline__ float unsort32(unsigned k) { const unsigned u = (k & 0x80000000u) ? (k & 0x7fffffffu) : ~k; return __uint_as_float(u); }
__device__ void phase_topk(const Params& p, const WS& w, int bid, int nb) {
  for (int th = bid * 512 + tidx(); th < T * 8; th += nb * 512) {
    const int t = th >> 3, h = th & 7;
    const uint4* s = (const uint4*)(w.sc + (size_t)t * D + h * 256);
    unsigned l[2][16];
#pragma unroll
    for (int pp = 0; pp < 2; ++pp) {
#pragma unroll
      for (int i = 0; i < 16; ++i) l[pp][i] = 0u;
      for (int q = 0; q < 16; ++q) {
        const uint4 v = s[pp * 16 + q]; const unsigned wds[4] = {v.x, v.y, v.z, v.w};
#pragma unroll
        for (int e = 0; e < 8; ++e) {
          const unsigned b = (e & 1) ? (wds[e >> 1] >> 16) : (wds[e >> 1] & 0xffffu);
          unsigned x = (sort16(b) << 16) | (unsigned)(q * 8 + e);
#pragma unroll
          for (int i = 0; i < 16; ++i) { const unsigned hi = max(l[pp][i], x); x = min(l[pp][i], x); l[pp][i] = hi; }
        }
      }
    }
    unsigned long long lc[16];
#pragma unroll
    for (int i = 0; i < 16; ++i) lc[i] = 0ull;
#pragma unroll
    for (int i = 0; i < 16; ++i)
#pragma unroll
      for (int j = 0; j < 16; ++j) if ((i + 1) * (j + 1) <= 16) {
        const float sv = unsort16(l[0][i] >> 16) + unsort16(l[1][j] >> 16);
        unsigned long long x = ((unsigned long long)sort32(sv) << 32) | (unsigned long long)((l[0][i] & 0xffffu) * 128u + (l[1][j] & 0xffffu));
#pragma unroll
        for (int k = 0; k < 16; ++k) { const bool gt = x > lc[k]; const unsigned long long hi = gt ? x : lc[k]; x = gt ? lc[k] : x; lc[k] = hi; }
      }
    const float mx = unsort32((unsigned)(lc[0] >> 32));
    float e[16], sum = 0.f;
#pragma unroll
    for (int k = 0; k < 16; ++k) { e[k] = __expf(unsort32((unsigned)(lc[k] >> 32)) - mx); sum += e[k]; }
    const float inv = 1.f / sum;
    int* ei = w.eidx + (size_t)t * 128 + h * 16; float* eg = w.eg + (size_t)t * 128 + h * 16;
#pragma unroll
    for (int k4 = 0; k4 < 4; ++k4) {
      *(int4*)(ei + k4 * 4) = make_int4((int)(lc[k4 * 4] & 0xffffffffu), (int)(lc[k4 * 4 + 1] & 0xffffffffu), (int)(lc[k4 * 4 + 2] & 0xffffffffu), (int)(lc[k4 * 4 + 3] & 0xffffffffu));
      *(float4*)(eg + k4 * 4) = make_float4(e[k4 * 4] * inv, e[k4 * 4 + 1] * inv, e[k4 * 4 + 2] * inv, e[k4 * 4 + 3] * inv);
    }
  }
}
__device__ __forceinline__ void ub16(const uint4 q, float* f) {
  const unsigned wd[4] = {q.x, q.y, q.z, q.w};
#pragma unroll
  for (int k = 0; k < 4; ++k) { f[k * 4] = (float)(wd[k] & 0xffu); f[k * 4 + 1] = (float)((wd[k] >> 8) & 0xffu); f[k * 4 + 2] = (float)((wd[k] >> 16) & 0xffu); f[k * 4 + 3] = (float)(wd[k] >> 24); }
}
#ifndef PEER_G
#define PEER_G 2
#endif
__device__ void phase_peer(const Params& p, const WS& w, int bid, int nb) {
  const int tid = tidx(), wave = tid >> 6, lane = tid & 63;
  for (int t = bid * 8 + wave; t < T; t += nb * 8) {
    float hr[32], out[32];
#pragma unroll
    for (int i = 0; i < 2; ++i) { unpack8(*(const uint4*)(w.h1b + (size_t)t * D + i * 1024 + lane * 16), hr + i * 16); unpack8(*(const uint4*)(w.h1b + (size_t)t * D + i * 1024 + lane * 16 + 8), hr + i * 16 + 8); }
    float hs = 0.f;
#pragma unroll
    for (int i = 0; i < 32; ++i) { out[i] = 0.f; hs += hr[i]; }
    hs = wave_sum(hs) * 128.f;
    float wsum = 0.f;
    const float rs2 = rsqrtf(w.ssq2[t] * (1.f / D) + EPS);
    const int idx0 = w.eidx[(size_t)t * 128 + lane], idx1 = w.eidx[(size_t)t * 128 + 64 + lane];
    const float g0 = w.eg[(size_t)t * 128 + lane], g1 = w.eg[(size_t)t * 128 + 64 + lane];
    const float su0 = w.usc[idx0] * rs2, su1 = w.usc[idx1] * rs2, sv0 = w.vsc[idx0], sv1 = w.vsc[idx1];
    uint4 bA[PEER_G][4], bB[PEER_G][4];
#define PEER_LOAD(buf, n0) do { _Pragma("unroll") for (int q = 0; q < PEER_G; ++q) { const int n = (n0) + q; \
      const int e = __builtin_amdgcn_readlane((n & 64) ? idx1 : idx0, n & 63); \
      const unsigned char* ur = w.u8 + (size_t)e * D + lane * 16; const unsigned char* vr = w.v8 + (size_t)e * D + lane * 16; \
      buf[q][0] = *(const uint4*)ur; buf[q][1] = *(const uint4*)(ur + 1024); buf[q][2] = *(const uint4*)vr; buf[q][3] = *(const uint4*)(vr + 1024); } } while (0)
#define PEER_COMP(buf, n0) do { _Pragma("unroll") for (int q = 0; q < PEER_G; ++q) { const int n = (n0) + q; \
      const float g = __uint_as_float(__builtin_amdgcn_readlane(__float_as_uint((n & 64) ? g1 : g0), n & 63)); \
      const float su = __uint_as_float(__builtin_amdgcn_readlane(__float_as_uint((n & 64) ? su1 : su0), n & 63)); \
      const float sv = __uint_as_float(__builtin_amdgcn_readlane(__float_as_uint((n & 64) ? sv1 : sv0), n & 63)); \
      float f[16]; float s = 0.f; \
      ub16(buf[q][0], f); _Pragma("unroll") for (int j = 0; j < 16; ++j) s += f[j] * hr[j]; \
      ub16(buf[q][1], f); _Pragma("unroll") for (int j = 0; j < 16; ++j) s += f[j] * hr[16 + j]; \
      s = wave_sum(s); \
      const float wgt = g * gelu_tanh((s - hs) * su) * sv; wsum += wgt; \
      ub16(buf[q][2], f); _Pragma("unroll") for (int j = 0; j < 16; ++j) out[j] += wgt * f[j]; \
      ub16(buf[q][3], f); _Pragma("unroll") for (int j = 0; j < 16; ++j) out[16 + j] += wgt * f[j]; } } while (0)
    PEER_LOAD(bA, 0);
    for (int n0 = 0; n0 < 128; n0 += 2 * PEER_G) {
      PEER_LOAD(bB, n0 + PEER_G);
      PEER_COMP(bA, n0);
      if (n0 + 2 * PEER_G < 128) PEER_LOAD(bA, n0 + 2 * PEER_G);
      PEER_COMP(bB, n0 + PEER_G);
    }
#undef PEER_LOAD
#undef PEER_COMP
    float ss = 0.f; const float off = 128.f * wsum;
#pragma unroll
    for (int i = 0; i < 32; ++i) { out[i] += hr[i] - off; ss += out[i] * out[i]; }
    ss = wave_sum(ss);
#pragma unroll
    for (int i = 0; i < 2; ++i) { *(uint4*)(w.h2b + (size_t)t * D + i * 1024 + lane * 16) = pack8(out + i * 16); *(uint4*)(w.h2b + (size_t)t * D + i * 1024 + lane * 16 + 8) = pack8(out + i * 16 + 8); }
    if (lane == 0) w.rstd3[t] = rsqrtf(ss * (1.f / D) + EPS);
  }
}
__device__ void phase_final(const Params& p, const WS& w, int bid, int nb) {
  const int wave = tidx() >> 6, lane = tidx() & 63;
  for (int row = bid * 8 + wave; row < T; row += nb * 8) {
    float4* o = (float4*)(p.out + (size_t)row * D);
    const float rs = rsqrtf(w.ssq4[row] * (1.f / D) + EPS);
#pragma unroll
    for (int i = 0; i < 8; ++i) { float4 v = o[i * 64 + lane]; const float4 g = *(const float4*)(p.norm_final + (i * 64 + lane) * 4); v.x *= rs * g.x; v.y *= rs * g.y; v.z *= rs * g.z; v.w *= rs * g.w; o[i * 64 + lane] = v; }
  }
}

constexpr int NPHASE = 10;
#ifndef FAST_MIX
#define FAST_MIX 1
#endif
template <int PH>
__device__ __forceinline__ void run_phase(const Params& p, float* lds, int bid, int nb) {
  const WS w = make_ws(p.ws);
  if (PH == 0) phase_prep(p, w, lds, bid, nb);
  if (PH == 1) { gemm_any(w.xb, w.win, T, NPROJ, D, EpiProjN{w.proj, w.rstd1}, lds, bid, nb);
                 gemm_any(w.win + (size_t)NPROJ * D, w.xb, 2048, T, D, EpiProjT{w.vT, w.rstd1}, lds, bid, nb); }
#if FAST_MIX
  if (PH == 2) phase_mix_items<0>(p, w, (unsigned char*)lds, bid, nb);
  if (PH == 3) mix_scan(p, w, bid, nb);
  if (PH == 4) phase_mix_items<1>(p, w, (unsigned char*)lds, bid, nb);
#else
  if (PH == 2) phase_mixer_naive(p, w, lds, bid, nb);
#endif
  if (PH == 5) gemm_any(w.y, w.wout, T, D, D, EpiOut{p.x, w.h1b, w.ssq2}, lds, bid, nb);
  if (PH == 6) gemm_any(w.h1b, w.wq, T, D, D, EpiScore{w.sc, w.ssq2}, lds, bid, nb);
  if (PH == 7) { phase_topk(p, w, bid, nb); gemm_any(w.pb, w.wple, T, D, 256, EpiPl{w.pl}, lds, bid, nb); }
  if (PH == 8) phase_peer(p, w, bid, nb);
  if (PH == 9) gemm_any(w.h2b, w.wg, T, D, D, EpiGate{w.h2b, w.pl, w.rstd3, p.out, w.ssq4}, lds, bid, nb);
  if (PH == 10) phase_final(p, w, bid, nb);
}

extern __shared__ __attribute__((aligned(16))) unsigned char dyn_lds[];

#if ONE_LAUNCH
__global__ void __launch_bounds__(512, 2) mega(Params p) {
  cg::grid_group grid = cg::this_grid();
  float* lds = (float*)dyn_lds; const int bid = blockIdx.x, nb = gridDim.x;
#ifndef DUP_PHASE
#define DUP_PHASE -1
#endif
#define RUNP(k) do { run_phase<k>(p, lds, bid, nb); if (DUP_PHASE == (k)) { grid.sync(); run_phase<k>(p, lds, bid, nb); } } while (0)
  RUNP(0); grid.sync();
  RUNP(1); grid.sync();
  RUNP(2); grid.sync();
#if FAST_MIX
  RUNP(3); grid.sync();
  RUNP(4); grid.sync();
#endif
  RUNP(5); grid.sync();
  RUNP(6); grid.sync();
  RUNP(7); grid.sync();
  RUNP(8); grid.sync();
  RUNP(9); grid.sync();
  RUNP(10);
#undef RUNP
}
#else
template <int PH> __global__ void __launch_bounds__(512, 2) k_phase(Params p) { run_phase<PH>(p, (float*)dyn_lds, blockIdx.x, gridDim.x); }
#endif

constexpr size_t kDynLds = 131072;

extern "C" void kernel_launch(void* const* d_in, const int* in_sizes, int n_in, void* d_out, int out_size, void* d_ws, size_t ws_size, hipStream_t stream) {
  if (n_in != 22 || out_size != T * D || ws_size < WS_NEED) { fprintf(stderr, "kernel_launch: unexpected shapes (n_in %d out %d ws %zu)\n", n_in, out_size, ws_size); return; }
  Params p{};
  const float** f = (const float**)&p;
  for (int i = 0; i < 22; ++i) f[i] = (const float*)d_in[i];
  p.out = (float*)d_out; p.ws = (unsigned char*)d_ws;
#if ONE_LAUNCH
  static int grid_blocks = 0;
  if (!grid_blocks) {
    int dev = 0, cus = 0, per_cu = 0;
    (void)hipGetDevice(&dev); (void)hipDeviceGetAttribute(&cus, hipDeviceAttributeMultiprocessorCount, dev);
    (void)hipFuncSetAttribute((const void*)mega, hipFuncAttributeMaxDynamicSharedMemorySize, (int)kDynLds);
    (void)hipOccupancyMaxActiveBlocksPerMultiprocessor(&per_cu, mega, 512, kDynLds);
    if (per_cu < 1) { fprintf(stderr, "occupancy query says 0 blocks/CU\n"); per_cu = 1; }
    grid_blocks = cus;
  }
  void* args[] = {&p};
  hipError_t e = hipLaunchCooperativeKernel((void*)mega, dim3(grid_blocks), dim3(512), args, kDynLds, stream);
  if (e != hipSuccess) fprintf(stderr, "cooperative launch failed: %s (grid %d)\n", hipGetErrorString(e), grid_blocks);
#else
  static bool attr = false;
  const int G = 256;
#define LAUNCH(PH) do { if (!attr) (void)hipFuncSetAttribute((const void*)k_phase<PH>, hipFuncAttributeMaxDynamicSharedMemorySize, (int)kDynLds); \
    hipLaunchKernelGGL(k_phase<PH>, dim3(G), dim3(512), kDynLds, stream, p); } while (0)
  LAUNCH(0); LAUNCH(1); LAUNCH(2); LAUNCH(3); LAUNCH(4); LAUNCH(5); LAUNCH(6); LAUNCH(7); LAUNCH(8); LAUNCH(9); LAUNCH(10);
  attr = true;
#undef LAUNCH
#endif
}
```

```cpp
#include <hip/hip_runtime.h>
#include <hip/hip_cooperative_groups.h>
#include <cstdio>
#include <cstdint>
namespace cg = cooperative_groups;

#ifndef ONE_LAUNCH
#define ONE_LAUNCH 1
#endif

typedef unsigned short bf16_t;
constexpr int T = 32768, SEQ = 16384, D = 2048;
constexpr int NPROJ = 4352;
constexpr int C_GQ = 0, C_GK = 512, C_GG = 1024, C_MQ = 2048, C_MK = 2560, C_MO = 3072, C_SM = 4096;
constexpr float EPS = 1e-6f;
constexpr size_t MiB = 1ull << 20;
constexpr size_t OFF_XB = 0, OFF_Y = 0, OFF_PL = 0;
constexpr size_t OFF_PROJ = 128 * MiB, OFF_H1B = 128 * MiB, OFF_H2B = 256 * MiB;
constexpr size_t OFF_VT = 400 * MiB, OFF_SC = 400 * MiB;
constexpr size_t OFF_UB = 528 * MiB, OFF_VB = 592 * MiB;
constexpr size_t OFF_WIN = 656 * MiB, OFF_WOUT = 681 * MiB, OFF_WQ = 689 * MiB, OFF_WG = 697 * MiB, OFF_WPLE = 705 * MiB;
constexpr size_t OFF_PB = 706 * MiB, OFF_EIDX = 722 * MiB, OFF_EG = 738 * MiB, OFF_MISC = 754 * MiB;
constexpr size_t OFF_GDEC = 755 * MiB, OFF_MN = 756 * MiB, OFF_MDEC = 757 * MiB, OFF_ESC = 758 * MiB;
constexpr size_t WS_NEED = 760 * MiB;

struct Params {
  const float *x, *p, *norm_mix, *w_in, *gate_up, *gate_bias, *gla_norm, *conv_w, *conv_b, *ig_bias, *fg_bias, *mlstm_norm,
      *w_out, *norm_ffn, *peer_query, *sub_keys, *peer_u, *peer_v, *norm_ple, *w_ple, *w_ple_gate, *norm_final;
  float* out;
  unsigned char* ws;
};

__device__ __forceinline__ float bf2f(bf16_t b) { return __uint_as_float(((unsigned)b) << 16); }
typedef __bf16 bf16v2_t __attribute__((ext_vector_type(2)));
__device__ __forceinline__ bf16_t f2bf(float f) { const __bf16 b = (__bf16)f; return __builtin_bit_cast(bf16_t, b); }
__device__ __forceinline__ unsigned pack2(float lo, float hi) { const bf16v2_t v = {(__bf16)lo, (__bf16)hi}; return __builtin_bit_cast(unsigned, v); }
__device__ __forceinline__ float lo_f(unsigned u) { return __uint_as_float(u << 16); }
__device__ __forceinline__ float hi_f(unsigned u) { return __uint_as_float(u & 0xffff0000u); }
__device__ __forceinline__ float wave_sum(float v) {
#pragma unroll
  for (int o = 32; o >= 1; o >>= 1) v += __shfl_xor(v, o);
  return v;
}
__device__ __forceinline__ int tidx() { int t = threadIdx.x; asm volatile("" : "+v"(t)); return t; }
__device__ __forceinline__ float sigmoidf_(float x) { return __builtin_amdgcn_rcpf(1.f + __expf(-x)); }
__device__ __forceinline__ float siluf_(float x) { return x * __builtin_amdgcn_rcpf(1.f + __expf(-x)); }
__device__ __forceinline__ float logsigmoidf_(float x) { return fminf(x, 0.f) - __logf(1.f + __expf(-fabsf(x))); }
__device__ __forceinline__ float gelu_tanh(float x) { const float u = 0.7978845608028654f * (x + 0.044715f * x * x * x); return x * __builtin_amdgcn_rcpf(1.f + __expf(-2.f * u)); }
__device__ __forceinline__ void unpack8(const uint4 q, float* f) {
  f[0] = lo_f(q.x); f[1] = hi_f(q.x); f[2] = lo_f(q.y); f[3] = hi_f(q.y); f[4] = lo_f(q.z); f[5] = hi_f(q.z); f[6] = lo_f(q.w); f[7] = hi_f(q.w);
}
__device__ __forceinline__ uint4 pack8(const float* f) { return make_uint4(pack2(f[0], f[1]), pack2(f[2], f[3]), pack2(f[4], f[5]), pack2(f[6], f[7])); }

struct WS {
  bf16_t *xb, *y, *pl, *proj, *h1b, *h2b, *vT, *sc, *ub, *vb, *win, *wout, *wq, *wg, *wple, *pb;
  int* eidx; float* eg; float *rstd1, *ssq2, *ssq3, *ssq4, *wsum, *gdec, *mn, *mdec, *usc, *vsc, *pd;
  unsigned char *u8, *v8;
};
__device__ __forceinline__ WS make_ws(unsigned char* ws, float* out) {
  WS w;
  w.xb = (bf16_t*)(ws + OFF_XB); w.y = (bf16_t*)(ws + OFF_Y); w.pl = (bf16_t*)(ws + OFF_PL); w.proj = (bf16_t*)(ws + OFF_PROJ);
  w.h1b = (bf16_t*)(ws + OFF_H1B); w.h2b = (bf16_t*)(ws + OFF_H2B); w.vT = (bf16_t*)(ws + OFF_VT); w.sc = (bf16_t*)(ws + OFF_SC);
  w.ub = (bf16_t*)(ws + OFF_UB); w.vb = (bf16_t*)(ws + OFF_VB); w.win = (bf16_t*)(ws + OFF_WIN); w.wout = (bf16_t*)(ws + OFF_WOUT);
  w.wq = (bf16_t*)(ws + OFF_WQ); w.wg = (bf16_t*)(ws + OFF_WG); w.wple = (bf16_t*)(ws + OFF_WPLE); w.pb = (bf16_t*)(ws + OFF_PB);
  w.eidx = (int*)(ws + OFF_EIDX); w.eg = (float*)(ws + OFF_EG);
  float* m = (float*)(ws + OFF_MISC); w.rstd1 = m; w.ssq2 = m + T; w.ssq3 = m + 2 * T; w.ssq4 = m + 3 * T; w.wsum = m + 4 * T;
  w.gdec = (float*)(ws + OFF_GDEC); w.mn = (float*)(ws + OFF_MN); w.mdec = (float*)(ws + OFF_MDEC);
  w.usc = (float*)(ws + OFF_ESC); w.vsc = w.usc + 16384; w.u8 = ws + OFF_UB; w.v8 = ws + OFF_VB; w.pd = out;
  return w;
}

__device__ void prep_x(const Params& p, const WS& w, int bid, int nb) {
  const int wave = tidx() >> 6, lane = tidx() & 63;
  for (int row = bid * 8 + wave; row < T; row += nb * 8) {
    const float4* src = (const float4*)(p.x + (size_t)row * D);
    uint2* dst = (uint2*)(w.xb + (size_t)row * D);
    float ss = 0.f;
#pragma unroll
    for (int i = 0; i < 8; ++i) { const float4 v = src[i * 64 + lane]; ss += v.x * v.x + v.y * v.y + v.z * v.z + v.w * v.w; dst[i * 64 + lane] = make_uint2(pack2(v.x, v.y), pack2(v.z, v.w)); }
    ss = wave_sum(ss);
    if (lane == 0) w.rstd1[row] = rsqrtf(ss * (1.f / D) + EPS);
  }
}
__device__ void cvt_rows(const float* src, bf16_t* dst, size_t n, const float* gain, int ncols, int bid, int nb) {
  const size_t n4 = n / 4;
  for (size_t i = (size_t)bid * 512 + tidx(); i < n4; i += (size_t)nb * 512) {
    float4 v = ((const float4*)src)[i];
    if (gain) { const float4 g = *(const float4*)(gain + (int)((i * 4) % (size_t)ncols)); v.x *= g.x; v.y *= g.y; v.z *= g.z; v.w *= g.w; }
    ((uint2*)dst)[i] = make_uint2(pack2(v.x, v.y), pack2(v.z, v.w));
  }
}
template <class CM>
__device__ void transpose_w(const float* src, int K, int ldsrc, bf16_t* dst, int Ndst, const float* gain, CM cm, float* lds, int bid, int nb) {
  const int tid = tidx(), tk = K / 64, ntile = (Ndst / 64) * tk;
  for (int tile = bid; tile < ntile; tile += nb) {
    const int n0 = (tile / tk) * 64, k0 = (tile % tk) * 64;
    const int nc = tid & 63, sc = cm(n0 + nc);
#pragma unroll
    for (int i = 0; i < 8; ++i) { const int kr = (tid >> 6) + 8 * i; float v = 0.f; if (sc >= 0) { v = src[(size_t)(k0 + kr) * ldsrc + sc]; if (gain) v *= gain[k0 + kr]; } lds[kr * 65 + nc] = v; }
    __syncthreads();
    { const int nr = tid >> 3, ks = (tid & 7) * 8; float f[8];
#pragma unroll
      for (int j = 0; j < 8; ++j) f[j] = lds[(ks + j) * 65 + nr];
      *(uint4*)(dst + (size_t)(n0 + nr) * K + k0 + ks) = pack8(f); }
    __syncthreads();
  }
}
struct CmIdent { __device__ int operator()(int n) const { return n; } };
struct CmWin {
  __device__ int operator()(int n) const {
    if (n < 1024) return n;
    if (n < 2048) return 2048 + (n - 1024);
    if (n < 2560) return 3088 + (n - 2048);
    if (n < 3072) return 3600 + (n - 2560);
    if (n < 4096) return 5136 + (n - 3072);
    if (n < 4352) { const int i = n - 4096; if (i < 16) return 3072 + i; if (i < 20) return 6160 + (i - 16); if (i < 24) return 6164 + (i - 20); return -1; }
    const int j = n - 4352; if (j < 1024) return 1024 + j;
    return 4112 + (j - 1024);
  }
};
__device__ void prep_wq(const Params& p, const WS& w, float* lds, int bid, int nb) {
  const int tid = tidx();
  float* SKs = lds;
  float* WQs = lds + 128 * 132;
  for (int item = bid; item < 16 * 32; item += nb) {
    const int hp = item >> 5, k0 = (item & 31) * 64;
#pragma unroll
    for (int i = 0; i < 8; ++i) { const int e4 = tid + 512 * i, key = e4 >> 5, d4 = (e4 & 31) * 4; *(float4*)(SKs + key * 132 + d4) = *(const float4*)(p.sub_keys + (size_t)hp * 16384 + key * 128 + d4); }
#pragma unroll
    for (int i = 0; i < 4; ++i) { const int e4 = tid + 512 * i, kr = e4 >> 5, d4 = (e4 & 31) * 4; float4 v = *(const float4*)(p.peer_query + (size_t)(k0 + kr) * 2048 + hp * 128 + d4); const float g = p.norm_ffn[k0 + kr]; v.x *= g; v.y *= g; v.z *= g; v.w *= g; *(float4*)(WQs + kr * 132 + d4) = v; }
    __syncthreads();
    const int k = tid & 63, kg = tid >> 6;
    float acc[16];
#pragma unroll
    for (int j = 0; j < 16; ++j) acc[j] = 0.f;
    for (int d4 = 0; d4 < 32; ++d4) {
      const float4 a = *(const float4*)(WQs + k * 132 + d4 * 4);
#pragma unroll
      for (int j = 0; j < 16; ++j) { const float4 s = *(const float4*)(SKs + (kg * 16 + j) * 132 + d4 * 4); acc[j] += a.x * s.x + a.y * s.y + a.z * s.z + a.w * s.w; }
    }
#pragma unroll
    for (int j = 0; j < 16; ++j) w.wq[(size_t)(hp * 128 + kg * 16 + j) * 2048 + k0 + k] = f2bf(acc[j]);
    __syncthreads();
  }
}

#ifndef PEER_SLW
#define PEER_SLW 256
#endif
constexpr int SLW = PEER_SLW, LPR = SLW / 16, EPI = 64 / LPR, NSL = 2048 / SLW, SPL = NSL / 8, NIT = 128 / EPI;
template <bool SIGNED>
__device__ void quant_rows(const float* src, const float* gain, unsigned char* dst, float* scale, int bid, int nb) {
  const int tid = tidx(), wave = tid >> 6, lane = tid & 63;
  for (int row = bid * 8 + wave; row < 16384; row += nb * 8) {
    float f[32]; float mx = 0.f;
#pragma unroll
    for (int i = 0; i < 2; ++i)
#pragma unroll
      for (int q = 0; q < 4; ++q) { float4 v = *(const float4*)(src + (size_t)row * 2048 + i * 1024 + lane * 16 + q * 4);
        if (gain) { const float4 g = *(const float4*)(gain + i * 1024 + lane * 16 + q * 4); v.x *= g.x; v.y *= g.y; v.z *= g.z; v.w *= g.w; }
        f[i * 16 + q * 4] = v.x; f[i * 16 + q * 4 + 1] = v.y; f[i * 16 + q * 4 + 2] = v.z; f[i * 16 + q * 4 + 3] = v.w;
        mx = fmaxf(mx, fmaxf(fmaxf(fabsf(v.x), fabsf(v.y)), fmaxf(fabsf(v.z), fabsf(v.w)))); }
#pragma unroll
    for (int o = 32; o >= 1; o >>= 1) mx = fmaxf(mx, __shfl_xor(mx, o));
    const float sc = fmaxf(mx, 1e-30f) * (1.f / 127.f), inv = 1.f / sc;
#pragma unroll
    for (int i = 0; i < 2; ++i) { unsigned wd[4];
#pragma unroll
      for (int q = 0; q < 4; ++q) { unsigned x = 0;
#pragma unroll
        for (int j = 0; j < 4; ++j) { const int v = (int)rintf(f[i * 16 + q * 4 + j] * inv) + (SIGNED ? 0 : 128); x |= ((unsigned)v & 0xffu) << (8 * j); }
        wd[q] = x; }
      const int el = i * 1024 + lane * 16;
      *(uint4*)(dst + ((size_t)(el / SLW) * 16384 + row) * SLW + (el % SLW)) = make_uint4(wd[0], wd[1], wd[2], wd[3]); }
    if (lane == 0) scale[row] = sc;
  }
}
__device__ void phase_prep(const Params& p, const WS& w, float* lds, int bid, int nb) {
  prep_x(p, w, bid, nb);
  cvt_rows(p.p, w.pb, (size_t)T * 256, nullptr, 256, bid, nb);
  quant_rows<true>(p.peer_u, p.norm_ffn, w.u8, w.usc, bid, nb);
  quant_rows<false>(p.peer_v, nullptr, w.v8, w.vsc, bid, nb);
  transpose_w(p.w_in, 2048, 6168, w.win, 6400, p.norm_mix, CmWin(), lds, bid, nb);
  transpose_w(p.w_out, 2048, 2048, w.wout, 2048, nullptr, CmIdent(), lds, bid, nb);
  transpose_w(p.w_ple_gate, 2048, 2048, w.wg, 2048, p.norm_ple, CmIdent(), lds, bid, nb);
  transpose_w(p.w_ple, 256, 2048, w.wple, 2048, nullptr, CmIdent(), lds, bid, nb);
  prep_wq(p, w, lds, bid, nb);
  for (int i = bid * 512 + tidx(); i < T; i += nb * 512) { w.ssq2[i] = 0.f; w.ssq3[i] = 0.f; w.ssq4[i] = 0.f; }
}

struct EpiProjN { bf16_t* out; const float* rstd; static constexpr bool ROWSUM = false;
  __device__ __forceinline__ float store8(int r, int c, const float* v) const { const float s = rstd[r]; float f[8];
#pragma unroll
    for (int j = 0; j < 8; ++j) f[j] = v[j] * s;
    *(uint4*)(out + (size_t)r * NPROJ + c) = pack8(f); return 0.f; }
  __device__ __forceinline__ void rowsum(int, float) const {} };
struct EpiProjT { bf16_t* out; const float* rstd; static constexpr bool ROWSUM = false;
  __device__ __forceinline__ float store8(int r, int c, const float* v) const { const float4 s0 = *(const float4*)(rstd + c), s1 = *(const float4*)(rstd + c + 4); float f[8];
    f[0] = v[0] * s0.x; f[1] = v[1] * s0.y; f[2] = v[2] * s0.z; f[3] = v[3] * s0.w; f[4] = v[4] * s1.x; f[5] = v[5] * s1.y; f[6] = v[6] * s1.z; f[7] = v[7] * s1.w;
    *(uint4*)(out + (size_t)r * T + c) = pack8(f); return 0.f; }
  __device__ __forceinline__ void rowsum(int, float) const {} };
struct EpiOut { const float* x; bf16_t* h1b; float* ssq; static constexpr bool ROWSUM = true;
  __device__ __forceinline__ float store8(int r, int c, const float* v) const { const float4 x0 = *(const float4*)(x + (size_t)r * D + c), x1 = *(const float4*)(x + (size_t)r * D + c + 4); float f[8];
    f[0] = v[0] + x0.x; f[1] = v[1] + x0.y; f[2] = v[2] + x0.z; f[3] = v[3] + x0.w; f[4] = v[4] + x1.x; f[5] = v[5] + x1.y; f[6] = v[6] + x1.z; f[7] = v[7] + x1.w;
    float s = 0.f;
#pragma unroll
    for (int j = 0; j < 8; ++j) s += f[j] * f[j];
    *(uint4*)(h1b + (size_t)r * D + c) = pack8(f); return s; }
  __device__ __forceinline__ void rowsum(int r, float s) const { atomicAdd(ssq + r, s); } };
struct EpiScore { bf16_t* sc; const float* ssq; static constexpr bool ROWSUM = false;
  __device__ __forceinline__ float store8(int r, int c, const float* v) const { const float s = rsqrtf(ssq[r] * (1.f / D) + EPS); float f[8];
#pragma unroll
    for (int j = 0; j < 8; ++j) f[j] = v[j] * s;
    *(uint4*)(sc + (size_t)r * D + c) = pack8(f); return 0.f; }
  __device__ __forceinline__ void rowsum(int, float) const {} };
struct EpiPl { bf16_t* pl; static constexpr bool ROWSUM = false;
  __device__ __forceinline__ float store8(int r, int c, const float* v) const { *(uint4*)(pl + (size_t)r * D + c) = pack8(v); return 0.f; }
  __device__ __forceinline__ void rowsum(int, float) const {} };
struct EpiGate { const bf16_t* h2b; const bf16_t* pl; const float* ssq3; float* out; float* ssq; static constexpr bool ROWSUM = true;
  __device__ __forceinline__ float store8(int r, int c, const float* v) const { const float rs = rsqrtf(ssq3[r] * (1.f / D) + EPS); float h[8], q[8], f[8];
    unpack8(*(const uint4*)(h2b + (size_t)r * D + c), h); unpack8(*(const uint4*)(pl + (size_t)r * D + c), q);
    float s = 0.f;
#pragma unroll
    for (int j = 0; j < 8; ++j) { f[j] = h[j] + sigmoidf_(v[j] * rs) * q[j]; s += f[j] * f[j]; }
    *(float4*)(out + (size_t)r * D + c) = make_float4(f[0], f[1], f[2], f[3]); *(float4*)(out + (size_t)r * D + c + 4) = make_float4(f[4], f[5], f[6], f[7]); return s; }
  __device__ __forceinline__ void rowsum(int r, float s) const { atomicAdd(ssq + r, s); } };

template <class Epi>
__device__ void gemm_naive(const bf16_t* A, const bf16_t* Bt, int M, int N, int K, const Epi& E, float* lds, int bid, int nb) {
  const int tid = tidx(), ty = tid >> 4, tx = tid & 15;
  float* As = lds;
  float* Bs = lds + 32 * 132;
  const int nM = M / 128, nN = N / 128;
  for (int tile = bid; tile < nM * nN; tile += nb) {
    const int m0 = (tile % nM) * 128, n0 = (tile / nM) * 128;
    float acc[4][8];
#pragma unroll
    for (int i = 0; i < 4; ++i)
#pragma unroll
      for (int j = 0; j < 8; ++j) acc[i][j] = 0.f;
    const int lr = tid >> 2, lk = (tid & 3) * 8;
    for (int k0 = 0; k0 < K; k0 += 32) {
      const uint4 av = *(const uint4*)(A + (size_t)(m0 + lr) * K + k0 + lk);
      const uint4 bv = *(const uint4*)(Bt + (size_t)(n0 + lr) * K + k0 + lk);
      float af[8], bf[8]; unpack8(av, af); unpack8(bv, bf);
      __syncthreads();
#pragma unroll
      for (int j = 0; j < 8; ++j) { As[(lk + j) * 132 + lr] = af[j]; Bs[(lk + j) * 132 + lr] = bf[j]; }
      __syncthreads();
#pragma unroll 8
      for (int kk = 0; kk < 32; ++kk) {
        const float4 a = *(const float4*)(As + kk * 132 + ty * 4);
        const float4 b0 = *(const float4*)(Bs + kk * 132 + tx * 8), b1 = *(const float4*)(Bs + kk * 132 + tx * 8 + 4);
        const float aa[4] = {a.x, a.y, a.z, a.w}; const float bb[8] = {b0.x, b0.y, b0.z, b0.w, b1.x, b1.y, b1.z, b1.w};
#pragma unroll
        for (int i = 0; i < 4; ++i)
#pragma unroll
          for (int j = 0; j < 8; ++j) acc[i][j] += aa[i] * bb[j];
      }
    }
#pragma unroll
    for (int i = 0; i < 4; ++i) {
      const int r = m0 + ty * 4 + i;
      float s = E.store8(r, n0 + tx * 8, acc[i]);
      if (Epi::ROWSUM) { s += __shfl_xor(s, 1); s += __shfl_xor(s, 2); s += __shfl_xor(s, 4); s += __shfl_xor(s, 8); if (tx == 0) E.rowsum(r, s); }
    }
  }
}


namespace pg8 {
#define PG8_LAS __attribute__((address_space(3)))
typedef short bf16x8 __attribute__((ext_vector_type(8)));
typedef float f32x4 __attribute__((ext_vector_type(4)));
constexpr int BM = 256, BK = 64, HALF = 128, HTB = HALF * BK * 2, STAGE_BYTES = 8 * HTB, NXCD = 8, WGM = 8;
__host__ __device__ __forceinline__ int lds_byte(int r, int c) { const int st = (r >> 4) * 2 + (c >> 5), rr = r & 15, cc = c & 31, ob = rr * 64 + cc * 2; return st * 1024 + (ob ^ (((ob >> 9) & 1) << 5)); }
__host__ __device__ __forceinline__ void stage_rc(int b, int& R, int& C) { const int st = b / 1024, sb = b % 1024, swz = sb ^ (((sb >> 9) & 1) << 5); R = (st >> 1) * 16 + swz / 64; C = (st & 1) * 32 + (swz % 64) / 2; }
__host__ __device__ __forceinline__ int perm32(int rho) { const int n = rho >> 4, i = rho & 15; return 8 * (i >> 2) + 4 * n + (i & 3); }
struct Unit { int pm, pn; };
struct Gemm { const bf16_t* A; const bf16_t* Bt; int M, N, K; };
struct StaticOrder {
    int nM, nN, nwg, G, c;
    __host__ __device__ void init(int M, int N, int G_, int c_) { nM = M / BM; nN = N / BM; nwg = nM * nN; G = G_; c = c_; }
    __host__ __device__ bool next(int i, Unit& u) const {
        const long L = (long)i * G + c; if (L >= nwg) return false;
        int wgid = (int)L; { const int q = nwg / NXCD, r = nwg % NXCD, xcd = wgid % NXCD, off = wgid / NXCD; wgid = (xcd < r ? xcd * (q + 1) : r * (q + 1) + (xcd - r) * q) + off; }
        const int nig = WGM * nN, gid = wgid / nig, fm = gid * WGM, gsz = (nM - fm) < WGM ? (nM - fm) : WGM;
        u.pm = fm + ((wgid % nig) % gsz); u.pn = (wgid % nig) / gsz; return true;
    }
    __device__ __forceinline__ void a_ready(const Unit&) const {}
    __device__ __forceinline__ void done(const Unit&) const {}
};
template <class E8> struct EpiA {
    static constexpr bool PERM = true, AFTER_DRAIN = false;
    E8 e;
    __device__ __forceinline__ void operator()(const f32x4 (&acc)[2][2][4][2], const Unit& u, int wr, int wc, int fr, int fq) const {
        const int row0 = u.pm * BM + wr * 64 + fr, col0 = u.pn * BM + wc * 32 + 8 * fq;
#pragma unroll
        for (int ai = 0; ai < 2; ++ai)
#pragma unroll
            for (int m = 0; m < 4; ++m) { const int r = row0 + ai * HALF + m * 16; float s = 0.f;
#pragma unroll
                for (int bj = 0; bj < 2; ++bj) { const float v[8] = {acc[ai][bj][m][0][0], acc[ai][bj][m][0][1], acc[ai][bj][m][0][2], acc[ai][bj][m][0][3], acc[ai][bj][m][1][0], acc[ai][bj][m][1][1], acc[ai][bj][m][1][2], acc[ai][bj][m][1][3]};
                    s += e.store8(r, col0 + bj * HALF, v); }
                if (E8::ROWSUM) { s += __shfl_xor(s, 16); s += __shfl_xor(s, 32); if (fq == 0) e.rowsum(r, s); }
                asm volatile("" ::: "memory"); }
    }
    __device__ __forceinline__ void fused(f32x4 (&)[2][2][4][2], const Unit&, int, int, int, int, PG8_LAS unsigned char*, int, int) const {}
};
template <class Epi, class Sched, bool ALIGN_EPI = false, bool SP2 = false>
__device__ __forceinline__ void gemm_phase(PG8_LAS unsigned char* lds, const Gemm g, const Sched& S, const Epi& E) {
    int tid_ = threadIdx.x; asm volatile("" : "+v"(tid_));
    const int tid = tid_, wid = __builtin_amdgcn_readfirstlane(tid >> 6), lane = tid & 63, wr = wid >> 2, wc = wid & 3, fr = lane & 15, fq = lane >> 4;
    const int K = g.K, nt = K / BK;
    unsigned voffA[2], voffB[2];
#pragma unroll
    for (int i = 0; i < 2; ++i) { int R, C; stage_rc(tid * 16 + i * 8192, R, C); const int Rb = Epi::PERM ? ((R & ~31) + perm32(R & 31)) : R;
        voffA[i] = (unsigned)(R * K + C) * 2u; voffB[i] = (unsigned)(Rb * K + C) * 2u; }
    const size_t kstep = (size_t)(BK * 2);
    const size_t hstep = (size_t)HALF * K * 2;
    const size_t tstep = 2 * hstep;
    const unsigned ldsw = (unsigned)wid * 1024u;
    const int aoff = lds_byte(wr * 64 + fr, fq * 8), boff = lds_byte(wc * 32 + fr, fq * 8);
#define PG8_SA(b, h) (((b) * 2 + (h)) * HTB)
#define PG8_SB(b, h) ((4 + (b) * 2 + (h)) * HTB)
#define PG8_STAGE(bufoff, gbase, voff) do { _Pragma("unroll") for (int _i = 0; _i < 2; ++_i) \
        __builtin_amdgcn_global_load_lds((const unsigned*)((const char*)(gbase) + (voff)[_i]), (PG8_LAS unsigned*)(lds + (bufoff) + ldsw + _i * 8192), 16, 0, 0); } while (0)
#define PG8_LDA(dst, b, h) do { _Pragma("unroll") for (int m = 0; m < 4; ++m) _Pragma("unroll") for (int k = 0; k < 2; ++k) dst[m][k] = *(const PG8_LAS bf16x8*)(lds + PG8_SA(b, h) + aoff + m * 2048 + k * 1024); } while (0)
#define PG8_LDB(dst, b, h) do { _Pragma("unroll") for (int n = 0; n < 2; ++n) _Pragma("unroll") for (int k = 0; k < 2; ++k) dst[n][k] = *(const PG8_LAS bf16x8*)(lds + PG8_SB(b, h) + boff + n * 2048 + k * 1024); } while (0)
#define PG8_MMA(ai, bj, At, Bt) do { __builtin_amdgcn_s_setprio(1); _Pragma("unroll") for (int m = 0; m < 4; ++m) _Pragma("unroll") for (int n = 0; n < 2; ++n) _Pragma("unroll") for (int k = 0; k < 2; ++k) \
        acc[ai][bj][m][n] = __builtin_amdgcn_mfma_f32_16x16x32_bf16(Bt[n][k], At[m][k], acc[ai][bj][m][n], 0, 0, 0); __builtin_amdgcn_s_setprio(0); } while (0)
#define PG8_WAIT_V(n) asm volatile("s_waitcnt vmcnt(" #n ")" ::: "memory")
#define PG8_WAIT_L(n) asm volatile("s_waitcnt lgkmcnt(" #n ")" ::: "memory")
#define PG8_BAR __builtin_amdgcn_s_barrier()
#define PG8_SCHED __builtin_amdgcn_sched_barrier(0)
    Unit cur, nxt; int ui = 0;
    if (!S.next(0, cur)) return;
    f32x4 acc[2][2][4][2];
#pragma unroll
    for (int a = 0; a < 2; ++a)
#pragma unroll
        for (int b = 0; b < 2; ++b)
#pragma unroll
            for (int m = 0; m < 4; ++m)
#pragma unroll
                for (int n = 0; n < 2; ++n) acc[a][b][m][n] = (f32x4){0.f, 0.f, 0.f, 0.f};
    bf16x8 At[4][2], B0[2][2], B1[2][2];
    const char* cA = (const char*)g.A + (size_t)cur.pm * tstep; const char* cB = (const char*)g.Bt + (size_t)cur.pn * tstep;
    S.a_ready(cur);
    if constexpr (SP2) {
        PG8_STAGE(PG8_SB(0, 0), cB, voffB); PG8_STAGE(PG8_SB(0, 1), cB + hstep, voffB); PG8_STAGE(PG8_SA(0, 0), cA, voffA); PG8_STAGE(PG8_SA(0, 1), cA + hstep, voffA);
        if (wr == 1) PG8_BAR;
        PG8_WAIT_V(2); PG8_BAR;
        PG8_STAGE(PG8_SB(1, 0), cB + kstep, voffB); PG8_STAGE(PG8_SA(1, 0), cA + kstep, voffA); PG8_STAGE(PG8_SB(1, 1), cB + hstep + kstep, voffB);
        PG8_WAIT_V(6); PG8_BAR;
    } else {
        PG8_STAGE(PG8_SB(0, 0), cB, voffB); PG8_STAGE(PG8_SA(0, 0), cA, voffA); PG8_STAGE(PG8_SB(0, 1), cB + hstep, voffB); PG8_STAGE(PG8_SA(0, 1), cA + hstep, voffA);
        if (wr == 1) PG8_BAR;
        PG8_WAIT_V(4); PG8_BAR;
        PG8_STAGE(PG8_SB(1, 0), cB + kstep, voffB); PG8_STAGE(PG8_SA(1, 0), cA + kstep, voffA); PG8_STAGE(PG8_SB(1, 1), cB + hstep + kstep, voffB);
        PG8_WAIT_V(6); PG8_BAR;
    }
    for (;;) {
        const bool has_next = S.next(ui + 1, nxt);
        const char* nA = has_next ? (const char*)g.A + (size_t)nxt.pm * tstep : cA; const char* nB = has_next ? (const char*)g.Bt + (size_t)nxt.pn * tstep : cB;
        for (int t = 0; t < nt; t += 2) {
            const bool last = (t == nt - 2);
            const char* a1 = cA + (size_t)(t + 1) * kstep;
            const char* a2 = last ? nA : cA + (size_t)(t + 2) * kstep; const char* b2 = last ? nB : cB + (size_t)(t + 2) * kstep;
            const char* a3 = a2 + kstep; const char* b3 = b2 + kstep;
            if (last && has_next) S.a_ready(nxt);
            if constexpr (SP2) {
            PG8_LDB(B0, 0, 0); PG8_LDB(B1, 0, 1); PG8_SCHED; PG8_LDA(At, 0, 0); PG8_STAGE(PG8_SA(1, 1), a1 + hstep, voffA);
            PG8_WAIT_V(8); PG8_WAIT_L(0); PG8_BAR; PG8_MMA(0, 0, At, B0); PG8_MMA(0, 1, At, B1); PG8_BAR; PG8_SCHED;
            PG8_LDA(At, 0, 1); PG8_STAGE(PG8_SB(0, 0), b2, voffB); PG8_STAGE(PG8_SB(0, 1), b2 + hstep, voffB); PG8_STAGE(PG8_SA(0, 0), a2, voffA);
            PG8_WAIT_V(8); PG8_WAIT_L(0); PG8_BAR; PG8_MMA(1, 0, At, B0); PG8_MMA(1, 1, At, B1); PG8_BAR; PG8_SCHED;
            PG8_LDB(B0, 1, 0); PG8_LDB(B1, 1, 1); PG8_SCHED; PG8_LDA(At, 1, 0); PG8_STAGE(PG8_SA(0, 1), a2 + hstep, voffA);
            PG8_WAIT_V(8); PG8_WAIT_L(0); PG8_BAR; PG8_MMA(0, 0, At, B0); PG8_MMA(0, 1, At, B1); PG8_BAR; PG8_SCHED;
            PG8_LDA(At, 1, 1); PG8_STAGE(PG8_SB(1, 0), b3, voffB); PG8_STAGE(PG8_SB(1, 1), b3 + hstep, voffB); PG8_STAGE(PG8_SA(1, 0), a3, voffA);
            PG8_WAIT_V(8); PG8_WAIT_L(0); PG8_BAR; PG8_MMA(1, 0, At, B0); PG8_MMA(1, 1, At, B1); PG8_BAR; PG8_SCHED;
            } else {
            PG8_LDB(B0, 0, 0); PG8_SCHED; PG8_LDA(At, 0, 0); PG8_STAGE(PG8_SA(1, 1), a1 + hstep, voffA);
            PG8_WAIT_L(8); PG8_BAR; PG8_WAIT_L(0); PG8_MMA(0, 0, At, B0); PG8_BAR; PG8_SCHED;
            PG8_LDB(B1, 0, 1); PG8_STAGE(PG8_SB(0, 0), b2, voffB);
            PG8_BAR; PG8_WAIT_L(0); PG8_MMA(0, 1, At, B1); PG8_BAR;
            PG8_LDA(At, 0, 1); PG8_STAGE(PG8_SA(0, 0), a2, voffA);
            PG8_BAR; PG8_WAIT_L(0); PG8_MMA(1, 0, At, B0); PG8_BAR; PG8_SCHED;
            PG8_STAGE(PG8_SB(0, 1), b2 + hstep, voffB);
            PG8_WAIT_V(6); PG8_BAR; PG8_MMA(1, 1, At, B1); PG8_BAR;
            PG8_LDB(B0, 1, 0); PG8_SCHED; PG8_LDA(At, 1, 0); PG8_STAGE(PG8_SA(0, 1), a2 + hstep, voffA);
            PG8_WAIT_L(8); PG8_BAR; PG8_WAIT_L(0); PG8_MMA(0, 0, At, B0); PG8_BAR; PG8_SCHED;
            PG8_LDB(B1, 1, 1); PG8_STAGE(PG8_SB(1, 0), b3, voffB);
            PG8_BAR; PG8_WAIT_L(0); PG8_MMA(0, 1, At, B1); PG8_BAR;
            PG8_LDA(At, 1, 1); PG8_STAGE(PG8_SA(1, 0), a3, voffA);
            PG8_BAR; PG8_WAIT_L(0); PG8_MMA(1, 0, At, B0); PG8_BAR; PG8_SCHED;
            PG8_STAGE(PG8_SB(1, 1), b3 + hstep, voffB);
            PG8_WAIT_V(6); PG8_BAR; PG8_MMA(1, 1, At, B1); PG8_BAR;
            }
        }
        if constexpr (ALIGN_EPI) { if (wr == 0) PG8_BAR; }
        if constexpr (!Epi::AFTER_DRAIN) { E(acc, cur, wr, wc, fr, fq); S.done(cur); }
        if (!has_next) break;
#pragma unroll
        for (int a = 0; a < 2; ++a)
#pragma unroll
            for (int b = 0; b < 2; ++b)
#pragma unroll
                for (int m = 0; m < 4; ++m)
#pragma unroll
                    for (int n = 0; n < 2; ++n) acc[a][b][m][n] = (f32x4){0.f, 0.f, 0.f, 0.f};
        cur = nxt; cA = nA; cB = nB; ++ui;
        if constexpr (ALIGN_EPI) { if (wr == 1) PG8_BAR; }
    }
    PG8_WAIT_V(0);
    if constexpr (!ALIGN_EPI) { if (wr == 0) PG8_BAR; }
    PG8_BAR;
    if constexpr (Epi::AFTER_DRAIN) { E.fused(acc, cur, wr, wc, fr, fq, lds, wid, lane); S.done(cur); }
#undef PG8_SA
#undef PG8_SB
#undef PG8_STAGE
#undef PG8_LDA
#undef PG8_LDB
#undef PG8_MMA
#undef PG8_WAIT_V
#undef PG8_WAIT_L
#undef PG8_BAR
#undef PG8_SCHED
}
}

#ifndef FAST_GEMM
#define FAST_GEMM 1
#endif
template <class E8>
__device__ __forceinline__ void gemm_any(const bf16_t* A, const bf16_t* Bt, int M, int N, int K, const E8& E, float* lds, int bid, int nb) {
#if FAST_GEMM
  pg8::Gemm g{A, Bt, M, N, K}; pg8::StaticOrder S; S.init(M, N, nb, bid);
  pg8::EpiA<E8> EA{E};
  pg8::gemm_phase<pg8::EpiA<E8>, pg8::StaticOrder, true, true>((PG8_LAS unsigned char*)lds, g, S, EA);
#else
  gemm_naive(A, Bt, M, N, K, E, lds, bid, nb);
#endif
}

__device__ void gla_naive(const Params& p, const WS& w, int b, int h, float* lds) {
  constexpr int CH = 16;
  const int tid = tidx(), dv = tid & 255, half = tid >> 8, wave = tid >> 6, lane = tid & 63;
  float* qf = lds; float* kf = qf + CH * 128; float* af = kf + CH * 128; float* vf = af + CH * 128; float* op = vf + CH * 256;
  float S[64];
#pragma unroll
  for (int i = 0; i < 64; ++i) S[i] = 0.f;
  const int gd = tid & 127;
  float gu[16];
#pragma unroll
  for (int r = 0; r < 16; ++r) gu[r] = p.gate_up[r * 512 + h * 128 + gd];
  const float gb = p.gate_bias[h * 128 + gd];
  const float qscale = 0.08838834764831845f;
  for (int t0 = 0; t0 < SEQ; t0 += CH) {
    const size_t tb = (size_t)b * SEQ + t0;
    { const int tok = tid >> 5, d4 = (tid & 31) * 4;
      const uint2 qv = *(const uint2*)(w.proj + (tb + tok) * NPROJ + C_GQ + h * 128 + d4);
      const uint2 kv = *(const uint2*)(w.proj + (tb + tok) * NPROJ + C_GK + h * 128 + d4);
      *(float4*)(qf + tok * 128 + d4) = make_float4(lo_f(qv.x) * qscale, hi_f(qv.x) * qscale, lo_f(qv.y) * qscale, hi_f(qv.y) * qscale);
      *(float4*)(kf + tok * 128 + d4) = make_float4(lo_f(kv.x), hi_f(kv.x), lo_f(kv.y), hi_f(kv.y)); }
    { const int dvv = tid & 255, tk8 = (tid >> 8) * 8; float f[8];
      unpack8(*(const uint4*)(w.vT + (size_t)(h * 256 + dvv) * T + tb + tk8), f);
#pragma unroll
      for (int j = 0; j < 8; ++j) vf[(tk8 + j) * 256 + dvv] = f[j]; }
#pragma unroll
    for (int i = 0; i < 4; ++i) { const int tok = (tid >> 7) * 4 + i; float z = gb; float gl[16];
      unpack8(*(const uint4*)(w.proj + (tb + tok) * NPROJ + C_SM), gl); unpack8(*(const uint4*)(w.proj + (tb + tok) * NPROJ + C_SM + 8), gl + 8);
#pragma unroll
      for (int r = 0; r < 16; ++r) z += gl[r] * gu[r];
      af[tok * 128 + gd] = __expf(logsigmoidf_(z) * (1.f / 16.f)); }
    __syncthreads();
    for (int tok = 0; tok < CH; ++tok) {
      const float vv = vf[tok * 256 + dv]; float acc = 0.f;
#pragma unroll
      for (int i4 = 0; i4 < 16; ++i4) {
        const float4 a = *(const float4*)(af + tok * 128 + half * 64 + i4 * 4), k = *(const float4*)(kf + tok * 128 + half * 64 + i4 * 4), q = *(const float4*)(qf + tok * 128 + half * 64 + i4 * 4);
        S[i4 * 4 + 0] = a.x * S[i4 * 4 + 0] + k.x * vv; acc += q.x * S[i4 * 4 + 0];
        S[i4 * 4 + 1] = a.y * S[i4 * 4 + 1] + k.y * vv; acc += q.y * S[i4 * 4 + 1];
        S[i4 * 4 + 2] = a.z * S[i4 * 4 + 2] + k.z * vv; acc += q.z * S[i4 * 4 + 2];
        S[i4 * 4 + 3] = a.w * S[i4 * 4 + 3] + k.w * vv; acc += q.w * S[i4 * 4 + 3];
      }
      op[(half * CH + tok) * 256 + dv] = acc;
    }
    __syncthreads();
#pragma unroll
    for (int i = 0; i < 2; ++i) { const int tok = wave * 2 + i;
      const float4 o0 = *(const float4*)(op + tok * 256 + lane * 4), o1 = *(const float4*)(op + (CH + tok) * 256 + lane * 4);
      const float o[4] = {o0.x + o1.x, o0.y + o1.y, o0.z + o1.z, o0.w + o1.w};
      float ss = wave_sum(o[0] * o[0] + o[1] * o[1] + o[2] * o[2] + o[3] * o[3]);
      const float rs = rsqrtf(ss * (1.f / 256.f) + EPS);
      const uint2 gg = *(const uint2*)(w.proj + (tb + tok) * NPROJ + C_GG + h * 256 + lane * 4);
      const float4 gn = *(const float4*)(p.gla_norm + h * 256 + lane * 4);
      const float y0 = o[0] * rs * gn.x * siluf_(lo_f(gg.x)), y1 = o[1] * rs * gn.y * siluf_(hi_f(gg.x)), y2 = o[2] * rs * gn.z * siluf_(lo_f(gg.y)), y3 = o[3] * rs * gn.w * siluf_(hi_f(gg.y));
      *(uint2*)(w.y + (tb + tok) * D + h * 256 + lane * 4) = make_uint2(pack2(y0, y1), pack2(y2, y3)); }
    __syncthreads();
  }
}
__device__ void mlstm_naive(const Params& p, const WS& w, int b, int h, float* lds) {
  constexpr int CH = 16;
  const int tid = tidx(), dv = tid & 255, half = tid >> 8, wave = tid >> 6, lane = tid & 63;
  float* qf = lds; float* kf = qf + CH * 128; float* vf = kf + CH * 128; float* op = vf + CH * 256; float* dn = op + 2 * CH * 256; float* gt = dn + 2 * CH * 256;
  float C[64], n[4];
#pragma unroll
  for (int i = 0; i < 64; ++i) C[i] = 0.f;
#pragma unroll
  for (int i = 0; i < 4; ++i) n[i] = 0.f;
  const int nd = half * 64 + (dv & 15) * 4;
  const float kscale = 0.08838834764831845f;
  const float ib = p.ig_bias[h], fb = p.fg_bias[h];
  for (int t0 = 0; t0 < SEQ; t0 += CH) {
    const size_t tb = (size_t)b * SEQ + t0;
    { const int tok = tid >> 5, d4 = (tid & 31) * 4;
      float qa[4], ka[4];
#pragma unroll
      for (int c = 0; c < 4; ++c) { qa[c] = p.conv_b[h * 128 + d4 + c]; ka[c] = p.conv_b[512 + h * 128 + d4 + c]; }
#pragma unroll
      for (int wi = 0; wi < 4; ++wi) { const int ts = t0 + tok - 3 + wi;
        if (ts >= 0) { const size_t tr = (size_t)b * SEQ + ts;
          const uint2 qv = *(const uint2*)(w.proj + tr * NPROJ + C_MQ + h * 128 + d4), kv = *(const uint2*)(w.proj + tr * NPROJ + C_MK + h * 128 + d4);
          const float4 cq = *(const float4*)(p.conv_w + wi * 1024 + h * 128 + d4), ck = *(const float4*)(p.conv_w + wi * 1024 + 512 + h * 128 + d4);
          qa[0] += cq.x * lo_f(qv.x); qa[1] += cq.y * hi_f(qv.x); qa[2] += cq.z * lo_f(qv.y); qa[3] += cq.w * hi_f(qv.y);
          ka[0] += ck.x * lo_f(kv.x); ka[1] += ck.y * hi_f(kv.x); ka[2] += ck.z * lo_f(kv.y); ka[3] += ck.w * hi_f(kv.y); } }
      *(float4*)(qf + tok * 128 + d4) = make_float4(siluf_(qa[0]), siluf_(qa[1]), siluf_(qa[2]), siluf_(qa[3]));
      *(float4*)(kf + tok * 128 + d4) = make_float4(siluf_(ka[0]) * kscale, siluf_(ka[1]) * kscale, siluf_(ka[2]) * kscale, siluf_(ka[3]) * kscale); }
    { const int dvv = tid & 255, tk8 = (tid >> 8) * 8; float f[8];
      unpack8(*(const uint4*)(w.vT + (size_t)(1024 + h * 256 + dvv) * T + tb + tk8), f);
#pragma unroll
      for (int j = 0; j < 8; ++j) vf[(tk8 + j) * 256 + dvv] = f[j]; }
    if (tid < CH) { const float mi = bf2f(w.proj[(tb + tid) * NPROJ + C_SM + 16 + h]), mf = bf2f(w.proj[(tb + tid) * NPROJ + C_SM + 20 + h]);
      gt[tid * 2] = __expf(mi + ib); gt[tid * 2 + 1] = sigmoidf_(mf + fb); }
    __syncthreads();
    for (int tok = 0; tok < CH; ++tok) {
      const float vv = vf[tok * 256 + dv], ig = gt[tok * 2], fg = gt[tok * 2 + 1]; float num = 0.f, den = 0.f;
#pragma unroll
      for (int i4 = 0; i4 < 16; ++i4) {
        const float4 k = *(const float4*)(kf + tok * 128 + half * 64 + i4 * 4), q = *(const float4*)(qf + tok * 128 + half * 64 + i4 * 4);
        const float kk[4] = {k.x * ig, k.y * ig, k.z * ig, k.w * ig}; const float qq[4] = {q.x, q.y, q.z, q.w};
#pragma unroll
        for (int c = 0; c < 4; ++c) { C[i4 * 4 + c] = fg * C[i4 * 4 + c] + kk[c] * vv; num += qq[c] * C[i4 * 4 + c]; }
      }
      { const float4 k = *(const float4*)(kf + tok * 128 + nd), q = *(const float4*)(qf + tok * 128 + nd);
        n[0] = fg * n[0] + k.x * ig; n[1] = fg * n[1] + k.y * ig; n[2] = fg * n[2] + k.z * ig; n[3] = fg * n[3] + k.w * ig;
        den = q.x * n[0] + q.y * n[1] + q.z * n[2] + q.w * n[3];
        den += __shfl_xor(den, 1); den += __shfl_xor(den, 2); den += __shfl_xor(den, 4); den += __shfl_xor(den, 8); }
      op[(half * CH + tok) * 256 + dv] = num; if (dv == 0) dn[half * CH + tok] = den;
    }
    __syncthreads();
#pragma unroll
    for (int i = 0; i < 2; ++i) { const int tok = wave * 2 + i;
      const float4 o0 = *(const float4*)(op + tok * 256 + lane * 4), o1 = *(const float4*)(op + (CH + tok) * 256 + lane * 4);
      const float den = dn[tok] + dn[CH + tok];
      const float inv = 1.f / fmaxf(fabsf(den), 1.f);
      const float o[4] = {(o0.x + o1.x) * inv, (o0.y + o1.y) * inv, (o0.z + o1.z) * inv, (o0.w + o1.w) * inv};
      float ss = wave_sum(o[0] * o[0] + o[1] * o[1] + o[2] * o[2] + o[3] * o[3]);
      const float rs = rsqrtf(ss * (1.f / 256.f) + EPS);
      const uint2 mo = *(const uint2*)(w.proj + (tb + tok) * NPROJ + C_MO + h * 256 + lane * 4);
      const float4 gn = *(const float4*)(p.mlstm_norm + h * 256 + lane * 4);
      const float y0 = o[0] * rs * gn.x * sigmoidf_(lo_f(mo.x)), y1 = o[1] * rs * gn.y * sigmoidf_(hi_f(mo.x)), y2 = o[2] * rs * gn.z * sigmoidf_(lo_f(mo.y)), y3 = o[3] * rs * gn.w * sigmoidf_(hi_f(mo.y));
      *(uint2*)(w.y + (tb + tok) * D + 1024 + h * 256 + lane * 4) = make_uint2(pack2(y0, y1), pack2(y2, y3)); }
    __syncthreads();
  }
}
__device__ void phase_mixer_naive(const Params& p, const WS& w, float* lds, int bid, int nb) {
  for (int item = bid; item < 16; item += nb) {
    if (item < 8) gla_naive(p, w, item >> 2, item & 3, lds); else mlstm_naive(p, w, (item - 8) >> 2, item & 3, lds);
    __syncthreads();
  }
}


typedef short bf16x8 __attribute__((ext_vector_type(8)));
typedef float f32x4 __attribute__((ext_vector_type(4)));
#define MFMA16(a, b, c) __builtin_amdgcn_mfma_f32_16x16x32_bf16(a, b, c, 0, 0, 0)
constexpr int L_GLR = 0, L_TOT = 4096, L_F = 6144, L_DEN = 6656, L_PART = 6912, L_QS = 9216, L_KS = 26624, L_P = 44032, L_NL = 53248, L_KDT = 9216;
constexpr int QS_LD = 136, P_LD = 72, KDT_LD = 72;

__device__ __forceinline__ void gla_gates(const Params& p, const WS& w, int h, size_t tb, unsigned char* ldsb, int tid, float* bv, float& blast) {
  float* glrs = (float*)(ldsb + L_GLR); float* tot = (float*)(ldsb + L_TOT);
  const int d = tid & 127, tg = tid >> 7;
  if (tid < 128) { float f[8]; unpack8(*(const uint4*)(w.proj + (tb + (tid >> 1)) * NPROJ + C_SM + (tid & 1) * 8), f);
#pragma unroll
    for (int j = 0; j < 8; ++j) glrs[(tid >> 1) * 16 + (tid & 1) * 8 + j] = f[j]; }
  float gu[16];
#pragma unroll
  for (int r = 0; r < 16; ++r) gu[r] = p.gate_up[r * 512 + h * 128 + d];
  const float gb = p.gate_bias[h * 128 + d];
  __syncthreads();
  float run = 0.f;
#pragma unroll
  for (int i = 0; i < 16; ++i) { const float* gl = glrs + (tg * 16 + i) * 16; float z = gb;
#pragma unroll
    for (int r4 = 0; r4 < 4; ++r4) { const float4 g4 = *(const float4*)(gl + r4 * 4); z += g4.x * gu[r4 * 4] + g4.y * gu[r4 * 4 + 1] + g4.z * gu[r4 * 4 + 2] + g4.w * gu[r4 * 4 + 3]; }
    run += logsigmoidf_(z) * (1.f / 16.f); bv[i] = run; }
  tot[tg * 128 + d] = run;
  __syncthreads();
  float off = 0.f; blast = 0.f;
#pragma unroll
  for (int g = 0; g < 4; ++g) { const float t = tot[g * 128 + d]; blast += t; if (g < tg) off += t; }
#pragma unroll
  for (int i = 0; i < 16; ++i) bv[i] += off;
}
__device__ __forceinline__ void mlstm_gates(const Params& p, const WS& w, int h, size_t tb, unsigned char* ldsb, int tid) {
  float* Fl = (float*)(ldsb + L_F);
  if (tid < 64) { const float mi = bf2f(w.proj[(tb + tid) * NPROJ + C_SM + 16 + h]), mf = bf2f(w.proj[(tb + tid) * NPROJ + C_SM + 20 + h]);
    float f = logsigmoidf_(mf + p.fg_bias[h]);
#pragma unroll
    for (int o = 1; o < 64; o <<= 1) { const float t = __shfl_up(f, o); if (tid >= o) f += t; }
    Fl[tid] = f; Fl[64 + tid] = mi + p.ig_bias[h]; }
  __syncthreads();
}
__device__ __forceinline__ void conv_load(const WS& w, int col, int b, int c, int tg, bf16_t* win) {
  const int s0 = c * 64 + tg * 16 - 3;
#pragma unroll
  for (int m = 0; m < 19; ++m) { const int sp = s0 + m; win[m] = (sp >= 0) ? w.proj[((size_t)b * SEQ + sp) * NPROJ + col] : (bf16_t)0; }
}
__device__ __forceinline__ void conv_apply(const Params& p, const bf16_t* win, int cch, float scale, float* out) {
  const float c0 = p.conv_w[cch], c1 = p.conv_w[1024 + cch], c2 = p.conv_w[2048 + cch], c3 = p.conv_w[3072 + cch], cb = p.conv_b[cch];
#pragma unroll
  for (int i = 0; i < 16; ++i) out[i] = siluf_(cb + c0 * bf2f(win[i]) + c1 * bf2f(win[i + 1]) + c2 * bf2f(win[i + 2]) + c3 * bf2f(win[i + 3])) * scale;
}

template <int KIND>
__device__ void mix_local(const Params& p, const WS& w, int b, int h, int c, int item, unsigned char* ldsb) {
  const int tid = tidx(), lane = tid & 63, wave = tid >> 6, fr = lane & 15, fq = lane >> 4, d = tid & 127, tg = tid >> 7;
  const size_t tb = (size_t)b * SEQ + (size_t)c * 64;
  float* tot = (float*)(ldsb + L_TOT); const float* Fl = (const float*)(ldsb + L_F);
  bf16_t* kdT = (bf16_t*)(ldsb + L_KDT);
  const bf16_t* vrow = w.vT + (size_t)(KIND * 1024 + h * 256 + wave * 32 + fr) * T + tb + fq * 8;
  bf16x8 yv[2][2];
#pragma unroll
  for (int ks = 0; ks < 2; ++ks) { yv[ks][0] = *(const bf16x8*)(vrow + ks * 32); yv[ks][1] = *(const bf16x8*)(vrow + (size_t)16 * T + ks * 32); }
  bf16_t kraw[19];
  if (KIND == 0) {
#pragma unroll
    for (int i = 0; i < 16; ++i) kraw[i] = w.proj[(tb + tg * 16 + i) * NPROJ + C_GK + h * 128 + d];
  } else conv_load(w, C_MK + h * 128 + d, b, c, tg, kraw);
  float wgt[16], kv[16];
  if (KIND == 0) {
    float bv[16], blast; gla_gates(p, w, h, tb, ldsb, tid, bv, blast);
#pragma unroll
    for (int i = 0; i < 16; ++i) { wgt[i] = __expf(blast - bv[i]); kv[i] = bf2f(kraw[i]); }
    if (tg == 0) w.gdec[(size_t)item * 128 + d] = __expf(blast);
  } else {
    mlstm_gates(p, w, h, tb, ldsb, tid);
    const float flast = Fl[63];
#pragma unroll
    for (int i = 0; i < 16; ++i) wgt[i] = __expf(flast - Fl[tg * 16 + i] + Fl[64 + tg * 16 + i]);
    conv_apply(p, kraw, 512 + h * 128 + d, 0.08838834764831845f, kv);
    if (tid == 0) w.mdec[item - 2048] = __expf(flast);
  }
  float un = 0.f; float kd[16];
#pragma unroll
  for (int i = 0; i < 16; ++i) { kd[i] = kv[i] * wgt[i]; un += kd[i]; }
  *(uint4*)(kdT + d * KDT_LD + tg * 16) = pack8(kd); *(uint4*)(kdT + d * KDT_LD + tg * 16 + 8) = pack8(kd + 8);
  if (KIND == 1) tot[tg * 128 + d] = un;
  __syncthreads();
  if (KIND == 1 && tg == 0) w.mn[(size_t)(item - 2048) * 128 + d] = tot[d] + tot[128 + d] + tot[256 + d] + tot[384 + d];
  f32x4 acc[2][8];
#pragma unroll
  for (int yt = 0; yt < 2; ++yt)
#pragma unroll
    for (int xt = 0; xt < 8; ++xt) acc[yt][xt] = (f32x4){0.f, 0.f, 0.f, 0.f};
#pragma unroll
  for (int ks = 0; ks < 2; ++ks) {
#pragma unroll
    for (int xt = 0; xt < 8; ++xt) { const bf16x8 xk = *(const bf16x8*)(kdT + (xt * 16 + fr) * KDT_LD + ks * 32 + fq * 8);
      acc[0][xt] = MFMA16(xk, yv[ks][0], acc[0][xt]); acc[1][xt] = MFMA16(xk, yv[ks][1], acc[1][xt]); }
  }
  bf16_t* S = (bf16_t*)p.out + (size_t)item * 32768;
#pragma unroll
  for (int yt = 0; yt < 2; ++yt)
#pragma unroll
    for (int xt = 0; xt < 8; ++xt) *(uint2*)(S + (wave * 32 + yt * 16 + fr) * 128 + xt * 16 + 4 * fq) = make_uint2(pack2(acc[yt][xt][0], acc[yt][xt][1]), pack2(acc[yt][xt][2], acc[yt][xt][3]));
  __syncthreads();
}

__device__ void mix_scan(const Params& p, const WS& w, int bid, int nb) {
  bf16_t* sbuf = (bf16_t*)p.out;
  for (int g = bid * 512 + tidx(); g < 16 * 8192; g += nb * 512) {
    const int combo = g >> 13, e = (g & 8191) * 4, dk = e & 127;
    bf16_t* base = sbuf + (size_t)combo * 256 * 32768 + e;
    float S0 = 0.f, S1 = 0.f, S2 = 0.f, S3 = 0.f;
    for (int c0 = 0; c0 < 256; c0 += 8) {
      uint2 u[8]; float4 dc[8];
#pragma unroll
      for (int k = 0; k < 8; ++k) { u[k] = *(const uint2*)(base + (size_t)(c0 + k) * 32768);
        if (combo < 8) dc[k] = *(const float4*)(w.gdec + (size_t)(combo * 256 + c0 + k) * 128 + dk);
        else { const float m = w.mdec[(combo - 8) * 256 + c0 + k]; dc[k] = make_float4(m, m, m, m); } }
#pragma unroll
      for (int k = 0; k < 8; ++k) { *(uint2*)(base + (size_t)(c0 + k) * 32768) = make_uint2(pack2(S0, S1), pack2(S2, S3));
        S0 = dc[k].x * S0 + lo_f(u[k].x); S1 = dc[k].y * S1 + hi_f(u[k].x); S2 = dc[k].z * S2 + lo_f(u[k].y); S3 = dc[k].w * S3 + hi_f(u[k].y); }
    }
  }
  for (int g = bid * 512 + tidx(); g < 8 * 128; g += nb * 512) {
    const int cb = g >> 7, d = g & 127; float n = 0.f;
    for (int c = 0; c < 256; ++c) { float* q = w.mn + (size_t)(cb * 256 + c) * 128 + d; const float u = *q; *q = n; n = w.mdec[cb * 256 + c] * n + u; }
  }
}

template <int KIND>
__device__ void mix_out(const Params& p, const WS& w, int b, int h, int c, int item, unsigned char* ldsb) {
  const int tid = tidx(), lane = tid & 63, wave = tid >> 6, fr = lane & 15, fq = lane >> 4, d = tid & 127, tg = tid >> 7;
  const size_t tb = (size_t)b * SEQ + (size_t)c * 64;
  const float* Fl = (const float*)(ldsb + L_F); float* denl = (float*)(ldsb + L_DEN); float* part = (float*)(ldsb + L_PART); float* nl = (float*)(ldsb + L_NL);
  bf16_t* qs = (bf16_t*)(ldsb + L_QS); bf16_t* ks = (bf16_t*)(ldsb + L_KS); bf16_t* P = (bf16_t*)(ldsb + L_P);
  bf16x8 vx[2][2], sx[4][2];
  { const bf16_t* vrow = w.vT + (size_t)(KIND * 1024 + h * 256 + wave * 32 + fr) * T + tb + fq * 8;
#pragma unroll
    for (int k2 = 0; k2 < 2; ++k2) { vx[k2][0] = *(const bf16x8*)(vrow + k2 * 32); vx[k2][1] = *(const bf16x8*)(vrow + (size_t)16 * T + k2 * 32); }
    const bf16_t* srow = (const bf16_t*)p.out + (size_t)item * 32768 + (wave * 32 + fr) * 128 + fq * 8;
#pragma unroll
    for (int k4 = 0; k4 < 4; ++k4) { sx[k4][0] = *(const bf16x8*)(srow + k4 * 32); sx[k4][1] = *(const bf16x8*)(srow + 16 * 128 + k4 * 32); } }
  uint2 gt[4][2];
#pragma unroll
  for (int yt = 0; yt < 4; ++yt)
#pragma unroll
    for (int xt = 0; xt < 2; ++xt) gt[yt][xt] = *(const uint2*)(w.proj + (tb + yt * 16 + fr) * NPROJ + (KIND == 0 ? C_GG : C_MO) + h * 256 + wave * 32 + xt * 16 + 4 * fq);
  const float* gain = (KIND == 0 ? p.gla_norm : p.mlstm_norm) + h * 256;
  const float4 gn0 = *(const float4*)(gain + wave * 32 + 4 * fq), gn1 = *(const float4*)(gain + wave * 32 + 16 + 4 * fq);
  bf16_t qraw[19], kraw[19];
  if (KIND == 0) {
#pragma unroll
    for (int i = 0; i < 16; ++i) { qraw[i] = w.proj[(tb + tg * 16 + i) * NPROJ + C_GQ + h * 128 + d]; kraw[i] = w.proj[(tb + tg * 16 + i) * NPROJ + C_GK + h * 128 + d]; }
  } else { conv_load(w, C_MQ + h * 128 + d, b, c, tg, qraw); conv_load(w, C_MK + h * 128 + d, b, c, tg, kraw); }
  float nlv = 0.f;
  if (KIND == 1 && tid < 128) nlv = w.mn[(size_t)(item - 2048) * 128 + tid];
  {
    float qm[16], km[16], qv[16], kv[16];
    if (KIND == 0) {
      float bv[16], blast; gla_gates(p, w, h, tb, ldsb, tid, bv, blast);
#pragma unroll
      for (int i = 0; i < 16; ++i) { qm[i] = 0.08838834764831845f * __expf(bv[i]); km[i] = __expf(-bv[i]); qv[i] = bf2f(qraw[i]); kv[i] = bf2f(kraw[i]); }
    } else {
      mlstm_gates(p, w, h, tb, ldsb, tid);
#pragma unroll
      for (int i = 0; i < 16; ++i) { const float F = Fl[tg * 16 + i]; qm[i] = __expf(F); km[i] = __expf(Fl[64 + tg * 16 + i] - F); }
      conv_apply(p, qraw, h * 128 + d, 1.f, qv);
      conv_apply(p, kraw, 512 + h * 128 + d, 0.08838834764831845f, kv);
      if (tid < 128) nl[tid] = nlv;
    }
#pragma unroll
    for (int i = 0; i < 16; ++i) { qs[(tg * 16 + i) * QS_LD + d] = f2bf(qv[i] * qm[i]); ks[(tg * 16 + i) * QS_LD + d] = f2bf(kv[i] * km[i]); }
  }
  __syncthreads();
#pragma unroll
  for (int q = 0; q < 2; ++q) { const int tt = wave * 2 + q, jt = tt >> 2, it = tt & 3; f32x4 a = (f32x4){0.f, 0.f, 0.f, 0.f};
#pragma unroll
    for (int k4 = 0; k4 < 4; ++k4) { const bf16x8 xk = *(const bf16x8*)(ks + (jt * 16 + fr) * QS_LD + k4 * 32 + fq * 8), yq = *(const bf16x8*)(qs + (it * 16 + fr) * QS_LD + k4 * 32 + fq * 8); a = MFMA16(xk, yq, a); }
    const int i = it * 16 + fr, j0 = jt * 16 + 4 * fq;
    const float v0 = (j0 <= i) ? a[0] : 0.f, v1 = (j0 + 1 <= i) ? a[1] : 0.f, v2 = (j0 + 2 <= i) ? a[2] : 0.f, v3 = (j0 + 3 <= i) ? a[3] : 0.f;
    *(uint2*)(P + i * P_LD + j0) = make_uint2(pack2(v0, v1), pack2(v2, v3)); }
  __syncthreads();
  if (KIND == 1) { const int i = tid >> 3, pt = tid & 7; float f[8]; float s = 0.f;
    unpack8(*(const uint4*)(P + i * P_LD + pt * 8), f);
#pragma unroll
    for (int j = 0; j < 8; ++j) s += f[j];
#pragma unroll
    for (int hh = 0; hh < 2; ++hh) { unpack8(*(const uint4*)(qs + i * QS_LD + pt * 16 + hh * 8), f);
#pragma unroll
      for (int j = 0; j < 8; ++j) s += f[j] * nl[pt * 16 + hh * 8 + j]; }
    s += __shfl_xor(s, 1); s += __shfl_xor(s, 2); s += __shfl_xor(s, 4);
    if (pt == 0) denl[i] = s; }
  f32x4 acc[2][4];
#pragma unroll
  for (int xt = 0; xt < 2; ++xt)
#pragma unroll
    for (int yt = 0; yt < 4; ++yt) acc[xt][yt] = (f32x4){0.f, 0.f, 0.f, 0.f};
#pragma unroll
  for (int k2 = 0; k2 < 2; ++k2)
#pragma unroll
    for (int yt = 0; yt < 4; ++yt) { const bf16x8 yp = *(const bf16x8*)(P + (yt * 16 + fr) * P_LD + k2 * 32 + fq * 8); acc[0][yt] = MFMA16(vx[k2][0], yp, acc[0][yt]); acc[1][yt] = MFMA16(vx[k2][1], yp, acc[1][yt]); }
#pragma unroll
  for (int k4 = 0; k4 < 4; ++k4)
#pragma unroll
    for (int yt = 0; yt < 4; ++yt) { const bf16x8 yq = *(const bf16x8*)(qs + (yt * 16 + fr) * QS_LD + k4 * 32 + fq * 8); acc[0][yt] = MFMA16(sx[k4][0], yq, acc[0][yt]); acc[1][yt] = MFMA16(sx[k4][1], yq, acc[1][yt]); }
  if (KIND == 1) __syncthreads();
#pragma unroll
  for (int yt = 0; yt < 4; ++yt) { float s = 0.f;
    if (KIND == 1) { const float inv = 1.f / fmaxf(fabsf(denl[yt * 16 + fr]), 1.f); acc[0][yt] *= inv; acc[1][yt] *= inv; }
#pragma unroll
    for (int xt = 0; xt < 2; ++xt)
#pragma unroll
      for (int r = 0; r < 4; ++r) s += acc[xt][yt][r] * acc[xt][yt][r];
    s += __shfl_xor(s, 16); s += __shfl_xor(s, 32);
    if (fq == 0) part[wave * 64 + yt * 16 + fr] = s; }
  __syncthreads();
#pragma unroll
  for (int yt = 0; yt < 4; ++yt) { const int i = yt * 16 + fr; float t = 0.f;
#pragma unroll
    for (int ww = 0; ww < 8; ++ww) t += part[ww * 64 + i];
    const float rs = rsqrtf(t * (1.f / 256.f) + EPS);
#pragma unroll
    for (int xt = 0; xt < 2; ++xt) { const int dv = wave * 32 + xt * 16 + 4 * fq;
      const float4 gn = xt == 0 ? gn0 : gn1; const uint2 g2 = gt[yt][xt];
      const float g0 = lo_f(g2.x), g1 = hi_f(g2.x), g2f = lo_f(g2.y), g3 = hi_f(g2.y);
      const float a0 = KIND == 0 ? siluf_(g0) : sigmoidf_(g0), a1 = KIND == 0 ? siluf_(g1) : sigmoidf_(g1), a2 = KIND == 0 ? siluf_(g2f) : sigmoidf_(g2f), a3 = KIND == 0 ? siluf_(g3) : sigmoidf_(g3);
      *(uint2*)(w.y + (tb + i) * D + KIND * 1024 + h * 256 + dv) = make_uint2(pack2(acc[xt][yt][0] * rs * gn.x * a0, acc[xt][yt][1] * rs * gn.y * a1), pack2(acc[xt][yt][2] * rs * gn.z * a2, acc[xt][yt][3] * rs * gn.w * a3)); } }
  __syncthreads();
}
template <int WHICH>
__device__ void phase_mix_items(const Params& p, const WS& w, unsigned char* ldsb, int bid, int nb) {
  for (int item = bid; item < 4096; item += nb) {
    const int kind = item >> 11, b = (item >> 10) & 1, h = (item >> 8) & 3, c = item & 255;
    if (WHICH == 0) { if (kind == 0) mix_local<0>(p, w, b, h, c, item, ldsb); else mix_local<1>(p, w, b, h, c, item, ldsb); }
    else { if (kind == 0) mix_out<0>(p, w, b, h, c, item, ldsb); else mix_out<1>(p, w, b, h, c, item, ldsb); }
  }
}

__device__ __forceinline__ unsigned sort16(unsigned b) { return (b & 0x8000u) ? (~b & 0xffffu) : (b | 0x8000u); }
__device__ __forceinline__ float unsort16(unsigned k) { const unsigned b = (k & 0x8000u) ? (k & 0x7fffu) : (~k & 0xffffu); return __uint_as_float(b << 16); }
__device__ __forceinline__ unsigned sort32(float f) { const unsigned u = __float_as_uint(f); return (u & 0x80000000u) ? ~u : (u | 0x80000000u); }
__device__ __forceinline__ float unsort32(unsigned k) { const unsigned u = (k & 0x80000000u) ? (k & 0x7fffffffu) : ~k; return __uint_as_float(u); }
__device__ void phase_topk(const Params& p, const WS& w, int bid, int nb) {
  for (int th = bid * 512 + tidx(); th < T * 8; th += nb * 512) {
    const int t = th >> 3, h = th & 7;
    const uint4* s = (const uint4*)(w.sc + (size_t)t * D + h * 256);
    unsigned l[2][16];
#pragma unroll
    for (int pp = 0; pp < 2; ++pp) {
#pragma unroll
      for (int i = 0; i < 16; ++i) l[pp][i] = 0u;
      for (int q = 0; q < 16; ++q) {
        const uint4 v = s[pp * 16 + q]; const unsigned wds[4] = {v.x, v.y, v.z, v.w};
#pragma unroll
        for (int e = 0; e < 8; ++e) {
          const unsigned b = (e & 1) ? (wds[e >> 1] >> 16) : (wds[e >> 1] & 0xffffu);
          unsigned x = (sort16(b) << 16) | (unsigned)(q * 8 + e);
#pragma unroll
          for (int i = 0; i < 16; ++i) { const unsigned hi = max(l[pp][i], x); x = min(l[pp][i], x); l[pp][i] = hi; }
        }
      }
    }
    unsigned long long lc[16];
#pragma unroll
    for (int i = 0; i < 16; ++i) lc[i] = 0ull;
#pragma unroll
    for (int i = 0; i < 16; ++i)
#pragma unroll
      for (int j = 0; j < 16; ++j) if ((i + 1) * (j + 1) <= 16) {
        const float sv = unsort16(l[0][i] >> 16) + unsort16(l[1][j] >> 16);
        unsigned long long x = ((unsigned long long)sort32(sv) << 32) | (unsigned long long)((l[0][i] & 0xffffu) * 128u + (l[1][j] & 0xffffu));
#pragma unroll
        for (int k = 0; k < 16; ++k) { const bool gt = x > lc[k]; const unsigned long long hi = gt ? x : lc[k]; x = gt ? lc[k] : x; lc[k] = hi; }
      }
    const float mx = unsort32((unsigned)(lc[0] >> 32));
    float e[16], sum = 0.f;
#pragma unroll
    for (int k = 0; k < 16; ++k) { e[k] = __expf(unsort32((unsigned)(lc[k] >> 32)) - mx); sum += e[k]; }
    const float inv = 1.f / sum;
    int* ei = w.eidx + (size_t)t * 128 + h * 16; float* eg = w.eg + (size_t)t * 128 + h * 16;
#pragma unroll
    for (int k4 = 0; k4 < 4; ++k4) {
      *(int4*)(ei + k4 * 4) = make_int4((int)(lc[k4 * 4] & 0xffffffffu), (int)(lc[k4 * 4 + 1] & 0xffffffffu), (int)(lc[k4 * 4 + 2] & 0xffffffffu), (int)(lc[k4 * 4 + 3] & 0xffffffffu));
      *(float4*)(eg + k4 * 4) = make_float4(e[k4 * 4] * inv, e[k4 * 4 + 1] * inv, e[k4 * 4 + 2] * inv, e[k4 * 4 + 3] * inv);
    }
  }
}
__device__ __forceinline__ void ub16(const uint4 q, float* f) {
  const unsigned wd[4] = {q.x, q.y, q.z, q.w};
#pragma unroll
  for (int k = 0; k < 4; ++k) { f[k * 4] = (float)(wd[k] & 0xffu); f[k * 4 + 1] = (float)((wd[k] >> 8) & 0xffu); f[k * 4 + 2] = (float)((wd[k] >> 16) & 0xffu); f[k * 4 + 3] = (float)(wd[k] >> 24); }
}
__device__ void peer_dots(const Params& p, const WS& w, int bid, int nb) {
  const int tid = tidx(), wave = tid >> 6, lane = tid & 63, r = lane % LPR, q = lane / LPR;
  const int x = bid & 7, nwl = (nb >> 3) * 8, wl = (bid >> 3) * 8 + wave;
  for (int sp = 0; sp < SPL; ++sp) {
    const int s = x * SPL + sp;
    const unsigned char* tab = w.u8 + (size_t)s * 16384 * SLW + r * 16;
    for (int t = wl; t < T; t += nwl) {
      const int idx0 = w.eidx[(size_t)t * 128 + lane], idx1 = w.eidx[(size_t)t * 128 + 64 + lane];
      float hf[16];
      unpack8(*(const uint4*)(w.h1b + (size_t)t * D + s * SLW + r * 16), hf); unpack8(*(const uint4*)(w.h1b + (size_t)t * D + s * SLW + r * 16 + 8), hf + 8);
      float am = 0.f;
#pragma unroll
      for (int j = 0; j < 16; ++j) am = fmaxf(am, fabsf(hf[j]));
#pragma unroll
      for (int o = 1; o < LPR; o <<= 1) am = fmaxf(am, __shfl_xor(am, o));
      const float sh = fmaxf(am, 1e-30f) * (1.f / 127.f), inv = 1.f / sh;
      int hq[4];
#pragma unroll
      for (int k = 0; k < 4; ++k) { unsigned xw = 0;
#pragma unroll
        for (int j = 0; j < 4; ++j) xw |= ((unsigned)(int)rintf(hf[k * 4 + j] * inv) & 0xffu) << (8 * j);
        hq[k] = (int)xw; }
      float res[2] = {0.f, 0.f};
#pragma unroll
      for (int i0 = 0; i0 < NIT; i0 += 8) {
        uint4 b[8];
#pragma unroll
        for (int k = 0; k < 8; ++k) { const int n = (i0 + k) * EPI + q; const int e = __shfl((n & 64) ? idx1 : idx0, n & 63); b[k] = *(const uint4*)(tab + (size_t)e * SLW); }
#pragma unroll
        for (int k = 0; k < 8; ++k) { int a = __builtin_amdgcn_sdot4((int)b[k].x, hq[0], 0, false); a = __builtin_amdgcn_sdot4((int)b[k].y, hq[1], a, false);
          a = __builtin_amdgcn_sdot4((int)b[k].z, hq[2], a, false); a = __builtin_amdgcn_sdot4((int)b[k].w, hq[3], a, false);
#pragma unroll
          for (int o = 1; o < LPR; o <<= 1) a += __shfl_xor(a, o);
          const int i = i0 + k;
          if (r == (i % LPR)) res[i / LPR] = (float)a * sh; }
      }
#pragma unroll
      for (int rho = 0; rho < 2; ++rho) w.pd[((size_t)s * T + t) * 128 + (rho * LPR + r) * EPI + q] = res[rho];
    }
  }
}
__device__ void peer_wgt(const Params& p, const WS& w, int bid, int nb) {
  const int tid = tidx(), wave = tid >> 6, lane = tid & 63;
  for (int t = bid * 8 + wave; t < T; t += nb * 8) {
    const float rs2 = rsqrtf(w.ssq2[t] * (1.f / D) + EPS);
    float tot = 0.f;
#pragma unroll
    for (int hh = 0; hh < 2; ++hh) { const size_t o = (size_t)t * 128 + hh * 64 + lane; float z = 0.f;
#pragma unroll
      for (int s = 0; s < NSL; ++s) z += w.pd[(size_t)s * T * 128 + o];
      const int e = w.eidx[o];
      const float wv = w.eg[o] * gelu_tanh(z * w.usc[e] * rs2) * w.vsc[e];
      w.eg[o] = wv; tot += wv; }
    tot = wave_sum(tot);
    if (lane == 0) w.wsum[t] = tot;
  }
}
__device__ void peer_vals(const Params& p, const WS& w, int bid, int nb) {
  const int tid = tidx(), wave = tid >> 6, lane = tid & 63, r = lane % LPR, q = lane / LPR;
  const int x = bid & 7, nwl = (nb >> 3) * 8, wl = (bid >> 3) * 8 + wave;
  for (int sp = 0; sp < SPL; ++sp) {
    const int s = x * SPL + sp;
    const unsigned char* tab = w.v8 + (size_t)s * 16384 * SLW + r * 16;
    for (int t = wl; t < T; t += nwl) {
      const int idx0 = w.eidx[(size_t)t * 128 + lane], idx1 = w.eidx[(size_t)t * 128 + 64 + lane];
      const float w0 = w.eg[(size_t)t * 128 + lane], w1 = w.eg[(size_t)t * 128 + 64 + lane];
      float acc[16];
#pragma unroll
      for (int j = 0; j < 16; ++j) acc[j] = 0.f;
#pragma unroll
      for (int i0 = 0; i0 < NIT; i0 += 8) {
        uint4 b[8]; float wn[8];
#pragma unroll
        for (int k = 0; k < 8; ++k) { const int n = (i0 + k) * EPI + q; const int e = __shfl((n & 64) ? idx1 : idx0, n & 63); wn[k] = __shfl((n & 64) ? w1 : w0, n & 63); b[k] = *(const uint4*)(tab + (size_t)e * SLW); }
#pragma unroll
        for (int k = 0; k < 8; ++k) { float f[16]; ub16(b[k], f);
#pragma unroll
          for (int j = 0; j < 16; ++j) acc[j] += wn[k] * f[j]; }
      }
#pragma unroll
      for (int o = LPR; o < 64; o <<= 1)
#pragma unroll
        for (int j = 0; j < 16; ++j) acc[j] += __shfl_xor(acc[j], o);
      float hf[16]; float ss = 0.f;
      unpack8(*(const uint4*)(w.h1b + (size_t)t * D + s * SLW + r * 16), hf); unpack8(*(const uint4*)(w.h1b + (size_t)t * D + s * SLW + r * 16 + 8), hf + 8);
      const float off = 128.f * w.wsum[t];
#pragma unroll
      for (int j = 0; j < 16; ++j) { acc[j] += hf[j] - off; ss += acc[j] * acc[j]; }
      if (q == 0) { *(uint4*)(w.h2b + (size_t)t * D + s * SLW + r * 16) = pack8(acc); *(uint4*)(w.h2b + (size_t)t * D + s * SLW + r * 16 + 8) = pack8(acc + 8); } else ss = 0.f;
      ss = wave_sum(ss);
      if (lane == 0) atomicAdd(w.ssq3 + t, ss);
    }
  }
}
__device__ void phase_final(const Params& p, const WS& w, int bid, int nb) {
  const int wave = tidx() >> 6, lane = tidx() & 63;
  for (int row = bid * 8 + wave; row < T; row += nb * 8) {
    float4* o = (float4*)(p.out + (size_t)row * D);
    const float rs = rsqrtf(w.ssq4[row] * (1.f / D) + EPS);
#pragma unroll
    for (int i = 0; i < 8; ++i) { float4 v = o[i * 64 + lane]; const float4 g = *(const float4*)(p.norm_final + (i * 64 + lane) * 4); v.x *= rs * g.x; v.y *= rs * g.y; v.z *= rs * g.z; v.w *= rs * g.w; o[i * 64 + lane] = v; }
  }
}

constexpr int NPHASE = 10;
#ifndef FAST_MIX
#define FAST_MIX 1
#endif
template <int PH>
__device__ __forceinline__ void run_phase(const Params& p, float* lds, int bid, int nb) {
  const WS w = make_ws(p.ws, p.out);
  if (PH == 0) phase_prep(p, w, lds, bid, nb);
  if (PH == 1) { gemm_any(w.xb, w.win, T, NPROJ, D, EpiProjN{w.proj, w.rstd1}, lds, bid, nb);
                 gemm_any(w.win + (size_t)NPROJ * D, w.xb, 2048, T, D, EpiProjT{w.vT, w.rstd1}, lds, bid, nb); }
#if FAST_MIX
  if (PH == 2) phase_mix_items<0>(p, w, (unsigned char*)lds, bid, nb);
  if (PH == 3) mix_scan(p, w, bid, nb);
  if (PH == 4) phase_mix_items<1>(p, w, (unsigned char*)lds, bid, nb);
#else
  if (PH == 2) phase_mixer_naive(p, w, lds, bid, nb);
#endif
  if (PH == 5) gemm_any(w.y, w.wout, T, D, D, EpiOut{p.x, w.h1b, w.ssq2}, lds, bid, nb);
  if (PH == 6) gemm_any(w.h1b, w.wq, T, D, D, EpiScore{w.sc, w.ssq2}, lds, bid, nb);
  if (PH == 7) { phase_topk(p, w, bid, nb); gemm_any(w.pb, w.wple, T, D, 256, EpiPl{w.pl}, lds, bid, nb); }
  if (PH == 8) peer_dots(p, w, bid, nb);
  if (PH == 9) peer_wgt(p, w, bid, nb);
  if (PH == 10) peer_vals(p, w, bid, nb);
  if (PH == 11) gemm_any(w.h2b, w.wg, T, D, D, EpiGate{w.h2b, w.pl, w.ssq3, p.out, w.ssq4}, lds, bid, nb);
  if (PH == 12) phase_final(p, w, bid, nb);
}

extern __shared__ __attribute__((aligned(16))) unsigned char dyn_lds[];

#if ONE_LAUNCH
__global__ void __launch_bounds__(512, 2) mega(Params p) {
  cg::grid_group grid = cg::this_grid();
  float* lds = (float*)dyn_lds; const int bid = blockIdx.x, nb = gridDim.x;
#ifndef DUP_PHASE
#define DUP_PHASE -1
#endif
#define RUNP(k) do { run_phase<k>(p, lds, bid, nb); if (DUP_PHASE == (k)) { grid.sync(); run_phase<k>(p, lds, bid, nb); } } while (0)
  RUNP(0); grid.sync();
  RUNP(1); grid.sync();
  RUNP(2); grid.sync();
#if FAST_MIX
  RUNP(3); grid.sync();
  RUNP(4); grid.sync();
#endif
  RUNP(5); grid.sync();
  RUNP(6); grid.sync();
  RUNP(7); grid.sync();
  RUNP(8); grid.sync();
  RUNP(9); grid.sync();
  RUNP(10); grid.sync();
  RUNP(11); grid.sync();
  RUNP(12);
#undef RUNP
}
#else
template <int PH> __global__ void __launch_bounds__(512, 2) k_phase(Params p) { run_phase<PH>(p, (float*)dyn_lds, blockIdx.x, gridDim.x); }
#endif

constexpr size_t kDynLds = 131072;

extern "C" void kernel_launch(void* const* d_in, const int* in_sizes, int n_in, void* d_out, int out_size, void* d_ws, size_t ws_size, hipStream_t stream) {
  if (n_in != 22 || out_size != T * D || ws_size < WS_NEED) { fprintf(stderr, "kernel_launch: unexpected shapes (n_in %d out %d ws %zu)\n", n_in, out_size, ws_size); return; }
  Params p{};
  const float** f = (const float**)&p;
  for (int i = 0; i < 22; ++i) f[i] = (const float*)d_in[i];
  p.out = (float*)d_out; p.ws = (unsigned char*)d_ws;
#if ONE_LAUNCH
  static int grid_blocks = 0;
  if (!grid_blocks) {
    int dev = 0, cus = 0, per_cu = 0;
    (void)hipGetDevice(&dev); (void)hipDeviceGetAttribute(&cus, hipDeviceAttributeMultiprocessorCount, dev);
    (void)hipFuncSetAttribute((const void*)mega, hipFuncAttributeMaxDynamicSharedMemorySize, (int)kDynLds);
    (void)hipOccupancyMaxActiveBlocksPerMultiprocessor(&per_cu, mega, 512, kDynLds);
    if (per_cu < 1) { fprintf(stderr, "occupancy query says 0 blocks/CU\n"); per_cu = 1; }
    grid_blocks = cus;
  }
  void* args[] = {&p};
  hipError_t e = hipLaunchCooperativeKernel((void*)mega, dim3(grid_blocks), dim3(512), args, kDynLds, stream);
  if (e != hipSuccess) fprintf(stderr, "cooperative launch failed: %s (grid %d)\n", hipGetErrorString(e), grid_blocks);
#else
  static bool attr = false;
  const int G = 256;
#define LAUNCH(PH) do { if (!attr) (void)hipFuncSetAttribute((const void*)k_phase<PH>, hipFuncAttributeMaxDynamicSharedMemorySize, (int)kDynLds); \
    hipLaunchKernelGGL(k_phase<PH>, dim3(G), dim3(512), kDynLds, stream, p); } while (0)
  LAUNCH(0); LAUNCH(1); LAUNCH(2); LAUNCH(3); LAUNCH(4); LAUNCH(5); LAUNCH(6); LAUNCH(7); LAUNCH(8); LAUNCH(9); LAUNCH(10); LAUNCH(11); LAUNCH(12);
  attr = true;
#undef LAUNCH
#endif
}
```

```cpp
#include <hip/hip_runtime.h>
#include <hip/hip_cooperative_groups.h>
#include <cstdio>
#include <cstdint>
namespace cg = cooperative_groups;

#ifndef ONE_LAUNCH
#define ONE_LAUNCH 1
#endif

typedef unsigned short bf16_t;
constexpr int T = 32768, SEQ = 16384, D = 2048;
constexpr int NPROJ = 4352;
constexpr int C_GQ = 0, C_GK = 512, C_GG = 1024, C_MQ = 2048, C_MK = 2560, C_MO = 3072, C_SM = 4096;
constexpr float EPS = 1e-6f;
constexpr size_t MiB = 1ull << 20;
constexpr size_t OFF_XB = 0, OFF_Y = 0, OFF_PL = 0;
constexpr size_t OFF_PROJ = 128 * MiB, OFF_H1B = 128 * MiB, OFF_H2B = 256 * MiB;
constexpr size_t OFF_VT = 400 * MiB, OFF_SC = 400 * MiB;
constexpr size_t OFF_UB = 528 * MiB, OFF_VB = 592 * MiB;
constexpr size_t OFF_WIN = 656 * MiB, OFF_WOUT = 681 * MiB, OFF_WQ = 689 * MiB, OFF_WG = 697 * MiB, OFF_WPLE = 705 * MiB;
constexpr size_t OFF_PB = 706 * MiB, OFF_EIDX = 722 * MiB, OFF_EG = 738 * MiB, OFF_MISC = 754 * MiB;
constexpr size_t OFF_GDEC = 755 * MiB, OFF_MN = 756 * MiB, OFF_MDEC = 757 * MiB, OFF_ESC = 758 * MiB;
constexpr size_t OFF_CTL = 759 * MiB, OFF_H2Q = 400 * MiB;
constexpr size_t WS_NEED = 760 * MiB;
#ifndef F8_IN
#define F8_IN 0
#endif
#ifndef F8_OUT
#define F8_OUT 1
#endif
#ifndef F8_GATE
#define F8_GATE 1
#endif
#ifndef F8_GEMM
#define F8_GEMM (F8_IN || F8_OUT || F8_GATE)
#endif

struct Params {
  const float *x, *p, *norm_mix, *w_in, *gate_up, *gate_bias, *gla_norm, *conv_w, *conv_b, *ig_bias, *fg_bias, *mlstm_norm,
      *w_out, *norm_ffn, *peer_query, *sub_keys, *peer_u, *peer_v, *norm_ple, *w_ple, *w_ple_gate, *norm_final;
  float* out;
  unsigned char* ws;
};

__device__ __forceinline__ float bf2f(bf16_t b) { return __uint_as_float(((unsigned)b) << 16); }
typedef __bf16 bf16v2_t __attribute__((ext_vector_type(2)));
__device__ __forceinline__ bf16_t f2bf(float f) { const __bf16 b = (__bf16)f; return __builtin_bit_cast(bf16_t, b); }
__device__ __forceinline__ unsigned pack2(float lo, float hi) { const bf16v2_t v = {(__bf16)lo, (__bf16)hi}; return __builtin_bit_cast(unsigned, v); }
__device__ __forceinline__ unsigned pack4_fp8(float a, float b, float c, float d) { int v = __builtin_amdgcn_cvt_pk_fp8_f32(a, b, 0, false); v = __builtin_amdgcn_cvt_pk_fp8_f32(c, d, v, true); return (unsigned)v; }
__device__ __forceinline__ float lo_f(unsigned u) { return __uint_as_float(u << 16); }
__device__ __forceinline__ float hi_f(unsigned u) { return __uint_as_float(u & 0xffff0000u); }
__device__ __forceinline__ int tidx() { int t = threadIdx.x; asm volatile("" : "+v"(t)); return t; }
template <int O> __device__ __forceinline__ int sxor_i(int v) {
  if constexpr (O < 32) return __builtin_amdgcn_ds_swizzle(v, (O << 10) | 0x1f);
  else return __builtin_amdgcn_ds_bpermute(((tidx() & 63) ^ 32) << 2, v);
}
template <int O> __device__ __forceinline__ float sxor(float v) { return __int_as_float(sxor_i<O>(__float_as_int(v))); }
template <int O> __device__ __forceinline__ int sxor(int v) { return sxor_i<O>(v); }
__device__ __forceinline__ int bperm(int v, int src_lane) { return __builtin_amdgcn_ds_bpermute(src_lane << 2, v); }
__device__ __forceinline__ float bperm(float v, int src_lane) { return __int_as_float(__builtin_amdgcn_ds_bpermute(src_lane << 2, __float_as_int(v))); }
template <int N> __device__ __forceinline__ float gsum(float v) {
  if constexpr (N >= 2) v += sxor<1>(v); if constexpr (N >= 4) v += sxor<2>(v); if constexpr (N >= 8) v += sxor<4>(v);
  if constexpr (N >= 16) v += sxor<8>(v); if constexpr (N >= 32) v += sxor<16>(v); if constexpr (N >= 64) v += sxor<32>(v); return v; }
template <int N> __device__ __forceinline__ int gsum(int v) {
  if constexpr (N >= 2) v += sxor<1>(v); if constexpr (N >= 4) v += sxor<2>(v); if constexpr (N >= 8) v += sxor<4>(v);
  if constexpr (N >= 16) v += sxor<8>(v); if constexpr (N >= 32) v += sxor<16>(v); if constexpr (N >= 64) v += sxor<32>(v); return v; }
template <int N> __device__ __forceinline__ float gmax(float v) {
  if constexpr (N >= 2) v = fmaxf(v, sxor<1>(v)); if constexpr (N >= 4) v = fmaxf(v, sxor<2>(v)); if constexpr (N >= 8) v = fmaxf(v, sxor<4>(v));
  if constexpr (N >= 16) v = fmaxf(v, sxor<8>(v)); if constexpr (N >= 32) v = fmaxf(v, sxor<16>(v)); if constexpr (N >= 64) v = fmaxf(v, sxor<32>(v)); return v; }
__device__ __forceinline__ float wave_sum(float v) { return gsum<64>(v); }
__device__ __forceinline__ float sigmoidf_(float x) { return __builtin_amdgcn_rcpf(1.f + __expf(-x)); }
__device__ __forceinline__ float siluf_(float x) { return x * __builtin_amdgcn_rcpf(1.f + __expf(-x)); }
__device__ __forceinline__ float logsigmoidf_(float x) { return fminf(x, 0.f) - __logf(1.f + __expf(-fabsf(x))); }
__device__ __forceinline__ float gelu_tanh(float x) { const float u = 0.7978845608028654f * (x + 0.044715f * x * x * x); return x * __builtin_amdgcn_rcpf(1.f + __expf(-2.f * u)); }
__device__ __forceinline__ void unpack8(const uint4 q, float* f) {
  f[0] = lo_f(q.x); f[1] = hi_f(q.x); f[2] = lo_f(q.y); f[3] = hi_f(q.y); f[4] = lo_f(q.z); f[5] = hi_f(q.z); f[6] = lo_f(q.w); f[7] = hi_f(q.w);
}
__device__ __forceinline__ uint4 pack8(const float* f) { return make_uint4(pack2(f[0], f[1]), pack2(f[2], f[3]), pack2(f[4], f[5]), pack2(f[6], f[7])); }

struct WS {
  bf16_t *xb, *y, *pl, *proj, *h1b, *h2b, *vT, *sc, *ub, *vb, *win, *wout, *wq, *wg, *wple, *pb;
  int* eidx; float* eg; float *rstd1, *ssq2, *ssq3, *ssq4, *wsum, *gdec, *mn, *mdec, *usc, *vsc, *pd;
  unsigned char *u8, *v8, *xq, *yq, *h2q, *winq, *woutq, *wgq;
  float* ctlf;
};
__device__ __forceinline__ WS make_ws(unsigned char* ws, float* out) {
  WS w;
  w.xb = (bf16_t*)(ws + OFF_XB); w.y = (bf16_t*)(ws + OFF_Y); w.pl = (bf16_t*)(ws + OFF_PL); w.proj = (bf16_t*)(ws + OFF_PROJ);
  w.h1b = (bf16_t*)(ws + OFF_H1B); w.h2b = (bf16_t*)(ws + OFF_H2B); w.vT = (bf16_t*)(ws + OFF_VT); w.sc = (bf16_t*)(ws + OFF_SC);
  w.ub = (bf16_t*)(ws + OFF_UB); w.vb = (bf16_t*)(ws + OFF_VB); w.win = (bf16_t*)(ws + OFF_WIN); w.wout = (bf16_t*)(ws + OFF_WOUT);
  w.wq = (bf16_t*)(ws + OFF_WQ); w.wg = (bf16_t*)(ws + OFF_WG); w.wple = (bf16_t*)(ws + OFF_WPLE); w.pb = (bf16_t*)(ws + OFF_PB);
  w.eidx = (int*)(ws + OFF_EIDX); w.eg = (float*)(ws + OFF_EG);
  float* m = (float*)(ws + OFF_MISC); w.rstd1 = m; w.ssq2 = m + T; w.ssq3 = m + 2 * T; w.ssq4 = m + 3 * T; w.wsum = m + 4 * T;
  w.gdec = (float*)(ws + OFF_GDEC); w.mn = (float*)(ws + OFF_MN); w.mdec = (float*)(ws + OFF_MDEC);
  w.usc = (float*)(ws + OFF_ESC); w.vsc = w.usc + 16384; w.u8 = ws + OFF_UB; w.v8 = ws + OFF_VB; w.pd = out;
  w.xq = ws + OFF_XB; w.yq = ws + OFF_Y; w.h2q = ws + OFF_H2Q; w.winq = ws + OFF_WIN; w.woutq = ws + OFF_WOUT; w.wgq = ws + OFF_WG; w.ctlf = (float*)(ws + OFF_CTL);
  return w;
}

__device__ void prep_x(const Params& p, const WS& w, int bid, int nb) {
  const int wave = tidx() >> 6, lane = tidx() & 63;
  for (int row = bid * 8 + wave; row < T; row += nb * 8) {
    const float4* src = (const float4*)(p.x + (size_t)row * D);
    float4 v[8]; float ss = 0.f;
#pragma unroll
    for (int i = 0; i < 8; ++i) { v[i] = src[i * 64 + lane]; ss += v[i].x * v[i].x + v[i].y * v[i].y + v[i].z * v[i].z + v[i].w * v[i].w; }
    ss = wave_sum(ss);
    const float rs = rsqrtf(ss * (1.f / D) + EPS);
#if F8_IN
    unsigned* dst = (unsigned*)(w.xq + (size_t)row * D);
#pragma unroll
    for (int i = 0; i < 8; ++i) dst[i * 64 + lane] = pack4_fp8(v[i].x * rs, v[i].y * rs, v[i].z * rs, v[i].w * rs);
#else
    uint2* dst = (uint2*)(w.xb + (size_t)row * D);
#pragma unroll
    for (int i = 0; i < 8; ++i) dst[i * 64 + lane] = make_uint2(pack2(v[i].x, v[i].y), pack2(v[i].z, v[i].w));
#endif
    if (lane == 0) w.rstd1[row] = rs;
  }
}
__device__ void absmax_w(const float* src, size_t n, const float* gain, int ncols, float* part, float* lds, int bid, int nb) {
  float m = 0.f;
  for (size_t i = (size_t)bid * 512 + tidx(); i < n / 4; i += (size_t)nb * 512) { const float4 v = ((const float4*)src)[i]; const float g = gain ? gain[(i * 4) / (size_t)ncols] : 1.f;
    m = fmaxf(m, fabsf(g) * fmaxf(fmaxf(fabsf(v.x), fabsf(v.y)), fmaxf(fabsf(v.z), fabsf(v.w)))); }
  m = gmax<64>(m);
  __syncthreads();
  if ((tidx() & 63) == 0) lds[tidx() >> 6] = m;
  __syncthreads();
  if (tidx() == 0) { float t = lds[0];
#pragma unroll
    for (int i = 1; i < 8; ++i) t = fmaxf(t, lds[i]);
    part[bid] = t; }
  __syncthreads();
}
__device__ float amax_reduce(const float* part, float* lds, int nb) {
  float m = 0.f;
  for (int i = tidx(); i < nb; i += 512) m = fmaxf(m, part[i]);
  m = gmax<64>(m);
  __syncthreads();
  if ((tidx() & 63) == 0) lds[tidx() >> 6] = m;
  __syncthreads();
  float t = lds[0];
#pragma unroll
  for (int i = 1; i < 8; ++i) t = fmaxf(t, lds[i]);
  return t;
}
__device__ void cvt_rows(const float* src, bf16_t* dst, size_t n, const float* gain, int ncols, int bid, int nb) {
  const size_t n4 = n / 4;
  for (size_t i = (size_t)bid * 512 + tidx(); i < n4; i += (size_t)nb * 512) {
    float4 v = ((const float4*)src)[i];
    if (gain) { const float4 g = *(const float4*)(gain + (int)((i * 4) % (size_t)ncols)); v.x *= g.x; v.y *= g.y; v.z *= g.z; v.w *= g.w; }
    ((uint2*)dst)[i] = make_uint2(pack2(v.x, v.y), pack2(v.z, v.w));
  }
}
template <bool F8OUT, class CM>
__device__ void transpose_w(const float* src, int K, int ldsrc, void* dstv, int Ndst, const float* gain, CM cm, float amax, float* lds, int bid, int nb) {
  const int tid = tidx(), tk = K / 64, ntile = (Ndst / 64) * tk;
  const float qs = F8OUT ? 256.f / fmaxf(amax, 1e-30f) : 1.f;
  for (int tile = bid; tile < ntile; tile += nb) {
    const int n0 = (tile / tk) * 64, k0 = (tile % tk) * 64;
    const int nc = tid & 63, sc = cm(n0 + nc);
#pragma unroll
    for (int i = 0; i < 8; ++i) { const int kr = (tid >> 6) + 8 * i; float v = 0.f; if (sc >= 0) { v = src[(size_t)(k0 + kr) * ldsrc + sc]; if (gain) v *= gain[k0 + kr]; } lds[kr * 65 + nc] = v * qs; }
    __syncthreads();
    { const int nr = tid >> 3, ks = (tid & 7) * 8; float f[8];
#pragma unroll
      for (int j = 0; j < 8; ++j) f[j] = lds[(ks + j) * 65 + nr];
      if (F8OUT) *(uint2*)((unsigned char*)dstv + (size_t)(n0 + nr) * K + k0 + ks) = make_uint2(pack4_fp8(f[0], f[1], f[2], f[3]), pack4_fp8(f[4], f[5], f[6], f[7]));
      else *(uint4*)((bf16_t*)dstv + (size_t)(n0 + nr) * K + k0 + ks) = pack8(f); }
    __syncthreads();
  }
}
struct CmIdent { __device__ int operator()(int n) const { return n; } };
struct CmWin {
  __device__ int operator()(int n) const {
    if (n < 1024) return n;
    if (n < 2048) return 2048 + (n - 1024);
    if (n < 2560) return 3088 + (n - 2048);
    if (n < 3072) return 3600 + (n - 2560);
    if (n < 4096) return 5136 + (n - 3072);
    if (n < 4352) { const int i = n - 4096; if (i < 16) return 3072 + i; if (i < 20) return 6160 + (i - 16); if (i < 24) return 6164 + (i - 20); return -1; }
    const int j = n - 4352; if (j < 1024) return 1024 + j;
    return 4112 + (j - 1024);
  }
};
__device__ void prep_wq(const Params& p, const WS& w, float* lds, int bid, int nb) {
  const int tid = tidx();
  float* SKs = lds;
  float* WQs = lds + 128 * 132;
  for (int item = bid; item < 16 * 32; item += nb) {
    const int hp = item >> 5, k0 = (item & 31) * 64;
#pragma unroll
    for (int i = 0; i < 8; ++i) { const int e4 = tid + 512 * i, key = e4 >> 5, d4 = (e4 & 31) * 4; *(float4*)(SKs + key * 132 + d4) = *(const float4*)(p.sub_keys + (size_t)hp * 16384 + key * 128 + d4); }
#pragma unroll
    for (int i = 0; i < 4; ++i) { const int e4 = tid + 512 * i, kr = e4 >> 5, d4 = (e4 & 31) * 4; float4 v = *(const float4*)(p.peer_query + (size_t)(k0 + kr) * 2048 + hp * 128 + d4); const float g = p.norm_ffn[k0 + kr]; v.x *= g; v.y *= g; v.z *= g; v.w *= g; *(float4*)(WQs + kr * 132 + d4) = v; }
    __syncthreads();
    const int k = tid & 63, kg = tid >> 6;
    float acc[16];
#pragma unroll
    for (int j = 0; j < 16; ++j) acc[j] = 0.f;
    for (int d4 = 0; d4 < 32; ++d4) {
      const float4 a = *(const float4*)(WQs + k * 132 + d4 * 4);
#pragma unroll
      for (int j = 0; j < 16; ++j) { const float4 s = *(const float4*)(SKs + (kg * 16 + j) * 132 + d4 * 4); acc[j] += a.x * s.x + a.y * s.y + a.z * s.z + a.w * s.w; }
    }
#pragma unroll
    for (int j = 0; j < 16; ++j) w.wq[(size_t)(hp * 128 + kg * 16 + j) * 2048 + k0 + k] = f2bf(acc[j]);
    __syncthreads();
  }
}

#ifndef PEER_SLW
#define PEER_SLW 256
#endif
constexpr int SLW = PEER_SLW, LPR = SLW / 16, EPI = 64 / LPR, NSL = 2048 / SLW, SPL = NSL / 8, NIT = 128 / EPI;
template <bool SIGNED>
__device__ void quant_rows(const float* src, const float* gain, unsigned char* dst, float* scale, int bid, int nb) {
  const int tid = tidx(), wave = tid >> 6, lane = tid & 63;
  for (int row = bid * 8 + wave; row < 16384; row += nb * 8) {
    float f[32]; float mx = 0.f;
#pragma unroll
    for (int i = 0; i < 2; ++i)
#pragma unroll
      for (int q = 0; q < 4; ++q) { float4 v = *(const float4*)(src + (size_t)row * 2048 + i * 1024 + lane * 16 + q * 4);
        if (gain) { const float4 g = *(const float4*)(gain + i * 1024 + lane * 16 + q * 4); v.x *= g.x; v.y *= g.y; v.z *= g.z; v.w *= g.w; }
        f[i * 16 + q * 4] = v.x; f[i * 16 + q * 4 + 1] = v.y; f[i * 16 + q * 4 + 2] = v.z; f[i * 16 + q * 4 + 3] = v.w;
        mx = fmaxf(mx, fmaxf(fmaxf(fabsf(v.x), fabsf(v.y)), fmaxf(fabsf(v.z), fabsf(v.w)))); }
    mx = gmax<64>(mx);
    const float sc = fmaxf(mx, 1e-30f) * (1.f / 127.f), inv = 1.f / sc;
#pragma unroll
    for (int i = 0; i < 2; ++i) { unsigned wd[4];
#pragma unroll
      for (int q = 0; q < 4; ++q) { unsigned x = 0;
#pragma unroll
        for (int j = 0; j < 4; ++j) { const int v = (int)rintf(f[i * 16 + q * 4 + j] * inv) + (SIGNED ? 0 : 128); x |= ((unsigned)v & 0xffu) << (8 * j); }
        wd[q] = x; }
      const int el = i * 1024 + lane * 16;
      *(uint4*)(dst + ((size_t)(el / SLW) * 16384 + row) * SLW + (el % SLW)) = make_uint4(wd[0], wd[1], wd[2], wd[3]); }
    if (lane == 0) scale[row] = sc;
  }
}
__device__ void phase_prep(const Params& p, const WS& w, float* lds, int bid, int nb) {
  prep_x(p, w, bid, nb);
#if F8_IN
  absmax_w(p.w_in, (size_t)2048 * 6168, p.norm_mix, 6168, w.ctlf + 1024, lds, bid, nb);
#else
  transpose_w<false>(p.w_in, 2048, 6168, w.win, 6400, p.norm_mix, CmWin(), 0.f, lds, bid, nb);
#endif
#if F8_OUT
  absmax_w(p.w_out, (size_t)2048 * 2048, nullptr, 2048, w.ctlf + 2048, lds, bid, nb);
#else
  transpose_w<false>(p.w_out, 2048, 2048, w.wout, 2048, nullptr, CmIdent(), 0.f, lds, bid, nb);
#endif
#if F8_GATE
  absmax_w(p.w_ple_gate, (size_t)2048 * 2048, p.norm_ple, 2048, w.ctlf + 3072, lds, bid, nb);
#else
  transpose_w<false>(p.w_ple_gate, 2048, 2048, w.wg, 2048, p.norm_ple, CmIdent(), 0.f, lds, bid, nb);
#endif
  cvt_rows(p.p, w.pb, (size_t)T * 256, nullptr, 256, bid, nb);
  quant_rows<true>(p.peer_u, p.norm_ffn, w.u8, w.usc, bid, nb);
  quant_rows<false>(p.peer_v, nullptr, w.v8, w.vsc, bid, nb);
  transpose_w<false>(p.w_ple, 256, 2048, w.wple, 2048, nullptr, CmIdent(), 0.f, lds, bid, nb);
  prep_wq(p, w, lds, bid, nb);
  for (int i = bid * 512 + tidx(); i < T; i += nb * 512) { w.ssq2[i] = 0.f; w.ssq3[i] = 0.f; w.ssq4[i] = 0.f; }
}
__device__ void phase_prep2(const Params& p, const WS& w, float* lds, int bid, int nb) {
#if F8_IN
  { const float a0 = amax_reduce(w.ctlf + 1024, lds, nb); if (bid == 0 && tidx() == 0) w.ctlf[0] = a0; __syncthreads();
    transpose_w<true>(p.w_in, 2048, 6168, w.winq, 6400, p.norm_mix, CmWin(), a0, lds, bid, nb); }
#endif
#if F8_OUT
  { const float a1 = amax_reduce(w.ctlf + 2048, lds, nb); if (bid == 0 && tidx() == 0) w.ctlf[1] = a1; __syncthreads();
    transpose_w<true>(p.w_out, 2048, 2048, w.woutq, 2048, nullptr, CmIdent(), a1, lds, bid, nb); }
#endif
#if F8_GATE
  { const float a2 = amax_reduce(w.ctlf + 3072, lds, nb); if (bid == 0 && tidx() == 0) w.ctlf[2] = a2; __syncthreads();
    transpose_w<true>(p.w_ple_gate, 2048, 2048, w.wgq, 2048, p.norm_ple, CmIdent(), a2, lds, bid, nb); }
#endif
}

struct EpiProjN { bf16_t* out; const float* rstd; float ws; static constexpr bool ROWSUM = false;
  __device__ __forceinline__ float store8(int r, int c, const float* v) const { const float s = F8_IN ? ws : rstd[r]; float f[8];
#pragma unroll
    for (int j = 0; j < 8; ++j) f[j] = v[j] * s;
    *(uint4*)(out + (size_t)r * NPROJ + c) = pack8(f); return 0.f; }
  __device__ __forceinline__ void rowsum(int, float) const {} };
struct EpiProjT { bf16_t* out; const float* rstd; float ws; static constexpr bool ROWSUM = false;
  __device__ __forceinline__ float store8(int r, int c, const float* v) const { const float4 s0 = F8_IN ? make_float4(ws, ws, ws, ws) : *(const float4*)(rstd + c), s1 = F8_IN ? s0 : *(const float4*)(rstd + c + 4); float f[8];
    f[0] = v[0] * s0.x; f[1] = v[1] * s0.y; f[2] = v[2] * s0.z; f[3] = v[3] * s0.w; f[4] = v[4] * s1.x; f[5] = v[5] * s1.y; f[6] = v[6] * s1.z; f[7] = v[7] * s1.w;
    *(uint4*)(out + (size_t)r * T + c) = pack8(f); return 0.f; }
  __device__ __forceinline__ void rowsum(int, float) const {} };
struct EpiOut { const float* x; bf16_t* h1b; float* ssq; float ws; static constexpr bool ROWSUM = true;
  __device__ __forceinline__ float store8(int r, int c, const float* v) const { const float4 x0 = *(const float4*)(x + (size_t)r * D + c), x1 = *(const float4*)(x + (size_t)r * D + c + 4); float f[8];
    f[0] = v[0] * ws + x0.x; f[1] = v[1] * ws + x0.y; f[2] = v[2] * ws + x0.z; f[3] = v[3] * ws + x0.w; f[4] = v[4] * ws + x1.x; f[5] = v[5] * ws + x1.y; f[6] = v[6] * ws + x1.z; f[7] = v[7] * ws + x1.w;
    float s = 0.f;
#pragma unroll
    for (int j = 0; j < 8; ++j) s += f[j] * f[j];
    *(uint4*)(h1b + (size_t)r * D + c) = pack8(f); return s; }
  __device__ __forceinline__ void rowsum(int r, float s) const { atomicAdd(ssq + r, s); } };
struct EpiScore { bf16_t* sc; const float* ssq; static constexpr bool ROWSUM = false;
  __device__ __forceinline__ float store8(int r, int c, const float* v) const { const float s = rsqrtf(ssq[r] * (1.f / D) + EPS); float f[8];
#pragma unroll
    for (int j = 0; j < 8; ++j) f[j] = v[j] * s;
    *(uint4*)(sc + (size_t)r * D + c) = pack8(f); return 0.f; }
  __device__ __forceinline__ void rowsum(int, float) const {} };
struct EpiPl { bf16_t* pl; static constexpr bool ROWSUM = false;
  __device__ __forceinline__ float store8(int r, int c, const float* v) const { *(uint4*)(pl + (size_t)r * D + c) = pack8(v); return 0.f; }
  __device__ __forceinline__ void rowsum(int, float) const {} };
struct EpiGate { const bf16_t* h2b; const bf16_t* pl; const float* ssq3; float* out; float* ssq; const float* ssq2; float ws; static constexpr bool ROWSUM = true;
  __device__ __forceinline__ float store8(int r, int c, const float* v) const { const float rs = rsqrtf(ssq3[r] * (1.f / D) + EPS) * (F8_GATE ? ws * sqrtf(ssq2[r] * (1.f / D) + EPS) : 1.f); float h[8], q[8], f[8];
    unpack8(*(const uint4*)(h2b + (size_t)r * D + c), h); unpack8(*(const uint4*)(pl + (size_t)r * D + c), q);
    float s = 0.f;
#pragma unroll
    for (int j = 0; j < 8; ++j) { f[j] = h[j] + sigmoidf_(v[j] * rs) * q[j]; s += f[j] * f[j]; }
    *(float4*)(out + (size_t)r * D + c) = make_float4(f[0], f[1], f[2], f[3]); *(float4*)(out + (size_t)r * D + c + 4) = make_float4(f[4], f[5], f[6], f[7]); return s; }
  __device__ __forceinline__ void rowsum(int r, float s) const { atomicAdd(ssq + r, s); } };

template <class Epi>
__device__ void gemm_naive(const bf16_t* A, const bf16_t* Bt, int M, int N, int K, const Epi& E, float* lds, int bid, int nb) {
  const int tid = tidx(), ty = tid >> 4, tx = tid & 15;
  float* As = lds;
  float* Bs = lds + 32 * 132;
  const int nM = M / 128, nN = N / 128;
  for (int tile = bid; tile < nM * nN; tile += nb) {
    const int m0 = (tile % nM) * 128, n0 = (tile / nM) * 128;
    float acc[4][8];
#pragma unroll
    for (int i = 0; i < 4; ++i)
#pragma unroll
      for (int j = 0; j < 8; ++j) acc[i][j] = 0.f;
    const int lr = tid >> 2, lk = (tid & 3) * 8;
    for (int k0 = 0; k0 < K; k0 += 32) {
      const uint4 av = *(const uint4*)(A + (size_t)(m0 + lr) * K + k0 + lk);
      const uint4 bv = *(const uint4*)(Bt + (size_t)(n0 + lr) * K + k0 + lk);
      float af[8], bf[8]; unpack8(av, af); unpack8(bv, bf);
      __syncthreads();
#pragma unroll
      for (int j = 0; j < 8; ++j) { As[(lk + j) * 132 + lr] = af[j]; Bs[(lk + j) * 132 + lr] = bf[j]; }
      __syncthreads();
#pragma unroll 8
      for (int kk = 0; kk < 32; ++kk) {
        const float4 a = *(const float4*)(As + kk * 132 + ty * 4);
        const float4 b0 = *(const float4*)(Bs + kk * 132 + tx * 8), b1 = *(const float4*)(Bs + kk * 132 + tx * 8 + 4);
        const float aa[4] = {a.x, a.y, a.z, a.w}; const float bb[8] = {b0.x, b0.y, b0.z, b0.w, b1.x, b1.y, b1.z, b1.w};
#pragma unroll
        for (int i = 0; i < 4; ++i)
#pragma unroll
          for (int j = 0; j < 8; ++j) acc[i][j] += aa[i] * bb[j];
      }
    }
#pragma unroll
    for (int i = 0; i < 4; ++i) {
      const int r = m0 + ty * 4 + i;
      float s = E.store8(r, n0 + tx * 8, acc[i]);
      if (Epi::ROWSUM) { s = gsum<16>(s); if (tx == 0) E.rowsum(r, s); }
    }
  }
}


namespace pg8 {
#define PG8_LAS __attribute__((address_space(3)))
typedef short bf16x8 __attribute__((ext_vector_type(8)));
typedef float f32x4 __attribute__((ext_vector_type(4)));
typedef int v4i_t __attribute__((ext_vector_type(4)));
typedef int v8i_t __attribute__((ext_vector_type(8)));
constexpr int BM = 256, BK = 64, HALF = 128, HTB = HALF * BK * 2, STAGE_BYTES = 8 * HTB, NXCD = 8, WGM = 8;
__host__ __device__ __forceinline__ int lds_byte(int r, int c) { const int st = (r >> 4) * 2 + (c >> 5), rr = r & 15, cc = c & 31, ob = rr * 64 + cc * 2; return st * 1024 + (ob ^ (((ob >> 9) & 1) << 5)); }
__host__ __device__ __forceinline__ void stage_rc(int b, int& R, int& C) { const int st = b / 1024, sb = b % 1024, swz = sb ^ (((sb >> 9) & 1) << 5); R = (st >> 1) * 16 + swz / 64; C = (st & 1) * 32 + (swz % 64) / 2; }
__host__ __device__ __forceinline__ int perm32(int rho) { const int n = rho >> 4, i = rho & 15; return 8 * (i >> 2) + 4 * n + (i & 3); }
struct Unit { int pm, pn; };
struct Gemm { const bf16_t* A; const bf16_t* Bt; int M, N, K; };
struct StaticOrder {
    int nM, nN, nwg, G, c;
    __host__ __device__ void init(int M, int N, int G_, int c_) { nM = M / BM; nN = N / BM; nwg = nM * nN; G = G_; c = c_; }
    __host__ __device__ bool next(int i, Unit& u) const {
        const long L = (long)i * G + c; if (L >= nwg) return false;
        int wgid = (int)L; { const int q = nwg / NXCD, r = nwg % NXCD, xcd = wgid % NXCD, off = wgid / NXCD; wgid = (xcd < r ? xcd * (q + 1) : r * (q + 1) + (xcd - r) * q) + off; }
        const int nig = WGM * nN, gid = wgid / nig, fm = gid * WGM, gsz = (nM - fm) < WGM ? (nM - fm) : WGM;
        u.pm = fm + ((wgid % nig) % gsz); u.pn = (wgid % nig) / gsz; return true;
    }
    __device__ __forceinline__ void a_ready(const Unit&) const {}
    __device__ __forceinline__ void done(const Unit&) const {}
};
template <class E8> struct EpiA {
    static constexpr bool PERM = true, AFTER_DRAIN = false;
    E8 e;
    __device__ __forceinline__ void operator()(const f32x4 (&acc)[2][2][4][2], const Unit& u, int wr, int wc, int fr, int fq) const {
        asm volatile("" : "+v"(fr), "+v"(fq));
        const int row0 = u.pm * BM + wr * 64 + fr, col0 = u.pn * BM + wc * 32 + 8 * fq;
#pragma unroll
        for (int ai = 0; ai < 2; ++ai)
#pragma unroll
            for (int m = 0; m < 4; ++m) { const int r = row0 + ai * HALF + m * 16; float s = 0.f;
#pragma unroll
                for (int bj = 0; bj < 2; ++bj) { const float v[8] = {acc[ai][bj][m][0][0], acc[ai][bj][m][0][1], acc[ai][bj][m][0][2], acc[ai][bj][m][0][3], acc[ai][bj][m][1][0], acc[ai][bj][m][1][1], acc[ai][bj][m][1][2], acc[ai][bj][m][1][3]};
                    s += e.store8(r, col0 + bj * HALF, v); }
                if (E8::ROWSUM) { s += sxor<16>(s); s += sxor<32>(s); if (fq == 0) e.rowsum(r, s); }
                asm volatile("" ::: "memory"); }
    }
    __device__ __forceinline__ void fused(f32x4 (&)[2][2][4][2], const Unit&, int, int, int, int, PG8_LAS unsigned char*, int, int) const {}
};
template <class Epi, class Sched, bool ALIGN_EPI = false, bool SP2 = false, bool F8 = false>
__device__ __forceinline__ void gemm_phase(PG8_LAS unsigned char* lds, const Gemm g, const Sched& S, const Epi& E) {
    int tid_ = threadIdx.x; asm volatile("" : "+v"(tid_));
    const int tid = tid_, wid = __builtin_amdgcn_readfirstlane(tid >> 6), lane = tid & 63, wr = wid >> 2, wc = wid & 3, fr = lane & 15, fq = lane >> 4;
    const int K = g.K, nt = K / BK;
    unsigned voffA[2], voffB[2];
#pragma unroll
    for (int i = 0; i < 2; ++i) { int R, C; stage_rc(tid * 16 + i * 8192, R, C); const int Rb = Epi::PERM ? ((R & ~31) + perm32(R & 31)) : R;
        voffA[i] = (unsigned)(R * K + C) * 2u; voffB[i] = (unsigned)(Rb * K + C) * 2u; }
    const size_t kstep = (size_t)(BK * 2);
    const size_t hstep = (size_t)HALF * K * 2;
    const size_t tstep = 2 * hstep;
    const unsigned ldsw = (unsigned)wid * 1024u;
    const int aoff = lds_byte(wr * 64 + fr, fq * 8), boff = lds_byte(wc * 32 + fr, fq * 8);
#define PG8_SA(b, h) (((b) * 2 + (h)) * HTB)
#define PG8_SB(b, h) ((4 + (b) * 2 + (h)) * HTB)
#define PG8_STAGE(bufoff, gbase, voff) do { _Pragma("unroll") for (int _i = 0; _i < 2; ++_i) \
        __builtin_amdgcn_global_load_lds((const unsigned*)((const char*)(gbase) + (voff)[_i]), (PG8_LAS unsigned*)(lds + (bufoff) + ldsw + _i * 8192), 16, 0, 0); } while (0)
#define PG8_LDA(dst, b, h) do { _Pragma("unroll") for (int m = 0; m < 4; ++m) { const v4i_t lo_ = *(const PG8_LAS v4i_t*)(lds + PG8_SA(b, h) + aoff + m * 2048), hi_ = *(const PG8_LAS v4i_t*)(lds + PG8_SA(b, h) + aoff + m * 2048 + 1024); dst[m] = __builtin_shufflevector(lo_, hi_, 0, 1, 2, 3, 4, 5, 6, 7); } } while (0)
#define PG8_LDB(dst, b, h) do { _Pragma("unroll") for (int n = 0; n < 2; ++n) { const v4i_t lo_ = *(const PG8_LAS v4i_t*)(lds + PG8_SB(b, h) + boff + n * 2048), hi_ = *(const PG8_LAS v4i_t*)(lds + PG8_SB(b, h) + boff + n * 2048 + 1024); dst[n] = __builtin_shufflevector(lo_, hi_, 0, 1, 2, 3, 4, 5, 6, 7); } } while (0)
#define PG8_MMA(ai, bj, At, Bt) do { __builtin_amdgcn_s_setprio(1); \
        if constexpr (F8) { asm volatile("s_nop 1\n\t" \
            "v_mfma_scale_f32_16x16x128_f8f6f4 %0, %12, %8, %0, %14, %14 op_sel_hi:[0,0,0]\n\t"  "v_mfma_scale_f32_16x16x128_f8f6f4 %1, %13, %8, %1, %14, %14 op_sel_hi:[0,0,0]\n\t" \
            "v_mfma_scale_f32_16x16x128_f8f6f4 %2, %12, %9, %2, %14, %14 op_sel_hi:[0,0,0]\n\t"  "v_mfma_scale_f32_16x16x128_f8f6f4 %3, %13, %9, %3, %14, %14 op_sel_hi:[0,0,0]\n\t" \
            "v_mfma_scale_f32_16x16x128_f8f6f4 %4, %12, %10, %4, %14, %14 op_sel_hi:[0,0,0]\n\t" "v_mfma_scale_f32_16x16x128_f8f6f4 %5, %13, %10, %5, %14, %14 op_sel_hi:[0,0,0]\n\t" \
            "v_mfma_scale_f32_16x16x128_f8f6f4 %6, %12, %11, %6, %14, %14 op_sel_hi:[0,0,0]\n\t" "v_mfma_scale_f32_16x16x128_f8f6f4 %7, %13, %11, %7, %14, %14 op_sel_hi:[0,0,0]" \
            : "+v"(acc[ai][bj][0][0]), "+v"(acc[ai][bj][0][1]), "+v"(acc[ai][bj][1][0]), "+v"(acc[ai][bj][1][1]), "+v"(acc[ai][bj][2][0]), "+v"(acc[ai][bj][2][1]), "+v"(acc[ai][bj][3][0]), "+v"(acc[ai][bj][3][1]) \
            : "v"(At[0]), "v"(At[1]), "v"(At[2]), "v"(At[3]), "v"(Bt[0]), "v"(Bt[1]), "v"(one_scale)); } \
        else { _Pragma("unroll") for (int m = 0; m < 4; ++m) _Pragma("unroll") for (int n = 0; n < 2; ++n) { \
            acc[ai][bj][m][n] = __builtin_amdgcn_mfma_f32_16x16x32_bf16(__builtin_bit_cast(bf16x8, __builtin_shufflevector(Bt[n], Bt[n], 0, 1, 2, 3)), __builtin_bit_cast(bf16x8, __builtin_shufflevector(At[m], At[m], 0, 1, 2, 3)), acc[ai][bj][m][n], 0, 0, 0); \
            acc[ai][bj][m][n] = __builtin_amdgcn_mfma_f32_16x16x32_bf16(__builtin_bit_cast(bf16x8, __builtin_shufflevector(Bt[n], Bt[n], 4, 5, 6, 7)), __builtin_bit_cast(bf16x8, __builtin_shufflevector(At[m], At[m], 4, 5, 6, 7)), acc[ai][bj][m][n], 0, 0, 0); } } \
        __builtin_amdgcn_s_setprio(0); } while (0)
#define PG8_MFMA_DRAIN() do { if constexpr (F8) asm volatile("s_nop 15\n\ts_nop 15\n\ts_nop 15" ::: "memory"); } while (0)
#define PG8_WAIT_V(n) asm volatile("s_waitcnt vmcnt(" #n ")" ::: "memory")
#define PG8_WAIT_L(n) asm volatile("s_waitcnt lgkmcnt(" #n ")" ::: "memory")
#define PG8_BAR __builtin_amdgcn_s_barrier()
#define PG8_SCHED __builtin_amdgcn_sched_barrier(0)
    Unit cur, nxt; int ui = 0;
    if (!S.next(0, cur)) return;
    f32x4 acc[2][2][4][2];
#pragma unroll
    for (int a = 0; a < 2; ++a)
#pragma unroll
        for (int b = 0; b < 2; ++b)
#pragma unroll
            for (int m = 0; m < 4; ++m)
#pragma unroll
                for (int n = 0; n < 2; ++n) acc[a][b][m][n] = (f32x4){0.f, 0.f, 0.f, 0.f};
    const int one_scale = 0x7f7f7f7f;
    v8i_t At[4], B0[2], B1[2];
    const char* cA = (const char*)g.A + (size_t)cur.pm * tstep; const char* cB = (const char*)g.Bt + (size_t)cur.pn * tstep;
    S.a_ready(cur);
    if constexpr (SP2) {
        PG8_STAGE(PG8_SB(0, 0), cB, voffB); PG8_STAGE(PG8_SB(0, 1), cB + hstep, voffB); PG8_STAGE(PG8_SA(0, 0), cA, voffA); PG8_STAGE(PG8_SA(0, 1), cA + hstep, voffA);
        if (wr == 1) PG8_BAR;
        PG8_WAIT_V(2); PG8_BAR;
        PG8_STAGE(PG8_SB(1, 0), cB + kstep, voffB); PG8_STAGE(PG8_SA(1, 0), cA + kstep, voffA); PG8_STAGE(PG8_SB(1, 1), cB + hstep + kstep, voffB);
        PG8_WAIT_V(6); PG8_BAR;
    } else {
        PG8_STAGE(PG8_SB(0, 0), cB, voffB); PG8_STAGE(PG8_SA(0, 0), cA, voffA); PG8_STAGE(PG8_SB(0, 1), cB + hstep, voffB); PG8_STAGE(PG8_SA(0, 1), cA + hstep, voffA);
        if (wr == 1) PG8_BAR;
        PG8_WAIT_V(4); PG8_BAR;
        PG8_STAGE(PG8_SB(1, 0), cB + kstep, voffB); PG8_STAGE(PG8_SA(1, 0), cA + kstep, voffA); PG8_STAGE(PG8_SB(1, 1), cB + hstep + kstep, voffB);
        PG8_WAIT_V(6); PG8_BAR;
    }
    for (;;) {
        const bool has_next = S.next(ui + 1, nxt);
        const char* nA = has_next ? (const char*)g.A + (size_t)nxt.pm * tstep : cA; const char* nB = has_next ? (const char*)g.Bt + (size_t)nxt.pn * tstep : cB;
        for (int t = 0; t < nt; t += 2) {
            const bool last = (t == nt - 2);
            const char* a1 = cA + (size_t)(t + 1) * kstep;
            const char* a2 = last ? nA : cA + (size_t)(t + 2) * kstep; const char* b2 = last ? nB : cB + (size_t)(t + 2) * kstep;
            const char* a3 = a2 + kstep; const char* b3 = b2 + kstep;
            if (last && has_next) S.a_ready(nxt);
            if constexpr (SP2) {
            PG8_LDB(B0, 0, 0); PG8_LDB(B1, 0, 1); PG8_SCHED; PG8_LDA(At, 0, 0); PG8_STAGE(PG8_SA(1, 1), a1 + hstep, voffA);
            PG8_WAIT_V(8); PG8_WAIT_L(0); PG8_BAR; PG8_MMA(0, 0, At, B0); PG8_MMA(0, 1, At, B1); PG8_BAR; PG8_SCHED;
            PG8_LDA(At, 0, 1); PG8_STAGE(PG8_SB(0, 0), b2, voffB); PG8_STAGE(PG8_SB(0, 1), b2 + hstep, voffB); PG8_STAGE(PG8_SA(0, 0), a2, voffA);
            PG8_WAIT_V(8); PG8_WAIT_L(0); PG8_BAR; PG8_MMA(1, 0, At, B0); PG8_MMA(1, 1, At, B1); PG8_BAR; PG8_SCHED;
            PG8_LDB(B0, 1, 0); PG8_LDB(B1, 1, 1); PG8_SCHED; PG8_LDA(At, 1, 0); PG8_STAGE(PG8_SA(0, 1), a2 + hstep, voffA);
            PG8_WAIT_V(8); PG8_WAIT_L(0); PG8_BAR; PG8_MMA(0, 0, At, B0); PG8_MMA(0, 1, At, B1); PG8_BAR; PG8_SCHED;
            PG8_LDA(At, 1, 1); PG8_STAGE(PG8_SB(1, 0), b3, voffB); PG8_STAGE(PG8_SB(1, 1), b3 + hstep, voffB); PG8_STAGE(PG8_SA(1, 0), a3, voffA);
            PG8_WAIT_V(8); PG8_WAIT_L(0); PG8_BAR; PG8_MMA(1, 0, At, B0); PG8_MMA(1, 1, At, B1); PG8_BAR; PG8_SCHED;
            } else {
            PG8_LDB(B0, 0, 0); PG8_SCHED; PG8_LDA(At, 0, 0); PG8_STAGE(PG8_SA(1, 1), a1 + hstep, voffA);
            PG8_WAIT_L(8); PG8_BAR; PG8_WAIT_L(0); PG8_MMA(0, 0, At, B0); PG8_BAR; PG8_SCHED;
            PG8_LDB(B1, 0, 1); PG8_STAGE(PG8_SB(0, 0), b2, voffB);
            PG8_BAR; PG8_WAIT_L(0); PG8_MMA(0, 1, At, B1); PG8_BAR;
            PG8_LDA(At, 0, 1); PG8_STAGE(PG8_SA(0, 0), a2, voffA);
            PG8_BAR; PG8_WAIT_L(0); PG8_MMA(1, 0, At, B0); PG8_BAR; PG8_SCHED;
            PG8_STAGE(PG8_SB(0, 1), b2 + hstep, voffB);
            PG8_WAIT_V(6); PG8_BAR; PG8_MMA(1, 1, At, B1); PG8_BAR;
            PG8_LDB(B0, 1, 0); PG8_SCHED; PG8_LDA(At, 1, 0); PG8_STAGE(PG8_SA(0, 1), a2 + hstep, voffA);
            PG8_WAIT_L(8); PG8_BAR; PG8_WAIT_L(0); PG8_MMA(0, 0, At, B0); PG8_BAR; PG8_SCHED;
            PG8_LDB(B1, 1, 1); PG8_STAGE(PG8_SB(1, 0), b3, voffB);
            PG8_BAR; PG8_WAIT_L(0); PG8_MMA(0, 1, At, B1); PG8_BAR;
            PG8_LDA(At, 1, 1); PG8_STAGE(PG8_SA(1, 0), a3, voffA);
            PG8_BAR; PG8_WAIT_L(0); PG8_MMA(1, 0, At, B0); PG8_BAR; PG8_SCHED;
            PG8_STAGE(PG8_SB(1, 1), b3 + hstep, voffB);
            PG8_WAIT_V(6); PG8_BAR; PG8_MMA(1, 1, At, B1); PG8_BAR;
            }
        }
        if constexpr (ALIGN_EPI) { if (wr == 0) PG8_BAR; }
        PG8_MFMA_DRAIN();
        if constexpr (!Epi::AFTER_DRAIN) { E(acc, cur, wr, wc, fr, fq); S.done(cur); }
        if (!has_next) break;
#pragma unroll
        for (int a = 0; a < 2; ++a)
#pragma unroll
            for (int b = 0; b < 2; ++b)
#pragma unroll
                for (int m = 0; m < 4; ++m)
#pragma unroll
                    for (int n = 0; n < 2; ++n) acc[a][b][m][n] = (f32x4){0.f, 0.f, 0.f, 0.f};
        cur = nxt; cA = nA; cB = nB; ++ui;
        if constexpr (ALIGN_EPI) { if (wr == 1) PG8_BAR; }
    }
    PG8_WAIT_V(0);
    if constexpr (!ALIGN_EPI) { if (wr == 0) PG8_BAR; }
    PG8_BAR;
    if constexpr (Epi::AFTER_DRAIN) { E.fused(acc, cur, wr, wc, fr, fq, lds, wid, lane); S.done(cur); }
#undef PG8_SA
#undef PG8_SB
#undef PG8_STAGE
#undef PG8_LDA
#undef PG8_LDB
#undef PG8_MMA
#undef PG8_MFMA_DRAIN
#undef PG8_WAIT_V
#undef PG8_WAIT_L
#undef PG8_BAR
#undef PG8_SCHED
}
}

#ifndef FAST_GEMM
#define FAST_GEMM 1
#endif
template <bool F8 = false, class E8>
__device__ __forceinline__ void gemm_any(const void* A, const void* Bt, int M, int N, int K, const E8& E, float* lds, int bid, int nb) {
#if FAST_GEMM
  pg8::Gemm g{(const bf16_t*)A, (const bf16_t*)Bt, M, N, F8 ? K / 2 : K}; pg8::StaticOrder S; S.init(M, N, nb, bid);
  pg8::EpiA<E8> EA{E};
  pg8::gemm_phase<pg8::EpiA<E8>, pg8::StaticOrder, true, true, F8>((PG8_LAS unsigned char*)lds, g, S, EA);
#else
  gemm_naive((const bf16_t*)A, (const bf16_t*)Bt, M, N, K, E, lds, bid, nb);
#endif
}

__device__ void gla_naive(const Params& p, const WS& w, int b, int h, float* lds) {
  constexpr int CH = 16;
  const int tid = tidx(), dv = tid & 255, half = tid >> 8, wave = tid >> 6, lane = tid & 63;
  float* qf = lds; float* kf = qf + CH * 128; float* af = kf + CH * 128; float* vf = af + CH * 128; float* op = vf + CH * 256;
  float S[64];
#pragma unroll
  for (int i = 0; i < 64; ++i) S[i] = 0.f;
  const int gd = tid & 127;
  float gu[16];
#pragma unroll
  for (int r = 0; r < 16; ++r) gu[r] = p.gate_up[r * 512 + h * 128 + gd];
  const float gb = p.gate_bias[h * 128 + gd];
  const float qscale = 0.08838834764831845f;
  for (int t0 = 0; t0 < SEQ; t0 += CH) {
    const size_t tb = (size_t)b * SEQ + t0;
    { const int tok = tid >> 5, d4 = (tid & 31) * 4;
      const uint2 qv = *(const uint2*)(w.proj + (tb + tok) * NPROJ + C_GQ + h * 128 + d4);
      const uint2 kv = *(const uint2*)(w.proj + (tb + tok) * NPROJ + C_GK + h * 128 + d4);
      *(float4*)(qf + tok * 128 + d4) = make_float4(lo_f(qv.x) * qscale, hi_f(qv.x) * qscale, lo_f(qv.y) * qscale, hi_f(qv.y) * qscale);
      *(float4*)(kf + tok * 128 + d4) = make_float4(lo_f(kv.x), hi_f(kv.x), lo_f(kv.y), hi_f(kv.y)); }
    { const int dvv = tid & 255, tk8 = (tid >> 8) * 8; float f[8];
      unpack8(*(const uint4*)(w.vT + (size_t)(h * 256 + dvv) * T + tb + tk8), f);
#pragma unroll
      for (int j = 0; j < 8; ++j) vf[(tk8 + j) * 256 + dvv] = f[j]; }
#pragma unroll
    for (int i = 0; i < 4; ++i) { const int tok = (tid >> 7) * 4 + i; float z = gb; float gl[16];
      unpack8(*(const uint4*)(w.proj + (tb + tok) * NPROJ + C_SM), gl); unpack8(*(const uint4*)(w.proj + (tb + tok) * NPROJ + C_SM + 8), gl + 8);
#pragma unroll
      for (int r = 0; r < 16; ++r) z += gl[r] * gu[r];
      af[tok * 128 + gd] = __expf(logsigmoidf_(z) * (1.f / 16.f)); }
    __syncthreads();
    for (int tok = 0; tok < CH; ++tok) {
      const float vv = vf[tok * 256 + dv]; float acc = 0.f;
#pragma unroll
      for (int i4 = 0; i4 < 16; ++i4) {
        const float4 a = *(const float4*)(af + tok * 128 + half * 64 + i4 * 4), k = *(const float4*)(kf + tok * 128 + half * 64 + i4 * 4), q = *(const float4*)(qf + tok * 128 + half * 64 + i4 * 4);
        S[i4 * 4 + 0] = a.x * S[i4 * 4 + 0] + k.x * vv; acc += q.x * S[i4 * 4 + 0];
        S[i4 * 4 + 1] = a.y * S[i4 * 4 + 1] + k.y * vv; acc += q.y * S[i4 * 4 + 1];
        S[i4 * 4 + 2] = a.z * S[i4 * 4 + 2] + k.z * vv; acc += q.z * S[i4 * 4 + 2];
        S[i4 * 4 + 3] = a.w * S[i4 * 4 + 3] + k.w * vv; acc += q.w * S[i4 * 4 + 3];
      }
      op[(half * CH + tok) * 256 + dv] = acc;
    }
    __syncthreads();
#pragma unroll
    for (int i = 0; i < 2; ++i) { const int tok = wave * 2 + i;
      const float4 o0 = *(const float4*)(op + tok * 256 + lane * 4), o1 = *(const float4*)(op + (CH + tok) * 256 + lane * 4);
      const float o[4] = {o0.x + o1.x, o0.y + o1.y, o0.z + o1.z, o0.w + o1.w};
      float ss = wave_sum(o[0] * o[0] + o[1] * o[1] + o[2] * o[2] + o[3] * o[3]);
      const float rs = rsqrtf(ss * (1.f / 256.f) + EPS);
      const uint2 gg = *(const uint2*)(w.proj + (tb + tok) * NPROJ + C_GG + h * 256 + lane * 4);
      const float4 gn = *(const float4*)(p.gla_norm + h * 256 + lane * 4);
      const float y0 = o[0] * rs * gn.x * siluf_(lo_f(gg.x)), y1 = o[1] * rs * gn.y * siluf_(hi_f(gg.x)), y2 = o[2] * rs * gn.z * siluf_(lo_f(gg.y)), y3 = o[3] * rs * gn.w * siluf_(hi_f(gg.y));
      *(uint2*)(w.y + (tb + tok) * D + h * 256 + lane * 4) = make_uint2(pack2(y0, y1), pack2(y2, y3)); }
    __syncthreads();
  }
}
__device__ void mlstm_naive(const Params& p, const WS& w, int b, int h, float* lds) {
  constexpr int CH = 16;
  const int tid = tidx(), dv = tid & 255, half = tid >> 8, wave = tid >> 6, lane = tid & 63;
  float* qf = lds; float* kf = qf + CH * 128; float* vf = kf + CH * 128; float* op = vf + CH * 256; float* dn = op + 2 * CH * 256; float* gt = dn + 2 * CH * 256;
  float C[64], n[4];
#pragma unroll
  for (int i = 0; i < 64; ++i) C[i] = 0.f;
#pragma unroll
  for (int i = 0; i < 4; ++i) n[i] = 0.f;
  const int nd = half * 64 + (dv & 15) * 4;
  const float kscale = 0.08838834764831845f;
  const float ib = p.ig_bias[h], fb = p.fg_bias[h];
  for (int t0 = 0; t0 < SEQ; t0 += CH) {
    const size_t tb = (size_t)b * SEQ + t0;
    { const int tok = tid >> 5, d4 = (tid & 31) * 4;
      float qa[4], ka[4];
#pragma unroll
      for (int c = 0; c < 4; ++c) { qa[c] = p.conv_b[h * 128 + d4 + c]; ka[c] = p.conv_b[512 + h * 128 + d4 + c]; }
#pragma unroll
      for (int wi = 0; wi < 4; ++wi) { const int ts = t0 + tok - 3 + wi;
        if (ts >= 0) { const size_t tr = (size_t)b * SEQ + ts;
          const uint2 qv = *(const uint2*)(w.proj + tr * NPROJ + C_MQ + h * 128 + d4), kv = *(const uint2*)(w.proj + tr * NPROJ + C_MK + h * 128 + d4);
          const float4 cq = *(const float4*)(p.conv_w + wi * 1024 + h * 128 + d4), ck = *(const float4*)(p.conv_w + wi * 1024 + 512 + h * 128 + d4);
          qa[0] += cq.x * lo_f(qv.x); qa[1] += cq.y * hi_f(qv.x); qa[2] += cq.z * lo_f(qv.y); qa[3] += cq.w * hi_f(qv.y);
          ka[0] += ck.x * lo_f(kv.x); ka[1] += ck.y * hi_f(kv.x); ka[2] += ck.z * lo_f(kv.y); ka[3] += ck.w * hi_f(kv.y); } }
      *(float4*)(qf + tok * 128 + d4) = make_float4(siluf_(qa[0]), siluf_(qa[1]), siluf_(qa[2]), siluf_(qa[3]));
      *(float4*)(kf + tok * 128 + d4) = make_float4(siluf_(ka[0]) * kscale, siluf_(ka[1]) * kscale, siluf_(ka[2]) * kscale, siluf_(ka[3]) * kscale); }
    { const int dvv = tid & 255, tk8 = (tid >> 8) * 8; float f[8];
      unpack8(*(const uint4*)(w.vT + (size_t)(1024 + h * 256 + dvv) * T + tb + tk8), f);
#pragma unroll
      for (int j = 0; j < 8; ++j) vf[(tk8 + j) * 256 + dvv] = f[j]; }
    if (tid < CH) { const float mi = bf2f(w.proj[(tb + tid) * NPROJ + C_SM + 16 + h]), mf = bf2f(w.proj[(tb + tid) * NPROJ + C_SM + 20 + h]);
      gt[tid * 2] = __expf(mi + ib); gt[tid * 2 + 1] = sigmoidf_(mf + fb); }
    __syncthreads();
    for (int tok = 0; tok < CH; ++tok) {
      const float vv = vf[tok * 256 + dv], ig = gt[tok * 2], fg = gt[tok * 2 + 1]; float num = 0.f, den = 0.f;
#pragma unroll
      for (int i4 = 0; i4 < 16; ++i4) {
        const float4 k = *(const float4*)(kf + tok * 128 + half * 64 + i4 * 4), q = *(const float4*)(qf + tok * 128 + half * 64 + i4 * 4);
        const float kk[4] = {k.x * ig, k.y * ig, k.z * ig, k.w * ig}; const float qq[4] = {q.x, q.y, q.z, q.w};
#pragma unroll
        for (int c = 0; c < 4; ++c) { C[i4 * 4 + c] = fg * C[i4 * 4 + c] + kk[c] * vv; num += qq[c] * C[i4 * 4 + c]; }
      }
      { const float4 k = *(const float4*)(kf + tok * 128 + nd), q = *(const float4*)(qf + tok * 128 + nd);
        n[0] = fg * n[0] + k.x * ig; n[1] = fg * n[1] + k.y * ig; n[2] = fg * n[2] + k.z * ig; n[3] = fg * n[3] + k.w * ig;
        den = q.x * n[0] + q.y * n[1] + q.z * n[2] + q.w * n[3];
        den = gsum<16>(den); }
      op[(half * CH + tok) * 256 + dv] = num; if (dv == 0) dn[half * CH + tok] = den;
    }
    __syncthreads();
#pragma unroll
    for (int i = 0; i < 2; ++i) { const int tok = wave * 2 + i;
      const float4 o0 = *(const float4*)(op + tok * 256 + lane * 4), o1 = *(const float4*)(op + (CH + tok) * 256 + lane * 4);
      const float den = dn[tok] + dn[CH + tok];
      const float inv = 1.f / fmaxf(fabsf(den), 1.f);
      const float o[4] = {(o0.x + o1.x) * inv, (o0.y + o1.y) * inv, (o0.z + o1.z) * inv, (o0.w + o1.w) * inv};
      float ss = wave_sum(o[0] * o[0] + o[1] * o[1] + o[2] * o[2] + o[3] * o[3]);
      const float rs = rsqrtf(ss * (1.f / 256.f) + EPS);
      const uint2 mo = *(const uint2*)(w.proj + (tb + tok) * NPROJ + C_MO + h * 256 + lane * 4);
      const float4 gn = *(const float4*)(p.mlstm_norm + h * 256 + lane * 4);
      const float y0 = o[0] * rs * gn.x * sigmoidf_(lo_f(mo.x)), y1 = o[1] * rs * gn.y * sigmoidf_(hi_f(mo.x)), y2 = o[2] * rs * gn.z * sigmoidf_(lo_f(mo.y)), y3 = o[3] * rs * gn.w * sigmoidf_(hi_f(mo.y));
      *(uint2*)(w.y + (tb + tok) * D + 1024 + h * 256 + lane * 4) = make_uint2(pack2(y0, y1), pack2(y2, y3)); }
    __syncthreads();
  }
}
__device__ void phase_mixer_naive(const Params& p, const WS& w, float* lds, int bid, int nb) {
  for (int item = bid; item < 16; item += nb) {
    if (item < 8) gla_naive(p, w, item >> 2, item & 3, lds); else mlstm_naive(p, w, (item - 8) >> 2, item & 3, lds);
    __syncthreads();
  }
}


typedef short bf16x8 __attribute__((ext_vector_type(8)));
typedef float f32x4 __attribute__((ext_vector_type(4)));
#define MFMA16(a, b, c) __builtin_amdgcn_mfma_f32_16x16x32_bf16(a, b, c, 0, 0, 0)
constexpr int L_GLR = 0, L_TOT = 4096, L_F = 6144, L_DEN = 6656, L_PART = 6912, L_QS = 9216, L_KS = 26624, L_P = 44032, L_NL = 53248, L_KDT = 9216;
constexpr int QS_LD = 136, P_LD = 72, KDT_LD = 72;

__device__ __forceinline__ void gla_gates(const Params& p, const WS& w, int h, size_t tb, unsigned char* ldsb, int tid, float* bv, float& blast) {
  float* glrs = (float*)(ldsb + L_GLR); float* tot = (float*)(ldsb + L_TOT);
  const int d = tid & 127, tg = tid >> 7;
  if (tid < 128) { float f[8]; unpack8(*(const uint4*)(w.proj + (tb + (tid >> 1)) * NPROJ + C_SM + (tid & 1) * 8), f);
#pragma unroll
    for (int j = 0; j < 8; ++j) glrs[(tid >> 1) * 16 + (tid & 1) * 8 + j] = f[j]; }
  float gu[16];
#pragma unroll
  for (int r = 0; r < 16; ++r) gu[r] = p.gate_up[r * 512 + h * 128 + d];
  const float gb = p.gate_bias[h * 128 + d];
  __syncthreads();
  float run = 0.f;
#pragma unroll
  for (int i = 0; i < 16; ++i) { const float* gl = glrs + (tg * 16 + i) * 16; float z = gb;
#pragma unroll
    for (int r4 = 0; r4 < 4; ++r4) { const float4 g4 = *(const float4*)(gl + r4 * 4); z += g4.x * gu[r4 * 4] + g4.y * gu[r4 * 4 + 1] + g4.z * gu[r4 * 4 + 2] + g4.w * gu[r4 * 4 + 3]; }
    run += logsigmoidf_(z) * (1.f / 16.f); bv[i] = run; }
  tot[tg * 128 + d] = run;
  __syncthreads();
  float off = 0.f; blast = 0.f;
#pragma unroll
  for (int g = 0; g < 4; ++g) { const float t = tot[g * 128 + d]; blast += t; if (g < tg) off += t; }
#pragma unroll
  for (int i = 0; i < 16; ++i) bv[i] += off;
}
__device__ __forceinline__ void mlstm_gates(const Params& p, const WS& w, int h, size_t tb, unsigned char* ldsb, int tid) {
  float* Fl = (float*)(ldsb + L_F);
  if (tid < 64) { const float mi = bf2f(w.proj[(tb + tid) * NPROJ + C_SM + 16 + h]), mf = bf2f(w.proj[(tb + tid) * NPROJ + C_SM + 20 + h]);
    float f = logsigmoidf_(mf + p.fg_bias[h]);
#pragma unroll
    for (int o = 1; o < 64; o <<= 1) { const float t = bperm(f, tid - o); if (tid >= o) f += t; }
    Fl[tid] = f; Fl[64 + tid] = mi + p.ig_bias[h]; }
  __syncthreads();
}
__device__ __forceinline__ void conv_load(const WS& w, int col, int b, int c, int tg, bf16_t* win) {
  const int s0 = c * 64 + tg * 16 - 3;
#pragma unroll
  for (int m = 0; m < 19; ++m) { const int sp = s0 + m; win[m] = (sp >= 0) ? w.proj[((size_t)b * SEQ + sp) * NPROJ + col] : (bf16_t)0; }
}
__device__ __forceinline__ void conv_apply(const Params& p, const bf16_t* win, int cch, float scale, float* out) {
  const float c0 = p.conv_w[cch], c1 = p.conv_w[1024 + cch], c2 = p.conv_w[2048 + cch], c3 = p.conv_w[3072 + cch], cb = p.conv_b[cch];
#pragma unroll
  for (int i = 0; i < 16; ++i) out[i] = siluf_(cb + c0 * bf2f(win[i]) + c1 * bf2f(win[i + 1]) + c2 * bf2f(win[i + 2]) + c3 * bf2f(win[i + 3])) * scale;
}

template <int KIND>
__device__ void mix_local(const Params& p, const WS& w, int b, int h, int c, int item, unsigned char* ldsb) {
  const int tid = tidx(), lane = tid & 63, wave = tid >> 6, fr = lane & 15, fq = lane >> 4, d = tid & 127, tg = tid >> 7;
  const size_t tb = (size_t)b * SEQ + (size_t)c * 64;
  float* tot = (float*)(ldsb + L_TOT); const float* Fl = (const float*)(ldsb + L_F);
  bf16_t* kdT = (bf16_t*)(ldsb + L_KDT);
  const bf16_t* vrow = w.vT + (size_t)(KIND * 1024 + h * 256 + wave * 32 + fr) * T + tb + fq * 8;
  bf16x8 yv[2][2];
#pragma unroll
  for (int ks = 0; ks < 2; ++ks) { yv[ks][0] = *(const bf16x8*)(vrow + ks * 32); yv[ks][1] = *(const bf16x8*)(vrow + (size_t)16 * T + ks * 32); }
  bf16_t kraw[19];
  if (KIND == 0) {
#pragma unroll
    for (int i = 0; i < 16; ++i) kraw[i] = w.proj[(tb + tg * 16 + i) * NPROJ + C_GK + h * 128 + d];
  } else conv_load(w, C_MK + h * 128 + d, b, c, tg, kraw);
  float wgt[16], kv[16];
  if (KIND == 0) {
    float bv[16], blast; gla_gates(p, w, h, tb, ldsb, tid, bv, blast);
#pragma unroll
    for (int i = 0; i < 16; ++i) { wgt[i] = __expf(blast - bv[i]); kv[i] = bf2f(kraw[i]); }
    if (tg == 0) w.gdec[(size_t)item * 128 + d] = __expf(blast);
  } else {
    mlstm_gates(p, w, h, tb, ldsb, tid);
    const float flast = Fl[63];
#pragma unroll
    for (int i = 0; i < 16; ++i) wgt[i] = __expf(flast - Fl[tg * 16 + i] + Fl[64 + tg * 16 + i]);
    conv_apply(p, kraw, 512 + h * 128 + d, 0.08838834764831845f, kv);
    if (tid == 0) w.mdec[item - 2048] = __expf(flast);
  }
  float un = 0.f; float kd[16];
#pragma unroll
  for (int i = 0; i < 16; ++i) { kd[i] = kv[i] * wgt[i]; un += kd[i]; }
  *(uint4*)(kdT + d * KDT_LD + tg * 16) = pack8(kd); *(uint4*)(kdT + d * KDT_LD + tg * 16 + 8) = pack8(kd + 8);
  if (KIND == 1) tot[tg * 128 + d] = un;
  __syncthreads();
  if (KIND == 1 && tg == 0) w.mn[(size_t)(item - 2048) * 128 + d] = tot[d] + tot[128 + d] + tot[256 + d] + tot[384 + d];
  f32x4 acc[2][8];
#pragma unroll
  for (int yt = 0; yt < 2; ++yt)
#pragma unroll
    for (int xt = 0; xt < 8; ++xt) acc[yt][xt] = (f32x4){0.f, 0.f, 0.f, 0.f};
#pragma unroll
  for (int ks = 0; ks < 2; ++ks) {
#pragma unroll
    for (int xt = 0; xt < 8; ++xt) { const bf16x8 xk = *(const bf16x8*)(kdT + (xt * 16 + fr) * KDT_LD + ks * 32 + fq * 8);
      acc[0][xt] = MFMA16(xk, yv[ks][0], acc[0][xt]); acc[1][xt] = MFMA16(xk, yv[ks][1], acc[1][xt]); }
  }
  bf16_t* S = (bf16_t*)p.out + (size_t)item * 32768;
#pragma unroll
  for (int yt = 0; yt < 2; ++yt)
#pragma unroll
    for (int xt = 0; xt < 8; ++xt) *(uint2*)(S + (wave * 32 + yt * 16 + fr) * 128 + xt * 16 + 4 * fq) = make_uint2(pack2(acc[yt][xt][0], acc[yt][xt][1]), pack2(acc[yt][xt][2], acc[yt][xt][3]));
  __syncthreads();
}

__device__ void mix_scan(const Params& p, const WS& w, int bid, int nb) {
  bf16_t* sbuf = (bf16_t*)p.out;
  for (int g = bid * 512 + tidx(); g < 16 * 8192; g += nb * 512) {
    const int combo = g >> 13, e = (g & 8191) * 4, dk = e & 127;
    bf16_t* base = sbuf + (size_t)combo * 256 * 32768 + e;
    float S0 = 0.f, S1 = 0.f, S2 = 0.f, S3 = 0.f;
    for (int c0 = 0; c0 < 256; c0 += 8) {
      uint2 u[8]; float4 dc[8];
#pragma unroll
      for (int k = 0; k < 8; ++k) { u[k] = *(const uint2*)(base + (size_t)(c0 + k) * 32768);
        if (combo < 8) dc[k] = *(const float4*)(w.gdec + (size_t)(combo * 256 + c0 + k) * 128 + dk);
        else { const float m = w.mdec[(combo - 8) * 256 + c0 + k]; dc[k] = make_float4(m, m, m, m); } }
#pragma unroll
      for (int k = 0; k < 8; ++k) { *(uint2*)(base + (size_t)(c0 + k) * 32768) = make_uint2(pack2(S0, S1), pack2(S2, S3));
        S0 = dc[k].x * S0 + lo_f(u[k].x); S1 = dc[k].y * S1 + hi_f(u[k].x); S2 = dc[k].z * S2 + lo_f(u[k].y); S3 = dc[k].w * S3 + hi_f(u[k].y); }
    }
  }
  for (int g = bid * 512 + tidx(); g < 8 * 128; g += nb * 512) {
    const int cb = g >> 7, d = g & 127; float n = 0.f;
    for (int c = 0; c < 256; ++c) { float* q = w.mn + (size_t)(cb * 256 + c) * 128 + d; const float u = *q; *q = n; n = w.mdec[cb * 256 + c] * n + u; }
  }
}

template <int KIND>
__device__ void mix_out(const Params& p, const WS& w, int b, int h, int c, int item, unsigned char* ldsb) {
  const int tid = tidx(), lane = tid & 63, wave = tid >> 6, fr = lane & 15, fq = lane >> 4, d = tid & 127, tg = tid >> 7;
  const size_t tb = (size_t)b * SEQ + (size_t)c * 64;
  const float* Fl = (const float*)(ldsb + L_F); float* denl = (float*)(ldsb + L_DEN); float* part = (float*)(ldsb + L_PART); float* nl = (float*)(ldsb + L_NL);
  bf16_t* qs = (bf16_t*)(ldsb + L_QS); bf16_t* ks = (bf16_t*)(ldsb + L_KS); bf16_t* P = (bf16_t*)(ldsb + L_P);
  bf16x8 vx[2][2], sx[4][2];
  { const bf16_t* vrow = w.vT + (size_t)(KIND * 1024 + h * 256 + wave * 32 + fr) * T + tb + fq * 8;
#pragma unroll
    for (int k2 = 0; k2 < 2; ++k2) { vx[k2][0] = *(const bf16x8*)(vrow + k2 * 32); vx[k2][1] = *(const bf16x8*)(vrow + (size_t)16 * T + k2 * 32); }
    const bf16_t* srow = (const bf16_t*)p.out + (size_t)item * 32768 + (wave * 32 + fr) * 128 + fq * 8;
#pragma unroll
    for (int k4 = 0; k4 < 4; ++k4) { sx[k4][0] = *(const bf16x8*)(srow + k4 * 32); sx[k4][1] = *(const bf16x8*)(srow + 16 * 128 + k4 * 32); } }
  uint2 gt[4][2];
#pragma unroll
  for (int yt = 0; yt < 4; ++yt)
#pragma unroll
    for (int xt = 0; xt < 2; ++xt) gt[yt][xt] = *(const uint2*)(w.proj + (tb + yt * 16 + fr) * NPROJ + (KIND == 0 ? C_GG : C_MO) + h * 256 + wave * 32 + xt * 16 + 4 * fq);
  const float* gain = (KIND == 0 ? p.gla_norm : p.mlstm_norm) + h * 256;
  const float4 gn0 = *(const float4*)(gain + wave * 32 + 4 * fq), gn1 = *(const float4*)(gain + wave * 32 + 16 + 4 * fq);
  bf16_t qraw[19], kraw[19];
  if (KIND == 0) {
#pragma unroll
    for (int i = 0; i < 16; ++i) { qraw[i] = w.proj[(tb + tg * 16 + i) * NPROJ + C_GQ + h * 128 + d]; kraw[i] = w.proj[(tb + tg * 16 + i) * NPROJ + C_GK + h * 128 + d]; }
  } else { conv_load(w, C_MQ + h * 128 + d, b, c, tg, qraw); conv_load(w, C_MK + h * 128 + d, b, c, tg, kraw); }
  float nlv = 0.f;
  if (KIND == 1 && tid < 128) nlv = w.mn[(size_t)(item - 2048) * 128 + tid];
  {
    float qm[16], km[16], qv[16], kv[16];
    if (KIND == 0) {
      float bv[16], blast; gla_gates(p, w, h, tb, ldsb, tid, bv, blast);
#pragma unroll
      for (int i = 0; i < 16; ++i) { qm[i] = 0.08838834764831845f * __expf(bv[i]); km[i] = __expf(-bv[i]); qv[i] = bf2f(qraw[i]); kv[i] = bf2f(kraw[i]); }
    } else {
      mlstm_gates(p, w, h, tb, ldsb, tid);
#pragma unroll
      for (int i = 0; i < 16; ++i) { const float F = Fl[tg * 16 + i]; qm[i] = __expf(F); km[i] = __expf(Fl[64 + tg * 16 + i] - F); }
      conv_apply(p, qraw, h * 128 + d, 1.f, qv);
      conv_apply(p, kraw, 512 + h * 128 + d, 0.08838834764831845f, kv);
      if (tid < 128) nl[tid] = nlv;
    }
#pragma unroll
    for (int i = 0; i < 16; ++i) { qs[(tg * 16 + i) * QS_LD + d] = f2bf(qv[i] * qm[i]); ks[(tg * 16 + i) * QS_LD + d] = f2bf(kv[i] * km[i]); }
  }
  __syncthreads();
#pragma unroll
  for (int q = 0; q < 2; ++q) { const int tt = wave * 2 + q, jt = tt >> 2, it = tt & 3; f32x4 a = (f32x4){0.f, 0.f, 0.f, 0.f};
#pragma unroll
    for (int k4 = 0; k4 < 4; ++k4) { const bf16x8 xk = *(const bf16x8*)(ks + (jt * 16 + fr) * QS_LD + k4 * 32 + fq * 8), yq = *(const bf16x8*)(qs + (it * 16 + fr) * QS_LD + k4 * 32 + fq * 8); a = MFMA16(xk, yq, a); }
    const int i = it * 16 + fr, j0 = jt * 16 + 4 * fq;
    const float v0 = (j0 <= i) ? a[0] : 0.f, v1 = (j0 + 1 <= i) ? a[1] : 0.f, v2 = (j0 + 2 <= i) ? a[2] : 0.f, v3 = (j0 + 3 <= i) ? a[3] : 0.f;
    *(uint2*)(P + i * P_LD + j0) = make_uint2(pack2(v0, v1), pack2(v2, v3)); }
  __syncthreads();
  if (KIND == 1) { const int i = tid >> 3, pt = tid & 7; float f[8]; float s = 0.f;
    unpack8(*(const uint4*)(P + i * P_LD + pt * 8), f);
#pragma unroll
    for (int j = 0; j < 8; ++j) s += f[j];
#pragma unroll
    for (int hh = 0; hh < 2; ++hh) { unpack8(*(const uint4*)(qs + i * QS_LD + pt * 16 + hh * 8), f);
#pragma unroll
      for (int j = 0; j < 8; ++j) s += f[j] * nl[pt * 16 + hh * 8 + j]; }
    s = gsum<8>(s);
    if (pt == 0) denl[i] = s; }
  f32x4 acc[2][4];
#pragma unroll
  for (int xt = 0; xt < 2; ++xt)
#pragma unroll
    for (int yt = 0; yt < 4; ++yt) acc[xt][yt] = (f32x4){0.f, 0.f, 0.f, 0.f};
#pragma unroll
  for (int k2 = 0; k2 < 2; ++k2)
#pragma unroll
    for (int yt = 0; yt < 4; ++yt) { const bf16x8 yp = *(const bf16x8*)(P + (yt * 16 + fr) * P_LD + k2 * 32 + fq * 8); acc[0][yt] = MFMA16(vx[k2][0], yp, acc[0][yt]); acc[1][yt] = MFMA16(vx[k2][1], yp, acc[1][yt]); }
#pragma unroll
  for (int k4 = 0; k4 < 4; ++k4)
#pragma unroll
    for (int yt = 0; yt < 4; ++yt) { const bf16x8 yq = *(const bf16x8*)(qs + (yt * 16 + fr) * QS_LD + k4 * 32 + fq * 8); acc[0][yt] = MFMA16(sx[k4][0], yq, acc[0][yt]); acc[1][yt] = MFMA16(sx[k4][1], yq, acc[1][yt]); }
  if (KIND == 1) __syncthreads();
#pragma unroll
  for (int yt = 0; yt < 4; ++yt) { float s = 0.f;
    if (KIND == 1) { const float inv = 1.f / fmaxf(fabsf(denl[yt * 16 + fr]), 1.f); acc[0][yt] *= inv; acc[1][yt] *= inv; }
#pragma unroll
    for (int xt = 0; xt < 2; ++xt)
#pragma unroll
      for (int r = 0; r < 4; ++r) s += acc[xt][yt][r] * acc[xt][yt][r];
    s += sxor<16>(s); s += sxor<32>(s);
    if (fq == 0) part[wave * 64 + yt * 16 + fr] = s; }
  __syncthreads();
#pragma unroll
  for (int yt = 0; yt < 4; ++yt) { const int i = yt * 16 + fr; float t = 0.f;
#pragma unroll
    for (int ww = 0; ww < 8; ++ww) t += part[ww * 64 + i];
    const float rs = rsqrtf(t * (1.f / 256.f) + EPS);
#pragma unroll
    for (int xt = 0; xt < 2; ++xt) { const int dv = wave * 32 + xt * 16 + 4 * fq;
      const float4 gn = xt == 0 ? gn0 : gn1; const uint2 g2 = gt[yt][xt];
      const float g0 = lo_f(g2.x), g1 = hi_f(g2.x), g2f = lo_f(g2.y), g3 = hi_f(g2.y);
      const float a0 = KIND == 0 ? siluf_(g0) : sigmoidf_(g0), a1 = KIND == 0 ? siluf_(g1) : sigmoidf_(g1), a2 = KIND == 0 ? siluf_(g2f) : sigmoidf_(g2f), a3 = KIND == 0 ? siluf_(g3) : sigmoidf_(g3);
      const float y0 = acc[xt][yt][0] * rs * gn.x * a0, y1 = acc[xt][yt][1] * rs * gn.y * a1, y2 = acc[xt][yt][2] * rs * gn.z * a2, y3 = acc[xt][yt][3] * rs * gn.w * a3;
#if F8_OUT
      *(unsigned*)(w.yq + (tb + i) * D + KIND * 1024 + h * 256 + dv) = pack4_fp8(y0, y1, y2, y3);
#else
      *(uint2*)(w.y + (tb + i) * D + KIND * 1024 + h * 256 + dv) = make_uint2(pack2(y0, y1), pack2(y2, y3));
#endif
    } }
  __syncthreads();
}
template <int WHICH>
__device__ void phase_mix_items(const Params& p, const WS& w, unsigned char* ldsb, int bid, int nb) {
  for (int item = bid; item < 4096; item += nb) {
    const int kind = item >> 11, b = (item >> 10) & 1, h = (item >> 8) & 3, c = item & 255;
    if (WHICH == 0) { if (kind == 0) mix_local<0>(p, w, b, h, c, item, ldsb); else mix_local<1>(p, w, b, h, c, item, ldsb); }
    else { if (kind == 0) mix_out<0>(p, w, b, h, c, item, ldsb); else mix_out<1>(p, w, b, h, c, item, ldsb); }
  }
}

__device__ __forceinline__ unsigned sort16(unsigned b) { return (b & 0x8000u) ? (~b & 0xffffu) : (b | 0x8000u); }
__device__ __forceinline__ float unsort16(unsigned k) { const unsigned b = (k & 0x8000u) ? (k & 0x7fffu) : (~k & 0xffffu); return __uint_as_float(b << 16); }
__device__ __forceinline__ unsigned sort32(float f) { const unsigned u = __float_as_uint(f); return (u & 0x80000000u) ? ~u : (u | 0x80000000u); }
__device__ __forceinline__ float unsort32(unsigned k) { const unsigned u = (k & 0x80000000u) ? (k & 0x7fffffffu) : ~k; return __uint_as_float(u); }
__device__ void phase_topk(const Params& p, const WS& w, int bid, int nb) {
  for (int th = bid * 512 + tidx(); th < T * 8; th += nb * 512) {
    const int t = th >> 3, h = th & 7;
    const uint4* s = (const uint4*)(w.sc + (size_t)t * D + h * 256);
    unsigned l[2][16];
#pragma unroll
    for (int pp = 0; pp < 2; ++pp) {
#pragma unroll
      for (int i = 0; i < 16; ++i) l[pp][i] = 0u;
      for (int q = 0; q < 16; ++q) {
        const uint4 v = s[pp * 16 + q]; const unsigned wds[4] = {v.x, v.y, v.z, v.w};
#pragma unroll
        for (int e = 0; e < 8; ++e) {
          const unsigned b = (e & 1) ? (wds[e >> 1] >> 16) : (wds[e >> 1] & 0xffffu);
          unsigned x = (sort16(b) << 16) | (unsigned)(q * 8 + e);
#pragma unroll
          for (int i = 0; i < 16; ++i) { const unsigned hi = max(l[pp][i], x); x = min(l[pp][i], x); l[pp][i] = hi; }
        }
      }
    }
    unsigned long long lc[16];
#pragma unroll
    for (int i = 0; i < 16; ++i) lc[i] = 0ull;
#pragma unroll
    for (int i = 0; i < 16; ++i)
#pragma unroll
      for (int j = 0; j < 16; ++j) if ((i + 1) * (j + 1) <= 16) {
        const float sv = unsort16(l[0][i] >> 16) + unsort16(l[1][j] >> 16);
        unsigned long long x = ((unsigned long long)sort32(sv) << 32) | (unsigned long long)((l[0][i] & 0xffffu) * 128u + (l[1][j] & 0xffffu));
#pragma unroll
        for (int k = 0; k < 16; ++k) { const bool gt = x > lc[k]; const unsigned long long hi = gt ? x : lc[k]; x = gt ? lc[k] : x; lc[k] = hi; }
      }
    const float mx = unsort32((unsigned)(lc[0] >> 32));
    float e[16], sum = 0.f;
#pragma unroll
    for (int k = 0; k < 16; ++k) { e[k] = __expf(unsort32((unsigned)(lc[k] >> 32)) - mx); sum += e[k]; }
    const float inv = 1.f / sum;
    int* ei = w.eidx + (size_t)t * 128 + h * 16; float* eg = w.eg + (size_t)t * 128 + h * 16;
#pragma unroll
    for (int k4 = 0; k4 < 4; ++k4) {
      *(int4*)(ei + k4 * 4) = make_int4((int)(lc[k4 * 4] & 0xffffffffu), (int)(lc[k4 * 4 + 1] & 0xffffffffu), (int)(lc[k4 * 4 + 2] & 0xffffffffu), (int)(lc[k4 * 4 + 3] & 0xffffffffu));
      *(float4*)(eg + k4 * 4) = make_float4(e[k4 * 4] * inv, e[k4 * 4 + 1] * inv, e[k4 * 4 + 2] * inv, e[k4 * 4 + 3] * inv);
    }
  }
}
__device__ __forceinline__ void ub16(const uint4 q, float* f) {
  const unsigned wd[4] = {q.x, q.y, q.z, q.w};
#pragma unroll
  for (int k = 0; k < 4; ++k) { f[k * 4] = (float)(wd[k] & 0xffu); f[k * 4 + 1] = (float)((wd[k] >> 8) & 0xffu); f[k * 4 + 2] = (float)((wd[k] >> 16) & 0xffu); f[k * 4 + 3] = (float)(wd[k] >> 24); }
}
__device__ void peer_dots(const Params& p, const WS& w, int bid, int nb) {
  const int tid = tidx(), wave = tid >> 6, lane = tid & 63, r = lane % LPR, q = lane / LPR;
  const int x = bid & 7, nwl = (nb >> 3) * 8, wl = (bid >> 3) * 8 + wave;
  for (int sp = 0; sp < SPL; ++sp) {
    const int s = x * SPL + sp;
    const unsigned char* tab = w.u8 + (size_t)s * 16384 * SLW + r * 16;
    for (int t = wl; t < T; t += nwl) {
      const int idx0 = w.eidx[(size_t)t * 128 + lane], idx1 = w.eidx[(size_t)t * 128 + 64 + lane];
      float hf[16];
      unpack8(*(const uint4*)(w.h1b + (size_t)t * D + s * SLW + r * 16), hf); unpack8(*(const uint4*)(w.h1b + (size_t)t * D + s * SLW + r * 16 + 8), hf + 8);
      float am = 0.f;
#pragma unroll
      for (int j = 0; j < 16; ++j) am = fmaxf(am, fabsf(hf[j]));
      am = gmax<LPR>(am);
      const float sh = fmaxf(am, 1e-30f) * (1.f / 127.f), inv = 1.f / sh;
      int hq[4];
#pragma unroll
      for (int k = 0; k < 4; ++k) { unsigned xw = 0;
#pragma unroll
        for (int j = 0; j < 4; ++j) xw |= ((unsigned)(int)rintf(hf[k * 4 + j] * inv) & 0xffu) << (8 * j);
        hq[k] = (int)xw; }
      float res[2] = {0.f, 0.f};
#pragma unroll
      for (int i0 = 0; i0 < NIT; i0 += 8) {
        uint4 b[8];
#pragma unroll
        for (int k = 0; k < 8; ++k) { const int n = (i0 + k) * EPI + q; const int e = bperm((n & 64) ? idx1 : idx0, n & 63); b[k] = *(const uint4*)(tab + (size_t)e * SLW); }
#pragma unroll
        for (int k = 0; k < 8; ++k) { int a = __builtin_amdgcn_sdot4((int)b[k].x, hq[0], 0, false); a = __builtin_amdgcn_sdot4((int)b[k].y, hq[1], a, false);
          a = __builtin_amdgcn_sdot4((int)b[k].z, hq[2], a, false); a = __builtin_amdgcn_sdot4((int)b[k].w, hq[3], a, false);
          a = gsum<LPR>(a);
          const int i = i0 + k;
          if (r == (i % LPR)) res[i / LPR] = (float)a * sh; }
      }
#pragma unroll
      for (int rho = 0; rho < 2; ++rho) w.pd[((size_t)s * T + t) * 128 + (rho * LPR + r) * EPI + q] = res[rho];
    }
  }
}
__device__ void peer_wgt(const Params& p, const WS& w, int bid, int nb) {
  const int tid = tidx(), wave = tid >> 6, lane = tid & 63;
  for (int t = bid * 8 + wave; t < T; t += nb * 8) {
    const float rs2 = rsqrtf(w.ssq2[t] * (1.f / D) + EPS);
    float tot = 0.f;
#pragma unroll
    for (int hh = 0; hh < 2; ++hh) { const size_t o = (size_t)t * 128 + hh * 64 + lane; float z = 0.f;
#pragma unroll
      for (int s = 0; s < NSL; ++s) z += w.pd[(size_t)s * T * 128 + o];
      const int e = w.eidx[o];
      const float wv = w.eg[o] * gelu_tanh(z * w.usc[e] * rs2) * w.vsc[e];
      w.eg[o] = wv; tot += wv; }
    tot = wave_sum(tot);
    if (lane == 0) w.wsum[t] = tot;
  }
}
__device__ void peer_vals(const Params& p, const WS& w, int bid, int nb) {
  const int tid = tidx(), wave = tid >> 6, lane = tid & 63, r = lane % LPR, q = lane / LPR;
  const int x = bid & 7, nwl = (nb >> 3) * 8, wl = (bid >> 3) * 8 + wave;
  for (int sp = 0; sp < SPL; ++sp) {
    const int s = x * SPL + sp;
    const unsigned char* tab = w.v8 + (size_t)s * 16384 * SLW + r * 16;
    for (int t = wl; t < T; t += nwl) {
      const int idx0 = w.eidx[(size_t)t * 128 + lane], idx1 = w.eidx[(size_t)t * 128 + 64 + lane];
      const float w0 = w.eg[(size_t)t * 128 + lane], w1 = w.eg[(size_t)t * 128 + 64 + lane];
      float acc[16];
#pragma unroll
      for (int j = 0; j < 16; ++j) acc[j] = 0.f;
#pragma unroll
      for (int i0 = 0; i0 < NIT; i0 += 8) {
        uint4 b[8]; float wn[8];
#pragma unroll
        for (int k = 0; k < 8; ++k) { const int n = (i0 + k) * EPI + q; const int e = bperm((n & 64) ? idx1 : idx0, n & 63); wn[k] = bperm((n & 64) ? w1 : w0, n & 63); b[k] = *(const uint4*)(tab + (size_t)e * SLW); }
#pragma unroll
        for (int k = 0; k < 8; ++k) { float f[16]; ub16(b[k], f);
#pragma unroll
          for (int j = 0; j < 16; ++j) acc[j] += wn[k] * f[j]; }
      }
#pragma unroll
      for (int j = 0; j < 16; ++j) { if (LPR <= 8) acc[j] += sxor<8>(acc[j]); acc[j] += sxor<16>(acc[j]); acc[j] += sxor<32>(acc[j]); }
      float hf[16]; float ss = 0.f;
      unpack8(*(const uint4*)(w.h1b + (size_t)t * D + s * SLW + r * 16), hf); unpack8(*(const uint4*)(w.h1b + (size_t)t * D + s * SLW + r * 16 + 8), hf + 8);
      const float off = 128.f * w.wsum[t];
#pragma unroll
      for (int j = 0; j < 16; ++j) { acc[j] += hf[j] - off; ss += acc[j] * acc[j]; }
      if (q == 0) { *(uint4*)(w.h2b + (size_t)t * D + s * SLW + r * 16) = pack8(acc); *(uint4*)(w.h2b + (size_t)t * D + s * SLW + r * 16 + 8) = pack8(acc + 8);
#if F8_GATE
        const float rs2 = rsqrtf(w.ssq2[t] * (1.f / D) + EPS);
        *(uint4*)(w.h2q + (size_t)t * D + s * SLW + r * 16) = make_uint4(pack4_fp8(acc[0] * rs2, acc[1] * rs2, acc[2] * rs2, acc[3] * rs2), pack4_fp8(acc[4] * rs2, acc[5] * rs2, acc[6] * rs2, acc[7] * rs2),
                                                                      pack4_fp8(acc[8] * rs2, acc[9] * rs2, acc[10] * rs2, acc[11] * rs2), pack4_fp8(acc[12] * rs2, acc[13] * rs2, acc[14] * rs2, acc[15] * rs2));
#endif
      } else ss = 0.f;
      ss = wave_sum(ss);
      if (lane == 0) atomicAdd(w.ssq3 + t, ss);
    }
  }
}
__device__ void phase_final(const Params& p, const WS& w, int bid, int nb) {
  const int wave = tidx() >> 6, lane = tidx() & 63;
  for (int row = bid * 8 + wave; row < T; row += nb * 8) {
    float4* o = (float4*)(p.out + (size_t)row * D);
    const float rs = rsqrtf(w.ssq4[row] * (1.f / D) + EPS);
#pragma unroll
    for (int i = 0; i < 8; ++i) { float4 v = o[i * 64 + lane]; const float4 g = *(const float4*)(p.norm_final + (i * 64 + lane) * 4); v.x *= rs * g.x; v.y *= rs * g.y; v.z *= rs * g.z; v.w *= rs * g.w; o[i * 64 + lane] = v; }
  }
}

constexpr int NPHASE = 10;
#ifndef FAST_MIX
#define FAST_MIX 1
#endif
template <int PH>
__device__ __forceinline__ void run_phase(const Params& p, float* lds, int bid, int nb) {
  const WS w = make_ws(p.ws, p.out);
  if (PH == 0) phase_prep(p, w, lds, bid, nb);
  if (PH == 13) phase_prep2(p, w, lds, bid, nb);
  const float s_in = __uint_as_float(__builtin_amdgcn_readfirstlane((F8_IN && PH == 1) ? __float_as_uint(w.ctlf[0]) : 0u)) * (1.f / 256.f);
  const float s_out = F8_OUT ? __uint_as_float(__builtin_amdgcn_readfirstlane((PH == 5) ? __float_as_uint(w.ctlf[1]) : 0u)) * (1.f / 256.f) : 1.f;
  const float s_g = __uint_as_float(__builtin_amdgcn_readfirstlane((F8_GATE && PH == 11) ? __float_as_uint(w.ctlf[2]) : 0u)) * (1.f / 256.f);
#if F8_IN
  if (PH == 1) { gemm_any<true>(w.xq, w.winq, T, NPROJ, D, EpiProjN{w.proj, w.rstd1, s_in}, lds, bid, nb);
                 gemm_any<true>(w.winq + (size_t)NPROJ * D, w.xq, 2048, T, D, EpiProjT{w.vT, w.rstd1, s_in}, lds, bid, nb); }
#else
  if (PH == 1) { gemm_any(w.xb, w.win, T, NPROJ, D, EpiProjN{w.proj, w.rstd1, 1.f}, lds, bid, nb);
                 gemm_any(w.win + (size_t)NPROJ * D, w.xb, 2048, T, D, EpiProjT{w.vT, w.rstd1, 1.f}, lds, bid, nb); }
#endif
#if F8_OUT
  if (PH == 5) gemm_any<true>(w.yq, w.woutq, T, D, D, EpiOut{p.x, w.h1b, w.ssq2, s_out}, lds, bid, nb);
#else
  if (PH == 5) gemm_any(w.y, w.wout, T, D, D, EpiOut{p.x, w.h1b, w.ssq2, 1.f}, lds, bid, nb);
#endif
#if F8_GATE
  if (PH == 11) gemm_any<true>(w.h2q, w.wgq, T, D, D, EpiGate{w.h2b, w.pl, w.ssq3, p.out, w.ssq4, w.ssq2, s_g}, lds, bid, nb);
#else
  if (PH == 11) gemm_any(w.h2b, w.wg, T, D, D, EpiGate{w.h2b, w.pl, w.ssq3, p.out, w.ssq4, w.ssq2, 1.f}, lds, bid, nb);
#endif
#if FAST_MIX
  if (PH == 2) phase_mix_items<0>(p, w, (unsigned char*)lds, bid, nb);
  if (PH == 3) mix_scan(p, w, bid, nb);
  if (PH == 4) phase_mix_items<1>(p, w, (unsigned char*)lds, bid, nb);
#else
  if (PH == 2) phase_mixer_naive(p, w, lds, bid, nb);
#endif
  if (PH == 6) gemm_any(w.h1b, w.wq, T, D, D, EpiScore{w.sc, w.ssq2}, lds, bid, nb);
  if (PH == 7) { phase_topk(p, w, bid, nb); gemm_any(w.pb, w.wple, T, D, 256, EpiPl{w.pl}, lds, bid, nb); }
  if (PH == 8) peer_dots(p, w, bid, nb);
  if (PH == 9) peer_wgt(p, w, bid, nb);
  if (PH == 10) peer_vals(p, w, bid, nb);
  if (PH == 12) phase_final(p, w, bid, nb);
}

extern __shared__ __attribute__((aligned(16))) unsigned char dyn_lds[];

#if ONE_LAUNCH
__global__ void __launch_bounds__(512, 2) mega(Params p) {
  cg::grid_group grid = cg::this_grid();
  float* lds = (float*)dyn_lds; const int bid = blockIdx.x, nb = gridDim.x;
#ifndef DUP_PHASE
#define DUP_PHASE -1
#endif
#define RUNP(k) do { run_phase<k>(p, lds, bid, nb); if (DUP_PHASE == (k)) { grid.sync(); run_phase<k>(p, lds, bid, nb); } } while (0)
  RUNP(0); grid.sync();
#if F8_GEMM
  RUNP(13); grid.sync();
#endif
  RUNP(1); grid.sync();
  RUNP(2); grid.sync();
#if FAST_MIX
  RUNP(3); grid.sync();
  RUNP(4); grid.sync();
#endif
  RUNP(5); grid.sync();
  RUNP(6); grid.sync();
  RUNP(7); grid.sync();
  RUNP(8); grid.sync();
  RUNP(9); grid.sync();
  RUNP(10); grid.sync();
  RUNP(11); grid.sync();
  RUNP(12);
#undef RUNP
}
#else
template <int PH> __global__ void __launch_bounds__(512, 2) k_phase(Params p) { run_phase<PH>(p, (float*)dyn_lds, blockIdx.x, gridDim.x); }
#endif

constexpr size_t kDynLds = 131072;

extern "C" void kernel_launch(void* const* d_in, const int* in_sizes, int n_in, void* d_out, int out_size, void* d_ws, size_t ws_size, hipStream_t stream) {
  if (n_in != 22 || out_size != T * D || ws_size < WS_NEED) { fprintf(stderr, "kernel_launch: unexpected shapes (n_in %d out %d ws %zu)\n", n_in, out_size, ws_size); return; }
  Params p{};
  const float** f = (const float**)&p;
  for (int i = 0; i < 22; ++i) f[i] = (const float*)d_in[i];
  p.out = (float*)d_out; p.ws = (unsigned char*)d_ws;
#if ONE_LAUNCH
  static int grid_blocks = 0;
  if (!grid_blocks) {
    int dev = 0, cus = 0, per_cu = 0;
    (void)hipGetDevice(&dev); (void)hipDeviceGetAttribute(&cus, hipDeviceAttributeMultiprocessorCount, dev);
    (void)hipFuncSetAttribute((const void*)mega, hipFuncAttributeMaxDynamicSharedMemorySize, (int)kDynLds);
    (void)hipOccupancyMaxActiveBlocksPerMultiprocessor(&per_cu, mega, 512, kDynLds);
    if (per_cu < 1) { fprintf(stderr, "occupancy query says 0 blocks/CU\n"); per_cu = 1; }
    grid_blocks = cus;
  }
  void* args[] = {&p};
  hipError_t e = hipLaunchCooperativeKernel((void*)mega, dim3(grid_blocks), dim3(512), args, kDynLds, stream);
  if (e != hipSuccess) fprintf(stderr, "cooperative launch failed: %s (grid %d)\n", hipGetErrorString(e), grid_blocks);
#else
  static bool attr = false;
  const int G = 256;
#define LAUNCH(PH) do { if (!attr) (void)hipFuncSetAttribute((const void*)k_phase<PH>, hipFuncAttributeMaxDynamicSharedMemorySize, (int)kDynLds); \
    hipLaunchKernelGGL(k_phase<PH>, dim3(G), dim3(512), kDynLds, stream, p); } while (0)
  LAUNCH(0); LAUNCH(13); LAUNCH(1); LAUNCH(2); LAUNCH(3); LAUNCH(4); LAUNCH(5); LAUNCH(6); LAUNCH(7); LAUNCH(8); LAUNCH(9); LAUNCH(10); LAUNCH(11); LAUNCH(12);
  attr = true;
#undef LAUNCH
#endif
}
```

```cpp
#include <hip/hip_runtime.h>
#include <hip/hip_cooperative_groups.h>
#include <cstdio>
#include <cstdint>
namespace cg = cooperative_groups;

#ifndef ONE_LAUNCH
#define ONE_LAUNCH 1
#endif

typedef unsigned short bf16_t;
constexpr int T = 32768, SEQ = 16384, D = 2048;
constexpr int NPROJ = 4352;
constexpr int C_GQ = 0, C_GK = 512, C_GG = 1024, C_MQ = 2048, C_MK = 2560, C_MO = 3072, C_SM = 4096;
constexpr float EPS = 1e-6f;
constexpr size_t MiB = 1ull << 20;
constexpr size_t OFF_XB = 0, OFF_Y = 0, OFF_PL = 0;
constexpr size_t OFF_PROJ = 128 * MiB, OFF_H1B = 128 * MiB, OFF_H2B = 256 * MiB;
constexpr size_t OFF_VT = 400 * MiB, OFF_SC = 400 * MiB;
constexpr size_t OFF_UB = 528 * MiB, OFF_VB = 592 * MiB;
constexpr size_t OFF_WIN = 656 * MiB, OFF_WOUT = 681 * MiB, OFF_WQ = 689 * MiB, OFF_WG = 697 * MiB, OFF_WPLE = 705 * MiB;
constexpr size_t OFF_PB = 706 * MiB, OFF_EIDX = 722 * MiB, OFF_EG = 738 * MiB, OFF_MISC = 754 * MiB;
constexpr size_t OFF_GDEC = 755 * MiB, OFF_MN = 756 * MiB, OFF_MDEC = 757 * MiB, OFF_ESC = 758 * MiB;
constexpr size_t OFF_CTL = 759 * MiB, OFF_H2Q = 400 * MiB, OFF_QS = 760 * MiB, OFF_KS = 824 * MiB, OFF_KDT = 888 * MiB;
constexpr size_t WS_NEED = 952 * MiB;
#ifndef F8_IN
#define F8_IN 0
#endif
#ifndef F8_OUT
#define F8_OUT 1
#endif
#ifndef F8_GATE
#define F8_GATE 1
#endif
#ifndef F8_GEMM
#define F8_GEMM (F8_IN || F8_OUT || F8_GATE)
#endif

struct Params {
  const float *x, *p, *norm_mix, *w_in, *gate_up, *gate_bias, *gla_norm, *conv_w, *conv_b, *ig_bias, *fg_bias, *mlstm_norm,
      *w_out, *norm_ffn, *peer_query, *sub_keys, *peer_u, *peer_v, *norm_ple, *w_ple, *w_ple_gate, *norm_final;
  float* out;
  unsigned char* ws;
};

__device__ __forceinline__ float bf2f(bf16_t b) { return __uint_as_float(((unsigned)b) << 16); }
typedef __bf16 bf16v2_t __attribute__((ext_vector_type(2)));
__device__ __forceinline__ bf16_t f2bf(float f) { const __bf16 b = (__bf16)f; return __builtin_bit_cast(bf16_t, b); }
__device__ __forceinline__ unsigned pack2(float lo, float hi) { const bf16v2_t v = {(__bf16)lo, (__bf16)hi}; return __builtin_bit_cast(unsigned, v); }
__device__ __forceinline__ unsigned pack4_fp8(float a, float b, float c, float d) { int v = __builtin_amdgcn_cvt_pk_fp8_f32(a, b, 0, false); v = __builtin_amdgcn_cvt_pk_fp8_f32(c, d, v, true); return (unsigned)v; }
__device__ __forceinline__ float lo_f(unsigned u) { return __uint_as_float(u << 16); }
__device__ __forceinline__ float hi_f(unsigned u) { return __uint_as_float(u & 0xffff0000u); }
__device__ __forceinline__ int tidx() { int t = threadIdx.x; asm volatile("" : "+v"(t)); return t; }
template <int O> __device__ __forceinline__ int sxor_i(int v) {
  if constexpr (O < 32) return __builtin_amdgcn_ds_swizzle(v, (O << 10) | 0x1f);
  else return __builtin_amdgcn_ds_bpermute(((tidx() & 63) ^ 32) << 2, v);
}
template <int O> __device__ __forceinline__ float sxor(float v) { return __int_as_float(sxor_i<O>(__float_as_int(v))); }
template <int O> __device__ __forceinline__ int sxor(int v) { return sxor_i<O>(v); }
__device__ __forceinline__ int bperm(int v, int src_lane) { return __builtin_amdgcn_ds_bpermute(src_lane << 2, v); }
__device__ __forceinline__ float bperm(float v, int src_lane) { return __int_as_float(__builtin_amdgcn_ds_bpermute(src_lane << 2, __float_as_int(v))); }
template <int N> __device__ __forceinline__ float gsum(float v) {
  if constexpr (N >= 2) v += sxor<1>(v); if constexpr (N >= 4) v += sxor<2>(v); if constexpr (N >= 8) v += sxor<4>(v);
  if constexpr (N >= 16) v += sxor<8>(v); if constexpr (N >= 32) v += sxor<16>(v); if constexpr (N >= 64) v += sxor<32>(v); return v; }
template <int N> __device__ __forceinline__ int gsum(int v) {
  if constexpr (N >= 2) v += sxor<1>(v); if constexpr (N >= 4) v += sxor<2>(v); if constexpr (N >= 8) v += sxor<4>(v);
  if constexpr (N >= 16) v += sxor<8>(v); if constexpr (N >= 32) v += sxor<16>(v); if constexpr (N >= 64) v += sxor<32>(v); return v; }
template <int N> __device__ __forceinline__ float gmax(float v) {
  if constexpr (N >= 2) v = fmaxf(v, sxor<1>(v)); if constexpr (N >= 4) v = fmaxf(v, sxor<2>(v)); if constexpr (N >= 8) v = fmaxf(v, sxor<4>(v));
  if constexpr (N >= 16) v = fmaxf(v, sxor<8>(v)); if constexpr (N >= 32) v = fmaxf(v, sxor<16>(v)); if constexpr (N >= 64) v = fmaxf(v, sxor<32>(v)); return v; }
__device__ __forceinline__ float wave_sum(float v) { return gsum<64>(v); }
__device__ __forceinline__ float sigmoidf_(float x) { return __builtin_amdgcn_rcpf(1.f + __expf(-x)); }
__device__ __forceinline__ float siluf_(float x) { return x * __builtin_amdgcn_rcpf(1.f + __expf(-x)); }
__device__ __forceinline__ float logsigmoidf_(float x) { return fminf(x, 0.f) - __logf(1.f + __expf(-fabsf(x))); }
__device__ __forceinline__ float gelu_tanh(float x) { const float u = 0.7978845608028654f * (x + 0.044715f * x * x * x); return x * __builtin_amdgcn_rcpf(1.f + __expf(-2.f * u)); }
__device__ __forceinline__ void unpack8(const uint4 q, float* f) {
  f[0] = lo_f(q.x); f[1] = hi_f(q.x); f[2] = lo_f(q.y); f[3] = hi_f(q.y); f[4] = lo_f(q.z); f[5] = hi_f(q.z); f[6] = lo_f(q.w); f[7] = hi_f(q.w);
}
__device__ __forceinline__ uint4 pack8(const float* f) { return make_uint4(pack2(f[0], f[1]), pack2(f[2], f[3]), pack2(f[4], f[5]), pack2(f[6], f[7])); }

struct WS {
  bf16_t *xb, *y, *pl, *proj, *h1b, *h2b, *vT, *sc, *ub, *vb, *win, *wout, *wq, *wg, *wple, *pb;
  int* eidx; float* eg; float *rstd1, *ssq2, *ssq3, *ssq4, *wsum, *gdec, *mn, *mdec, *usc, *vsc, *pd;
  unsigned char *u8, *v8, *xq, *yq, *h2q, *winq, *woutq, *wgq;
  bf16_t *qs, *ks, *kdT;
  float* ctlf;
};
__device__ __forceinline__ WS make_ws(unsigned char* ws, float* out) {
  WS w;
  w.xb = (bf16_t*)(ws + OFF_XB); w.y = (bf16_t*)(ws + OFF_Y); w.pl = (bf16_t*)(ws + OFF_PL); w.proj = (bf16_t*)(ws + OFF_PROJ);
  w.h1b = (bf16_t*)(ws + OFF_H1B); w.h2b = (bf16_t*)(ws + OFF_H2B); w.vT = (bf16_t*)(ws + OFF_VT); w.sc = (bf16_t*)(ws + OFF_SC);
  w.ub = (bf16_t*)(ws + OFF_UB); w.vb = (bf16_t*)(ws + OFF_VB); w.win = (bf16_t*)(ws + OFF_WIN); w.wout = (bf16_t*)(ws + OFF_WOUT);
  w.wq = (bf16_t*)(ws + OFF_WQ); w.wg = (bf16_t*)(ws + OFF_WG); w.wple = (bf16_t*)(ws + OFF_WPLE); w.pb = (bf16_t*)(ws + OFF_PB);
  w.eidx = (int*)(ws + OFF_EIDX); w.eg = (float*)(ws + OFF_EG);
  float* m = (float*)(ws + OFF_MISC); w.rstd1 = m; w.ssq2 = m + T; w.ssq3 = m + 2 * T; w.ssq4 = m + 3 * T; w.wsum = m + 4 * T;
  w.gdec = (float*)(ws + OFF_GDEC); w.mn = (float*)(ws + OFF_MN); w.mdec = (float*)(ws + OFF_MDEC);
  w.usc = (float*)(ws + OFF_ESC); w.vsc = w.usc + 16384; w.u8 = ws + OFF_UB; w.v8 = ws + OFF_VB; w.pd = out;
  w.xq = ws + OFF_XB; w.yq = ws + OFF_Y; w.h2q = ws + OFF_H2Q; w.winq = ws + OFF_WIN; w.woutq = ws + OFF_WOUT; w.wgq = ws + OFF_WG; w.ctlf = (float*)(ws + OFF_CTL);
  w.qs = (bf16_t*)(ws + OFF_QS); w.ks = (bf16_t*)(ws + OFF_KS); w.kdT = (bf16_t*)(ws + OFF_KDT);
  return w;
}

__device__ void prep_x(const Params& p, const WS& w, int bid, int nb) {
  const int wave = tidx() >> 6, lane = tidx() & 63;
  for (int row = bid * 8 + wave; row < T; row += nb * 8) {
    const float4* src = (const float4*)(p.x + (size_t)row * D);
    float4 v[8]; float ss = 0.f;
#pragma unroll
    for (int i = 0; i < 8; ++i) { v[i] = src[i * 64 + lane]; ss += v[i].x * v[i].x + v[i].y * v[i].y + v[i].z * v[i].z + v[i].w * v[i].w; }
    ss = wave_sum(ss);
    const float rs = rsqrtf(ss * (1.f / D) + EPS);
#if F8_IN
    unsigned* dst = (unsigned*)(w.xq + (size_t)row * D);
#pragma unroll
    for (int i = 0; i < 8; ++i) dst[i * 64 + lane] = pack4_fp8(v[i].x * rs, v[i].y * rs, v[i].z * rs, v[i].w * rs);
#else
    uint2* dst = (uint2*)(w.xb + (size_t)row * D);
#pragma unroll
    for (int i = 0; i < 8; ++i) dst[i * 64 + lane] = make_uint2(pack2(v[i].x, v[i].y), pack2(v[i].z, v[i].w));
#endif
    if (lane == 0) w.rstd1[row] = rs;
  }
}
__device__ void absmax_w(const float* src, size_t n, const float* gain, int ncols, float* part, float* lds, int bid, int nb) {
  float m = 0.f;
  for (size_t i = (size_t)bid * 512 + tidx(); i < n / 4; i += (size_t)nb * 512) { const float4 v = ((const float4*)src)[i]; const float g = gain ? gain[(i * 4) / (size_t)ncols] : 1.f;
    m = fmaxf(m, fabsf(g) * fmaxf(fmaxf(fabsf(v.x), fabsf(v.y)), fmaxf(fabsf(v.z), fabsf(v.w)))); }
  m = gmax<64>(m);
  __syncthreads();
  if ((tidx() & 63) == 0) lds[tidx() >> 6] = m;
  __syncthreads();
  if (tidx() == 0) { float t = lds[0];
#pragma unroll
    for (int i = 1; i < 8; ++i) t = fmaxf(t, lds[i]);
    part[bid] = t; }
  __syncthreads();
}
__device__ float amax_reduce(const float* part, float* lds, int nb) {
  float m = 0.f;
  for (int i = tidx(); i < nb; i += 512) m = fmaxf(m, part[i]);
  m = gmax<64>(m);
  __syncthreads();
  if ((tidx() & 63) == 0) lds[tidx() >> 6] = m;
  __syncthreads();
  float t = lds[0];
#pragma unroll
  for (int i = 1; i < 8; ++i) t = fmaxf(t, lds[i]);
  return t;
}
__device__ void cvt_rows(const float* src, bf16_t* dst, size_t n, const float* gain, int ncols, int bid, int nb) {
  const size_t n4 = n / 4;
  for (size_t i = (size_t)bid * 512 + tidx(); i < n4; i += (size_t)nb * 512) {
    float4 v = ((const float4*)src)[i];
    if (gain) { const float4 g = *(const float4*)(gain + (int)((i * 4) % (size_t)ncols)); v.x *= g.x; v.y *= g.y; v.z *= g.z; v.w *= g.w; }
    ((uint2*)dst)[i] = make_uint2(pack2(v.x, v.y), pack2(v.z, v.w));
  }
}
template <bool F8OUT, class CM>
__device__ void transpose_w(const float* src, int K, int ldsrc, void* dstv, int Ndst, const float* gain, CM cm, float amax, float* lds, int bid, int nb) {
  const int tid = tidx(), tk = K / 64, ntile = (Ndst / 64) * tk;
  const float qs = F8OUT ? 256.f / fmaxf(amax, 1e-30f) : 1.f;
  for (int tile = bid; tile < ntile; tile += nb) {
    const int n0 = (tile / tk) * 64, k0 = (tile % tk) * 64;
    const int nc = tid & 63, sc = cm(n0 + nc);
#pragma unroll
    for (int i = 0; i < 8; ++i) { const int kr = (tid >> 6) + 8 * i; float v = 0.f; if (sc >= 0) { v = src[(size_t)(k0 + kr) * ldsrc + sc]; if (gain) v *= gain[k0 + kr]; } lds[kr * 65 + nc] = v * qs; }
    __syncthreads();
    { const int nr = tid >> 3, ks = (tid & 7) * 8; float f[8];
#pragma unroll
      for (int j = 0; j < 8; ++j) f[j] = lds[(ks + j) * 65 + nr];
      if (F8OUT) *(uint2*)((unsigned char*)dstv + (size_t)(n0 + nr) * K + k0 + ks) = make_uint2(pack4_fp8(f[0], f[1], f[2], f[3]), pack4_fp8(f[4], f[5], f[6], f[7]));
      else *(uint4*)((bf16_t*)dstv + (size_t)(n0 + nr) * K + k0 + ks) = pack8(f); }
    __syncthreads();
  }
}
struct CmIdent { __device__ int operator()(int n) const { return n; } };
struct CmWin {
  __device__ int operator()(int n) const {
    if (n < 1024) return n;
    if (n < 2048) return 2048 + (n - 1024);
    if (n < 2560) return 3088 + (n - 2048);
    if (n < 3072) return 3600 + (n - 2560);
    if (n < 4096) return 5136 + (n - 3072);
    if (n < 4352) { const int i = n - 4096; if (i < 16) return 3072 + i; if (i < 20) return 6160 + (i - 16); if (i < 24) return 6164 + (i - 20); return -1; }
    const int j = n - 4352; if (j < 1024) return 1024 + j;
    return 4112 + (j - 1024);
  }
};
__device__ void prep_wq(const Params& p, const WS& w, float* lds, int bid, int nb) {
  const int tid = tidx();
  float* SKs = lds;
  float* WQs = lds + 128 * 132;
  for (int item = bid; item < 16 * 32; item += nb) {
    const int hp = item >> 5, k0 = (item & 31) * 64;
#pragma unroll
    for (int i = 0; i < 8; ++i) { const int e4 = tid + 512 * i, key = e4 >> 5, d4 = (e4 & 31) * 4; *(float4*)(SKs + key * 132 + d4) = *(const float4*)(p.sub_keys + (size_t)hp * 16384 + key * 128 + d4); }
#pragma unroll
    for (int i = 0; i < 4; ++i) { const int e4 = tid + 512 * i, kr = e4 >> 5, d4 = (e4 & 31) * 4; float4 v = *(const float4*)(p.peer_query + (size_t)(k0 + kr) * 2048 + hp * 128 + d4); const float g = p.norm_ffn[k0 + kr]; v.x *= g; v.y *= g; v.z *= g; v.w *= g; *(float4*)(WQs + kr * 132 + d4) = v; }
    __syncthreads();
    const int k = tid & 63, kg = tid >> 6;
    float acc[16];
#pragma unroll
    for (int j = 0; j < 16; ++j) acc[j] = 0.f;
    for (int d4 = 0; d4 < 32; ++d4) {
      const float4 a = *(const float4*)(WQs + k * 132 + d4 * 4);
#pragma unroll
      for (int j = 0; j < 16; ++j) { const float4 s = *(const float4*)(SKs + (kg * 16 + j) * 132 + d4 * 4); acc[j] += a.x * s.x + a.y * s.y + a.z * s.z + a.w * s.w; }
    }
#pragma unroll
    for (int j = 0; j < 16; ++j) w.wq[(size_t)(hp * 128 + kg * 16 + j) * 2048 + k0 + k] = f2bf(acc[j]);
    __syncthreads();
  }
}

#ifndef PEER_SLW
#define PEER_SLW 256
#endif
constexpr int SLW = PEER_SLW, LPR = SLW / 16, EPI = 64 / LPR, NSL = 2048 / SLW, SPL = NSL / 8, NIT = 128 / EPI;
template <bool SIGNED>
__device__ void quant_rows(const float* src, const float* gain, unsigned char* dst, float* scale, int bid, int nb) {
  const int tid = tidx(), wave = tid >> 6, lane = tid & 63;
  for (int row = bid * 8 + wave; row < 16384; row += nb * 8) {
    float f[32]; float mx = 0.f;
#pragma unroll
    for (int i = 0; i < 2; ++i)
#pragma unroll
      for (int q = 0; q < 4; ++q) { float4 v = *(const float4*)(src + (size_t)row * 2048 + i * 1024 + lane * 16 + q * 4);
        if (gain) { const float4 g = *(const float4*)(gain + i * 1024 + lane * 16 + q * 4); v.x *= g.x; v.y *= g.y; v.z *= g.z; v.w *= g.w; }
        f[i * 16 + q * 4] = v.x; f[i * 16 + q * 4 + 1] = v.y; f[i * 16 + q * 4 + 2] = v.z; f[i * 16 + q * 4 + 3] = v.w;
        mx = fmaxf(mx, fmaxf(fmaxf(fabsf(v.x), fabsf(v.y)), fmaxf(fabsf(v.z), fabsf(v.w)))); }
    mx = gmax<64>(mx);
    const float sc = fmaxf(mx, 1e-30f) * (1.f / 127.f), inv = 1.f / sc;
#pragma unroll
    for (int i = 0; i < 2; ++i) { unsigned wd[4];
#pragma unroll
      for (int q = 0; q < 4; ++q) { unsigned x = 0;
#pragma unroll
        for (int j = 0; j < 4; ++j) { const int v = (int)rintf(f[i * 16 + q * 4 + j] * inv) + (SIGNED ? 0 : 128); x |= ((unsigned)v & 0xffu) << (8 * j); }
        wd[q] = x; }
      const int el = i * 1024 + lane * 16;
      *(uint4*)(dst + ((size_t)(el / SLW) * 16384 + row) * SLW + (el % SLW)) = make_uint4(wd[0], wd[1], wd[2], wd[3]); }
    if (lane == 0) scale[row] = sc;
  }
}
__device__ void phase_prep(const Params& p, const WS& w, float* lds, int bid, int nb) {
  prep_x(p, w, bid, nb);
#if F8_IN
  absmax_w(p.w_in, (size_t)2048 * 6168, p.norm_mix, 6168, w.ctlf + 1024, lds, bid, nb);
#else
  transpose_w<false>(p.w_in, 2048, 6168, w.win, 6400, p.norm_mix, CmWin(), 0.f, lds, bid, nb);
#endif
#if F8_OUT
  absmax_w(p.w_out, (size_t)2048 * 2048, nullptr, 2048, w.ctlf + 2048, lds, bid, nb);
#else
  transpose_w<false>(p.w_out, 2048, 2048, w.wout, 2048, nullptr, CmIdent(), 0.f, lds, bid, nb);
#endif
#if F8_GATE
  absmax_w(p.w_ple_gate, (size_t)2048 * 2048, p.norm_ple, 2048, w.ctlf + 3072, lds, bid, nb);
#else
  transpose_w<false>(p.w_ple_gate, 2048, 2048, w.wg, 2048, p.norm_ple, CmIdent(), 0.f, lds, bid, nb);
#endif
  cvt_rows(p.p, w.pb, (size_t)T * 256, nullptr, 256, bid, nb);
  quant_rows<true>(p.peer_u, p.norm_ffn, w.u8, w.usc, bid, nb);
  quant_rows<false>(p.peer_v, nullptr, w.v8, w.vsc, bid, nb);
  transpose_w<false>(p.w_ple, 256, 2048, w.wple, 2048, nullptr, CmIdent(), 0.f, lds, bid, nb);
  prep_wq(p, w, lds, bid, nb);
  for (int i = bid * 512 + tidx(); i < T; i += nb * 512) { w.ssq2[i] = 0.f; w.ssq3[i] = 0.f; w.ssq4[i] = 0.f; }
}
__device__ void phase_prep2(const Params& p, const WS& w, float* lds, int bid, int nb) {
#if F8_IN
  { const float a0 = amax_reduce(w.ctlf + 1024, lds, nb); if (bid == 0 && tidx() == 0) w.ctlf[0] = a0; __syncthreads();
    transpose_w<true>(p.w_in, 2048, 6168, w.winq, 6400, p.norm_mix, CmWin(), a0, lds, bid, nb); }
#endif
#if F8_OUT
  { const float a1 = amax_reduce(w.ctlf + 2048, lds, nb); if (bid == 0 && tidx() == 0) w.ctlf[1] = a1; __syncthreads();
    transpose_w<true>(p.w_out, 2048, 2048, w.woutq, 2048, nullptr, CmIdent(), a1, lds, bid, nb); }
#endif
#if F8_GATE
  { const float a2 = amax_reduce(w.ctlf + 3072, lds, nb); if (bid == 0 && tidx() == 0) w.ctlf[2] = a2; __syncthreads();
    transpose_w<true>(p.w_ple_gate, 2048, 2048, w.wgq, 2048, p.norm_ple, CmIdent(), a2, lds, bid, nb); }
#endif
}

struct EpiProjN { bf16_t* out; const float* rstd; float ws; static constexpr bool ROWSUM = false;
  __device__ __forceinline__ float store8(int r, int c, const float* v) const { const float s = F8_IN ? ws : rstd[r]; float f[8];
#pragma unroll
    for (int j = 0; j < 8; ++j) f[j] = v[j] * s;
    *(uint4*)(out + (size_t)r * NPROJ + c) = pack8(f); return 0.f; }
  __device__ __forceinline__ void rowsum(int, float) const {} };
struct EpiProjT { bf16_t* out; const float* rstd; float ws; static constexpr bool ROWSUM = false;
  __device__ __forceinline__ float store8(int r, int c, const float* v) const { const float4 s0 = F8_IN ? make_float4(ws, ws, ws, ws) : *(const float4*)(rstd + c), s1 = F8_IN ? s0 : *(const float4*)(rstd + c + 4); float f[8];
    f[0] = v[0] * s0.x; f[1] = v[1] * s0.y; f[2] = v[2] * s0.z; f[3] = v[3] * s0.w; f[4] = v[4] * s1.x; f[5] = v[5] * s1.y; f[6] = v[6] * s1.z; f[7] = v[7] * s1.w;
    *(uint4*)(out + (size_t)r * T + c) = pack8(f); return 0.f; }
  __device__ __forceinline__ void rowsum(int, float) const {} };
struct EpiOut { const float* x; bf16_t* h1b; float* ssq; float ws; static constexpr bool ROWSUM = true;
  __device__ __forceinline__ float store8(int r, int c, const float* v) const { const float4 x0 = *(const float4*)(x + (size_t)r * D + c), x1 = *(const float4*)(x + (size_t)r * D + c + 4); float f[8];
    f[0] = v[0] * ws + x0.x; f[1] = v[1] * ws + x0.y; f[2] = v[2] * ws + x0.z; f[3] = v[3] * ws + x0.w; f[4] = v[4] * ws + x1.x; f[5] = v[5] * ws + x1.y; f[6] = v[6] * ws + x1.z; f[7] = v[7] * ws + x1.w;
    float s = 0.f;
#pragma unroll
    for (int j = 0; j < 8; ++j) s += f[j] * f[j];
    *(uint4*)(h1b + (size_t)r * D + c) = pack8(f); return s; }
  __device__ __forceinline__ void rowsum(int r, float s) const { atomicAdd(ssq + r, s); } };
struct EpiScore { bf16_t* sc; const float* ssq; static constexpr bool ROWSUM = false;
  __device__ __forceinline__ float store8(int r, int c, const float* v) const { const float s = rsqrtf(ssq[r] * (1.f / D) + EPS); float f[8];
#pragma unroll
    for (int j = 0; j < 8; ++j) f[j] = v[j] * s;
    *(uint4*)(sc + (size_t)r * D + c) = pack8(f); return 0.f; }
  __device__ __forceinline__ void rowsum(int, float) const {} };
struct EpiPl { bf16_t* pl; static constexpr bool ROWSUM = false;
  __device__ __forceinline__ float store8(int r, int c, const float* v) const { *(uint4*)(pl + (size_t)r * D + c) = pack8(v); return 0.f; }
  __device__ __forceinline__ void rowsum(int, float) const {} };
struct EpiGate { const bf16_t* h2b; const bf16_t* pl; const float* ssq3; float* out; float* ssq; const float* ssq2; float ws; static constexpr bool ROWSUM = true;
  __device__ __forceinline__ float store8(int r, int c, const float* v) const { const float rs = rsqrtf(ssq3[r] * (1.f / D) + EPS) * (F8_GATE ? ws * sqrtf(ssq2[r] * (1.f / D) + EPS) : 1.f); float h[8], q[8], f[8];
    unpack8(*(const uint4*)(h2b + (size_t)r * D + c), h); unpack8(*(const uint4*)(pl + (size_t)r * D + c), q);
    float s = 0.f;
#pragma unroll
    for (int j = 0; j < 8; ++j) { f[j] = h[j] + sigmoidf_(v[j] * rs) * q[j]; s += f[j] * f[j]; }
    *(float4*)(out + (size_t)r * D + c) = make_float4(f[0], f[1], f[2], f[3]); *(float4*)(out + (size_t)r * D + c + 4) = make_float4(f[4], f[5], f[6], f[7]); return s; }
  __device__ __forceinline__ void rowsum(int r, float s) const { atomicAdd(ssq + r, s); } };

template <class Epi>
__device__ void gemm_naive(const bf16_t* A, const bf16_t* Bt, int M, int N, int K, const Epi& E, float* lds, int bid, int nb) {
  const int tid = tidx(), ty = tid >> 4, tx = tid & 15;
  float* As = lds;
  float* Bs = lds + 32 * 132;
  const int nM = M / 128, nN = N / 128;
  for (int tile = bid; tile < nM * nN; tile += nb) {
    const int m0 = (tile % nM) * 128, n0 = (tile / nM) * 128;
    float acc[4][8];
#pragma unroll
    for (int i = 0; i < 4; ++i)
#pragma unroll
      for (int j = 0; j < 8; ++j) acc[i][j] = 0.f;
    const int lr = tid >> 2, lk = (tid & 3) * 8;
    for (int k0 = 0; k0 < K; k0 += 32) {
      const uint4 av = *(const uint4*)(A + (size_t)(m0 + lr) * K + k0 + lk);
      const uint4 bv = *(const uint4*)(Bt + (size_t)(n0 + lr) * K + k0 + lk);
      float af[8], bf[8]; unpack8(av, af); unpack8(bv, bf);
      __syncthreads();
#pragma unroll
      for (int j = 0; j < 8; ++j) { As[(lk + j) * 132 + lr] = af[j]; Bs[(lk + j) * 132 + lr] = bf[j]; }
      __syncthreads();
#pragma unroll 8
      for (int kk = 0; kk < 32; ++kk) {
        const float4 a = *(const float4*)(As + kk * 132 + ty * 4);
        const float4 b0 = *(const float4*)(Bs + kk * 132 + tx * 8), b1 = *(const float4*)(Bs + kk * 132 + tx * 8 + 4);
        const float aa[4] = {a.x, a.y, a.z, a.w}; const float bb[8] = {b0.x, b0.y, b0.z, b0.w, b1.x, b1.y, b1.z, b1.w};
#pragma unroll
        for (int i = 0; i < 4; ++i)
#pragma unroll
          for (int j = 0; j < 8; ++j) acc[i][j] += aa[i] * bb[j];
      }
    }
#pragma unroll
    for (int i = 0; i < 4; ++i) {
      const int r = m0 + ty * 4 + i;
      float s = E.store8(r, n0 + tx * 8, acc[i]);
      if (Epi::ROWSUM) { s = gsum<16>(s); if (tx == 0) E.rowsum(r, s); }
    }
  }
}


namespace pg8 {
#define PG8_LAS __attribute__((address_space(3)))
typedef short bf16x8 __attribute__((ext_vector_type(8)));
typedef float f32x4 __attribute__((ext_vector_type(4)));
typedef int v4i_t __attribute__((ext_vector_type(4)));
typedef int v8i_t __attribute__((ext_vector_type(8)));
constexpr int BM = 256, BK = 64, HALF = 128, HTB = HALF * BK * 2, STAGE_BYTES = 8 * HTB, NXCD = 8, WGM = 8;
__host__ __device__ __forceinline__ int lds_byte(int r, int c) { const int st = (r >> 4) * 2 + (c >> 5), rr = r & 15, cc = c & 31, ob = rr * 64 + cc * 2; return st * 1024 + (ob ^ (((ob >> 9) & 1) << 5)); }
__host__ __device__ __forceinline__ void stage_rc(int b, int& R, int& C) { const int st = b / 1024, sb = b % 1024, swz = sb ^ (((sb >> 9) & 1) << 5); R = (st >> 1) * 16 + swz / 64; C = (st & 1) * 32 + (swz % 64) / 2; }
__host__ __device__ __forceinline__ int perm32(int rho) { const int n = rho >> 4, i = rho & 15; return 8 * (i >> 2) + 4 * n + (i & 3); }
struct Unit { int pm, pn; };
struct Gemm { const bf16_t* A; const bf16_t* Bt; int M, N, K; };
struct StaticOrder {
    int nM, nN, nwg, G, c;
    __host__ __device__ void init(int M, int N, int G_, int c_) { nM = M / BM; nN = N / BM; nwg = nM * nN; G = G_; c = c_; }
    __host__ __device__ bool next(int i, Unit& u) const {
        const long L = (long)i * G + c; if (L >= nwg) return false;
        int wgid = (int)L; { const int q = nwg / NXCD, r = nwg % NXCD, xcd = wgid % NXCD, off = wgid / NXCD; wgid = (xcd < r ? xcd * (q + 1) : r * (q + 1) + (xcd - r) * q) + off; }
        const int nig = WGM * nN, gid = wgid / nig, fm = gid * WGM, gsz = (nM - fm) < WGM ? (nM - fm) : WGM;
        u.pm = fm + ((wgid % nig) % gsz); u.pn = (wgid % nig) / gsz; return true;
    }
    __device__ __forceinline__ void a_ready(const Unit&) const {}
    __device__ __forceinline__ void done(const Unit&) const {}
};
template <class E8> struct EpiA {
    static constexpr bool PERM = true, AFTER_DRAIN = false;
    E8 e;
    __device__ __forceinline__ void operator()(const f32x4 (&acc)[2][2][4][2], const Unit& u, int wr, int wc, int fr, int fq) const {
        asm volatile("" : "+v"(fr), "+v"(fq));
        const int row0 = u.pm * BM + wr * 64 + fr, col0 = u.pn * BM + wc * 32 + 8 * fq;
#pragma unroll
        for (int ai = 0; ai < 2; ++ai)
#pragma unroll
            for (int m = 0; m < 4; ++m) { const int r = row0 + ai * HALF + m * 16; float s = 0.f;
#pragma unroll
                for (int bj = 0; bj < 2; ++bj) { const float v[8] = {acc[ai][bj][m][0][0], acc[ai][bj][m][0][1], acc[ai][bj][m][0][2], acc[ai][bj][m][0][3], acc[ai][bj][m][1][0], acc[ai][bj][m][1][1], acc[ai][bj][m][1][2], acc[ai][bj][m][1][3]};
                    s += e.store8(r, col0 + bj * HALF, v); }
                if (E8::ROWSUM) { s += sxor<16>(s); s += sxor<32>(s); if (fq == 0) e.rowsum(r, s); }
                asm volatile("" ::: "memory"); }
    }
    __device__ __forceinline__ void fused(f32x4 (&)[2][2][4][2], const Unit&, int, int, int, int, PG8_LAS unsigned char*, int, int) const {}
};
template <class Epi, class Sched, bool ALIGN_EPI = false, bool SP2 = false, bool F8 = false>
__device__ __forceinline__ void gemm_phase(PG8_LAS unsigned char* lds, const Gemm g, const Sched& S, const Epi& E) {
    int tid_ = threadIdx.x; asm volatile("" : "+v"(tid_));
    const int tid = tid_, wid = __builtin_amdgcn_readfirstlane(tid >> 6), lane = tid & 63, wr = wid >> 2, wc = wid & 3, fr = lane & 15, fq = lane >> 4;
    const int K = g.K, nt = K / BK;
    unsigned voffA[2], voffB[2];
#pragma unroll
    for (int i = 0; i < 2; ++i) { int R, C; stage_rc(tid * 16 + i * 8192, R, C); const int Rb = Epi::PERM ? ((R & ~31) + perm32(R & 31)) : R;
        voffA[i] = (unsigned)(R * K + C) * 2u; voffB[i] = (unsigned)(Rb * K + C) * 2u; }
    const size_t kstep = (size_t)(BK * 2);
    const size_t hstep = (size_t)HALF * K * 2;
    const size_t tstep = 2 * hstep;
    const unsigned ldsw = (unsigned)wid * 1024u;
    const int aoff = lds_byte(wr * 64 + fr, fq * 8), boff = lds_byte(wc * 32 + fr, fq * 8);
#define PG8_SA(b, h) (((b) * 2 + (h)) * HTB)
#define PG8_SB(b, h) ((4 + (b) * 2 + (h)) * HTB)
#define PG8_STAGE(bufoff, gbase, voff) do { _Pragma("unroll") for (int _i = 0; _i < 2; ++_i) \
        __builtin_amdgcn_global_load_lds((const unsigned*)((const char*)(gbase) + (voff)[_i]), (PG8_LAS unsigned*)(lds + (bufoff) + ldsw + _i * 8192), 16, 0, 0); } while (0)
#define PG8_LDA(dst, b, h) do { _Pragma("unroll") for (int m = 0; m < 4; ++m) { const v4i_t lo_ = *(const PG8_LAS v4i_t*)(lds + PG8_SA(b, h) + aoff + m * 2048), hi_ = *(const PG8_LAS v4i_t*)(lds + PG8_SA(b, h) + aoff + m * 2048 + 1024); dst[m] = __builtin_shufflevector(lo_, hi_, 0, 1, 2, 3, 4, 5, 6, 7); } } while (0)
#define PG8_LDB(dst, b, h) do { _Pragma("unroll") for (int n = 0; n < 2; ++n) { const v4i_t lo_ = *(const PG8_LAS v4i_t*)(lds + PG8_SB(b, h) + boff + n * 2048), hi_ = *(const PG8_LAS v4i_t*)(lds + PG8_SB(b, h) + boff + n * 2048 + 1024); dst[n] = __builtin_shufflevector(lo_, hi_, 0, 1, 2, 3, 4, 5, 6, 7); } } while (0)
#define PG8_MMA(ai, bj, At, Bt) do { __builtin_amdgcn_s_setprio(1); \
        if constexpr (F8) { asm volatile("s_nop 1\n\t" \
            "v_mfma_scale_f32_16x16x128_f8f6f4 %0, %12, %8, %0, %14, %14 op_sel_hi:[0,0,0]\n\t"  "v_mfma_scale_f32_16x16x128_f8f6f4 %1, %13, %8, %1, %14, %14 op_sel_hi:[0,0,0]\n\t" \
            "v_mfma_scale_f32_16x16x128_f8f6f4 %2, %12, %9, %2, %14, %14 op_sel_hi:[0,0,0]\n\t"  "v_mfma_scale_f32_16x16x128_f8f6f4 %3, %13, %9, %3, %14, %14 op_sel_hi:[0,0,0]\n\t" \
            "v_mfma_scale_f32_16x16x128_f8f6f4 %4, %12, %10, %4, %14, %14 op_sel_hi:[0,0,0]\n\t" "v_mfma_scale_f32_16x16x128_f8f6f4 %5, %13, %10, %5, %14, %14 op_sel_hi:[0,0,0]\n\t" \
            "v_mfma_scale_f32_16x16x128_f8f6f4 %6, %12, %11, %6, %14, %14 op_sel_hi:[0,0,0]\n\t" "v_mfma_scale_f32_16x16x128_f8f6f4 %7, %13, %11, %7, %14, %14 op_sel_hi:[0,0,0]" \
            : "+v"(acc[ai][bj][0][0]), "+v"(acc[ai][bj][0][1]), "+v"(acc[ai][bj][1][0]), "+v"(acc[ai][bj][1][1]), "+v"(acc[ai][bj][2][0]), "+v"(acc[ai][bj][2][1]), "+v"(acc[ai][bj][3][0]), "+v"(acc[ai][bj][3][1]) \
            : "v"(At[0]), "v"(At[1]), "v"(At[2]), "v"(At[3]), "v"(Bt[0]), "v"(Bt[1]), "v"(one_scale)); } \
        else { _Pragma("unroll") for (int m = 0; m < 4; ++m) _Pragma("unroll") for (int n = 0; n < 2; ++n) { \
            acc[ai][bj][m][n] = __builtin_amdgcn_mfma_f32_16x16x32_bf16(__builtin_bit_cast(bf16x8, __builtin_shufflevector(Bt[n], Bt[n], 0, 1, 2, 3)), __builtin_bit_cast(bf16x8, __builtin_shufflevector(At[m], At[m], 0, 1, 2, 3)), acc[ai][bj][m][n], 0, 0, 0); \
            acc[ai][bj][m][n] = __builtin_amdgcn_mfma_f32_16x16x32_bf16(__builtin_bit_cast(bf16x8, __builtin_shufflevector(Bt[n], Bt[n], 4, 5, 6, 7)), __builtin_bit_cast(bf16x8, __builtin_shufflevector(At[m], At[m], 4, 5, 6, 7)), acc[ai][bj][m][n], 0, 0, 0); } } \
        __builtin_amdgcn_s_setprio(0); } while (0)
#define PG8_MFMA_DRAIN() do { if constexpr (F8) asm volatile("s_nop 15\n\ts_nop 15\n\ts_nop 15" ::: "memory"); } while (0)
#define PG8_WAIT_V(n) asm volatile("s_waitcnt vmcnt(" #n ")" ::: "memory")
#define PG8_WAIT_L(n) asm volatile("s_waitcnt lgkmcnt(" #n ")" ::: "memory")
#define PG8_BAR __builtin_amdgcn_s_barrier()
#define PG8_SCHED __builtin_amdgcn_sched_barrier(0)
    Unit cur, nxt; int ui = 0;
    if (!S.next(0, cur)) return;
    f32x4 acc[2][2][4][2];
#pragma unroll
    for (int a = 0; a < 2; ++a)
#pragma unroll
        for (int b = 0; b < 2; ++b)
#pragma unroll
            for (int m = 0; m < 4; ++m)
#pragma unroll
                for (int n = 0; n < 2; ++n) acc[a][b][m][n] = (f32x4){0.f, 0.f, 0.f, 0.f};
    const int one_scale = 0x7f7f7f7f;
    v8i_t At[4], B0[2], B1[2];
    const char* cA = (const char*)g.A + (size_t)cur.pm * tstep; const char* cB = (const char*)g.Bt + (size_t)cur.pn * tstep;
    S.a_ready(cur);
    if constexpr (SP2) {
        PG8_STAGE(PG8_SB(0, 0), cB, voffB); PG8_STAGE(PG8_SB(0, 1), cB + hstep, voffB); PG8_STAGE(PG8_SA(0, 0), cA, voffA); PG8_STAGE(PG8_SA(0, 1), cA + hstep, voffA);
        if (wr == 1) PG8_BAR;
        PG8_WAIT_V(2); PG8_BAR;
        PG8_STAGE(PG8_SB(1, 0), cB + kstep, voffB); PG8_STAGE(PG8_SA(1, 0), cA + kstep, voffA); PG8_STAGE(PG8_SB(1, 1), cB + hstep + kstep, voffB);
        PG8_WAIT_V(6); PG8_BAR;
    } else {
        PG8_STAGE(PG8_SB(0, 0), cB, voffB); PG8_STAGE(PG8_SA(0, 0), cA, voffA); PG8_STAGE(PG8_SB(0, 1), cB + hstep, voffB); PG8_STAGE(PG8_SA(0, 1), cA + hstep, voffA);
        if (wr == 1) PG8_BAR;
        PG8_WAIT_V(4); PG8_BAR;
        PG8_STAGE(PG8_SB(1, 0), cB + kstep, voffB); PG8_STAGE(PG8_SA(1, 0), cA + kstep, voffA); PG8_STAGE(PG8_SB(1, 1), cB + hstep + kstep, voffB);
        PG8_WAIT_V(6); PG8_BAR;
    }
    for (;;) {
        const bool has_next = S.next(ui + 1, nxt);
        const char* nA = has_next ? (const char*)g.A + (size_t)nxt.pm * tstep : cA; const char* nB = has_next ? (const char*)g.Bt + (size_t)nxt.pn * tstep : cB;
        for (int t = 0; t < nt; t += 2) {
            const bool last = (t == nt - 2);
            const char* a1 = cA + (size_t)(t + 1) * kstep;
            const char* a2 = last ? nA : cA + (size_t)(t + 2) * kstep; const char* b2 = last ? nB : cB + (size_t)(t + 2) * kstep;
            const char* a3 = a2 + kstep; const char* b3 = b2 + kstep;
            if (last && has_next) S.a_ready(nxt);
            if constexpr (SP2) {
            PG8_LDB(B0, 0, 0); PG8_LDB(B1, 0, 1); PG8_SCHED; PG8_LDA(At, 0, 0); PG8_STAGE(PG8_SA(1, 1), a1 + hstep, voffA);
            PG8_WAIT_V(8); PG8_WAIT_L(0); PG8_BAR; PG8_MMA(0, 0, At, B0); PG8_MMA(0, 1, At, B1); PG8_BAR; PG8_SCHED;
            PG8_LDA(At, 0, 1); PG8_STAGE(PG8_SB(0, 0), b2, voffB); PG8_STAGE(PG8_SB(0, 1), b2 + hstep, voffB); PG8_STAGE(PG8_SA(0, 0), a2, voffA);
            PG8_WAIT_V(8); PG8_WAIT_L(0); PG8_BAR; PG8_MMA(1, 0, At, B0); PG8_MMA(1, 1, At, B1); PG8_BAR; PG8_SCHED;
            PG8_LDB(B0, 1, 0); PG8_LDB(B1, 1, 1); PG8_SCHED; PG8_LDA(At, 1, 0); PG8_STAGE(PG8_SA(0, 1), a2 + hstep, voffA);
            PG8_WAIT_V(8); PG8_WAIT_L(0); PG8_BAR; PG8_MMA(0, 0, At, B0); PG8_MMA(0, 1, At, B1); PG8_BAR; PG8_SCHED;
            PG8_LDA(At, 1, 1); PG8_STAGE(PG8_SB(1, 0), b3, voffB); PG8_STAGE(PG8_SB(1, 1), b3 + hstep, voffB); PG8_STAGE(PG8_SA(1, 0), a3, voffA);
            PG8_WAIT_V(8); PG8_WAIT_L(0); PG8_BAR; PG8_MMA(1, 0, At, B0); PG8_MMA(1, 1, At, B1); PG8_BAR; PG8_SCHED;
            } else {
            PG8_LDB(B0, 0, 0); PG8_SCHED; PG8_LDA(At, 0, 0); PG8_STAGE(PG8_SA(1, 1), a1 + hstep, voffA);
            PG8_WAIT_L(8); PG8_BAR; PG8_WAIT_L(0); PG8_MMA(0, 0, At, B0); PG8_BAR; PG8_SCHED;
            PG8_LDB(B1, 0, 1); PG8_STAGE(PG8_SB(0, 0), b2, voffB);
            PG8_BAR; PG8_WAIT_L(0); PG8_MMA(0, 1, At, B1); PG8_BAR;
            PG8_LDA(At, 0, 1); PG8_STAGE(PG8_SA(0, 0), a2, voffA);
            PG8_BAR; PG8_WAIT_L(0); PG8_MMA(1, 0, At, B0); PG8_BAR; PG8_SCHED;
            PG8_STAGE(PG8_SB(0, 1), b2 + hstep, voffB);
            PG8_WAIT_V(6); PG8_BAR; PG8_MMA(1, 1, At, B1); PG8_BAR;
            PG8_LDB(B0, 1, 0); PG8_SCHED; PG8_LDA(At, 1, 0); PG8_STAGE(PG8_SA(0, 1), a2 + hstep, voffA);
            PG8_WAIT_L(8); PG8_BAR; PG8_WAIT_L(0); PG8_MMA(0, 0, At, B0); PG8_BAR; PG8_SCHED;
            PG8_LDB(B1, 1, 1); PG8_STAGE(PG8_SB(1, 0), b3, voffB);
            PG8_BAR; PG8_WAIT_L(0); PG8_MMA(0, 1, At, B1); PG8_BAR;
            PG8_LDA(At, 1, 1); PG8_STAGE(PG8_SA(1, 0), a3, voffA);
            PG8_BAR; PG8_WAIT_L(0); PG8_MMA(1, 0, At, B0); PG8_BAR; PG8_SCHED;
            PG8_STAGE(PG8_SB(1, 1), b3 + hstep, voffB);
            PG8_WAIT_V(6); PG8_BAR; PG8_MMA(1, 1, At, B1); PG8_BAR;
            }
        }
        if constexpr (ALIGN_EPI) { if (wr == 0) PG8_BAR; }
        PG8_MFMA_DRAIN();
        if constexpr (!Epi::AFTER_DRAIN) { E(acc, cur, wr, wc, fr, fq); S.done(cur); }
        if (!has_next) break;
#pragma unroll
        for (int a = 0; a < 2; ++a)
#pragma unroll
            for (int b = 0; b < 2; ++b)
#pragma unroll
                for (int m = 0; m < 4; ++m)
#pragma unroll
                    for (int n = 0; n < 2; ++n) acc[a][b][m][n] = (f32x4){0.f, 0.f, 0.f, 0.f};
        cur = nxt; cA = nA; cB = nB; ++ui;
        if constexpr (ALIGN_EPI) { if (wr == 1) PG8_BAR; }
    }
    PG8_WAIT_V(0);
    if constexpr (!ALIGN_EPI) { if (wr == 0) PG8_BAR; }
    PG8_BAR;
    if constexpr (Epi::AFTER_DRAIN) { E.fused(acc, cur, wr, wc, fr, fq, lds, wid, lane); S.done(cur); }
#undef PG8_SA
#undef PG8_SB
#undef PG8_STAGE
#undef PG8_LDA
#undef PG8_LDB
#undef PG8_MMA
#undef PG8_MFMA_DRAIN
#undef PG8_WAIT_V
#undef PG8_WAIT_L
#undef PG8_BAR
#undef PG8_SCHED
}
}

#ifndef FAST_GEMM
#define FAST_GEMM 1
#endif
template <bool F8 = false, class E8>
__device__ __forceinline__ void gemm_any(const void* A, const void* Bt, int M, int N, int K, const E8& E, float* lds, int bid, int nb) {
#if FAST_GEMM
  pg8::Gemm g{(const bf16_t*)A, (const bf16_t*)Bt, M, N, F8 ? K / 2 : K}; pg8::StaticOrder S; S.init(M, N, nb, bid);
  pg8::EpiA<E8> EA{E};
  pg8::gemm_phase<pg8::EpiA<E8>, pg8::StaticOrder, true, true, F8>((PG8_LAS unsigned char*)lds, g, S, EA);
#else
  gemm_naive((const bf16_t*)A, (const bf16_t*)Bt, M, N, K, E, lds, bid, nb);
#endif
}

__device__ void gla_naive(const Params& p, const WS& w, int b, int h, float* lds) {
  constexpr int CH = 16;
  const int tid = tidx(), dv = tid & 255, half = tid >> 8, wave = tid >> 6, lane = tid & 63;
  float* qf = lds; float* kf = qf + CH * 128; float* af = kf + CH * 128; float* vf = af + CH * 128; float* op = vf + CH * 256;
  float S[64];
#pragma unroll
  for (int i = 0; i < 64; ++i) S[i] = 0.f;
  const int gd = tid & 127;
  float gu[16];
#pragma unroll
  for (int r = 0; r < 16; ++r) gu[r] = p.gate_up[r * 512 + h * 128 + gd];
  const float gb = p.gate_bias[h * 128 + gd];
  const float qscale = 0.08838834764831845f;
  for (int t0 = 0; t0 < SEQ; t0 += CH) {
    const size_t tb = (size_t)b * SEQ + t0;
    { const int tok = tid >> 5, d4 = (tid & 31) * 4;
      const uint2 qv = *(const uint2*)(w.proj + (tb + tok) * NPROJ + C_GQ + h * 128 + d4);
      const uint2 kv = *(const uint2*)(w.proj + (tb + tok) * NPROJ + C_GK + h * 128 + d4);
      *(float4*)(qf + tok * 128 + d4) = make_float4(lo_f(qv.x) * qscale, hi_f(qv.x) * qscale, lo_f(qv.y) * qscale, hi_f(qv.y) * qscale);
      *(float4*)(kf + tok * 128 + d4) = make_float4(lo_f(kv.x), hi_f(kv.x), lo_f(kv.y), hi_f(kv.y)); }
    { const int dvv = tid & 255, tk8 = (tid >> 8) * 8; float f[8];
      unpack8(*(const uint4*)(w.vT + (size_t)(h * 256 + dvv) * T + tb + tk8), f);
#pragma unroll
      for (int j = 0; j < 8; ++j) vf[(tk8 + j) * 256 + dvv] = f[j]; }
#pragma unroll
    for (int i = 0; i < 4; ++i) { const int tok = (tid >> 7) * 4 + i; float z = gb; float gl[16];
      unpack8(*(const uint4*)(w.proj + (tb + tok) * NPROJ + C_SM), gl); unpack8(*(const uint4*)(w.proj + (tb + tok) * NPROJ + C_SM + 8), gl + 8);
#pragma unroll
      for (int r = 0; r < 16; ++r) z += gl[r] * gu[r];
      af[tok * 128 + gd] = __expf(logsigmoidf_(z) * (1.f / 16.f)); }
    __syncthreads();
    for (int tok = 0; tok < CH; ++tok) {
      const float vv = vf[tok * 256 + dv]; float acc = 0.f;
#pragma unroll
      for (int i4 = 0; i4 < 16; ++i4) {
        const float4 a = *(const float4*)(af + tok * 128 + half * 64 + i4 * 4), k = *(const float4*)(kf + tok * 128 + half * 64 + i4 * 4), q = *(const float4*)(qf + tok * 128 + half * 64 + i4 * 4);
        S[i4 * 4 + 0] = a.x * S[i4 * 4 + 0] + k.x * vv; acc += q.x * S[i4 * 4 + 0];
        S[i4 * 4 + 1] = a.y * S[i4 * 4 + 1] + k.y * vv; acc += q.y * S[i4 * 4 + 1];
        S[i4 * 4 + 2] = a.z * S[i4 * 4 + 2] + k.z * vv; acc += q.z * S[i4 * 4 + 2];
        S[i4 * 4 + 3] = a.w * S[i4 * 4 + 3] + k.w * vv; acc += q.w * S[i4 * 4 + 3];
      }
      op[(half * CH + tok) * 256 + dv] = acc;
    }
    __syncthreads();
#pragma unroll
    for (int i = 0; i < 2; ++i) { const int tok = wave * 2 + i;
      const float4 o0 = *(const float4*)(op + tok * 256 + lane * 4), o1 = *(const float4*)(op + (CH + tok) * 256 + lane * 4);
      const float o[4] = {o0.x + o1.x, o0.y + o1.y, o0.z + o1.z, o0.w + o1.w};
      float ss = wave_sum(o[0] * o[0] + o[1] * o[1] + o[2] * o[2] + o[3] * o[3]);
      const float rs = rsqrtf(ss * (1.f / 256.f) + EPS);
      const uint2 gg = *(const uint2*)(w.proj + (tb + tok) * NPROJ + C_GG + h * 256 + lane * 4);
      const float4 gn = *(const float4*)(p.gla_norm + h * 256 + lane * 4);
      const float y0 = o[0] * rs * gn.x * siluf_(lo_f(gg.x)), y1 = o[1] * rs * gn.y * siluf_(hi_f(gg.x)), y2 = o[2] * rs * gn.z * siluf_(lo_f(gg.y)), y3 = o[3] * rs * gn.w * siluf_(hi_f(gg.y));
      *(uint2*)(w.y + (tb + tok) * D + h * 256 + lane * 4) = make_uint2(pack2(y0, y1), pack2(y2, y3)); }
    __syncthreads();
  }
}
__device__ void mlstm_naive(const Params& p, const WS& w, int b, int h, float* lds) {
  constexpr int CH = 16;
  const int tid = tidx(), dv = tid & 255, half = tid >> 8, wave = tid >> 6, lane = tid & 63;
  float* qf = lds; float* kf = qf + CH * 128; float* vf = kf + CH * 128; float* op = vf + CH * 256; float* dn = op + 2 * CH * 256; float* gt = dn + 2 * CH * 256;
  float C[64], n[4];
#pragma unroll
  for (int i = 0; i < 64; ++i) C[i] = 0.f;
#pragma unroll
  for (int i = 0; i < 4; ++i) n[i] = 0.f;
  const int nd = half * 64 + (dv & 15) * 4;
  const float kscale = 0.08838834764831845f;
  const float ib = p.ig_bias[h], fb = p.fg_bias[h];
  for (int t0 = 0; t0 < SEQ; t0 += CH) {
    const size_t tb = (size_t)b * SEQ + t0;
    { const int tok = tid >> 5, d4 = (tid & 31) * 4;
      float qa[4], ka[4];
#pragma unroll
      for (int c = 0; c < 4; ++c) { qa[c] = p.conv_b[h * 128 + d4 + c]; ka[c] = p.conv_b[512 + h * 128 + d4 + c]; }
#pragma unroll
      for (int wi = 0; wi < 4; ++wi) { const int ts = t0 + tok - 3 + wi;
        if (ts >= 0) { const size_t tr = (size_t)b * SEQ + ts;
          const uint2 qv = *(const uint2*)(w.proj + tr * NPROJ + C_MQ + h * 128 + d4), kv = *(const uint2*)(w.proj + tr * NPROJ + C_MK + h * 128 + d4);
          const float4 cq = *(const float4*)(p.conv_w + wi * 1024 + h * 128 + d4), ck = *(const float4*)(p.conv_w + wi * 1024 + 512 + h * 128 + d4);
          qa[0] += cq.x * lo_f(qv.x); qa[1] += cq.y * hi_f(qv.x); qa[2] += cq.z * lo_f(qv.y); qa[3] += cq.w * hi_f(qv.y);
          ka[0] += ck.x * lo_f(kv.x); ka[1] += ck.y * hi_f(kv.x); ka[2] += ck.z * lo_f(kv.y); ka[3] += ck.w * hi_f(kv.y); } }
      *(float4*)(qf + tok * 128 + d4) = make_float4(siluf_(qa[0]), siluf_(qa[1]), siluf_(qa[2]), siluf_(qa[3]));
      *(float4*)(kf + tok * 128 + d4) = make_float4(siluf_(ka[0]) * kscale, siluf_(ka[1]) * kscale, siluf_(ka[2]) * kscale, siluf_(ka[3]) * kscale); }
    { const int dvv = tid & 255, tk8 = (tid >> 8) * 8; float f[8];
      unpack8(*(const uint4*)(w.vT + (size_t)(1024 + h * 256 + dvv) * T + tb + tk8), f);
#pragma unroll
      for (int j = 0; j < 8; ++j) vf[(tk8 + j) * 256 + dvv] = f[j]; }
    if (tid < CH) { const float mi = bf2f(w.proj[(tb + tid) * NPROJ + C_SM + 16 + h]), mf = bf2f(w.proj[(tb + tid) * NPROJ + C_SM + 20 + h]);
      gt[tid * 2] = __expf(mi + ib); gt[tid * 2 + 1] = sigmoidf_(mf + fb); }
    __syncthreads();
    for (int tok = 0; tok < CH; ++tok) {
      const float vv = vf[tok * 256 + dv], ig = gt[tok * 2], fg = gt[tok * 2 + 1]; float num = 0.f, den = 0.f;
#pragma unroll
      for (int i4 = 0; i4 < 16; ++i4) {
        const float4 k = *(const float4*)(kf + tok * 128 + half * 64 + i4 * 4), q = *(const float4*)(qf + tok * 128 + half * 64 + i4 * 4);
        const float kk[4] = {k.x * ig, k.y * ig, k.z * ig, k.w * ig}; const float qq[4] = {q.x, q.y, q.z, q.w};
#pragma unroll
        for (int c = 0; c < 4; ++c) { C[i4 * 4 + c] = fg * C[i4 * 4 + c] + kk[c] * vv; num += qq[c] * C[i4 * 4 + c]; }
      }
      { const float4 k = *(const float4*)(kf + tok * 128 + nd), q = *(const float4*)(qf + tok * 128 + nd);
        n[0] = fg * n[0] + k.x * ig; n[1] = fg * n[1] + k.y * ig; n[2] = fg * n[2] + k.z * ig; n[3] = fg * n[3] + k.w * ig;
        den = q.x * n[0] + q.y * n[1] + q.z * n[2] + q.w * n[3];
        den = gsum<16>(den); }
      op[(half * CH + tok) * 256 + dv] = num; if (dv == 0) dn[half * CH + tok] = den;
    }
    __syncthreads();
#pragma unroll
    for (int i = 0; i < 2; ++i) { const int tok = wave * 2 + i;
      const float4 o0 = *(const float4*)(op + tok * 256 + lane * 4), o1 = *(const float4*)(op + (CH + tok) * 256 + lane * 4);
      const float den = dn[tok] + dn[CH + tok];
      const float inv = 1.f / fmaxf(fabsf(den), 1.f);
      const float o[4] = {(o0.x + o1.x) * inv, (o0.y + o1.y) * inv, (o0.z + o1.z) * inv, (o0.w + o1.w) * inv};
      float ss = wave_sum(o[0] * o[0] + o[1] * o[1] + o[2] * o[2] + o[3] * o[3]);
      const float rs = rsqrtf(ss * (1.f / 256.f) + EPS);
      const uint2 mo = *(const uint2*)(w.proj + (tb + tok) * NPROJ + C_MO + h * 256 + lane * 4);
      const float4 gn = *(const float4*)(p.mlstm_norm + h * 256 + lane * 4);
      const float y0 = o[0] * rs * gn.x * sigmoidf_(lo_f(mo.x)), y1 = o[1] * rs * gn.y * sigmoidf_(hi_f(mo.x)), y2 = o[2] * rs * gn.z * sigmoidf_(lo_f(mo.y)), y3 = o[3] * rs * gn.w * sigmoidf_(hi_f(mo.y));
      *(uint2*)(w.y + (tb + tok) * D + 1024 + h * 256 + lane * 4) = make_uint2(pack2(y0, y1), pack2(y2, y3)); }
    __syncthreads();
  }
}
__device__ void phase_mixer_naive(const Params& p, const WS& w, float* lds, int bid, int nb) {
  for (int item = bid; item < 16; item += nb) {
    if (item < 8) gla_naive(p, w, item >> 2, item & 3, lds); else mlstm_naive(p, w, (item - 8) >> 2, item & 3, lds);
    __syncthreads();
  }
}


typedef short bf16x8 __attribute__((ext_vector_type(8)));
typedef float f32x4 __attribute__((ext_vector_type(4)));
#define MFMA16(a, b, c) __builtin_amdgcn_mfma_f32_16x16x32_bf16(a, b, c, 0, 0, 0)
constexpr int L_GLR = 0, L_TOT = 4096, L_F = 6144, L_DEN = 6656, L_PART = 6912, L_QS = 9216, L_KS = 26624, L_P = 44032, L_NL = 53248, L_KDT = 9216;
constexpr int QS_LD = 136, P_LD = 72, KDT_LD = 72;

__device__ __forceinline__ void gla_gates(const Params& p, const WS& w, int h, size_t tb, unsigned char* ldsb, int tid, float* bv, float& blast) {
  float* glrs = (float*)(ldsb + L_GLR); float* tot = (float*)(ldsb + L_TOT);
  const int d = tid & 127, tg = tid >> 7;
  if (tid < 128) { float f[8]; unpack8(*(const uint4*)(w.proj + (tb + (tid >> 1)) * NPROJ + C_SM + (tid & 1) * 8), f);
#pragma unroll
    for (int j = 0; j < 8; ++j) glrs[(tid >> 1) * 16 + (tid & 1) * 8 + j] = f[j]; }
  float gu[16];
#pragma unroll
  for (int r = 0; r < 16; ++r) gu[r] = p.gate_up[r * 512 + h * 128 + d];
  const float gb = p.gate_bias[h * 128 + d];
  __syncthreads();
  float run = 0.f;
#pragma unroll
  for (int i = 0; i < 16; ++i) { const float* gl = glrs + (tg * 16 + i) * 16; float z = gb;
#pragma unroll
    for (int r4 = 0; r4 < 4; ++r4) { const float4 g4 = *(const float4*)(gl + r4 * 4); z += g4.x * gu[r4 * 4] + g4.y * gu[r4 * 4 + 1] + g4.z * gu[r4 * 4 + 2] + g4.w * gu[r4 * 4 + 3]; }
    run += logsigmoidf_(z) * (1.f / 16.f); bv[i] = run; }
  tot[tg * 128 + d] = run;
  __syncthreads();
  float off = 0.f; blast = 0.f;
#pragma unroll
  for (int g = 0; g < 4; ++g) { const float t = tot[g * 128 + d]; blast += t; if (g < tg) off += t; }
#pragma unroll
  for (int i = 0; i < 16; ++i) bv[i] += off;
}
__device__ __forceinline__ void mlstm_gates(const Params& p, const WS& w, int h, size_t tb, unsigned char* ldsb, int tid) {
  float* Fl = (float*)(ldsb + L_F);
  if (tid < 64) { const float mi = bf2f(w.proj[(tb + tid) * NPROJ + C_SM + 16 + h]), mf = bf2f(w.proj[(tb + tid) * NPROJ + C_SM + 20 + h]);
    float f = logsigmoidf_(mf + p.fg_bias[h]);
#pragma unroll
    for (int o = 1; o < 64; o <<= 1) { const float t = bperm(f, tid - o); if (tid >= o) f += t; }
    Fl[tid] = f; Fl[64 + tid] = mi + p.ig_bias[h]; }
  __syncthreads();
}
__device__ __forceinline__ void conv_load(const WS& w, int col, int b, int c, int tg, bf16_t* win) {
  const int s0 = c * 64 + tg * 16 - 3;
#pragma unroll
  for (int m = 0; m < 19; ++m) { const int sp = s0 + m; win[m] = (sp >= 0) ? w.proj[((size_t)b * SEQ + sp) * NPROJ + col] : (bf16_t)0; }
}
__device__ __forceinline__ void conv_apply(const Params& p, const bf16_t* win, int cch, float scale, float* out) {
  const float c0 = p.conv_w[cch], c1 = p.conv_w[1024 + cch], c2 = p.conv_w[2048 + cch], c3 = p.conv_w[3072 + cch], cb = p.conv_b[cch];
#pragma unroll
  for (int i = 0; i < 16; ++i) out[i] = siluf_(cb + c0 * bf2f(win[i]) + c1 * bf2f(win[i + 1]) + c2 * bf2f(win[i + 2]) + c3 * bf2f(win[i + 3])) * scale;
}

template <int KIND>
__device__ void mix_local(const Params& p, const WS& w, int b, int h, int c, int item, unsigned char* ldsb) {
  const int tid = tidx(), lane = tid & 63, wave = tid >> 6, fr = lane & 15, fq = lane >> 4, d = tid & 127, tg = tid >> 7;
  const size_t tb = (size_t)b * SEQ + (size_t)c * 64;
  float* tot = (float*)(ldsb + L_TOT); const float* Fl = (const float*)(ldsb + L_F);
  bf16_t* kdT = (bf16_t*)(ldsb + L_KDT);
  const bf16_t* vrow = w.vT + (size_t)(KIND * 1024 + h * 256 + wave * 32 + fr) * T + tb + fq * 8;
  bf16x8 yv[2][2];
#pragma unroll
  for (int ks = 0; ks < 2; ++ks) { yv[ks][0] = *(const bf16x8*)(vrow + ks * 32); yv[ks][1] = *(const bf16x8*)(vrow + (size_t)16 * T + ks * 32); }
  bf16_t kraw[19];
  if (KIND == 0) {
#pragma unroll
    for (int i = 0; i < 16; ++i) kraw[i] = w.proj[(tb + tg * 16 + i) * NPROJ + C_GK + h * 128 + d];
  } else conv_load(w, C_MK + h * 128 + d, b, c, tg, kraw);
  float wgt[16], kv[16];
  if (KIND == 0) {
    float bv[16], blast; gla_gates(p, w, h, tb, ldsb, tid, bv, blast);
#pragma unroll
    for (int i = 0; i < 16; ++i) { wgt[i] = __expf(blast - bv[i]); kv[i] = bf2f(kraw[i]); }
    if (tg == 0) w.gdec[(size_t)item * 128 + d] = __expf(blast);
  } else {
    mlstm_gates(p, w, h, tb, ldsb, tid);
    const float flast = Fl[63];
#pragma unroll
    for (int i = 0; i < 16; ++i) wgt[i] = __expf(flast - Fl[tg * 16 + i] + Fl[64 + tg * 16 + i]);
    conv_apply(p, kraw, 512 + h * 128 + d, 0.08838834764831845f, kv);
    if (tid == 0) w.mdec[item - 2048] = __expf(flast);
  }
  float un = 0.f; float kd[16];
#pragma unroll
  for (int i = 0; i < 16; ++i) { kd[i] = kv[i] * wgt[i]; un += kd[i]; }
  *(uint4*)(kdT + d * KDT_LD + tg * 16) = pack8(kd); *(uint4*)(kdT + d * KDT_LD + tg * 16 + 8) = pack8(kd + 8);
  if (KIND == 1) tot[tg * 128 + d] = un;
  __syncthreads();
  if (KIND == 1 && tg == 0) w.mn[(size_t)(item - 2048) * 128 + d] = tot[d] + tot[128 + d] + tot[256 + d] + tot[384 + d];
  f32x4 acc[2][8];
#pragma unroll
  for (int yt = 0; yt < 2; ++yt)
#pragma unroll
    for (int xt = 0; xt < 8; ++xt) acc[yt][xt] = (f32x4){0.f, 0.f, 0.f, 0.f};
#pragma unroll
  for (int ks = 0; ks < 2; ++ks) {
#pragma unroll
    for (int xt = 0; xt < 8; ++xt) { const bf16x8 xk = *(const bf16x8*)(kdT + (xt * 16 + fr) * KDT_LD + ks * 32 + fq * 8);
      acc[0][xt] = MFMA16(xk, yv[ks][0], acc[0][xt]); acc[1][xt] = MFMA16(xk, yv[ks][1], acc[1][xt]); }
  }
  bf16_t* S = (bf16_t*)p.out + (size_t)item * 32768;
#pragma unroll
  for (int yt = 0; yt < 2; ++yt)
#pragma unroll
    for (int xt = 0; xt < 8; ++xt) *(uint2*)(S + (wave * 32 + yt * 16 + fr) * 128 + xt * 16 + 4 * fq) = make_uint2(pack2(acc[yt][xt][0], acc[yt][xt][1]), pack2(acc[yt][xt][2], acc[yt][xt][3]));
  __syncthreads();
}

__device__ void mix_scan(const Params& p, const WS& w, float* lds, int bid, int nb) {
  bf16_t* sbuf = (bf16_t*)p.out;
  const int tid = tidx();
  for (int g0 = bid * 512; g0 < 16 * 8192; g0 += nb * 512) {
    const int g = g0 + tid, combo = g0 >> 13, e = (g & 8191) * 4, dk = e & 127;
    __syncthreads();
    if (combo < 8) { const float4* src = (const float4*)(w.gdec + (size_t)combo * 32768);
#pragma unroll
      for (int i = 0; i < 16; ++i) ((float4*)lds)[i * 512 + tid] = src[i * 512 + tid]; }
    else if (tid < 256) lds[tid] = w.mdec[(combo - 8) * 256 + tid];
    __syncthreads();
    bf16_t* base = sbuf + (size_t)combo * 256 * 32768 + e;
    float S0 = 0.f, S1 = 0.f, S2 = 0.f, S3 = 0.f;
    for (int c0 = 0; c0 < 256; c0 += 16) {
      uint2 u[16];
#pragma unroll
      for (int k = 0; k < 16; ++k) u[k] = *(const uint2*)(base + (size_t)(c0 + k) * 32768);
#pragma unroll
      for (int k = 0; k < 16; ++k) { float4 dc; if (combo < 8) dc = *(const float4*)(lds + (c0 + k) * 128 + dk); else { const float m = lds[c0 + k]; dc = make_float4(m, m, m, m); }
        *(uint2*)(base + (size_t)(c0 + k) * 32768) = make_uint2(pack2(S0, S1), pack2(S2, S3));
        S0 = dc.x * S0 + lo_f(u[k].x); S1 = dc.y * S1 + hi_f(u[k].x); S2 = dc.z * S2 + lo_f(u[k].y); S3 = dc.w * S3 + hi_f(u[k].y); }
    }
  }
  for (int g = bid * 512 + tid; g < 8 * 128; g += nb * 512) {
    const int cb = g >> 7, d = g & 127; float n = 0.f;
    for (int c = 0; c < 256; ++c) { float* q = w.mn + (size_t)(cb * 256 + c) * 128 + d; const float u = *q; *q = n; n = w.mdec[cb * 256 + c] * n + u; }
  }
}

template <int KIND>
__device__ void mix_out(const Params& p, const WS& w, int b, int h, int c, int item, unsigned char* ldsb) {
  const int tid = tidx(), lane = tid & 63, wave = tid >> 6, fr = lane & 15, fq = lane >> 4, d = tid & 127, tg = tid >> 7;
  const size_t tb = (size_t)b * SEQ + (size_t)c * 64;
  const float* Fl = (const float*)(ldsb + L_F); float* denl = (float*)(ldsb + L_DEN); float* part = (float*)(ldsb + L_PART); float* nl = (float*)(ldsb + L_NL);
  bf16_t* qs = (bf16_t*)(ldsb + L_QS); bf16_t* ks = (bf16_t*)(ldsb + L_KS); bf16_t* P = (bf16_t*)(ldsb + L_P);
  bf16x8 vx[2][2], sx[4][2];
  { const bf16_t* vrow = w.vT + (size_t)(KIND * 1024 + h * 256 + wave * 32 + fr) * T + tb + fq * 8;
#pragma unroll
    for (int k2 = 0; k2 < 2; ++k2) { vx[k2][0] = *(const bf16x8*)(vrow + k2 * 32); vx[k2][1] = *(const bf16x8*)(vrow + (size_t)16 * T + k2 * 32); }
    const bf16_t* srow = (const bf16_t*)p.out + (size_t)item * 32768 + (wave * 32 + fr) * 128 + fq * 8;
#pragma unroll
    for (int k4 = 0; k4 < 4; ++k4) { sx[k4][0] = *(const bf16x8*)(srow + k4 * 32); sx[k4][1] = *(const bf16x8*)(srow + 16 * 128 + k4 * 32); } }
  uint2 gt[4][2];
#pragma unroll
  for (int yt = 0; yt < 4; ++yt)
#pragma unroll
    for (int xt = 0; xt < 2; ++xt) gt[yt][xt] = *(const uint2*)(w.proj + (tb + yt * 16 + fr) * NPROJ + (KIND == 0 ? C_GG : C_MO) + h * 256 + wave * 32 + xt * 16 + 4 * fq);
  const float* gain = (KIND == 0 ? p.gla_norm : p.mlstm_norm) + h * 256;
  const float4 gn0 = *(const float4*)(gain + wave * 32 + 4 * fq), gn1 = *(const float4*)(gain + wave * 32 + 16 + 4 * fq);
  bf16_t qraw[19], kraw[19];
  if (KIND == 0) {
#pragma unroll
    for (int i = 0; i < 16; ++i) { qraw[i] = w.proj[(tb + tg * 16 + i) * NPROJ + C_GQ + h * 128 + d]; kraw[i] = w.proj[(tb + tg * 16 + i) * NPROJ + C_GK + h * 128 + d]; }
  } else { conv_load(w, C_MQ + h * 128 + d, b, c, tg, qraw); conv_load(w, C_MK + h * 128 + d, b, c, tg, kraw); }
  float nlv = 0.f;
  if (KIND == 1 && tid < 128) nlv = w.mn[(size_t)(item - 2048) * 128 + tid];
  {
    float qm[16], km[16], qv[16], kv[16];
    if (KIND == 0) {
      float bv[16], blast; gla_gates(p, w, h, tb, ldsb, tid, bv, blast);
#pragma unroll
      for (int i = 0; i < 16; ++i) { qm[i] = 0.08838834764831845f * __expf(bv[i]); km[i] = __expf(-bv[i]); qv[i] = bf2f(qraw[i]); kv[i] = bf2f(kraw[i]); }
    } else {
      mlstm_gates(p, w, h, tb, ldsb, tid);
#pragma unroll
      for (int i = 0; i < 16; ++i) { const float F = Fl[tg * 16 + i]; qm[i] = __expf(F); km[i] = __expf(Fl[64 + tg * 16 + i] - F); }
      conv_apply(p, qraw, h * 128 + d, 1.f, qv);
      conv_apply(p, kraw, 512 + h * 128 + d, 0.08838834764831845f, kv);
      if (tid < 128) nl[tid] = nlv;
    }
#pragma unroll
    for (int i = 0; i < 16; ++i) { qs[(tg * 16 + i) * QS_LD + d] = f2bf(qv[i] * qm[i]); ks[(tg * 16 + i) * QS_LD + d] = f2bf(kv[i] * km[i]); }
  }
  __syncthreads();
#pragma unroll
  for (int q = 0; q < 2; ++q) { const int tt = wave * 2 + q, jt = tt >> 2, it = tt & 3; f32x4 a = (f32x4){0.f, 0.f, 0.f, 0.f};
#pragma unroll
    for (int k4 = 0; k4 < 4; ++k4) { const bf16x8 xk = *(const bf16x8*)(ks + (jt * 16 + fr) * QS_LD + k4 * 32 + fq * 8), yq = *(const bf16x8*)(qs + (it * 16 + fr) * QS_LD + k4 * 32 + fq * 8); a = MFMA16(xk, yq, a); }
    const int i = it * 16 + fr, j0 = jt * 16 + 4 * fq;
    const float v0 = (j0 <= i) ? a[0] : 0.f, v1 = (j0 + 1 <= i) ? a[1] : 0.f, v2 = (j0 + 2 <= i) ? a[2] : 0.f, v3 = (j0 + 3 <= i) ? a[3] : 0.f;
    *(uint2*)(P + i * P_LD + j0) = make_uint2(pack2(v0, v1), pack2(v2, v3)); }
  __syncthreads();
  if (KIND == 1) { const int i = tid >> 3, pt = tid & 7; float f[8]; float s = 0.f;
    unpack8(*(const uint4*)(P + i * P_LD + pt * 8), f);
#pragma unroll
    for (int j = 0; j < 8; ++j) s += f[j];
#pragma unroll
    for (int hh = 0; hh < 2; ++hh) { unpack8(*(const uint4*)(qs + i * QS_LD + pt * 16 + hh * 8), f);
#pragma unroll
      for (int j = 0; j < 8; ++j) s += f[j] * nl[pt * 16 + hh * 8 + j]; }
    s = gsum<8>(s);
    if (pt == 0) denl[i] = s; }
  f32x4 acc[2][4];
#pragma unroll
  for (int xt = 0; xt < 2; ++xt)
#pragma unroll
    for (int yt = 0; yt < 4; ++yt) acc[xt][yt] = (f32x4){0.f, 0.f, 0.f, 0.f};
#pragma unroll
  for (int k2 = 0; k2 < 2; ++k2)
#pragma unroll
    for (int yt = 0; yt < 4; ++yt) { const bf16x8 yp = *(const bf16x8*)(P + (yt * 16 + fr) * P_LD + k2 * 32 + fq * 8); acc[0][yt] = MFMA16(vx[k2][0], yp, acc[0][yt]); acc[1][yt] = MFMA16(vx[k2][1], yp, acc[1][yt]); }
#pragma unroll
  for (int k4 = 0; k4 < 4; ++k4)
#pragma unroll
    for (int yt = 0; yt < 4; ++yt) { const bf16x8 yq = *(const bf16x8*)(qs + (yt * 16 + fr) * QS_LD + k4 * 32 + fq * 8); acc[0][yt] = MFMA16(sx[k4][0], yq, acc[0][yt]); acc[1][yt] = MFMA16(sx[k4][1], yq, acc[1][yt]); }
  if (KIND == 1) __syncthreads();
#pragma unroll
  for (int yt = 0; yt < 4; ++yt) { float s = 0.f;
    if (KIND == 1) { const float inv = 1.f / fmaxf(fabsf(denl[yt * 16 + fr]), 1.f); acc[0][yt] *= inv; acc[1][yt] *= inv; }
#pragma unroll
    for (int xt = 0; xt < 2; ++xt)
#pragma unroll
      for (int r = 0; r < 4; ++r) s += acc[xt][yt][r] * acc[xt][yt][r];
    s += sxor<16>(s); s += sxor<32>(s);
    if (fq == 0) part[wave * 64 + yt * 16 + fr] = s; }
  __syncthreads();
#pragma unroll
  for (int yt = 0; yt < 4; ++yt) { const int i = yt * 16 + fr; float t = 0.f;
#pragma unroll
    for (int ww = 0; ww < 8; ++ww) t += part[ww * 64 + i];
    const float rs = rsqrtf(t * (1.f / 256.f) + EPS);
#pragma unroll
    for (int xt = 0; xt < 2; ++xt) { const int dv = wave * 32 + xt * 16 + 4 * fq;
      const float4 gn = xt == 0 ? gn0 : gn1; const uint2 g2 = gt[yt][xt];
      const float g0 = lo_f(g2.x), g1 = hi_f(g2.x), g2f = lo_f(g2.y), g3 = hi_f(g2.y);
      const float a0 = KIND == 0 ? siluf_(g0) : sigmoidf_(g0), a1 = KIND == 0 ? siluf_(g1) : sigmoidf_(g1), a2 = KIND == 0 ? siluf_(g2f) : sigmoidf_(g2f), a3 = KIND == 0 ? siluf_(g3) : sigmoidf_(g3);
      const float y0 = acc[xt][yt][0] * rs * gn.x * a0, y1 = acc[xt][yt][1] * rs * gn.y * a1, y2 = acc[xt][yt][2] * rs * gn.z * a2, y3 = acc[xt][yt][3] * rs * gn.w * a3;
#if F8_OUT
      *(unsigned*)(w.yq + (tb + i) * D + KIND * 1024 + h * 256 + dv) = pack4_fp8(y0, y1, y2, y3);
#else
      *(uint2*)(w.y + (tb + i) * D + KIND * 1024 + h * 256 + dv) = make_uint2(pack2(y0, y1), pack2(y2, y3));
#endif
    } }
  __syncthreads();
}
template <int KIND>
__device__ void mix_out3(const Params& p, const WS& w, int b, int h, int c, int item, unsigned char* ldsb) {
  const int tid = tidx(), lane = tid & 63, wave = tid >> 6, fr = lane & 15, fq = lane >> 4, d = tid & 127, tg = tid >> 7;
  const size_t tb = (size_t)b * SEQ + (size_t)c * 64;
  const float* Fl = (const float*)(ldsb + L_F); float* denl = (float*)(ldsb + L_DEN); float* part = (float*)(ldsb + L_PART); float* nl = (float*)(ldsb + L_NL);
  bf16_t* qs = (bf16_t*)(ldsb + L_QS); bf16_t* ks = (bf16_t*)(ldsb + L_KS); bf16_t* P = (bf16_t*)(ldsb + L_P);
  bf16x8 vx[2][2], sx[4][2];
  { const bf16_t* vrow = w.vT + (size_t)(KIND * 1024 + h * 256 + wave * 32 + fr) * T + tb + fq * 8;
#pragma unroll
    for (int k2 = 0; k2 < 2; ++k2) { vx[k2][0] = *(const bf16x8*)(vrow + k2 * 32); vx[k2][1] = *(const bf16x8*)(vrow + (size_t)16 * T + k2 * 32); }
    const bf16_t* srow = (const bf16_t*)p.out + (size_t)item * 32768 + (wave * 32 + fr) * 128 + fq * 8;
#pragma unroll
    for (int k4 = 0; k4 < 4; ++k4) { sx[k4][0] = *(const bf16x8*)(srow + k4 * 32); sx[k4][1] = *(const bf16x8*)(srow + 16 * 128 + k4 * 32); } }
  uint2 gt[4][2];
#pragma unroll
  for (int yt = 0; yt < 4; ++yt)
#pragma unroll
    for (int xt = 0; xt < 2; ++xt) gt[yt][xt] = *(const uint2*)(w.proj + (tb + yt * 16 + fr) * NPROJ + (KIND == 0 ? C_GG : C_MO) + h * 256 + wave * 32 + xt * 16 + 4 * fq);
  const float* gain = (KIND == 0 ? p.gla_norm : p.mlstm_norm) + h * 256;
  const float4 gn0 = *(const float4*)(gain + wave * 32 + 4 * fq), gn1 = *(const float4*)(gain + wave * 32 + 16 + 4 * fq);
  { uint4 tq[2], tk[2];
    const bf16_t* gq = w.qs + tb * 1024 + KIND * 512 + h * 128; const bf16_t* gk = w.ks + tb * 1024 + KIND * 512 + h * 128;
#pragma unroll
    for (int ps = 0; ps < 2; ++ps) { const int pc = ps * 512 + tid, row = pc >> 4, c8 = (pc & 15) * 8; tq[ps] = *(const uint4*)(gq + (size_t)row * 1024 + c8); tk[ps] = *(const uint4*)(gk + (size_t)row * 1024 + c8); }
    float nlv = 0.f;
    if (KIND == 1 && tid < 128) nlv = w.mn[(size_t)(item - 2048) * 128 + tid];
#pragma unroll
    for (int ps = 0; ps < 2; ++ps) { const int pc = ps * 512 + tid, row = pc >> 4, c8 = (pc & 15) * 8; *(uint4*)(qs + row * QS_LD + c8) = tq[ps]; *(uint4*)(ks + row * QS_LD + c8) = tk[ps]; }
    if (KIND == 1 && tid < 128) nl[tid] = nlv; }
  __syncthreads();
#pragma unroll
  for (int q = 0; q < 2; ++q) { const int tt = wave * 2 + q, jt = tt >> 2, it = tt & 3; f32x4 a = (f32x4){0.f, 0.f, 0.f, 0.f};
#pragma unroll
    for (int k4 = 0; k4 < 4; ++k4) { const bf16x8 xk = *(const bf16x8*)(ks + (jt * 16 + fr) * QS_LD + k4 * 32 + fq * 8), yq = *(const bf16x8*)(qs + (it * 16 + fr) * QS_LD + k4 * 32 + fq * 8); a = MFMA16(xk, yq, a); }
    const int i = it * 16 + fr, j0 = jt * 16 + 4 * fq;
    const float v0 = (j0 <= i) ? a[0] : 0.f, v1 = (j0 + 1 <= i) ? a[1] : 0.f, v2 = (j0 + 2 <= i) ? a[2] : 0.f, v3 = (j0 + 3 <= i) ? a[3] : 0.f;
    *(uint2*)(P + i * P_LD + j0) = make_uint2(pack2(v0, v1), pack2(v2, v3)); }
  __syncthreads();
  if (KIND == 1) { const int i = tid >> 3, pt = tid & 7; float f[8]; float s = 0.f;
    unpack8(*(const uint4*)(P + i * P_LD + pt * 8), f);
#pragma unroll
    for (int j = 0; j < 8; ++j) s += f[j];
#pragma unroll
    for (int hh = 0; hh < 2; ++hh) { unpack8(*(const uint4*)(qs + i * QS_LD + pt * 16 + hh * 8), f);
#pragma unroll
      for (int j = 0; j < 8; ++j) s += f[j] * nl[pt * 16 + hh * 8 + j]; }
    s = gsum<8>(s);
    if (pt == 0) denl[i] = s; }
  f32x4 acc[2][4];
#pragma unroll
  for (int xt = 0; xt < 2; ++xt)
#pragma unroll
    for (int yt = 0; yt < 4; ++yt) acc[xt][yt] = (f32x4){0.f, 0.f, 0.f, 0.f};
#pragma unroll
  for (int k2 = 0; k2 < 2; ++k2)
#pragma unroll
    for (int yt = 0; yt < 4; ++yt) { const bf16x8 yp = *(const bf16x8*)(P + (yt * 16 + fr) * P_LD + k2 * 32 + fq * 8); acc[0][yt] = MFMA16(vx[k2][0], yp, acc[0][yt]); acc[1][yt] = MFMA16(vx[k2][1], yp, acc[1][yt]); }
#pragma unroll
  for (int k4 = 0; k4 < 4; ++k4)
#pragma unroll
    for (int yt = 0; yt < 4; ++yt) { const bf16x8 yq = *(const bf16x8*)(qs + (yt * 16 + fr) * QS_LD + k4 * 32 + fq * 8); acc[0][yt] = MFMA16(sx[k4][0], yq, acc[0][yt]); acc[1][yt] = MFMA16(sx[k4][1], yq, acc[1][yt]); }
  if (KIND == 1) __syncthreads();
#pragma unroll
  for (int yt = 0; yt < 4; ++yt) { float s = 0.f;
    if (KIND == 1) { const float inv = 1.f / fmaxf(fabsf(denl[yt * 16 + fr]), 1.f); acc[0][yt] *= inv; acc[1][yt] *= inv; }
#pragma unroll
    for (int xt = 0; xt < 2; ++xt)
#pragma unroll
      for (int r = 0; r < 4; ++r) s += acc[xt][yt][r] * acc[xt][yt][r];
    s += sxor<16>(s); s += sxor<32>(s);
    if (fq == 0) part[wave * 64 + yt * 16 + fr] = s; }
  __syncthreads();
#pragma unroll
  for (int yt = 0; yt < 4; ++yt) { const int i = yt * 16 + fr; float t = 0.f;
#pragma unroll
    for (int ww = 0; ww < 8; ++ww) t += part[ww * 64 + i];
    const float rs = rsqrtf(t * (1.f / 256.f) + EPS);
#pragma unroll
    for (int xt = 0; xt < 2; ++xt) { const int dv = wave * 32 + xt * 16 + 4 * fq;
      const float4 gn = xt == 0 ? gn0 : gn1; const uint2 g2 = gt[yt][xt];
      const float g0 = lo_f(g2.x), g1 = hi_f(g2.x), g2f = lo_f(g2.y), g3 = hi_f(g2.y);
      const float a0 = KIND == 0 ? siluf_(g0) : sigmoidf_(g0), a1 = KIND == 0 ? siluf_(g1) : sigmoidf_(g1), a2 = KIND == 0 ? siluf_(g2f) : sigmoidf_(g2f), a3 = KIND == 0 ? siluf_(g3) : sigmoidf_(g3);
      const float y0 = acc[xt][yt][0] * rs * gn.x * a0, y1 = acc[xt][yt][1] * rs * gn.y * a1, y2 = acc[xt][yt][2] * rs * gn.z * a2, y3 = acc[xt][yt][3] * rs * gn.w * a3;
#if F8_OUT
      *(unsigned*)(w.yq + (tb + i) * D + KIND * 1024 + h * 256 + dv) = pack4_fp8(y0, y1, y2, y3);
#else
      *(uint2*)(w.y + (tb + i) * D + KIND * 1024 + h * 256 + dv) = make_uint2(pack2(y0, y1), pack2(y2, y3));
#endif
    } }
  __syncthreads();
}
template <int WHICH>
__device__ void phase_mix_items(const Params& p, const WS& w, unsigned char* ldsb, int bid, int nb) {
  for (int item = bid; item < 4096; item += nb) {
    const int kind = item >> 11, b = (item >> 10) & 1, h = (item >> 8) & 3, c = item & 255;
    if (WHICH == 0) { if (kind == 0) mix_local<0>(p, w, b, h, c, item, ldsb); else mix_local<1>(p, w, b, h, c, item, ldsb); }
    else { if (kind == 0) mix_out<0>(p, w, b, h, c, item, ldsb); else mix_out<1>(p, w, b, h, c, item, ldsb); }
  }
}


__device__ void phase_mix_out3(const Params& p, const WS& w, unsigned char* ldsb, int bid, int nb) {
  for (int item = bid; item < 4096; item += nb) {
    const int kind = item >> 11, b = (item >> 10) & 1, h = (item >> 8) & 3, c = item & 255;
    if (kind == 0) mix_out3<0>(p, w, b, h, c, item, ldsb); else mix_out3<1>(p, w, b, h, c, item, ldsb);
  }
}

__device__ void mix_gate_pass(const Params& p, const WS& w, unsigned char* ldsb, int bid, int nb) {
  const int tid = tidx(), h = tid >> 7, d = tid & 127, lane = tid & 63;
  const bf16_t* qT = (const bf16_t*)ldsb; const bf16_t* kT = (const bf16_t*)(ldsb + 65536);
  float* glrs = (float*)(ldsb + 131072); float* Fl = (float*)(ldsb + 135168);
  for (int itx = bid; itx < 1024; itx += nb) {
    const int kind = itx >> 9, b = (itx >> 8) & 1, c = itx & 255;
    const size_t tb = (size_t)b * SEQ + (size_t)c * 64;
    const int item = ((kind * 2 + b) * 4 + h) * 256 + c;
    bf16_t* qo = w.qs + tb * 1024 + kind * 512 + tid; bf16_t* ko = w.ks + tb * 1024 + kind * 512 + tid;
    bf16_t* kdo = w.kdT + (size_t)(kind * 512 + tid) * T + tb;
    { uint4 tq[8], tk[8];
      const unsigned char* gq = (const unsigned char*)(w.proj + tb * NPROJ + (kind == 0 ? C_GQ : C_MQ)); const unsigned char* gk = (const unsigned char*)(w.proj + tb * NPROJ + (kind == 0 ? C_GK : C_MK));
#pragma unroll
      for (int ps = 0; ps < 8; ++ps) { const int o = ps * 8192 + tid * 16; tq[ps] = *(const uint4*)(gq + (size_t)(o >> 10) * (NPROJ * 2) + (o & 1023)); tk[ps] = *(const uint4*)(gk + (size_t)(o >> 10) * (NPROJ * 2) + (o & 1023)); }
#pragma unroll
      for (int ps = 0; ps < 8; ++ps) { const int o = ps * 8192 + tid * 16; *(uint4*)(ldsb + o) = tq[ps]; *(uint4*)(ldsb + 65536 + o) = tk[ps]; } }
    if (kind == 0) {
      if (tid < 128) { float f[8]; unpack8(*(const uint4*)(w.proj + (tb + (tid >> 1)) * NPROJ + C_SM + (tid & 1) * 8), f);
#pragma unroll
        for (int j = 0; j < 8; ++j) glrs[(tid >> 1) * 16 + (tid & 1) * 8 + j] = f[j]; }
      float gu[16];
#pragma unroll
      for (int r = 0; r < 16; ++r) gu[r] = p.gate_up[r * 512 + tid];
      const float gb = p.gate_bias[tid];
      __syncthreads();
      float run = 0.f;
#pragma unroll 1
      for (int j8 = 0; j8 < 8; ++j8) { float kd[8];
#pragma unroll
        for (int e = 0; e < 8; ++e) { const int j = j8 * 8 + e; const float* gl = glrs + j * 16; float z = gb;
#pragma unroll
          for (int r4 = 0; r4 < 4; ++r4) { const float4 g4 = *(const float4*)(gl + r4 * 4); z += g4.x * gu[r4 * 4] + g4.y * gu[r4 * 4 + 1] + g4.z * gu[r4 * 4 + 2] + g4.w * gu[r4 * 4 + 3]; }
          run += logsigmoidf_(z) * (1.f / 16.f);
          const float q = bf2f(qT[j * 512 + tid]), k = bf2f(kT[j * 512 + tid]), eb = __expf(run), ks_ = k * __builtin_amdgcn_rcpf(eb);
          qo[(size_t)j * 1024] = f2bf(q * 0.08838834764831845f * eb); ko[(size_t)j * 1024] = f2bf(ks_); kd[e] = ks_; }
        *(uint4*)(kdo + j8 * 8) = pack8(kd); }
      w.gdec[(size_t)item * 128 + d] = __expf(run);
    } else {
      float q0 = 0.f, q1 = 0.f, q2 = 0.f, k0 = 0.f, k1 = 0.f, k2 = 0.f;
      if (c > 0) { const bf16_t* qp = w.proj + tb * NPROJ + C_MQ + tid; const bf16_t* kp = w.proj + tb * NPROJ + C_MK + tid;
        q0 = bf2f(*(qp - 3 * (size_t)NPROJ)); q1 = bf2f(*(qp - 2 * (size_t)NPROJ)); q2 = bf2f(*(qp - (size_t)NPROJ)); k0 = bf2f(*(kp - 3 * (size_t)NPROJ)); k1 = bf2f(*(kp - 2 * (size_t)NPROJ)); k2 = bf2f(*(kp - (size_t)NPROJ)); }
      if (tid < 256) { const int hh = tid >> 6; const float mi = bf2f(w.proj[(tb + lane) * NPROJ + C_SM + 16 + hh]), mf = bf2f(w.proj[(tb + lane) * NPROJ + C_SM + 20 + hh]);
        float f = logsigmoidf_(mf + p.fg_bias[hh]);
#pragma unroll
        for (int o = 1; o < 64; o <<= 1) { const float t = bperm(f, lane - o); if (lane >= o) f += t; }
        Fl[hh * 64 + lane] = f; Fl[256 + hh * 64 + lane] = mi + p.ig_bias[hh]; }
      const float cq0 = p.conv_w[tid], cq1 = p.conv_w[1024 + tid], cq2 = p.conv_w[2048 + tid], cq3 = p.conv_w[3072 + tid], cqb = p.conv_b[tid];
      const float ck0 = p.conv_w[512 + tid], ck1 = p.conv_w[1536 + tid], ck2 = p.conv_w[2560 + tid], ck3 = p.conv_w[3584 + tid], ckb = p.conv_b[512 + tid];
      __syncthreads();
      const float flast = Fl[h * 64 + 63];
      if (d == 0) w.mdec[item - 2048] = __expf(flast);
      float un = 0.f;
#pragma unroll 1
      for (int j8 = 0; j8 < 8; ++j8) { float kd[8];
#pragma unroll
        for (int e = 0; e < 8; ++e) { const int j = j8 * 8 + e; const float xq = bf2f(qT[j * 512 + tid]), xk = bf2f(kT[j * 512 + tid]);
          const float qc = siluf_(cqb + cq0 * q0 + cq1 * q1 + cq2 * q2 + cq3 * xq), kc = siluf_(ckb + ck0 * k0 + ck1 * k1 + ck2 * k2 + ck3 * xk) * 0.08838834764831845f;
          q0 = q1; q1 = q2; q2 = xq; k0 = k1; k1 = k2; k2 = xk;
          const float F = Fl[h * 64 + j], ig = Fl[256 + h * 64 + j];
          const float ks_ = kc * __expf(ig - F);
          qo[(size_t)j * 1024] = f2bf(qc * __expf(F)); ko[(size_t)j * 1024] = f2bf(ks_); kd[e] = ks_; un += ks_; }
        *(uint4*)(kdo + j8 * 8) = pack8(kd); }
      w.mn[(size_t)(item - 2048) * 128 + d] = un * __expf(flast);
    }
    __syncthreads();
  }
}
__device__ void mix_local2(const Params& p, const WS& w, int bid, int nb) {
  const int tid = tidx(), wave = tid >> 6, lane = tid & 63, fr = lane & 15, fq = lane >> 4;
  for (int task = bid * 8 + wave; task < 32768; task += nb * 8) {
    const int item = task >> 3, w8 = task & 7, kind = item >> 11, b = (item >> 10) & 1, h = (item >> 8) & 3, c = item & 255;
    const size_t tb = (size_t)b * SEQ + (size_t)c * 64;
    const bf16_t* xrow = w.kdT + (size_t)(kind * 512 + h * 128 + fr) * T + tb + fq * 8;
    const bf16_t* yrow = w.vT + (size_t)(kind * 1024 + h * 256 + w8 * 32 + fr) * T + tb + fq * 8;
    f32x4 acc[2][8];
#pragma unroll
    for (int yt = 0; yt < 2; ++yt)
#pragma unroll
      for (int xt = 0; xt < 8; ++xt) acc[yt][xt] = (f32x4){0.f, 0.f, 0.f, 0.f};
#pragma unroll
    for (int ks = 0; ks < 2; ++ks) {
      const bf16x8 y0 = *(const bf16x8*)(yrow + ks * 32), y1 = *(const bf16x8*)(yrow + (size_t)16 * T + ks * 32);
#pragma unroll
      for (int xt = 0; xt < 8; ++xt) { const bf16x8 xk = *(const bf16x8*)(xrow + (size_t)xt * 16 * T + ks * 32);
        acc[0][xt] = MFMA16(xk, y0, acc[0][xt]); acc[1][xt] = MFMA16(xk, y1, acc[1][xt]); }
    }
    bf16_t* S = (bf16_t*)p.out + (size_t)item * 32768;
    const float md = kind ? w.mdec[item - 2048] : 0.f;
#pragma unroll
    for (int xt = 0; xt < 8; ++xt) { const float4 dc = kind ? make_float4(md, md, md, md) : *(const float4*)(w.gdec + (size_t)item * 128 + xt * 16 + 4 * fq);
#pragma unroll
      for (int yt = 0; yt < 2; ++yt) *(uint2*)(S + (w8 * 32 + yt * 16 + fr) * 128 + xt * 16 + 4 * fq) = make_uint2(pack2(acc[yt][xt][0] * dc.x, acc[yt][xt][1] * dc.y), pack2(acc[yt][xt][2] * dc.z, acc[yt][xt][3] * dc.w)); }
  }
}
template <int KIND>
__device__ __forceinline__ void mix_out2_task(const Params& p, const WS& w, int item, int it, int fr, int fq) {
  const int b = (item >> 10) & 1, h = (item >> 8) & 3, c = item & 255;
  const size_t tb = (size_t)b * SEQ + (size_t)c * 64;
  const int i = it * 16 + fr;
  typedef unsigned u32x4_t __attribute__((ext_vector_type(4)));
  bf16x8 yq[4];
  { const bf16_t* qrow = w.qs + (tb + i) * 1024 + KIND * 512 + h * 128 + fq * 8;
#pragma unroll
    for (int k4 = 0; k4 < 4; ++k4) yq[k4] = *(const bf16x8*)(qrow + k4 * 32); }
  uint2 pk[4]; float rsum = 0.f;
  { bf16x8 kf[4][4];
#pragma unroll
    for (int jt = 0; jt < 4; ++jt) if (jt <= it) { const bf16_t* krow = w.ks + (tb + jt * 16 + fr) * 1024 + KIND * 512 + h * 128 + fq * 8;
#pragma unroll
      for (int k4 = 0; k4 < 4; ++k4) kf[jt][k4] = *(const bf16x8*)(krow + k4 * 32); }
#pragma unroll
    for (int jt = 0; jt < 4; ++jt) { pk[jt] = make_uint2(0u, 0u);
      if (jt <= it) { f32x4 a = (f32x4){0.f, 0.f, 0.f, 0.f};
#pragma unroll
        for (int k4 = 0; k4 < 4; ++k4) a = MFMA16(kf[jt][k4], yq[k4], a);
        if (jt == it) {
#pragma unroll
          for (int r = 0; r < 4; ++r) a[r] = (4 * fq + r <= fr) ? a[r] : 0.f; }
        rsum += a[0] + a[1] + a[2] + a[3];
        pk[jt] = make_uint2(pack2(a[0], a[1]), pack2(a[2], a[3])); } } }
  f32x4 acc[16];
#pragma unroll
  for (int xt = 0; xt < 16; ++xt) acc[xt] = (f32x4){0.f, 0.f, 0.f, 0.f};
  const bf16_t* vbase = w.vT + (size_t)(KIND * 1024 + h * 256 + fr) * T + tb + 4 * fq;
  const bf16_t* sbase = (const bf16_t*)p.out + (size_t)item * 32768 + fr * 128 + fq * 8;
  const u32x4_t yp0 = {pk[0].x, pk[0].y, pk[1].x, pk[1].y}, yp1 = {pk[2].x, pk[2].y, pk[3].x, pk[3].y};
  uint2 va[2][2][2], vb[2][2][2]; bf16x8 sf[2][2][4];
#define MO_LOAD(bufi, g) do { _Pragma("unroll") for (int x2 = 0; x2 < 2; ++x2) { const int xt = (g) * 2 + x2; const bf16_t* vr = vbase + (size_t)xt * 16 * T; \
      va[bufi][x2][0] = *(const uint2*)vr; vb[bufi][x2][0] = *(const uint2*)(vr + 16); if (it >= 2) { va[bufi][x2][1] = *(const uint2*)(vr + 32); vb[bufi][x2][1] = *(const uint2*)(vr + 48); } \
      _Pragma("unroll") for (int k4 = 0; k4 < 4; ++k4) sf[bufi][x2][k4] = *(const bf16x8*)(sbase + xt * 16 * 128 + k4 * 32); } } while (0)
#define MO_COMP(bufi, g) do { _Pragma("unroll") for (int x2 = 0; x2 < 2; ++x2) { const int xt = (g) * 2 + x2; \
      { const u32x4_t xv = {va[bufi][x2][0].x, va[bufi][x2][0].y, vb[bufi][x2][0].x, vb[bufi][x2][0].y}; acc[xt] = MFMA16(__builtin_bit_cast(bf16x8, xv), __builtin_bit_cast(bf16x8, yp0), acc[xt]); } \
      if (it >= 2) { const u32x4_t xv = {va[bufi][x2][1].x, va[bufi][x2][1].y, vb[bufi][x2][1].x, vb[bufi][x2][1].y}; acc[xt] = MFMA16(__builtin_bit_cast(bf16x8, xv), __builtin_bit_cast(bf16x8, yp1), acc[xt]); } \
      _Pragma("unroll") for (int k4 = 0; k4 < 4; ++k4) acc[xt] = MFMA16(sf[bufi][x2][k4], yq[k4], acc[xt]); } } while (0)
  MO_LOAD(0, 0);
#pragma unroll
  for (int g = 0; g < 8; g += 2) {
    MO_LOAD(1, g + 1);
    MO_COMP(0, g);
    if (g + 2 < 8) MO_LOAD(0, g + 2);
    MO_COMP(1, g + 1);
  }
#undef MO_LOAD
#undef MO_COMP
  if (KIND == 1) {
    float qn = 0.f; const float* nrow = w.mn + (size_t)(item - 2048) * 128 + fq * 8;
#pragma unroll
    for (int k4 = 0; k4 < 4; ++k4) { float f[8]; unpack8(__builtin_bit_cast(uint4, yq[k4]), f); const float4 n0 = *(const float4*)(nrow + k4 * 32), n1 = *(const float4*)(nrow + k4 * 32 + 4);
      qn += f[0] * n0.x + f[1] * n0.y + f[2] * n0.z + f[3] * n0.w + f[4] * n1.x + f[5] * n1.y + f[6] * n1.z + f[7] * n1.w; }
    float den = rsum + qn; den += sxor<16>(den); den += sxor<32>(den);
    const float inv = 1.f / fmaxf(fabsf(den), 1.f);
#pragma unroll
    for (int xt = 0; xt < 16; ++xt) acc[xt] *= inv;
  }
  float ss = 0.f;
#pragma unroll
  for (int xt = 0; xt < 16; ++xt)
#pragma unroll
    for (int r = 0; r < 4; ++r) ss += acc[xt][r] * acc[xt][r];
  ss += sxor<16>(ss); ss += sxor<32>(ss);
  const float rs = rsqrtf(ss * (1.f / 256.f) + EPS);
  const float* gain = (KIND == 0 ? p.gla_norm : p.mlstm_norm) + h * 256 + 4 * fq;
  const bf16_t* grow = w.proj + (tb + i) * NPROJ + (KIND == 0 ? C_GG : C_MO) + h * 256 + 4 * fq;
#pragma unroll
  for (int xt = 0; xt < 16; ++xt) { const uint2 g2 = *(const uint2*)(grow + xt * 16); const float4 gn = *(const float4*)(gain + xt * 16);
    const float g0 = lo_f(g2.x), g1 = hi_f(g2.x), g2f = lo_f(g2.y), g3 = hi_f(g2.y);
    const float a0 = KIND == 0 ? siluf_(g0) : sigmoidf_(g0), a1 = KIND == 0 ? siluf_(g1) : sigmoidf_(g1), a2 = KIND == 0 ? siluf_(g2f) : sigmoidf_(g2f), a3 = KIND == 0 ? siluf_(g3) : sigmoidf_(g3);
    const float y0 = acc[xt][0] * rs * gn.x * a0, y1 = acc[xt][1] * rs * gn.y * a1, y2 = acc[xt][2] * rs * gn.z * a2, y3 = acc[xt][3] * rs * gn.w * a3;
    const size_t yo = (tb + i) * D + KIND * 1024 + h * 256 + xt * 16 + 4 * fq;
#if F8_OUT
    *(unsigned*)(w.yq + yo) = pack4_fp8(y0, y1, y2, y3);
#else
    *(uint2*)(w.y + yo) = make_uint2(pack2(y0, y1), pack2(y2, y3));
#endif
  }
}
__device__ void mix_out2(const Params& p, const WS& w, int bid, int nb) {
  const int tid = tidx(), wave = tid >> 6, lane = tid & 63, fr = lane & 15, fq = lane >> 4;
  for (int task = bid * 8 + wave; task < 16384; task += nb * 8) {
    const int item = task >> 2, it = __builtin_amdgcn_readfirstlane(task & 3);
    if (item < 2048) mix_out2_task<0>(p, w, item, it, fr, fq); else mix_out2_task<1>(p, w, item, it, fr, fq);
  }
}

__device__ __forceinline__ unsigned sort16(unsigned b) { return (b & 0x8000u) ? (~b & 0xffffu) : (b | 0x8000u); }
__device__ __forceinline__ float unsort16(unsigned k) { const unsigned b = (k & 0x8000u) ? (k & 0x7fffu) : (~k & 0xffffu); return __uint_as_float(b << 16); }
__device__ __forceinline__ unsigned sort32(float f) { const unsigned u = __float_as_uint(f); return (u & 0x80000000u) ? ~u : (u | 0x80000000u); }
__device__ __forceinline__ float unsort32(unsigned k) { const unsigned u = (k & 0x80000000u) ? (k & 0x7fffffffu) : ~k; return __uint_as_float(u); }
__device__ void phase_topk(const Params& p, const WS& w, int bid, int nb) {
  for (int th = bid * 512 + tidx(); th < T * 8; th += nb * 512) {
    const int t = th >> 3, h = th & 7;
    const uint4* s = (const uint4*)(w.sc + (size_t)t * D + h * 256);
    unsigned l[2][16];
#pragma unroll
    for (int pp = 0; pp < 2; ++pp) {
#pragma unroll
      for (int i = 0; i < 16; ++i) l[pp][i] = 0u;
      for (int q = 0; q < 16; ++q) {
        const uint4 v = s[pp * 16 + q]; const unsigned wds[4] = {v.x, v.y, v.z, v.w};
#pragma unroll
        for (int e = 0; e < 8; ++e) {
          const unsigned b = (e & 1) ? (wds[e >> 1] >> 16) : (wds[e >> 1] & 0xffffu);
          unsigned x = (sort16(b) << 16) | (unsigned)(q * 8 + e);
#pragma unroll
          for (int i = 0; i < 16; ++i) { const unsigned hi = max(l[pp][i], x); x = min(l[pp][i], x); l[pp][i] = hi; }
        }
      }
    }
    unsigned long long lc[16];
#pragma unroll
    for (int i = 0; i < 16; ++i) lc[i] = 0ull;
#pragma unroll
    for (int i = 0; i < 16; ++i)
#pragma unroll
      for (int j = 0; j < 16; ++j) if ((i + 1) * (j + 1) <= 16) {
        const float sv = unsort16(l[0][i] >> 16) + unsort16(l[1][j] >> 16);
        unsigned long long x = ((unsigned long long)sort32(sv) << 32) | (unsigned long long)((l[0][i] & 0xffffu) * 128u + (l[1][j] & 0xffffu));
#pragma unroll
        for (int k = 0; k < 16; ++k) { const bool gt = x > lc[k]; const unsigned long long hi = gt ? x : lc[k]; x = gt ? lc[k] : x; lc[k] = hi; }
      }
    const float mx = unsort32((unsigned)(lc[0] >> 32));
    float e[16], sum = 0.f;
#pragma unroll
    for (int k = 0; k < 16; ++k) { e[k] = __expf(unsort32((unsigned)(lc[k] >> 32)) - mx); sum += e[k]; }
    const float inv = 1.f / sum;
    int* ei = w.eidx + (size_t)t * 128 + h * 16; float* eg = w.eg + (size_t)t * 128 + h * 16;
#pragma unroll
    for (int k4 = 0; k4 < 4; ++k4) {
      *(int4*)(ei + k4 * 4) = make_int4((int)(lc[k4 * 4] & 0xffffffffu), (int)(lc[k4 * 4 + 1] & 0xffffffffu), (int)(lc[k4 * 4 + 2] & 0xffffffffu), (int)(lc[k4 * 4 + 3] & 0xffffffffu));
      *(float4*)(eg + k4 * 4) = make_float4(e[k4 * 4] * inv, e[k4 * 4 + 1] * inv, e[k4 * 4 + 2] * inv, e[k4 * 4 + 3] * inv);
    }
  }
}
__device__ __forceinline__ void ub16(const uint4 q, float* f) {
  const unsigned wd[4] = {q.x, q.y, q.z, q.w};
#pragma unroll
  for (int k = 0; k < 4; ++k) { f[k * 4] = (float)(wd[k] & 0xffu); f[k * 4 + 1] = (float)((wd[k] >> 8) & 0xffu); f[k * 4 + 2] = (float)((wd[k] >> 16) & 0xffu); f[k * 4 + 3] = (float)(wd[k] >> 24); }
}
__device__ void peer_dots(const Params& p, const WS& w, int bid, int nb) {
  const int tid = tidx(), wave = tid >> 6, lane = tid & 63, r = lane % LPR, q = lane / LPR;
  const int x = bid & 7, nwl = (nb >> 3) * 8, wl = (bid >> 3) * 8 + wave;
  for (int sp = 0; sp < SPL; ++sp) {
    const int s = x * SPL + sp;
    const unsigned char* tab = w.u8 + (size_t)s * 16384 * SLW + r * 16;
    for (int t = wl; t < T; t += nwl) {
      const int idx0 = w.eidx[(size_t)t * 128 + lane], idx1 = w.eidx[(size_t)t * 128 + 64 + lane];
      float hf[16];
      unpack8(*(const uint4*)(w.h1b + (size_t)t * D + s * SLW + r * 16), hf); unpack8(*(const uint4*)(w.h1b + (size_t)t * D + s * SLW + r * 16 + 8), hf + 8);
      float am = 0.f;
#pragma unroll
      for (int j = 0; j < 16; ++j) am = fmaxf(am, fabsf(hf[j]));
      am = gmax<LPR>(am);
      const float sh = fmaxf(am, 1e-30f) * (1.f / 127.f), inv = 1.f / sh;
      int hq[4];
#pragma unroll
      for (int k = 0; k < 4; ++k) { unsigned xw = 0;
#pragma unroll
        for (int j = 0; j < 4; ++j) xw |= ((unsigned)(int)rintf(hf[k * 4 + j] * inv) & 0xffu) << (8 * j);
        hq[k] = (int)xw; }
      float res[2] = {0.f, 0.f};
#pragma unroll
      for (int i0 = 0; i0 < NIT; i0 += 8) {
        uint4 b[8];
#pragma unroll
        for (int k = 0; k < 8; ++k) { const int n = (i0 + k) * EPI + q; const int e = bperm((n & 64) ? idx1 : idx0, n & 63); b[k] = *(const uint4*)(tab + (size_t)e * SLW); }
#pragma unroll
        for (int k = 0; k < 8; ++k) { int a = __builtin_amdgcn_sdot4((int)b[k].x, hq[0], 0, false); a = __builtin_amdgcn_sdot4((int)b[k].y, hq[1], a, false);
          a = __builtin_amdgcn_sdot4((int)b[k].z, hq[2], a, false); a = __builtin_amdgcn_sdot4((int)b[k].w, hq[3], a, false);
          a = gsum<LPR>(a);
          const int i = i0 + k;
          if (r == (i % LPR)) res[i / LPR] = (float)a * sh; }
      }
#pragma unroll
      for (int rho = 0; rho < 2; ++rho) w.pd[((size_t)s * T + t) * 128 + (rho * LPR + r) * EPI + q] = res[rho];
    }
  }
}
__device__ void peer_wgt(const Params& p, const WS& w, int bid, int nb) {
  const int tid = tidx(), wave = tid >> 6, lane = tid & 63;
  for (int t = bid * 8 + wave; t < T; t += nb * 8) {
    const float rs2 = rsqrtf(w.ssq2[t] * (1.f / D) + EPS);
    float tot = 0.f;
#pragma unroll
    for (int hh = 0; hh < 2; ++hh) { const size_t o = (size_t)t * 128 + hh * 64 + lane; float z = 0.f;
#pragma unroll
      for (int s = 0; s < NSL; ++s) z += w.pd[(size_t)s * T * 128 + o];
      const int e = w.eidx[o];
      const float wv = w.eg[o] * gelu_tanh(z * w.usc[e] * rs2) * w.vsc[e];
      w.eg[o] = wv; tot += wv; }
    tot = wave_sum(tot);
    if (lane == 0) w.wsum[t] = tot;
  }
}
__device__ void peer_vals(const Params& p, const WS& w, int bid, int nb) {
  const int tid = tidx(), wave = tid >> 6, lane = tid & 63, r = lane % LPR, q = lane / LPR;
  const int x = bid & 7, nwl = (nb >> 3) * 8, wl = (bid >> 3) * 8 + wave;
  for (int sp = 0; sp < SPL; ++sp) {
    const int s = x * SPL + sp;
    const unsigned char* tab = w.v8 + (size_t)s * 16384 * SLW + r * 16;
    for (int t = wl; t < T; t += nwl) {
      const int idx0 = w.eidx[(size_t)t * 128 + lane], idx1 = w.eidx[(size_t)t * 128 + 64 + lane];
      const float w0 = w.eg[(size_t)t * 128 + lane], w1 = w.eg[(size_t)t * 128 + 64 + lane];
      float acc[16];
#pragma unroll
      for (int j = 0; j < 16; ++j) acc[j] = 0.f;
#pragma unroll
      for (int i0 = 0; i0 < NIT; i0 += 8) {
        uint4 b[8]; float wn[8];
#pragma unroll
        for (int k = 0; k < 8; ++k) { const int n = (i0 + k) * EPI + q; const int e = bperm((n & 64) ? idx1 : idx0, n & 63); wn[k] = bperm((n & 64) ? w1 : w0, n & 63); b[k] = *(const uint4*)(tab + (size_t)e * SLW); }
#pragma unroll
        for (int k = 0; k < 8; ++k) { float f[16]; ub16(b[k], f);
#pragma unroll
          for (int j = 0; j < 16; ++j) acc[j] += wn[k] * f[j]; }
      }
#pragma unroll
      for (int j = 0; j < 16; ++j) { if (LPR <= 8) acc[j] += sxor<8>(acc[j]); acc[j] += sxor<16>(acc[j]); acc[j] += sxor<32>(acc[j]); }
      float hf[16]; float ss = 0.f;
      unpack8(*(const uint4*)(w.h1b + (size_t)t * D + s * SLW + r * 16), hf); unpack8(*(const uint4*)(w.h1b + (size_t)t * D + s * SLW + r * 16 + 8), hf + 8);
      const float off = 128.f * w.wsum[t];
#pragma unroll
      for (int j = 0; j < 16; ++j) { acc[j] += hf[j] - off; ss += acc[j] * acc[j]; }
      if (q == 0) { *(uint4*)(w.h2b + (size_t)t * D + s * SLW + r * 16) = pack8(acc); *(uint4*)(w.h2b + (size_t)t * D + s * SLW + r * 16 + 8) = pack8(acc + 8);
#if F8_GATE
        const float rs2 = rsqrtf(w.ssq2[t] * (1.f / D) + EPS);
        *(uint4*)(w.h2q + (size_t)t * D + s * SLW + r * 16) = make_uint4(pack4_fp8(acc[0] * rs2, acc[1] * rs2, acc[2] * rs2, acc[3] * rs2), pack4_fp8(acc[4] * rs2, acc[5] * rs2, acc[6] * rs2, acc[7] * rs2),
                                                                      pack4_fp8(acc[8] * rs2, acc[9] * rs2, acc[10] * rs2, acc[11] * rs2), pack4_fp8(acc[12] * rs2, acc[13] * rs2, acc[14] * rs2, acc[15] * rs2));
#endif
      } else ss = 0.f;
      ss = wave_sum(ss);
      if (lane == 0) atomicAdd(w.ssq3 + t, ss);
    }
  }
}
__device__ void phase_final(const Params& p, const WS& w, int bid, int nb) {
  const int wave = tidx() >> 6, lane = tidx() & 63;
  for (int row = bid * 8 + wave; row < T; row += nb * 8) {
    float4* o = (float4*)(p.out + (size_t)row * D);
    const float rs = rsqrtf(w.ssq4[row] * (1.f / D) + EPS);
#pragma unroll
    for (int i = 0; i < 8; ++i) { float4 v = o[i * 64 + lane]; const float4 g = *(const float4*)(p.norm_final + (i * 64 + lane) * 4); v.x *= rs * g.x; v.y *= rs * g.y; v.z *= rs * g.z; v.w *= rs * g.w; o[i * 64 + lane] = v; }
  }
}

constexpr int NPHASE = 10;
#ifndef MIX_OUT3
#define MIX_OUT3 1
#endif
#ifndef FAST_MIX
#define FAST_MIX 2
#endif
template <int PH>
__device__ __forceinline__ void run_phase(const Params& p, float* lds, int bid, int nb) {
  const WS w = make_ws(p.ws, p.out);
  if (PH == 0) phase_prep(p, w, lds, bid, nb);
  if (PH == 13) phase_prep2(p, w, lds, bid, nb);
  const float s_in = __uint_as_float(__builtin_amdgcn_readfirstlane((F8_IN && PH == 1) ? __float_as_uint(w.ctlf[0]) : 0u)) * (1.f / 256.f);
  const float s_out = F8_OUT ? __uint_as_float(__builtin_amdgcn_readfirstlane((PH == 5) ? __float_as_uint(w.ctlf[1]) : 0u)) * (1.f / 256.f) : 1.f;
  const float s_g = __uint_as_float(__builtin_amdgcn_readfirstlane((F8_GATE && PH == 11) ? __float_as_uint(w.ctlf[2]) : 0u)) * (1.f / 256.f);
#if F8_IN
  if (PH == 1) { gemm_any<true>(w.xq, w.winq, T, NPROJ, D, EpiProjN{w.proj, w.rstd1, s_in}, lds, bid, nb);
                 gemm_any<true>(w.winq + (size_t)NPROJ * D, w.xq, 2048, T, D, EpiProjT{w.vT, w.rstd1, s_in}, lds, bid, nb); }
#else
  if (PH == 1) { gemm_any(w.xb, w.win, T, NPROJ, D, EpiProjN{w.proj, w.rstd1, 1.f}, lds, bid, nb);
                 gemm_any(w.win + (size_t)NPROJ * D, w.xb, 2048, T, D, EpiProjT{w.vT, w.rstd1, 1.f}, lds, bid, nb); }
#endif
#if F8_OUT
  if (PH == 5) gemm_any<true>(w.yq, w.woutq, T, D, D, EpiOut{p.x, w.h1b, w.ssq2, s_out}, lds, bid, nb);
#else
  if (PH == 5) gemm_any(w.y, w.wout, T, D, D, EpiOut{p.x, w.h1b, w.ssq2, 1.f}, lds, bid, nb);
#endif
#if F8_GATE
  if (PH == 11) gemm_any<true>(w.h2q, w.wgq, T, D, D, EpiGate{w.h2b, w.pl, w.ssq3, p.out, w.ssq4, w.ssq2, s_g}, lds, bid, nb);
#else
  if (PH == 11) gemm_any(w.h2b, w.wg, T, D, D, EpiGate{w.h2b, w.pl, w.ssq3, p.out, w.ssq4, w.ssq2, 1.f}, lds, bid, nb);
#endif
#if FAST_MIX == 2
  if (PH == 14) mix_gate_pass(p, w, (unsigned char*)lds, bid, nb);
  if (PH == 2) mix_local2(p, w, bid, nb);
  if (PH == 3) mix_scan(p, w, lds, bid, nb);
#if MIX_OUT3
  if (PH == 4) phase_mix_out3(p, w, (unsigned char*)lds, bid, nb);
#else
  if (PH == 4) mix_out2(p, w, bid, nb);
#endif
#elif FAST_MIX
  if (PH == 2) phase_mix_items<0>(p, w, (unsigned char*)lds, bid, nb);
  if (PH == 3) mix_scan(p, w, lds, bid, nb);
  if (PH == 4) phase_mix_items<1>(p, w, (unsigned char*)lds, bid, nb);
#else
  if (PH == 2) phase_mixer_naive(p, w, lds, bid, nb);
#endif
  if (PH == 6) gemm_any(w.h1b, w.wq, T, D, D, EpiScore{w.sc, w.ssq2}, lds, bid, nb);
  if (PH == 7) { phase_topk(p, w, bid, nb); gemm_any(w.pb, w.wple, T, D, 256, EpiPl{w.pl}, lds, bid, nb); }
  if (PH == 8) peer_dots(p, w, bid, nb);
  if (PH == 9) peer_wgt(p, w, bid, nb);
  if (PH == 10) peer_vals(p, w, bid, nb);
  if (PH == 12) phase_final(p, w, bid, nb);
}

extern __shared__ __attribute__((aligned(16))) unsigned char dyn_lds[];

#if ONE_LAUNCH
__global__ void __launch_bounds__(512, 2) mega(Params p) {
  cg::grid_group grid = cg::this_grid();
  float* lds = (float*)dyn_lds; const int bid = blockIdx.x, nb = gridDim.x;
#ifndef DUP_PHASE
#define DUP_PHASE -1
#endif
#define RUNP(k) do { run_phase<k>(p, lds, bid, nb); if (DUP_PHASE == (k)) { grid.sync(); run_phase<k>(p, lds, bid, nb); } } while (0)
  RUNP(0); grid.sync();
#if F8_GEMM
  RUNP(13); grid.sync();
#endif
  RUNP(1); grid.sync();
#if FAST_MIX == 2
  RUNP(14); grid.sync();
#endif
  RUNP(2); grid.sync();
#if FAST_MIX
  RUNP(3); grid.sync();
  RUNP(4); grid.sync();
#endif
  RUNP(5); grid.sync();
  RUNP(6); grid.sync();
  RUNP(7); grid.sync();
  RUNP(8); grid.sync();
  RUNP(9); grid.sync();
  RUNP(10); grid.sync();
  RUNP(11); grid.sync();
  RUNP(12);
#undef RUNP
}
#else
template <int PH> __global__ void __launch_bounds__(512, 2) k_phase(Params p) { run_phase<PH>(p, (float*)dyn_lds, blockIdx.x, gridDim.x); }
#endif

constexpr size_t kDynLds = 143360;

extern "C" void kernel_launch(void* const* d_in, const int* in_sizes, int n_in, void* d_out, int out_size, void* d_ws, size_t ws_size, hipStream_t stream) {
  if (n_in != 22 || out_size != T * D || ws_size < WS_NEED) { fprintf(stderr, "kernel_launch: unexpected shapes (n_in %d out %d ws %zu)\n", n_in, out_size, ws_size); return; }
  Params p{};
  const float** f = (const float**)&p;
  for (int i = 0; i < 22; ++i) f[i] = (const float*)d_in[i];
  p.out = (float*)d_out; p.ws = (unsigned char*)d_ws;
#if ONE_LAUNCH
  static int grid_blocks = 0;
  if (!grid_blocks) {
    int dev = 0, cus = 0, per_cu = 0;
    (void)hipGetDevice(&dev); (void)hipDeviceGetAttribute(&cus, hipDeviceAttributeMultiprocessorCount, dev);
    (void)hipFuncSetAttribute((const void*)mega, hipFuncAttributeMaxDynamicSharedMemorySize, (int)kDynLds);
    (void)hipOccupancyMaxActiveBlocksPerMultiprocessor(&per_cu, mega, 512, kDynLds);
    if (per_cu < 1) { fprintf(stderr, "occupancy query says 0 blocks/CU\n"); per_cu = 1; }
    grid_blocks = cus;
  }
  void* args[] = {&p};
  hipError_t e = hipLaunchCooperativeKernel((void*)mega, dim3(grid_blocks), dim3(512), args, kDynLds, stream);
  if (e != hipSuccess) fprintf(stderr, "cooperative launch failed: %s (grid %d)\n", hipGetErrorString(e), grid_blocks);
#else
  static bool attr = false;
  const int G = 256;
#define LAUNCH(PH) do { if (!attr) (void)hipFuncSetAttribute((const void*)k_phase<PH>, hipFuncAttributeMaxDynamicSharedMemorySize, (int)kDynLds); \
    hipLaunchKernelGGL(k_phase<PH>, dim3(G), dim3(512), kDynLds, stream, p); } while (0)
  LAUNCH(0); LAUNCH(13); LAUNCH(1); LAUNCH(14); LAUNCH(2); LAUNCH(3); LAUNCH(4); LAUNCH(5); LAUNCH(6); LAUNCH(7); LAUNCH(8); LAUNCH(9); LAUNCH(10); LAUNCH(11); LAUNCH(12);
  attr = true;
#undef LAUNCH
#endif
}
```

```cpp
#include <hip/hip_runtime.h>
#include <hip/hip_cooperative_groups.h>
#include <cstdio>
#include <cstdint>
namespace cg = cooperative_groups;

#ifndef ONE_LAUNCH
#define ONE_LAUNCH 1
#endif

typedef unsigned short bf16_t;
constexpr int T = 32768, SEQ = 16384, D = 2048;
constexpr int NPROJ = 4352;
constexpr int C_GQ = 0, C_GK = 512, C_GG = 1024, C_MQ = 2048, C_MK = 2560, C_MO = 3072, C_SM = 4096;
constexpr float EPS = 1e-6f;
constexpr size_t MiB = 1ull << 20;
constexpr size_t OFF_XB = 0, OFF_Y = 0, OFF_PL = 0;
constexpr size_t OFF_PROJ = 128 * MiB, OFF_H1B = 128 * MiB, OFF_H2B = 256 * MiB;
constexpr size_t OFF_VT = 400 * MiB, OFF_SC = 400 * MiB;
constexpr size_t OFF_UB = 528 * MiB, OFF_VB = 592 * MiB;
constexpr size_t OFF_WIN = 656 * MiB, OFF_WOUT = 681 * MiB, OFF_WQ = 689 * MiB, OFF_WG = 697 * MiB, OFF_WPLE = 705 * MiB;
constexpr size_t OFF_PB = 706 * MiB, OFF_EIDX = 722 * MiB, OFF_EG = 738 * MiB, OFF_MISC = 754 * MiB;
constexpr size_t OFF_GDEC = 755 * MiB, OFF_MN = 756 * MiB, OFF_MDEC = 757 * MiB, OFF_ESC = 758 * MiB;
constexpr size_t OFF_CTL = 759 * MiB, OFF_H2Q = 400 * MiB, OFF_QS = 760 * MiB, OFF_KS = 824 * MiB, OFF_KDT = 888 * MiB;
constexpr size_t OFF_ESU = 952 * MiB;
constexpr size_t WS_NEED = 968 * MiB;
#ifndef F8_IN
#define F8_IN 0
#endif
#ifndef F8_OUT
#define F8_OUT 1
#endif
#ifndef F8_GATE
#define F8_GATE 1
#endif
#ifndef F8_GEMM
#define F8_GEMM (F8_IN || F8_OUT || F8_GATE)
#endif

struct Params {
  const float *x, *p, *norm_mix, *w_in, *gate_up, *gate_bias, *gla_norm, *conv_w, *conv_b, *ig_bias, *fg_bias, *mlstm_norm,
      *w_out, *norm_ffn, *peer_query, *sub_keys, *peer_u, *peer_v, *norm_ple, *w_ple, *w_ple_gate, *norm_final;
  float* out;
  unsigned char* ws;
};

__device__ __forceinline__ float bf2f(bf16_t b) { return __uint_as_float(((unsigned)b) << 16); }
typedef __bf16 bf16v2_t __attribute__((ext_vector_type(2)));
__device__ __forceinline__ bf16_t f2bf(float f) { const __bf16 b = (__bf16)f; return __builtin_bit_cast(bf16_t, b); }
__device__ __forceinline__ unsigned pack2(float lo, float hi) { const bf16v2_t v = {(__bf16)lo, (__bf16)hi}; return __builtin_bit_cast(unsigned, v); }
__device__ __forceinline__ unsigned pack4_fp8(float a, float b, float c, float d) { int v = __builtin_amdgcn_cvt_pk_fp8_f32(a, b, 0, false); v = __builtin_amdgcn_cvt_pk_fp8_f32(c, d, v, true); return (unsigned)v; }
__device__ __forceinline__ float lo_f(unsigned u) { return __uint_as_float(u << 16); }
__device__ __forceinline__ float hi_f(unsigned u) { return __uint_as_float(u & 0xffff0000u); }
__device__ __forceinline__ int tidx() { int t = threadIdx.x; asm volatile("" : "+v"(t)); return t; }
template <int O> __device__ __forceinline__ int sxor_i(int v) {
  if constexpr (O < 32) return __builtin_amdgcn_ds_swizzle(v, (O << 10) | 0x1f);
  else return __builtin_amdgcn_ds_bpermute(((tidx() & 63) ^ 32) << 2, v);
}
template <int O> __device__ __forceinline__ float sxor(float v) { return __int_as_float(sxor_i<O>(__float_as_int(v))); }
template <int O> __device__ __forceinline__ int sxor(int v) { return sxor_i<O>(v); }
__device__ __forceinline__ int bperm(int v, int src_lane) { return __builtin_amdgcn_ds_bpermute(src_lane << 2, v); }
__device__ __forceinline__ float bperm(float v, int src_lane) { return __int_as_float(__builtin_amdgcn_ds_bpermute(src_lane << 2, __float_as_int(v))); }
template <int N> __device__ __forceinline__ float gsum(float v) {
  if constexpr (N >= 2) v += sxor<1>(v); if constexpr (N >= 4) v += sxor<2>(v); if constexpr (N >= 8) v += sxor<4>(v);
  if constexpr (N >= 16) v += sxor<8>(v); if constexpr (N >= 32) v += sxor<16>(v); if constexpr (N >= 64) v += sxor<32>(v); return v; }
template <int N> __device__ __forceinline__ int gsum(int v) {
  if constexpr (N >= 2) v += sxor<1>(v); if constexpr (N >= 4) v += sxor<2>(v); if constexpr (N >= 8) v += sxor<4>(v);
  if constexpr (N >= 16) v += sxor<8>(v); if constexpr (N >= 32) v += sxor<16>(v); if constexpr (N >= 64) v += sxor<32>(v); return v; }
template <int N> __device__ __forceinline__ float gmax(float v) {
  if constexpr (N >= 2) v = fmaxf(v, sxor<1>(v)); if constexpr (N >= 4) v = fmaxf(v, sxor<2>(v)); if constexpr (N >= 8) v = fmaxf(v, sxor<4>(v));
  if constexpr (N >= 16) v = fmaxf(v, sxor<8>(v)); if constexpr (N >= 32) v = fmaxf(v, sxor<16>(v)); if constexpr (N >= 64) v = fmaxf(v, sxor<32>(v)); return v; }
__device__ __forceinline__ float wave_sum(float v) { return gsum<64>(v); }
__device__ __forceinline__ float sigmoidf_(float x) { return __builtin_amdgcn_rcpf(1.f + __expf(-x)); }
__device__ __forceinline__ float siluf_(float x) { return x * __builtin_amdgcn_rcpf(1.f + __expf(-x)); }
__device__ __forceinline__ float logsigmoidf_(float x) { return fminf(x, 0.f) - __logf(1.f + __expf(-fabsf(x))); }
__device__ __forceinline__ float gelu_tanh(float x) { const float u = 0.7978845608028654f * (x + 0.044715f * x * x * x); return x * __builtin_amdgcn_rcpf(1.f + __expf(-2.f * u)); }
__device__ __forceinline__ void unpack8(const uint4 q, float* f) {
  f[0] = lo_f(q.x); f[1] = hi_f(q.x); f[2] = lo_f(q.y); f[3] = hi_f(q.y); f[4] = lo_f(q.z); f[5] = hi_f(q.z); f[6] = lo_f(q.w); f[7] = hi_f(q.w);
}
__device__ __forceinline__ uint4 pack8(const float* f) { return make_uint4(pack2(f[0], f[1]), pack2(f[2], f[3]), pack2(f[4], f[5]), pack2(f[6], f[7])); }

struct WS {
  bf16_t *xb, *y, *pl, *proj, *h1b, *h2b, *vT, *sc, *ub, *vb, *win, *wout, *wq, *wg, *wple, *pb;
  int* eidx; float* eg; float* esu; float *rstd1, *ssq2, *ssq3, *ssq4, *wsum, *gdec, *mn, *mdec, *usc, *vsc, *pd;
  unsigned char *u8, *v8, *xq, *yq, *h2q, *winq, *woutq, *wgq;
  bf16_t *qs, *ks, *kdT;
  float* ctlf;
};
__device__ __forceinline__ WS make_ws(unsigned char* ws, float* out) {
  WS w;
  w.xb = (bf16_t*)(ws + OFF_XB); w.y = (bf16_t*)(ws + OFF_Y); w.pl = (bf16_t*)(ws + OFF_PL); w.proj = (bf16_t*)(ws + OFF_PROJ);
  w.h1b = (bf16_t*)(ws + OFF_H1B); w.h2b = (bf16_t*)(ws + OFF_H2B); w.vT = (bf16_t*)(ws + OFF_VT); w.sc = (bf16_t*)(ws + OFF_SC);
  w.ub = (bf16_t*)(ws + OFF_UB); w.vb = (bf16_t*)(ws + OFF_VB); w.win = (bf16_t*)(ws + OFF_WIN); w.wout = (bf16_t*)(ws + OFF_WOUT);
  w.wq = (bf16_t*)(ws + OFF_WQ); w.wg = (bf16_t*)(ws + OFF_WG); w.wple = (bf16_t*)(ws + OFF_WPLE); w.pb = (bf16_t*)(ws + OFF_PB);
  w.eidx = (int*)(ws + OFF_EIDX); w.eg = (float*)(ws + OFF_EG); w.esu = (float*)(ws + OFF_ESU);
  float* m = (float*)(ws + OFF_MISC); w.rstd1 = m; w.ssq2 = m + T; w.ssq3 = m + 2 * T; w.ssq4 = m + 3 * T; w.wsum = m + 4 * T;
  w.gdec = (float*)(ws + OFF_GDEC); w.mn = (float*)(ws + OFF_MN); w.mdec = (float*)(ws + OFF_MDEC);
  w.usc = (float*)(ws + OFF_ESC); w.vsc = w.usc + 16384; w.u8 = ws + OFF_UB; w.v8 = ws + OFF_VB; w.pd = out;
  w.xq = ws + OFF_XB; w.yq = ws + OFF_Y; w.h2q = ws + OFF_H2Q; w.winq = ws + OFF_WIN; w.woutq = ws + OFF_WOUT; w.wgq = ws + OFF_WG; w.ctlf = (float*)(ws + OFF_CTL);
  w.qs = (bf16_t*)(ws + OFF_QS); w.ks = (bf16_t*)(ws + OFF_KS); w.kdT = (bf16_t*)(ws + OFF_KDT);
  return w;
}

__device__ void prep_x(const Params& p, const WS& w, int bid, int nb) {
  const int wave = tidx() >> 6, lane = tidx() & 63;
  for (int row0 = (bid * 8 + wave) * 2; row0 < T; row0 += nb * 16) {
    float4 v[2][8]; float ss[2] = {0.f, 0.f};
#pragma unroll
    for (int rr = 0; rr < 2; ++rr) { const float4* src = (const float4*)(p.x + (size_t)(row0 + rr) * D);
#pragma unroll
      for (int i = 0; i < 8; ++i) v[rr][i] = src[i * 64 + lane]; }
#pragma unroll
    for (int rr = 0; rr < 2; ++rr) {
#pragma unroll
      for (int i = 0; i < 8; ++i) ss[rr] += v[rr][i].x * v[rr][i].x + v[rr][i].y * v[rr][i].y + v[rr][i].z * v[rr][i].z + v[rr][i].w * v[rr][i].w;
      ss[rr] = wave_sum(ss[rr]);
      const float rs = rsqrtf(ss[rr] * (1.f / D) + EPS);
#if F8_IN
      unsigned* dst = (unsigned*)(w.xq + (size_t)(row0 + rr) * D);
#pragma unroll
      for (int i = 0; i < 8; ++i) dst[i * 64 + lane] = pack4_fp8(v[rr][i].x * rs, v[rr][i].y * rs, v[rr][i].z * rs, v[rr][i].w * rs);
#else
      uint2* dst = (uint2*)(w.xb + (size_t)(row0 + rr) * D);
#pragma unroll
      for (int i = 0; i < 8; ++i) dst[i * 64 + lane] = make_uint2(pack2(v[rr][i].x, v[rr][i].y), pack2(v[rr][i].z, v[rr][i].w));
#endif
      if (lane == 0) w.rstd1[row0 + rr] = rs; }
  }
}
__device__ void absmax_w(const float* src, size_t n, const float* gain, int ncols, float* part, float* lds, int bid, int nb) {
  float m = 0.f;
  for (size_t i = (size_t)bid * 512 + tidx(); i < n / 4; i += (size_t)nb * 512) { const float4 v = ((const float4*)src)[i]; const float g = gain ? gain[(i * 4) / (size_t)ncols] : 1.f;
    m = fmaxf(m, fabsf(g) * fmaxf(fmaxf(fabsf(v.x), fabsf(v.y)), fmaxf(fabsf(v.z), fabsf(v.w)))); }
  m = gmax<64>(m);
  __syncthreads();
  if ((tidx() & 63) == 0) lds[tidx() >> 6] = m;
  __syncthreads();
  if (tidx() == 0) { float t = lds[0];
#pragma unroll
    for (int i = 1; i < 8; ++i) t = fmaxf(t, lds[i]);
    part[bid] = t; }
  __syncthreads();
}
__device__ float amax_reduce(const float* part, float* lds, int nb) {
  float m = 0.f;
  for (int i = tidx(); i < nb; i += 512) m = fmaxf(m, part[i]);
  m = gmax<64>(m);
  __syncthreads();
  if ((tidx() & 63) == 0) lds[tidx() >> 6] = m;
  __syncthreads();
  float t = lds[0];
#pragma unroll
  for (int i = 1; i < 8; ++i) t = fmaxf(t, lds[i]);
  return t;
}
__device__ void cvt_rows(const float* src, bf16_t* dst, size_t n, const float* gain, int ncols, int bid, int nb) {
  const size_t n4 = n / 4, step = (size_t)nb * 512;
  for (size_t i0 = (size_t)bid * 512 + tidx(); i0 < n4; i0 += 4 * step) {
    float4 v[4];
#pragma unroll
    for (int u = 0; u < 4; ++u) { const size_t i = i0 + u * step; if (i < n4) v[u] = ((const float4*)src)[i]; }
#pragma unroll
    for (int u = 0; u < 4; ++u) { const size_t i = i0 + u * step; if (i < n4) {
      if (gain) { const float4 g = *(const float4*)(gain + (int)((i * 4) % (size_t)ncols)); v[u].x *= g.x; v[u].y *= g.y; v[u].z *= g.z; v[u].w *= g.w; }
      ((uint2*)dst)[i] = make_uint2(pack2(v[u].x, v[u].y), pack2(v[u].z, v[u].w)); } }
  }
}
template <bool F8OUT, class CM>
__device__ void transpose_w(const float* src, int K, int ldsrc, void* dstv, int Ndst, const float* gain, CM cm, float amax, float* lds, int bid, int nb) {
  const int tid = tidx(), tk = K / 64, ntile = (Ndst / 64) * tk, nc = tid & 63;
  const float qs = F8OUT ? 256.f / fmaxf(amax, 1e-30f) : 1.f;
  float rv[8];
#define TW_LOAD(tile) do { const int n0_ = ((tile) / tk) * 64, k0_ = ((tile) % tk) * 64, sc_ = cm(n0_ + nc); \
    _Pragma("unroll") for (int i = 0; i < 8; ++i) { const int kr = (tid >> 6) + 8 * i; float v = 0.f; if (sc_ >= 0) { v = src[(size_t)(k0_ + kr) * ldsrc + sc_]; if (gain) v *= gain[k0_ + kr]; } rv[i] = v * qs; } } while (0)
  if (bid < ntile) TW_LOAD(bid);
  for (int tile = bid; tile < ntile; tile += nb) {
    const int n0 = (tile / tk) * 64, k0 = (tile % tk) * 64;
#pragma unroll
    for (int i = 0; i < 8; ++i) lds[((tid >> 6) + 8 * i) * 65 + nc] = rv[i];
    __syncthreads();
    if (tile + nb < ntile) TW_LOAD(tile + nb);
    { const int nr = tid >> 3, ks = (tid & 7) * 8; float f[8];
#pragma unroll
      for (int j = 0; j < 8; ++j) f[j] = lds[(ks + j) * 65 + nr];
      if (F8OUT) *(uint2*)((unsigned char*)dstv + (size_t)(n0 + nr) * K + k0 + ks) = make_uint2(pack4_fp8(f[0], f[1], f[2], f[3]), pack4_fp8(f[4], f[5], f[6], f[7]));
      else *(uint4*)((bf16_t*)dstv + (size_t)(n0 + nr) * K + k0 + ks) = pack8(f); }
    __syncthreads();
  }
#undef TW_LOAD
}
struct CmIdent { __device__ int operator()(int n) const { return n; } };
struct CmWin {
  __device__ int operator()(int n) const {
    if (n < 1024) return n;
    if (n < 2048) return 2048 + (n - 1024);
    if (n < 2560) return 3088 + (n - 2048);
    if (n < 3072) return 3600 + (n - 2560);
    if (n < 4096) return 5136 + (n - 3072);
    if (n < 4352) { const int i = n - 4096; if (i < 16) return 3072 + i; if (i < 20) return 6160 + (i - 16); if (i < 24) return 6164 + (i - 20); return -1; }
    const int j = n - 4352; if (j < 1024) return 1024 + j;
    return 4112 + (j - 1024);
  }
};
__device__ void prep_wq(const Params& p, const WS& w, float* lds, int bid, int nb) {
  const int tid = tidx();
  float* SKs = lds;
  float* WQs = lds + 128 * 132;
  for (int item = bid; item < 16 * 32; item += nb) {
    const int hp = item >> 5, k0 = (item & 31) * 64;
#pragma unroll
    for (int i = 0; i < 8; ++i) { const int e4 = tid + 512 * i, key = e4 >> 5, d4 = (e4 & 31) * 4; *(float4*)(SKs + key * 132 + d4) = *(const float4*)(p.sub_keys + (size_t)hp * 16384 + key * 128 + d4); }
#pragma unroll
    for (int i = 0; i < 4; ++i) { const int e4 = tid + 512 * i, kr = e4 >> 5, d4 = (e4 & 31) * 4; float4 v = *(const float4*)(p.peer_query + (size_t)(k0 + kr) * 2048 + hp * 128 + d4); const float g = p.norm_ffn[k0 + kr]; v.x *= g; v.y *= g; v.z *= g; v.w *= g; *(float4*)(WQs + kr * 132 + d4) = v; }
    __syncthreads();
    const int k = tid & 63, kg = tid >> 6;
    float acc[16];
#pragma unroll
    for (int j = 0; j < 16; ++j) acc[j] = 0.f;
    for (int d4 = 0; d4 < 32; ++d4) {
      const float4 a = *(const float4*)(WQs + k * 132 + d4 * 4);
#pragma unroll
      for (int j = 0; j < 16; ++j) { const float4 s = *(const float4*)(SKs + (kg * 16 + j) * 132 + d4 * 4); acc[j] += a.x * s.x + a.y * s.y + a.z * s.z + a.w * s.w; }
    }
#pragma unroll
    for (int j = 0; j < 16; ++j) w.wq[(size_t)(hp * 128 + kg * 16 + j) * 2048 + k0 + k] = f2bf(acc[j]);
    __syncthreads();
  }
}

#ifndef PEER_SLW
#define PEER_SLW 256
#endif
constexpr int SLW = PEER_SLW, LPR = SLW / 16, EPI = 64 / LPR, NSL = 2048 / SLW, SPL = NSL / 8, NIT = 128 / EPI;
template <bool SIGNED>
__device__ void quant_rows(const float* src, const float* gain, unsigned char* dst, float* scale, int bid, int nb) {
  const int tid = tidx(), wave = tid >> 6, lane = tid & 63;
  for (int row0 = (bid * 8 + wave) * 2; row0 < 16384; row0 += nb * 16) {
    float4 f4[2][8];
#pragma unroll
    for (int rr = 0; rr < 2; ++rr)
#pragma unroll
      for (int i = 0; i < 2; ++i)
#pragma unroll
        for (int q = 0; q < 4; ++q) f4[rr][i * 4 + q] = *(const float4*)(src + (size_t)(row0 + rr) * 2048 + i * 1024 + lane * 16 + q * 4);
#pragma unroll
    for (int rr = 0; rr < 2; ++rr) { const int row = row0 + rr; float f[32]; float mx = 0.f;
#pragma unroll
      for (int i = 0; i < 2; ++i)
#pragma unroll
        for (int q = 0; q < 4; ++q) { float4 v = f4[rr][i * 4 + q];
          if (gain) { const float4 g = *(const float4*)(gain + i * 1024 + lane * 16 + q * 4); v.x *= g.x; v.y *= g.y; v.z *= g.z; v.w *= g.w; }
          f[i * 16 + q * 4] = v.x; f[i * 16 + q * 4 + 1] = v.y; f[i * 16 + q * 4 + 2] = v.z; f[i * 16 + q * 4 + 3] = v.w;
          mx = fmaxf(mx, fmaxf(fmaxf(fabsf(v.x), fabsf(v.y)), fmaxf(fabsf(v.z), fabsf(v.w)))); }
      mx = gmax<64>(mx);
      const float sc = fmaxf(mx, 1e-30f) * (1.f / 127.f), inv = 1.f / sc;
#pragma unroll
      for (int i = 0; i < 2; ++i) { unsigned wd[4];
#pragma unroll
        for (int q = 0; q < 4; ++q) { unsigned x = 0;
#pragma unroll
          for (int j = 0; j < 4; ++j) { const int v = (int)rintf(f[i * 16 + q * 4 + j] * inv) + (SIGNED ? 0 : 128); x |= ((unsigned)v & 0xffu) << (8 * j); }
          wd[q] = x; }
        const int el = i * 1024 + lane * 16;
        *(uint4*)(dst + ((size_t)(el / SLW) * 16384 + row) * SLW + (el % SLW)) = make_uint4(wd[0], wd[1], wd[2], wd[3]); }
      if (lane == 0) scale[row] = sc; }
  }
}
__device__ void phase_prep(const Params& p, const WS& w, float* lds, int bid, int nb) {
  prep_x(p, w, bid, nb);
#if F8_IN
  absmax_w(p.w_in, (size_t)2048 * 6168, p.norm_mix, 6168, w.ctlf + 1024, lds, bid, nb);
#else
  transpose_w<false>(p.w_in, 2048, 6168, w.win, 6400, p.norm_mix, CmWin(), 0.f, lds, bid, nb);
#endif
#if F8_OUT
  absmax_w(p.w_out, (size_t)2048 * 2048, nullptr, 2048, w.ctlf + 2048, lds, bid, nb);
#else
  transpose_w<false>(p.w_out, 2048, 2048, w.wout, 2048, nullptr, CmIdent(), 0.f, lds, bid, nb);
#endif
#if F8_GATE
  absmax_w(p.w_ple_gate, (size_t)2048 * 2048, p.norm_ple, 2048, w.ctlf + 3072, lds, bid, nb);
#else
  transpose_w<false>(p.w_ple_gate, 2048, 2048, w.wg, 2048, p.norm_ple, CmIdent(), 0.f, lds, bid, nb);
#endif
  cvt_rows(p.p, w.pb, (size_t)T * 256, nullptr, 256, bid, nb);
  quant_rows<true>(p.peer_u, p.norm_ffn, w.u8, w.usc, bid, nb);
  quant_rows<true>(p.peer_v, nullptr, w.v8, w.vsc, bid, nb);
  transpose_w<false>(p.w_ple, 256, 2048, w.wple, 2048, nullptr, CmIdent(), 0.f, lds, bid, nb);
  prep_wq(p, w, lds, bid, nb);
  for (int i = bid * 512 + tidx(); i < T; i += nb * 512) { w.ssq2[i] = 0.f; w.ssq3[i] = 0.f; w.ssq4[i] = 0.f; }
}
__device__ void phase_prep2(const Params& p, const WS& w, float* lds, int bid, int nb) {
#if F8_IN
  { const float a0 = amax_reduce(w.ctlf + 1024, lds, nb); if (bid == 0 && tidx() == 0) w.ctlf[0] = a0; __syncthreads();
    transpose_w<true>(p.w_in, 2048, 6168, w.winq, 6400, p.norm_mix, CmWin(), a0, lds, bid, nb); }
#endif
#if F8_OUT
  { const float a1 = amax_reduce(w.ctlf + 2048, lds, nb); if (bid == 0 && tidx() == 0) w.ctlf[1] = a1; __syncthreads();
    transpose_w<true>(p.w_out, 2048, 2048, w.woutq, 2048, nullptr, CmIdent(), a1, lds, bid, nb); }
#endif
#if F8_GATE
  { const float a2 = amax_reduce(w.ctlf + 3072, lds, nb); if (bid == 0 && tidx() == 0) w.ctlf[2] = a2; __syncthreads();
    transpose_w<true>(p.w_ple_gate, 2048, 2048, w.wgq, 2048, p.norm_ple, CmIdent(), a2, lds, bid, nb); }
#endif
}

struct EpiProjN { bf16_t* out; const float* rstd; float ws; static constexpr bool ROWSUM = false;
  __device__ __forceinline__ float store8(int r, int c, const float* v) const { const float s = F8_IN ? ws : rstd[r]; float f[8];
#pragma unroll
    for (int j = 0; j < 8; ++j) f[j] = v[j] * s;
    *(uint4*)(out + (size_t)r * NPROJ + c) = pack8(f); return 0.f; }
  __device__ __forceinline__ void rowsum(int, float) const {} };
struct EpiProjT { bf16_t* out; const float* rstd; float ws; static constexpr bool ROWSUM = false;
  __device__ __forceinline__ float store8(int r, int c, const float* v) const { const float4 s0 = F8_IN ? make_float4(ws, ws, ws, ws) : *(const float4*)(rstd + c), s1 = F8_IN ? s0 : *(const float4*)(rstd + c + 4); float f[8];
    f[0] = v[0] * s0.x; f[1] = v[1] * s0.y; f[2] = v[2] * s0.z; f[3] = v[3] * s0.w; f[4] = v[4] * s1.x; f[5] = v[5] * s1.y; f[6] = v[6] * s1.z; f[7] = v[7] * s1.w;
    *(uint4*)(out + (size_t)r * T + c) = pack8(f); return 0.f; }
  __device__ __forceinline__ void rowsum(int, float) const {} };
struct EpiOut { const float* x; bf16_t* h1b; float* ssq; float ws; static constexpr bool ROWSUM = true;
  __device__ __forceinline__ float store8(int r, int c, const float* v) const { const float4 x0 = *(const float4*)(x + (size_t)r * D + c), x1 = *(const float4*)(x + (size_t)r * D + c + 4); float f[8];
    f[0] = v[0] * ws + x0.x; f[1] = v[1] * ws + x0.y; f[2] = v[2] * ws + x0.z; f[3] = v[3] * ws + x0.w; f[4] = v[4] * ws + x1.x; f[5] = v[5] * ws + x1.y; f[6] = v[6] * ws + x1.z; f[7] = v[7] * ws + x1.w;
    float s = 0.f;
#pragma unroll
    for (int j = 0; j < 8; ++j) s += f[j] * f[j];
    *(uint4*)(h1b + (size_t)r * D + c) = pack8(f); return s; }
  __device__ __forceinline__ void rowsum(int r, float s) const { atomicAdd(ssq + r, s); } };
struct EpiScore { bf16_t* sc; const float* ssq; static constexpr bool ROWSUM = false;
  __device__ __forceinline__ float store8(int r, int c, const float* v) const { const float s = rsqrtf(ssq[r] * (1.f / D) + EPS); float f[8];
#pragma unroll
    for (int j = 0; j < 8; ++j) f[j] = v[j] * s;
    *(uint4*)(sc + (size_t)r * D + c) = pack8(f); return 0.f; }
  __device__ __forceinline__ void rowsum(int, float) const {} };
struct EpiPl { bf16_t* pl; static constexpr bool ROWSUM = false;
  __device__ __forceinline__ float store8(int r, int c, const float* v) const { *(uint4*)(pl + (size_t)r * D + c) = pack8(v); return 0.f; }
  __device__ __forceinline__ void rowsum(int, float) const {} };
struct EpiGate { const bf16_t* h2b; const bf16_t* pl; const float* ssq3; float* out; float* ssq; const float* ssq2; float ws; static constexpr bool ROWSUM = true;
  __device__ __forceinline__ float store8(int r, int c, const float* v) const { const float rs = rsqrtf(ssq3[r] * (1.f / D) + EPS) * (F8_GATE ? ws * sqrtf(ssq2[r] * (1.f / D) + EPS) : 1.f); float h[8], q[8], f[8];
    unpack8(*(const uint4*)(h2b + (size_t)r * D + c), h); unpack8(*(const uint4*)(pl + (size_t)r * D + c), q);
    float s = 0.f;
#pragma unroll
    for (int j = 0; j < 8; ++j) { f[j] = h[j] + sigmoidf_(v[j] * rs) * q[j]; s += f[j] * f[j]; }
    *(float4*)(out + (size_t)r * D + c) = make_float4(f[0], f[1], f[2], f[3]); *(float4*)(out + (size_t)r * D + c + 4) = make_float4(f[4], f[5], f[6], f[7]); return s; }
  __device__ __forceinline__ void rowsum(int r, float s) const { atomicAdd(ssq + r, s); } };

template <class Epi>
__device__ void gemm_naive(const bf16_t* A, const bf16_t* Bt, int M, int N, int K, const Epi& E, float* lds, int bid, int nb) {
  const int tid = tidx(), ty = tid >> 4, tx = tid & 15;
  float* As = lds;
  float* Bs = lds + 32 * 132;
  const int nM = M / 128, nN = N / 128;
  for (int tile = bid; tile < nM * nN; tile += nb) {
    const int m0 = (tile % nM) * 128, n0 = (tile / nM) * 128;
    float acc[4][8];
#pragma unroll
    for (int i = 0; i < 4; ++i)
#pragma unroll
      for (int j = 0; j < 8; ++j) acc[i][j] = 0.f;
    const int lr = tid >> 2, lk = (tid & 3) * 8;
    for (int k0 = 0; k0 < K; k0 += 32) {
      const uint4 av = *(const uint4*)(A + (size_t)(m0 + lr) * K + k0 + lk);
      const uint4 bv = *(const uint4*)(Bt + (size_t)(n0 + lr) * K + k0 + lk);
      float af[8], bf[8]; unpack8(av, af); unpack8(bv, bf);
      __syncthreads();
#pragma unroll
      for (int j = 0; j < 8; ++j) { As[(lk + j) * 132 + lr] = af[j]; Bs[(lk + j) * 132 + lr] = bf[j]; }
      __syncthreads();
#pragma unroll 8
      for (int kk = 0; kk < 32; ++kk) {
        const float4 a = *(const float4*)(As + kk * 132 + ty * 4);
        const float4 b0 = *(const float4*)(Bs + kk * 132 + tx * 8), b1 = *(const float4*)(Bs + kk * 132 + tx * 8 + 4);
        const float aa[4] = {a.x, a.y, a.z, a.w}; const float bb[8] = {b0.x, b0.y, b0.z, b0.w, b1.x, b1.y, b1.z, b1.w};
#pragma unroll
        for (int i = 0; i < 4; ++i)
#pragma unroll
          for (int j = 0; j < 8; ++j) acc[i][j] += aa[i] * bb[j];
      }
    }
#pragma unroll
    for (int i = 0; i < 4; ++i) {
      const int r = m0 + ty * 4 + i;
      float s = E.store8(r, n0 + tx * 8, acc[i]);
      if (Epi::ROWSUM) { s = gsum<16>(s); if (tx == 0) E.rowsum(r, s); }
    }
  }
}


namespace pg8 {
#define PG8_LAS __attribute__((address_space(3)))
typedef short bf16x8 __attribute__((ext_vector_type(8)));
typedef float f32x4 __attribute__((ext_vector_type(4)));
typedef int v4i_t __attribute__((ext_vector_type(4)));
typedef int v8i_t __attribute__((ext_vector_type(8)));
constexpr int BM = 256, BK = 64, HALF = 128, HTB = HALF * BK * 2, STAGE_BYTES = 8 * HTB, NXCD = 8, WGM = 8;
__host__ __device__ __forceinline__ int lds_byte(int r, int c) { const int st = (r >> 4) * 2 + (c >> 5), rr = r & 15, cc = c & 31, ob = rr * 64 + cc * 2; return st * 1024 + (ob ^ (((ob >> 9) & 1) << 5)); }
__host__ __device__ __forceinline__ void stage_rc(int b, int& R, int& C) { const int st = b / 1024, sb = b % 1024, swz = sb ^ (((sb >> 9) & 1) << 5); R = (st >> 1) * 16 + swz / 64; C = (st & 1) * 32 + (swz % 64) / 2; }
__host__ __device__ __forceinline__ int perm32(int rho) { const int n = rho >> 4, i = rho & 15; return 8 * (i >> 2) + 4 * n + (i & 3); }
struct Unit { int pm, pn; };
struct Gemm { const bf16_t* A; const bf16_t* Bt; int M, N, K; };
struct StaticOrder {
    int nM, nN, nwg, G, c;
    __host__ __device__ void init(int M, int N, int G_, int c_) { nM = M / BM; nN = N / BM; nwg = nM * nN; G = G_; c = c_; }
    __host__ __device__ bool next(int i, Unit& u) const {
        const long L = (long)i * G + c; if (L >= nwg) return false;
        int wgid = (int)L; { const int q = nwg / NXCD, r = nwg % NXCD, xcd = wgid % NXCD, off = wgid / NXCD; wgid = (xcd < r ? xcd * (q + 1) : r * (q + 1) + (xcd - r) * q) + off; }
        const int nig = WGM * nN, gid = wgid / nig, fm = gid * WGM, gsz = (nM - fm) < WGM ? (nM - fm) : WGM;
        u.pm = fm + ((wgid % nig) % gsz); u.pn = (wgid % nig) / gsz; return true;
    }
    __device__ __forceinline__ void a_ready(const Unit&) const {}
    __device__ __forceinline__ void done(const Unit&) const {}
};
template <class E8> struct EpiA {
    static constexpr bool PERM = true, AFTER_DRAIN = false;
    E8 e;
    __device__ __forceinline__ void operator()(const f32x4 (&acc)[2][2][4][2], const Unit& u, int wr, int wc, int fr, int fq) const {
        asm volatile("" : "+v"(fr), "+v"(fq));
        const int row0 = u.pm * BM + wr * 64 + fr, col0 = u.pn * BM + wc * 32 + 8 * fq;
#pragma unroll
        for (int ai = 0; ai < 2; ++ai)
#pragma unroll
            for (int m = 0; m < 4; ++m) { const int r = row0 + ai * HALF + m * 16; float s = 0.f;
#pragma unroll
                for (int bj = 0; bj < 2; ++bj) { const float v[8] = {acc[ai][bj][m][0][0], acc[ai][bj][m][0][1], acc[ai][bj][m][0][2], acc[ai][bj][m][0][3], acc[ai][bj][m][1][0], acc[ai][bj][m][1][1], acc[ai][bj][m][1][2], acc[ai][bj][m][1][3]};
                    s += e.store8(r, col0 + bj * HALF, v); }
                if (E8::ROWSUM) { s += sxor<16>(s); s += sxor<32>(s); if (fq == 0) e.rowsum(r, s); }
                asm volatile("" ::: "memory"); }
    }
    __device__ __forceinline__ void fused(f32x4 (&)[2][2][4][2], const Unit&, int, int, int, int, PG8_LAS unsigned char*, int, int) const {}
};
template <class Epi, class Sched, bool ALIGN_EPI = false, bool SP2 = false, bool F8 = false>
__device__ __forceinline__ void gemm_phase(PG8_LAS unsigned char* lds, const Gemm g, const Sched& S, const Epi& E) {
    int tid_ = threadIdx.x; asm volatile("" : "+v"(tid_));
    const int tid = tid_, wid = __builtin_amdgcn_readfirstlane(tid >> 6), lane = tid & 63, wr = wid >> 2, wc = wid & 3, fr = lane & 15, fq = lane >> 4;
    const int K = g.K, nt = K / BK;
    unsigned voffA[2], voffB[2];
#pragma unroll
    for (int i = 0; i < 2; ++i) { int R, C; stage_rc(tid * 16 + i * 8192, R, C); const int Rb = Epi::PERM ? ((R & ~31) + perm32(R & 31)) : R;
        voffA[i] = (unsigned)(R * K + C) * 2u; voffB[i] = (unsigned)(Rb * K + C) * 2u; }
    const size_t kstep = (size_t)(BK * 2);
    const size_t hstep = (size_t)HALF * K * 2;
    const size_t tstep = 2 * hstep;
    const unsigned ldsw = (unsigned)wid * 1024u;
    const int aoff = lds_byte(wr * 64 + fr, fq * 8), boff = lds_byte(wc * 32 + fr, fq * 8);
#define PG8_SA(b, h) (((b) * 2 + (h)) * HTB)
#define PG8_SB(b, h) ((4 + (b) * 2 + (h)) * HTB)
#define PG8_STAGE(bufoff, gbase, voff) do { _Pragma("unroll") for (int _i = 0; _i < 2; ++_i) \
        __builtin_amdgcn_global_load_lds((const unsigned*)((const char*)(gbase) + (voff)[_i]), (PG8_LAS unsigned*)(lds + (bufoff) + ldsw + _i * 8192), 16, 0, 0); } while (0)
#define PG8_LDA(dst, b, h) do { _Pragma("unroll") for (int m = 0; m < 4; ++m) { const v4i_t lo_ = *(const PG8_LAS v4i_t*)(lds + PG8_SA(b, h) + aoff + m * 2048), hi_ = *(const PG8_LAS v4i_t*)(lds + PG8_SA(b, h) + aoff + m * 2048 + 1024); dst[m] = __builtin_shufflevector(lo_, hi_, 0, 1, 2, 3, 4, 5, 6, 7); } } while (0)
#define PG8_LDB(dst, b, h) do { _Pragma("unroll") for (int n = 0; n < 2; ++n) { const v4i_t lo_ = *(const PG8_LAS v4i_t*)(lds + PG8_SB(b, h) + boff + n * 2048), hi_ = *(const PG8_LAS v4i_t*)(lds + PG8_SB(b, h) + boff + n * 2048 + 1024); dst[n] = __builtin_shufflevector(lo_, hi_, 0, 1, 2, 3, 4, 5, 6, 7); } } while (0)
#define PG8_MMA(ai, bj, At, Bt) do { __builtin_amdgcn_s_setprio(1); \
        if constexpr (F8) { asm volatile("s_nop 1\n\t" \
            "v_mfma_scale_f32_16x16x128_f8f6f4 %0, %12, %8, %0, %14, %14 op_sel_hi:[0,0,0]\n\t"  "v_mfma_scale_f32_16x16x128_f8f6f4 %1, %13, %8, %1, %14, %14 op_sel_hi:[0,0,0]\n\t" \
            "v_mfma_scale_f32_16x16x128_f8f6f4 %2, %12, %9, %2, %14, %14 op_sel_hi:[0,0,0]\n\t"  "v_mfma_scale_f32_16x16x128_f8f6f4 %3, %13, %9, %3, %14, %14 op_sel_hi:[0,0,0]\n\t" \
            "v_mfma_scale_f32_16x16x128_f8f6f4 %4, %12, %10, %4, %14, %14 op_sel_hi:[0,0,0]\n\t" "v_mfma_scale_f32_16x16x128_f8f6f4 %5, %13, %10, %5, %14, %14 op_sel_hi:[0,0,0]\n\t" \
            "v_mfma_scale_f32_16x16x128_f8f6f4 %6, %12, %11, %6, %14, %14 op_sel_hi:[0,0,0]\n\t" "v_mfma_scale_f32_16x16x128_f8f6f4 %7, %13, %11, %7, %14, %14 op_sel_hi:[0,0,0]" \
            : "+v"(acc[ai][bj][0][0]), "+v"(acc[ai][bj][0][1]), "+v"(acc[ai][bj][1][0]), "+v"(acc[ai][bj][1][1]), "+v"(acc[ai][bj][2][0]), "+v"(acc[ai][bj][2][1]), "+v"(acc[ai][bj][3][0]), "+v"(acc[ai][bj][3][1]) \
            : "v"(At[0]), "v"(At[1]), "v"(At[2]), "v"(At[3]), "v"(Bt[0]), "v"(Bt[1]), "v"(one_scale)); } \
        else { _Pragma("unroll") for (int m = 0; m < 4; ++m) _Pragma("unroll") for (int n = 0; n < 2; ++n) { \
            acc[ai][bj][m][n] = __builtin_amdgcn_mfma_f32_16x16x32_bf16(__builtin_bit_cast(bf16x8, __builtin_shufflevector(Bt[n], Bt[n], 0, 1, 2, 3)), __builtin_bit_cast(bf16x8, __builtin_shufflevector(At[m], At[m], 0, 1, 2, 3)), acc[ai][bj][m][n], 0, 0, 0); \
            acc[ai][bj][m][n] = __builtin_amdgcn_mfma_f32_16x16x32_bf16(__builtin_bit_cast(bf16x8, __builtin_shufflevector(Bt[n], Bt[n], 4, 5, 6, 7)), __builtin_bit_cast(bf16x8, __builtin_shufflevector(At[m], At[m], 4, 5, 6, 7)), acc[ai][bj][m][n], 0, 0, 0); } } \
        __builtin_amdgcn_s_setprio(0); } while (0)
#define PG8_MFMA_DRAIN() do { if constexpr (F8) asm volatile("s_nop 15\n\ts_nop 15\n\ts_nop 15" ::: "memory"); } while (0)
#define PG8_WAIT_V(n) asm volatile("s_waitcnt vmcnt(" #n ")" ::: "memory")
#define PG8_WAIT_L(n) asm volatile("s_waitcnt lgkmcnt(" #n ")" ::: "memory")
#define PG8_BAR __builtin_amdgcn_s_barrier()
#define PG8_SCHED __builtin_amdgcn_sched_barrier(0)
    Unit cur, nxt; int ui = 0;
    if (!S.next(0, cur)) return;
    f32x4 acc[2][2][4][2];
#pragma unroll
    for (int a = 0; a < 2; ++a)
#pragma unroll
        for (int b = 0; b < 2; ++b)
#pragma unroll
            for (int m = 0; m < 4; ++m)
#pragma unroll
                for (int n = 0; n < 2; ++n) acc[a][b][m][n] = (f32x4){0.f, 0.f, 0.f, 0.f};
    const int one_scale = 0x7f7f7f7f;
    v8i_t At[4], B0[2], B1[2];
    const char* cA = (const char*)g.A + (size_t)cur.pm * tstep; const char* cB = (const char*)g.Bt + (size_t)cur.pn * tstep;
    S.a_ready(cur);
    if constexpr (SP2) {
        PG8_STAGE(PG8_SB(0, 0), cB, voffB); PG8_STAGE(PG8_SB(0, 1), cB + hstep, voffB); PG8_STAGE(PG8_SA(0, 0), cA, voffA); PG8_STAGE(PG8_SA(0, 1), cA + hstep, voffA);
        if (wr == 1) PG8_BAR;
        PG8_WAIT_V(2); PG8_BAR;
        PG8_STAGE(PG8_SB(1, 0), cB + kstep, voffB); PG8_STAGE(PG8_SA(1, 0), cA + kstep, voffA); PG8_STAGE(PG8_SB(1, 1), cB + hstep + kstep, voffB);
        PG8_WAIT_V(6); PG8_BAR;
    } else {
        PG8_STAGE(PG8_SB(0, 0), cB, voffB); PG8_STAGE(PG8_SA(0, 0), cA, voffA); PG8_STAGE(PG8_SB(0, 1), cB + hstep, voffB); PG8_STAGE(PG8_SA(0, 1), cA + hstep, voffA);
        if (wr == 1) PG8_BAR;
        PG8_WAIT_V(4); PG8_BAR;
        PG8_STAGE(PG8_SB(1, 0), cB + kstep, voffB); PG8_STAGE(PG8_SA(1, 0), cA + kstep, voffA); PG8_STAGE(PG8_SB(1, 1), cB + hstep + kstep, voffB);
        PG8_WAIT_V(6); PG8_BAR;
    }
    for (;;) {
        const bool has_next = S.next(ui + 1, nxt);
        const char* nA = has_next ? (const char*)g.A + (size_t)nxt.pm * tstep : cA; const char* nB = has_next ? (const char*)g.Bt + (size_t)nxt.pn * tstep : cB;
        for (int t = 0; t < nt; t += 2) {
            const bool last = (t == nt - 2);
            const char* a1 = cA + (size_t)(t + 1) * kstep;
            const char* a2 = last ? nA : cA + (size_t)(t + 2) * kstep; const char* b2 = last ? nB : cB + (size_t)(t + 2) * kstep;
            const char* a3 = a2 + kstep; const char* b3 = b2 + kstep;
            if (last && has_next) S.a_ready(nxt);
            if constexpr (SP2) {
            PG8_LDB(B0, 0, 0); PG8_LDB(B1, 0, 1); PG8_SCHED; PG8_LDA(At, 0, 0); PG8_STAGE(PG8_SA(1, 1), a1 + hstep, voffA);
            PG8_WAIT_V(8); PG8_WAIT_L(0); PG8_BAR; PG8_MMA(0, 0, At, B0); PG8_MMA(0, 1, At, B1); PG8_BAR; PG8_SCHED;
            PG8_LDA(At, 0, 1); PG8_STAGE(PG8_SB(0, 0), b2, voffB); PG8_STAGE(PG8_SB(0, 1), b2 + hstep, voffB); PG8_STAGE(PG8_SA(0, 0), a2, voffA);
            PG8_WAIT_V(8); PG8_WAIT_L(0); PG8_BAR; PG8_MMA(1, 0, At, B0); PG8_MMA(1, 1, At, B1); PG8_BAR; PG8_SCHED;
            PG8_LDB(B0, 1, 0); PG8_LDB(B1, 1, 1); PG8_SCHED; PG8_LDA(At, 1, 0); PG8_STAGE(PG8_SA(0, 1), a2 + hstep, voffA);
            PG8_WAIT_V(8); PG8_WAIT_L(0); PG8_BAR; PG8_MMA(0, 0, At, B0); PG8_MMA(0, 1, At, B1); PG8_BAR; PG8_SCHED;
            PG8_LDA(At, 1, 1); PG8_STAGE(PG8_SB(1, 0), b3, voffB); PG8_STAGE(PG8_SB(1, 1), b3 + hstep, voffB); PG8_STAGE(PG8_SA(1, 0), a3, voffA);
            PG8_WAIT_V(8); PG8_WAIT_L(0); PG8_BAR; PG8_MMA(1, 0, At, B0); PG8_MMA(1, 1, At, B1); PG8_BAR; PG8_SCHED;
            } else {
            PG8_LDB(B0, 0, 0); PG8_SCHED; PG8_LDA(At, 0, 0); PG8_STAGE(PG8_SA(1, 1), a1 + hstep, voffA);
            PG8_WAIT_L(8); PG8_BAR; PG8_WAIT_L(0); PG8_MMA(0, 0, At, B0); PG8_BAR; PG8_SCHED;
            PG8_LDB(B1, 0, 1); PG8_STAGE(PG8_SB(0, 0), b2, voffB);
            PG8_BAR; PG8_WAIT_L(0); PG8_MMA(0, 1, At, B1); PG8_BAR;
            PG8_LDA(At, 0, 1); PG8_STAGE(PG8_SA(0, 0), a2, voffA);
            PG8_BAR; PG8_WAIT_L(0); PG8_MMA(1, 0, At, B0); PG8_BAR; PG8_SCHED;
            PG8_STAGE(PG8_SB(0, 1), b2 + hstep, voffB);
            PG8_WAIT_V(6); PG8_BAR; PG8_MMA(1, 1, At, B1); PG8_BAR;
            PG8_LDB(B0, 1, 0); PG8_SCHED; PG8_LDA(At, 1, 0); PG8_STAGE(PG8_SA(0, 1), a2 + hstep, voffA);
            PG8_WAIT_L(8); PG8_BAR; PG8_WAIT_L(0); PG8_MMA(0, 0, At, B0); PG8_BAR; PG8_SCHED;
            PG8_LDB(B1, 1, 1); PG8_STAGE(PG8_SB(1, 0), b3, voffB);
            PG8_BAR; PG8_WAIT_L(0); PG8_MMA(0, 1, At, B1); PG8_BAR;
            PG8_LDA(At, 1, 1); PG8_STAGE(PG8_SA(1, 0), a3, voffA);
            PG8_BAR; PG8_WAIT_L(0); PG8_MMA(1, 0, At, B0); PG8_BAR; PG8_SCHED;
            PG8_STAGE(PG8_SB(1, 1), b3 + hstep, voffB);
            PG8_WAIT_V(6); PG8_BAR; PG8_MMA(1, 1, At, B1); PG8_BAR;
            }
        }
        if constexpr (ALIGN_EPI) { if (wr == 0) PG8_BAR; }
        PG8_MFMA_DRAIN();
        if constexpr (!Epi::AFTER_DRAIN) { E(acc, cur, wr, wc, fr, fq); S.done(cur); }
        if (!has_next) break;
#pragma unroll
        for (int a = 0; a < 2; ++a)
#pragma unroll
            for (int b = 0; b < 2; ++b)
#pragma unroll
                for (int m = 0; m < 4; ++m)
#pragma unroll
                    for (int n = 0; n < 2; ++n) acc[a][b][m][n] = (f32x4){0.f, 0.f, 0.f, 0.f};
        cur = nxt; cA = nA; cB = nB; ++ui;
        if constexpr (ALIGN_EPI) { if (wr == 1) PG8_BAR; }
    }
    PG8_WAIT_V(0);
    if constexpr (!ALIGN_EPI) { if (wr == 0) PG8_BAR; }
    PG8_BAR;
    if constexpr (Epi::AFTER_DRAIN) { E.fused(acc, cur, wr, wc, fr, fq, lds, wid, lane); S.done(cur); }
#undef PG8_SA
#undef PG8_SB
#undef PG8_STAGE
#undef PG8_LDA
#undef PG8_LDB
#undef PG8_MMA
#undef PG8_MFMA_DRAIN
#undef PG8_WAIT_V
#undef PG8_WAIT_L
#undef PG8_BAR
#undef PG8_SCHED
}
}

#ifndef FAST_GEMM
#define FAST_GEMM 1
#endif
template <bool F8 = false, class E8>
__device__ __forceinline__ void gemm_any(const void* A, const void* Bt, int M, int N, int K, const E8& E, float* lds, int bid, int nb) {
#if FAST_GEMM
  pg8::Gemm g{(const bf16_t*)A, (const bf16_t*)Bt, M, N, F8 ? K / 2 : K}; pg8::StaticOrder S; S.init(M, N, nb, bid);
  pg8::EpiA<E8> EA{E};
  pg8::gemm_phase<pg8::EpiA<E8>, pg8::StaticOrder, true, true, F8>((PG8_LAS unsigned char*)lds, g, S, EA);
#else
  gemm_naive((const bf16_t*)A, (const bf16_t*)Bt, M, N, K, E, lds, bid, nb);
#endif
}

__device__ void gla_naive(const Params& p, const WS& w, int b, int h, float* lds) {
  constexpr int CH = 16;
  const int tid = tidx(), dv = tid & 255, half = tid >> 8, wave = tid >> 6, lane = tid & 63;
  float* qf = lds; float* kf = qf + CH * 128; float* af = kf + CH * 128; float* vf = af + CH * 128; float* op = vf + CH * 256;
  float S[64];
#pragma unroll
  for (int i = 0; i < 64; ++i) S[i] = 0.f;
  const int gd = tid & 127;
  float gu[16];
#pragma unroll
  for (int r = 0; r < 16; ++r) gu[r] = p.gate_up[r * 512 + h * 128 + gd];
  const float gb = p.gate_bias[h * 128 + gd];
  const float qscale = 0.08838834764831845f;
  for (int t0 = 0; t0 < SEQ; t0 += CH) {
    const size_t tb = (size_t)b * SEQ + t0;
    { const int tok = tid >> 5, d4 = (tid & 31) * 4;
      const uint2 qv = *(const uint2*)(w.proj + (tb + tok) * NPROJ + C_GQ + h * 128 + d4);
      const uint2 kv = *(const uint2*)(w.proj + (tb + tok) * NPROJ + C_GK + h * 128 + d4);
      *(float4*)(qf + tok * 128 + d4) = make_float4(lo_f(qv.x) * qscale, hi_f(qv.x) * qscale, lo_f(qv.y) * qscale, hi_f(qv.y) * qscale);
      *(float4*)(kf + tok * 128 + d4) = make_float4(lo_f(kv.x), hi_f(kv.x), lo_f(kv.y), hi_f(kv.y)); }
    { const int dvv = tid & 255, tk8 = (tid >> 8) * 8; float f[8];
      unpack8(*(const uint4*)(w.vT + (size_t)(h * 256 + dvv) * T + tb + tk8), f);
#pragma unroll
      for (int j = 0; j < 8; ++j) vf[(tk8 + j) * 256 + dvv] = f[j]; }
#pragma unroll
    for (int i = 0; i < 4; ++i) { const int tok = (tid >> 7) * 4 + i; float z = gb; float gl[16];
      unpack8(*(const uint4*)(w.proj + (tb + tok) * NPROJ + C_SM), gl); unpack8(*(const uint4*)(w.proj + (tb + tok) * NPROJ + C_SM + 8), gl + 8);
#pragma unroll
      for (int r = 0; r < 16; ++r) z += gl[r] * gu[r];
      af[tok * 128 + gd] = __expf(logsigmoidf_(z) * (1.f / 16.f)); }
    __syncthreads();
    for (int tok = 0; tok < CH; ++tok) {
      const float vv = vf[tok * 256 + dv]; float acc = 0.f;
#pragma unroll
      for (int i4 = 0; i4 < 16; ++i4) {
        const float4 a = *(const float4*)(af + tok * 128 + half * 64 + i4 * 4), k = *(const float4*)(kf + tok * 128 + half * 64 + i4 * 4), q = *(const float4*)(qf + tok * 128 + half * 64 + i4 * 4);
        S[i4 * 4 + 0] = a.x * S[i4 * 4 + 0] + k.x * vv; acc += q.x * S[i4 * 4 + 0];
        S[i4 * 4 + 1] = a.y * S[i4 * 4 + 1] + k.y * vv; acc += q.y * S[i4 * 4 + 1];
        S[i4 * 4 + 2] = a.z * S[i4 * 4 + 2] + k.z * vv; acc += q.z * S[i4 * 4 + 2];
        S[i4 * 4 + 3] = a.w * S[i4 * 4 + 3] + k.w * vv; acc += q.w * S[i4 * 4 + 3];
      }
      op[(half * CH + tok) * 256 + dv] = acc;
    }
    __syncthreads();
#pragma unroll
    for (int i = 0; i < 2; ++i) { const int tok = wave * 2 + i;
      const float4 o0 = *(const float4*)(op + tok * 256 + lane * 4), o1 = *(const float4*)(op + (CH + tok) * 256 + lane * 4);
      const float o[4] = {o0.x + o1.x, o0.y + o1.y, o0.z + o1.z, o0.w + o1.w};
      float ss = wave_sum(o[0] * o[0] + o[1] * o[1] + o[2] * o[2] + o[3] * o[3]);
      const float rs = rsqrtf(ss * (1.f / 256.f) + EPS);
      const uint2 gg = *(const uint2*)(w.proj + (tb + tok) * NPROJ + C_GG + h * 256 + lane * 4);
      const float4 gn = *(const float4*)(p.gla_norm + h * 256 + lane * 4);
      const float y0 = o[0] * rs * gn.x * siluf_(lo_f(gg.x)), y1 = o[1] * rs * gn.y * siluf_(hi_f(gg.x)), y2 = o[2] * rs * gn.z * siluf_(lo_f(gg.y)), y3 = o[3] * rs * gn.w * siluf_(hi_f(gg.y));
      *(uint2*)(w.y + (tb + tok) * D + h * 256 + lane * 4) = make_uint2(pack2(y0, y1), pack2(y2, y3)); }
    __syncthreads();
  }
}
__device__ void mlstm_naive(const Params& p, const WS& w, int b, int h, float* lds) {
  constexpr int CH = 16;
  const int tid = tidx(), dv = tid & 255, half = tid >> 8, wave = tid >> 6, lane = tid & 63;
  float* qf = lds; float* kf = qf + CH * 128; float* vf = kf + CH * 128; float* op = vf + CH * 256; float* dn = op + 2 * CH * 256; float* gt = dn + 2 * CH * 256;
  float C[64], n[4];
#pragma unroll
  for (int i = 0; i < 64; ++i) C[i] = 0.f;
#pragma unroll
  for (int i = 0; i < 4; ++i) n[i] = 0.f;
  const int nd = half * 64 + (dv & 15) * 4;
  const float kscale = 0.08838834764831845f;
  const float ib = p.ig_bias[h], fb = p.fg_bias[h];
  for (int t0 = 0; t0 < SEQ; t0 += CH) {
    const size_t tb = (size_t)b * SEQ + t0;
    { const int tok = tid >> 5, d4 = (tid & 31) * 4;
      float qa[4], ka[4];
#pragma unroll
      for (int c = 0; c < 4; ++c) { qa[c] = p.conv_b[h * 128 + d4 + c]; ka[c] = p.conv_b[512 + h * 128 + d4 + c]; }
#pragma unroll
      for (int wi = 0; wi < 4; ++wi) { const int ts = t0 + tok - 3 + wi;
        if (ts >= 0) { const size_t tr = (size_t)b * SEQ + ts;
          const uint2 qv = *(const uint2*)(w.proj + tr * NPROJ + C_MQ + h * 128 + d4), kv = *(const uint2*)(w.proj + tr * NPROJ + C_MK + h * 128 + d4);
          const float4 cq = *(const float4*)(p.conv_w + wi * 1024 + h * 128 + d4), ck = *(const float4*)(p.conv_w + wi * 1024 + 512 + h * 128 + d4);
          qa[0] += cq.x * lo_f(qv.x); qa[1] += cq.y * hi_f(qv.x); qa[2] += cq.z * lo_f(qv.y); qa[3] += cq.w * hi_f(qv.y);
          ka[0] += ck.x * lo_f(kv.x); ka[1] += ck.y * hi_f(kv.x); ka[2] += ck.z * lo_f(kv.y); ka[3] += ck.w * hi_f(kv.y); } }
      *(float4*)(qf + tok * 128 + d4) = make_float4(siluf_(qa[0]), siluf_(qa[1]), siluf_(qa[2]), siluf_(qa[3]));
      *(float4*)(kf + tok * 128 + d4) = make_float4(siluf_(ka[0]) * kscale, siluf_(ka[1]) * kscale, siluf_(ka[2]) * kscale, siluf_(ka[3]) * kscale); }
    { const int dvv = tid & 255, tk8 = (tid >> 8) * 8; float f[8];
      unpack8(*(const uint4*)(w.vT + (size_t)(1024 + h * 256 + dvv) * T + tb + tk8), f);
#pragma unroll
      for (int j = 0; j < 8; ++j) vf[(tk8 + j) * 256 + dvv] = f[j]; }
    if (tid < CH) { const float mi = bf2f(w.proj[(tb + tid) * NPROJ + C_SM + 16 + h]), mf = bf2f(w.proj[(tb + tid) * NPROJ + C_SM + 20 + h]);
      gt[tid * 2] = __expf(mi + ib); gt[tid * 2 + 1] = sigmoidf_(mf + fb); }
    __syncthreads();
    for (int tok = 0; tok < CH; ++tok) {
      const float vv = vf[tok * 256 + dv], ig = gt[tok * 2], fg = gt[tok * 2 + 1]; float num = 0.f, den = 0.f;
#pragma unroll
      for (int i4 = 0; i4 < 16; ++i4) {
        const float4 k = *(const float4*)(kf + tok * 128 + half * 64 + i4 * 4), q = *(const float4*)(qf + tok * 128 + half * 64 + i4 * 4);
        const float kk[4] = {k.x * ig, k.y * ig, k.z * ig, k.w * ig}; const float qq[4] = {q.x, q.y, q.z, q.w};
#pragma unroll
        for (int c = 0; c < 4; ++c) { C[i4 * 4 + c] = fg * C[i4 * 4 + c] + kk[c] * vv; num += qq[c] * C[i4 * 4 + c]; }
      }
      { const float4 k = *(const float4*)(kf + tok * 128 + nd), q = *(const float4*)(qf + tok * 128 + nd);
        n[0] = fg * n[0] + k.x * ig; n[1] = fg * n[1] + k.y * ig; n[2] = fg * n[2] + k.z * ig; n[3] = fg * n[3] + k.w * ig;
        den = q.x * n[0] + q.y * n[1] + q.z * n[2] + q.w * n[3];
        den = gsum<16>(den); }
      op[(half * CH + tok) * 256 + dv] = num; if (dv == 0) dn[half * CH + tok] = den;
    }
    __syncthreads();
#pragma unroll
    for (int i = 0; i < 2; ++i) { const int tok = wave * 2 + i;
      const float4 o0 = *(const float4*)(op + tok * 256 + lane * 4), o1 = *(const float4*)(op + (CH + tok) * 256 + lane * 4);
      const float den = dn[tok] + dn[CH + tok];
      const float inv = 1.f / fmaxf(fabsf(den), 1.f);
      const float o[4] = {(o0.x + o1.x) * inv, (o0.y + o1.y) * inv, (o0.z + o1.z) * inv, (o0.w + o1.w) * inv};
      float ss = wave_sum(o[0] * o[0] + o[1] * o[1] + o[2] * o[2] + o[3] * o[3]);
      const float rs = rsqrtf(ss * (1.f / 256.f) + EPS);
      const uint2 mo = *(const uint2*)(w.proj + (tb + tok) * NPROJ + C_MO + h * 256 + lane * 4);
      const float4 gn = *(const float4*)(p.mlstm_norm + h * 256 + lane * 4);
      const float y0 = o[0] * rs * gn.x * sigmoidf_(lo_f(mo.x)), y1 = o[1] * rs * gn.y * sigmoidf_(hi_f(mo.x)), y2 = o[2] * rs * gn.z * sigmoidf_(lo_f(mo.y)), y3 = o[3] * rs * gn.w * sigmoidf_(hi_f(mo.y));
      *(uint2*)(w.y + (tb + tok) * D + 1024 + h * 256 + lane * 4) = make_uint2(pack2(y0, y1), pack2(y2, y3)); }
    __syncthreads();
  }
}
__device__ void phase_mixer_naive(const Params& p, const WS& w, float* lds, int bid, int nb) {
  for (int item = bid; item < 16; item += nb) {
    if (item < 8) gla_naive(p, w, item >> 2, item & 3, lds); else mlstm_naive(p, w, (item - 8) >> 2, item & 3, lds);
    __syncthreads();
  }
}


typedef short bf16x8 __attribute__((ext_vector_type(8)));
typedef float f32x4 __attribute__((ext_vector_type(4)));
#define MFMA16(a, b, c) __builtin_amdgcn_mfma_f32_16x16x32_bf16(a, b, c, 0, 0, 0)
constexpr int L_GLR = 0, L_TOT = 4096, L_F = 6144, L_DEN = 6656, L_PART = 6912, L_QS = 9216, L_KS = 26624, L_P = 44032, L_NL = 53248, L_KDT = 9216;
constexpr int QS_LD = 136, P_LD = 72, KDT_LD = 72;

__device__ __forceinline__ void gla_gates(const Params& p, const WS& w, int h, size_t tb, unsigned char* ldsb, int tid, float* bv, float& blast) {
  float* glrs = (float*)(ldsb + L_GLR); float* tot = (float*)(ldsb + L_TOT);
  const int d = tid & 127, tg = tid >> 7;
  if (tid < 128) { float f[8]; unpack8(*(const uint4*)(w.proj + (tb + (tid >> 1)) * NPROJ + C_SM + (tid & 1) * 8), f);
#pragma unroll
    for (int j = 0; j < 8; ++j) glrs[(tid >> 1) * 16 + (tid & 1) * 8 + j] = f[j]; }
  float gu[16];
#pragma unroll
  for (int r = 0; r < 16; ++r) gu[r] = p.gate_up[r * 512 + h * 128 + d];
  const float gb = p.gate_bias[h * 128 + d];
  __syncthreads();
  float run = 0.f;
#pragma unroll
  for (int i = 0; i < 16; ++i) { const float* gl = glrs + (tg * 16 + i) * 16; float z = gb;
#pragma unroll
    for (int r4 = 0; r4 < 4; ++r4) { const float4 g4 = *(const float4*)(gl + r4 * 4); z += g4.x * gu[r4 * 4] + g4.y * gu[r4 * 4 + 1] + g4.z * gu[r4 * 4 + 2] + g4.w * gu[r4 * 4 + 3]; }
    run += logsigmoidf_(z) * (1.f / 16.f); bv[i] = run; }
  tot[tg * 128 + d] = run;
  __syncthreads();
  float off = 0.f; blast = 0.f;
#pragma unroll
  for (int g = 0; g < 4; ++g) { const float t = tot[g * 128 + d]; blast += t; if (g < tg) off += t; }
#pragma unroll
  for (int i = 0; i < 16; ++i) bv[i] += off;
}
__device__ __forceinline__ void mlstm_gates(const Params& p, const WS& w, int h, size_t tb, unsigned char* ldsb, int tid) {
  float* Fl = (float*)(ldsb + L_F);
  if (tid < 64) { const float mi = bf2f(w.proj[(tb + tid) * NPROJ + C_SM + 16 + h]), mf = bf2f(w.proj[(tb + tid) * NPROJ + C_SM + 20 + h]);
    float f = logsigmoidf_(mf + p.fg_bias[h]);
#pragma unroll
    for (int o = 1; o < 64; o <<= 1) { const float t = bperm(f, tid - o); if (tid >= o) f += t; }
    Fl[tid] = f; Fl[64 + tid] = mi + p.ig_bias[h]; }
  __syncthreads();
}
__device__ __forceinline__ void conv_load(const WS& w, int col, int b, int c, int tg, bf16_t* win) {
  const int s0 = c * 64 + tg * 16 - 3;
#pragma unroll
  for (int m = 0; m < 19; ++m) { const int sp = s0 + m; win[m] = (sp >= 0) ? w.proj[((size_t)b * SEQ + sp) * NPROJ + col] : (bf16_t)0; }
}
__device__ __forceinline__ void conv_apply(const Params& p, const bf16_t* win, int cch, float scale, float* out) {
  const float c0 = p.conv_w[cch], c1 = p.conv_w[1024 + cch], c2 = p.conv_w[2048 + cch], c3 = p.conv_w[3072 + cch], cb = p.conv_b[cch];
#pragma unroll
  for (int i = 0; i < 16; ++i) out[i] = siluf_(cb + c0 * bf2f(win[i]) + c1 * bf2f(win[i + 1]) + c2 * bf2f(win[i + 2]) + c3 * bf2f(win[i + 3])) * scale;
}

template <int KIND>
__device__ void mix_local(const Params& p, const WS& w, int b, int h, int c, int item, unsigned char* ldsb) {
  const int tid = tidx(), lane = tid & 63, wave = tid >> 6, fr = lane & 15, fq = lane >> 4, d = tid & 127, tg = tid >> 7;
  const size_t tb = (size_t)b * SEQ + (size_t)c * 64;
  float* tot = (float*)(ldsb + L_TOT); const float* Fl = (const float*)(ldsb + L_F);
  bf16_t* kdT = (bf16_t*)(ldsb + L_KDT);
  const bf16_t* vrow = w.vT + (size_t)(KIND * 1024 + h * 256 + wave * 32 + fr) * T + tb + fq * 8;
  bf16x8 yv[2][2];
#pragma unroll
  for (int ks = 0; ks < 2; ++ks) { yv[ks][0] = *(const bf16x8*)(vrow + ks * 32); yv[ks][1] = *(const bf16x8*)(vrow + (size_t)16 * T + ks * 32); }
  bf16_t kraw[19];
  if (KIND == 0) {
#pragma unroll
    for (int i = 0; i < 16; ++i) kraw[i] = w.proj[(tb + tg * 16 + i) * NPROJ + C_GK + h * 128 + d];
  } else conv_load(w, C_MK + h * 128 + d, b, c, tg, kraw);
  float wgt[16], kv[16];
  if (KIND == 0) {
    float bv[16], blast; gla_gates(p, w, h, tb, ldsb, tid, bv, blast);
#pragma unroll
    for (int i = 0; i < 16; ++i) { wgt[i] = __expf(blast - bv[i]); kv[i] = bf2f(kraw[i]); }
    if (tg == 0) w.gdec[(size_t)item * 128 + d] = __expf(blast);
  } else {
    mlstm_gates(p, w, h, tb, ldsb, tid);
    const float flast = Fl[63];
#pragma unroll
    for (int i = 0; i < 16; ++i) wgt[i] = __expf(flast - Fl[tg * 16 + i] + Fl[64 + tg * 16 + i]);
    conv_apply(p, kraw, 512 + h * 128 + d, 0.08838834764831845f, kv);
    if (tid == 0) w.mdec[item - 2048] = __expf(flast);
  }
  float un = 0.f; float kd[16];
#pragma unroll
  for (int i = 0; i < 16; ++i) { kd[i] = kv[i] * wgt[i]; un += kd[i]; }
  *(uint4*)(kdT + d * KDT_LD + tg * 16) = pack8(kd); *(uint4*)(kdT + d * KDT_LD + tg * 16 + 8) = pack8(kd + 8);
  if (KIND == 1) tot[tg * 128 + d] = un;
  __syncthreads();
  if (KIND == 1 && tg == 0) w.mn[(size_t)(item - 2048) * 128 + d] = tot[d] + tot[128 + d] + tot[256 + d] + tot[384 + d];
  f32x4 acc[2][8];
#pragma unroll
  for (int yt = 0; yt < 2; ++yt)
#pragma unroll
    for (int xt = 0; xt < 8; ++xt) acc[yt][xt] = (f32x4){0.f, 0.f, 0.f, 0.f};
#pragma unroll
  for (int ks = 0; ks < 2; ++ks) {
#pragma unroll
    for (int xt = 0; xt < 8; ++xt) { const bf16x8 xk = *(const bf16x8*)(kdT + (xt * 16 + fr) * KDT_LD + ks * 32 + fq * 8);
      acc[0][xt] = MFMA16(xk, yv[ks][0], acc[0][xt]); acc[1][xt] = MFMA16(xk, yv[ks][1], acc[1][xt]); }
  }
  bf16_t* S = (bf16_t*)p.out + (size_t)item * 32768;
#pragma unroll
  for (int yt = 0; yt < 2; ++yt)
#pragma unroll
    for (int xt = 0; xt < 8; ++xt) *(uint2*)(S + (wave * 32 + yt * 16 + fr) * 128 + xt * 16 + 4 * fq) = make_uint2(pack2(acc[yt][xt][0], acc[yt][xt][1]), pack2(acc[yt][xt][2], acc[yt][xt][3]));
  __syncthreads();
}

__device__ void mix_scan(const Params& p, const WS& w, float* lds, int bid, int nb) {
  bf16_t* sbuf = (bf16_t*)p.out;
  const int tid = tidx();
  for (int g0 = bid * 512; g0 < 16 * 8192; g0 += nb * 512) {
    const int g = g0 + tid, combo = g0 >> 13, e = (g & 8191) * 4, dk = e & 127;
    __syncthreads();
    if (combo < 8) { const float4* src = (const float4*)(w.gdec + (size_t)combo * 32768);
#pragma unroll
      for (int i = 0; i < 16; ++i) ((float4*)lds)[i * 512 + tid] = src[i * 512 + tid]; }
    else if (tid < 256) lds[tid] = w.mdec[(combo - 8) * 256 + tid];
    __syncthreads();
    bf16_t* base = sbuf + (size_t)combo * 256 * 32768 + e;
    float S0 = 0.f, S1 = 0.f, S2 = 0.f, S3 = 0.f;
    for (int c0 = 0; c0 < 256; c0 += 16) {
      uint2 u[16];
#pragma unroll
      for (int k = 0; k < 16; ++k) u[k] = *(const uint2*)(base + (size_t)(c0 + k) * 32768);
#pragma unroll
      for (int k = 0; k < 16; ++k) { float4 dc; if (combo < 8) dc = *(const float4*)(lds + (c0 + k) * 128 + dk); else { const float m = lds[c0 + k]; dc = make_float4(m, m, m, m); }
        *(uint2*)(base + (size_t)(c0 + k) * 32768) = make_uint2(pack2(S0, S1), pack2(S2, S3));
        S0 = dc.x * S0 + lo_f(u[k].x); S1 = dc.y * S1 + hi_f(u[k].x); S2 = dc.z * S2 + lo_f(u[k].y); S3 = dc.w * S3 + hi_f(u[k].y); }
    }
  }
  for (int g = bid * 512 + tid; g < 8 * 128; g += nb * 512) {
    const int cb = g >> 7, d = g & 127; float n = 0.f;
    for (int c = 0; c < 256; ++c) { float* q = w.mn + (size_t)(cb * 256 + c) * 128 + d; const float u = *q; *q = n; n = w.mdec[cb * 256 + c] * n + u; }
  }
}

template <int KIND>
__device__ void mix_out(const Params& p, const WS& w, int b, int h, int c, int item, unsigned char* ldsb) {
  const int tid = tidx(), lane = tid & 63, wave = tid >> 6, fr = lane & 15, fq = lane >> 4, d = tid & 127, tg = tid >> 7;
  const size_t tb = (size_t)b * SEQ + (size_t)c * 64;
  const float* Fl = (const float*)(ldsb + L_F); float* denl = (float*)(ldsb + L_DEN); float* part = (float*)(ldsb + L_PART); float* nl = (float*)(ldsb + L_NL);
  bf16_t* qs = (bf16_t*)(ldsb + L_QS); bf16_t* ks = (bf16_t*)(ldsb + L_KS); bf16_t* P = (bf16_t*)(ldsb + L_P);
  bf16x8 vx[2][2], sx[4][2];
  { const bf16_t* vrow = w.vT + (size_t)(KIND * 1024 + h * 256 + wave * 32 + fr) * T + tb + fq * 8;
#pragma unroll
    for (int k2 = 0; k2 < 2; ++k2) { vx[k2][0] = *(const bf16x8*)(vrow + k2 * 32); vx[k2][1] = *(const bf16x8*)(vrow + (size_t)16 * T + k2 * 32); }
    const bf16_t* srow = (const bf16_t*)p.out + (size_t)item * 32768 + (wave * 32 + fr) * 128 + fq * 8;
#pragma unroll
    for (int k4 = 0; k4 < 4; ++k4) { sx[k4][0] = *(const bf16x8*)(srow + k4 * 32); sx[k4][1] = *(const bf16x8*)(srow + 16 * 128 + k4 * 32); } }
  uint2 gt[4][2];
#pragma unroll
  for (int yt = 0; yt < 4; ++yt)
#pragma unroll
    for (int xt = 0; xt < 2; ++xt) gt[yt][xt] = *(const uint2*)(w.proj + (tb + yt * 16 + fr) * NPROJ + (KIND == 0 ? C_GG : C_MO) + h * 256 + wave * 32 + xt * 16 + 4 * fq);
  const float* gain = (KIND == 0 ? p.gla_norm : p.mlstm_norm) + h * 256;
  const float4 gn0 = *(const float4*)(gain + wave * 32 + 4 * fq), gn1 = *(const float4*)(gain + wave * 32 + 16 + 4 * fq);
  bf16_t qraw[19], kraw[19];
  if (KIND == 0) {
#pragma unroll
    for (int i = 0; i < 16; ++i) { qraw[i] = w.proj[(tb + tg * 16 + i) * NPROJ + C_GQ + h * 128 + d]; kraw[i] = w.proj[(tb + tg * 16 + i) * NPROJ + C_GK + h * 128 + d]; }
  } else { conv_load(w, C_MQ + h * 128 + d, b, c, tg, qraw); conv_load(w, C_MK + h * 128 + d, b, c, tg, kraw); }
  float nlv = 0.f;
  if (KIND == 1 && tid < 128) nlv = w.mn[(size_t)(item - 2048) * 128 + tid];
  {
    float qm[16], km[16], qv[16], kv[16];
    if (KIND == 0) {
      float bv[16], blast; gla_gates(p, w, h, tb, ldsb, tid, bv, blast);
#pragma unroll
      for (int i = 0; i < 16; ++i) { qm[i] = 0.08838834764831845f * __expf(bv[i]); km[i] = __expf(-bv[i]); qv[i] = bf2f(qraw[i]); kv[i] = bf2f(kraw[i]); }
    } else {
      mlstm_gates(p, w, h, tb, ldsb, tid);
#pragma unroll
      for (int i = 0; i < 16; ++i) { const float F = Fl[tg * 16 + i]; qm[i] = __expf(F); km[i] = __expf(Fl[64 + tg * 16 + i] - F); }
      conv_apply(p, qraw, h * 128 + d, 1.f, qv);
      conv_apply(p, kraw, 512 + h * 128 + d, 0.08838834764831845f, kv);
      if (tid < 128) nl[tid] = nlv;
    }
#pragma unroll
    for (int i = 0; i < 16; ++i) { qs[(tg * 16 + i) * QS_LD + d] = f2bf(qv[i] * qm[i]); ks[(tg * 16 + i) * QS_LD + d] = f2bf(kv[i] * km[i]); }
  }
  __syncthreads();
#pragma unroll
  for (int q = 0; q < 2; ++q) { const int tt = wave * 2 + q, jt = tt >> 2, it = tt & 3; f32x4 a = (f32x4){0.f, 0.f, 0.f, 0.f};
#pragma unroll
    for (int k4 = 0; k4 < 4; ++k4) { const bf16x8 xk = *(const bf16x8*)(ks + (jt * 16 + fr) * QS_LD + k4 * 32 + fq * 8), yq = *(const bf16x8*)(qs + (it * 16 + fr) * QS_LD + k4 * 32 + fq * 8); a = MFMA16(xk, yq, a); }
    const int i = it * 16 + fr, j0 = jt * 16 + 4 * fq;
    const float v0 = (j0 <= i) ? a[0] : 0.f, v1 = (j0 + 1 <= i) ? a[1] : 0.f, v2 = (j0 + 2 <= i) ? a[2] : 0.f, v3 = (j0 + 3 <= i) ? a[3] : 0.f;
    *(uint2*)(P + i * P_LD + j0) = make_uint2(pack2(v0, v1), pack2(v2, v3)); }
  __syncthreads();
  if (KIND == 1) { const int i = tid >> 3, pt = tid & 7; float f[8]; float s = 0.f;
    unpack8(*(const uint4*)(P + i * P_LD + pt * 8), f);
#pragma unroll
    for (int j = 0; j < 8; ++j) s += f[j];
#pragma unroll
    for (int hh = 0; hh < 2; ++hh) { unpack8(*(const uint4*)(qs + i * QS_LD + pt * 16 + hh * 8), f);
#pragma unroll
      for (int j = 0; j < 8; ++j) s += f[j] * nl[pt * 16 + hh * 8 + j]; }
    s = gsum<8>(s);
    if (pt == 0) denl[i] = s; }
  f32x4 acc[2][4];
#pragma unroll
  for (int xt = 0; xt < 2; ++xt)
#pragma unroll
    for (int yt = 0; yt < 4; ++yt) acc[xt][yt] = (f32x4){0.f, 0.f, 0.f, 0.f};
#pragma unroll
  for (int k2 = 0; k2 < 2; ++k2)
#pragma unroll
    for (int yt = 0; yt < 4; ++yt) { const bf16x8 yp = *(const bf16x8*)(P + (yt * 16 + fr) * P_LD + k2 * 32 + fq * 8); acc[0][yt] = MFMA16(vx[k2][0], yp, acc[0][yt]); acc[1][yt] = MFMA16(vx[k2][1], yp, acc[1][yt]); }
#pragma unroll
  for (int k4 = 0; k4 < 4; ++k4)
#pragma unroll
    for (int yt = 0; yt < 4; ++yt) { const bf16x8 yq = *(const bf16x8*)(qs + (yt * 16 + fr) * QS_LD + k4 * 32 + fq * 8); acc[0][yt] = MFMA16(sx[k4][0], yq, acc[0][yt]); acc[1][yt] = MFMA16(sx[k4][1], yq, acc[1][yt]); }
  if (KIND == 1) __syncthreads();
#pragma unroll
  for (int yt = 0; yt < 4; ++yt) { float s = 0.f;
    if (KIND == 1) { const float inv = 1.f / fmaxf(fabsf(denl[yt * 16 + fr]), 1.f); acc[0][yt] *= inv; acc[1][yt] *= inv; }
#pragma unroll
    for (int xt = 0; xt < 2; ++xt)
#pragma unroll
      for (int r = 0; r < 4; ++r) s += acc[xt][yt][r] * acc[xt][yt][r];
    s += sxor<16>(s); s += sxor<32>(s);
    if (fq == 0) part[wave * 64 + yt * 16 + fr] = s; }
  __syncthreads();
#pragma unroll
  for (int yt = 0; yt < 4; ++yt) { const int i = yt * 16 + fr; float t = 0.f;
#pragma unroll
    for (int ww = 0; ww < 8; ++ww) t += part[ww * 64 + i];
    const float rs = rsqrtf(t * (1.f / 256.f) + EPS);
#pragma unroll
    for (int xt = 0; xt < 2; ++xt) { const int dv = wave * 32 + xt * 16 + 4 * fq;
      const float4 gn = xt == 0 ? gn0 : gn1; const uint2 g2 = gt[yt][xt];
      const float g0 = lo_f(g2.x), g1 = hi_f(g2.x), g2f = lo_f(g2.y), g3 = hi_f(g2.y);
      const float a0 = KIND == 0 ? siluf_(g0) : sigmoidf_(g0), a1 = KIND == 0 ? siluf_(g1) : sigmoidf_(g1), a2 = KIND == 0 ? siluf_(g2f) : sigmoidf_(g2f), a3 = KIND == 0 ? siluf_(g3) : sigmoidf_(g3);
      const float y0 = acc[xt][yt][0] * rs * gn.x * a0, y1 = acc[xt][yt][1] * rs * gn.y * a1, y2 = acc[xt][yt][2] * rs * gn.z * a2, y3 = acc[xt][yt][3] * rs * gn.w * a3;
#if F8_OUT
      *(unsigned*)(w.yq + (tb + i) * D + KIND * 1024 + h * 256 + dv) = pack4_fp8(y0, y1, y2, y3);
#else
      *(uint2*)(w.y + (tb + i) * D + KIND * 1024 + h * 256 + dv) = make_uint2(pack2(y0, y1), pack2(y2, y3));
#endif
    } }
  __syncthreads();
}
template <int KIND>
__device__ void mix_out3(const Params& p, const WS& w, int b, int h, int c, int item, unsigned char* ldsb) {
  const int tid = tidx(), lane = tid & 63, wave = tid >> 6, fr = lane & 15, fq = lane >> 4, d = tid & 127, tg = tid >> 7;
  const size_t tb = (size_t)b * SEQ + (size_t)c * 64;
  const float* Fl = (const float*)(ldsb + L_F); float* denl = (float*)(ldsb + L_DEN); float* part = (float*)(ldsb + L_PART); float* nl = (float*)(ldsb + L_NL);
  bf16_t* qs = (bf16_t*)(ldsb + L_QS); bf16_t* ks = (bf16_t*)(ldsb + L_KS); bf16_t* P = (bf16_t*)(ldsb + L_P);
  bf16x8 vx[2][2], sx[4][2];
  { const bf16_t* vrow = w.vT + (size_t)(KIND * 1024 + h * 256 + wave * 32 + fr) * T + tb + fq * 8;
#pragma unroll
    for (int k2 = 0; k2 < 2; ++k2) { vx[k2][0] = *(const bf16x8*)(vrow + k2 * 32); vx[k2][1] = *(const bf16x8*)(vrow + (size_t)16 * T + k2 * 32); }
    const bf16_t* srow = (const bf16_t*)p.out + (size_t)item * 32768 + (wave * 32 + fr) * 128 + fq * 8;
#pragma unroll
    for (int k4 = 0; k4 < 4; ++k4) { sx[k4][0] = *(const bf16x8*)(srow + k4 * 32); sx[k4][1] = *(const bf16x8*)(srow + 16 * 128 + k4 * 32); } }
  uint2 gt[4][2];
#pragma unroll
  for (int yt = 0; yt < 4; ++yt)
#pragma unroll
    for (int xt = 0; xt < 2; ++xt) gt[yt][xt] = *(const uint2*)(w.proj + (tb + yt * 16 + fr) * NPROJ + (KIND == 0 ? C_GG : C_MO) + h * 256 + wave * 32 + xt * 16 + 4 * fq);
  const float* gain = (KIND == 0 ? p.gla_norm : p.mlstm_norm) + h * 256;
  const float4 gn0 = *(const float4*)(gain + wave * 32 + 4 * fq), gn1 = *(const float4*)(gain + wave * 32 + 16 + 4 * fq);
  { uint4 tq[2], tk[2];
    const bf16_t* gq = w.qs + tb * 1024 + KIND * 512 + h * 128; const bf16_t* gk = w.ks + tb * 1024 + KIND * 512 + h * 128;
#pragma unroll
    for (int ps = 0; ps < 2; ++ps) { const int pc = ps * 512 + tid, row = pc >> 4, c8 = (pc & 15) * 8; tq[ps] = *(const uint4*)(gq + (size_t)row * 1024 + c8); tk[ps] = *(const uint4*)(gk + (size_t)row * 1024 + c8); }
    float nlv = 0.f;
    if (KIND == 1 && tid < 128) nlv = w.mn[(size_t)(item - 2048) * 128 + tid];
#pragma unroll
    for (int ps = 0; ps < 2; ++ps) { const int pc = ps * 512 + tid, row = pc >> 4, c8 = (pc & 15) * 8; *(uint4*)(qs + row * QS_LD + c8) = tq[ps]; *(uint4*)(ks + row * QS_LD + c8) = tk[ps]; }
    if (KIND == 1 && tid < 128) nl[tid] = nlv; }
  __syncthreads();
#pragma unroll
  for (int q = 0; q < 2; ++q) { const int tt = wave * 2 + q, jt = tt >> 2, it = tt & 3; f32x4 a = (f32x4){0.f, 0.f, 0.f, 0.f};
#pragma unroll
    for (int k4 = 0; k4 < 4; ++k4) { const bf16x8 xk = *(const bf16x8*)(ks + (jt * 16 + fr) * QS_LD + k4 * 32 + fq * 8), yq = *(const bf16x8*)(qs + (it * 16 + fr) * QS_LD + k4 * 32 + fq * 8); a = MFMA16(xk, yq, a); }
    const int i = it * 16 + fr, j0 = jt * 16 + 4 * fq;
    const float v0 = (j0 <= i) ? a[0] : 0.f, v1 = (j0 + 1 <= i) ? a[1] : 0.f, v2 = (j0 + 2 <= i) ? a[2] : 0.f, v3 = (j0 + 3 <= i) ? a[3] : 0.f;
    *(uint2*)(P + i * P_LD + j0) = make_uint2(pack2(v0, v1), pack2(v2, v3)); }
  __syncthreads();
  if (KIND == 1) { const int i = tid >> 3, pt = tid & 7; float f[8]; float s = 0.f;
    unpack8(*(const uint4*)(P + i * P_LD + pt * 8), f);
#pragma unroll
    for (int j = 0; j < 8; ++j) s += f[j];
#pragma unroll
    for (int hh = 0; hh < 2; ++hh) { unpack8(*(const uint4*)(qs + i * QS_LD + pt * 16 + hh * 8), f);
#pragma unroll
      for (int j = 0; j < 8; ++j) s += f[j] * nl[pt * 16 + hh * 8 + j]; }
    s = gsum<8>(s);
    if (pt == 0) denl[i] = s; }
  f32x4 acc[2][4];
#pragma unroll
  for (int xt = 0; xt < 2; ++xt)
#pragma unroll
    for (int yt = 0; yt < 4; ++yt) acc[xt][yt] = (f32x4){0.f, 0.f, 0.f, 0.f};
#pragma unroll
  for (int k2 = 0; k2 < 2; ++k2)
#pragma unroll
    for (int yt = 0; yt < 4; ++yt) { const bf16x8 yp = *(const bf16x8*)(P + (yt * 16 + fr) * P_LD + k2 * 32 + fq * 8); acc[0][yt] = MFMA16(vx[k2][0], yp, acc[0][yt]); acc[1][yt] = MFMA16(vx[k2][1], yp, acc[1][yt]); }
#pragma unroll
  for (int k4 = 0; k4 < 4; ++k4)
#pragma unroll
    for (int yt = 0; yt < 4; ++yt) { const bf16x8 yq = *(const bf16x8*)(qs + (yt * 16 + fr) * QS_LD + k4 * 32 + fq * 8); acc[0][yt] = MFMA16(sx[k4][0], yq, acc[0][yt]); acc[1][yt] = MFMA16(sx[k4][1], yq, acc[1][yt]); }
  if (KIND == 1) __syncthreads();
#pragma unroll
  for (int yt = 0; yt < 4; ++yt) { float s = 0.f;
    if (KIND == 1) { const float inv = 1.f / fmaxf(fabsf(denl[yt * 16 + fr]), 1.f); acc[0][yt] *= inv; acc[1][yt] *= inv; }
#pragma unroll
    for (int xt = 0; xt < 2; ++xt)
#pragma unroll
      for (int r = 0; r < 4; ++r) s += acc[xt][yt][r] * acc[xt][yt][r];
    s += sxor<16>(s); s += sxor<32>(s);
    if (fq == 0) part[wave * 64 + yt * 16 + fr] = s; }
  __syncthreads();
#pragma unroll
  for (int yt = 0; yt < 4; ++yt) { const int i = yt * 16 + fr; float t = 0.f;
#pragma unroll
    for (int ww = 0; ww < 8; ++ww) t += part[ww * 64 + i];
    const float rs = rsqrtf(t * (1.f / 256.f) + EPS);
#pragma unroll
    for (int xt = 0; xt < 2; ++xt) { const int dv = wave * 32 + xt * 16 + 4 * fq;
      const float4 gn = xt == 0 ? gn0 : gn1; const uint2 g2 = gt[yt][xt];
      const float g0 = lo_f(g2.x), g1 = hi_f(g2.x), g2f = lo_f(g2.y), g3 = hi_f(g2.y);
      const float a0 = KIND == 0 ? siluf_(g0) : sigmoidf_(g0), a1 = KIND == 0 ? siluf_(g1) : sigmoidf_(g1), a2 = KIND == 0 ? siluf_(g2f) : sigmoidf_(g2f), a3 = KIND == 0 ? siluf_(g3) : sigmoidf_(g3);
      const float y0 = acc[xt][yt][0] * rs * gn.x * a0, y1 = acc[xt][yt][1] * rs * gn.y * a1, y2 = acc[xt][yt][2] * rs * gn.z * a2, y3 = acc[xt][yt][3] * rs * gn.w * a3;
#if F8_OUT
      *(unsigned*)(w.yq + (tb + i) * D + KIND * 1024 + h * 256 + dv) = pack4_fp8(y0, y1, y2, y3);
#else
      *(uint2*)(w.y + (tb + i) * D + KIND * 1024 + h * 256 + dv) = make_uint2(pack2(y0, y1), pack2(y2, y3));
#endif
    } }
  __syncthreads();
}
template <int WHICH>
__device__ void phase_mix_items(const Params& p, const WS& w, unsigned char* ldsb, int bid, int nb) {
  for (int item = bid; item < 4096; item += nb) {
    const int kind = item >> 11, b = (item >> 10) & 1, h = (item >> 8) & 3, c = item & 255;
    if (WHICH == 0) { if (kind == 0) mix_local<0>(p, w, b, h, c, item, ldsb); else mix_local<1>(p, w, b, h, c, item, ldsb); }
    else { if (kind == 0) mix_out<0>(p, w, b, h, c, item, ldsb); else mix_out<1>(p, w, b, h, c, item, ldsb); }
  }
}


__device__ void phase_mix_out3(const Params& p, const WS& w, unsigned char* ldsb, int bid, int nb) {
  for (int item = bid; item < 4096; item += nb) {
    const int kind = item >> 11, b = (item >> 10) & 1, h = (item >> 8) & 3, c = item & 255;
    if (kind == 0) mix_out3<0>(p, w, b, h, c, item, ldsb); else mix_out3<1>(p, w, b, h, c, item, ldsb);
  }
}

__device__ void mix_gate_pass(const Params& p, const WS& w, unsigned char* ldsb, int bid, int nb) {
  const int tid = tidx(), h = tid >> 7, d = tid & 127, lane = tid & 63;
  const bf16_t* qT = (const bf16_t*)ldsb; const bf16_t* kT = (const bf16_t*)(ldsb + 65536);
  float* glrs = (float*)(ldsb + 131072); float* Fl = (float*)(ldsb + 135168);
  for (int itx = bid; itx < 1024; itx += nb) {
    const int kind = itx >> 9, b = (itx >> 8) & 1, c = itx & 255;
    const size_t tb = (size_t)b * SEQ + (size_t)c * 64;
    const int item = ((kind * 2 + b) * 4 + h) * 256 + c;
    bf16_t* qo = w.qs + tb * 1024 + kind * 512 + tid; bf16_t* ko = w.ks + tb * 1024 + kind * 512 + tid;
    bf16_t* kdo = w.kdT + (size_t)(kind * 512 + tid) * T + tb;
    { uint4 tq[8], tk[8];
      const unsigned char* gq = (const unsigned char*)(w.proj + tb * NPROJ + (kind == 0 ? C_GQ : C_MQ)); const unsigned char* gk = (const unsigned char*)(w.proj + tb * NPROJ + (kind == 0 ? C_GK : C_MK));
#pragma unroll
      for (int ps = 0; ps < 8; ++ps) { const int o = ps * 8192 + tid * 16; tq[ps] = *(const uint4*)(gq + (size_t)(o >> 10) * (NPROJ * 2) + (o & 1023)); tk[ps] = *(const uint4*)(gk + (size_t)(o >> 10) * (NPROJ * 2) + (o & 1023)); }
#pragma unroll
      for (int ps = 0; ps < 8; ++ps) { const int o = ps * 8192 + tid * 16; *(uint4*)(ldsb + o) = tq[ps]; *(uint4*)(ldsb + 65536 + o) = tk[ps]; } }
    if (kind == 0) {
      if (tid < 128) { float f[8]; unpack8(*(const uint4*)(w.proj + (tb + (tid >> 1)) * NPROJ + C_SM + (tid & 1) * 8), f);
#pragma unroll
        for (int j = 0; j < 8; ++j) glrs[(tid >> 1) * 16 + (tid & 1) * 8 + j] = f[j]; }
      float gu[16];
#pragma unroll
      for (int r = 0; r < 16; ++r) gu[r] = p.gate_up[r * 512 + tid];
      const float gb = p.gate_bias[tid];
      __syncthreads();
      float run = 0.f;
#pragma unroll 1
      for (int j8 = 0; j8 < 8; ++j8) { float kd[8];
#pragma unroll
        for (int e = 0; e < 8; ++e) { const int j = j8 * 8 + e; const float* gl = glrs + j * 16; float z = gb;
#pragma unroll
          for (int r4 = 0; r4 < 4; ++r4) { const float4 g4 = *(const float4*)(gl + r4 * 4); z += g4.x * gu[r4 * 4] + g4.y * gu[r4 * 4 + 1] + g4.z * gu[r4 * 4 + 2] + g4.w * gu[r4 * 4 + 3]; }
          run += logsigmoidf_(z) * (1.f / 16.f);
          const float q = bf2f(qT[j * 512 + tid]), k = bf2f(kT[j * 512 + tid]), eb = __expf(run), ks_ = k * __builtin_amdgcn_rcpf(eb);
          qo[(size_t)j * 1024] = f2bf(q * 0.08838834764831845f * eb); ko[(size_t)j * 1024] = f2bf(ks_); kd[e] = ks_; }
        *(uint4*)(kdo + j8 * 8) = pack8(kd); }
      w.gdec[(size_t)item * 128 + d] = __expf(run);
    } else {
      float q0 = 0.f, q1 = 0.f, q2 = 0.f, k0 = 0.f, k1 = 0.f, k2 = 0.f;
      if (c > 0) { const bf16_t* qp = w.proj + tb * NPROJ + C_MQ + tid; const bf16_t* kp = w.proj + tb * NPROJ + C_MK + tid;
        q0 = bf2f(*(qp - 3 * (size_t)NPROJ)); q1 = bf2f(*(qp - 2 * (size_t)NPROJ)); q2 = bf2f(*(qp - (size_t)NPROJ)); k0 = bf2f(*(kp - 3 * (size_t)NPROJ)); k1 = bf2f(*(kp - 2 * (size_t)NPROJ)); k2 = bf2f(*(kp - (size_t)NPROJ)); }
      if (tid < 256) { const int hh = tid >> 6; const float mi = bf2f(w.proj[(tb + lane) * NPROJ + C_SM + 16 + hh]), mf = bf2f(w.proj[(tb + lane) * NPROJ + C_SM + 20 + hh]);
        float f = logsigmoidf_(mf + p.fg_bias[hh]);
#pragma unroll
        for (int o = 1; o < 64; o <<= 1) { const float t = bperm(f, lane - o); if (lane >= o) f += t; }
        Fl[hh * 64 + lane] = f; Fl[256 + hh * 64 + lane] = mi + p.ig_bias[hh]; }
      const float cq0 = p.conv_w[tid], cq1 = p.conv_w[1024 + tid], cq2 = p.conv_w[2048 + tid], cq3 = p.conv_w[3072 + tid], cqb = p.conv_b[tid];
      const float ck0 = p.conv_w[512 + tid], ck1 = p.conv_w[1536 + tid], ck2 = p.conv_w[2560 + tid], ck3 = p.conv_w[3584 + tid], ckb = p.conv_b[512 + tid];
      __syncthreads();
      const float flast = Fl[h * 64 + 63];
      if (d == 0) w.mdec[item - 2048] = __expf(flast);
      float un = 0.f;
#pragma unroll 1
      for (int j8 = 0; j8 < 8; ++j8) { float kd[8];
#pragma unroll
        for (int e = 0; e < 8; ++e) { const int j = j8 * 8 + e; const float xq = bf2f(qT[j * 512 + tid]), xk = bf2f(kT[j * 512 + tid]);
          const float qc = siluf_(cqb + cq0 * q0 + cq1 * q1 + cq2 * q2 + cq3 * xq), kc = siluf_(ckb + ck0 * k0 + ck1 * k1 + ck2 * k2 + ck3 * xk) * 0.08838834764831845f;
          q0 = q1; q1 = q2; q2 = xq; k0 = k1; k1 = k2; k2 = xk;
          const float F = Fl[h * 64 + j], ig = Fl[256 + h * 64 + j];
          const float ks_ = kc * __expf(ig - F);
          qo[(size_t)j * 1024] = f2bf(qc * __expf(F)); ko[(size_t)j * 1024] = f2bf(ks_); kd[e] = ks_; un += ks_; }
        *(uint4*)(kdo + j8 * 8) = pack8(kd); }
      w.mn[(size_t)(item - 2048) * 128 + d] = un * __expf(flast);
    }
    __syncthreads();
  }
}
__device__ void mix_local2(const Params& p, const WS& w, int bid, int nb) {
  const int tid = tidx(), wave = tid >> 6, lane = tid & 63, fr = lane & 15, fq = lane >> 4;
  for (int task = bid * 8 + wave; task < 32768; task += nb * 8) {
    const int item = task >> 3, w8 = task & 7, kind = item >> 11, b = (item >> 10) & 1, h = (item >> 8) & 3, c = item & 255;
    const size_t tb = (size_t)b * SEQ + (size_t)c * 64;
    const bf16_t* xrow = w.kdT + (size_t)(kind * 512 + h * 128 + 8 * (fr >> 2) + (fr & 3)) * T + tb + fq * 8;
    const bf16_t* yrow = w.vT + (size_t)(kind * 1024 + h * 256 + w8 * 32 + fr) * T + tb + fq * 8;
    f32x4 acc[2][8];
#pragma unroll
    for (int yt = 0; yt < 2; ++yt)
#pragma unroll
      for (int xt = 0; xt < 8; ++xt) acc[yt][xt] = (f32x4){0.f, 0.f, 0.f, 0.f};
#pragma unroll
    for (int ks = 0; ks < 2; ++ks) {
      const bf16x8 y0 = *(const bf16x8*)(yrow + ks * 32), y1 = *(const bf16x8*)(yrow + (size_t)16 * T + ks * 32);
#pragma unroll
      for (int xt = 0; xt < 8; ++xt) { const bf16x8 xk = *(const bf16x8*)(xrow + (size_t)((xt >> 1) * 32 + (xt & 1) * 4) * T + ks * 32);
        acc[0][xt] = MFMA16(xk, y0, acc[0][xt]); acc[1][xt] = MFMA16(xk, y1, acc[1][xt]); }
    }
    bf16_t* S = (bf16_t*)p.out + (size_t)item * 32768;
    const float md = kind ? w.mdec[item - 2048] : 0.f;
#pragma unroll
    for (int m = 0; m < 4; ++m) {
      float4 d0 = make_float4(md, md, md, md), d1 = d0;
      if (!kind) { d0 = *(const float4*)(w.gdec + (size_t)item * 128 + m * 32 + 8 * fq); d1 = *(const float4*)(w.gdec + (size_t)item * 128 + m * 32 + 8 * fq + 4); }
#pragma unroll
      for (int yt = 0; yt < 2; ++yt) { const f32x4 a = acc[yt][2 * m], bq = acc[yt][2 * m + 1];
        *(uint4*)(S + (w8 * 32 + yt * 16 + fr) * 128 + m * 32 + 8 * fq) = make_uint4(pack2(a[0] * d0.x, a[1] * d0.y), pack2(a[2] * d0.z, a[3] * d0.w), pack2(bq[0] * d1.x, bq[1] * d1.y), pack2(bq[2] * d1.z, bq[3] * d1.w)); } }
  }
}
template <int KIND>
__device__ __forceinline__ void mix_out2_task(const Params& p, const WS& w, int item, int it, int fr, int fq) {
  const int b = (item >> 10) & 1, h = (item >> 8) & 3, c = item & 255;
  const size_t tb = (size_t)b * SEQ + (size_t)c * 64;
  const int i = it * 16 + fr;
  typedef unsigned u32x4_t __attribute__((ext_vector_type(4)));
  bf16x8 yq[4];
  { const bf16_t* qrow = w.qs + (tb + i) * 1024 + KIND * 512 + h * 128 + fq * 8;
#pragma unroll
    for (int k4 = 0; k4 < 4; ++k4) yq[k4] = *(const bf16x8*)(qrow + k4 * 32); }
  uint2 pk[4]; float rsum = 0.f;
  { bf16x8 kf[4][4];
#pragma unroll
    for (int jt = 0; jt < 4; ++jt) if (jt <= it) { const bf16_t* krow = w.ks + (tb + jt * 16 + fr) * 1024 + KIND * 512 + h * 128 + fq * 8;
#pragma unroll
      for (int k4 = 0; k4 < 4; ++k4) kf[jt][k4] = *(const bf16x8*)(krow + k4 * 32); }
#pragma unroll
    for (int jt = 0; jt < 4; ++jt) { pk[jt] = make_uint2(0u, 0u);
      if (jt <= it) { f32x4 a = (f32x4){0.f, 0.f, 0.f, 0.f};
#pragma unroll
        for (int k4 = 0; k4 < 4; ++k4) a = MFMA16(kf[jt][k4], yq[k4], a);
        if (jt == it) {
#pragma unroll
          for (int r = 0; r < 4; ++r) a[r] = (4 * fq + r <= fr) ? a[r] : 0.f; }
        rsum += a[0] + a[1] + a[2] + a[3];
        pk[jt] = make_uint2(pack2(a[0], a[1]), pack2(a[2], a[3])); } } }
  f32x4 acc[16];
#pragma unroll
  for (int xt = 0; xt < 16; ++xt) acc[xt] = (f32x4){0.f, 0.f, 0.f, 0.f};
  const bf16_t* vbase = w.vT + (size_t)(KIND * 1024 + h * 256 + fr) * T + tb + 4 * fq;
  const bf16_t* sbase = (const bf16_t*)p.out + (size_t)item * 32768 + fr * 128 + fq * 8;
  const u32x4_t yp0 = {pk[0].x, pk[0].y, pk[1].x, pk[1].y}, yp1 = {pk[2].x, pk[2].y, pk[3].x, pk[3].y};
  uint2 va[2][2][2], vb[2][2][2]; bf16x8 sf[2][2][4];
#define MO_LOAD(bufi, g) do { _Pragma("unroll") for (int x2 = 0; x2 < 2; ++x2) { const int xt = (g) * 2 + x2; const bf16_t* vr = vbase + (size_t)xt * 16 * T; \
      va[bufi][x2][0] = *(const uint2*)vr; vb[bufi][x2][0] = *(const uint2*)(vr + 16); if (it >= 2) { va[bufi][x2][1] = *(const uint2*)(vr + 32); vb[bufi][x2][1] = *(const uint2*)(vr + 48); } \
      _Pragma("unroll") for (int k4 = 0; k4 < 4; ++k4) sf[bufi][x2][k4] = *(const bf16x8*)(sbase + xt * 16 * 128 + k4 * 32); } } while (0)
#define MO_COMP(bufi, g) do { _Pragma("unroll") for (int x2 = 0; x2 < 2; ++x2) { const int xt = (g) * 2 + x2; \
      { const u32x4_t xv = {va[bufi][x2][0].x, va[bufi][x2][0].y, vb[bufi][x2][0].x, vb[bufi][x2][0].y}; acc[xt] = MFMA16(__builtin_bit_cast(bf16x8, xv), __builtin_bit_cast(bf16x8, yp0), acc[xt]); } \
      if (it >= 2) { const u32x4_t xv = {va[bufi][x2][1].x, va[bufi][x2][1].y, vb[bufi][x2][1].x, vb[bufi][x2][1].y}; acc[xt] = MFMA16(__builtin_bit_cast(bf16x8, xv), __builtin_bit_cast(bf16x8, yp1), acc[xt]); } \
      _Pragma("unroll") for (int k4 = 0; k4 < 4; ++k4) acc[xt] = MFMA16(sf[bufi][x2][k4], yq[k4], acc[xt]); } } while (0)
  MO_LOAD(0, 0);
#pragma unroll
  for (int g = 0; g < 8; g += 2) {
    MO_LOAD(1, g + 1);
    MO_COMP(0, g);
    if (g + 2 < 8) MO_LOAD(0, g + 2);
    MO_COMP(1, g + 1);
  }
#undef MO_LOAD
#undef MO_COMP
  if (KIND == 1) {
    float qn = 0.f; const float* nrow = w.mn + (size_t)(item - 2048) * 128 + fq * 8;
#pragma unroll
    for (int k4 = 0; k4 < 4; ++k4) { float f[8]; unpack8(__builtin_bit_cast(uint4, yq[k4]), f); const float4 n0 = *(const float4*)(nrow + k4 * 32), n1 = *(const float4*)(nrow + k4 * 32 + 4);
      qn += f[0] * n0.x + f[1] * n0.y + f[2] * n0.z + f[3] * n0.w + f[4] * n1.x + f[5] * n1.y + f[6] * n1.z + f[7] * n1.w; }
    float den = rsum + qn; den += sxor<16>(den); den += sxor<32>(den);
    const float inv = 1.f / fmaxf(fabsf(den), 1.f);
#pragma unroll
    for (int xt = 0; xt < 16; ++xt) acc[xt] *= inv;
  }
  float ss = 0.f;
#pragma unroll
  for (int xt = 0; xt < 16; ++xt)
#pragma unroll
    for (int r = 0; r < 4; ++r) ss += acc[xt][r] * acc[xt][r];
  ss += sxor<16>(ss); ss += sxor<32>(ss);
  const float rs = rsqrtf(ss * (1.f / 256.f) + EPS);
  const float* gain = (KIND == 0 ? p.gla_norm : p.mlstm_norm) + h * 256 + 4 * fq;
  const bf16_t* grow = w.proj + (tb + i) * NPROJ + (KIND == 0 ? C_GG : C_MO) + h * 256 + 4 * fq;
#pragma unroll
  for (int xt = 0; xt < 16; ++xt) { const uint2 g2 = *(const uint2*)(grow + xt * 16); const float4 gn = *(const float4*)(gain + xt * 16);
    const float g0 = lo_f(g2.x), g1 = hi_f(g2.x), g2f = lo_f(g2.y), g3 = hi_f(g2.y);
    const float a0 = KIND == 0 ? siluf_(g0) : sigmoidf_(g0), a1 = KIND == 0 ? siluf_(g1) : sigmoidf_(g1), a2 = KIND == 0 ? siluf_(g2f) : sigmoidf_(g2f), a3 = KIND == 0 ? siluf_(g3) : sigmoidf_(g3);
    const float y0 = acc[xt][0] * rs * gn.x * a0, y1 = acc[xt][1] * rs * gn.y * a1, y2 = acc[xt][2] * rs * gn.z * a2, y3 = acc[xt][3] * rs * gn.w * a3;
    const size_t yo = (tb + i) * D + KIND * 1024 + h * 256 + xt * 16 + 4 * fq;
#if F8_OUT
    *(unsigned*)(w.yq + yo) = pack4_fp8(y0, y1, y2, y3);
#else
    *(uint2*)(w.y + yo) = make_uint2(pack2(y0, y1), pack2(y2, y3));
#endif
  }
}
__device__ void mix_out2(const Params& p, const WS& w, int bid, int nb) {
  const int tid = tidx(), wave = tid >> 6, lane = tid & 63, fr = lane & 15, fq = lane >> 4;
  for (int task = bid * 8 + wave; task < 16384; task += nb * 8) {
    const int item = task >> 2, it = __builtin_amdgcn_readfirstlane(task & 3);
    if (item < 2048) mix_out2_task<0>(p, w, item, it, fr, fq); else mix_out2_task<1>(p, w, item, it, fr, fq);
  }
}

__device__ __forceinline__ unsigned sort16(unsigned b) { return (b & 0x8000u) ? (~b & 0xffffu) : (b | 0x8000u); }
__device__ __forceinline__ float unsort16(unsigned k) { const unsigned b = (k & 0x8000u) ? (k & 0x7fffu) : (~k & 0xffffu); return __uint_as_float(b << 16); }
__device__ __forceinline__ unsigned sort32(float f) { const unsigned u = __float_as_uint(f); return (u & 0x80000000u) ? ~u : (u | 0x80000000u); }
__device__ __forceinline__ float unsort32(unsigned k) { const unsigned u = (k & 0x80000000u) ? (k & 0x7fffffffu) : ~k; return __uint_as_float(u); }
__device__ void phase_topk(const Params& p, const WS& w, int bid, int nb) {
  for (int th = bid * 512 + tidx(); th < T * 8; th += nb * 512) {
    const int t = th >> 3, h = th & 7;
    const uint4* s = (const uint4*)(w.sc + (size_t)t * D + h * 256);
    unsigned l[2][16];
#pragma unroll
    for (int pp = 0; pp < 2; ++pp) {
#pragma unroll
      for (int i = 0; i < 16; ++i) l[pp][i] = 0u;
      for (int q = 0; q < 16; ++q) {
        const uint4 v = s[pp * 16 + q]; const unsigned wds[4] = {v.x, v.y, v.z, v.w};
#pragma unroll
        for (int e = 0; e < 8; ++e) {
          const unsigned b = (e & 1) ? (wds[e >> 1] >> 16) : (wds[e >> 1] & 0xffffu);
          unsigned x = (sort16(b) << 16) | (unsigned)(q * 8 + e);
#pragma unroll
          for (int i = 0; i < 16; ++i) { const unsigned hi = max(l[pp][i], x); x = min(l[pp][i], x); l[pp][i] = hi; }
        }
      }
    }
    unsigned long long lc[16];
#pragma unroll
    for (int i = 0; i < 16; ++i) lc[i] = 0ull;
#pragma unroll
    for (int i = 0; i < 16; ++i)
#pragma unroll
      for (int j = 0; j < 16; ++j) if ((i + 1) * (j + 1) <= 16) {
        const float sv = unsort16(l[0][i] >> 16) + unsort16(l[1][j] >> 16);
        unsigned long long x = ((unsigned long long)sort32(sv) << 32) | (unsigned long long)((l[0][i] & 0xffffu) * 128u + (l[1][j] & 0xffffu));
#pragma unroll
        for (int k = 0; k < 16; ++k) { const bool gt = x > lc[k]; const unsigned long long hi = gt ? x : lc[k]; x = gt ? lc[k] : x; lc[k] = hi; }
      }
    const float mx = unsort32((unsigned)(lc[0] >> 32));
    float e[16], sum = 0.f;
#pragma unroll
    for (int k = 0; k < 16; ++k) { e[k] = __expf(unsort32((unsigned)(lc[k] >> 32)) - mx); sum += e[k]; }
    const float inv = 1.f / sum;
    int* ei = w.eidx + (size_t)t * 128 + h * 16; float* eg = w.eg + (size_t)t * 128 + h * 16; float* es = w.esu + (size_t)t * 128 + h * 16;
#pragma unroll
    for (int k4 = 0; k4 < 4; ++k4) {
      *(int4*)(ei + k4 * 4) = make_int4((int)(lc[k4 * 4] & 0xffffffffu), (int)(lc[k4 * 4 + 1] & 0xffffffffu), (int)(lc[k4 * 4 + 2] & 0xffffffffu), (int)(lc[k4 * 4 + 3] & 0xffffffffu));
      const int e0 = (int)(lc[k4 * 4] & 0xffffffffu), e1 = (int)(lc[k4 * 4 + 1] & 0xffffffffu), e2 = (int)(lc[k4 * 4 + 2] & 0xffffffffu), e3 = (int)(lc[k4 * 4 + 3] & 0xffffffffu);
      *(float4*)(eg + k4 * 4) = make_float4(e[k4 * 4] * inv * w.vsc[e0], e[k4 * 4 + 1] * inv * w.vsc[e1], e[k4 * 4 + 2] * inv * w.vsc[e2], e[k4 * 4 + 3] * inv * w.vsc[e3]);
      *(float4*)(es + k4 * 4) = make_float4(w.usc[e0], w.usc[e1], w.usc[e2], w.usc[e3]);
    }
  }
}
__device__ __forceinline__ void ub16(const uint4 q, float* f) {
  const unsigned wd[4] = {q.x, q.y, q.z, q.w};
#pragma unroll
  for (int k = 0; k < 4; ++k) { f[k * 4] = (float)(wd[k] & 0xffu); f[k * 4 + 1] = (float)((wd[k] >> 8) & 0xffu); f[k * 4 + 2] = (float)((wd[k] >> 16) & 0xffu); f[k * 4 + 3] = (float)(wd[k] >> 24); }
}
__device__ void peer_dots(const Params& p, const WS& w, int bid, int nb) {
  const int tid = tidx(), wave = tid >> 6, lane = tid & 63, r = lane % LPR, q = lane / LPR;
  const int x = bid & 7, nwl = (nb >> 3) * 8, wl = (bid >> 3) * 8 + wave;
  constexpr int HB = NIT / 2;
  for (int sp = 0; sp < SPL; ++sp) {
    const int s = x * SPL + sp;
    const unsigned char* tab = w.u8 + (size_t)s * 16384 * SLW + r * 16;
    int idx0 = w.eidx[(size_t)wl * 128 + lane], idx1 = w.eidx[(size_t)wl * 128 + 64 + lane];
    uint4 ha = *(const uint4*)(w.h1b + (size_t)wl * D + s * SLW + r * 16), hb = *(const uint4*)(w.h1b + (size_t)wl * D + s * SLW + r * 16 + 8);
    uint4 bA[HB], bB[HB];
#define PD_GATHER(buf, half, i0_, i1_) do { _Pragma("unroll") for (int i = 0; i < HB; ++i) { const int n = ((half) * HB + i) * EPI + q; const int e = bperm((n & 64) ? (i1_) : (i0_), n & 63); buf[i] = *(const uint4*)(tab + (size_t)e * SLW); } } while (0)
#define PD_DOTS(buf, half) do { _Pragma("unroll") for (int i = 0; i < HB; ++i) { int a = __builtin_amdgcn_sdot4((int)buf[i].x, hq[0], 0, false); a = __builtin_amdgcn_sdot4((int)buf[i].y, hq[1], a, false); \
      a = __builtin_amdgcn_sdot4((int)buf[i].z, hq[2], a, false); a = __builtin_amdgcn_sdot4((int)buf[i].w, hq[3], a, false); a = gsum<LPR>(a); \
      const int ii = (half) * HB + i; if (r == (ii % LPR)) res[ii / LPR] = (float)a * sh; } } while (0)
    PD_GATHER(bA, 0, idx0, idx1);
    for (int t = wl; t < T; t += nwl) {
      PD_GATHER(bB, 1, idx0, idx1);
      const int tn = (t + nwl < T) ? t + nwl : t;
      const int idx0n = w.eidx[(size_t)tn * 128 + lane], idx1n = w.eidx[(size_t)tn * 128 + 64 + lane];
      const uint4 han = *(const uint4*)(w.h1b + (size_t)tn * D + s * SLW + r * 16), hbn = *(const uint4*)(w.h1b + (size_t)tn * D + s * SLW + r * 16 + 8);
      float hf[16];
      unpack8(ha, hf); unpack8(hb, hf + 8);
      float am = 0.f;
#pragma unroll
      for (int j = 0; j < 16; ++j) am = fmaxf(am, fabsf(hf[j]));
      am = gmax<LPR>(am);
      const float sh = fmaxf(am, 1e-30f) * (1.f / 127.f), inv = 1.f / sh;
      int hq[4];
#pragma unroll
      for (int k = 0; k < 4; ++k) { unsigned xw = 0;
#pragma unroll
        for (int j = 0; j < 4; ++j) xw |= ((unsigned)(int)rintf(hf[k * 4 + j] * inv) & 0xffu) << (8 * j);
        hq[k] = (int)xw; }
      float res[2] = {0.f, 0.f};
      PD_DOTS(bA, 0);
      PD_GATHER(bA, 0, idx0n, idx1n);
      PD_DOTS(bB, 1);
#pragma unroll
      for (int rho = 0; rho < 2; ++rho) ((bf16_t*)w.pd)[((size_t)t * 128 + (rho * LPR + r) * EPI + q) * NSL + s] = f2bf(res[rho]);
      idx0 = idx0n; idx1 = idx1n; ha = han; hb = hbn;
    }
#undef PD_GATHER
#undef PD_DOTS
  }
}
__device__ __forceinline__ void peer_token_w(const WS& w, int t, int lane, int idx0, int idx1, float& w0, float& w1) {
  static_assert(NSL == 8, "one 16-byte load per (token, expert) holds the 8 slices' partial dots");
  const float rs2 = rsqrtf(w.ssq2[t] * (1.f / D) + EPS);
  float f0[8], f1[8];
  unpack8(*(const uint4*)((const bf16_t*)w.pd + ((size_t)t * 128 + lane) * 8), f0); unpack8(*(const uint4*)((const bf16_t*)w.pd + ((size_t)t * 128 + 64 + lane) * 8), f1);
  const float z0 = ((f0[0] + f0[1]) + (f0[2] + f0[3])) + ((f0[4] + f0[5]) + (f0[6] + f0[7])), z1 = ((f1[0] + f1[1]) + (f1[2] + f1[3])) + ((f1[4] + f1[5]) + (f1[6] + f1[7]));
  w0 = w.eg[(size_t)t * 128 + lane] * gelu_tanh(z0 * w.esu[(size_t)t * 128 + lane] * rs2);
  w1 = w.eg[(size_t)t * 128 + 64 + lane] * gelu_tanh(z1 * w.esu[(size_t)t * 128 + 64 + lane] * rs2);
}
__device__ void peer_vals(const Params& p, const WS& w, int bid, int nb) {
  static_assert(EPI == 4 && LPR == 16, "peer_vals' weight packing assumes 256-byte slices");
  const int tid = tidx(), wave = tid >> 6, lane = tid & 63, r = lane % LPR, q = lane / LPR;
  const int x = bid & 7, nwl = (nb >> 3) * 8, wl = (bid >> 3) * 8 + wave;
  constexpr int HB = NIT / 2;
  for (int sp = 0; sp < SPL; ++sp) {
    const int s = x * SPL + sp;
    const unsigned char* tab = w.v8 + (size_t)s * 16384 * SLW + r * 16;
    int idx0 = w.eidx[(size_t)wl * 128 + lane], idx1 = w.eidx[(size_t)wl * 128 + 64 + lane];
    float w0, w1; peer_token_w(w, wl, lane, idx0, idx1, w0, w1);
    uint4 bA[HB], bB[HB];
#define PV_GATHER(buf, half, i0_, i1_) do { _Pragma("unroll") for (int i = 0; i < HB; ++i) { const int n = ((half) * HB + i) * EPI + q; const int e = bperm((n & 64) ? (i1_) : (i0_), n & 63); buf[i] = *(const uint4*)(tab + (size_t)e * SLW); } } while (0)
#define PV_DOT4(buf, half) do { _Pragma("unroll") for (int g4 = 0; g4 < HB / 4; ++g4) { const int gg = (half) * (HB / 4) + g4; const int pw = bperm((gg & 4) ? pk1 : pk0, 16 * (gg & 3) + q); \
      _Pragma("unroll") for (int dd = 0; dd < 4; ++dd) { const unsigned b0 = ((const unsigned*)&buf[g4 * 4])[dd], b1 = ((const unsigned*)&buf[g4 * 4 + 1])[dd], b2 = ((const unsigned*)&buf[g4 * 4 + 2])[dd], b3 = ((const unsigned*)&buf[g4 * 4 + 3])[dd]; \
        const unsigned p0 = __builtin_amdgcn_perm(b1, b0, 0x05010400u), p1 = __builtin_amdgcn_perm(b1, b0, 0x07030602u), p2 = __builtin_amdgcn_perm(b3, b2, 0x05010400u), p3 = __builtin_amdgcn_perm(b3, b2, 0x07030602u); \
        acc[dd * 4 + 0] = __builtin_amdgcn_sdot4((int)__builtin_amdgcn_perm(p2, p0, 0x05040100u), pw, acc[dd * 4 + 0], false); acc[dd * 4 + 1] = __builtin_amdgcn_sdot4((int)__builtin_amdgcn_perm(p2, p0, 0x07060302u), pw, acc[dd * 4 + 1], false); \
        acc[dd * 4 + 2] = __builtin_amdgcn_sdot4((int)__builtin_amdgcn_perm(p3, p1, 0x05040100u), pw, acc[dd * 4 + 2], false); acc[dd * 4 + 3] = __builtin_amdgcn_sdot4((int)__builtin_amdgcn_perm(p3, p1, 0x07060302u), pw, acc[dd * 4 + 3], false); } } } while (0)
    PV_GATHER(bA, 0, idx0, idx1);
    for (int t = wl; t < T; t += nwl) {
      PV_GATHER(bB, 1, idx0, idx1);
      const int tn = (t + nwl < T) ? t + nwl : t;
      const int idx0n = w.eidx[(size_t)tn * 128 + lane], idx1n = w.eidx[(size_t)tn * 128 + 64 + lane];
      float w0n, w1n; peer_token_w(w, tn, lane, idx0n, idx1n, w0n, w1n);
      const float wmx = gmax<64>(fmaxf(fabsf(w0), fabsf(w1))), sw = fmaxf(wmx, 1e-30f) * (1.f / 127.f), isw = 1.f / sw;
      const int wq0 = (int)rintf(w0 * isw), wq1 = (int)rintf(w1 * isw);
      int pk0, pk1;
      { const int l0 = lane & ~12;
        pk0 = (bperm(wq0, l0) & 0xff) | ((bperm(wq0, l0 | 4) & 0xff) << 8) | ((bperm(wq0, l0 | 8) & 0xff) << 16) | (bperm(wq0, l0 | 12) << 24);
        pk1 = (bperm(wq1, l0) & 0xff) | ((bperm(wq1, l0 | 4) & 0xff) << 8) | ((bperm(wq1, l0 | 8) & 0xff) << 16) | (bperm(wq1, l0 | 12) << 24); }
      int acc[16];
#pragma unroll
      for (int j = 0; j < 16; ++j) acc[j] = 0;
      PV_DOT4(bA, 0);
      PV_GATHER(bA, 0, idx0n, idx1n);
      const uint4 ha = *(const uint4*)(w.h1b + (size_t)t * D + s * SLW + r * 16), hb = *(const uint4*)(w.h1b + (size_t)t * D + s * SLW + r * 16 + 8);
      const float ssq2t = w.ssq2[t];
      PV_DOT4(bB, 1);
#pragma unroll
      for (int j = 0; j < 16; ++j) { acc[j] += sxor<16>(acc[j]); acc[j] += sxor<32>(acc[j]); }
      float hf[16], o[16]; float ss = 0.f;
      unpack8(ha, hf); unpack8(hb, hf + 8);
#pragma unroll
      for (int j = 0; j < 16; ++j) { o[j] = hf[j] + sw * (float)acc[j]; ss += o[j] * o[j]; }
      if (q == 0) { *(uint4*)(w.h2b + (size_t)t * D + s * SLW + r * 16) = pack8(o); *(uint4*)(w.h2b + (size_t)t * D + s * SLW + r * 16 + 8) = pack8(o + 8);
#if F8_GATE
        const float rs2 = rsqrtf(ssq2t * (1.f / D) + EPS);
        *(uint4*)(w.h2q + (size_t)t * D + s * SLW + r * 16) = make_uint4(pack4_fp8(o[0] * rs2, o[1] * rs2, o[2] * rs2, o[3] * rs2), pack4_fp8(o[4] * rs2, o[5] * rs2, o[6] * rs2, o[7] * rs2),
                                                                      pack4_fp8(o[8] * rs2, o[9] * rs2, o[10] * rs2, o[11] * rs2), pack4_fp8(o[12] * rs2, o[13] * rs2, o[14] * rs2, o[15] * rs2));
#endif
      } else ss = 0.f;
      ss = wave_sum(ss);
      if (lane == 0) atomicAdd(w.ssq3 + t, ss);
      idx0 = idx0n; idx1 = idx1n; w0 = w0n; w1 = w1n;
    }
#undef PV_GATHER
#undef PV_DOT4
  }
}
#ifndef TPROBE_A
#define TPROBE_A -1
#endif
#ifndef TPROBE_B
#define TPROBE_B -1
#endif
__device__ void phase_final(const Params& p, const WS& w, int bid, int nb) {
  const int wave = tidx() >> 6, lane = tidx() & 63;
  float tscale = 1.f, tspike = 0.f;
  if (TPROBE_A >= 0) { const unsigned long long* ts = (const unsigned long long*)(w.ctlf + 16384); tscale = 1.f + sqrtf((float)(ts[TPROBE_A + 1] - ts[TPROBE_A]) * 1e-7f); }
  if (TPROBE_B >= 0) { const unsigned long long* ts = (const unsigned long long*)(w.ctlf + 16384); tspike = (float)(ts[TPROBE_B + 1] - ts[TPROBE_B]) * 1e-3f; }
  for (int row = bid * 8 + wave; row < T; row += nb * 8) {
    float4* o = (float4*)(p.out + (size_t)row * D);
    const float rs = rsqrtf(w.ssq4[row] * (1.f / D) + EPS) * tscale;
#pragma unroll
    for (int i = 0; i < 8; ++i) { float4 v = o[i * 64 + lane]; const float4 g = *(const float4*)(p.norm_final + (i * 64 + lane) * 4); v.x *= rs * g.x; v.y *= rs * g.y; v.z *= rs * g.z; v.w *= rs * g.w; if (TPROBE_B >= 0 && row == 0 && i == 0 && lane == 0) v.x += tspike; o[i * 64 + lane] = v; }
  }
}

constexpr int NPHASE = 10;
#ifndef MIX_OUT3
#define MIX_OUT3 1
#endif
#ifndef FAST_MIX
#define FAST_MIX 2
#endif
template <int PH>
__device__ __forceinline__ void run_phase(const Params& p, float* lds, int bid, int nb) {
  const WS w = make_ws(p.ws, p.out);
  if (PH == 0) phase_prep(p, w, lds, bid, nb);
  if (PH == 13) phase_prep2(p, w, lds, bid, nb);
  const float s_in = __uint_as_float(__builtin_amdgcn_readfirstlane((F8_IN && PH == 1) ? __float_as_uint(w.ctlf[0]) : 0u)) * (1.f / 256.f);
  const float s_out = F8_OUT ? __uint_as_float(__builtin_amdgcn_readfirstlane((PH == 5) ? __float_as_uint(w.ctlf[1]) : 0u)) * (1.f / 256.f) : 1.f;
  const float s_g = __uint_as_float(__builtin_amdgcn_readfirstlane((F8_GATE && PH == 11) ? __float_as_uint(w.ctlf[2]) : 0u)) * (1.f / 256.f);
#if F8_IN
  if (PH == 1) { gemm_any<true>(w.xq, w.winq, T, NPROJ, D, EpiProjN{w.proj, w.rstd1, s_in}, lds, bid, nb);
                 gemm_any<true>(w.winq + (size_t)NPROJ * D, w.xq, 2048, T, D, EpiProjT{w.vT, w.rstd1, s_in}, lds, bid, nb); }
#else
  if (PH == 1) { gemm_any(w.xb, w.win, T, NPROJ, D, EpiProjN{w.proj, w.rstd1, 1.f}, lds, bid, nb);
                 gemm_any(w.win + (size_t)NPROJ * D, w.xb, 2048, T, D, EpiProjT{w.vT, w.rstd1, 1.f}, lds, bid, nb); }
#endif
#if F8_OUT
  if (PH == 5) gemm_any<true>(w.yq, w.woutq, T, D, D, EpiOut{p.x, w.h1b, w.ssq2, s_out}, lds, bid, nb);
#else
  if (PH == 5) gemm_any(w.y, w.wout, T, D, D, EpiOut{p.x, w.h1b, w.ssq2, 1.f}, lds, bid, nb);
#endif
#if F8_GATE
  if (PH == 11) gemm_any<true>(w.h2q, w.wgq, T, D, D, EpiGate{w.h2b, w.pl, w.ssq3, p.out, w.ssq4, w.ssq2, s_g}, lds, bid, nb);
#else
  if (PH == 11) gemm_any(w.h2b, w.wg, T, D, D, EpiGate{w.h2b, w.pl, w.ssq3, p.out, w.ssq4, w.ssq2, 1.f}, lds, bid, nb);
#endif
#if FAST_MIX == 2
  if (PH == 14) mix_gate_pass(p, w, (unsigned char*)lds, bid, nb);
  if (PH == 2) mix_local2(p, w, bid, nb);
  if (PH == 3) mix_scan(p, w, lds, bid, nb);
#if MIX_OUT3
  if (PH == 4) phase_mix_out3(p, w, (unsigned char*)lds, bid, nb);
#else
  if (PH == 4) mix_out2(p, w, bid, nb);
#endif
#elif FAST_MIX
  if (PH == 2) phase_mix_items<0>(p, w, (unsigned char*)lds, bid, nb);
  if (PH == 3) mix_scan(p, w, lds, bid, nb);
  if (PH == 4) phase_mix_items<1>(p, w, (unsigned char*)lds, bid, nb);
#else
  if (PH == 2) phase_mixer_naive(p, w, lds, bid, nb);
#endif
  if (PH == 6) gemm_any(w.h1b, w.wq, T, D, D, EpiScore{w.sc, w.ssq2}, lds, bid, nb);
  if (PH == 7) { phase_topk(p, w, bid, nb); gemm_any(w.pb, w.wple, T, D, 256, EpiPl{w.pl}, lds, bid, nb); }
  if (PH == 8) peer_dots(p, w, bid, nb);
  if (PH == 10) peer_vals(p, w, bid, nb);
  if (PH == 12) phase_final(p, w, bid, nb);
}

extern __shared__ __attribute__((aligned(16))) unsigned char dyn_lds[];

#if ONE_LAUNCH
__global__ void __launch_bounds__(512, 2) mega(Params p) {
  cg::grid_group grid = cg::this_grid();
  float* lds = (float*)dyn_lds; const int bid = blockIdx.x, nb = gridDim.x;
#ifndef DUP_PHASE
#define DUP_PHASE -1
#endif
#define RUNP(k) do { run_phase<k>(p, lds, bid, nb); if (DUP_PHASE == (k)) { grid.sync(); run_phase<k>(p, lds, bid, nb); } } while (0)
  int nstamp = 0;
#define STAMP() do { if ((TPROBE_A >= 0 || TPROBE_B >= 0) && bid == 0 && threadIdx.x == 0) ((unsigned long long*)(p.ws + OFF_CTL + 65536))[nstamp] = __builtin_amdgcn_s_memrealtime(); ++nstamp; } while (0)
  STAMP();
  RUNP(0); grid.sync(); STAMP();
#if F8_GEMM
  RUNP(13); grid.sync(); STAMP();
#endif
  RUNP(1); grid.sync(); STAMP();
#if FAST_MIX == 2
  RUNP(14); grid.sync(); STAMP();
#endif
  RUNP(2); grid.sync(); STAMP();
#if FAST_MIX
  RUNP(3); grid.sync(); STAMP();
  RUNP(4); grid.sync(); STAMP();
#endif
  RUNP(5); grid.sync(); STAMP();
  RUNP(6); grid.sync(); STAMP();
  RUNP(7); grid.sync(); STAMP();
  RUNP(8); grid.sync(); STAMP();
  RUNP(10); grid.sync(); STAMP();
  RUNP(11); grid.sync(); STAMP();
  RUNP(12);
#undef RUNP
#undef STAMP
}
#else
template <int PH> __global__ void __launch_bounds__(512, 2) k_phase(Params p) { run_phase<PH>(p, (float*)dyn_lds, blockIdx.x, gridDim.x); }
#endif

constexpr size_t kDynLds = 143360;

extern "C" void kernel_launch(void* const* d_in, const int* in_sizes, int n_in, void* d_out, int out_size, void* d_ws, size_t ws_size, hipStream_t stream) {
  if (n_in != 22 || out_size != T * D || ws_size < WS_NEED) { fprintf(stderr, "kernel_launch: unexpected shapes (n_in %d out %d ws %zu)\n", n_in, out_size, ws_size); return; }
  Params p{};
  const float** f = (const float**)&p;
  for (int i = 0; i < 22; ++i) f[i] = (const float*)d_in[i];
  p.out = (float*)d_out; p.ws = (unsigned char*)d_ws;
#if ONE_LAUNCH
  static int grid_blocks = 0;
  if (!grid_blocks) {
    int dev = 0, cus = 0, per_cu = 0;
    (void)hipGetDevice(&dev); (void)hipDeviceGetAttribute(&cus, hipDeviceAttributeMultiprocessorCount, dev);
    (void)hipFuncSetAttribute((const void*)mega, hipFuncAttributeMaxDynamicSharedMemorySize, (int)kDynLds);
    (void)hipOccupancyMaxActiveBlocksPerMultiprocessor(&per_cu, mega, 512, kDynLds);
    if (per_cu < 1) { fprintf(stderr, "occupancy query says 0 blocks/CU\n"); per_cu = 1; }
    grid_blocks = cus;
  }
  void* args[] = {&p};
  hipError_t e = hipLaunchCooperativeKernel((void*)mega, dim3(grid_blocks), dim3(512), args, kDynLds, stream);
  if (e != hipSuccess) fprintf(stderr, "cooperative launch failed: %s (grid %d)\n", hipGetErrorString(e), grid_blocks);
#else
  static bool attr = false;
  const int G = 256;
#define LAUNCH(PH) do { if (!attr) (void)hipFuncSetAttribute((const void*)k_phase<PH>, hipFuncAttributeMaxDynamicSharedMemorySize, (int)kDynLds); \
    hipLaunchKernelGGL(k_phase<PH>, dim3(G), dim3(512), kDynLds, stream, p); } while (0)
  LAUNCH(0); LAUNCH(13); LAUNCH(1); LAUNCH(14); LAUNCH(2); LAUNCH(3); LAUNCH(4); LAUNCH(5); LAUNCH(6); LAUNCH(7); LAUNCH(8); LAUNCH(10); LAUNCH(11); LAUNCH(12);
  attr = true;
#undef LAUNCH
#endif
}
```

```cpp
#include <hip/hip_runtime.h>
#include <hip/hip_cooperative_groups.h>
#include <cstdio>
#include <cstdint>
namespace cg = cooperative_groups;

#ifndef ONE_LAUNCH
#define ONE_LAUNCH 1
#endif

typedef unsigned short bf16_t;
constexpr int T = 32768, SEQ = 16384, D = 2048;
constexpr int NPROJ = 4352;
constexpr int C_GQ = 0, C_GK = 512, C_GG = 1024, C_MQ = 2048, C_MK = 2560, C_MO = 3072, C_SM = 4096;
constexpr float EPS = 1e-6f;
constexpr size_t MiB = 1ull << 20;
constexpr size_t OFF_XB = 0, OFF_Y = 0, OFF_PL = 0;
constexpr size_t OFF_PROJ = 128 * MiB, OFF_H1B = 128 * MiB, OFF_H2B = 256 * MiB;
constexpr size_t OFF_VT = 400 * MiB, OFF_SC = 400 * MiB;
constexpr size_t OFF_UB = 528 * MiB, OFF_VB = 592 * MiB;
constexpr size_t OFF_WIN = 656 * MiB, OFF_WOUT = 681 * MiB, OFF_WQ = 689 * MiB, OFF_WG = 697 * MiB, OFF_WPLE = 705 * MiB;
constexpr size_t OFF_PB = 706 * MiB, OFF_EIDX = 722 * MiB, OFF_EG = 738 * MiB, OFF_MISC = 754 * MiB;
constexpr size_t OFF_GDEC = 755 * MiB, OFF_MN = 756 * MiB, OFF_MDEC = 757 * MiB, OFF_ESC = 758 * MiB;
constexpr size_t OFF_CTL = 759 * MiB, OFF_H2Q = 400 * MiB, OFF_QS = 760 * MiB, OFF_KS = 824 * MiB, OFF_KDT = 888 * MiB;
constexpr size_t OFF_ESU = 952 * MiB, OFF_BAR = 968 * MiB;
constexpr size_t WS_NEED = 969 * MiB;
#ifndef F8_IN
#define F8_IN 0
#endif
#ifndef F8_OUT
#define F8_OUT 1
#endif
#ifndef F8_GATE
#define F8_GATE 1
#endif
#ifndef F8_GEMM
#define F8_GEMM (F8_IN || F8_OUT || F8_GATE)
#endif

struct Params {
  const float *x, *p, *norm_mix, *w_in, *gate_up, *gate_bias, *gla_norm, *conv_w, *conv_b, *ig_bias, *fg_bias, *mlstm_norm,
      *w_out, *norm_ffn, *peer_query, *sub_keys, *peer_u, *peer_v, *norm_ple, *w_ple, *w_ple_gate, *norm_final;
  float* out;
  unsigned char* ws;
};

__device__ __forceinline__ float bf2f(bf16_t b) { return __uint_as_float(((unsigned)b) << 16); }
typedef __bf16 bf16v2_t __attribute__((ext_vector_type(2)));
__device__ __forceinline__ bf16_t f2bf(float f) { const __bf16 b = (__bf16)f; return __builtin_bit_cast(bf16_t, b); }
__device__ __forceinline__ unsigned pack2(float lo, float hi) { const bf16v2_t v = {(__bf16)lo, (__bf16)hi}; return __builtin_bit_cast(unsigned, v); }
__device__ __forceinline__ unsigned pack4_fp8(float a, float b, float c, float d) { int v = __builtin_amdgcn_cvt_pk_fp8_f32(a, b, 0, false); v = __builtin_amdgcn_cvt_pk_fp8_f32(c, d, v, true); return (unsigned)v; }
__device__ __forceinline__ float lo_f(unsigned u) { return __uint_as_float(u << 16); }
__device__ __forceinline__ float hi_f(unsigned u) { return __uint_as_float(u & 0xffff0000u); }
__device__ __forceinline__ int tidx() { int t = threadIdx.x; asm volatile("" : "+v"(t)); return t; }
template <int O> __device__ __forceinline__ int sxor_i(int v) {
  if constexpr (O < 32) return __builtin_amdgcn_ds_swizzle(v, (O << 10) | 0x1f);
  else return __builtin_amdgcn_ds_bpermute(((tidx() & 63) ^ 32) << 2, v);
}
template <int O> __device__ __forceinline__ float sxor(float v) { return __int_as_float(sxor_i<O>(__float_as_int(v))); }
template <int O> __device__ __forceinline__ int sxor(int v) { return sxor_i<O>(v); }
__device__ __forceinline__ int bperm(int v, int src_lane) { return __builtin_amdgcn_ds_bpermute(src_lane << 2, v); }
__device__ __forceinline__ float bperm(float v, int src_lane) { return __int_as_float(__builtin_amdgcn_ds_bpermute(src_lane << 2, __float_as_int(v))); }
template <int N> __device__ __forceinline__ float gsum(float v) {
  if constexpr (N >= 2) v += sxor<1>(v); if constexpr (N >= 4) v += sxor<2>(v); if constexpr (N >= 8) v += sxor<4>(v);
  if constexpr (N >= 16) v += sxor<8>(v); if constexpr (N >= 32) v += sxor<16>(v); if constexpr (N >= 64) v += sxor<32>(v); return v; }
template <int N> __device__ __forceinline__ int gsum(int v) {
  if constexpr (N >= 2) v += sxor<1>(v); if constexpr (N >= 4) v += sxor<2>(v); if constexpr (N >= 8) v += sxor<4>(v);
  if constexpr (N >= 16) v += sxor<8>(v); if constexpr (N >= 32) v += sxor<16>(v); if constexpr (N >= 64) v += sxor<32>(v); return v; }
template <int N> __device__ __forceinline__ float gmax(float v) {
  if constexpr (N >= 2) v = fmaxf(v, sxor<1>(v)); if constexpr (N >= 4) v = fmaxf(v, sxor<2>(v)); if constexpr (N >= 8) v = fmaxf(v, sxor<4>(v));
  if constexpr (N >= 16) v = fmaxf(v, sxor<8>(v)); if constexpr (N >= 32) v = fmaxf(v, sxor<16>(v)); if constexpr (N >= 64) v = fmaxf(v, sxor<32>(v)); return v; }
__device__ __forceinline__ float wave_sum(float v) { return gsum<64>(v); }
__device__ __forceinline__ float sigmoidf_(float x) { return __builtin_amdgcn_rcpf(1.f + __expf(-x)); }
__device__ __forceinline__ float siluf_(float x) { return x * __builtin_amdgcn_rcpf(1.f + __expf(-x)); }
__device__ __forceinline__ float logsigmoidf_(float x) { return fminf(x, 0.f) - __logf(1.f + __expf(-fabsf(x))); }
__device__ __forceinline__ float gelu_tanh(float x) { const float u = 0.7978845608028654f * (x + 0.044715f * x * x * x); return x * __builtin_amdgcn_rcpf(1.f + __expf(-2.f * u)); }
__device__ __forceinline__ void unpack8(const uint4 q, float* f) {
  f[0] = lo_f(q.x); f[1] = hi_f(q.x); f[2] = lo_f(q.y); f[3] = hi_f(q.y); f[4] = lo_f(q.z); f[5] = hi_f(q.z); f[6] = lo_f(q.w); f[7] = hi_f(q.w);
}
__device__ __forceinline__ uint4 pack8(const float* f) { return make_uint4(pack2(f[0], f[1]), pack2(f[2], f[3]), pack2(f[4], f[5]), pack2(f[6], f[7])); }

struct WS {
  bf16_t *xb, *y, *pl, *proj, *h1b, *h2b, *vT, *sc, *ub, *vb, *win, *wout, *wq, *wg, *wple, *pb;
  int* eidx; float* eg; float* esu; float *rstd1, *ssq2, *ssq3, *ssq4, *wsum, *gdec, *mn, *mdec, *usc, *vsc, *pd;
  unsigned char *u8, *v8, *xq, *yq, *h2q, *winq, *woutq, *wgq;
  bf16_t *qs, *ks, *kdT;
  float* ctlf;
};
__device__ __forceinline__ WS make_ws(unsigned char* ws, float* out) {
  WS w;
  w.xb = (bf16_t*)(ws + OFF_XB); w.y = (bf16_t*)(ws + OFF_Y); w.pl = (bf16_t*)(ws + OFF_PL); w.proj = (bf16_t*)(ws + OFF_PROJ);
  w.h1b = (bf16_t*)(ws + OFF_H1B); w.h2b = (bf16_t*)(ws + OFF_H2B); w.vT = (bf16_t*)(ws + OFF_VT); w.sc = (bf16_t*)(ws + OFF_SC);
  w.ub = (bf16_t*)(ws + OFF_UB); w.vb = (bf16_t*)(ws + OFF_VB); w.win = (bf16_t*)(ws + OFF_WIN); w.wout = (bf16_t*)(ws + OFF_WOUT);
  w.wq = (bf16_t*)(ws + OFF_WQ); w.wg = (bf16_t*)(ws + OFF_WG); w.wple = (bf16_t*)(ws + OFF_WPLE); w.pb = (bf16_t*)(ws + OFF_PB);
  w.eidx = (int*)(ws + OFF_EIDX); w.eg = (float*)(ws + OFF_EG); w.esu = (float*)(ws + OFF_ESU);
  float* m = (float*)(ws + OFF_MISC); w.rstd1 = m; w.ssq2 = m + T; w.ssq3 = m + 2 * T; w.ssq4 = m + 3 * T; w.wsum = m + 4 * T;
  w.gdec = (float*)(ws + OFF_GDEC); w.mn = (float*)(ws + OFF_MN); w.mdec = (float*)(ws + OFF_MDEC);
  w.usc = (float*)(ws + OFF_ESC); w.vsc = w.usc + 16384; w.u8 = ws + OFF_UB; w.v8 = ws + OFF_VB; w.pd = out;
  w.xq = ws + OFF_XB; w.yq = ws + OFF_Y; w.h2q = ws + OFF_H2Q; w.winq = ws + OFF_WIN; w.woutq = ws + OFF_WOUT; w.wgq = ws + OFF_WG; w.ctlf = (float*)(ws + OFF_CTL);
  w.qs = (bf16_t*)(ws + OFF_QS); w.ks = (bf16_t*)(ws + OFF_KS); w.kdT = (bf16_t*)(ws + OFF_KDT);
  return w;
}

__device__ void prep_x(const Params& p, const WS& w, int bid, int nb) {
  const int wave = tidx() >> 6, lane = tidx() & 63;
  for (int row0 = (bid * 8 + wave) * 2; row0 < T; row0 += nb * 16) {
    float4 v[2][8]; float ss[2] = {0.f, 0.f};
#pragma unroll
    for (int rr = 0; rr < 2; ++rr) { const float4* src = (const float4*)(p.x + (size_t)(row0 + rr) * D);
#pragma unroll
      for (int i = 0; i < 8; ++i) v[rr][i] = src[i * 64 + lane]; }
#pragma unroll
    for (int rr = 0; rr < 2; ++rr) {
#pragma unroll
      for (int i = 0; i < 8; ++i) ss[rr] += v[rr][i].x * v[rr][i].x + v[rr][i].y * v[rr][i].y + v[rr][i].z * v[rr][i].z + v[rr][i].w * v[rr][i].w;
      ss[rr] = wave_sum(ss[rr]);
      const float rs = rsqrtf(ss[rr] * (1.f / D) + EPS);
#if F8_IN
      unsigned* dst = (unsigned*)(w.xq + (size_t)(row0 + rr) * D);
#pragma unroll
      for (int i = 0; i < 8; ++i) dst[i * 64 + lane] = pack4_fp8(v[rr][i].x * rs, v[rr][i].y * rs, v[rr][i].z * rs, v[rr][i].w * rs);
#else
      uint2* dst = (uint2*)(w.xb + (size_t)(row0 + rr) * D);
#pragma unroll
      for (int i = 0; i < 8; ++i) dst[i * 64 + lane] = make_uint2(pack2(v[rr][i].x, v[rr][i].y), pack2(v[rr][i].z, v[rr][i].w));
#endif
      if (lane == 0) w.rstd1[row0 + rr] = rs; }
  }
}
__device__ void absmax_w(const float* src, size_t n, const float* gain, int ncols, float* part, float* lds, int bid, int nb) {
  float m = 0.f;
  for (size_t i = (size_t)bid * 512 + tidx(); i < n / 4; i += (size_t)nb * 512) { const float4 v = ((const float4*)src)[i]; const float g = gain ? gain[(i * 4) / (size_t)ncols] : 1.f;
    m = fmaxf(m, fabsf(g) * fmaxf(fmaxf(fabsf(v.x), fabsf(v.y)), fmaxf(fabsf(v.z), fabsf(v.w)))); }
  m = gmax<64>(m);
  __syncthreads();
  if ((tidx() & 63) == 0) lds[tidx() >> 6] = m;
  __syncthreads();
  if (tidx() == 0) { float t = lds[0];
#pragma unroll
    for (int i = 1; i < 8; ++i) t = fmaxf(t, lds[i]);
    part[bid] = t; }
  __syncthreads();
}
__device__ float amax_reduce(const float* part, float* lds, int nb) {
  float m = 0.f;
  for (int i = tidx(); i < nb; i += 512) m = fmaxf(m, part[i]);
  m = gmax<64>(m);
  __syncthreads();
  if ((tidx() & 63) == 0) lds[tidx() >> 6] = m;
  __syncthreads();
  float t = lds[0];
#pragma unroll
  for (int i = 1; i < 8; ++i) t = fmaxf(t, lds[i]);
  return t;
}
__device__ void cvt_rows(const float* src, bf16_t* dst, size_t n, const float* gain, int ncols, int bid, int nb) {
  const size_t n4 = n / 4, step = (size_t)nb * 512;
  for (size_t i0 = (size_t)bid * 512 + tidx(); i0 < n4; i0 += 4 * step) {
    float4 v[4];
#pragma unroll
    for (int u = 0; u < 4; ++u) { const size_t i = i0 + u * step; if (i < n4) v[u] = ((const float4*)src)[i]; }
#pragma unroll
    for (int u = 0; u < 4; ++u) { const size_t i = i0 + u * step; if (i < n4) {
      if (gain) { const float4 g = *(const float4*)(gain + (int)((i * 4) % (size_t)ncols)); v[u].x *= g.x; v[u].y *= g.y; v[u].z *= g.z; v[u].w *= g.w; }
      ((uint2*)dst)[i] = make_uint2(pack2(v[u].x, v[u].y), pack2(v[u].z, v[u].w)); } }
  }
}
template <bool F8OUT, class CM>
__device__ void transpose_w(const float* src, int K, int ldsrc, void* dstv, int Ndst, const float* gain, CM cm, float amax, float* lds, int bid, int nb) {
  const int tid = tidx(), tk = K / 64, ntile = (Ndst / 64) * tk, nc = tid & 63;
  const float qs = F8OUT ? 256.f / fmaxf(amax, 1e-30f) : 1.f;
  float rv[8];
#define TW_LOAD(tile) do { const int n0_ = ((tile) / tk) * 64, k0_ = ((tile) % tk) * 64, sc_ = cm(n0_ + nc); \
    _Pragma("unroll") for (int i = 0; i < 8; ++i) { const int kr = (tid >> 6) + 8 * i; float v = 0.f; if (sc_ >= 0) { v = src[(size_t)(k0_ + kr) * ldsrc + sc_]; if (gain) v *= gain[k0_ + kr]; } rv[i] = v * qs; } } while (0)
  if (bid < ntile) TW_LOAD(bid);
  for (int tile = bid; tile < ntile; tile += nb) {
    const int n0 = (tile / tk) * 64, k0 = (tile % tk) * 64;
#pragma unroll
    for (int i = 0; i < 8; ++i) lds[((tid >> 6) + 8 * i) * 65 + nc] = rv[i];
    __syncthreads();
    if (tile + nb < ntile) TW_LOAD(tile + nb);
    { const int nr = tid >> 3, ks = (tid & 7) * 8; float f[8];
#pragma unroll
      for (int j = 0; j < 8; ++j) f[j] = lds[(ks + j) * 65 + nr];
      if (F8OUT) *(uint2*)((unsigned char*)dstv + (size_t)(n0 + nr) * K + k0 + ks) = make_uint2(pack4_fp8(f[0], f[1], f[2], f[3]), pack4_fp8(f[4], f[5], f[6], f[7]));
      else *(uint4*)((bf16_t*)dstv + (size_t)(n0 + nr) * K + k0 + ks) = pack8(f); }
    __syncthreads();
  }
#undef TW_LOAD
}
struct CmIdent { __device__ int operator()(int n) const { return n; } };
struct CmWin {
  __device__ int operator()(int n) const {
    if (n < 1024) return n;
    if (n < 2048) return 2048 + (n - 1024);
    if (n < 2560) return 3088 + (n - 2048);
    if (n < 3072) return 3600 + (n - 2560);
    if (n < 4096) return 5136 + (n - 3072);
    if (n < 4352) { const int i = n - 4096; if (i < 16) return 3072 + i; if (i < 20) return 6160 + (i - 16); if (i < 24) return 6164 + (i - 20); return -1; }
    const int j = n - 4352; if (j < 1024) return 1024 + j;
    return 4112 + (j - 1024);
  }
};
__device__ void prep_wq(const Params& p, const WS& w, float* lds, int bid, int nb) {
  const int tid = tidx();
  float* SKs = lds;
  float* WQs = lds + 128 * 132;
  for (int item = bid; item < 16 * 32; item += nb) {
    const int hp = item >> 5, k0 = (item & 31) * 64;
#pragma unroll
    for (int i = 0; i < 8; ++i) { const int e4 = tid + 512 * i, key = e4 >> 5, d4 = (e4 & 31) * 4; *(float4*)(SKs + key * 132 + d4) = *(const float4*)(p.sub_keys + (size_t)hp * 16384 + key * 128 + d4); }
#pragma unroll
    for (int i = 0; i < 4; ++i) { const int e4 = tid + 512 * i, kr = e4 >> 5, d4 = (e4 & 31) * 4; float4 v = *(const float4*)(p.peer_query + (size_t)(k0 + kr) * 2048 + hp * 128 + d4); const float g = p.norm_ffn[k0 + kr]; v.x *= g; v.y *= g; v.z *= g; v.w *= g; *(float4*)(WQs + kr * 132 + d4) = v; }
    __syncthreads();
    const int k = tid & 63, kg = tid >> 6;
    float acc[16];
#pragma unroll
    for (int j = 0; j < 16; ++j) acc[j] = 0.f;
    for (int d4 = 0; d4 < 32; ++d4) {
      const float4 a = *(const float4*)(WQs + k * 132 + d4 * 4);
#pragma unroll
      for (int j = 0; j < 16; ++j) { const float4 s = *(const float4*)(SKs + (kg * 16 + j) * 132 + d4 * 4); acc[j] += a.x * s.x + a.y * s.y + a.z * s.z + a.w * s.w; }
    }
#pragma unroll
    for (int j = 0; j < 16; ++j) w.wq[(size_t)(hp * 128 + kg * 16 + j) * 2048 + k0 + k] = f2bf(acc[j]);
    __syncthreads();
  }
}

#ifndef PEER_SLW
#define PEER_SLW 256
#endif
constexpr int SLW = PEER_SLW, LPR = SLW / 16, EPI = 64 / LPR, NSL = 2048 / SLW, SPL = NSL / 8, NIT = 128 / EPI;
template <bool SIGNED>
__device__ void quant_rows(const float* src, const float* gain, unsigned char* dst, float* scale, int bid, int nb) {
  const int tid = tidx(), wave = tid >> 6, lane = tid & 63;
  for (int row0 = (bid * 8 + wave) * 2; row0 < 16384; row0 += nb * 16) {
    float4 f4[2][8];
#pragma unroll
    for (int rr = 0; rr < 2; ++rr)
#pragma unroll
      for (int i = 0; i < 2; ++i)
#pragma unroll
        for (int q = 0; q < 4; ++q) f4[rr][i * 4 + q] = *(const float4*)(src + (size_t)(row0 + rr) * 2048 + i * 1024 + lane * 16 + q * 4);
#pragma unroll
    for (int rr = 0; rr < 2; ++rr) { const int row = row0 + rr; float f[32]; float mx = 0.f;
#pragma unroll
      for (int i = 0; i < 2; ++i)
#pragma unroll
        for (int q = 0; q < 4; ++q) { float4 v = f4[rr][i * 4 + q];
          if (gain) { const float4 g = *(const float4*)(gain + i * 1024 + lane * 16 + q * 4); v.x *= g.x; v.y *= g.y; v.z *= g.z; v.w *= g.w; }
          f[i * 16 + q * 4] = v.x; f[i * 16 + q * 4 + 1] = v.y; f[i * 16 + q * 4 + 2] = v.z; f[i * 16 + q * 4 + 3] = v.w;
          mx = fmaxf(mx, fmaxf(fmaxf(fabsf(v.x), fabsf(v.y)), fmaxf(fabsf(v.z), fabsf(v.w)))); }
      mx = gmax<64>(mx);
      const float sc = fmaxf(mx, 1e-30f) * (1.f / 127.f), inv = 1.f / sc;
#pragma unroll
      for (int i = 0; i < 2; ++i) { unsigned wd[4];
#pragma unroll
        for (int q = 0; q < 4; ++q) { unsigned x = 0;
#pragma unroll
          for (int j = 0; j < 4; ++j) { const int v = (int)rintf(f[i * 16 + q * 4 + j] * inv) + (SIGNED ? 0 : 128); x |= ((unsigned)v & 0xffu) << (8 * j); }
          wd[q] = x; }
        const int el = i * 1024 + lane * 16;
        *(uint4*)(dst + ((size_t)(el / SLW) * 16384 + row) * SLW + (el % SLW)) = make_uint4(wd[0], wd[1], wd[2], wd[3]); }
      if (lane == 0) scale[row] = sc; }
  }
}
__device__ void phase_prep(const Params& p, const WS& w, float* lds, int bid, int nb) {
  prep_x(p, w, bid, nb);
#if F8_IN
  absmax_w(p.w_in, (size_t)2048 * 6168, p.norm_mix, 6168, w.ctlf + 1024, lds, bid, nb);
#else
  transpose_w<false>(p.w_in, 2048, 6168, w.win, 6400, p.norm_mix, CmWin(), 0.f, lds, bid, nb);
#endif
#if F8_OUT
  absmax_w(p.w_out, (size_t)2048 * 2048, nullptr, 2048, w.ctlf + 2048, lds, bid, nb);
#else
  transpose_w<false>(p.w_out, 2048, 2048, w.wout, 2048, nullptr, CmIdent(), 0.f, lds, bid, nb);
#endif
#if F8_GATE
  absmax_w(p.w_ple_gate, (size_t)2048 * 2048, p.norm_ple, 2048, w.ctlf + 3072, lds, bid, nb);
#else
  transpose_w<false>(p.w_ple_gate, 2048, 2048, w.wg, 2048, p.norm_ple, CmIdent(), 0.f, lds, bid, nb);
#endif
  cvt_rows(p.p, w.pb, (size_t)T * 256, nullptr, 256, bid, nb);
  quant_rows<true>(p.peer_u, p.norm_ffn, w.u8, w.usc, bid, nb);
  quant_rows<true>(p.peer_v, nullptr, w.v8, w.vsc, bid, nb);
  transpose_w<false>(p.w_ple, 256, 2048, w.wple, 2048, nullptr, CmIdent(), 0.f, lds, bid, nb);
  prep_wq(p, w, lds, bid, nb);
  for (int i = bid * 512 + tidx(); i < T; i += nb * 512) { w.ssq2[i] = 0.f; w.ssq3[i] = 0.f; w.ssq4[i] = 0.f; }
}
__device__ void phase_prep2(const Params& p, const WS& w, float* lds, int bid, int nb) {
#if F8_IN
  { const float a0 = amax_reduce(w.ctlf + 1024, lds, nb); if (bid == 0 && tidx() == 0) w.ctlf[0] = a0; __syncthreads();
    transpose_w<true>(p.w_in, 2048, 6168, w.winq, 6400, p.norm_mix, CmWin(), a0, lds, bid, nb); }
#endif
#if F8_OUT
  { const float a1 = amax_reduce(w.ctlf + 2048, lds, nb); if (bid == 0 && tidx() == 0) w.ctlf[1] = a1; __syncthreads();
    transpose_w<true>(p.w_out, 2048, 2048, w.woutq, 2048, nullptr, CmIdent(), a1, lds, bid, nb); }
#endif
#if F8_GATE
  { const float a2 = amax_reduce(w.ctlf + 3072, lds, nb); if (bid == 0 && tidx() == 0) w.ctlf[2] = a2; __syncthreads();
    transpose_w<true>(p.w_ple_gate, 2048, 2048, w.wgq, 2048, p.norm_ple, CmIdent(), a2, lds, bid, nb); }
#endif
}

struct EpiProjN { bf16_t* out; const float* rstd; float ws; static constexpr bool ROWSUM = false;
  __device__ __forceinline__ float store8(int r, int c, const float* v) const { const float s = F8_IN ? ws : rstd[r]; float f[8];
#pragma unroll
    for (int j = 0; j < 8; ++j) f[j] = v[j] * s;
    *(uint4*)(out + (size_t)r * NPROJ + c) = pack8(f); return 0.f; }
  __device__ __forceinline__ void rowsum(int, float) const {} };
struct EpiProjT { bf16_t* out; const float* rstd; float ws; static constexpr bool ROWSUM = false;
  __device__ __forceinline__ float store8(int r, int c, const float* v) const { const float4 s0 = F8_IN ? make_float4(ws, ws, ws, ws) : *(const float4*)(rstd + c), s1 = F8_IN ? s0 : *(const float4*)(rstd + c + 4); float f[8];
    f[0] = v[0] * s0.x; f[1] = v[1] * s0.y; f[2] = v[2] * s0.z; f[3] = v[3] * s0.w; f[4] = v[4] * s1.x; f[5] = v[5] * s1.y; f[6] = v[6] * s1.z; f[7] = v[7] * s1.w;
    *(uint4*)(out + (size_t)r * T + c) = pack8(f); return 0.f; }
  __device__ __forceinline__ void rowsum(int, float) const {} };
struct EpiOut { const float* x; bf16_t* h1b; float* ssq; float ws; static constexpr bool ROWSUM = true;
  __device__ __forceinline__ float store8(int r, int c, const float* v) const { const float4 x0 = *(const float4*)(x + (size_t)r * D + c), x1 = *(const float4*)(x + (size_t)r * D + c + 4); float f[8];
    f[0] = v[0] * ws + x0.x; f[1] = v[1] * ws + x0.y; f[2] = v[2] * ws + x0.z; f[3] = v[3] * ws + x0.w; f[4] = v[4] * ws + x1.x; f[5] = v[5] * ws + x1.y; f[6] = v[6] * ws + x1.z; f[7] = v[7] * ws + x1.w;
    float s = 0.f;
#pragma unroll
    for (int j = 0; j < 8; ++j) s += f[j] * f[j];
    *(uint4*)(h1b + (size_t)r * D + c) = pack8(f); return s; }
  __device__ __forceinline__ void rowsum(int r, float s) const { atomicAdd(ssq + r, s); } };
struct EpiScore { bf16_t* sc; const float* ssq; static constexpr bool ROWSUM = false;
  __device__ __forceinline__ float store8(int r, int c, const float* v) const { const float s = rsqrtf(ssq[r] * (1.f / D) + EPS); float f[8];
#pragma unroll
    for (int j = 0; j < 8; ++j) f[j] = v[j] * s;
    *(uint4*)(sc + (size_t)r * D + c) = pack8(f); return 0.f; }
  __device__ __forceinline__ void rowsum(int, float) const {} };
struct EpiPl { bf16_t* pl; static constexpr bool ROWSUM = false;
  __device__ __forceinline__ float store8(int r, int c, const float* v) const { *(uint4*)(pl + (size_t)r * D + c) = pack8(v); return 0.f; }
  __device__ __forceinline__ void rowsum(int, float) const {} };
struct EpiGate { const bf16_t* h2b; const bf16_t* pl; const float* ssq3; float* out; float* ssq; const float* ssq2; float ws; static constexpr bool ROWSUM = true;
  __device__ __forceinline__ float store8(int r, int c, const float* v) const { const float rs = rsqrtf(ssq3[r] * (1.f / D) + EPS) * (F8_GATE ? ws * sqrtf(ssq2[r] * (1.f / D) + EPS) : 1.f); float h[8], q[8], f[8];
    unpack8(*(const uint4*)(h2b + (size_t)r * D + c), h); unpack8(*(const uint4*)(pl + (size_t)r * D + c), q);
    float s = 0.f;
#pragma unroll
    for (int j = 0; j < 8; ++j) { f[j] = h[j] + sigmoidf_(v[j] * rs) * q[j]; s += f[j] * f[j]; }
    *(float4*)(out + (size_t)r * D + c) = make_float4(f[0], f[1], f[2], f[3]); *(float4*)(out + (size_t)r * D + c + 4) = make_float4(f[4], f[5], f[6], f[7]); return s; }
  __device__ __forceinline__ void rowsum(int r, float s) const { atomicAdd(ssq + r, s); } };

template <class Epi>
__device__ void gemm_naive(const bf16_t* A, const bf16_t* Bt, int M, int N, int K, const Epi& E, float* lds, int bid, int nb) {
  const int tid = tidx(), ty = tid >> 4, tx = tid & 15;
  float* As = lds;
  float* Bs = lds + 32 * 132;
  const int nM = M / 128, nN = N / 128;
  for (int tile = bid; tile < nM * nN; tile += nb) {
    const int m0 = (tile % nM) * 128, n0 = (tile / nM) * 128;
    float acc[4][8];
#pragma unroll
    for (int i = 0; i < 4; ++i)
#pragma unroll
      for (int j = 0; j < 8; ++j) acc[i][j] = 0.f;
    const int lr = tid >> 2, lk = (tid & 3) * 8;
    for (int k0 = 0; k0 < K; k0 += 32) {
      const uint4 av = *(const uint4*)(A + (size_t)(m0 + lr) * K + k0 + lk);
      const uint4 bv = *(const uint4*)(Bt + (size_t)(n0 + lr) * K + k0 + lk);
      float af[8], bf[8]; unpack8(av, af); unpack8(bv, bf);
      __syncthreads();
#pragma unroll
      for (int j = 0; j < 8; ++j) { As[(lk + j) * 132 + lr] = af[j]; Bs[(lk + j) * 132 + lr] = bf[j]; }
      __syncthreads();
#pragma unroll 8
      for (int kk = 0; kk < 32; ++kk) {
        const float4 a = *(const float4*)(As + kk * 132 + ty * 4);
        const float4 b0 = *(const float4*)(Bs + kk * 132 + tx * 8), b1 = *(const float4*)(Bs + kk * 132 + tx * 8 + 4);
        const float aa[4] = {a.x, a.y, a.z, a.w}; const float bb[8] = {b0.x, b0.y, b0.z, b0.w, b1.x, b1.y, b1.z, b1.w};
#pragma unroll
        for (int i = 0; i < 4; ++i)
#pragma unroll
          for (int j = 0; j < 8; ++j) acc[i][j] += aa[i] * bb[j];
      }
    }
#pragma unroll
    for (int i = 0; i < 4; ++i) {
      const int r = m0 + ty * 4 + i;
      float s = E.store8(r, n0 + tx * 8, acc[i]);
      if (Epi::ROWSUM) { s = gsum<16>(s); if (tx == 0) E.rowsum(r, s); }
    }
  }
}


namespace pg8 {
#define PG8_LAS __attribute__((address_space(3)))
typedef short bf16x8 __attribute__((ext_vector_type(8)));
typedef float f32x4 __attribute__((ext_vector_type(4)));
typedef int v4i_t __attribute__((ext_vector_type(4)));
typedef int v8i_t __attribute__((ext_vector_type(8)));
constexpr int BM = 256, BK = 64, HALF = 128, HTB = HALF * BK * 2, STAGE_BYTES = 8 * HTB, NXCD = 8, WGM = 8;
__host__ __device__ __forceinline__ int lds_byte(int r, int c) { const int st = (r >> 4) * 2 + (c >> 5), rr = r & 15, cc = c & 31, ob = rr * 64 + cc * 2; return st * 1024 + (ob ^ (((ob >> 9) & 1) << 5)); }
__host__ __device__ __forceinline__ void stage_rc(int b, int& R, int& C) { const int st = b / 1024, sb = b % 1024, swz = sb ^ (((sb >> 9) & 1) << 5); R = (st >> 1) * 16 + swz / 64; C = (st & 1) * 32 + (swz % 64) / 2; }
__host__ __device__ __forceinline__ int perm32(int rho) { const int n = rho >> 4, i = rho & 15; return 8 * (i >> 2) + 4 * n + (i & 3); }
struct Unit { int pm, pn; };
struct Gemm { const bf16_t* A; const bf16_t* Bt; int M, N, K; };
struct StaticOrder {
    int nM, nN, nwg, G, c;
    __host__ __device__ void init(int M, int N, int G_, int c_) { nM = M / BM; nN = N / BM; nwg = nM * nN; G = G_; c = c_; }
    __host__ __device__ bool next(int i, Unit& u) const {
        const long L = (long)i * G + c; if (L >= nwg) return false;
        int wgid = (int)L; { const int q = nwg / NXCD, r = nwg % NXCD, xcd = wgid % NXCD, off = wgid / NXCD; wgid = (xcd < r ? xcd * (q + 1) : r * (q + 1) + (xcd - r) * q) + off; }
        const int nig = WGM * nN, gid = wgid / nig, fm = gid * WGM, gsz = (nM - fm) < WGM ? (nM - fm) : WGM;
        u.pm = fm + ((wgid % nig) % gsz); u.pn = (wgid % nig) / gsz; return true;
    }
    __device__ __forceinline__ void a_ready(const Unit&) const {}
    __device__ __forceinline__ void done(const Unit&) const {}
};
template <class E8> struct EpiA {
    static constexpr bool PERM = true, AFTER_DRAIN = false;
    E8 e;
    __device__ __forceinline__ void operator()(const f32x4 (&acc)[2][2][4][2], const Unit& u, int wr, int wc, int fr, int fq) const {
        asm volatile("" : "+v"(fr), "+v"(fq));
        const int row0 = u.pm * BM + wr * 64 + fr, col0 = u.pn * BM + wc * 32 + 8 * fq;
#pragma unroll
        for (int ai = 0; ai < 2; ++ai)
#pragma unroll
            for (int m = 0; m < 4; ++m) { const int r = row0 + ai * HALF + m * 16; float s = 0.f;
#pragma unroll
                for (int bj = 0; bj < 2; ++bj) { const float v[8] = {acc[ai][bj][m][0][0], acc[ai][bj][m][0][1], acc[ai][bj][m][0][2], acc[ai][bj][m][0][3], acc[ai][bj][m][1][0], acc[ai][bj][m][1][1], acc[ai][bj][m][1][2], acc[ai][bj][m][1][3]};
                    s += e.store8(r, col0 + bj * HALF, v); }
                if (E8::ROWSUM) { s += sxor<16>(s); s += sxor<32>(s); if (fq == 0) e.rowsum(r, s); }
                asm volatile("" ::: "memory"); }
    }
    __device__ __forceinline__ void fused(f32x4 (&)[2][2][4][2], const Unit&, int, int, int, int, PG8_LAS unsigned char*, int, int) const {}
};
template <class Epi, class Sched, bool ALIGN_EPI = false, bool SP2 = false, bool F8 = false>
__device__ __forceinline__ void gemm_phase(PG8_LAS unsigned char* lds, const Gemm g, const Sched& S, const Epi& E) {
    int tid_ = threadIdx.x; asm volatile("" : "+v"(tid_));
    const int tid = tid_, wid = __builtin_amdgcn_readfirstlane(tid >> 6), lane = tid & 63, wr = wid >> 2, wc = wid & 3, fr = lane & 15, fq = lane >> 4;
    const int K = g.K, nt = K / BK;
    unsigned voffA[2], voffB[2];
#pragma unroll
    for (int i = 0; i < 2; ++i) { int R, C; stage_rc(tid * 16 + i * 8192, R, C); const int Rb = Epi::PERM ? ((R & ~31) + perm32(R & 31)) : R;
        voffA[i] = (unsigned)(R * K + C) * 2u; voffB[i] = (unsigned)(Rb * K + C) * 2u; }
    const size_t kstep = (size_t)(BK * 2);
    const size_t hstep = (size_t)HALF * K * 2;
    const size_t tstep = 2 * hstep;
    const unsigned ldsw = (unsigned)wid * 1024u;
    const int aoff = lds_byte(wr * 64 + fr, fq * 8), boff = lds_byte(wc * 32 + fr, fq * 8);
#define PG8_SA(b, h) (((b) * 2 + (h)) * HTB)
#define PG8_SB(b, h) ((4 + (b) * 2 + (h)) * HTB)
#define PG8_STAGE(bufoff, gbase, voff) do { _Pragma("unroll") for (int _i = 0; _i < 2; ++_i) \
        __builtin_amdgcn_global_load_lds((const unsigned*)((const char*)(gbase) + (voff)[_i]), (PG8_LAS unsigned*)(lds + (bufoff) + ldsw + _i * 8192), 16, 0, 0); } while (0)
#define PG8_LDA(dst, b, h) do { _Pragma("unroll") for (int m = 0; m < 4; ++m) { const v4i_t lo_ = *(const PG8_LAS v4i_t*)(lds + PG8_SA(b, h) + aoff + m * 2048), hi_ = *(const PG8_LAS v4i_t*)(lds + PG8_SA(b, h) + aoff + m * 2048 + 1024); dst[m] = __builtin_shufflevector(lo_, hi_, 0, 1, 2, 3, 4, 5, 6, 7); } } while (0)
#define PG8_LDB(dst, b, h) do { _Pragma("unroll") for (int n = 0; n < 2; ++n) { const v4i_t lo_ = *(const PG8_LAS v4i_t*)(lds + PG8_SB(b, h) + boff + n * 2048), hi_ = *(const PG8_LAS v4i_t*)(lds + PG8_SB(b, h) + boff + n * 2048 + 1024); dst[n] = __builtin_shufflevector(lo_, hi_, 0, 1, 2, 3, 4, 5, 6, 7); } } while (0)
#define PG8_MMA(ai, bj, At, Bt) do { __builtin_amdgcn_s_setprio(1); \
        if constexpr (F8) { asm volatile("s_nop 1\n\t" \
            "v_mfma_scale_f32_16x16x128_f8f6f4 %0, %12, %8, %0, %14, %14 op_sel_hi:[0,0,0]\n\t"  "v_mfma_scale_f32_16x16x128_f8f6f4 %1, %13, %8, %1, %14, %14 op_sel_hi:[0,0,0]\n\t" \
            "v_mfma_scale_f32_16x16x128_f8f6f4 %2, %12, %9, %2, %14, %14 op_sel_hi:[0,0,0]\n\t"  "v_mfma_scale_f32_16x16x128_f8f6f4 %3, %13, %9, %3, %14, %14 op_sel_hi:[0,0,0]\n\t" \
            "v_mfma_scale_f32_16x16x128_f8f6f4 %4, %12, %10, %4, %14, %14 op_sel_hi:[0,0,0]\n\t" "v_mfma_scale_f32_16x16x128_f8f6f4 %5, %13, %10, %5, %14, %14 op_sel_hi:[0,0,0]\n\t" \
            "v_mfma_scale_f32_16x16x128_f8f6f4 %6, %12, %11, %6, %14, %14 op_sel_hi:[0,0,0]\n\t" "v_mfma_scale_f32_16x16x128_f8f6f4 %7, %13, %11, %7, %14, %14 op_sel_hi:[0,0,0]" \
            : "+v"(acc[ai][bj][0][0]), "+v"(acc[ai][bj][0][1]), "+v"(acc[ai][bj][1][0]), "+v"(acc[ai][bj][1][1]), "+v"(acc[ai][bj][2][0]), "+v"(acc[ai][bj][2][1]), "+v"(acc[ai][bj][3][0]), "+v"(acc[ai][bj][3][1]) \
            : "v"(At[0]), "v"(At[1]), "v"(At[2]), "v"(At[3]), "v"(Bt[0]), "v"(Bt[1]), "v"(one_scale)); } \
        else { _Pragma("unroll") for (int m = 0; m < 4; ++m) _Pragma("unroll") for (int n = 0; n < 2; ++n) { \
            acc[ai][bj][m][n] = __builtin_amdgcn_mfma_f32_16x16x32_bf16(__builtin_bit_cast(bf16x8, __builtin_shufflevector(Bt[n], Bt[n], 0, 1, 2, 3)), __builtin_bit_cast(bf16x8, __builtin_shufflevector(At[m], At[m], 0, 1, 2, 3)), acc[ai][bj][m][n], 0, 0, 0); \
            acc[ai][bj][m][n] = __builtin_amdgcn_mfma_f32_16x16x32_bf16(__builtin_bit_cast(bf16x8, __builtin_shufflevector(Bt[n], Bt[n], 4, 5, 6, 7)), __builtin_bit_cast(bf16x8, __builtin_shufflevector(At[m], At[m], 4, 5, 6, 7)), acc[ai][bj][m][n], 0, 0, 0); } } \
        __builtin_amdgcn_s_setprio(0); } while (0)
#define PG8_MFMA_DRAIN() do { if constexpr (F8) asm volatile("s_nop 15\n\ts_nop 15\n\ts_nop 15" ::: "memory"); } while (0)
#define PG8_WAIT_V(n) asm volatile("s_waitcnt vmcnt(" #n ")" ::: "memory")
#define PG8_WAIT_L(n) asm volatile("s_waitcnt lgkmcnt(" #n ")" ::: "memory")
#define PG8_BAR __builtin_amdgcn_s_barrier()
#define PG8_SCHED __builtin_amdgcn_sched_barrier(0)
    Unit cur, nxt; int ui = 0;
    if (!S.next(0, cur)) return;
    f32x4 acc[2][2][4][2];
#pragma unroll
    for (int a = 0; a < 2; ++a)
#pragma unroll
        for (int b = 0; b < 2; ++b)
#pragma unroll
            for (int m = 0; m < 4; ++m)
#pragma unroll
                for (int n = 0; n < 2; ++n) acc[a][b][m][n] = (f32x4){0.f, 0.f, 0.f, 0.f};
    const int one_scale = 0x7f7f7f7f;
    v8i_t At[4], B0[2], B1[2];
    const char* cA = (const char*)g.A + (size_t)cur.pm * tstep; const char* cB = (const char*)g.Bt + (size_t)cur.pn * tstep;
    S.a_ready(cur);
    if constexpr (SP2) {
        PG8_STAGE(PG8_SB(0, 0), cB, voffB); PG8_STAGE(PG8_SB(0, 1), cB + hstep, voffB); PG8_STAGE(PG8_SA(0, 0), cA, voffA); PG8_STAGE(PG8_SA(0, 1), cA + hstep, voffA);
        if (wr == 1) PG8_BAR;
        PG8_WAIT_V(2); PG8_BAR;
        PG8_STAGE(PG8_SB(1, 0), cB + kstep, voffB); PG8_STAGE(PG8_SA(1, 0), cA + kstep, voffA); PG8_STAGE(PG8_SB(1, 1), cB + hstep + kstep, voffB);
        PG8_WAIT_V(6); PG8_BAR;
    } else {
        PG8_STAGE(PG8_SB(0, 0), cB, voffB); PG8_STAGE(PG8_SA(0, 0), cA, voffA); PG8_STAGE(PG8_SB(0, 1), cB + hstep, voffB); PG8_STAGE(PG8_SA(0, 1), cA + hstep, voffA);
        if (wr == 1) PG8_BAR;
        PG8_WAIT_V(4); PG8_BAR;
        PG8_STAGE(PG8_SB(1, 0), cB + kstep, voffB); PG8_STAGE(PG8_SA(1, 0), cA + kstep, voffA); PG8_STAGE(PG8_SB(1, 1), cB + hstep + kstep, voffB);
        PG8_WAIT_V(6); PG8_BAR;
    }
    for (;;) {
        const bool has_next = S.next(ui + 1, nxt);
        const char* nA = has_next ? (const char*)g.A + (size_t)nxt.pm * tstep : cA; const char* nB = has_next ? (const char*)g.Bt + (size_t)nxt.pn * tstep : cB;
        for (int t = 0; t < nt; t += 2) {
            const bool last = (t == nt - 2);
            const char* a1 = cA + (size_t)(t + 1) * kstep;
            const char* a2 = last ? nA : cA + (size_t)(t + 2) * kstep; const char* b2 = last ? nB : cB + (size_t)(t + 2) * kstep;
            const char* a3 = a2 + kstep; const char* b3 = b2 + kstep;
            if (last && has_next) S.a_ready(nxt);
            if constexpr (SP2) {
            PG8_LDB(B0, 0, 0); PG8_LDB(B1, 0, 1); PG8_SCHED; PG8_LDA(At, 0, 0); PG8_STAGE(PG8_SA(1, 1), a1 + hstep, voffA);
            PG8_WAIT_V(8); PG8_WAIT_L(0); PG8_BAR; PG8_MMA(0, 0, At, B0); PG8_MMA(0, 1, At, B1); PG8_BAR; PG8_SCHED;
            PG8_LDA(At, 0, 1); PG8_STAGE(PG8_SB(0, 0), b2, voffB); PG8_STAGE(PG8_SB(0, 1), b2 + hstep, voffB); PG8_STAGE(PG8_SA(0, 0), a2, voffA);
            PG8_WAIT_V(8); PG8_WAIT_L(0); PG8_BAR; PG8_MMA(1, 0, At, B0); PG8_MMA(1, 1, At, B1); PG8_BAR; PG8_SCHED;
            PG8_LDB(B0, 1, 0); PG8_LDB(B1, 1, 1); PG8_SCHED; PG8_LDA(At, 1, 0); PG8_STAGE(PG8_SA(0, 1), a2 + hstep, voffA);
            PG8_WAIT_V(8); PG8_WAIT_L(0); PG8_BAR; PG8_MMA(0, 0, At, B0); PG8_MMA(0, 1, At, B1); PG8_BAR; PG8_SCHED;
            PG8_LDA(At, 1, 1); PG8_STAGE(PG8_SB(1, 0), b3, voffB); PG8_STAGE(PG8_SB(1, 1), b3 + hstep, voffB); PG8_STAGE(PG8_SA(1, 0), a3, voffA);
            PG8_WAIT_V(8); PG8_WAIT_L(0); PG8_BAR; PG8_MMA(1, 0, At, B0); PG8_MMA(1, 1, At, B1); PG8_BAR; PG8_SCHED;
            } else {
            PG8_LDB(B0, 0, 0); PG8_SCHED; PG8_LDA(At, 0, 0); PG8_STAGE(PG8_SA(1, 1), a1 + hstep, voffA);
            PG8_WAIT_L(8); PG8_BAR; PG8_WAIT_L(0); PG8_MMA(0, 0, At, B0); PG8_BAR; PG8_SCHED;
            PG8_LDB(B1, 0, 1); PG8_STAGE(PG8_SB(0, 0), b2, voffB);
            PG8_BAR; PG8_WAIT_L(0); PG8_MMA(0, 1, At, B1); PG8_BAR;
            PG8_LDA(At, 0, 1); PG8_STAGE(PG8_SA(0, 0), a2, voffA);
            PG8_BAR; PG8_WAIT_L(0); PG8_MMA(1, 0, At, B0); PG8_BAR; PG8_SCHED;
            PG8_STAGE(PG8_SB(0, 1), b2 + hstep, voffB);
            PG8_WAIT_V(6); PG8_BAR; PG8_MMA(1, 1, At, B1); PG8_BAR;
            PG8_LDB(B0, 1, 0); PG8_SCHED; PG8_LDA(At, 1, 0); PG8_STAGE(PG8_SA(0, 1), a2 + hstep, voffA);
            PG8_WAIT_L(8); PG8_BAR; PG8_WAIT_L(0); PG8_MMA(0, 0, At, B0); PG8_BAR; PG8_SCHED;
            PG8_LDB(B1, 1, 1); PG8_STAGE(PG8_SB(1, 0), b3, voffB);
            PG8_BAR; PG8_WAIT_L(0); PG8_MMA(0, 1, At, B1); PG8_BAR;
            PG8_LDA(At, 1, 1); PG8_STAGE(PG8_SA(1, 0), a3, voffA);
            PG8_BAR; PG8_WAIT_L(0); PG8_MMA(1, 0, At, B0); PG8_BAR; PG8_SCHED;
            PG8_STAGE(PG8_SB(1, 1), b3 + hstep, voffB);
            PG8_WAIT_V(6); PG8_BAR; PG8_MMA(1, 1, At, B1); PG8_BAR;
            }
        }
        if constexpr (ALIGN_EPI) { if (wr == 0) PG8_BAR; }
        PG8_MFMA_DRAIN();
        if constexpr (!Epi::AFTER_DRAIN) { E(acc, cur, wr, wc, fr, fq); S.done(cur); }
        if (!has_next) break;
#pragma unroll
        for (int a = 0; a < 2; ++a)
#pragma unroll
            for (int b = 0; b < 2; ++b)
#pragma unroll
                for (int m = 0; m < 4; ++m)
#pragma unroll
                    for (int n = 0; n < 2; ++n) acc[a][b][m][n] = (f32x4){0.f, 0.f, 0.f, 0.f};
        cur = nxt; cA = nA; cB = nB; ++ui;
        if constexpr (ALIGN_EPI) { if (wr == 1) PG8_BAR; }
    }
    PG8_WAIT_V(0);
    if constexpr (!ALIGN_EPI) { if (wr == 0) PG8_BAR; }
    PG8_BAR;
    if constexpr (Epi::AFTER_DRAIN) { E.fused(acc, cur, wr, wc, fr, fq, lds, wid, lane); S.done(cur); }
#undef PG8_SA
#undef PG8_SB
#undef PG8_STAGE
#undef PG8_LDA
#undef PG8_LDB
#undef PG8_MMA
#undef PG8_MFMA_DRAIN
#undef PG8_WAIT_V
#undef PG8_WAIT_L
#undef PG8_BAR
#undef PG8_SCHED
}
}

#ifndef FAST_GEMM
#define FAST_GEMM 1
#endif
template <bool F8 = false, class E8>
__device__ __forceinline__ void gemm_any(const void* A, const void* Bt, int M, int N, int K, const E8& E, float* lds, int bid, int nb) {
#if FAST_GEMM
  pg8::Gemm g{(const bf16_t*)A, (const bf16_t*)Bt, M, N, F8 ? K / 2 : K}; pg8::StaticOrder S; S.init(M, N, nb, bid);
  pg8::EpiA<E8> EA{E};
  pg8::gemm_phase<pg8::EpiA<E8>, pg8::StaticOrder, true, true, F8>((PG8_LAS unsigned char*)lds, g, S, EA);
#else
  gemm_naive((const bf16_t*)A, (const bf16_t*)Bt, M, N, K, E, lds, bid, nb);
#endif
}

__device__ void gla_naive(const Params& p, const WS& w, int b, int h, float* lds) {
  constexpr int CH = 16;
  const int tid = tidx(), dv = tid & 255, half = tid >> 8, wave = tid >> 6, lane = tid & 63;
  float* qf = lds; float* kf = qf + CH * 128; float* af = kf + CH * 128; float* vf = af + CH * 128; float* op = vf + CH * 256;
  float S[64];
#pragma unroll
  for (int i = 0; i < 64; ++i) S[i] = 0.f;
  const int gd = tid & 127;
  float gu[16];
#pragma unroll
  for (int r = 0; r < 16; ++r) gu[r] = p.gate_up[r * 512 + h * 128 + gd];
  const float gb = p.gate_bias[h * 128 + gd];
  const float qscale = 0.08838834764831845f;
  for (int t0 = 0; t0 < SEQ; t0 += CH) {
    const size_t tb = (size_t)b * SEQ + t0;
    { const int tok = tid >> 5, d4 = (tid & 31) * 4;
      const uint2 qv = *(const uint2*)(w.proj + (tb + tok) * NPROJ + C_GQ + h * 128 + d4);
      const uint2 kv = *(const uint2*)(w.proj + (tb + tok) * NPROJ + C_GK + h * 128 + d4);
      *(float4*)(qf + tok * 128 + d4) = make_float4(lo_f(qv.x) * qscale, hi_f(qv.x) * qscale, lo_f(qv.y) * qscale, hi_f(qv.y) * qscale);
      *(float4*)(kf + tok * 128 + d4) = make_float4(lo_f(kv.x), hi_f(kv.x), lo_f(kv.y), hi_f(kv.y)); }
    { const int dvv = tid & 255, tk8 = (tid >> 8) * 8; float f[8];
      unpack8(*(const uint4*)(w.vT + (size_t)(h * 256 + dvv) * T + tb + tk8), f);
#pragma unroll
      for (int j = 0; j < 8; ++j) vf[(tk8 + j) * 256 + dvv] = f[j]; }
#pragma unroll
    for (int i = 0; i < 4; ++i) { const int tok = (tid >> 7) * 4 + i; float z = gb; float gl[16];
      unpack8(*(const uint4*)(w.proj + (tb + tok) * NPROJ + C_SM), gl); unpack8(*(const uint4*)(w.proj + (tb + tok) * NPROJ + C_SM + 8), gl + 8);
#pragma unroll
      for (int r = 0; r < 16; ++r) z += gl[r] * gu[r];
      af[tok * 128 + gd] = __expf(logsigmoidf_(z) * (1.f / 16.f)); }
    __syncthreads();
    for (int tok = 0; tok < CH; ++tok) {
      const float vv = vf[tok * 256 + dv]; float acc = 0.f;
#pragma unroll
      for (int i4 = 0; i4 < 16; ++i4) {
        const float4 a = *(const float4*)(af + tok * 128 + half * 64 + i4 * 4), k = *(const float4*)(kf + tok * 128 + half * 64 + i4 * 4), q = *(const float4*)(qf + tok * 128 + half * 64 + i4 * 4);
        S[i4 * 4 + 0] = a.x * S[i4 * 4 + 0] + k.x * vv; acc += q.x * S[i4 * 4 + 0];
        S[i4 * 4 + 1] = a.y * S[i4 * 4 + 1] + k.y * vv; acc += q.y * S[i4 * 4 + 1];
        S[i4 * 4 + 2] = a.z * S[i4 * 4 + 2] + k.z * vv; acc += q.z * S[i4 * 4 + 2];
        S[i4 * 4 + 3] = a.w * S[i4 * 4 + 3] + k.w * vv; acc += q.w * S[i4 * 4 + 3];
      }
      op[(half * CH + tok) * 256 + dv] = acc;
    }
    __syncthreads();
#pragma unroll
    for (int i = 0; i < 2; ++i) { const int tok = wave * 2 + i;
      const float4 o0 = *(const float4*)(op + tok * 256 + lane * 4), o1 = *(const float4*)(op + (CH + tok) * 256 + lane * 4);
      const float o[4] = {o0.x + o1.x, o0.y + o1.y, o0.z + o1.z, o0.w + o1.w};
      float ss = wave_sum(o[0] * o[0] + o[1] * o[1] + o[2] * o[2] + o[3] * o[3]);
      const float rs = rsqrtf(ss * (1.f / 256.f) + EPS);
      const uint2 gg = *(const uint2*)(w.proj + (tb + tok) * NPROJ + C_GG + h * 256 + lane * 4);
      const float4 gn = *(const float4*)(p.gla_norm + h * 256 + lane * 4);
      const float y0 = o[0] * rs * gn.x * siluf_(lo_f(gg.x)), y1 = o[1] * rs * gn.y * siluf_(hi_f(gg.x)), y2 = o[2] * rs * gn.z * siluf_(lo_f(gg.y)), y3 = o[3] * rs * gn.w * siluf_(hi_f(gg.y));
      *(uint2*)(w.y + (tb + tok) * D + h * 256 + lane * 4) = make_uint2(pack2(y0, y1), pack2(y2, y3)); }
    __syncthreads();
  }
}
__device__ void mlstm_naive(const Params& p, const WS& w, int b, int h, float* lds) {
  constexpr int CH = 16;
  const int tid = tidx(), dv = tid & 255, half = tid >> 8, wave = tid >> 6, lane = tid & 63;
  float* qf = lds; float* kf = qf + CH * 128; float* vf = kf + CH * 128; float* op = vf + CH * 256; float* dn = op + 2 * CH * 256; float* gt = dn + 2 * CH * 256;
  float C[64], n[4];
#pragma unroll
  for (int i = 0; i < 64; ++i) C[i] = 0.f;
#pragma unroll
  for (int i = 0; i < 4; ++i) n[i] = 0.f;
  const int nd = half * 64 + (dv & 15) * 4;
  const float kscale = 0.08838834764831845f;
  const float ib = p.ig_bias[h], fb = p.fg_bias[h];
  for (int t0 = 0; t0 < SEQ; t0 += CH) {
    const size_t tb = (size_t)b * SEQ + t0;
    { const int tok = tid >> 5, d4 = (tid & 31) * 4;
      float qa[4], ka[4];
#pragma unroll
      for (int c = 0; c < 4; ++c) { qa[c] = p.conv_b[h * 128 + d4 + c]; ka[c] = p.conv_b[512 + h * 128 + d4 + c]; }
#pragma unroll
      for (int wi = 0; wi < 4; ++wi) { const int ts = t0 + tok - 3 + wi;
        if (ts >= 0) { const size_t tr = (size_t)b * SEQ + ts;
          const uint2 qv = *(const uint2*)(w.proj + tr * NPROJ + C_MQ + h * 128 + d4), kv = *(const uint2*)(w.proj + tr * NPROJ + C_MK + h * 128 + d4);
          const float4 cq = *(const float4*)(p.conv_w + wi * 1024 + h * 128 + d4), ck = *(const float4*)(p.conv_w + wi * 1024 + 512 + h * 128 + d4);
          qa[0] += cq.x * lo_f(qv.x); qa[1] += cq.y * hi_f(qv.x); qa[2] += cq.z * lo_f(qv.y); qa[3] += cq.w * hi_f(qv.y);
          ka[0] += ck.x * lo_f(kv.x); ka[1] += ck.y * hi_f(kv.x); ka[2] += ck.z * lo_f(kv.y); ka[3] += ck.w * hi_f(kv.y); } }
      *(float4*)(qf + tok * 128 + d4) = make_float4(siluf_(qa[0]), siluf_(qa[1]), siluf_(qa[2]), siluf_(qa[3]));
      *(float4*)(kf + tok * 128 + d4) = make_float4(siluf_(ka[0]) * kscale, siluf_(ka[1]) * kscale, siluf_(ka[2]) * kscale, siluf_(ka[3]) * kscale); }
    { const int dvv = tid & 255, tk8 = (tid >> 8) * 8; float f[8];
      unpack8(*(const uint4*)(w.vT + (size_t)(1024 + h * 256 + dvv) * T + tb + tk8), f);
#pragma unroll
      for (int j = 0; j < 8; ++j) vf[(tk8 + j) * 256 + dvv] = f[j]; }
    if (tid < CH) { const float mi = bf2f(w.proj[(tb + tid) * NPROJ + C_SM + 16 + h]), mf = bf2f(w.proj[(tb + tid) * NPROJ + C_SM + 20 + h]);
      gt[tid * 2] = __expf(mi + ib); gt[tid * 2 + 1] = sigmoidf_(mf + fb); }
    __syncthreads();
    for (int tok = 0; tok < CH; ++tok) {
      const float vv = vf[tok * 256 + dv], ig = gt[tok * 2], fg = gt[tok * 2 + 1]; float num = 0.f, den = 0.f;
#pragma unroll
      for (int i4 = 0; i4 < 16; ++i4) {
        const float4 k = *(const float4*)(kf + tok * 128 + half * 64 + i4 * 4), q = *(const float4*)(qf + tok * 128 + half * 64 + i4 * 4);
        const float kk[4] = {k.x * ig, k.y * ig, k.z * ig, k.w * ig}; const float qq[4] = {q.x, q.y, q.z, q.w};
#pragma unroll
        for (int c = 0; c < 4; ++c) { C[i4 * 4 + c] = fg * C[i4 * 4 + c] + kk[c] * vv; num += qq[c] * C[i4 * 4 + c]; }
      }
      { const float4 k = *(const float4*)(kf + tok * 128 + nd), q = *(const float4*)(qf + tok * 128 + nd);
        n[0] = fg * n[0] + k.x * ig; n[1] = fg * n[1] + k.y * ig; n[2] = fg * n[2] + k.z * ig; n[3] = fg * n[3] + k.w * ig;
        den = q.x * n[0] + q.y * n[1] + q.z * n[2] + q.w * n[3];
        den = gsum<16>(den); }
      op[(half * CH + tok) * 256 + dv] = num; if (dv == 0) dn[half * CH + tok] = den;
    }
    __syncthreads();
#pragma unroll
    for (int i = 0; i < 2; ++i) { const int tok = wave * 2 + i;
      const float4 o0 = *(const float4*)(op + tok * 256 + lane * 4), o1 = *(const float4*)(op + (CH + tok) * 256 + lane * 4);
      const float den = dn[tok] + dn[CH + tok];
      const float inv = 1.f / fmaxf(fabsf(den), 1.f);
      const float o[4] = {(o0.x + o1.x) * inv, (o0.y + o1.y) * inv, (o0.z + o1.z) * inv, (o0.w + o1.w) * inv};
      float ss = wave_sum(o[0] * o[0] + o[1] * o[1] + o[2] * o[2] + o[3] * o[3]);
      const float rs = rsqrtf(ss * (1.f / 256.f) + EPS);
      const uint2 mo = *(const uint2*)(w.proj + (tb + tok) * NPROJ + C_MO + h * 256 + lane * 4);
      const float4 gn = *(const float4*)(p.mlstm_norm + h * 256 + lane * 4);
      const float y0 = o[0] * rs * gn.x * sigmoidf_(lo_f(mo.x)), y1 = o[1] * rs * gn.y * sigmoidf_(hi_f(mo.x)), y2 = o[2] * rs * gn.z * sigmoidf_(lo_f(mo.y)), y3 = o[3] * rs * gn.w * sigmoidf_(hi_f(mo.y));
      *(uint2*)(w.y + (tb + tok) * D + 1024 + h * 256 + lane * 4) = make_uint2(pack2(y0, y1), pack2(y2, y3)); }
    __syncthreads();
  }
}
__device__ void phase_mixer_naive(const Params& p, const WS& w, float* lds, int bid, int nb) {
  for (int item = bid; item < 16; item += nb) {
    if (item < 8) gla_naive(p, w, item >> 2, item & 3, lds); else mlstm_naive(p, w, (item - 8) >> 2, item & 3, lds);
    __syncthreads();
  }
}


typedef short bf16x8 __attribute__((ext_vector_type(8)));
typedef float f32x4 __attribute__((ext_vector_type(4)));
#define MFMA16(a, b, c) __builtin_amdgcn_mfma_f32_16x16x32_bf16(a, b, c, 0, 0, 0)
constexpr int L_GLR = 0, L_TOT = 4096, L_F = 6144, L_DEN = 6656, L_PART = 6912, L_QS = 9216, L_KS = 26624, L_P = 44032, L_NL = 53248, L_KDT = 9216;
constexpr int QS_LD = 136, P_LD = 72, KDT_LD = 72;

__device__ __forceinline__ void gla_gates(const Params& p, const WS& w, int h, size_t tb, unsigned char* ldsb, int tid, float* bv, float& blast) {
  float* glrs = (float*)(ldsb + L_GLR); float* tot = (float*)(ldsb + L_TOT);
  const int d = tid & 127, tg = tid >> 7;
  if (tid < 128) { float f[8]; unpack8(*(const uint4*)(w.proj + (tb + (tid >> 1)) * NPROJ + C_SM + (tid & 1) * 8), f);
#pragma unroll
    for (int j = 0; j < 8; ++j) glrs[(tid >> 1) * 16 + (tid & 1) * 8 + j] = f[j]; }
  float gu[16];
#pragma unroll
  for (int r = 0; r < 16; ++r) gu[r] = p.gate_up[r * 512 + h * 128 + d];
  const float gb = p.gate_bias[h * 128 + d];
  __syncthreads();
  float run = 0.f;
#pragma unroll
  for (int i = 0; i < 16; ++i) { const float* gl = glrs + (tg * 16 + i) * 16; float z = gb;
#pragma unroll
    for (int r4 = 0; r4 < 4; ++r4) { const float4 g4 = *(const float4*)(gl + r4 * 4); z += g4.x * gu[r4 * 4] + g4.y * gu[r4 * 4 + 1] + g4.z * gu[r4 * 4 + 2] + g4.w * gu[r4 * 4 + 3]; }
    run += logsigmoidf_(z) * (1.f / 16.f); bv[i] = run; }
  tot[tg * 128 + d] = run;
  __syncthreads();
  float off = 0.f; blast = 0.f;
#pragma unroll
  for (int g = 0; g < 4; ++g) { const float t = tot[g * 128 + d]; blast += t; if (g < tg) off += t; }
#pragma unroll
  for (int i = 0; i < 16; ++i) bv[i] += off;
}
__device__ __forceinline__ void mlstm_gates(const Params& p, const WS& w, int h, size_t tb, unsigned char* ldsb, int tid) {
  float* Fl = (float*)(ldsb + L_F);
  if (tid < 64) { const float mi = bf2f(w.proj[(tb + tid) * NPROJ + C_SM + 16 + h]), mf = bf2f(w.proj[(tb + tid) * NPROJ + C_SM + 20 + h]);
    float f = logsigmoidf_(mf + p.fg_bias[h]);
#pragma unroll
    for (int o = 1; o < 64; o <<= 1) { const float t = bperm(f, tid - o); if (tid >= o) f += t; }
    Fl[tid] = f; Fl[64 + tid] = mi + p.ig_bias[h]; }
  __syncthreads();
}
__device__ __forceinline__ void conv_load(const WS& w, int col, int b, int c, int tg, bf16_t* win) {
  const int s0 = c * 64 + tg * 16 - 3;
#pragma unroll
  for (int m = 0; m < 19; ++m) { const int sp = s0 + m; win[m] = (sp >= 0) ? w.proj[((size_t)b * SEQ + sp) * NPROJ + col] : (bf16_t)0; }
}
__device__ __forceinline__ void conv_apply(const Params& p, const bf16_t* win, int cch, float scale, float* out) {
  const float c0 = p.conv_w[cch], c1 = p.conv_w[1024 + cch], c2 = p.conv_w[2048 + cch], c3 = p.conv_w[3072 + cch], cb = p.conv_b[cch];
#pragma unroll
  for (int i = 0; i < 16; ++i) out[i] = siluf_(cb + c0 * bf2f(win[i]) + c1 * bf2f(win[i + 1]) + c2 * bf2f(win[i + 2]) + c3 * bf2f(win[i + 3])) * scale;
}

template <int KIND>
__device__ void mix_local(const Params& p, const WS& w, int b, int h, int c, int item, unsigned char* ldsb) {
  const int tid = tidx(), lane = tid & 63, wave = tid >> 6, fr = lane & 15, fq = lane >> 4, d = tid & 127, tg = tid >> 7;
  const size_t tb = (size_t)b * SEQ + (size_t)c * 64;
  float* tot = (float*)(ldsb + L_TOT); const float* Fl = (const float*)(ldsb + L_F);
  bf16_t* kdT = (bf16_t*)(ldsb + L_KDT);
  const bf16_t* vrow = w.vT + (size_t)(KIND * 1024 + h * 256 + wave * 32 + fr) * T + tb + fq * 8;
  bf16x8 yv[2][2];
#pragma unroll
  for (int ks = 0; ks < 2; ++ks) { yv[ks][0] = *(const bf16x8*)(vrow + ks * 32); yv[ks][1] = *(const bf16x8*)(vrow + (size_t)16 * T + ks * 32); }
  bf16_t kraw[19];
  if (KIND == 0) {
#pragma unroll
    for (int i = 0; i < 16; ++i) kraw[i] = w.proj[(tb + tg * 16 + i) * NPROJ + C_GK + h * 128 + d];
  } else conv_load(w, C_MK + h * 128 + d, b, c, tg, kraw);
  float wgt[16], kv[16];
  if (KIND == 0) {
    float bv[16], blast; gla_gates(p, w, h, tb, ldsb, tid, bv, blast);
#pragma unroll
    for (int i = 0; i < 16; ++i) { wgt[i] = __expf(blast - bv[i]); kv[i] = bf2f(kraw[i]); }
    if (tg == 0) w.gdec[(size_t)item * 128 + d] = __expf(blast);
  } else {
    mlstm_gates(p, w, h, tb, ldsb, tid);
    const float flast = Fl[63];
#pragma unroll
    for (int i = 0; i < 16; ++i) wgt[i] = __expf(flast - Fl[tg * 16 + i] + Fl[64 + tg * 16 + i]);
    conv_apply(p, kraw, 512 + h * 128 + d, 0.08838834764831845f, kv);
    if (tid == 0) w.mdec[item - 2048] = __expf(flast);
  }
  float un = 0.f; float kd[16];
#pragma unroll
  for (int i = 0; i < 16; ++i) { kd[i] = kv[i] * wgt[i]; un += kd[i]; }
  *(uint4*)(kdT + d * KDT_LD + tg * 16) = pack8(kd); *(uint4*)(kdT + d * KDT_LD + tg * 16 + 8) = pack8(kd + 8);
  if (KIND == 1) tot[tg * 128 + d] = un;
  __syncthreads();
  if (KIND == 1 && tg == 0) w.mn[(size_t)(item - 2048) * 128 + d] = tot[d] + tot[128 + d] + tot[256 + d] + tot[384 + d];
  f32x4 acc[2][8];
#pragma unroll
  for (int yt = 0; yt < 2; ++yt)
#pragma unroll
    for (int xt = 0; xt < 8; ++xt) acc[yt][xt] = (f32x4){0.f, 0.f, 0.f, 0.f};
#pragma unroll
  for (int ks = 0; ks < 2; ++ks) {
#pragma unroll
    for (int xt = 0; xt < 8; ++xt) { const bf16x8 xk = *(const bf16x8*)(kdT + (xt * 16 + fr) * KDT_LD + ks * 32 + fq * 8);
      acc[0][xt] = MFMA16(xk, yv[ks][0], acc[0][xt]); acc[1][xt] = MFMA16(xk, yv[ks][1], acc[1][xt]); }
  }
  bf16_t* S = (bf16_t*)p.out + (size_t)item * 32768;
#pragma unroll
  for (int yt = 0; yt < 2; ++yt)
#pragma unroll
    for (int xt = 0; xt < 8; ++xt) *(uint2*)(S + (wave * 32 + yt * 16 + fr) * 128 + xt * 16 + 4 * fq) = make_uint2(pack2(acc[yt][xt][0], acc[yt][xt][1]), pack2(acc[yt][xt][2], acc[yt][xt][3]));
  __syncthreads();
}

__device__ void mix_scan(const Params& p, const WS& w, float* lds, int bid, int nb) {
  bf16_t* sbuf = (bf16_t*)p.out;
  const int tid = tidx();
  for (int g0 = bid * 512; g0 < 16 * 8192; g0 += nb * 512) {
    const int g = g0 + tid, combo = g0 >> 13, e = (g & 8191) * 4, dk = e & 127;
    __syncthreads();
    if (combo < 8) { const float4* src = (const float4*)(w.gdec + (size_t)combo * 32768);
#pragma unroll
      for (int i = 0; i < 16; ++i) ((float4*)lds)[i * 512 + tid] = src[i * 512 + tid]; }
    else if (tid < 256) lds[tid] = w.mdec[(combo - 8) * 256 + tid];
    __syncthreads();
    bf16_t* base = sbuf + (size_t)combo * 256 * 32768 + e;
    float S0 = 0.f, S1 = 0.f, S2 = 0.f, S3 = 0.f;
    for (int c0 = 0; c0 < 256; c0 += 16) {
      uint2 u[16];
#pragma unroll
      for (int k = 0; k < 16; ++k) u[k] = *(const uint2*)(base + (size_t)(c0 + k) * 32768);
#pragma unroll
      for (int k = 0; k < 16; ++k) { float4 dc; if (combo < 8) dc = *(const float4*)(lds + (c0 + k) * 128 + dk); else { const float m = lds[c0 + k]; dc = make_float4(m, m, m, m); }
        *(uint2*)(base + (size_t)(c0 + k) * 32768) = make_uint2(pack2(S0, S1), pack2(S2, S3));
        S0 = dc.x * S0 + lo_f(u[k].x); S1 = dc.y * S1 + hi_f(u[k].x); S2 = dc.z * S2 + lo_f(u[k].y); S3 = dc.w * S3 + hi_f(u[k].y); }
    }
  }
  for (int g = bid * 512 + tid; g < 8 * 128; g += nb * 512) {
    const int cb = g >> 7, d = g & 127; float n = 0.f;
    for (int c = 0; c < 256; ++c) { float* q = w.mn + (size_t)(cb * 256 + c) * 128 + d; const float u = *q; *q = n; n = w.mdec[cb * 256 + c] * n + u; }
  }
}

template <int KIND>
__device__ void mix_out(const Params& p, const WS& w, int b, int h, int c, int item, unsigned char* ldsb) {
  const int tid = tidx(), lane = tid & 63, wave = tid >> 6, fr = lane & 15, fq = lane >> 4, d = tid & 127, tg = tid >> 7;
  const size_t tb = (size_t)b * SEQ + (size_t)c * 64;
  const float* Fl = (const float*)(ldsb + L_F); float* denl = (float*)(ldsb + L_DEN); float* part = (float*)(ldsb + L_PART); float* nl = (float*)(ldsb + L_NL);
  bf16_t* qs = (bf16_t*)(ldsb + L_QS); bf16_t* ks = (bf16_t*)(ldsb + L_KS); bf16_t* P = (bf16_t*)(ldsb + L_P);
  bf16x8 vx[2][2], sx[4][2];
  { const bf16_t* vrow = w.vT + (size_t)(KIND * 1024 + h * 256 + wave * 32 + fr) * T + tb + fq * 8;
#pragma unroll
    for (int k2 = 0; k2 < 2; ++k2) { vx[k2][0] = *(const bf16x8*)(vrow + k2 * 32); vx[k2][1] = *(const bf16x8*)(vrow + (size_t)16 * T + k2 * 32); }
    const bf16_t* srow = (const bf16_t*)p.out + (size_t)item * 32768 + (wave * 32 + fr) * 128 + fq * 8;
#pragma unroll
    for (int k4 = 0; k4 < 4; ++k4) { sx[k4][0] = *(const bf16x8*)(srow + k4 * 32); sx[k4][1] = *(const bf16x8*)(srow + 16 * 128 + k4 * 32); } }
  uint2 gt[4][2];
#pragma unroll
  for (int yt = 0; yt < 4; ++yt)
#pragma unroll
    for (int xt = 0; xt < 2; ++xt) gt[yt][xt] = *(const uint2*)(w.proj + (tb + yt * 16 + fr) * NPROJ + (KIND == 0 ? C_GG : C_MO) + h * 256 + wave * 32 + xt * 16 + 4 * fq);
  const float* gain = (KIND == 0 ? p.gla_norm : p.mlstm_norm) + h * 256;
  const float4 gn0 = *(const float4*)(gain + wave * 32 + 4 * fq), gn1 = *(const float4*)(gain + wave * 32 + 16 + 4 * fq);
  bf16_t qraw[19], kraw[19];
  if (KIND == 0) {
#pragma unroll
    for (int i = 0; i < 16; ++i) { qraw[i] = w.proj[(tb + tg * 16 + i) * NPROJ + C_GQ + h * 128 + d]; kraw[i] = w.proj[(tb + tg * 16 + i) * NPROJ + C_GK + h * 128 + d]; }
  } else { conv_load(w, C_MQ + h * 128 + d, b, c, tg, qraw); conv_load(w, C_MK + h * 128 + d, b, c, tg, kraw); }
  float nlv = 0.f;
  if (KIND == 1 && tid < 128) nlv = w.mn[(size_t)(item - 2048) * 128 + tid];
  {
    float qm[16], km[16], qv[16], kv[16];
    if (KIND == 0) {
      float bv[16], blast; gla_gates(p, w, h, tb, ldsb, tid, bv, blast);
#pragma unroll
      for (int i = 0; i < 16; ++i) { qm[i] = 0.08838834764831845f * __expf(bv[i]); km[i] = __expf(-bv[i]); qv[i] = bf2f(qraw[i]); kv[i] = bf2f(kraw[i]); }
    } else {
      mlstm_gates(p, w, h, tb, ldsb, tid);
#pragma unroll
      for (int i = 0; i < 16; ++i) { const float F = Fl[tg * 16 + i]; qm[i] = __expf(F); km[i] = __expf(Fl[64 + tg * 16 + i] - F); }
      conv_apply(p, qraw, h * 128 + d, 1.f, qv);
      conv_apply(p, kraw, 512 + h * 128 + d, 0.08838834764831845f, kv);
      if (tid < 128) nl[tid] = nlv;
    }
#pragma unroll
    for (int i = 0; i < 16; ++i) { qs[(tg * 16 + i) * QS_LD + d] = f2bf(qv[i] * qm[i]); ks[(tg * 16 + i) * QS_LD + d] = f2bf(kv[i] * km[i]); }
  }
  __syncthreads();
#pragma unroll
  for (int q = 0; q < 2; ++q) { const int tt = wave * 2 + q, jt = tt >> 2, it = tt & 3; f32x4 a = (f32x4){0.f, 0.f, 0.f, 0.f};
#pragma unroll
    for (int k4 = 0; k4 < 4; ++k4) { const bf16x8 xk = *(const bf16x8*)(ks + (jt * 16 + fr) * QS_LD + k4 * 32 + fq * 8), yq = *(const bf16x8*)(qs + (it * 16 + fr) * QS_LD + k4 * 32 + fq * 8); a = MFMA16(xk, yq, a); }
    const int i = it * 16 + fr, j0 = jt * 16 + 4 * fq;
    const float v0 = (j0 <= i) ? a[0] : 0.f, v1 = (j0 + 1 <= i) ? a[1] : 0.f, v2 = (j0 + 2 <= i) ? a[2] : 0.f, v3 = (j0 + 3 <= i) ? a[3] : 0.f;
    *(uint2*)(P + i * P_LD + j0) = make_uint2(pack2(v0, v1), pack2(v2, v3)); }
  __syncthreads();
  if (KIND == 1) { const int i = tid >> 3, pt = tid & 7; float f[8]; float s = 0.f;
    unpack8(*(const uint4*)(P + i * P_LD + pt * 8), f);
#pragma unroll
    for (int j = 0; j < 8; ++j) s += f[j];
#pragma unroll
    for (int hh = 0; hh < 2; ++hh) { unpack8(*(const uint4*)(qs + i * QS_LD + pt * 16 + hh * 8), f);
#pragma unroll
      for (int j = 0; j < 8; ++j) s += f[j] * nl[pt * 16 + hh * 8 + j]; }
    s = gsum<8>(s);
    if (pt == 0) denl[i] = s; }
  f32x4 acc[2][4];
#pragma unroll
  for (int xt = 0; xt < 2; ++xt)
#pragma unroll
    for (int yt = 0; yt < 4; ++yt) acc[xt][yt] = (f32x4){0.f, 0.f, 0.f, 0.f};
#pragma unroll
  for (int k2 = 0; k2 < 2; ++k2)
#pragma unroll
    for (int yt = 0; yt < 4; ++yt) { const bf16x8 yp = *(const bf16x8*)(P + (yt * 16 + fr) * P_LD + k2 * 32 + fq * 8); acc[0][yt] = MFMA16(vx[k2][0], yp, acc[0][yt]); acc[1][yt] = MFMA16(vx[k2][1], yp, acc[1][yt]); }
#pragma unroll
  for (int k4 = 0; k4 < 4; ++k4)
#pragma unroll
    for (int yt = 0; yt < 4; ++yt) { const bf16x8 yq = *(const bf16x8*)(qs + (yt * 16 + fr) * QS_LD + k4 * 32 + fq * 8); acc[0][yt] = MFMA16(sx[k4][0], yq, acc[0][yt]); acc[1][yt] = MFMA16(sx[k4][1], yq, acc[1][yt]); }
  if (KIND == 1) __syncthreads();
#pragma unroll
  for (int yt = 0; yt < 4; ++yt) { float s = 0.f;
    if (KIND == 1) { const float inv = 1.f / fmaxf(fabsf(denl[yt * 16 + fr]), 1.f); acc[0][yt] *= inv; acc[1][yt] *= inv; }
#pragma unroll
    for (int xt = 0; xt < 2; ++xt)
#pragma unroll
      for (int r = 0; r < 4; ++r) s += acc[xt][yt][r] * acc[xt][yt][r];
    s += sxor<16>(s); s += sxor<32>(s);
    if (fq == 0) part[wave * 64 + yt * 16 + fr] = s; }
  __syncthreads();
#pragma unroll
  for (int yt = 0; yt < 4; ++yt) { const int i = yt * 16 + fr; float t = 0.f;
#pragma unroll
    for (int ww = 0; ww < 8; ++ww) t += part[ww * 64 + i];
    const float rs = rsqrtf(t * (1.f / 256.f) + EPS);
#pragma unroll
    for (int xt = 0; xt < 2; ++xt) { const int dv = wave * 32 + xt * 16 + 4 * fq;
      const float4 gn = xt == 0 ? gn0 : gn1; const uint2 g2 = gt[yt][xt];
      const float g0 = lo_f(g2.x), g1 = hi_f(g2.x), g2f = lo_f(g2.y), g3 = hi_f(g2.y);
      const float a0 = KIND == 0 ? siluf_(g0) : sigmoidf_(g0), a1 = KIND == 0 ? siluf_(g1) : sigmoidf_(g1), a2 = KIND == 0 ? siluf_(g2f) : sigmoidf_(g2f), a3 = KIND == 0 ? siluf_(g3) : sigmoidf_(g3);
      const float y0 = acc[xt][yt][0] * rs * gn.x * a0, y1 = acc[xt][yt][1] * rs * gn.y * a1, y2 = acc[xt][yt][2] * rs * gn.z * a2, y3 = acc[xt][yt][3] * rs * gn.w * a3;
#if F8_OUT
      *(unsigned*)(w.yq + (tb + i) * D + KIND * 1024 + h * 256 + dv) = pack4_fp8(y0, y1, y2, y3);
#else
      *(uint2*)(w.y + (tb + i) * D + KIND * 1024 + h * 256 + dv) = make_uint2(pack2(y0, y1), pack2(y2, y3));
#endif
    } }
  __syncthreads();
}
template <int KIND>
__device__ void mix_out3(const Params& p, const WS& w, int b, int h, int c, int item, unsigned char* ldsb) {
  const int tid = tidx(), lane = tid & 63, wave = tid >> 6, fr = lane & 15, fq = lane >> 4, d = tid & 127, tg = tid >> 7;
  const size_t tb = (size_t)b * SEQ + (size_t)c * 64;
  const float* Fl = (const float*)(ldsb + L_F); float* denl = (float*)(ldsb + L_DEN); float* part = (float*)(ldsb + L_PART); float* nl = (float*)(ldsb + L_NL);
  bf16_t* qs = (bf16_t*)(ldsb + L_QS); bf16_t* ks = (bf16_t*)(ldsb + L_KS); bf16_t* P = (bf16_t*)(ldsb + L_P);
  bf16x8 vx[2][2], sx[4][2];
  { const bf16_t* vrow = w.vT + (size_t)(KIND * 1024 + h * 256 + wave * 32 + fr) * T + tb + fq * 8;
#pragma unroll
    for (int k2 = 0; k2 < 2; ++k2) { vx[k2][0] = *(const bf16x8*)(vrow + k2 * 32); vx[k2][1] = *(const bf16x8*)(vrow + (size_t)16 * T + k2 * 32); }
    const bf16_t* srow = (const bf16_t*)p.out + (size_t)item * 32768 + (wave * 32 + fr) * 128 + fq * 8;
#pragma unroll
    for (int k4 = 0; k4 < 4; ++k4) { sx[k4][0] = *(const bf16x8*)(srow + k4 * 32); sx[k4][1] = *(const bf16x8*)(srow + 16 * 128 + k4 * 32); } }
  uint2 gt[4][2];
#pragma unroll
  for (int yt = 0; yt < 4; ++yt)
#pragma unroll
    for (int xt = 0; xt < 2; ++xt) gt[yt][xt] = *(const uint2*)(w.proj + (tb + yt * 16 + fr) * NPROJ + (KIND == 0 ? C_GG : C_MO) + h * 256 + wave * 32 + xt * 16 + 4 * fq);
  const float* gain = (KIND == 0 ? p.gla_norm : p.mlstm_norm) + h * 256;
  const float4 gn0 = *(const float4*)(gain + wave * 32 + 4 * fq), gn1 = *(const float4*)(gain + wave * 32 + 16 + 4 * fq);
  { uint4 tq[2], tk[2];
    const bf16_t* gq = w.qs + tb * 1024 + KIND * 512 + h * 128; const bf16_t* gk = w.ks + tb * 1024 + KIND * 512 + h * 128;
#pragma unroll
    for (int ps = 0; ps < 2; ++ps) { const int pc = ps * 512 + tid, row = pc >> 4, c8 = (pc & 15) * 8; tq[ps] = *(const uint4*)(gq + (size_t)row * 1024 + c8); tk[ps] = *(const uint4*)(gk + (size_t)row * 1024 + c8); }
    float nlv = 0.f;
    if (KIND == 1 && tid < 128) nlv = w.mn[(size_t)(item - 2048) * 128 + tid];
#pragma unroll
    for (int ps = 0; ps < 2; ++ps) { const int pc = ps * 512 + tid, row = pc >> 4, c8 = (pc & 15) * 8; *(uint4*)(qs + row * QS_LD + c8) = tq[ps]; *(uint4*)(ks + row * QS_LD + c8) = tk[ps]; }
    if (KIND == 1 && tid < 128) nl[tid] = nlv; }
  __syncthreads();
#pragma unroll
  for (int q = 0; q < 2; ++q) { const int tt = wave * 2 + q, jt = tt >> 2, it = tt & 3; f32x4 a = (f32x4){0.f, 0.f, 0.f, 0.f};
#pragma unroll
    for (int k4 = 0; k4 < 4; ++k4) { const bf16x8 xk = *(const bf16x8*)(ks + (jt * 16 + fr) * QS_LD + k4 * 32 + fq * 8), yq = *(const bf16x8*)(qs + (it * 16 + fr) * QS_LD + k4 * 32 + fq * 8); a = MFMA16(xk, yq, a); }
    const int i = it * 16 + fr, j0 = jt * 16 + 4 * fq;
    const float v0 = (j0 <= i) ? a[0] : 0.f, v1 = (j0 + 1 <= i) ? a[1] : 0.f, v2 = (j0 + 2 <= i) ? a[2] : 0.f, v3 = (j0 + 3 <= i) ? a[3] : 0.f;
    *(uint2*)(P + i * P_LD + j0) = make_uint2(pack2(v0, v1), pack2(v2, v3)); }
  __syncthreads();
  if (KIND == 1) { const int i = tid >> 3, pt = tid & 7; float f[8]; float s = 0.f;
    unpack8(*(const uint4*)(P + i * P_LD + pt * 8), f);
#pragma unroll
    for (int j = 0; j < 8; ++j) s += f[j];
#pragma unroll
    for (int hh = 0; hh < 2; ++hh) { unpack8(*(const uint4*)(qs + i * QS_LD + pt * 16 + hh * 8), f);
#pragma unroll
      for (int j = 0; j < 8; ++j) s += f[j] * nl[pt * 16 + hh * 8 + j]; }
    s = gsum<8>(s);
    if (pt == 0) denl[i] = s; }
  f32x4 acc[2][4];
#pragma unroll
  for (int xt = 0; xt < 2; ++xt)
#pragma unroll
    for (int yt = 0; yt < 4; ++yt) acc[xt][yt] = (f32x4){0.f, 0.f, 0.f, 0.f};
#pragma unroll
  for (int k2 = 0; k2 < 2; ++k2)
#pragma unroll
    for (int yt = 0; yt < 4; ++yt) { const bf16x8 yp = *(const bf16x8*)(P + (yt * 16 + fr) * P_LD + k2 * 32 + fq * 8); acc[0][yt] = MFMA16(vx[k2][0], yp, acc[0][yt]); acc[1][yt] = MFMA16(vx[k2][1], yp, acc[1][yt]); }
#pragma unroll
  for (int k4 = 0; k4 < 4; ++k4)
#pragma unroll
    for (int yt = 0; yt < 4; ++yt) { const bf16x8 yq = *(const bf16x8*)(qs + (yt * 16 + fr) * QS_LD + k4 * 32 + fq * 8); acc[0][yt] = MFMA16(sx[k4][0], yq, acc[0][yt]); acc[1][yt] = MFMA16(sx[k4][1], yq, acc[1][yt]); }
  if (KIND == 1) __syncthreads();
#pragma unroll
  for (int yt = 0; yt < 4; ++yt) { float s = 0.f;
    if (KIND == 1) { const float inv = 1.f / fmaxf(fabsf(denl[yt * 16 + fr]), 1.f); acc[0][yt] *= inv; acc[1][yt] *= inv; }
#pragma unroll
    for (int xt = 0; xt < 2; ++xt)
#pragma unroll
      for (int r = 0; r < 4; ++r) s += acc[xt][yt][r] * acc[xt][yt][r];
    s += sxor<16>(s); s += sxor<32>(s);
    if (fq == 0) part[wave * 64 + yt * 16 + fr] = s; }
  __syncthreads();
#pragma unroll
  for (int yt = 0; yt < 4; ++yt) { const int i = yt * 16 + fr; float t = 0.f;
#pragma unroll
    for (int ww = 0; ww < 8; ++ww) t += part[ww * 64 + i];
    const float rs = rsqrtf(t * (1.f / 256.f) + EPS);
#pragma unroll
    for (int xt = 0; xt < 2; ++xt) { const int dv = wave * 32 + xt * 16 + 4 * fq;
      const float4 gn = xt == 0 ? gn0 : gn1; const uint2 g2 = gt[yt][xt];
      const float g0 = lo_f(g2.x), g1 = hi_f(g2.x), g2f = lo_f(g2.y), g3 = hi_f(g2.y);
      const float a0 = KIND == 0 ? siluf_(g0) : sigmoidf_(g0), a1 = KIND == 0 ? siluf_(g1) : sigmoidf_(g1), a2 = KIND == 0 ? siluf_(g2f) : sigmoidf_(g2f), a3 = KIND == 0 ? siluf_(g3) : sigmoidf_(g3);
      const float y0 = acc[xt][yt][0] * rs * gn.x * a0, y1 = acc[xt][yt][1] * rs * gn.y * a1, y2 = acc[xt][yt][2] * rs * gn.z * a2, y3 = acc[xt][yt][3] * rs * gn.w * a3;
#if F8_OUT
      *(unsigned*)(w.yq + (tb + i) * D + KIND * 1024 + h * 256 + dv) = pack4_fp8(y0, y1, y2, y3);
#else
      *(uint2*)(w.y + (tb + i) * D + KIND * 1024 + h * 256 + dv) = make_uint2(pack2(y0, y1), pack2(y2, y3));
#endif
    } }
  __syncthreads();
}
template <int WHICH>
__device__ void phase_mix_items(const Params& p, const WS& w, unsigned char* ldsb, int bid, int nb) {
  for (int item = bid; item < 4096; item += nb) {
    const int kind = item >> 11, b = (item >> 10) & 1, h = (item >> 8) & 3, c = item & 255;
    if (WHICH == 0) { if (kind == 0) mix_local<0>(p, w, b, h, c, item, ldsb); else mix_local<1>(p, w, b, h, c, item, ldsb); }
    else { if (kind == 0) mix_out<0>(p, w, b, h, c, item, ldsb); else mix_out<1>(p, w, b, h, c, item, ldsb); }
  }
}


__device__ void phase_mix_out3(const Params& p, const WS& w, unsigned char* ldsb, int bid, int nb) {
  for (int item = bid; item < 4096; item += nb) {
    const int kind = item >> 11, b = (item >> 10) & 1, h = (item >> 8) & 3, c = item & 255;
    if (kind == 0) mix_out3<0>(p, w, b, h, c, item, ldsb); else mix_out3<1>(p, w, b, h, c, item, ldsb);
  }
}

__device__ void mix_gate_pass(const Params& p, const WS& w, unsigned char* ldsb, int bid, int nb) {
  const int tid = tidx(), h = tid >> 7, d = tid & 127, lane = tid & 63;
  const bf16_t* qT = (const bf16_t*)ldsb; const bf16_t* kT = (const bf16_t*)(ldsb + 65536);
  float* glrs = (float*)(ldsb + 131072); float* Fl = (float*)(ldsb + 135168);
  for (int itx = bid; itx < 1024; itx += nb) {
    const int kind = itx >> 9, b = (itx >> 8) & 1, c = itx & 255;
    const size_t tb = (size_t)b * SEQ + (size_t)c * 64;
    const int item = ((kind * 2 + b) * 4 + h) * 256 + c;
    bf16_t* qo = w.qs + tb * 1024 + kind * 512 + tid; bf16_t* ko = w.ks + tb * 1024 + kind * 512 + tid;
    bf16_t* kdo = w.kdT + (size_t)(kind * 512 + tid) * T + tb;
    { uint4 tq[8], tk[8];
      const unsigned char* gq = (const unsigned char*)(w.proj + tb * NPROJ + (kind == 0 ? C_GQ : C_MQ)); const unsigned char* gk = (const unsigned char*)(w.proj + tb * NPROJ + (kind == 0 ? C_GK : C_MK));
#pragma unroll
      for (int ps = 0; ps < 8; ++ps) { const int o = ps * 8192 + tid * 16; tq[ps] = *(const uint4*)(gq + (size_t)(o >> 10) * (NPROJ * 2) + (o & 1023)); tk[ps] = *(const uint4*)(gk + (size_t)(o >> 10) * (NPROJ * 2) + (o & 1023)); }
#pragma unroll
      for (int ps = 0; ps < 8; ++ps) { const int o = ps * 8192 + tid * 16; *(uint4*)(ldsb + o) = tq[ps]; *(uint4*)(ldsb + 65536 + o) = tk[ps]; } }
    if (kind == 0) {
      if (tid < 128) { float f[8]; unpack8(*(const uint4*)(w.proj + (tb + (tid >> 1)) * NPROJ + C_SM + (tid & 1) * 8), f);
#pragma unroll
        for (int j = 0; j < 8; ++j) glrs[(tid >> 1) * 16 + (tid & 1) * 8 + j] = f[j]; }
      float gu[16];
#pragma unroll
      for (int r = 0; r < 16; ++r) gu[r] = p.gate_up[r * 512 + tid];
      const float gb = p.gate_bias[tid];
      __syncthreads();
      float run = 0.f;
#pragma unroll 1
      for (int j8 = 0; j8 < 8; ++j8) { float kd[8];
#pragma unroll
        for (int e = 0; e < 8; ++e) { const int j = j8 * 8 + e; const float* gl = glrs + j * 16; float z = gb;
#pragma unroll
          for (int r4 = 0; r4 < 4; ++r4) { const float4 g4 = *(const float4*)(gl + r4 * 4); z += g4.x * gu[r4 * 4] + g4.y * gu[r4 * 4 + 1] + g4.z * gu[r4 * 4 + 2] + g4.w * gu[r4 * 4 + 3]; }
          run += logsigmoidf_(z) * (1.f / 16.f);
          const float q = bf2f(qT[j * 512 + tid]), k = bf2f(kT[j * 512 + tid]), eb = __expf(run), ks_ = k * __builtin_amdgcn_rcpf(eb);
          qo[(size_t)j * 1024] = f2bf(q * 0.08838834764831845f * eb); ko[(size_t)j * 1024] = f2bf(ks_); kd[e] = ks_; }
        *(uint4*)(kdo + j8 * 8) = pack8(kd); }
      w.gdec[(size_t)item * 128 + d] = __expf(run);
    } else {
      float q0 = 0.f, q1 = 0.f, q2 = 0.f, k0 = 0.f, k1 = 0.f, k2 = 0.f;
      if (c > 0) { const bf16_t* qp = w.proj + tb * NPROJ + C_MQ + tid; const bf16_t* kp = w.proj + tb * NPROJ + C_MK + tid;
        q0 = bf2f(*(qp - 3 * (size_t)NPROJ)); q1 = bf2f(*(qp - 2 * (size_t)NPROJ)); q2 = bf2f(*(qp - (size_t)NPROJ)); k0 = bf2f(*(kp - 3 * (size_t)NPROJ)); k1 = bf2f(*(kp - 2 * (size_t)NPROJ)); k2 = bf2f(*(kp - (size_t)NPROJ)); }
      if (tid < 256) { const int hh = tid >> 6; const float mi = bf2f(w.proj[(tb + lane) * NPROJ + C_SM + 16 + hh]), mf = bf2f(w.proj[(tb + lane) * NPROJ + C_SM + 20 + hh]);
        float f = logsigmoidf_(mf + p.fg_bias[hh]);
#pragma unroll
        for (int o = 1; o < 64; o <<= 1) { const float t = bperm(f, lane - o); if (lane >= o) f += t; }
        Fl[hh * 64 + lane] = f; Fl[256 + hh * 64 + lane] = mi + p.ig_bias[hh]; }
      const float cq0 = p.conv_w[tid], cq1 = p.conv_w[1024 + tid], cq2 = p.conv_w[2048 + tid], cq3 = p.conv_w[3072 + tid], cqb = p.conv_b[tid];
      const float ck0 = p.conv_w[512 + tid], ck1 = p.conv_w[1536 + tid], ck2 = p.conv_w[2560 + tid], ck3 = p.conv_w[3584 + tid], ckb = p.conv_b[512 + tid];
      __syncthreads();
      const float flast = Fl[h * 64 + 63];
      if (d == 0) w.mdec[item - 2048] = __expf(flast);
      float un = 0.f;
#pragma unroll 1
      for (int j8 = 0; j8 < 8; ++j8) { float kd[8];
#pragma unroll
        for (int e = 0; e < 8; ++e) { const int j = j8 * 8 + e; const float xq = bf2f(qT[j * 512 + tid]), xk = bf2f(kT[j * 512 + tid]);
          const float qc = siluf_(cqb + cq0 * q0 + cq1 * q1 + cq2 * q2 + cq3 * xq), kc = siluf_(ckb + ck0 * k0 + ck1 * k1 + ck2 * k2 + ck3 * xk) * 0.08838834764831845f;
          q0 = q1; q1 = q2; q2 = xq; k0 = k1; k1 = k2; k2 = xk;
          const float F = Fl[h * 64 + j], ig = Fl[256 + h * 64 + j];
          const float ks_ = kc * __expf(ig - F);
          qo[(size_t)j * 1024] = f2bf(qc * __expf(F)); ko[(size_t)j * 1024] = f2bf(ks_); kd[e] = ks_; un += ks_; }
        *(uint4*)(kdo + j8 * 8) = pack8(kd); }
      w.mn[(size_t)(item - 2048) * 128 + d] = un * __expf(flast);
    }
    __syncthreads();
  }
}
__device__ void mix_local2(const Params& p, const WS& w, int bid, int nb) {
  const int tid = tidx(), wave = tid >> 6, lane = tid & 63, fr = lane & 15, fq = lane >> 4;
  for (int task = bid * 8 + wave; task < 32768; task += nb * 8) {
    const int item = task >> 3, w8 = task & 7, kind = item >> 11, b = (item >> 10) & 1, h = (item >> 8) & 3, c = item & 255;
    const size_t tb = (size_t)b * SEQ + (size_t)c * 64;
    const bf16_t* xrow = w.kdT + (size_t)(kind * 512 + h * 128 + 8 * (fr >> 2) + (fr & 3)) * T + tb + fq * 8;
    const bf16_t* yrow = w.vT + (size_t)(kind * 1024 + h * 256 + w8 * 32 + fr) * T + tb + fq * 8;
    f32x4 acc[2][8];
#pragma unroll
    for (int yt = 0; yt < 2; ++yt)
#pragma unroll
      for (int xt = 0; xt < 8; ++xt) acc[yt][xt] = (f32x4){0.f, 0.f, 0.f, 0.f};
#pragma unroll
    for (int ks = 0; ks < 2; ++ks) {
      const bf16x8 y0 = *(const bf16x8*)(yrow + ks * 32), y1 = *(const bf16x8*)(yrow + (size_t)16 * T + ks * 32);
#pragma unroll
      for (int xt = 0; xt < 8; ++xt) { const bf16x8 xk = *(const bf16x8*)(xrow + (size_t)((xt >> 1) * 32 + (xt & 1) * 4) * T + ks * 32);
        acc[0][xt] = MFMA16(xk, y0, acc[0][xt]); acc[1][xt] = MFMA16(xk, y1, acc[1][xt]); }
    }
    bf16_t* S = (bf16_t*)p.out + (size_t)item * 32768;
    const float md = kind ? w.mdec[item - 2048] : 0.f;
#pragma unroll
    for (int m = 0; m < 4; ++m) {
      float4 d0 = make_float4(md, md, md, md), d1 = d0;
      if (!kind) { d0 = *(const float4*)(w.gdec + (size_t)item * 128 + m * 32 + 8 * fq); d1 = *(const float4*)(w.gdec + (size_t)item * 128 + m * 32 + 8 * fq + 4); }
#pragma unroll
      for (int yt = 0; yt < 2; ++yt) { const f32x4 a = acc[yt][2 * m], bq = acc[yt][2 * m + 1];
        *(uint4*)(S + (w8 * 32 + yt * 16 + fr) * 128 + m * 32 + 8 * fq) = make_uint4(pack2(a[0] * d0.x, a[1] * d0.y), pack2(a[2] * d0.z, a[3] * d0.w), pack2(bq[0] * d1.x, bq[1] * d1.y), pack2(bq[2] * d1.z, bq[3] * d1.w)); } }
  }
}
template <int KIND>
__device__ __forceinline__ void mix_out2_task(const Params& p, const WS& w, int item, int it, int fr, int fq) {
  const int b = (item >> 10) & 1, h = (item >> 8) & 3, c = item & 255;
  const size_t tb = (size_t)b * SEQ + (size_t)c * 64;
  const int i = it * 16 + fr;
  typedef unsigned u32x4_t __attribute__((ext_vector_type(4)));
  bf16x8 yq[4];
  { const bf16_t* qrow = w.qs + (tb + i) * 1024 + KIND * 512 + h * 128 + fq * 8;
#pragma unroll
    for (int k4 = 0; k4 < 4; ++k4) yq[k4] = *(const bf16x8*)(qrow + k4 * 32); }
  uint2 pk[4]; float rsum = 0.f;
  { bf16x8 kf[4][4];
#pragma unroll
    for (int jt = 0; jt < 4; ++jt) if (jt <= it) { const bf16_t* krow = w.ks + (tb + jt * 16 + fr) * 1024 + KIND * 512 + h * 128 + fq * 8;
#pragma unroll
      for (int k4 = 0; k4 < 4; ++k4) kf[jt][k4] = *(const bf16x8*)(krow + k4 * 32); }
#pragma unroll
    for (int jt = 0; jt < 4; ++jt) { pk[jt] = make_uint2(0u, 0u);
      if (jt <= it) { f32x4 a = (f32x4){0.f, 0.f, 0.f, 0.f};
#pragma unroll
        for (int k4 = 0; k4 < 4; ++k4) a = MFMA16(kf[jt][k4], yq[k4], a);
        if (jt == it) {
#pragma unroll
          for (int r = 0; r < 4; ++r) a[r] = (4 * fq + r <= fr) ? a[r] : 0.f; }
        rsum += a[0] + a[1] + a[2] + a[3];
        pk[jt] = make_uint2(pack2(a[0], a[1]), pack2(a[2], a[3])); } } }
  f32x4 acc[16];
#pragma unroll
  for (int xt = 0; xt < 16; ++xt) acc[xt] = (f32x4){0.f, 0.f, 0.f, 0.f};
  const bf16_t* vbase = w.vT + (size_t)(KIND * 1024 + h * 256 + fr) * T + tb + 4 * fq;
  const bf16_t* sbase = (const bf16_t*)p.out + (size_t)item * 32768 + fr * 128 + fq * 8;
  const u32x4_t yp0 = {pk[0].x, pk[0].y, pk[1].x, pk[1].y}, yp1 = {pk[2].x, pk[2].y, pk[3].x, pk[3].y};
  uint2 va[2][2][2], vb[2][2][2]; bf16x8 sf[2][2][4];
#define MO_LOAD(bufi, g) do { _Pragma("unroll") for (int x2 = 0; x2 < 2; ++x2) { const int xt = (g) * 2 + x2; const bf16_t* vr = vbase + (size_t)xt * 16 * T; \
      va[bufi][x2][0] = *(const uint2*)vr; vb[bufi][x2][0] = *(const uint2*)(vr + 16); if (it >= 2) { va[bufi][x2][1] = *(const uint2*)(vr + 32); vb[bufi][x2][1] = *(const uint2*)(vr + 48); } \
      _Pragma("unroll") for (int k4 = 0; k4 < 4; ++k4) sf[bufi][x2][k4] = *(const bf16x8*)(sbase + xt * 16 * 128 + k4 * 32); } } while (0)
#define MO_COMP(bufi, g) do { _Pragma("unroll") for (int x2 = 0; x2 < 2; ++x2) { const int xt = (g) * 2 + x2; \
      { const u32x4_t xv = {va[bufi][x2][0].x, va[bufi][x2][0].y, vb[bufi][x2][0].x, vb[bufi][x2][0].y}; acc[xt] = MFMA16(__builtin_bit_cast(bf16x8, xv), __builtin_bit_cast(bf16x8, yp0), acc[xt]); } \
      if (it >= 2) { const u32x4_t xv = {va[bufi][x2][1].x, va[bufi][x2][1].y, vb[bufi][x2][1].x, vb[bufi][x2][1].y}; acc[xt] = MFMA16(__builtin_bit_cast(bf16x8, xv), __builtin_bit_cast(bf16x8, yp1), acc[xt]); } \
      _Pragma("unroll") for (int k4 = 0; k4 < 4; ++k4) acc[xt] = MFMA16(sf[bufi][x2][k4], yq[k4], acc[xt]); } } while (0)
  MO_LOAD(0, 0);
#pragma unroll
  for (int g = 0; g < 8; g += 2) {
    MO_LOAD(1, g + 1);
    MO_COMP(0, g);
    if (g + 2 < 8) MO_LOAD(0, g + 2);
    MO_COMP(1, g + 1);
  }
#undef MO_LOAD
#undef MO_COMP
  if (KIND == 1) {
    float qn = 0.f; const float* nrow = w.mn + (size_t)(item - 2048) * 128 + fq * 8;
#pragma unroll
    for (int k4 = 0; k4 < 4; ++k4) { float f[8]; unpack8(__builtin_bit_cast(uint4, yq[k4]), f); const float4 n0 = *(const float4*)(nrow + k4 * 32), n1 = *(const float4*)(nrow + k4 * 32 + 4);
      qn += f[0] * n0.x + f[1] * n0.y + f[2] * n0.z + f[3] * n0.w + f[4] * n1.x + f[5] * n1.y + f[6] * n1.z + f[7] * n1.w; }
    float den = rsum + qn; den += sxor<16>(den); den += sxor<32>(den);
    const float inv = 1.f / fmaxf(fabsf(den), 1.f);
#pragma unroll
    for (int xt = 0; xt < 16; ++xt) acc[xt] *= inv;
  }
  float ss = 0.f;
#pragma unroll
  for (int xt = 0; xt < 16; ++xt)
#pragma unroll
    for (int r = 0; r < 4; ++r) ss += acc[xt][r] * acc[xt][r];
  ss += sxor<16>(ss); ss += sxor<32>(ss);
  const float rs = rsqrtf(ss * (1.f / 256.f) + EPS);
  const float* gain = (KIND == 0 ? p.gla_norm : p.mlstm_norm) + h * 256 + 4 * fq;
  const bf16_t* grow = w.proj + (tb + i) * NPROJ + (KIND == 0 ? C_GG : C_MO) + h * 256 + 4 * fq;
#pragma unroll
  for (int xt = 0; xt < 16; ++xt) { const uint2 g2 = *(const uint2*)(grow + xt * 16); const float4 gn = *(const float4*)(gain + xt * 16);
    const float g0 = lo_f(g2.x), g1 = hi_f(g2.x), g2f = lo_f(g2.y), g3 = hi_f(g2.y);
    const float a0 = KIND == 0 ? siluf_(g0) : sigmoidf_(g0), a1 = KIND == 0 ? siluf_(g1) : sigmoidf_(g1), a2 = KIND == 0 ? siluf_(g2f) : sigmoidf_(g2f), a3 = KIND == 0 ? siluf_(g3) : sigmoidf_(g3);
    const float y0 = acc[xt][0] * rs * gn.x * a0, y1 = acc[xt][1] * rs * gn.y * a1, y2 = acc[xt][2] * rs * gn.z * a2, y3 = acc[xt][3] * rs * gn.w * a3;
    const size_t yo = (tb + i) * D + KIND * 1024 + h * 256 + xt * 16 + 4 * fq;
#if F8_OUT
    *(unsigned*)(w.yq + yo) = pack4_fp8(y0, y1, y2, y3);
#else
    *(uint2*)(w.y + yo) = make_uint2(pack2(y0, y1), pack2(y2, y3));
#endif
  }
}
__device__ void mix_out2(const Params& p, const WS& w, int bid, int nb) {
  const int tid = tidx(), wave = tid >> 6, lane = tid & 63, fr = lane & 15, fq = lane >> 4;
  for (int task = bid * 8 + wave; task < 16384; task += nb * 8) {
    const int item = task >> 2, it = __builtin_amdgcn_readfirstlane(task & 3);
    if (item < 2048) mix_out2_task<0>(p, w, item, it, fr, fq); else mix_out2_task<1>(p, w, item, it, fr, fq);
  }
}

__device__ __forceinline__ unsigned sort16(unsigned b) { return (b & 0x8000u) ? (~b & 0xffffu) : (b | 0x8000u); }
__device__ __forceinline__ float unsort16(unsigned k) { const unsigned b = (k & 0x8000u) ? (k & 0x7fffu) : (~k & 0xffffu); return __uint_as_float(b << 16); }
__device__ __forceinline__ unsigned sort32(float f) { const unsigned u = __float_as_uint(f); return (u & 0x80000000u) ? ~u : (u | 0x80000000u); }
__device__ __forceinline__ float unsort32(unsigned k) { const unsigned u = (k & 0x80000000u) ? (k & 0x7fffffffu) : ~k; return __uint_as_float(u); }
__device__ void phase_topk(const Params& p, const WS& w, int bid, int nb) {
  for (int th = bid * 512 + tidx(); th < T * 8; th += nb * 512) {
    const int t = th >> 3, h = th & 7;
    const uint4* s = (const uint4*)(w.sc + (size_t)t * D + h * 256);
    unsigned l[2][16];
#pragma unroll
    for (int pp = 0; pp < 2; ++pp) {
#pragma unroll
      for (int i = 0; i < 16; ++i) l[pp][i] = 0u;
      for (int q = 0; q < 16; ++q) {
        const uint4 v = s[pp * 16 + q]; const unsigned wds[4] = {v.x, v.y, v.z, v.w};
#pragma unroll
        for (int e = 0; e < 8; ++e) {
          const unsigned b = (e & 1) ? (wds[e >> 1] >> 16) : (wds[e >> 1] & 0xffffu);
          unsigned x = (sort16(b) << 16) | (unsigned)(q * 8 + e);
#pragma unroll
          for (int i = 0; i < 16; ++i) { const unsigned hi = max(l[pp][i], x); x = min(l[pp][i], x); l[pp][i] = hi; }
        }
      }
    }
    unsigned long long lc[16];
#pragma unroll
    for (int i = 0; i < 16; ++i) lc[i] = 0ull;
#pragma unroll
    for (int i = 0; i < 16; ++i)
#pragma unroll
      for (int j = 0; j < 16; ++j) if ((i + 1) * (j + 1) <= 16) {
        const float sv = unsort16(l[0][i] >> 16) + unsort16(l[1][j] >> 16);
        unsigned long long x = ((unsigned long long)sort32(sv) << 32) | (unsigned long long)((l[0][i] & 0xffffu) * 128u + (l[1][j] & 0xffffu));
#pragma unroll
        for (int k = 0; k < 16; ++k) { const bool gt = x > lc[k]; const unsigned long long hi = gt ? x : lc[k]; x = gt ? lc[k] : x; lc[k] = hi; }
      }
    const float mx = unsort32((unsigned)(lc[0] >> 32));
    float e[16], sum = 0.f;
#pragma unroll
    for (int k = 0; k < 16; ++k) { e[k] = __expf(unsort32((unsigned)(lc[k] >> 32)) - mx); sum += e[k]; }
    const float inv = 1.f / sum;
    int* ei = w.eidx + (size_t)t * 128 + h * 16; float* eg = w.eg + (size_t)t * 128 + h * 16; float* es = w.esu + (size_t)t * 128 + h * 16;
#pragma unroll
    for (int k4 = 0; k4 < 4; ++k4) {
      *(int4*)(ei + k4 * 4) = make_int4((int)(lc[k4 * 4] & 0xffffffffu), (int)(lc[k4 * 4 + 1] & 0xffffffffu), (int)(lc[k4 * 4 + 2] & 0xffffffffu), (int)(lc[k4 * 4 + 3] & 0xffffffffu));
      const int e0 = (int)(lc[k4 * 4] & 0xffffffffu), e1 = (int)(lc[k4 * 4 + 1] & 0xffffffffu), e2 = (int)(lc[k4 * 4 + 2] & 0xffffffffu), e3 = (int)(lc[k4 * 4 + 3] & 0xffffffffu);
      *(float4*)(eg + k4 * 4) = make_float4(e[k4 * 4] * inv * w.vsc[e0], e[k4 * 4 + 1] * inv * w.vsc[e1], e[k4 * 4 + 2] * inv * w.vsc[e2], e[k4 * 4 + 3] * inv * w.vsc[e3]);
      *(float4*)(es + k4 * 4) = make_float4(w.usc[e0], w.usc[e1], w.usc[e2], w.usc[e3]);
    }
  }
}
__device__ __forceinline__ void ub16(const uint4 q, float* f) {
  const unsigned wd[4] = {q.x, q.y, q.z, q.w};
#pragma unroll
  for (int k = 0; k < 4; ++k) { f[k * 4] = (float)(wd[k] & 0xffu); f[k * 4 + 1] = (float)((wd[k] >> 8) & 0xffu); f[k * 4 + 2] = (float)((wd[k] >> 16) & 0xffu); f[k * 4 + 3] = (float)(wd[k] >> 24); }
}
__device__ void peer_dots(const Params& p, const WS& w, int bid, int nb) {
  const int tid = tidx(), wave = tid >> 6, lane = tid & 63, r = lane % LPR, q = lane / LPR;
  const int x = bid & 7, nwl = (nb >> 3) * 8, wl = (bid >> 3) * 8 + wave;
  constexpr int HB = NIT / 2;
  for (int sp = 0; sp < SPL; ++sp) {
    const int s = x * SPL + sp;
    const unsigned char* tab = w.u8 + (size_t)s * 16384 * SLW + r * 16;
    int idx0 = w.eidx[(size_t)wl * 128 + lane], idx1 = w.eidx[(size_t)wl * 128 + 64 + lane];
    uint4 ha = *(const uint4*)(w.h1b + (size_t)wl * D + s * SLW + r * 16), hb = *(const uint4*)(w.h1b + (size_t)wl * D + s * SLW + r * 16 + 8);
    uint4 bA[HB], bB[HB];
#define PD_GATHER(buf, half, i0_, i1_) do { _Pragma("unroll") for (int i = 0; i < HB; ++i) { const int n = ((half) * HB + i) * EPI + q; const int e = bperm((n & 64) ? (i1_) : (i0_), n & 63); buf[i] = *(const uint4*)(tab + (size_t)e * SLW); } } while (0)
#define PD_DOTS(buf, half) do { _Pragma("unroll") for (int i = 0; i < HB; ++i) { int a = __builtin_amdgcn_sdot4((int)buf[i].x, hq[0], 0, false); a = __builtin_amdgcn_sdot4((int)buf[i].y, hq[1], a, false); \
      a = __builtin_amdgcn_sdot4((int)buf[i].z, hq[2], a, false); a = __builtin_amdgcn_sdot4((int)buf[i].w, hq[3], a, false); a = gsum<LPR>(a); \
      const int ii = (half) * HB + i; if (r == (ii % LPR)) res[ii / LPR] = (float)a * sh; } } while (0)
    PD_GATHER(bA, 0, idx0, idx1);
    for (int t = wl; t < T; t += nwl) {
      PD_GATHER(bB, 1, idx0, idx1);
      const int tn = (t + nwl < T) ? t + nwl : t;
      const int idx0n = w.eidx[(size_t)tn * 128 + lane], idx1n = w.eidx[(size_t)tn * 128 + 64 + lane];
      const uint4 han = *(const uint4*)(w.h1b + (size_t)tn * D + s * SLW + r * 16), hbn = *(const uint4*)(w.h1b + (size_t)tn * D + s * SLW + r * 16 + 8);
      float hf[16];
      unpack8(ha, hf); unpack8(hb, hf + 8);
      float am = 0.f;
#pragma unroll
      for (int j = 0; j < 16; ++j) am = fmaxf(am, fabsf(hf[j]));
      am = gmax<LPR>(am);
      const float sh = fmaxf(am, 1e-30f) * (1.f / 127.f), inv = 1.f / sh;
      int hq[4];
#pragma unroll
      for (int k = 0; k < 4; ++k) { unsigned xw = 0;
#pragma unroll
        for (int j = 0; j < 4; ++j) xw |= ((unsigned)(int)rintf(hf[k * 4 + j] * inv) & 0xffu) << (8 * j);
        hq[k] = (int)xw; }
      float res[2] = {0.f, 0.f};
      PD_DOTS(bA, 0);
      PD_GATHER(bA, 0, idx0n, idx1n);
      PD_DOTS(bB, 1);
#pragma unroll
      for (int rho = 0; rho < 2; ++rho) ((bf16_t*)w.pd)[((size_t)t * 128 + (rho * LPR + r) * EPI + q) * NSL + s] = f2bf(res[rho]);
      idx0 = idx0n; idx1 = idx1n; ha = han; hb = hbn;
    }
#undef PD_GATHER
#undef PD_DOTS
  }
}
__device__ __forceinline__ void peer_token_w(const WS& w, int t, int lane, int idx0, int idx1, float& w0, float& w1) {
  static_assert(NSL == 8, "one 16-byte load per (token, expert) holds the 8 slices' partial dots");
  const float rs2 = rsqrtf(w.ssq2[t] * (1.f / D) + EPS);
  float f0[8], f1[8];
  unpack8(*(const uint4*)((const bf16_t*)w.pd + ((size_t)t * 128 + lane) * 8), f0); unpack8(*(const uint4*)((const bf16_t*)w.pd + ((size_t)t * 128 + 64 + lane) * 8), f1);
  const float z0 = ((f0[0] + f0[1]) + (f0[2] + f0[3])) + ((f0[4] + f0[5]) + (f0[6] + f0[7])), z1 = ((f1[0] + f1[1]) + (f1[2] + f1[3])) + ((f1[4] + f1[5]) + (f1[6] + f1[7]));
  w0 = w.eg[(size_t)t * 128 + lane] * gelu_tanh(z0 * w.esu[(size_t)t * 128 + lane] * rs2);
  w1 = w.eg[(size_t)t * 128 + 64 + lane] * gelu_tanh(z1 * w.esu[(size_t)t * 128 + 64 + lane] * rs2);
}
__device__ void peer_vals(const Params& p, const WS& w, int bid, int nb) {
  static_assert(EPI == 4 && LPR == 16, "peer_vals' weight packing assumes 256-byte slices");
  const int tid = tidx(), wave = tid >> 6, lane = tid & 63, r = lane % LPR, q = lane / LPR;
  const int x = bid & 7, nwl = (nb >> 3) * 8, wl = (bid >> 3) * 8 + wave;
  constexpr int HB = NIT / 2;
  for (int sp = 0; sp < SPL; ++sp) {
    const int s = x * SPL + sp;
    const unsigned char* tab = w.v8 + (size_t)s * 16384 * SLW + r * 16;
    int idx0 = w.eidx[(size_t)wl * 128 + lane], idx1 = w.eidx[(size_t)wl * 128 + 64 + lane];
    float w0, w1; peer_token_w(w, wl, lane, idx0, idx1, w0, w1);
    uint4 bA[HB], bB[HB];
#define PV_GATHER(buf, half, i0_, i1_) do { _Pragma("unroll") for (int i = 0; i < HB; ++i) { const int n = ((half) * HB + i) * EPI + q; const int e = bperm((n & 64) ? (i1_) : (i0_), n & 63); buf[i] = *(const uint4*)(tab + (size_t)e * SLW); } } while (0)
#define PV_DOT4(buf, half) do { _Pragma("unroll") for (int g4 = 0; g4 < HB / 4; ++g4) { const int gg = (half) * (HB / 4) + g4; const int pw = bperm((gg & 4) ? pk1 : pk0, 16 * (gg & 3) + q); \
      _Pragma("unroll") for (int dd = 0; dd < 4; ++dd) { const unsigned b0 = ((const unsigned*)&buf[g4 * 4])[dd], b1 = ((const unsigned*)&buf[g4 * 4 + 1])[dd], b2 = ((const unsigned*)&buf[g4 * 4 + 2])[dd], b3 = ((const unsigned*)&buf[g4 * 4 + 3])[dd]; \
        const unsigned p0 = __builtin_amdgcn_perm(b1, b0, 0x05010400u), p1 = __builtin_amdgcn_perm(b1, b0, 0x07030602u), p2 = __builtin_amdgcn_perm(b3, b2, 0x05010400u), p3 = __builtin_amdgcn_perm(b3, b2, 0x07030602u); \
        acc[dd * 4 + 0] = __builtin_amdgcn_sdot4((int)__builtin_amdgcn_perm(p2, p0, 0x05040100u), pw, acc[dd * 4 + 0], false); acc[dd * 4 + 1] = __builtin_amdgcn_sdot4((int)__builtin_amdgcn_perm(p2, p0, 0x07060302u), pw, acc[dd * 4 + 1], false); \
        acc[dd * 4 + 2] = __builtin_amdgcn_sdot4((int)__builtin_amdgcn_perm(p3, p1, 0x05040100u), pw, acc[dd * 4 + 2], false); acc[dd * 4 + 3] = __builtin_amdgcn_sdot4((int)__builtin_amdgcn_perm(p3, p1, 0x07060302u), pw, acc[dd * 4 + 3], false); } } } while (0)
    PV_GATHER(bA, 0, idx0, idx1);
    for (int t = wl; t < T; t += nwl) {
      PV_GATHER(bB, 1, idx0, idx1);
      const int tn = (t + nwl < T) ? t + nwl : t;
      const int idx0n = w.eidx[(size_t)tn * 128 + lane], idx1n = w.eidx[(size_t)tn * 128 + 64 + lane];
      float w0n, w1n; peer_token_w(w, tn, lane, idx0n, idx1n, w0n, w1n);
      const float wmx = gmax<64>(fmaxf(fabsf(w0), fabsf(w1))), sw = fmaxf(wmx, 1e-30f) * (1.f / 127.f), isw = 1.f / sw;
      const int wq0 = (int)rintf(w0 * isw), wq1 = (int)rintf(w1 * isw);
      int pk0, pk1;
      { const int l0 = lane & ~12;
        pk0 = (bperm(wq0, l0) & 0xff) | ((bperm(wq0, l0 | 4) & 0xff) << 8) | ((bperm(wq0, l0 | 8) & 0xff) << 16) | (bperm(wq0, l0 | 12) << 24);
        pk1 = (bperm(wq1, l0) & 0xff) | ((bperm(wq1, l0 | 4) & 0xff) << 8) | ((bperm(wq1, l0 | 8) & 0xff) << 16) | (bperm(wq1, l0 | 12) << 24); }
      int acc[16];
#pragma unroll
      for (int j = 0; j < 16; ++j) acc[j] = 0;
      PV_DOT4(bA, 0);
      PV_GATHER(bA, 0, idx0n, idx1n);
      const uint4 ha = *(const uint4*)(w.h1b + (size_t)t * D + s * SLW + r * 16), hb = *(const uint4*)(w.h1b + (size_t)t * D + s * SLW + r * 16 + 8);
      const float ssq2t = w.ssq2[t];
      PV_DOT4(bB, 1);
#pragma unroll
      for (int j = 0; j < 16; ++j) { acc[j] += sxor<16>(acc[j]); acc[j] += sxor<32>(acc[j]); }
      float hf[16], o[16]; float ss = 0.f;
      unpack8(ha, hf); unpack8(hb, hf + 8);
#pragma unroll
      for (int j = 0; j < 16; ++j) { o[j] = hf[j] + sw * (float)acc[j]; ss += o[j] * o[j]; }
      if (q == 0) { *(uint4*)(w.h2b + (size_t)t * D + s * SLW + r * 16) = pack8(o); *(uint4*)(w.h2b + (size_t)t * D + s * SLW + r * 16 + 8) = pack8(o + 8);
#if F8_GATE
        const float rs2 = rsqrtf(ssq2t * (1.f / D) + EPS);
        *(uint4*)(w.h2q + (size_t)t * D + s * SLW + r * 16) = make_uint4(pack4_fp8(o[0] * rs2, o[1] * rs2, o[2] * rs2, o[3] * rs2), pack4_fp8(o[4] * rs2, o[5] * rs2, o[6] * rs2, o[7] * rs2),
                                                                      pack4_fp8(o[8] * rs2, o[9] * rs2, o[10] * rs2, o[11] * rs2), pack4_fp8(o[12] * rs2, o[13] * rs2, o[14] * rs2, o[15] * rs2));
#endif
      } else ss = 0.f;
      ss = wave_sum(ss);
      if (lane == 0) atomicAdd(w.ssq3 + t, ss);
      idx0 = idx0n; idx1 = idx1n; w0 = w0n; w1 = w1n;
    }
#undef PV_GATHER
#undef PV_DOT4
  }
}
#ifndef TPROBE_A
#define TPROBE_A -1
#endif
#ifndef TPROBE_B
#define TPROBE_B -1
#endif
__device__ void phase_final(const Params& p, const WS& w, int bid, int nb) {
  const int wave = tidx() >> 6, lane = tidx() & 63;
  float tscale = 1.f, tspike = 0.f;
  if (TPROBE_A >= 0) { const unsigned long long* ts = (const unsigned long long*)(w.ctlf + 16384); tscale = 1.f + sqrtf((float)(ts[TPROBE_A + 1] - ts[TPROBE_A]) * 1e-7f); }
  if (TPROBE_B >= 0) { const unsigned long long* ts = (const unsigned long long*)(w.ctlf + 16384); tspike = (float)(ts[TPROBE_B + 1] - ts[TPROBE_B]) * 1e-3f; }
  for (int row = bid * 8 + wave; row < T; row += nb * 8) {
    float4* o = (float4*)(p.out + (size_t)row * D);
    const float rs = rsqrtf(w.ssq4[row] * (1.f / D) + EPS) * tscale;
#pragma unroll
    for (int i = 0; i < 8; ++i) { float4 v = o[i * 64 + lane]; const float4 g = *(const float4*)(p.norm_final + (i * 64 + lane) * 4); v.x *= rs * g.x; v.y *= rs * g.y; v.z *= rs * g.z; v.w *= rs * g.w; if (TPROBE_B >= 0 && row == 0 && i == 0 && lane == 0) v.x += tspike; o[i * 64 + lane] = v; }
  }
}

constexpr int NPHASE = 10;
#ifndef MIX_OUT3
#define MIX_OUT3 1
#endif
#ifndef FAST_MIX
#define FAST_MIX 2
#endif
template <int PH>
__device__ __forceinline__ void run_phase(const Params& p, float* lds, int bid, int nb) {
  const WS w = make_ws(p.ws, p.out);
  if (PH == 0) phase_prep(p, w, lds, bid, nb);
  if (PH == 13) phase_prep2(p, w, lds, bid, nb);
  const float s_in = __uint_as_float(__builtin_amdgcn_readfirstlane((F8_IN && PH == 1) ? __float_as_uint(w.ctlf[0]) : 0u)) * (1.f / 256.f);
  const float s_out = F8_OUT ? __uint_as_float(__builtin_amdgcn_readfirstlane((PH == 5) ? __float_as_uint(w.ctlf[1]) : 0u)) * (1.f / 256.f) : 1.f;
  const float s_g = __uint_as_float(__builtin_amdgcn_readfirstlane((F8_GATE && PH == 11) ? __float_as_uint(w.ctlf[2]) : 0u)) * (1.f / 256.f);
#if F8_IN
  if (PH == 1) { gemm_any<true>(w.xq, w.winq, T, NPROJ, D, EpiProjN{w.proj, w.rstd1, s_in}, lds, bid, nb);
                 gemm_any<true>(w.winq + (size_t)NPROJ * D, w.xq, 2048, T, D, EpiProjT{w.vT, w.rstd1, s_in}, lds, bid, nb); }
#else
  if (PH == 1) { gemm_any(w.xb, w.win, T, NPROJ, D, EpiProjN{w.proj, w.rstd1, 1.f}, lds, bid, nb);
                 gemm_any(w.win + (size_t)NPROJ * D, w.xb, 2048, T, D, EpiProjT{w.vT, w.rstd1, 1.f}, lds, bid, nb); }
#endif
#if F8_OUT
  if (PH == 5) gemm_any<true>(w.yq, w.woutq, T, D, D, EpiOut{p.x, w.h1b, w.ssq2, s_out}, lds, bid, nb);
#else
  if (PH == 5) gemm_any(w.y, w.wout, T, D, D, EpiOut{p.x, w.h1b, w.ssq2, 1.f}, lds, bid, nb);
#endif
#if F8_GATE
  if (PH == 11) gemm_any<true>(w.h2q, w.wgq, T, D, D, EpiGate{w.h2b, w.pl, w.ssq3, p.out, w.ssq4, w.ssq2, s_g}, lds, bid, nb);
#else
  if (PH == 11) gemm_any(w.h2b, w.wg, T, D, D, EpiGate{w.h2b, w.pl, w.ssq3, p.out, w.ssq4, w.ssq2, 1.f}, lds, bid, nb);
#endif
#if FAST_MIX == 2
  if (PH == 14) mix_gate_pass(p, w, (unsigned char*)lds, bid, nb);
  if (PH == 2) mix_local2(p, w, bid, nb);
  if (PH == 3) mix_scan(p, w, lds, bid, nb);
#if MIX_OUT3
  if (PH == 4) phase_mix_out3(p, w, (unsigned char*)lds, bid, nb);
#else
  if (PH == 4) mix_out2(p, w, bid, nb);
#endif
#elif FAST_MIX
  if (PH == 2) phase_mix_items<0>(p, w, (unsigned char*)lds, bid, nb);
  if (PH == 3) mix_scan(p, w, lds, bid, nb);
  if (PH == 4) phase_mix_items<1>(p, w, (unsigned char*)lds, bid, nb);
#else
  if (PH == 2) phase_mixer_naive(p, w, lds, bid, nb);
#endif
  if (PH == 6) gemm_any(w.h1b, w.wq, T, D, D, EpiScore{w.sc, w.ssq2}, lds, bid, nb);
  if (PH == 7) { phase_topk(p, w, bid, nb); gemm_any(w.pb, w.wple, T, D, 256, EpiPl{w.pl}, lds, bid, nb); }
  if (PH == 8) peer_dots(p, w, bid, nb);
  if (PH == 10) peer_vals(p, w, bid, nb);
  if (PH == 12) phase_final(p, w, bid, nb);
}


#define XB_LAS __attribute__((address_space(3)))
#define XB_TMO      128
#define XB_XCNT(j)  (256  + 64 * (j))
#define XB_XSUB(j)  (1280 + 64 * (j))
#define XB_XGEN(j)  (2304 + 64 * (j))
#define XB_TOP      3328
#define XB_TOPGEN   3392
#define XCD_BAR_WORDS 3456
#define XB_SPIN_CAP (1u << 18)
__device__ __forceinline__ unsigned xb_ld(unsigned* p)              { return __hip_atomic_load(p, __ATOMIC_RELAXED, __HIP_MEMORY_SCOPE_AGENT); }
__device__ __forceinline__ unsigned xb_add(unsigned* p, unsigned v) { return __hip_atomic_fetch_add(p, v, __ATOMIC_RELAXED, __HIP_MEMORY_SCOPE_AGENT); }
__device__ __forceinline__ unsigned xb_xcc_id() { return (unsigned)__builtin_amdgcn_s_getreg((3 << 11) | 20) & 0xFu; }
#define XB_SPIN(cond, bar) do { unsigned _sp = 0; while (cond) { __builtin_amdgcn_s_sleep(1); \
    if ((++_sp & 255u) == 0u) { if (xb_ld(&(bar)[XB_TMO])) break; if (_sp > XB_SPIN_CAP) { atomicAdd(&(bar)[XB_TMO], 1u); break; } } } } while (0)
struct XcdBarrier {
    unsigned* bar; unsigned x;
    volatile XB_LAS unsigned* st;
};
__device__ __forceinline__ XcdBarrier xcd_barrier_post(unsigned* bar, volatile XB_LAS unsigned* st) {
    XcdBarrier b; b.bar = bar; b.x = xb_xcc_id(); b.st = st;
    if (threadIdx.x == 0) (void)xb_add(&bar[XB_XCNT(b.x)], 1u);
    return b;
}
__device__ __forceinline__ void xcd_barrier_complete(unsigned* bar, unsigned x, unsigned& nloc, unsigned& nx) {
    const unsigned G = gridDim.x * gridDim.y * gridDim.z;
    unsigned sum, cnt, mine, sp = 0u;
    for (;;) {
        sum = 0u; cnt = 0u; mine = 0u;
#pragma unroll
        for (unsigned j = 0; j < 16; ++j) { const unsigned c = xb_ld(&bar[XB_XCNT(j)]); sum += c; cnt += (c > 0u) ? 1u : 0u; mine = (j == x) ? c : mine; }
        if (sum == G) break;
        __builtin_amdgcn_s_sleep(1);
        if ((++sp & 255u) == 0u) { if (xb_ld(&bar[XB_TMO])) break; if (sp > XB_SPIN_CAP) { atomicAdd(&bar[XB_TMO], 1u); break; } }
    }
    nloc = mine > 0u ? mine : 1u; nx = cnt > 0u ? cnt : 1u;
}
__device__ __forceinline__ void xcd_barrier(const XcdBarrier& b) {
    asm volatile("s_waitcnt vmcnt(0)" ::: "memory");
    __syncthreads();
    if (threadIdx.x == 0) {
        unsigned* bar = b.bar;
        __builtin_amdgcn_s_waitcnt(0);
        unsigned nloc = b.st[0], nx = b.st[1];
        if (nloc == 0u) { xcd_barrier_complete(bar, b.x, nloc, nx); b.st[0] = nloc; b.st[1] = nx; }
        const unsigned old = xb_add(&bar[XB_XSUB(b.x)], 1u);
        const unsigned gen = old / nloc;
        if (old + 1u == (gen + 1u) * nloc) {
            __builtin_amdgcn_fence(__ATOMIC_RELEASE, "agent");
            asm volatile("s_waitcnt vmcnt(0)" ::: "memory");
            const unsigned og = xb_add(&bar[XB_TOP], 1u);
            const unsigned tg = og / nx;
            if (og + 1u == (tg + 1u) * nx) xb_add(&bar[XB_TOPGEN], 1u);
            else XB_SPIN(xb_ld(&bar[XB_TOPGEN]) == tg, bar);
            __builtin_amdgcn_fence(__ATOMIC_ACQUIRE, "agent");
            xb_add(&bar[XB_XGEN(b.x)], 1u);
            asm volatile("s_waitcnt vmcnt(0)" ::: "memory");
        } else {
            XB_SPIN(xb_ld(&bar[XB_XGEN(b.x)]) == gen, bar);
            __builtin_amdgcn_fence(__ATOMIC_ACQUIRE, "agent");
            asm volatile("s_waitcnt vmcnt(0)" ::: "memory");
        }
    }
    __syncthreads();
}

constexpr size_t kDynLds = 143360;
extern __shared__ __attribute__((aligned(16))) unsigned char dyn_lds[];

#if ONE_LAUNCH
__global__ void __launch_bounds__(512, 2) mega(Params p) {
  cg::grid_group grid = cg::this_grid();
  float* lds = (float*)dyn_lds; const int bid = blockIdx.x, nb = gridDim.x;
#ifndef DUP_PHASE
#define DUP_PHASE -1
#endif
#define RUNP(k) do { run_phase<k>(p, lds, bid, nb); } while (0)
  int nstamp = 0;
#define STAMP() do { if ((TPROBE_A >= 0 || TPROBE_B >= 0) && bid == 0 && threadIdx.x == 0) ((unsigned long long*)(p.ws + OFF_CTL + 65536))[nstamp] = __builtin_amdgcn_s_memrealtime(); ++nstamp; } while (0)
  STAMP();
  unsigned* barw = (unsigned*)(p.ws + OFF_BAR);
  volatile XB_LAS unsigned* bst = (volatile XB_LAS unsigned*)(dyn_lds + kDynLds - 16);
  if (threadIdx.x == 0) { bst[0] = 0u; bst[1] = 0u; }
  if (bid == 0) for (int i = threadIdx.x; i < XCD_BAR_WORDS; i += 512) __hip_atomic_store(barw + i, 0u, __ATOMIC_RELAXED, __HIP_MEMORY_SCOPE_AGENT);
  RUNP(0); grid.sync(); STAMP();
  const XcdBarrier xbar = xcd_barrier_post(barw, bst);
#define GSYNC() xcd_barrier(xbar)
#ifdef EXTRA_SYNCS
  for (int i = 0; i < EXTRA_SYNCS; ++i) GSYNC();
#endif
#if F8_GEMM
  RUNP(13); GSYNC(); STAMP();
#endif
  RUNP(1); GSYNC(); STAMP();
#if FAST_MIX == 2
  RUNP(14); GSYNC(); STAMP();
#endif
  RUNP(2); GSYNC(); STAMP();
#if FAST_MIX
  RUNP(3); GSYNC(); STAMP();
  RUNP(4); GSYNC(); STAMP();
#endif
  RUNP(5); GSYNC(); STAMP();
  RUNP(6); GSYNC(); STAMP();
  RUNP(7); GSYNC(); STAMP();
  RUNP(8); GSYNC(); STAMP();
  RUNP(10); GSYNC(); STAMP();
  RUNP(11); GSYNC(); STAMP();
  RUNP(12);
#undef RUNP
#undef STAMP
#undef GSYNC
}
#else
template <int PH> __global__ void __launch_bounds__(512, 2) k_phase(Params p) { run_phase<PH>(p, (float*)dyn_lds, blockIdx.x, gridDim.x); }
#endif


extern "C" void kernel_launch(void* const* d_in, const int* in_sizes, int n_in, void* d_out, int out_size, void* d_ws, size_t ws_size, hipStream_t stream) {
  if (n_in != 22 || out_size != T * D || ws_size < WS_NEED) { fprintf(stderr, "kernel_launch: unexpected shapes (n_in %d out %d ws %zu)\n", n_in, out_size, ws_size); return; }
  Params p{};
  const float** f = (const float**)&p;
  for (int i = 0; i < 22; ++i) f[i] = (const float*)d_in[i];
  p.out = (float*)d_out; p.ws = (unsigned char*)d_ws;
#if ONE_LAUNCH
  static int grid_blocks = 0;
  if (!grid_blocks) {
    int dev = 0, cus = 0, per_cu = 0;
    (void)hipGetDevice(&dev); (void)hipDeviceGetAttribute(&cus, hipDeviceAttributeMultiprocessorCount, dev);
    (void)hipFuncSetAttribute((const void*)mega, hipFuncAttributeMaxDynamicSharedMemorySize, (int)kDynLds);
    (void)hipOccupancyMaxActiveBlocksPerMultiprocessor(&per_cu, mega, 512, kDynLds);
    if (per_cu < 1) { fprintf(stderr, "occupancy query says 0 blocks/CU\n"); per_cu = 1; }
    grid_blocks = cus;
  }
  void* args[] = {&p};
  hipError_t e = hipLaunchCooperativeKernel((void*)mega, dim3(grid_blocks), dim3(512), args, kDynLds, stream);
  if (e != hipSuccess) fprintf(stderr, "cooperative launch failed: %s (grid %d)\n", hipGetErrorString(e), grid_blocks);
#else
  static bool attr = false;
  const int G = 256;
#define LAUNCH(PH) do { if (!attr) (void)hipFuncSetAttribute((const void*)k_phase<PH>, hipFuncAttributeMaxDynamicSharedMemorySize, (int)kDynLds); \
    hipLaunchKernelGGL(k_phase<PH>, dim3(G), dim3(512), kDynLds, stream, p); } while (0)
  LAUNCH(0); LAUNCH(13); LAUNCH(1); LAUNCH(14); LAUNCH(2); LAUNCH(3); LAUNCH(4); LAUNCH(5); LAUNCH(6); LAUNCH(7); LAUNCH(8); LAUNCH(10); LAUNCH(11); LAUNCH(12);
  attr = true;
#undef LAUNCH
#endif
}
```

```cpp
#include <hip/hip_runtime.h>
#include <hip/hip_cooperative_groups.h>
#include <cstdio>
#include <cstdint>
namespace cg = cooperative_groups;

#ifndef ONE_LAUNCH
#define ONE_LAUNCH 1
#endif

typedef unsigned short bf16_t;
constexpr int T = 32768, SEQ = 16384, D = 2048;
constexpr int NPROJ = 4352;
constexpr int C_GQ = 0, C_GK = 512, C_GG = 1024, C_MQ = 2048, C_MK = 2560, C_MO = 3072, C_SM = 4096;
constexpr float EPS = 1e-6f;
constexpr size_t MiB = 1ull << 20;
constexpr size_t OFF_XB = 0, OFF_Y = 0, OFF_PL = 0;
constexpr size_t OFF_PROJ = 128 * MiB, OFF_H1B = 128 * MiB, OFF_H2B = 256 * MiB;
constexpr size_t OFF_VT = 400 * MiB, OFF_SC = 400 * MiB;
constexpr size_t OFF_UB = 528 * MiB, OFF_VB = 592 * MiB;
constexpr size_t OFF_WIN = 656 * MiB, OFF_WOUT = 681 * MiB, OFF_WQ = 689 * MiB, OFF_WG = 697 * MiB, OFF_WPLE = 705 * MiB;
constexpr size_t OFF_PB = 706 * MiB, OFF_EIDX = 722 * MiB, OFF_EG = 738 * MiB, OFF_MISC = 754 * MiB;
constexpr size_t OFF_GDEC = 755 * MiB, OFF_MN = 756 * MiB, OFF_MDEC = 757 * MiB, OFF_ESC = 758 * MiB;
constexpr size_t OFF_CTL = 759 * MiB, OFF_H2Q = 400 * MiB, OFF_QS = 760 * MiB, OFF_KS = 824 * MiB, OFF_KDT = 888 * MiB;
constexpr size_t OFF_ESU = 952 * MiB, OFF_BAR = 968 * MiB;
constexpr size_t WS_NEED = 969 * MiB;
#ifndef F8_IN
#define F8_IN 0
#endif
#ifndef F8_OUT
#define F8_OUT 1
#endif
#ifndef F8_GATE
#define F8_GATE 1
#endif
#ifndef F8_GEMM
#define F8_GEMM (F8_IN || F8_OUT || F8_GATE)
#endif

struct Params {
  const float *x, *p, *norm_mix, *w_in, *gate_up, *gate_bias, *gla_norm, *conv_w, *conv_b, *ig_bias, *fg_bias, *mlstm_norm,
      *w_out, *norm_ffn, *peer_query, *sub_keys, *peer_u, *peer_v, *norm_ple, *w_ple, *w_ple_gate, *norm_final;
  float* out;
  unsigned char* ws;
};

__device__ __forceinline__ float bf2f(bf16_t b) { return __uint_as_float(((unsigned)b) << 16); }
typedef __bf16 bf16v2_t __attribute__((ext_vector_type(2)));
__device__ __forceinline__ bf16_t f2bf(float f) { const __bf16 b = (__bf16)f; return __builtin_bit_cast(bf16_t, b); }
__device__ __forceinline__ unsigned pack2(float lo, float hi) { const bf16v2_t v = {(__bf16)lo, (__bf16)hi}; return __builtin_bit_cast(unsigned, v); }
__device__ __forceinline__ unsigned pack4_fp8(float a, float b, float c, float d) { int v = __builtin_amdgcn_cvt_pk_fp8_f32(a, b, 0, false); v = __builtin_amdgcn_cvt_pk_fp8_f32(c, d, v, true); return (unsigned)v; }
__device__ __forceinline__ float lo_f(unsigned u) { return __uint_as_float(u << 16); }
__device__ __forceinline__ float hi_f(unsigned u) { return __uint_as_float(u & 0xffff0000u); }
__device__ __forceinline__ int tidx() { int t = threadIdx.x; asm volatile("" : "+v"(t)); return t; }
template <int O> __device__ __forceinline__ int sxor_i(int v) {
  if constexpr (O < 32) return __builtin_amdgcn_ds_swizzle(v, (O << 10) | 0x1f);
  else return __builtin_amdgcn_ds_bpermute(((tidx() & 63) ^ 32) << 2, v);
}
template <int O> __device__ __forceinline__ float sxor(float v) { return __int_as_float(sxor_i<O>(__float_as_int(v))); }
template <int O> __device__ __forceinline__ int sxor(int v) { return sxor_i<O>(v); }
__device__ __forceinline__ int bperm(int v, int src_lane) { return __builtin_amdgcn_ds_bpermute(src_lane << 2, v); }
__device__ __forceinline__ float bperm(float v, int src_lane) { return __int_as_float(__builtin_amdgcn_ds_bpermute(src_lane << 2, __float_as_int(v))); }
template <int N> __device__ __forceinline__ float gsum(float v) {
  if constexpr (N >= 2) v += sxor<1>(v); if constexpr (N >= 4) v += sxor<2>(v); if constexpr (N >= 8) v += sxor<4>(v);
  if constexpr (N >= 16) v += sxor<8>(v); if constexpr (N >= 32) v += sxor<16>(v); if constexpr (N >= 64) v += sxor<32>(v); return v; }
template <int N> __device__ __forceinline__ int gsum(int v) {
  if constexpr (N >= 2) v += sxor<1>(v); if constexpr (N >= 4) v += sxor<2>(v); if constexpr (N >= 8) v += sxor<4>(v);
  if constexpr (N >= 16) v += sxor<8>(v); if constexpr (N >= 32) v += sxor<16>(v); if constexpr (N >= 64) v += sxor<32>(v); return v; }
template <int N> __device__ __forceinline__ float gmax(float v) {
  if constexpr (N >= 2) v = fmaxf(v, sxor<1>(v)); if constexpr (N >= 4) v = fmaxf(v, sxor<2>(v)); if constexpr (N >= 8) v = fmaxf(v, sxor<4>(v));
  if constexpr (N >= 16) v = fmaxf(v, sxor<8>(v)); if constexpr (N >= 32) v = fmaxf(v, sxor<16>(v)); if constexpr (N >= 64) v = fmaxf(v, sxor<32>(v)); return v; }
__device__ __forceinline__ float wave_sum(float v) { return gsum<64>(v); }
__device__ __forceinline__ float sigmoidf_(float x) { return __builtin_amdgcn_rcpf(1.f + __expf(-x)); }
__device__ __forceinline__ float siluf_(float x) { return x * __builtin_amdgcn_rcpf(1.f + __expf(-x)); }
__device__ __forceinline__ float logsigmoidf_(float x) { return fminf(x, 0.f) - __logf(1.f + __expf(-fabsf(x))); }
__device__ __forceinline__ float gelu_tanh(float x) { const float u = 0.7978845608028654f * (x + 0.044715f * x * x * x); return x * __builtin_amdgcn_rcpf(1.f + __expf(-2.f * u)); }
__device__ __forceinline__ void unpack8(const uint4 q, float* f) {
  f[0] = lo_f(q.x); f[1] = hi_f(q.x); f[2] = lo_f(q.y); f[3] = hi_f(q.y); f[4] = lo_f(q.z); f[5] = hi_f(q.z); f[6] = lo_f(q.w); f[7] = hi_f(q.w);
}
__device__ __forceinline__ uint4 pack8(const float* f) { return make_uint4(pack2(f[0], f[1]), pack2(f[2], f[3]), pack2(f[4], f[5]), pack2(f[6], f[7])); }

struct WS {
  bf16_t *xb, *y, *pl, *proj, *h1b, *h2b, *vT, *sc, *ub, *vb, *win, *wout, *wq, *wg, *wple, *pb;
  int* eidx; float* eg; float* esu; float *rstd1, *ssq2, *ssq3, *ssq4, *wsum, *gdec, *mn, *mdec, *usc, *vsc, *pd;
  unsigned char *u8, *v8, *xq, *yq, *h2q, *winq, *woutq, *wgq;
  bf16_t *qs, *ks, *kdT;
  float* ctlf;
};
__device__ __forceinline__ WS make_ws(unsigned char* ws, float* out) {
  WS w;
  w.xb = (bf16_t*)(ws + OFF_XB); w.y = (bf16_t*)(ws + OFF_Y); w.pl = (bf16_t*)(ws + OFF_PL); w.proj = (bf16_t*)(ws + OFF_PROJ);
  w.h1b = (bf16_t*)(ws + OFF_H1B); w.h2b = (bf16_t*)(ws + OFF_H2B); w.vT = (bf16_t*)(ws + OFF_VT); w.sc = (bf16_t*)(ws + OFF_SC);
  w.ub = (bf16_t*)(ws + OFF_UB); w.vb = (bf16_t*)(ws + OFF_VB); w.win = (bf16_t*)(ws + OFF_WIN); w.wout = (bf16_t*)(ws + OFF_WOUT);
  w.wq = (bf16_t*)(ws + OFF_WQ); w.wg = (bf16_t*)(ws + OFF_WG); w.wple = (bf16_t*)(ws + OFF_WPLE); w.pb = (bf16_t*)(ws + OFF_PB);
  w.eidx = (int*)(ws + OFF_EIDX); w.eg = (float*)(ws + OFF_EG); w.esu = (float*)(ws + OFF_ESU);
  float* m = (float*)(ws + OFF_MISC); w.rstd1 = m; w.ssq2 = m + T; w.ssq3 = m + 2 * T; w.ssq4 = m + 3 * T; w.wsum = m + 4 * T;
  w.gdec = (float*)(ws + OFF_GDEC); w.mn = (float*)(ws + OFF_MN); w.mdec = (float*)(ws + OFF_MDEC);
  w.usc = (float*)(ws + OFF_ESC); w.vsc = w.usc + 16384; w.u8 = ws + OFF_UB; w.v8 = ws + OFF_VB; w.pd = out;
  w.xq = ws + OFF_XB; w.yq = ws + OFF_Y; w.h2q = ws + OFF_H2Q; w.winq = ws + OFF_WIN; w.woutq = ws + OFF_WOUT; w.wgq = ws + OFF_WG; w.ctlf = (float*)(ws + OFF_CTL);
  w.qs = (bf16_t*)(ws + OFF_QS); w.ks = (bf16_t*)(ws + OFF_KS); w.kdT = (bf16_t*)(ws + OFF_KDT);
  return w;
}

__device__ void prep_x(const Params& p, const WS& w, int bid, int nb) {
  const int wave = tidx() >> 6, lane = tidx() & 63;
  for (int row0 = (bid * 8 + wave) * 2; row0 < T; row0 += nb * 16) {
    float4 v[2][8]; float ss[2] = {0.f, 0.f};
#pragma unroll
    for (int rr = 0; rr < 2; ++rr) { const float4* src = (const float4*)(p.x + (size_t)(row0 + rr) * D);
#pragma unroll
      for (int i = 0; i < 8; ++i) v[rr][i] = src[i * 64 + lane]; }
#pragma unroll
    for (int rr = 0; rr < 2; ++rr) {
#pragma unroll
      for (int i = 0; i < 8; ++i) ss[rr] += v[rr][i].x * v[rr][i].x + v[rr][i].y * v[rr][i].y + v[rr][i].z * v[rr][i].z + v[rr][i].w * v[rr][i].w;
      ss[rr] = wave_sum(ss[rr]);
      const float rs = rsqrtf(ss[rr] * (1.f / D) + EPS);
#if F8_IN
      unsigned* dst = (unsigned*)(w.xq + (size_t)(row0 + rr) * D);
#pragma unroll
      for (int i = 0; i < 8; ++i) dst[i * 64 + lane] = pack4_fp8(v[rr][i].x * rs, v[rr][i].y * rs, v[rr][i].z * rs, v[rr][i].w * rs);
#else
      uint2* dst = (uint2*)(w.xb + (size_t)(row0 + rr) * D);
#pragma unroll
      for (int i = 0; i < 8; ++i) dst[i * 64 + lane] = make_uint2(pack2(v[rr][i].x, v[rr][i].y), pack2(v[rr][i].z, v[rr][i].w));
#endif
      if (lane == 0) w.rstd1[row0 + rr] = rs; }
  }
}
__device__ void absmax_w(const float* src, size_t n, const float* gain, int ncols, float* part, float* lds, int bid, int nb) {
  float m = 0.f;
  for (size_t i = (size_t)bid * 512 + tidx(); i < n / 4; i += (size_t)nb * 512) { const float4 v = ((const float4*)src)[i]; const float g = gain ? gain[(i * 4) / (size_t)ncols] : 1.f;
    m = fmaxf(m, fabsf(g) * fmaxf(fmaxf(fabsf(v.x), fabsf(v.y)), fmaxf(fabsf(v.z), fabsf(v.w)))); }
  m = gmax<64>(m);
  __syncthreads();
  if ((tidx() & 63) == 0) lds[tidx() >> 6] = m;
  __syncthreads();
  if (tidx() == 0) { float t = lds[0];
#pragma unroll
    for (int i = 1; i < 8; ++i) t = fmaxf(t, lds[i]);
    part[bid] = t; }
  __syncthreads();
}
__device__ float amax_reduce(const float* part, float* lds, int nb) {
  float m = 0.f;
  for (int i = tidx(); i < nb; i += 512) m = fmaxf(m, part[i]);
  m = gmax<64>(m);
  __syncthreads();
  if ((tidx() & 63) == 0) lds[tidx() >> 6] = m;
  __syncthreads();
  float t = lds[0];
#pragma unroll
  for (int i = 1; i < 8; ++i) t = fmaxf(t, lds[i]);
  return t;
}
__device__ void cvt_rows(const float* src, bf16_t* dst, size_t n, const float* gain, int ncols, int bid, int nb) {
  const size_t n4 = n / 4, step = (size_t)nb * 512;
  for (size_t i0 = (size_t)bid * 512 + tidx(); i0 < n4; i0 += 4 * step) {
    float4 v[4];
#pragma unroll
    for (int u = 0; u < 4; ++u) { const size_t i = i0 + u * step; if (i < n4) v[u] = ((const float4*)src)[i]; }
#pragma unroll
    for (int u = 0; u < 4; ++u) { const size_t i = i0 + u * step; if (i < n4) {
      if (gain) { const float4 g = *(const float4*)(gain + (int)((i * 4) % (size_t)ncols)); v[u].x *= g.x; v[u].y *= g.y; v[u].z *= g.z; v[u].w *= g.w; }
      ((uint2*)dst)[i] = make_uint2(pack2(v[u].x, v[u].y), pack2(v[u].z, v[u].w)); } }
  }
}
template <bool F8OUT, class CM>
__device__ void transpose_w(const float* src, int K, int ldsrc, void* dstv, int Ndst, const float* gain, CM cm, float amax, float* lds, int bid, int nb) {
  const int tid = tidx(), tk = K / 64, ntile = (Ndst / 64) * tk, nc = tid & 63;
  const float qs = F8OUT ? 256.f / fmaxf(amax, 1e-30f) : 1.f;
  float rv[8];
#define TW_LOAD(tile) do { const int n0_ = ((tile) / tk) * 64, k0_ = ((tile) % tk) * 64, sc_ = cm(n0_ + nc); \
    _Pragma("unroll") for (int i = 0; i < 8; ++i) { const int kr = (tid >> 6) + 8 * i; float v = 0.f; if (sc_ >= 0) { v = src[(size_t)(k0_ + kr) * ldsrc + sc_]; if (gain) v *= gain[k0_ + kr]; } rv[i] = v * qs; } } while (0)
  if (bid < ntile) TW_LOAD(bid);
  for (int tile = bid; tile < ntile; tile += nb) {
    const int n0 = (tile / tk) * 64, k0 = (tile % tk) * 64;
#pragma unroll
    for (int i = 0; i < 8; ++i) lds[((tid >> 6) + 8 * i) * 65 + nc] = rv[i];
    __syncthreads();
    if (tile + nb < ntile) TW_LOAD(tile + nb);
    { const int nr = tid >> 3, ks = (tid & 7) * 8; float f[8];
#pragma unroll
      for (int j = 0; j < 8; ++j) f[j] = lds[(ks + j) * 65 + nr];
      if (F8OUT) *(uint2*)((unsigned char*)dstv + (size_t)(n0 + nr) * K + k0 + ks) = make_uint2(pack4_fp8(f[0], f[1], f[2], f[3]), pack4_fp8(f[4], f[5], f[6], f[7]));
      else *(uint4*)((bf16_t*)dstv + (size_t)(n0 + nr) * K + k0 + ks) = pack8(f); }
    __syncthreads();
  }
#undef TW_LOAD
}
struct CmIdent { __device__ int operator()(int n) const { return n; } };
struct CmWin {
  __device__ int operator()(int n) const {
    if (n < 1024) return n;
    if (n < 2048) return 2048 + (n - 1024);
    if (n < 2560) return 3088 + (n - 2048);
    if (n < 3072) return 3600 + (n - 2560);
    if (n < 4096) return 5136 + (n - 3072);
    if (n < 4352) { const int i = n - 4096; if (i < 16) return 3072 + i; if (i < 20) return 6160 + (i - 16); if (i < 24) return 6164 + (i - 20); return -1; }
    const int j = n - 4352; if (j < 1024) return 1024 + j;
    return 4112 + (j - 1024);
  }
};
__device__ void prep_wq(const Params& p, const WS& w, float* lds, int bid, int nb) {
  const int tid = tidx();
  float* SKs = lds;
  float* WQs = lds + 128 * 132;
  for (int item = bid; item < 16 * 32; item += nb) {
    const int hp = item >> 5, k0 = (item & 31) * 64;
#pragma unroll
    for (int i = 0; i < 8; ++i) { const int e4 = tid + 512 * i, key = e4 >> 5, d4 = (e4 & 31) * 4; *(float4*)(SKs + key * 132 + d4) = *(const float4*)(p.sub_keys + (size_t)hp * 16384 + key * 128 + d4); }
#pragma unroll
    for (int i = 0; i < 4; ++i) { const int e4 = tid + 512 * i, kr = e4 >> 5, d4 = (e4 & 31) * 4; float4 v = *(const float4*)(p.peer_query + (size_t)(k0 + kr) * 2048 + hp * 128 + d4); const float g = p.norm_ffn[k0 + kr]; v.x *= g; v.y *= g; v.z *= g; v.w *= g; *(float4*)(WQs + kr * 132 + d4) = v; }
    __syncthreads();
    const int k = tid & 63, kg = tid >> 6;
    float acc[16];
#pragma unroll
    for (int j = 0; j < 16; ++j) acc[j] = 0.f;
    for (int d4 = 0; d4 < 32; ++d4) {
      const float4 a = *(const float4*)(WQs + k * 132 + d4 * 4);
#pragma unroll
      for (int j = 0; j < 16; ++j) { const float4 s = *(const float4*)(SKs + (kg * 16 + j) * 132 + d4 * 4); acc[j] += a.x * s.x + a.y * s.y + a.z * s.z + a.w * s.w; }
    }
#pragma unroll
    for (int j = 0; j < 16; ++j) w.wq[(size_t)(hp * 128 + kg * 16 + j) * 2048 + k0 + k] = f2bf(acc[j]);
    __syncthreads();
  }
}

#ifndef PEER_SLW
#define PEER_SLW 256
#endif
constexpr int SLW = PEER_SLW, LPR = SLW / 16, EPI = 64 / LPR, NSL = 2048 / SLW, SPL = NSL / 8, NIT = 128 / EPI;
template <bool SIGNED>
__device__ void quant_rows(const float* src, const float* gain, unsigned char* dst, float* scale, int bid, int nb) {
  const int tid = tidx(), wave = tid >> 6, lane = tid & 63;
  for (int row0 = (bid * 8 + wave) * 2; row0 < 16384; row0 += nb * 16) {
    float4 f4[2][8];
#pragma unroll
    for (int rr = 0; rr < 2; ++rr)
#pragma unroll
      for (int i = 0; i < 2; ++i)
#pragma unroll
        for (int q = 0; q < 4; ++q) f4[rr][i * 4 + q] = *(const float4*)(src + (size_t)(row0 + rr) * 2048 + i * 1024 + lane * 16 + q * 4);
#pragma unroll
    for (int rr = 0; rr < 2; ++rr) { const int row = row0 + rr; float f[32]; float mx = 0.f;
#pragma unroll
      for (int i = 0; i < 2; ++i)
#pragma unroll
        for (int q = 0; q < 4; ++q) { float4 v = f4[rr][i * 4 + q];
          if (gain) { const float4 g = *(const float4*)(gain + i * 1024 + lane * 16 + q * 4); v.x *= g.x; v.y *= g.y; v.z *= g.z; v.w *= g.w; }
          f[i * 16 + q * 4] = v.x; f[i * 16 + q * 4 + 1] = v.y; f[i * 16 + q * 4 + 2] = v.z; f[i * 16 + q * 4 + 3] = v.w;
          mx = fmaxf(mx, fmaxf(fmaxf(fabsf(v.x), fabsf(v.y)), fmaxf(fabsf(v.z), fabsf(v.w)))); }
      mx = gmax<64>(mx);
      const float sc = fmaxf(mx, 1e-30f) * (1.f / 127.f), inv = 1.f / sc;
#pragma unroll
      for (int i = 0; i < 2; ++i) { unsigned wd[4];
#pragma unroll
        for (int q = 0; q < 4; ++q) { unsigned x = 0;
#pragma unroll
          for (int j = 0; j < 4; ++j) { const int v = (int)rintf(f[i * 16 + q * 4 + j] * inv) + (SIGNED ? 0 : 128); x |= ((unsigned)v & 0xffu) << (8 * j); }
          wd[q] = x; }
        const int el = i * 1024 + lane * 16;
        *(uint4*)(dst + ((size_t)(el / SLW) * 16384 + row) * SLW + (el % SLW)) = make_uint4(wd[0], wd[1], wd[2], wd[3]); }
      if (lane == 0) scale[row] = sc; }
  }
}
__device__ void phase_prep(const Params& p, const WS& w, float* lds, int bid, int nb) {
  prep_x(p, w, bid, nb);
#if F8_IN
  absmax_w(p.w_in, (size_t)2048 * 6168, p.norm_mix, 6168, w.ctlf + 1024, lds, bid, nb);
#else
  transpose_w<false>(p.w_in, 2048, 6168, w.win, 6400, p.norm_mix, CmWin(), 0.f, lds, bid, nb);
#endif
#if F8_OUT
  absmax_w(p.w_out, (size_t)2048 * 2048, nullptr, 2048, w.ctlf + 2048, lds, bid, nb);
#else
  transpose_w<false>(p.w_out, 2048, 2048, w.wout, 2048, nullptr, CmIdent(), 0.f, lds, bid, nb);
#endif
#if F8_GATE
  absmax_w(p.w_ple_gate, (size_t)2048 * 2048, p.norm_ple, 2048, w.ctlf + 3072, lds, bid, nb);
#else
  transpose_w<false>(p.w_ple_gate, 2048, 2048, w.wg, 2048, p.norm_ple, CmIdent(), 0.f, lds, bid, nb);
#endif
  cvt_rows(p.p, w.pb, (size_t)T * 256, nullptr, 256, bid, nb);
  quant_rows<true>(p.peer_u, p.norm_ffn, w.u8, w.usc, bid, nb);
  quant_rows<true>(p.peer_v, nullptr, w.v8, w.vsc, bid, nb);
  transpose_w<false>(p.w_ple, 256, 2048, w.wple, 2048, nullptr, CmIdent(), 0.f, lds, bid, nb);
  prep_wq(p, w, lds, bid, nb);
  for (int i = bid * 512 + tidx(); i < T; i += nb * 512) { w.ssq2[i] = 0.f; w.ssq3[i] = 0.f; w.ssq4[i] = 0.f; }
}
static_assert(!F8_IN, "phase_prep2 now runs after the in-projection: an fp8 in-projection needs its weight copy (and a seam) before phase 1 again");
__device__ void phase_prep2(const Params& p, const WS& w, float* lds, int bid, int nb) {
#if F8_IN
  { const float a0 = amax_reduce(w.ctlf + 1024, lds, nb); if (bid == 0 && tidx() == 0) w.ctlf[0] = a0; __syncthreads();
    transpose_w<true>(p.w_in, 2048, 6168, w.winq, 6400, p.norm_mix, CmWin(), a0, lds, bid, nb); }
#endif
#if F8_OUT
  { const float a1 = amax_reduce(w.ctlf + 2048, lds, nb); if (bid == 0 && tidx() == 0) w.ctlf[1] = a1; __syncthreads();
    transpose_w<true>(p.w_out, 2048, 2048, w.woutq, 2048, nullptr, CmIdent(), a1, lds, bid, nb); }
#endif
#if F8_GATE
  { const float a2 = amax_reduce(w.ctlf + 3072, lds, nb); if (bid == 0 && tidx() == 0) w.ctlf[2] = a2; __syncthreads();
    transpose_w<true>(p.w_ple_gate, 2048, 2048, w.wgq, 2048, p.norm_ple, CmIdent(), a2, lds, bid, nb); }
#endif
}

struct EpiProjN { bf16_t* out; const float* rstd; float ws; static constexpr bool ROWSUM = false;
  __device__ __forceinline__ float store8(int r, int c, const float* v) const { const float s = F8_IN ? ws : rstd[r]; float f[8];
#pragma unroll
    for (int j = 0; j < 8; ++j) f[j] = v[j] * s;
    *(uint4*)(out + (size_t)r * NPROJ + c) = pack8(f); return 0.f; }
  __device__ __forceinline__ void rowsum(int, float) const {} };
struct EpiProjT { bf16_t* out; const float* rstd; float ws; static constexpr bool ROWSUM = false;
  __device__ __forceinline__ float store8(int r, int c, const float* v) const { const float4 s0 = F8_IN ? make_float4(ws, ws, ws, ws) : *(const float4*)(rstd + c), s1 = F8_IN ? s0 : *(const float4*)(rstd + c + 4); float f[8];
    f[0] = v[0] * s0.x; f[1] = v[1] * s0.y; f[2] = v[2] * s0.z; f[3] = v[3] * s0.w; f[4] = v[4] * s1.x; f[5] = v[5] * s1.y; f[6] = v[6] * s1.z; f[7] = v[7] * s1.w;
    *(uint4*)(out + (size_t)r * T + c) = pack8(f); return 0.f; }
  __device__ __forceinline__ void rowsum(int, float) const {} };
struct EpiOut { const float* x; bf16_t* h1b; float* ssq; float ws; static constexpr bool ROWSUM = true;
  __device__ __forceinline__ float store8(int r, int c, const float* v) const { const float4 x0 = *(const float4*)(x + (size_t)r * D + c), x1 = *(const float4*)(x + (size_t)r * D + c + 4); float f[8];
    f[0] = v[0] * ws + x0.x; f[1] = v[1] * ws + x0.y; f[2] = v[2] * ws + x0.z; f[3] = v[3] * ws + x0.w; f[4] = v[4] * ws + x1.x; f[5] = v[5] * ws + x1.y; f[6] = v[6] * ws + x1.z; f[7] = v[7] * ws + x1.w;
    float s = 0.f;
#pragma unroll
    for (int j = 0; j < 8; ++j) s += f[j] * f[j];
    *(uint4*)(h1b + (size_t)r * D + c) = pack8(f); return s; }
  __device__ __forceinline__ void rowsum(int r, float s) const { atomicAdd(ssq + r, s); } };
struct EpiScore { bf16_t* sc; const float* ssq; static constexpr bool ROWSUM = false;
  __device__ __forceinline__ float store8(int r, int c, const float* v) const { const float s = rsqrtf(ssq[r] * (1.f / D) + EPS); float f[8];
#pragma unroll
    for (int j = 0; j < 8; ++j) f[j] = v[j] * s;
    *(uint4*)(sc + (size_t)r * D + c) = pack8(f); return 0.f; }
  __device__ __forceinline__ void rowsum(int, float) const {} };
struct EpiPl { bf16_t* pl; static constexpr bool ROWSUM = false;
  __device__ __forceinline__ float store8(int r, int c, const float* v) const { *(uint4*)(pl + (size_t)r * D + c) = pack8(v); return 0.f; }
  __device__ __forceinline__ void rowsum(int, float) const {} };
struct EpiGate { const bf16_t* h2b; const bf16_t* pl; const float* ssq3; bf16_t* out; float* ssq; const float* ssq2; float ws; static constexpr bool ROWSUM = true;
  __device__ __forceinline__ float store8(int r, int c, const float* v) const { const float rs = rsqrtf(ssq3[r] * (1.f / D) + EPS) * (F8_GATE ? ws * sqrtf(ssq2[r] * (1.f / D) + EPS) : 1.f); float h[8], q[8], f[8];
    unpack8(*(const uint4*)(h2b + (size_t)r * D + c), h); unpack8(*(const uint4*)(pl + (size_t)r * D + c), q);
    float s = 0.f;
#pragma unroll
    for (int j = 0; j < 8; ++j) { f[j] = h[j] + sigmoidf_(v[j] * rs) * q[j]; s += f[j] * f[j]; }
    *(uint4*)(out + (size_t)r * D + c) = pack8(f); return s; }
  __device__ __forceinline__ void rowsum(int r, float s) const { atomicAdd(ssq + r, s); } };

template <class Epi>
__device__ void gemm_naive(const bf16_t* A, const bf16_t* Bt, int M, int N, int K, const Epi& E, float* lds, int bid, int nb) {
  const int tid = tidx(), ty = tid >> 4, tx = tid & 15;
  float* As = lds;
  float* Bs = lds + 32 * 132;
  const int nM = M / 128, nN = N / 128;
  for (int tile = bid; tile < nM * nN; tile += nb) {
    const int m0 = (tile % nM) * 128, n0 = (tile / nM) * 128;
    float acc[4][8];
#pragma unroll
    for (int i = 0; i < 4; ++i)
#pragma unroll
      for (int j = 0; j < 8; ++j) acc[i][j] = 0.f;
    const int lr = tid >> 2, lk = (tid & 3) * 8;
    for (int k0 = 0; k0 < K; k0 += 32) {
      const uint4 av = *(const uint4*)(A + (size_t)(m0 + lr) * K + k0 + lk);
      const uint4 bv = *(const uint4*)(Bt + (size_t)(n0 + lr) * K + k0 + lk);
      float af[8], bf[8]; unpack8(av, af); unpack8(bv, bf);
      __syncthreads();
#pragma unroll
      for (int j = 0; j < 8; ++j) { As[(lk + j) * 132 + lr] = af[j]; Bs[(lk + j) * 132 + lr] = bf[j]; }
      __syncthreads();
#pragma unroll 8
      for (int kk = 0; kk < 32; ++kk) {
        const float4 a = *(const float4*)(As + kk * 132 + ty * 4);
        const float4 b0 = *(const float4*)(Bs + kk * 132 + tx * 8), b1 = *(const float4*)(Bs + kk * 132 + tx * 8 + 4);
        const float aa[4] = {a.x, a.y, a.z, a.w}; const float bb[8] = {b0.x, b0.y, b0.z, b0.w, b1.x, b1.y, b1.z, b1.w};
#pragma unroll
        for (int i = 0; i < 4; ++i)
#pragma unroll
          for (int j = 0; j < 8; ++j) acc[i][j] += aa[i] * bb[j];
      }
    }
#pragma unroll
    for (int i = 0; i < 4; ++i) {
      const int r = m0 + ty * 4 + i;
      float s = E.store8(r, n0 + tx * 8, acc[i]);
      if (Epi::ROWSUM) { s = gsum<16>(s); if (tx == 0) E.rowsum(r, s); }
    }
  }
}


namespace pg8 {
#define PG8_LAS __attribute__((address_space(3)))
typedef short bf16x8 __attribute__((ext_vector_type(8)));
typedef float f32x4 __attribute__((ext_vector_type(4)));
typedef int v4i_t __attribute__((ext_vector_type(4)));
typedef int v8i_t __attribute__((ext_vector_type(8)));
constexpr int BM = 256, BK = 64, HALF = 128, HTB = HALF * BK * 2, STAGE_BYTES = 8 * HTB, NXCD = 8, WGM = 8;
__host__ __device__ __forceinline__ int lds_byte(int r, int c) { const int st = (r >> 4) * 2 + (c >> 5), rr = r & 15, cc = c & 31, ob = rr * 64 + cc * 2; return st * 1024 + (ob ^ (((ob >> 9) & 1) << 5)); }
__host__ __device__ __forceinline__ void stage_rc(int b, int& R, int& C) { const int st = b / 1024, sb = b % 1024, swz = sb ^ (((sb >> 9) & 1) << 5); R = (st >> 1) * 16 + swz / 64; C = (st & 1) * 32 + (swz % 64) / 2; }
__host__ __device__ __forceinline__ int perm32(int rho) { const int n = rho >> 4, i = rho & 15; return 8 * (i >> 2) + 4 * n + (i & 3); }
struct Unit { int pm, pn; };
struct Gemm { const bf16_t* A; const bf16_t* Bt; int M, N, K; };
struct StaticOrder {
    int nM, nN, nwg, G, c;
    __host__ __device__ void init(int M, int N, int G_, int c_) { nM = M / BM; nN = N / BM; nwg = nM * nN; G = G_; c = c_; }
    __host__ __device__ bool next(int i, Unit& u) const {
        const long L = (long)i * G + c; if (L >= nwg) return false;
        int wgid = (int)L; { const int q = nwg / NXCD, r = nwg % NXCD, xcd = wgid % NXCD, off = wgid / NXCD; wgid = (xcd < r ? xcd * (q + 1) : r * (q + 1) + (xcd - r) * q) + off; }
        const int nig = WGM * nN, gid = wgid / nig, fm = gid * WGM, gsz = (nM - fm) < WGM ? (nM - fm) : WGM;
        u.pm = fm + ((wgid % nig) % gsz); u.pn = (wgid % nig) / gsz; return true;
    }
    __device__ __forceinline__ void a_ready(const Unit&) const {}
    __device__ __forceinline__ void done(const Unit&) const {}
};
template <class E8> struct EpiA {
    static constexpr bool PERM = true, AFTER_DRAIN = false;
    E8 e;
    __device__ __forceinline__ void operator()(const f32x4 (&acc)[2][2][4][2], const Unit& u, int wr, int wc, int fr, int fq) const {
        asm volatile("" : "+v"(fr), "+v"(fq));
        const int row0 = u.pm * BM + wr * 64 + fr, col0 = u.pn * BM + wc * 32 + 8 * fq;
#pragma unroll
        for (int ai = 0; ai < 2; ++ai)
#pragma unroll
            for (int m = 0; m < 4; ++m) { const int r = row0 + ai * HALF + m * 16; float s = 0.f;
#pragma unroll
                for (int bj = 0; bj < 2; ++bj) { const float v[8] = {acc[ai][bj][m][0][0], acc[ai][bj][m][0][1], acc[ai][bj][m][0][2], acc[ai][bj][m][0][3], acc[ai][bj][m][1][0], acc[ai][bj][m][1][1], acc[ai][bj][m][1][2], acc[ai][bj][m][1][3]};
                    s += e.store8(r, col0 + bj * HALF, v); }
                if (E8::ROWSUM) { s += sxor<16>(s); s += sxor<32>(s); if (fq == 0) e.rowsum(r, s); }
                asm volatile("" ::: "memory"); }
    }
    __device__ __forceinline__ void fused(f32x4 (&)[2][2][4][2], const Unit&, int, int, int, int, PG8_LAS unsigned char*, int, int) const {}
};
template <class Epi, class Sched, bool ALIGN_EPI = false, bool SP2 = false, bool F8 = false>
__device__ __forceinline__ void gemm_phase(PG8_LAS unsigned char* lds, const Gemm g, const Sched& S, const Epi& E) {
    int tid_ = threadIdx.x; asm volatile("" : "+v"(tid_));
    const int tid = tid_, wid = __builtin_amdgcn_readfirstlane(tid >> 6), lane = tid & 63, wr = wid >> 2, wc = wid & 3, fr = lane & 15, fq = lane >> 4;
    const int K = g.K, nt = K / BK;
    unsigned voffA[2], voffB[2];
#pragma unroll
    for (int i = 0; i < 2; ++i) { int R, C; stage_rc(tid * 16 + i * 8192, R, C); const int Rb = Epi::PERM ? ((R & ~31) + perm32(R & 31)) : R;
        voffA[i] = (unsigned)(R * K + C) * 2u; voffB[i] = (unsigned)(Rb * K + C) * 2u; }
    const size_t kstep = (size_t)(BK * 2);
    const size_t hstep = (size_t)HALF * K * 2;
    const size_t tstep = 2 * hstep;
    const unsigned ldsw = (unsigned)wid * 1024u;
    const int aoff = lds_byte(wr * 64 + fr, fq * 8), boff = lds_byte(wc * 32 + fr, fq * 8);
#define PG8_SA(b, h) (((b) * 2 + (h)) * HTB)
#define PG8_SB(b, h) ((4 + (b) * 2 + (h)) * HTB)
#define PG8_STAGE(bufoff, gbase, voff) do { _Pragma("unroll") for (int _i = 0; _i < 2; ++_i) \
        __builtin_amdgcn_global_load_lds((const unsigned*)((const char*)(gbase) + (voff)[_i]), (PG8_LAS unsigned*)(lds + (bufoff) + ldsw + _i * 8192), 16, 0, 0); } while (0)
#define PG8_LDA(dst, b, h) do { _Pragma("unroll") for (int m = 0; m < 4; ++m) { const v4i_t lo_ = *(const PG8_LAS v4i_t*)(lds + PG8_SA(b, h) + aoff + m * 2048), hi_ = *(const PG8_LAS v4i_t*)(lds + PG8_SA(b, h) + aoff + m * 2048 + 1024); dst[m] = __builtin_shufflevector(lo_, hi_, 0, 1, 2, 3, 4, 5, 6, 7); } } while (0)
#define PG8_LDB(dst, b, h) do { _Pragma("unroll") for (int n = 0; n < 2; ++n) { const v4i_t lo_ = *(const PG8_LAS v4i_t*)(lds + PG8_SB(b, h) + boff + n * 2048), hi_ = *(const PG8_LAS v4i_t*)(lds + PG8_SB(b, h) + boff + n * 2048 + 1024); dst[n] = __builtin_shufflevector(lo_, hi_, 0, 1, 2, 3, 4, 5, 6, 7); } } while (0)
#define PG8_MMA(ai, bj, At, Bt) do { __builtin_amdgcn_s_setprio(1); \
        if constexpr (F8) { asm volatile("s_nop 1\n\t" \
            "v_mfma_scale_f32_16x16x128_f8f6f4 %0, %12, %8, %0, %14, %14 op_sel_hi:[0,0,0]\n\t"  "v_mfma_scale_f32_16x16x128_f8f6f4 %1, %13, %8, %1, %14, %14 op_sel_hi:[0,0,0]\n\t" \
            "v_mfma_scale_f32_16x16x128_f8f6f4 %2, %12, %9, %2, %14, %14 op_sel_hi:[0,0,0]\n\t"  "v_mfma_scale_f32_16x16x128_f8f6f4 %3, %13, %9, %3, %14, %14 op_sel_hi:[0,0,0]\n\t" \
            "v_mfma_scale_f32_16x16x128_f8f6f4 %4, %12, %10, %4, %14, %14 op_sel_hi:[0,0,0]\n\t" "v_mfma_scale_f32_16x16x128_f8f6f4 %5, %13, %10, %5, %14, %14 op_sel_hi:[0,0,0]\n\t" \
            "v_mfma_scale_f32_16x16x128_f8f6f4 %6, %12, %11, %6, %14, %14 op_sel_hi:[0,0,0]\n\t" "v_mfma_scale_f32_16x16x128_f8f6f4 %7, %13, %11, %7, %14, %14 op_sel_hi:[0,0,0]" \
            : "+v"(acc[ai][bj][0][0]), "+v"(acc[ai][bj][0][1]), "+v"(acc[ai][bj][1][0]), "+v"(acc[ai][bj][1][1]), "+v"(acc[ai][bj][2][0]), "+v"(acc[ai][bj][2][1]), "+v"(acc[ai][bj][3][0]), "+v"(acc[ai][bj][3][1]) \
            : "v"(At[0]), "v"(At[1]), "v"(At[2]), "v"(At[3]), "v"(Bt[0]), "v"(Bt[1]), "v"(one_scale)); } \
        else { _Pragma("unroll") for (int m = 0; m < 4; ++m) _Pragma("unroll") for (int n = 0; n < 2; ++n) { \
            acc[ai][bj][m][n] = __builtin_amdgcn_mfma_f32_16x16x32_bf16(__builtin_bit_cast(bf16x8, __builtin_shufflevector(Bt[n], Bt[n], 0, 1, 2, 3)), __builtin_bit_cast(bf16x8, __builtin_shufflevector(At[m], At[m], 0, 1, 2, 3)), acc[ai][bj][m][n], 0, 0, 0); \
            acc[ai][bj][m][n] = __builtin_amdgcn_mfma_f32_16x16x32_bf16(__builtin_bit_cast(bf16x8, __builtin_shufflevector(Bt[n], Bt[n], 4, 5, 6, 7)), __builtin_bit_cast(bf16x8, __builtin_shufflevector(At[m], At[m], 4, 5, 6, 7)), acc[ai][bj][m][n], 0, 0, 0); } } \
        __builtin_amdgcn_s_setprio(0); } while (0)
#define PG8_MFMA_DRAIN() do { if constexpr (F8) asm volatile("s_nop 15\n\ts_nop 15\n\ts_nop 15" ::: "memory"); } while (0)
#define PG8_WAIT_V(n) asm volatile("s_waitcnt vmcnt(" #n ")" ::: "memory")
#define PG8_WAIT_L(n) asm volatile("s_waitcnt lgkmcnt(" #n ")" ::: "memory")
#define PG8_BAR __builtin_amdgcn_s_barrier()
#define PG8_SCHED __builtin_amdgcn_sched_barrier(0)
    Unit cur, nxt; int ui = 0;
    if (!S.next(0, cur)) return;
    f32x4 acc[2][2][4][2];
#pragma unroll
    for (int a = 0; a < 2; ++a)
#pragma unroll
        for (int b = 0; b < 2; ++b)
#pragma unroll
            for (int m = 0; m < 4; ++m)
#pragma unroll
                for (int n = 0; n < 2; ++n) acc[a][b][m][n] = (f32x4){0.f, 0.f, 0.f, 0.f};
    const int one_scale = 0x7f7f7f7f;
    v8i_t At[4], B0[2], B1[2];
    const char* cA = (const char*)g.A + (size_t)cur.pm * tstep; const char* cB = (const char*)g.Bt + (size_t)cur.pn * tstep;
    S.a_ready(cur);
    if constexpr (SP2) {
        PG8_STAGE(PG8_SB(0, 0), cB, voffB); PG8_STAGE(PG8_SB(0, 1), cB + hstep, voffB); PG8_STAGE(PG8_SA(0, 0), cA, voffA); PG8_STAGE(PG8_SA(0, 1), cA + hstep, voffA);
        if (wr == 1) PG8_BAR;
        PG8_WAIT_V(2); PG8_BAR;
        PG8_STAGE(PG8_SB(1, 0), cB + kstep, voffB); PG8_STAGE(PG8_SA(1, 0), cA + kstep, voffA); PG8_STAGE(PG8_SB(1, 1), cB + hstep + kstep, voffB);
        PG8_WAIT_V(6); PG8_BAR;
    } else {
        PG8_STAGE(PG8_SB(0, 0), cB, voffB); PG8_STAGE(PG8_SA(0, 0), cA, voffA); PG8_STAGE(PG8_SB(0, 1), cB + hstep, voffB); PG8_STAGE(PG8_SA(0, 1), cA + hstep, voffA);
        if (wr == 1) PG8_BAR;
        PG8_WAIT_V(4); PG8_BAR;
        PG8_STAGE(PG8_SB(1, 0), cB + kstep, voffB); PG8_STAGE(PG8_SA(1, 0), cA + kstep, voffA); PG8_STAGE(PG8_SB(1, 1), cB + hstep + kstep, voffB);
        PG8_WAIT_V(6); PG8_BAR;
    }
    for (;;) {
        const bool has_next = S.next(ui + 1, nxt);
        const char* nA = has_next ? (const char*)g.A + (size_t)nxt.pm * tstep : cA; const char* nB = has_next ? (const char*)g.Bt + (size_t)nxt.pn * tstep : cB;
        for (int t = 0; t < nt; t += 2) {
            const bool last = (t == nt - 2);
            const char* a1 = cA + (size_t)(t + 1) * kstep;
            const char* a2 = last ? nA : cA + (size_t)(t + 2) * kstep; const char* b2 = last ? nB : cB + (size_t)(t + 2) * kstep;
            const char* a3 = a2 + kstep; const char* b3 = b2 + kstep;
            if (last && has_next) S.a_ready(nxt);
            if constexpr (SP2) {
            PG8_LDB(B0, 0, 0); PG8_LDB(B1, 0, 1); PG8_SCHED; PG8_LDA(At, 0, 0); PG8_STAGE(PG8_SA(1, 1), a1 + hstep, voffA);
            PG8_WAIT_V(8); PG8_WAIT_L(0); PG8_BAR; PG8_MMA(0, 0, At, B0); PG8_MMA(0, 1, At, B1); PG8_BAR; PG8_SCHED;
            PG8_LDA(At, 0, 1); PG8_STAGE(PG8_SB(0, 0), b2, voffB); PG8_STAGE(PG8_SB(0, 1), b2 + hstep, voffB); PG8_STAGE(PG8_SA(0, 0), a2, voffA);
            PG8_WAIT_V(8); PG8_WAIT_L(0); PG8_BAR; PG8_MMA(1, 0, At, B0); PG8_MMA(1, 1, At, B1); PG8_BAR; PG8_SCHED;
            PG8_LDB(B0, 1, 0); PG8_LDB(B1, 1, 1); PG8_SCHED; PG8_LDA(At, 1, 0); PG8_STAGE(PG8_SA(0, 1), a2 + hstep, voffA);
            PG8_WAIT_V(8); PG8_WAIT_L(0); PG8_BAR; PG8_MMA(0, 0, At, B0); PG8_MMA(0, 1, At, B1); PG8_BAR; PG8_SCHED;
            PG8_LDA(At, 1, 1); PG8_STAGE(PG8_SB(1, 0), b3, voffB); PG8_STAGE(PG8_SB(1, 1), b3 + hstep, voffB); PG8_STAGE(PG8_SA(1, 0), a3, voffA);
            PG8_WAIT_V(8); PG8_WAIT_L(0); PG8_BAR; PG8_MMA(1, 0, At, B0); PG8_MMA(1, 1, At, B1); PG8_BAR; PG8_SCHED;
            } else {
            PG8_LDB(B0, 0, 0); PG8_SCHED; PG8_LDA(At, 0, 0); PG8_STAGE(PG8_SA(1, 1), a1 + hstep, voffA);
            PG8_WAIT_L(8); PG8_BAR; PG8_WAIT_L(0); PG8_MMA(0, 0, At, B0); PG8_BAR; PG8_SCHED;
            PG8_LDB(B1, 0, 1); PG8_STAGE(PG8_SB(0, 0), b2, voffB);
            PG8_BAR; PG8_WAIT_L(0); PG8_MMA(0, 1, At, B1); PG8_BAR;
            PG8_LDA(At, 0, 1); PG8_STAGE(PG8_SA(0, 0), a2, voffA);
            PG8_BAR; PG8_WAIT_L(0); PG8_MMA(1, 0, At, B0); PG8_BAR; PG8_SCHED;
            PG8_STAGE(PG8_SB(0, 1), b2 + hstep, voffB);
            PG8_WAIT_V(6); PG8_BAR; PG8_MMA(1, 1, At, B1); PG8_BAR;
            PG8_LDB(B0, 1, 0); PG8_SCHED; PG8_LDA(At, 1, 0); PG8_STAGE(PG8_SA(0, 1), a2 + hstep, voffA);
            PG8_WAIT_L(8); PG8_BAR; PG8_WAIT_L(0); PG8_MMA(0, 0, At, B0); PG8_BAR; PG8_SCHED;
            PG8_LDB(B1, 1, 1); PG8_STAGE(PG8_SB(1, 0), b3, voffB);
            PG8_BAR; PG8_WAIT_L(0); PG8_MMA(0, 1, At, B1); PG8_BAR;
            PG8_LDA(At, 1, 1); PG8_STAGE(PG8_SA(1, 0), a3, voffA);
            PG8_BAR; PG8_WAIT_L(0); PG8_MMA(1, 0, At, B0); PG8_BAR; PG8_SCHED;
            PG8_STAGE(PG8_SB(1, 1), b3 + hstep, voffB);
            PG8_WAIT_V(6); PG8_BAR; PG8_MMA(1, 1, At, B1); PG8_BAR;
            }
        }
        if constexpr (ALIGN_EPI) { if (wr == 0) PG8_BAR; }
        PG8_MFMA_DRAIN();
        if constexpr (!Epi::AFTER_DRAIN) { E(acc, cur, wr, wc, fr, fq); S.done(cur); }
        if (!has_next) break;
#pragma unroll
        for (int a = 0; a < 2; ++a)
#pragma unroll
            for (int b = 0; b < 2; ++b)
#pragma unroll
                for (int m = 0; m < 4; ++m)
#pragma unroll
                    for (int n = 0; n < 2; ++n) acc[a][b][m][n] = (f32x4){0.f, 0.f, 0.f, 0.f};
        cur = nxt; cA = nA; cB = nB; ++ui;
        if constexpr (ALIGN_EPI) { if (wr == 1) PG8_BAR; }
    }
    PG8_WAIT_V(0);
    if constexpr (!ALIGN_EPI) { if (wr == 0) PG8_BAR; }
    PG8_BAR;
    if constexpr (Epi::AFTER_DRAIN) { E.fused(acc, cur, wr, wc, fr, fq, lds, wid, lane); S.done(cur); }
#undef PG8_SA
#undef PG8_SB
#undef PG8_STAGE
#undef PG8_LDA
#undef PG8_LDB
#undef PG8_MMA
#undef PG8_MFMA_DRAIN
#undef PG8_WAIT_V
#undef PG8_WAIT_L
#undef PG8_BAR
#undef PG8_SCHED
}
}

#ifndef FAST_GEMM
#define FAST_GEMM 1
#endif
template <bool F8 = false, class E8>
__device__ __forceinline__ void gemm_any(const void* A, const void* Bt, int M, int N, int K, const E8& E, float* lds, int bid, int nb) {
#if FAST_GEMM
  pg8::Gemm g{(const bf16_t*)A, (const bf16_t*)Bt, M, N, F8 ? K / 2 : K}; pg8::StaticOrder S; S.init(M, N, nb, bid);
  pg8::EpiA<E8> EA{E};
  pg8::gemm_phase<pg8::EpiA<E8>, pg8::StaticOrder, true, true, F8>((PG8_LAS unsigned char*)lds, g, S, EA);
#else
  gemm_naive((const bf16_t*)A, (const bf16_t*)Bt, M, N, K, E, lds, bid, nb);
#endif
}

__device__ void gla_naive(const Params& p, const WS& w, int b, int h, float* lds) {
  constexpr int CH = 16;
  const int tid = tidx(), dv = tid & 255, half = tid >> 8, wave = tid >> 6, lane = tid & 63;
  float* qf = lds; float* kf = qf + CH * 128; float* af = kf + CH * 128; float* vf = af + CH * 128; float* op = vf + CH * 256;
  float S[64];
#pragma unroll
  for (int i = 0; i < 64; ++i) S[i] = 0.f;
  const int gd = tid & 127;
  float gu[16];
#pragma unroll
  for (int r = 0; r < 16; ++r) gu[r] = p.gate_up[r * 512 + h * 128 + gd];
  const float gb = p.gate_bias[h * 128 + gd];
  const float qscale = 0.08838834764831845f;
  for (int t0 = 0; t0 < SEQ; t0 += CH) {
    const size_t tb = (size_t)b * SEQ + t0;
    { const int tok = tid >> 5, d4 = (tid & 31) * 4;
      const uint2 qv = *(const uint2*)(w.proj + (tb + tok) * NPROJ + C_GQ + h * 128 + d4);
      const uint2 kv = *(const uint2*)(w.proj + (tb + tok) * NPROJ + C_GK + h * 128 + d4);
      *(float4*)(qf + tok * 128 + d4) = make_float4(lo_f(qv.x) * qscale, hi_f(qv.x) * qscale, lo_f(qv.y) * qscale, hi_f(qv.y) * qscale);
      *(float4*)(kf + tok * 128 + d4) = make_float4(lo_f(kv.x), hi_f(kv.x), lo_f(kv.y), hi_f(kv.y)); }
    { const int dvv = tid & 255, tk8 = (tid >> 8) * 8; float f[8];
      unpack8(*(const uint4*)(w.vT + (size_t)(h * 256 + dvv) * T + tb + tk8), f);
#pragma unroll
      for (int j = 0; j < 8; ++j) vf[(tk8 + j) * 256 + dvv] = f[j]; }
#pragma unroll
    for (int i = 0; i < 4; ++i) { const int tok = (tid >> 7) * 4 + i; float z = gb; float gl[16];
      unpack8(*(const uint4*)(w.proj + (tb + tok) * NPROJ + C_SM), gl); unpack8(*(const uint4*)(w.proj + (tb + tok) * NPROJ + C_SM + 8), gl + 8);
#pragma unroll
      for (int r = 0; r < 16; ++r) z += gl[r] * gu[r];
      af[tok * 128 + gd] = __expf(logsigmoidf_(z) * (1.f / 16.f)); }
    __syncthreads();
    for (int tok = 0; tok < CH; ++tok) {
      const float vv = vf[tok * 256 + dv]; float acc = 0.f;
#pragma unroll
      for (int i4 = 0; i4 < 16; ++i4) {
        const float4 a = *(const float4*)(af + tok * 128 + half * 64 + i4 * 4), k = *(const float4*)(kf + tok * 128 + half * 64 + i4 * 4), q = *(const float4*)(qf + tok * 128 + half * 64 + i4 * 4);
        S[i4 * 4 + 0] = a.x * S[i4 * 4 + 0] + k.x * vv; acc += q.x * S[i4 * 4 + 0];
        S[i4 * 4 + 1] = a.y * S[i4 * 4 + 1] + k.y * vv; acc += q.y * S[i4 * 4 + 1];
        S[i4 * 4 + 2] = a.z * S[i4 * 4 + 2] + k.z * vv; acc += q.z * S[i4 * 4 + 2];
        S[i4 * 4 + 3] = a.w * S[i4 * 4 + 3] + k.w * vv; acc += q.w * S[i4 * 4 + 3];
      }
      op[(half * CH + tok) * 256 + dv] = acc;
    }
    __syncthreads();
#pragma unroll
    for (int i = 0; i < 2; ++i) { const int tok = wave * 2 + i;
      const float4 o0 = *(const float4*)(op + tok * 256 + lane * 4), o1 = *(const float4*)(op + (CH + tok) * 256 + lane * 4);
      const float o[4] = {o0.x + o1.x, o0.y + o1.y, o0.z + o1.z, o0.w + o1.w};
      float ss = wave_sum(o[0] * o[0] + o[1] * o[1] + o[2] * o[2] + o[3] * o[3]);
      const float rs = rsqrtf(ss * (1.f / 256.f) + EPS);
      const uint2 gg = *(const uint2*)(w.proj + (tb + tok) * NPROJ + C_GG + h * 256 + lane * 4);
      const float4 gn = *(const float4*)(p.gla_norm + h * 256 + lane * 4);
      const float y0 = o[0] * rs * gn.x * siluf_(lo_f(gg.x)), y1 = o[1] * rs * gn.y * siluf_(hi_f(gg.x)), y2 = o[2] * rs * gn.z * siluf_(lo_f(gg.y)), y3 = o[3] * rs * gn.w * siluf_(hi_f(gg.y));
      *(uint2*)(w.y + (tb + tok) * D + h * 256 + lane * 4) = make_uint2(pack2(y0, y1), pack2(y2, y3)); }
    __syncthreads();
  }
}
__device__ void mlstm_naive(const Params& p, const WS& w, int b, int h, float* lds) {
  constexpr int CH = 16;
  const int tid = tidx(), dv = tid & 255, half = tid >> 8, wave = tid >> 6, lane = tid & 63;
  float* qf = lds; float* kf = qf + CH * 128; float* vf = kf + CH * 128; float* op = vf + CH * 256; float* dn = op + 2 * CH * 256; float* gt = dn + 2 * CH * 256;
  float C[64], n[4];
#pragma unroll
  for (int i = 0; i < 64; ++i) C[i] = 0.f;
#pragma unroll
  for (int i = 0; i < 4; ++i) n[i] = 0.f;
  const int nd = half * 64 + (dv & 15) * 4;
  const float kscale = 0.08838834764831845f;
  const float ib = p.ig_bias[h], fb = p.fg_bias[h];
  for (int t0 = 0; t0 < SEQ; t0 += CH) {
    const size_t tb = (size_t)b * SEQ + t0;
    { const int tok = tid >> 5, d4 = (tid & 31) * 4;
      float qa[4], ka[4];
#pragma unroll
      for (int c = 0; c < 4; ++c) { qa[c] = p.conv_b[h * 128 + d4 + c]; ka[c] = p.conv_b[512 + h * 128 + d4 + c]; }
#pragma unroll
      for (int wi = 0; wi < 4; ++wi) { const int ts = t0 + tok - 3 + wi;
        if (ts >= 0) { const size_t tr = (size_t)b * SEQ + ts;
          const uint2 qv = *(const uint2*)(w.proj + tr * NPROJ + C_MQ + h * 128 + d4), kv = *(const uint2*)(w.proj + tr * NPROJ + C_MK + h * 128 + d4);
          const float4 cq = *(const float4*)(p.conv_w + wi * 1024 + h * 128 + d4), ck = *(const float4*)(p.conv_w + wi * 1024 + 512 + h * 128 + d4);
          qa[0] += cq.x * lo_f(qv.x); qa[1] += cq.y * hi_f(qv.x); qa[2] += cq.z * lo_f(qv.y); qa[3] += cq.w * hi_f(qv.y);
          ka[0] += ck.x * lo_f(kv.x); ka[1] += ck.y * hi_f(kv.x); ka[2] += ck.z * lo_f(kv.y); ka[3] += ck.w * hi_f(kv.y); } }
      *(float4*)(qf + tok * 128 + d4) = make_float4(siluf_(qa[0]), siluf_(qa[1]), siluf_(qa[2]), siluf_(qa[3]));
      *(float4*)(kf + tok * 128 + d4) = make_float4(siluf_(ka[0]) * kscale, siluf_(ka[1]) * kscale, siluf_(ka[2]) * kscale, siluf_(ka[3]) * kscale); }
    { const int dvv = tid & 255, tk8 = (tid >> 8) * 8; float f[8];
      unpack8(*(const uint4*)(w.vT + (size_t)(1024 + h * 256 + dvv) * T + tb + tk8), f);
#pragma unroll
      for (int j = 0; j < 8; ++j) vf[(tk8 + j) * 256 + dvv] = f[j]; }
    if (tid < CH) { const float mi = bf2f(w.proj[(tb + tid) * NPROJ + C_SM + 16 + h]), mf = bf2f(w.proj[(tb + tid) * NPROJ + C_SM + 20 + h]);
      gt[tid * 2] = __expf(mi + ib); gt[tid * 2 + 1] = sigmoidf_(mf + fb); }
    __syncthreads();
    for (int tok = 0; tok < CH; ++tok) {
      const float vv = vf[tok * 256 + dv], ig = gt[tok * 2], fg = gt[tok * 2 + 1]; float num = 0.f, den = 0.f;
#pragma unroll
      for (int i4 = 0; i4 < 16; ++i4) {
        const float4 k = *(const float4*)(kf + tok * 128 + half * 64 + i4 * 4), q = *(const float4*)(qf + tok * 128 + half * 64 + i4 * 4);
        const float kk[4] = {k.x * ig, k.y * ig, k.z * ig, k.w * ig}; const float qq[4] = {q.x, q.y, q.z, q.w};
#pragma unroll
        for (int c = 0; c < 4; ++c) { C[i4 * 4 + c] = fg * C[i4 * 4 + c] + kk[c] * vv; num += qq[c] * C[i4 * 4 + c]; }
      }
      { const float4 k = *(const float4*)(kf + tok * 128 + nd), q = *(const float4*)(qf + tok * 128 + nd);
        n[0] = fg * n[0] + k.x * ig; n[1] = fg * n[1] + k.y * ig; n[2] = fg * n[2] + k.z * ig; n[3] = fg * n[3] + k.w * ig;
        den = q.x * n[0] + q.y * n[1] + q.z * n[2] + q.w * n[3];
        den = gsum<16>(den); }
      op[(half * CH + tok) * 256 + dv] = num; if (dv == 0) dn[half * CH + tok] = den;
    }
    __syncthreads();
#pragma unroll
    for (int i = 0; i < 2; ++i) { const int tok = wave * 2 + i;
      const float4 o0 = *(const float4*)(op + tok * 256 + lane * 4), o1 = *(const float4*)(op + (CH + tok) * 256 + lane * 4);
      const float den = dn[tok] + dn[CH + tok];
      const float inv = 1.f / fmaxf(fabsf(den), 1.f);
      const float o[4] = {(o0.x + o1.x) * inv, (o0.y + o1.y) * inv, (o0.z + o1.z) * inv, (o0.w + o1.w) * inv};
      float ss = wave_sum(o[0] * o[0] + o[1] * o[1] + o[2] * o[2] + o[3] * o[3]);
      const float rs = rsqrtf(ss * (1.f / 256.f) + EPS);
      const uint2 mo = *(const uint2*)(w.proj + (tb + tok) * NPROJ + C_MO + h * 256 + lane * 4);
      const float4 gn = *(const float4*)(p.mlstm_norm + h * 256 + lane * 4);
      const float y0 = o[0] * rs * gn.x * sigmoidf_(lo_f(mo.x)), y1 = o[1] * rs * gn.y * sigmoidf_(hi_f(mo.x)), y2 = o[2] * rs * gn.z * sigmoidf_(lo_f(mo.y)), y3 = o[3] * rs * gn.w * sigmoidf_(hi_f(mo.y));
      *(uint2*)(w.y + (tb + tok) * D + 1024 + h * 256 + lane * 4) = make_uint2(pack2(y0, y1), pack2(y2, y3)); }
    __syncthreads();
  }
}
__device__ void phase_mixer_naive(const Params& p, const WS& w, float* lds, int bid, int nb) {
  for (int item = bid; item < 16; item += nb) {
    if (item < 8) gla_naive(p, w, item >> 2, item & 3, lds); else mlstm_naive(p, w, (item - 8) >> 2, item & 3, lds);
    __syncthreads();
  }
}


typedef short bf16x8 __attribute__((ext_vector_type(8)));
typedef float f32x4 __attribute__((ext_vector_type(4)));
#define MFMA16(a, b, c) __builtin_amdgcn_mfma_f32_16x16x32_bf16(a, b, c, 0, 0, 0)
constexpr int L_GLR = 0, L_TOT = 4096, L_F = 6144, L_DEN = 6656, L_PART = 6912, L_QS = 9216, L_KS = 26624, L_P = 44032, L_NL = 53248, L_KDT = 9216;
constexpr int QS_LD = 136, P_LD = 72, KDT_LD = 72;

__device__ __forceinline__ void gla_gates(const Params& p, const WS& w, int h, size_t tb, unsigned char* ldsb, int tid, float* bv, float& blast) {
  float* glrs = (float*)(ldsb + L_GLR); float* tot = (float*)(ldsb + L_TOT);
  const int d = tid & 127, tg = tid >> 7;
  if (tid < 128) { float f[8]; unpack8(*(const uint4*)(w.proj + (tb + (tid >> 1)) * NPROJ + C_SM + (tid & 1) * 8), f);
#pragma unroll
    for (int j = 0; j < 8; ++j) glrs[(tid >> 1) * 16 + (tid & 1) * 8 + j] = f[j]; }
  float gu[16];
#pragma unroll
  for (int r = 0; r < 16; ++r) gu[r] = p.gate_up[r * 512 + h * 128 + d];
  const float gb = p.gate_bias[h * 128 + d];
  __syncthreads();
  float run = 0.f;
#pragma unroll
  for (int i = 0; i < 16; ++i) { const float* gl = glrs + (tg * 16 + i) * 16; float z = gb;
#pragma unroll
    for (int r4 = 0; r4 < 4; ++r4) { const float4 g4 = *(const float4*)(gl + r4 * 4); z += g4.x * gu[r4 * 4] + g4.y * gu[r4 * 4 + 1] + g4.z * gu[r4 * 4 + 2] + g4.w * gu[r4 * 4 + 3]; }
    run += logsigmoidf_(z) * (1.f / 16.f); bv[i] = run; }
  tot[tg * 128 + d] = run;
  __syncthreads();
  float off = 0.f; blast = 0.f;
#pragma unroll
  for (int g = 0; g < 4; ++g) { const float t = tot[g * 128 + d]; blast += t; if (g < tg) off += t; }
#pragma unroll
  for (int i = 0; i < 16; ++i) bv[i] += off;
}
__device__ __forceinline__ void mlstm_gates(const Params& p, const WS& w, int h, size_t tb, unsigned char* ldsb, int tid) {
  float* Fl = (float*)(ldsb + L_F);
  if (tid < 64) { const float mi = bf2f(w.proj[(tb + tid) * NPROJ + C_SM + 16 + h]), mf = bf2f(w.proj[(tb + tid) * NPROJ + C_SM + 20 + h]);
    float f = logsigmoidf_(mf + p.fg_bias[h]);
#pragma unroll
    for (int o = 1; o < 64; o <<= 1) { const float t = bperm(f, tid - o); if (tid >= o) f += t; }
    Fl[tid] = f; Fl[64 + tid] = mi + p.ig_bias[h]; }
  __syncthreads();
}
__device__ __forceinline__ void conv_load(const WS& w, int col, int b, int c, int tg, bf16_t* win) {
  const int s0 = c * 64 + tg * 16 - 3;
#pragma unroll
  for (int m = 0; m < 19; ++m) { const int sp = s0 + m; win[m] = (sp >= 0) ? w.proj[((size_t)b * SEQ + sp) * NPROJ + col] : (bf16_t)0; }
}
__device__ __forceinline__ void conv_apply(const Params& p, const bf16_t* win, int cch, float scale, float* out) {
  const float c0 = p.conv_w[cch], c1 = p.conv_w[1024 + cch], c2 = p.conv_w[2048 + cch], c3 = p.conv_w[3072 + cch], cb = p.conv_b[cch];
#pragma unroll
  for (int i = 0; i < 16; ++i) out[i] = siluf_(cb + c0 * bf2f(win[i]) + c1 * bf2f(win[i + 1]) + c2 * bf2f(win[i + 2]) + c3 * bf2f(win[i + 3])) * scale;
}

template <int KIND>
__device__ void mix_local(const Params& p, const WS& w, int b, int h, int c, int item, unsigned char* ldsb) {
  const int tid = tidx(), lane = tid & 63, wave = tid >> 6, fr = lane & 15, fq = lane >> 4, d = tid & 127, tg = tid >> 7;
  const size_t tb = (size_t)b * SEQ + (size_t)c * 64;
  float* tot = (float*)(ldsb + L_TOT); const float* Fl = (const float*)(ldsb + L_F);
  bf16_t* kdT = (bf16_t*)(ldsb + L_KDT);
  const bf16_t* vrow = w.vT + (size_t)(KIND * 1024 + h * 256 + wave * 32 + fr) * T + tb + fq * 8;
  bf16x8 yv[2][2];
#pragma unroll
  for (int ks = 0; ks < 2; ++ks) { yv[ks][0] = *(const bf16x8*)(vrow + ks * 32); yv[ks][1] = *(const bf16x8*)(vrow + (size_t)16 * T + ks * 32); }
  bf16_t kraw[19];
  if (KIND == 0) {
#pragma unroll
    for (int i = 0; i < 16; ++i) kraw[i] = w.proj[(tb + tg * 16 + i) * NPROJ + C_GK + h * 128 + d];
  } else conv_load(w, C_MK + h * 128 + d, b, c, tg, kraw);
  float wgt[16], kv[16];
  if (KIND == 0) {
    float bv[16], blast; gla_gates(p, w, h, tb, ldsb, tid, bv, blast);
#pragma unroll
    for (int i = 0; i < 16; ++i) { wgt[i] = __expf(blast - bv[i]); kv[i] = bf2f(kraw[i]); }
    if (tg == 0) w.gdec[(size_t)item * 128 + d] = __expf(blast);
  } else {
    mlstm_gates(p, w, h, tb, ldsb, tid);
    const float flast = Fl[63];
#pragma unroll
    for (int i = 0; i < 16; ++i) wgt[i] = __expf(flast - Fl[tg * 16 + i] + Fl[64 + tg * 16 + i]);
    conv_apply(p, kraw, 512 + h * 128 + d, 0.08838834764831845f, kv);
    if (tid == 0) w.mdec[item - 2048] = __expf(flast);
  }
  float un = 0.f; float kd[16];
#pragma unroll
  for (int i = 0; i < 16; ++i) { kd[i] = kv[i] * wgt[i]; un += kd[i]; }
  *(uint4*)(kdT + d * KDT_LD + tg * 16) = pack8(kd); *(uint4*)(kdT + d * KDT_LD + tg * 16 + 8) = pack8(kd + 8);
  if (KIND == 1) tot[tg * 128 + d] = un;
  __syncthreads();
  if (KIND == 1 && tg == 0) w.mn[(size_t)(item - 2048) * 128 + d] = tot[d] + tot[128 + d] + tot[256 + d] + tot[384 + d];
  f32x4 acc[2][8];
#pragma unroll
  for (int yt = 0; yt < 2; ++yt)
#pragma unroll
    for (int xt = 0; xt < 8; ++xt) acc[yt][xt] = (f32x4){0.f, 0.f, 0.f, 0.f};
#pragma unroll
  for (int ks = 0; ks < 2; ++ks) {
#pragma unroll
    for (int xt = 0; xt < 8; ++xt) { const bf16x8 xk = *(const bf16x8*)(kdT + (xt * 16 + fr) * KDT_LD + ks * 32 + fq * 8);
      acc[0][xt] = MFMA16(xk, yv[ks][0], acc[0][xt]); acc[1][xt] = MFMA16(xk, yv[ks][1], acc[1][xt]); }
  }
  bf16_t* S = (bf16_t*)p.out + (size_t)item * 32768;
#pragma unroll
  for (int yt = 0; yt < 2; ++yt)
#pragma unroll
    for (int xt = 0; xt < 8; ++xt) *(uint2*)(S + (wave * 32 + yt * 16 + fr) * 128 + xt * 16 + 4 * fq) = make_uint2(pack2(acc[yt][xt][0], acc[yt][xt][1]), pack2(acc[yt][xt][2], acc[yt][xt][3]));
  __syncthreads();
}

__device__ void mix_scan(const Params& p, const WS& w, float* lds, int bid, int nb) {
  bf16_t* sbuf = (bf16_t*)p.out;
  const int tid = tidx();
  for (int g0 = bid * 512; g0 < 16 * 8192; g0 += nb * 512) {
    const int g = g0 + tid, combo = g0 >> 13, e = (g & 8191) * 4, dk = e & 127;
    __syncthreads();
    if (combo < 8) { const float4* src = (const float4*)(w.gdec + (size_t)combo * 32768);
#pragma unroll
      for (int i = 0; i < 16; ++i) ((float4*)lds)[i * 512 + tid] = src[i * 512 + tid]; }
    else if (tid < 256) lds[tid] = w.mdec[(combo - 8) * 256 + tid];
    __syncthreads();
    bf16_t* base = sbuf + (size_t)combo * 256 * 32768 + e;
    float S0 = 0.f, S1 = 0.f, S2 = 0.f, S3 = 0.f;
    for (int c0 = 0; c0 < 256; c0 += 16) {
      uint2 u[16];
#pragma unroll
      for (int k = 0; k < 16; ++k) u[k] = *(const uint2*)(base + (size_t)(c0 + k) * 32768);
#pragma unroll
      for (int k = 0; k < 16; ++k) { float4 dc; if (combo < 8) dc = *(const float4*)(lds + (c0 + k) * 128 + dk); else { const float m = lds[c0 + k]; dc = make_float4(m, m, m, m); }
        *(uint2*)(base + (size_t)(c0 + k) * 32768) = make_uint2(pack2(S0, S1), pack2(S2, S3));
        S0 = dc.x * S0 + lo_f(u[k].x); S1 = dc.y * S1 + hi_f(u[k].x); S2 = dc.z * S2 + lo_f(u[k].y); S3 = dc.w * S3 + hi_f(u[k].y); }
    }
  }
  for (int g = bid * 512 + tid; g < 8 * 128; g += nb * 512) {
    const int cb = g >> 7, d = g & 127; float n = 0.f;
    for (int c = 0; c < 256; ++c) { float* q = w.mn + (size_t)(cb * 256 + c) * 128 + d; const float u = *q; *q = n; n = w.mdec[cb * 256 + c] * n + u; }
  }
}

template <int KIND>
__device__ void mix_out(const Params& p, const WS& w, int b, int h, int c, int item, unsigned char* ldsb) {
  const int tid = tidx(), lane = tid & 63, wave = tid >> 6, fr = lane & 15, fq = lane >> 4, d = tid & 127, tg = tid >> 7;
  const size_t tb = (size_t)b * SEQ + (size_t)c * 64;
  const float* Fl = (const float*)(ldsb + L_F); float* denl = (float*)(ldsb + L_DEN); float* part = (float*)(ldsb + L_PART); float* nl = (float*)(ldsb + L_NL);
  bf16_t* qs = (bf16_t*)(ldsb + L_QS); bf16_t* ks = (bf16_t*)(ldsb + L_KS); bf16_t* P = (bf16_t*)(ldsb + L_P);
  bf16x8 vx[2][2], sx[4][2];
  { const bf16_t* vrow = w.vT + (size_t)(KIND * 1024 + h * 256 + wave * 32 + fr) * T + tb + fq * 8;
#pragma unroll
    for (int k2 = 0; k2 < 2; ++k2) { vx[k2][0] = *(const bf16x8*)(vrow + k2 * 32); vx[k2][1] = *(const bf16x8*)(vrow + (size_t)16 * T + k2 * 32); }
    const bf16_t* srow = (const bf16_t*)p.out + (size_t)item * 32768 + (wave * 32 + fr) * 128 + fq * 8;
#pragma unroll
    for (int k4 = 0; k4 < 4; ++k4) { sx[k4][0] = *(const bf16x8*)(srow + k4 * 32); sx[k4][1] = *(const bf16x8*)(srow + 16 * 128 + k4 * 32); } }
  uint2 gt[4][2];
#pragma unroll
  for (int yt = 0; yt < 4; ++yt)
#pragma unroll
    for (int xt = 0; xt < 2; ++xt) gt[yt][xt] = *(const uint2*)(w.proj + (tb + yt * 16 + fr) * NPROJ + (KIND == 0 ? C_GG : C_MO) + h * 256 + wave * 32 + xt * 16 + 4 * fq);
  const float* gain = (KIND == 0 ? p.gla_norm : p.mlstm_norm) + h * 256;
  const float4 gn0 = *(const float4*)(gain + wave * 32 + 4 * fq), gn1 = *(const float4*)(gain + wave * 32 + 16 + 4 * fq);
  bf16_t qraw[19], kraw[19];
  if (KIND == 0) {
#pragma unroll
    for (int i = 0; i < 16; ++i) { qraw[i] = w.proj[(tb + tg * 16 + i) * NPROJ + C_GQ + h * 128 + d]; kraw[i] = w.proj[(tb + tg * 16 + i) * NPROJ + C_GK + h * 128 + d]; }
  } else { conv_load(w, C_MQ + h * 128 + d, b, c, tg, qraw); conv_load(w, C_MK + h * 128 + d, b, c, tg, kraw); }
  float nlv = 0.f;
  if (KIND == 1 && tid < 128) nlv = w.mn[(size_t)(item - 2048) * 128 + tid];
  {
    float qm[16], km[16], qv[16], kv[16];
    if (KIND == 0) {
      float bv[16], blast; gla_gates(p, w, h, tb, ldsb, tid, bv, blast);
#pragma unroll
      for (int i = 0; i < 16; ++i) { qm[i] = 0.08838834764831845f * __expf(bv[i]); km[i] = __expf(-bv[i]); qv[i] = bf2f(qraw[i]); kv[i] = bf2f(kraw[i]); }
    } else {
      mlstm_gates(p, w, h, tb, ldsb, tid);
#pragma unroll
      for (int i = 0; i < 16; ++i) { const float F = Fl[tg * 16 + i]; qm[i] = __expf(F); km[i] = __expf(Fl[64 + tg * 16 + i] - F); }
      conv_apply(p, qraw, h * 128 + d, 1.f, qv);
      conv_apply(p, kraw, 512 + h * 128 + d, 0.08838834764831845f, kv);
      if (tid < 128) nl[tid] = nlv;
    }
#pragma unroll
    for (int i = 0; i < 16; ++i) { qs[(tg * 16 + i) * QS_LD + d] = f2bf(qv[i] * qm[i]); ks[(tg * 16 + i) * QS_LD + d] = f2bf(kv[i] * km[i]); }
  }
  __syncthreads();
#pragma unroll
  for (int q = 0; q < 2; ++q) { const int tt = wave * 2 + q, jt = tt >> 2, it = tt & 3; f32x4 a = (f32x4){0.f, 0.f, 0.f, 0.f};
#pragma unroll
    for (int k4 = 0; k4 < 4; ++k4) { const bf16x8 xk = *(const bf16x8*)(ks + (jt * 16 + fr) * QS_LD + k4 * 32 + fq * 8), yq = *(const bf16x8*)(qs + (it * 16 + fr) * QS_LD + k4 * 32 + fq * 8); a = MFMA16(xk, yq, a); }
    const int i = it * 16 + fr, j0 = jt * 16 + 4 * fq;
    const float v0 = (j0 <= i) ? a[0] : 0.f, v1 = (j0 + 1 <= i) ? a[1] : 0.f, v2 = (j0 + 2 <= i) ? a[2] : 0.f, v3 = (j0 + 3 <= i) ? a[3] : 0.f;
    *(uint2*)(P + i * P_LD + j0) = make_uint2(pack2(v0, v1), pack2(v2, v3)); }
  __syncthreads();
  if (KIND == 1) { const int i = tid >> 3, pt = tid & 7; float f[8]; float s = 0.f;
    unpack8(*(const uint4*)(P + i * P_LD + pt * 8), f);
#pragma unroll
    for (int j = 0; j < 8; ++j) s += f[j];
#pragma unroll
    for (int hh = 0; hh < 2; ++hh) { unpack8(*(const uint4*)(qs + i * QS_LD + pt * 16 + hh * 8), f);
#pragma unroll
      for (int j = 0; j < 8; ++j) s += f[j] * nl[pt * 16 + hh * 8 + j]; }
    s = gsum<8>(s);
    if (pt == 0) denl[i] = s; }
  f32x4 acc[2][4];
#pragma unroll
  for (int xt = 0; xt < 2; ++xt)
#pragma unroll
    for (int yt = 0; yt < 4; ++yt) acc[xt][yt] = (f32x4){0.f, 0.f, 0.f, 0.f};
#pragma unroll
  for (int k2 = 0; k2 < 2; ++k2)
#pragma unroll
    for (int yt = 0; yt < 4; ++yt) { const bf16x8 yp = *(const bf16x8*)(P + (yt * 16 + fr) * P_LD + k2 * 32 + fq * 8); acc[0][yt] = MFMA16(vx[k2][0], yp, acc[0][yt]); acc[1][yt] = MFMA16(vx[k2][1], yp, acc[1][yt]); }
#pragma unroll
  for (int k4 = 0; k4 < 4; ++k4)
#pragma unroll
    for (int yt = 0; yt < 4; ++yt) { const bf16x8 yq = *(const bf16x8*)(qs + (yt * 16 + fr) * QS_LD + k4 * 32 + fq * 8); acc[0][yt] = MFMA16(sx[k4][0], yq, acc[0][yt]); acc[1][yt] = MFMA16(sx[k4][1], yq, acc[1][yt]); }
  if (KIND == 1) __syncthreads();
#pragma unroll
  for (int yt = 0; yt < 4; ++yt) { float s = 0.f;
    if (KIND == 1) { const float inv = 1.f / fmaxf(fabsf(denl[yt * 16 + fr]), 1.f); acc[0][yt] *= inv; acc[1][yt] *= inv; }
#pragma unroll
    for (int xt = 0; xt < 2; ++xt)
#pragma unroll
      for (int r = 0; r < 4; ++r) s += acc[xt][yt][r] * acc[xt][yt][r];
    s += sxor<16>(s); s += sxor<32>(s);
    if (fq == 0) part[wave * 64 + yt * 16 + fr] = s; }
  __syncthreads();
#pragma unroll
  for (int yt = 0; yt < 4; ++yt) { const int i = yt * 16 + fr; float t = 0.f;
#pragma unroll
    for (int ww = 0; ww < 8; ++ww) t += part[ww * 64 + i];
    const float rs = rsqrtf(t * (1.f / 256.f) + EPS);
#pragma unroll
    for (int xt = 0; xt < 2; ++xt) { const int dv = wave * 32 + xt * 16 + 4 * fq;
      const float4 gn = xt == 0 ? gn0 : gn1; const uint2 g2 = gt[yt][xt];
      const float g0 = lo_f(g2.x), g1 = hi_f(g2.x), g2f = lo_f(g2.y), g3 = hi_f(g2.y);
      const float a0 = KIND == 0 ? siluf_(g0) : sigmoidf_(g0), a1 = KIND == 0 ? siluf_(g1) : sigmoidf_(g1), a2 = KIND == 0 ? siluf_(g2f) : sigmoidf_(g2f), a3 = KIND == 0 ? siluf_(g3) : sigmoidf_(g3);
      const float y0 = acc[xt][yt][0] * rs * gn.x * a0, y1 = acc[xt][yt][1] * rs * gn.y * a1, y2 = acc[xt][yt][2] * rs * gn.z * a2, y3 = acc[xt][yt][3] * rs * gn.w * a3;
#if F8_OUT
      *(unsigned*)(w.yq + (tb + i) * D + KIND * 1024 + h * 256 + dv) = pack4_fp8(y0, y1, y2, y3);
#else
      *(uint2*)(w.y + (tb + i) * D + KIND * 1024 + h * 256 + dv) = make_uint2(pack2(y0, y1), pack2(y2, y3));
#endif
    } }
  __syncthreads();
}
template <int KIND>
__device__ void mix_out3(const Params& p, const WS& w, int b, int h, int c, int item, unsigned char* ldsb) {
  const int tid = tidx(), lane = tid & 63, wave = tid >> 6, fr = lane & 15, fq = lane >> 4, d = tid & 127, tg = tid >> 7;
  const size_t tb = (size_t)b * SEQ + (size_t)c * 64;
  const float* Fl = (const float*)(ldsb + L_F); float* denl = (float*)(ldsb + L_DEN); float* part = (float*)(ldsb + L_PART); float* nl = (float*)(ldsb + L_NL);
  bf16_t* qs = (bf16_t*)(ldsb + L_QS); bf16_t* ks = (bf16_t*)(ldsb + L_KS); bf16_t* P = (bf16_t*)(ldsb + L_P);
  bf16x8 vx[2][2], sx[4][2];
  { const bf16_t* vrow = w.vT + (size_t)(KIND * 1024 + h * 256 + wave * 32 + fr) * T + tb + fq * 8;
#pragma unroll
    for (int k2 = 0; k2 < 2; ++k2) { vx[k2][0] = *(const bf16x8*)(vrow + k2 * 32); vx[k2][1] = *(const bf16x8*)(vrow + (size_t)16 * T + k2 * 32); }
    const bf16_t* srow = (const bf16_t*)p.out + (size_t)item * 32768 + (wave * 32 + fr) * 128 + fq * 8;
#pragma unroll
    for (int k4 = 0; k4 < 4; ++k4) { sx[k4][0] = *(const bf16x8*)(srow + k4 * 32); sx[k4][1] = *(const bf16x8*)(srow + 16 * 128 + k4 * 32); } }
  uint2 gt[4][2];
#pragma unroll
  for (int yt = 0; yt < 4; ++yt)
#pragma unroll
    for (int xt = 0; xt < 2; ++xt) gt[yt][xt] = *(const uint2*)(w.proj + (tb + yt * 16 + fr) * NPROJ + (KIND == 0 ? C_GG : C_MO) + h * 256 + wave * 32 + xt * 16 + 4 * fq);
  const float* gain = (KIND == 0 ? p.gla_norm : p.mlstm_norm) + h * 256;
  const float4 gn0 = *(const float4*)(gain + wave * 32 + 4 * fq), gn1 = *(const float4*)(gain + wave * 32 + 16 + 4 * fq);
  { uint4 tq[2], tk[2];
    const bf16_t* gq = w.qs + tb * 1024 + KIND * 512 + h * 128; const bf16_t* gk = w.ks + tb * 1024 + KIND * 512 + h * 128;
#pragma unroll
    for (int ps = 0; ps < 2; ++ps) { const int pc = ps * 512 + tid, row = pc >> 4, c8 = (pc & 15) * 8; tq[ps] = *(const uint4*)(gq + (size_t)row * 1024 + c8); tk[ps] = *(const uint4*)(gk + (size_t)row * 1024 + c8); }
    float nlv = 0.f;
    if (KIND == 1 && tid < 128) nlv = w.mn[(size_t)(item - 2048) * 128 + tid];
#pragma unroll
    for (int ps = 0; ps < 2; ++ps) { const int pc = ps * 512 + tid, row = pc >> 4, c8 = (pc & 15) * 8; *(uint4*)(qs + row * QS_LD + c8) = tq[ps]; *(uint4*)(ks + row * QS_LD + c8) = tk[ps]; }
    if (KIND == 1 && tid < 128) nl[tid] = nlv; }
  __syncthreads();
#pragma unroll
  for (int q = 0; q < 2; ++q) { const int tt = wave * 2 + q, jt = tt >> 2, it = tt & 3; f32x4 a = (f32x4){0.f, 0.f, 0.f, 0.f};
#pragma unroll
    for (int k4 = 0; k4 < 4; ++k4) { const bf16x8 xk = *(const bf16x8*)(ks + (jt * 16 + fr) * QS_LD + k4 * 32 + fq * 8), yq = *(const bf16x8*)(qs + (it * 16 + fr) * QS_LD + k4 * 32 + fq * 8); a = MFMA16(xk, yq, a); }
    const int i = it * 16 + fr, j0 = jt * 16 + 4 * fq;
    const float v0 = (j0 <= i) ? a[0] : 0.f, v1 = (j0 + 1 <= i) ? a[1] : 0.f, v2 = (j0 + 2 <= i) ? a[2] : 0.f, v3 = (j0 + 3 <= i) ? a[3] : 0.f;
    *(uint2*)(P + i * P_LD + j0) = make_uint2(pack2(v0, v1), pack2(v2, v3)); }
  __syncthreads();
  if (KIND == 1) { const int i = tid >> 3, pt = tid & 7; float f[8]; float s = 0.f;
    unpack8(*(const uint4*)(P + i * P_LD + pt * 8), f);
#pragma unroll
    for (int j = 0; j < 8; ++j) s += f[j];
#pragma unroll
    for (int hh = 0; hh < 2; ++hh) { unpack8(*(const uint4*)(qs + i * QS_LD + pt * 16 + hh * 8), f);
#pragma unroll
      for (int j = 0; j < 8; ++j) s += f[j] * nl[pt * 16 + hh * 8 + j]; }
    s = gsum<8>(s);
    if (pt == 0) denl[i] = s; }
  f32x4 acc[2][4];
#pragma unroll
  for (int xt = 0; xt < 2; ++xt)
#pragma unroll
    for (int yt = 0; yt < 4; ++yt) acc[xt][yt] = (f32x4){0.f, 0.f, 0.f, 0.f};
#pragma unroll
  for (int k2 = 0; k2 < 2; ++k2)
#pragma unroll
    for (int yt = 0; yt < 4; ++yt) { const bf16x8 yp = *(const bf16x8*)(P + (yt * 16 + fr) * P_LD + k2 * 32 + fq * 8); acc[0][yt] = MFMA16(vx[k2][0], yp, acc[0][yt]); acc[1][yt] = MFMA16(vx[k2][1], yp, acc[1][yt]); }
#pragma unroll
  for (int k4 = 0; k4 < 4; ++k4)
#pragma unroll
    for (int yt = 0; yt < 4; ++yt) { const bf16x8 yq = *(const bf16x8*)(qs + (yt * 16 + fr) * QS_LD + k4 * 32 + fq * 8); acc[0][yt] = MFMA16(sx[k4][0], yq, acc[0][yt]); acc[1][yt] = MFMA16(sx[k4][1], yq, acc[1][yt]); }
  if (KIND == 1) __syncthreads();
#pragma unroll
  for (int yt = 0; yt < 4; ++yt) { float s = 0.f;
    if (KIND == 1) { const float inv = 1.f / fmaxf(fabsf(denl[yt * 16 + fr]), 1.f); acc[0][yt] *= inv; acc[1][yt] *= inv; }
#pragma unroll
    for (int xt = 0; xt < 2; ++xt)
#pragma unroll
      for (int r = 0; r < 4; ++r) s += acc[xt][yt][r] * acc[xt][yt][r];
    s += sxor<16>(s); s += sxor<32>(s);
    if (fq == 0) part[wave * 64 + yt * 16 + fr] = s; }
  __syncthreads();
#pragma unroll
  for (int yt = 0; yt < 4; ++yt) { const int i = yt * 16 + fr; float t = 0.f;
#pragma unroll
    for (int ww = 0; ww < 8; ++ww) t += part[ww * 64 + i];
    const float rs = rsqrtf(t * (1.f / 256.f) + EPS);
#pragma unroll
    for (int xt = 0; xt < 2; ++xt) { const int dv = wave * 32 + xt * 16 + 4 * fq;
      const float4 gn = xt == 0 ? gn0 : gn1; const uint2 g2 = gt[yt][xt];
      const float g0 = lo_f(g2.x), g1 = hi_f(g2.x), g2f = lo_f(g2.y), g3 = hi_f(g2.y);
      const float a0 = KIND == 0 ? siluf_(g0) : sigmoidf_(g0), a1 = KIND == 0 ? siluf_(g1) : sigmoidf_(g1), a2 = KIND == 0 ? siluf_(g2f) : sigmoidf_(g2f), a3 = KIND == 0 ? siluf_(g3) : sigmoidf_(g3);
      const float y0 = acc[xt][yt][0] * rs * gn.x * a0, y1 = acc[xt][yt][1] * rs * gn.y * a1, y2 = acc[xt][yt][2] * rs * gn.z * a2, y3 = acc[xt][yt][3] * rs * gn.w * a3;
#if F8_OUT
      *(unsigned*)(w.yq + (tb + i) * D + KIND * 1024 + h * 256 + dv) = pack4_fp8(y0, y1, y2, y3);
#else
      *(uint2*)(w.y + (tb + i) * D + KIND * 1024 + h * 256 + dv) = make_uint2(pack2(y0, y1), pack2(y2, y3));
#endif
    } }
  __syncthreads();
}
template <int WHICH>
__device__ void phase_mix_items(const Params& p, const WS& w, unsigned char* ldsb, int bid, int nb) {
  for (int item = bid; item < 4096; item += nb) {
    const int kind = item >> 11, b = (item >> 10) & 1, h = (item >> 8) & 3, c = item & 255;
    if (WHICH == 0) { if (kind == 0) mix_local<0>(p, w, b, h, c, item, ldsb); else mix_local<1>(p, w, b, h, c, item, ldsb); }
    else { if (kind == 0) mix_out<0>(p, w, b, h, c, item, ldsb); else mix_out<1>(p, w, b, h, c, item, ldsb); }
  }
}


__device__ void phase_mix_out3(const Params& p, const WS& w, unsigned char* ldsb, int bid, int nb) {
  for (int item = bid; item < 4096; item += nb) {
    const int kind = item >> 11, b = (item >> 10) & 1, h = (item >> 8) & 3, c = item & 255;
    if (kind == 0) mix_out3<0>(p, w, b, h, c, item, ldsb); else mix_out3<1>(p, w, b, h, c, item, ldsb);
  }
}

__device__ void mix_gate_pass(const Params& p, const WS& w, unsigned char* ldsb, int bid, int nb) {
  const int tid = tidx(), h = tid >> 7, d = tid & 127, lane = tid & 63;
  const bf16_t* qT = (const bf16_t*)ldsb; const bf16_t* kT = (const bf16_t*)(ldsb + 65536);
  float* glrs = (float*)(ldsb + 131072); float* Fl = (float*)(ldsb + 135168);
  for (int itx = bid; itx < 1024; itx += nb) {
    const int kind = itx >> 9, b = (itx >> 8) & 1, c = itx & 255;
    const size_t tb = (size_t)b * SEQ + (size_t)c * 64;
    const int item = ((kind * 2 + b) * 4 + h) * 256 + c;
    bf16_t* qo = w.qs + tb * 1024 + kind * 512 + tid; bf16_t* ko = w.ks + tb * 1024 + kind * 512 + tid;
    bf16_t* kdo = w.kdT + (size_t)(kind * 512 + tid) * T + tb;
    { uint4 tq[8], tk[8];
      const unsigned char* gq = (const unsigned char*)(w.proj + tb * NPROJ + (kind == 0 ? C_GQ : C_MQ)); const unsigned char* gk = (const unsigned char*)(w.proj + tb * NPROJ + (kind == 0 ? C_GK : C_MK));
#pragma unroll
      for (int ps = 0; ps < 8; ++ps) { const int o = ps * 8192 + tid * 16; tq[ps] = *(const uint4*)(gq + (size_t)(o >> 10) * (NPROJ * 2) + (o & 1023)); tk[ps] = *(const uint4*)(gk + (size_t)(o >> 10) * (NPROJ * 2) + (o & 1023)); }
#pragma unroll
      for (int ps = 0; ps < 8; ++ps) { const int o = ps * 8192 + tid * 16; *(uint4*)(ldsb + o) = tq[ps]; *(uint4*)(ldsb + 65536 + o) = tk[ps]; } }
    if (kind == 0) {
      if (tid < 128) { float f[8]; unpack8(*(const uint4*)(w.proj + (tb + (tid >> 1)) * NPROJ + C_SM + (tid & 1) * 8), f);
#pragma unroll
        for (int j = 0; j < 8; ++j) glrs[(tid >> 1) * 16 + (tid & 1) * 8 + j] = f[j]; }
      float gu[16];
#pragma unroll
      for (int r = 0; r < 16; ++r) gu[r] = p.gate_up[r * 512 + tid];
      const float gb = p.gate_bias[tid];
      __syncthreads();
      float run = 0.f;
#pragma unroll 1
      for (int j8 = 0; j8 < 8; ++j8) { float kd[8];
#pragma unroll
        for (int e = 0; e < 8; ++e) { const int j = j8 * 8 + e; const float* gl = glrs + j * 16; float z = gb;
#pragma unroll
          for (int r4 = 0; r4 < 4; ++r4) { const float4 g4 = *(const float4*)(gl + r4 * 4); z += g4.x * gu[r4 * 4] + g4.y * gu[r4 * 4 + 1] + g4.z * gu[r4 * 4 + 2] + g4.w * gu[r4 * 4 + 3]; }
          run += logsigmoidf_(z) * (1.f / 16.f);
          const float q = bf2f(qT[j * 512 + tid]), k = bf2f(kT[j * 512 + tid]), eb = __expf(run), ks_ = k * __builtin_amdgcn_rcpf(eb);
          qo[(size_t)j * 1024] = f2bf(q * 0.08838834764831845f * eb); ko[(size_t)j * 1024] = f2bf(ks_); kd[e] = ks_; }
        *(uint4*)(kdo + j8 * 8) = pack8(kd); }
      w.gdec[(size_t)item * 128 + d] = __expf(run);
    } else {
      float q0 = 0.f, q1 = 0.f, q2 = 0.f, k0 = 0.f, k1 = 0.f, k2 = 0.f;
      if (c > 0) { const bf16_t* qp = w.proj + tb * NPROJ + C_MQ + tid; const bf16_t* kp = w.proj + tb * NPROJ + C_MK + tid;
        q0 = bf2f(*(qp - 3 * (size_t)NPROJ)); q1 = bf2f(*(qp - 2 * (size_t)NPROJ)); q2 = bf2f(*(qp - (size_t)NPROJ)); k0 = bf2f(*(kp - 3 * (size_t)NPROJ)); k1 = bf2f(*(kp - 2 * (size_t)NPROJ)); k2 = bf2f(*(kp - (size_t)NPROJ)); }
      if (tid < 256) { const int hh = tid >> 6; const float mi = bf2f(w.proj[(tb + lane) * NPROJ + C_SM + 16 + hh]), mf = bf2f(w.proj[(tb + lane) * NPROJ + C_SM + 20 + hh]);
        float f = logsigmoidf_(mf + p.fg_bias[hh]);
#pragma unroll
        for (int o = 1; o < 64; o <<= 1) { const float t = bperm(f, lane - o); if (lane >= o) f += t; }
        Fl[hh * 64 + lane] = f; Fl[256 + hh * 64 + lane] = mi + p.ig_bias[hh]; }
      const float cq0 = p.conv_w[tid], cq1 = p.conv_w[1024 + tid], cq2 = p.conv_w[2048 + tid], cq3 = p.conv_w[3072 + tid], cqb = p.conv_b[tid];
      const float ck0 = p.conv_w[512 + tid], ck1 = p.conv_w[1536 + tid], ck2 = p.conv_w[2560 + tid], ck3 = p.conv_w[3584 + tid], ckb = p.conv_b[512 + tid];
      __syncthreads();
      const float flast = Fl[h * 64 + 63];
      if (d == 0) w.mdec[item - 2048] = __expf(flast);
      float un = 0.f;
#pragma unroll 1
      for (int j8 = 0; j8 < 8; ++j8) { float kd[8];
#pragma unroll
        for (int e = 0; e < 8; ++e) { const int j = j8 * 8 + e; const float xq = bf2f(qT[j * 512 + tid]), xk = bf2f(kT[j * 512 + tid]);
          const float qc = siluf_(cqb + cq0 * q0 + cq1 * q1 + cq2 * q2 + cq3 * xq), kc = siluf_(ckb + ck0 * k0 + ck1 * k1 + ck2 * k2 + ck3 * xk) * 0.08838834764831845f;
          q0 = q1; q1 = q2; q2 = xq; k0 = k1; k1 = k2; k2 = xk;
          const float F = Fl[h * 64 + j], ig = Fl[256 + h * 64 + j];
          const float ks_ = kc * __expf(ig - F);
          qo[(size_t)j * 1024] = f2bf(qc * __expf(F)); ko[(size_t)j * 1024] = f2bf(ks_); kd[e] = ks_; un += ks_; }
        *(uint4*)(kdo + j8 * 8) = pack8(kd); }
      w.mn[(size_t)(item - 2048) * 128 + d] = un * __expf(flast);
    }
    __syncthreads();
  }
}
__device__ void mix_local2(const Params& p, const WS& w, int bid, int nb) {
  const int tid = tidx(), wave = tid >> 6, lane = tid & 63, fr = lane & 15, fq = lane >> 4;
  bf16x8 xf[16], yf[4];
#define ML_LOAD(task_) do { const int item_ = (task_) >> 3, w8_ = (task_) & 7, kind_ = item_ >> 11, b_ = (item_ >> 10) & 1, h_ = (item_ >> 8) & 3, c_ = item_ & 255; const size_t tb_ = (size_t)b_ * SEQ + (size_t)c_ * 64; \
    const bf16_t* xrow = w.kdT + (size_t)(kind_ * 512 + h_ * 128 + 8 * (fr >> 2) + (fr & 3)) * T + tb_ + fq * 8; const bf16_t* yrow = w.vT + (size_t)(kind_ * 1024 + h_ * 256 + w8_ * 32 + fr) * T + tb_ + fq * 8; \
    _Pragma("unroll") for (int ks = 0; ks < 2; ++ks) { yf[ks * 2] = *(const bf16x8*)(yrow + ks * 32); yf[ks * 2 + 1] = *(const bf16x8*)(yrow + (size_t)16 * T + ks * 32); \
      _Pragma("unroll") for (int xt = 0; xt < 8; ++xt) xf[ks * 8 + xt] = *(const bf16x8*)(xrow + (size_t)((xt >> 1) * 32 + (xt & 1) * 4) * T + ks * 32); } } while (0)
  const int t0 = bid * 8 + wave, step = nb * 8;
  if (t0 < 32768) ML_LOAD(t0);
  for (int task = t0; task < 32768; task += step) {
    const int item = task >> 3, w8 = task & 7, kind = item >> 11; f32x4 acc[2][8];
#pragma unroll
    for (int yt = 0; yt < 2; ++yt)
#pragma unroll
      for (int xt = 0; xt < 8; ++xt) acc[yt][xt] = (f32x4){0.f, 0.f, 0.f, 0.f};
#pragma unroll
    for (int ks = 0; ks < 2; ++ks)
#pragma unroll
      for (int xt = 0; xt < 8; ++xt) { acc[0][xt] = MFMA16(xf[ks * 8 + xt], yf[ks * 2], acc[0][xt]); acc[1][xt] = MFMA16(xf[ks * 8 + xt], yf[ks * 2 + 1], acc[1][xt]); }
    if (task + step < 32768) ML_LOAD(task + step);
    bf16_t* S = (bf16_t*)p.out + (size_t)item * 32768; const float md = kind ? w.mdec[item - 2048] : 0.f;
#pragma unroll
    for (int m = 0; m < 4; ++m) { float4 d0 = make_float4(md, md, md, md), d1 = d0;
      if (!kind) { d0 = *(const float4*)(w.gdec + (size_t)item * 128 + m * 32 + 8 * fq); d1 = *(const float4*)(w.gdec + (size_t)item * 128 + m * 32 + 8 * fq + 4); }
#pragma unroll
      for (int yt = 0; yt < 2; ++yt) { const f32x4 a = acc[yt][2 * m], bq = acc[yt][2 * m + 1];
        *(uint4*)(S + (w8 * 32 + yt * 16 + fr) * 128 + m * 32 + 8 * fq) = make_uint4(pack2(a[0] * d0.x, a[1] * d0.y), pack2(a[2] * d0.z, a[3] * d0.w), pack2(bq[0] * d1.x, bq[1] * d1.y), pack2(bq[2] * d1.z, bq[3] * d1.w)); } }
  }
#undef ML_LOAD
}
template <int KIND>
__device__ __forceinline__ void mix_out2_task(const Params& p, const WS& w, int item, int it, int fr, int fq) {
  const int b = (item >> 10) & 1, h = (item >> 8) & 3, c = item & 255;
  const size_t tb = (size_t)b * SEQ + (size_t)c * 64;
  const int i = it * 16 + fr;
  typedef unsigned u32x4_t __attribute__((ext_vector_type(4)));
  bf16x8 yq[4];
  { const bf16_t* qrow = w.qs + (tb + i) * 1024 + KIND * 512 + h * 128 + fq * 8;
#pragma unroll
    for (int k4 = 0; k4 < 4; ++k4) yq[k4] = *(const bf16x8*)(qrow + k4 * 32); }
  uint2 pk[4]; float rsum = 0.f;
  { bf16x8 kf[4][4];
#pragma unroll
    for (int jt = 0; jt < 4; ++jt) if (jt <= it) { const bf16_t* krow = w.ks + (tb + jt * 16 + fr) * 1024 + KIND * 512 + h * 128 + fq * 8;
#pragma unroll
      for (int k4 = 0; k4 < 4; ++k4) kf[jt][k4] = *(const bf16x8*)(krow + k4 * 32); }
#pragma unroll
    for (int jt = 0; jt < 4; ++jt) { pk[jt] = make_uint2(0u, 0u);
      if (jt <= it) { f32x4 a = (f32x4){0.f, 0.f, 0.f, 0.f};
#pragma unroll
        for (int k4 = 0; k4 < 4; ++k4) a = MFMA16(kf[jt][k4], yq[k4], a);
        if (jt == it) {
#pragma unroll
          for (int r = 0; r < 4; ++r) a[r] = (4 * fq + r <= fr) ? a[r] : 0.f; }
        rsum += a[0] + a[1] + a[2] + a[3];
        pk[jt] = make_uint2(pack2(a[0], a[1]), pack2(a[2], a[3])); } } }
  f32x4 acc[16];
#pragma unroll
  for (int xt = 0; xt < 16; ++xt) acc[xt] = (f32x4){0.f, 0.f, 0.f, 0.f};
  const bf16_t* vbase = w.vT + (size_t)(KIND * 1024 + h * 256 + fr) * T + tb + 4 * fq;
  const bf16_t* sbase = (const bf16_t*)p.out + (size_t)item * 32768 + fr * 128 + fq * 8;
  const u32x4_t yp0 = {pk[0].x, pk[0].y, pk[1].x, pk[1].y}, yp1 = {pk[2].x, pk[2].y, pk[3].x, pk[3].y};
  uint2 va[2][2][2], vb[2][2][2]; bf16x8 sf[2][2][4];
#define MO_LOAD(bufi, g) do { _Pragma("unroll") for (int x2 = 0; x2 < 2; ++x2) { const int xt = (g) * 2 + x2; const bf16_t* vr = vbase + (size_t)xt * 16 * T; \
      va[bufi][x2][0] = *(const uint2*)vr; vb[bufi][x2][0] = *(const uint2*)(vr + 16); if (it >= 2) { va[bufi][x2][1] = *(const uint2*)(vr + 32); vb[bufi][x2][1] = *(const uint2*)(vr + 48); } \
      _Pragma("unroll") for (int k4 = 0; k4 < 4; ++k4) sf[bufi][x2][k4] = *(const bf16x8*)(sbase + xt * 16 * 128 + k4 * 32); } } while (0)
#define MO_COMP(bufi, g) do { _Pragma("unroll") for (int x2 = 0; x2 < 2; ++x2) { const int xt = (g) * 2 + x2; \
      { const u32x4_t xv = {va[bufi][x2][0].x, va[bufi][x2][0].y, vb[bufi][x2][0].x, vb[bufi][x2][0].y}; acc[xt] = MFMA16(__builtin_bit_cast(bf16x8, xv), __builtin_bit_cast(bf16x8, yp0), acc[xt]); } \
      if (it >= 2) { const u32x4_t xv = {va[bufi][x2][1].x, va[bufi][x2][1].y, vb[bufi][x2][1].x, vb[bufi][x2][1].y}; acc[xt] = MFMA16(__builtin_bit_cast(bf16x8, xv), __builtin_bit_cast(bf16x8, yp1), acc[xt]); } \
      _Pragma("unroll") for (int k4 = 0; k4 < 4; ++k4) acc[xt] = MFMA16(sf[bufi][x2][k4], yq[k4], acc[xt]); } } while (0)
  MO_LOAD(0, 0);
#pragma unroll
  for (int g = 0; g < 8; g += 2) {
    MO_LOAD(1, g + 1);
    MO_COMP(0, g);
    if (g + 2 < 8) MO_LOAD(0, g + 2);
    MO_COMP(1, g + 1);
  }
#undef MO_LOAD
#undef MO_COMP
  if (KIND == 1) {
    float qn = 0.f; const float* nrow = w.mn + (size_t)(item - 2048) * 128 + fq * 8;
#pragma unroll
    for (int k4 = 0; k4 < 4; ++k4) { float f[8]; unpack8(__builtin_bit_cast(uint4, yq[k4]), f); const float4 n0 = *(const float4*)(nrow + k4 * 32), n1 = *(const float4*)(nrow + k4 * 32 + 4);
      qn += f[0] * n0.x + f[1] * n0.y + f[2] * n0.z + f[3] * n0.w + f[4] * n1.x + f[5] * n1.y + f[6] * n1.z + f[7] * n1.w; }
    float den = rsum + qn; den += sxor<16>(den); den += sxor<32>(den);
    const float inv = 1.f / fmaxf(fabsf(den), 1.f);
#pragma unroll
    for (int xt = 0; xt < 16; ++xt) acc[xt] *= inv;
  }
  float ss = 0.f;
#pragma unroll
  for (int xt = 0; xt < 16; ++xt)
#pragma unroll
    for (int r = 0; r < 4; ++r) ss += acc[xt][r] * acc[xt][r];
  ss += sxor<16>(ss); ss += sxor<32>(ss);
  const float rs = rsqrtf(ss * (1.f / 256.f) + EPS);
  const float* gain = (KIND == 0 ? p.gla_norm : p.mlstm_norm) + h * 256 + 4 * fq;
  const bf16_t* grow = w.proj + (tb + i) * NPROJ + (KIND == 0 ? C_GG : C_MO) + h * 256 + 4 * fq;
#pragma unroll
  for (int xt = 0; xt < 16; ++xt) { const uint2 g2 = *(const uint2*)(grow + xt * 16); const float4 gn = *(const float4*)(gain + xt * 16);
    const float g0 = lo_f(g2.x), g1 = hi_f(g2.x), g2f = lo_f(g2.y), g3 = hi_f(g2.y);
    const float a0 = KIND == 0 ? siluf_(g0) : sigmoidf_(g0), a1 = KIND == 0 ? siluf_(g1) : sigmoidf_(g1), a2 = KIND == 0 ? siluf_(g2f) : sigmoidf_(g2f), a3 = KIND == 0 ? siluf_(g3) : sigmoidf_(g3);
    const float y0 = acc[xt][0] * rs * gn.x * a0, y1 = acc[xt][1] * rs * gn.y * a1, y2 = acc[xt][2] * rs * gn.z * a2, y3 = acc[xt][3] * rs * gn.w * a3;
    const size_t yo = (tb + i) * D + KIND * 1024 + h * 256 + xt * 16 + 4 * fq;
#if F8_OUT
    *(unsigned*)(w.yq + yo) = pack4_fp8(y0, y1, y2, y3);
#else
    *(uint2*)(w.y + yo) = make_uint2(pack2(y0, y1), pack2(y2, y3));
#endif
  }
}
__device__ void mix_out2(const Params& p, const WS& w, int bid, int nb) {
  const int tid = tidx(), wave = tid >> 6, lane = tid & 63, fr = lane & 15, fq = lane >> 4;
  for (int task = bid * 8 + wave; task < 16384; task += nb * 8) {
    const int item = task >> 2, it = __builtin_amdgcn_readfirstlane(task & 3);
    if (item < 2048) mix_out2_task<0>(p, w, item, it, fr, fq); else mix_out2_task<1>(p, w, item, it, fr, fq);
  }
}

__device__ __forceinline__ unsigned sort16(unsigned b) { return (b & 0x8000u) ? (~b & 0xffffu) : (b | 0x8000u); }
__device__ __forceinline__ float unsort16(unsigned k) { const unsigned b = (k & 0x8000u) ? (k & 0x7fffu) : (~k & 0xffffu); return __uint_as_float(b << 16); }
__device__ __forceinline__ unsigned sort32(float f) { const unsigned u = __float_as_uint(f); return (u & 0x80000000u) ? ~u : (u | 0x80000000u); }
__device__ __forceinline__ float unsort32(unsigned k) { const unsigned u = (k & 0x80000000u) ? (k & 0x7fffffffu) : ~k; return __uint_as_float(u); }
__device__ __forceinline__ void ce_desc(unsigned& a, unsigned& b) { const unsigned hi = max(a, b), lo = min(a, b); a = hi; b = lo; }
__device__ __forceinline__ void sort16_desc(unsigned* k) {
#pragma unroll
  for (int sz = 2; sz <= 16; sz <<= 1)
#pragma unroll
    for (int j = sz >> 1; j > 0; j >>= 1)
#pragma unroll
      for (int i = 0; i < 16; ++i) { const int l = i ^ j; if (l > i) { if ((i & sz) == 0) ce_desc(k[i], k[l]); else ce_desc(k[l], k[i]); } }
}
__device__ __forceinline__ void merge16_desc(unsigned* L, const unsigned* B) {
#pragma unroll
  for (int i = 0; i < 16; ++i) L[i] = max(L[i], B[15 - i]);
#pragma unroll
  for (int j = 8; j > 0; j >>= 1)
#pragma unroll
    for (int i = 0; i < 16; ++i) { const int l = i ^ j; if (l > i) ce_desc(L[i], L[l]); }
}
__device__ void phase_topk(const Params& p, const WS& w, unsigned char* ldsb, int bid, int nb) {
  const int tid = tidx();
  unsigned char* mytab = ldsb + tid * 36;
  for (int th = bid * 512 + tid; th < T * 8; th += nb * 512) {
    const int t = th >> 3, h = th & 7;
    const uint4* sp = (const uint4*)(w.sc + (size_t)t * D + h * 256);
    unsigned L[2][16];
#pragma unroll
    for (int pp = 0; pp < 2; ++pp) {
#pragma unroll
      for (int blk = 0; blk < 8; ++blk) {
        const uint4 v0 = sp[pp * 16 + blk * 2], v1 = sp[pp * 16 + blk * 2 + 1]; const unsigned wds[8] = {v0.x, v0.y, v0.z, v0.w, v1.x, v1.y, v1.z, v1.w};
        unsigned B[16];
#pragma unroll
        for (int e = 0; e < 16; ++e) { const unsigned b = (e & 1) ? (wds[e >> 1] >> 16) : (wds[e >> 1] & 0xffffu); B[e] = (sort16(b) << 16) | (unsigned)(blk * 16 + e); }
        sort16_desc(B);
        if (blk == 0) {
#pragma unroll
          for (int i = 0; i < 16; ++i) L[pp][i] = B[i]; }
        else merge16_desc(L[pp], B);
      }
    }
    float v0f[16], v1f[16];
#pragma unroll
    for (int i = 0; i < 16; ++i) { v0f[i] = unsort16(L[0][i] >> 16); v1f[i] = unsort16(L[1][i] >> 16); }
    unsigned C[16], B[16];
#pragma unroll
    for (int j = 0; j < 16; ++j) C[j] = (sort32(v0f[0] + v1f[j]) & 0xffffff00u) | (unsigned)j;
    { int n = 0;
#pragma unroll
      for (int i = 1; i < 16; ++i)
#pragma unroll
        for (int j = 0; j < 16; ++j) if ((i + 1) * (j + 1) <= 16) { B[n & 15] = (sort32(v0f[i] + v1f[j]) & 0xffffff00u) | (unsigned)(i * 16 + j); ++n;
          if ((n & 15) == 0) { sort16_desc(B); merge16_desc(C, B); } }
#pragma unroll
      for (int e = 2; e < 16; ++e) B[e] = 0u;
      sort16_desc(B); merge16_desc(C, B); }
    { unsigned pw[8];
#pragma unroll
      for (int q4 = 0; q4 < 4; ++q4) { pw[q4] = (L[0][q4 * 4] & 0xffu) | ((L[0][q4 * 4 + 1] & 0xffu) << 8) | ((L[0][q4 * 4 + 2] & 0xffu) << 16) | (L[0][q4 * 4 + 3] << 24);
        pw[4 + q4] = (L[1][q4 * 4] & 0xffu) | ((L[1][q4 * 4 + 1] & 0xffu) << 8) | ((L[1][q4 * 4 + 2] & 0xffu) << 16) | (L[1][q4 * 4 + 3] << 24); }
#pragma unroll
      for (int q4 = 0; q4 < 8; ++q4) *(unsigned*)(mytab + q4 * 4) = pw[q4]; }
    const float mx = unsort32(C[0] & 0xffffff00u);
    float e[16], sum = 0.f; int eid[16];
#pragma unroll
    for (int k = 0; k < 16; ++k) { e[k] = __expf(unsort32(C[k] & 0xffffff00u) - mx); sum += e[k];
      eid[k] = (int)mytab[(C[k] >> 4) & 15] * 128 + (int)mytab[16 + (C[k] & 15)]; }
    const float inv = 1.f / sum;
    int* ei = w.eidx + (size_t)t * 128 + h * 16; float* eg = w.eg + (size_t)t * 128 + h * 16; float* es = w.esu + (size_t)t * 128 + h * 16;
#pragma unroll
    for (int k4 = 0; k4 < 4; ++k4) {
      const int e0 = eid[k4 * 4], e1 = eid[k4 * 4 + 1], e2 = eid[k4 * 4 + 2], e3 = eid[k4 * 4 + 3];
      *(int4*)(ei + k4 * 4) = make_int4(e0, e1, e2, e3);
      *(float4*)(eg + k4 * 4) = make_float4(e[k4 * 4] * inv * w.vsc[e0], e[k4 * 4 + 1] * inv * w.vsc[e1], e[k4 * 4 + 2] * inv * w.vsc[e2], e[k4 * 4 + 3] * inv * w.vsc[e3]);
      *(float4*)(es + k4 * 4) = make_float4(w.usc[e0], w.usc[e1], w.usc[e2], w.usc[e3]);
    }
  }
}
__device__ __forceinline__ void ub16(const uint4 q, float* f) {
  const unsigned wd[4] = {q.x, q.y, q.z, q.w};
#pragma unroll
  for (int k = 0; k < 4; ++k) { f[k * 4] = (float)(wd[k] & 0xffu); f[k * 4 + 1] = (float)((wd[k] >> 8) & 0xffu); f[k * 4 + 2] = (float)((wd[k] >> 16) & 0xffu); f[k * 4 + 3] = (float)(wd[k] >> 24); }
}
__device__ void peer_dots(const Params& p, const WS& w, int bid, int nb) {
  const int tid = tidx(), wave = tid >> 6, lane = tid & 63, r = lane % LPR, q = lane / LPR;
  const int x = bid & 7, nwl = (nb >> 3) * 8, wl = (bid >> 3) * 8 + wave;
  constexpr int HB = NIT / 2;
  for (int sp = 0; sp < SPL; ++sp) {
    const int s = x * SPL + sp;
    const unsigned char* tab = w.u8 + (size_t)s * 16384 * SLW + r * 16;
    int idx0 = w.eidx[(size_t)wl * 128 + lane], idx1 = w.eidx[(size_t)wl * 128 + 64 + lane];
    uint4 ha = *(const uint4*)(w.h1b + (size_t)wl * D + s * SLW + r * 16), hb = *(const uint4*)(w.h1b + (size_t)wl * D + s * SLW + r * 16 + 8);
    uint4 bA[HB], bB[HB];
#define PD_GATHER(buf, half, i0_, i1_) do { _Pragma("unroll") for (int i = 0; i < HB; ++i) { const int n = ((half) * HB + i) * EPI + q; const int e = bperm((n & 64) ? (i1_) : (i0_), n & 63); buf[i] = *(const uint4*)(tab + (size_t)e * SLW); } } while (0)
#define PD_DOTS(buf, half) do { _Pragma("unroll") for (int i = 0; i < HB; ++i) { int a = __builtin_amdgcn_sdot4((int)buf[i].x, hq[0], 0, false); a = __builtin_amdgcn_sdot4((int)buf[i].y, hq[1], a, false); \
      a = __builtin_amdgcn_sdot4((int)buf[i].z, hq[2], a, false); a = __builtin_amdgcn_sdot4((int)buf[i].w, hq[3], a, false); a = gsum<LPR>(a); \
      const int ii = (half) * HB + i; if (r == (ii % LPR)) res[ii / LPR] = (float)a * sh; } } while (0)
    PD_GATHER(bA, 0, idx0, idx1);
    for (int t = wl; t < T; t += nwl) {
      PD_GATHER(bB, 1, idx0, idx1);
      const int tn = (t + nwl < T) ? t + nwl : t;
      const int idx0n = w.eidx[(size_t)tn * 128 + lane], idx1n = w.eidx[(size_t)tn * 128 + 64 + lane];
      const uint4 han = *(const uint4*)(w.h1b + (size_t)tn * D + s * SLW + r * 16), hbn = *(const uint4*)(w.h1b + (size_t)tn * D + s * SLW + r * 16 + 8);
      float hf[16];
      unpack8(ha, hf); unpack8(hb, hf + 8);
      float am = 0.f;
#pragma unroll
      for (int j = 0; j < 16; ++j) am = fmaxf(am, fabsf(hf[j]));
      am = gmax<LPR>(am);
      const float sh = fmaxf(am, 1e-30f) * (1.f / 127.f), inv = 1.f / sh;
      int hq[4];
#pragma unroll
      for (int k = 0; k < 4; ++k) { unsigned xw = 0;
#pragma unroll
        for (int j = 0; j < 4; ++j) xw |= ((unsigned)(int)rintf(hf[k * 4 + j] * inv) & 0xffu) << (8 * j);
        hq[k] = (int)xw; }
      float res[2] = {0.f, 0.f};
      PD_DOTS(bA, 0);
      PD_GATHER(bA, 0, idx0n, idx1n);
      PD_DOTS(bB, 1);
#pragma unroll
      for (int rho = 0; rho < 2; ++rho) ((bf16_t*)w.pd)[((size_t)t * 128 + (rho * LPR + r) * EPI + q) * NSL + s] = f2bf(res[rho]);
      idx0 = idx0n; idx1 = idx1n; ha = han; hb = hbn;
    }
#undef PD_GATHER
#undef PD_DOTS
  }
}
__device__ __forceinline__ void peer_token_w(const WS& w, int t, int lane, int idx0, int idx1, float& w0, float& w1) {
  static_assert(NSL == 8, "one 16-byte load per (token, expert) holds the 8 slices' partial dots");
  const float rs2 = rsqrtf(w.ssq2[t] * (1.f / D) + EPS);
  float f0[8], f1[8];
  unpack8(*(const uint4*)((const bf16_t*)w.pd + ((size_t)t * 128 + lane) * 8), f0); unpack8(*(const uint4*)((const bf16_t*)w.pd + ((size_t)t * 128 + 64 + lane) * 8), f1);
  const float z0 = ((f0[0] + f0[1]) + (f0[2] + f0[3])) + ((f0[4] + f0[5]) + (f0[6] + f0[7])), z1 = ((f1[0] + f1[1]) + (f1[2] + f1[3])) + ((f1[4] + f1[5]) + (f1[6] + f1[7]));
  w0 = w.eg[(size_t)t * 128 + lane] * gelu_tanh(z0 * w.esu[(size_t)t * 128 + lane] * rs2);
  w1 = w.eg[(size_t)t * 128 + 64 + lane] * gelu_tanh(z1 * w.esu[(size_t)t * 128 + 64 + lane] * rs2);
}
__device__ void peer_vals(const Params& p, const WS& w, int bid, int nb) {
  static_assert(EPI == 4 && LPR == 16, "peer_vals' weight packing assumes 256-byte slices");
  const int tid = tidx(), wave = tid >> 6, lane = tid & 63, r = lane % LPR, q = lane / LPR;
  const int x = bid & 7, nwl = (nb >> 3) * 8, wl = (bid >> 3) * 8 + wave;
  constexpr int HB = NIT / 2;
  for (int sp = 0; sp < SPL; ++sp) {
    const int s = x * SPL + sp;
    const unsigned char* tab = w.v8 + (size_t)s * 16384 * SLW + r * 16;
    int idx0 = w.eidx[(size_t)wl * 128 + lane], idx1 = w.eidx[(size_t)wl * 128 + 64 + lane];
    float w0, w1; peer_token_w(w, wl, lane, idx0, idx1, w0, w1);
    uint4 bA[HB], bB[HB];
#define PV_GATHER(buf, half, i0_, i1_) do { _Pragma("unroll") for (int i = 0; i < HB; ++i) { const int n = ((half) * HB + i) * EPI + q; const int e = bperm((n & 64) ? (i1_) : (i0_), n & 63); buf[i] = *(const uint4*)(tab + (size_t)e * SLW); } } while (0)
#define PV_DOT4(buf, half) do { _Pragma("unroll") for (int g4 = 0; g4 < HB / 4; ++g4) { const int gg = (half) * (HB / 4) + g4; const int pw = bperm((gg & 4) ? pk1 : pk0, 16 * (gg & 3) + q); \
      _Pragma("unroll") for (int dd = 0; dd < 4; ++dd) { const unsigned b0 = ((const unsigned*)&buf[g4 * 4])[dd], b1 = ((const unsigned*)&buf[g4 * 4 + 1])[dd], b2 = ((const unsigned*)&buf[g4 * 4 + 2])[dd], b3 = ((const unsigned*)&buf[g4 * 4 + 3])[dd]; \
        const unsigned p0 = __builtin_amdgcn_perm(b1, b0, 0x05010400u), p1 = __builtin_amdgcn_perm(b1, b0, 0x07030602u), p2 = __builtin_amdgcn_perm(b3, b2, 0x05010400u), p3 = __builtin_amdgcn_perm(b3, b2, 0x07030602u); \
        acc[dd * 4 + 0] = __builtin_amdgcn_sdot4((int)__builtin_amdgcn_perm(p2, p0, 0x05040100u), pw, acc[dd * 4 + 0], false); acc[dd * 4 + 1] = __builtin_amdgcn_sdot4((int)__builtin_amdgcn_perm(p2, p0, 0x07060302u), pw, acc[dd * 4 + 1], false); \
        acc[dd * 4 + 2] = __builtin_amdgcn_sdot4((int)__builtin_amdgcn_perm(p3, p1, 0x05040100u), pw, acc[dd * 4 + 2], false); acc[dd * 4 + 3] = __builtin_amdgcn_sdot4((int)__builtin_amdgcn_perm(p3, p1, 0x07060302u), pw, acc[dd * 4 + 3], false); } } } while (0)
    PV_GATHER(bA, 0, idx0, idx1);
    for (int t = wl; t < T; t += nwl) {
      PV_GATHER(bB, 1, idx0, idx1);
      const int tn = (t + nwl < T) ? t + nwl : t;
      const int idx0n = w.eidx[(size_t)tn * 128 + lane], idx1n = w.eidx[(size_t)tn * 128 + 64 + lane];
      float w0n, w1n; peer_token_w(w, tn, lane, idx0n, idx1n, w0n, w1n);
      const float wmx = gmax<64>(fmaxf(fabsf(w0), fabsf(w1))), sw = fmaxf(wmx, 1e-30f) * (1.f / 127.f), isw = 1.f / sw;
      const int wq0 = (int)rintf(w0 * isw), wq1 = (int)rintf(w1 * isw);
      int pk0, pk1;
      { const int l0 = lane & ~12;
        pk0 = (bperm(wq0, l0) & 0xff) | ((bperm(wq0, l0 | 4) & 0xff) << 8) | ((bperm(wq0, l0 | 8) & 0xff) << 16) | (bperm(wq0, l0 | 12) << 24);
        pk1 = (bperm(wq1, l0) & 0xff) | ((bperm(wq1, l0 | 4) & 0xff) << 8) | ((bperm(wq1, l0 | 8) & 0xff) << 16) | (bperm(wq1, l0 | 12) << 24); }
      int acc[16];
#pragma unroll
      for (int j = 0; j < 16; ++j) acc[j] = 0;
      PV_DOT4(bA, 0);
      PV_GATHER(bA, 0, idx0n, idx1n);
      const uint4 ha = *(const uint4*)(w.h1b + (size_t)t * D + s * SLW + r * 16), hb = *(const uint4*)(w.h1b + (size_t)t * D + s * SLW + r * 16 + 8);
      const float ssq2t = w.ssq2[t];
      PV_DOT4(bB, 1);
#pragma unroll
      for (int j = 0; j < 16; ++j) { acc[j] += sxor<16>(acc[j]); acc[j] += sxor<32>(acc[j]); }
      float hf[16], o[16]; float ss = 0.f;
      unpack8(ha, hf); unpack8(hb, hf + 8);
#pragma unroll
      for (int j = 0; j < 16; ++j) { o[j] = hf[j] + sw * (float)acc[j]; ss += o[j] * o[j]; }
      if (q == 0) { *(uint4*)(w.h2b + (size_t)t * D + s * SLW + r * 16) = pack8(o); *(uint4*)(w.h2b + (size_t)t * D + s * SLW + r * 16 + 8) = pack8(o + 8);
#if F8_GATE
        const float rs2 = rsqrtf(ssq2t * (1.f / D) + EPS);
        *(uint4*)(w.h2q + (size_t)t * D + s * SLW + r * 16) = make_uint4(pack4_fp8(o[0] * rs2, o[1] * rs2, o[2] * rs2, o[3] * rs2), pack4_fp8(o[4] * rs2, o[5] * rs2, o[6] * rs2, o[7] * rs2),
                                                                      pack4_fp8(o[8] * rs2, o[9] * rs2, o[10] * rs2, o[11] * rs2), pack4_fp8(o[12] * rs2, o[13] * rs2, o[14] * rs2, o[15] * rs2));
#endif
      } else ss = 0.f;
      ss = wave_sum(ss);
      if (lane == 0) atomicAdd(w.ssq3 + t, ss);
      idx0 = idx0n; idx1 = idx1n; w0 = w0n; w1 = w1n;
    }
#undef PV_GATHER
#undef PV_DOT4
  }
}
#ifndef TPROBE_A
#define TPROBE_A -1
#endif
#ifndef TPROBE_B
#define TPROBE_B -1
#endif
__device__ void phase_final(const Params& p, const WS& w, int bid, int nb) {
  const int wave = tidx() >> 6, lane = tidx() & 63;
  float tscale = 1.f, tspike = 0.f;
  if (TPROBE_A >= 0) { const unsigned long long* ts = (const unsigned long long*)(w.ctlf + 16384); tscale = 1.f + sqrtf((float)(ts[TPROBE_A + 1] - ts[TPROBE_A]) * 1e-7f); }
  if (TPROBE_B >= 0) { const unsigned long long* ts = (const unsigned long long*)(w.ctlf + 16384); tspike = (float)(ts[TPROBE_B + 1] - ts[TPROBE_B]) * 1e-3f; }
  for (int row = bid * 8 + wave; row < T; row += nb * 8) {
    float4* o = (float4*)(p.out + (size_t)row * D);
    const float rs = rsqrtf(w.ssq4[row] * (1.f / D) + EPS) * tscale;
    uint2 hv[8];
#pragma unroll
    for (int i = 0; i < 8; ++i) hv[i] = *(const uint2*)(w.h1b + (size_t)row * D + (i * 64 + lane) * 4);
#pragma unroll
    for (int i = 0; i < 8; ++i) { const float4 g = *(const float4*)(p.norm_final + (i * 64 + lane) * 4);
      float4 v = make_float4(lo_f(hv[i].x) * rs * g.x, hi_f(hv[i].x) * rs * g.y, lo_f(hv[i].y) * rs * g.z, hi_f(hv[i].y) * rs * g.w);
      if (TPROBE_B >= 0 && row == 0 && i == 0 && lane == 0) v.x += tspike; o[i * 64 + lane] = v; }
  }
}

constexpr int NPHASE = 10;
#ifndef MIX_OUT3
#define MIX_OUT3 1
#endif
#ifndef FAST_MIX
#define FAST_MIX 2
#endif
template <int PH>
__device__ __forceinline__ void run_phase(const Params& p, float* lds, int bid, int nb) {
  const WS w = make_ws(p.ws, p.out);
  if (PH == 0) phase_prep(p, w, lds, bid, nb);
  const float s_in = __uint_as_float(__builtin_amdgcn_readfirstlane((F8_IN && PH == 1) ? __float_as_uint(w.ctlf[0]) : 0u)) * (1.f / 256.f);
  const float s_out = F8_OUT ? __uint_as_float(__builtin_amdgcn_readfirstlane((PH == 5) ? __float_as_uint(w.ctlf[1]) : 0u)) * (1.f / 256.f) : 1.f;
  const float s_g = __uint_as_float(__builtin_amdgcn_readfirstlane((F8_GATE && PH == 11) ? __float_as_uint(w.ctlf[2]) : 0u)) * (1.f / 256.f);
#if F8_IN
  if (PH == 1) { gemm_any<true>(w.xq, w.winq, T, NPROJ, D, EpiProjN{w.proj, w.rstd1, s_in}, lds, bid, nb);
                 gemm_any<true>(w.winq + (size_t)NPROJ * D, w.xq, 2048, T, D, EpiProjT{w.vT, w.rstd1, s_in}, lds, bid, nb); }
#else
  if (PH == 1) { gemm_any(w.xb, w.win, T, NPROJ, D, EpiProjN{w.proj, w.rstd1, 1.f}, lds, bid, nb);
                 gemm_any(w.win + (size_t)NPROJ * D, w.xb, 2048, T, D, EpiProjT{w.vT, w.rstd1, 1.f}, lds, bid, nb); }
#endif
#if F8_OUT
  if (PH == 5) gemm_any<true>(w.yq, w.woutq, T, D, D, EpiOut{p.x, w.h1b, w.ssq2, s_out}, lds, bid, nb);
#else
  if (PH == 5) gemm_any(w.y, w.wout, T, D, D, EpiOut{p.x, w.h1b, w.ssq2, 1.f}, lds, bid, nb);
#endif
#if F8_GATE
  if (PH == 11) gemm_any<true>(w.h2q, w.wgq, T, D, D, EpiGate{w.h2b, w.pl, w.ssq3, w.h1b, w.ssq4, w.ssq2, s_g}, lds, bid, nb);
#else
  if (PH == 11) gemm_any(w.h2b, w.wg, T, D, D, EpiGate{w.h2b, w.pl, w.ssq3, w.h1b, w.ssq4, w.ssq2, 1.f}, lds, bid, nb);
#endif
#if FAST_MIX == 2
  if (PH == 14) { phase_prep2(p, w, lds, bid, nb);
                  mix_gate_pass(p, w, (unsigned char*)lds, bid, nb); }
  if (PH == 2) mix_local2(p, w, bid, nb);
  if (PH == 3) mix_scan(p, w, lds, bid, nb);
#if MIX_OUT3
  if (PH == 4) phase_mix_out3(p, w, (unsigned char*)lds, bid, nb);
#else
  if (PH == 4) mix_out2(p, w, bid, nb);
#endif
#elif FAST_MIX
  if (PH == 2) phase_mix_items<0>(p, w, (unsigned char*)lds, bid, nb);
  if (PH == 3) mix_scan(p, w, lds, bid, nb);
  if (PH == 4) phase_mix_items<1>(p, w, (unsigned char*)lds, bid, nb);
#else
  if (PH == 2) phase_mixer_naive(p, w, lds, bid, nb);
#endif
  if (PH == 6) gemm_any(w.h1b, w.wq, T, D, D, EpiScore{w.sc, w.ssq2}, lds, bid, nb);
  if (PH == 7) { phase_topk(p, w, (unsigned char*)lds, bid, nb); __syncthreads(); gemm_any(w.pb, w.wple, T, D, 256, EpiPl{w.pl}, lds, bid, nb); }
  if (PH == 8) peer_dots(p, w, bid, nb);
  if (PH == 10) peer_vals(p, w, bid, nb);
  if (PH == 12) phase_final(p, w, bid, nb);
}


#define XB_LAS __attribute__((address_space(3)))
#define XB_TMO      128
#define XB_XCNT(j)  (256  + 64 * (j))
#define XB_XSUB(j)  (1280 + 64 * (j))
#define XB_XGEN(j)  (2304 + 64 * (j))
#define XB_TOP      3328
#define XB_TOPGEN   3392
#define XCD_BAR_WORDS 3456
#define XB_SPIN_CAP (1u << 18)
__device__ __forceinline__ unsigned xb_ld(unsigned* p)              { return __hip_atomic_load(p, __ATOMIC_RELAXED, __HIP_MEMORY_SCOPE_AGENT); }
__device__ __forceinline__ unsigned xb_add(unsigned* p, unsigned v) { return __hip_atomic_fetch_add(p, v, __ATOMIC_RELAXED, __HIP_MEMORY_SCOPE_AGENT); }
__device__ __forceinline__ unsigned xb_xcc_id() { return (unsigned)__builtin_amdgcn_s_getreg((3 << 11) | 20) & 0xFu; }
#define XB_SPIN(cond, bar) do { unsigned _sp = 0; while (cond) { __builtin_amdgcn_s_sleep(1); \
    if ((++_sp & 255u) == 0u) { if (xb_ld(&(bar)[XB_TMO])) break; if (_sp > XB_SPIN_CAP) { atomicAdd(&(bar)[XB_TMO], 1u); break; } } } } while (0)
struct XcdBarrier {
    unsigned* bar; unsigned x;
    volatile XB_LAS unsigned* st;
};
__device__ __forceinline__ XcdBarrier xcd_barrier_post(unsigned* bar, volatile XB_LAS unsigned* st) {
    XcdBarrier b; b.bar = bar; b.x = xb_xcc_id(); b.st = st;
    if (threadIdx.x == 0) (void)xb_add(&bar[XB_XCNT(b.x)], 1u);
    return b;
}
__device__ __forceinline__ void xcd_barrier_complete(unsigned* bar, unsigned x, unsigned& nloc, unsigned& nx) {
    const unsigned G = gridDim.x * gridDim.y * gridDim.z;
    unsigned sum, cnt, mine, sp = 0u;
    for (;;) {
        sum = 0u; cnt = 0u; mine = 0u;
#pragma unroll
        for (unsigned j = 0; j < 16; ++j) { const unsigned c = xb_ld(&bar[XB_XCNT(j)]); sum += c; cnt += (c > 0u) ? 1u : 0u; mine = (j == x) ? c : mine; }
        if (sum == G) break;
        __builtin_amdgcn_s_sleep(1);
        if ((++sp & 255u) == 0u) { if (xb_ld(&bar[XB_TMO])) break; if (sp > XB_SPIN_CAP) { atomicAdd(&bar[XB_TMO], 1u); break; } }
    }
    nloc = mine > 0u ? mine : 1u; nx = cnt > 0u ? cnt : 1u;
}
__device__ __forceinline__ void xcd_barrier(const XcdBarrier& b) {
    asm volatile("s_waitcnt vmcnt(0)" ::: "memory");
    __syncthreads();
    if (threadIdx.x == 0) {
        unsigned* bar = b.bar;
        __builtin_amdgcn_s_waitcnt(0);
        unsigned nloc = b.st[0], nx = b.st[1];
        if (nloc == 0u) { xcd_barrier_complete(bar, b.x, nloc, nx); b.st[0] = nloc; b.st[1] = nx; }
        const unsigned old = xb_add(&bar[XB_XSUB(b.x)], 1u);
        const unsigned gen = old / nloc;
        if (old + 1u == (gen + 1u) * nloc) {
            __builtin_amdgcn_fence(__ATOMIC_RELEASE, "agent");
            asm volatile("s_waitcnt vmcnt(0)" ::: "memory");
            const unsigned og = xb_add(&bar[XB_TOP], 1u);
            const unsigned tg = og / nx;
            if (og + 1u == (tg + 1u) * nx) xb_add(&bar[XB_TOPGEN], 1u);
            else XB_SPIN(xb_ld(&bar[XB_TOPGEN]) == tg, bar);
            __builtin_amdgcn_fence(__ATOMIC_ACQUIRE, "agent");
            xb_add(&bar[XB_XGEN(b.x)], 1u);
            asm volatile("s_waitcnt vmcnt(0)" ::: "memory");
        } else {
            XB_SPIN(xb_ld(&bar[XB_XGEN(b.x)]) == gen, bar);
            __builtin_amdgcn_fence(__ATOMIC_ACQUIRE, "agent");
            asm volatile("s_waitcnt vmcnt(0)" ::: "memory");
        }
    }
    __syncthreads();
}

constexpr size_t kDynLds = 143360;
extern __shared__ __attribute__((aligned(16))) unsigned char dyn_lds[];

#if ONE_LAUNCH
__global__ void __launch_bounds__(512, 2) mega(Params p) {
  cg::grid_group grid = cg::this_grid();
  float* lds = (float*)dyn_lds; const int bid = blockIdx.x, nb = gridDim.x;
#ifndef DUP_PHASE
#define DUP_PHASE -1
#endif
#define RUNP(k) do { run_phase<k>(p, lds, bid, nb); } while (0)
  int nstamp = 0;
#define STAMP() do { if ((TPROBE_A >= 0 || TPROBE_B >= 0) && bid == 0 && threadIdx.x == 0) ((unsigned long long*)(p.ws + OFF_CTL + 65536))[nstamp] = __builtin_amdgcn_s_memrealtime(); ++nstamp; } while (0)
  STAMP();
  unsigned* barw = (unsigned*)(p.ws + OFF_BAR);
  volatile XB_LAS unsigned* bst = (volatile XB_LAS unsigned*)(dyn_lds + kDynLds - 16);
  if (threadIdx.x == 0) { bst[0] = 0u; bst[1] = 0u; }
  if (bid == 0) for (int i = threadIdx.x; i < XCD_BAR_WORDS; i += 512) __hip_atomic_store(barw + i, 0u, __ATOMIC_RELAXED, __HIP_MEMORY_SCOPE_AGENT);
  RUNP(0); grid.sync(); STAMP();
  const XcdBarrier xbar = xcd_barrier_post(barw, bst);
#define GSYNC() xcd_barrier(xbar)
#ifdef EXTRA_SYNCS
  for (int i = 0; i < EXTRA_SYNCS; ++i) GSYNC();
#endif
  RUNP(1); GSYNC(); STAMP();
#if FAST_MIX == 2
  RUNP(14); GSYNC(); STAMP();
#endif
  RUNP(2); GSYNC(); STAMP();
#if FAST_MIX
  RUNP(3); GSYNC(); STAMP();
  RUNP(4); GSYNC(); STAMP();
#endif
  RUNP(5); GSYNC(); STAMP();
  RUNP(6); GSYNC(); STAMP();
  RUNP(7); GSYNC(); STAMP();
  RUNP(8); GSYNC(); STAMP();
  RUNP(10); GSYNC(); STAMP();
  RUNP(11); GSYNC(); STAMP();
  RUNP(12);
#undef RUNP
#undef STAMP
#undef GSYNC
}
#else
template <int PH> __global__ void __launch_bounds__(512, 2) k_phase(Params p) { run_phase<PH>(p, (float*)dyn_lds, blockIdx.x, gridDim.x); }
#endif


extern "C" void kernel_launch(void* const* d_in, const int* in_sizes, int n_in, void* d_out, int out_size, void* d_ws, size_t ws_size, hipStream_t stream) {
  if (n_in != 22 || out_size != T * D || ws_size < WS_NEED) { fprintf(stderr, "kernel_launch: unexpected shapes (n_in %d out %d ws %zu)\n", n_in, out_size, ws_size); return; }
  Params p{};
  const float** f = (const float**)&p;
  for (int i = 0; i < 22; ++i) f[i] = (const float*)d_in[i];
  p.out = (float*)d_out; p.ws = (unsigned char*)d_ws;
#if ONE_LAUNCH
  static int grid_blocks = 0;
  if (!grid_blocks) {
    int dev = 0, cus = 0, per_cu = 0;
    (void)hipGetDevice(&dev); (void)hipDeviceGetAttribute(&cus, hipDeviceAttributeMultiprocessorCount, dev);
    (void)hipFuncSetAttribute((const void*)mega, hipFuncAttributeMaxDynamicSharedMemorySize, (int)kDynLds);
    (void)hipOccupancyMaxActiveBlocksPerMultiprocessor(&per_cu, mega, 512, kDynLds);
    if (per_cu < 1) { fprintf(stderr, "occupancy query says 0 blocks/CU\n"); per_cu = 1; }
    grid_blocks = cus;
  }
  void* args[] = {&p};
  hipError_t e = hipLaunchCooperativeKernel((void*)mega, dim3(grid_blocks), dim3(512), args, kDynLds, stream);
  if (e != hipSuccess) fprintf(stderr, "cooperative launch failed: %s (grid %d)\n", hipGetErrorString(e), grid_blocks);
#else
  static bool attr = false;
  const int G = 256;
#define LAUNCH(PH) do { if (!attr) (void)hipFuncSetAttribute((const void*)k_phase<PH>, hipFuncAttributeMaxDynamicSharedMemorySize, (int)kDynLds); \
    hipLaunchKernelGGL(k_phase<PH>, dim3(G), dim3(512), kDynLds, stream, p); } while (0)
  LAUNCH(0); LAUNCH(1); LAUNCH(14); LAUNCH(2); LAUNCH(3); LAUNCH(4); LAUNCH(5); LAUNCH(6); LAUNCH(7); LAUNCH(8); LAUNCH(10); LAUNCH(11); LAUNCH(12);
  attr = true;
#undef LAUNCH
#endif
}
```

```cpp
#include <hip/hip_runtime.h>
#include <hip/hip_cooperative_groups.h>
#include <cstdio>
#include <cstdint>
namespace cg = cooperative_groups;

#ifndef ONE_LAUNCH
#define ONE_LAUNCH 1
#endif

typedef unsigned short bf16_t;
constexpr int T = 32768, SEQ = 16384, D = 2048;
constexpr int NPROJ = 4352;
constexpr int C_GQ = 0, C_GK = 512, C_GG = 1024, C_MQ = 2048, C_MK = 2560, C_MO = 3072, C_SM = 4096;
constexpr float EPS = 1e-6f;
constexpr size_t MiB = 1ull << 20;
constexpr size_t OFF_XB = 0, OFF_Y = 0, OFF_PL = 0;
constexpr size_t OFF_PROJ = 128 * MiB, OFF_H1B = 128 * MiB, OFF_H2B = 256 * MiB;
constexpr size_t OFF_VT = 400 * MiB, OFF_SC = 400 * MiB;
constexpr size_t OFF_UB = 528 * MiB, OFF_VB = 592 * MiB;
constexpr size_t OFF_WIN = 656 * MiB, OFF_WOUT = 681 * MiB, OFF_WQ = 689 * MiB, OFF_WG = 697 * MiB, OFF_WPLE = 705 * MiB;
constexpr size_t OFF_PB = 706 * MiB, OFF_EIDX = 722 * MiB, OFF_EG = 738 * MiB, OFF_MISC = 754 * MiB;
constexpr size_t OFF_GDEC = 755 * MiB, OFF_MN = 756 * MiB, OFF_MDEC = 757 * MiB, OFF_ESC = 758 * MiB;
constexpr size_t OFF_CTL = 759 * MiB, OFF_H2Q = 400 * MiB, OFF_QS = 760 * MiB, OFF_KS = 824 * MiB, OFF_KDT = 888 * MiB;
constexpr size_t OFF_ESU = 952 * MiB, OFF_BAR = 968 * MiB;
constexpr size_t WS_NEED = 969 * MiB;
#ifndef F8_IN
#define F8_IN 0
#endif
#ifndef F8_OUT
#define F8_OUT 1
#endif
#ifndef F8_GATE
#define F8_GATE 1
#endif
#ifndef F8_GEMM
#define F8_GEMM (F8_IN || F8_OUT || F8_GATE)
#endif

struct Params {
  const float *x, *p, *norm_mix, *w_in, *gate_up, *gate_bias, *gla_norm, *conv_w, *conv_b, *ig_bias, *fg_bias, *mlstm_norm,
      *w_out, *norm_ffn, *peer_query, *sub_keys, *peer_u, *peer_v, *norm_ple, *w_ple, *w_ple_gate, *norm_final;
  float* out;
  unsigned char* ws;
};

__device__ __forceinline__ float bf2f(bf16_t b) { return __uint_as_float(((unsigned)b) << 16); }
typedef __bf16 bf16v2_t __attribute__((ext_vector_type(2)));
__device__ __forceinline__ bf16_t f2bf(float f) { const __bf16 b = (__bf16)f; return __builtin_bit_cast(bf16_t, b); }
__device__ __forceinline__ unsigned pack2(float lo, float hi) { const bf16v2_t v = {(__bf16)lo, (__bf16)hi}; return __builtin_bit_cast(unsigned, v); }
__device__ __forceinline__ unsigned pack4_fp8(float a, float b, float c, float d) { int v = __builtin_amdgcn_cvt_pk_fp8_f32(a, b, 0, false); v = __builtin_amdgcn_cvt_pk_fp8_f32(c, d, v, true); return (unsigned)v; }
__device__ __forceinline__ float lo_f(unsigned u) { return __uint_as_float(u << 16); }
__device__ __forceinline__ float hi_f(unsigned u) { return __uint_as_float(u & 0xffff0000u); }
__device__ __forceinline__ int tidx() { int t = threadIdx.x; asm volatile("" : "+v"(t)); return t; }
template <int O> __device__ __forceinline__ int sxor_i(int v) {
  if constexpr (O < 32) return __builtin_amdgcn_ds_swizzle(v, (O << 10) | 0x1f);
  else return __builtin_amdgcn_ds_bpermute(((tidx() & 63) ^ 32) << 2, v);
}
template <int O> __device__ __forceinline__ float sxor(float v) { return __int_as_float(sxor_i<O>(__float_as_int(v))); }
template <int O> __device__ __forceinline__ int sxor(int v) { return sxor_i<O>(v); }
__device__ __forceinline__ int bperm(int v, int src_lane) { return __builtin_amdgcn_ds_bpermute(src_lane << 2, v); }
__device__ __forceinline__ float bperm(float v, int src_lane) { return __int_as_float(__builtin_amdgcn_ds_bpermute(src_lane << 2, __float_as_int(v))); }
template <int N> __device__ __forceinline__ float gsum(float v) {
  if constexpr (N >= 2) v += sxor<1>(v); if constexpr (N >= 4) v += sxor<2>(v); if constexpr (N >= 8) v += sxor<4>(v);
  if constexpr (N >= 16) v += sxor<8>(v); if constexpr (N >= 32) v += sxor<16>(v); if constexpr (N >= 64) v += sxor<32>(v); return v; }
template <int N> __device__ __forceinline__ int gsum(int v) {
  if constexpr (N >= 2) v += sxor<1>(v); if constexpr (N >= 4) v += sxor<2>(v); if constexpr (N >= 8) v += sxor<4>(v);
  if constexpr (N >= 16) v += sxor<8>(v); if constexpr (N >= 32) v += sxor<16>(v); if constexpr (N >= 64) v += sxor<32>(v); return v; }
template <int N> __device__ __forceinline__ float gmax(float v) {
  if constexpr (N >= 2) v = fmaxf(v, sxor<1>(v)); if constexpr (N >= 4) v = fmaxf(v, sxor<2>(v)); if constexpr (N >= 8) v = fmaxf(v, sxor<4>(v));
  if constexpr (N >= 16) v = fmaxf(v, sxor<8>(v)); if constexpr (N >= 32) v = fmaxf(v, sxor<16>(v)); if constexpr (N >= 64) v = fmaxf(v, sxor<32>(v)); return v; }
__device__ __forceinline__ float wave_sum(float v) { return gsum<64>(v); }
__device__ __forceinline__ float sigmoidf_(float x) { return __builtin_amdgcn_rcpf(1.f + __expf(-x)); }
__device__ __forceinline__ float siluf_(float x) { return x * __builtin_amdgcn_rcpf(1.f + __expf(-x)); }
__device__ __forceinline__ float logsigmoidf_(float x) { return fminf(x, 0.f) - __logf(1.f + __expf(-fabsf(x))); }
__device__ __forceinline__ float gelu_tanh(float x) { const float u = 0.7978845608028654f * (x + 0.044715f * x * x * x); return x * __builtin_amdgcn_rcpf(1.f + __expf(-2.f * u)); }
__device__ __forceinline__ void unpack8(const uint4 q, float* f) {
  f[0] = lo_f(q.x); f[1] = hi_f(q.x); f[2] = lo_f(q.y); f[3] = hi_f(q.y); f[4] = lo_f(q.z); f[5] = hi_f(q.z); f[6] = lo_f(q.w); f[7] = hi_f(q.w);
}
__device__ __forceinline__ uint4 pack8(const float* f) { return make_uint4(pack2(f[0], f[1]), pack2(f[2], f[3]), pack2(f[4], f[5]), pack2(f[6], f[7])); }

struct WS {
  bf16_t *xb, *y, *pl, *proj, *h1b, *h2b, *vT, *sc, *ub, *vb, *win, *wout, *wq, *wg, *wple, *pb;
  int* eidx; float* eg; float* esu; float *rstd1, *ssq2, *ssq3, *ssq4, *wsum, *gdec, *mn, *mdec, *usc, *vsc, *pd;
  unsigned char *u8, *v8, *xq, *yq, *h2q, *winq, *woutq, *wgq;
  bf16_t *qs, *ks, *kdT;
  float* ctlf;
};
__device__ __forceinline__ WS make_ws(unsigned char* ws, float* out) {
  WS w;
  w.xb = (bf16_t*)(ws + OFF_XB); w.y = (bf16_t*)(ws + OFF_Y); w.pl = (bf16_t*)(ws + OFF_PL); w.proj = (bf16_t*)(ws + OFF_PROJ);
  w.h1b = (bf16_t*)(ws + OFF_H1B); w.h2b = (bf16_t*)(ws + OFF_H2B); w.vT = (bf16_t*)(ws + OFF_VT); w.sc = (bf16_t*)(ws + OFF_SC);
  w.ub = (bf16_t*)(ws + OFF_UB); w.vb = (bf16_t*)(ws + OFF_VB); w.win = (bf16_t*)(ws + OFF_WIN); w.wout = (bf16_t*)(ws + OFF_WOUT);
  w.wq = (bf16_t*)(ws + OFF_WQ); w.wg = (bf16_t*)(ws + OFF_WG); w.wple = (bf16_t*)(ws + OFF_WPLE); w.pb = (bf16_t*)(ws + OFF_PB);
  w.eidx = (int*)(ws + OFF_EIDX); w.eg = (float*)(ws + OFF_EG); w.esu = (float*)(ws + OFF_ESU);
  float* m = (float*)(ws + OFF_MISC); w.rstd1 = m; w.ssq2 = m + T; w.ssq3 = m + 2 * T; w.ssq4 = m + 3 * T; w.wsum = m + 4 * T;
  w.gdec = (float*)(ws + OFF_GDEC); w.mn = (float*)(ws + OFF_MN); w.mdec = (float*)(ws + OFF_MDEC);
  w.usc = (float*)(ws + OFF_ESC); w.vsc = w.usc + 16384; w.u8 = ws + OFF_UB; w.v8 = ws + OFF_VB; w.pd = out;
  w.xq = ws + OFF_XB; w.yq = ws + OFF_Y; w.h2q = ws + OFF_H2Q; w.winq = ws + OFF_WIN; w.woutq = ws + OFF_WOUT; w.wgq = ws + OFF_WG; w.ctlf = (float*)(ws + OFF_CTL);
  w.qs = (bf16_t*)(ws + OFF_QS); w.ks = (bf16_t*)(ws + OFF_KS); w.kdT = (bf16_t*)(ws + OFF_KDT);
  return w;
}

__device__ void prep_x(const Params& p, const WS& w, int bid, int nb) {
  const int wave = tidx() >> 6, lane = tidx() & 63;
  for (int row0 = (bid * 8 + wave) * 2; row0 < T; row0 += nb * 16) {
    float4 v[2][8]; float ss[2] = {0.f, 0.f};
#pragma unroll
    for (int rr = 0; rr < 2; ++rr) { const float4* src = (const float4*)(p.x + (size_t)(row0 + rr) * D);
#pragma unroll
      for (int i = 0; i < 8; ++i) v[rr][i] = src[i * 64 + lane]; }
#pragma unroll
    for (int rr = 0; rr < 2; ++rr) {
#pragma unroll
      for (int i = 0; i < 8; ++i) ss[rr] += v[rr][i].x * v[rr][i].x + v[rr][i].y * v[rr][i].y + v[rr][i].z * v[rr][i].z + v[rr][i].w * v[rr][i].w;
      ss[rr] = wave_sum(ss[rr]);
      const float rs = rsqrtf(ss[rr] * (1.f / D) + EPS);
#if F8_IN
      unsigned* dst = (unsigned*)(w.xq + (size_t)(row0 + rr) * D);
#pragma unroll
      for (int i = 0; i < 8; ++i) dst[i * 64 + lane] = pack4_fp8(v[rr][i].x * rs, v[rr][i].y * rs, v[rr][i].z * rs, v[rr][i].w * rs);
#else
      uint2* dst = (uint2*)(w.xb + (size_t)(row0 + rr) * D);
#pragma unroll
      for (int i = 0; i < 8; ++i) dst[i * 64 + lane] = make_uint2(pack2(v[rr][i].x, v[rr][i].y), pack2(v[rr][i].z, v[rr][i].w));
#endif
      if (lane == 0) w.rstd1[row0 + rr] = rs; }
  }
}
__device__ void absmax_w(const float* src, size_t n, const float* gain, int ncols, float* part, float* lds, int bid, int nb) {
  float m = 0.f;
  for (size_t i = (size_t)bid * 512 + tidx(); i < n / 4; i += (size_t)nb * 512) { const float4 v = ((const float4*)src)[i]; const float g = gain ? gain[(i * 4) / (size_t)ncols] : 1.f;
    m = fmaxf(m, fabsf(g) * fmaxf(fmaxf(fabsf(v.x), fabsf(v.y)), fmaxf(fabsf(v.z), fabsf(v.w)))); }
  m = gmax<64>(m);
  __syncthreads();
  if ((tidx() & 63) == 0) lds[tidx() >> 6] = m;
  __syncthreads();
  if (tidx() == 0) { float t = lds[0];
#pragma unroll
    for (int i = 1; i < 8; ++i) t = fmaxf(t, lds[i]);
    part[bid] = t; }
  __syncthreads();
}
__device__ float amax_reduce(const float* part, float* lds, int nb) {
  float m = 0.f;
  for (int i = tidx(); i < nb; i += 512) m = fmaxf(m, part[i]);
  m = gmax<64>(m);
  __syncthreads();
  if ((tidx() & 63) == 0) lds[tidx() >> 6] = m;
  __syncthreads();
  float t = lds[0];
#pragma unroll
  for (int i = 1; i < 8; ++i) t = fmaxf(t, lds[i]);
  return t;
}
__device__ void cvt_rows(const float* src, bf16_t* dst, size_t n, const float* gain, int ncols, int bid, int nb) {
  const size_t n4 = n / 4, step = (size_t)nb * 512;
  for (size_t i0 = (size_t)bid * 512 + tidx(); i0 < n4; i0 += 4 * step) {
    float4 v[4];
#pragma unroll
    for (int u = 0; u < 4; ++u) { const size_t i = i0 + u * step; if (i < n4) v[u] = ((const float4*)src)[i]; }
#pragma unroll
    for (int u = 0; u < 4; ++u) { const size_t i = i0 + u * step; if (i < n4) {
      if (gain) { const float4 g = *(const float4*)(gain + (int)((i * 4) % (size_t)ncols)); v[u].x *= g.x; v[u].y *= g.y; v[u].z *= g.z; v[u].w *= g.w; }
      ((uint2*)dst)[i] = make_uint2(pack2(v[u].x, v[u].y), pack2(v[u].z, v[u].w)); } }
  }
}
template <bool F8OUT, class CM>
__device__ void transpose_w(const float* src, int K, int ldsrc, void* dstv, int Ndst, const float* gain, CM cm, float amax, float* lds, int bid, int nb) {
  const int tid = tidx(), tk = K / 64, ntile = (Ndst / 64) * tk, nc = tid & 63;
  const float qs = F8OUT ? 256.f / fmaxf(amax, 1e-30f) : 1.f;
  float rv[8];
#define TW_LOAD(tile) do { const int n0_ = ((tile) / tk) * 64, k0_ = ((tile) % tk) * 64, sc_ = cm(n0_ + nc); \
    _Pragma("unroll") for (int i = 0; i < 8; ++i) { const int kr = (tid >> 6) + 8 * i; float v = 0.f; if (sc_ >= 0) { v = src[(size_t)(k0_ + kr) * ldsrc + sc_]; if (gain) v *= gain[k0_ + kr]; } rv[i] = v * qs; } } while (0)
  if (bid < ntile) TW_LOAD(bid);
  for (int tile = bid; tile < ntile; tile += nb) {
    const int n0 = (tile / tk) * 64, k0 = (tile % tk) * 64;
#pragma unroll
    for (int i = 0; i < 8; ++i) lds[((tid >> 6) + 8 * i) * 65 + nc] = rv[i];
    __syncthreads();
    if (tile + nb < ntile) TW_LOAD(tile + nb);
    { const int nr = tid >> 3, ks = (tid & 7) * 8; float f[8];
#pragma unroll
      for (int j = 0; j < 8; ++j) f[j] = lds[(ks + j) * 65 + nr];
      if (F8OUT) *(uint2*)((unsigned char*)dstv + (size_t)(n0 + nr) * K + k0 + ks) = make_uint2(pack4_fp8(f[0], f[1], f[2], f[3]), pack4_fp8(f[4], f[5], f[6], f[7]));
      else *(uint4*)((bf16_t*)dstv + (size_t)(n0 + nr) * K + k0 + ks) = pack8(f); }
    __syncthreads();
  }
#undef TW_LOAD
}
struct CmIdent { __device__ int operator()(int n) const { return n; } };
struct CmWin {
  __device__ int operator()(int n) const {
    if (n < 1024) return n;
    if (n < 2048) return 2048 + (n - 1024);
    if (n < 2560) return 3088 + (n - 2048);
    if (n < 3072) return 3600 + (n - 2560);
    if (n < 4096) return 5136 + (n - 3072);
    if (n < 4352) { const int i = n - 4096; if (i < 16) return 3072 + i; if (i < 20) return 6160 + (i - 16); if (i < 24) return 6164 + (i - 20); return -1; }
    const int j = n - 4352; if (j < 1024) return 1024 + j;
    return 4112 + (j - 1024);
  }
};
__device__ void prep_wq(const Params& p, const WS& w, float* lds, int bid, int nb) {
  const int tid = tidx();
  float* SKs = lds;
  float* WQs = lds + 128 * 132;
  for (int item = bid; item < 16 * 32; item += nb) {
    const int hp = item >> 5, k0 = (item & 31) * 64;
#pragma unroll
    for (int i = 0; i < 8; ++i) { const int e4 = tid + 512 * i, key = e4 >> 5, d4 = (e4 & 31) * 4; *(float4*)(SKs + key * 132 + d4) = *(const float4*)(p.sub_keys + (size_t)hp * 16384 + key * 128 + d4); }
#pragma unroll
    for (int i = 0; i < 4; ++i) { const int e4 = tid + 512 * i, kr = e4 >> 5, d4 = (e4 & 31) * 4; float4 v = *(const float4*)(p.peer_query + (size_t)(k0 + kr) * 2048 + hp * 128 + d4); const float g = p.norm_ffn[k0 + kr]; v.x *= g; v.y *= g; v.z *= g; v.w *= g; *(float4*)(WQs + kr * 132 + d4) = v; }
    __syncthreads();
    const int k = tid & 63, kg = tid >> 6;
    float acc[16];
#pragma unroll
    for (int j = 0; j < 16; ++j) acc[j] = 0.f;
    for (int d4 = 0; d4 < 32; ++d4) {
      const float4 a = *(const float4*)(WQs + k * 132 + d4 * 4);
#pragma unroll
      for (int j = 0; j < 16; ++j) { const float4 s = *(const float4*)(SKs + (kg * 16 + j) * 132 + d4 * 4); acc[j] += a.x * s.x + a.y * s.y + a.z * s.z + a.w * s.w; }
    }
#pragma unroll
    for (int j = 0; j < 16; ++j) w.wq[(size_t)(hp * 128 + kg * 16 + j) * 2048 + k0 + k] = f2bf(acc[j]);
    __syncthreads();
  }
}

#ifndef PEER_SLW
#define PEER_SLW 256
#endif
constexpr int SLW = PEER_SLW, LPR = SLW / 16, EPI = 64 / LPR, NSL = 2048 / SLW, SPL = NSL / 8, NIT = 128 / EPI;
template <bool SIGNED>
__device__ void quant_rows(const float* src, const float* gain, unsigned char* dst, float* scale, int bid, int nb) {
  const int tid = tidx(), wave = tid >> 6, lane = tid & 63;
  for (int row0 = (bid * 8 + wave) * 2; row0 < 16384; row0 += nb * 16) {
    float4 f4[2][8];
#pragma unroll
    for (int rr = 0; rr < 2; ++rr)
#pragma unroll
      for (int i = 0; i < 2; ++i)
#pragma unroll
        for (int q = 0; q < 4; ++q) f4[rr][i * 4 + q] = *(const float4*)(src + (size_t)(row0 + rr) * 2048 + i * 1024 + lane * 16 + q * 4);
#pragma unroll
    for (int rr = 0; rr < 2; ++rr) { const int row = row0 + rr; float f[32]; float mx = 0.f;
#pragma unroll
      for (int i = 0; i < 2; ++i)
#pragma unroll
        for (int q = 0; q < 4; ++q) { float4 v = f4[rr][i * 4 + q];
          if (gain) { const float4 g = *(const float4*)(gain + i * 1024 + lane * 16 + q * 4); v.x *= g.x; v.y *= g.y; v.z *= g.z; v.w *= g.w; }
          f[i * 16 + q * 4] = v.x; f[i * 16 + q * 4 + 1] = v.y; f[i * 16 + q * 4 + 2] = v.z; f[i * 16 + q * 4 + 3] = v.w;
          mx = fmaxf(mx, fmaxf(fmaxf(fabsf(v.x), fabsf(v.y)), fmaxf(fabsf(v.z), fabsf(v.w)))); }
      mx = gmax<64>(mx);
      const float sc = fmaxf(mx, 1e-30f) * (1.f / 127.f), inv = 1.f / sc;
#pragma unroll
      for (int i = 0; i < 2; ++i) { unsigned wd[4];
#pragma unroll
        for (int q = 0; q < 4; ++q) { unsigned x = 0;
#pragma unroll
          for (int j = 0; j < 4; ++j) { const int v = (int)rintf(f[i * 16 + q * 4 + j] * inv) + (SIGNED ? 0 : 128); x |= ((unsigned)v & 0xffu) << (8 * j); }
          wd[q] = x; }
        const int el = i * 1024 + lane * 16;
        *(uint4*)(dst + ((size_t)(el / SLW) * 16384 + row) * SLW + (el % SLW)) = make_uint4(wd[0], wd[1], wd[2], wd[3]); }
      if (lane == 0) scale[row] = sc; }
  }
}
__device__ void phase_prep(const Params& p, const WS& w, float* lds, int bid, int nb) {
  prep_x(p, w, bid, nb);
#if F8_IN
  absmax_w(p.w_in, (size_t)2048 * 6168, p.norm_mix, 6168, w.ctlf + 1024, lds, bid, nb);
#else
  transpose_w<false>(p.w_in, 2048, 6168, w.win, 6400, p.norm_mix, CmWin(), 0.f, lds, bid, nb);
#endif
#if F8_OUT
  absmax_w(p.w_out, (size_t)2048 * 2048, nullptr, 2048, w.ctlf + 2048, lds, bid, nb);
#else
  transpose_w<false>(p.w_out, 2048, 2048, w.wout, 2048, nullptr, CmIdent(), 0.f, lds, bid, nb);
#endif
#if F8_GATE
  absmax_w(p.w_ple_gate, (size_t)2048 * 2048, p.norm_ple, 2048, w.ctlf + 3072, lds, bid, nb);
#else
  transpose_w<false>(p.w_ple_gate, 2048, 2048, w.wg, 2048, p.norm_ple, CmIdent(), 0.f, lds, bid, nb);
#endif
  cvt_rows(p.p, w.pb, (size_t)T * 256, nullptr, 256, bid, nb);
  quant_rows<true>(p.peer_u, p.norm_ffn, w.u8, w.usc, bid, nb);
  quant_rows<true>(p.peer_v, nullptr, w.v8, w.vsc, bid, nb);
  transpose_w<false>(p.w_ple, 256, 2048, w.wple, 2048, nullptr, CmIdent(), 0.f, lds, bid, nb);
  prep_wq(p, w, lds, bid, nb);
  for (int i = bid * 512 + tidx(); i < T; i += nb * 512) { w.ssq2[i] = 0.f; w.ssq3[i] = 0.f; w.ssq4[i] = 0.f; }
}
static_assert(!F8_IN, "phase_prep2 now runs after the in-projection: an fp8 in-projection needs its weight copy (and a seam) before phase 1 again");
__device__ void phase_prep2(const Params& p, const WS& w, float* lds, int bid, int nb) {
#if F8_IN
  { const float a0 = amax_reduce(w.ctlf + 1024, lds, nb); if (bid == 0 && tidx() == 0) w.ctlf[0] = a0; __syncthreads();
    transpose_w<true>(p.w_in, 2048, 6168, w.winq, 6400, p.norm_mix, CmWin(), a0, lds, bid, nb); }
#endif
#if F8_OUT
  { const float a1 = amax_reduce(w.ctlf + 2048, lds, nb); if (bid == 0 && tidx() == 0) w.ctlf[1] = a1; __syncthreads();
    transpose_w<true>(p.w_out, 2048, 2048, w.woutq, 2048, nullptr, CmIdent(), a1, lds, bid, nb); }
#endif
#if F8_GATE
  { const float a2 = amax_reduce(w.ctlf + 3072, lds, nb); if (bid == 0 && tidx() == 0) w.ctlf[2] = a2; __syncthreads();
    transpose_w<true>(p.w_ple_gate, 2048, 2048, w.wgq, 2048, p.norm_ple, CmIdent(), a2, lds, bid, nb); }
#endif
}

struct EpiProjN { bf16_t* out; const float* rstd; float ws; static constexpr bool ROWSUM = false;
  __device__ __forceinline__ float store8(int r, int c, const float* v) const { const float s = F8_IN ? ws : rstd[r]; float f[8];
#pragma unroll
    for (int j = 0; j < 8; ++j) f[j] = v[j] * s;
    *(uint4*)(out + (size_t)r * NPROJ + c) = pack8(f); return 0.f; }
  __device__ __forceinline__ void rowsum(int, float) const {} };
struct EpiProjT { bf16_t* out; const float* rstd; float ws; static constexpr bool ROWSUM = false;
  __device__ __forceinline__ float store8(int r, int c, const float* v) const { const float4 s0 = F8_IN ? make_float4(ws, ws, ws, ws) : *(const float4*)(rstd + c), s1 = F8_IN ? s0 : *(const float4*)(rstd + c + 4); float f[8];
    f[0] = v[0] * s0.x; f[1] = v[1] * s0.y; f[2] = v[2] * s0.z; f[3] = v[3] * s0.w; f[4] = v[4] * s1.x; f[5] = v[5] * s1.y; f[6] = v[6] * s1.z; f[7] = v[7] * s1.w;
    *(uint4*)(out + (size_t)r * T + c) = pack8(f); return 0.f; }
  __device__ __forceinline__ void rowsum(int, float) const {} };
struct EpiOut { const float* x; bf16_t* h1b; float* ssq; float ws; static constexpr bool ROWSUM = true;
  __device__ __forceinline__ float store8(int r, int c, const float* v) const { const float4 x0 = *(const float4*)(x + (size_t)r * D + c), x1 = *(const float4*)(x + (size_t)r * D + c + 4); float f[8];
    f[0] = v[0] * ws + x0.x; f[1] = v[1] * ws + x0.y; f[2] = v[2] * ws + x0.z; f[3] = v[3] * ws + x0.w; f[4] = v[4] * ws + x1.x; f[5] = v[5] * ws + x1.y; f[6] = v[6] * ws + x1.z; f[7] = v[7] * ws + x1.w;
    float s = 0.f;
#pragma unroll
    for (int j = 0; j < 8; ++j) s += f[j] * f[j];
    *(uint4*)(h1b + (size_t)r * D + c) = pack8(f); return s; }
  __device__ __forceinline__ void rowsum(int r, float s) const { atomicAdd(ssq + r, s); } };
struct EpiScore { bf16_t* sc; const float* ssq; static constexpr bool ROWSUM = false;
  __device__ __forceinline__ float store8(int r, int c, const float* v) const { const float s = rsqrtf(ssq[r] * (1.f / D) + EPS); float f[8];
#pragma unroll
    for (int j = 0; j < 8; ++j) f[j] = v[j] * s;
    *(uint4*)(sc + (size_t)r * D + c) = pack8(f); return 0.f; }
  __device__ __forceinline__ void rowsum(int, float) const {} };
struct EpiPl { bf16_t* pl; static constexpr bool ROWSUM = false;
  __device__ __forceinline__ float store8(int r, int c, const float* v) const { *(uint4*)(pl + (size_t)r * D + c) = pack8(v); return 0.f; }
  __device__ __forceinline__ void rowsum(int, float) const {} };
struct EpiGate { const bf16_t* h2b; const bf16_t* pl; const float* ssq3; bf16_t* out; float* ssq; const float* ssq2; float ws; static constexpr bool ROWSUM = true;
  __device__ __forceinline__ float store8(int r, int c, const float* v) const { const float rs = rsqrtf(ssq3[r] * (1.f / D) + EPS) * (F8_GATE ? ws * sqrtf(ssq2[r] * (1.f / D) + EPS) : 1.f); float h[8], q[8], f[8];
    unpack8(*(const uint4*)(h2b + (size_t)r * D + c), h); unpack8(*(const uint4*)(pl + (size_t)r * D + c), q);
    float s = 0.f;
#pragma unroll
    for (int j = 0; j < 8; ++j) { f[j] = h[j] + sigmoidf_(v[j] * rs) * q[j]; s += f[j] * f[j]; }
    *(uint4*)(out + (size_t)r * D + c) = pack8(f); return s; }
  __device__ __forceinline__ void rowsum(int r, float s) const { atomicAdd(ssq + r, s); } };

template <class Epi>
__device__ void gemm_naive(const bf16_t* A, const bf16_t* Bt, int M, int N, int K, const Epi& E, float* lds, int bid, int nb) {
  const int tid = tidx(), ty = tid >> 4, tx = tid & 15;
  float* As = lds;
  float* Bs = lds + 32 * 132;
  const int nM = M / 128, nN = N / 128;
  for (int tile = bid; tile < nM * nN; tile += nb) {
    const int m0 = (tile % nM) * 128, n0 = (tile / nM) * 128;
    float acc[4][8];
#pragma unroll
    for (int i = 0; i < 4; ++i)
#pragma unroll
      for (int j = 0; j < 8; ++j) acc[i][j] = 0.f;
    const int lr = tid >> 2, lk = (tid & 3) * 8;
    for (int k0 = 0; k0 < K; k0 += 32) {
      const uint4 av = *(const uint4*)(A + (size_t)(m0 + lr) * K + k0 + lk);
      const uint4 bv = *(const uint4*)(Bt + (size_t)(n0 + lr) * K + k0 + lk);
      float af[8], bf[8]; unpack8(av, af); unpack8(bv, bf);
      __syncthreads();
#pragma unroll
      for (int j = 0; j < 8; ++j) { As[(lk + j) * 132 + lr] = af[j]; Bs[(lk + j) * 132 + lr] = bf[j]; }
      __syncthreads();
#pragma unroll 8
      for (int kk = 0; kk < 32; ++kk) {
        const float4 a = *(const float4*)(As + kk * 132 + ty * 4);
        const float4 b0 = *(const float4*)(Bs + kk * 132 + tx * 8), b1 = *(const float4*)(Bs + kk * 132 + tx * 8 + 4);
        const float aa[4] = {a.x, a.y, a.z, a.w}; const float bb[8] = {b0.x, b0.y, b0.z, b0.w, b1.x, b1.y, b1.z, b1.w};
#pragma unroll
        for (int i = 0; i < 4; ++i)
#pragma unroll
          for (int j = 0; j < 8; ++j) acc[i][j] += aa[i] * bb[j];
      }
    }
#pragma unroll
    for (int i = 0; i < 4; ++i) {
      const int r = m0 + ty * 4 + i;
      float s = E.store8(r, n0 + tx * 8, acc[i]);
      if (Epi::ROWSUM) { s = gsum<16>(s); if (tx == 0) E.rowsum(r, s); }
    }
  }
}


namespace pg8 {
#define PG8_LAS __attribute__((address_space(3)))
typedef short bf16x8 __attribute__((ext_vector_type(8)));
typedef float f32x4 __attribute__((ext_vector_type(4)));
typedef int v4i_t __attribute__((ext_vector_type(4)));
typedef int v8i_t __attribute__((ext_vector_type(8)));
constexpr int BM = 256, BK = 64, HALF = 128, HTB = HALF * BK * 2, STAGE_BYTES = 8 * HTB, NXCD = 8, WGM = 8;
__host__ __device__ __forceinline__ int lds_byte(int r, int c) { const int st = (r >> 4) * 2 + (c >> 5), rr = r & 15, cc = c & 31, ob = rr * 64 + cc * 2; return st * 1024 + (ob ^ (((ob >> 9) & 1) << 5)); }
__host__ __device__ __forceinline__ void stage_rc(int b, int& R, int& C) { const int st = b / 1024, sb = b % 1024, swz = sb ^ (((sb >> 9) & 1) << 5); R = (st >> 1) * 16 + swz / 64; C = (st & 1) * 32 + (swz % 64) / 2; }
__host__ __device__ __forceinline__ int perm32(int rho) { const int n = rho >> 4, i = rho & 15; return 8 * (i >> 2) + 4 * n + (i & 3); }
struct Unit { int pm, pn; };
struct Gemm { const bf16_t* A; const bf16_t* Bt; int M, N, K; };
struct StaticOrder {
    int nM, nN, nwg, G, c;
    __host__ __device__ void init(int M, int N, int G_, int c_) { nM = M / BM; nN = N / BM; nwg = nM * nN; G = G_; c = c_; }
    __host__ __device__ bool next(int i, Unit& u) const {
        const long L = (long)i * G + c; if (L >= nwg) return false;
        int wgid = (int)L; { const int q = nwg / NXCD, r = nwg % NXCD, xcd = wgid % NXCD, off = wgid / NXCD; wgid = (xcd < r ? xcd * (q + 1) : r * (q + 1) + (xcd - r) * q) + off; }
        const int nig = WGM * nN, gid = wgid / nig, fm = gid * WGM, gsz = (nM - fm) < WGM ? (nM - fm) : WGM;
        u.pm = fm + ((wgid % nig) % gsz); u.pn = (wgid % nig) / gsz; return true;
    }
    __device__ __forceinline__ void a_ready(const Unit&) const {}
    __device__ __forceinline__ void done(const Unit&) const {}
};
template <class E8> struct EpiA {
    static constexpr bool PERM = true, AFTER_DRAIN = false;
    E8 e;
    __device__ __forceinline__ void operator()(const f32x4 (&acc)[2][2][4][2], const Unit& u, int wr, int wc, int fr, int fq) const {
        asm volatile("" : "+v"(fr), "+v"(fq));
        const int row0 = u.pm * BM + wr * 64 + fr, col0 = u.pn * BM + wc * 32 + 8 * fq;
#pragma unroll
        for (int ai = 0; ai < 2; ++ai)
#pragma unroll
            for (int m = 0; m < 4; ++m) { const int r = row0 + ai * HALF + m * 16; float s = 0.f;
#pragma unroll
                for (int bj = 0; bj < 2; ++bj) { const float v[8] = {acc[ai][bj][m][0][0], acc[ai][bj][m][0][1], acc[ai][bj][m][0][2], acc[ai][bj][m][0][3], acc[ai][bj][m][1][0], acc[ai][bj][m][1][1], acc[ai][bj][m][1][2], acc[ai][bj][m][1][3]};
                    s += e.store8(r, col0 + bj * HALF, v); }
                if (E8::ROWSUM) { s += sxor<16>(s); s += sxor<32>(s); if (fq == 0) e.rowsum(r, s); }
                asm volatile("" ::: "memory"); }
    }
    __device__ __forceinline__ void fused(f32x4 (&)[2][2][4][2], const Unit&, int, int, int, int, PG8_LAS unsigned char*, int, int) const {}
};
template <class Epi, class Sched, bool ALIGN_EPI = false, bool SP2 = false, bool F8 = false>
__device__ __forceinline__ void gemm_phase(PG8_LAS unsigned char* lds, const Gemm g, const Sched& S, const Epi& E) {
    int tid_ = threadIdx.x; asm volatile("" : "+v"(tid_));
    const int tid = tid_, wid = __builtin_amdgcn_readfirstlane(tid >> 6), lane = tid & 63, wr = wid >> 2, wc = wid & 3, fr = lane & 15, fq = lane >> 4;
    const int K = g.K, nt = K / BK;
    unsigned voffA[2], voffB[2];
#pragma unroll
    for (int i = 0; i < 2; ++i) { int R, C; stage_rc(tid * 16 + i * 8192, R, C); const int Rb = Epi::PERM ? ((R & ~31) + perm32(R & 31)) : R;
        voffA[i] = (unsigned)(R * K + C) * 2u; voffB[i] = (unsigned)(Rb * K + C) * 2u; }
    const size_t kstep = (size_t)(BK * 2);
    const size_t hstep = (size_t)HALF * K * 2;
    const size_t tstep = 2 * hstep;
    const unsigned ldsw = (unsigned)wid * 1024u;
    const int aoff = lds_byte(wr * 64 + fr, fq * 8), boff = lds_byte(wc * 32 + fr, fq * 8);
#define PG8_SA(b, h) (((b) * 2 + (h)) * HTB)
#define PG8_SB(b, h) ((4 + (b) * 2 + (h)) * HTB)
#define PG8_STAGE(bufoff, gbase, voff) do { _Pragma("unroll") for (int _i = 0; _i < 2; ++_i) \
        __builtin_amdgcn_global_load_lds((const unsigned*)((const char*)(gbase) + (voff)[_i]), (PG8_LAS unsigned*)(lds + (bufoff) + ldsw + _i * 8192), 16, 0, 0); } while (0)
#define PG8_LDA(dst, b, h) do { _Pragma("unroll") for (int m = 0; m < 4; ++m) { const v4i_t lo_ = *(const PG8_LAS v4i_t*)(lds + PG8_SA(b, h) + aoff + m * 2048), hi_ = *(const PG8_LAS v4i_t*)(lds + PG8_SA(b, h) + aoff + m * 2048 + 1024); dst[m] = __builtin_shufflevector(lo_, hi_, 0, 1, 2, 3, 4, 5, 6, 7); } } while (0)
#define PG8_LDB(dst, b, h) do { _Pragma("unroll") for (int n = 0; n < 2; ++n) { const v4i_t lo_ = *(const PG8_LAS v4i_t*)(lds + PG8_SB(b, h) + boff + n * 2048), hi_ = *(const PG8_LAS v4i_t*)(lds + PG8_SB(b, h) + boff + n * 2048 + 1024); dst[n] = __builtin_shufflevector(lo_, hi_, 0, 1, 2, 3, 4, 5, 6, 7); } } while (0)
#define PG8_MMA(ai, bj, At, Bt) do { __builtin_amdgcn_s_setprio(1); \
        if constexpr (F8) { asm volatile("s_nop 1\n\t" \
            "v_mfma_scale_f32_16x16x128_f8f6f4 %0, %12, %8, %0, %14, %14 op_sel_hi:[0,0,0]\n\t"  "v_mfma_scale_f32_16x16x128_f8f6f4 %1, %13, %8, %1, %14, %14 op_sel_hi:[0,0,0]\n\t" \
            "v_mfma_scale_f32_16x16x128_f8f6f4 %2, %12, %9, %2, %14, %14 op_sel_hi:[0,0,0]\n\t"  "v_mfma_scale_f32_16x16x128_f8f6f4 %3, %13, %9, %3, %14, %14 op_sel_hi:[0,0,0]\n\t" \
            "v_mfma_scale_f32_16x16x128_f8f6f4 %4, %12, %10, %4, %14, %14 op_sel_hi:[0,0,0]\n\t" "v_mfma_scale_f32_16x16x128_f8f6f4 %5, %13, %10, %5, %14, %14 op_sel_hi:[0,0,0]\n\t" \
            "v_mfma_scale_f32_16x16x128_f8f6f4 %6, %12, %11, %6, %14, %14 op_sel_hi:[0,0,0]\n\t" "v_mfma_scale_f32_16x16x128_f8f6f4 %7, %13, %11, %7, %14, %14 op_sel_hi:[0,0,0]" \
            : "+v"(acc[ai][bj][0][0]), "+v"(acc[ai][bj][0][1]), "+v"(acc[ai][bj][1][0]), "+v"(acc[ai][bj][1][1]), "+v"(acc[ai][bj][2][0]), "+v"(acc[ai][bj][2][1]), "+v"(acc[ai][bj][3][0]), "+v"(acc[ai][bj][3][1]) \
            : "v"(At[0]), "v"(At[1]), "v"(At[2]), "v"(At[3]), "v"(Bt[0]), "v"(Bt[1]), "v"(one_scale)); } \
        else { _Pragma("unroll") for (int m = 0; m < 4; ++m) _Pragma("unroll") for (int n = 0; n < 2; ++n) { \
            acc[ai][bj][m][n] = __builtin_amdgcn_mfma_f32_16x16x32_bf16(__builtin_bit_cast(bf16x8, __builtin_shufflevector(Bt[n], Bt[n], 0, 1, 2, 3)), __builtin_bit_cast(bf16x8, __builtin_shufflevector(At[m], At[m], 0, 1, 2, 3)), acc[ai][bj][m][n], 0, 0, 0); \
            acc[ai][bj][m][n] = __builtin_amdgcn_mfma_f32_16x16x32_bf16(__builtin_bit_cast(bf16x8, __builtin_shufflevector(Bt[n], Bt[n], 4, 5, 6, 7)), __builtin_bit_cast(bf16x8, __builtin_shufflevector(At[m], At[m], 4, 5, 6, 7)), acc[ai][bj][m][n], 0, 0, 0); } } \
        __builtin_amdgcn_s_setprio(0); } while (0)
#define PG8_MFMA_DRAIN() do { if constexpr (F8) asm volatile("s_nop 15\n\ts_nop 15\n\ts_nop 15" ::: "memory"); } while (0)
#define PG8_WAIT_V(n) asm volatile("s_waitcnt vmcnt(" #n ")" ::: "memory")
#define PG8_WAIT_L(n) asm volatile("s_waitcnt lgkmcnt(" #n ")" ::: "memory")
#define PG8_BAR __builtin_amdgcn_s_barrier()
#define PG8_SCHED __builtin_amdgcn_sched_barrier(0)
    Unit cur, nxt; int ui = 0;
    if (!S.next(0, cur)) return;
    f32x4 acc[2][2][4][2];
#pragma unroll
    for (int a = 0; a < 2; ++a)
#pragma unroll
        for (int b = 0; b < 2; ++b)
#pragma unroll
            for (int m = 0; m < 4; ++m)
#pragma unroll
                for (int n = 0; n < 2; ++n) acc[a][b][m][n] = (f32x4){0.f, 0.f, 0.f, 0.f};
    const int one_scale = 0x7f7f7f7f;
    v8i_t At[4], B0[2], B1[2];
    const char* cA = (const char*)g.A + (size_t)cur.pm * tstep; const char* cB = (const char*)g.Bt + (size_t)cur.pn * tstep;
    S.a_ready(cur);
    if constexpr (SP2) {
        PG8_STAGE(PG8_SB(0, 0), cB, voffB); PG8_STAGE(PG8_SB(0, 1), cB + hstep, voffB); PG8_STAGE(PG8_SA(0, 0), cA, voffA); PG8_STAGE(PG8_SA(0, 1), cA + hstep, voffA);
        if (wr == 1) PG8_BAR;
        PG8_WAIT_V(2); PG8_BAR;
        PG8_STAGE(PG8_SB(1, 0), cB + kstep, voffB); PG8_STAGE(PG8_SA(1, 0), cA + kstep, voffA); PG8_STAGE(PG8_SB(1, 1), cB + hstep + kstep, voffB);
        PG8_WAIT_V(6); PG8_BAR;
    } else {
        PG8_STAGE(PG8_SB(0, 0), cB, voffB); PG8_STAGE(PG8_SA(0, 0), cA, voffA); PG8_STAGE(PG8_SB(0, 1), cB + hstep, voffB); PG8_STAGE(PG8_SA(0, 1), cA + hstep, voffA);
        if (wr == 1) PG8_BAR;
        PG8_WAIT_V(4); PG8_BAR;
        PG8_STAGE(PG8_SB(1, 0), cB + kstep, voffB); PG8_STAGE(PG8_SA(1, 0), cA + kstep, voffA); PG8_STAGE(PG8_SB(1, 1), cB + hstep + kstep, voffB);
        PG8_WAIT_V(6); PG8_BAR;
    }
    for (;;) {
        const bool has_next = S.next(ui + 1, nxt);
        const char* nA = has_next ? (const char*)g.A + (size_t)nxt.pm * tstep : cA; const char* nB = has_next ? (const char*)g.Bt + (size_t)nxt.pn * tstep : cB;
        for (int t = 0; t < nt; t += 2) {
            const bool last = (t == nt - 2);
            const char* a1 = cA + (size_t)(t + 1) * kstep;
            const char* a2 = last ? nA : cA + (size_t)(t + 2) * kstep; const char* b2 = last ? nB : cB + (size_t)(t + 2) * kstep;
            const char* a3 = a2 + kstep; const char* b3 = b2 + kstep;
            if (last && has_next) S.a_ready(nxt);
            if constexpr (SP2) {
            PG8_LDB(B0, 0, 0); PG8_LDB(B1, 0, 1); PG8_SCHED; PG8_LDA(At, 0, 0); PG8_STAGE(PG8_SA(1, 1), a1 + hstep, voffA);
            PG8_WAIT_V(8); PG8_WAIT_L(0); PG8_BAR; PG8_MMA(0, 0, At, B0); PG8_MMA(0, 1, At, B1); PG8_BAR; PG8_SCHED;
            PG8_LDA(At, 0, 1); PG8_STAGE(PG8_SB(0, 0), b2, voffB); PG8_STAGE(PG8_SB(0, 1), b2 + hstep, voffB); PG8_STAGE(PG8_SA(0, 0), a2, voffA);
            PG8_WAIT_V(8); PG8_WAIT_L(0); PG8_BAR; PG8_MMA(1, 0, At, B0); PG8_MMA(1, 1, At, B1); PG8_BAR; PG8_SCHED;
            PG8_LDB(B0, 1, 0); PG8_LDB(B1, 1, 1); PG8_SCHED; PG8_LDA(At, 1, 0); PG8_STAGE(PG8_SA(0, 1), a2 + hstep, voffA);
            PG8_WAIT_V(8); PG8_WAIT_L(0); PG8_BAR; PG8_MMA(0, 0, At, B0); PG8_MMA(0, 1, At, B1); PG8_BAR; PG8_SCHED;
            PG8_LDA(At, 1, 1); PG8_STAGE(PG8_SB(1, 0), b3, voffB); PG8_STAGE(PG8_SB(1, 1), b3 + hstep, voffB); PG8_STAGE(PG8_SA(1, 0), a3, voffA);
            PG8_WAIT_V(8); PG8_WAIT_L(0); PG8_BAR; PG8_MMA(1, 0, At, B0); PG8_MMA(1, 1, At, B1); PG8_BAR; PG8_SCHED;
            } else {
            PG8_LDB(B0, 0, 0); PG8_SCHED; PG8_LDA(At, 0, 0); PG8_STAGE(PG8_SA(1, 1), a1 + hstep, voffA);
            PG8_WAIT_L(8); PG8_BAR; PG8_WAIT_L(0); PG8_MMA(0, 0, At, B0); PG8_BAR; PG8_SCHED;
            PG8_LDB(B1, 0, 1); PG8_STAGE(PG8_SB(0, 0), b2, voffB);
            PG8_BAR; PG8_WAIT_L(0); PG8_MMA(0, 1, At, B1); PG8_BAR;
            PG8_LDA(At, 0, 1); PG8_STAGE(PG8_SA(0, 0), a2, voffA);
            PG8_BAR; PG8_WAIT_L(0); PG8_MMA(1, 0, At, B0); PG8_BAR; PG8_SCHED;
            PG8_STAGE(PG8_SB(0, 1), b2 + hstep, voffB);
            PG8_WAIT_V(6); PG8_BAR; PG8_MMA(1, 1, At, B1); PG8_BAR;
            PG8_LDB(B0, 1, 0); PG8_SCHED; PG8_LDA(At, 1, 0); PG8_STAGE(PG8_SA(0, 1), a2 + hstep, voffA);
            PG8_WAIT_L(8); PG8_BAR; PG8_WAIT_L(0); PG8_MMA(0, 0, At, B0); PG8_BAR; PG8_SCHED;
            PG8_LDB(B1, 1, 1); PG8_STAGE(PG8_SB(1, 0), b3, voffB);
            PG8_BAR; PG8_WAIT_L(0); PG8_MMA(0, 1, At, B1); PG8_BAR;
            PG8_LDA(At, 1, 1); PG8_STAGE(PG8_SA(1, 0), a3, voffA);
            PG8_BAR; PG8_WAIT_L(0); PG8_MMA(1, 0, At, B0); PG8_BAR; PG8_SCHED;
            PG8_STAGE(PG8_SB(1, 1), b3 + hstep, voffB);
            PG8_WAIT_V(6); PG8_BAR; PG8_MMA(1, 1, At, B1); PG8_BAR;
            }
        }
        if constexpr (ALIGN_EPI) { if (wr == 0) PG8_BAR; }
        PG8_MFMA_DRAIN();
        if constexpr (!Epi::AFTER_DRAIN) { E(acc, cur, wr, wc, fr, fq); S.done(cur); }
        if (!has_next) break;
#pragma unroll
        for (int a = 0; a < 2; ++a)
#pragma unroll
            for (int b = 0; b < 2; ++b)
#pragma unroll
                for (int m = 0; m < 4; ++m)
#pragma unroll
                    for (int n = 0; n < 2; ++n) acc[a][b][m][n] = (f32x4){0.f, 0.f, 0.f, 0.f};
        cur = nxt; cA = nA; cB = nB; ++ui;
        if constexpr (ALIGN_EPI) { if (wr == 1) PG8_BAR; }
    }
    PG8_WAIT_V(0);
    if constexpr (!ALIGN_EPI) { if (wr == 0) PG8_BAR; }
    PG8_BAR;
    if constexpr (Epi::AFTER_DRAIN) { E.fused(acc, cur, wr, wc, fr, fq, lds, wid, lane); S.done(cur); }
#undef PG8_SA
#undef PG8_SB
#undef PG8_STAGE
#undef PG8_LDA
#undef PG8_LDB
#undef PG8_MMA
#undef PG8_MFMA_DRAIN
#undef PG8_WAIT_V
#undef PG8_WAIT_L
#undef PG8_BAR
#undef PG8_SCHED
}
}

#ifndef FAST_GEMM
#define FAST_GEMM 1
#endif
template <bool F8 = false, class E8>
__device__ __forceinline__ void gemm_any(const void* A, const void* Bt, int M, int N, int K, const E8& E, float* lds, int bid, int nb) {
#if FAST_GEMM
  pg8::Gemm g{(const bf16_t*)A, (const bf16_t*)Bt, M, N, F8 ? K / 2 : K}; pg8::StaticOrder S; S.init(M, N, nb, bid);
  pg8::EpiA<E8> EA{E};
  pg8::gemm_phase<pg8::EpiA<E8>, pg8::StaticOrder, true, true, F8>((PG8_LAS unsigned char*)lds, g, S, EA);
#else
  gemm_naive((const bf16_t*)A, (const bf16_t*)Bt, M, N, K, E, lds, bid, nb);
#endif
}

__device__ void gla_naive(const Params& p, const WS& w, int b, int h, float* lds) {
  constexpr int CH = 16;
  const int tid = tidx(), dv = tid & 255, half = tid >> 8, wave = tid >> 6, lane = tid & 63;
  float* qf = lds; float* kf = qf + CH * 128; float* af = kf + CH * 128; float* vf = af + CH * 128; float* op = vf + CH * 256;
  float S[64];
#pragma unroll
  for (int i = 0; i < 64; ++i) S[i] = 0.f;
  const int gd = tid & 127;
  float gu[16];
#pragma unroll
  for (int r = 0; r < 16; ++r) gu[r] = p.gate_up[r * 512 + h * 128 + gd];
  const float gb = p.gate_bias[h * 128 + gd];
  const float qscale = 0.08838834764831845f;
  for (int t0 = 0; t0 < SEQ; t0 += CH) {
    const size_t tb = (size_t)b * SEQ + t0;
    { const int tok = tid >> 5, d4 = (tid & 31) * 4;
      const uint2 qv = *(const uint2*)(w.proj + (tb + tok) * NPROJ + C_GQ + h * 128 + d4);
      const uint2 kv = *(const uint2*)(w.proj + (tb + tok) * NPROJ + C_GK + h * 128 + d4);
      *(float4*)(qf + tok * 128 + d4) = make_float4(lo_f(qv.x) * qscale, hi_f(qv.x) * qscale, lo_f(qv.y) * qscale, hi_f(qv.y) * qscale);
      *(float4*)(kf + tok * 128 + d4) = make_float4(lo_f(kv.x), hi_f(kv.x), lo_f(kv.y), hi_f(kv.y)); }
    { const int dvv = tid & 255, tk8 = (tid >> 8) * 8; float f[8];
      unpack8(*(const uint4*)(w.vT + (size_t)(h * 256 + dvv) * T + tb + tk8), f);
#pragma unroll
      for (int j = 0; j < 8; ++j) vf[(tk8 + j) * 256 + dvv] = f[j]; }
#pragma unroll
    for (int i = 0; i < 4; ++i) { const int tok = (tid >> 7) * 4 + i; float z = gb; float gl[16];
      unpack8(*(const uint4*)(w.proj + (tb + tok) * NPROJ + C_SM), gl); unpack8(*(const uint4*)(w.proj + (tb + tok) * NPROJ + C_SM + 8), gl + 8);
#pragma unroll
      for (int r = 0; r < 16; ++r) z += gl[r] * gu[r];
      af[tok * 128 + gd] = __expf(logsigmoidf_(z) * (1.f / 16.f)); }
    __syncthreads();
    for (int tok = 0; tok < CH; ++tok) {
      const float vv = vf[tok * 256 + dv]; float acc = 0.f;
#pragma unroll
      for (int i4 = 0; i4 < 16; ++i4) {
        const float4 a = *(const float4*)(af + tok * 128 + half * 64 + i4 * 4), k = *(const float4*)(kf + tok * 128 + half * 64 + i4 * 4), q = *(const float4*)(qf + tok * 128 + half * 64 + i4 * 4);
        S[i4 * 4 + 0] = a.x * S[i4 * 4 + 0] + k.x * vv; acc += q.x * S[i4 * 4 + 0];
        S[i4 * 4 + 1] = a.y * S[i4 * 4 + 1] + k.y * vv; acc += q.y * S[i4 * 4 + 1];
        S[i4 * 4 + 2] = a.z * S[i4 * 4 + 2] + k.z * vv; acc += q.z * S[i4 * 4 + 2];
        S[i4 * 4 + 3] = a.w * S[i4 * 4 + 3] + k.w * vv; acc += q.w * S[i4 * 4 + 3];
      }
      op[(half * CH + tok) * 256 + dv] = acc;
    }
    __syncthreads();
#pragma unroll
    for (int i = 0; i < 2; ++i) { const int tok = wave * 2 + i;
      const float4 o0 = *(const float4*)(op + tok * 256 + lane * 4), o1 = *(const float4*)(op + (CH + tok) * 256 + lane * 4);
      const float o[4] = {o0.x + o1.x, o0.y + o1.y, o0.z + o1.z, o0.w + o1.w};
      float ss = wave_sum(o[0] * o[0] + o[1] * o[1] + o[2] * o[2] + o[3] * o[3]);
      const float rs = rsqrtf(ss * (1.f / 256.f) + EPS);
      const uint2 gg = *(const uint2*)(w.proj + (tb + tok) * NPROJ + C_GG + h * 256 + lane * 4);
      const float4 gn = *(const float4*)(p.gla_norm + h * 256 + lane * 4);
      const float y0 = o[0] * rs * gn.x * siluf_(lo_f(gg.x)), y1 = o[1] * rs * gn.y * siluf_(hi_f(gg.x)), y2 = o[2] * rs * gn.z * siluf_(lo_f(gg.y)), y3 = o[3] * rs * gn.w * siluf_(hi_f(gg.y));
      *(uint2*)(w.y + (tb + tok) * D + h * 256 + lane * 4) = make_uint2(pack2(y0, y1), pack2(y2, y3)); }
    __syncthreads();
  }
}
__device__ void mlstm_naive(const Params& p, const WS& w, int b, int h, float* lds) {
  constexpr int CH = 16;
  const int tid = tidx(), dv = tid & 255, half = tid >> 8, wave = tid >> 6, lane = tid & 63;
  float* qf = lds; float* kf = qf + CH * 128; float* vf = kf + CH * 128; float* op = vf + CH * 256; float* dn = op + 2 * CH * 256; float* gt = dn + 2 * CH * 256;
  float C[64], n[4];
#pragma unroll
  for (int i = 0; i < 64; ++i) C[i] = 0.f;
#pragma unroll
  for (int i = 0; i < 4; ++i) n[i] = 0.f;
  const int nd = half * 64 + (dv & 15) * 4;
  const float kscale = 0.08838834764831845f;
  const float ib = p.ig_bias[h], fb = p.fg_bias[h];
  for (int t0 = 0; t0 < SEQ; t0 += CH) {
    const size_t tb = (size_t)b * SEQ + t0;
    { const int tok = tid >> 5, d4 = (tid & 31) * 4;
      float qa[4], ka[4];
#pragma unroll
      for (int c = 0; c < 4; ++c) { qa[c] = p.conv_b[h * 128 + d4 + c]; ka[c] = p.conv_b[512 + h * 128 + d4 + c]; }
#pragma unroll
      for (int wi = 0; wi < 4; ++wi) { const int ts = t0 + tok - 3 + wi;
        if (ts >= 0) { const size_t tr = (size_t)b * SEQ + ts;
          const uint2 qv = *(const uint2*)(w.proj + tr * NPROJ + C_MQ + h * 128 + d4), kv = *(const uint2*)(w.proj + tr * NPROJ + C_MK + h * 128 + d4);
          const float4 cq = *(const float4*)(p.conv_w + wi * 1024 + h * 128 + d4), ck = *(const float4*)(p.conv_w + wi * 1024 + 512 + h * 128 + d4);
          qa[0] += cq.x * lo_f(qv.x); qa[1] += cq.y * hi_f(qv.x); qa[2] += cq.z * lo_f(qv.y); qa[3] += cq.w * hi_f(qv.y);
          ka[0] += ck.x * lo_f(kv.x); ka[1] += ck.y * hi_f(kv.x); ka[2] += ck.z * lo_f(kv.y); ka[3] += ck.w * hi_f(kv.y); } }
      *(float4*)(qf + tok * 128 + d4) = make_float4(siluf_(qa[0]), siluf_(qa[1]), siluf_(qa[2]), siluf_(qa[3]));
      *(float4*)(kf + tok * 128 + d4) = make_float4(siluf_(ka[0]) * kscale, siluf_(ka[1]) * kscale, siluf_(ka[2]) * kscale, siluf_(ka[3]) * kscale); }
    { const int dvv = tid & 255, tk8 = (tid >> 8) * 8; float f[8];
      unpack8(*(const uint4*)(w.vT + (size_t)(1024 + h * 256 + dvv) * T + tb + tk8), f);
#pragma unroll
      for (int j = 0; j < 8; ++j) vf[(tk8 + j) * 256 + dvv] = f[j]; }
    if (tid < CH) { const float mi = bf2f(w.proj[(tb + tid) * NPROJ + C_SM + 16 + h]), mf = bf2f(w.proj[(tb + tid) * NPROJ + C_SM + 20 + h]);
      gt[tid * 2] = __expf(mi + ib); gt[tid * 2 + 1] = sigmoidf_(mf + fb); }
    __syncthreads();
    for (int tok = 0; tok < CH; ++tok) {
      const float vv = vf[tok * 256 + dv], ig = gt[tok * 2], fg = gt[tok * 2 + 1]; float num = 0.f, den = 0.f;
#pragma unroll
      for (int i4 = 0; i4 < 16; ++i4) {
        const float4 k = *(const float4*)(kf + tok * 128 + half * 64 + i4 * 4), q = *(const float4*)(qf + tok * 128 + half * 64 + i4 * 4);
        const float kk[4] = {k.x * ig, k.y * ig, k.z * ig, k.w * ig}; const float qq[4] = {q.x, q.y, q.z, q.w};
#pragma unroll
        for (int c = 0; c < 4; ++c) { C[i4 * 4 + c] = fg * C[i4 * 4 + c] + kk[c] * vv; num += qq[c] * C[i4 * 4 + c]; }
      }
      { const float4 k = *(const float4*)(kf + tok * 128 + nd), q = *(const float4*)(qf + tok * 128 + nd);
        n[0] = fg * n[0] + k.x * ig; n[1] = fg * n[1] + k.y * ig; n[2] = fg * n[2] + k.z * ig; n[3] = fg * n[3] + k.w * ig;
        den = q.x * n[0] + q.y * n[1] + q.z * n[2] + q.w * n[3];
        den = gsum<16>(den); }
      op[(half * CH + tok) * 256 + dv] = num; if (dv == 0) dn[half * CH + tok] = den;
    }
    __syncthreads();
#pragma unroll
    for (int i = 0; i < 2; ++i) { const int tok = wave * 2 + i;
      const float4 o0 = *(const float4*)(op + tok * 256 + lane * 4), o1 = *(const float4*)(op + (CH + tok) * 256 + lane * 4);
      const float den = dn[tok] + dn[CH + tok];
      const float inv = 1.f / fmaxf(fabsf(den), 1.f);
      const float o[4] = {(o0.x + o1.x) * inv, (o0.y + o1.y) * inv, (o0.z + o1.z) * inv, (o0.w + o1.w) * inv};
      float ss = wave_sum(o[0] * o[0] + o[1] * o[1] + o[2] * o[2] + o[3] * o[3]);
      const float rs = rsqrtf(ss * (1.f / 256.f) + EPS);
      const uint2 mo = *(const uint2*)(w.proj + (tb + tok) * NPROJ + C_MO + h * 256 + lane * 4);
      const float4 gn = *(const float4*)(p.mlstm_norm + h * 256 + lane * 4);
      const float y0 = o[0] * rs * gn.x * sigmoidf_(lo_f(mo.x)), y1 = o[1] * rs * gn.y * sigmoidf_(hi_f(mo.x)), y2 = o[2] * rs * gn.z * sigmoidf_(lo_f(mo.y)), y3 = o[3] * rs * gn.w * sigmoidf_(hi_f(mo.y));
      *(uint2*)(w.y + (tb + tok) * D + 1024 + h * 256 + lane * 4) = make_uint2(pack2(y0, y1), pack2(y2, y3)); }
    __syncthreads();
  }
}
__device__ void phase_mixer_naive(const Params& p, const WS& w, float* lds, int bid, int nb) {
  for (int item = bid; item < 16; item += nb) {
    if (item < 8) gla_naive(p, w, item >> 2, item & 3, lds); else mlstm_naive(p, w, (item - 8) >> 2, item & 3, lds);
    __syncthreads();
  }
}


typedef short bf16x8 __attribute__((ext_vector_type(8)));
typedef float f32x4 __attribute__((ext_vector_type(4)));
#define MFMA16(a, b, c) __builtin_amdgcn_mfma_f32_16x16x32_bf16(a, b, c, 0, 0, 0)
constexpr int L_GLR = 0, L_TOT = 4096, L_F = 6144, L_DEN = 6656, L_PART = 6912, L_QS = 9216, L_KS = 26624, L_P = 44032, L_NL = 53248, L_KDT = 9216;
constexpr int QS_LD = 136, P_LD = 72, KDT_LD = 72;

__device__ __forceinline__ void gla_gates(const Params& p, const WS& w, int h, size_t tb, unsigned char* ldsb, int tid, float* bv, float& blast) {
  float* glrs = (float*)(ldsb + L_GLR); float* tot = (float*)(ldsb + L_TOT);
  const int d = tid & 127, tg = tid >> 7;
  if (tid < 128) { float f[8]; unpack8(*(const uint4*)(w.proj + (tb + (tid >> 1)) * NPROJ + C_SM + (tid & 1) * 8), f);
#pragma unroll
    for (int j = 0; j < 8; ++j) glrs[(tid >> 1) * 16 + (tid & 1) * 8 + j] = f[j]; }
  float gu[16];
#pragma unroll
  for (int r = 0; r < 16; ++r) gu[r] = p.gate_up[r * 512 + h * 128 + d];
  const float gb = p.gate_bias[h * 128 + d];
  __syncthreads();
  float run = 0.f;
#pragma unroll
  for (int i = 0; i < 16; ++i) { const float* gl = glrs + (tg * 16 + i) * 16; float z = gb;
#pragma unroll
    for (int r4 = 0; r4 < 4; ++r4) { const float4 g4 = *(const float4*)(gl + r4 * 4); z += g4.x * gu[r4 * 4] + g4.y * gu[r4 * 4 + 1] + g4.z * gu[r4 * 4 + 2] + g4.w * gu[r4 * 4 + 3]; }
    run += logsigmoidf_(z) * (1.f / 16.f); bv[i] = run; }
  tot[tg * 128 + d] = run;
  __syncthreads();
  float off = 0.f; blast = 0.f;
#pragma unroll
  for (int g = 0; g < 4; ++g) { const float t = tot[g * 128 + d]; blast += t; if (g < tg) off += t; }
#pragma unroll
  for (int i = 0; i < 16; ++i) bv[i] += off;
}
__device__ __forceinline__ void mlstm_gates(const Params& p, const WS& w, int h, size_t tb, unsigned char* ldsb, int tid) {
  float* Fl = (float*)(ldsb + L_F);
  if (tid < 64) { const float mi = bf2f(w.proj[(tb + tid) * NPROJ + C_SM + 16 + h]), mf = bf2f(w.proj[(tb + tid) * NPROJ + C_SM + 20 + h]);
    float f = logsigmoidf_(mf + p.fg_bias[h]);
#pragma unroll
    for (int o = 1; o < 64; o <<= 1) { const float t = bperm(f, tid - o); if (tid >= o) f += t; }
    Fl[tid] = f; Fl[64 + tid] = mi + p.ig_bias[h]; }
  __syncthreads();
}
__device__ __forceinline__ void conv_load(const WS& w, int col, int b, int c, int tg, bf16_t* win) {
  const int s0 = c * 64 + tg * 16 - 3;
#pragma unroll
  for (int m = 0; m < 19; ++m) { const int sp = s0 + m; win[m] = (sp >= 0) ? w.proj[((size_t)b * SEQ + sp) * NPROJ + col] : (bf16_t)0; }
}
__device__ __forceinline__ void conv_apply(const Params& p, const bf16_t* win, int cch, float scale, float* out) {
  const float c0 = p.conv_w[cch], c1 = p.conv_w[1024 + cch], c2 = p.conv_w[2048 + cch], c3 = p.conv_w[3072 + cch], cb = p.conv_b[cch];
#pragma unroll
  for (int i = 0; i < 16; ++i) out[i] = siluf_(cb + c0 * bf2f(win[i]) + c1 * bf2f(win[i + 1]) + c2 * bf2f(win[i + 2]) + c3 * bf2f(win[i + 3])) * scale;
}

template <int KIND>
__device__ void mix_local(const Params& p, const WS& w, int b, int h, int c, int item, unsigned char* ldsb) {
  const int tid = tidx(), lane = tid & 63, wave = tid >> 6, fr = lane & 15, fq = lane >> 4, d = tid & 127, tg = tid >> 7;
  const size_t tb = (size_t)b * SEQ + (size_t)c * 64;
  float* tot = (float*)(ldsb + L_TOT); const float* Fl = (const float*)(ldsb + L_F);
  bf16_t* kdT = (bf16_t*)(ldsb + L_KDT);
  const bf16_t* vrow = w.vT + (size_t)(KIND * 1024 + h * 256 + wave * 32 + fr) * T + tb + fq * 8;
  bf16x8 yv[2][2];
#pragma unroll
  for (int ks = 0; ks < 2; ++ks) { yv[ks][0] = *(const bf16x8*)(vrow + ks * 32); yv[ks][1] = *(const bf16x8*)(vrow + (size_t)16 * T + ks * 32); }
  bf16_t kraw[19];
  if (KIND == 0) {
#pragma unroll
    for (int i = 0; i < 16; ++i) kraw[i] = w.proj[(tb + tg * 16 + i) * NPROJ + C_GK + h * 128 + d];
  } else conv_load(w, C_MK + h * 128 + d, b, c, tg, kraw);
  float wgt[16], kv[16];
  if (KIND == 0) {
    float bv[16], blast; gla_gates(p, w, h, tb, ldsb, tid, bv, blast);
#pragma unroll
    for (int i = 0; i < 16; ++i) { wgt[i] = __expf(blast - bv[i]); kv[i] = bf2f(kraw[i]); }
    if (tg == 0) w.gdec[(size_t)item * 128 + d] = __expf(blast);
  } else {
    mlstm_gates(p, w, h, tb, ldsb, tid);
    const float flast = Fl[63];
#pragma unroll
    for (int i = 0; i < 16; ++i) wgt[i] = __expf(flast - Fl[tg * 16 + i] + Fl[64 + tg * 16 + i]);
    conv_apply(p, kraw, 512 + h * 128 + d, 0.08838834764831845f, kv);
    if (tid == 0) w.mdec[item - 2048] = __expf(flast);
  }
  float un = 0.f; float kd[16];
#pragma unroll
  for (int i = 0; i < 16; ++i) { kd[i] = kv[i] * wgt[i]; un += kd[i]; }
  *(uint4*)(kdT + d * KDT_LD + tg * 16) = pack8(kd); *(uint4*)(kdT + d * KDT_LD + tg * 16 + 8) = pack8(kd + 8);
  if (KIND == 1) tot[tg * 128 + d] = un;
  __syncthreads();
  if (KIND == 1 && tg == 0) w.mn[(size_t)(item - 2048) * 128 + d] = tot[d] + tot[128 + d] + tot[256 + d] + tot[384 + d];
  f32x4 acc[2][8];
#pragma unroll
  for (int yt = 0; yt < 2; ++yt)
#pragma unroll
    for (int xt = 0; xt < 8; ++xt) acc[yt][xt] = (f32x4){0.f, 0.f, 0.f, 0.f};
#pragma unroll
  for (int ks = 0; ks < 2; ++ks) {
#pragma unroll
    for (int xt = 0; xt < 8; ++xt) { const bf16x8 xk = *(const bf16x8*)(kdT + (xt * 16 + fr) * KDT_LD + ks * 32 + fq * 8);
      acc[0][xt] = MFMA16(xk, yv[ks][0], acc[0][xt]); acc[1][xt] = MFMA16(xk, yv[ks][1], acc[1][xt]); }
  }
  bf16_t* S = (bf16_t*)p.out + (size_t)item * 32768;
#pragma unroll
  for (int yt = 0; yt < 2; ++yt)
#pragma unroll
    for (int xt = 0; xt < 8; ++xt) *(uint2*)(S + (wave * 32 + yt * 16 + fr) * 128 + xt * 16 + 4 * fq) = make_uint2(pack2(acc[yt][xt][0], acc[yt][xt][1]), pack2(acc[yt][xt][2], acc[yt][xt][3]));
  __syncthreads();
}

__device__ void mix_scan(const Params& p, const WS& w, float* lds, int bid, int nb) {
  bf16_t* sbuf = (bf16_t*)p.out;
  const int tid = tidx();
  for (int g0 = bid * 512; g0 < 16 * 8192; g0 += nb * 512) {
    const int g = g0 + tid, combo = g0 >> 13, e = (g & 8191) * 4, dk = e & 127;
    __syncthreads();
    if (combo < 8) { const float4* src = (const float4*)(w.gdec + (size_t)combo * 32768);
#pragma unroll
      for (int i = 0; i < 16; ++i) ((float4*)lds)[i * 512 + tid] = src[i * 512 + tid]; }
    else if (tid < 256) lds[tid] = w.mdec[(combo - 8) * 256 + tid];
    __syncthreads();
    bf16_t* base = sbuf + (size_t)combo * 256 * 32768 + e;
    float S0 = 0.f, S1 = 0.f, S2 = 0.f, S3 = 0.f;
    for (int c0 = 0; c0 < 256; c0 += 16) {
      uint2 u[16];
#pragma unroll
      for (int k = 0; k < 16; ++k) u[k] = *(const uint2*)(base + (size_t)(c0 + k) * 32768);
#pragma unroll
      for (int k = 0; k < 16; ++k) { float4 dc; if (combo < 8) dc = *(const float4*)(lds + (c0 + k) * 128 + dk); else { const float m = lds[c0 + k]; dc = make_float4(m, m, m, m); }
        *(uint2*)(base + (size_t)(c0 + k) * 32768) = make_uint2(pack2(S0, S1), pack2(S2, S3));
        S0 = dc.x * S0 + lo_f(u[k].x); S1 = dc.y * S1 + hi_f(u[k].x); S2 = dc.z * S2 + lo_f(u[k].y); S3 = dc.w * S3 + hi_f(u[k].y); }
    }
  }
  for (int g = bid * 512 + tid; g < 8 * 128; g += nb * 512) {
    const int cb = g >> 7, d = g & 127; float n = 0.f;
    for (int c = 0; c < 256; ++c) { float* q = w.mn + (size_t)(cb * 256 + c) * 128 + d; const float u = *q; *q = n; n = w.mdec[cb * 256 + c] * n + u; }
  }
}

template <int KIND>
__device__ void mix_out(const Params& p, const WS& w, int b, int h, int c, int item, unsigned char* ldsb) {
  const int tid = tidx(), lane = tid & 63, wave = tid >> 6, fr = lane & 15, fq = lane >> 4, d = tid & 127, tg = tid >> 7;
  const size_t tb = (size_t)b * SEQ + (size_t)c * 64;
  const float* Fl = (const float*)(ldsb + L_F); float* denl = (float*)(ldsb + L_DEN); float* part = (float*)(ldsb + L_PART); float* nl = (float*)(ldsb + L_NL);
  bf16_t* qs = (bf16_t*)(ldsb + L_QS); bf16_t* ks = (bf16_t*)(ldsb + L_KS); bf16_t* P = (bf16_t*)(ldsb + L_P);
  bf16x8 vx[2][2], sx[4][2];
  { const bf16_t* vrow = w.vT + (size_t)(KIND * 1024 + h * 256 + wave * 32 + fr) * T + tb + fq * 8;
#pragma unroll
    for (int k2 = 0; k2 < 2; ++k2) { vx[k2][0] = *(const bf16x8*)(vrow + k2 * 32); vx[k2][1] = *(const bf16x8*)(vrow + (size_t)16 * T + k2 * 32); }
    const bf16_t* srow = (const bf16_t*)p.out + (size_t)item * 32768 + (wave * 32 + fr) * 128 + fq * 8;
#pragma unroll
    for (int k4 = 0; k4 < 4; ++k4) { sx[k4][0] = *(const bf16x8*)(srow + k4 * 32); sx[k4][1] = *(const bf16x8*)(srow + 16 * 128 + k4 * 32); } }
  uint2 gt[4][2];
#pragma unroll
  for (int yt = 0; yt < 4; ++yt)
#pragma unroll
    for (int xt = 0; xt < 2; ++xt) gt[yt][xt] = *(const uint2*)(w.proj + (tb + yt * 16 + fr) * NPROJ + (KIND == 0 ? C_GG : C_MO) + h * 256 + wave * 32 + xt * 16 + 4 * fq);
  const float* gain = (KIND == 0 ? p.gla_norm : p.mlstm_norm) + h * 256;
  const float4 gn0 = *(const float4*)(gain + wave * 32 + 4 * fq), gn1 = *(const float4*)(gain + wave * 32 + 16 + 4 * fq);
  bf16_t qraw[19], kraw[19];
  if (KIND == 0) {
#pragma unroll
    for (int i = 0; i < 16; ++i) { qraw[i] = w.proj[(tb + tg * 16 + i) * NPROJ + C_GQ + h * 128 + d]; kraw[i] = w.proj[(tb + tg * 16 + i) * NPROJ + C_GK + h * 128 + d]; }
  } else { conv_load(w, C_MQ + h * 128 + d, b, c, tg, qraw); conv_load(w, C_MK + h * 128 + d, b, c, tg, kraw); }
  float nlv = 0.f;
  if (KIND == 1 && tid < 128) nlv = w.mn[(size_t)(item - 2048) * 128 + tid];
  {
    float qm[16], km[16], qv[16], kv[16];
    if (KIND == 0) {
      float bv[16], blast; gla_gates(p, w, h, tb, ldsb, tid, bv, blast);
#pragma unroll
      for (int i = 0; i < 16; ++i) { qm[i] = 0.08838834764831845f * __expf(bv[i]); km[i] = __expf(-bv[i]); qv[i] = bf2f(qraw[i]); kv[i] = bf2f(kraw[i]); }
    } else {
      mlstm_gates(p, w, h, tb, ldsb, tid);
#pragma unroll
      for (int i = 0; i < 16; ++i) { const float F = Fl[tg * 16 + i]; qm[i] = __expf(F); km[i] = __expf(Fl[64 + tg * 16 + i] - F); }
      conv_apply(p, qraw, h * 128 + d, 1.f, qv);
      conv_apply(p, kraw, 512 + h * 128 + d, 0.08838834764831845f, kv);
      if (tid < 128) nl[tid] = nlv;
    }
#pragma unroll
    for (int i = 0; i < 16; ++i) { qs[(tg * 16 + i) * QS_LD + d] = f2bf(qv[i] * qm[i]); ks[(tg * 16 + i) * QS_LD + d] = f2bf(kv[i] * km[i]); }
  }
  __syncthreads();
#pragma unroll
  for (int q = 0; q < 2; ++q) { const int tt = wave * 2 + q, jt = tt >> 2, it = tt & 3; f32x4 a = (f32x4){0.f, 0.f, 0.f, 0.f};
#pragma unroll
    for (int k4 = 0; k4 < 4; ++k4) { const bf16x8 xk = *(const bf16x8*)(ks + (jt * 16 + fr) * QS_LD + k4 * 32 + fq * 8), yq = *(const bf16x8*)(qs + (it * 16 + fr) * QS_LD + k4 * 32 + fq * 8); a = MFMA16(xk, yq, a); }
    const int i = it * 16 + fr, j0 = jt * 16 + 4 * fq;
    const float v0 = (j0 <= i) ? a[0] : 0.f, v1 = (j0 + 1 <= i) ? a[1] : 0.f, v2 = (j0 + 2 <= i) ? a[2] : 0.f, v3 = (j0 + 3 <= i) ? a[3] : 0.f;
    *(uint2*)(P + i * P_LD + j0) = make_uint2(pack2(v0, v1), pack2(v2, v3)); }
  __syncthreads();
  if (KIND == 1) { const int i = tid >> 3, pt = tid & 7; float f[8]; float s = 0.f;
    unpack8(*(const uint4*)(P + i * P_LD + pt * 8), f);
#pragma unroll
    for (int j = 0; j < 8; ++j) s += f[j];
#pragma unroll
    for (int hh = 0; hh < 2; ++hh) { unpack8(*(const uint4*)(qs + i * QS_LD + pt * 16 + hh * 8), f);
#pragma unroll
      for (int j = 0; j < 8; ++j) s += f[j] * nl[pt * 16 + hh * 8 + j]; }
    s = gsum<8>(s);
    if (pt == 0) denl[i] = s; }
  f32x4 acc[2][4];
#pragma unroll
  for (int xt = 0; xt < 2; ++xt)
#pragma unroll
    for (int yt = 0; yt < 4; ++yt) acc[xt][yt] = (f32x4){0.f, 0.f, 0.f, 0.f};
#pragma unroll
  for (int k2 = 0; k2 < 2; ++k2)
#pragma unroll
    for (int yt = 0; yt < 4; ++yt) { const bf16x8 yp = *(const bf16x8*)(P + (yt * 16 + fr) * P_LD + k2 * 32 + fq * 8); acc[0][yt] = MFMA16(vx[k2][0], yp, acc[0][yt]); acc[1][yt] = MFMA16(vx[k2][1], yp, acc[1][yt]); }
#pragma unroll
  for (int k4 = 0; k4 < 4; ++k4)
#pragma unroll
    for (int yt = 0; yt < 4; ++yt) { const bf16x8 yq = *(const bf16x8*)(qs + (yt * 16 + fr) * QS_LD + k4 * 32 + fq * 8); acc[0][yt] = MFMA16(sx[k4][0], yq, acc[0][yt]); acc[1][yt] = MFMA16(sx[k4][1], yq, acc[1][yt]); }
  if (KIND == 1) __syncthreads();
#pragma unroll
  for (int yt = 0; yt < 4; ++yt) { float s = 0.f;
    if (KIND == 1) { const float inv = 1.f / fmaxf(fabsf(denl[yt * 16 + fr]), 1.f); acc[0][yt] *= inv; acc[1][yt] *= inv; }
#pragma unroll
    for (int xt = 0; xt < 2; ++xt)
#pragma unroll
      for (int r = 0; r < 4; ++r) s += acc[xt][yt][r] * acc[xt][yt][r];
    s += sxor<16>(s); s += sxor<32>(s);
    if (fq == 0) part[wave * 64 + yt * 16 + fr] = s; }
  __syncthreads();
#pragma unroll
  for (int yt = 0; yt < 4; ++yt) { const int i = yt * 16 + fr; float t = 0.f;
#pragma unroll
    for (int ww = 0; ww < 8; ++ww) t += part[ww * 64 + i];
    const float rs = rsqrtf(t * (1.f / 256.f) + EPS);
#pragma unroll
    for (int xt = 0; xt < 2; ++xt) { const int dv = wave * 32 + xt * 16 + 4 * fq;
      const float4 gn = xt == 0 ? gn0 : gn1; const uint2 g2 = gt[yt][xt];
      const float g0 = lo_f(g2.x), g1 = hi_f(g2.x), g2f = lo_f(g2.y), g3 = hi_f(g2.y);
      const float a0 = KIND == 0 ? siluf_(g0) : sigmoidf_(g0), a1 = KIND == 0 ? siluf_(g1) : sigmoidf_(g1), a2 = KIND == 0 ? siluf_(g2f) : sigmoidf_(g2f), a3 = KIND == 0 ? siluf_(g3) : sigmoidf_(g3);
      const float y0 = acc[xt][yt][0] * rs * gn.x * a0, y1 = acc[xt][yt][1] * rs * gn.y * a1, y2 = acc[xt][yt][2] * rs * gn.z * a2, y3 = acc[xt][yt][3] * rs * gn.w * a3;
#if F8_OUT
      *(unsigned*)(w.yq + (tb + i) * D + KIND * 1024 + h * 256 + dv) = pack4_fp8(y0, y1, y2, y3);
#else
      *(uint2*)(w.y + (tb + i) * D + KIND * 1024 + h * 256 + dv) = make_uint2(pack2(y0, y1), pack2(y2, y3));
#endif
    } }
  __syncthreads();
}
__device__ __forceinline__ void mix_out3_fetch(const WS& w, int item, int tid, uint4& tq0, uint4& tq1, uint4& tk0, uint4& tk1, float& nlv) {
  const int kind = item >> 11, b = (item >> 10) & 1, h = (item >> 8) & 3, c = item & 255;
  const size_t tb = (size_t)b * SEQ + (size_t)c * 64;
  const bf16_t* gq = w.qs + tb * 1024 + kind * 512 + h * 128; const bf16_t* gk = w.ks + tb * 1024 + kind * 512 + h * 128;
  const int r0 = tid >> 4, r1 = (512 + tid) >> 4, c8 = (tid & 15) * 8;
  tq0 = *(const uint4*)(gq + (size_t)r0 * 1024 + c8); tq1 = *(const uint4*)(gq + (size_t)r1 * 1024 + c8); tk0 = *(const uint4*)(gk + (size_t)r0 * 1024 + c8); tk1 = *(const uint4*)(gk + (size_t)r1 * 1024 + c8);
  if (kind == 1 && tid < 128) nlv = w.mn[(size_t)(item - 2048) * 128 + tid];
}
template <int KIND>
__device__ __forceinline__ void mix_out3(const Params& p, const WS& w, int b, int h, int c, int item, unsigned char* ldsb, uint4& tq0, uint4& tq1, uint4& tk0, uint4& tk1, float& nlv, int nitem) {
  const int tid = tidx(), lane = tid & 63, wave = tid >> 6, fr = lane & 15, fq = lane >> 4, d = tid & 127, tg = tid >> 7;
  const size_t tb = (size_t)b * SEQ + (size_t)c * 64;
  const float* Fl = (const float*)(ldsb + L_F); float* denl = (float*)(ldsb + L_DEN); float* part = (float*)(ldsb + L_PART); float* nl = (float*)(ldsb + L_NL);
  bf16_t* qs = (bf16_t*)(ldsb + L_QS); bf16_t* ks = (bf16_t*)(ldsb + L_KS); bf16_t* P = (bf16_t*)(ldsb + L_P);
  bf16x8 vx[2][2], sx[4][2];
  { const bf16_t* vrow = w.vT + (size_t)(KIND * 1024 + h * 256 + wave * 32 + fr) * T + tb + fq * 8;
#pragma unroll
    for (int k2 = 0; k2 < 2; ++k2) { vx[k2][0] = *(const bf16x8*)(vrow + k2 * 32); vx[k2][1] = *(const bf16x8*)(vrow + (size_t)16 * T + k2 * 32); }
    const bf16_t* srow = (const bf16_t*)p.out + (size_t)item * 32768 + (wave * 32 + fr) * 128 + fq * 8;
#pragma unroll
    for (int k4 = 0; k4 < 4; ++k4) { sx[k4][0] = *(const bf16x8*)(srow + k4 * 32); sx[k4][1] = *(const bf16x8*)(srow + 16 * 128 + k4 * 32); } }
  uint2 gt[4][2];
#pragma unroll
  for (int yt = 0; yt < 4; ++yt)
#pragma unroll
    for (int xt = 0; xt < 2; ++xt) gt[yt][xt] = *(const uint2*)(w.proj + (tb + yt * 16 + fr) * NPROJ + (KIND == 0 ? C_GG : C_MO) + h * 256 + wave * 32 + xt * 16 + 4 * fq);
  const float* gain = (KIND == 0 ? p.gla_norm : p.mlstm_norm) + h * 256;
  const float4 gn0 = *(const float4*)(gain + wave * 32 + 4 * fq), gn1 = *(const float4*)(gain + wave * 32 + 16 + 4 * fq);
  { const int r0 = tid >> 4, r1 = (512 + tid) >> 4, c8 = (tid & 15) * 8;
    *(uint4*)(qs + r0 * QS_LD + c8) = tq0; *(uint4*)(qs + r1 * QS_LD + c8) = tq1; *(uint4*)(ks + r0 * QS_LD + c8) = tk0; *(uint4*)(ks + r1 * QS_LD + c8) = tk1;
    if (KIND == 1 && tid < 128) nl[tid] = nlv;
    if (nitem >= 0) mix_out3_fetch(w, nitem, tid, tq0, tq1, tk0, tk1, nlv); }
  __syncthreads();
#pragma unroll
  for (int q = 0; q < 2; ++q) { const int tt = wave * 2 + q, jt = tt >> 2, it = tt & 3; f32x4 a = (f32x4){0.f, 0.f, 0.f, 0.f};
#pragma unroll
    for (int k4 = 0; k4 < 4; ++k4) { const bf16x8 xk = *(const bf16x8*)(ks + (jt * 16 + fr) * QS_LD + k4 * 32 + fq * 8), yq = *(const bf16x8*)(qs + (it * 16 + fr) * QS_LD + k4 * 32 + fq * 8); a = MFMA16(xk, yq, a); }
    const int i = it * 16 + fr, j0 = jt * 16 + 4 * fq;
    const float v0 = (j0 <= i) ? a[0] : 0.f, v1 = (j0 + 1 <= i) ? a[1] : 0.f, v2 = (j0 + 2 <= i) ? a[2] : 0.f, v3 = (j0 + 3 <= i) ? a[3] : 0.f;
    *(uint2*)(P + i * P_LD + j0) = make_uint2(pack2(v0, v1), pack2(v2, v3)); }
  __syncthreads();
  if (KIND == 1) { const int i = tid >> 3, pt = tid & 7; float f[8]; float s = 0.f;
    unpack8(*(const uint4*)(P + i * P_LD + pt * 8), f);
#pragma unroll
    for (int j = 0; j < 8; ++j) s += f[j];
#pragma unroll
    for (int hh = 0; hh < 2; ++hh) { unpack8(*(const uint4*)(qs + i * QS_LD + pt * 16 + hh * 8), f);
#pragma unroll
      for (int j = 0; j < 8; ++j) s += f[j] * nl[pt * 16 + hh * 8 + j]; }
    s = gsum<8>(s);
    if (pt == 0) denl[i] = s; }
  f32x4 acc[2][4];
#pragma unroll
  for (int xt = 0; xt < 2; ++xt)
#pragma unroll
    for (int yt = 0; yt < 4; ++yt) acc[xt][yt] = (f32x4){0.f, 0.f, 0.f, 0.f};
#pragma unroll
  for (int k2 = 0; k2 < 2; ++k2)
#pragma unroll
    for (int yt = 0; yt < 4; ++yt) { const bf16x8 yp = *(const bf16x8*)(P + (yt * 16 + fr) * P_LD + k2 * 32 + fq * 8); acc[0][yt] = MFMA16(vx[k2][0], yp, acc[0][yt]); acc[1][yt] = MFMA16(vx[k2][1], yp, acc[1][yt]); }
#pragma unroll
  for (int k4 = 0; k4 < 4; ++k4)
#pragma unroll
    for (int yt = 0; yt < 4; ++yt) { const bf16x8 yq = *(const bf16x8*)(qs + (yt * 16 + fr) * QS_LD + k4 * 32 + fq * 8); acc[0][yt] = MFMA16(sx[k4][0], yq, acc[0][yt]); acc[1][yt] = MFMA16(sx[k4][1], yq, acc[1][yt]); }
#pragma unroll
  for (int yt = 0; yt < 4; ++yt) { float s = 0.f;
#pragma unroll
    for (int xt = 0; xt < 2; ++xt)
#pragma unroll
      for (int r = 0; r < 4; ++r) s += acc[xt][yt][r] * acc[xt][yt][r];
    s += sxor<16>(s); s += sxor<32>(s);
    if (fq == 0) part[wave * 64 + yt * 16 + fr] = s; }
  __syncthreads();
#pragma unroll
  for (int yt = 0; yt < 4; ++yt) { const int i = yt * 16 + fr; float t = 0.f;
#pragma unroll
    for (int ww = 0; ww < 8; ++ww) t += part[ww * 64 + i];
    float dd = 1.f; if (KIND == 1) { dd = fmaxf(fabsf(denl[i]), 1.f); dd *= dd; }
    const float rs = rsqrtf(t * (1.f / 256.f) + EPS * dd);
#pragma unroll
    for (int xt = 0; xt < 2; ++xt) { const int dv = wave * 32 + xt * 16 + 4 * fq;
      const float4 gn = xt == 0 ? gn0 : gn1; const uint2 g2 = gt[yt][xt];
      const float g0 = lo_f(g2.x), g1 = hi_f(g2.x), g2f = lo_f(g2.y), g3 = hi_f(g2.y);
      const float a0 = KIND == 0 ? siluf_(g0) : sigmoidf_(g0), a1 = KIND == 0 ? siluf_(g1) : sigmoidf_(g1), a2 = KIND == 0 ? siluf_(g2f) : sigmoidf_(g2f), a3 = KIND == 0 ? siluf_(g3) : sigmoidf_(g3);
      const float y0 = acc[xt][yt][0] * rs * gn.x * a0, y1 = acc[xt][yt][1] * rs * gn.y * a1, y2 = acc[xt][yt][2] * rs * gn.z * a2, y3 = acc[xt][yt][3] * rs * gn.w * a3;
#if F8_OUT
      *(unsigned*)(w.yq + (tb + i) * D + KIND * 1024 + h * 256 + dv) = pack4_fp8(y0, y1, y2, y3);
#else
      *(uint2*)(w.y + (tb + i) * D + KIND * 1024 + h * 256 + dv) = make_uint2(pack2(y0, y1), pack2(y2, y3));
#endif
    } }
}

template <int WHICH>
__device__ void phase_mix_items(const Params& p, const WS& w, unsigned char* ldsb, int bid, int nb) {
  for (int item = bid; item < 4096; item += nb) {
    const int kind = item >> 11, b = (item >> 10) & 1, h = (item >> 8) & 3, c = item & 255;
    if (WHICH == 0) { if (kind == 0) mix_local<0>(p, w, b, h, c, item, ldsb); else mix_local<1>(p, w, b, h, c, item, ldsb); }
    else { if (kind == 0) mix_out<0>(p, w, b, h, c, item, ldsb); else mix_out<1>(p, w, b, h, c, item, ldsb); }
  }
}


__device__ void phase_mix_out3(const Params& p, const WS& w, unsigned char* ldsb, int bid, int nb) {
  int par = 0;
  uint4 tq0, tq1, tk0, tk1; float nlv = 0.f;
  if (bid < 4096) mix_out3_fetch(w, bid, tidx(), tq0, tq1, tk0, tk1, nlv);
  for (int item = bid; item < 4096; item += nb, par ^= 1) {
    const int kind = item >> 11, b = (item >> 10) & 1, h = (item >> 8) & 3, c = item & 255, nitem = (item + nb < 4096) ? item + nb : -1;
    if (kind == 0) mix_out3<0>(p, w, b, h, c, item, ldsb + par * 57344, tq0, tq1, tk0, tk1, nlv, nitem); else mix_out3<1>(p, w, b, h, c, item, ldsb + par * 57344, tq0, tq1, tk0, tk1, nlv, nitem);
  }
  __syncthreads();
}

__device__ void mix_gate_pass(const Params& p, const WS& w, unsigned char* ldsb, int bid, int nb) {
  const int tid = tidx(), h = tid >> 7, d = tid & 127, lane = tid & 63;
  bf16_t* qT = (bf16_t*)ldsb; bf16_t* kT = (bf16_t*)(ldsb + 65536);
  float* glrs = (float*)(ldsb + 131072); float* Fl = (float*)(ldsb + 135168);
  for (int itx = bid; itx < 1024; itx += nb) {
    const int kind = itx >> 9, b = (itx >> 8) & 1, c = itx & 255;
    const size_t tb = (size_t)b * SEQ + (size_t)c * 64;
    const int item = ((kind * 2 + b) * 4 + h) * 256 + c;
    bf16_t* kdo = w.kdT + (size_t)(kind * 512 + tid) * T + tb;
    { uint4 tq[8], tk[8];
      const unsigned char* gq = (const unsigned char*)(w.proj + tb * NPROJ + (kind == 0 ? C_GQ : C_MQ)); const unsigned char* gk = (const unsigned char*)(w.proj + tb * NPROJ + (kind == 0 ? C_GK : C_MK));
#pragma unroll
      for (int ps = 0; ps < 8; ++ps) { const int o = ps * 8192 + tid * 16; tq[ps] = *(const uint4*)(gq + (size_t)(o >> 10) * (NPROJ * 2) + (o & 1023)); tk[ps] = *(const uint4*)(gk + (size_t)(o >> 10) * (NPROJ * 2) + (o & 1023)); }
#pragma unroll
      for (int ps = 0; ps < 8; ++ps) { const int o = ps * 8192 + tid * 16; *(uint4*)(ldsb + o) = tq[ps]; *(uint4*)(ldsb + 65536 + o) = tk[ps]; } }
    if (kind == 0) {
      if (tid < 128) { float f[8]; unpack8(*(const uint4*)(w.proj + (tb + (tid >> 1)) * NPROJ + C_SM + (tid & 1) * 8), f);
#pragma unroll
        for (int j = 0; j < 8; ++j) glrs[(tid >> 1) * 16 + (tid & 1) * 8 + j] = f[j]; }
      float gu[16];
#pragma unroll
      for (int r = 0; r < 16; ++r) gu[r] = p.gate_up[r * 512 + tid];
      const float gb = p.gate_bias[tid];
      __syncthreads();
      float run = 0.f;
#pragma unroll 1
      for (int j8 = 0; j8 < 8; ++j8) { float kd[8];
#pragma unroll
        for (int e = 0; e < 8; ++e) { const int j = j8 * 8 + e; const float* gl = glrs + j * 16; float z = gb;
#pragma unroll
          for (int r4 = 0; r4 < 4; ++r4) { const float4 g4 = *(const float4*)(gl + r4 * 4); z += g4.x * gu[r4 * 4] + g4.y * gu[r4 * 4 + 1] + g4.z * gu[r4 * 4 + 2] + g4.w * gu[r4 * 4 + 3]; }
          run += logsigmoidf_(z) * (1.f / 16.f);
          const float q = bf2f(qT[j * 512 + tid]), k = bf2f(kT[j * 512 + tid]), eb = __expf(run), ks_ = k * __builtin_amdgcn_rcpf(eb);
          qT[j * 512 + tid] = f2bf(q * 0.08838834764831845f * eb); kT[j * 512 + tid] = f2bf(ks_); kd[e] = ks_; }
        *(uint4*)(kdo + j8 * 8) = pack8(kd); }
      w.gdec[(size_t)item * 128 + d] = __expf(run);
    } else {
      float q0 = 0.f, q1 = 0.f, q2 = 0.f, k0 = 0.f, k1 = 0.f, k2 = 0.f;
      if (c > 0) { const bf16_t* qp = w.proj + tb * NPROJ + C_MQ + tid; const bf16_t* kp = w.proj + tb * NPROJ + C_MK + tid;
        q0 = bf2f(*(qp - 3 * (size_t)NPROJ)); q1 = bf2f(*(qp - 2 * (size_t)NPROJ)); q2 = bf2f(*(qp - (size_t)NPROJ)); k0 = bf2f(*(kp - 3 * (size_t)NPROJ)); k1 = bf2f(*(kp - 2 * (size_t)NPROJ)); k2 = bf2f(*(kp - (size_t)NPROJ)); }
      if (tid < 256) { const int hh = tid >> 6; const float mi = bf2f(w.proj[(tb + lane) * NPROJ + C_SM + 16 + hh]), mf = bf2f(w.proj[(tb + lane) * NPROJ + C_SM + 20 + hh]);
        float f = logsigmoidf_(mf + p.fg_bias[hh]);
#pragma unroll
        for (int o = 1; o < 64; o <<= 1) { const float t = bperm(f, lane - o); if (lane >= o) f += t; }
        Fl[hh * 64 + lane] = f; Fl[256 + hh * 64 + lane] = mi + p.ig_bias[hh]; }
      const float cq0 = p.conv_w[tid], cq1 = p.conv_w[1024 + tid], cq2 = p.conv_w[2048 + tid], cq3 = p.conv_w[3072 + tid], cqb = p.conv_b[tid];
      const float ck0 = p.conv_w[512 + tid], ck1 = p.conv_w[1536 + tid], ck2 = p.conv_w[2560 + tid], ck3 = p.conv_w[3584 + tid], ckb = p.conv_b[512 + tid];
      __syncthreads();
      const float flast = Fl[h * 64 + 63];
      if (d == 0) w.mdec[item - 2048] = __expf(flast);
      float un = 0.f;
#pragma unroll 1
      for (int j8 = 0; j8 < 8; ++j8) { float kd[8];
#pragma unroll
        for (int e = 0; e < 8; ++e) { const int j = j8 * 8 + e; const float xq = bf2f(qT[j * 512 + tid]), xk = bf2f(kT[j * 512 + tid]);
          const float qc = siluf_(cqb + cq0 * q0 + cq1 * q1 + cq2 * q2 + cq3 * xq), kc = siluf_(ckb + ck0 * k0 + ck1 * k1 + ck2 * k2 + ck3 * xk) * 0.08838834764831845f;
          q0 = q1; q1 = q2; q2 = xq; k0 = k1; k1 = k2; k2 = xk;
          const float F = Fl[h * 64 + j], ig = Fl[256 + h * 64 + j];
          const float ks_ = kc * __expf(ig - F);
          qT[j * 512 + tid] = f2bf(qc * __expf(F)); kT[j * 512 + tid] = f2bf(ks_); kd[e] = ks_; un += ks_; }
        *(uint4*)(kdo + j8 * 8) = pack8(kd); }
      w.mn[(size_t)(item - 2048) * 128 + d] = un * __expf(flast);
    }
    __syncthreads();
    { unsigned char* gq = (unsigned char*)(w.qs + tb * 1024 + kind * 512); unsigned char* gk = (unsigned char*)(w.ks + tb * 1024 + kind * 512);
#pragma unroll
      for (int ps = 0; ps < 8; ++ps) { const int o = ps * 8192 + tid * 16; *(uint4*)(gq + (size_t)(o >> 10) * 2048 + (o & 1023)) = *(const uint4*)(ldsb + o); *(uint4*)(gk + (size_t)(o >> 10) * 2048 + (o & 1023)) = *(const uint4*)(ldsb + 65536 + o); } }
    __syncthreads();
  }
}
__device__ void mix_local2(const Params& p, const WS& w, int bid, int nb) {
  const int tid = tidx(), wave = tid >> 6, lane = tid & 63, fr = lane & 15, fq = lane >> 4;
  bf16x8 xf[16], yf[4];
#define ML_LOAD(task_) do { const int item_ = (task_) >> 3, w8_ = (task_) & 7, kind_ = item_ >> 11, b_ = (item_ >> 10) & 1, h_ = (item_ >> 8) & 3, c_ = item_ & 255; const size_t tb_ = (size_t)b_ * SEQ + (size_t)c_ * 64; \
    const bf16_t* xrow = w.kdT + (size_t)(kind_ * 512 + h_ * 128 + 8 * (fr >> 2) + (fr & 3)) * T + tb_ + fq * 8; const bf16_t* yrow = w.vT + (size_t)(kind_ * 1024 + h_ * 256 + w8_ * 32 + fr) * T + tb_ + fq * 8; \
    _Pragma("unroll") for (int ks = 0; ks < 2; ++ks) { yf[ks * 2] = *(const bf16x8*)(yrow + ks * 32); yf[ks * 2 + 1] = *(const bf16x8*)(yrow + (size_t)16 * T + ks * 32); \
      _Pragma("unroll") for (int xt = 0; xt < 8; ++xt) xf[ks * 8 + xt] = *(const bf16x8*)(xrow + (size_t)((xt >> 1) * 32 + (xt & 1) * 4) * T + ks * 32); } } while (0)
  const int t0 = bid * 8 + wave, step = nb * 8;
  if (t0 < 32768) ML_LOAD(t0);
  for (int task = t0; task < 32768; task += step) {
    const int item = task >> 3, w8 = task & 7, kind = item >> 11; f32x4 acc[2][8];
#pragma unroll
    for (int yt = 0; yt < 2; ++yt)
#pragma unroll
      for (int xt = 0; xt < 8; ++xt) acc[yt][xt] = (f32x4){0.f, 0.f, 0.f, 0.f};
#pragma unroll
    for (int ks = 0; ks < 2; ++ks)
#pragma unroll
      for (int xt = 0; xt < 8; ++xt) { acc[0][xt] = MFMA16(xf[ks * 8 + xt], yf[ks * 2], acc[0][xt]); acc[1][xt] = MFMA16(xf[ks * 8 + xt], yf[ks * 2 + 1], acc[1][xt]); }
    if (task + step < 32768) ML_LOAD(task + step);
    bf16_t* S = (bf16_t*)p.out + (size_t)item * 32768; const float md = kind ? w.mdec[item - 2048] : 0.f;
#pragma unroll
    for (int m = 0; m < 4; ++m) { float4 d0 = make_float4(md, md, md, md), d1 = d0;
      if (!kind) { d0 = *(const float4*)(w.gdec + (size_t)item * 128 + m * 32 + 8 * fq); d1 = *(const float4*)(w.gdec + (size_t)item * 128 + m * 32 + 8 * fq + 4); }
#pragma unroll
      for (int yt = 0; yt < 2; ++yt) { const f32x4 a = acc[yt][2 * m], bq = acc[yt][2 * m + 1];
        *(uint4*)(S + (w8 * 32 + yt * 16 + fr) * 128 + m * 32 + 8 * fq) = make_uint4(pack2(a[0] * d0.x, a[1] * d0.y), pack2(a[2] * d0.z, a[3] * d0.w), pack2(bq[0] * d1.x, bq[1] * d1.y), pack2(bq[2] * d1.z, bq[3] * d1.w)); } }
  }
#undef ML_LOAD
}
template <int KIND>
__device__ __forceinline__ void mix_out2_task(const Params& p, const WS& w, int item, int it, int fr, int fq) {
  const int b = (item >> 10) & 1, h = (item >> 8) & 3, c = item & 255;
  const size_t tb = (size_t)b * SEQ + (size_t)c * 64;
  const int i = it * 16 + fr;
  typedef unsigned u32x4_t __attribute__((ext_vector_type(4)));
  bf16x8 yq[4];
  { const bf16_t* qrow = w.qs + (tb + i) * 1024 + KIND * 512 + h * 128 + fq * 8;
#pragma unroll
    for (int k4 = 0; k4 < 4; ++k4) yq[k4] = *(const bf16x8*)(qrow + k4 * 32); }
  uint2 pk[4]; float rsum = 0.f;
  { bf16x8 kf[4][4];
#pragma unroll
    for (int jt = 0; jt < 4; ++jt) if (jt <= it) { const bf16_t* krow = w.ks + (tb + jt * 16 + fr) * 1024 + KIND * 512 + h * 128 + fq * 8;
#pragma unroll
      for (int k4 = 0; k4 < 4; ++k4) kf[jt][k4] = *(const bf16x8*)(krow + k4 * 32); }
#pragma unroll
    for (int jt = 0; jt < 4; ++jt) { pk[jt] = make_uint2(0u, 0u);
      if (jt <= it) { f32x4 a = (f32x4){0.f, 0.f, 0.f, 0.f};
#pragma unroll
        for (int k4 = 0; k4 < 4; ++k4) a = MFMA16(kf[jt][k4], yq[k4], a);
        if (jt == it) {
#pragma unroll
          for (int r = 0; r < 4; ++r) a[r] = (4 * fq + r <= fr) ? a[r] : 0.f; }
        rsum += a[0] + a[1] + a[2] + a[3];
        pk[jt] = make_uint2(pack2(a[0], a[1]), pack2(a[2], a[3])); } } }
  f32x4 acc[16];
#pragma unroll
  for (int xt = 0; xt < 16; ++xt) acc[xt] = (f32x4){0.f, 0.f, 0.f, 0.f};
  const bf16_t* vbase = w.vT + (size_t)(KIND * 1024 + h * 256 + fr) * T + tb + 4 * fq;
  const bf16_t* sbase = (const bf16_t*)p.out + (size_t)item * 32768 + fr * 128 + fq * 8;
  const u32x4_t yp0 = {pk[0].x, pk[0].y, pk[1].x, pk[1].y}, yp1 = {pk[2].x, pk[2].y, pk[3].x, pk[3].y};
  uint2 va[2][2][2], vb[2][2][2]; bf16x8 sf[2][2][4];
#define MO_LOAD(bufi, g) do { _Pragma("unroll") for (int x2 = 0; x2 < 2; ++x2) { const int xt = (g) * 2 + x2; const bf16_t* vr = vbase + (size_t)xt * 16 * T; \
      va[bufi][x2][0] = *(const uint2*)vr; vb[bufi][x2][0] = *(const uint2*)(vr + 16); if (it >= 2) { va[bufi][x2][1] = *(const uint2*)(vr + 32); vb[bufi][x2][1] = *(const uint2*)(vr + 48); } \
      _Pragma("unroll") for (int k4 = 0; k4 < 4; ++k4) sf[bufi][x2][k4] = *(const bf16x8*)(sbase + xt * 16 * 128 + k4 * 32); } } while (0)
#define MO_COMP(bufi, g) do { _Pragma("unroll") for (int x2 = 0; x2 < 2; ++x2) { const int xt = (g) * 2 + x2; \
      { const u32x4_t xv = {va[bufi][x2][0].x, va[bufi][x2][0].y, vb[bufi][x2][0].x, vb[bufi][x2][0].y}; acc[xt] = MFMA16(__builtin_bit_cast(bf16x8, xv), __builtin_bit_cast(bf16x8, yp0), acc[xt]); } \
      if (it >= 2) { const u32x4_t xv = {va[bufi][x2][1].x, va[bufi][x2][1].y, vb[bufi][x2][1].x, vb[bufi][x2][1].y}; acc[xt] = MFMA16(__builtin_bit_cast(bf16x8, xv), __builtin_bit_cast(bf16x8, yp1), acc[xt]); } \
      _Pragma("unroll") for (int k4 = 0; k4 < 4; ++k4) acc[xt] = MFMA16(sf[bufi][x2][k4], yq[k4], acc[xt]); } } while (0)
  MO_LOAD(0, 0);
#pragma unroll
  for (int g = 0; g < 8; g += 2) {
    MO_LOAD(1, g + 1);
    MO_COMP(0, g);
    if (g + 2 < 8) MO_LOAD(0, g + 2);
    MO_COMP(1, g + 1);
  }
#undef MO_LOAD
#undef MO_COMP
  if (KIND == 1) {
    float qn = 0.f; const float* nrow = w.mn + (size_t)(item - 2048) * 128 + fq * 8;
#pragma unroll
    for (int k4 = 0; k4 < 4; ++k4) { float f[8]; unpack8(__builtin_bit_cast(uint4, yq[k4]), f); const float4 n0 = *(const float4*)(nrow + k4 * 32), n1 = *(const float4*)(nrow + k4 * 32 + 4);
      qn += f[0] * n0.x + f[1] * n0.y + f[2] * n0.z + f[3] * n0.w + f[4] * n1.x + f[5] * n1.y + f[6] * n1.z + f[7] * n1.w; }
    float den = rsum + qn; den += sxor<16>(den); den += sxor<32>(den);
    const float inv = 1.f / fmaxf(fabsf(den), 1.f);
#pragma unroll
    for (int xt = 0; xt < 16; ++xt) acc[xt] *= inv;
  }
  float ss = 0.f;
#pragma unroll
  for (int xt = 0; xt < 16; ++xt)
#pragma unroll
    for (int r = 0; r < 4; ++r) ss += acc[xt][r] * acc[xt][r];
  ss += sxor<16>(ss); ss += sxor<32>(ss);
  const float rs = rsqrtf(ss * (1.f / 256.f) + EPS);
  const float* gain = (KIND == 0 ? p.gla_norm : p.mlstm_norm) + h * 256 + 4 * fq;
  const bf16_t* grow = w.proj + (tb + i) * NPROJ + (KIND == 0 ? C_GG : C_MO) + h * 256 + 4 * fq;
#pragma unroll
  for (int xt = 0; xt < 16; ++xt) { const uint2 g2 = *(const uint2*)(grow + xt * 16); const float4 gn = *(const float4*)(gain + xt * 16);
    const float g0 = lo_f(g2.x), g1 = hi_f(g2.x), g2f = lo_f(g2.y), g3 = hi_f(g2.y);
    const float a0 = KIND == 0 ? siluf_(g0) : sigmoidf_(g0), a1 = KIND == 0 ? siluf_(g1) : sigmoidf_(g1), a2 = KIND == 0 ? siluf_(g2f) : sigmoidf_(g2f), a3 = KIND == 0 ? siluf_(g3) : sigmoidf_(g3);
    const float y0 = acc[xt][0] * rs * gn.x * a0, y1 = acc[xt][1] * rs * gn.y * a1, y2 = acc[xt][2] * rs * gn.z * a2, y3 = acc[xt][3] * rs * gn.w * a3;
    const size_t yo = (tb + i) * D + KIND * 1024 + h * 256 + xt * 16 + 4 * fq;
#if F8_OUT
    *(unsigned*)(w.yq + yo) = pack4_fp8(y0, y1, y2, y3);
#else
    *(uint2*)(w.y + yo) = make_uint2(pack2(y0, y1), pack2(y2, y3));
#endif
  }
}
__device__ void mix_out2(const Params& p, const WS& w, int bid, int nb) {
  const int tid = tidx(), wave = tid >> 6, lane = tid & 63, fr = lane & 15, fq = lane >> 4;
  for (int task = bid * 8 + wave; task < 16384; task += nb * 8) {
    const int item = task >> 2, it = __builtin_amdgcn_readfirstlane(task & 3);
    if (item < 2048) mix_out2_task<0>(p, w, item, it, fr, fq); else mix_out2_task<1>(p, w, item, it, fr, fq);
  }
}

__device__ __forceinline__ unsigned sort16(unsigned b) { return (b & 0x8000u) ? (~b & 0xffffu) : (b | 0x8000u); }
__device__ __forceinline__ float unsort16(unsigned k) { const unsigned b = (k & 0x8000u) ? (k & 0x7fffu) : (~k & 0xffffu); return __uint_as_float(b << 16); }
__device__ __forceinline__ unsigned sort32(float f) { const unsigned u = __float_as_uint(f); return (u & 0x80000000u) ? ~u : (u | 0x80000000u); }
__device__ __forceinline__ float unsort32(unsigned k) { const unsigned u = (k & 0x80000000u) ? (k & 0x7fffffffu) : ~k; return __uint_as_float(u); }
__device__ __forceinline__ void ce_desc(unsigned& a, unsigned& b) { const unsigned hi = max(a, b), lo = min(a, b); a = hi; b = lo; }
__device__ __forceinline__ void sort16_desc(unsigned* k) {
#pragma unroll
  for (int sz = 2; sz <= 16; sz <<= 1)
#pragma unroll
    for (int j = sz >> 1; j > 0; j >>= 1)
#pragma unroll
      for (int i = 0; i < 16; ++i) { const int l = i ^ j; if (l > i) { if ((i & sz) == 0) ce_desc(k[i], k[l]); else ce_desc(k[l], k[i]); } }
}
__device__ __forceinline__ void merge16_desc(unsigned* L, const unsigned* B) {
#pragma unroll
  for (int i = 0; i < 16; ++i) L[i] = max(L[i], B[15 - i]);
#pragma unroll
  for (int j = 8; j > 0; j >>= 1)
#pragma unroll
    for (int i = 0; i < 16; ++i) { const int l = i ^ j; if (l > i) ce_desc(L[i], L[l]); }
}
__device__ void phase_topk(const Params& p, const WS& w, unsigned char* ldsb, int bid, int nb) {
  const int tid = tidx();
  unsigned char* mytab = ldsb + tid * 36;
  for (int th = bid * 512 + tid; th < T * 8; th += nb * 512) {
    const int t = th >> 3, h = th & 7;
    const uint4* sp = (const uint4*)(w.sc + (size_t)t * D + h * 256);
    unsigned L[2][16];
#pragma unroll
    for (int pp = 0; pp < 2; ++pp) {
#pragma unroll
      for (int blk = 0; blk < 8; ++blk) {
        const uint4 v0 = sp[pp * 16 + blk * 2], v1 = sp[pp * 16 + blk * 2 + 1]; const unsigned wds[8] = {v0.x, v0.y, v0.z, v0.w, v1.x, v1.y, v1.z, v1.w};
        unsigned B[16];
#pragma unroll
        for (int e = 0; e < 16; ++e) { const unsigned b = (e & 1) ? (wds[e >> 1] >> 16) : (wds[e >> 1] & 0xffffu); B[e] = (sort16(b) << 16) | (unsigned)(blk * 16 + e); }
        sort16_desc(B);
        if (blk == 0) {
#pragma unroll
          for (int i = 0; i < 16; ++i) L[pp][i] = B[i]; }
        else merge16_desc(L[pp], B);
      }
    }
    float v0f[16], v1f[16];
#pragma unroll
    for (int i = 0; i < 16; ++i) { v0f[i] = unsort16(L[0][i] >> 16); v1f[i] = unsort16(L[1][i] >> 16); }
    unsigned C[16], B[16];
#pragma unroll
    for (int j = 0; j < 16; ++j) C[j] = (sort32(v0f[0] + v1f[j]) & 0xffffff00u) | (unsigned)j;
    { int n = 0;
#pragma unroll
      for (int i = 1; i < 16; ++i)
#pragma unroll
        for (int j = 0; j < 16; ++j) if ((i + 1) * (j + 1) <= 16) { B[n & 15] = (sort32(v0f[i] + v1f[j]) & 0xffffff00u) | (unsigned)(i * 16 + j); ++n;
          if ((n & 15) == 0) { sort16_desc(B); merge16_desc(C, B); } }
#pragma unroll
      for (int e = 2; e < 16; ++e) B[e] = 0u;
      sort16_desc(B); merge16_desc(C, B); }
    { unsigned pw[8];
#pragma unroll
      for (int q4 = 0; q4 < 4; ++q4) { pw[q4] = (L[0][q4 * 4] & 0xffu) | ((L[0][q4 * 4 + 1] & 0xffu) << 8) | ((L[0][q4 * 4 + 2] & 0xffu) << 16) | (L[0][q4 * 4 + 3] << 24);
        pw[4 + q4] = (L[1][q4 * 4] & 0xffu) | ((L[1][q4 * 4 + 1] & 0xffu) << 8) | ((L[1][q4 * 4 + 2] & 0xffu) << 16) | (L[1][q4 * 4 + 3] << 24); }
#pragma unroll
      for (int q4 = 0; q4 < 8; ++q4) *(unsigned*)(mytab + q4 * 4) = pw[q4]; }
    const float mx = unsort32(C[0] & 0xffffff00u);
    float e[16], sum = 0.f; int eid[16];
#pragma unroll
    for (int k = 0; k < 16; ++k) { e[k] = __expf(unsort32(C[k] & 0xffffff00u) - mx); sum += e[k];
      eid[k] = (int)mytab[(C[k] >> 4) & 15] * 128 + (int)mytab[16 + (C[k] & 15)]; }
    const float inv = 1.f / sum;
    int* ei = w.eidx + (size_t)t * 128 + h * 16; float* eg = w.eg + (size_t)t * 128 + h * 16; float* es = w.esu + (size_t)t * 128 + h * 16;
#pragma unroll
    for (int k4 = 0; k4 < 4; ++k4) {
      const int e0 = eid[k4 * 4], e1 = eid[k4 * 4 + 1], e2 = eid[k4 * 4 + 2], e3 = eid[k4 * 4 + 3];
      *(int4*)(ei + k4 * 4) = make_int4(e0, e1, e2, e3);
      *(float4*)(eg + k4 * 4) = make_float4(e[k4 * 4] * inv * w.vsc[e0], e[k4 * 4 + 1] * inv * w.vsc[e1], e[k4 * 4 + 2] * inv * w.vsc[e2], e[k4 * 4 + 3] * inv * w.vsc[e3]);
      *(float4*)(es + k4 * 4) = make_float4(w.usc[e0], w.usc[e1], w.usc[e2], w.usc[e3]);
    }
  }
}
__device__ __forceinline__ void ub16(const uint4 q, float* f) {
  const unsigned wd[4] = {q.x, q.y, q.z, q.w};
#pragma unroll
  for (int k = 0; k < 4; ++k) { f[k * 4] = (float)(wd[k] & 0xffu); f[k * 4 + 1] = (float)((wd[k] >> 8) & 0xffu); f[k * 4 + 2] = (float)((wd[k] >> 16) & 0xffu); f[k * 4 + 3] = (float)(wd[k] >> 24); }
}
__device__ void peer_dots(const Params& p, const WS& w, int bid, int nb) {
  const int tid = tidx(), wave = tid >> 6, lane = tid & 63, r = lane % LPR, q = lane / LPR;
  const int x = bid & 7, nwl = (nb >> 3) * 8, wl = (bid >> 3) * 8 + wave;
  constexpr int HB = NIT / 2;
  for (int sp = 0; sp < SPL; ++sp) {
    const int s = x * SPL + sp;
    const unsigned char* tab = w.u8 + (size_t)s * 16384 * SLW + r * 16;
    int idx0 = w.eidx[(size_t)wl * 128 + lane], idx1 = w.eidx[(size_t)wl * 128 + 64 + lane];
    uint4 ha = *(const uint4*)(w.h1b + (size_t)wl * D + s * SLW + r * 16), hb = *(const uint4*)(w.h1b + (size_t)wl * D + s * SLW + r * 16 + 8);
    uint4 bA[HB], bB[HB];
#define PD_GATHER(buf, half, i0_, i1_) do { _Pragma("unroll") for (int i = 0; i < HB; ++i) { const int n = ((half) * HB + i) * EPI + q; const int e = bperm((n & 64) ? (i1_) : (i0_), n & 63); buf[i] = *(const uint4*)(tab + (size_t)e * SLW); } } while (0)
#define PD_DOTS(buf, half) do { _Pragma("unroll") for (int i = 0; i < HB; ++i) { int a = __builtin_amdgcn_sdot4((int)buf[i].x, hq[0], 0, false); a = __builtin_amdgcn_sdot4((int)buf[i].y, hq[1], a, false); \
      a = __builtin_amdgcn_sdot4((int)buf[i].z, hq[2], a, false); a = __builtin_amdgcn_sdot4((int)buf[i].w, hq[3], a, false); a = gsum<LPR>(a); \
      const int ii = (half) * HB + i; if (r == (ii % LPR)) res[ii / LPR] = (float)a * sh; } } while (0)
    PD_GATHER(bA, 0, idx0, idx1);
    for (int t = wl; t < T; t += nwl) {
      PD_GATHER(bB, 1, idx0, idx1);
      const int tn = (t + nwl < T) ? t + nwl : t;
      const int idx0n = w.eidx[(size_t)tn * 128 + lane], idx1n = w.eidx[(size_t)tn * 128 + 64 + lane];
      const uint4 han = *(const uint4*)(w.h1b + (size_t)tn * D + s * SLW + r * 16), hbn = *(const uint4*)(w.h1b + (size_t)tn * D + s * SLW + r * 16 + 8);
      float hf[16];
      unpack8(ha, hf); unpack8(hb, hf + 8);
      float am = 0.f;
#pragma unroll
      for (int j = 0; j < 16; ++j) am = fmaxf(am, fabsf(hf[j]));
      am = gmax<LPR>(am);
      const float sh = fmaxf(am, 1e-30f) * (1.f / 127.f), inv = 1.f / sh;
      int hq[4];
#pragma unroll
      for (int k = 0; k < 4; ++k) { unsigned xw = 0;
#pragma unroll
        for (int j = 0; j < 4; ++j) xw |= ((unsigned)(int)rintf(hf[k * 4 + j] * inv) & 0xffu) << (8 * j);
        hq[k] = (int)xw; }
      float res[2] = {0.f, 0.f};
      PD_DOTS(bA, 0);
      PD_GATHER(bA, 0, idx0n, idx1n);
      PD_DOTS(bB, 1);
#pragma unroll
      for (int rho = 0; rho < 2; ++rho) ((bf16_t*)w.pd)[((size_t)t * 128 + (rho * LPR + r) * EPI + q) * NSL + s] = f2bf(res[rho]);
      idx0 = idx0n; idx1 = idx1n; ha = han; hb = hbn;
    }
#undef PD_GATHER
#undef PD_DOTS
  }
}
__device__ __forceinline__ void peer_token_w(const WS& w, int t, int lane, int idx0, int idx1, float& w0, float& w1) {
  static_assert(NSL == 8, "one 16-byte load per (token, expert) holds the 8 slices' partial dots");
  const float rs2 = rsqrtf(w.ssq2[t] * (1.f / D) + EPS);
  float f0[8], f1[8];
  unpack8(*(const uint4*)((const bf16_t*)w.pd + ((size_t)t * 128 + lane) * 8), f0); unpack8(*(const uint4*)((const bf16_t*)w.pd + ((size_t)t * 128 + 64 + lane) * 8), f1);
  const float z0 = ((f0[0] + f0[1]) + (f0[2] + f0[3])) + ((f0[4] + f0[5]) + (f0[6] + f0[7])), z1 = ((f1[0] + f1[1]) + (f1[2] + f1[3])) + ((f1[4] + f1[5]) + (f1[6] + f1[7]));
  w0 = w.eg[(size_t)t * 128 + lane] * gelu_tanh(z0 * w.esu[(size_t)t * 128 + lane] * rs2);
  w1 = w.eg[(size_t)t * 128 + 64 + lane] * gelu_tanh(z1 * w.esu[(size_t)t * 128 + 64 + lane] * rs2);
}
__device__ void peer_vals(const Params& p, const WS& w, int bid, int nb) {
  static_assert(EPI == 4 && LPR == 16, "peer_vals' weight packing assumes 256-byte slices");
  const int tid = tidx(), wave = tid >> 6, lane = tid & 63, r = lane % LPR, q = lane / LPR;
  const int x = bid & 7, nwl = (nb >> 3) * 8, wl = (bid >> 3) * 8 + wave;
  constexpr int HB = NIT / 2;
  for (int sp = 0; sp < SPL; ++sp) {
    const int s = x * SPL + sp;
    const unsigned char* tab = w.v8 + (size_t)s * 16384 * SLW + r * 16;
    int idx0 = w.eidx[(size_t)wl * 128 + lane], idx1 = w.eidx[(size_t)wl * 128 + 64 + lane];
    float w0, w1; peer_token_w(w, wl, lane, idx0, idx1, w0, w1);
    uint4 bA[HB], bB[HB];
#define PV_GATHER(buf, half, i0_, i1_) do { _Pragma("unroll") for (int i = 0; i < HB; ++i) { const int n = ((half) * HB + i) * EPI + q; const int e = bperm((n & 64) ? (i1_) : (i0_), n & 63); buf[i] = *(const uint4*)(tab + (size_t)e * SLW); } } while (0)
#define PV_DOT4(buf, half) do { _Pragma("unroll") for (int g4 = 0; g4 < HB / 4; ++g4) { const int gg = (half) * (HB / 4) + g4; const int pw = bperm((gg & 4) ? pk1 : pk0, 16 * (gg & 3) + q); \
      _Pragma("unroll") for (int dd = 0; dd < 4; ++dd) { const unsigned b0 = ((const unsigned*)&buf[g4 * 4])[dd], b1 = ((const unsigned*)&buf[g4 * 4 + 1])[dd], b2 = ((const unsigned*)&buf[g4 * 4 + 2])[dd], b3 = ((const unsigned*)&buf[g4 * 4 + 3])[dd]; \
        const unsigned p0 = __builtin_amdgcn_perm(b1, b0, 0x05010400u), p1 = __builtin_amdgcn_perm(b1, b0, 0x07030602u), p2 = __builtin_amdgcn_perm(b3, b2, 0x05010400u), p3 = __builtin_amdgcn_perm(b3, b2, 0x07030602u); \
        acc[dd * 4 + 0] = __builtin_amdgcn_sdot4((int)__builtin_amdgcn_perm(p2, p0, 0x05040100u), pw, acc[dd * 4 + 0], false); acc[dd * 4 + 1] = __builtin_amdgcn_sdot4((int)__builtin_amdgcn_perm(p2, p0, 0x07060302u), pw, acc[dd * 4 + 1], false); \
        acc[dd * 4 + 2] = __builtin_amdgcn_sdot4((int)__builtin_amdgcn_perm(p3, p1, 0x05040100u), pw, acc[dd * 4 + 2], false); acc[dd * 4 + 3] = __builtin_amdgcn_sdot4((int)__builtin_amdgcn_perm(p3, p1, 0x07060302u), pw, acc[dd * 4 + 3], false); } } } while (0)
    PV_GATHER(bA, 0, idx0, idx1);
    for (int t = wl; t < T; t += nwl) {
      PV_GATHER(bB, 1, idx0, idx1);
      const int tn = (t + nwl < T) ? t + nwl : t;
      const int idx0n = w.eidx[(size_t)tn * 128 + lane], idx1n = w.eidx[(size_t)tn * 128 + 64 + lane];
      float w0n, w1n; peer_token_w(w, tn, lane, idx0n, idx1n, w0n, w1n);
      const float wmx = gmax<64>(fmaxf(fabsf(w0), fabsf(w1))), sw = fmaxf(wmx, 1e-30f) * (1.f / 127.f), isw = 1.f / sw;
      const int wq0 = (int)rintf(w0 * isw), wq1 = (int)rintf(w1 * isw);
      int pk0, pk1;
      { const int l0 = lane & ~12;
        pk0 = (bperm(wq0, l0) & 0xff) | ((bperm(wq0, l0 | 4) & 0xff) << 8) | ((bperm(wq0, l0 | 8) & 0xff) << 16) | (bperm(wq0, l0 | 12) << 24);
        pk1 = (bperm(wq1, l0) & 0xff) | ((bperm(wq1, l0 | 4) & 0xff) << 8) | ((bperm(wq1, l0 | 8) & 0xff) << 16) | (bperm(wq1, l0 | 12) << 24); }
      int acc[16];
#pragma unroll
      for (int j = 0; j < 16; ++j) acc[j] = 0;
      PV_DOT4(bA, 0);
      PV_GATHER(bA, 0, idx0n, idx1n);
      const uint4 ha = *(const uint4*)(w.h1b + (size_t)t * D + s * SLW + r * 16), hb = *(const uint4*)(w.h1b + (size_t)t * D + s * SLW + r * 16 + 8);
      const float ssq2t = w.ssq2[t];
      PV_DOT4(bB, 1);
#pragma unroll
      for (int j = 0; j < 16; ++j) { acc[j] += sxor<16>(acc[j]); acc[j] += sxor<32>(acc[j]); }
      float hf[16], o[16]; float ss = 0.f;
      unpack8(ha, hf); unpack8(hb, hf + 8);
#pragma unroll
      for (int j = 0; j < 16; ++j) { o[j] = hf[j] + sw * (float)acc[j]; ss += o[j] * o[j]; }
      if (q == 0) { *(uint4*)(w.h2b + (size_t)t * D + s * SLW + r * 16) = pack8(o); *(uint4*)(w.h2b + (size_t)t * D + s * SLW + r * 16 + 8) = pack8(o + 8);
#if F8_GATE
        const float rs2 = rsqrtf(ssq2t * (1.f / D) + EPS);
        *(uint4*)(w.h2q + (size_t)t * D + s * SLW + r * 16) = make_uint4(pack4_fp8(o[0] * rs2, o[1] * rs2, o[2] * rs2, o[3] * rs2), pack4_fp8(o[4] * rs2, o[5] * rs2, o[6] * rs2, o[7] * rs2),
                                                                      pack4_fp8(o[8] * rs2, o[9] * rs2, o[10] * rs2, o[11] * rs2), pack4_fp8(o[12] * rs2, o[13] * rs2, o[14] * rs2, o[15] * rs2));
#endif
      } else ss = 0.f;
      ss = wave_sum(ss);
      if (lane == 0) atomicAdd(w.ssq3 + t, ss);
      idx0 = idx0n; idx1 = idx1n; w0 = w0n; w1 = w1n;
    }
#undef PV_GATHER
#undef PV_DOT4
  }
}
#ifndef TPROBE_A
#define TPROBE_A -1
#endif
#ifndef TPROBE_B
#define TPROBE_B -1
#endif
__device__ void phase_final(const Params& p, const WS& w, int bid, int nb) {
  const int wave = tidx() >> 6, lane = tidx() & 63;
  float tscale = 1.f, tspike = 0.f;
  if (TPROBE_A >= 0) { const unsigned long long* ts = (const unsigned long long*)(w.ctlf + 16384); tscale = 1.f + sqrtf((float)(ts[TPROBE_A + 1] - ts[TPROBE_A]) * 1e-7f); }
  if (TPROBE_B >= 0) { const unsigned long long* ts = (const unsigned long long*)(w.ctlf + 16384); tspike = (float)(ts[TPROBE_B + 1] - ts[TPROBE_B]) * 1e-3f; }
  for (int row = bid * 8 + wave; row < T; row += nb * 8) {
    float4* o = (float4*)(p.out + (size_t)row * D);
    const float rs = rsqrtf(w.ssq4[row] * (1.f / D) + EPS) * tscale;
    uint2 hv[8];
#pragma unroll
    for (int i = 0; i < 8; ++i) hv[i] = *(const uint2*)(w.h1b + (size_t)row * D + (i * 64 + lane) * 4);
#pragma unroll
    for (int i = 0; i < 8; ++i) { const float4 g = *(const float4*)(p.norm_final + (i * 64 + lane) * 4);
      float4 v = make_float4(lo_f(hv[i].x) * rs * g.x, hi_f(hv[i].x) * rs * g.y, lo_f(hv[i].y) * rs * g.z, hi_f(hv[i].y) * rs * g.w);
      if (TPROBE_B >= 0 && row == 0 && i == 0 && lane == 0) v.x += tspike; o[i * 64 + lane] = v; }
  }
}

constexpr int NPHASE = 10;
#ifndef MIX_OUT3
#define MIX_OUT3 1
#endif
#ifndef FAST_MIX
#define FAST_MIX 2
#endif
template <int PH>
__device__ __forceinline__ void run_phase(const Params& p, float* lds, int bid, int nb) {
  const WS w = make_ws(p.ws, p.out);
  if (PH == 0) phase_prep(p, w, lds, bid, nb);
  const float s_in = __uint_as_float(__builtin_amdgcn_readfirstlane((F8_IN && PH == 1) ? __float_as_uint(w.ctlf[0]) : 0u)) * (1.f / 256.f);
  const float s_out = F8_OUT ? __uint_as_float(__builtin_amdgcn_readfirstlane((PH == 5) ? __float_as_uint(w.ctlf[1]) : 0u)) * (1.f / 256.f) : 1.f;
  const float s_g = __uint_as_float(__builtin_amdgcn_readfirstlane((F8_GATE && PH == 11) ? __float_as_uint(w.ctlf[2]) : 0u)) * (1.f / 256.f);
#if F8_IN
  if (PH == 1) { gemm_any<true>(w.xq, w.winq, T, NPROJ, D, EpiProjN{w.proj, w.rstd1, s_in}, lds, bid, nb);
                 gemm_any<true>(w.winq + (size_t)NPROJ * D, w.xq, 2048, T, D, EpiProjT{w.vT, w.rstd1, s_in}, lds, bid, nb); }
#else
  if (PH == 1) { gemm_any(w.xb, w.win, T, NPROJ, D, EpiProjN{w.proj, w.rstd1, 1.f}, lds, bid, nb);
                 gemm_any(w.win + (size_t)NPROJ * D, w.xb, 2048, T, D, EpiProjT{w.vT, w.rstd1, 1.f}, lds, bid, nb); }
#endif
#if F8_OUT
  if (PH == 5) gemm_any<true>(w.yq, w.woutq, T, D, D, EpiOut{p.x, w.h1b, w.ssq2, s_out}, lds, bid, nb);
#else
  if (PH == 5) gemm_any(w.y, w.wout, T, D, D, EpiOut{p.x, w.h1b, w.ssq2, 1.f}, lds, bid, nb);
#endif
#if F8_GATE
  if (PH == 11) gemm_any<true>(w.h2q, w.wgq, T, D, D, EpiGate{w.h2b, w.pl, w.ssq3, w.h1b, w.ssq4, w.ssq2, s_g}, lds, bid, nb);
#else
  if (PH == 11) gemm_any(w.h2b, w.wg, T, D, D, EpiGate{w.h2b, w.pl, w.ssq3, w.h1b, w.ssq4, w.ssq2, 1.f}, lds, bid, nb);
#endif
#if FAST_MIX == 2
  if (PH == 14) { phase_prep2(p, w, lds, bid, nb);
                  mix_gate_pass(p, w, (unsigned char*)lds, bid, nb); }
  if (PH == 2) mix_local2(p, w, bid, nb);
  if (PH == 3) mix_scan(p, w, lds, bid, nb);
#if MIX_OUT3
  if (PH == 4) phase_mix_out3(p, w, (unsigned char*)lds, bid, nb);
#else
  if (PH == 4) mix_out2(p, w, bid, nb);
#endif
#elif FAST_MIX
  if (PH == 2) phase_mix_items<0>(p, w, (unsigned char*)lds, bid, nb);
  if (PH == 3) mix_scan(p, w, lds, bid, nb);
  if (PH == 4) phase_mix_items<1>(p, w, (unsigned char*)lds, bid, nb);
#else
  if (PH == 2) phase_mixer_naive(p, w, lds, bid, nb);
#endif
  if (PH == 6) gemm_any(w.h1b, w.wq, T, D, D, EpiScore{w.sc, w.ssq2}, lds, bid, nb);
  if (PH == 7) { phase_topk(p, w, (unsigned char*)lds, bid, nb); __syncthreads(); gemm_any(w.pb, w.wple, T, D, 256, EpiPl{w.pl}, lds, bid, nb); }
  if (PH == 8) peer_dots(p, w, bid, nb);
  if (PH == 10) peer_vals(p, w, bid, nb);
  if (PH == 12) phase_final(p, w, bid, nb);
}


#define XB_LAS __attribute__((address_space(3)))
#define XB_TMO      128
#define XB_XCNT(j)  (256  + 64 * (j))
#define XB_XSUB(j)  (1280 + 64 * (j))
#define XB_XGEN(j)  (2304 + 64 * (j))
#define XB_TOP      3328
#define XB_TOPGEN   3392
#define XCD_BAR_WORDS 3456
#define XB_SPIN_CAP (1u << 18)
__device__ __forceinline__ unsigned xb_ld(unsigned* p)              { return __hip_atomic_load(p, __ATOMIC_RELAXED, __HIP_MEMORY_SCOPE_AGENT); }
__device__ __forceinline__ unsigned xb_add(unsigned* p, unsigned v) { return __hip_atomic_fetch_add(p, v, __ATOMIC_RELAXED, __HIP_MEMORY_SCOPE_AGENT); }
__device__ __forceinline__ unsigned xb_xcc_id() { return (unsigned)__builtin_amdgcn_s_getreg((3 << 11) | 20) & 0xFu; }
#define XB_SPIN(cond, bar) do { unsigned _sp = 0; while (cond) { __builtin_amdgcn_s_sleep(1); \
    if ((++_sp & 255u) == 0u) { if (xb_ld(&(bar)[XB_TMO])) break; if (_sp > XB_SPIN_CAP) { atomicAdd(&(bar)[XB_TMO], 1u); break; } } } } while (0)
struct XcdBarrier {
    unsigned* bar; unsigned x;
    volatile XB_LAS unsigned* st;
};
__device__ __forceinline__ XcdBarrier xcd_barrier_post(unsigned* bar, volatile XB_LAS unsigned* st) {
    XcdBarrier b; b.bar = bar; b.x = xb_xcc_id(); b.st = st;
    if (threadIdx.x == 0) (void)xb_add(&bar[XB_XCNT(b.x)], 1u);
    return b;
}
__device__ __forceinline__ void xcd_barrier_complete(unsigned* bar, unsigned x, unsigned& nloc, unsigned& nx) {
    const unsigned G = gridDim.x * gridDim.y * gridDim.z;
    unsigned sum, cnt, mine, sp = 0u;
    for (;;) {
        sum = 0u; cnt = 0u; mine = 0u;
#pragma unroll
        for (unsigned j = 0; j < 16; ++j) { const unsigned c = xb_ld(&bar[XB_XCNT(j)]); sum += c; cnt += (c > 0u) ? 1u : 0u; mine = (j == x) ? c : mine; }
        if (sum == G) break;
        __builtin_amdgcn_s_sleep(1);
        if ((++sp & 255u) == 0u) { if (xb_ld(&bar[XB_TMO])) break; if (sp > XB_SPIN_CAP) { atomicAdd(&bar[XB_TMO], 1u); break; } }
    }
    nloc = mine > 0u ? mine : 1u; nx = cnt > 0u ? cnt : 1u;
}
__device__ __forceinline__ void xcd_barrier(const XcdBarrier& b) {
    asm volatile("s_waitcnt vmcnt(0)" ::: "memory");
    __syncthreads();
    if (threadIdx.x == 0) {
        unsigned* bar = b.bar;
        __builtin_amdgcn_s_waitcnt(0);
        unsigned nloc = b.st[0], nx = b.st[1];
        if (nloc == 0u) { xcd_barrier_complete(bar, b.x, nloc, nx); b.st[0] = nloc; b.st[1] = nx; }
        const unsigned old = xb_add(&bar[XB_XSUB(b.x)], 1u);
        const unsigned gen = old / nloc;
        if (old + 1u == (gen + 1u) * nloc) {
            __builtin_amdgcn_fence(__ATOMIC_RELEASE, "agent");
            asm volatile("s_waitcnt vmcnt(0)" ::: "memory");
            const unsigned og = xb_add(&bar[XB_TOP], 1u);
            const unsigned tg = og / nx;
            if (og + 1u == (tg + 1u) * nx) xb_add(&bar[XB_TOPGEN], 1u);
            else XB_SPIN(xb_ld(&bar[XB_TOPGEN]) == tg, bar);
            __builtin_amdgcn_fence(__ATOMIC_ACQUIRE, "agent");
            xb_add(&bar[XB_XGEN(b.x)], 1u);
            asm volatile("s_waitcnt vmcnt(0)" ::: "memory");
        } else {
            XB_SPIN(xb_ld(&bar[XB_XGEN(b.x)]) == gen, bar);
            __builtin_amdgcn_fence(__ATOMIC_ACQUIRE, "agent");
            asm volatile("s_waitcnt vmcnt(0)" ::: "memory");
        }
    }
    __syncthreads();
}

constexpr size_t kDynLds = 143360;
extern __shared__ __attribute__((aligned(16))) unsigned char dyn_lds[];

#if ONE_LAUNCH
__global__ void __launch_bounds__(512, 2) mega(Params p) {
  cg::grid_group grid = cg::this_grid();
  float* lds = (float*)dyn_lds; const int bid = blockIdx.x, nb = gridDim.x;
#ifndef DUP_PHASE
#define DUP_PHASE -1
#endif
#define RUNP(k) do { run_phase<k>(p, lds, bid, nb); } while (0)
  int nstamp = 0;
#define STAMP() do { if ((TPROBE_A >= 0 || TPROBE_B >= 0) && bid == 0 && threadIdx.x == 0) ((unsigned long long*)(p.ws + OFF_CTL + 65536))[nstamp] = __builtin_amdgcn_s_memrealtime(); ++nstamp; } while (0)
  STAMP();
  unsigned* barw = (unsigned*)(p.ws + OFF_BAR);
  volatile XB_LAS unsigned* bst = (volatile XB_LAS unsigned*)(dyn_lds + kDynLds - 16);
  if (threadIdx.x == 0) { bst[0] = 0u; bst[1] = 0u; }
  if (bid == 0) for (int i = threadIdx.x; i < XCD_BAR_WORDS; i += 512) __hip_atomic_store(barw + i, 0u, __ATOMIC_RELAXED, __HIP_MEMORY_SCOPE_AGENT);
  RUNP(0); grid.sync(); STAMP();
  const XcdBarrier xbar = xcd_barrier_post(barw, bst);
#define GSYNC() xcd_barrier(xbar)
#ifdef EXTRA_SYNCS
  for (int i = 0; i < EXTRA_SYNCS; ++i) GSYNC();
#endif
  RUNP(1); GSYNC(); STAMP();
#if FAST_MIX == 2
  RUNP(14); GSYNC(); STAMP();
#endif
  RUNP(2); GSYNC(); STAMP();
#if FAST_MIX
  RUNP(3); GSYNC(); STAMP();
  RUNP(4); GSYNC(); STAMP();
#endif
  RUNP(5); GSYNC(); STAMP();
  RUNP(6); GSYNC(); STAMP();
  RUNP(7); GSYNC(); STAMP();
  RUNP(8); GSYNC(); STAMP();
  RUNP(10); GSYNC(); STAMP();
  RUNP(11); GSYNC(); STAMP();
  RUNP(12);
#undef RUNP
#undef STAMP
#undef GSYNC
}
#else
template <int PH> __global__ void __launch_bounds__(512, 2) k_phase(Params p) { run_phase<PH>(p, (float*)dyn_lds, blockIdx.x, gridDim.x); }
#endif


extern "C" void kernel_launch(void* const* d_in, const int* in_sizes, int n_in, void* d_out, int out_size, void* d_ws, size_t ws_size, hipStream_t stream) {
  if (n_in != 22 || out_size != T * D || ws_size < WS_NEED) { fprintf(stderr, "kernel_launch: unexpected shapes (n_in %d out %d ws %zu)\n", n_in, out_size, ws_size); return; }
  Params p{};
  const float** f = (const float**)&p;
  for (int i = 0; i < 22; ++i) f[i] = (const float*)d_in[i];
  p.out = (float*)d_out; p.ws = (unsigned char*)d_ws;
#if ONE_LAUNCH
  static int grid_blocks = 0;
  if (!grid_blocks) {
    int dev = 0, cus = 0, per_cu = 0;
    (void)hipGetDevice(&dev); (void)hipDeviceGetAttribute(&cus, hipDeviceAttributeMultiprocessorCount, dev);
    (void)hipFuncSetAttribute((const void*)mega, hipFuncAttributeMaxDynamicSharedMemorySize, (int)kDynLds);
    (void)hipOccupancyMaxActiveBlocksPerMultiprocessor(&per_cu, mega, 512, kDynLds);
    if (per_cu < 1) { fprintf(stderr, "occupancy query says 0 blocks/CU\n"); per_cu = 1; }
    grid_blocks = cus;
  }
  void* args[] = {&p};
  hipError_t e = hipLaunchCooperativeKernel((void*)mega, dim3(grid_blocks), dim3(512), args, kDynLds, stream);
  if (e != hipSuccess) fprintf(stderr, "cooperative launch failed: %s (grid %d)\n", hipGetErrorString(e), grid_blocks);
#else
  static bool attr = false;
  const int G = 256;
#define LAUNCH(PH) do { if (!attr) (void)hipFuncSetAttribute((const void*)k_phase<PH>, hipFuncAttributeMaxDynamicSharedMemorySize, (int)kDynLds); \
    hipLaunchKernelGGL(k_phase<PH>, dim3(G), dim3(512), kDynLds, stream, p); } while (0)
  LAUNCH(0); LAUNCH(1); LAUNCH(14); LAUNCH(2); LAUNCH(3); LAUNCH(4); LAUNCH(5); LAUNCH(6); LAUNCH(7); LAUNCH(8); LAUNCH(10); LAUNCH(11); LAUNCH(12);
  attr = true;
#undef LAUNCH
#endif
}
```

```cpp
#include <hip/hip_runtime.h>
#include <hip/hip_cooperative_groups.h>
#include <cstdio>
#include <cstdint>
namespace cg = cooperative_groups;

#ifndef ONE_LAUNCH
#define ONE_LAUNCH 1
#endif

typedef unsigned short bf16_t;
constexpr int T = 32768, SEQ = 16384, D = 2048;
constexpr int NPROJ = 4352;
constexpr int C_GQ = 0, C_GK = 512, C_GG = 1024, C_MQ = 2048, C_MK = 2560, C_MO = 3072, C_SM = 4096;
constexpr float EPS = 1e-6f;
constexpr size_t MiB = 1ull << 20;
constexpr size_t OFF_XB = 0, OFF_Y = 0, OFF_PL = 0;
constexpr size_t OFF_PROJ = 128 * MiB, OFF_H1B = 128 * MiB, OFF_H2B = 256 * MiB;
constexpr size_t OFF_VT = 400 * MiB, OFF_SC = 400 * MiB;
constexpr size_t OFF_UB = 528 * MiB, OFF_VB = 592 * MiB;
constexpr size_t OFF_WIN = 656 * MiB, OFF_WOUT = 681 * MiB, OFF_WQ = 689 * MiB, OFF_WG = 697 * MiB, OFF_WPLE = 705 * MiB;
constexpr size_t OFF_PB = 706 * MiB, OFF_EIDX = 722 * MiB, OFF_EG = 738 * MiB, OFF_MISC = 754 * MiB;
constexpr size_t OFF_GDEC = 755 * MiB, OFF_MN = 756 * MiB, OFF_MDEC = 757 * MiB, OFF_ESC = 758 * MiB;
constexpr size_t OFF_CTL = 759 * MiB, OFF_H2Q = 400 * MiB, OFF_QS = 760 * MiB, OFF_KS = 824 * MiB, OFF_KDT = 888 * MiB;
constexpr size_t OFF_ESU = 952 * MiB, OFF_BAR = 968 * MiB;
constexpr size_t WS_NEED = 969 * MiB;
#ifndef F8_IN
#define F8_IN 0
#endif
#ifndef F8_OUT
#define F8_OUT 1
#endif
#ifndef F8_GATE
#define F8_GATE 1
#endif
#ifndef F8_GEMM
#define F8_GEMM (F8_IN || F8_OUT || F8_GATE)
#endif

struct Params {
  const float *x, *p, *norm_mix, *w_in, *gate_up, *gate_bias, *gla_norm, *conv_w, *conv_b, *ig_bias, *fg_bias, *mlstm_norm,
      *w_out, *norm_ffn, *peer_query, *sub_keys, *peer_u, *peer_v, *norm_ple, *w_ple, *w_ple_gate, *norm_final;
  float* out;
  unsigned char* ws;
};

__device__ __forceinline__ float bf2f(bf16_t b) { return __uint_as_float(((unsigned)b) << 16); }
typedef __bf16 bf16v2_t __attribute__((ext_vector_type(2)));
__device__ __forceinline__ bf16_t f2bf(float f) { const __bf16 b = (__bf16)f; return __builtin_bit_cast(bf16_t, b); }
__device__ __forceinline__ unsigned pack2(float lo, float hi) { const bf16v2_t v = {(__bf16)lo, (__bf16)hi}; return __builtin_bit_cast(unsigned, v); }
__device__ __forceinline__ unsigned pack4_fp8(float a, float b, float c, float d) { int v = __builtin_amdgcn_cvt_pk_fp8_f32(a, b, 0, false); v = __builtin_amdgcn_cvt_pk_fp8_f32(c, d, v, true); return (unsigned)v; }
__device__ __forceinline__ float lo_f(unsigned u) { return __uint_as_float(u << 16); }
__device__ __forceinline__ float hi_f(unsigned u) { return __uint_as_float(u & 0xffff0000u); }
__device__ __forceinline__ int tidx() { int t = threadIdx.x; asm volatile("" : "+v"(t)); return t; }
template <int O> __device__ __forceinline__ int sxor_i(int v) {
  if constexpr (O < 32) return __builtin_amdgcn_ds_swizzle(v, (O << 10) | 0x1f);
  else return __builtin_amdgcn_ds_bpermute(((tidx() & 63) ^ 32) << 2, v);
}
template <int O> __device__ __forceinline__ float sxor(float v) { return __int_as_float(sxor_i<O>(__float_as_int(v))); }
template <int O> __device__ __forceinline__ int sxor(int v) { return sxor_i<O>(v); }
__device__ __forceinline__ int bperm(int v, int src_lane) { return __builtin_amdgcn_ds_bpermute(src_lane << 2, v); }
__device__ __forceinline__ float bperm(float v, int src_lane) { return __int_as_float(__builtin_amdgcn_ds_bpermute(src_lane << 2, __float_as_int(v))); }
template <int N> __device__ __forceinline__ float gsum(float v) {
  if constexpr (N >= 2) v += sxor<1>(v); if constexpr (N >= 4) v += sxor<2>(v); if constexpr (N >= 8) v += sxor<4>(v);
  if constexpr (N >= 16) v += sxor<8>(v); if constexpr (N >= 32) v += sxor<16>(v); if constexpr (N >= 64) v += sxor<32>(v); return v; }
template <int N> __device__ __forceinline__ int gsum(int v) {
  if constexpr (N >= 2) v += sxor<1>(v); if constexpr (N >= 4) v += sxor<2>(v); if constexpr (N >= 8) v += sxor<4>(v);
  if constexpr (N >= 16) v += sxor<8>(v); if constexpr (N >= 32) v += sxor<16>(v); if constexpr (N >= 64) v += sxor<32>(v); return v; }
template <int N> __device__ __forceinline__ float gmax(float v) {
  if constexpr (N >= 2) v = fmaxf(v, sxor<1>(v)); if constexpr (N >= 4) v = fmaxf(v, sxor<2>(v)); if constexpr (N >= 8) v = fmaxf(v, sxor<4>(v));
  if constexpr (N >= 16) v = fmaxf(v, sxor<8>(v)); if constexpr (N >= 32) v = fmaxf(v, sxor<16>(v)); if constexpr (N >= 64) v = fmaxf(v, sxor<32>(v)); return v; }
__device__ __forceinline__ float wave_sum(float v) { return gsum<64>(v); }
__device__ __forceinline__ float sigmoidf_(float x) { return __builtin_amdgcn_rcpf(1.f + __expf(-x)); }
__device__ __forceinline__ float siluf_(float x) { return x * __builtin_amdgcn_rcpf(1.f + __expf(-x)); }
__device__ __forceinline__ float logsigmoidf_(float x) { return fminf(x, 0.f) - __logf(1.f + __expf(-fabsf(x))); }
__device__ __forceinline__ float gelu_tanh(float x) { const float u = 0.7978845608028654f * (x + 0.044715f * x * x * x); return x * __builtin_amdgcn_rcpf(1.f + __expf(-2.f * u)); }
__device__ __forceinline__ void unpack8(const uint4 q, float* f) {
  f[0] = lo_f(q.x); f[1] = hi_f(q.x); f[2] = lo_f(q.y); f[3] = hi_f(q.y); f[4] = lo_f(q.z); f[5] = hi_f(q.z); f[6] = lo_f(q.w); f[7] = hi_f(q.w);
}
__device__ __forceinline__ uint4 pack8(const float* f) { return make_uint4(pack2(f[0], f[1]), pack2(f[2], f[3]), pack2(f[4], f[5]), pack2(f[6], f[7])); }

struct WS {
  bf16_t *xb, *y, *pl, *proj, *h1b, *h2b, *vT, *sc, *ub, *vb, *win, *wout, *wq, *wg, *wple, *pb;
  int* eidx; float* eg; float* esu; float *rstd1, *ssq2, *ssq3, *ssq4, *wsum, *gdec, *mn, *mdec, *usc, *vsc, *pd;
  unsigned char *u8, *v8, *xq, *yq, *h2q, *winq, *woutq, *wgq;
  bf16_t *qs, *ks, *kdT;
  float* ctlf;
};
__device__ __forceinline__ WS make_ws(unsigned char* ws, float* out) {
  WS w;
  w.xb = (bf16_t*)(ws + OFF_XB); w.y = (bf16_t*)(ws + OFF_Y); w.pl = (bf16_t*)(ws + OFF_PL); w.proj = (bf16_t*)(ws + OFF_PROJ);
  w.h1b = (bf16_t*)(ws + OFF_H1B); w.h2b = (bf16_t*)(ws + OFF_H2B); w.vT = (bf16_t*)(ws + OFF_VT); w.sc = (bf16_t*)(ws + OFF_SC);
  w.ub = (bf16_t*)(ws + OFF_UB); w.vb = (bf16_t*)(ws + OFF_VB); w.win = (bf16_t*)(ws + OFF_WIN); w.wout = (bf16_t*)(ws + OFF_WOUT);
  w.wq = (bf16_t*)(ws + OFF_WQ); w.wg = (bf16_t*)(ws + OFF_WG); w.wple = (bf16_t*)(ws + OFF_WPLE); w.pb = (bf16_t*)(ws + OFF_PB);
  w.eidx = (int*)(ws + OFF_EIDX); w.eg = (float*)(ws + OFF_EG); w.esu = (float*)(ws + OFF_ESU);
  float* m = (float*)(ws + OFF_MISC); w.rstd1 = m; w.ssq2 = m + T; w.ssq3 = m + 2 * T; w.ssq4 = m + 3 * T; w.wsum = m + 4 * T;
  w.gdec = (float*)(ws + OFF_GDEC); w.mn = (float*)(ws + OFF_MN); w.mdec = (float*)(ws + OFF_MDEC);
  w.usc = (float*)(ws + OFF_ESC); w.vsc = w.usc + 16384; w.u8 = ws + OFF_UB; w.v8 = ws + OFF_VB; w.pd = out;
  w.xq = ws + OFF_XB; w.yq = ws + OFF_Y; w.h2q = ws + OFF_H2Q; w.winq = ws + OFF_WIN; w.woutq = ws + OFF_WOUT; w.wgq = ws + OFF_WG; w.ctlf = (float*)(ws + OFF_CTL);
  w.qs = (bf16_t*)(ws + OFF_QS); w.ks = (bf16_t*)(ws + OFF_KS); w.kdT = (bf16_t*)(ws + OFF_KDT);
  return w;
}

__device__ void prep_x(const Params& p, const WS& w, int bid, int nb) {
  const int wave = tidx() >> 6, lane = tidx() & 63;
  for (int row0 = (bid * 8 + wave) * 2; row0 < T; row0 += nb * 16) {
    float4 v[2][8]; float ss[2] = {0.f, 0.f};
#pragma unroll
    for (int rr = 0; rr < 2; ++rr) { const float4* src = (const float4*)(p.x + (size_t)(row0 + rr) * D);
#pragma unroll
      for (int i = 0; i < 8; ++i) v[rr][i] = src[i * 64 + lane]; }
#pragma unroll
    for (int rr = 0; rr < 2; ++rr) {
#pragma unroll
      for (int i = 0; i < 8; ++i) ss[rr] += v[rr][i].x * v[rr][i].x + v[rr][i].y * v[rr][i].y + v[rr][i].z * v[rr][i].z + v[rr][i].w * v[rr][i].w;
      ss[rr] = wave_sum(ss[rr]);
      const float rs = rsqrtf(ss[rr] * (1.f / D) + EPS);
#if F8_IN
      unsigned* dst = (unsigned*)(w.xq + (size_t)(row0 + rr) * D);
#pragma unroll
      for (int i = 0; i < 8; ++i) dst[i * 64 + lane] = pack4_fp8(v[rr][i].x * rs, v[rr][i].y * rs, v[rr][i].z * rs, v[rr][i].w * rs);
#else
      uint2* dst = (uint2*)(w.xb + (size_t)(row0 + rr) * D);
#pragma unroll
      for (int i = 0; i < 8; ++i) dst[i * 64 + lane] = make_uint2(pack2(v[rr][i].x, v[rr][i].y), pack2(v[rr][i].z, v[rr][i].w));
#endif
      if (lane == 0) w.rstd1[row0 + rr] = rs; }
  }
}
__device__ void absmax_w(const float* src, size_t n, const float* gain, int ncols, float* part, float* lds, int bid, int nb) {
  float m = 0.f;
  for (size_t i = (size_t)bid * 512 + tidx(); i < n / 4; i += (size_t)nb * 512) { const float4 v = ((const float4*)src)[i]; const float g = gain ? gain[(i * 4) / (size_t)ncols] : 1.f;
    m = fmaxf(m, fabsf(g) * fmaxf(fmaxf(fabsf(v.x), fabsf(v.y)), fmaxf(fabsf(v.z), fabsf(v.w)))); }
  m = gmax<64>(m);
  __syncthreads();
  if ((tidx() & 63) == 0) lds[tidx() >> 6] = m;
  __syncthreads();
  if (tidx() == 0) { float t = lds[0];
#pragma unroll
    for (int i = 1; i < 8; ++i) t = fmaxf(t, lds[i]);
    part[bid] = t; }
  __syncthreads();
}
__device__ float amax_reduce(const float* part, float* lds, int nb) {
  float m = 0.f;
  for (int i = tidx(); i < nb; i += 512) m = fmaxf(m, part[i]);
  m = gmax<64>(m);
  __syncthreads();
  if ((tidx() & 63) == 0) lds[tidx() >> 6] = m;
  __syncthreads();
  float t = lds[0];
#pragma unroll
  for (int i = 1; i < 8; ++i) t = fmaxf(t, lds[i]);
  return t;
}
__device__ void cvt_rows(const float* src, bf16_t* dst, size_t n, const float* gain, int ncols, int bid, int nb) {
  const size_t n4 = n / 4, step = (size_t)nb * 512;
  for (size_t i0 = (size_t)bid * 512 + tidx(); i0 < n4; i0 += 4 * step) {
    float4 v[4];
#pragma unroll
    for (int u = 0; u < 4; ++u) { const size_t i = i0 + u * step; if (i < n4) v[u] = ((const float4*)src)[i]; }
#pragma unroll
    for (int u = 0; u < 4; ++u) { const size_t i = i0 + u * step; if (i < n4) {
      if (gain) { const float4 g = *(const float4*)(gain + (int)((i * 4) % (size_t)ncols)); v[u].x *= g.x; v[u].y *= g.y; v[u].z *= g.z; v[u].w *= g.w; }
      ((uint2*)dst)[i] = make_uint2(pack2(v[u].x, v[u].y), pack2(v[u].z, v[u].w)); } }
  }
}
template <bool F8OUT, class CM>
__device__ void transpose_w(const float* src, int K, int ldsrc, void* dstv, int Ndst, const float* gain, CM cm, float amax, float* lds, int bid, int nb) {
  const int tid = tidx(), tk = K / 64, ntile = (Ndst / 64) * tk, nc = tid & 63;
  const float qs = F8OUT ? 256.f / fmaxf(amax, 1e-30f) : 1.f;
  float rv[8];
#define TW_LOAD(tile) do { const int n0_ = ((tile) / tk) * 64, k0_ = ((tile) % tk) * 64, sc_ = cm(n0_ + nc); \
    _Pragma("unroll") for (int i = 0; i < 8; ++i) { const int kr = (tid >> 6) + 8 * i; float v = 0.f; if (sc_ >= 0) { v = src[(size_t)(k0_ + kr) * ldsrc + sc_]; if (gain) v *= gain[k0_ + kr]; } rv[i] = v * qs; } } while (0)
  if (bid < ntile) TW_LOAD(bid);
  for (int tile = bid; tile < ntile; tile += nb) {
    const int n0 = (tile / tk) * 64, k0 = (tile % tk) * 64;
#pragma unroll
    for (int i = 0; i < 8; ++i) lds[((tid >> 6) + 8 * i) * 65 + nc] = rv[i];
    __syncthreads();
    if (tile + nb < ntile) TW_LOAD(tile + nb);
    { const int nr = tid >> 3, ks = (tid & 7) * 8; float f[8];
#pragma unroll
      for (int j = 0; j < 8; ++j) f[j] = lds[(ks + j) * 65 + nr];
      if (F8OUT) *(uint2*)((unsigned char*)dstv + (size_t)(n0 + nr) * K + k0 + ks) = make_uint2(pack4_fp8(f[0], f[1], f[2], f[3]), pack4_fp8(f[4], f[5], f[6], f[7]));
      else *(uint4*)((bf16_t*)dstv + (size_t)(n0 + nr) * K + k0 + ks) = pack8(f); }
    __syncthreads();
  }
#undef TW_LOAD
}
struct CmIdent { __device__ int operator()(int n) const { return n; } };
struct CmWin {
  __device__ int operator()(int n) const {
    if (n < 1024) return n;
    if (n < 2048) return 2048 + (n - 1024);
    if (n < 2560) return 3088 + (n - 2048);
    if (n < 3072) return 3600 + (n - 2560);
    if (n < 4096) return 5136 + (n - 3072);
    if (n < 4352) { const int i = n - 4096; if (i < 16) return 3072 + i; if (i < 20) return 6160 + (i - 16); if (i < 24) return 6164 + (i - 20); return -1; }
    const int j = n - 4352; if (j < 1024) return 1024 + j;
    return 4112 + (j - 1024);
  }
};
__device__ void prep_wq(const Params& p, const WS& w, float* lds, int bid, int nb) {
  const int tid = tidx();
  float* SKs = lds;
  float* WQs = lds + 128 * 132;
  for (int item = bid; item < 16 * 32; item += nb) {
    const int hp = item >> 5, k0 = (item & 31) * 64;
#pragma unroll
    for (int i = 0; i < 8; ++i) { const int e4 = tid + 512 * i, key = e4 >> 5, d4 = (e4 & 31) * 4; *(float4*)(SKs + key * 132 + d4) = *(const float4*)(p.sub_keys + (size_t)hp * 16384 + key * 128 + d4); }
#pragma unroll
    for (int i = 0; i < 4; ++i) { const int e4 = tid + 512 * i, kr = e4 >> 5, d4 = (e4 & 31) * 4; float4 v = *(const float4*)(p.peer_query + (size_t)(k0 + kr) * 2048 + hp * 128 + d4); const float g = p.norm_ffn[k0 + kr]; v.x *= g; v.y *= g; v.z *= g; v.w *= g; *(float4*)(WQs + kr * 132 + d4) = v; }
    __syncthreads();
    const int k = tid & 63, kg = tid >> 6;
    float acc[16];
#pragma unroll
    for (int j = 0; j < 16; ++j) acc[j] = 0.f;
    for (int d4 = 0; d4 < 32; ++d4) {
      const float4 a = *(const float4*)(WQs + k * 132 + d4 * 4);
#pragma unroll
      for (int j = 0; j < 16; ++j) { const float4 s = *(const float4*)(SKs + (kg * 16 + j) * 132 + d4 * 4); acc[j] += a.x * s.x + a.y * s.y + a.z * s.z + a.w * s.w; }
    }
#pragma unroll
    for (int j = 0; j < 16; ++j) w.wq[(size_t)(hp * 128 + kg * 16 + j) * 2048 + k0 + k] = f2bf(acc[j]);
    __syncthreads();
  }
}

#ifndef PEER_SLW
#define PEER_SLW 256
#endif
constexpr int SLW = PEER_SLW, LPR = SLW / 16, EPI = 64 / LPR, NSL = 2048 / SLW, SPL = NSL / 8, NIT = 128 / EPI;
template <bool SIGNED>
__device__ void quant_rows(const float* src, const float* gain, unsigned char* dst, float* scale, int bid, int nb) {
  const int tid = tidx(), wave = tid >> 6, lane = tid & 63;
  for (int row0 = (bid * 8 + wave) * 2; row0 < 16384; row0 += nb * 16) {
    float4 f4[2][8];
#pragma unroll
    for (int rr = 0; rr < 2; ++rr)
#pragma unroll
      for (int i = 0; i < 2; ++i)
#pragma unroll
        for (int q = 0; q < 4; ++q) f4[rr][i * 4 + q] = *(const float4*)(src + (size_t)(row0 + rr) * 2048 + i * 1024 + lane * 16 + q * 4);
#pragma unroll
    for (int rr = 0; rr < 2; ++rr) { const int row = row0 + rr; float f[32]; float mx = 0.f;
#pragma unroll
      for (int i = 0; i < 2; ++i)
#pragma unroll
        for (int q = 0; q < 4; ++q) { float4 v = f4[rr][i * 4 + q];
          if (gain) { const float4 g = *(const float4*)(gain + i * 1024 + lane * 16 + q * 4); v.x *= g.x; v.y *= g.y; v.z *= g.z; v.w *= g.w; }
          f[i * 16 + q * 4] = v.x; f[i * 16 + q * 4 + 1] = v.y; f[i * 16 + q * 4 + 2] = v.z; f[i * 16 + q * 4 + 3] = v.w;
          mx = fmaxf(mx, fmaxf(fmaxf(fabsf(v.x), fabsf(v.y)), fmaxf(fabsf(v.z), fabsf(v.w)))); }
      mx = gmax<64>(mx);
      const float sc = fmaxf(mx, 1e-30f) * (1.f / 127.f), inv = 1.f / sc;
#pragma unroll
      for (int i = 0; i < 2; ++i) { unsigned wd[4];
#pragma unroll
        for (int q = 0; q < 4; ++q) { unsigned x = 0;
#pragma unroll
          for (int j = 0; j < 4; ++j) { const int v = (int)rintf(f[i * 16 + q * 4 + j] * inv) + (SIGNED ? 0 : 128); x |= ((unsigned)v & 0xffu) << (8 * j); }
          wd[q] = x; }
        const int el = i * 1024 + lane * 16;
        *(uint4*)(dst + ((size_t)(el / SLW) * 16384 + row) * SLW + (el % SLW)) = make_uint4(wd[0], wd[1], wd[2], wd[3]); }
      if (lane == 0) scale[row] = sc; }
  }
}
__device__ void phase_prep(const Params& p, const WS& w, float* lds, int bid, int nb) {
  static_assert(!F8_IN && F8_OUT && F8_GATE, "prep order written for the bf16 in-projection / fp8 out-projection + gate build");
  if (bid & 1) {
    quant_rows<true>(p.peer_u, p.norm_ffn, w.u8, w.usc, bid, nb);
    quant_rows<true>(p.peer_v, nullptr, w.v8, w.vsc, bid, nb);
    prep_x(p, w, bid, nb);
    cvt_rows(p.p, w.pb, (size_t)T * 256, nullptr, 256, bid, nb);
  }
  transpose_w<false>(p.w_in, 2048, 6168, w.win, 6400, p.norm_mix, CmWin(), 0.f, lds, bid, nb);
  absmax_w(p.w_out, (size_t)2048 * 2048, nullptr, 2048, w.ctlf + 2048, lds, bid, nb);
  absmax_w(p.w_ple_gate, (size_t)2048 * 2048, p.norm_ple, 2048, w.ctlf + 3072, lds, bid, nb);
  transpose_w<false>(p.w_ple, 256, 2048, w.wple, 2048, nullptr, CmIdent(), 0.f, lds, bid, nb);
  prep_wq(p, w, lds, bid, nb);
  if (!(bid & 1)) {
    prep_x(p, w, bid, nb);
    cvt_rows(p.p, w.pb, (size_t)T * 256, nullptr, 256, bid, nb);
    quant_rows<true>(p.peer_u, p.norm_ffn, w.u8, w.usc, bid, nb);
    quant_rows<true>(p.peer_v, nullptr, w.v8, w.vsc, bid, nb);
  }
  for (int i = bid * 512 + tidx(); i < T; i += nb * 512) { w.ssq2[i] = 0.f; w.ssq3[i] = 0.f; w.ssq4[i] = 0.f; }
}
static_assert(!F8_IN, "phase_prep2 now runs after the in-projection: an fp8 in-projection needs its weight copy (and a seam) before phase 1 again");
__device__ void phase_prep2(const Params& p, const WS& w, float* lds, int bid, int nb) {
#if F8_IN
  { const float a0 = amax_reduce(w.ctlf + 1024, lds, nb); if (bid == 0 && tidx() == 0) w.ctlf[0] = a0; __syncthreads();
    transpose_w<true>(p.w_in, 2048, 6168, w.winq, 6400, p.norm_mix, CmWin(), a0, lds, bid, nb); }
#endif
#if F8_OUT
  { const float a1 = amax_reduce(w.ctlf + 2048, lds, nb); if (bid == 0 && tidx() == 0) w.ctlf[1] = a1; __syncthreads();
    transpose_w<true>(p.w_out, 2048, 2048, w.woutq, 2048, nullptr, CmIdent(), a1, lds, bid, nb); }
#endif
#if F8_GATE
  { const float a2 = amax_reduce(w.ctlf + 3072, lds, nb); if (bid == 0 && tidx() == 0) w.ctlf[2] = a2; __syncthreads();
    transpose_w<true>(p.w_ple_gate, 2048, 2048, w.wgq, 2048, p.norm_ple, CmIdent(), a2, lds, bid, nb); }
#endif
}

struct EpiProjN { bf16_t* out; const float* rstd; float ws; static constexpr bool ROWSUM = false;
  __device__ __forceinline__ float store8(int r, int c, const float* v) const { const float s = F8_IN ? ws : rstd[r]; float f[8];
#pragma unroll
    for (int j = 0; j < 8; ++j) f[j] = v[j] * s;
    *(uint4*)(out + (size_t)r * NPROJ + c) = pack8(f); return 0.f; }
  __device__ __forceinline__ void rowsum(int, float) const {} };
struct EpiProjT { bf16_t* out; const float* rstd; float ws; static constexpr bool ROWSUM = false;
  __device__ __forceinline__ float store8(int r, int c, const float* v) const { const float4 s0 = F8_IN ? make_float4(ws, ws, ws, ws) : *(const float4*)(rstd + c), s1 = F8_IN ? s0 : *(const float4*)(rstd + c + 4); float f[8];
    f[0] = v[0] * s0.x; f[1] = v[1] * s0.y; f[2] = v[2] * s0.z; f[3] = v[3] * s0.w; f[4] = v[4] * s1.x; f[5] = v[5] * s1.y; f[6] = v[6] * s1.z; f[7] = v[7] * s1.w;
    *(uint4*)(out + (size_t)r * T + c) = pack8(f); return 0.f; }
  __device__ __forceinline__ void rowsum(int, float) const {} };
struct EpiOut { const float* x; bf16_t* h1b; float* ssq; float ws; static constexpr bool ROWSUM = true;
  __device__ __forceinline__ float store8(int r, int c, const float* v) const { const float4 x0 = *(const float4*)(x + (size_t)r * D + c), x1 = *(const float4*)(x + (size_t)r * D + c + 4); float f[8];
    f[0] = v[0] * ws + x0.x; f[1] = v[1] * ws + x0.y; f[2] = v[2] * ws + x0.z; f[3] = v[3] * ws + x0.w; f[4] = v[4] * ws + x1.x; f[5] = v[5] * ws + x1.y; f[6] = v[6] * ws + x1.z; f[7] = v[7] * ws + x1.w;
    float s = 0.f;
#pragma unroll
    for (int j = 0; j < 8; ++j) s += f[j] * f[j];
    *(uint4*)(h1b + (size_t)r * D + c) = pack8(f); return s; }
  __device__ __forceinline__ void rowsum(int r, float s) const { atomicAdd(ssq + r, s); } };
struct EpiScore { bf16_t* sc; const float* ssq; static constexpr bool ROWSUM = false;
  __device__ __forceinline__ float store8(int r, int c, const float* v) const { const float s = rsqrtf(ssq[r] * (1.f / D) + EPS); float f[8];
#pragma unroll
    for (int j = 0; j < 8; ++j) f[j] = v[j] * s;
    *(uint4*)(sc + (size_t)r * D + c) = pack8(f); return 0.f; }
  __device__ __forceinline__ void rowsum(int, float) const {} };
struct EpiPl { bf16_t* pl; static constexpr bool ROWSUM = false;
  __device__ __forceinline__ float store8(int r, int c, const float* v) const { *(uint4*)(pl + (size_t)r * D + c) = pack8(v); return 0.f; }
  __device__ __forceinline__ void rowsum(int, float) const {} };
struct EpiGate { const bf16_t* h2b; const bf16_t* pl; const float* ssq3; bf16_t* out; float* ssq; const float* ssq2; float ws; static constexpr bool ROWSUM = true;
  __device__ __forceinline__ float store8(int r, int c, const float* v) const { const float rs = rsqrtf(ssq3[r] * (1.f / D) + EPS) * (F8_GATE ? ws * sqrtf(ssq2[r] * (1.f / D) + EPS) : 1.f); float h[8], q[8], f[8];
    unpack8(*(const uint4*)(h2b + (size_t)r * D + c), h); unpack8(*(const uint4*)(pl + (size_t)r * D + c), q);
    float s = 0.f;
#pragma unroll
    for (int j = 0; j < 8; ++j) { f[j] = h[j] + sigmoidf_(v[j] * rs) * q[j]; s += f[j] * f[j]; }
    *(uint4*)(out + (size_t)r * D + c) = pack8(f); return s; }
  __device__ __forceinline__ void rowsum(int r, float s) const { atomicAdd(ssq + r, s); } };

template <class Epi>
__device__ void gemm_naive(const bf16_t* A, const bf16_t* Bt, int M, int N, int K, const Epi& E, float* lds, int bid, int nb) {
  const int tid = tidx(), ty = tid >> 4, tx = tid & 15;
  float* As = lds;
  float* Bs = lds + 32 * 132;
  const int nM = M / 128, nN = N / 128;
  for (int tile = bid; tile < nM * nN; tile += nb) {
    const int m0 = (tile % nM) * 128, n0 = (tile / nM) * 128;
    float acc[4][8];
#pragma unroll
    for (int i = 0; i < 4; ++i)
#pragma unroll
      for (int j = 0; j < 8; ++j) acc[i][j] = 0.f;
    const int lr = tid >> 2, lk = (tid & 3) * 8;
    for (int k0 = 0; k0 < K; k0 += 32) {
      const uint4 av = *(const uint4*)(A + (size_t)(m0 + lr) * K + k0 + lk);
      const uint4 bv = *(const uint4*)(Bt + (size_t)(n0 + lr) * K + k0 + lk);
      float af[8], bf[8]; unpack8(av, af); unpack8(bv, bf);
      __syncthreads();
#pragma unroll
      for (int j = 0; j < 8; ++j) { As[(lk + j) * 132 + lr] = af[j]; Bs[(lk + j) * 132 + lr] = bf[j]; }
      __syncthreads();
#pragma unroll 8
      for (int kk = 0; kk < 32; ++kk) {
        const float4 a = *(const float4*)(As + kk * 132 + ty * 4);
        const float4 b0 = *(const float4*)(Bs + kk * 132 + tx * 8), b1 = *(const float4*)(Bs + kk * 132 + tx * 8 + 4);
        const float aa[4] = {a.x, a.y, a.z, a.w}; const float bb[8] = {b0.x, b0.y, b0.z, b0.w, b1.x, b1.y, b1.z, b1.w};
#pragma unroll
        for (int i = 0; i < 4; ++i)
#pragma unroll
          for (int j = 0; j < 8; ++j) acc[i][j] += aa[i] * bb[j];
      }
    }
#pragma unroll
    for (int i = 0; i < 4; ++i) {
      const int r = m0 + ty * 4 + i;
      float s = E.store8(r, n0 + tx * 8, acc[i]);
      if (Epi::ROWSUM) { s = gsum<16>(s); if (tx == 0) E.rowsum(r, s); }
    }
  }
}


namespace pg8 {
#define PG8_LAS __attribute__((address_space(3)))
typedef short bf16x8 __attribute__((ext_vector_type(8)));
typedef float f32x4 __attribute__((ext_vector_type(4)));
typedef int v4i_t __attribute__((ext_vector_type(4)));
typedef int v8i_t __attribute__((ext_vector_type(8)));
constexpr int BM = 256, BK = 64, HALF = 128, HTB = HALF * BK * 2, STAGE_BYTES = 8 * HTB, NXCD = 8, WGM = 8;
__host__ __device__ __forceinline__ int lds_byte(int r, int c) { const int st = (r >> 4) * 2 + (c >> 5), rr = r & 15, cc = c & 31, ob = rr * 64 + cc * 2; return st * 1024 + (ob ^ (((ob >> 9) & 1) << 5)); }
__host__ __device__ __forceinline__ void stage_rc(int b, int& R, int& C) { const int st = b / 1024, sb = b % 1024, swz = sb ^ (((sb >> 9) & 1) << 5); R = (st >> 1) * 16 + swz / 64; C = (st & 1) * 32 + (swz % 64) / 2; }
__host__ __device__ __forceinline__ int perm32(int rho) { const int n = rho >> 4, i = rho & 15; return 8 * (i >> 2) + 4 * n + (i & 3); }
struct Unit { int pm, pn; };
struct Gemm { const bf16_t* A; const bf16_t* Bt; int M, N, K; };
struct StaticOrder {
    int nM, nN, nwg, G, c;
    __host__ __device__ void init(int M, int N, int G_, int c_) { nM = M / BM; nN = N / BM; nwg = nM * nN; G = G_; c = c_; }
    __host__ __device__ bool next(int i, Unit& u) const {
        const long L = (long)i * G + c; if (L >= nwg) return false;
        int wgid = (int)L; { const int q = nwg / NXCD, r = nwg % NXCD, xcd = wgid % NXCD, off = wgid / NXCD; wgid = (xcd < r ? xcd * (q + 1) : r * (q + 1) + (xcd - r) * q) + off; }
        const int nig = WGM * nN, gid = wgid / nig, fm = gid * WGM, gsz = (nM - fm) < WGM ? (nM - fm) : WGM;
        u.pm = fm + ((wgid % nig) % gsz); u.pn = (wgid % nig) / gsz; return true;
    }
    __device__ __forceinline__ void a_ready(const Unit&) const {}
    __device__ __forceinline__ void done(const Unit&) const {}
};
template <class E8> struct EpiA {
    static constexpr bool PERM = true, AFTER_DRAIN = false;
    E8 e;
    __device__ __forceinline__ void operator()(const f32x4 (&acc)[2][2][4][2], const Unit& u, int wr, int wc, int fr, int fq) const {
        asm volatile("" : "+v"(fr), "+v"(fq));
        const int row0 = u.pm * BM + wr * 64 + fr, col0 = u.pn * BM + wc * 32 + 8 * fq;
#pragma unroll
        for (int ai = 0; ai < 2; ++ai)
#pragma unroll
            for (int m = 0; m < 4; ++m) { const int r = row0 + ai * HALF + m * 16; float s = 0.f;
#pragma unroll
                for (int bj = 0; bj < 2; ++bj) { const float v[8] = {acc[ai][bj][m][0][0], acc[ai][bj][m][0][1], acc[ai][bj][m][0][2], acc[ai][bj][m][0][3], acc[ai][bj][m][1][0], acc[ai][bj][m][1][1], acc[ai][bj][m][1][2], acc[ai][bj][m][1][3]};
                    s += e.store8(r, col0 + bj * HALF, v); }
                if (E8::ROWSUM) { s += sxor<16>(s); s += sxor<32>(s); if (fq == 0) e.rowsum(r, s); }
                asm volatile("" ::: "memory"); }
    }
    __device__ __forceinline__ void fused(f32x4 (&)[2][2][4][2], const Unit&, int, int, int, int, PG8_LAS unsigned char*, int, int) const {}
};
template <class Epi, class Sched, bool ALIGN_EPI = false, bool SP2 = false, bool F8 = false>
__device__ __forceinline__ void gemm_phase(PG8_LAS unsigned char* lds, const Gemm g, const Sched& S, const Epi& E) {
    int tid_ = threadIdx.x; asm volatile("" : "+v"(tid_));
    const int tid = tid_, wid = __builtin_amdgcn_readfirstlane(tid >> 6), lane = tid & 63, wr = wid >> 2, wc = wid & 3, fr = lane & 15, fq = lane >> 4;
    const int K = g.K, nt = K / BK;
    unsigned voffA[2], voffB[2];
#pragma unroll
    for (int i = 0; i < 2; ++i) { int R, C; stage_rc(tid * 16 + i * 8192, R, C); const int Rb = Epi::PERM ? ((R & ~31) + perm32(R & 31)) : R;
        voffA[i] = (unsigned)(R * K + C) * 2u; voffB[i] = (unsigned)(Rb * K + C) * 2u; }
    const size_t kstep = (size_t)(BK * 2);
    const size_t hstep = (size_t)HALF * K * 2;
    const size_t tstep = 2 * hstep;
    const unsigned ldsw = (unsigned)wid * 1024u;
    const int aoff = lds_byte(wr * 64 + fr, fq * 8), boff = lds_byte(wc * 32 + fr, fq * 8);
#define PG8_SA(b, h) (((b) * 2 + (h)) * HTB)
#define PG8_SB(b, h) ((4 + (b) * 2 + (h)) * HTB)
#define PG8_STAGE(bufoff, gbase, voff) do { _Pragma("unroll") for (int _i = 0; _i < 2; ++_i) \
        __builtin_amdgcn_global_load_lds((const unsigned*)((const char*)(gbase) + (voff)[_i]), (PG8_LAS unsigned*)(lds + (bufoff) + ldsw + _i * 8192), 16, 0, 0); } while (0)
#define PG8_LDA(dst, b, h) do { _Pragma("unroll") for (int m = 0; m < 4; ++m) { const v4i_t lo_ = *(const PG8_LAS v4i_t*)(lds + PG8_SA(b, h) + aoff + m * 2048), hi_ = *(const PG8_LAS v4i_t*)(lds + PG8_SA(b, h) + aoff + m * 2048 + 1024); dst[m] = __builtin_shufflevector(lo_, hi_, 0, 1, 2, 3, 4, 5, 6, 7); } } while (0)
#define PG8_LDB(dst, b, h) do { _Pragma("unroll") for (int n = 0; n < 2; ++n) { const v4i_t lo_ = *(const PG8_LAS v4i_t*)(lds + PG8_SB(b, h) + boff + n * 2048), hi_ = *(const PG8_LAS v4i_t*)(lds + PG8_SB(b, h) + boff + n * 2048 + 1024); dst[n] = __builtin_shufflevector(lo_, hi_, 0, 1, 2, 3, 4, 5, 6, 7); } } while (0)
#define PG8_MMA(ai, bj, At, Bt) do { __builtin_amdgcn_s_setprio(1); \
        if constexpr (F8) { asm volatile("s_nop 1\n\t" \
            "v_mfma_scale_f32_16x16x128_f8f6f4 %0, %12, %8, %0, %14, %14 op_sel_hi:[0,0,0]\n\t"  "v_mfma_scale_f32_16x16x128_f8f6f4 %1, %13, %8, %1, %14, %14 op_sel_hi:[0,0,0]\n\t" \
            "v_mfma_scale_f32_16x16x128_f8f6f4 %2, %12, %9, %2, %14, %14 op_sel_hi:[0,0,0]\n\t"  "v_mfma_scale_f32_16x16x128_f8f6f4 %3, %13, %9, %3, %14, %14 op_sel_hi:[0,0,0]\n\t" \
            "v_mfma_scale_f32_16x16x128_f8f6f4 %4, %12, %10, %4, %14, %14 op_sel_hi:[0,0,0]\n\t" "v_mfma_scale_f32_16x16x128_f8f6f4 %5, %13, %10, %5, %14, %14 op_sel_hi:[0,0,0]\n\t" \
            "v_mfma_scale_f32_16x16x128_f8f6f4 %6, %12, %11, %6, %14, %14 op_sel_hi:[0,0,0]\n\t" "v_mfma_scale_f32_16x16x128_f8f6f4 %7, %13, %11, %7, %14, %14 op_sel_hi:[0,0,0]" \
            : "+v"(acc[ai][bj][0][0]), "+v"(acc[ai][bj][0][1]), "+v"(acc[ai][bj][1][0]), "+v"(acc[ai][bj][1][1]), "+v"(acc[ai][bj][2][0]), "+v"(acc[ai][bj][2][1]), "+v"(acc[ai][bj][3][0]), "+v"(acc[ai][bj][3][1]) \
            : "v"(At[0]), "v"(At[1]), "v"(At[2]), "v"(At[3]), "v"(Bt[0]), "v"(Bt[1]), "v"(one_scale)); } \
        else { _Pragma("unroll") for (int m = 0; m < 4; ++m) _Pragma("unroll") for (int n = 0; n < 2; ++n) { \
            acc[ai][bj][m][n] = __builtin_amdgcn_mfma_f32_16x16x32_bf16(__builtin_bit_cast(bf16x8, __builtin_shufflevector(Bt[n], Bt[n], 0, 1, 2, 3)), __builtin_bit_cast(bf16x8, __builtin_shufflevector(At[m], At[m], 0, 1, 2, 3)), acc[ai][bj][m][n], 0, 0, 0); \
            acc[ai][bj][m][n] = __builtin_amdgcn_mfma_f32_16x16x32_bf16(__builtin_bit_cast(bf16x8, __builtin_shufflevector(Bt[n], Bt[n], 4, 5, 6, 7)), __builtin_bit_cast(bf16x8, __builtin_shufflevector(At[m], At[m], 4, 5, 6, 7)), acc[ai][bj][m][n], 0, 0, 0); } } \
        __builtin_amdgcn_s_setprio(0); } while (0)
#define PG8_MFMA_DRAIN() do { if constexpr (F8) asm volatile("s_nop 15\n\ts_nop 15\n\ts_nop 15" ::: "memory"); } while (0)
#define PG8_WAIT_V(n) asm volatile("s_waitcnt vmcnt(" #n ")" ::: "memory")
#define PG8_WAIT_L(n) asm volatile("s_waitcnt lgkmcnt(" #n ")" ::: "memory")
#define PG8_BAR __builtin_amdgcn_s_barrier()
#define PG8_SCHED __builtin_amdgcn_sched_barrier(0)
    Unit cur, nxt; int ui = 0;
    if (!S.next(0, cur)) return;
    f32x4 acc[2][2][4][2];
#pragma unroll
    for (int a = 0; a < 2; ++a)
#pragma unroll
        for (int b = 0; b < 2; ++b)
#pragma unroll
            for (int m = 0; m < 4; ++m)
#pragma unroll
                for (int n = 0; n < 2; ++n) acc[a][b][m][n] = (f32x4){0.f, 0.f, 0.f, 0.f};
    const int one_scale = 0x7f7f7f7f;
    v8i_t At[4], B0[2], B1[2];
    const char* cA = (const char*)g.A + (size_t)cur.pm * tstep; const char* cB = (const char*)g.Bt + (size_t)cur.pn * tstep;
    S.a_ready(cur);
    if constexpr (SP2) {
        PG8_STAGE(PG8_SB(0, 0), cB, voffB); PG8_STAGE(PG8_SB(0, 1), cB + hstep, voffB); PG8_STAGE(PG8_SA(0, 0), cA, voffA); PG8_STAGE(PG8_SA(0, 1), cA + hstep, voffA);
        if (wr == 1) PG8_BAR;
        PG8_WAIT_V(2); PG8_BAR;
        PG8_STAGE(PG8_SB(1, 0), cB + kstep, voffB); PG8_STAGE(PG8_SA(1, 0), cA + kstep, voffA); PG8_STAGE(PG8_SB(1, 1), cB + hstep + kstep, voffB);
        PG8_WAIT_V(6); PG8_BAR;
    } else {
        PG8_STAGE(PG8_SB(0, 0), cB, voffB); PG8_STAGE(PG8_SA(0, 0), cA, voffA); PG8_STAGE(PG8_SB(0, 1), cB + hstep, voffB); PG8_STAGE(PG8_SA(0, 1), cA + hstep, voffA);
        if (wr == 1) PG8_BAR;
        PG8_WAIT_V(4); PG8_BAR;
        PG8_STAGE(PG8_SB(1, 0), cB + kstep, voffB); PG8_STAGE(PG8_SA(1, 0), cA + kstep, voffA); PG8_STAGE(PG8_SB(1, 1), cB + hstep + kstep, voffB);
        PG8_WAIT_V(6); PG8_BAR;
    }
    for (;;) {
        const bool has_next = S.next(ui + 1, nxt);
        const char* nA = has_next ? (const char*)g.A + (size_t)nxt.pm * tstep : cA; const char* nB = has_next ? (const char*)g.Bt + (size_t)nxt.pn * tstep : cB;
        for (int t = 0; t < nt; t += 2) {
            const bool last = (t == nt - 2);
            const char* a1 = cA + (size_t)(t + 1) * kstep;
            const char* a2 = last ? nA : cA + (size_t)(t + 2) * kstep; const char* b2 = last ? nB : cB + (size_t)(t + 2) * kstep;
            const char* a3 = a2 + kstep; const char* b3 = b2 + kstep;
            if (last && has_next) S.a_ready(nxt);
            if constexpr (SP2) {
            PG8_LDB(B0, 0, 0); PG8_LDB(B1, 0, 1); PG8_SCHED; PG8_LDA(At, 0, 0); PG8_STAGE(PG8_SA(1, 1), a1 + hstep, voffA);
            PG8_WAIT_V(8); PG8_WAIT_L(0); PG8_BAR; PG8_MMA(0, 0, At, B0); PG8_MMA(0, 1, At, B1); PG8_BAR; PG8_SCHED;
            PG8_LDA(At, 0, 1); PG8_STAGE(PG8_SB(0, 0), b2, voffB); PG8_STAGE(PG8_SB(0, 1), b2 + hstep, voffB); PG8_STAGE(PG8_SA(0, 0), a2, voffA);
            PG8_WAIT_V(8); PG8_WAIT_L(0); PG8_BAR; PG8_MMA(1, 0, At, B0); PG8_MMA(1, 1, At, B1); PG8_BAR; PG8_SCHED;
            PG8_LDB(B0, 1, 0); PG8_LDB(B1, 1, 1); PG8_SCHED; PG8_LDA(At, 1, 0); PG8_STAGE(PG8_SA(0, 1), a2 + hstep, voffA);
            PG8_WAIT_V(8); PG8_WAIT_L(0); PG8_BAR; PG8_MMA(0, 0, At, B0); PG8_MMA(0, 1, At, B1); PG8_BAR; PG8_SCHED;
            PG8_LDA(At, 1, 1); PG8_STAGE(PG8_SB(1, 0), b3, voffB); PG8_STAGE(PG8_SB(1, 1), b3 + hstep, voffB); PG8_STAGE(PG8_SA(1, 0), a3, voffA);
            PG8_WAIT_V(8); PG8_WAIT_L(0); PG8_BAR; PG8_MMA(1, 0, At, B0); PG8_MMA(1, 1, At, B1); PG8_BAR; PG8_SCHED;
            } else {
            PG8_LDB(B0, 0, 0); PG8_SCHED; PG8_LDA(At, 0, 0); PG8_STAGE(PG8_SA(1, 1), a1 + hstep, voffA);
            PG8_WAIT_L(8); PG8_BAR; PG8_WAIT_L(0); PG8_MMA(0, 0, At, B0); PG8_BAR; PG8_SCHED;
            PG8_LDB(B1, 0, 1); PG8_STAGE(PG8_SB(0, 0), b2, voffB);
            PG8_BAR; PG8_WAIT_L(0); PG8_MMA(0, 1, At, B1); PG8_BAR;
            PG8_LDA(At, 0, 1); PG8_STAGE(PG8_SA(0, 0), a2, voffA);
            PG8_BAR; PG8_WAIT_L(0); PG8_MMA(1, 0, At, B0); PG8_BAR; PG8_SCHED;
            PG8_STAGE(PG8_SB(0, 1), b2 + hstep, voffB);
            PG8_WAIT_V(6); PG8_BAR; PG8_MMA(1, 1, At, B1); PG8_BAR;
            PG8_LDB(B0, 1, 0); PG8_SCHED; PG8_LDA(At, 1, 0); PG8_STAGE(PG8_SA(0, 1), a2 + hstep, voffA);
            PG8_WAIT_L(8); PG8_BAR; PG8_WAIT_L(0); PG8_MMA(0, 0, At, B0); PG8_BAR; PG8_SCHED;
            PG8_LDB(B1, 1, 1); PG8_STAGE(PG8_SB(1, 0), b3, voffB);
            PG8_BAR; PG8_WAIT_L(0); PG8_MMA(0, 1, At, B1); PG8_BAR;
            PG8_LDA(At, 1, 1); PG8_STAGE(PG8_SA(1, 0), a3, voffA);
            PG8_BAR; PG8_WAIT_L(0); PG8_MMA(1, 0, At, B0); PG8_BAR; PG8_SCHED;
            PG8_STAGE(PG8_SB(1, 1), b3 + hstep, voffB);
            PG8_WAIT_V(6); PG8_BAR; PG8_MMA(1, 1, At, B1); PG8_BAR;
            }
        }
        if constexpr (ALIGN_EPI) { if (wr == 0) PG8_BAR; }
        PG8_MFMA_DRAIN();
        if constexpr (!Epi::AFTER_DRAIN) { E(acc, cur, wr, wc, fr, fq); S.done(cur); }
        if (!has_next) break;
#pragma unroll
        for (int a = 0; a < 2; ++a)
#pragma unroll
            for (int b = 0; b < 2; ++b)
#pragma unroll
                for (int m = 0; m < 4; ++m)
#pragma unroll
                    for (int n = 0; n < 2; ++n) acc[a][b][m][n] = (f32x4){0.f, 0.f, 0.f, 0.f};
        cur = nxt; cA = nA; cB = nB; ++ui;
        if constexpr (ALIGN_EPI) { if (wr == 1) PG8_BAR; }
    }
    PG8_WAIT_V(0);
    if constexpr (!ALIGN_EPI) { if (wr == 0) PG8_BAR; }
    PG8_BAR;
    if constexpr (Epi::AFTER_DRAIN) { E.fused(acc, cur, wr, wc, fr, fq, lds, wid, lane); S.done(cur); }
#undef PG8_SA
#undef PG8_SB
#undef PG8_STAGE
#undef PG8_LDA
#undef PG8_LDB
#undef PG8_MMA
#undef PG8_MFMA_DRAIN
#undef PG8_WAIT_V
#undef PG8_WAIT_L
#undef PG8_BAR
#undef PG8_SCHED
}
}

#ifndef FAST_GEMM
#define FAST_GEMM 1
#endif
template <bool F8 = false, class E8>
__device__ __forceinline__ void gemm_any(const void* A, const void* Bt, int M, int N, int K, const E8& E, float* lds, int bid, int nb) {
#if FAST_GEMM
  pg8::Gemm g{(const bf16_t*)A, (const bf16_t*)Bt, M, N, F8 ? K / 2 : K}; pg8::StaticOrder S; S.init(M, N, nb, bid);
  pg8::EpiA<E8> EA{E};
  pg8::gemm_phase<pg8::EpiA<E8>, pg8::StaticOrder, true, true, F8>((PG8_LAS unsigned char*)lds, g, S, EA);
#else
  gemm_naive((const bf16_t*)A, (const bf16_t*)Bt, M, N, K, E, lds, bid, nb);
#endif
}

__device__ void gla_naive(const Params& p, const WS& w, int b, int h, float* lds) {
  constexpr int CH = 16;
  const int tid = tidx(), dv = tid & 255, half = tid >> 8, wave = tid >> 6, lane = tid & 63;
  float* qf = lds; float* kf = qf + CH * 128; float* af = kf + CH * 128; float* vf = af + CH * 128; float* op = vf + CH * 256;
  float S[64];
#pragma unroll
  for (int i = 0; i < 64; ++i) S[i] = 0.f;
  const int gd = tid & 127;
  float gu[16];
#pragma unroll
  for (int r = 0; r < 16; ++r) gu[r] = p.gate_up[r * 512 + h * 128 + gd];
  const float gb = p.gate_bias[h * 128 + gd];
  const float qscale = 0.08838834764831845f;
  for (int t0 = 0; t0 < SEQ; t0 += CH) {
    const size_t tb = (size_t)b * SEQ + t0;
    { const int tok = tid >> 5, d4 = (tid & 31) * 4;
      const uint2 qv = *(const uint2*)(w.proj + (tb + tok) * NPROJ + C_GQ + h * 128 + d4);
      const uint2 kv = *(const uint2*)(w.proj + (tb + tok) * NPROJ + C_GK + h * 128 + d4);
      *(float4*)(qf + tok * 128 + d4) = make_float4(lo_f(qv.x) * qscale, hi_f(qv.x) * qscale, lo_f(qv.y) * qscale, hi_f(qv.y) * qscale);
      *(float4*)(kf + tok * 128 + d4) = make_float4(lo_f(kv.x), hi_f(kv.x), lo_f(kv.y), hi_f(kv.y)); }
    { const int dvv = tid & 255, tk8 = (tid >> 8) * 8; float f[8];
      unpack8(*(const uint4*)(w.vT + (size_t)(h * 256 + dvv) * T + tb + tk8), f);
#pragma unroll
      for (int j = 0; j < 8; ++j) vf[(tk8 + j) * 256 + dvv] = f[j]; }
#pragma unroll
    for (int i = 0; i < 4; ++i) { const int tok = (tid >> 7) * 4 + i; float z = gb; float gl[16];
      unpack8(*(const uint4*)(w.proj + (tb + tok) * NPROJ + C_SM), gl); unpack8(*(const uint4*)(w.proj + (tb + tok) * NPROJ + C_SM + 8), gl + 8);
#pragma unroll
      for (int r = 0; r < 16; ++r) z += gl[r] * gu[r];
      af[tok * 128 + gd] = __expf(logsigmoidf_(z) * (1.f / 16.f)); }
    __syncthreads();
    for (int tok = 0; tok < CH; ++tok) {
      const float vv = vf[tok * 256 + dv]; float acc = 0.f;
#pragma unroll
      for (int i4 = 0; i4 < 16; ++i4) {
        const float4 a = *(const float4*)(af + tok * 128 + half * 64 + i4 * 4), k = *(const float4*)(kf + tok * 128 + half * 64 + i4 * 4), q = *(const float4*)(qf + tok * 128 + half * 64 + i4 * 4);
        S[i4 * 4 + 0] = a.x * S[i4 * 4 + 0] + k.x * vv; acc += q.x * S[i4 * 4 + 0];
        S[i4 * 4 + 1] = a.y * S[i4 * 4 + 1] + k.y * vv; acc += q.y * S[i4 * 4 + 1];
        S[i4 * 4 + 2] = a.z * S[i4 * 4 + 2] + k.z * vv; acc += q.z * S[i4 * 4 + 2];
        S[i4 * 4 + 3] = a.w * S[i4 * 4 + 3] + k.w * vv; acc += q.w * S[i4 * 4 + 3];
      }
      op[(half * CH + tok) * 256 + dv] = acc;
    }
    __syncthreads();
#pragma unroll
    for (int i = 0; i < 2; ++i) { const int tok = wave * 2 + i;
      const float4 o0 = *(const float4*)(op + tok * 256 + lane * 4), o1 = *(const float4*)(op + (CH + tok) * 256 + lane * 4);
      const float o[4] = {o0.x + o1.x, o0.y + o1.y, o0.z + o1.z, o0.w + o1.w};
      float ss = wave_sum(o[0] * o[0] + o[1] * o[1] + o[2] * o[2] + o[3] * o[3]);
      const float rs = rsqrtf(ss * (1.f / 256.f) + EPS);
      const uint2 gg = *(const uint2*)(w.proj + (tb + tok) * NPROJ + C_GG + h * 256 + lane * 4);
      const float4 gn = *(const float4*)(p.gla_norm + h * 256 + lane * 4);
      const float y0 = o[0] * rs * gn.x * siluf_(lo_f(gg.x)), y1 = o[1] * rs * gn.y * siluf_(hi_f(gg.x)), y2 = o[2] * rs * gn.z * siluf_(lo_f(gg.y)), y3 = o[3] * rs * gn.w * siluf_(hi_f(gg.y));
      *(uint2*)(w.y + (tb + tok) * D + h * 256 + lane * 4) = make_uint2(pack2(y0, y1), pack2(y2, y3)); }
    __syncthreads();
  }
}
__device__ void mlstm_naive(const Params& p, const WS& w, int b, int h, float* lds) {
  constexpr int CH = 16;
  const int tid = tidx(), dv = tid & 255, half = tid >> 8, wave = tid >> 6, lane = tid & 63;
  float* qf = lds; float* kf = qf + CH * 128; float* vf = kf + CH * 128; float* op = vf + CH * 256; float* dn = op + 2 * CH * 256; float* gt = dn + 2 * CH * 256;
  float C[64], n[4];
#pragma unroll
  for (int i = 0; i < 64; ++i) C[i] = 0.f;
#pragma unroll
  for (int i = 0; i < 4; ++i) n[i] = 0.f;
  const int nd = half * 64 + (dv & 15) * 4;
  const float kscale = 0.08838834764831845f;
  const float ib = p.ig_bias[h], fb = p.fg_bias[h];
  for (int t0 = 0; t0 < SEQ; t0 += CH) {
    const size_t tb = (size_t)b * SEQ + t0;
    { const int tok = tid >> 5, d4 = (tid & 31) * 4;
      float qa[4], ka[4];
#pragma unroll
      for (int c = 0; c < 4; ++c) { qa[c] = p.conv_b[h * 128 + d4 + c]; ka[c] = p.conv_b[512 + h * 128 + d4 + c]; }
#pragma unroll
      for (int wi = 0; wi < 4; ++wi) { const int ts = t0 + tok - 3 + wi;
        if (ts >= 0) { const size_t tr = (size_t)b * SEQ + ts;
          const uint2 qv = *(const uint2*)(w.proj + tr * NPROJ + C_MQ + h * 128 + d4), kv = *(const uint2*)(w.proj + tr * NPROJ + C_MK + h * 128 + d4);
          const float4 cq = *(const float4*)(p.conv_w + wi * 1024 + h * 128 + d4), ck = *(const float4*)(p.conv_w + wi * 1024 + 512 + h * 128 + d4);
          qa[0] += cq.x * lo_f(qv.x); qa[1] += cq.y * hi_f(qv.x); qa[2] += cq.z * lo_f(qv.y); qa[3] += cq.w * hi_f(qv.y);
          ka[0] += ck.x * lo_f(kv.x); ka[1] += ck.y * hi_f(kv.x); ka[2] += ck.z * lo_f(kv.y); ka[3] += ck.w * hi_f(kv.y); } }
      *(float4*)(qf + tok * 128 + d4) = make_float4(siluf_(qa[0]), siluf_(qa[1]), siluf_(qa[2]), siluf_(qa[3]));
      *(float4*)(kf + tok * 128 + d4) = make_float4(siluf_(ka[0]) * kscale, siluf_(ka[1]) * kscale, siluf_(ka[2]) * kscale, siluf_(ka[3]) * kscale); }
    { const int dvv = tid & 255, tk8 = (tid >> 8) * 8; float f[8];
      unpack8(*(const uint4*)(w.vT + (size_t)(1024 + h * 256 + dvv) * T + tb + tk8), f);
#pragma unroll
      for (int j = 0; j < 8; ++j) vf[(tk8 + j) * 256 + dvv] = f[j]; }
    if (tid < CH) { const float mi = bf2f(w.proj[(tb + tid) * NPROJ + C_SM + 16 + h]), mf = bf2f(w.proj[(tb + tid) * NPROJ + C_SM + 20 + h]);
      gt[tid * 2] = __expf(mi + ib); gt[tid * 2 + 1] = sigmoidf_(mf + fb); }
    __syncthreads();
    for (int tok = 0; tok < CH; ++tok) {
      const float vv = vf[tok * 256 + dv], ig = gt[tok * 2], fg = gt[tok * 2 + 1]; float num = 0.f, den = 0.f;
#pragma unroll
      for (int i4 = 0; i4 < 16; ++i4) {
        const float4 k = *(const float4*)(kf + tok * 128 + half * 64 + i4 * 4), q = *(const float4*)(qf + tok * 128 + half * 64 + i4 * 4);
        const float kk[4] = {k.x * ig, k.y * ig, k.z * ig, k.w * ig}; const float qq[4] = {q.x, q.y, q.z, q.w};
#pragma unroll
        for (int c = 0; c < 4; ++c) { C[i4 * 4 + c] = fg * C[i4 * 4 + c] + kk[c] * vv; num += qq[c] * C[i4 * 4 + c]; }
      }
      { const float4 k = *(const float4*)(kf + tok * 128 + nd), q = *(const float4*)(qf + tok * 128 + nd);
        n[0] = fg * n[0] + k.x * ig; n[1] = fg * n[1] + k.y * ig; n[2] = fg * n[2] + k.z * ig; n[3] = fg * n[3] + k.w * ig;
        den = q.x * n[0] + q.y * n[1] + q.z * n[2] + q.w * n[3];
        den = gsum<16>(den); }
      op[(half * CH + tok) * 256 + dv] = num; if (dv == 0) dn[half * CH + tok] = den;
    }
    __syncthreads();
#pragma unroll
    for (int i = 0; i < 2; ++i) { const int tok = wave * 2 + i;
      const float4 o0 = *(const float4*)(op + tok * 256 + lane * 4), o1 = *(const float4*)(op + (CH + tok) * 256 + lane * 4);
      const float den = dn[tok] + dn[CH + tok];
      const float inv = 1.f / fmaxf(fabsf(den), 1.f);
      const float o[4] = {(o0.x + o1.x) * inv, (o0.y + o1.y) * inv, (o0.z + o1.z) * inv, (o0.w + o1.w) * inv};
      float ss = wave_sum(o[0] * o[0] + o[1] * o[1] + o[2] * o[2] + o[3] * o[3]);
      const float rs = rsqrtf(ss * (1.f / 256.f) + EPS);
      const uint2 mo = *(const uint2*)(w.proj + (tb + tok) * NPROJ + C_MO + h * 256 + lane * 4);
      const float4 gn = *(const float4*)(p.mlstm_norm + h * 256 + lane * 4);
      const float y0 = o[0] * rs * gn.x * sigmoidf_(lo_f(mo.x)), y1 = o[1] * rs * gn.y * sigmoidf_(hi_f(mo.x)), y2 = o[2] * rs * gn.z * sigmoidf_(lo_f(mo.y)), y3 = o[3] * rs * gn.w * sigmoidf_(hi_f(mo.y));
      *(uint2*)(w.y + (tb + tok) * D + 1024 + h * 256 + lane * 4) = make_uint2(pack2(y0, y1), pack2(y2, y3)); }
    __syncthreads();
  }
}
__device__ void phase_mixer_naive(const Params& p, const WS& w, float* lds, int bid, int nb) {
  for (int item = bid; item < 16; item += nb) {
    if (item < 8) gla_naive(p, w, item >> 2, item & 3, lds); else mlstm_naive(p, w, (item - 8) >> 2, item & 3, lds);
    __syncthreads();
  }
}


typedef short bf16x8 __attribute__((ext_vector_type(8)));
typedef float f32x4 __attribute__((ext_vector_type(4)));
#define MFMA16(a, b, c) __builtin_amdgcn_mfma_f32_16x16x32_bf16(a, b, c, 0, 0, 0)
constexpr int L_GLR = 0, L_TOT = 4096, L_F = 6144, L_DEN = 6656, L_PART = 6912, L_QS = 9216, L_KS = 26624, L_P = 44032, L_NL = 53248, L_KDT = 9216;
constexpr int QS_LD = 136, P_LD = 72, KDT_LD = 72;

__device__ __forceinline__ void gla_gates(const Params& p, const WS& w, int h, size_t tb, unsigned char* ldsb, int tid, float* bv, float& blast) {
  float* glrs = (float*)(ldsb + L_GLR); float* tot = (float*)(ldsb + L_TOT);
  const int d = tid & 127, tg = tid >> 7;
  if (tid < 128) { float f[8]; unpack8(*(const uint4*)(w.proj + (tb + (tid >> 1)) * NPROJ + C_SM + (tid & 1) * 8), f);
#pragma unroll
    for (int j = 0; j < 8; ++j) glrs[(tid >> 1) * 16 + (tid & 1) * 8 + j] = f[j]; }
  float gu[16];
#pragma unroll
  for (int r = 0; r < 16; ++r) gu[r] = p.gate_up[r * 512 + h * 128 + d];
  const float gb = p.gate_bias[h * 128 + d];
  __syncthreads();
  float run = 0.f;
#pragma unroll
  for (int i = 0; i < 16; ++i) { const float* gl = glrs + (tg * 16 + i) * 16; float z = gb;
#pragma unroll
    for (int r4 = 0; r4 < 4; ++r4) { const float4 g4 = *(const float4*)(gl + r4 * 4); z += g4.x * gu[r4 * 4] + g4.y * gu[r4 * 4 + 1] + g4.z * gu[r4 * 4 + 2] + g4.w * gu[r4 * 4 + 3]; }
    run += logsigmoidf_(z) * (1.f / 16.f); bv[i] = run; }
  tot[tg * 128 + d] = run;
  __syncthreads();
  float off = 0.f; blast = 0.f;
#pragma unroll
  for (int g = 0; g < 4; ++g) { const float t = tot[g * 128 + d]; blast += t; if (g < tg) off += t; }
#pragma unroll
  for (int i = 0; i < 16; ++i) bv[i] += off;
}
__device__ __forceinline__ void mlstm_gates(const Params& p, const WS& w, int h, size_t tb, unsigned char* ldsb, int tid) {
  float* Fl = (float*)(ldsb + L_F);
  if (tid < 64) { const float mi = bf2f(w.proj[(tb + tid) * NPROJ + C_SM + 16 + h]), mf = bf2f(w.proj[(tb + tid) * NPROJ + C_SM + 20 + h]);
    float f = logsigmoidf_(mf + p.fg_bias[h]);
#pragma unroll
    for (int o = 1; o < 64; o <<= 1) { const float t = bperm(f, tid - o); if (tid >= o) f += t; }
    Fl[tid] = f; Fl[64 + tid] = mi + p.ig_bias[h]; }
  __syncthreads();
}
__device__ __forceinline__ void conv_load(const WS& w, int col, int b, int c, int tg, bf16_t* win) {
  const int s0 = c * 64 + tg * 16 - 3;
#pragma unroll
  for (int m = 0; m < 19; ++m) { const int sp = s0 + m; win[m] = (sp >= 0) ? w.proj[((size_t)b * SEQ + sp) * NPROJ + col] : (bf16_t)0; }
}
__device__ __forceinline__ void conv_apply(const Params& p, const bf16_t* win, int cch, float scale, float* out) {
  const float c0 = p.conv_w[cch], c1 = p.conv_w[1024 + cch], c2 = p.conv_w[2048 + cch], c3 = p.conv_w[3072 + cch], cb = p.conv_b[cch];
#pragma unroll
  for (int i = 0; i < 16; ++i) out[i] = siluf_(cb + c0 * bf2f(win[i]) + c1 * bf2f(win[i + 1]) + c2 * bf2f(win[i + 2]) + c3 * bf2f(win[i + 3])) * scale;
}

template <int KIND>
__device__ void mix_local(const Params& p, const WS& w, int b, int h, int c, int item, unsigned char* ldsb) {
  const int tid = tidx(), lane = tid & 63, wave = tid >> 6, fr = lane & 15, fq = lane >> 4, d = tid & 127, tg = tid >> 7;
  const size_t tb = (size_t)b * SEQ + (size_t)c * 64;
  float* tot = (float*)(ldsb + L_TOT); const float* Fl = (const float*)(ldsb + L_F);
  bf16_t* kdT = (bf16_t*)(ldsb + L_KDT);
  const bf16_t* vrow = w.vT + (size_t)(KIND * 1024 + h * 256 + wave * 32 + fr) * T + tb + fq * 8;
  bf16x8 yv[2][2];
#pragma unroll
  for (int ks = 0; ks < 2; ++ks) { yv[ks][0] = *(const bf16x8*)(vrow + ks * 32); yv[ks][1] = *(const bf16x8*)(vrow + (size_t)16 * T + ks * 32); }
  bf16_t kraw[19];
  if (KIND == 0) {
#pragma unroll
    for (int i = 0; i < 16; ++i) kraw[i] = w.proj[(tb + tg * 16 + i) * NPROJ + C_GK + h * 128 + d];
  } else conv_load(w, C_MK + h * 128 + d, b, c, tg, kraw);
  float wgt[16], kv[16];
  if (KIND == 0) {
    float bv[16], blast; gla_gates(p, w, h, tb, ldsb, tid, bv, blast);
#pragma unroll
    for (int i = 0; i < 16; ++i) { wgt[i] = __expf(blast - bv[i]); kv[i] = bf2f(kraw[i]); }
    if (tg == 0) w.gdec[(size_t)item * 128 + d] = __expf(blast);
  } else {
    mlstm_gates(p, w, h, tb, ldsb, tid);
    const float flast = Fl[63];
#pragma unroll
    for (int i = 0; i < 16; ++i) wgt[i] = __expf(flast - Fl[tg * 16 + i] + Fl[64 + tg * 16 + i]);
    conv_apply(p, kraw, 512 + h * 128 + d, 0.08838834764831845f, kv);
    if (tid == 0) w.mdec[item - 2048] = __expf(flast);
  }
  float un = 0.f; float kd[16];
#pragma unroll
  for (int i = 0; i < 16; ++i) { kd[i] = kv[i] * wgt[i]; un += kd[i]; }
  *(uint4*)(kdT + d * KDT_LD + tg * 16) = pack8(kd); *(uint4*)(kdT + d * KDT_LD + tg * 16 + 8) = pack8(kd + 8);
  if (KIND == 1) tot[tg * 128 + d] = un;
  __syncthreads();
  if (KIND == 1 && tg == 0) w.mn[(size_t)(item - 2048) * 128 + d] = tot[d] + tot[128 + d] + tot[256 + d] + tot[384 + d];
  f32x4 acc[2][8];
#pragma unroll
  for (int yt = 0; yt < 2; ++yt)
#pragma unroll
    for (int xt = 0; xt < 8; ++xt) acc[yt][xt] = (f32x4){0.f, 0.f, 0.f, 0.f};
#pragma unroll
  for (int ks = 0; ks < 2; ++ks) {
#pragma unroll
    for (int xt = 0; xt < 8; ++xt) { const bf16x8 xk = *(const bf16x8*)(kdT + (xt * 16 + fr) * KDT_LD + ks * 32 + fq * 8);
      acc[0][xt] = MFMA16(xk, yv[ks][0], acc[0][xt]); acc[1][xt] = MFMA16(xk, yv[ks][1], acc[1][xt]); }
  }
  bf16_t* S = (bf16_t*)p.out + (size_t)item * 32768;
#pragma unroll
  for (int yt = 0; yt < 2; ++yt)
#pragma unroll
    for (int xt = 0; xt < 8; ++xt) *(uint2*)(S + (wave * 32 + yt * 16 + fr) * 128 + xt * 16 + 4 * fq) = make_uint2(pack2(acc[yt][xt][0], acc[yt][xt][1]), pack2(acc[yt][xt][2], acc[yt][xt][3]));
  __syncthreads();
}

__device__ void mix_scan(const Params& p, const WS& w, float* lds, int bid, int nb) {
  bf16_t* sbuf = (bf16_t*)p.out;
  const int tid = tidx();
  for (int g0 = bid * 512; g0 < 16 * 8192; g0 += nb * 512) {
    const int g = g0 + tid, combo = g0 >> 13, e = (g & 8191) * 4, dk = e & 127;
    __syncthreads();
    if (combo < 8) { const float4* src = (const float4*)(w.gdec + (size_t)combo * 32768);
#pragma unroll
      for (int i = 0; i < 16; ++i) ((float4*)lds)[i * 512 + tid] = src[i * 512 + tid]; }
    else if (tid < 256) lds[tid] = w.mdec[(combo - 8) * 256 + tid];
    __syncthreads();
    bf16_t* base = sbuf + (size_t)combo * 256 * 32768 + e;
    float S0 = 0.f, S1 = 0.f, S2 = 0.f, S3 = 0.f;
    for (int c0 = 0; c0 < 256; c0 += 16) {
      uint2 u[16];
#pragma unroll
      for (int k = 0; k < 16; ++k) u[k] = *(const uint2*)(base + (size_t)(c0 + k) * 32768);
#pragma unroll
      for (int k = 0; k < 16; ++k) { float4 dc; if (combo < 8) dc = *(const float4*)(lds + (c0 + k) * 128 + dk); else { const float m = lds[c0 + k]; dc = make_float4(m, m, m, m); }
        *(uint2*)(base + (size_t)(c0 + k) * 32768) = make_uint2(pack2(S0, S1), pack2(S2, S3));
        S0 = dc.x * S0 + lo_f(u[k].x); S1 = dc.y * S1 + hi_f(u[k].x); S2 = dc.z * S2 + lo_f(u[k].y); S3 = dc.w * S3 + hi_f(u[k].y); }
    }
  }
  for (int g = bid * 512 + tid; g < 8 * 128; g += nb * 512) {
    const int cb = g >> 7, d = g & 127; float n = 0.f;
    for (int c = 0; c < 256; ++c) { float* q = w.mn + (size_t)(cb * 256 + c) * 128 + d; const float u = *q; *q = n; n = w.mdec[cb * 256 + c] * n + u; }
  }
}

template <int KIND>
__device__ void mix_out(const Params& p, const WS& w, int b, int h, int c, int item, unsigned char* ldsb) {
  const int tid = tidx(), lane = tid & 63, wave = tid >> 6, fr = lane & 15, fq = lane >> 4, d = tid & 127, tg = tid >> 7;
  const size_t tb = (size_t)b * SEQ + (size_t)c * 64;
  const float* Fl = (const float*)(ldsb + L_F); float* denl = (float*)(ldsb + L_DEN); float* part = (float*)(ldsb + L_PART); float* nl = (float*)(ldsb + L_NL);
  bf16_t* qs = (bf16_t*)(ldsb + L_QS); bf16_t* ks = (bf16_t*)(ldsb + L_KS); bf16_t* P = (bf16_t*)(ldsb + L_P);
  bf16x8 vx[2][2], sx[4][2];
  { const bf16_t* vrow = w.vT + (size_t)(KIND * 1024 + h * 256 + wave * 32 + fr) * T + tb + fq * 8;
#pragma unroll
    for (int k2 = 0; k2 < 2; ++k2) { vx[k2][0] = *(const bf16x8*)(vrow + k2 * 32); vx[k2][1] = *(const bf16x8*)(vrow + (size_t)16 * T + k2 * 32); }
    const bf16_t* srow = (const bf16_t*)p.out + (size_t)item * 32768 + (wave * 32 + fr) * 128 + fq * 8;
#pragma unroll
    for (int k4 = 0; k4 < 4; ++k4) { sx[k4][0] = *(const bf16x8*)(srow + k4 * 32); sx[k4][1] = *(const bf16x8*)(srow + 16 * 128 + k4 * 32); } }
  uint2 gt[4][2];
#pragma unroll
  for (int yt = 0; yt < 4; ++yt)
#pragma unroll
    for (int xt = 0; xt < 2; ++xt) gt[yt][xt] = *(const uint2*)(w.proj + (tb + yt * 16 + fr) * NPROJ + (KIND == 0 ? C_GG : C_MO) + h * 256 + wave * 32 + xt * 16 + 4 * fq);
  const float* gain = (KIND == 0 ? p.gla_norm : p.mlstm_norm) + h * 256;
  const float4 gn0 = *(const float4*)(gain + wave * 32 + 4 * fq), gn1 = *(const float4*)(gain + wave * 32 + 16 + 4 * fq);
  bf16_t qraw[19], kraw[19];
  if (KIND == 0) {
#pragma unroll
    for (int i = 0; i < 16; ++i) { qraw[i] = w.proj[(tb + tg * 16 + i) * NPROJ + C_GQ + h * 128 + d]; kraw[i] = w.proj[(tb + tg * 16 + i) * NPROJ + C_GK + h * 128 + d]; }
  } else { conv_load(w, C_MQ + h * 128 + d, b, c, tg, qraw); conv_load(w, C_MK + h * 128 + d, b, c, tg, kraw); }
  float nlv = 0.f;
  if (KIND == 1 && tid < 128) nlv = w.mn[(size_t)(item - 2048) * 128 + tid];
  {
    float qm[16], km[16], qv[16], kv[16];
    if (KIND == 0) {
      float bv[16], blast; gla_gates(p, w, h, tb, ldsb, tid, bv, blast);
#pragma unroll
      for (int i = 0; i < 16; ++i) { qm[i] = 0.08838834764831845f * __expf(bv[i]); km[i] = __expf(-bv[i]); qv[i] = bf2f(qraw[i]); kv[i] = bf2f(kraw[i]); }
    } else {
      mlstm_gates(p, w, h, tb, ldsb, tid);
#pragma unroll
      for (int i = 0; i < 16; ++i) { const float F = Fl[tg * 16 + i]; qm[i] = __expf(F); km[i] = __expf(Fl[64 + tg * 16 + i] - F); }
      conv_apply(p, qraw, h * 128 + d, 1.f, qv);
      conv_apply(p, kraw, 512 + h * 128 + d, 0.08838834764831845f, kv);
      if (tid < 128) nl[tid] = nlv;
    }
#pragma unroll
    for (int i = 0; i < 16; ++i) { qs[(tg * 16 + i) * QS_LD + d] = f2bf(qv[i] * qm[i]); ks[(tg * 16 + i) * QS_LD + d] = f2bf(kv[i] * km[i]); }
  }
  __syncthreads();
#pragma unroll
  for (int q = 0; q < 2; ++q) { const int tt = wave * 2 + q, jt = tt >> 2, it = tt & 3; f32x4 a = (f32x4){0.f, 0.f, 0.f, 0.f};
#pragma unroll
    for (int k4 = 0; k4 < 4; ++k4) { const bf16x8 xk = *(const bf16x8*)(ks + (jt * 16 + fr) * QS_LD + k4 * 32 + fq * 8), yq = *(const bf16x8*)(qs + (it * 16 + fr) * QS_LD + k4 * 32 + fq * 8); a = MFMA16(xk, yq, a); }
    const int i = it * 16 + fr, j0 = jt * 16 + 4 * fq;
    const float v0 = (j0 <= i) ? a[0] : 0.f, v1 = (j0 + 1 <= i) ? a[1] : 0.f, v2 = (j0 + 2 <= i) ? a[2] : 0.f, v3 = (j0 + 3 <= i) ? a[3] : 0.f;
    *(uint2*)(P + i * P_LD + j0) = make_uint2(pack2(v0, v1), pack2(v2, v3)); }
  __syncthreads();
  if (KIND == 1) { const int i = tid >> 3, pt = tid & 7; float f[8]; float s = 0.f;
    unpack8(*(const uint4*)(P + i * P_LD + pt * 8), f);
#pragma unroll
    for (int j = 0; j < 8; ++j) s += f[j];
#pragma unroll
    for (int hh = 0; hh < 2; ++hh) { unpack8(*(const uint4*)(qs + i * QS_LD + pt * 16 + hh * 8), f);
#pragma unroll
      for (int j = 0; j < 8; ++j) s += f[j] * nl[pt * 16 + hh * 8 + j]; }
    s = gsum<8>(s);
    if (pt == 0) denl[i] = s; }
  f32x4 acc[2][4];
#pragma unroll
  for (int xt = 0; xt < 2; ++xt)
#pragma unroll
    for (int yt = 0; yt < 4; ++yt) acc[xt][yt] = (f32x4){0.f, 0.f, 0.f, 0.f};
#pragma unroll
  for (int k2 = 0; k2 < 2; ++k2)
#pragma unroll
    for (int yt = 0; yt < 4; ++yt) { const bf16x8 yp = *(const bf16x8*)(P + (yt * 16 + fr) * P_LD + k2 * 32 + fq * 8); acc[0][yt] = MFMA16(vx[k2][0], yp, acc[0][yt]); acc[1][yt] = MFMA16(vx[k2][1], yp, acc[1][yt]); }
#pragma unroll
  for (int k4 = 0; k4 < 4; ++k4)
#pragma unroll
    for (int yt = 0; yt < 4; ++yt) { const bf16x8 yq = *(const bf16x8*)(qs + (yt * 16 + fr) * QS_LD + k4 * 32 + fq * 8); acc[0][yt] = MFMA16(sx[k4][0], yq, acc[0][yt]); acc[1][yt] = MFMA16(sx[k4][1], yq, acc[1][yt]); }
  if (KIND == 1) __syncthreads();
#pragma unroll
  for (int yt = 0; yt < 4; ++yt) { float s = 0.f;
    if (KIND == 1) { const float inv = 1.f / fmaxf(fabsf(denl[yt * 16 + fr]), 1.f); acc[0][yt] *= inv; acc[1][yt] *= inv; }
#pragma unroll
    for (int xt = 0; xt < 2; ++xt)
#pragma unroll
      for (int r = 0; r < 4; ++r) s += acc[xt][yt][r] * acc[xt][yt][r];
    s += sxor<16>(s); s += sxor<32>(s);
    if (fq == 0) part[wave * 64 + yt * 16 + fr] = s; }
  __syncthreads();
#pragma unroll
  for (int yt = 0; yt < 4; ++yt) { const int i = yt * 16 + fr; float t = 0.f;
#pragma unroll
    for (int ww = 0; ww < 8; ++ww) t += part[ww * 64 + i];
    const float rs = rsqrtf(t * (1.f / 256.f) + EPS);
#pragma unroll
    for (int xt = 0; xt < 2; ++xt) { const int dv = wave * 32 + xt * 16 + 4 * fq;
      const float4 gn = xt == 0 ? gn0 : gn1; const uint2 g2 = gt[yt][xt];
      const float g0 = lo_f(g2.x), g1 = hi_f(g2.x), g2f = lo_f(g2.y), g3 = hi_f(g2.y);
      const float a0 = KIND == 0 ? siluf_(g0) : sigmoidf_(g0), a1 = KIND == 0 ? siluf_(g1) : sigmoidf_(g1), a2 = KIND == 0 ? siluf_(g2f) : sigmoidf_(g2f), a3 = KIND == 0 ? siluf_(g3) : sigmoidf_(g3);
      const float y0 = acc[xt][yt][0] * rs * gn.x * a0, y1 = acc[xt][yt][1] * rs * gn.y * a1, y2 = acc[xt][yt][2] * rs * gn.z * a2, y3 = acc[xt][yt][3] * rs * gn.w * a3;
#if F8_OUT
      *(unsigned*)(w.yq + (tb + i) * D + KIND * 1024 + h * 256 + dv) = pack4_fp8(y0, y1, y2, y3);
#else
      *(uint2*)(w.y + (tb + i) * D + KIND * 1024 + h * 256 + dv) = make_uint2(pack2(y0, y1), pack2(y2, y3));
#endif
    } }
  __syncthreads();
}
__device__ __forceinline__ void mix_out3_fetch(const WS& w, int item, int tid, uint4& tq0, uint4& tq1, uint4& tk0, uint4& tk1, float& nlv) {
  const int kind = item >> 11, b = (item >> 10) & 1, h = (item >> 8) & 3, c = item & 255;
  const size_t tb = (size_t)b * SEQ + (size_t)c * 64;
  const bf16_t* gq = w.qs + tb * 1024 + kind * 512 + h * 128; const bf16_t* gk = w.ks + tb * 1024 + kind * 512 + h * 128;
  const int r0 = tid >> 4, r1 = (512 + tid) >> 4, c8 = (tid & 15) * 8;
  tq0 = *(const uint4*)(gq + (size_t)r0 * 1024 + c8); tq1 = *(const uint4*)(gq + (size_t)r1 * 1024 + c8); tk0 = *(const uint4*)(gk + (size_t)r0 * 1024 + c8); tk1 = *(const uint4*)(gk + (size_t)r1 * 1024 + c8);
  if (kind == 1 && tid < 128) nlv = w.mn[(size_t)(item - 2048) * 128 + tid];
}
template <int KIND>
__device__ __forceinline__ void mix_out3(const Params& p, const WS& w, int b, int h, int c, int item, unsigned char* ldsb, uint4& tq0, uint4& tq1, uint4& tk0, uint4& tk1, float& nlv, int nitem) {
  const int tid = tidx(), lane = tid & 63, wave = tid >> 6, fr = lane & 15, fq = lane >> 4, d = tid & 127, tg = tid >> 7;
  const size_t tb = (size_t)b * SEQ + (size_t)c * 64;
  const float* Fl = (const float*)(ldsb + L_F); float* denl = (float*)(ldsb + L_DEN); float* part = (float*)(ldsb + L_PART); float* nl = (float*)(ldsb + L_NL);
  bf16_t* qs = (bf16_t*)(ldsb + L_QS); bf16_t* ks = (bf16_t*)(ldsb + L_KS); bf16_t* P = (bf16_t*)(ldsb + L_P);
  bf16x8 vx[2][2], sx[4][2];
  { const bf16_t* vrow = w.vT + (size_t)(KIND * 1024 + h * 256 + wave * 32 + fr) * T + tb + fq * 8;
#pragma unroll
    for (int k2 = 0; k2 < 2; ++k2) { vx[k2][0] = *(const bf16x8*)(vrow + k2 * 32); vx[k2][1] = *(const bf16x8*)(vrow + (size_t)16 * T + k2 * 32); }
    const bf16_t* srow = (const bf16_t*)p.out + (size_t)item * 32768 + (wave * 32 + fr) * 128 + fq * 8;
#pragma unroll
    for (int k4 = 0; k4 < 4; ++k4) { sx[k4][0] = *(const bf16x8*)(srow + k4 * 32); sx[k4][1] = *(const bf16x8*)(srow + 16 * 128 + k4 * 32); } }
  uint2 gt[4][2];
#pragma unroll
  for (int yt = 0; yt < 4; ++yt)
#pragma unroll
    for (int xt = 0; xt < 2; ++xt) gt[yt][xt] = *(const uint2*)(w.proj + (tb + yt * 16 + fr) * NPROJ + (KIND == 0 ? C_GG : C_MO) + h * 256 + wave * 32 + xt * 16 + 4 * fq);
  const float* gain = (KIND == 0 ? p.gla_norm : p.mlstm_norm) + h * 256;
  const float4 gn0 = *(const float4*)(gain + wave * 32 + 4 * fq), gn1 = *(const float4*)(gain + wave * 32 + 16 + 4 * fq);
  { const int r0 = tid >> 4, r1 = (512 + tid) >> 4, c8 = (tid & 15) * 8;
    *(uint4*)(qs + r0 * QS_LD + c8) = tq0; *(uint4*)(qs + r1 * QS_LD + c8) = tq1; *(uint4*)(ks + r0 * QS_LD + c8) = tk0; *(uint4*)(ks + r1 * QS_LD + c8) = tk1;
    if (KIND == 1 && tid < 128) nl[tid] = nlv;
    if (nitem >= 0) mix_out3_fetch(w, nitem, tid, tq0, tq1, tk0, tk1, nlv); }
  __syncthreads();
#pragma unroll
  for (int q = 0; q < 2; ++q) { const int tt = wave * 2 + q, jt = tt >> 2, it = tt & 3; f32x4 a = (f32x4){0.f, 0.f, 0.f, 0.f};
#pragma unroll
    for (int k4 = 0; k4 < 4; ++k4) { const bf16x8 xk = *(const bf16x8*)(ks + (jt * 16 + fr) * QS_LD + k4 * 32 + fq * 8), yq = *(const bf16x8*)(qs + (it * 16 + fr) * QS_LD + k4 * 32 + fq * 8); a = MFMA16(xk, yq, a); }
    const int i = it * 16 + fr, j0 = jt * 16 + 4 * fq;
    const float v0 = (j0 <= i) ? a[0] : 0.f, v1 = (j0 + 1 <= i) ? a[1] : 0.f, v2 = (j0 + 2 <= i) ? a[2] : 0.f, v3 = (j0 + 3 <= i) ? a[3] : 0.f;
    *(uint2*)(P + i * P_LD + j0) = make_uint2(pack2(v0, v1), pack2(v2, v3)); }
  __syncthreads();
  if (KIND == 1) { const int i = tid >> 3, pt = tid & 7; float f[8]; float s = 0.f;
    unpack8(*(const uint4*)(P + i * P_LD + pt * 8), f);
#pragma unroll
    for (int j = 0; j < 8; ++j) s += f[j];
#pragma unroll
    for (int hh = 0; hh < 2; ++hh) { unpack8(*(const uint4*)(qs + i * QS_LD + pt * 16 + hh * 8), f);
#pragma unroll
      for (int j = 0; j < 8; ++j) s += f[j] * nl[pt * 16 + hh * 8 + j]; }
    s = gsum<8>(s);
    if (pt == 0) denl[i] = s; }
  f32x4 acc[2][4];
#pragma unroll
  for (int xt = 0; xt < 2; ++xt)
#pragma unroll
    for (int yt = 0; yt < 4; ++yt) acc[xt][yt] = (f32x4){0.f, 0.f, 0.f, 0.f};
#pragma unroll
  for (int k2 = 0; k2 < 2; ++k2)
#pragma unroll
    for (int yt = 0; yt < 4; ++yt) { const bf16x8 yp = *(const bf16x8*)(P + (yt * 16 + fr) * P_LD + k2 * 32 + fq * 8); acc[0][yt] = MFMA16(vx[k2][0], yp, acc[0][yt]); acc[1][yt] = MFMA16(vx[k2][1], yp, acc[1][yt]); }
#pragma unroll
  for (int k4 = 0; k4 < 4; ++k4)
#pragma unroll
    for (int yt = 0; yt < 4; ++yt) { const bf16x8 yq = *(const bf16x8*)(qs + (yt * 16 + fr) * QS_LD + k4 * 32 + fq * 8); acc[0][yt] = MFMA16(sx[k4][0], yq, acc[0][yt]); acc[1][yt] = MFMA16(sx[k4][1], yq, acc[1][yt]); }
#pragma unroll
  for (int yt = 0; yt < 4; ++yt) { float s = 0.f;
#pragma unroll
    for (int xt = 0; xt < 2; ++xt)
#pragma unroll
      for (int r = 0; r < 4; ++r) s += acc[xt][yt][r] * acc[xt][yt][r];
    s += sxor<16>(s); s += sxor<32>(s);
    if (fq == 0) part[wave * 64 + yt * 16 + fr] = s; }
  __syncthreads();
#pragma unroll
  for (int yt = 0; yt < 4; ++yt) { const int i = yt * 16 + fr; float t = 0.f;
#pragma unroll
    for (int ww = 0; ww < 8; ++ww) t += part[ww * 64 + i];
    float dd = 1.f; if (KIND == 1) { dd = fmaxf(fabsf(denl[i]), 1.f); dd *= dd; }
    const float rs = rsqrtf(t * (1.f / 256.f) + EPS * dd);
#pragma unroll
    for (int xt = 0; xt < 2; ++xt) { const int dv = wave * 32 + xt * 16 + 4 * fq;
      const float4 gn = xt == 0 ? gn0 : gn1; const uint2 g2 = gt[yt][xt];
      const float g0 = lo_f(g2.x), g1 = hi_f(g2.x), g2f = lo_f(g2.y), g3 = hi_f(g2.y);
      const float a0 = KIND == 0 ? siluf_(g0) : sigmoidf_(g0), a1 = KIND == 0 ? siluf_(g1) : sigmoidf_(g1), a2 = KIND == 0 ? siluf_(g2f) : sigmoidf_(g2f), a3 = KIND == 0 ? siluf_(g3) : sigmoidf_(g3);
      const float y0 = acc[xt][yt][0] * rs * gn.x * a0, y1 = acc[xt][yt][1] * rs * gn.y * a1, y2 = acc[xt][yt][2] * rs * gn.z * a2, y3 = acc[xt][yt][3] * rs * gn.w * a3;
#if F8_OUT
      *(unsigned*)(w.yq + (tb + i) * D + KIND * 1024 + h * 256 + dv) = pack4_fp8(y0, y1, y2, y3);
#else
      *(uint2*)(w.y + (tb + i) * D + KIND * 1024 + h * 256 + dv) = make_uint2(pack2(y0, y1), pack2(y2, y3));
#endif
    } }
}

template <int WHICH>
__device__ void phase_mix_items(const Params& p, const WS& w, unsigned char* ldsb, int bid, int nb) {
  for (int item = bid; item < 4096; item += nb) {
    const int kind = item >> 11, b = (item >> 10) & 1, h = (item >> 8) & 3, c = item & 255;
    if (WHICH == 0) { if (kind == 0) mix_local<0>(p, w, b, h, c, item, ldsb); else mix_local<1>(p, w, b, h, c, item, ldsb); }
    else { if (kind == 0) mix_out<0>(p, w, b, h, c, item, ldsb); else mix_out<1>(p, w, b, h, c, item, ldsb); }
  }
}


__device__ void phase_mix_out3(const Params& p, const WS& w, unsigned char* ldsb, int bid, int nb) {
  int par = 0;
  uint4 tq0, tq1, tk0, tk1; float nlv = 0.f;
  if (bid < 4096) mix_out3_fetch(w, bid, tidx(), tq0, tq1, tk0, tk1, nlv);
  for (int item = bid; item < 4096; item += nb, par ^= 1) {
    const int kind = item >> 11, b = (item >> 10) & 1, h = (item >> 8) & 3, c = item & 255, nitem = (item + nb < 4096) ? item + nb : -1;
    if (kind == 0) mix_out3<0>(p, w, b, h, c, item, ldsb + par * 57344, tq0, tq1, tk0, tk1, nlv, nitem); else mix_out3<1>(p, w, b, h, c, item, ldsb + par * 57344, tq0, tq1, tk0, tk1, nlv, nitem);
  }
  __syncthreads();
}

__device__ void mix_gate_pass(const Params& p, const WS& w, unsigned char* ldsb, int bid, int nb) {
  const int tid = tidx(), h = tid >> 7, d = tid & 127, lane = tid & 63;
  bf16_t* qT = (bf16_t*)ldsb; bf16_t* kT = (bf16_t*)(ldsb + 65536);
  float* glrs = (float*)(ldsb + 131072); float* Fl = (float*)(ldsb + 135168);
  for (int itx = bid; itx < 1024; itx += nb) {
    const int kind = itx >> 9, b = (itx >> 8) & 1, c = itx & 255;
    const size_t tb = (size_t)b * SEQ + (size_t)c * 64;
    const int item = ((kind * 2 + b) * 4 + h) * 256 + c;
    bf16_t* kdo = w.kdT + (size_t)(kind * 512 + tid) * T + tb;
    { uint4 tq[8], tk[8];
      const unsigned char* gq = (const unsigned char*)(w.proj + tb * NPROJ + (kind == 0 ? C_GQ : C_MQ)); const unsigned char* gk = (const unsigned char*)(w.proj + tb * NPROJ + (kind == 0 ? C_GK : C_MK));
#pragma unroll
      for (int ps = 0; ps < 8; ++ps) { const int o = ps * 8192 + tid * 16; tq[ps] = *(const uint4*)(gq + (size_t)(o >> 10) * (NPROJ * 2) + (o & 1023)); tk[ps] = *(const uint4*)(gk + (size_t)(o >> 10) * (NPROJ * 2) + (o & 1023)); }
#pragma unroll
      for (int ps = 0; ps < 8; ++ps) { const int o = ps * 8192 + tid * 16; *(uint4*)(ldsb + o) = tq[ps]; *(uint4*)(ldsb + 65536 + o) = tk[ps]; } }
    if (kind == 0) {
      if (tid < 128) { float f[8]; unpack8(*(const uint4*)(w.proj + (tb + (tid >> 1)) * NPROJ + C_SM + (tid & 1) * 8), f);
#pragma unroll
        for (int j = 0; j < 8; ++j) glrs[(tid >> 1) * 16 + (tid & 1) * 8 + j] = f[j]; }
      float gu[16];
#pragma unroll
      for (int r = 0; r < 16; ++r) gu[r] = p.gate_up[r * 512 + tid];
      const float gb = p.gate_bias[tid];
      __syncthreads();
      float run = 0.f;
#pragma unroll 1
      for (int j8 = 0; j8 < 8; ++j8) { float kd[8];
#pragma unroll
        for (int e = 0; e < 8; ++e) { const int j = j8 * 8 + e; const float* gl = glrs + j * 16; float z = gb;
#pragma unroll
          for (int r4 = 0; r4 < 4; ++r4) { const float4 g4 = *(const float4*)(gl + r4 * 4); z += g4.x * gu[r4 * 4] + g4.y * gu[r4 * 4 + 1] + g4.z * gu[r4 * 4 + 2] + g4.w * gu[r4 * 4 + 3]; }
          run += logsigmoidf_(z) * (1.f / 16.f);
          const float q = bf2f(qT[j * 512 + tid]), k = bf2f(kT[j * 512 + tid]), eb = __expf(run), ks_ = k * __builtin_amdgcn_rcpf(eb);
          qT[j * 512 + tid] = f2bf(q * 0.08838834764831845f * eb); kT[j * 512 + tid] = f2bf(ks_); kd[e] = ks_; }
        *(uint4*)(kdo + j8 * 8) = pack8(kd); }
      w.gdec[(size_t)item * 128 + d] = __expf(run);
    } else {
      float q0 = 0.f, q1 = 0.f, q2 = 0.f, k0 = 0.f, k1 = 0.f, k2 = 0.f;
      if (c > 0) { const bf16_t* qp = w.proj + tb * NPROJ + C_MQ + tid; const bf16_t* kp = w.proj + tb * NPROJ + C_MK + tid;
        q0 = bf2f(*(qp - 3 * (size_t)NPROJ)); q1 = bf2f(*(qp - 2 * (size_t)NPROJ)); q2 = bf2f(*(qp - (size_t)NPROJ)); k0 = bf2f(*(kp - 3 * (size_t)NPROJ)); k1 = bf2f(*(kp - 2 * (size_t)NPROJ)); k2 = bf2f(*(kp - (size_t)NPROJ)); }
      if (tid < 256) { const int hh = tid >> 6; const float mi = bf2f(w.proj[(tb + lane) * NPROJ + C_SM + 16 + hh]), mf = bf2f(w.proj[(tb + lane) * NPROJ + C_SM + 20 + hh]);
        float f = logsigmoidf_(mf + p.fg_bias[hh]);
#pragma unroll
        for (int o = 1; o < 64; o <<= 1) { const float t = bperm(f, lane - o); if (lane >= o) f += t; }
        Fl[hh * 64 + lane] = f; Fl[256 + hh * 64 + lane] = mi + p.ig_bias[hh]; }
      const float cq0 = p.conv_w[tid], cq1 = p.conv_w[1024 + tid], cq2 = p.conv_w[2048 + tid], cq3 = p.conv_w[3072 + tid], cqb = p.conv_b[tid];
      const float ck0 = p.conv_w[512 + tid], ck1 = p.conv_w[1536 + tid], ck2 = p.conv_w[2560 + tid], ck3 = p.conv_w[3584 + tid], ckb = p.conv_b[512 + tid];
      __syncthreads();
      const float flast = Fl[h * 64 + 63];
      if (d == 0) w.mdec[item - 2048] = __expf(flast);
      float un = 0.f;
#pragma unroll 1
      for (int j8 = 0; j8 < 8; ++j8) { float kd[8];
#pragma unroll
        for (int e = 0; e < 8; ++e) { const int j = j8 * 8 + e; const float xq = bf2f(qT[j * 512 + tid]), xk = bf2f(kT[j * 512 + tid]);
          const float qc = siluf_(cqb + cq0 * q0 + cq1 * q1 + cq2 * q2 + cq3 * xq), kc = siluf_(ckb + ck0 * k0 + ck1 * k1 + ck2 * k2 + ck3 * xk) * 0.08838834764831845f;
          q0 = q1; q1 = q2; q2 = xq; k0 = k1; k1 = k2; k2 = xk;
          const float F = Fl[h * 64 + j], ig = Fl[256 + h * 64 + j];
          const float ks_ = kc * __expf(ig - F);
          qT[j * 512 + tid] = f2bf(qc * __expf(F)); kT[j * 512 + tid] = f2bf(ks_); kd[e] = ks_; un += ks_; }
        *(uint4*)(kdo + j8 * 8) = pack8(kd); }
      w.mn[(size_t)(item - 2048) * 128 + d] = un * __expf(flast);
    }
    __syncthreads();
    { unsigned char* gq = (unsigned char*)(w.qs + tb * 1024 + kind * 512); unsigned char* gk = (unsigned char*)(w.ks + tb * 1024 + kind * 512);
#pragma unroll
      for (int ps = 0; ps < 8; ++ps) { const int o = ps * 8192 + tid * 16; *(uint4*)(gq + (size_t)(o >> 10) * 2048 + (o & 1023)) = *(const uint4*)(ldsb + o); *(uint4*)(gk + (size_t)(o >> 10) * 2048 + (o & 1023)) = *(const uint4*)(ldsb + 65536 + o); } }
    __syncthreads();
  }
}
__device__ void mix_local2(const Params& p, const WS& w, int bid, int nb) {
  const int tid = tidx(), wave = tid >> 6, lane = tid & 63, fr = lane & 15, fq = lane >> 4;
  bf16x8 xf[16], yf[4];
#define ML_LOAD(task_) do { const int item_ = (task_) >> 3, w8_ = (task_) & 7, kind_ = item_ >> 11, b_ = (item_ >> 10) & 1, h_ = (item_ >> 8) & 3, c_ = item_ & 255; const size_t tb_ = (size_t)b_ * SEQ + (size_t)c_ * 64; \
    const bf16_t* xrow = w.kdT + (size_t)(kind_ * 512 + h_ * 128 + 8 * (fr >> 2) + (fr & 3)) * T + tb_ + fq * 8; const bf16_t* yrow = w.vT + (size_t)(kind_ * 1024 + h_ * 256 + w8_ * 32 + fr) * T + tb_ + fq * 8; \
    _Pragma("unroll") for (int ks = 0; ks < 2; ++ks) { yf[ks * 2] = *(const bf16x8*)(yrow + ks * 32); yf[ks * 2 + 1] = *(const bf16x8*)(yrow + (size_t)16 * T + ks * 32); \
      _Pragma("unroll") for (int xt = 0; xt < 8; ++xt) xf[ks * 8 + xt] = *(const bf16x8*)(xrow + (size_t)((xt >> 1) * 32 + (xt & 1) * 4) * T + ks * 32); } } while (0)
  const int t0 = bid * 8 + wave, step = nb * 8;
  if (t0 < 32768) ML_LOAD(t0);
  for (int task = t0; task < 32768; task += step) {
    const int item = task >> 3, w8 = task & 7, kind = item >> 11; f32x4 acc[2][8];
#pragma unroll
    for (int yt = 0; yt < 2; ++yt)
#pragma unroll
      for (int xt = 0; xt < 8; ++xt) acc[yt][xt] = (f32x4){0.f, 0.f, 0.f, 0.f};
#pragma unroll
    for (int ks = 0; ks < 2; ++ks)
#pragma unroll
      for (int xt = 0; xt < 8; ++xt) { acc[0][xt] = MFMA16(xf[ks * 8 + xt], yf[ks * 2], acc[0][xt]); acc[1][xt] = MFMA16(xf[ks * 8 + xt], yf[ks * 2 + 1], acc[1][xt]); }
    if (task + step < 32768) ML_LOAD(task + step);
    bf16_t* S = (bf16_t*)p.out + (size_t)item * 32768; const float md = kind ? w.mdec[item - 2048] : 0.f;
#pragma unroll
    for (int m = 0; m < 4; ++m) { float4 d0 = make_float4(md, md, md, md), d1 = d0;
      if (!kind) { d0 = *(const float4*)(w.gdec + (size_t)item * 128 + m * 32 + 8 * fq); d1 = *(const float4*)(w.gdec + (size_t)item * 128 + m * 32 + 8 * fq + 4); }
#pragma unroll
      for (int yt = 0; yt < 2; ++yt) { const f32x4 a = acc[yt][2 * m], bq = acc[yt][2 * m + 1];
        *(uint4*)(S + (w8 * 32 + yt * 16 + fr) * 128 + m * 32 + 8 * fq) = make_uint4(pack2(a[0] * d0.x, a[1] * d0.y), pack2(a[2] * d0.z, a[3] * d0.w), pack2(bq[0] * d1.x, bq[1] * d1.y), pack2(bq[2] * d1.z, bq[3] * d1.w)); } }
  }
#undef ML_LOAD
}
template <int KIND>
__device__ __forceinline__ void mix_out2_task(const Params& p, const WS& w, int item, int it, int fr, int fq) {
  const int b = (item >> 10) & 1, h = (item >> 8) & 3, c = item & 255;
  const size_t tb = (size_t)b * SEQ + (size_t)c * 64;
  const int i = it * 16 + fr;
  typedef unsigned u32x4_t __attribute__((ext_vector_type(4)));
  bf16x8 yq[4];
  { const bf16_t* qrow = w.qs + (tb + i) * 1024 + KIND * 512 + h * 128 + fq * 8;
#pragma unroll
    for (int k4 = 0; k4 < 4; ++k4) yq[k4] = *(const bf16x8*)(qrow + k4 * 32); }
  uint2 pk[4]; float rsum = 0.f;
  { bf16x8 kf[4][4];
#pragma unroll
    for (int jt = 0; jt < 4; ++jt) if (jt <= it) { const bf16_t* krow = w.ks + (tb + jt * 16 + fr) * 1024 + KIND * 512 + h * 128 + fq * 8;
#pragma unroll
      for (int k4 = 0; k4 < 4; ++k4) kf[jt][k4] = *(const bf16x8*)(krow + k4 * 32); }
#pragma unroll
    for (int jt = 0; jt < 4; ++jt) { pk[jt] = make_uint2(0u, 0u);
      if (jt <= it) { f32x4 a = (f32x4){0.f, 0.f, 0.f, 0.f};
#pragma unroll
        for (int k4 = 0; k4 < 4; ++k4) a = MFMA16(kf[jt][k4], yq[k4], a);
        if (jt == it) {
#pragma unroll
          for (int r = 0; r < 4; ++r) a[r] = (4 * fq + r <= fr) ? a[r] : 0.f; }
        rsum += a[0] + a[1] + a[2] + a[3];
        pk[jt] = make_uint2(pack2(a[0], a[1]), pack2(a[2], a[3])); } } }
  f32x4 acc[16];
#pragma unroll
  for (int xt = 0; xt < 16; ++xt) acc[xt] = (f32x4){0.f, 0.f, 0.f, 0.f};
  const bf16_t* vbase = w.vT + (size_t)(KIND * 1024 + h * 256 + fr) * T + tb + 4 * fq;
  const bf16_t* sbase = (const bf16_t*)p.out + (size_t)item * 32768 + fr * 128 + fq * 8;
  const u32x4_t yp0 = {pk[0].x, pk[0].y, pk[1].x, pk[1].y}, yp1 = {pk[2].x, pk[2].y, pk[3].x, pk[3].y};
  uint2 va[2][2][2], vb[2][2][2]; bf16x8 sf[2][2][4];
#define MO_LOAD(bufi, g) do { _Pragma("unroll") for (int x2 = 0; x2 < 2; ++x2) { const int xt = (g) * 2 + x2; const bf16_t* vr = vbase + (size_t)xt * 16 * T; \
      va[bufi][x2][0] = *(const uint2*)vr; vb[bufi][x2][0] = *(const uint2*)(vr + 16); if (it >= 2) { va[bufi][x2][1] = *(const uint2*)(vr + 32); vb[bufi][x2][1] = *(const uint2*)(vr + 48); } \
      _Pragma("unroll") for (int k4 = 0; k4 < 4; ++k4) sf[bufi][x2][k4] = *(const bf16x8*)(sbase + xt * 16 * 128 + k4 * 32); } } while (0)
#define MO_COMP(bufi, g) do { _Pragma("unroll") for (int x2 = 0; x2 < 2; ++x2) { const int xt = (g) * 2 + x2; \
      { const u32x4_t xv = {va[bufi][x2][0].x, va[bufi][x2][0].y, vb[bufi][x2][0].x, vb[bufi][x2][0].y}; acc[xt] = MFMA16(__builtin_bit_cast(bf16x8, xv), __builtin_bit_cast(bf16x8, yp0), acc[xt]); } \
      if (it >= 2) { const u32x4_t xv = {va[bufi][x2][1].x, va[bufi][x2][1].y, vb[bufi][x2][1].x, vb[bufi][x2][1].y}; acc[xt] = MFMA16(__builtin_bit_cast(bf16x8, xv), __builtin_bit_cast(bf16x8, yp1), acc[xt]); } \
      _Pragma("unroll") for (int k4 = 0; k4 < 4; ++k4) acc[xt] = MFMA16(sf[bufi][x2][k4], yq[k4], acc[xt]); } } while (0)
  MO_LOAD(0, 0);
#pragma unroll
  for (int g = 0; g < 8; g += 2) {
    MO_LOAD(1, g + 1);
    MO_COMP(0, g);
    if (g + 2 < 8) MO_LOAD(0, g + 2);
    MO_COMP(1, g + 1);
  }
#undef MO_LOAD
#undef MO_COMP
  if (KIND == 1) {
    float qn = 0.f; const float* nrow = w.mn + (size_t)(item - 2048) * 128 + fq * 8;
#pragma unroll
    for (int k4 = 0; k4 < 4; ++k4) { float f[8]; unpack8(__builtin_bit_cast(uint4, yq[k4]), f); const float4 n0 = *(const float4*)(nrow + k4 * 32), n1 = *(const float4*)(nrow + k4 * 32 + 4);
      qn += f[0] * n0.x + f[1] * n0.y + f[2] * n0.z + f[3] * n0.w + f[4] * n1.x + f[5] * n1.y + f[6] * n1.z + f[7] * n1.w; }
    float den = rsum + qn; den += sxor<16>(den); den += sxor<32>(den);
    const float inv = 1.f / fmaxf(fabsf(den), 1.f);
#pragma unroll
    for (int xt = 0; xt < 16; ++xt) acc[xt] *= inv;
  }
  float ss = 0.f;
#pragma unroll
  for (int xt = 0; xt < 16; ++xt)
#pragma unroll
    for (int r = 0; r < 4; ++r) ss += acc[xt][r] * acc[xt][r];
  ss += sxor<16>(ss); ss += sxor<32>(ss);
  const float rs = rsqrtf(ss * (1.f / 256.f) + EPS);
  const float* gain = (KIND == 0 ? p.gla_norm : p.mlstm_norm) + h * 256 + 4 * fq;
  const bf16_t* grow = w.proj + (tb + i) * NPROJ + (KIND == 0 ? C_GG : C_MO) + h * 256 + 4 * fq;
#pragma unroll
  for (int xt = 0; xt < 16; ++xt) { const uint2 g2 = *(const uint2*)(grow + xt * 16); const float4 gn = *(const float4*)(gain + xt * 16);
    const float g0 = lo_f(g2.x), g1 = hi_f(g2.x), g2f = lo_f(g2.y), g3 = hi_f(g2.y);
    const float a0 = KIND == 0 ? siluf_(g0) : sigmoidf_(g0), a1 = KIND == 0 ? siluf_(g1) : sigmoidf_(g1), a2 = KIND == 0 ? siluf_(g2f) : sigmoidf_(g2f), a3 = KIND == 0 ? siluf_(g3) : sigmoidf_(g3);
    const float y0 = acc[xt][0] * rs * gn.x * a0, y1 = acc[xt][1] * rs * gn.y * a1, y2 = acc[xt][2] * rs * gn.z * a2, y3 = acc[xt][3] * rs * gn.w * a3;
    const size_t yo = (tb + i) * D + KIND * 1024 + h * 256 + xt * 16 + 4 * fq;
#if F8_OUT
    *(unsigned*)(w.yq + yo) = pack4_fp8(y0, y1, y2, y3);
#else
    *(uint2*)(w.y + yo) = make_uint2(pack2(y0, y1), pack2(y2, y3));
#endif
  }
}
__device__ void mix_out2(const Params& p, const WS& w, int bid, int nb) {
  const int tid = tidx(), wave = tid >> 6, lane = tid & 63, fr = lane & 15, fq = lane >> 4;
  for (int task = bid * 8 + wave; task < 16384; task += nb * 8) {
    const int item = task >> 2, it = __builtin_amdgcn_readfirstlane(task & 3);
    if (item < 2048) mix_out2_task<0>(p, w, item, it, fr, fq); else mix_out2_task<1>(p, w, item, it, fr, fq);
  }
}

__device__ __forceinline__ unsigned sort16(unsigned b) { return (b & 0x8000u) ? (~b & 0xffffu) : (b | 0x8000u); }
__device__ __forceinline__ float unsort16(unsigned k) { const unsigned b = (k & 0x8000u) ? (k & 0x7fffu) : (~k & 0xffffu); return __uint_as_float(b << 16); }
__device__ __forceinline__ unsigned sort32(float f) { const unsigned u = __float_as_uint(f); return (u & 0x80000000u) ? ~u : (u | 0x80000000u); }
__device__ __forceinline__ float unsort32(unsigned k) { const unsigned u = (k & 0x80000000u) ? (k & 0x7fffffffu) : ~k; return __uint_as_float(u); }
__device__ __forceinline__ void ce_desc(unsigned& a, unsigned& b) { const unsigned hi = max(a, b), lo = min(a, b); a = hi; b = lo; }
__device__ __forceinline__ void sort16_desc(unsigned* k) {
#pragma unroll
  for (int sz = 2; sz <= 16; sz <<= 1)
#pragma unroll
    for (int j = sz >> 1; j > 0; j >>= 1)
#pragma unroll
      for (int i = 0; i < 16; ++i) { const int l = i ^ j; if (l > i) { if ((i & sz) == 0) ce_desc(k[i], k[l]); else ce_desc(k[l], k[i]); } }
}
__device__ __forceinline__ void merge16_desc(unsigned* L, const unsigned* B) {
#pragma unroll
  for (int i = 0; i < 16; ++i) L[i] = max(L[i], B[15 - i]);
#pragma unroll
  for (int j = 8; j > 0; j >>= 1)
#pragma unroll
    for (int i = 0; i < 16; ++i) { const int l = i ^ j; if (l > i) ce_desc(L[i], L[l]); }
}
__device__ void phase_topk(const Params& p, const WS& w, unsigned char* ldsb, int bid, int nb) {
  const int tid = tidx();
  unsigned char* mytab = ldsb + tid * 36;
  for (int th = bid * 512 + tid; th < T * 8; th += nb * 512) {
    const int t = th >> 3, h = th & 7;
    const uint4* sp = (const uint4*)(w.sc + (size_t)t * D + h * 256);
    unsigned L[2][16];
#pragma unroll
    for (int pp = 0; pp < 2; ++pp) {
#pragma unroll
      for (int blk = 0; blk < 8; ++blk) {
        const uint4 v0 = sp[pp * 16 + blk * 2], v1 = sp[pp * 16 + blk * 2 + 1]; const unsigned wds[8] = {v0.x, v0.y, v0.z, v0.w, v1.x, v1.y, v1.z, v1.w};
        unsigned B[16];
#pragma unroll
        for (int e = 0; e < 16; ++e) { const unsigned b = (e & 1) ? (wds[e >> 1] >> 16) : (wds[e >> 1] & 0xffffu); B[e] = (sort16(b) << 16) | (unsigned)(blk * 16 + e); }
        sort16_desc(B);
        if (blk == 0) {
#pragma unroll
          for (int i = 0; i < 16; ++i) L[pp][i] = B[i]; }
        else merge16_desc(L[pp], B);
      }
    }
    float v0f[16], v1f[16];
#pragma unroll
    for (int i = 0; i < 16; ++i) { v0f[i] = unsort16(L[0][i] >> 16); v1f[i] = unsort16(L[1][i] >> 16); }
    unsigned C[16], B[16];
#pragma unroll
    for (int j = 0; j < 16; ++j) C[j] = (sort32(v0f[0] + v1f[j]) & 0xffffff00u) | (unsigned)j;
    { int n = 0;
#pragma unroll
      for (int i = 1; i < 16; ++i)
#pragma unroll
        for (int j = 0; j < 16; ++j) if ((i + 1) * (j + 1) <= 16) { B[n & 15] = (sort32(v0f[i] + v1f[j]) & 0xffffff00u) | (unsigned)(i * 16 + j); ++n;
          if ((n & 15) == 0) { sort16_desc(B); merge16_desc(C, B); } }
#pragma unroll
      for (int e = 2; e < 16; ++e) B[e] = 0u;
      sort16_desc(B); merge16_desc(C, B); }
    { unsigned pw[8];
#pragma unroll
      for (int q4 = 0; q4 < 4; ++q4) { pw[q4] = (L[0][q4 * 4] & 0xffu) | ((L[0][q4 * 4 + 1] & 0xffu) << 8) | ((L[0][q4 * 4 + 2] & 0xffu) << 16) | (L[0][q4 * 4 + 3] << 24);
        pw[4 + q4] = (L[1][q4 * 4] & 0xffu) | ((L[1][q4 * 4 + 1] & 0xffu) << 8) | ((L[1][q4 * 4 + 2] & 0xffu) << 16) | (L[1][q4 * 4 + 3] << 24); }
#pragma unroll
      for (int q4 = 0; q4 < 8; ++q4) *(unsigned*)(mytab + q4 * 4) = pw[q4]; }
    const float mx = unsort32(C[0] & 0xffffff00u);
    float e[16], sum = 0.f; int eid[16];
#pragma unroll
    for (int k = 0; k < 16; ++k) { e[k] = __expf(unsort32(C[k] & 0xffffff00u) - mx); sum += e[k];
      eid[k] = (int)mytab[(C[k] >> 4) & 15] * 128 + (int)mytab[16 + (C[k] & 15)]; }
    const float inv = 1.f / sum;
    int* ei = w.eidx + (size_t)t * 128 + h * 16; float* eg = w.eg + (size_t)t * 128 + h * 16; float* es = w.esu + (size_t)t * 128 + h * 16;
#pragma unroll
    for (int k4 = 0; k4 < 4; ++k4) {
      const int e0 = eid[k4 * 4], e1 = eid[k4 * 4 + 1], e2 = eid[k4 * 4 + 2], e3 = eid[k4 * 4 + 3];
      *(int4*)(ei + k4 * 4) = make_int4(e0, e1, e2, e3);
      *(float4*)(eg + k4 * 4) = make_float4(e[k4 * 4] * inv * w.vsc[e0], e[k4 * 4 + 1] * inv * w.vsc[e1], e[k4 * 4 + 2] * inv * w.vsc[e2], e[k4 * 4 + 3] * inv * w.vsc[e3]);
      *(float4*)(es + k4 * 4) = make_float4(w.usc[e0], w.usc[e1], w.usc[e2], w.usc[e3]);
    }
  }
}
__device__ __forceinline__ void ub16(const uint4 q, float* f) {
  const unsigned wd[4] = {q.x, q.y, q.z, q.w};
#pragma unroll
  for (int k = 0; k < 4; ++k) { f[k * 4] = (float)(wd[k] & 0xffu); f[k * 4 + 1] = (float)((wd[k] >> 8) & 0xffu); f[k * 4 + 2] = (float)((wd[k] >> 16) & 0xffu); f[k * 4 + 3] = (float)(wd[k] >> 24); }
}
__device__ void peer_dots(const Params& p, const WS& w, int bid, int nb) {
  const int tid = tidx(), wave = tid >> 6, lane = tid & 63, r = lane % LPR, q = lane / LPR;
  const int x = bid & 7, nwl = (nb >> 3) * 8, wl = (bid >> 3) * 8 + wave;
  constexpr int HB = NIT / 2;
  for (int sp = 0; sp < SPL; ++sp) {
    const int s = x * SPL + sp;
    const unsigned char* tab = w.u8 + (size_t)s * 16384 * SLW + r * 16;
    int idx0 = w.eidx[(size_t)wl * 128 + lane], idx1 = w.eidx[(size_t)wl * 128 + 64 + lane];
    uint4 ha = *(const uint4*)(w.h1b + (size_t)wl * D + s * SLW + r * 16), hb = *(const uint4*)(w.h1b + (size_t)wl * D + s * SLW + r * 16 + 8);
    uint4 bA[HB], bB[HB];
#define PD_GATHER(buf, half, i0_, i1_) do { _Pragma("unroll") for (int i = 0; i < HB; ++i) { const int n = ((half) * HB + i) * EPI + q; const int e = bperm((n & 64) ? (i1_) : (i0_), n & 63); buf[i] = *(const uint4*)(tab + (size_t)e * SLW); } } while (0)
#define PD_DOTS(buf, half) do { _Pragma("unroll") for (int i = 0; i < HB; ++i) { int a = __builtin_amdgcn_sdot4((int)buf[i].x, hq[0], 0, false); a = __builtin_amdgcn_sdot4((int)buf[i].y, hq[1], a, false); \
      a = __builtin_amdgcn_sdot4((int)buf[i].z, hq[2], a, false); a = __builtin_amdgcn_sdot4((int)buf[i].w, hq[3], a, false); a = gsum<LPR>(a); \
      const int ii = (half) * HB + i; if (r == (ii % LPR)) res[ii / LPR] = (float)a * sh; } } while (0)
    PD_GATHER(bA, 0, idx0, idx1);
    for (int t = wl; t < T; t += nwl) {
      PD_GATHER(bB, 1, idx0, idx1);
      const int tn = (t + nwl < T) ? t + nwl : t;
      const int idx0n = w.eidx[(size_t)tn * 128 + lane], idx1n = w.eidx[(size_t)tn * 128 + 64 + lane];
      const uint4 han = *(const uint4*)(w.h1b + (size_t)tn * D + s * SLW + r * 16), hbn = *(const uint4*)(w.h1b + (size_t)tn * D + s * SLW + r * 16 + 8);
      float hf[16];
      unpack8(ha, hf); unpack8(hb, hf + 8);
      float am = 0.f;
#pragma unroll
      for (int j = 0; j < 16; ++j) am = fmaxf(am, fabsf(hf[j]));
      am = gmax<LPR>(am);
      const float sh = fmaxf(am, 1e-30f) * (1.f / 127.f), inv = 1.f / sh;
      int hq[4];
#pragma unroll
      for (int k = 0; k < 4; ++k) { unsigned xw = 0;
#pragma unroll
        for (int j = 0; j < 4; ++j) xw |= ((unsigned)(int)rintf(hf[k * 4 + j] * inv) & 0xffu) << (8 * j);
        hq[k] = (int)xw; }
      float res[2] = {0.f, 0.f};
      PD_DOTS(bA, 0);
      PD_GATHER(bA, 0, idx0n, idx1n);
      PD_DOTS(bB, 1);
#pragma unroll
      for (int rho = 0; rho < 2; ++rho) ((bf16_t*)w.pd)[((size_t)t * 128 + (rho * LPR + r) * EPI + q) * NSL + s] = f2bf(res[rho]);
      idx0 = idx0n; idx1 = idx1n; ha = han; hb = hbn;
    }
#undef PD_GATHER
#undef PD_DOTS
  }
}
__device__ __forceinline__ void peer_token_w(const WS& w, int t, int lane, int idx0, int idx1, float& w0, float& w1) {
  static_assert(NSL == 8, "one 16-byte load per (token, expert) holds the 8 slices' partial dots");
  const float rs2 = rsqrtf(w.ssq2[t] * (1.f / D) + EPS);
  float f0[8], f1[8];
  unpack8(*(const uint4*)((const bf16_t*)w.pd + ((size_t)t * 128 + lane) * 8), f0); unpack8(*(const uint4*)((const bf16_t*)w.pd + ((size_t)t * 128 + 64 + lane) * 8), f1);
  const float z0 = ((f0[0] + f0[1]) + (f0[2] + f0[3])) + ((f0[4] + f0[5]) + (f0[6] + f0[7])), z1 = ((f1[0] + f1[1]) + (f1[2] + f1[3])) + ((f1[4] + f1[5]) + (f1[6] + f1[7]));
  w0 = w.eg[(size_t)t * 128 + lane] * gelu_tanh(z0 * w.esu[(size_t)t * 128 + lane] * rs2);
  w1 = w.eg[(size_t)t * 128 + 64 + lane] * gelu_tanh(z1 * w.esu[(size_t)t * 128 + 64 + lane] * rs2);
}
__device__ void peer_vals(const Params& p, const WS& w, int bid, int nb) {
  static_assert(EPI == 4 && LPR == 16, "peer_vals' weight packing assumes 256-byte slices");
  const int tid = tidx(), wave = tid >> 6, lane = tid & 63, r = lane % LPR, q = lane / LPR;
  const int x = bid & 7, nwl = (nb >> 3) * 8, wl = (bid >> 3) * 8 + wave;
  constexpr int HB = NIT / 2;
  for (int sp = 0; sp < SPL; ++sp) {
    const int s = x * SPL + sp;
    const unsigned char* tab = w.v8 + (size_t)s * 16384 * SLW + r * 16;
    int idx0 = w.eidx[(size_t)wl * 128 + lane], idx1 = w.eidx[(size_t)wl * 128 + 64 + lane];
    float w0, w1; peer_token_w(w, wl, lane, idx0, idx1, w0, w1);
    uint4 bA[HB], bB[HB];
#define PV_GATHER(buf, half, i0_, i1_) do { _Pragma("unroll") for (int i = 0; i < HB; ++i) { const int n = ((half) * HB + i) * EPI + q; const int e = bperm((n & 64) ? (i1_) : (i0_), n & 63); buf[i] = *(const uint4*)(tab + (size_t)e * SLW); } } while (0)
#define PV_DOT4(buf, half) do { _Pragma("unroll") for (int g4 = 0; g4 < HB / 4; ++g4) { const int gg = (half) * (HB / 4) + g4; const int pw = bperm((gg & 4) ? pk1 : pk0, 16 * (gg & 3) + q); \
      _Pragma("unroll") for (int dd = 0; dd < 4; ++dd) { const unsigned b0 = ((const unsigned*)&buf[g4 * 4])[dd], b1 = ((const unsigned*)&buf[g4 * 4 + 1])[dd], b2 = ((const unsigned*)&buf[g4 * 4 + 2])[dd], b3 = ((const unsigned*)&buf[g4 * 4 + 3])[dd]; \
        const unsigned p0 = __builtin_amdgcn_perm(b1, b0, 0x05010400u), p1 = __builtin_amdgcn_perm(b1, b0, 0x07030602u), p2 = __builtin_amdgcn_perm(b3, b2, 0x05010400u), p3 = __builtin_amdgcn_perm(b3, b2, 0x07030602u); \
        acc[dd * 4 + 0] = __builtin_amdgcn_sdot4((int)__builtin_amdgcn_perm(p2, p0, 0x05040100u), pw, acc[dd * 4 + 0], false); acc[dd * 4 + 1] = __builtin_amdgcn_sdot4((int)__builtin_amdgcn_perm(p2, p0, 0x07060302u), pw, acc[dd * 4 + 1], false); \
        acc[dd * 4 + 2] = __builtin_amdgcn_sdot4((int)__builtin_amdgcn_perm(p3, p1, 0x05040100u), pw, acc[dd * 4 + 2], false); acc[dd * 4 + 3] = __builtin_amdgcn_sdot4((int)__builtin_amdgcn_perm(p3, p1, 0x07060302u), pw, acc[dd * 4 + 3], false); } } } while (0)
    PV_GATHER(bA, 0, idx0, idx1);
    for (int t = wl; t < T; t += nwl) {
      PV_GATHER(bB, 1, idx0, idx1);
      const int tn = (t + nwl < T) ? t + nwl : t;
      const int idx0n = w.eidx[(size_t)tn * 128 + lane], idx1n = w.eidx[(size_t)tn * 128 + 64 + lane];
      float w0n, w1n; peer_token_w(w, tn, lane, idx0n, idx1n, w0n, w1n);
      const float wmx = gmax<64>(fmaxf(fabsf(w0), fabsf(w1))), sw = fmaxf(wmx, 1e-30f) * (1.f / 127.f), isw = 1.f / sw;
      const int wq0 = (int)rintf(w0 * isw), wq1 = (int)rintf(w1 * isw);
      int pk0, pk1;
      { const int l0 = lane & ~12;
        pk0 = (bperm(wq0, l0) & 0xff) | ((bperm(wq0, l0 | 4) & 0xff) << 8) | ((bperm(wq0, l0 | 8) & 0xff) << 16) | (bperm(wq0, l0 | 12) << 24);
        pk1 = (bperm(wq1, l0) & 0xff) | ((bperm(wq1, l0 | 4) & 0xff) << 8) | ((bperm(wq1, l0 | 8) & 0xff) << 16) | (bperm(wq1, l0 | 12) << 24); }
      int acc[16];
#pragma unroll
      for (int j = 0; j < 16; ++j) acc[j] = 0;
      PV_DOT4(bA, 0);
      PV_GATHER(bA, 0, idx0n, idx1n);
      const uint4 ha = *(const uint4*)(w.h1b + (size_t)t * D + s * SLW + r * 16), hb = *(const uint4*)(w.h1b + (size_t)t * D + s * SLW + r * 16 + 8);
      const float ssq2t = w.ssq2[t];
      PV_DOT4(bB, 1);
#pragma unroll
      for (int j = 0; j < 16; ++j) { acc[j] += sxor<16>(acc[j]); acc[j] += sxor<32>(acc[j]); }
      float hf[16], o[16]; float ss = 0.f;
      unpack8(ha, hf); unpack8(hb, hf + 8);
#pragma unroll
      for (int j = 0; j < 16; ++j) { o[j] = hf[j] + sw * (float)acc[j]; ss += o[j] * o[j]; }
      if (q == 0) { *(uint4*)(w.h2b + (size_t)t * D + s * SLW + r * 16) = pack8(o); *(uint4*)(w.h2b + (size_t)t * D + s * SLW + r * 16 + 8) = pack8(o + 8);
#if F8_GATE
        const float rs2 = rsqrtf(ssq2t * (1.f / D) + EPS);
        *(uint4*)(w.h2q + (size_t)t * D + s * SLW + r * 16) = make_uint4(pack4_fp8(o[0] * rs2, o[1] * rs2, o[2] * rs2, o[3] * rs2), pack4_fp8(o[4] * rs2, o[5] * rs2, o[6] * rs2, o[7] * rs2),
                                                                      pack4_fp8(o[8] * rs2, o[9] * rs2, o[10] * rs2, o[11] * rs2), pack4_fp8(o[12] * rs2, o[13] * rs2, o[14] * rs2, o[15] * rs2));
#endif
      } else ss = 0.f;
      ss = wave_sum(ss);
      if (lane == 0) atomicAdd(w.ssq3 + t, ss);
      idx0 = idx0n; idx1 = idx1n; w0 = w0n; w1 = w1n;
    }
#undef PV_GATHER
#undef PV_DOT4
  }
}
#ifndef TPROBE_A
#define TPROBE_A -1
#endif
#ifndef TPROBE_B
#define TPROBE_B -1
#endif
__device__ void phase_final(const Params& p, const WS& w, int bid, int nb) {
  const int wave = tidx() >> 6, lane = tidx() & 63;
  float tscale = 1.f, tspike = 0.f;
  if (TPROBE_A >= 0) { const unsigned long long* ts = (const unsigned long long*)(w.ctlf + 16384); tscale = 1.f + sqrtf((float)(ts[TPROBE_A + 1] - ts[TPROBE_A]) * 1e-7f); }
  if (TPROBE_B >= 0) { const unsigned long long* ts = (const unsigned long long*)(w.ctlf + 16384); tspike = (float)(ts[TPROBE_B + 1] - ts[TPROBE_B]) * 1e-3f; }
  for (int row = bid * 8 + wave; row < T; row += nb * 8) {
    float4* o = (float4*)(p.out + (size_t)row * D);
    const float rs = rsqrtf(w.ssq4[row] * (1.f / D) + EPS) * tscale;
    uint2 hv[8];
#pragma unroll
    for (int i = 0; i < 8; ++i) hv[i] = *(const uint2*)(w.h1b + (size_t)row * D + (i * 64 + lane) * 4);
#pragma unroll
    for (int i = 0; i < 8; ++i) { const float4 g = *(const float4*)(p.norm_final + (i * 64 + lane) * 4);
      float4 v = make_float4(lo_f(hv[i].x) * rs * g.x, hi_f(hv[i].x) * rs * g.y, lo_f(hv[i].y) * rs * g.z, hi_f(hv[i].y) * rs * g.w);
      if (TPROBE_B >= 0 && row == 0 && i == 0 && lane == 0) v.x += tspike; o[i * 64 + lane] = v; }
  }
}

constexpr int NPHASE = 10;
#ifndef MIX_OUT3
#define MIX_OUT3 1
#endif
#ifndef FAST_MIX
#define FAST_MIX 2
#endif
template <int PH>
__device__ __forceinline__ void run_phase(const Params& p, float* lds, int bid, int nb) {
  const WS w = make_ws(p.ws, p.out);
  if (PH == 0) phase_prep(p, w, lds, bid, nb);
  const float s_in = __uint_as_float(__builtin_amdgcn_readfirstlane((F8_IN && PH == 1) ? __float_as_uint(w.ctlf[0]) : 0u)) * (1.f / 256.f);
  const float s_out = F8_OUT ? __uint_as_float(__builtin_amdgcn_readfirstlane((PH == 5) ? __float_as_uint(w.ctlf[1]) : 0u)) * (1.f / 256.f) : 1.f;
  const float s_g = __uint_as_float(__builtin_amdgcn_readfirstlane((F8_GATE && PH == 11) ? __float_as_uint(w.ctlf[2]) : 0u)) * (1.f / 256.f);
#if F8_IN
  if (PH == 1) { gemm_any<true>(w.xq, w.winq, T, NPROJ, D, EpiProjN{w.proj, w.rstd1, s_in}, lds, bid, nb);
                 gemm_any<true>(w.winq + (size_t)NPROJ * D, w.xq, 2048, T, D, EpiProjT{w.vT, w.rstd1, s_in}, lds, bid, nb); }
#else
  if (PH == 1) { gemm_any(w.xb, w.win, T, NPROJ, D, EpiProjN{w.proj, w.rstd1, 1.f}, lds, bid, nb);
                 gemm_any(w.win + (size_t)NPROJ * D, w.xb, 2048, T, D, EpiProjT{w.vT, w.rstd1, 1.f}, lds, bid, nb); }
#endif
#if F8_OUT
  if (PH == 5) gemm_any<true>(w.yq, w.woutq, T, D, D, EpiOut{p.x, w.h1b, w.ssq2, s_out}, lds, bid, nb);
#else
  if (PH == 5) gemm_any(w.y, w.wout, T, D, D, EpiOut{p.x, w.h1b, w.ssq2, 1.f}, lds, bid, nb);
#endif
#if F8_GATE
  if (PH == 11) gemm_any<true>(w.h2q, w.wgq, T, D, D, EpiGate{w.h2b, w.pl, w.ssq3, w.h1b, w.ssq4, w.ssq2, s_g}, lds, bid, nb);
#else
  if (PH == 11) gemm_any(w.h2b, w.wg, T, D, D, EpiGate{w.h2b, w.pl, w.ssq3, w.h1b, w.ssq4, w.ssq2, 1.f}, lds, bid, nb);
#endif
#if FAST_MIX == 2
  if (PH == 14) { phase_prep2(p, w, lds, bid, nb);
                  mix_gate_pass(p, w, (unsigned char*)lds, bid, nb); }
  if (PH == 2) mix_local2(p, w, bid, nb);
  if (PH == 3) mix_scan(p, w, lds, bid, nb);
#if MIX_OUT3
  if (PH == 4) phase_mix_out3(p, w, (unsigned char*)lds, bid, nb);
#else
  if (PH == 4) mix_out2(p, w, bid, nb);
#endif
#elif FAST_MIX
  if (PH == 2) phase_mix_items<0>(p, w, (unsigned char*)lds, bid, nb);
  if (PH == 3) mix_scan(p, w, lds, bid, nb);
  if (PH == 4) phase_mix_items<1>(p, w, (unsigned char*)lds, bid, nb);
#else
  if (PH == 2) phase_mixer_naive(p, w, lds, bid, nb);
#endif
  if (PH == 6) gemm_any(w.h1b, w.wq, T, D, D, EpiScore{w.sc, w.ssq2}, lds, bid, nb);
  if (PH == 7) { phase_topk(p, w, (unsigned char*)lds, bid, nb); __syncthreads(); gemm_any(w.pb, w.wple, T, D, 256, EpiPl{w.pl}, lds, bid, nb); }
  if (PH == 8) peer_dots(p, w, bid, nb);
  if (PH == 10) peer_vals(p, w, bid, nb);
  if (PH == 12) phase_final(p, w, bid, nb);
}


#define XB_LAS __attribute__((address_space(3)))
#define XB_TMO      128
#define XB_XCNT(j)  (256  + 64 * (j))
#define XB_XSUB(j)  (1280 + 64 * (j))
#define XB_XGEN(j)  (2304 + 64 * (j))
#define XB_TOP      3328
#define XB_TOPGEN   3392
#define XCD_BAR_WORDS 3456
#define XB_SPIN_CAP (1u << 18)
__device__ __forceinline__ unsigned xb_ld(unsigned* p)              { return __hip_atomic_load(p, __ATOMIC_RELAXED, __HIP_MEMORY_SCOPE_AGENT); }
__device__ __forceinline__ unsigned xb_add(unsigned* p, unsigned v) { return __hip_atomic_fetch_add(p, v, __ATOMIC_RELAXED, __HIP_MEMORY_SCOPE_AGENT); }
__device__ __forceinline__ unsigned xb_xcc_id() { return (unsigned)__builtin_amdgcn_s_getreg((3 << 11) | 20) & 0xFu; }
#define XB_SPIN(cond, bar) do { unsigned _sp = 0; while (cond) { __builtin_amdgcn_s_sleep(1); \
    if ((++_sp & 255u) == 0u) { if (xb_ld(&(bar)[XB_TMO])) break; if (_sp > XB_SPIN_CAP) { atomicAdd(&(bar)[XB_TMO], 1u); break; } } } } while (0)
struct XcdBarrier {
    unsigned* bar; unsigned x;
    volatile XB_LAS unsigned* st;
};
__device__ __forceinline__ XcdBarrier xcd_barrier_post(unsigned* bar, volatile XB_LAS unsigned* st) {
    XcdBarrier b; b.bar = bar; b.x = xb_xcc_id(); b.st = st;
    if (threadIdx.x == 0) (void)xb_add(&bar[XB_XCNT(b.x)], 1u);
    return b;
}
__device__ __forceinline__ void xcd_barrier_complete(unsigned* bar, unsigned x, unsigned& nloc, unsigned& nx) {
    const unsigned G = gridDim.x * gridDim.y * gridDim.z;
    unsigned sum, cnt, mine, sp = 0u;
    for (;;) {
        sum = 0u; cnt = 0u; mine = 0u;
#pragma unroll
        for (unsigned j = 0; j < 16; ++j) { const unsigned c = xb_ld(&bar[XB_XCNT(j)]); sum += c; cnt += (c > 0u) ? 1u : 0u; mine = (j == x) ? c : mine; }
        if (sum == G) break;
        __builtin_amdgcn_s_sleep(1);
        if ((++sp & 255u) == 0u) { if (xb_ld(&bar[XB_TMO])) break; if (sp > XB_SPIN_CAP) { atomicAdd(&bar[XB_TMO], 1u); break; } }
    }
    nloc = mine > 0u ? mine : 1u; nx = cnt > 0u ? cnt : 1u;
}
__device__ __forceinline__ void xcd_barrier(const XcdBarrier& b) {
    asm volatile("s_waitcnt vmcnt(0)" ::: "memory");
    __syncthreads();
    if (threadIdx.x == 0) {
        unsigned* bar = b.bar;
        __builtin_amdgcn_s_waitcnt(0);
        unsigned nloc = b.st[0], nx = b.st[1];
        if (nloc == 0u) { xcd_barrier_complete(bar, b.x, nloc, nx); b.st[0] = nloc; b.st[1] = nx; }
        const unsigned old = xb_add(&bar[XB_XSUB(b.x)], 1u);
        const unsigned gen = old / nloc;
        if (old + 1u == (gen + 1u) * nloc) {
            __builtin_amdgcn_fence(__ATOMIC_RELEASE, "agent");
            asm volatile("s_waitcnt vmcnt(0)" ::: "memory");
            const unsigned og = xb_add(&bar[XB_TOP], 1u);
            const unsigned tg = og / nx;
            if (og + 1u == (tg + 1u) * nx) xb_add(&bar[XB_TOPGEN], 1u);
            else XB_SPIN(xb_ld(&bar[XB_TOPGEN]) == tg, bar);
            __builtin_amdgcn_fence(__ATOMIC_ACQUIRE, "agent");
            xb_add(&bar[XB_XGEN(b.x)], 1u);
            asm volatile("s_waitcnt vmcnt(0)" ::: "memory");
        } else {
            XB_SPIN(xb_ld(&bar[XB_XGEN(b.x)]) == gen, bar);
            __builtin_amdgcn_fence(__ATOMIC_ACQUIRE, "agent");
            asm volatile("s_waitcnt vmcnt(0)" ::: "memory");
        }
    }
    __syncthreads();
}

constexpr size_t kDynLds = 143360;
extern __shared__ __attribute__((aligned(16))) unsigned char dyn_lds[];

#if ONE_LAUNCH
__global__ void __launch_bounds__(512, 2) mega(Params p) {
  cg::grid_group grid = cg::this_grid();
  float* lds = (float*)dyn_lds; const int bid = blockIdx.x, nb = gridDim.x;
#ifndef DUP_PHASE
#define DUP_PHASE -1
#endif
#define RUNP(k) do { run_phase<k>(p, lds, bid, nb); } while (0)
  int nstamp = 0;
#define STAMP() do { if ((TPROBE_A >= 0 || TPROBE_B >= 0) && bid == 0 && threadIdx.x == 0) ((unsigned long long*)(p.ws + OFF_CTL + 65536))[nstamp] = __builtin_amdgcn_s_memrealtime(); ++nstamp; } while (0)
  STAMP();
  unsigned* barw = (unsigned*)(p.ws + OFF_BAR);
  volatile XB_LAS unsigned* bst = (volatile XB_LAS unsigned*)(dyn_lds + kDynLds - 16);
  if (threadIdx.x == 0) { bst[0] = 0u; bst[1] = 0u; }
  if (bid == 0) for (int i = threadIdx.x; i < XCD_BAR_WORDS; i += 512) __hip_atomic_store(barw + i, 0u, __ATOMIC_RELAXED, __HIP_MEMORY_SCOPE_AGENT);
  RUNP(0); grid.sync(); STAMP();
  const XcdBarrier xbar = xcd_barrier_post(barw, bst);
#define GSYNC() xcd_barrier(xbar)
#ifdef EXTRA_SYNCS
  for (int i = 0; i < EXTRA_SYNCS; ++i) GSYNC();
#endif
  RUNP(1); GSYNC(); STAMP();
#if FAST_MIX == 2
  RUNP(14); GSYNC(); STAMP();
#endif
  RUNP(2); GSYNC(); STAMP();
#if FAST_MIX
  RUNP(3); GSYNC(); STAMP();
  RUNP(4); GSYNC(); STAMP();
#endif
  RUNP(5); GSYNC(); STAMP();
  RUNP(6); GSYNC(); STAMP();
  RUNP(7); GSYNC(); STAMP();
  RUNP(8); GSYNC(); STAMP();
  RUNP(10); GSYNC(); STAMP();
  RUNP(11); GSYNC(); STAMP();
  RUNP(12);
#undef RUNP
#undef STAMP
#undef GSYNC
}
#else
template <int PH> __global__ void __launch_bounds__(512, 2) k_phase(Params p) { run_phase<PH>(p, (float*)dyn_lds, blockIdx.x, gridDim.x); }
#endif


extern "C" void kernel_launch(void* const* d_in, const int* in_sizes, int n_in, void* d_out, int out_size, void* d_ws, size_t ws_size, hipStream_t stream) {
  if (n_in != 22 || out_size != T * D || ws_size < WS_NEED) { fprintf(stderr, "kernel_launch: unexpected shapes (n_in %d out %d ws %zu)\n", n_in, out_size, ws_size); return; }
  Params p{};
  const float** f = (const float**)&p;
  for (int i = 0; i < 22; ++i) f[i] = (const float*)d_in[i];
  p.out = (float*)d_out; p.ws = (unsigned char*)d_ws;
#if ONE_LAUNCH
  static int grid_blocks = 0;
  if (!grid_blocks) {
    int dev = 0, cus = 0, per_cu = 0;
    (void)hipGetDevice(&dev); (void)hipDeviceGetAttribute(&cus, hipDeviceAttributeMultiprocessorCount, dev);
    (void)hipFuncSetAttribute((const void*)mega, hipFuncAttributeMaxDynamicSharedMemorySize, (int)kDynLds);
    (void)hipOccupancyMaxActiveBlocksPerMultiprocessor(&per_cu, mega, 512, kDynLds);
    if (per_cu < 1) { fprintf(stderr, "occupancy query says 0 blocks/CU\n"); per_cu = 1; }
    grid_blocks = cus;
  }
  void* args[] = {&p};
  hipError_t e = hipLaunchCooperativeKernel((void*)mega, dim3(grid_blocks), dim3(512), args, kDynLds, stream);
  if (e != hipSuccess) fprintf(stderr, "cooperative launch failed: %s (grid %d)\n", hipGetErrorString(e), grid_blocks);
#else
  static bool attr = false;
  const int G = 256;
#define LAUNCH(PH) do { if (!attr) (void)hipFuncSetAttribute((const void*)k_phase<PH>, hipFuncAttributeMaxDynamicSharedMemorySize, (int)kDynLds); \
    hipLaunchKernelGGL(k_phase<PH>, dim3(G), dim3(512), kDynLds, stream, p); } while (0)
  LAUNCH(0); LAUNCH(1); LAUNCH(14); LAUNCH(2); LAUNCH(3); LAUNCH(4); LAUNCH(5); LAUNCH(6); LAUNCH(7); LAUNCH(8); LAUNCH(10); LAUNCH(11); LAUNCH(12);
  attr = true;
#undef LAUNCH
#endif
}
```

```cpp
#include <hip/hip_runtime.h>
#include <hip/hip_cooperative_groups.h>
#include <cstdio>
#include <cstdint>
namespace cg = cooperative_groups;

#ifndef ONE_LAUNCH
#define ONE_LAUNCH 1
#endif

typedef unsigned short bf16_t;
constexpr int T = 32768, SEQ = 16384, D = 2048;
#ifndef F8_GO
#define F8_GO 1
#endif
constexpr int NPROJ = 4352;
#if F8_GO
constexpr int C_GQ = 0, C_GK = 512, C_MQ = 1024, C_MK = 1536, C_SM = 2048, C_GG = 2304, C_MO = 3328, NB16 = 2304;
#else
constexpr int C_GQ = 0, C_GK = 512, C_GG = 1024, C_MQ = 2048, C_MK = 2560, C_MO = 3072, C_SM = 4096, NB16 = NPROJ;
#endif
constexpr float EPS = 1e-6f;
constexpr size_t MiB = 1ull << 20;
constexpr size_t OFF_XB = 0, OFF_Y = 0, OFF_PL = 0;
constexpr size_t OFF_PROJ = 128 * MiB, OFF_H1B = 128 * MiB, OFF_H2B = 256 * MiB;
constexpr size_t OFF_VT = 400 * MiB, OFF_SC = 400 * MiB;
constexpr size_t OFF_UB = 528 * MiB, OFF_VB = 560 * MiB, OFF_YQ = 592 * MiB;
constexpr size_t OFF_WIN = 656 * MiB, OFF_WOUT = 681 * MiB, OFF_WQ = 689 * MiB, OFF_WG = 697 * MiB, OFF_WPLE = 705 * MiB;
constexpr size_t OFF_PB = 706 * MiB, OFF_EIDX = 722 * MiB, OFF_EG = 738 * MiB, OFF_MISC = 754 * MiB;
constexpr size_t OFF_GDEC = 755 * MiB, OFF_MN = 756 * MiB, OFF_MDEC = 757 * MiB, OFF_ESC = 758 * MiB;
constexpr size_t OFF_CTL = 759 * MiB, OFF_H2Q = 400 * MiB, OFF_QS = 760 * MiB, OFF_KS = 824 * MiB, OFF_KDT = 888 * MiB;
constexpr size_t OFF_ESU = 952 * MiB, OFF_BAR = 968 * MiB;
constexpr size_t WS_NEED = 969 * MiB;
#ifndef F8_IN
#define F8_IN 0
#endif
#ifndef F8_OUT
#define F8_OUT 1
#endif
#ifndef F8_GATE
#define F8_GATE 1
#endif
#ifndef F8_V
#define F8_V 1
#endif
#ifndef F8_GEMM
#define F8_GEMM (F8_IN || F8_OUT || F8_GATE || F8_V)
#endif

struct Params {
  const float *x, *p, *norm_mix, *w_in, *gate_up, *gate_bias, *gla_norm, *conv_w, *conv_b, *ig_bias, *fg_bias, *mlstm_norm,
      *w_out, *norm_ffn, *peer_query, *sub_keys, *peer_u, *peer_v, *norm_ple, *w_ple, *w_ple_gate, *norm_final;
  float* out;
  unsigned char* ws;
};

__device__ __forceinline__ float bf2f(bf16_t b) { return __uint_as_float(((unsigned)b) << 16); }
typedef __bf16 bf16v2_t __attribute__((ext_vector_type(2)));
__device__ __forceinline__ bf16_t f2bf(float f) { const __bf16 b = (__bf16)f; return __builtin_bit_cast(bf16_t, b); }
__device__ __forceinline__ unsigned pack2(float lo, float hi) { const bf16v2_t v = {(__bf16)lo, (__bf16)hi}; return __builtin_bit_cast(unsigned, v); }
__device__ __forceinline__ unsigned pack4_fp8(float a, float b, float c, float d) { int v = __builtin_amdgcn_cvt_pk_fp8_f32(a, b, 0, false); v = __builtin_amdgcn_cvt_pk_fp8_f32(c, d, v, true); return (unsigned)v; }
__device__ __forceinline__ float lo_f(unsigned u) { return __uint_as_float(u << 16); }
__device__ __forceinline__ float hi_f(unsigned u) { return __uint_as_float(u & 0xffff0000u); }
__device__ __forceinline__ int tidx() { int t = threadIdx.x; asm volatile("" : "+v"(t)); return t; }
template <int O> __device__ __forceinline__ int sxor_i(int v) {
  if constexpr (O < 32) return __builtin_amdgcn_ds_swizzle(v, (O << 10) | 0x1f);
  else return __builtin_amdgcn_ds_bpermute(((tidx() & 63) ^ 32) << 2, v);
}
template <int O> __device__ __forceinline__ float sxor(float v) { return __int_as_float(sxor_i<O>(__float_as_int(v))); }
template <int O> __device__ __forceinline__ int sxor(int v) { return sxor_i<O>(v); }
__device__ __forceinline__ int bperm(int v, int src_lane) { return __builtin_amdgcn_ds_bpermute(src_lane << 2, v); }
__device__ __forceinline__ float bperm(float v, int src_lane) { return __int_as_float(__builtin_amdgcn_ds_bpermute(src_lane << 2, __float_as_int(v))); }
template <int N> __device__ __forceinline__ float gsum(float v) {
  if constexpr (N >= 2) v += sxor<1>(v); if constexpr (N >= 4) v += sxor<2>(v); if constexpr (N >= 8) v += sxor<4>(v);
  if constexpr (N >= 16) v += sxor<8>(v); if constexpr (N >= 32) v += sxor<16>(v); if constexpr (N >= 64) v += sxor<32>(v); return v; }
template <int N> __device__ __forceinline__ int gsum(int v) {
  if constexpr (N >= 2) v += sxor<1>(v); if constexpr (N >= 4) v += sxor<2>(v); if constexpr (N >= 8) v += sxor<4>(v);
  if constexpr (N >= 16) v += sxor<8>(v); if constexpr (N >= 32) v += sxor<16>(v); if constexpr (N >= 64) v += sxor<32>(v); return v; }
template <int N> __device__ __forceinline__ float gmax(float v) {
  if constexpr (N >= 2) v = fmaxf(v, sxor<1>(v)); if constexpr (N >= 4) v = fmaxf(v, sxor<2>(v)); if constexpr (N >= 8) v = fmaxf(v, sxor<4>(v));
  if constexpr (N >= 16) v = fmaxf(v, sxor<8>(v)); if constexpr (N >= 32) v = fmaxf(v, sxor<16>(v)); if constexpr (N >= 64) v = fmaxf(v, sxor<32>(v)); return v; }
__device__ __forceinline__ float wave_sum(float v) { return gsum<64>(v); }
__device__ __forceinline__ float sigmoidf_(float x) { return __builtin_amdgcn_rcpf(1.f + __expf(-x)); }
__device__ __forceinline__ float siluf_(float x) { return x * __builtin_amdgcn_rcpf(1.f + __expf(-x)); }
__device__ __forceinline__ float logsigmoidf_(float x) { return fminf(x, 0.f) - __logf(1.f + __expf(-fabsf(x))); }
__device__ __forceinline__ float gelu_tanh(float x) { const float u = 0.7978845608028654f * (x + 0.044715f * x * x * x); return x * __builtin_amdgcn_rcpf(1.f + __expf(-2.f * u)); }
__device__ __forceinline__ void unpack8(const uint4 q, float* f) {
  f[0] = lo_f(q.x); f[1] = hi_f(q.x); f[2] = lo_f(q.y); f[3] = hi_f(q.y); f[4] = lo_f(q.z); f[5] = hi_f(q.z); f[6] = lo_f(q.w); f[7] = hi_f(q.w);
}
__device__ __forceinline__ uint4 pack8(const float* f) { return make_uint4(pack2(f[0], f[1]), pack2(f[2], f[3]), pack2(f[4], f[5]), pack2(f[6], f[7])); }

__device__ __forceinline__ size_t vT_at(int chan, size_t tok0) { return (tok0 >> 6) * (size_t)(2048 * 64) + (size_t)chan * 64; }
__device__ __forceinline__ size_t kdT_at(int chan, size_t tok0) { return (tok0 >> 6) * (size_t)(1024 * 64) + (size_t)chan * 64; }
__device__ __forceinline__ size_t qs_at(int kh, size_t tok0) { return (tok0 >> 6) * (size_t)(8 * 64 * 128) + (size_t)kh * (64 * 128); }
struct WS {
  bf16_t *xb, *y, *pl, *proj, *h1b, *h2b, *vT, *sc, *ub, *vb, *win, *wout, *wq, *wg, *wple, *pb;
  bf16_t* eidx; bf16_t* eg; bf16_t* esu;
  float *rstd1, *ssq2, *ssq3, *ssq4, *wsum, *gdec, *mn, *mdec, *usc, *vsc, *pd;
  unsigned char *u8, *v8, *xq, *yq, *h2q, *winq, *woutq, *wgq;
  unsigned char *xq8, *wvq; float* wvs;
  bf16_t *qs, *ks, *kdT;
  float* ctlf;
};
__device__ __forceinline__ WS make_ws(unsigned char* ws, float* out) {
  WS w;
  w.xb = (bf16_t*)(ws + OFF_XB); w.y = (bf16_t*)(ws + OFF_Y); w.pl = (bf16_t*)(ws + OFF_PL); w.proj = (bf16_t*)(ws + OFF_PROJ);
  w.h1b = (bf16_t*)(ws + OFF_H1B); w.h2b = (bf16_t*)(ws + OFF_H2B); w.vT = (bf16_t*)(ws + OFF_VT); w.sc = (bf16_t*)(ws + OFF_SC);
  w.ub = (bf16_t*)(ws + OFF_UB); w.vb = (bf16_t*)(ws + OFF_VB); w.win = (bf16_t*)(ws + OFF_WIN); w.wout = (bf16_t*)(ws + OFF_WOUT);
  w.wq = (bf16_t*)(ws + OFF_WQ); w.wg = (bf16_t*)(ws + OFF_WG); w.wple = (bf16_t*)(ws + OFF_WPLE); w.pb = (bf16_t*)(ws + OFF_PB);
  w.eidx = (bf16_t*)(ws + OFF_EIDX); w.eg = (bf16_t*)(ws + OFF_EG); w.esu = (bf16_t*)(ws + OFF_ESU);
  float* m = (float*)(ws + OFF_MISC); w.rstd1 = m; w.ssq2 = m + T; w.ssq3 = m + 2 * T; w.ssq4 = m + 3 * T; w.wsum = m + 4 * T;
  w.gdec = (float*)(ws + OFF_GDEC); w.mn = (float*)(ws + OFF_MN); w.mdec = (float*)(ws + OFF_MDEC);
  w.usc = (float*)(ws + OFF_ESC); w.vsc = w.usc + 16384; w.u8 = ws + OFF_UB; w.v8 = ws + OFF_VB; w.pd = out;
  w.xq = ws + OFF_XB; w.yq = ws + OFF_YQ; w.h2q = ws + OFF_H2Q; w.winq = ws + OFF_WIN; w.woutq = ws + OFF_WOUT; w.wgq = ws + OFF_WG; w.ctlf = (float*)(ws + OFF_CTL);
  w.xq8 = ws + OFF_YQ; w.wvq = ws + OFF_KDT + 32 * MiB; w.wvs = (float*)(ws + OFF_KDT + 40 * MiB);
  w.qs = (bf16_t*)(ws + OFF_QS); w.ks = (bf16_t*)(ws + OFF_KS); w.kdT = (bf16_t*)(ws + OFF_KDT);
  return w;
}

__device__ void prep_x(const Params& p, const WS& w, int bid, int nb) {
  const int wave = tidx() >> 6, lane = tidx() & 63;
  for (int row0 = (bid * 8 + wave) * 2; row0 < T; row0 += nb * 16) {
    float4 v[2][8]; float ss[2] = {0.f, 0.f};
#pragma unroll
    for (int rr = 0; rr < 2; ++rr) { const float4* src = (const float4*)(p.x + (size_t)(row0 + rr) * D);
#pragma unroll
      for (int i = 0; i < 8; ++i) v[rr][i] = src[i * 64 + lane]; }
#pragma unroll
    for (int rr = 0; rr < 2; ++rr) {
#pragma unroll
      for (int i = 0; i < 8; ++i) ss[rr] += v[rr][i].x * v[rr][i].x + v[rr][i].y * v[rr][i].y + v[rr][i].z * v[rr][i].z + v[rr][i].w * v[rr][i].w;
      ss[rr] = wave_sum(ss[rr]);
      const float rs = rsqrtf(ss[rr] * (1.f / D) + EPS);
#if F8_IN
      unsigned* dst = (unsigned*)(w.xq + (size_t)(row0 + rr) * D);
#pragma unroll
      for (int i = 0; i < 8; ++i) dst[i * 64 + lane] = pack4_fp8(v[rr][i].x * rs, v[rr][i].y * rs, v[rr][i].z * rs, v[rr][i].w * rs);
#else
      uint2* dst = (uint2*)(w.xb + (size_t)(row0 + rr) * D);
#pragma unroll
      for (int i = 0; i < 8; ++i) dst[i * 64 + lane] = make_uint2(pack2(v[rr][i].x, v[rr][i].y), pack2(v[rr][i].z, v[rr][i].w));
#if F8_V
      unsigned* dq = (unsigned*)(w.xq8 + (size_t)(row0 + rr) * D);
#pragma unroll
      for (int i = 0; i < 8; ++i) dq[i * 64 + lane] = pack4_fp8(v[rr][i].x * rs, v[rr][i].y * rs, v[rr][i].z * rs, v[rr][i].w * rs);
#endif
#endif
      if (lane == 0) w.rstd1[row0 + rr] = rs; }
  }
}
__device__ void absmax_w(const float* src, size_t n, const float* gain, int ncols, float* part, float* lds, int bid, int nb) {
  float m = 0.f;
  for (size_t i = (size_t)bid * 512 + tidx(); i < n / 4; i += (size_t)nb * 512) { const float4 v = ((const float4*)src)[i]; const float g = gain ? gain[(i * 4) / (size_t)ncols] : 1.f;
    m = fmaxf(m, fabsf(g) * fmaxf(fmaxf(fabsf(v.x), fabsf(v.y)), fmaxf(fabsf(v.z), fabsf(v.w)))); }
  m = gmax<64>(m);
  __syncthreads();
  if ((tidx() & 63) == 0) lds[tidx() >> 6] = m;
  __syncthreads();
  if (tidx() == 0) { float t = lds[0];
#pragma unroll
    for (int i = 1; i < 8; ++i) t = fmaxf(t, lds[i]);
    part[bid] = t; }
  __syncthreads();
}
__device__ float amax_reduce(const float* part, float* lds, int nb) {
  float m = 0.f;
  for (int i = tidx(); i < nb; i += 512) m = fmaxf(m, part[i]);
  m = gmax<64>(m);
  __syncthreads();
  if ((tidx() & 63) == 0) lds[tidx() >> 6] = m;
  __syncthreads();
  float t = lds[0];
#pragma unroll
  for (int i = 1; i < 8; ++i) t = fmaxf(t, lds[i]);
  return t;
}
__device__ void cvt_rows(const float* src, bf16_t* dst, size_t n, const float* gain, int ncols, int bid, int nb) {
  const size_t n4 = n / 4, step = (size_t)nb * 512;
  for (size_t i0 = (size_t)bid * 512 + tidx(); i0 < n4; i0 += 4 * step) {
    float4 v[4];
#pragma unroll
    for (int u = 0; u < 4; ++u) { const size_t i = i0 + u * step; if (i < n4) v[u] = ((const float4*)src)[i]; }
#pragma unroll
    for (int u = 0; u < 4; ++u) { const size_t i = i0 + u * step; if (i < n4) {
      if (gain) { const float4 g = *(const float4*)(gain + (int)((i * 4) % (size_t)ncols)); v[u].x *= g.x; v[u].y *= g.y; v[u].z *= g.z; v[u].w *= g.w; }
      ((uint2*)dst)[i] = make_uint2(pack2(v[u].x, v[u].y), pack2(v[u].z, v[u].w)); } }
  }
}
template <bool F8OUT, class CM>
__device__ void transpose_w(const float* src, int K, int ldsrc, void* dstv, int Ndst, const float* gain, CM cm, float amax, float* lds, int bid, int nb) {
  const int tid = tidx(), tk = K / 64, ntile = (Ndst / 64) * tk, nc = tid & 63;
  const float qs = F8OUT ? 256.f / fmaxf(amax, 1e-30f) : 1.f;
  float rv[8];
#define TW_LOAD(tile) do { const int n0_ = ((tile) / tk) * 64, k0_ = ((tile) % tk) * 64, sc_ = cm(n0_ + nc); \
    _Pragma("unroll") for (int i = 0; i < 8; ++i) { const int kr = (tid >> 6) + 8 * i; float v = 0.f; if (sc_ >= 0) { v = src[(size_t)(k0_ + kr) * ldsrc + sc_]; if (gain) v *= gain[k0_ + kr]; } rv[i] = v * qs; } } while (0)
  if (bid < ntile) TW_LOAD(bid);
  for (int tile = bid; tile < ntile; tile += nb) {
    const int n0 = (tile / tk) * 64, k0 = (tile % tk) * 64;
#pragma unroll
    for (int i = 0; i < 8; ++i) lds[((tid >> 6) + 8 * i) * 65 + nc] = rv[i];
    __syncthreads();
    if (tile + nb < ntile) TW_LOAD(tile + nb);
    { const int nr = tid >> 3, ks = (tid & 7) * 8; float f[8];
#pragma unroll
      for (int j = 0; j < 8; ++j) f[j] = lds[(ks + j) * 65 + nr];
      if (F8OUT) *(uint2*)((unsigned char*)dstv + (size_t)(n0 + nr) * K + k0 + ks) = make_uint2(pack4_fp8(f[0], f[1], f[2], f[3]), pack4_fp8(f[4], f[5], f[6], f[7]));
      else *(uint4*)((bf16_t*)dstv + (size_t)(n0 + nr) * K + k0 + ks) = pack8(f); }
    __syncthreads();
  }
#undef TW_LOAD
}
struct CmIdent { __device__ int operator()(int n) const { return n; } };
struct CmWin {
  __device__ int operator()(int n) const {
#if F8_GO
    if (n < 1024) return n;
    if (n < 1536) return 3088 + (n - 1024);
    if (n < 2048) return 3600 + (n - 1536);
    if (n < 2304) { const int i = n - 2048; if (i < 16) return 3072 + i; if (i < 20) return 6160 + (i - 16); if (i < 24) return 6164 + (i - 20); return -1; }
    if (n < 3328) return 2048 + (n - 2304);
    if (n < 4352) return 5136 + (n - 3328);
    { const int j = n - 4352; if (j < 1024) return 1024 + j; return 4112 + (j - 1024); }
#endif
    if (n < 1024) return n;
    if (n < 2048) return 2048 + (n - 1024);
    if (n < 2560) return 3088 + (n - 2048);
    if (n < 3072) return 3600 + (n - 2560);
    if (n < 4096) return 5136 + (n - 3072);
    if (n < 4352) { const int i = n - 4096; if (i < 16) return 3072 + i; if (i < 20) return 6160 + (i - 16); if (i < 24) return 6164 + (i - 20); return -1; }
    const int j = n - 4352; if (j < 1024) return 1024 + j;
    return 4112 + (j - 1024);
  }
};
__device__ void prep_wq(const Params& p, const WS& w, float* lds, int bid, int nb) {
  const int tid = tidx();
  float* SKs = lds;
  float* WQs = lds + 128 * 132;
  for (int item = bid; item < 16 * 32; item += nb) {
    const int hp = item >> 5, k0 = (item & 31) * 64;
#pragma unroll
    for (int i = 0; i < 8; ++i) { const int e4 = tid + 512 * i, key = e4 >> 5, d4 = (e4 & 31) * 4; *(float4*)(SKs + key * 132 + d4) = *(const float4*)(p.sub_keys + (size_t)hp * 16384 + key * 128 + d4); }
#pragma unroll
    for (int i = 0; i < 4; ++i) { const int e4 = tid + 512 * i, kr = e4 >> 5, d4 = (e4 & 31) * 4; float4 v = *(const float4*)(p.peer_query + (size_t)(k0 + kr) * 2048 + hp * 128 + d4); const float g = p.norm_ffn[k0 + kr]; v.x *= g; v.y *= g; v.z *= g; v.w *= g; *(float4*)(WQs + kr * 132 + d4) = v; }
    __syncthreads();
    const int k = tid & 63, kg = tid >> 6;
    float acc[16];
#pragma unroll
    for (int j = 0; j < 16; ++j) acc[j] = 0.f;
    for (int d4 = 0; d4 < 32; ++d4) {
      const float4 a = *(const float4*)(WQs + k * 132 + d4 * 4);
#pragma unroll
      for (int j = 0; j < 16; ++j) { const float4 s = *(const float4*)(SKs + (kg * 16 + j) * 132 + d4 * 4); acc[j] += a.x * s.x + a.y * s.y + a.z * s.z + a.w * s.w; }
    }
#pragma unroll
    for (int j = 0; j < 16; ++j) w.wq[(size_t)(hp * 128 + kg * 16 + j) * 2048 + k0 + k] = f2bf(acc[j]);
    __syncthreads();
  }
}

#ifndef PEER_SLW
#define PEER_SLW 256
#endif
constexpr int SLW = PEER_SLW, LPR = SLW / 16, EPI = 64 / LPR, NSL = 2048 / SLW, SPL = NSL / 8, NIT = 128 / EPI;
template <bool SIGNED>
__device__ void quant_rows(const float* src, const float* gain, unsigned char* dst, float* scale, int bid, int nb) {
  const int tid = tidx(), wave = tid >> 6, lane = tid & 63;
  for (int row0 = (bid * 8 + wave) * 2; row0 < 16384; row0 += nb * 16) {
    float4 f4[2][8];
#pragma unroll
    for (int rr = 0; rr < 2; ++rr)
#pragma unroll
      for (int i = 0; i < 2; ++i)
#pragma unroll
        for (int q = 0; q < 4; ++q) f4[rr][i * 4 + q] = *(const float4*)(src + (size_t)(row0 + rr) * 2048 + i * 1024 + lane * 16 + q * 4);
#pragma unroll
    for (int rr = 0; rr < 2; ++rr) { const int row = row0 + rr; float f[32]; float mx = 0.f;
#pragma unroll
      for (int i = 0; i < 2; ++i)
#pragma unroll
        for (int q = 0; q < 4; ++q) { float4 v = f4[rr][i * 4 + q];
          if (gain) { const float4 g = *(const float4*)(gain + i * 1024 + lane * 16 + q * 4); v.x *= g.x; v.y *= g.y; v.z *= g.z; v.w *= g.w; }
          f[i * 16 + q * 4] = v.x; f[i * 16 + q * 4 + 1] = v.y; f[i * 16 + q * 4 + 2] = v.z; f[i * 16 + q * 4 + 3] = v.w;
          mx = fmaxf(mx, fmaxf(fmaxf(fabsf(v.x), fabsf(v.y)), fmaxf(fabsf(v.z), fabsf(v.w)))); }
      mx = gmax<64>(mx);
      const float sc = fmaxf(mx, 1e-30f) * (1.f / 127.f), inv = 1.f / sc;
#pragma unroll
      for (int i = 0; i < 2; ++i) { unsigned wd[4];
#pragma unroll
        for (int q = 0; q < 4; ++q) { unsigned x = 0;
#pragma unroll
          for (int j = 0; j < 4; ++j) { const int v = (int)rintf(f[i * 16 + q * 4 + j] * inv) + (SIGNED ? 0 : 128); x |= ((unsigned)v & 0xffu) << (8 * j); }
          wd[q] = x; }
        const int el = i * 1024 + lane * 16;
        *(uint4*)(dst + ((size_t)(el / SLW) * 16384 + row) * SLW + (el % SLW)) = make_uint4(wd[0], wd[1], wd[2], wd[3]); }
      if (lane == 0) scale[row] = sc; }
  }
}
__device__ void phase_prep(const Params& p, const WS& w, float* lds, int bid, int nb) {
  static_assert(!F8_IN && F8_OUT && F8_GATE, "prep order written for the bf16 in-projection / fp8 out-projection + gate build");
  if (bid & 1) {
    quant_rows<true>(p.peer_u, p.norm_ffn, w.u8, w.usc, bid, nb);
    quant_rows<true>(p.peer_v, nullptr, w.v8, w.vsc, bid, nb);
    prep_x(p, w, bid, nb);
    cvt_rows(p.p, w.pb, (size_t)T * 256, nullptr, 256, bid, nb);
  }
  transpose_w<false>(p.w_in, 2048, 6168, w.win, 6400, p.norm_mix, CmWin(), 0.f, lds, bid, nb);
  absmax_w(p.w_out, (size_t)2048 * 2048, nullptr, 2048, w.ctlf + 2048, lds, bid, nb);
  absmax_w(p.w_ple_gate, (size_t)2048 * 2048, p.norm_ple, 2048, w.ctlf + 3072, lds, bid, nb);
  transpose_w<false>(p.w_ple, 256, 2048, w.wple, 2048, nullptr, CmIdent(), 0.f, lds, bid, nb);
  prep_wq(p, w, lds, bid, nb);
  if (!(bid & 1)) {
    prep_x(p, w, bid, nb);
    cvt_rows(p.p, w.pb, (size_t)T * 256, nullptr, 256, bid, nb);
    quant_rows<true>(p.peer_u, p.norm_ffn, w.u8, w.usc, bid, nb);
    quant_rows<true>(p.peer_v, nullptr, w.v8, w.vsc, bid, nb);
  }
  for (int i = bid * 512 + tidx(); i < T; i += nb * 512) { w.ssq2[i] = 0.f; w.ssq3[i] = 0.f; w.ssq4[i] = 0.f; }
}
static_assert(!F8_IN, "phase_prep2 now runs after the in-projection: an fp8 in-projection needs its weight copy (and a seam) before phase 1 again");
__device__ void phase_prep2(const Params& p, const WS& w, float* lds, int bid, int nb) {
#if F8_IN
  { const float a0 = amax_reduce(w.ctlf + 1024, lds, nb); if (bid == 0 && tidx() == 0) w.ctlf[0] = a0; __syncthreads();
    transpose_w<true>(p.w_in, 2048, 6168, w.winq, 6400, p.norm_mix, CmWin(), a0, lds, bid, nb); }
#endif
#if F8_OUT
  { const float a1 = amax_reduce(w.ctlf + 2048, lds, nb); if (bid == 0 && tidx() == 0) w.ctlf[1] = a1; __syncthreads();
    transpose_w<true>(p.w_out, 2048, 2048, w.woutq, 2048, nullptr, CmIdent(), a1, lds, bid, nb); }
#endif
#if F8_GATE
  { const float a2 = amax_reduce(w.ctlf + 3072, lds, nb); if (bid == 0 && tidx() == 0) w.ctlf[2] = a2; __syncthreads();
    transpose_w<true>(p.w_ple_gate, 2048, 2048, w.wgq, 2048, p.norm_ple, CmIdent(), a2, lds, bid, nb); }
#endif
}

struct EpiProjN { bf16_t* out; const float* rstd; float ws; static constexpr bool ROWSUM = false;
  __device__ __forceinline__ float store8(int r, int c, const float* v) const { const float s = F8_IN ? ws : rstd[r]; float f[8];
#pragma unroll
    for (int j = 0; j < 8; ++j) f[j] = v[j] * s;
    *(uint4*)(out + (size_t)r * NPROJ + c) = pack8(f); return 0.f; }
  __device__ __forceinline__ void rowsum(int, float) const {} };
__device__ void cvt_wv(const WS& w, int bid, int nb) {
  const int wave = tidx() >> 6, lane = tidx() & 63;
  constexpr int R0 = F8_GO ? NB16 : NPROJ;
  for (int n = bid * 8 + wave; n < 6400 - R0; n += nb * 8) {
    const bf16_t* src = w.win + (size_t)(R0 + n) * D; float f[4][8]; float am = 0.f;
#pragma unroll
    for (int i = 0; i < 4; ++i) { unpack8(*(const uint4*)(src + (i * 64 + lane) * 8), f[i]);
#pragma unroll
      for (int j = 0; j < 8; ++j) am = fmaxf(am, fabsf(f[i][j])); }
    am = fmaxf(gmax<64>(am), 1e-30f);
    const float qs = 256.f / am;
#pragma unroll
    for (int i = 0; i < 4; ++i) *(uint2*)(w.wvq + (size_t)n * D + (i * 64 + lane) * 8) = make_uint2(pack4_fp8(f[i][0] * qs, f[i][1] * qs, f[i][2] * qs, f[i][3] * qs), pack4_fp8(f[i][4] * qs, f[i][5] * qs, f[i][6] * qs, f[i][7] * qs));
    if (lane == 0) w.wvs[n] = am * (1.f / 256.f);
  }
}
struct EpiProjN8 { bf16_t* out; const float* cs; static constexpr bool ROWSUM = false;
  __device__ __forceinline__ float store8(int r, int c, const float* v) const { const float4 s0 = *(const float4*)(cs + c), s1 = *(const float4*)(cs + c + 4); float f[8];
    f[0] = v[0] * s0.x; f[1] = v[1] * s0.y; f[2] = v[2] * s0.z; f[3] = v[3] * s0.w; f[4] = v[4] * s1.x; f[5] = v[5] * s1.y; f[6] = v[6] * s1.z; f[7] = v[7] * s1.w;
    *(uint4*)(out + (size_t)r * NPROJ + c) = pack8(f); return 0.f; }
  __device__ __forceinline__ void rowsum(int, float) const {} };
struct EpiProjT { bf16_t* out; const float* rstd; float ws; static constexpr bool ROWSUM = false;
  __device__ __forceinline__ float store8(int r, int c, const float* v) const { const float rsc = F8_V ? rstd[r] : 0.f; const float4 s0 = F8_V ? make_float4(rsc, rsc, rsc, rsc) : F8_IN ? make_float4(ws, ws, ws, ws) : *(const float4*)(rstd + c), s1 = (F8_IN || F8_V) ? s0 : *(const float4*)(rstd + c + 4); float f[8];
    f[0] = v[0] * s0.x; f[1] = v[1] * s0.y; f[2] = v[2] * s0.z; f[3] = v[3] * s0.w; f[4] = v[4] * s1.x; f[5] = v[5] * s1.y; f[6] = v[6] * s1.z; f[7] = v[7] * s1.w;
    *(uint4*)(out + vT_at(r, (size_t)c) + (c & 63)) = pack8(f); return 0.f; }
  __device__ __forceinline__ void rowsum(int, float) const {} };
struct EpiOut { const bf16_t* x; bf16_t* h1b; float* ssq; float ws; static constexpr bool ROWSUM = true;
  __device__ __forceinline__ float store8(int r, int c, const float* v) const { float xf[8], f[8]; unpack8(*(const uint4*)(x + (size_t)r * D + c), xf);
#pragma unroll
    for (int j = 0; j < 8; ++j) f[j] = v[j] * ws + xf[j];
    float s = 0.f;
#pragma unroll
    for (int j = 0; j < 8; ++j) s += f[j] * f[j];
    *(uint4*)(h1b + (size_t)r * D + c) = pack8(f); return s; }
  __device__ __forceinline__ void rowsum(int r, float s) const { atomicAdd(ssq + r, s); } };
struct EpiScore { bf16_t* sc; const float* ssq; static constexpr bool ROWSUM = false;
  __device__ __forceinline__ float store8(int r, int c, const float* v) const { const float s = rsqrtf(ssq[r] * (1.f / D) + EPS); float f[8];
#pragma unroll
    for (int j = 0; j < 8; ++j) f[j] = v[j] * s;
    *(uint4*)(sc + (size_t)r * D + c) = pack8(f); return 0.f; }
  __device__ __forceinline__ void rowsum(int, float) const {} };
struct EpiPl { bf16_t* pl; static constexpr bool ROWSUM = false;
  __device__ __forceinline__ float store8(int r, int c, const float* v) const { *(uint4*)(pl + (size_t)r * D + c) = pack8(v); return 0.f; }
  __device__ __forceinline__ void rowsum(int, float) const {} };
struct EpiGate { const bf16_t* h2b; const bf16_t* pl; const float* ssq3; bf16_t* out; float* ssq; const float* ssq2; float ws; static constexpr bool ROWSUM = true;
  __device__ __forceinline__ float store8(int r, int c, const float* v) const { const float rs = rsqrtf(ssq3[r] * (1.f / D) + EPS) * (F8_GATE ? ws * sqrtf(ssq2[r] * (1.f / D) + EPS) : 1.f); float h[8], q[8], f[8];
    unpack8(*(const uint4*)(h2b + (size_t)r * D + c), h); unpack8(*(const uint4*)(pl + (size_t)r * D + c), q);
    float s = 0.f;
#pragma unroll
    for (int j = 0; j < 8; ++j) { f[j] = h[j] + sigmoidf_(v[j] * rs) * q[j]; s += f[j] * f[j]; }
    *(uint4*)(out + (size_t)r * D + c) = pack8(f); return s; }
  __device__ __forceinline__ void rowsum(int r, float s) const { atomicAdd(ssq + r, s); } };

template <class Epi>
__device__ void gemm_naive(const bf16_t* A, const bf16_t* Bt, int M, int N, int K, const Epi& E, float* lds, int bid, int nb) {
  const int tid = tidx(), ty = tid >> 4, tx = tid & 15;
  float* As = lds;
  float* Bs = lds + 32 * 132;
  const int nM = M / 128, nN = N / 128;
  for (int tile = bid; tile < nM * nN; tile += nb) {
    const int m0 = (tile % nM) * 128, n0 = (tile / nM) * 128;
    float acc[4][8];
#pragma unroll
    for (int i = 0; i < 4; ++i)
#pragma unroll
      for (int j = 0; j < 8; ++j) acc[i][j] = 0.f;
    const int lr = tid >> 2, lk = (tid & 3) * 8;
    for (int k0 = 0; k0 < K; k0 += 32) {
      const uint4 av = *(const uint4*)(A + (size_t)(m0 + lr) * K + k0 + lk);
      const uint4 bv = *(const uint4*)(Bt + (size_t)(n0 + lr) * K + k0 + lk);
      float af[8], bf[8]; unpack8(av, af); unpack8(bv, bf);
      __syncthreads();
#pragma unroll
      for (int j = 0; j < 8; ++j) { As[(lk + j) * 132 + lr] = af[j]; Bs[(lk + j) * 132 + lr] = bf[j]; }
      __syncthreads();
#pragma unroll 8
      for (int kk = 0; kk < 32; ++kk) {
        const float4 a = *(const float4*)(As + kk * 132 + ty * 4);
        const float4 b0 = *(const float4*)(Bs + kk * 132 + tx * 8), b1 = *(const float4*)(Bs + kk * 132 + tx * 8 + 4);
        const float aa[4] = {a.x, a.y, a.z, a.w}; const float bb[8] = {b0.x, b0.y, b0.z, b0.w, b1.x, b1.y, b1.z, b1.w};
#pragma unroll
        for (int i = 0; i < 4; ++i)
#pragma unroll
          for (int j = 0; j < 8; ++j) acc[i][j] += aa[i] * bb[j];
      }
    }
#pragma unroll
    for (int i = 0; i < 4; ++i) {
      const int r = m0 + ty * 4 + i;
      float s = E.store8(r, n0 + tx * 8, acc[i]);
      if (Epi::ROWSUM) { s = gsum<16>(s); if (tx == 0) E.rowsum(r, s); }
    }
  }
}


namespace pg8 {
#define PG8_LAS __attribute__((address_space(3)))
typedef short bf16x8 __attribute__((ext_vector_type(8)));
typedef float f32x4 __attribute__((ext_vector_type(4)));
typedef int v4i_t __attribute__((ext_vector_type(4)));
typedef int v8i_t __attribute__((ext_vector_type(8)));
constexpr int BM = 256, BK = 64, HALF = 128, HTB = HALF * BK * 2, STAGE_BYTES = 8 * HTB, NXCD = 8, WGM = 4;
__host__ __device__ __forceinline__ int lds_byte(int r, int c) { const int st = (r >> 4) * 2 + (c >> 5), rr = r & 15, cc = c & 31, ob = rr * 64 + cc * 2; return st * 1024 + (ob ^ (((ob >> 9) & 1) << 5)); }
__host__ __device__ __forceinline__ void stage_rc(int b, int& R, int& C) { const int st = b / 1024, sb = b % 1024, swz = sb ^ (((sb >> 9) & 1) << 5); R = (st >> 1) * 16 + swz / 64; C = (st & 1) * 32 + (swz % 64) / 2; }
__host__ __device__ __forceinline__ int perm32(int rho) { const int n = rho >> 4, i = rho & 15; return 8 * (i >> 2) + 4 * n + (i & 3); }
struct Unit { int pm, pn; };
struct Gemm { const bf16_t* A; const bf16_t* Bt; int M, N, K; };
struct StaticOrder {
    int nM, nN, nwg, G, c;
    __host__ __device__ void init(int M, int N, int G_, int c_) { nM = M / BM; nN = N / BM; nwg = nM * nN; G = G_; c = c_; }
    __host__ __device__ bool next(int i, Unit& u) const {
        const long L = (long)i * G + c; if (L >= nwg) return false;
        map((int)L, u); return true;
    }
    __host__ __device__ void map(int L, Unit& u) const {
        int wgid = L; { const int q = nwg / NXCD, r = nwg % NXCD, xcd = wgid % NXCD, off = wgid / NXCD; wgid = (xcd < r ? xcd * (q + 1) : r * (q + 1) + (xcd - r) * q) + off; }
        const int nig = WGM * nN, gid = wgid / nig, fm = gid * WGM, gsz = (nM - fm) < WGM ? (nM - fm) : WGM;
        u.pm = fm + ((wgid % nig) % gsz); u.pn = (wgid % nig) / gsz;
    }
    __device__ __forceinline__ void a_ready(const Unit&) const {}
    __device__ __forceinline__ void done(const Unit&) const {}
};
struct BalOrder {
    StaticOrder S;
    __device__ bool next(int i, Unit& u) const {
        if (S.G != 256 || S.nwg != 1024) return S.next(i, u);
        int L;
        if (S.c < 128) { if (i >= 3) return false; L = i * 256 + S.c; }
        else { if (i >= 5) return false; L = i < 3 ? i * 256 + S.c : 768 + (i - 3) * 128 + (S.c - 128); }
        S.map(L, u); return true;
    }
    __device__ __forceinline__ void a_ready(const Unit&) const {}
    __device__ __forceinline__ void done(const Unit&) const {}
};
template <class E8> struct EpiA {
    static constexpr bool PERM = true, AFTER_DRAIN = false;
    E8 e;
    __device__ __forceinline__ void operator()(const f32x4 (&acc)[2][2][4][2], const Unit& u, int wr, int wc, int fr, int fq) const {
        asm volatile("" : "+v"(fr), "+v"(fq));
        const int row0 = u.pm * BM + wr * 64 + fr, col0 = u.pn * BM + wc * 32 + 8 * fq;
#pragma unroll
        for (int ai = 0; ai < 2; ++ai)
#pragma unroll
            for (int m = 0; m < 4; ++m) { const int r = row0 + ai * HALF + m * 16; float s = 0.f;
#pragma unroll
                for (int bj = 0; bj < 2; ++bj) { const float v[8] = {acc[ai][bj][m][0][0], acc[ai][bj][m][0][1], acc[ai][bj][m][0][2], acc[ai][bj][m][0][3], acc[ai][bj][m][1][0], acc[ai][bj][m][1][1], acc[ai][bj][m][1][2], acc[ai][bj][m][1][3]};
                    s += e.store8(r, col0 + bj * HALF, v); }
                if (E8::ROWSUM) { s += sxor<16>(s); s += sxor<32>(s); if (fq == 0) e.rowsum(r, s); }
                asm volatile("" ::: "memory"); }
    }
    __device__ __forceinline__ void fused(f32x4 (&)[2][2][4][2], const Unit&, int, int, int, int, PG8_LAS unsigned char*, int, int) const {}
};
template <class Epi, class Sched, bool ALIGN_EPI = false, bool SP2 = false, bool F8 = false>
__device__ __forceinline__ void gemm_phase(PG8_LAS unsigned char* lds, const Gemm g, const Sched& S, const Epi& E) {
    int tid_ = threadIdx.x; asm volatile("" : "+v"(tid_));
    const int tid = tid_, wid = __builtin_amdgcn_readfirstlane(tid >> 6), lane = tid & 63, wr = wid >> 2, wc = wid & 3, fr = lane & 15, fq = lane >> 4;
    const int K = g.K, nt = K / BK;
    unsigned voffA[2], voffB[2];
#pragma unroll
    for (int i = 0; i < 2; ++i) { int R, C; stage_rc(tid * 16 + i * 8192, R, C); const int Rb = Epi::PERM ? ((R & ~31) + perm32(R & 31)) : R;
        voffA[i] = (unsigned)(R * K + C) * 2u; voffB[i] = (unsigned)(Rb * K + C) * 2u; }
    const size_t kstep = (size_t)(BK * 2);
    const size_t hstep = (size_t)HALF * K * 2;
    const size_t tstep = 2 * hstep;
    const unsigned ldsw = (unsigned)wid * 1024u;
    const int aoff = lds_byte(wr * 64 + fr, fq * 8), boff = lds_byte(wc * 32 + fr, fq * 8);
#define PG8_SA(b, h) (((b) * 2 + (h)) * HTB)
#define PG8_SB(b, h) ((4 + (b) * 2 + (h)) * HTB)
#define PG8_STAGE(bufoff, gbase, voff) do { _Pragma("unroll") for (int _i = 0; _i < 2; ++_i) \
        __builtin_amdgcn_global_load_lds((const unsigned*)((const char*)(gbase) + (voff)[_i]), (PG8_LAS unsigned*)(lds + (bufoff) + ldsw + _i * 8192), 16, 0, 0); } while (0)
#define PG8_LDA(dst, b, h) do { _Pragma("unroll") for (int m = 0; m < 4; ++m) { const v4i_t lo_ = *(const PG8_LAS v4i_t*)(lds + PG8_SA(b, h) + aoff + m * 2048), hi_ = *(const PG8_LAS v4i_t*)(lds + PG8_SA(b, h) + aoff + m * 2048 + 1024); dst[m] = __builtin_shufflevector(lo_, hi_, 0, 1, 2, 3, 4, 5, 6, 7); } } while (0)
#define PG8_LDB(dst, b, h) do { _Pragma("unroll") for (int n = 0; n < 2; ++n) { const v4i_t lo_ = *(const PG8_LAS v4i_t*)(lds + PG8_SB(b, h) + boff + n * 2048), hi_ = *(const PG8_LAS v4i_t*)(lds + PG8_SB(b, h) + boff + n * 2048 + 1024); dst[n] = __builtin_shufflevector(lo_, hi_, 0, 1, 2, 3, 4, 5, 6, 7); } } while (0)
#define PG8_MMA(ai, bj, At, Bt) do { __builtin_amdgcn_s_setprio(1); \
        if constexpr (F8) { asm volatile("s_nop 1\n\t" \
            "v_mfma_scale_f32_16x16x128_f8f6f4 %0, %12, %8, %0, %14, %14 op_sel_hi:[0,0,0]\n\t"  "v_mfma_scale_f32_16x16x128_f8f6f4 %1, %13, %8, %1, %14, %14 op_sel_hi:[0,0,0]\n\t" \
            "v_mfma_scale_f32_16x16x128_f8f6f4 %2, %12, %9, %2, %14, %14 op_sel_hi:[0,0,0]\n\t"  "v_mfma_scale_f32_16x16x128_f8f6f4 %3, %13, %9, %3, %14, %14 op_sel_hi:[0,0,0]\n\t" \
            "v_mfma_scale_f32_16x16x128_f8f6f4 %4, %12, %10, %4, %14, %14 op_sel_hi:[0,0,0]\n\t" "v_mfma_scale_f32_16x16x128_f8f6f4 %5, %13, %10, %5, %14, %14 op_sel_hi:[0,0,0]\n\t" \
            "v_mfma_scale_f32_16x16x128_f8f6f4 %6, %12, %11, %6, %14, %14 op_sel_hi:[0,0,0]\n\t" "v_mfma_scale_f32_16x16x128_f8f6f4 %7, %13, %11, %7, %14, %14 op_sel_hi:[0,0,0]" \
            : "+v"(acc[ai][bj][0][0]), "+v"(acc[ai][bj][0][1]), "+v"(acc[ai][bj][1][0]), "+v"(acc[ai][bj][1][1]), "+v"(acc[ai][bj][2][0]), "+v"(acc[ai][bj][2][1]), "+v"(acc[ai][bj][3][0]), "+v"(acc[ai][bj][3][1]) \
            : "v"(At[0]), "v"(At[1]), "v"(At[2]), "v"(At[3]), "v"(Bt[0]), "v"(Bt[1]), "v"(one_scale)); } \
        else { _Pragma("unroll") for (int m = 0; m < 4; ++m) _Pragma("unroll") for (int n = 0; n < 2; ++n) { \
            acc[ai][bj][m][n] = __builtin_amdgcn_mfma_f32_16x16x32_bf16(__builtin_bit_cast(bf16x8, __builtin_shufflevector(Bt[n], Bt[n], 0, 1, 2, 3)), __builtin_bit_cast(bf16x8, __builtin_shufflevector(At[m], At[m], 0, 1, 2, 3)), acc[ai][bj][m][n], 0, 0, 0); \
            acc[ai][bj][m][n] = __builtin_amdgcn_mfma_f32_16x16x32_bf16(__builtin_bit_cast(bf16x8, __builtin_shufflevector(Bt[n], Bt[n], 4, 5, 6, 7)), __builtin_bit_cast(bf16x8, __builtin_shufflevector(At[m], At[m], 4, 5, 6, 7)), acc[ai][bj][m][n], 0, 0, 0); } } \
        __builtin_amdgcn_s_setprio(0); } while (0)
#define PG8_MFMA_DRAIN() do { if constexpr (F8) asm volatile("s_nop 15\n\ts_nop 15\n\ts_nop 15" ::: "memory"); } while (0)
#define PG8_WAIT_V(n) asm volatile("s_waitcnt vmcnt(" #n ")" ::: "memory")
#define PG8_WAIT_L(n) asm volatile("s_waitcnt lgkmcnt(" #n ")" ::: "memory")
#define PG8_BAR __builtin_amdgcn_s_barrier()
#define PG8_SCHED __builtin_amdgcn_sched_barrier(0)
    Unit cur, nxt; int ui = 0;
    if (!S.next(0, cur)) return;
    f32x4 acc[2][2][4][2];
#pragma unroll
    for (int a = 0; a < 2; ++a)
#pragma unroll
        for (int b = 0; b < 2; ++b)
#pragma unroll
            for (int m = 0; m < 4; ++m)
#pragma unroll
                for (int n = 0; n < 2; ++n) acc[a][b][m][n] = (f32x4){0.f, 0.f, 0.f, 0.f};
    const int one_scale = 0x7f7f7f7f;
    v8i_t At[4], B0[2], B1[2];
    const char* cA = (const char*)g.A + (size_t)cur.pm * tstep; const char* cB = (const char*)g.Bt + (size_t)cur.pn * tstep;
    S.a_ready(cur);
    if constexpr (SP2) {
        PG8_STAGE(PG8_SB(0, 0), cB, voffB); PG8_STAGE(PG8_SB(0, 1), cB + hstep, voffB); PG8_STAGE(PG8_SA(0, 0), cA, voffA); PG8_STAGE(PG8_SA(0, 1), cA + hstep, voffA);
        if (wr == 1) PG8_BAR;
        PG8_WAIT_V(2); PG8_BAR;
        PG8_STAGE(PG8_SB(1, 0), cB + kstep, voffB); PG8_STAGE(PG8_SA(1, 0), cA + kstep, voffA); PG8_STAGE(PG8_SB(1, 1), cB + hstep + kstep, voffB);
        PG8_WAIT_V(6); PG8_BAR;
    } else {
        PG8_STAGE(PG8_SB(0, 0), cB, voffB); PG8_STAGE(PG8_SA(0, 0), cA, voffA); PG8_STAGE(PG8_SB(0, 1), cB + hstep, voffB); PG8_STAGE(PG8_SA(0, 1), cA + hstep, voffA);
        if (wr == 1) PG8_BAR;
        PG8_WAIT_V(4); PG8_BAR;
        PG8_STAGE(PG8_SB(1, 0), cB + kstep, voffB); PG8_STAGE(PG8_SA(1, 0), cA + kstep, voffA); PG8_STAGE(PG8_SB(1, 1), cB + hstep + kstep, voffB);
        PG8_WAIT_V(6); PG8_BAR;
    }
    for (;;) {
        const bool has_next = S.next(ui + 1, nxt);
        const char* nA = has_next ? (const char*)g.A + (size_t)nxt.pm * tstep : cA; const char* nB = has_next ? (const char*)g.Bt + (size_t)nxt.pn * tstep : cB;
        for (int t = 0; t < nt; t += 2) {
            const bool last = (t == nt - 2);
            const char* a1 = cA + (size_t)(t + 1) * kstep;
            const char* a2 = last ? nA : cA + (size_t)(t + 2) * kstep; const char* b2 = last ? nB : cB + (size_t)(t + 2) * kstep;
            const char* a3 = a2 + kstep; const char* b3 = b2 + kstep;
            if (last && has_next) S.a_ready(nxt);
            if constexpr (SP2) {
            PG8_LDB(B0, 0, 0); PG8_LDB(B1, 0, 1); PG8_SCHED; PG8_LDA(At, 0, 0); PG8_STAGE(PG8_SA(1, 1), a1 + hstep, voffA);
            PG8_WAIT_V(8); PG8_WAIT_L(0); PG8_BAR; PG8_MMA(0, 0, At, B0); PG8_MMA(0, 1, At, B1); PG8_BAR; PG8_SCHED;
            PG8_LDA(At, 0, 1); PG8_STAGE(PG8_SB(0, 0), b2, voffB); PG8_STAGE(PG8_SB(0, 1), b2 + hstep, voffB); PG8_STAGE(PG8_SA(0, 0), a2, voffA);
            PG8_WAIT_V(8); PG8_WAIT_L(0); PG8_BAR; PG8_MMA(1, 0, At, B0); PG8_MMA(1, 1, At, B1); PG8_BAR; PG8_SCHED;
            PG8_LDB(B0, 1, 0); PG8_LDB(B1, 1, 1); PG8_SCHED; PG8_LDA(At, 1, 0); PG8_STAGE(PG8_SA(0, 1), a2 + hstep, voffA);
            PG8_WAIT_V(8); PG8_WAIT_L(0); PG8_BAR; PG8_MMA(0, 0, At, B0); PG8_MMA(0, 1, At, B1); PG8_BAR; PG8_SCHED;
            PG8_LDA(At, 1, 1); PG8_STAGE(PG8_SB(1, 0), b3, voffB); PG8_STAGE(PG8_SB(1, 1), b3 + hstep, voffB); PG8_STAGE(PG8_SA(1, 0), a3, voffA);
            PG8_WAIT_V(8); PG8_WAIT_L(0); PG8_BAR; PG8_MMA(1, 0, At, B0); PG8_MMA(1, 1, At, B1); PG8_BAR; PG8_SCHED;
            } else {
            PG8_LDB(B0, 0, 0); PG8_SCHED; PG8_LDA(At, 0, 0); PG8_STAGE(PG8_SA(1, 1), a1 + hstep, voffA);
            PG8_WAIT_L(8); PG8_BAR; PG8_WAIT_L(0); PG8_MMA(0, 0, At, B0); PG8_BAR; PG8_SCHED;
            PG8_LDB(B1, 0, 1); PG8_STAGE(PG8_SB(0, 0), b2, voffB);
            PG8_BAR; PG8_WAIT_L(0); PG8_MMA(0, 1, At, B1); PG8_BAR;
            PG8_LDA(At, 0, 1); PG8_STAGE(PG8_SA(0, 0), a2, voffA);
            PG8_BAR; PG8_WAIT_L(0); PG8_MMA(1, 0, At, B0); PG8_BAR; PG8_SCHED;
            PG8_STAGE(PG8_SB(0, 1), b2 + hstep, voffB);
            PG8_WAIT_V(6); PG8_BAR; PG8_MMA(1, 1, At, B1); PG8_BAR;
            PG8_LDB(B0, 1, 0); PG8_SCHED; PG8_LDA(At, 1, 0); PG8_STAGE(PG8_SA(0, 1), a2 + hstep, voffA);
            PG8_WAIT_L(8); PG8_BAR; PG8_WAIT_L(0); PG8_MMA(0, 0, At, B0); PG8_BAR; PG8_SCHED;
            PG8_LDB(B1, 1, 1); PG8_STAGE(PG8_SB(1, 0), b3, voffB);
            PG8_BAR; PG8_WAIT_L(0); PG8_MMA(0, 1, At, B1); PG8_BAR;
            PG8_LDA(At, 1, 1); PG8_STAGE(PG8_SA(1, 0), a3, voffA);
            PG8_BAR; PG8_WAIT_L(0); PG8_MMA(1, 0, At, B0); PG8_BAR; PG8_SCHED;
            PG8_STAGE(PG8_SB(1, 1), b3 + hstep, voffB);
            PG8_WAIT_V(6); PG8_BAR; PG8_MMA(1, 1, At, B1); PG8_BAR;
            }
        }
        if constexpr (ALIGN_EPI) { if (wr == 0) PG8_BAR; }
        PG8_MFMA_DRAIN();
        if constexpr (!Epi::AFTER_DRAIN) { E(acc, cur, wr, wc, fr, fq); S.done(cur); }
        if (!has_next) break;
#pragma unroll
        for (int a = 0; a < 2; ++a)
#pragma unroll
            for (int b = 0; b < 2; ++b)
#pragma unroll
                for (int m = 0; m < 4; ++m)
#pragma unroll
                    for (int n = 0; n < 2; ++n) acc[a][b][m][n] = (f32x4){0.f, 0.f, 0.f, 0.f};
        cur = nxt; cA = nA; cB = nB; ++ui;
        if constexpr (ALIGN_EPI) { if (wr == 1) PG8_BAR; }
    }
    PG8_WAIT_V(0);
    if constexpr (!ALIGN_EPI) { if (wr == 0) PG8_BAR; }
    PG8_BAR;
    if constexpr (Epi::AFTER_DRAIN) { E.fused(acc, cur, wr, wc, fr, fq, lds, wid, lane); S.done(cur); }
#undef PG8_SA
#undef PG8_SB
#undef PG8_STAGE
#undef PG8_LDA
#undef PG8_LDB
#undef PG8_MMA
#undef PG8_MFMA_DRAIN
#undef PG8_WAIT_V
#undef PG8_WAIT_L
#undef PG8_BAR
#undef PG8_SCHED
}
}

#ifndef FAST_GEMM
#define FAST_GEMM 1
#endif
template <bool F8 = false, class E8>
__device__ __forceinline__ void gemm_any(const void* A, const void* Bt, int M, int N, int K, const E8& E, float* lds, int bid, int nb) {
#if FAST_GEMM
  pg8::Gemm g{(const bf16_t*)A, (const bf16_t*)Bt, M, N, F8 ? K / 2 : K}; pg8::StaticOrder S; S.init(M, N, nb, bid);
  pg8::EpiA<E8> EA{E};
  pg8::gemm_phase<pg8::EpiA<E8>, pg8::StaticOrder, true, true, F8>((PG8_LAS unsigned char*)lds, g, S, EA);
#else
  gemm_naive((const bf16_t*)A, (const bf16_t*)Bt, M, N, K, E, lds, bid, nb);
#endif
}
template <bool F8 = false, class E8>
__device__ __forceinline__ void gemm_bal(const void* A, const void* Bt, int M, int N, int K, const E8& E, float* lds, int bid, int nb) {
#if FAST_GEMM
  pg8::Gemm g{(const bf16_t*)A, (const bf16_t*)Bt, M, N, F8 ? K / 2 : K}; pg8::BalOrder S; S.S.init(M, N, nb, bid);
  pg8::EpiA<E8> EA{E};
  pg8::gemm_phase<pg8::EpiA<E8>, pg8::BalOrder, true, true, F8>((PG8_LAS unsigned char*)lds, g, S, EA);
#else
  gemm_naive((const bf16_t*)A, (const bf16_t*)Bt, M, N, K, E, lds, bid, nb);
#endif
}

__device__ void gla_naive(const Params& p, const WS& w, int b, int h, float* lds) {
  constexpr int CH = 16;
  const int tid = tidx(), dv = tid & 255, half = tid >> 8, wave = tid >> 6, lane = tid & 63;
  float* qf = lds; float* kf = qf + CH * 128; float* af = kf + CH * 128; float* vf = af + CH * 128; float* op = vf + CH * 256;
  float S[64];
#pragma unroll
  for (int i = 0; i < 64; ++i) S[i] = 0.f;
  const int gd = tid & 127;
  float gu[16];
#pragma unroll
  for (int r = 0; r < 16; ++r) gu[r] = p.gate_up[r * 512 + h * 128 + gd];
  const float gb = p.gate_bias[h * 128 + gd];
  const float qscale = 0.08838834764831845f;
  for (int t0 = 0; t0 < SEQ; t0 += CH) {
    const size_t tb = (size_t)b * SEQ + t0;
    { const int tok = tid >> 5, d4 = (tid & 31) * 4;
      const uint2 qv = *(const uint2*)(w.proj + (tb + tok) * NPROJ + C_GQ + h * 128 + d4);
      const uint2 kv = *(const uint2*)(w.proj + (tb + tok) * NPROJ + C_GK + h * 128 + d4);
      *(float4*)(qf + tok * 128 + d4) = make_float4(lo_f(qv.x) * qscale, hi_f(qv.x) * qscale, lo_f(qv.y) * qscale, hi_f(qv.y) * qscale);
      *(float4*)(kf + tok * 128 + d4) = make_float4(lo_f(kv.x), hi_f(kv.x), lo_f(kv.y), hi_f(kv.y)); }
    { const int dvv = tid & 255, tk8 = (tid >> 8) * 8; float f[8];
      unpack8(*(const uint4*)(w.vT + vT_at(h * 256 + dvv, tb) + tk8), f);
#pragma unroll
      for (int j = 0; j < 8; ++j) vf[(tk8 + j) * 256 + dvv] = f[j]; }
#pragma unroll
    for (int i = 0; i < 4; ++i) { const int tok = (tid >> 7) * 4 + i; float z = gb; float gl[16];
      unpack8(*(const uint4*)(w.proj + (tb + tok) * NPROJ + C_SM), gl); unpack8(*(const uint4*)(w.proj + (tb + tok) * NPROJ + C_SM + 8), gl + 8);
#pragma unroll
      for (int r = 0; r < 16; ++r) z += gl[r] * gu[r];
      af[tok * 128 + gd] = __expf(logsigmoidf_(z) * (1.f / 16.f)); }
    __syncthreads();
    for (int tok = 0; tok < CH; ++tok) {
      const float vv = vf[tok * 256 + dv]; float acc = 0.f;
#pragma unroll
      for (int i4 = 0; i4 < 16; ++i4) {
        const float4 a = *(const float4*)(af + tok * 128 + half * 64 + i4 * 4), k = *(const float4*)(kf + tok * 128 + half * 64 + i4 * 4), q = *(const float4*)(qf + tok * 128 + half * 64 + i4 * 4);
        S[i4 * 4 + 0] = a.x * S[i4 * 4 + 0] + k.x * vv; acc += q.x * S[i4 * 4 + 0];
        S[i4 * 4 + 1] = a.y * S[i4 * 4 + 1] + k.y * vv; acc += q.y * S[i4 * 4 + 1];
        S[i4 * 4 + 2] = a.z * S[i4 * 4 + 2] + k.z * vv; acc += q.z * S[i4 * 4 + 2];
        S[i4 * 4 + 3] = a.w * S[i4 * 4 + 3] + k.w * vv; acc += q.w * S[i4 * 4 + 3];
      }
      op[(half * CH + tok) * 256 + dv] = acc;
    }
    __syncthreads();
#pragma unroll
    for (int i = 0; i < 2; ++i) { const int tok = wave * 2 + i;
      const float4 o0 = *(const float4*)(op + tok * 256 + lane * 4), o1 = *(const float4*)(op + (CH + tok) * 256 + lane * 4);
      const float o[4] = {o0.x + o1.x, o0.y + o1.y, o0.z + o1.z, o0.w + o1.w};
      float ss = wave_sum(o[0] * o[0] + o[1] * o[1] + o[2] * o[2] + o[3] * o[3]);
      const float rs = rsqrtf(ss * (1.f / 256.f) + EPS);
      const uint2 gg = *(const uint2*)(w.proj + (tb + tok) * NPROJ + C_GG + h * 256 + lane * 4);
      const float4 gn = *(const float4*)(p.gla_norm + h * 256 + lane * 4);
      const float y0 = o[0] * rs * gn.x * siluf_(lo_f(gg.x)), y1 = o[1] * rs * gn.y * siluf_(hi_f(gg.x)), y2 = o[2] * rs * gn.z * siluf_(lo_f(gg.y)), y3 = o[3] * rs * gn.w * siluf_(hi_f(gg.y));
      *(uint2*)(w.y + (tb + tok) * D + h * 256 + lane * 4) = make_uint2(pack2(y0, y1), pack2(y2, y3)); }
    __syncthreads();
  }
}
__device__ void mlstm_naive(const Params& p, const WS& w, int b, int h, float* lds) {
  constexpr int CH = 16;
  const int tid = tidx(), dv = tid & 255, half = tid >> 8, wave = tid >> 6, lane = tid & 63;
  float* qf = lds; float* kf = qf + CH * 128; float* vf = kf + CH * 128; float* op = vf + CH * 256; float* dn = op + 2 * CH * 256; float* gt = dn + 2 * CH * 256;
  float C[64], n[4];
#pragma unroll
  for (int i = 0; i < 64; ++i) C[i] = 0.f;
#pragma unroll
  for (int i = 0; i < 4; ++i) n[i] = 0.f;
  const int nd = half * 64 + (dv & 15) * 4;
  const float kscale = 0.08838834764831845f;
  const float ib = p.ig_bias[h], fb = p.fg_bias[h];
  for (int t0 = 0; t0 < SEQ; t0 += CH) {
    const size_t tb = (size_t)b * SEQ + t0;
    { const int tok = tid >> 5, d4 = (tid & 31) * 4;
      float qa[4], ka[4];
#pragma unroll
      for (int c = 0; c < 4; ++c) { qa[c] = p.conv_b[h * 128 + d4 + c]; ka[c] = p.conv_b[512 + h * 128 + d4 + c]; }
#pragma unroll
      for (int wi = 0; wi < 4; ++wi) { const int ts = t0 + tok - 3 + wi;
        if (ts >= 0) { const size_t tr = (size_t)b * SEQ + ts;
          const uint2 qv = *(const uint2*)(w.proj + tr * NPROJ + C_MQ + h * 128 + d4), kv = *(const uint2*)(w.proj + tr * NPROJ + C_MK + h * 128 + d4);
          const float4 cq = *(const float4*)(p.conv_w + wi * 1024 + h * 128 + d4), ck = *(const float4*)(p.conv_w + wi * 1024 + 512 + h * 128 + d4);
          qa[0] += cq.x * lo_f(qv.x); qa[1] += cq.y * hi_f(qv.x); qa[2] += cq.z * lo_f(qv.y); qa[3] += cq.w * hi_f(qv.y);
          ka[0] += ck.x * lo_f(kv.x); ka[1] += ck.y * hi_f(kv.x); ka[2] += ck.z * lo_f(kv.y); ka[3] += ck.w * hi_f(kv.y); } }
      *(float4*)(qf + tok * 128 + d4) = make_float4(siluf_(qa[0]), siluf_(qa[1]), siluf_(qa[2]), siluf_(qa[3]));
      *(float4*)(kf + tok * 128 + d4) = make_float4(siluf_(ka[0]) * kscale, siluf_(ka[1]) * kscale, siluf_(ka[2]) * kscale, siluf_(ka[3]) * kscale); }
    { const int dvv = tid & 255, tk8 = (tid >> 8) * 8; float f[8];
      unpack8(*(const uint4*)(w.vT + vT_at(1024 + h * 256 + dvv, tb) + tk8), f);
#pragma unroll
      for (int j = 0; j < 8; ++j) vf[(tk8 + j) * 256 + dvv] = f[j]; }
    if (tid < CH) { const float mi = bf2f(w.proj[(tb + tid) * NPROJ + C_SM + 16 + h]), mf = bf2f(w.proj[(tb + tid) * NPROJ + C_SM + 20 + h]);
      gt[tid * 2] = __expf(mi + ib); gt[tid * 2 + 1] = sigmoidf_(mf + fb); }
    __syncthreads();
    for (int tok = 0; tok < CH; ++tok) {
      const float vv = vf[tok * 256 + dv], ig = gt[tok * 2], fg = gt[tok * 2 + 1]; float num = 0.f, den = 0.f;
#pragma unroll
      for (int i4 = 0; i4 < 16; ++i4) {
        const float4 k = *(const float4*)(kf + tok * 128 + half * 64 + i4 * 4), q = *(const float4*)(qf + tok * 128 + half * 64 + i4 * 4);
        const float kk[4] = {k.x * ig, k.y * ig, k.z * ig, k.w * ig}; const float qq[4] = {q.x, q.y, q.z, q.w};
#pragma unroll
        for (int c = 0; c < 4; ++c) { C[i4 * 4 + c] = fg * C[i4 * 4 + c] + kk[c] * vv; num += qq[c] * C[i4 * 4 + c]; }
      }
      { const float4 k = *(const float4*)(kf + tok * 128 + nd), q = *(const float4*)(qf + tok * 128 + nd);
        n[0] = fg * n[0] + k.x * ig; n[1] = fg * n[1] + k.y * ig; n[2] = fg * n[2] + k.z * ig; n[3] = fg * n[3] + k.w * ig;
        den = q.x * n[0] + q.y * n[1] + q.z * n[2] + q.w * n[3];
        den = gsum<16>(den); }
      op[(half * CH + tok) * 256 + dv] = num; if (dv == 0) dn[half * CH + tok] = den;
    }
    __syncthreads();
#pragma unroll
    for (int i = 0; i < 2; ++i) { const int tok = wave * 2 + i;
      const float4 o0 = *(const float4*)(op + tok * 256 + lane * 4), o1 = *(const float4*)(op + (CH + tok) * 256 + lane * 4);
      const float den = dn[tok] + dn[CH + tok];
      const float inv = 1.f / fmaxf(fabsf(den), 1.f);
      const float o[4] = {(o0.x + o1.x) * inv, (o0.y + o1.y) * inv, (o0.z + o1.z) * inv, (o0.w + o1.w) * inv};
      float ss = wave_sum(o[0] * o[0] + o[1] * o[1] + o[2] * o[2] + o[3] * o[3]);
      const float rs = rsqrtf(ss * (1.f / 256.f) + EPS);
      const uint2 mo = *(const uint2*)(w.proj + (tb + tok) * NPROJ + C_MO + h * 256 + lane * 4);
      const float4 gn = *(const float4*)(p.mlstm_norm + h * 256 + lane * 4);
      const float y0 = o[0] * rs * gn.x * sigmoidf_(lo_f(mo.x)), y1 = o[1] * rs * gn.y * sigmoidf_(hi_f(mo.x)), y2 = o[2] * rs * gn.z * sigmoidf_(lo_f(mo.y)), y3 = o[3] * rs * gn.w * sigmoidf_(hi_f(mo.y));
      *(uint2*)(w.y + (tb + tok) * D + 1024 + h * 256 + lane * 4) = make_uint2(pack2(y0, y1), pack2(y2, y3)); }
    __syncthreads();
  }
}
__device__ void phase_mixer_naive(const Params& p, const WS& w, float* lds, int bid, int nb) {
  for (int item = bid; item < 16; item += nb) {
    if (item < 8) gla_naive(p, w, item >> 2, item & 3, lds); else mlstm_naive(p, w, (item - 8) >> 2, item & 3, lds);
    __syncthreads();
  }
}


typedef short bf16x8 __attribute__((ext_vector_type(8)));
typedef float f32x4 __attribute__((ext_vector_type(4)));
#define MFMA16(a, b, c) __builtin_amdgcn_mfma_f32_16x16x32_bf16(a, b, c, 0, 0, 0)
constexpr int L_GLR = 0, L_TOT = 4096, L_F = 6144, L_DEN = 6656, L_PART = 6912, L_QS = 9216, L_KS = 26624, L_P = 44032, L_NL = 53248, L_KDT = 9216;
constexpr int QS_LD = 136, P_LD = 72, KDT_LD = 72;

__device__ __forceinline__ void gla_gates(const Params& p, const WS& w, int h, size_t tb, unsigned char* ldsb, int tid, float* bv, float& blast) {
  float* glrs = (float*)(ldsb + L_GLR); float* tot = (float*)(ldsb + L_TOT);
  const int d = tid & 127, tg = tid >> 7;
  if (tid < 128) { float f[8]; unpack8(*(const uint4*)(w.proj + (tb + (tid >> 1)) * NPROJ + C_SM + (tid & 1) * 8), f);
#pragma unroll
    for (int j = 0; j < 8; ++j) glrs[(tid >> 1) * 16 + (tid & 1) * 8 + j] = f[j]; }
  float gu[16];
#pragma unroll
  for (int r = 0; r < 16; ++r) gu[r] = p.gate_up[r * 512 + h * 128 + d];
  const float gb = p.gate_bias[h * 128 + d];
  __syncthreads();
  float run = 0.f;
#pragma unroll
  for (int i = 0; i < 16; ++i) { const float* gl = glrs + (tg * 16 + i) * 16; float z = gb;
#pragma unroll
    for (int r4 = 0; r4 < 4; ++r4) { const float4 g4 = *(const float4*)(gl + r4 * 4); z += g4.x * gu[r4 * 4] + g4.y * gu[r4 * 4 + 1] + g4.z * gu[r4 * 4 + 2] + g4.w * gu[r4 * 4 + 3]; }
    run += logsigmoidf_(z) * (1.f / 16.f); bv[i] = run; }
  tot[tg * 128 + d] = run;
  __syncthreads();
  float off = 0.f; blast = 0.f;
#pragma unroll
  for (int g = 0; g < 4; ++g) { const float t = tot[g * 128 + d]; blast += t; if (g < tg) off += t; }
#pragma unroll
  for (int i = 0; i < 16; ++i) bv[i] += off;
}
__device__ __forceinline__ void mlstm_gates(const Params& p, const WS& w, int h, size_t tb, unsigned char* ldsb, int tid) {
  float* Fl = (float*)(ldsb + L_F);
  if (tid < 64) { const float mi = bf2f(w.proj[(tb + tid) * NPROJ + C_SM + 16 + h]), mf = bf2f(w.proj[(tb + tid) * NPROJ + C_SM + 20 + h]);
    float f = logsigmoidf_(mf + p.fg_bias[h]);
#pragma unroll
    for (int o = 1; o < 64; o <<= 1) { const float t = bperm(f, tid - o); if (tid >= o) f += t; }
    Fl[tid] = f; Fl[64 + tid] = mi + p.ig_bias[h]; }
  __syncthreads();
}
__device__ __forceinline__ void conv_load(const WS& w, int col, int b, int c, int tg, bf16_t* win) {
  const int s0 = c * 64 + tg * 16 - 3;
#pragma unroll
  for (int m = 0; m < 19; ++m) { const int sp = s0 + m; win[m] = (sp >= 0) ? w.proj[((size_t)b * SEQ + sp) * NPROJ + col] : (bf16_t)0; }
}
__device__ __forceinline__ void conv_apply(const Params& p, const bf16_t* win, int cch, float scale, float* out) {
  const float c0 = p.conv_w[cch], c1 = p.conv_w[1024 + cch], c2 = p.conv_w[2048 + cch], c3 = p.conv_w[3072 + cch], cb = p.conv_b[cch];
#pragma unroll
  for (int i = 0; i < 16; ++i) out[i] = siluf_(cb + c0 * bf2f(win[i]) + c1 * bf2f(win[i + 1]) + c2 * bf2f(win[i + 2]) + c3 * bf2f(win[i + 3])) * scale;
}

template <int KIND>
__device__ void mix_local(const Params& p, const WS& w, int b, int h, int c, int item, unsigned char* ldsb) {
  const int tid = tidx(), lane = tid & 63, wave = tid >> 6, fr = lane & 15, fq = lane >> 4, d = tid & 127, tg = tid >> 7;
  const size_t tb = (size_t)b * SEQ + (size_t)c * 64;
  float* tot = (float*)(ldsb + L_TOT); const float* Fl = (const float*)(ldsb + L_F);
  bf16_t* kdT = (bf16_t*)(ldsb + L_KDT);
  const bf16_t* vrow = w.vT + vT_at(KIND * 1024 + h * 256 + wave * 32 + fr, tb) + fq * 8;
  bf16x8 yv[2][2];
#pragma unroll
  for (int ks = 0; ks < 2; ++ks) { yv[ks][0] = *(const bf16x8*)(vrow + ks * 32); yv[ks][1] = *(const bf16x8*)(vrow + 16 * 64 + ks * 32); }
  bf16_t kraw[19];
  if (KIND == 0) {
#pragma unroll
    for (int i = 0; i < 16; ++i) kraw[i] = w.proj[(tb + tg * 16 + i) * NPROJ + C_GK + h * 128 + d];
  } else conv_load(w, C_MK + h * 128 + d, b, c, tg, kraw);
  float wgt[16], kv[16];
  if (KIND == 0) {
    float bv[16], blast; gla_gates(p, w, h, tb, ldsb, tid, bv, blast);
#pragma unroll
    for (int i = 0; i < 16; ++i) { wgt[i] = __expf(blast - bv[i]); kv[i] = bf2f(kraw[i]); }
    if (tg == 0) w.gdec[(size_t)item * 128 + d] = __expf(blast);
  } else {
    mlstm_gates(p, w, h, tb, ldsb, tid);
    const float flast = Fl[63];
#pragma unroll
    for (int i = 0; i < 16; ++i) wgt[i] = __expf(flast - Fl[tg * 16 + i] + Fl[64 + tg * 16 + i]);
    conv_apply(p, kraw, 512 + h * 128 + d, 0.08838834764831845f, kv);
    if (tid == 0) w.mdec[item - 2048] = __expf(flast);
  }
  float un = 0.f; float kd[16];
#pragma unroll
  for (int i = 0; i < 16; ++i) { kd[i] = kv[i] * wgt[i]; un += kd[i]; }
  *(uint4*)(kdT + d * KDT_LD + tg * 16) = pack8(kd); *(uint4*)(kdT + d * KDT_LD + tg * 16 + 8) = pack8(kd + 8);
  if (KIND == 1) tot[tg * 128 + d] = un;
  __syncthreads();
  if (KIND == 1 && tg == 0) w.mn[(size_t)(item - 2048) * 128 + d] = tot[d] + tot[128 + d] + tot[256 + d] + tot[384 + d];
  f32x4 acc[2][8];
#pragma unroll
  for (int yt = 0; yt < 2; ++yt)
#pragma unroll
    for (int xt = 0; xt < 8; ++xt) acc[yt][xt] = (f32x4){0.f, 0.f, 0.f, 0.f};
#pragma unroll
  for (int ks = 0; ks < 2; ++ks) {
#pragma unroll
    for (int xt = 0; xt < 8; ++xt) { const bf16x8 xk = *(const bf16x8*)(kdT + (xt * 16 + fr) * KDT_LD + ks * 32 + fq * 8);
      acc[0][xt] = MFMA16(xk, yv[ks][0], acc[0][xt]); acc[1][xt] = MFMA16(xk, yv[ks][1], acc[1][xt]); }
  }
  bf16_t* S = (bf16_t*)p.out + (size_t)item * 32768;
#pragma unroll
  for (int yt = 0; yt < 2; ++yt)
#pragma unroll
    for (int xt = 0; xt < 8; ++xt) *(uint2*)(S + (wave * 32 + yt * 16 + fr) * 128 + xt * 16 + 4 * fq) = make_uint2(pack2(acc[yt][xt][0], acc[yt][xt][1]), pack2(acc[yt][xt][2], acc[yt][xt][3]));
  __syncthreads();
}

#ifndef SCAN_GROUPS
#define SCAN_GROUPS 1
#endif
__device__ void mix_scan(const Params& p, const WS& w, float* lds, int bid, int nb) {
  bf16_t* sbuf = (bf16_t*)p.out;
  const int tid = tidx();
  const bool inl = nb >= 2 && nb * 512 <= 16 * 8192;
  const int gm = (nb - 1 - bid) * 512 + tid; const bool hasm = inl && gm < 8 * 128; const int mcb = (gm >> 7) & 7, md = gm & 127; float nrun = 0.f;
  for (int g0 = bid * 512; g0 < 16 * 8192; g0 += nb * 512) {
    const int g = g0 + tid, combo = g0 >> 13, e = (g & 8191) * 4, dk = e & 127;
    const bool mnow = hasm && g0 == bid * 512;
    __syncthreads();
    if (combo < 8) { const float4* src = (const float4*)(w.gdec + (size_t)combo * 32768);
#pragma unroll
      for (int i = 0; i < 16; ++i) ((float4*)lds)[i * 512 + tid] = src[i * 512 + tid]; }
    else if (tid < 256) lds[tid] = w.mdec[(combo - 8) * 256 + tid];
    __syncthreads();
    bf16_t* base = sbuf + (size_t)combo * 256 * 32768 + e;
    float S0 = 0.f, S1 = 0.f, S2 = 0.f, S3 = 0.f;
    for (int c0 = 0; c0 < 256; c0 += 16) {
      uint2 u[16]; float um[16], dm[16];
#pragma unroll
      for (int k = 0; k < 16; ++k) u[k] = *(const uint2*)(base + (size_t)(c0 + k) * 32768);
      if (mnow) {
#pragma unroll
        for (int k = 0; k < 16; ++k) { um[k] = w.mn[(size_t)(mcb * 256 + c0 + k) * 128 + md]; dm[k] = w.mdec[mcb * 256 + c0 + k]; } }
#pragma unroll
      for (int k = 0; k < 16; ++k) { float4 dc; if (combo < 8) dc = *(const float4*)(lds + (c0 + k) * 128 + dk); else { const float m = lds[c0 + k]; dc = make_float4(m, m, m, m); }
#if SCAN_GROUPS
        if (k == 0) *(float4*)((float*)w.kdT + (size_t)(combo * 16 + (c0 >> 4)) * 32768 + e) = make_float4(S0, S1, S2, S3);
#else
        *(uint2*)(base + (size_t)(c0 + k) * 32768) = make_uint2(pack2(S0, S1), pack2(S2, S3));
#endif
        S0 = dc.x * S0 + lo_f(u[k].x); S1 = dc.y * S1 + hi_f(u[k].x); S2 = dc.z * S2 + lo_f(u[k].y); S3 = dc.w * S3 + hi_f(u[k].y); }
      if (mnow) {
#pragma unroll
        for (int k = 0; k < 16; ++k) { w.mn[(size_t)(mcb * 256 + c0 + k) * 128 + md] = nrun; nrun = dm[k] * nrun + um[k]; } }
    }
  }
  if (!inl) {
    for (int g = bid * 512 + tid; g < 8 * 128; g += nb * 512) {
      const int cb = g >> 7, d = g & 127; float n = 0.f;
      for (int c = 0; c < 256; ++c) { float* q = w.mn + (size_t)(cb * 256 + c) * 128 + d; const float u = *q; *q = n; n = w.mdec[cb * 256 + c] * n + u; }
    }
  }
}

template <int KIND>
__device__ void mix_out(const Params& p, const WS& w, int b, int h, int c, int item, unsigned char* ldsb) {
  const int tid = tidx(), lane = tid & 63, wave = tid >> 6, fr = lane & 15, fq = lane >> 4, d = tid & 127, tg = tid >> 7;
  const size_t tb = (size_t)b * SEQ + (size_t)c * 64;
  const float* Fl = (const float*)(ldsb + L_F); float* denl = (float*)(ldsb + L_DEN); float* part = (float*)(ldsb + L_PART); float* nl = (float*)(ldsb + L_NL);
  bf16_t* qs = (bf16_t*)(ldsb + L_QS); bf16_t* ks = (bf16_t*)(ldsb + L_KS); bf16_t* P = (bf16_t*)(ldsb + L_P);
  bf16x8 vx[2][2], sx[4][2];
  { const bf16_t* vrow = w.vT + vT_at(KIND * 1024 + h * 256 + wave * 32 + fr, tb) + fq * 8;
#pragma unroll
    for (int k2 = 0; k2 < 2; ++k2) { vx[k2][0] = *(const bf16x8*)(vrow + k2 * 32); vx[k2][1] = *(const bf16x8*)(vrow + 16 * 64 + k2 * 32); }
    const bf16_t* srow = (const bf16_t*)p.out + (size_t)item * 32768 + (wave * 32 + fr) * 128 + fq * 8;
#pragma unroll
    for (int k4 = 0; k4 < 4; ++k4) { sx[k4][0] = *(const bf16x8*)(srow + k4 * 32); sx[k4][1] = *(const bf16x8*)(srow + 16 * 128 + k4 * 32); } }
  uint2 gt[4][2];
#pragma unroll
  for (int yt = 0; yt < 4; ++yt)
#pragma unroll
    for (int xt = 0; xt < 2; ++xt) gt[yt][xt] = *(const uint2*)(w.proj + (tb + yt * 16 + fr) * NPROJ + (KIND == 0 ? C_GG : C_MO) + h * 256 + wave * 32 + xt * 16 + 4 * fq);
  const float* gain = (KIND == 0 ? p.gla_norm : p.mlstm_norm) + h * 256;
  const float4 gn0 = *(const float4*)(gain + wave * 32 + 4 * fq), gn1 = *(const float4*)(gain + wave * 32 + 16 + 4 * fq);
  bf16_t qraw[19], kraw[19];
  if (KIND == 0) {
#pragma unroll
    for (int i = 0; i < 16; ++i) { qraw[i] = w.proj[(tb + tg * 16 + i) * NPROJ + C_GQ + h * 128 + d]; kraw[i] = w.proj[(tb + tg * 16 + i) * NPROJ + C_GK + h * 128 + d]; }
  } else { conv_load(w, C_MQ + h * 128 + d, b, c, tg, qraw); conv_load(w, C_MK + h * 128 + d, b, c, tg, kraw); }
  float nlv = 0.f;
  if (KIND == 1 && tid < 128) nlv = w.mn[(size_t)(item - 2048) * 128 + tid];
  {
    float qm[16], km[16], qv[16], kv[16];
    if (KIND == 0) {
      float bv[16], blast; gla_gates(p, w, h, tb, ldsb, tid, bv, blast);
#pragma unroll
      for (int i = 0; i < 16; ++i) { qm[i] = 0.08838834764831845f * __expf(bv[i]); km[i] = __expf(-bv[i]); qv[i] = bf2f(qraw[i]); kv[i] = bf2f(kraw[i]); }
    } else {
      mlstm_gates(p, w, h, tb, ldsb, tid);
#pragma unroll
      for (int i = 0; i < 16; ++i) { const float F = Fl[tg * 16 + i]; qm[i] = __expf(F); km[i] = __expf(Fl[64 + tg * 16 + i] - F); }
      conv_apply(p, qraw, h * 128 + d, 1.f, qv);
      conv_apply(p, kraw, 512 + h * 128 + d, 0.08838834764831845f, kv);
      if (tid < 128) nl[tid] = nlv;
    }
#pragma unroll
    for (int i = 0; i < 16; ++i) { qs[(tg * 16 + i) * QS_LD + d] = f2bf(qv[i] * qm[i]); ks[(tg * 16 + i) * QS_LD + d] = f2bf(kv[i] * km[i]); }
  }
  __syncthreads();
#pragma unroll
  for (int q = 0; q < 2; ++q) { const int tt = wave * 2 + q, jt = tt >> 2, it = tt & 3; f32x4 a = (f32x4){0.f, 0.f, 0.f, 0.f};
#pragma unroll
    for (int k4 = 0; k4 < 4; ++k4) { const bf16x8 xk = *(const bf16x8*)(ks + (jt * 16 + fr) * QS_LD + k4 * 32 + fq * 8), yq = *(const bf16x8*)(qs + (it * 16 + fr) * QS_LD + k4 * 32 + fq * 8); a = MFMA16(xk, yq, a); }
    const int i = it * 16 + fr, j0 = jt * 16 + 4 * fq;
    const float v0 = (j0 <= i) ? a[0] : 0.f, v1 = (j0 + 1 <= i) ? a[1] : 0.f, v2 = (j0 + 2 <= i) ? a[2] : 0.f, v3 = (j0 + 3 <= i) ? a[3] : 0.f;
    *(uint2*)(P + i * P_LD + j0) = make_uint2(pack2(v0, v1), pack2(v2, v3)); }
  __syncthreads();
  if (KIND == 1) { const int i = tid >> 3, pt = tid & 7; float f[8]; float s = 0.f;
    unpack8(*(const uint4*)(P + i * P_LD + pt * 8), f);
#pragma unroll
    for (int j = 0; j < 8; ++j) s += f[j];
#pragma unroll
    for (int hh = 0; hh < 2; ++hh) { unpack8(*(const uint4*)(qs + i * QS_LD + pt * 16 + hh * 8), f);
#pragma unroll
      for (int j = 0; j < 8; ++j) s += f[j] * nl[pt * 16 + hh * 8 + j]; }
    s = gsum<8>(s);
    if (pt == 0) denl[i] = s; }
  f32x4 acc[2][4];
#pragma unroll
  for (int xt = 0; xt < 2; ++xt)
#pragma unroll
    for (int yt = 0; yt < 4; ++yt) acc[xt][yt] = (f32x4){0.f, 0.f, 0.f, 0.f};
#pragma unroll
  for (int k2 = 0; k2 < 2; ++k2)
#pragma unroll
    for (int yt = 0; yt < 4; ++yt) { const bf16x8 yp = *(const bf16x8*)(P + (yt * 16 + fr) * P_LD + k2 * 32 + fq * 8); acc[0][yt] = MFMA16(vx[k2][0], yp, acc[0][yt]); acc[1][yt] = MFMA16(vx[k2][1], yp, acc[1][yt]); }
#pragma unroll
  for (int k4 = 0; k4 < 4; ++k4)
#pragma unroll
    for (int yt = 0; yt < 4; ++yt) { const bf16x8 yq = *(const bf16x8*)(qs + (yt * 16 + fr) * QS_LD + k4 * 32 + fq * 8); acc[0][yt] = MFMA16(sx[k4][0], yq, acc[0][yt]); acc[1][yt] = MFMA16(sx[k4][1], yq, acc[1][yt]); }
  if (KIND == 1) __syncthreads();
#pragma unroll
  for (int yt = 0; yt < 4; ++yt) { float s = 0.f;
    if (KIND == 1) { const float inv = 1.f / fmaxf(fabsf(denl[yt * 16 + fr]), 1.f); acc[0][yt] *= inv; acc[1][yt] *= inv; }
#pragma unroll
    for (int xt = 0; xt < 2; ++xt)
#pragma unroll
      for (int r = 0; r < 4; ++r) s += acc[xt][yt][r] * acc[xt][yt][r];
    s += sxor<16>(s); s += sxor<32>(s);
    if (fq == 0) part[wave * 64 + yt * 16 + fr] = s; }
  __syncthreads();
#pragma unroll
  for (int yt = 0; yt < 4; ++yt) { const int i = yt * 16 + fr; float t = 0.f;
#pragma unroll
    for (int ww = 0; ww < 8; ++ww) t += part[ww * 64 + i];
    const float rs = rsqrtf(t * (1.f / 256.f) + EPS);
#pragma unroll
    for (int xt = 0; xt < 2; ++xt) { const int dv = wave * 32 + xt * 16 + 4 * fq;
      const float4 gn = xt == 0 ? gn0 : gn1; const uint2 g2 = gt[yt][xt];
      const float g0 = lo_f(g2.x), g1 = hi_f(g2.x), g2f = lo_f(g2.y), g3 = hi_f(g2.y);
      const float a0 = KIND == 0 ? siluf_(g0) : sigmoidf_(g0), a1 = KIND == 0 ? siluf_(g1) : sigmoidf_(g1), a2 = KIND == 0 ? siluf_(g2f) : sigmoidf_(g2f), a3 = KIND == 0 ? siluf_(g3) : sigmoidf_(g3);
      const float y0 = acc[xt][yt][0] * rs * gn.x * a0, y1 = acc[xt][yt][1] * rs * gn.y * a1, y2 = acc[xt][yt][2] * rs * gn.z * a2, y3 = acc[xt][yt][3] * rs * gn.w * a3;
#if F8_OUT
      *(unsigned*)(w.yq + (tb + i) * D + KIND * 1024 + h * 256 + dv) = pack4_fp8(y0, y1, y2, y3);
#else
      *(uint2*)(w.y + (tb + i) * D + KIND * 1024 + h * 256 + dv) = make_uint2(pack2(y0, y1), pack2(y2, y3));
#endif
    } }
  __syncthreads();
}
__device__ __forceinline__ void mix_out3_fetch(const WS& w, int item, int tid, uint4& tq0, uint4& tq1, uint4& tk0, uint4& tk1, float& nlv) {
  const int kind = item >> 11, b = (item >> 10) & 1, h = (item >> 8) & 3, c = item & 255;
  const size_t tb = (size_t)b * SEQ + (size_t)c * 64;
  const bf16_t* gq = w.qs + qs_at(kind * 4 + h, tb); const bf16_t* gk = w.ks + qs_at(kind * 4 + h, tb);
  const int r0 = tid >> 4, r1 = (512 + tid) >> 4, c8 = (tid & 15) * 8;
  tq0 = *(const uint4*)(gq + r0 * 128 + c8); tq1 = *(const uint4*)(gq + r1 * 128 + c8); tk0 = *(const uint4*)(gk + r0 * 128 + c8); tk1 = *(const uint4*)(gk + r1 * 128 + c8);
  if (kind == 1 && tid < 128) nlv = w.mn[(size_t)(item - 2048) * 128 + tid];
}
template <int KIND>
__device__ __forceinline__ void mix_out3(const Params& p, const WS& w, int b, int h, int c, int item, unsigned char* ldsb, uint4& tq0, uint4& tq1, uint4& tk0, uint4& tk1, float& nlv, int nitem) {
  const int tid = tidx(), lane = tid & 63, wave = tid >> 6, fr = lane & 15, fq = lane >> 4, d = tid & 127, tg = tid >> 7;
  const size_t tb = (size_t)b * SEQ + (size_t)c * 64;
  const float* Fl = (const float*)(ldsb + L_F); float* denl = (float*)(ldsb + L_DEN); float* part = (float*)(ldsb + L_PART); float* nl = (float*)(ldsb + L_NL);
  bf16_t* qs = (bf16_t*)(ldsb + L_QS); bf16_t* ks = (bf16_t*)(ldsb + L_KS); bf16_t* P = (bf16_t*)(ldsb + L_P);
  bf16x8 vx[2][2], sx[4][2];
  { const bf16_t* vrow = w.vT + vT_at(KIND * 1024 + h * 256 + wave * 32 + fr, tb) + fq * 8;
#pragma unroll
    for (int k2 = 0; k2 < 2; ++k2) { vx[k2][0] = *(const bf16x8*)(vrow + k2 * 32); vx[k2][1] = *(const bf16x8*)(vrow + 16 * 64 + k2 * 32); }
    const bf16_t* srow = (const bf16_t*)p.out + (size_t)item * 32768 + (wave * 32 + fr) * 128 + fq * 8;
#pragma unroll
    for (int k4 = 0; k4 < 4; ++k4) { sx[k4][0] = *(const bf16x8*)(srow + k4 * 32); sx[k4][1] = *(const bf16x8*)(srow + 16 * 128 + k4 * 32); } }
  uint2 gt[4][2];
#pragma unroll
  for (int yt = 0; yt < 4; ++yt)
#pragma unroll
    for (int xt = 0; xt < 2; ++xt) gt[yt][xt] = *(const uint2*)(w.proj + (tb + yt * 16 + fr) * NPROJ + (KIND == 0 ? C_GG : C_MO) + h * 256 + wave * 32 + xt * 16 + 4 * fq);
  const float* gain = (KIND == 0 ? p.gla_norm : p.mlstm_norm) + h * 256;
  const float4 gn0 = *(const float4*)(gain + wave * 32 + 4 * fq), gn1 = *(const float4*)(gain + wave * 32 + 16 + 4 * fq);
  { const int r0 = tid >> 4, r1 = (512 + tid) >> 4, c8 = (tid & 15) * 8;
    *(uint4*)(qs + r0 * QS_LD + c8) = tq0; *(uint4*)(qs + r1 * QS_LD + c8) = tq1; *(uint4*)(ks + r0 * QS_LD + c8) = tk0; *(uint4*)(ks + r1 * QS_LD + c8) = tk1;
    if (KIND == 1 && tid < 128) nl[tid] = nlv;
    if (nitem >= 0) mix_out3_fetch(w, nitem, tid, tq0, tq1, tk0, tk1, nlv); }
  __syncthreads();
#pragma unroll
  for (int q = 0; q < 2; ++q) { const int tt = wave * 2 + q, jt = tt >> 2, it = tt & 3; f32x4 a = (f32x4){0.f, 0.f, 0.f, 0.f};
#pragma unroll
    for (int k4 = 0; k4 < 4; ++k4) { const bf16x8 xk = *(const bf16x8*)(ks + (jt * 16 + fr) * QS_LD + k4 * 32 + fq * 8), yq = *(const bf16x8*)(qs + (it * 16 + fr) * QS_LD + k4 * 32 + fq * 8); a = MFMA16(xk, yq, a); }
    const int i = it * 16 + fr, j0 = jt * 16 + 4 * fq;
    const float v0 = (j0 <= i) ? a[0] : 0.f, v1 = (j0 + 1 <= i) ? a[1] : 0.f, v2 = (j0 + 2 <= i) ? a[2] : 0.f, v3 = (j0 + 3 <= i) ? a[3] : 0.f;
    *(uint2*)(P + i * P_LD + j0) = make_uint2(pack2(v0, v1), pack2(v2, v3)); }
  __syncthreads();
  if (KIND == 1) { const int i = tid >> 3, pt = tid & 7; float f[8]; float s = 0.f;
    unpack8(*(const uint4*)(P + i * P_LD + pt * 8), f);
#pragma unroll
    for (int j = 0; j < 8; ++j) s += f[j];
#pragma unroll
    for (int hh = 0; hh < 2; ++hh) { unpack8(*(const uint4*)(qs + i * QS_LD + pt * 16 + hh * 8), f);
#pragma unroll
      for (int j = 0; j < 8; ++j) s += f[j] * nl[pt * 16 + hh * 8 + j]; }
    s = gsum<8>(s);
    if (pt == 0) denl[i] = s; }
  f32x4 acc[2][4];
#pragma unroll
  for (int xt = 0; xt < 2; ++xt)
#pragma unroll
    for (int yt = 0; yt < 4; ++yt) acc[xt][yt] = (f32x4){0.f, 0.f, 0.f, 0.f};
#pragma unroll
  for (int k2 = 0; k2 < 2; ++k2)
#pragma unroll
    for (int yt = 0; yt < 4; ++yt) { const bf16x8 yp = *(const bf16x8*)(P + (yt * 16 + fr) * P_LD + k2 * 32 + fq * 8); acc[0][yt] = MFMA16(vx[k2][0], yp, acc[0][yt]); acc[1][yt] = MFMA16(vx[k2][1], yp, acc[1][yt]); }
#pragma unroll
  for (int k4 = 0; k4 < 4; ++k4)
#pragma unroll
    for (int yt = 0; yt < 4; ++yt) { const bf16x8 yq = *(const bf16x8*)(qs + (yt * 16 + fr) * QS_LD + k4 * 32 + fq * 8); acc[0][yt] = MFMA16(sx[k4][0], yq, acc[0][yt]); acc[1][yt] = MFMA16(sx[k4][1], yq, acc[1][yt]); }
#pragma unroll
  for (int yt = 0; yt < 4; ++yt) { float s = 0.f;
#pragma unroll
    for (int xt = 0; xt < 2; ++xt)
#pragma unroll
      for (int r = 0; r < 4; ++r) s += acc[xt][yt][r] * acc[xt][yt][r];
    s += sxor<16>(s); s += sxor<32>(s);
    if (fq == 0) part[wave * 64 + yt * 16 + fr] = s; }
  __syncthreads();
#pragma unroll
  for (int yt = 0; yt < 4; ++yt) { const int i = yt * 16 + fr; float t = 0.f;
#pragma unroll
    for (int ww = 0; ww < 8; ++ww) t += part[ww * 64 + i];
    float dd = 1.f; if (KIND == 1) { dd = fmaxf(fabsf(denl[i]), 1.f); dd *= dd; }
    const float rs = rsqrtf(t * (1.f / 256.f) + EPS * dd);
#pragma unroll
    for (int xt = 0; xt < 2; ++xt) { const int dv = wave * 32 + xt * 16 + 4 * fq;
      const float4 gn = xt == 0 ? gn0 : gn1; const uint2 g2 = gt[yt][xt];
      const float g0 = lo_f(g2.x), g1 = hi_f(g2.x), g2f = lo_f(g2.y), g3 = hi_f(g2.y);
      const float a0 = KIND == 0 ? siluf_(g0) : sigmoidf_(g0), a1 = KIND == 0 ? siluf_(g1) : sigmoidf_(g1), a2 = KIND == 0 ? siluf_(g2f) : sigmoidf_(g2f), a3 = KIND == 0 ? siluf_(g3) : sigmoidf_(g3);
      const float y0 = acc[xt][yt][0] * rs * gn.x * a0, y1 = acc[xt][yt][1] * rs * gn.y * a1, y2 = acc[xt][yt][2] * rs * gn.z * a2, y3 = acc[xt][yt][3] * rs * gn.w * a3;
#if F8_OUT
      *(unsigned*)(w.yq + (tb + i) * D + KIND * 1024 + h * 256 + dv) = pack4_fp8(y0, y1, y2, y3);
#else
      *(uint2*)(w.y + (tb + i) * D + KIND * 1024 + h * 256 + dv) = make_uint2(pack2(y0, y1), pack2(y2, y3));
#endif
    } }
}

template <int KIND>
__device__ __forceinline__ void mix_out4_group(const Params& p, const WS& w, int seq, int grp, unsigned char* ldsb0, int& par) {
  const int b = (seq >> 2) & 1, h = seq & 3, item0 = seq * 256 + grp * 16;
  float Sf[4][2][8];
  { const int t0 = tidx(), wave = t0 >> 6, fr = t0 & 15, fq = (t0 >> 4) & 3;
    const float* grow = (const float*)w.kdT + (size_t)(seq * 16 + grp) * 32768 + (wave * 32 + fr) * 128 + fq * 8;
#pragma unroll
    for (int k4 = 0; k4 < 4; ++k4)
#pragma unroll
      for (int xt = 0; xt < 2; ++xt) { const float4 lo = *(const float4*)(grow + xt * 16 * 128 + k4 * 32), hi = *(const float4*)(grow + xt * 16 * 128 + k4 * 32 + 4);
        Sf[k4][xt][0] = lo.x; Sf[k4][xt][1] = lo.y; Sf[k4][xt][2] = lo.z; Sf[k4][xt][3] = lo.w; Sf[k4][xt][4] = hi.x; Sf[k4][xt][5] = hi.y; Sf[k4][xt][6] = hi.z; Sf[k4][xt][7] = hi.w; } }
  uint4 tq0, tq1, tk0, tk1; float nlv = 0.f;
  mix_out3_fetch(w, item0, tidx(), tq0, tq1, tk0, tk1, nlv);
#pragma unroll 1
  for (int ci = 0; ci < 16; ++ci, par ^= 1) {
    unsigned char* ldsb = ldsb0 + par * 57344;
    const int item = item0 + ci, c = grp * 16 + ci, nitem = ci < 15 ? item + 1 : -1;
    const int tid = tidx(), lane = tid & 63, wave = tid >> 6, fr = lane & 15, fq = lane >> 4;
    const size_t tb = (size_t)b * SEQ + (size_t)c * 64;
    float* denl = (float*)(ldsb + L_DEN); float* part = (float*)(ldsb + L_PART); float* nl = (float*)(ldsb + L_NL);
    bf16_t* qs = (bf16_t*)(ldsb + L_QS); bf16_t* ks = (bf16_t*)(ldsb + L_KS); bf16_t* P = (bf16_t*)(ldsb + L_P);
    bf16x8 vx[2][2], ux[4][2];
    { const bf16_t* vrow = w.vT + vT_at(KIND * 1024 + h * 256 + wave * 32 + fr, tb) + fq * 8;
#pragma unroll
      for (int k2 = 0; k2 < 2; ++k2) { vx[k2][0] = *(const bf16x8*)(vrow + k2 * 32); vx[k2][1] = *(const bf16x8*)(vrow + 16 * 64 + k2 * 32); }
      const bf16_t* urow = (const bf16_t*)p.out + (size_t)item * 32768 + (wave * 32 + fr) * 128 + fq * 8;
#pragma unroll
      for (int k4 = 0; k4 < 4; ++k4) { ux[k4][0] = *(const bf16x8*)(urow + k4 * 32); ux[k4][1] = *(const bf16x8*)(urow + 16 * 128 + k4 * 32); } }
    uint2 gt[4][2];
#pragma unroll
    for (int yt = 0; yt < 4; ++yt)
#pragma unroll
      for (int xt = 0; xt < 2; ++xt) gt[yt][xt] = *(const uint2*)(w.proj + (tb + yt * 16 + fr) * NPROJ + (KIND == 0 ? C_GG : C_MO) + h * 256 + wave * 32 + xt * 16 + 4 * fq);
    const float* gain = (KIND == 0 ? p.gla_norm : p.mlstm_norm) + h * 256;
    const float4 gn0 = *(const float4*)(gain + wave * 32 + 4 * fq), gn1 = *(const float4*)(gain + wave * 32 + 16 + 4 * fq);
    { const int r0 = tid >> 4, r1 = (512 + tid) >> 4, c8 = (tid & 15) * 8;
      *(uint4*)(qs + r0 * QS_LD + c8) = tq0; *(uint4*)(qs + r1 * QS_LD + c8) = tq1; *(uint4*)(ks + r0 * QS_LD + c8) = tk0; *(uint4*)(ks + r1 * QS_LD + c8) = tk1;
      if (KIND == 1 && tid < 128) nl[tid] = nlv;
      if (nitem >= 0) mix_out3_fetch(w, nitem, tid, tq0, tq1, tk0, tk1, nlv); }
    __syncthreads();
#pragma unroll
    for (int q = 0; q < 2; ++q) { const int tt = wave * 2 + q, jt = tt >> 2, it = tt & 3; f32x4 a = (f32x4){0.f, 0.f, 0.f, 0.f};
#pragma unroll
      for (int k4 = 0; k4 < 4; ++k4) { const bf16x8 xk = *(const bf16x8*)(ks + (jt * 16 + fr) * QS_LD + k4 * 32 + fq * 8), yq = *(const bf16x8*)(qs + (it * 16 + fr) * QS_LD + k4 * 32 + fq * 8); a = MFMA16(xk, yq, a); }
      const int i = it * 16 + fr, j0 = jt * 16 + 4 * fq;
      const float v0 = (j0 <= i) ? a[0] : 0.f, v1 = (j0 + 1 <= i) ? a[1] : 0.f, v2 = (j0 + 2 <= i) ? a[2] : 0.f, v3 = (j0 + 3 <= i) ? a[3] : 0.f;
      *(uint2*)(P + i * P_LD + j0) = make_uint2(pack2(v0, v1), pack2(v2, v3)); }
    __syncthreads();
    if (KIND == 1) { const int i = tid >> 3, pt = tid & 7; float f[8]; float s = 0.f;
      unpack8(*(const uint4*)(P + i * P_LD + pt * 8), f);
#pragma unroll
      for (int j = 0; j < 8; ++j) s += f[j];
#pragma unroll
      for (int hh = 0; hh < 2; ++hh) { unpack8(*(const uint4*)(qs + i * QS_LD + pt * 16 + hh * 8), f);
#pragma unroll
        for (int j = 0; j < 8; ++j) s += f[j] * nl[pt * 16 + hh * 8 + j]; }
      s = gsum<8>(s);
      if (pt == 0) denl[i] = s; }
    f32x4 acc[2][4];
#pragma unroll
    for (int xt = 0; xt < 2; ++xt)
#pragma unroll
      for (int yt = 0; yt < 4; ++yt) acc[xt][yt] = (f32x4){0.f, 0.f, 0.f, 0.f};
#pragma unroll
    for (int k2 = 0; k2 < 2; ++k2)
#pragma unroll
      for (int yt = 0; yt < 4; ++yt) { const bf16x8 yp = *(const bf16x8*)(P + (yt * 16 + fr) * P_LD + k2 * 32 + fq * 8); acc[0][yt] = MFMA16(vx[k2][0], yp, acc[0][yt]); acc[1][yt] = MFMA16(vx[k2][1], yp, acc[1][yt]); }
#pragma unroll
    for (int k4 = 0; k4 < 4; ++k4) {
      bf16x8 sx0, sx1;
      { const uint4 q0 = pack8(Sf[k4][0]), q1 = pack8(Sf[k4][1]); sx0 = __builtin_bit_cast(bf16x8, q0); sx1 = __builtin_bit_cast(bf16x8, q1); }
#pragma unroll
      for (int yt = 0; yt < 4; ++yt) { const bf16x8 yq = *(const bf16x8*)(qs + (yt * 16 + fr) * QS_LD + k4 * 32 + fq * 8); acc[0][yt] = MFMA16(sx0, yq, acc[0][yt]); acc[1][yt] = MFMA16(sx1, yq, acc[1][yt]); }
      float dcy[8];
      if (KIND == 0) { const float4 d0 = *(const float4*)(w.gdec + (size_t)item * 128 + k4 * 32 + 8 * fq), d1 = *(const float4*)(w.gdec + (size_t)item * 128 + k4 * 32 + 8 * fq + 4);
        dcy[0] = d0.x; dcy[1] = d0.y; dcy[2] = d0.z; dcy[3] = d0.w; dcy[4] = d1.x; dcy[5] = d1.y; dcy[6] = d1.z; dcy[7] = d1.w; }
      else { const float m = w.mdec[item - 2048];
#pragma unroll
        for (int j = 0; j < 8; ++j) dcy[j] = m; }
#pragma unroll
      for (int xt = 0; xt < 2; ++xt) { float uf[8]; unpack8(__builtin_bit_cast(uint4, ux[k4][xt]), uf);
#pragma unroll
        for (int j = 0; j < 8; ++j) Sf[k4][xt][j] = dcy[j] * Sf[k4][xt][j] + uf[j]; } }
#pragma unroll
    for (int yt = 0; yt < 4; ++yt) { float s = 0.f;
#pragma unroll
      for (int xt = 0; xt < 2; ++xt)
#pragma unroll
        for (int r = 0; r < 4; ++r) s += acc[xt][yt][r] * acc[xt][yt][r];
      s += sxor<16>(s); s += sxor<32>(s);
      if (fq == 0) part[wave * 64 + yt * 16 + fr] = s; }
    __syncthreads();
#pragma unroll
    for (int yt = 0; yt < 4; ++yt) { const int i = yt * 16 + fr; float t = 0.f;
#pragma unroll
      for (int ww = 0; ww < 8; ++ww) t += part[ww * 64 + i];
      float dd = 1.f; if (KIND == 1) { dd = fmaxf(fabsf(denl[i]), 1.f); dd *= dd; }
      const float rs = rsqrtf(t * (1.f / 256.f) + EPS * dd);
#pragma unroll
      for (int xt = 0; xt < 2; ++xt) { const int dv = wave * 32 + xt * 16 + 4 * fq;
        const float4 gn = xt == 0 ? gn0 : gn1; const uint2 g2 = gt[yt][xt];
        const float g0 = lo_f(g2.x), g1 = hi_f(g2.x), g2f = lo_f(g2.y), g3 = hi_f(g2.y);
        const float a0 = KIND == 0 ? siluf_(g0) : sigmoidf_(g0), a1 = KIND == 0 ? siluf_(g1) : sigmoidf_(g1), a2 = KIND == 0 ? siluf_(g2f) : sigmoidf_(g2f), a3 = KIND == 0 ? siluf_(g3) : sigmoidf_(g3);
        const float y0 = acc[xt][yt][0] * rs * gn.x * a0, y1 = acc[xt][yt][1] * rs * gn.y * a1, y2 = acc[xt][yt][2] * rs * gn.z * a2, y3 = acc[xt][yt][3] * rs * gn.w * a3;
#if F8_OUT
        *(unsigned*)(w.yq + (tb + i) * D + KIND * 1024 + h * 256 + dv) = pack4_fp8(y0, y1, y2, y3);
#else
        *(uint2*)(w.y + (tb + i) * D + KIND * 1024 + h * 256 + dv) = make_uint2(pack2(y0, y1), pack2(y2, y3));
#endif
      } }
  }
}
__device__ void phase_mix_out4(const Params& p, const WS& w, unsigned char* ldsb, int bid, int nb) {
  int par = 0;
  for (int gi = bid; gi < 256; gi += nb) {
    const int seq = gi >> 4, grp = gi & 15;
    if (seq < 8) mix_out4_group<0>(p, w, seq, grp, ldsb, par); else mix_out4_group<1>(p, w, seq, grp, ldsb, par);
  }
  __syncthreads();
}

template <int WHICH>
__device__ void phase_mix_items(const Params& p, const WS& w, unsigned char* ldsb, int bid, int nb) {
  for (int item = bid; item < 4096; item += nb) {
    const int kind = item >> 11, b = (item >> 10) & 1, h = (item >> 8) & 3, c = item & 255;
    if (WHICH == 0) { if (kind == 0) mix_local<0>(p, w, b, h, c, item, ldsb); else mix_local<1>(p, w, b, h, c, item, ldsb); }
    else { if (kind == 0) mix_out<0>(p, w, b, h, c, item, ldsb); else mix_out<1>(p, w, b, h, c, item, ldsb); }
  }
}


__device__ void phase_mix_out3(const Params& p, const WS& w, unsigned char* ldsb, int bid, int nb) {
  int par = 0;
  uint4 tq0, tq1, tk0, tk1; float nlv = 0.f;
  if (bid < 4096) mix_out3_fetch(w, bid, tidx(), tq0, tq1, tk0, tk1, nlv);
  for (int item = bid; item < 4096; item += nb, par ^= 1) {
    const int kind = item >> 11, b = (item >> 10) & 1, h = (item >> 8) & 3, c = item & 255, nitem = (item + nb < 4096) ? item + nb : -1;
    if (kind == 0) mix_out3<0>(p, w, b, h, c, item, ldsb + par * 57344, tq0, tq1, tk0, tk1, nlv, nitem); else mix_out3<1>(p, w, b, h, c, item, ldsb + par * 57344, tq0, tq1, tk0, tk1, nlv, nitem);
  }
  __syncthreads();
}

__device__ void mix_gate_pass(const Params& p, const WS& w, unsigned char* ldsb, int bid, int nb) {
  const int tid = tidx(), h = tid >> 7, d = tid & 127, lane = tid & 63;
  bf16_t* qT = (bf16_t*)ldsb; bf16_t* kT = (bf16_t*)(ldsb + 65536);
  float* glrs = (float*)(ldsb + 131072); float* Fl = (float*)(ldsb + 135168);
  for (int itx = bid; itx < 1024; itx += nb) {
    const int kind = itx >> 9, b = (itx >> 8) & 1, c = itx & 255;
    const size_t tb = (size_t)b * SEQ + (size_t)c * 64;
    const int item = ((kind * 2 + b) * 4 + h) * 256 + c;
    bf16_t* kdo = w.kdT + kdT_at(kind * 512 + tid, tb);
    { uint4 tq[8], tk[8];
      const unsigned char* gq = (const unsigned char*)(w.proj + tb * NPROJ + (kind == 0 ? C_GQ : C_MQ)); const unsigned char* gk = (const unsigned char*)(w.proj + tb * NPROJ + (kind == 0 ? C_GK : C_MK));
#pragma unroll
      for (int ps = 0; ps < 8; ++ps) { const int o = ps * 8192 + tid * 16; tq[ps] = *(const uint4*)(gq + (size_t)(o >> 10) * (NPROJ * 2) + (o & 1023)); tk[ps] = *(const uint4*)(gk + (size_t)(o >> 10) * (NPROJ * 2) + (o & 1023)); }
#pragma unroll
      for (int ps = 0; ps < 8; ++ps) { const int o = ps * 8192 + tid * 16; *(uint4*)(ldsb + o) = tq[ps]; *(uint4*)(ldsb + 65536 + o) = tk[ps]; } }
    if (kind == 0) {
      if (tid < 128) { float f[8]; unpack8(*(const uint4*)(w.proj + (tb + (tid >> 1)) * NPROJ + C_SM + (tid & 1) * 8), f);
#pragma unroll
        for (int j = 0; j < 8; ++j) glrs[(tid >> 1) * 16 + (tid & 1) * 8 + j] = f[j]; }
      float gu[16];
#pragma unroll
      for (int r = 0; r < 16; ++r) gu[r] = p.gate_up[r * 512 + tid];
      const float gb = p.gate_bias[tid];
      __syncthreads();
      float run = 0.f;
#pragma unroll 1
      for (int j8 = 0; j8 < 8; ++j8) { float kd[8];
#pragma unroll
        for (int e = 0; e < 8; ++e) { const int j = j8 * 8 + e; const float* gl = glrs + j * 16; float z = gb;
#pragma unroll
          for (int r4 = 0; r4 < 4; ++r4) { const float4 g4 = *(const float4*)(gl + r4 * 4); z += g4.x * gu[r4 * 4] + g4.y * gu[r4 * 4 + 1] + g4.z * gu[r4 * 4 + 2] + g4.w * gu[r4 * 4 + 3]; }
          run += logsigmoidf_(z) * (1.f / 16.f);
          const float q = bf2f(qT[j * 512 + tid]), k = bf2f(kT[j * 512 + tid]), eb = __expf(run), ks_ = k * __builtin_amdgcn_rcpf(eb);
          qT[j * 512 + tid] = f2bf(q * 0.08838834764831845f * eb); kT[j * 512 + tid] = f2bf(ks_); kd[e] = ks_; }
        *(uint4*)(kdo + j8 * 8) = pack8(kd); }
      w.gdec[(size_t)item * 128 + d] = __expf(run);
    } else {
      float q0 = 0.f, q1 = 0.f, q2 = 0.f, k0 = 0.f, k1 = 0.f, k2 = 0.f;
      if (c > 0) { const bf16_t* qp = w.proj + tb * NPROJ + C_MQ + tid; const bf16_t* kp = w.proj + tb * NPROJ + C_MK + tid;
        q0 = bf2f(*(qp - 3 * (size_t)NPROJ)); q1 = bf2f(*(qp - 2 * (size_t)NPROJ)); q2 = bf2f(*(qp - (size_t)NPROJ)); k0 = bf2f(*(kp - 3 * (size_t)NPROJ)); k1 = bf2f(*(kp - 2 * (size_t)NPROJ)); k2 = bf2f(*(kp - (size_t)NPROJ)); }
      if (tid < 256) { const int hh = tid >> 6; const float mi = bf2f(w.proj[(tb + lane) * NPROJ + C_SM + 16 + hh]), mf = bf2f(w.proj[(tb + lane) * NPROJ + C_SM + 20 + hh]);
        float f = logsigmoidf_(mf + p.fg_bias[hh]);
#pragma unroll
        for (int o = 1; o < 64; o <<= 1) { const float t = bperm(f, lane - o); if (lane >= o) f += t; }
        Fl[hh * 64 + lane] = f; Fl[256 + hh * 64 + lane] = mi + p.ig_bias[hh]; }
      const float cq0 = p.conv_w[tid], cq1 = p.conv_w[1024 + tid], cq2 = p.conv_w[2048 + tid], cq3 = p.conv_w[3072 + tid], cqb = p.conv_b[tid];
      const float ck0 = p.conv_w[512 + tid], ck1 = p.conv_w[1536 + tid], ck2 = p.conv_w[2560 + tid], ck3 = p.conv_w[3584 + tid], ckb = p.conv_b[512 + tid];
      __syncthreads();
      const float flast = Fl[h * 64 + 63];
      if (d == 0) w.mdec[item - 2048] = __expf(flast);
      float un = 0.f;
#pragma unroll 1
      for (int j8 = 0; j8 < 8; ++j8) { float kd[8];
#pragma unroll
        for (int e = 0; e < 8; ++e) { const int j = j8 * 8 + e; const float xq = bf2f(qT[j * 512 + tid]), xk = bf2f(kT[j * 512 + tid]);
          const float qc = siluf_(cqb + cq0 * q0 + cq1 * q1 + cq2 * q2 + cq3 * xq), kc = siluf_(ckb + ck0 * k0 + ck1 * k1 + ck2 * k2 + ck3 * xk) * 0.08838834764831845f;
          q0 = q1; q1 = q2; q2 = xq; k0 = k1; k1 = k2; k2 = xk;
          const float F = Fl[h * 64 + j], ig = Fl[256 + h * 64 + j];
          const float ks_ = kc * __expf(ig - F);
          qT[j * 512 + tid] = f2bf(qc * __expf(F)); kT[j * 512 + tid] = f2bf(ks_); kd[e] = ks_; un += ks_; }
        *(uint4*)(kdo + j8 * 8) = pack8(kd); }
      w.mn[(size_t)(item - 2048) * 128 + d] = un * __expf(flast);
    }
    __syncthreads();
    { unsigned char* gq = (unsigned char*)(w.qs + qs_at(kind * 4, tb)); unsigned char* gk = (unsigned char*)(w.ks + qs_at(kind * 4, tb));
#pragma unroll
      for (int ps = 0; ps < 8; ++ps) { const int o = ps * 8192 + tid * 16, row = o >> 10, cb = o & 1023; const size_t dsto = (size_t)(cb >> 8) * 16384 + row * 256 + (cb & 255);
        *(uint4*)(gq + dsto) = *(const uint4*)(ldsb + o); *(uint4*)(gk + dsto) = *(const uint4*)(ldsb + 65536 + o); } }
    __syncthreads();
  }
}
#ifndef GATE_LOCAL
#define GATE_LOCAL 1
#endif
typedef short s16x4 __attribute__((ext_vector_type(4)));
#define GL_LAS __attribute__((address_space(3)))
__device__ void mix_gate_local(const Params& p, const WS& w, unsigned char* ldsb, int bid, int nb) {
  constexpr int KRS = 1088;
  bf16_t* qT = (bf16_t*)ldsb; unsigned char* kB = ldsb + 65536;
  float* glrs = (float*)(ldsb + 135168); float* Fl = (float*)(ldsb + 139264);
  for (int itx = bid; itx < 1024; itx += nb) {
    const int tid = tidx(), h = tid >> 7, d = tid & 127, lane = tid & 63;
    const int kind = itx >> 9, b = (itx >> 8) & 1, c = itx & 255;
    const size_t tb = (size_t)b * SEQ + (size_t)c * 64;
    const int item = ((kind * 2 + b) * 4 + h) * 256 + c;
    { uint4 tq[8], tk[8];
      const unsigned char* gq = (const unsigned char*)(w.proj + tb * NPROJ + (kind == 0 ? C_GQ : C_MQ)); const unsigned char* gk = (const unsigned char*)(w.proj + tb * NPROJ + (kind == 0 ? C_GK : C_MK));
#pragma unroll
      for (int ps = 0; ps < 8; ++ps) { const int o = ps * 8192 + tid * 16; tq[ps] = *(const uint4*)(gq + (size_t)(o >> 10) * (NPROJ * 2) + (o & 1023)); tk[ps] = *(const uint4*)(gk + (size_t)(o >> 10) * (NPROJ * 2) + (o & 1023)); }
#pragma unroll
      for (int ps = 0; ps < 8; ++ps) { const int o = ps * 8192 + tid * 16; *(uint4*)(ldsb + o) = tq[ps]; *(uint4*)(kB + (o >> 10) * KRS + (o & 1023)) = tk[ps]; } }
    bf16x8 yf[16];
    { const int wave = tid >> 6, hw = wave >> 1, fr = lane & 15, fq = lane >> 4; const bf16_t* yrow = w.vT + vT_at(kind * 1024 + hw * 256 + (wave & 1) * 128 + fr, tb) + fq * 8;
#pragma unroll
      for (int j = 0; j < 4; ++j)
#pragma unroll
        for (int ks = 0; ks < 2; ++ks) { yf[j * 4 + ks * 2] = *(const bf16x8*)(yrow + j * 32 * 64 + ks * 32); yf[j * 4 + ks * 2 + 1] = *(const bf16x8*)(yrow + (j * 32 + 16) * 64 + ks * 32); } }
    if (kind == 0) {
      if (tid < 128) { float f[8]; unpack8(*(const uint4*)(w.proj + (tb + (tid >> 1)) * NPROJ + C_SM + (tid & 1) * 8), f);
#pragma unroll
        for (int j = 0; j < 8; ++j) glrs[(tid >> 1) * 16 + (tid & 1) * 8 + j] = f[j]; }
      float gu[16];
#pragma unroll
      for (int r = 0; r < 16; ++r) gu[r] = p.gate_up[r * 512 + tid];
      const float gb = p.gate_bias[tid];
      __syncthreads();
      float run = 0.f;
#pragma unroll 1
      for (int j8 = 0; j8 < 8; ++j8) {
#pragma unroll
        for (int e = 0; e < 8; ++e) { const int j = j8 * 8 + e; const float* gl = glrs + j * 16; float z = gb;
#pragma unroll
          for (int r4 = 0; r4 < 4; ++r4) { const float4 g4 = *(const float4*)(gl + r4 * 4); z += g4.x * gu[r4 * 4] + g4.y * gu[r4 * 4 + 1] + g4.z * gu[r4 * 4 + 2] + g4.w * gu[r4 * 4 + 3]; }
          run += logsigmoidf_(z) * (1.f / 16.f);
          bf16_t* kp = (bf16_t*)(kB + j * KRS) + tid;
          const float q = bf2f(qT[j * 512 + tid]), k = bf2f(*kp), eb = __expf(run), ks_ = k * __builtin_amdgcn_rcpf(eb);
          qT[j * 512 + tid] = f2bf(q * 0.08838834764831845f * eb); *kp = f2bf(ks_); } }
      const float dec = __expf(run);
      w.gdec[(size_t)item * 128 + d] = dec; Fl[tid] = dec;
    } else {
      float q0 = 0.f, q1 = 0.f, q2 = 0.f, k0 = 0.f, k1 = 0.f, k2 = 0.f;
      if (c > 0) { const bf16_t* qp = w.proj + tb * NPROJ + C_MQ + tid; const bf16_t* kp = w.proj + tb * NPROJ + C_MK + tid;
        q0 = bf2f(*(qp - 3 * (size_t)NPROJ)); q1 = bf2f(*(qp - 2 * (size_t)NPROJ)); q2 = bf2f(*(qp - (size_t)NPROJ)); k0 = bf2f(*(kp - 3 * (size_t)NPROJ)); k1 = bf2f(*(kp - 2 * (size_t)NPROJ)); k2 = bf2f(*(kp - (size_t)NPROJ)); }
      if (tid < 256) { const int hh = tid >> 6; const float mi = bf2f(w.proj[(tb + lane) * NPROJ + C_SM + 16 + hh]), mf = bf2f(w.proj[(tb + lane) * NPROJ + C_SM + 20 + hh]);
        float f = logsigmoidf_(mf + p.fg_bias[hh]);
#pragma unroll
        for (int o = 1; o < 64; o <<= 1) { const float t = bperm(f, lane - o); if (lane >= o) f += t; }
        Fl[hh * 64 + lane] = f; Fl[256 + hh * 64 + lane] = mi + p.ig_bias[hh]; }
      const float cq0 = p.conv_w[tid], cq1 = p.conv_w[1024 + tid], cq2 = p.conv_w[2048 + tid], cq3 = p.conv_w[3072 + tid], cqb = p.conv_b[tid];
      const float ck0 = p.conv_w[512 + tid], ck1 = p.conv_w[1536 + tid], ck2 = p.conv_w[2560 + tid], ck3 = p.conv_w[3584 + tid], ckb = p.conv_b[512 + tid];
      __syncthreads();
      const float flast = Fl[h * 64 + 63];
      if (d == 0) w.mdec[item - 2048] = __expf(flast);
      float un = 0.f;
#pragma unroll 1
      for (int j8 = 0; j8 < 8; ++j8) {
#pragma unroll
        for (int e = 0; e < 8; ++e) { const int j = j8 * 8 + e; bf16_t* kp = (bf16_t*)(kB + j * KRS) + tid; const float xq = bf2f(qT[j * 512 + tid]), xk = bf2f(*kp);
          const float qc = siluf_(cqb + cq0 * q0 + cq1 * q1 + cq2 * q2 + cq3 * xq), kc = siluf_(ckb + ck0 * k0 + ck1 * k1 + ck2 * k2 + ck3 * xk) * 0.08838834764831845f;
          q0 = q1; q1 = q2; q2 = xq; k0 = k1; k1 = k2; k2 = xk;
          const float F = Fl[h * 64 + j], ig = Fl[256 + h * 64 + j];
          const float ks_ = kc * __expf(ig - F);
          qT[j * 512 + tid] = f2bf(qc * __expf(F)); *kp = f2bf(ks_); un += ks_; } }
      w.mn[(size_t)(item - 2048) * 128 + d] = un * __expf(flast);
    }
    __syncthreads();
    { unsigned char* gq = (unsigned char*)(w.qs + qs_at(kind * 4, tb)); unsigned char* gk = (unsigned char*)(w.ks + qs_at(kind * 4, tb));
#pragma unroll
      for (int ps = 0; ps < 8; ++ps) { const int o = ps * 8192 + tid * 16, row = o >> 10, cb = o & 1023; const size_t dsto = (size_t)(cb >> 8) * 16384 + row * 256 + (cb & 255);
        *(uint4*)(gq + dsto) = *(const uint4*)(ldsb + o); *(uint4*)(gk + dsto) = *(const uint4*)(kB + row * KRS + cb); } }
    const int t2 = tidx(), wave = t2 >> 6, hw = wave >> 1, fr = t2 & 15, fq = (t2 >> 4) & 3;
    bf16x8 xf[16];
    { const GL_LAS unsigned char* xb = (const GL_LAS unsigned char*)kB + (8 * fq + (fr >> 2)) * KRS + (hw * 128 + 8 * (fr & 3)) * 2;
#pragma unroll
      for (int ks = 0; ks < 2; ++ks)
#pragma unroll
        for (int xt = 0; xt < 8; ++xt) { const GL_LAS unsigned char* a = xb + ks * 32 * KRS + ((xt >> 1) * 32 + (xt & 1) * 4) * 2;
          const s16x4 lo = __builtin_amdgcn_ds_read_tr16_b64_v4i16((GL_LAS s16x4*)a), hi = __builtin_amdgcn_ds_read_tr16_b64_v4i16((GL_LAS s16x4*)(a + 4 * KRS));
          xf[ks * 8 + xt] = __builtin_shufflevector(lo, hi, 0, 1, 2, 3, 4, 5, 6, 7); } }
    const int itw = ((kind * 2 + b) * 4 + hw) * 256 + c;
    bf16_t* S = (bf16_t*)p.out + (size_t)itw * 32768;
    const float md = kind ? __expf(Fl[hw * 64 + 63]) : 0.f;
#pragma unroll
    for (int j = 0; j < 4; ++j) { f32x4 acc[2][8];
#pragma unroll
      for (int yt = 0; yt < 2; ++yt)
#pragma unroll
        for (int xt = 0; xt < 8; ++xt) acc[yt][xt] = (f32x4){0.f, 0.f, 0.f, 0.f};
#pragma unroll
      for (int ks = 0; ks < 2; ++ks)
#pragma unroll
        for (int xt = 0; xt < 8; ++xt) { acc[0][xt] = MFMA16(xf[ks * 8 + xt], yf[j * 4 + ks * 2], acc[0][xt]); acc[1][xt] = MFMA16(xf[ks * 8 + xt], yf[j * 4 + ks * 2 + 1], acc[1][xt]); }
      const int w8 = (wave & 1) * 4 + j;
#pragma unroll
      for (int m = 0; m < 4; ++m) { float4 d0 = make_float4(md, md, md, md), d1 = d0;
        if (!kind) { d0 = *(const float4*)(Fl + hw * 128 + m * 32 + 8 * fq); d1 = *(const float4*)(Fl + hw * 128 + m * 32 + 8 * fq + 4); }
#pragma unroll
        for (int yt = 0; yt < 2; ++yt) { const f32x4 a = acc[yt][2 * m], bq = acc[yt][2 * m + 1];
          *(uint4*)(S + (w8 * 32 + yt * 16 + fr) * 128 + m * 32 + 8 * fq) = make_uint4(pack2(a[0] * d0.x, a[1] * d0.y), pack2(a[2] * d0.z, a[3] * d0.w), pack2(bq[0] * d1.x, bq[1] * d1.y), pack2(bq[2] * d1.z, bq[3] * d1.w)); } }
      __builtin_amdgcn_sched_barrier(0); }
    __syncthreads();
  }
}
__device__ void mix_local2(const Params& p, const WS& w, int bid, int nb) {
  const int tid = tidx(), wave = tid >> 6, lane = tid & 63, fr = lane & 15, fq = lane >> 4;
  bf16x8 xf[16], yf[4];
#define ML_LOAD(task_) do { const int item_ = (task_) >> 3, w8_ = (task_) & 7, kind_ = item_ >> 11, b_ = (item_ >> 10) & 1, h_ = (item_ >> 8) & 3, c_ = item_ & 255; const size_t tb_ = (size_t)b_ * SEQ + (size_t)c_ * 64; \
    const bf16_t* xrow = w.kdT + kdT_at(kind_ * 512 + h_ * 128 + 8 * (fr >> 2) + (fr & 3), tb_) + fq * 8; const bf16_t* yrow = w.vT + vT_at(kind_ * 1024 + h_ * 256 + w8_ * 32 + fr, tb_) + fq * 8; \
    _Pragma("unroll") for (int ks = 0; ks < 2; ++ks) { yf[ks * 2] = *(const bf16x8*)(yrow + ks * 32); yf[ks * 2 + 1] = *(const bf16x8*)(yrow + 16 * 64 + ks * 32); \
      _Pragma("unroll") for (int xt = 0; xt < 8; ++xt) xf[ks * 8 + xt] = *(const bf16x8*)(xrow + ((xt >> 1) * 32 + (xt & 1) * 4) * 64 + ks * 32); } } while (0)
  const int t0 = bid * 8 + wave, step = nb * 8;
  if (t0 < 32768) ML_LOAD(t0);
  for (int task = t0; task < 32768; task += step) {
    const int item = task >> 3, w8 = task & 7, kind = item >> 11; f32x4 acc[2][8];
#pragma unroll
    for (int yt = 0; yt < 2; ++yt)
#pragma unroll
      for (int xt = 0; xt < 8; ++xt) acc[yt][xt] = (f32x4){0.f, 0.f, 0.f, 0.f};
#pragma unroll
    for (int ks = 0; ks < 2; ++ks)
#pragma unroll
      for (int xt = 0; xt < 8; ++xt) { acc[0][xt] = MFMA16(xf[ks * 8 + xt], yf[ks * 2], acc[0][xt]); acc[1][xt] = MFMA16(xf[ks * 8 + xt], yf[ks * 2 + 1], acc[1][xt]); }
    if (task + step < 32768) ML_LOAD(task + step);
    bf16_t* S = (bf16_t*)p.out + (size_t)item * 32768; const float md = kind ? w.mdec[item - 2048] : 0.f;
#pragma unroll
    for (int m = 0; m < 4; ++m) { float4 d0 = make_float4(md, md, md, md), d1 = d0;
      if (!kind) { d0 = *(const float4*)(w.gdec + (size_t)item * 128 + m * 32 + 8 * fq); d1 = *(const float4*)(w.gdec + (size_t)item * 128 + m * 32 + 8 * fq + 4); }
#pragma unroll
      for (int yt = 0; yt < 2; ++yt) { const f32x4 a = acc[yt][2 * m], bq = acc[yt][2 * m + 1];
        *(uint4*)(S + (w8 * 32 + yt * 16 + fr) * 128 + m * 32 + 8 * fq) = make_uint4(pack2(a[0] * d0.x, a[1] * d0.y), pack2(a[2] * d0.z, a[3] * d0.w), pack2(bq[0] * d1.x, bq[1] * d1.y), pack2(bq[2] * d1.z, bq[3] * d1.w)); } }
  }
#undef ML_LOAD
}
template <int KIND>
__device__ __forceinline__ void mix_out2_task(const Params& p, const WS& w, int item, int it, int fr, int fq) {
  const int b = (item >> 10) & 1, h = (item >> 8) & 3, c = item & 255;
  const size_t tb = (size_t)b * SEQ + (size_t)c * 64;
  const int i = it * 16 + fr;
  typedef unsigned u32x4_t __attribute__((ext_vector_type(4)));
  bf16x8 yq[4];
  { const bf16_t* qrow = w.qs + qs_at(KIND * 4 + h, tb) + i * 128 + fq * 8;
#pragma unroll
    for (int k4 = 0; k4 < 4; ++k4) yq[k4] = *(const bf16x8*)(qrow + k4 * 32); }
  uint2 pk[4]; float rsum = 0.f;
  { bf16x8 kf[4][4];
#pragma unroll
    for (int jt = 0; jt < 4; ++jt) if (jt <= it) { const bf16_t* krow = w.ks + qs_at(KIND * 4 + h, tb) + (jt * 16 + fr) * 128 + fq * 8;
#pragma unroll
      for (int k4 = 0; k4 < 4; ++k4) kf[jt][k4] = *(const bf16x8*)(krow + k4 * 32); }
#pragma unroll
    for (int jt = 0; jt < 4; ++jt) { pk[jt] = make_uint2(0u, 0u);
      if (jt <= it) { f32x4 a = (f32x4){0.f, 0.f, 0.f, 0.f};
#pragma unroll
        for (int k4 = 0; k4 < 4; ++k4) a = MFMA16(kf[jt][k4], yq[k4], a);
        if (jt == it) {
#pragma unroll
          for (int r = 0; r < 4; ++r) a[r] = (4 * fq + r <= fr) ? a[r] : 0.f; }
        rsum += a[0] + a[1] + a[2] + a[3];
        pk[jt] = make_uint2(pack2(a[0], a[1]), pack2(a[2], a[3])); } } }
  f32x4 acc[16];
#pragma unroll
  for (int xt = 0; xt < 16; ++xt) acc[xt] = (f32x4){0.f, 0.f, 0.f, 0.f};
  const bf16_t* vbase = w.vT + vT_at(KIND * 1024 + h * 256 + fr, tb) + 4 * fq;
  const bf16_t* sbase = (const bf16_t*)p.out + (size_t)item * 32768 + fr * 128 + fq * 8;
  const u32x4_t yp0 = {pk[0].x, pk[0].y, pk[1].x, pk[1].y}, yp1 = {pk[2].x, pk[2].y, pk[3].x, pk[3].y};
  uint2 va[2][2][2], vb[2][2][2]; bf16x8 sf[2][2][4];
#define MO_LOAD(bufi, g) do { _Pragma("unroll") for (int x2 = 0; x2 < 2; ++x2) { const int xt = (g) * 2 + x2; const bf16_t* vr = vbase + xt * 16 * 64; \
      va[bufi][x2][0] = *(const uint2*)vr; vb[bufi][x2][0] = *(const uint2*)(vr + 16); if (it >= 2) { va[bufi][x2][1] = *(const uint2*)(vr + 32); vb[bufi][x2][1] = *(const uint2*)(vr + 48); } \
      _Pragma("unroll") for (int k4 = 0; k4 < 4; ++k4) sf[bufi][x2][k4] = *(const bf16x8*)(sbase + xt * 16 * 128 + k4 * 32); } } while (0)
#define MO_COMP(bufi, g) do { _Pragma("unroll") for (int x2 = 0; x2 < 2; ++x2) { const int xt = (g) * 2 + x2; \
      { const u32x4_t xv = {va[bufi][x2][0].x, va[bufi][x2][0].y, vb[bufi][x2][0].x, vb[bufi][x2][0].y}; acc[xt] = MFMA16(__builtin_bit_cast(bf16x8, xv), __builtin_bit_cast(bf16x8, yp0), acc[xt]); } \
      if (it >= 2) { const u32x4_t xv = {va[bufi][x2][1].x, va[bufi][x2][1].y, vb[bufi][x2][1].x, vb[bufi][x2][1].y}; acc[xt] = MFMA16(__builtin_bit_cast(bf16x8, xv), __builtin_bit_cast(bf16x8, yp1), acc[xt]); } \
      _Pragma("unroll") for (int k4 = 0; k4 < 4; ++k4) acc[xt] = MFMA16(sf[bufi][x2][k4], yq[k4], acc[xt]); } } while (0)
  MO_LOAD(0, 0);
#pragma unroll
  for (int g = 0; g < 8; g += 2) {
    MO_LOAD(1, g + 1);
    MO_COMP(0, g);
    if (g + 2 < 8) MO_LOAD(0, g + 2);
    MO_COMP(1, g + 1);
  }
#undef MO_LOAD
#undef MO_COMP
  if (KIND == 1) {
    float qn = 0.f; const float* nrow = w.mn + (size_t)(item - 2048) * 128 + fq * 8;
#pragma unroll
    for (int k4 = 0; k4 < 4; ++k4) { float f[8]; unpack8(__builtin_bit_cast(uint4, yq[k4]), f); const float4 n0 = *(const float4*)(nrow + k4 * 32), n1 = *(const float4*)(nrow + k4 * 32 + 4);
      qn += f[0] * n0.x + f[1] * n0.y + f[2] * n0.z + f[3] * n0.w + f[4] * n1.x + f[5] * n1.y + f[6] * n1.z + f[7] * n1.w; }
    float den = rsum + qn; den += sxor<16>(den); den += sxor<32>(den);
    const float inv = 1.f / fmaxf(fabsf(den), 1.f);
#pragma unroll
    for (int xt = 0; xt < 16; ++xt) acc[xt] *= inv;
  }
  float ss = 0.f;
#pragma unroll
  for (int xt = 0; xt < 16; ++xt)
#pragma unroll
    for (int r = 0; r < 4; ++r) ss += acc[xt][r] * acc[xt][r];
  ss += sxor<16>(ss); ss += sxor<32>(ss);
  const float rs = rsqrtf(ss * (1.f / 256.f) + EPS);
  const float* gain = (KIND == 0 ? p.gla_norm : p.mlstm_norm) + h * 256 + 4 * fq;
  const bf16_t* grow = w.proj + (tb + i) * NPROJ + (KIND == 0 ? C_GG : C_MO) + h * 256 + 4 * fq;
#pragma unroll
  for (int xt = 0; xt < 16; ++xt) { const uint2 g2 = *(const uint2*)(grow + xt * 16); const float4 gn = *(const float4*)(gain + xt * 16);
    const float g0 = lo_f(g2.x), g1 = hi_f(g2.x), g2f = lo_f(g2.y), g3 = hi_f(g2.y);
    const float a0 = KIND == 0 ? siluf_(g0) : sigmoidf_(g0), a1 = KIND == 0 ? siluf_(g1) : sigmoidf_(g1), a2 = KIND == 0 ? siluf_(g2f) : sigmoidf_(g2f), a3 = KIND == 0 ? siluf_(g3) : sigmoidf_(g3);
    const float y0 = acc[xt][0] * rs * gn.x * a0, y1 = acc[xt][1] * rs * gn.y * a1, y2 = acc[xt][2] * rs * gn.z * a2, y3 = acc[xt][3] * rs * gn.w * a3;
    const size_t yo = (tb + i) * D + KIND * 1024 + h * 256 + xt * 16 + 4 * fq;
#if F8_OUT
    *(unsigned*)(w.yq + yo) = pack4_fp8(y0, y1, y2, y3);
#else
    *(uint2*)(w.y + yo) = make_uint2(pack2(y0, y1), pack2(y2, y3));
#endif
  }
}
__device__ void mix_out2(const Params& p, const WS& w, int bid, int nb) {
  const int tid = tidx(), wave = tid >> 6, lane = tid & 63, fr = lane & 15, fq = lane >> 4;
  for (int task = bid * 8 + wave; task < 16384; task += nb * 8) {
    const int item = task >> 2, it = __builtin_amdgcn_readfirstlane(task & 3);
    if (item < 2048) mix_out2_task<0>(p, w, item, it, fr, fq); else mix_out2_task<1>(p, w, item, it, fr, fq);
  }
}

__device__ __forceinline__ unsigned sort16(unsigned b) { return (b & 0x8000u) ? (~b & 0xffffu) : (b | 0x8000u); }
__device__ __forceinline__ float unsort16(unsigned k) { const unsigned b = (k & 0x8000u) ? (k & 0x7fffu) : (~k & 0xffffu); return __uint_as_float(b << 16); }
__device__ __forceinline__ unsigned sort32(float f) { const unsigned u = __float_as_uint(f); return (u & 0x80000000u) ? ~u : (u | 0x80000000u); }
__device__ __forceinline__ float unsort32(unsigned k) { const unsigned u = (k & 0x80000000u) ? (k & 0x7fffffffu) : ~k; return __uint_as_float(u); }
__device__ __forceinline__ void ce_desc(unsigned& a, unsigned& b) { const unsigned hi = max(a, b), lo = min(a, b); a = hi; b = lo; }
__device__ __forceinline__ void sort16_desc(unsigned* k) {
#pragma unroll
  for (int sz = 2; sz <= 16; sz <<= 1)
#pragma unroll
    for (int j = sz >> 1; j > 0; j >>= 1)
#pragma unroll
      for (int i = 0; i < 16; ++i) { const int l = i ^ j; if (l > i) { if ((i & sz) == 0) ce_desc(k[i], k[l]); else ce_desc(k[l], k[i]); } }
}
__device__ __forceinline__ void merge16_desc(unsigned* L, const unsigned* B) {
#pragma unroll
  for (int i = 0; i < 16; ++i) L[i] = max(L[i], B[15 - i]);
#pragma unroll
  for (int j = 8; j > 0; j >>= 1)
#pragma unroll
    for (int i = 0; i < 16; ++i) { const int l = i ^ j; if (l > i) ce_desc(L[i], L[l]); }
}
__device__ void phase_topk(const Params& p, const WS& w, unsigned char* ldsb, int bid, int nb) {
  const int tid = tidx();
  unsigned char* mytab = ldsb + tid * 36;
  for (int th = bid * 512 + tid; th < T * 8; th += nb * 512) {
    const int t = th >> 3, h = th & 7;
    const uint4* sp = (const uint4*)(w.sc + (size_t)t * D + h * 256);
    unsigned L[2][16];
#pragma unroll
    for (int pp = 0; pp < 2; ++pp) {
#pragma unroll
      for (int blk = 0; blk < 8; ++blk) {
        const uint4 v0 = sp[pp * 16 + blk * 2], v1 = sp[pp * 16 + blk * 2 + 1]; const unsigned wds[8] = {v0.x, v0.y, v0.z, v0.w, v1.x, v1.y, v1.z, v1.w};
        unsigned B[16];
#pragma unroll
        for (int e = 0; e < 16; ++e) { const unsigned b = (e & 1) ? (wds[e >> 1] >> 16) : (wds[e >> 1] & 0xffffu); B[e] = (sort16(b) << 16) | (unsigned)(blk * 16 + e); }
        sort16_desc(B);
        if (blk == 0) {
#pragma unroll
          for (int i = 0; i < 16; ++i) L[pp][i] = B[i]; }
        else merge16_desc(L[pp], B);
      }
    }
    float v0f[16], v1f[16];
#pragma unroll
    for (int i = 0; i < 16; ++i) { v0f[i] = unsort16(L[0][i] >> 16); v1f[i] = unsort16(L[1][i] >> 16); }
    unsigned C[16], B[16];
#pragma unroll
    for (int j = 0; j < 16; ++j) C[j] = (sort32(v0f[0] + v1f[j]) & 0xffffff00u) | (unsigned)j;
    { int n = 0;
#pragma unroll
      for (int i = 1; i < 16; ++i)
#pragma unroll
        for (int j = 0; j < 16; ++j) if ((i + 1) * (j + 1) <= 16) { B[n & 15] = (sort32(v0f[i] + v1f[j]) & 0xffffff00u) | (unsigned)(i * 16 + j); ++n;
          if ((n & 15) == 0) { sort16_desc(B); merge16_desc(C, B); } }
#pragma unroll
      for (int e = 2; e < 16; ++e) B[e] = 0u;
      sort16_desc(B); merge16_desc(C, B); }
    { unsigned pw[8];
#pragma unroll
      for (int q4 = 0; q4 < 4; ++q4) { pw[q4] = (L[0][q4 * 4] & 0xffu) | ((L[0][q4 * 4 + 1] & 0xffu) << 8) | ((L[0][q4 * 4 + 2] & 0xffu) << 16) | (L[0][q4 * 4 + 3] << 24);
        pw[4 + q4] = (L[1][q4 * 4] & 0xffu) | ((L[1][q4 * 4 + 1] & 0xffu) << 8) | ((L[1][q4 * 4 + 2] & 0xffu) << 16) | (L[1][q4 * 4 + 3] << 24); }
#pragma unroll
      for (int q4 = 0; q4 < 8; ++q4) *(unsigned*)(mytab + q4 * 4) = pw[q4]; }
    const float mx = unsort32(C[0] & 0xffffff00u);
    float e[16], sum = 0.f; int eid[16];
#pragma unroll
    for (int k = 0; k < 16; ++k) { e[k] = __expf(unsort32(C[k] & 0xffffff00u) - mx); sum += e[k];
      eid[k] = (int)mytab[(C[k] >> 4) & 15] * 128 + (int)mytab[16 + (C[k] & 15)]; }
    const float inv = 1.f / sum;
    bf16_t* ei = w.eidx + (size_t)t * 128 + h * 16; bf16_t* eg = w.eg + (size_t)t * 128 + h * 16; bf16_t* es = w.esu + (size_t)t * 128 + h * 16;
#pragma unroll
    for (int k8 = 0; k8 < 2; ++k8) { float gsv[8], su[8]; unsigned idp[4];
#pragma unroll
      for (int k = 0; k < 8; ++k) { const int ex = eid[k8 * 8 + k]; gsv[k] = e[k8 * 8 + k] * inv * w.vsc[ex]; su[k] = w.usc[ex]; }
#pragma unroll
      for (int k = 0; k < 4; ++k) idp[k] = (unsigned)eid[k8 * 8 + 2 * k] | ((unsigned)eid[k8 * 8 + 2 * k + 1] << 16);
      *(uint4*)(ei + k8 * 8) = make_uint4(idp[0], idp[1], idp[2], idp[3]); *(uint4*)(eg + k8 * 8) = pack8(gsv); *(uint4*)(es + k8 * 8) = pack8(su); }
  }
}
__device__ __forceinline__ void ub16(const uint4 q, float* f) {
  const unsigned wd[4] = {q.x, q.y, q.z, q.w};
#pragma unroll
  for (int k = 0; k < 4; ++k) { f[k * 4] = (float)(wd[k] & 0xffu); f[k * 4 + 1] = (float)((wd[k] >> 8) & 0xffu); f[k * 4 + 2] = (float)((wd[k] >> 16) & 0xffu); f[k * 4 + 3] = (float)(wd[k] >> 24); }
}
template <int EM = 0xFFFF>
__device__ void peer_dots(const Params& p, const WS& w, int bid, int nb) {
  const int tid = tidx(), wave = tid >> 6, lane = tid & 63, r = lane % LPR, q = lane / LPR;
  const int x = bid & 7, nwl = (nb >> 3) * 8, wl = (bid >> 3) * 8 + wave;
  constexpr int HB = NIT / 2;
  for (int sp = 0; sp < SPL; ++sp) {
    const int s = x * SPL + sp;
    const unsigned char* tab = w.u8 + (size_t)s * 16384 * SLW + r * 16;
    int idx0 = w.eidx[(size_t)wl * 128 + lane], idx1 = w.eidx[(size_t)wl * 128 + 64 + lane];
    uint4 ha = *(const uint4*)(w.h1b + (size_t)wl * D + s * SLW + r * 16), hb = *(const uint4*)(w.h1b + (size_t)wl * D + s * SLW + r * 16 + 8);
    uint4 bA[HB], bB[HB];
#define PD_GATHER(buf, half, i0_, i1_) do { _Pragma("unroll") for (int i = 0; i < HB; ++i) { const int n = ((half) * HB + i) * EPI + q; const int e_ = bperm((n & 64) ? (i1_) : (i0_), n & 63), e = (EM == 0xFFFF) ? e_ : (e_ & EM); buf[i] = *(const uint4*)(tab + (size_t)e * SLW); } } while (0)
#define PD_DOTS(buf, half) do { _Pragma("unroll") for (int i = 0; i < HB; ++i) { int a = __builtin_amdgcn_sdot4((int)buf[i].x, hq[0], 0, false); a = __builtin_amdgcn_sdot4((int)buf[i].y, hq[1], a, false); \
      a = __builtin_amdgcn_sdot4((int)buf[i].z, hq[2], a, false); a = __builtin_amdgcn_sdot4((int)buf[i].w, hq[3], a, false); a = gsum<LPR>(a); \
      const int ii = (half) * HB + i; if (r == (ii % LPR)) res[ii / LPR] = (float)a * sh; } } while (0)
    PD_GATHER(bA, 0, idx0, idx1);
    for (int t = wl; t < T; t += nwl) {
      PD_GATHER(bB, 1, idx0, idx1);
      const int tn = (t + nwl < T) ? t + nwl : t;
      const int idx0n = w.eidx[(size_t)tn * 128 + lane], idx1n = w.eidx[(size_t)tn * 128 + 64 + lane];
      const uint4 han = *(const uint4*)(w.h1b + (size_t)tn * D + s * SLW + r * 16), hbn = *(const uint4*)(w.h1b + (size_t)tn * D + s * SLW + r * 16 + 8);
      float hf[16];
      unpack8(ha, hf); unpack8(hb, hf + 8);
      float am = 0.f;
#pragma unroll
      for (int j = 0; j < 16; ++j) am = fmaxf(am, fabsf(hf[j]));
      am = gmax<LPR>(am);
      const float sh = fmaxf(am, 1e-30f) * (1.f / 127.f), inv = 1.f / sh;
      int hq[4];
#pragma unroll
      for (int k = 0; k < 4; ++k) { unsigned xw = 0;
#pragma unroll
        for (int j = 0; j < 4; ++j) xw |= ((unsigned)(int)rintf(hf[k * 4 + j] * inv) & 0xffu) << (8 * j);
        hq[k] = (int)xw; }
      float res[2] = {0.f, 0.f};
      PD_DOTS(bA, 0);
      PD_GATHER(bA, 0, idx0n, idx1n);
      PD_DOTS(bB, 1);
#pragma unroll
      for (int rho = 0; rho < 2; ++rho) ((bf16_t*)w.pd)[((size_t)t * 128 + (rho * LPR + r) * EPI + q) * NSL + s] = f2bf(res[rho]);
      idx0 = idx0n; idx1 = idx1n; ha = han; hb = hbn;
    }
#undef PD_GATHER
#undef PD_DOTS
  }
}
__device__ __forceinline__ void peer_token_w(const WS& w, int t, int lane, int idx0, int idx1, float& w0, float& w1) {
  static_assert(NSL == 8, "one 16-byte load per (token, expert) holds the 8 slices' partial dots");
  const float rs2 = rsqrtf(w.ssq2[t] * (1.f / D) + EPS);
  float f0[8], f1[8];
  unpack8(*(const uint4*)((const bf16_t*)w.pd + ((size_t)t * 128 + lane) * 8), f0); unpack8(*(const uint4*)((const bf16_t*)w.pd + ((size_t)t * 128 + 64 + lane) * 8), f1);
  const float z0 = ((f0[0] + f0[1]) + (f0[2] + f0[3])) + ((f0[4] + f0[5]) + (f0[6] + f0[7])), z1 = ((f1[0] + f1[1]) + (f1[2] + f1[3])) + ((f1[4] + f1[5]) + (f1[6] + f1[7]));
  w0 = bf2f(w.eg[(size_t)t * 128 + lane]) * gelu_tanh(z0 * bf2f(w.esu[(size_t)t * 128 + lane]) * rs2);
  w1 = bf2f(w.eg[(size_t)t * 128 + 64 + lane]) * gelu_tanh(z1 * bf2f(w.esu[(size_t)t * 128 + 64 + lane]) * rs2);
}
__device__ void peer_vals(const Params& p, const WS& w, int bid, int nb) {
  static_assert(EPI == 4 && LPR == 16, "peer_vals' weight packing assumes 256-byte slices");
  const int tid = tidx(), wave = tid >> 6, lane = tid & 63, r = lane % LPR, q = lane / LPR;
  const int x = bid & 7, nwl = (nb >> 3) * 8, wl = (bid >> 3) * 8 + wave;
  constexpr int HB = NIT / 2;
  for (int sp = 0; sp < SPL; ++sp) {
    const int s = x * SPL + sp;
    const unsigned char* tab = w.v8 + (size_t)s * 16384 * SLW + r * 16;
    int idx0 = w.eidx[(size_t)wl * 128 + lane], idx1 = w.eidx[(size_t)wl * 128 + 64 + lane];
    float w0, w1; peer_token_w(w, wl, lane, idx0, idx1, w0, w1);
    uint4 bA[HB], bB[HB];
#define PV_GATHER(buf, half, i0_, i1_) do { _Pragma("unroll") for (int i = 0; i < HB; ++i) { const int n = ((half) * HB + i) * EPI + q; const int e = bperm((n & 64) ? (i1_) : (i0_), n & 63); buf[i] = *(const uint4*)(tab + (size_t)e * SLW); } } while (0)
#define PV_DOT4(buf, half) do { _Pragma("unroll") for (int g4 = 0; g4 < HB / 4; ++g4) { const int gg = (half) * (HB / 4) + g4; const int pw = bperm((gg & 4) ? pk1 : pk0, 16 * (gg & 3) + q); \
      _Pragma("unroll") for (int dd = 0; dd < 4; ++dd) { const unsigned b0 = ((const unsigned*)&buf[g4 * 4])[dd], b1 = ((const unsigned*)&buf[g4 * 4 + 1])[dd], b2 = ((const unsigned*)&buf[g4 * 4 + 2])[dd], b3 = ((const unsigned*)&buf[g4 * 4 + 3])[dd]; \
        const unsigned p0 = __builtin_amdgcn_perm(b1, b0, 0x05010400u), p1 = __builtin_amdgcn_perm(b1, b0, 0x07030602u), p2 = __builtin_amdgcn_perm(b3, b2, 0x05010400u), p3 = __builtin_amdgcn_perm(b3, b2, 0x07030602u); \
        acc[dd * 4 + 0] = __builtin_amdgcn_sdot4((int)__builtin_amdgcn_perm(p2, p0, 0x05040100u), pw, acc[dd * 4 + 0], false); acc[dd * 4 + 1] = __builtin_amdgcn_sdot4((int)__builtin_amdgcn_perm(p2, p0, 0x07060302u), pw, acc[dd * 4 + 1], false); \
        acc[dd * 4 + 2] = __builtin_amdgcn_sdot4((int)__builtin_amdgcn_perm(p3, p1, 0x05040100u), pw, acc[dd * 4 + 2], false); acc[dd * 4 + 3] = __builtin_amdgcn_sdot4((int)__builtin_amdgcn_perm(p3, p1, 0x07060302u), pw, acc[dd * 4 + 3], false); } } } while (0)
    PV_GATHER(bA, 0, idx0, idx1);
    for (int t = wl; t < T; t += nwl) {
      PV_GATHER(bB, 1, idx0, idx1);
      const int tn = (t + nwl < T) ? t + nwl : t;
      const int idx0n = w.eidx[(size_t)tn * 128 + lane], idx1n = w.eidx[(size_t)tn * 128 + 64 + lane];
      float w0n, w1n; peer_token_w(w, tn, lane, idx0n, idx1n, w0n, w1n);
      const float wmx = gmax<64>(fmaxf(fabsf(w0), fabsf(w1))), sw = fmaxf(wmx, 1e-30f) * (1.f / 127.f), isw = 1.f / sw;
      const int wq0 = (int)rintf(w0 * isw), wq1 = (int)rintf(w1 * isw);
      int pk0, pk1;
      { const int l0 = lane & ~12;
        pk0 = (bperm(wq0, l0) & 0xff) | ((bperm(wq0, l0 | 4) & 0xff) << 8) | ((bperm(wq0, l0 | 8) & 0xff) << 16) | (bperm(wq0, l0 | 12) << 24);
        pk1 = (bperm(wq1, l0) & 0xff) | ((bperm(wq1, l0 | 4) & 0xff) << 8) | ((bperm(wq1, l0 | 8) & 0xff) << 16) | (bperm(wq1, l0 | 12) << 24); }
      int acc[16];
#pragma unroll
      for (int j = 0; j < 16; ++j) acc[j] = 0;
      PV_DOT4(bA, 0);
      PV_GATHER(bA, 0, idx0n, idx1n);
      const uint4 ha = *(const uint4*)(w.h1b + (size_t)t * D + s * SLW + r * 16), hb = *(const uint4*)(w.h1b + (size_t)t * D + s * SLW + r * 16 + 8);
      const float ssq2t = w.ssq2[t];
      PV_DOT4(bB, 1);
#pragma unroll
      for (int j = 0; j < 16; ++j) { acc[j] += sxor<16>(acc[j]); acc[j] += sxor<32>(acc[j]); }
      float hf[16], o[16]; float ss = 0.f;
      unpack8(ha, hf); unpack8(hb, hf + 8);
#pragma unroll
      for (int j = 0; j < 16; ++j) { o[j] = hf[j] + sw * (float)acc[j]; ss += o[j] * o[j]; }
      if (q == 0) { *(uint4*)(w.h2b + (size_t)t * D + s * SLW + r * 16) = pack8(o); *(uint4*)(w.h2b + (size_t)t * D + s * SLW + r * 16 + 8) = pack8(o + 8);
#if F8_GATE
        const float rs2 = rsqrtf(ssq2t * (1.f / D) + EPS);
        *(uint4*)(w.h2q + (size_t)t * D + s * SLW + r * 16) = make_uint4(pack4_fp8(o[0] * rs2, o[1] * rs2, o[2] * rs2, o[3] * rs2), pack4_fp8(o[4] * rs2, o[5] * rs2, o[6] * rs2, o[7] * rs2),
                                                                      pack4_fp8(o[8] * rs2, o[9] * rs2, o[10] * rs2, o[11] * rs2), pack4_fp8(o[12] * rs2, o[13] * rs2, o[14] * rs2, o[15] * rs2));
#endif
      } else ss = 0.f;
      ss = wave_sum(ss);
      if (lane == 0) atomicAdd(w.ssq3 + t, ss);
      idx0 = idx0n; idx1 = idx1n; w0 = w0n; w1 = w1n;
    }
#undef PV_GATHER
#undef PV_DOT4
  }
}
#ifndef TPROBE_A
#define TPROBE_A -1
#endif
#ifndef TPROBE_B
#define TPROBE_B -1
#endif
__device__ void phase_final(const Params& p, const WS& w, int bid, int nb) {
  const int wave = tidx() >> 6, lane = tidx() & 63;
  float tscale = 1.f, tspike = 0.f;
  if (TPROBE_A >= 0) { const unsigned long long* ts = (const unsigned long long*)(w.ctlf + 16384); tscale = 1.f + sqrtf((float)(ts[TPROBE_A + 1] - ts[TPROBE_A]) * 1e-7f); }
  if (TPROBE_B >= 0) { const unsigned long long* ts = (const unsigned long long*)(w.ctlf + 16384); tspike = (float)(ts[TPROBE_B + 1] - ts[TPROBE_B]) * 1e-3f; }
  for (int row = bid * 8 + wave; row < T; row += nb * 8) {
    float4* o = (float4*)(p.out + (size_t)row * D);
    const float rs = rsqrtf(w.ssq4[row] * (1.f / D) + EPS) * tscale;
    uint2 hv[8];
#pragma unroll
    for (int i = 0; i < 8; ++i) hv[i] = *(const uint2*)(w.h1b + (size_t)row * D + (i * 64 + lane) * 4);
#pragma unroll
    for (int i = 0; i < 8; ++i) { const float4 g = *(const float4*)(p.norm_final + (i * 64 + lane) * 4);
      float4 v = make_float4(lo_f(hv[i].x) * rs * g.x, hi_f(hv[i].x) * rs * g.y, lo_f(hv[i].y) * rs * g.z, hi_f(hv[i].y) * rs * g.w);
      if (TPROBE_B >= 0 && row == 0 && i == 0 && lane == 0) v.x += tspike; o[i * 64 + lane] = v; }
  }
}

constexpr int NPHASE = 10;
#ifndef MIX_OUT3
#define MIX_OUT3 1
#endif
#ifndef FAST_MIX
#define FAST_MIX 2
#endif
template <int PH>
__device__ __forceinline__ void run_phase(const Params& p, float* lds, int bid, int nb) {
  const WS w = make_ws(p.ws, p.out);
  if (PH == 0) phase_prep(p, w, lds, bid, nb);
  const float s_in = __uint_as_float(__builtin_amdgcn_readfirstlane((F8_IN && PH == 1) ? __float_as_uint(w.ctlf[0]) : 0u)) * (1.f / 256.f);
  const float s_out = F8_OUT ? __uint_as_float(__builtin_amdgcn_readfirstlane((PH == 5) ? __float_as_uint(w.ctlf[1]) : 0u)) * (1.f / 256.f) : 1.f;
  const float s_g = __uint_as_float(__builtin_amdgcn_readfirstlane((F8_GATE && PH == 11) ? __float_as_uint(w.ctlf[2]) : 0u)) * (1.f / 256.f);
#if F8_IN
  if (PH == 1) { gemm_any<true>(w.xq, w.winq, T, NPROJ, D, EpiProjN{w.proj, w.rstd1, s_in}, lds, bid, nb);
                 gemm_any<true>(w.winq + (size_t)NPROJ * D, w.xq, 2048, T, D, EpiProjT{w.vT, w.rstd1, s_in}, lds, bid, nb); }
#else
#if F8_V
  if (PH == 1) { cvt_wv(w, bid, nb); gemm_any(w.xb, w.win, T, NB16, D, EpiProjN{w.proj, w.rstd1, 1.f}, lds, bid, nb); }
#if F8_GO
  if (PH == 15) { gemm_bal<true>(w.xq8, w.wvq, T, 2048, D, EpiProjN8{w.proj + NB16, w.wvs}, lds, bid, nb);
                  gemm_any<true>(w.wvq + (size_t)2048 * D, w.xq8, 2048, T, D, EpiProjT{w.vT, w.wvs + 2048, 1.f}, lds, bid, nb); }
#else
  if (PH == 15) gemm_bal<true>(w.wvq, w.xq8, 2048, T, D, EpiProjT{w.vT, w.wvs, 1.f}, lds, bid, nb);
#endif
#else
  if (PH == 1) { gemm_any(w.xb, w.win, T, NPROJ, D, EpiProjN{w.proj, w.rstd1, 1.f}, lds, bid, nb);
                 gemm_any(w.win + (size_t)NPROJ * D, w.xb, 2048, T, D, EpiProjT{w.vT, w.rstd1, 1.f}, lds, bid, nb); }
#endif
#endif
#if F8_OUT
  if (PH == 5) gemm_any<true>(w.yq, w.woutq, T, D, D, EpiOut{w.xb, w.h1b, w.ssq2, s_out}, lds, bid, nb);
#else
  if (PH == 5) gemm_any(w.y, w.wout, T, D, D, EpiOut{w.xb, w.h1b, w.ssq2, 1.f}, lds, bid, nb);
#endif
#if F8_GATE
  if (PH == 11) gemm_any<true>(w.h2q, w.wgq, T, D, D, EpiGate{w.h2b, w.pl, w.ssq3, w.h1b, w.ssq4, w.ssq2, s_g}, lds, bid, nb);
#else
  if (PH == 11) gemm_any(w.h2b, w.wg, T, D, D, EpiGate{w.h2b, w.pl, w.ssq3, w.h1b, w.ssq4, w.ssq2, 1.f}, lds, bid, nb);
#endif
#if FAST_MIX == 2
  if (PH == 14) { phase_prep2(p, w, lds, bid, nb);
                  if (GATE_LOCAL) mix_gate_local(p, w, (unsigned char*)lds, bid, nb); else mix_gate_pass(p, w, (unsigned char*)lds, bid, nb); }
  if (PH == 2 && !GATE_LOCAL) mix_local2(p, w, bid, nb);
  if (PH == 3) mix_scan(p, w, lds, bid, nb);
#if MIX_OUT3
  if (PH == 4) { if (SCAN_GROUPS) phase_mix_out4(p, w, (unsigned char*)lds, bid, nb); else phase_mix_out3(p, w, (unsigned char*)lds, bid, nb); }
#else
  if (PH == 4) mix_out2(p, w, bid, nb);
#endif
#elif FAST_MIX
  if (PH == 2) phase_mix_items<0>(p, w, (unsigned char*)lds, bid, nb);
  if (PH == 3) mix_scan(p, w, lds, bid, nb);
  if (PH == 4) phase_mix_items<1>(p, w, (unsigned char*)lds, bid, nb);
#else
  if (PH == 2) phase_mixer_naive(p, w, lds, bid, nb);
#endif
  if (PH == 6) gemm_any(w.h1b, w.wq, T, D, D, EpiScore{w.sc, w.ssq2}, lds, bid, nb);
  if (PH == 7) { phase_topk(p, w, (unsigned char*)lds, bid, nb); __syncthreads(); gemm_any(w.pb, w.wple, T, D, 256, EpiPl{w.pl}, lds, bid, nb); }
  if (PH == 8) peer_dots(p, w, bid, nb);
#ifdef PROBE_DOTS_MASK
  if (PH == 80) peer_dots<PROBE_DOTS_MASK>(p, w, bid, nb);
#endif
  if (PH == 10) peer_vals(p, w, bid, nb);
  if (PH == 12) phase_final(p, w, bid, nb);
}


#define XB_LAS __attribute__((address_space(3)))
#define XB_TMO      128
#define XB_XCNT(j)  (256  + 64 * (j))
#define XB_XSUB(j)  (1280 + 64 * (j))
#define XB_XGEN(j)  (2304 + 64 * (j))
#define XB_TOP      3328
#define XB_TOPGEN   3392
#define XCD_BAR_WORDS 3456
#define XB_SPIN_CAP (1u << 18)
__device__ __forceinline__ unsigned xb_ld(unsigned* p)              { return __hip_atomic_load(p, __ATOMIC_RELAXED, __HIP_MEMORY_SCOPE_AGENT); }
__device__ __forceinline__ unsigned xb_add(unsigned* p, unsigned v) { return __hip_atomic_fetch_add(p, v, __ATOMIC_RELAXED, __HIP_MEMORY_SCOPE_AGENT); }
__device__ __forceinline__ unsigned xb_xcc_id() { return (unsigned)__builtin_amdgcn_s_getreg((3 << 11) | 20) & 0xFu; }
#define XB_SPIN(cond, bar) do { unsigned _sp = 0; while (cond) { __builtin_amdgcn_s_sleep(1); \
    if ((++_sp & 255u) == 0u) { if (xb_ld(&(bar)[XB_TMO])) break; if (_sp > XB_SPIN_CAP) { atomicAdd(&(bar)[XB_TMO], 1u); break; } } } } while (0)
struct XcdBarrier {
    unsigned* bar; unsigned x;
    volatile XB_LAS unsigned* st;
};
__device__ __forceinline__ XcdBarrier xcd_barrier_post(unsigned* bar, volatile XB_LAS unsigned* st) {
    XcdBarrier b; b.bar = bar; b.x = xb_xcc_id(); b.st = st;
    if (threadIdx.x == 0) (void)xb_add(&bar[XB_XCNT(b.x)], 1u);
    return b;
}
__device__ __forceinline__ void xcd_barrier_complete(unsigned* bar, unsigned x, unsigned& nloc, unsigned& nx) {
    const unsigned G = gridDim.x * gridDim.y * gridDim.z;
    unsigned sum, cnt, mine, sp = 0u;
    for (;;) {
        sum = 0u; cnt = 0u; mine = 0u;
#pragma unroll
        for (unsigned j = 0; j < 16; ++j) { const unsigned c = xb_ld(&bar[XB_XCNT(j)]); sum += c; cnt += (c > 0u) ? 1u : 0u; mine = (j == x) ? c : mine; }
        if (sum == G) break;
        __builtin_amdgcn_s_sleep(1);
        if ((++sp & 255u) == 0u) { if (xb_ld(&bar[XB_TMO])) break; if (sp > XB_SPIN_CAP) { atomicAdd(&bar[XB_TMO], 1u); break; } }
    }
    nloc = mine > 0u ? mine : 1u; nx = cnt > 0u ? cnt : 1u;
}
__device__ __forceinline__ void xcd_barrier(const XcdBarrier& b) {
    asm volatile("s_waitcnt vmcnt(0)" ::: "memory");
    __syncthreads();
    if (threadIdx.x == 0) {
        unsigned* bar = b.bar;
        __builtin_amdgcn_s_waitcnt(0);
        unsigned nloc = b.st[0], nx = b.st[1];
        if (nloc == 0u) { xcd_barrier_complete(bar, b.x, nloc, nx); b.st[0] = nloc; b.st[1] = nx; }
        const unsigned old = xb_add(&bar[XB_XSUB(b.x)], 1u);
        const unsigned gen = old / nloc;
        if (old + 1u == (gen + 1u) * nloc) {
            __builtin_amdgcn_fence(__ATOMIC_RELEASE, "agent");
            asm volatile("s_waitcnt vmcnt(0)" ::: "memory");
            const unsigned og = xb_add(&bar[XB_TOP], 1u);
            const unsigned tg = og / nx;
            if (og + 1u == (tg + 1u) * nx) xb_add(&bar[XB_TOPGEN], 1u);
            else XB_SPIN(xb_ld(&bar[XB_TOPGEN]) == tg, bar);
            __builtin_amdgcn_fence(__ATOMIC_ACQUIRE, "agent");
            xb_add(&bar[XB_XGEN(b.x)], 1u);
            asm volatile("s_waitcnt vmcnt(0)" ::: "memory");
        } else {
            XB_SPIN(xb_ld(&bar[XB_XGEN(b.x)]) == gen, bar);
            __builtin_amdgcn_fence(__ATOMIC_ACQUIRE, "agent");
            asm volatile("s_waitcnt vmcnt(0)" ::: "memory");
        }
    }
    __syncthreads();
}

constexpr size_t kDynLds = 143360;
extern __shared__ __attribute__((aligned(16))) unsigned char dyn_lds[];

#if ONE_LAUNCH
__global__ void __launch_bounds__(512, 2) mega(Params p) {
  float* lds = (float*)dyn_lds; const int bid = blockIdx.x, nb = gridDim.x;
#ifndef DUP_PHASE
#define DUP_PHASE -1
#endif
#define RUNP(k) do { run_phase<k>(p, lds, bid, nb); } while (0)
  int nstamp = 0;
#define STAMP() do { if ((TPROBE_A >= 0 || TPROBE_B >= 0) && bid == 0 && threadIdx.x == 0) ((unsigned long long*)(p.ws + OFF_CTL + 65536))[nstamp] = __builtin_amdgcn_s_memrealtime(); ++nstamp; } while (0)
  STAMP();
  unsigned* barw = (unsigned*)(p.ws + OFF_BAR);
  volatile XB_LAS unsigned* bst = (volatile XB_LAS unsigned*)(dyn_lds + kDynLds - 16);
  if (threadIdx.x == 0) { bst[0] = 0u; bst[1] = 0u; }
  const XcdBarrier xbar = xcd_barrier_post(barw, bst);
#define GSYNC() xcd_barrier(xbar)
  RUNP(0); GSYNC(); STAMP();
#ifdef EXTRA_SYNCS
  for (int i = 0; i < EXTRA_SYNCS; ++i) GSYNC();
#endif
  RUNP(1); GSYNC(); STAMP();
#if F8_V
  RUNP(15); GSYNC();
#endif
#if FAST_MIX == 2
  RUNP(14); GSYNC(); STAMP();
#endif
  if (!(FAST_MIX == 2 && GATE_LOCAL)) { RUNP(2); GSYNC(); } STAMP();
#if FAST_MIX
  RUNP(3); GSYNC(); STAMP();
  RUNP(4); GSYNC(); STAMP();
#endif
  RUNP(5); GSYNC(); STAMP();
  RUNP(6); GSYNC(); STAMP();
  RUNP(7); GSYNC(); STAMP();
#ifdef PROBE_DOTS_MASK
  RUNP(80); GSYNC();
#endif
  RUNP(8); GSYNC(); STAMP();
  RUNP(10); GSYNC(); STAMP();
  RUNP(11); GSYNC(); STAMP();
  RUNP(12);
#undef RUNP
#undef STAMP
#undef GSYNC
}
#else
template <int PH> __global__ void __launch_bounds__(512, 2) k_phase(Params p) { run_phase<PH>(p, (float*)dyn_lds, blockIdx.x, gridDim.x); }
#endif


extern "C" void kernel_launch(void* const* d_in, const int* in_sizes, int n_in, void* d_out, int out_size, void* d_ws, size_t ws_size, hipStream_t stream) {
  if (n_in != 22 || out_size != T * D || ws_size < WS_NEED) { fprintf(stderr, "kernel_launch: unexpected shapes (n_in %d out %d ws %zu)\n", n_in, out_size, ws_size); return; }
  Params p{};
  const float** f = (const float**)&p;
  for (int i = 0; i < 22; ++i) f[i] = (const float*)d_in[i];
  p.out = (float*)d_out; p.ws = (unsigned char*)d_ws;
#if ONE_LAUNCH
  static int grid_blocks = 0;
  if (!grid_blocks) {
    int dev = 0, cus = 0, per_cu = 0;
    (void)hipGetDevice(&dev); (void)hipDeviceGetAttribute(&cus, hipDeviceAttributeMultiprocessorCount, dev);
    (void)hipFuncSetAttribute((const void*)mega, hipFuncAttributeMaxDynamicSharedMemorySize, (int)kDynLds);
    (void)hipOccupancyMaxActiveBlocksPerMultiprocessor(&per_cu, mega, 512, kDynLds);
    if (per_cu < 1) { fprintf(stderr, "occupancy query says 0 blocks/CU\n"); per_cu = 1; }
    grid_blocks = cus;
  }
  void* args[] = {&p};
  (void)hipMemsetAsync((unsigned char*)d_ws + OFF_BAR, 0, (XCD_BAR_WORDS + 64) * sizeof(unsigned), stream);
  hipError_t e = hipLaunchCooperativeKernel((void*)mega, dim3(grid_blocks), dim3(512), args, kDynLds, stream);
  if (e != hipSuccess) fprintf(stderr, "cooperative launch failed: %s (grid %d)\n", hipGetErrorString(e), grid_blocks);
#else
  static bool attr = false;
  const int G = 256;
#define LAUNCH(PH) do { if (!attr) (void)hipFuncSetAttribute((const void*)k_phase<PH>, hipFuncAttributeMaxDynamicSharedMemorySize, (int)kDynLds); \
    hipLaunchKernelGGL(k_phase<PH>, dim3(G), dim3(512), kDynLds, stream, p); } while (0)
  LAUNCH(0); LAUNCH(1); LAUNCH(14); LAUNCH(2); LAUNCH(3); LAUNCH(4); LAUNCH(5); LAUNCH(6); LAUNCH(7); LAUNCH(8); LAUNCH(10); LAUNCH(11); LAUNCH(12);
  attr = true;
#undef LAUNCH
#endif
}
```

```cpp
#include <hip/hip_runtime.h>
#include <hip/hip_cooperative_groups.h>
#include <cstdio>
#include <cstdint>
namespace cg = cooperative_groups;

#ifndef ONE_LAUNCH
#define ONE_LAUNCH 1
#endif

typedef unsigned short bf16_t;
constexpr int T = 32768, SEQ = 16384, D = 2048;
#ifndef F8_GO
#define F8_GO 1
#endif
constexpr int NPROJ = 4352;
#if F8_GO
#ifndef F8_MQK
#define F8_MQK 1
#endif
#if F8_MQK
constexpr int C_GQ = 0, C_GK = 512, C_SM = 1024, C_MQ = 1280, C_MK = 1792, C_GG = 2304, C_MO = 3328, NB16 = 1280;
#else
constexpr int C_GQ = 0, C_GK = 512, C_MQ = 1024, C_MK = 1536, C_SM = 2048, C_GG = 2304, C_MO = 3328, NB16 = 2304;
#endif
#else
constexpr int C_GQ = 0, C_GK = 512, C_GG = 1024, C_MQ = 2048, C_MK = 2560, C_MO = 3072, C_SM = 4096, NB16 = NPROJ;
#endif
constexpr float EPS = 1e-6f;
constexpr size_t MiB = 1ull << 20;
constexpr size_t OFF_XB = 0, OFF_Y = 0, OFF_PL = 0;
constexpr size_t OFF_PROJ = 128 * MiB, OFF_H1B = 128 * MiB, OFF_H2B = 256 * MiB;
constexpr size_t OFF_VT = 400 * MiB, OFF_SC = 400 * MiB;
constexpr size_t OFF_UB = 528 * MiB, OFF_VB = 560 * MiB, OFF_YQ = 592 * MiB;
constexpr size_t OFF_WIN = 656 * MiB, OFF_WOUT = 681 * MiB, OFF_WQ = 689 * MiB, OFF_WG = 697 * MiB, OFF_WPLE = 705 * MiB;
constexpr size_t OFF_PB = 706 * MiB, OFF_EIDX = 722 * MiB, OFF_EG = 738 * MiB, OFF_MISC = 754 * MiB;
constexpr size_t OFF_GDEC = 755 * MiB, OFF_MN = 756 * MiB, OFF_MDEC = 757 * MiB, OFF_ESC = 758 * MiB;
constexpr size_t OFF_CTL = 759 * MiB, OFF_H2Q = 400 * MiB, OFF_QS = 760 * MiB, OFF_KS = 824 * MiB, OFF_KDT = 888 * MiB;
constexpr size_t OFF_ESU = 952 * MiB, OFF_BAR = 968 * MiB;
constexpr size_t WS_NEED = 969 * MiB;
#ifndef F8_IN
#define F8_IN 0
#endif
#ifndef F8_OUT
#define F8_OUT 1
#endif
#ifndef F8_GATE
#define F8_GATE 1
#endif
#ifndef F8_V
#define F8_V 1
#endif
#ifndef U_FP8
#define U_FP8 1
#endif
#ifndef F8_GEMM
#define F8_GEMM (F8_IN || F8_OUT || F8_GATE || F8_V)
#endif

struct Params {
  const float *x, *p, *norm_mix, *w_in, *gate_up, *gate_bias, *gla_norm, *conv_w, *conv_b, *ig_bias, *fg_bias, *mlstm_norm,
      *w_out, *norm_ffn, *peer_query, *sub_keys, *peer_u, *peer_v, *norm_ple, *w_ple, *w_ple_gate, *norm_final;
  float* out;
  unsigned char* ws;
};

__device__ __forceinline__ float bf2f(bf16_t b) { return __uint_as_float(((unsigned)b) << 16); }
typedef __bf16 bf16v2_t __attribute__((ext_vector_type(2)));
__device__ __forceinline__ bf16_t f2bf(float f) { const __bf16 b = (__bf16)f; return __builtin_bit_cast(bf16_t, b); }
__device__ __forceinline__ unsigned pack2(float lo, float hi) { const bf16v2_t v = {(__bf16)lo, (__bf16)hi}; return __builtin_bit_cast(unsigned, v); }
__device__ __forceinline__ unsigned pack4_fp8(float a, float b, float c, float d) { int v = __builtin_amdgcn_cvt_pk_fp8_f32(a, b, 0, false); v = __builtin_amdgcn_cvt_pk_fp8_f32(c, d, v, true); return (unsigned)v; }
__device__ __forceinline__ void unpack4_fp8(unsigned v, float* f) { const auto a = __builtin_amdgcn_cvt_pk_f32_fp8((int)v, false), b = __builtin_amdgcn_cvt_pk_f32_fp8((int)v, true); f[0] = a[0]; f[1] = a[1]; f[2] = b[0]; f[3] = b[1]; }
__device__ __forceinline__ float lo_f(unsigned u) { return __uint_as_float(u << 16); }
__device__ __forceinline__ float hi_f(unsigned u) { return __uint_as_float(u & 0xffff0000u); }
__device__ __forceinline__ int tidx() { int t = threadIdx.x; asm volatile("" : "+v"(t)); return t; }
template <int O> __device__ __forceinline__ int sxor_i(int v) {
  if constexpr (O == 1) return __builtin_amdgcn_update_dpp(0, v, 0xB1, 0xF, 0xF, true);
  else if constexpr (O == 2) return __builtin_amdgcn_update_dpp(0, v, 0x4E, 0xF, 0xF, true);
  else if constexpr (O == 8) return __builtin_amdgcn_update_dpp(0, v, 0x128, 0xF, 0xF, true);
  else if constexpr (O < 32) return __builtin_amdgcn_ds_swizzle(v, (O << 10) | 0x1f);
  else return __builtin_amdgcn_ds_bpermute(((tidx() & 63) ^ 32) << 2, v);
}
__device__ __forceinline__ void fold16(int v, int& a, int& b) { const auto r = __builtin_amdgcn_permlane16_swap(v, v, false, false); a = (int)r[0]; b = (int)r[1]; }
__device__ __forceinline__ void fold32(int v, int& a, int& b) { const auto r = __builtin_amdgcn_permlane32_swap(v, v, false, false); a = (int)r[0]; b = (int)r[1]; }
template <int O> __device__ __forceinline__ float sxor(float v) { return __int_as_float(sxor_i<O>(__float_as_int(v))); }
template <int O> __device__ __forceinline__ int sxor(int v) { return sxor_i<O>(v); }
__device__ __forceinline__ int bperm(int v, int src_lane) { return __builtin_amdgcn_ds_bpermute(src_lane << 2, v); }
__device__ __forceinline__ float bperm(float v, int src_lane) { return __int_as_float(__builtin_amdgcn_ds_bpermute(src_lane << 2, __float_as_int(v))); }
template <int N> __device__ __forceinline__ float gsum(float v) {
  if constexpr (N >= 2) v += sxor<1>(v); if constexpr (N >= 4) v += sxor<2>(v); if constexpr (N >= 8) v += sxor<4>(v);
  if constexpr (N >= 16) v += sxor<8>(v);
  if constexpr (N >= 32) { int a, b; fold16(__float_as_int(v), a, b); v = __int_as_float(a) + __int_as_float(b); }
  if constexpr (N >= 64) { int a, b; fold32(__float_as_int(v), a, b); v = __int_as_float(a) + __int_as_float(b); } return v; }
template <int N> __device__ __forceinline__ int gsum(int v) {
  if constexpr (N >= 2) v += sxor<1>(v); if constexpr (N >= 4) v += sxor<2>(v); if constexpr (N >= 8) v += sxor<4>(v);
  if constexpr (N >= 16) v += sxor<8>(v);
  if constexpr (N >= 32) { int a, b; fold16(v, a, b); v = a + b; }
  if constexpr (N >= 64) { int a, b; fold32(v, a, b); v = a + b; } return v; }
template <int N> __device__ __forceinline__ float gmax(float v) {
  if constexpr (N >= 2) v = fmaxf(v, sxor<1>(v)); if constexpr (N >= 4) v = fmaxf(v, sxor<2>(v)); if constexpr (N >= 8) v = fmaxf(v, sxor<4>(v));
  if constexpr (N >= 16) v = fmaxf(v, sxor<8>(v));
  if constexpr (N >= 32) { int a, b; fold16(__float_as_int(v), a, b); v = fmaxf(__int_as_float(a), __int_as_float(b)); }
  if constexpr (N >= 64) { int a, b; fold32(__float_as_int(v), a, b); v = fmaxf(__int_as_float(a), __int_as_float(b)); } return v; }
__device__ __forceinline__ float wave_sum(float v) { return gsum<64>(v); }
__device__ __forceinline__ float sigmoidf_(float x) { return __builtin_amdgcn_rcpf(1.f + __expf(-x)); }
__device__ __forceinline__ float siluf_(float x) { return x * __builtin_amdgcn_rcpf(1.f + __expf(-x)); }
__device__ __forceinline__ float logsigmoidf_(float x) { return fminf(x, 0.f) - __logf(1.f + __expf(-fabsf(x))); }
__device__ __forceinline__ float gelu_tanh(float x) { const float u = 0.7978845608028654f * (x + 0.044715f * x * x * x); return x * __builtin_amdgcn_rcpf(1.f + __expf(-2.f * u)); }
__device__ __forceinline__ void unpack8(const uint4 q, float* f) {
  f[0] = lo_f(q.x); f[1] = hi_f(q.x); f[2] = lo_f(q.y); f[3] = hi_f(q.y); f[4] = lo_f(q.z); f[5] = hi_f(q.z); f[6] = lo_f(q.w); f[7] = hi_f(q.w);
}
__device__ __forceinline__ uint4 pack8(const float* f) { return make_uint4(pack2(f[0], f[1]), pack2(f[2], f[3]), pack2(f[4], f[5]), pack2(f[6], f[7])); }

__device__ __forceinline__ size_t vT_at(int chan, size_t tok0) { return (tok0 >> 6) * (size_t)(2048 * 64) + (size_t)chan * 64; }
__device__ __forceinline__ size_t kdT_at(int chan, size_t tok0) { return (tok0 >> 6) * (size_t)(1024 * 64) + (size_t)chan * 64; }
__device__ __forceinline__ size_t qs_at(int kh, size_t tok0) { return (tok0 >> 6) * (size_t)(8 * 64 * 128) + (size_t)kh * (64 * 128); }
struct WS {
  bf16_t *xb, *y, *pl, *proj, *h1b, *h2b, *vT, *sc, *ub, *vb, *win, *wout, *wq, *wg, *wple, *pb;
  bf16_t* eidx; bf16_t* eg; bf16_t* esu;
  float *rstd1, *ssq2, *ssq3, *ssq4, *wsum, *gdec, *mn, *mdec, *usc, *vsc, *pd;
  unsigned char *u8, *v8, *xq, *yq, *h2q, *winq, *woutq, *wgq;
  unsigned char *xq8, *wvq; float* wvs;
  bf16_t *qs, *ks, *kdT;
  float* ctlf;
};
__device__ __forceinline__ WS make_ws(unsigned char* ws, float* out) {
  WS w;
  w.xb = (bf16_t*)(ws + OFF_XB); w.y = (bf16_t*)(ws + OFF_Y); w.pl = (bf16_t*)(ws + OFF_PL); w.proj = (bf16_t*)(ws + OFF_PROJ);
  w.h1b = (bf16_t*)(ws + OFF_H1B); w.h2b = (bf16_t*)(ws + OFF_H2B); w.vT = (bf16_t*)(ws + OFF_VT); w.sc = (bf16_t*)(ws + OFF_SC);
  w.ub = (bf16_t*)(ws + OFF_UB); w.vb = (bf16_t*)(ws + OFF_VB); w.win = (bf16_t*)(ws + OFF_WIN); w.wout = (bf16_t*)(ws + OFF_WOUT);
  w.wq = (bf16_t*)(ws + OFF_WQ); w.wg = (bf16_t*)(ws + OFF_WG); w.wple = (bf16_t*)(ws + OFF_WPLE); w.pb = (bf16_t*)(ws + OFF_PB);
  w.eidx = (bf16_t*)(ws + OFF_EIDX); w.eg = (bf16_t*)(ws + OFF_EG); w.esu = (bf16_t*)(ws + OFF_ESU);
  float* m = (float*)(ws + OFF_MISC); w.rstd1 = m; w.ssq2 = m + T; w.ssq3 = m + 2 * T; w.ssq4 = m + 3 * T; w.wsum = m + 4 * T;
  w.gdec = (float*)(ws + OFF_GDEC); w.mn = (float*)(ws + OFF_MN); w.mdec = (float*)(ws + OFF_MDEC);
  w.usc = (float*)(ws + OFF_ESC); w.vsc = w.usc + 16384; w.u8 = ws + OFF_UB; w.v8 = ws + OFF_VB; w.pd = out;
  w.xq = ws + OFF_XB; w.yq = ws + OFF_YQ; w.h2q = ws + OFF_H2Q; w.winq = ws + OFF_WIN; w.woutq = ws + OFF_WOUT; w.wgq = ws + OFF_WG; w.ctlf = (float*)(ws + OFF_CTL);
  w.xq8 = ws + OFF_YQ; w.wvq = ws + OFF_KDT + 32 * MiB; w.wvs = (float*)(ws + OFF_KDT + 43 * MiB);
  w.qs = (bf16_t*)(ws + OFF_QS); w.ks = (bf16_t*)(ws + OFF_KS); w.kdT = (bf16_t*)(ws + OFF_KDT);
  return w;
}

__device__ void prep_x(const Params& p, const WS& w, int bid, int nb) {
  const int wave = tidx() >> 6, lane = tidx() & 63;
  for (int row0 = (bid * 8 + wave) * 2; row0 < T; row0 += nb * 16) {
    float4 v[2][8]; float ss[2] = {0.f, 0.f};
#pragma unroll
    for (int rr = 0; rr < 2; ++rr) { const float4* src = (const float4*)(p.x + (size_t)(row0 + rr) * D);
#pragma unroll
      for (int i = 0; i < 8; ++i) v[rr][i] = src[i * 64 + lane]; }
#pragma unroll
    for (int rr = 0; rr < 2; ++rr) {
#pragma unroll
      for (int i = 0; i < 8; ++i) ss[rr] += v[rr][i].x * v[rr][i].x + v[rr][i].y * v[rr][i].y + v[rr][i].z * v[rr][i].z + v[rr][i].w * v[rr][i].w;
      ss[rr] = wave_sum(ss[rr]);
      const float rs = rsqrtf(ss[rr] * (1.f / D) + EPS);
#if F8_IN
      unsigned* dst = (unsigned*)(w.xq + (size_t)(row0 + rr) * D);
#pragma unroll
      for (int i = 0; i < 8; ++i) dst[i * 64 + lane] = pack4_fp8(v[rr][i].x * rs, v[rr][i].y * rs, v[rr][i].z * rs, v[rr][i].w * rs);
#else
      uint2* dst = (uint2*)(w.xb + (size_t)(row0 + rr) * D);
#pragma unroll
      for (int i = 0; i < 8; ++i) dst[i * 64 + lane] = make_uint2(pack2(v[rr][i].x, v[rr][i].y), pack2(v[rr][i].z, v[rr][i].w));
#if F8_V
      unsigned* dq = (unsigned*)(w.xq8 + (size_t)(row0 + rr) * D);
#pragma unroll
      for (int i = 0; i < 8; ++i) dq[i * 64 + lane] = pack4_fp8(v[rr][i].x * rs, v[rr][i].y * rs, v[rr][i].z * rs, v[rr][i].w * rs);
#endif
#endif
      if (lane == 0) w.rstd1[row0 + rr] = rs; }
  }
}
__device__ void absmax_w(const float* src, size_t n, const float* gain, int ncols, float* part, float* lds, int bid, int nb) {
  float m = 0.f;
  for (size_t i = (size_t)bid * 512 + tidx(); i < n / 4; i += (size_t)nb * 512) { const float4 v = ((const float4*)src)[i]; const float g = gain ? gain[(i * 4) / (size_t)ncols] : 1.f;
    m = fmaxf(m, fabsf(g) * fmaxf(fmaxf(fabsf(v.x), fabsf(v.y)), fmaxf(fabsf(v.z), fabsf(v.w)))); }
  m = gmax<64>(m);
  __syncthreads();
  if ((tidx() & 63) == 0) lds[tidx() >> 6] = m;
  __syncthreads();
  if (tidx() == 0) { float t = lds[0];
#pragma unroll
    for (int i = 1; i < 8; ++i) t = fmaxf(t, lds[i]);
    part[bid] = t; }
  __syncthreads();
}
__device__ float amax_reduce(const float* part, float* lds, int nb) {
  float m = 0.f;
  for (int i = tidx(); i < nb; i += 512) m = fmaxf(m, part[i]);
  m = gmax<64>(m);
  __syncthreads();
  if ((tidx() & 63) == 0) lds[tidx() >> 6] = m;
  __syncthreads();
  float t = lds[0];
#pragma unroll
  for (int i = 1; i < 8; ++i) t = fmaxf(t, lds[i]);
  return t;
}
__device__ void cvt_rows(const float* src, bf16_t* dst, size_t n, const float* gain, int ncols, int bid, int nb) {
  const size_t n4 = n / 4, step = (size_t)nb * 512;
  for (size_t i0 = (size_t)bid * 512 + tidx(); i0 < n4; i0 += 4 * step) {
    float4 v[4];
#pragma unroll
    for (int u = 0; u < 4; ++u) { const size_t i = i0 + u * step; if (i < n4) v[u] = ((const float4*)src)[i]; }
#pragma unroll
    for (int u = 0; u < 4; ++u) { const size_t i = i0 + u * step; if (i < n4) {
      if (gain) { const float4 g = *(const float4*)(gain + (int)((i * 4) % (size_t)ncols)); v[u].x *= g.x; v[u].y *= g.y; v[u].z *= g.z; v[u].w *= g.w; }
      ((uint2*)dst)[i] = make_uint2(pack2(v[u].x, v[u].y), pack2(v[u].z, v[u].w)); } }
  }
}
template <bool F8OUT, class CM>
__device__ void transpose_w(const float* src, int K, int ldsrc, void* dstv, int Ndst, const float* gain, CM cm, float amax, float* lds, int bid, int nb) {
  const int tid = tidx(), tk = K / 64, ntile = (Ndst / 64) * tk, nc = tid & 63;
  const float qs = F8OUT ? 256.f / fmaxf(amax, 1e-30f) : 1.f;
  float rv[8];
#define TW_LOAD(tile) do { const int n0_ = ((tile) / tk) * 64, k0_ = ((tile) % tk) * 64, sc_ = cm(n0_ + nc); \
    _Pragma("unroll") for (int i = 0; i < 8; ++i) { const int kr = (tid >> 6) + 8 * i; float v = 0.f; if (sc_ >= 0) { v = src[(size_t)(k0_ + kr) * ldsrc + sc_]; if (gain) v *= gain[k0_ + kr]; } rv[i] = v * qs; } } while (0)
  if (bid < ntile) TW_LOAD(bid);
  for (int tile = bid; tile < ntile; tile += nb) {
    const int n0 = (tile / tk) * 64, k0 = (tile % tk) * 64;
#pragma unroll
    for (int i = 0; i < 8; ++i) lds[((tid >> 6) + 8 * i) * 65 + nc] = rv[i];
    __syncthreads();
    if (tile + nb < ntile) TW_LOAD(tile + nb);
    { const int nr = tid >> 3, ks = (tid & 7) * 8; float f[8];
#pragma unroll
      for (int j = 0; j < 8; ++j) f[j] = lds[(ks + j) * 65 + nr];
      if (F8OUT) *(uint2*)((unsigned char*)dstv + (size_t)(n0 + nr) * K + k0 + ks) = make_uint2(pack4_fp8(f[0], f[1], f[2], f[3]), pack4_fp8(f[4], f[5], f[6], f[7]));
      else *(uint4*)((bf16_t*)dstv + (size_t)(n0 + nr) * K + k0 + ks) = pack8(f); }
    __syncthreads();
  }
#undef TW_LOAD
}
struct CmIdent { __device__ int operator()(int n) const { return n; } };
struct CmWin {
  __device__ int operator()(int n) const {
#if F8_GO
    if (n < 1024) return n;
#if F8_MQK
    if (n < 1280) { const int i = n - 1024; if (i < 16) return 3072 + i; if (i < 20) return 6160 + (i - 16); if (i < 24) return 6164 + (i - 20); return -1; }
    if (n < 1792) return 3088 + (n - 1280);
    if (n < 2304) return 3600 + (n - 1792);
#else
    if (n < 1536) return 3088 + (n - 1024);
    if (n < 2048) return 3600 + (n - 1536);
    if (n < 2304) { const int i = n - 2048; if (i < 16) return 3072 + i; if (i < 20) return 6160 + (i - 16); if (i < 24) return 6164 + (i - 20); return -1; }
#endif
    if (n < 3328) return 2048 + (n - 2304);
    if (n < 4352) return 5136 + (n - 3328);
    { const int j = n - 4352; if (j < 1024) return 1024 + j; return 4112 + (j - 1024); }
#endif
    if (n < 1024) return n;
    if (n < 2048) return 2048 + (n - 1024);
    if (n < 2560) return 3088 + (n - 2048);
    if (n < 3072) return 3600 + (n - 2560);
    if (n < 4096) return 5136 + (n - 3072);
    if (n < 4352) { const int i = n - 4096; if (i < 16) return 3072 + i; if (i < 20) return 6160 + (i - 16); if (i < 24) return 6164 + (i - 20); return -1; }
    const int j = n - 4352; if (j < 1024) return 1024 + j;
    return 4112 + (j - 1024);
  }
};
__device__ void prep_wq(const Params& p, const WS& w, float* lds, int bid, int nb) {
  const int tid = tidx();
  float* SKs = lds;
  float* WQs = lds + 128 * 132;
  for (int item = bid; item < 16 * 32; item += nb) {
    const int hp = item >> 5, k0 = (item & 31) * 64;
#pragma unroll
    for (int i = 0; i < 8; ++i) { const int e4 = tid + 512 * i, key = e4 >> 5, d4 = (e4 & 31) * 4; *(float4*)(SKs + key * 132 + d4) = *(const float4*)(p.sub_keys + (size_t)hp * 16384 + key * 128 + d4); }
#pragma unroll
    for (int i = 0; i < 4; ++i) { const int e4 = tid + 512 * i, kr = e4 >> 5, d4 = (e4 & 31) * 4; float4 v = *(const float4*)(p.peer_query + (size_t)(k0 + kr) * 2048 + hp * 128 + d4); const float g = p.norm_ffn[k0 + kr]; v.x *= g; v.y *= g; v.z *= g; v.w *= g; *(float4*)(WQs + kr * 132 + d4) = v; }
    __syncthreads();
    const int k = tid & 63, kg = tid >> 6;
    float acc[16];
#pragma unroll
    for (int j = 0; j < 16; ++j) acc[j] = 0.f;
    for (int d4 = 0; d4 < 32; ++d4) {
      const float4 a = *(const float4*)(WQs + k * 132 + d4 * 4);
#pragma unroll
      for (int j = 0; j < 16; ++j) { const float4 s = *(const float4*)(SKs + (kg * 16 + j) * 132 + d4 * 4); acc[j] += a.x * s.x + a.y * s.y + a.z * s.z + a.w * s.w; }
    }
#pragma unroll
    for (int j = 0; j < 16; ++j) w.wq[(size_t)(hp * 128 + kg * 16 + j) * 2048 + k0 + k] = f2bf(acc[j]);
    __syncthreads();
  }
}

#ifndef PEER_SLW
#define PEER_SLW 256
#endif
constexpr int SLW = PEER_SLW, LPR = SLW / 16, EPI = 64 / LPR, NSL = 2048 / SLW, SPL = NSL / 8, NIT = 128 / EPI;
template <bool SIGNED>
__device__ void quant_rows(const float* src, const float* gain, unsigned char* dst, float* scale, int bid, int nb) {
  const int tid = tidx(), wave = tid >> 6, lane = tid & 63;
  for (int row0 = (bid * 8 + wave) * 2; row0 < 16384; row0 += nb * 16) {
    float4 f4[2][8];
#pragma unroll
    for (int rr = 0; rr < 2; ++rr)
#pragma unroll
      for (int i = 0; i < 2; ++i)
#pragma unroll
        for (int q = 0; q < 4; ++q) f4[rr][i * 4 + q] = *(const float4*)(src + (size_t)(row0 + rr) * 2048 + i * 1024 + lane * 16 + q * 4);
#pragma unroll
    for (int rr = 0; rr < 2; ++rr) { const int row = row0 + rr; float f[32]; float mx = 0.f;
#pragma unroll
      for (int i = 0; i < 2; ++i)
#pragma unroll
        for (int q = 0; q < 4; ++q) { float4 v = f4[rr][i * 4 + q];
          if (gain) { const float4 g = *(const float4*)(gain + i * 1024 + lane * 16 + q * 4); v.x *= g.x; v.y *= g.y; v.z *= g.z; v.w *= g.w; }
          f[i * 16 + q * 4] = v.x; f[i * 16 + q * 4 + 1] = v.y; f[i * 16 + q * 4 + 2] = v.z; f[i * 16 + q * 4 + 3] = v.w;
          mx = fmaxf(mx, fmaxf(fmaxf(fabsf(v.x), fabsf(v.y)), fmaxf(fabsf(v.z), fabsf(v.w)))); }
      mx = gmax<64>(mx);
      const float sc = fmaxf(mx, 1e-30f) * (1.f / 127.f), inv = 1.f / sc;
#pragma unroll
      for (int i = 0; i < 2; ++i) { unsigned wd[4];
#pragma unroll
        for (int q = 0; q < 4; ++q) { unsigned x = 0;
#pragma unroll
          for (int j = 0; j < 4; ++j) { const int v = (int)rintf(f[i * 16 + q * 4 + j] * inv) + (SIGNED ? 0 : 128); x |= ((unsigned)v & 0xffu) << (8 * j); }
          wd[q] = x; }
        const int el = i * 1024 + lane * 16;
        *(uint4*)(dst + ((size_t)(el / SLW) * 16384 + row) * SLW + (el % SLW)) = make_uint4(wd[0], wd[1], wd[2], wd[3]); }
      if (lane == 0) scale[row] = sc; }
  }
}
__device__ __forceinline__ void prep_wq_mfma(const Params& p, const WS& w, float* lds, int bid, int nb);
__device__ void phase_prep(const Params& p, const WS& w, float* lds, int bid, int nb) {
  static_assert(!F8_IN && F8_OUT && F8_GATE, "prep order written for the bf16 in-projection / fp8 out-projection + gate build");
  if (bid & 1) {
    quant_rows<true>(p.peer_u, p.norm_ffn, w.u8, w.usc, bid, nb);
    quant_rows<true>(p.peer_v, nullptr, w.v8, w.vsc, bid, nb);
    prep_x(p, w, bid, nb);
    cvt_rows(p.p, w.pb, (size_t)T * 256, nullptr, 256, bid, nb);
  }
  transpose_w<false>(p.w_in, 2048, 6168, w.win, 6400, p.norm_mix, CmWin(), 0.f, lds, bid, nb);
  absmax_w(p.w_out, (size_t)2048 * 2048, nullptr, 2048, w.ctlf + 2048, lds, bid, nb);
  absmax_w(p.w_ple_gate, (size_t)2048 * 2048, p.norm_ple, 2048, w.ctlf + 3072, lds, bid, nb);
  transpose_w<false>(p.w_ple, 256, 2048, w.wple, 2048, nullptr, CmIdent(), 0.f, lds, bid, nb);
  prep_wq_mfma(p, w, lds, bid, nb);
  if (!(bid & 1)) {
    prep_x(p, w, bid, nb);
    cvt_rows(p.p, w.pb, (size_t)T * 256, nullptr, 256, bid, nb);
    quant_rows<true>(p.peer_u, p.norm_ffn, w.u8, w.usc, bid, nb);
    quant_rows<true>(p.peer_v, nullptr, w.v8, w.vsc, bid, nb);
  }
  for (int i = bid * 512 + tidx(); i < T; i += nb * 512) { w.ssq2[i] = 0.f; w.ssq3[i] = 0.f; w.ssq4[i] = 0.f; }
}
static_assert(!F8_IN, "phase_prep2 now runs after the in-projection: an fp8 in-projection needs its weight copy (and a seam) before phase 1 again");
__device__ void phase_prep2(const Params& p, const WS& w, float* lds, int bid, int nb, int nparts = -1) {
  if (nparts < 0) nparts = nb;
#if F8_IN
  { const float a0 = amax_reduce(w.ctlf + 1024, lds, nb); if (bid == 0 && tidx() == 0) w.ctlf[0] = a0; __syncthreads();
    transpose_w<true>(p.w_in, 2048, 6168, w.winq, 6400, p.norm_mix, CmWin(), a0, lds, bid, nb); }
#endif
#if F8_OUT
  { const float a1 = amax_reduce(w.ctlf + 2048, lds, nparts); if (bid == 0 && tidx() == 0) w.ctlf[1] = a1; __syncthreads();
    transpose_w<true>(p.w_out, 2048, 2048, w.woutq, 2048, nullptr, CmIdent(), a1, lds, bid, nb); }
#endif
#if F8_GATE
  { const float a2 = amax_reduce(w.ctlf + 3072, lds, nparts); if (bid == 0 && tidx() == 0) w.ctlf[2] = a2; __syncthreads();
    transpose_w<true>(p.w_ple_gate, 2048, 2048, w.wgq, 2048, p.norm_ple, CmIdent(), a2, lds, bid, nb); }
#endif
}

struct EpiProjN { bf16_t* out; const float* rstd; float ws; static constexpr bool ROWSUM = false;
  __device__ __forceinline__ float store8(int r, int c, const float* v) const { const float s = F8_IN ? ws : rstd[r]; float f[8];
#pragma unroll
    for (int j = 0; j < 8; ++j) f[j] = v[j] * s;
    *(uint4*)(out + (size_t)r * NPROJ + c) = pack8(f); return 0.f; }
  __device__ __forceinline__ void rowsum(int, float) const {} };
__device__ void cvt_wv(const WS& w, int bid, int nb) {
  const int wave = tidx() >> 6, lane = tidx() & 63;
  constexpr int R0 = F8_GO ? NB16 : NPROJ;
  for (int n = bid * 8 + wave; n < 6400 - R0; n += nb * 8) {
    const bf16_t* src = w.win + (size_t)(R0 + n) * D; float f[4][8]; float am = 0.f;
#pragma unroll
    for (int i = 0; i < 4; ++i) { unpack8(*(const uint4*)(src + (i * 64 + lane) * 8), f[i]);
#pragma unroll
      for (int j = 0; j < 8; ++j) am = fmaxf(am, fabsf(f[i][j])); }
    am = fmaxf(gmax<64>(am), 1e-30f);
    const float qs = 256.f / am;
#pragma unroll
    for (int i = 0; i < 4; ++i) *(uint2*)(w.wvq + (size_t)n * D + (i * 64 + lane) * 8) = make_uint2(pack4_fp8(f[i][0] * qs, f[i][1] * qs, f[i][2] * qs, f[i][3] * qs), pack4_fp8(f[i][4] * qs, f[i][5] * qs, f[i][6] * qs, f[i][7] * qs));
    if (lane == 0) w.wvs[n] = am * (1.f / 256.f);
  }
}
struct EpiProjN8 { bf16_t* out; const float* cs; static constexpr bool ROWSUM = false;
  __device__ __forceinline__ float store8(int r, int c, const float* v) const { const float4 s0 = *(const float4*)(cs + c), s1 = *(const float4*)(cs + c + 4); float f[8];
    f[0] = v[0] * s0.x; f[1] = v[1] * s0.y; f[2] = v[2] * s0.z; f[3] = v[3] * s0.w; f[4] = v[4] * s1.x; f[5] = v[5] * s1.y; f[6] = v[6] * s1.z; f[7] = v[7] * s1.w;
    *(uint4*)(out + (size_t)r * NPROJ + c) = pack8(f); return 0.f; }
  __device__ __forceinline__ void rowsum(int, float) const {} };
struct EpiProjT { bf16_t* out; const float* rstd; float ws; static constexpr bool ROWSUM = false;
  __device__ __forceinline__ float store8(int r, int c, const float* v) const { const float rsc = F8_V ? rstd[r] : 0.f; const float4 s0 = F8_V ? make_float4(rsc, rsc, rsc, rsc) : F8_IN ? make_float4(ws, ws, ws, ws) : *(const float4*)(rstd + c), s1 = (F8_IN || F8_V) ? s0 : *(const float4*)(rstd + c + 4); float f[8];
    f[0] = v[0] * s0.x; f[1] = v[1] * s0.y; f[2] = v[2] * s0.z; f[3] = v[3] * s0.w; f[4] = v[4] * s1.x; f[5] = v[5] * s1.y; f[6] = v[6] * s1.z; f[7] = v[7] * s1.w;
    *(uint4*)(out + vT_at(r, (size_t)c) + (c & 63)) = pack8(f); return 0.f; }
  __device__ __forceinline__ void rowsum(int, float) const {} };
struct EpiOut { const bf16_t* x; bf16_t* h1b; float* ssq; float ws; static constexpr bool ROWSUM = true;
  __device__ __forceinline__ float store8(int r, int c, const float* v) const { float xf[8], f[8]; unpack8(*(const uint4*)(x + (size_t)r * D + c), xf);
#pragma unroll
    for (int j = 0; j < 8; ++j) f[j] = v[j] * ws + xf[j];
    float s = 0.f;
#pragma unroll
    for (int j = 0; j < 8; ++j) s += f[j] * f[j];
    *(uint4*)(h1b + (size_t)r * D + c) = pack8(f); return s; }
  __device__ __forceinline__ void rowsum(int r, float s) const { atomicAdd(ssq + r, s); } };
struct EpiScore { bf16_t* sc; const float* ssq; static constexpr bool ROWSUM = false;
  __device__ __forceinline__ float store8(int r, int c, const float* v) const { const float s = rsqrtf(ssq[r] * (1.f / D) + EPS); float f[8];
#pragma unroll
    for (int j = 0; j < 8; ++j) f[j] = v[j] * s;
    *(uint4*)(sc + (size_t)r * D + c) = pack8(f); return 0.f; }
  __device__ __forceinline__ void rowsum(int, float) const {} };
struct EpiPl { bf16_t* pl; static constexpr bool ROWSUM = false;
  __device__ __forceinline__ float store8(int r, int c, const float* v) const { *(uint4*)(pl + (size_t)r * D + c) = pack8(v); return 0.f; }
  __device__ __forceinline__ void rowsum(int, float) const {} };
struct EpiGate { const bf16_t* h2b; const bf16_t* pl; const float* ssq3; bf16_t* out; float* ssq; const float* ssq2; float ws; static constexpr bool ROWSUM = true;
  __device__ __forceinline__ float store8(int r, int c, const float* v) const { const float rs = rsqrtf(ssq3[r] * (1.f / D) + EPS) * (F8_GATE ? ws * sqrtf(ssq2[r] * (1.f / D) + EPS) : 1.f); float h[8], q[8], f[8];
    unpack8(*(const uint4*)(h2b + (size_t)r * D + c), h); unpack8(*(const uint4*)(pl + (size_t)r * D + c), q);
    float s = 0.f;
#pragma unroll
    for (int j = 0; j < 8; ++j) { f[j] = h[j] + sigmoidf_(v[j] * rs) * q[j]; s += f[j] * f[j]; }
    *(uint4*)(out + (size_t)r * D + c) = pack8(f); return s; }
  __device__ __forceinline__ void rowsum(int r, float s) const { atomicAdd(ssq + r, s); } };

template <class Epi>
__device__ void gemm_naive(const bf16_t* A, const bf16_t* Bt, int M, int N, int K, const Epi& E, float* lds, int bid, int nb) {
  const int tid = tidx(), ty = tid >> 4, tx = tid & 15;
  float* As = lds;
  float* Bs = lds + 32 * 132;
  const int nM = M / 128, nN = N / 128;
  for (int tile = bid; tile < nM * nN; tile += nb) {
    const int m0 = (tile % nM) * 128, n0 = (tile / nM) * 128;
    float acc[4][8];
#pragma unroll
    for (int i = 0; i < 4; ++i)
#pragma unroll
      for (int j = 0; j < 8; ++j) acc[i][j] = 0.f;
    const int lr = tid >> 2, lk = (tid & 3) * 8;
    for (int k0 = 0; k0 < K; k0 += 32) {
      const uint4 av = *(const uint4*)(A + (size_t)(m0 + lr) * K + k0 + lk);
      const uint4 bv = *(const uint4*)(Bt + (size_t)(n0 + lr) * K + k0 + lk);
      float af[8], bf[8]; unpack8(av, af); unpack8(bv, bf);
      __syncthreads();
#pragma unroll
      for (int j = 0; j < 8; ++j) { As[(lk + j) * 132 + lr] = af[j]; Bs[(lk + j) * 132 + lr] = bf[j]; }
      __syncthreads();
#pragma unroll 8
      for (int kk = 0; kk < 32; ++kk) {
        const float4 a = *(const float4*)(As + kk * 132 + ty * 4);
        const float4 b0 = *(const float4*)(Bs + kk * 132 + tx * 8), b1 = *(const float4*)(Bs + kk * 132 + tx * 8 + 4);
        const float aa[4] = {a.x, a.y, a.z, a.w}; const float bb[8] = {b0.x, b0.y, b0.z, b0.w, b1.x, b1.y, b1.z, b1.w};
#pragma unroll
        for (int i = 0; i < 4; ++i)
#pragma unroll
          for (int j = 0; j < 8; ++j) acc[i][j] += aa[i] * bb[j];
      }
    }
#pragma unroll
    for (int i = 0; i < 4; ++i) {
      const int r = m0 + ty * 4 + i;
      float s = E.store8(r, n0 + tx * 8, acc[i]);
      if (Epi::ROWSUM) { s = gsum<16>(s); if (tx == 0) E.rowsum(r, s); }
    }
  }
}


namespace pg8 {
#define PG8_LAS __attribute__((address_space(3)))
typedef short bf16x8 __attribute__((ext_vector_type(8)));
typedef float f32x4 __attribute__((ext_vector_type(4)));
typedef int v4i_t __attribute__((ext_vector_type(4)));
typedef int v8i_t __attribute__((ext_vector_type(8)));
constexpr int BM = 256, BK = 64, HALF = 128, HTB = HALF * BK * 2, STAGE_BYTES = 8 * HTB, NXCD = 8, WGM = 4;
__host__ __device__ __forceinline__ int lds_byte(int r, int c) { const int st = (r >> 4) * 2 + (c >> 5), rr = r & 15, cc = c & 31, ob = rr * 64 + cc * 2; return st * 1024 + (ob ^ (((ob >> 9) & 1) << 5)); }
__host__ __device__ __forceinline__ void stage_rc(int b, int& R, int& C) { const int st = b / 1024, sb = b % 1024, swz = sb ^ (((sb >> 9) & 1) << 5); R = (st >> 1) * 16 + swz / 64; C = (st & 1) * 32 + (swz % 64) / 2; }
__host__ __device__ __forceinline__ int perm32(int rho) { const int n = rho >> 4, i = rho & 15; return 8 * (i >> 2) + 4 * n + (i & 3); }
struct Unit { int pm, pn; };
struct Gemm { const bf16_t* A; const bf16_t* Bt; int M, N, K; };
struct StaticOrder {
    int nM, nN, nwg, G, c;
    __host__ __device__ void init(int M, int N, int G_, int c_) { nM = M / BM; nN = N / BM; nwg = nM * nN; G = G_; c = c_; }
    __host__ __device__ bool next(int i, Unit& u) const {
        const long L = (long)i * G + c; if (L >= nwg) return false;
        map((int)L, u); return true;
    }
    __host__ __device__ void map(int L, Unit& u) const {
        int wgid = L; { const int q = nwg / NXCD, r = nwg % NXCD, xcd = wgid % NXCD, off = wgid / NXCD; wgid = (xcd < r ? xcd * (q + 1) : r * (q + 1) + (xcd - r) * q) + off; }
        const int nig = WGM * nN, gid = wgid / nig, fm = gid * WGM, gsz = (nM - fm) < WGM ? (nM - fm) : WGM;
        u.pm = fm + ((wgid % nig) % gsz); u.pn = (wgid % nig) / gsz;
    }
    __device__ __forceinline__ void a_ready(const Unit&) const {}
    __device__ __forceinline__ void done(const Unit&) const {}
};
struct BalOrder {
    StaticOrder S;
    __device__ bool next(int i, Unit& u) const {
        if (S.G != 256 || S.nwg != 1024) return S.next(i, u);
        int L;
        if (S.c < 128) { if (i >= 3) return false; L = i * 256 + S.c; }
        else { if (i >= 5) return false; L = i < 3 ? i * 256 + S.c : 768 + (i - 3) * 128 + (S.c - 128); }
        S.map(L, u); return true;
    }
    __device__ __forceinline__ void a_ready(const Unit&) const {}
    __device__ __forceinline__ void done(const Unit&) const {}
};
template <class E8> struct EpiA {
    static constexpr bool PERM = true, AFTER_DRAIN = false;
    E8 e;
    __device__ __forceinline__ void operator()(const f32x4 (&acc)[2][2][4][2], const Unit& u, int wr, int wc, int fr, int fq) const {
        asm volatile("" : "+v"(fr), "+v"(fq));
        const int row0 = u.pm * BM + wr * 64 + fr, col0 = u.pn * BM + wc * 32 + 8 * fq;
#pragma unroll
        for (int ai = 0; ai < 2; ++ai)
#pragma unroll
            for (int m = 0; m < 4; ++m) { const int r = row0 + ai * HALF + m * 16; float s = 0.f;
#pragma unroll
                for (int bj = 0; bj < 2; ++bj) { const float v[8] = {acc[ai][bj][m][0][0], acc[ai][bj][m][0][1], acc[ai][bj][m][0][2], acc[ai][bj][m][0][3], acc[ai][bj][m][1][0], acc[ai][bj][m][1][1], acc[ai][bj][m][1][2], acc[ai][bj][m][1][3]};
                    s += e.store8(r, col0 + bj * HALF, v); }
                if (E8::ROWSUM) { s += sxor<16>(s); s += sxor<32>(s); if (fq == 0) e.rowsum(r, s); }
                asm volatile("" ::: "memory"); }
    }
    __device__ __forceinline__ void fused(f32x4 (&)[2][2][4][2], const Unit&, int, int, int, int, PG8_LAS unsigned char*, int, int) const {}
};
template <class Epi, class Sched, bool ALIGN_EPI = false, bool SP2 = false, bool F8 = false>
__device__ __forceinline__ void gemm_phase(PG8_LAS unsigned char* lds, const Gemm g, const Sched& S, const Epi& E) {
    int tid_ = threadIdx.x; asm volatile("" : "+v"(tid_));
    const int tid = tid_, wid = __builtin_amdgcn_readfirstlane(tid >> 6), lane = tid & 63, wr = wid >> 2, wc = wid & 3, fr = lane & 15, fq = lane >> 4;
    const int K = g.K, nt = K / BK;
    unsigned voffA[2], voffB[2];
#pragma unroll
    for (int i = 0; i < 2; ++i) { int R, C; stage_rc(tid * 16 + i * 8192, R, C); const int Rb = Epi::PERM ? ((R & ~31) + perm32(R & 31)) : R;
        voffA[i] = (unsigned)(R * K + C) * 2u; voffB[i] = (unsigned)(Rb * K + C) * 2u; }
    const size_t kstep = (size_t)(BK * 2);
    const size_t hstep = (size_t)HALF * K * 2;
    const size_t tstep = 2 * hstep;
    const unsigned ldsw = (unsigned)wid * 1024u;
    const int aoff = lds_byte(wr * 64 + fr, fq * 8), boff = lds_byte(wc * 32 + fr, fq * 8);
#define PG8_SA(b, h) (((b) * 2 + (h)) * HTB)
#define PG8_SB(b, h) ((4 + (b) * 2 + (h)) * HTB)
#define PG8_STAGE(bufoff, gbase, voff) do { _Pragma("unroll") for (int _i = 0; _i < 2; ++_i) \
        __builtin_amdgcn_global_load_lds((const unsigned*)((const char*)(gbase) + (voff)[_i]), (PG8_LAS unsigned*)(lds + (bufoff) + ldsw + _i * 8192), 16, 0, 0); } while (0)
#define PG8_LDA(dst, b, h) do { _Pragma("unroll") for (int m = 0; m < 4; ++m) { const v4i_t lo_ = *(const PG8_LAS v4i_t*)(lds + PG8_SA(b, h) + aoff + m * 2048), hi_ = *(const PG8_LAS v4i_t*)(lds + PG8_SA(b, h) + aoff + m * 2048 + 1024); dst[m] = __builtin_shufflevector(lo_, hi_, 0, 1, 2, 3, 4, 5, 6, 7); } } while (0)
#define PG8_LDB(dst, b, h) do { _Pragma("unroll") for (int n = 0; n < 2; ++n) { const v4i_t lo_ = *(const PG8_LAS v4i_t*)(lds + PG8_SB(b, h) + boff + n * 2048), hi_ = *(const PG8_LAS v4i_t*)(lds + PG8_SB(b, h) + boff + n * 2048 + 1024); dst[n] = __builtin_shufflevector(lo_, hi_, 0, 1, 2, 3, 4, 5, 6, 7); } } while (0)
#define PG8_MMA(ai, bj, At, Bt) do { __builtin_amdgcn_s_setprio(1); \
        if constexpr (F8) { asm volatile("s_nop 1\n\t" \
            "v_mfma_scale_f32_16x16x128_f8f6f4 %0, %12, %8, %0, %14, %14 op_sel_hi:[0,0,0]\n\t"  "v_mfma_scale_f32_16x16x128_f8f6f4 %1, %13, %8, %1, %14, %14 op_sel_hi:[0,0,0]\n\t" \
            "v_mfma_scale_f32_16x16x128_f8f6f4 %2, %12, %9, %2, %14, %14 op_sel_hi:[0,0,0]\n\t"  "v_mfma_scale_f32_16x16x128_f8f6f4 %3, %13, %9, %3, %14, %14 op_sel_hi:[0,0,0]\n\t" \
            "v_mfma_scale_f32_16x16x128_f8f6f4 %4, %12, %10, %4, %14, %14 op_sel_hi:[0,0,0]\n\t" "v_mfma_scale_f32_16x16x128_f8f6f4 %5, %13, %10, %5, %14, %14 op_sel_hi:[0,0,0]\n\t" \
            "v_mfma_scale_f32_16x16x128_f8f6f4 %6, %12, %11, %6, %14, %14 op_sel_hi:[0,0,0]\n\t" "v_mfma_scale_f32_16x16x128_f8f6f4 %7, %13, %11, %7, %14, %14 op_sel_hi:[0,0,0]" \
            : "+v"(acc[ai][bj][0][0]), "+v"(acc[ai][bj][0][1]), "+v"(acc[ai][bj][1][0]), "+v"(acc[ai][bj][1][1]), "+v"(acc[ai][bj][2][0]), "+v"(acc[ai][bj][2][1]), "+v"(acc[ai][bj][3][0]), "+v"(acc[ai][bj][3][1]) \
            : "v"(At[0]), "v"(At[1]), "v"(At[2]), "v"(At[3]), "v"(Bt[0]), "v"(Bt[1]), "v"(one_scale)); } \
        else { _Pragma("unroll") for (int m = 0; m < 4; ++m) _Pragma("unroll") for (int n = 0; n < 2; ++n) { \
            acc[ai][bj][m][n] = __builtin_amdgcn_mfma_f32_16x16x32_bf16(__builtin_bit_cast(bf16x8, __builtin_shufflevector(Bt[n], Bt[n], 0, 1, 2, 3)), __builtin_bit_cast(bf16x8, __builtin_shufflevector(At[m], At[m], 0, 1, 2, 3)), acc[ai][bj][m][n], 0, 0, 0); \
            acc[ai][bj][m][n] = __builtin_amdgcn_mfma_f32_16x16x32_bf16(__builtin_bit_cast(bf16x8, __builtin_shufflevector(Bt[n], Bt[n], 4, 5, 6, 7)), __builtin_bit_cast(bf16x8, __builtin_shufflevector(At[m], At[m], 4, 5, 6, 7)), acc[ai][bj][m][n], 0, 0, 0); } } \
        __builtin_amdgcn_s_setprio(0); } while (0)
#define PG8_MFMA_DRAIN() do { if constexpr (F8) asm volatile("s_nop 15\n\ts_nop 15\n\ts_nop 15" ::: "memory"); } while (0)
#define PG8_WAIT_V(n) asm volatile("s_waitcnt vmcnt(" #n ")" ::: "memory")
#define PG8_WAIT_L(n) asm volatile("s_waitcnt lgkmcnt(" #n ")" ::: "memory")
#define PG8_BAR __builtin_amdgcn_s_barrier()
#define PG8_SCHED __builtin_amdgcn_sched_barrier(0)
    Unit cur, nxt; int ui = 0;
    if (!S.next(0, cur)) return;
    f32x4 acc[2][2][4][2];
#pragma unroll
    for (int a = 0; a < 2; ++a)
#pragma unroll
        for (int b = 0; b < 2; ++b)
#pragma unroll
            for (int m = 0; m < 4; ++m)
#pragma unroll
                for (int n = 0; n < 2; ++n) acc[a][b][m][n] = (f32x4){0.f, 0.f, 0.f, 0.f};
    const int one_scale = 0x7f7f7f7f;
    v8i_t At[4], B0[2], B1[2];
    const char* cA = (const char*)g.A + (size_t)cur.pm * tstep; const char* cB = (const char*)g.Bt + (size_t)cur.pn * tstep;
    S.a_ready(cur);
    if constexpr (SP2) {
        PG8_STAGE(PG8_SB(0, 0), cB, voffB); PG8_STAGE(PG8_SB(0, 1), cB + hstep, voffB); PG8_STAGE(PG8_SA(0, 0), cA, voffA); PG8_STAGE(PG8_SA(0, 1), cA + hstep, voffA);
        if (wr == 1) PG8_BAR;
        PG8_WAIT_V(2); PG8_BAR;
        PG8_STAGE(PG8_SB(1, 0), cB + kstep, voffB); PG8_STAGE(PG8_SA(1, 0), cA + kstep, voffA); PG8_STAGE(PG8_SB(1, 1), cB + hstep + kstep, voffB);
        PG8_WAIT_V(6); PG8_BAR;
    } else {
        PG8_STAGE(PG8_SB(0, 0), cB, voffB); PG8_STAGE(PG8_SA(0, 0), cA, voffA); PG8_STAGE(PG8_SB(0, 1), cB + hstep, voffB); PG8_STAGE(PG8_SA(0, 1), cA + hstep, voffA);
        if (wr == 1) PG8_BAR;
        PG8_WAIT_V(4); PG8_BAR;
        PG8_STAGE(PG8_SB(1, 0), cB + kstep, voffB); PG8_STAGE(PG8_SA(1, 0), cA + kstep, voffA); PG8_STAGE(PG8_SB(1, 1), cB + hstep + kstep, voffB);
        PG8_WAIT_V(6); PG8_BAR;
    }
    for (;;) {
        const bool has_next = S.next(ui + 1, nxt);
        const char* nA = has_next ? (const char*)g.A + (size_t)nxt.pm * tstep : cA; const char* nB = has_next ? (const char*)g.Bt + (size_t)nxt.pn * tstep : cB;
        for (int t = 0; t < nt; t += 2) {
            const bool last = (t == nt - 2);
            const char* a1 = cA + (size_t)(t + 1) * kstep;
            const char* a2 = last ? nA : cA + (size_t)(t + 2) * kstep; const char* b2 = last ? nB : cB + (size_t)(t + 2) * kstep;
            const char* a3 = a2 + kstep; const char* b3 = b2 + kstep;
            if (last && has_next) S.a_ready(nxt);
            if constexpr (SP2) {
            PG8_LDB(B0, 0, 0); PG8_LDB(B1, 0, 1); PG8_SCHED; PG8_LDA(At, 0, 0); PG8_STAGE(PG8_SA(1, 1), a1 + hstep, voffA);
            PG8_WAIT_V(8); PG8_WAIT_L(0); PG8_BAR; PG8_MMA(0, 0, At, B0); PG8_MMA(0, 1, At, B1); PG8_BAR; PG8_SCHED;
            PG8_LDA(At, 0, 1); PG8_STAGE(PG8_SB(0, 0), b2, voffB); PG8_STAGE(PG8_SB(0, 1), b2 + hstep, voffB); PG8_STAGE(PG8_SA(0, 0), a2, voffA);
            PG8_WAIT_V(8); PG8_WAIT_L(0); PG8_BAR; PG8_MMA(1, 0, At, B0); PG8_MMA(1, 1, At, B1); PG8_BAR; PG8_SCHED;
            PG8_LDB(B0, 1, 0); PG8_LDB(B1, 1, 1); PG8_SCHED; PG8_LDA(At, 1, 0); PG8_STAGE(PG8_SA(0, 1), a2 + hstep, voffA);
            PG8_WAIT_V(8); PG8_WAIT_L(0); PG8_BAR; PG8_MMA(0, 0, At, B0); PG8_MMA(0, 1, At, B1); PG8_BAR; PG8_SCHED;
            PG8_LDA(At, 1, 1); PG8_STAGE(PG8_SB(1, 0), b3, voffB); PG8_STAGE(PG8_SB(1, 1), b3 + hstep, voffB); PG8_STAGE(PG8_SA(1, 0), a3, voffA);
            PG8_WAIT_V(8); PG8_WAIT_L(0); PG8_BAR; PG8_MMA(1, 0, At, B0); PG8_MMA(1, 1, At, B1); PG8_BAR; PG8_SCHED;
            } else {
            PG8_LDB(B0, 0, 0); PG8_SCHED; PG8_LDA(At, 0, 0); PG8_STAGE(PG8_SA(1, 1), a1 + hstep, voffA);
            PG8_WAIT_L(8); PG8_BAR; PG8_WAIT_L(0); PG8_MMA(0, 0, At, B0); PG8_BAR; PG8_SCHED;
            PG8_LDB(B1, 0, 1); PG8_STAGE(PG8_SB(0, 0), b2, voffB);
            PG8_BAR; PG8_WAIT_L(0); PG8_MMA(0, 1, At, B1); PG8_BAR;
            PG8_LDA(At, 0, 1); PG8_STAGE(PG8_SA(0, 0), a2, voffA);
            PG8_BAR; PG8_WAIT_L(0); PG8_MMA(1, 0, At, B0); PG8_BAR; PG8_SCHED;
            PG8_STAGE(PG8_SB(0, 1), b2 + hstep, voffB);
            PG8_WAIT_V(6); PG8_BAR; PG8_MMA(1, 1, At, B1); PG8_BAR;
            PG8_LDB(B0, 1, 0); PG8_SCHED; PG8_LDA(At, 1, 0); PG8_STAGE(PG8_SA(0, 1), a2 + hstep, voffA);
            PG8_WAIT_L(8); PG8_BAR; PG8_WAIT_L(0); PG8_MMA(0, 0, At, B0); PG8_BAR; PG8_SCHED;
            PG8_LDB(B1, 1, 1); PG8_STAGE(PG8_SB(1, 0), b3, voffB);
            PG8_BAR; PG8_WAIT_L(0); PG8_MMA(0, 1, At, B1); PG8_BAR;
            PG8_LDA(At, 1, 1); PG8_STAGE(PG8_SA(1, 0), a3, voffA);
            PG8_BAR; PG8_WAIT_L(0); PG8_MMA(1, 0, At, B0); PG8_BAR; PG8_SCHED;
            PG8_STAGE(PG8_SB(1, 1), b3 + hstep, voffB);
            PG8_WAIT_V(6); PG8_BAR; PG8_MMA(1, 1, At, B1); PG8_BAR;
            }
        }
        if constexpr (ALIGN_EPI) { if (wr == 0) PG8_BAR; }
        PG8_MFMA_DRAIN();
        if constexpr (!Epi::AFTER_DRAIN) { E(acc, cur, wr, wc, fr, fq); S.done(cur); }
        if (!has_next) break;
#pragma unroll
        for (int a = 0; a < 2; ++a)
#pragma unroll
            for (int b = 0; b < 2; ++b)
#pragma unroll
                for (int m = 0; m < 4; ++m)
#pragma unroll
                    for (int n = 0; n < 2; ++n) acc[a][b][m][n] = (f32x4){0.f, 0.f, 0.f, 0.f};
        cur = nxt; cA = nA; cB = nB; ++ui;
        if constexpr (ALIGN_EPI) { if (wr == 1) PG8_BAR; }
    }
    PG8_WAIT_V(0);
    if constexpr (!ALIGN_EPI) { if (wr == 0) PG8_BAR; }
    PG8_BAR;
    if constexpr (Epi::AFTER_DRAIN) { E.fused(acc, cur, wr, wc, fr, fq, lds, wid, lane); S.done(cur); }
#undef PG8_SA
#undef PG8_SB
#undef PG8_STAGE
#undef PG8_LDA
#undef PG8_LDB
#undef PG8_MMA
#undef PG8_MFMA_DRAIN
#undef PG8_WAIT_V
#undef PG8_WAIT_L
#undef PG8_BAR
#undef PG8_SCHED
}
}

#ifndef FAST_GEMM
#define FAST_GEMM 1
#endif
template <bool F8 = false, class E8>
__device__ __forceinline__ void gemm_any(const void* A, const void* Bt, int M, int N, int K, const E8& E, float* lds, int bid, int nb) {
#if FAST_GEMM
  pg8::Gemm g{(const bf16_t*)A, (const bf16_t*)Bt, M, N, F8 ? K / 2 : K}; pg8::StaticOrder S; S.init(M, N, nb, bid);
  pg8::EpiA<E8> EA{E};
  pg8::gemm_phase<pg8::EpiA<E8>, pg8::StaticOrder, true, true, F8>((PG8_LAS unsigned char*)lds, g, S, EA);
#else
  gemm_naive((const bf16_t*)A, (const bf16_t*)Bt, M, N, K, E, lds, bid, nb);
#endif
}
template <bool F8 = false, class E8>
__device__ __forceinline__ void gemm_bal(const void* A, const void* Bt, int M, int N, int K, const E8& E, float* lds, int bid, int nb) {
#if FAST_GEMM
  pg8::Gemm g{(const bf16_t*)A, (const bf16_t*)Bt, M, N, F8 ? K / 2 : K}; pg8::BalOrder S; S.S.init(M, N, nb, bid);
  pg8::EpiA<E8> EA{E};
  pg8::gemm_phase<pg8::EpiA<E8>, pg8::BalOrder, true, true, F8>((PG8_LAS unsigned char*)lds, g, S, EA);
#else
  gemm_naive((const bf16_t*)A, (const bf16_t*)Bt, M, N, K, E, lds, bid, nb);
#endif
}

__device__ void gla_naive(const Params& p, const WS& w, int b, int h, float* lds) {
  constexpr int CH = 16;
  const int tid = tidx(), dv = tid & 255, half = tid >> 8, wave = tid >> 6, lane = tid & 63;
  float* qf = lds; float* kf = qf + CH * 128; float* af = kf + CH * 128; float* vf = af + CH * 128; float* op = vf + CH * 256;
  float S[64];
#pragma unroll
  for (int i = 0; i < 64; ++i) S[i] = 0.f;
  const int gd = tid & 127;
  float gu[16];
#pragma unroll
  for (int r = 0; r < 16; ++r) gu[r] = p.gate_up[r * 512 + h * 128 + gd];
  const float gb = p.gate_bias[h * 128 + gd];
  const float qscale = 0.08838834764831845f;
  for (int t0 = 0; t0 < SEQ; t0 += CH) {
    const size_t tb = (size_t)b * SEQ + t0;
    { const int tok = tid >> 5, d4 = (tid & 31) * 4;
      const uint2 qv = *(const uint2*)(w.proj + (tb + tok) * NPROJ + C_GQ + h * 128 + d4);
      const uint2 kv = *(const uint2*)(w.proj + (tb + tok) * NPROJ + C_GK + h * 128 + d4);
      *(float4*)(qf + tok * 128 + d4) = make_float4(lo_f(qv.x) * qscale, hi_f(qv.x) * qscale, lo_f(qv.y) * qscale, hi_f(qv.y) * qscale);
      *(float4*)(kf + tok * 128 + d4) = make_float4(lo_f(kv.x), hi_f(kv.x), lo_f(kv.y), hi_f(kv.y)); }
    { const int dvv = tid & 255, tk8 = (tid >> 8) * 8; float f[8];
      unpack8(*(const uint4*)(w.vT + vT_at(h * 256 + dvv, tb) + tk8), f);
#pragma unroll
      for (int j = 0; j < 8; ++j) vf[(tk8 + j) * 256 + dvv] = f[j]; }
#pragma unroll
    for (int i = 0; i < 4; ++i) { const int tok = (tid >> 7) * 4 + i; float z = gb; float gl[16];
      unpack8(*(const uint4*)(w.proj + (tb + tok) * NPROJ + C_SM), gl); unpack8(*(const uint4*)(w.proj + (tb + tok) * NPROJ + C_SM + 8), gl + 8);
#pragma unroll
      for (int r = 0; r < 16; ++r) z += gl[r] * gu[r];
      af[tok * 128 + gd] = __expf(logsigmoidf_(z) * (1.f / 16.f)); }
    __syncthreads();
    for (int tok = 0; tok < CH; ++tok) {
      const float vv = vf[tok * 256 + dv]; float acc = 0.f;
#pragma unroll
      for (int i4 = 0; i4 < 16; ++i4) {
        const float4 a = *(const float4*)(af + tok * 128 + half * 64 + i4 * 4), k = *(const float4*)(kf + tok * 128 + half * 64 + i4 * 4), q = *(const float4*)(qf + tok * 128 + half * 64 + i4 * 4);
        S[i4 * 4 + 0] = a.x * S[i4 * 4 + 0] + k.x * vv; acc += q.x * S[i4 * 4 + 0];
        S[i4 * 4 + 1] = a.y * S[i4 * 4 + 1] + k.y * vv; acc += q.y * S[i4 * 4 + 1];
        S[i4 * 4 + 2] = a.z * S[i4 * 4 + 2] + k.z * vv; acc += q.z * S[i4 * 4 + 2];
        S[i4 * 4 + 3] = a.w * S[i4 * 4 + 3] + k.w * vv; acc += q.w * S[i4 * 4 + 3];
      }
      op[(half * CH + tok) * 256 + dv] = acc;
    }
    __syncthreads();
#pragma unroll
    for (int i = 0; i < 2; ++i) { const int tok = wave * 2 + i;
      const float4 o0 = *(const float4*)(op + tok * 256 + lane * 4), o1 = *(const float4*)(op + (CH + tok) * 256 + lane * 4);
      const float o[4] = {o0.x + o1.x, o0.y + o1.y, o0.z + o1.z, o0.w + o1.w};
      float ss = wave_sum(o[0] * o[0] + o[1] * o[1] + o[2] * o[2] + o[3] * o[3]);
      const float rs = rsqrtf(ss * (1.f / 256.f) + EPS);
      const uint2 gg = *(const uint2*)(w.proj + (tb + tok) * NPROJ + C_GG + h * 256 + lane * 4);
      const float4 gn = *(const float4*)(p.gla_norm + h * 256 + lane * 4);
      const float y0 = o[0] * rs * gn.x * siluf_(lo_f(gg.x)), y1 = o[1] * rs * gn.y * siluf_(hi_f(gg.x)), y2 = o[2] * rs * gn.z * siluf_(lo_f(gg.y)), y3 = o[3] * rs * gn.w * siluf_(hi_f(gg.y));
      *(uint2*)(w.y + (tb + tok) * D + h * 256 + lane * 4) = make_uint2(pack2(y0, y1), pack2(y2, y3)); }
    __syncthreads();
  }
}
__device__ void mlstm_naive(const Params& p, const WS& w, int b, int h, float* lds) {
  constexpr int CH = 16;
  const int tid = tidx(), dv = tid & 255, half = tid >> 8, wave = tid >> 6, lane = tid & 63;
  float* qf = lds; float* kf = qf + CH * 128; float* vf = kf + CH * 128; float* op = vf + CH * 256; float* dn = op + 2 * CH * 256; float* gt = dn + 2 * CH * 256;
  float C[64], n[4];
#pragma unroll
  for (int i = 0; i < 64; ++i) C[i] = 0.f;
#pragma unroll
  for (int i = 0; i < 4; ++i) n[i] = 0.f;
  const int nd = half * 64 + (dv & 15) * 4;
  const float kscale = 0.08838834764831845f;
  const float ib = p.ig_bias[h], fb = p.fg_bias[h];
  for (int t0 = 0; t0 < SEQ; t0 += CH) {
    const size_t tb = (size_t)b * SEQ + t0;
    { const int tok = tid >> 5, d4 = (tid & 31) * 4;
      float qa[4], ka[4];
#pragma unroll
      for (int c = 0; c < 4; ++c) { qa[c] = p.conv_b[h * 128 + d4 + c]; ka[c] = p.conv_b[512 + h * 128 + d4 + c]; }
#pragma unroll
      for (int wi = 0; wi < 4; ++wi) { const int ts = t0 + tok - 3 + wi;
        if (ts >= 0) { const size_t tr = (size_t)b * SEQ + ts;
          const uint2 qv = *(const uint2*)(w.proj + tr * NPROJ + C_MQ + h * 128 + d4), kv = *(const uint2*)(w.proj + tr * NPROJ + C_MK + h * 128 + d4);
          const float4 cq = *(const float4*)(p.conv_w + wi * 1024 + h * 128 + d4), ck = *(const float4*)(p.conv_w + wi * 1024 + 512 + h * 128 + d4);
          qa[0] += cq.x * lo_f(qv.x); qa[1] += cq.y * hi_f(qv.x); qa[2] += cq.z * lo_f(qv.y); qa[3] += cq.w * hi_f(qv.y);
          ka[0] += ck.x * lo_f(kv.x); ka[1] += ck.y * hi_f(kv.x); ka[2] += ck.z * lo_f(kv.y); ka[3] += ck.w * hi_f(kv.y); } }
      *(float4*)(qf + tok * 128 + d4) = make_float4(siluf_(qa[0]), siluf_(qa[1]), siluf_(qa[2]), siluf_(qa[3]));
      *(float4*)(kf + tok * 128 + d4) = make_float4(siluf_(ka[0]) * kscale, siluf_(ka[1]) * kscale, siluf_(ka[2]) * kscale, siluf_(ka[3]) * kscale); }
    { const int dvv = tid & 255, tk8 = (tid >> 8) * 8; float f[8];
      unpack8(*(const uint4*)(w.vT + vT_at(1024 + h * 256 + dvv, tb) + tk8), f);
#pragma unroll
      for (int j = 0; j < 8; ++j) vf[(tk8 + j) * 256 + dvv] = f[j]; }
    if (tid < CH) { const float mi = bf2f(w.proj[(tb + tid) * NPROJ + C_SM + 16 + h]), mf = bf2f(w.proj[(tb + tid) * NPROJ + C_SM + 20 + h]);
      gt[tid * 2] = __expf(mi + ib); gt[tid * 2 + 1] = sigmoidf_(mf + fb); }
    __syncthreads();
    for (int tok = 0; tok < CH; ++tok) {
      const float vv = vf[tok * 256 + dv], ig = gt[tok * 2], fg = gt[tok * 2 + 1]; float num = 0.f, den = 0.f;
#pragma unroll
      for (int i4 = 0; i4 < 16; ++i4) {
        const float4 k = *(const float4*)(kf + tok * 128 + half * 64 + i4 * 4), q = *(const float4*)(qf + tok * 128 + half * 64 + i4 * 4);
        const float kk[4] = {k.x * ig, k.y * ig, k.z * ig, k.w * ig}; const float qq[4] = {q.x, q.y, q.z, q.w};
#pragma unroll
        for (int c = 0; c < 4; ++c) { C[i4 * 4 + c] = fg * C[i4 * 4 + c] + kk[c] * vv; num += qq[c] * C[i4 * 4 + c]; }
      }
      { const float4 k = *(const float4*)(kf + tok * 128 + nd), q = *(const float4*)(qf + tok * 128 + nd);
        n[0] = fg * n[0] + k.x * ig; n[1] = fg * n[1] + k.y * ig; n[2] = fg * n[2] + k.z * ig; n[3] = fg * n[3] + k.w * ig;
        den = q.x * n[0] + q.y * n[1] + q.z * n[2] + q.w * n[3];
        den = gsum<16>(den); }
      op[(half * CH + tok) * 256 + dv] = num; if (dv == 0) dn[half * CH + tok] = den;
    }
    __syncthreads();
#pragma unroll
    for (int i = 0; i < 2; ++i) { const int tok = wave * 2 + i;
      const float4 o0 = *(const float4*)(op + tok * 256 + lane * 4), o1 = *(const float4*)(op + (CH + tok) * 256 + lane * 4);
      const float den = dn[tok] + dn[CH + tok];
      const float inv = 1.f / fmaxf(fabsf(den), 1.f);
      const float o[4] = {(o0.x + o1.x) * inv, (o0.y + o1.y) * inv, (o0.z + o1.z) * inv, (o0.w + o1.w) * inv};
      float ss = wave_sum(o[0] * o[0] + o[1] * o[1] + o[2] * o[2] + o[3] * o[3]);
      const float rs = rsqrtf(ss * (1.f / 256.f) + EPS);
      const uint2 mo = *(const uint2*)(w.proj + (tb + tok) * NPROJ + C_MO + h * 256 + lane * 4);
      const float4 gn = *(const float4*)(p.mlstm_norm + h * 256 + lane * 4);
      const float y0 = o[0] * rs * gn.x * sigmoidf_(lo_f(mo.x)), y1 = o[1] * rs * gn.y * sigmoidf_(hi_f(mo.x)), y2 = o[2] * rs * gn.z * sigmoidf_(lo_f(mo.y)), y3 = o[3] * rs * gn.w * sigmoidf_(hi_f(mo.y));
      *(uint2*)(w.y + (tb + tok) * D + 1024 + h * 256 + lane * 4) = make_uint2(pack2(y0, y1), pack2(y2, y3)); }
    __syncthreads();
  }
}
__device__ void phase_mixer_naive(const Params& p, const WS& w, float* lds, int bid, int nb) {
  for (int item = bid; item < 16; item += nb) {
    if (item < 8) gla_naive(p, w, item >> 2, item & 3, lds); else mlstm_naive(p, w, (item - 8) >> 2, item & 3, lds);
    __syncthreads();
  }
}


typedef short bf16x8 __attribute__((ext_vector_type(8)));
typedef float f32x4 __attribute__((ext_vector_type(4)));
#define MFMA16(a, b, c) __builtin_amdgcn_mfma_f32_16x16x32_bf16(a, b, c, 0, 0, 0)

__device__ __forceinline__ void split8_bf16(const float* f, bf16x8& hi, bf16x8& lo) {
  unsigned h[4], l[4]; float r[8];
#pragma unroll
  for (int j = 0; j < 4; ++j) h[j] = pack2(f[2 * j], f[2 * j + 1]);
#pragma unroll
  for (int j = 0; j < 8; ++j) r[j] = f[j] - ((j & 1) ? hi_f(h[j >> 1]) : lo_f(h[j >> 1]));
#pragma unroll
  for (int j = 0; j < 4; ++j) l[j] = pack2(r[2 * j], r[2 * j + 1]);
  hi = __builtin_bit_cast(bf16x8, make_uint4(h[0], h[1], h[2], h[3])); lo = __builtin_bit_cast(bf16x8, make_uint4(l[0], l[1], l[2], l[3]));
}
__device__ __forceinline__ void prep_wq_mfma(const Params& p, const WS& w, float* lds, int bid, int nb) {
  float* SKs = lds;
  float* WQs = lds + 128 * 132;
  for (int item = bid; item < 16 * 32; item += nb) {
    const int tid = tidx(), wave = tid >> 6, lane = tid & 63, fr = lane & 15, fq = lane >> 4;
    const int hp = item >> 5, k0 = (item & 31) * 64;
#pragma unroll
    for (int i = 0; i < 8; ++i) { const int e4 = tid + 512 * i, key = e4 >> 5, d4 = (e4 & 31) * 4; *(float4*)(SKs + key * 132 + d4) = *(const float4*)(p.sub_keys + (size_t)hp * 16384 + key * 128 + d4); }
#pragma unroll
    for (int i = 0; i < 4; ++i) { const int e4 = tid + 512 * i, kr = e4 >> 5, d4 = (e4 & 31) * 4; float4 v = *(const float4*)(p.peer_query + (size_t)(k0 + kr) * 2048 + hp * 128 + d4); const float g = p.norm_ffn[k0 + kr]; v.x *= g; v.y *= g; v.z *= g; v.w *= g; *(float4*)(WQs + kr * 132 + d4) = v; }
    __syncthreads();
    bf16x8 bh[4], bl[4];
#pragma unroll
    for (int ks = 0; ks < 4; ++ks) { float f[8]; const float* s = SKs + (wave * 16 + fr) * 132 + ks * 32 + fq * 8;
      const float4 a = *(const float4*)s, b = *(const float4*)(s + 4); f[0] = a.x; f[1] = a.y; f[2] = a.z; f[3] = a.w; f[4] = b.x; f[5] = b.y; f[6] = b.z; f[7] = b.w;
      split8_bf16(f, bh[ks], bl[ks]); }
#pragma unroll 1
    for (int kt = 0; kt < 4; ++kt) { f32x4 acc = (f32x4){0.f, 0.f, 0.f, 0.f};
#pragma unroll
      for (int ks = 0; ks < 4; ++ks) { float f[8]; const float* s = WQs + (kt * 16 + fr) * 132 + ks * 32 + fq * 8; bf16x8 ah, al;
        const float4 a = *(const float4*)s, b = *(const float4*)(s + 4); f[0] = a.x; f[1] = a.y; f[2] = a.z; f[3] = a.w; f[4] = b.x; f[5] = b.y; f[6] = b.z; f[7] = b.w;
        split8_bf16(f, ah, al);
        acc = MFMA16(ah, bh[ks], acc); acc = MFMA16(ah, bl[ks], acc); acc = MFMA16(al, bh[ks], acc); }
      *(uint2*)(w.wq + (size_t)(hp * 128 + wave * 16 + fr) * 2048 + k0 + kt * 16 + 4 * fq) = make_uint2(pack2(acc[0], acc[1]), pack2(acc[2], acc[3])); }
    __syncthreads();
  }
}
constexpr int L_GLR = 0, L_TOT = 4096, L_F = 6144, L_DEN = 6656, L_PART = 6912, L_QS = 9216, L_KS = 26624, L_P = 44032, L_NL = 53248, L_KDT = 9216;
constexpr int QS_LD = 136, P_LD = 72, KDT_LD = 72;

__device__ __forceinline__ void gla_gates(const Params& p, const WS& w, int h, size_t tb, unsigned char* ldsb, int tid, float* bv, float& blast) {
  float* glrs = (float*)(ldsb + L_GLR); float* tot = (float*)(ldsb + L_TOT);
  const int d = tid & 127, tg = tid >> 7;
  if (tid < 128) { float f[8]; unpack8(*(const uint4*)(w.proj + (tb + (tid >> 1)) * NPROJ + C_SM + (tid & 1) * 8), f);
#pragma unroll
    for (int j = 0; j < 8; ++j) glrs[(tid >> 1) * 16 + (tid & 1) * 8 + j] = f[j]; }
  float gu[16];
#pragma unroll
  for (int r = 0; r < 16; ++r) gu[r] = p.gate_up[r * 512 + h * 128 + d];
  const float gb = p.gate_bias[h * 128 + d];
  __syncthreads();
  float run = 0.f;
#pragma unroll
  for (int i = 0; i < 16; ++i) { const float* gl = glrs + (tg * 16 + i) * 16; float z = gb;
#pragma unroll
    for (int r4 = 0; r4 < 4; ++r4) { const float4 g4 = *(const float4*)(gl + r4 * 4); z += g4.x * gu[r4 * 4] + g4.y * gu[r4 * 4 + 1] + g4.z * gu[r4 * 4 + 2] + g4.w * gu[r4 * 4 + 3]; }
    run += logsigmoidf_(z) * (1.f / 16.f); bv[i] = run; }
  tot[tg * 128 + d] = run;
  __syncthreads();
  float off = 0.f; blast = 0.f;
#pragma unroll
  for (int g = 0; g < 4; ++g) { const float t = tot[g * 128 + d]; blast += t; if (g < tg) off += t; }
#pragma unroll
  for (int i = 0; i < 16; ++i) bv[i] += off;
}
__device__ __forceinline__ void mlstm_gates(const Params& p, const WS& w, int h, size_t tb, unsigned char* ldsb, int tid) {
  float* Fl = (float*)(ldsb + L_F);
  if (tid < 64) { const float mi = bf2f(w.proj[(tb + tid) * NPROJ + C_SM + 16 + h]), mf = bf2f(w.proj[(tb + tid) * NPROJ + C_SM + 20 + h]);
    float f = logsigmoidf_(mf + p.fg_bias[h]);
#pragma unroll
    for (int o = 1; o < 64; o <<= 1) { const float t = bperm(f, tid - o); if (tid >= o) f += t; }
    Fl[tid] = f; Fl[64 + tid] = mi + p.ig_bias[h]; }
  __syncthreads();
}
__device__ __forceinline__ void conv_load(const WS& w, int col, int b, int c, int tg, bf16_t* win) {
  const int s0 = c * 64 + tg * 16 - 3;
#pragma unroll
  for (int m = 0; m < 19; ++m) { const int sp = s0 + m; win[m] = (sp >= 0) ? w.proj[((size_t)b * SEQ + sp) * NPROJ + col] : (bf16_t)0; }
}
__device__ __forceinline__ void conv_apply(const Params& p, const bf16_t* win, int cch, float scale, float* out) {
  const float c0 = p.conv_w[cch], c1 = p.conv_w[1024 + cch], c2 = p.conv_w[2048 + cch], c3 = p.conv_w[3072 + cch], cb = p.conv_b[cch];
#pragma unroll
  for (int i = 0; i < 16; ++i) out[i] = siluf_(cb + c0 * bf2f(win[i]) + c1 * bf2f(win[i + 1]) + c2 * bf2f(win[i + 2]) + c3 * bf2f(win[i + 3])) * scale;
}

template <int KIND>
__device__ void mix_local(const Params& p, const WS& w, int b, int h, int c, int item, unsigned char* ldsb) {
  const int tid = tidx(), lane = tid & 63, wave = tid >> 6, fr = lane & 15, fq = lane >> 4, d = tid & 127, tg = tid >> 7;
  const size_t tb = (size_t)b * SEQ + (size_t)c * 64;
  float* tot = (float*)(ldsb + L_TOT); const float* Fl = (const float*)(ldsb + L_F);
  bf16_t* kdT = (bf16_t*)(ldsb + L_KDT);
  const bf16_t* vrow = w.vT + vT_at(KIND * 1024 + h * 256 + wave * 32 + fr, tb) + fq * 8;
  bf16x8 yv[2][2];
#pragma unroll
  for (int ks = 0; ks < 2; ++ks) { yv[ks][0] = *(const bf16x8*)(vrow + ks * 32); yv[ks][1] = *(const bf16x8*)(vrow + 16 * 64 + ks * 32); }
  bf16_t kraw[19];
  if (KIND == 0) {
#pragma unroll
    for (int i = 0; i < 16; ++i) kraw[i] = w.proj[(tb + tg * 16 + i) * NPROJ + C_GK + h * 128 + d];
  } else conv_load(w, C_MK + h * 128 + d, b, c, tg, kraw);
  float wgt[16], kv[16];
  if (KIND == 0) {
    float bv[16], blast; gla_gates(p, w, h, tb, ldsb, tid, bv, blast);
#pragma unroll
    for (int i = 0; i < 16; ++i) { wgt[i] = __expf(blast - bv[i]); kv[i] = bf2f(kraw[i]); }
    if (tg == 0) w.gdec[(size_t)item * 128 + d] = __expf(blast);
  } else {
    mlstm_gates(p, w, h, tb, ldsb, tid);
    const float flast = Fl[63];
#pragma unroll
    for (int i = 0; i < 16; ++i) wgt[i] = __expf(flast - Fl[tg * 16 + i] + Fl[64 + tg * 16 + i]);
    conv_apply(p, kraw, 512 + h * 128 + d, 0.08838834764831845f, kv);
    if (tid == 0) w.mdec[item - 2048] = __expf(flast);
  }
  float un = 0.f; float kd[16];
#pragma unroll
  for (int i = 0; i < 16; ++i) { kd[i] = kv[i] * wgt[i]; un += kd[i]; }
  *(uint4*)(kdT + d * KDT_LD + tg * 16) = pack8(kd); *(uint4*)(kdT + d * KDT_LD + tg * 16 + 8) = pack8(kd + 8);
  if (KIND == 1) tot[tg * 128 + d] = un;
  __syncthreads();
  if (KIND == 1 && tg == 0) w.mn[(size_t)(item - 2048) * 128 + d] = tot[d] + tot[128 + d] + tot[256 + d] + tot[384 + d];
  f32x4 acc[2][8];
#pragma unroll
  for (int yt = 0; yt < 2; ++yt)
#pragma unroll
    for (int xt = 0; xt < 8; ++xt) acc[yt][xt] = (f32x4){0.f, 0.f, 0.f, 0.f};
#pragma unroll
  for (int ks = 0; ks < 2; ++ks) {
#pragma unroll
    for (int xt = 0; xt < 8; ++xt) { const bf16x8 xk = *(const bf16x8*)(kdT + (xt * 16 + fr) * KDT_LD + ks * 32 + fq * 8);
      acc[0][xt] = MFMA16(xk, yv[ks][0], acc[0][xt]); acc[1][xt] = MFMA16(xk, yv[ks][1], acc[1][xt]); }
  }
  bf16_t* S = (bf16_t*)p.out + (size_t)item * 32768;
#pragma unroll
  for (int yt = 0; yt < 2; ++yt)
#pragma unroll
    for (int xt = 0; xt < 8; ++xt) *(uint2*)(S + (wave * 32 + yt * 16 + fr) * 128 + xt * 16 + 4 * fq) = make_uint2(pack2(acc[yt][xt][0], acc[yt][xt][1]), pack2(acc[yt][xt][2], acc[yt][xt][3]));
  __syncthreads();
}

#ifndef SCAN_GROUPS
#define SCAN_GROUPS 1
#endif
#if U_FP8
__device__ void mix_scan(const Params& p, const WS& w, float* lds, int bid, int nb) {
  const int tid = tidx();
  const float* uscl = (const float*)(p.ws + OFF_KDT + 44 * MiB);
  for (int g0 = bid * 512; g0 < 16 * 4096; g0 += nb * 512) {
    const int g = g0 + tid, combo = g0 >> 12, u = g & 4095, dv = u >> 4, p8 = u & 15, dk0 = (p8 & 3) * 32 + (p8 >> 2) * 8, w8 = (g0 & 4095) >> 9;
    __syncthreads();
    if (combo < 8) { const float4* src = (const float4*)(w.gdec + (size_t)combo * 32768);
#pragma unroll
      for (int i = 0; i < 16; ++i) ((float4*)lds)[i * 512 + tid] = src[i * 512 + tid]; }
    else if (tid < 256) lds[tid] = w.mdec[(combo - 8) * 256 + tid];
    if (tid < 256) lds[32768 + tid] = uscl[((size_t)combo * 256 + tid) * 8 + w8];
    __syncthreads();
    const unsigned char* base = (const unsigned char*)p.out + (size_t)combo * 256 * 32768 + (size_t)u * 8;
    float S[8];
#pragma unroll
    for (int j = 0; j < 8; ++j) S[j] = 0.f;
    for (int c0 = 0; c0 < 256; c0 += 16) {
      uint2 uu[16];
#pragma unroll
      for (int k = 0; k < 16; ++k) uu[k] = *(const uint2*)(base + (size_t)(c0 + k) * 32768);
#pragma unroll
      for (int k = 0; k < 16; ++k) { float dc[8];
        if (combo < 8) { const float4 d0 = *(const float4*)(lds + (c0 + k) * 128 + dk0), d1 = *(const float4*)(lds + (c0 + k) * 128 + dk0 + 4); dc[0] = d0.x; dc[1] = d0.y; dc[2] = d0.z; dc[3] = d0.w; dc[4] = d1.x; dc[5] = d1.y; dc[6] = d1.z; dc[7] = d1.w; }
        else { const float m = lds[c0 + k];
#pragma unroll
          for (int j = 0; j < 8; ++j) dc[j] = m; }
        if (k == 0) { float* gp = (float*)w.kdT + (size_t)(combo * 16 + ((c0 + k) >> 4)) * 32768 + dv * 128 + dk0;
          *(float4*)gp = make_float4(S[0], S[1], S[2], S[3]); *(float4*)(gp + 4) = make_float4(S[4], S[5], S[6], S[7]); }
        float uf[8]; unpack4_fp8(uu[k].x, uf); unpack4_fp8(uu[k].y, uf + 4); const float us = lds[32768 + c0 + k];
#pragma unroll
        for (int j = 0; j < 8; ++j) S[j] = dc[j] * S[j] + uf[j] * us; }
    }
  }
  for (int g = (nb - 1 - bid) * 512 + tid; g < 8 * 128; g += nb * 512) {
    const int cb = g >> 7, d = g & 127; float n = 0.f;
    for (int c0 = 0; c0 < 256; c0 += 32) { float u[32], dc[32];
#pragma unroll
      for (int k = 0; k < 32; ++k) { u[k] = w.mn[(size_t)(cb * 256 + c0 + k) * 128 + d]; dc[k] = w.mdec[cb * 256 + c0 + k]; }
#pragma unroll
      for (int k = 0; k < 32; ++k) { w.mn[(size_t)(cb * 256 + c0 + k) * 128 + d] = n; n = dc[k] * n + u[k]; } }
  }
}
#else
__device__ void mix_scan(const Params& p, const WS& w, float* lds, int bid, int nb) {
  bf16_t* sbuf = (bf16_t*)p.out;
  const int tid = tidx();
  for (int g0 = bid * 512; g0 < 16 * 8192; g0 += nb * 512) {
    const int g = g0 + tid, combo = g0 >> 13, e = (g & 8191) * 4, dk = e & 127;
    __syncthreads();
    if (combo < 8) { const float4* src = (const float4*)(w.gdec + (size_t)combo * 32768);
#pragma unroll
      for (int i = 0; i < 16; ++i) ((float4*)lds)[i * 512 + tid] = src[i * 512 + tid]; }
    else if (tid < 256) lds[tid] = w.mdec[(combo - 8) * 256 + tid];
    __syncthreads();
    bf16_t* base = sbuf + (size_t)combo * 256 * 32768 + e;
    float S0 = 0.f, S1 = 0.f, S2 = 0.f, S3 = 0.f;
    for (int c0 = 0; c0 < 256; c0 += 16) {
      uint2 u[16];
#pragma unroll
      for (int k = 0; k < 16; ++k) u[k] = *(const uint2*)(base + (size_t)(c0 + k) * 32768);
#pragma unroll
      for (int k = 0; k < 16; ++k) { float4 dc; if (combo < 8) dc = *(const float4*)(lds + (c0 + k) * 128 + dk); else { const float m = lds[c0 + k]; dc = make_float4(m, m, m, m); }
#if SCAN_GROUPS
        if (k == 0) *(float4*)((float*)w.kdT + (size_t)(combo * 16 + (c0 >> 4)) * 32768 + e) = make_float4(S0, S1, S2, S3);
#else
        *(uint2*)(base + (size_t)(c0 + k) * 32768) = make_uint2(pack2(S0, S1), pack2(S2, S3));
#endif
        S0 = dc.x * S0 + lo_f(u[k].x); S1 = dc.y * S1 + hi_f(u[k].x); S2 = dc.z * S2 + lo_f(u[k].y); S3 = dc.w * S3 + hi_f(u[k].y); }
    }
  }
  for (int g = (nb - 1 - bid) * 512 + tid; g < 8 * 128; g += nb * 512) {
    const int cb = g >> 7, d = g & 127; float n = 0.f;
    for (int c0 = 0; c0 < 256; c0 += 32) { float u[32], dc[32];
#pragma unroll
      for (int k = 0; k < 32; ++k) { u[k] = w.mn[(size_t)(cb * 256 + c0 + k) * 128 + d]; dc[k] = w.mdec[cb * 256 + c0 + k]; }
#pragma unroll
      for (int k = 0; k < 32; ++k) { w.mn[(size_t)(cb * 256 + c0 + k) * 128 + d] = n; n = dc[k] * n + u[k]; } }
  }
}

#endif
template <int KIND>
__device__ void mix_out(const Params& p, const WS& w, int b, int h, int c, int item, unsigned char* ldsb) {
  const int tid = tidx(), lane = tid & 63, wave = tid >> 6, fr = lane & 15, fq = lane >> 4, d = tid & 127, tg = tid >> 7;
  const size_t tb = (size_t)b * SEQ + (size_t)c * 64;
  const float* Fl = (const float*)(ldsb + L_F); float* denl = (float*)(ldsb + L_DEN); float* part = (float*)(ldsb + L_PART); float* nl = (float*)(ldsb + L_NL);
  bf16_t* qs = (bf16_t*)(ldsb + L_QS); bf16_t* ks = (bf16_t*)(ldsb + L_KS); bf16_t* P = (bf16_t*)(ldsb + L_P);
  bf16x8 vx[2][2], sx[4][2];
  { const bf16_t* vrow = w.vT + vT_at(KIND * 1024 + h * 256 + wave * 32 + fr, tb) + fq * 8;
#pragma unroll
    for (int k2 = 0; k2 < 2; ++k2) { vx[k2][0] = *(const bf16x8*)(vrow + k2 * 32); vx[k2][1] = *(const bf16x8*)(vrow + 16 * 64 + k2 * 32); }
    const bf16_t* srow = (const bf16_t*)p.out + (size_t)item * 32768 + (wave * 32 + fr) * 128 + fq * 8;
#pragma unroll
    for (int k4 = 0; k4 < 4; ++k4) { sx[k4][0] = *(const bf16x8*)(srow + k4 * 32); sx[k4][1] = *(const bf16x8*)(srow + 16 * 128 + k4 * 32); } }
  uint2 gt[4][2];
#pragma unroll
  for (int yt = 0; yt < 4; ++yt)
#pragma unroll
    for (int xt = 0; xt < 2; ++xt) gt[yt][xt] = *(const uint2*)(w.proj + (tb + yt * 16 + fr) * NPROJ + (KIND == 0 ? C_GG : C_MO) + h * 256 + wave * 32 + xt * 16 + 4 * fq);
  const float* gain = (KIND == 0 ? p.gla_norm : p.mlstm_norm) + h * 256;
  const float4 gn0 = *(const float4*)(gain + wave * 32 + 4 * fq), gn1 = *(const float4*)(gain + wave * 32 + 16 + 4 * fq);
  bf16_t qraw[19], kraw[19];
  if (KIND == 0) {
#pragma unroll
    for (int i = 0; i < 16; ++i) { qraw[i] = w.proj[(tb + tg * 16 + i) * NPROJ + C_GQ + h * 128 + d]; kraw[i] = w.proj[(tb + tg * 16 + i) * NPROJ + C_GK + h * 128 + d]; }
  } else { conv_load(w, C_MQ + h * 128 + d, b, c, tg, qraw); conv_load(w, C_MK + h * 128 + d, b, c, tg, kraw); }
  float nlv = 0.f;
  if (KIND == 1 && tid < 128) nlv = w.mn[(size_t)(item - 2048) * 128 + tid];
  {
    float qm[16], km[16], qv[16], kv[16];
    if (KIND == 0) {
      float bv[16], blast; gla_gates(p, w, h, tb, ldsb, tid, bv, blast);
#pragma unroll
      for (int i = 0; i < 16; ++i) { qm[i] = 0.08838834764831845f * __expf(bv[i]); km[i] = __expf(-bv[i]); qv[i] = bf2f(qraw[i]); kv[i] = bf2f(kraw[i]); }
    } else {
      mlstm_gates(p, w, h, tb, ldsb, tid);
#pragma unroll
      for (int i = 0; i < 16; ++i) { const float F = Fl[tg * 16 + i]; qm[i] = __expf(F); km[i] = __expf(Fl[64 + tg * 16 + i] - F); }
      conv_apply(p, qraw, h * 128 + d, 1.f, qv);
      conv_apply(p, kraw, 512 + h * 128 + d, 0.08838834764831845f, kv);
      if (tid < 128) nl[tid] = nlv;
    }
#pragma unroll
    for (int i = 0; i < 16; ++i) { qs[(tg * 16 + i) * QS_LD + d] = f2bf(qv[i] * qm[i]); ks[(tg * 16 + i) * QS_LD + d] = f2bf(kv[i] * km[i]); }
  }
  __syncthreads();
#pragma unroll
  for (int q = 0; q < 2; ++q) { const int tt = wave * 2 + q, jt = tt >> 2, it = tt & 3; f32x4 a = (f32x4){0.f, 0.f, 0.f, 0.f};
#pragma unroll
    for (int k4 = 0; k4 < 4; ++k4) { const bf16x8 xk = *(const bf16x8*)(ks + (jt * 16 + fr) * QS_LD + k4 * 32 + fq * 8), yq = *(const bf16x8*)(qs + (it * 16 + fr) * QS_LD + k4 * 32 + fq * 8); a = MFMA16(xk, yq, a); }
    const int i = it * 16 + fr, j0 = jt * 16 + 4 * fq;
    const float v0 = (j0 <= i) ? a[0] : 0.f, v1 = (j0 + 1 <= i) ? a[1] : 0.f, v2 = (j0 + 2 <= i) ? a[2] : 0.f, v3 = (j0 + 3 <= i) ? a[3] : 0.f;
    *(uint2*)(P + i * P_LD + j0) = make_uint2(pack2(v0, v1), pack2(v2, v3)); }
  __syncthreads();
  if (KIND == 1) { const int i = tid >> 3, pt = tid & 7; float f[8]; float s = 0.f;
    unpack8(*(const uint4*)(P + i * P_LD + pt * 8), f);
#pragma unroll
    for (int j = 0; j < 8; ++j) s += f[j];
#pragma unroll
    for (int hh = 0; hh < 2; ++hh) { unpack8(*(const uint4*)(qs + i * QS_LD + pt * 16 + hh * 8), f);
#pragma unroll
      for (int j = 0; j < 8; ++j) s += f[j] * nl[pt * 16 + hh * 8 + j]; }
    s = gsum<8>(s);
    if (pt == 0) denl[i] = s; }
  f32x4 acc[2][4];
#pragma unroll
  for (int xt = 0; xt < 2; ++xt)
#pragma unroll
    for (int yt = 0; yt < 4; ++yt) acc[xt][yt] = (f32x4){0.f, 0.f, 0.f, 0.f};
#pragma unroll
  for (int k2 = 0; k2 < 2; ++k2)
#pragma unroll
    for (int yt = 0; yt < 4; ++yt) { const bf16x8 yp = *(const bf16x8*)(P + (yt * 16 + fr) * P_LD + k2 * 32 + fq * 8); acc[0][yt] = MFMA16(vx[k2][0], yp, acc[0][yt]); acc[1][yt] = MFMA16(vx[k2][1], yp, acc[1][yt]); }
#pragma unroll
  for (int k4 = 0; k4 < 4; ++k4)
#pragma unroll
    for (int yt = 0; yt < 4; ++yt) { const bf16x8 yq = *(const bf16x8*)(qs + (yt * 16 + fr) * QS_LD + k4 * 32 + fq * 8); acc[0][yt] = MFMA16(sx[k4][0], yq, acc[0][yt]); acc[1][yt] = MFMA16(sx[k4][1], yq, acc[1][yt]); }
  if (KIND == 1) __syncthreads();
#pragma unroll
  for (int yt = 0; yt < 4; ++yt) { float s = 0.f;
    if (KIND == 1) { const float inv = 1.f / fmaxf(fabsf(denl[yt * 16 + fr]), 1.f); acc[0][yt] *= inv; acc[1][yt] *= inv; }
#pragma unroll
    for (int xt = 0; xt < 2; ++xt)
#pragma unroll
      for (int r = 0; r < 4; ++r) s += acc[xt][yt][r] * acc[xt][yt][r];
    s += sxor<16>(s); s += sxor<32>(s);
    if (fq == 0) part[wave * 64 + yt * 16 + fr] = s; }
  __syncthreads();
#pragma unroll
  for (int yt = 0; yt < 4; ++yt) { const int i = yt * 16 + fr; float t = 0.f;
#pragma unroll
    for (int ww = 0; ww < 8; ++ww) t += part[ww * 64 + i];
    const float rs = rsqrtf(t * (1.f / 256.f) + EPS);
#pragma unroll
    for (int xt = 0; xt < 2; ++xt) { const int dv = wave * 32 + xt * 16 + 4 * fq;
      const float4 gn = xt == 0 ? gn0 : gn1; const uint2 g2 = gt[yt][xt];
      const float g0 = lo_f(g2.x), g1 = hi_f(g2.x), g2f = lo_f(g2.y), g3 = hi_f(g2.y);
      const float a0 = KIND == 0 ? siluf_(g0) : sigmoidf_(g0), a1 = KIND == 0 ? siluf_(g1) : sigmoidf_(g1), a2 = KIND == 0 ? siluf_(g2f) : sigmoidf_(g2f), a3 = KIND == 0 ? siluf_(g3) : sigmoidf_(g3);
      const float y0 = acc[xt][yt][0] * rs * gn.x * a0, y1 = acc[xt][yt][1] * rs * gn.y * a1, y2 = acc[xt][yt][2] * rs * gn.z * a2, y3 = acc[xt][yt][3] * rs * gn.w * a3;
#if F8_OUT
      *(unsigned*)(w.yq + (tb + i) * D + KIND * 1024 + h * 256 + dv) = pack4_fp8(y0, y1, y2, y3);
#else
      *(uint2*)(w.y + (tb + i) * D + KIND * 1024 + h * 256 + dv) = make_uint2(pack2(y0, y1), pack2(y2, y3));
#endif
    } }
  __syncthreads();
}
__device__ __forceinline__ void mix_out3_fetch(const WS& w, int item, int tid, uint4& tq0, uint4& tq1, uint4& tk0, uint4& tk1, float& nlv) {
  const int kind = item >> 11, b = (item >> 10) & 1, h = (item >> 8) & 3, c = item & 255;
  const size_t tb = (size_t)b * SEQ + (size_t)c * 64;
  const bf16_t* gq = w.qs + qs_at(kind * 4 + h, tb); const bf16_t* gk = w.ks + qs_at(kind * 4 + h, tb);
  const int r0 = tid >> 4, r1 = (512 + tid) >> 4, c8 = (tid & 15) * 8;
  tq0 = *(const uint4*)(gq + r0 * 128 + c8); tq1 = *(const uint4*)(gq + r1 * 128 + c8); tk0 = *(const uint4*)(gk + r0 * 128 + c8); tk1 = *(const uint4*)(gk + r1 * 128 + c8);
  if (kind == 1 && tid < 128) nlv = w.mn[(size_t)(item - 2048) * 128 + tid];
}
template <int KIND>
__device__ __forceinline__ void mix_out3(const Params& p, const WS& w, int b, int h, int c, int item, unsigned char* ldsb, uint4& tq0, uint4& tq1, uint4& tk0, uint4& tk1, float& nlv, int nitem) {
  const int tid = tidx(), lane = tid & 63, wave = tid >> 6, fr = lane & 15, fq = lane >> 4, d = tid & 127, tg = tid >> 7;
  const size_t tb = (size_t)b * SEQ + (size_t)c * 64;
  const float* Fl = (const float*)(ldsb + L_F); float* denl = (float*)(ldsb + L_DEN); float* part = (float*)(ldsb + L_PART); float* nl = (float*)(ldsb + L_NL);
  bf16_t* qs = (bf16_t*)(ldsb + L_QS); bf16_t* ks = (bf16_t*)(ldsb + L_KS); bf16_t* P = (bf16_t*)(ldsb + L_P);
  bf16x8 vx[2][2], sx[4][2];
  { const bf16_t* vrow = w.vT + vT_at(KIND * 1024 + h * 256 + wave * 32 + fr, tb) + fq * 8;
#pragma unroll
    for (int k2 = 0; k2 < 2; ++k2) { vx[k2][0] = *(const bf16x8*)(vrow + k2 * 32); vx[k2][1] = *(const bf16x8*)(vrow + 16 * 64 + k2 * 32); }
    const bf16_t* srow = (const bf16_t*)p.out + (size_t)item * 32768 + (wave * 32 + fr) * 128 + fq * 8;
#pragma unroll
    for (int k4 = 0; k4 < 4; ++k4) { sx[k4][0] = *(const bf16x8*)(srow + k4 * 32); sx[k4][1] = *(const bf16x8*)(srow + 16 * 128 + k4 * 32); } }
  uint2 gt[4][2];
#pragma unroll
  for (int yt = 0; yt < 4; ++yt)
#pragma unroll
    for (int xt = 0; xt < 2; ++xt) gt[yt][xt] = *(const uint2*)(w.proj + (tb + yt * 16 + fr) * NPROJ + (KIND == 0 ? C_GG : C_MO) + h * 256 + wave * 32 + xt * 16 + 4 * fq);
  const float* gain = (KIND == 0 ? p.gla_norm : p.mlstm_norm) + h * 256;
  const float4 gn0 = *(const float4*)(gain + wave * 32 + 4 * fq), gn1 = *(const float4*)(gain + wave * 32 + 16 + 4 * fq);
  { const int r0 = tid >> 4, r1 = (512 + tid) >> 4, c8 = (tid & 15) * 8;
    *(uint4*)(qs + r0 * QS_LD + c8) = tq0; *(uint4*)(qs + r1 * QS_LD + c8) = tq1; *(uint4*)(ks + r0 * QS_LD + c8) = tk0; *(uint4*)(ks + r1 * QS_LD + c8) = tk1;
    if (KIND == 1 && tid < 128) nl[tid] = nlv;
    if (nitem >= 0) mix_out3_fetch(w, nitem, tid, tq0, tq1, tk0, tk1, nlv); }
  __syncthreads();
#pragma unroll
  for (int q = 0; q < 2; ++q) { const int tt = wave * 2 + q, jt = tt >> 2, it = tt & 3; f32x4 a = (f32x4){0.f, 0.f, 0.f, 0.f};
#pragma unroll
    for (int k4 = 0; k4 < 4; ++k4) { const bf16x8 xk = *(const bf16x8*)(ks + (jt * 16 + fr) * QS_LD + k4 * 32 + fq * 8), yq = *(const bf16x8*)(qs + (it * 16 + fr) * QS_LD + k4 * 32 + fq * 8); a = MFMA16(xk, yq, a); }
    const int i = it * 16 + fr, j0 = jt * 16 + 4 * fq;
    const float v0 = (j0 <= i) ? a[0] : 0.f, v1 = (j0 + 1 <= i) ? a[1] : 0.f, v2 = (j0 + 2 <= i) ? a[2] : 0.f, v3 = (j0 + 3 <= i) ? a[3] : 0.f;
    *(uint2*)(P + i * P_LD + j0) = make_uint2(pack2(v0, v1), pack2(v2, v3)); }
  __syncthreads();
  if (KIND == 1) { const int i = tid >> 3, pt = tid & 7; float f[8]; float s = 0.f;
    unpack8(*(const uint4*)(P + i * P_LD + pt * 8), f);
#pragma unroll
    for (int j = 0; j < 8; ++j) s += f[j];
#pragma unroll
    for (int hh = 0; hh < 2; ++hh) { unpack8(*(const uint4*)(qs + i * QS_LD + pt * 16 + hh * 8), f);
#pragma unroll
      for (int j = 0; j < 8; ++j) s += f[j] * nl[pt * 16 + hh * 8 + j]; }
    s = gsum<8>(s);
    if (pt == 0) denl[i] = s; }
  f32x4 acc[2][4];
#pragma unroll
  for (int xt = 0; xt < 2; ++xt)
#pragma unroll
    for (int yt = 0; yt < 4; ++yt) acc[xt][yt] = (f32x4){0.f, 0.f, 0.f, 0.f};
#pragma unroll
  for (int k2 = 0; k2 < 2; ++k2)
#pragma unroll
    for (int yt = 0; yt < 4; ++yt) { const bf16x8 yp = *(const bf16x8*)(P + (yt * 16 + fr) * P_LD + k2 * 32 + fq * 8); acc[0][yt] = MFMA16(vx[k2][0], yp, acc[0][yt]); acc[1][yt] = MFMA16(vx[k2][1], yp, acc[1][yt]); }
#pragma unroll
  for (int k4 = 0; k4 < 4; ++k4)
#pragma unroll
    for (int yt = 0; yt < 4; ++yt) { const bf16x8 yq = *(const bf16x8*)(qs + (yt * 16 + fr) * QS_LD + k4 * 32 + fq * 8); acc[0][yt] = MFMA16(sx[k4][0], yq, acc[0][yt]); acc[1][yt] = MFMA16(sx[k4][1], yq, acc[1][yt]); }
#pragma unroll
  for (int yt = 0; yt < 4; ++yt) { float s = 0.f;
#pragma unroll
    for (int xt = 0; xt < 2; ++xt)
#pragma unroll
      for (int r = 0; r < 4; ++r) s += acc[xt][yt][r] * acc[xt][yt][r];
    s += sxor<16>(s); s += sxor<32>(s);
    if (fq == 0) part[wave * 64 + yt * 16 + fr] = s; }
  __syncthreads();
#pragma unroll
  for (int yt = 0; yt < 4; ++yt) { const int i = yt * 16 + fr; float t = 0.f;
#pragma unroll
    for (int ww = 0; ww < 8; ++ww) t += part[ww * 64 + i];
    float dd = 1.f; if (KIND == 1) { dd = fmaxf(fabsf(denl[i]), 1.f); dd *= dd; }
    const float rs = rsqrtf(t * (1.f / 256.f) + EPS * dd);
#pragma unroll
    for (int xt = 0; xt < 2; ++xt) { const int dv = wave * 32 + xt * 16 + 4 * fq;
      const float4 gn = xt == 0 ? gn0 : gn1; const uint2 g2 = gt[yt][xt];
      const float g0 = lo_f(g2.x), g1 = hi_f(g2.x), g2f = lo_f(g2.y), g3 = hi_f(g2.y);
      const float a0 = KIND == 0 ? siluf_(g0) : sigmoidf_(g0), a1 = KIND == 0 ? siluf_(g1) : sigmoidf_(g1), a2 = KIND == 0 ? siluf_(g2f) : sigmoidf_(g2f), a3 = KIND == 0 ? siluf_(g3) : sigmoidf_(g3);
      const float y0 = acc[xt][yt][0] * rs * gn.x * a0, y1 = acc[xt][yt][1] * rs * gn.y * a1, y2 = acc[xt][yt][2] * rs * gn.z * a2, y3 = acc[xt][yt][3] * rs * gn.w * a3;
#if F8_OUT
      *(unsigned*)(w.yq + (tb + i) * D + KIND * 1024 + h * 256 + dv) = pack4_fp8(y0, y1, y2, y3);
#else
      *(uint2*)(w.y + (tb + i) * D + KIND * 1024 + h * 256 + dv) = make_uint2(pack2(y0, y1), pack2(y2, y3));
#endif
    } }
}

template <int KIND>
__device__ __forceinline__ void mix_out4_group(const Params& p, const WS& w, int seq, int grp, unsigned char* ldsb0, int& par) {
  const int b = (seq >> 2) & 1, h = seq & 3, item0 = seq * 256 + grp * 16;
  float Sf[4][2][8];
  { const int t0 = tidx(), wave = t0 >> 6, fr = t0 & 15, fq = (t0 >> 4) & 3;
    const float* grow = (const float*)w.kdT + (size_t)(seq * 16 + grp) * 32768 + (wave * 32 + fr) * 128 + fq * 8;
#pragma unroll
    for (int k4 = 0; k4 < 4; ++k4)
#pragma unroll
      for (int xt = 0; xt < 2; ++xt) { const float4 lo = *(const float4*)(grow + xt * 16 * 128 + k4 * 32), hi = *(const float4*)(grow + xt * 16 * 128 + k4 * 32 + 4);
        Sf[k4][xt][0] = lo.x; Sf[k4][xt][1] = lo.y; Sf[k4][xt][2] = lo.z; Sf[k4][xt][3] = lo.w; Sf[k4][xt][4] = hi.x; Sf[k4][xt][5] = hi.y; Sf[k4][xt][6] = hi.z; Sf[k4][xt][7] = hi.w; } }
  uint4 tq0, tq1, tk0, tk1; float nlv = 0.f;
  mix_out3_fetch(w, item0, tidx(), tq0, tq1, tk0, tk1, nlv);
#pragma unroll 1
  for (int ci = 0; ci < 16; ++ci, par ^= 1) {
    unsigned char* ldsb = ldsb0 + par * 57344;
    const int item = item0 + ci, c = grp * 16 + ci, nitem = ci < 15 ? item + 1 : -1;
    const int tid = tidx(), lane = tid & 63, wave = tid >> 6, fr = lane & 15, fq = lane >> 4;
    const size_t tb = (size_t)b * SEQ + (size_t)c * 64;
    float* denl = (float*)(ldsb + L_DEN); float* part = (float*)(ldsb + L_PART); float* nl = (float*)(ldsb + L_NL);
    bf16_t* qs = (bf16_t*)(ldsb + L_QS); bf16_t* ks = (bf16_t*)(ldsb + L_KS); bf16_t* P = (bf16_t*)(ldsb + L_P);
    bf16x8 vx[2][2];
#if U_FP8
    uint4 u8a0, u8a1, u8b0, u8b1; float uscale;
#else
    bf16x8 ux[4][2];
#endif
    { const bf16_t* vrow = w.vT + vT_at(KIND * 1024 + h * 256 + wave * 32 + fr, tb) + fq * 8;
#pragma unroll
      for (int k2 = 0; k2 < 2; ++k2) { vx[k2][0] = *(const bf16x8*)(vrow + k2 * 32); vx[k2][1] = *(const bf16x8*)(vrow + 16 * 64 + k2 * 32); }
#if U_FP8
      const unsigned char* urow = (const unsigned char*)p.out + (size_t)item * 32768 + (wave * 32 + fr) * 128 + fq * 32;
      u8a0 = *(const uint4*)urow; u8a1 = *(const uint4*)(urow + 16); u8b0 = *(const uint4*)(urow + 16 * 128); u8b1 = *(const uint4*)(urow + 16 * 128 + 16);
      uscale = ((const float*)(p.ws + OFF_KDT + 44 * MiB))[(size_t)item * 8 + wave]; }
#else
      const bf16_t* urow = (const bf16_t*)p.out + (size_t)item * 32768 + (wave * 32 + fr) * 128 + fq * 8;
#pragma unroll
      for (int k4 = 0; k4 < 4; ++k4) { ux[k4][0] = *(const bf16x8*)(urow + k4 * 32); ux[k4][1] = *(const bf16x8*)(urow + 16 * 128 + k4 * 32); } }
#endif
    uint2 gt[4][2];
#pragma unroll
    for (int yt = 0; yt < 4; ++yt)
#pragma unroll
      for (int xt = 0; xt < 2; ++xt) gt[yt][xt] = *(const uint2*)(w.proj + (tb + yt * 16 + fr) * NPROJ + (KIND == 0 ? C_GG : C_MO) + h * 256 + wave * 32 + xt * 16 + 4 * fq);
    const float* gain = (KIND == 0 ? p.gla_norm : p.mlstm_norm) + h * 256;
    const float4 gn0 = *(const float4*)(gain + wave * 32 + 4 * fq), gn1 = *(const float4*)(gain + wave * 32 + 16 + 4 * fq);
    { const int r0 = tid >> 4, r1 = (512 + tid) >> 4, c8 = (tid & 15) * 8;
      *(uint4*)(qs + r0 * QS_LD + c8) = tq0; *(uint4*)(qs + r1 * QS_LD + c8) = tq1; *(uint4*)(ks + r0 * QS_LD + c8) = tk0; *(uint4*)(ks + r1 * QS_LD + c8) = tk1;
      if (KIND == 1 && tid < 128) nl[tid] = nlv;
      if (nitem >= 0) mix_out3_fetch(w, nitem, tid, tq0, tq1, tk0, tk1, nlv); }
    __syncthreads();
#pragma unroll
    for (int q = 0; q < 2; ++q) { const int tt = wave * 2 + q, jt = tt >> 2, it = tt & 3; f32x4 a = (f32x4){0.f, 0.f, 0.f, 0.f};
#pragma unroll
      for (int k4 = 0; k4 < 4; ++k4) { const bf16x8 xk = *(const bf16x8*)(ks + (jt * 16 + fr) * QS_LD + k4 * 32 + fq * 8), yq = *(const bf16x8*)(qs + (it * 16 + fr) * QS_LD + k4 * 32 + fq * 8); a = MFMA16(xk, yq, a); }
      const int i = it * 16 + fr, j0 = jt * 16 + 4 * fq;
      const float v0 = (j0 <= i) ? a[0] : 0.f, v1 = (j0 + 1 <= i) ? a[1] : 0.f, v2 = (j0 + 2 <= i) ? a[2] : 0.f, v3 = (j0 + 3 <= i) ? a[3] : 0.f;
      *(uint2*)(P + i * P_LD + j0) = make_uint2(pack2(v0, v1), pack2(v2, v3)); }
    __syncthreads();
    if (KIND == 1) { const int i = tid >> 3, pt = tid & 7; float f[8]; float s = 0.f;
      unpack8(*(const uint4*)(P + i * P_LD + pt * 8), f);
#pragma unroll
      for (int j = 0; j < 8; ++j) s += f[j];
#pragma unroll
      for (int hh = 0; hh < 2; ++hh) { unpack8(*(const uint4*)(qs + i * QS_LD + pt * 16 + hh * 8), f);
#pragma unroll
        for (int j = 0; j < 8; ++j) s += f[j] * nl[pt * 16 + hh * 8 + j]; }
      s = gsum<8>(s);
      if (pt == 0) denl[i] = s; }
    f32x4 acc[2][4];
#pragma unroll
    for (int xt = 0; xt < 2; ++xt)
#pragma unroll
      for (int yt = 0; yt < 4; ++yt) acc[xt][yt] = (f32x4){0.f, 0.f, 0.f, 0.f};
#pragma unroll
    for (int k2 = 0; k2 < 2; ++k2)
#pragma unroll
      for (int yt = 0; yt < 4; ++yt) { const bf16x8 yp = *(const bf16x8*)(P + (yt * 16 + fr) * P_LD + k2 * 32 + fq * 8); acc[0][yt] = MFMA16(vx[k2][0], yp, acc[0][yt]); acc[1][yt] = MFMA16(vx[k2][1], yp, acc[1][yt]); }
#pragma unroll
    for (int k4 = 0; k4 < 4; ++k4) {
      bf16x8 sx0, sx1;
      { const uint4 q0 = pack8(Sf[k4][0]), q1 = pack8(Sf[k4][1]); sx0 = __builtin_bit_cast(bf16x8, q0); sx1 = __builtin_bit_cast(bf16x8, q1); }
#pragma unroll
      for (int yt = 0; yt < 4; ++yt) { const bf16x8 yq = *(const bf16x8*)(qs + (yt * 16 + fr) * QS_LD + k4 * 32 + fq * 8); acc[0][yt] = MFMA16(sx0, yq, acc[0][yt]); acc[1][yt] = MFMA16(sx1, yq, acc[1][yt]); }
      float dcy[8];
      if (KIND == 0) { const float4 d0 = *(const float4*)(w.gdec + (size_t)item * 128 + k4 * 32 + 8 * fq), d1 = *(const float4*)(w.gdec + (size_t)item * 128 + k4 * 32 + 8 * fq + 4);
        dcy[0] = d0.x; dcy[1] = d0.y; dcy[2] = d0.z; dcy[3] = d0.w; dcy[4] = d1.x; dcy[5] = d1.y; dcy[6] = d1.z; dcy[7] = d1.w; }
      else { const float m = w.mdec[item - 2048];
#pragma unroll
        for (int j = 0; j < 8; ++j) dcy[j] = m; }
#pragma unroll
      for (int xt = 0; xt < 2; ++xt) { float uf[8];
#if U_FP8
        { const uint4 lo = xt ? u8b0 : u8a0, hi = xt ? u8b1 : u8a1; const unsigned w0_ = k4 == 0 ? lo.x : k4 == 1 ? lo.z : k4 == 2 ? hi.x : hi.z, w1_ = k4 == 0 ? lo.y : k4 == 1 ? lo.w : k4 == 2 ? hi.y : hi.w;
          unpack4_fp8(w0_, uf); unpack4_fp8(w1_, uf + 4);
#pragma unroll
          for (int j = 0; j < 8; ++j) uf[j] *= uscale; }
#else
        unpack8(__builtin_bit_cast(uint4, ux[k4][xt]), uf);
#endif
#pragma unroll
        for (int j = 0; j < 8; ++j) Sf[k4][xt][j] = dcy[j] * Sf[k4][xt][j] + uf[j]; } }
#pragma unroll
    for (int yt = 0; yt < 4; ++yt) { float s = 0.f;
#pragma unroll
      for (int xt = 0; xt < 2; ++xt)
#pragma unroll
        for (int r = 0; r < 4; ++r) s += acc[xt][yt][r] * acc[xt][yt][r];
      s += sxor<16>(s); s += sxor<32>(s);
      if (fq == 0) part[wave * 64 + yt * 16 + fr] = s; }
    __syncthreads();
#pragma unroll
    for (int yt = 0; yt < 4; ++yt) { const int i = yt * 16 + fr; float t = 0.f;
#pragma unroll
      for (int ww = 0; ww < 8; ++ww) t += part[ww * 64 + i];
      float dd = 1.f; if (KIND == 1) { dd = fmaxf(fabsf(denl[i]), 1.f); dd *= dd; }
      const float rs = rsqrtf(t * (1.f / 256.f) + EPS * dd);
#pragma unroll
      for (int xt = 0; xt < 2; ++xt) { const int dv = wave * 32 + xt * 16 + 4 * fq;
        const float4 gn = xt == 0 ? gn0 : gn1; const uint2 g2 = gt[yt][xt];
        const float g0 = lo_f(g2.x), g1 = hi_f(g2.x), g2f = lo_f(g2.y), g3 = hi_f(g2.y);
        const float a0 = KIND == 0 ? siluf_(g0) : sigmoidf_(g0), a1 = KIND == 0 ? siluf_(g1) : sigmoidf_(g1), a2 = KIND == 0 ? siluf_(g2f) : sigmoidf_(g2f), a3 = KIND == 0 ? siluf_(g3) : sigmoidf_(g3);
        const float y0 = acc[xt][yt][0] * rs * gn.x * a0, y1 = acc[xt][yt][1] * rs * gn.y * a1, y2 = acc[xt][yt][2] * rs * gn.z * a2, y3 = acc[xt][yt][3] * rs * gn.w * a3;
#if F8_OUT
        *(unsigned*)(w.yq + (tb + i) * D + KIND * 1024 + h * 256 + dv) = pack4_fp8(y0, y1, y2, y3);
#else
        *(uint2*)(w.y + (tb + i) * D + KIND * 1024 + h * 256 + dv) = make_uint2(pack2(y0, y1), pack2(y2, y3));
#endif
      } }
  }
}
__device__ void phase_mix_out4(const Params& p, const WS& w, unsigned char* ldsb, int bid, int nb) {
  int par = 0;
  for (int gi = bid; gi < 256; gi += nb) {
    const int seq = gi >> 4, grp = gi & 15;
    if (seq < 8) mix_out4_group<0>(p, w, seq, grp, ldsb, par); else mix_out4_group<1>(p, w, seq, grp, ldsb, par);
  }
  __syncthreads();
}

template <int WHICH>
__device__ void phase_mix_items(const Params& p, const WS& w, unsigned char* ldsb, int bid, int nb) {
  for (int item = bid; item < 4096; item += nb) {
    const int kind = item >> 11, b = (item >> 10) & 1, h = (item >> 8) & 3, c = item & 255;
    if (WHICH == 0) { if (kind == 0) mix_local<0>(p, w, b, h, c, item, ldsb); else mix_local<1>(p, w, b, h, c, item, ldsb); }
    else { if (kind == 0) mix_out<0>(p, w, b, h, c, item, ldsb); else mix_out<1>(p, w, b, h, c, item, ldsb); }
  }
}


__device__ void phase_mix_out3(const Params& p, const WS& w, unsigned char* ldsb, int bid, int nb) {
  int par = 0;
  uint4 tq0, tq1, tk0, tk1; float nlv = 0.f;
  if (bid < 4096) mix_out3_fetch(w, bid, tidx(), tq0, tq1, tk0, tk1, nlv);
  for (int item = bid; item < 4096; item += nb, par ^= 1) {
    const int kind = item >> 11, b = (item >> 10) & 1, h = (item >> 8) & 3, c = item & 255, nitem = (item + nb < 4096) ? item + nb : -1;
    if (kind == 0) mix_out3<0>(p, w, b, h, c, item, ldsb + par * 57344, tq0, tq1, tk0, tk1, nlv, nitem); else mix_out3<1>(p, w, b, h, c, item, ldsb + par * 57344, tq0, tq1, tk0, tk1, nlv, nitem);
  }
  __syncthreads();
}

__device__ void mix_gate_pass(const Params& p, const WS& w, unsigned char* ldsb, int bid, int nb) {
  const int tid = tidx(), h = tid >> 7, d = tid & 127, lane = tid & 63;
  bf16_t* qT = (bf16_t*)ldsb; bf16_t* kT = (bf16_t*)(ldsb + 65536);
  float* glrs = (float*)(ldsb + 131072); float* Fl = (float*)(ldsb + 135168);
  for (int itx = bid; itx < 1024; itx += nb) {
    const int kind = itx >> 9, b = (itx >> 8) & 1, c = itx & 255;
    const size_t tb = (size_t)b * SEQ + (size_t)c * 64;
    const int item = ((kind * 2 + b) * 4 + h) * 256 + c;
    bf16_t* kdo = w.kdT + kdT_at(kind * 512 + tid, tb);
    { uint4 tq[8], tk[8];
      const unsigned char* gq = (const unsigned char*)(w.proj + tb * NPROJ + (kind == 0 ? C_GQ : C_MQ)); const unsigned char* gk = (const unsigned char*)(w.proj + tb * NPROJ + (kind == 0 ? C_GK : C_MK));
#pragma unroll
      for (int ps = 0; ps < 8; ++ps) { const int o = ps * 8192 + tid * 16; tq[ps] = *(const uint4*)(gq + (size_t)(o >> 10) * (NPROJ * 2) + (o & 1023)); tk[ps] = *(const uint4*)(gk + (size_t)(o >> 10) * (NPROJ * 2) + (o & 1023)); }
#pragma unroll
      for (int ps = 0; ps < 8; ++ps) { const int o = ps * 8192 + tid * 16; *(uint4*)(ldsb + o) = tq[ps]; *(uint4*)(ldsb + 65536 + o) = tk[ps]; } }
    if (kind == 0) {
      if (tid < 128) { float f[8]; unpack8(*(const uint4*)(w.proj + (tb + (tid >> 1)) * NPROJ + C_SM + (tid & 1) * 8), f);
#pragma unroll
        for (int j = 0; j < 8; ++j) glrs[(tid >> 1) * 16 + (tid & 1) * 8 + j] = f[j]; }
      float gu[16];
#pragma unroll
      for (int r = 0; r < 16; ++r) gu[r] = p.gate_up[r * 512 + tid];
      const float gb = p.gate_bias[tid];
      __syncthreads();
      float run = 0.f;
#pragma unroll 1
      for (int j8 = 0; j8 < 8; ++j8) { float kd[8];
#pragma unroll
        for (int e = 0; e < 8; ++e) { const int j = j8 * 8 + e; const float* gl = glrs + j * 16; float z = gb;
#pragma unroll
          for (int r4 = 0; r4 < 4; ++r4) { const float4 g4 = *(const float4*)(gl + r4 * 4); z += g4.x * gu[r4 * 4] + g4.y * gu[r4 * 4 + 1] + g4.z * gu[r4 * 4 + 2] + g4.w * gu[r4 * 4 + 3]; }
          run += logsigmoidf_(z) * (1.f / 16.f);
          const float q = bf2f(qT[j * 512 + tid]), k = bf2f(kT[j * 512 + tid]), eb = __expf(run), ks_ = k * __builtin_amdgcn_rcpf(eb);
          qT[j * 512 + tid] = f2bf(q * 0.08838834764831845f * eb); kT[j * 512 + tid] = f2bf(ks_); kd[e] = ks_; }
        *(uint4*)(kdo + j8 * 8) = pack8(kd); }
      w.gdec[(size_t)item * 128 + d] = __expf(run);
    } else {
      float q0 = 0.f, q1 = 0.f, q2 = 0.f, k0 = 0.f, k1 = 0.f, k2 = 0.f;
      if (c > 0) { const bf16_t* qp = w.proj + tb * NPROJ + C_MQ + tid; const bf16_t* kp = w.proj + tb * NPROJ + C_MK + tid;
        q0 = bf2f(*(qp - 3 * (size_t)NPROJ)); q1 = bf2f(*(qp - 2 * (size_t)NPROJ)); q2 = bf2f(*(qp - (size_t)NPROJ)); k0 = bf2f(*(kp - 3 * (size_t)NPROJ)); k1 = bf2f(*(kp - 2 * (size_t)NPROJ)); k2 = bf2f(*(kp - (size_t)NPROJ)); }
      if (tid < 256) { const int hh = tid >> 6; const float mi = bf2f(w.proj[(tb + lane) * NPROJ + C_SM + 16 + hh]), mf = bf2f(w.proj[(tb + lane) * NPROJ + C_SM + 20 + hh]);
        float f = logsigmoidf_(mf + p.fg_bias[hh]);
#pragma unroll
        for (int o = 1; o < 64; o <<= 1) { const float t = bperm(f, lane - o); if (lane >= o) f += t; }
        Fl[hh * 64 + lane] = f; Fl[256 + hh * 64 + lane] = mi + p.ig_bias[hh]; }
      const float cq0 = p.conv_w[tid], cq1 = p.conv_w[1024 + tid], cq2 = p.conv_w[2048 + tid], cq3 = p.conv_w[3072 + tid], cqb = p.conv_b[tid];
      const float ck0 = p.conv_w[512 + tid], ck1 = p.conv_w[1536 + tid], ck2 = p.conv_w[2560 + tid], ck3 = p.conv_w[3584 + tid], ckb = p.conv_b[512 + tid];
      __syncthreads();
      const float flast = Fl[h * 64 + 63];
      if (d == 0) w.mdec[item - 2048] = __expf(flast);
      float un = 0.f;
#pragma unroll 1
      for (int j8 = 0; j8 < 8; ++j8) { float kd[8];
#pragma unroll
        for (int e = 0; e < 8; ++e) { const int j = j8 * 8 + e; const float xq = bf2f(qT[j * 512 + tid]), xk = bf2f(kT[j * 512 + tid]);
          const float qc = siluf_(cqb + cq0 * q0 + cq1 * q1 + cq2 * q2 + cq3 * xq), kc = siluf_(ckb + ck0 * k0 + ck1 * k1 + ck2 * k2 + ck3 * xk) * 0.08838834764831845f;
          q0 = q1; q1 = q2; q2 = xq; k0 = k1; k1 = k2; k2 = xk;
          const float F = Fl[h * 64 + j], ig = Fl[256 + h * 64 + j];
          const float ks_ = kc * __expf(ig - F);
          qT[j * 512 + tid] = f2bf(qc * __expf(F)); kT[j * 512 + tid] = f2bf(ks_); kd[e] = ks_; un += ks_; }
        *(uint4*)(kdo + j8 * 8) = pack8(kd); }
      w.mn[(size_t)(item - 2048) * 128 + d] = un * __expf(flast);
    }
    __syncthreads();
    { unsigned char* gq = (unsigned char*)(w.qs + qs_at(kind * 4, tb)); unsigned char* gk = (unsigned char*)(w.ks + qs_at(kind * 4, tb));
#pragma unroll
      for (int ps = 0; ps < 8; ++ps) { const int o = ps * 8192 + tid * 16, row = o >> 10, cb = o & 1023; const size_t dsto = (size_t)(cb >> 8) * 16384 + row * 256 + (cb & 255);
        *(uint4*)(gq + dsto) = *(const uint4*)(ldsb + o); *(uint4*)(gk + dsto) = *(const uint4*)(ldsb + 65536 + o); } }
    __syncthreads();
  }
}
#ifndef GATE_LOCAL
#define GATE_LOCAL 1
#endif
typedef short s16x4 __attribute__((ext_vector_type(4)));
#define GL_LAS __attribute__((address_space(3)))
__device__ void mix_gate_local(const Params& p, const WS& w, unsigned char* ldsb, int bid, int nb) {
  constexpr int KRS = 1088;
  bf16_t* qT = (bf16_t*)ldsb; unsigned char* kB = ldsb + 65536;
  float* glrs = (float*)(ldsb + 135168); float* Fl = (float*)(ldsb + 139264);
  for (int itx = bid; itx < 1024; itx += nb) {
    const int tid = tidx(), h = tid >> 7, d = tid & 127, lane = tid & 63;
    const int kind = itx >> 9, b = (itx >> 8) & 1, c = itx & 255;
    const size_t tb = (size_t)b * SEQ + (size_t)c * 64;
    const int item = ((kind * 2 + b) * 4 + h) * 256 + c;
    { uint4 tq[8], tk[8];
      const unsigned char* gq = (const unsigned char*)(w.proj + tb * NPROJ + (kind == 0 ? C_GQ : C_MQ)); const unsigned char* gk = (const unsigned char*)(w.proj + tb * NPROJ + (kind == 0 ? C_GK : C_MK));
#pragma unroll
      for (int ps = 0; ps < 8; ++ps) { const int o = ps * 8192 + tid * 16; tq[ps] = *(const uint4*)(gq + (size_t)(o >> 10) * (NPROJ * 2) + (o & 1023)); tk[ps] = *(const uint4*)(gk + (size_t)(o >> 10) * (NPROJ * 2) + (o & 1023)); }
#pragma unroll
      for (int ps = 0; ps < 8; ++ps) { const int o = ps * 8192 + tid * 16; *(uint4*)(ldsb + o) = tq[ps]; *(uint4*)(kB + (o >> 10) * KRS + (o & 1023)) = tk[ps]; } }
    bf16x8 yf[16];
    { const int wave = tid >> 6, hw = wave >> 1, fr = lane & 15, fq = lane >> 4; const bf16_t* yrow = w.vT + vT_at(kind * 1024 + hw * 256 + (wave & 1) * 128 + fr, tb) + fq * 8;
#pragma unroll
      for (int j = 0; j < 4; ++j)
#pragma unroll
        for (int ks = 0; ks < 2; ++ks) { yf[j * 4 + ks * 2] = *(const bf16x8*)(yrow + j * 32 * 64 + ks * 32); yf[j * 4 + ks * 2 + 1] = *(const bf16x8*)(yrow + (j * 32 + 16) * 64 + ks * 32); } }
    if (kind == 0) {
      if (tid < 128) { float f[8]; unpack8(*(const uint4*)(w.proj + (tb + (tid >> 1)) * NPROJ + C_SM + (tid & 1) * 8), f);
#pragma unroll
        for (int j = 0; j < 8; ++j) glrs[(tid >> 1) * 16 + (tid & 1) * 8 + j] = f[j]; }
      float gu[16];
#pragma unroll
      for (int r = 0; r < 16; ++r) gu[r] = p.gate_up[r * 512 + tid];
      const float gb = p.gate_bias[tid];
      __syncthreads();
      float run = 0.f;
#pragma unroll 1
      for (int j8 = 0; j8 < 8; ++j8) {
#pragma unroll
        for (int e = 0; e < 8; ++e) { const int j = j8 * 8 + e; const float* gl = glrs + j * 16; float z = gb;
#pragma unroll
          for (int r4 = 0; r4 < 4; ++r4) { const float4 g4 = *(const float4*)(gl + r4 * 4); z += g4.x * gu[r4 * 4] + g4.y * gu[r4 * 4 + 1] + g4.z * gu[r4 * 4 + 2] + g4.w * gu[r4 * 4 + 3]; }
          run += logsigmoidf_(z) * (1.f / 16.f);
          bf16_t* kp = (bf16_t*)(kB + j * KRS) + tid;
          const float q = bf2f(qT[j * 512 + tid]), k = bf2f(*kp), eb = __expf(run), ks_ = k * __builtin_amdgcn_rcpf(eb);
          qT[j * 512 + tid] = f2bf(q * 0.08838834764831845f * eb); *kp = f2bf(ks_); } }
      const float dec = __expf(run);
      w.gdec[(size_t)item * 128 + d] = dec; Fl[tid] = dec;
    } else {
      float q0 = 0.f, q1 = 0.f, q2 = 0.f, k0 = 0.f, k1 = 0.f, k2 = 0.f;
      if (c > 0) { const bf16_t* qp = w.proj + tb * NPROJ + C_MQ + tid; const bf16_t* kp = w.proj + tb * NPROJ + C_MK + tid;
        q0 = bf2f(*(qp - 3 * (size_t)NPROJ)); q1 = bf2f(*(qp - 2 * (size_t)NPROJ)); q2 = bf2f(*(qp - (size_t)NPROJ)); k0 = bf2f(*(kp - 3 * (size_t)NPROJ)); k1 = bf2f(*(kp - 2 * (size_t)NPROJ)); k2 = bf2f(*(kp - (size_t)NPROJ)); }
      if (tid < 256) { const int hh = tid >> 6; const float mi = bf2f(w.proj[(tb + lane) * NPROJ + C_SM + 16 + hh]), mf = bf2f(w.proj[(tb + lane) * NPROJ + C_SM + 20 + hh]);
        float f = logsigmoidf_(mf + p.fg_bias[hh]);
#pragma unroll
        for (int o = 1; o < 64; o <<= 1) { const float t = bperm(f, lane - o); if (lane >= o) f += t; }
        Fl[hh * 64 + lane] = f; Fl[256 + hh * 64 + lane] = mi + p.ig_bias[hh]; }
      const float cq0 = p.conv_w[tid], cq1 = p.conv_w[1024 + tid], cq2 = p.conv_w[2048 + tid], cq3 = p.conv_w[3072 + tid], cqb = p.conv_b[tid];
      const float ck0 = p.conv_w[512 + tid], ck1 = p.conv_w[1536 + tid], ck2 = p.conv_w[2560 + tid], ck3 = p.conv_w[3584 + tid], ckb = p.conv_b[512 + tid];
      __syncthreads();
      const float flast = Fl[h * 64 + 63];
      if (d == 0) w.mdec[item - 2048] = __expf(flast);
      float un = 0.f;
#pragma unroll 1
      for (int j8 = 0; j8 < 8; ++j8) {
#pragma unroll
        for (int e = 0; e < 8; ++e) { const int j = j8 * 8 + e; bf16_t* kp = (bf16_t*)(kB + j * KRS) + tid; const float xq = bf2f(qT[j * 512 + tid]), xk = bf2f(*kp);
          const float qc = siluf_(cqb + cq0 * q0 + cq1 * q1 + cq2 * q2 + cq3 * xq), kc = siluf_(ckb + ck0 * k0 + ck1 * k1 + ck2 * k2 + ck3 * xk) * 0.08838834764831845f;
          q0 = q1; q1 = q2; q2 = xq; k0 = k1; k1 = k2; k2 = xk;
          const float F = Fl[h * 64 + j], ig = Fl[256 + h * 64 + j];
          const float ks_ = kc * __expf(ig - F);
          qT[j * 512 + tid] = f2bf(qc * __expf(F)); *kp = f2bf(ks_); un += ks_; } }
      w.mn[(size_t)(item - 2048) * 128 + d] = un * __expf(flast);
    }
    __syncthreads();
    { unsigned char* gq = (unsigned char*)(w.qs + qs_at(kind * 4, tb)); unsigned char* gk = (unsigned char*)(w.ks + qs_at(kind * 4, tb));
#pragma unroll
      for (int ps = 0; ps < 8; ++ps) { const int o = ps * 8192 + tid * 16, row = o >> 10, cb = o & 1023; const size_t dsto = (size_t)(cb >> 8) * 16384 + row * 256 + (cb & 255);
        *(uint4*)(gq + dsto) = *(const uint4*)(ldsb + o); *(uint4*)(gk + dsto) = *(const uint4*)(kB + row * KRS + cb); } }
    const int t2 = tidx(), wave = t2 >> 6, hw = wave >> 1, fr = t2 & 15, fq = (t2 >> 4) & 3;
    bf16x8 xf[16];
    { const GL_LAS unsigned char* xb = (const GL_LAS unsigned char*)kB + (8 * fq + (fr >> 2)) * KRS + (hw * 128 + 8 * (fr & 3)) * 2;
#pragma unroll
      for (int ks = 0; ks < 2; ++ks)
#pragma unroll
        for (int xt = 0; xt < 8; ++xt) { const GL_LAS unsigned char* a = xb + ks * 32 * KRS + ((xt >> 1) * 32 + (xt & 1) * 4) * 2;
          const s16x4 lo = __builtin_amdgcn_ds_read_tr16_b64_v4i16((GL_LAS s16x4*)a), hi = __builtin_amdgcn_ds_read_tr16_b64_v4i16((GL_LAS s16x4*)(a + 4 * KRS));
          xf[ks * 8 + xt] = __builtin_shufflevector(lo, hi, 0, 1, 2, 3, 4, 5, 6, 7); } }
    const int itw = ((kind * 2 + b) * 4 + hw) * 256 + c;
    bf16_t* S = (bf16_t*)p.out + (size_t)itw * 32768;
    const float md = kind ? __expf(Fl[hw * 64 + 63]) : 0.f;
#pragma unroll
    for (int j = 0; j < 4; ++j) { f32x4 acc[2][8];
#pragma unroll
      for (int yt = 0; yt < 2; ++yt)
#pragma unroll
        for (int xt = 0; xt < 8; ++xt) acc[yt][xt] = (f32x4){0.f, 0.f, 0.f, 0.f};
#pragma unroll
      for (int ks = 0; ks < 2; ++ks)
#pragma unroll
        for (int xt = 0; xt < 8; ++xt) { acc[0][xt] = MFMA16(xf[ks * 8 + xt], yf[j * 4 + ks * 2], acc[0][xt]); acc[1][xt] = MFMA16(xf[ks * 8 + xt], yf[j * 4 + ks * 2 + 1], acc[1][xt]); }
      const int w8 = (wave & 1) * 4 + j;
#if U_FP8
      float amax = 0.f;
#pragma unroll
      for (int m = 0; m < 4; ++m) { float4 d0 = make_float4(md, md, md, md), d1 = d0;
        if (!kind) { d0 = *(const float4*)(Fl + hw * 128 + m * 32 + 8 * fq); d1 = *(const float4*)(Fl + hw * 128 + m * 32 + 8 * fq + 4); }
#pragma unroll
        for (int yt = 0; yt < 2; ++yt) { f32x4& a = acc[yt][2 * m]; f32x4& bq = acc[yt][2 * m + 1];
          a[0] *= d0.x; a[1] *= d0.y; a[2] *= d0.z; a[3] *= d0.w; bq[0] *= d1.x; bq[1] *= d1.y; bq[2] *= d1.z; bq[3] *= d1.w;
          amax = fmaxf(amax, fmaxf(fmaxf(fmaxf(fabsf(a[0]), fabsf(a[1])), fmaxf(fabsf(a[2]), fabsf(a[3]))), fmaxf(fmaxf(fabsf(bq[0]), fabsf(bq[1])), fmaxf(fabsf(bq[2]), fabsf(bq[3]))))); } }
      amax = gmax<64>(amax);
      const float usc = fmaxf(amax, 1e-30f) * (1.f / 256.f), uinv = 1.f / usc;
      if ((t2 & 63) == 0) ((float*)(p.ws + OFF_KDT + 44 * MiB))[(size_t)itw * 8 + w8] = usc;
      unsigned char* S8 = (unsigned char*)p.out + (size_t)itw * 32768;
#pragma unroll
      for (int yt = 0; yt < 2; ++yt) { unsigned wd[8];
#pragma unroll
        for (int m = 0; m < 4; ++m) { const f32x4 a = acc[yt][2 * m], bq = acc[yt][2 * m + 1];
          wd[2 * m] = pack4_fp8(a[0] * uinv, a[1] * uinv, a[2] * uinv, a[3] * uinv); wd[2 * m + 1] = pack4_fp8(bq[0] * uinv, bq[1] * uinv, bq[2] * uinv, bq[3] * uinv); }
        unsigned char* dst = S8 + (w8 * 32 + yt * 16 + fr) * 128 + fq * 32;
        *(uint4*)dst = make_uint4(wd[0], wd[1], wd[2], wd[3]); *(uint4*)(dst + 16) = make_uint4(wd[4], wd[5], wd[6], wd[7]); }
#else
#pragma unroll
      for (int m = 0; m < 4; ++m) { float4 d0 = make_float4(md, md, md, md), d1 = d0;
        if (!kind) { d0 = *(const float4*)(Fl + hw * 128 + m * 32 + 8 * fq); d1 = *(const float4*)(Fl + hw * 128 + m * 32 + 8 * fq + 4); }
#pragma unroll
        for (int yt = 0; yt < 2; ++yt) { const f32x4 a = acc[yt][2 * m], bq = acc[yt][2 * m + 1];
          *(uint4*)(S + (w8 * 32 + yt * 16 + fr) * 128 + m * 32 + 8 * fq) = make_uint4(pack2(a[0] * d0.x, a[1] * d0.y), pack2(a[2] * d0.z, a[3] * d0.w), pack2(bq[0] * d1.x, bq[1] * d1.y), pack2(bq[2] * d1.z, bq[3] * d1.w)); } }
#endif
      __builtin_amdgcn_sched_barrier(0); }
    __syncthreads();
  }
}
__device__ void mix_local2(const Params& p, const WS& w, int bid, int nb) {
  const int tid = tidx(), wave = tid >> 6, lane = tid & 63, fr = lane & 15, fq = lane >> 4;
  bf16x8 xf[16], yf[4];
#define ML_LOAD(task_) do { const int item_ = (task_) >> 3, w8_ = (task_) & 7, kind_ = item_ >> 11, b_ = (item_ >> 10) & 1, h_ = (item_ >> 8) & 3, c_ = item_ & 255; const size_t tb_ = (size_t)b_ * SEQ + (size_t)c_ * 64; \
    const bf16_t* xrow = w.kdT + kdT_at(kind_ * 512 + h_ * 128 + 8 * (fr >> 2) + (fr & 3), tb_) + fq * 8; const bf16_t* yrow = w.vT + vT_at(kind_ * 1024 + h_ * 256 + w8_ * 32 + fr, tb_) + fq * 8; \
    _Pragma("unroll") for (int ks = 0; ks < 2; ++ks) { yf[ks * 2] = *(const bf16x8*)(yrow + ks * 32); yf[ks * 2 + 1] = *(const bf16x8*)(yrow + 16 * 64 + ks * 32); \
      _Pragma("unroll") for (int xt = 0; xt < 8; ++xt) xf[ks * 8 + xt] = *(const bf16x8*)(xrow + ((xt >> 1) * 32 + (xt & 1) * 4) * 64 + ks * 32); } } while (0)
  const int t0 = bid * 8 + wave, step = nb * 8;
  if (t0 < 32768) ML_LOAD(t0);
  for (int task = t0; task < 32768; task += step) {
    const int item = task >> 3, w8 = task & 7, kind = item >> 11; f32x4 acc[2][8];
#pragma unroll
    for (int yt = 0; yt < 2; ++yt)
#pragma unroll
      for (int xt = 0; xt < 8; ++xt) acc[yt][xt] = (f32x4){0.f, 0.f, 0.f, 0.f};
#pragma unroll
    for (int ks = 0; ks < 2; ++ks)
#pragma unroll
      for (int xt = 0; xt < 8; ++xt) { acc[0][xt] = MFMA16(xf[ks * 8 + xt], yf[ks * 2], acc[0][xt]); acc[1][xt] = MFMA16(xf[ks * 8 + xt], yf[ks * 2 + 1], acc[1][xt]); }
    if (task + step < 32768) ML_LOAD(task + step);
    bf16_t* S = (bf16_t*)p.out + (size_t)item * 32768; const float md = kind ? w.mdec[item - 2048] : 0.f;
#pragma unroll
    for (int m = 0; m < 4; ++m) { float4 d0 = make_float4(md, md, md, md), d1 = d0;
      if (!kind) { d0 = *(const float4*)(w.gdec + (size_t)item * 128 + m * 32 + 8 * fq); d1 = *(const float4*)(w.gdec + (size_t)item * 128 + m * 32 + 8 * fq + 4); }
#pragma unroll
      for (int yt = 0; yt < 2; ++yt) { const f32x4 a = acc[yt][2 * m], bq = acc[yt][2 * m + 1];
        *(uint4*)(S + (w8 * 32 + yt * 16 + fr) * 128 + m * 32 + 8 * fq) = make_uint4(pack2(a[0] * d0.x, a[1] * d0.y), pack2(a[2] * d0.z, a[3] * d0.w), pack2(bq[0] * d1.x, bq[1] * d1.y), pack2(bq[2] * d1.z, bq[3] * d1.w)); } }
  }
#undef ML_LOAD
}
template <int KIND>
__device__ __forceinline__ void mix_out2_task(const Params& p, const WS& w, int item, int it, int fr, int fq) {
  const int b = (item >> 10) & 1, h = (item >> 8) & 3, c = item & 255;
  const size_t tb = (size_t)b * SEQ + (size_t)c * 64;
  const int i = it * 16 + fr;
  typedef unsigned u32x4_t __attribute__((ext_vector_type(4)));
  bf16x8 yq[4];
  { const bf16_t* qrow = w.qs + qs_at(KIND * 4 + h, tb) + i * 128 + fq * 8;
#pragma unroll
    for (int k4 = 0; k4 < 4; ++k4) yq[k4] = *(const bf16x8*)(qrow + k4 * 32); }
  uint2 pk[4]; float rsum = 0.f;
  { bf16x8 kf[4][4];
#pragma unroll
    for (int jt = 0; jt < 4; ++jt) if (jt <= it) { const bf16_t* krow = w.ks + qs_at(KIND * 4 + h, tb) + (jt * 16 + fr) * 128 + fq * 8;
#pragma unroll
      for (int k4 = 0; k4 < 4; ++k4) kf[jt][k4] = *(const bf16x8*)(krow + k4 * 32); }
#pragma unroll
    for (int jt = 0; jt < 4; ++jt) { pk[jt] = make_uint2(0u, 0u);
      if (jt <= it) { f32x4 a = (f32x4){0.f, 0.f, 0.f, 0.f};
#pragma unroll
        for (int k4 = 0; k4 < 4; ++k4) a = MFMA16(kf[jt][k4], yq[k4], a);
        if (jt == it) {
#pragma unroll
          for (int r = 0; r < 4; ++r) a[r] = (4 * fq + r <= fr) ? a[r] : 0.f; }
        rsum += a[0] + a[1] + a[2] + a[3];
        pk[jt] = make_uint2(pack2(a[0], a[1]), pack2(a[2], a[3])); } } }
  f32x4 acc[16];
#pragma unroll
  for (int xt = 0; xt < 16; ++xt) acc[xt] = (f32x4){0.f, 0.f, 0.f, 0.f};
  const bf16_t* vbase = w.vT + vT_at(KIND * 1024 + h * 256 + fr, tb) + 4 * fq;
  const bf16_t* sbase = (const bf16_t*)p.out + (size_t)item * 32768 + fr * 128 + fq * 8;
  const u32x4_t yp0 = {pk[0].x, pk[0].y, pk[1].x, pk[1].y}, yp1 = {pk[2].x, pk[2].y, pk[3].x, pk[3].y};
  uint2 va[2][2][2], vb[2][2][2]; bf16x8 sf[2][2][4];
#define MO_LOAD(bufi, g) do { _Pragma("unroll") for (int x2 = 0; x2 < 2; ++x2) { const int xt = (g) * 2 + x2; const bf16_t* vr = vbase + xt * 16 * 64; \
      va[bufi][x2][0] = *(const uint2*)vr; vb[bufi][x2][0] = *(const uint2*)(vr + 16); if (it >= 2) { va[bufi][x2][1] = *(const uint2*)(vr + 32); vb[bufi][x2][1] = *(const uint2*)(vr + 48); } \
      _Pragma("unroll") for (int k4 = 0; k4 < 4; ++k4) sf[bufi][x2][k4] = *(const bf16x8*)(sbase + xt * 16 * 128 + k4 * 32); } } while (0)
#define MO_COMP(bufi, g) do { _Pragma("unroll") for (int x2 = 0; x2 < 2; ++x2) { const int xt = (g) * 2 + x2; \
      { const u32x4_t xv = {va[bufi][x2][0].x, va[bufi][x2][0].y, vb[bufi][x2][0].x, vb[bufi][x2][0].y}; acc[xt] = MFMA16(__builtin_bit_cast(bf16x8, xv), __builtin_bit_cast(bf16x8, yp0), acc[xt]); } \
      if (it >= 2) { const u32x4_t xv = {va[bufi][x2][1].x, va[bufi][x2][1].y, vb[bufi][x2][1].x, vb[bufi][x2][1].y}; acc[xt] = MFMA16(__builtin_bit_cast(bf16x8, xv), __builtin_bit_cast(bf16x8, yp1), acc[xt]); } \
      _Pragma("unroll") for (int k4 = 0; k4 < 4; ++k4) acc[xt] = MFMA16(sf[bufi][x2][k4], yq[k4], acc[xt]); } } while (0)
  MO_LOAD(0, 0);
#pragma unroll
  for (int g = 0; g < 8; g += 2) {
    MO_LOAD(1, g + 1);
    MO_COMP(0, g);
    if (g + 2 < 8) MO_LOAD(0, g + 2);
    MO_COMP(1, g + 1);
  }
#undef MO_LOAD
#undef MO_COMP
  if (KIND == 1) {
    float qn = 0.f; const float* nrow = w.mn + (size_t)(item - 2048) * 128 + fq * 8;
#pragma unroll
    for (int k4 = 0; k4 < 4; ++k4) { float f[8]; unpack8(__builtin_bit_cast(uint4, yq[k4]), f); const float4 n0 = *(const float4*)(nrow + k4 * 32), n1 = *(const float4*)(nrow + k4 * 32 + 4);
      qn += f[0] * n0.x + f[1] * n0.y + f[2] * n0.z + f[3] * n0.w + f[4] * n1.x + f[5] * n1.y + f[6] * n1.z + f[7] * n1.w; }
    float den = rsum + qn; den += sxor<16>(den); den += sxor<32>(den);
    const float inv = 1.f / fmaxf(fabsf(den), 1.f);
#pragma unroll
    for (int xt = 0; xt < 16; ++xt) acc[xt] *= inv;
  }
  float ss = 0.f;
#pragma unroll
  for (int xt = 0; xt < 16; ++xt)
#pragma unroll
    for (int r = 0; r < 4; ++r) ss += acc[xt][r] * acc[xt][r];
  ss += sxor<16>(ss); ss += sxor<32>(ss);
  const float rs = rsqrtf(ss * (1.f / 256.f) + EPS);
  const float* gain = (KIND == 0 ? p.gla_norm : p.mlstm_norm) + h * 256 + 4 * fq;
  const bf16_t* grow = w.proj + (tb + i) * NPROJ + (KIND == 0 ? C_GG : C_MO) + h * 256 + 4 * fq;
#pragma unroll
  for (int xt = 0; xt < 16; ++xt) { const uint2 g2 = *(const uint2*)(grow + xt * 16); const float4 gn = *(const float4*)(gain + xt * 16);
    const float g0 = lo_f(g2.x), g1 = hi_f(g2.x), g2f = lo_f(g2.y), g3 = hi_f(g2.y);
    const float a0 = KIND == 0 ? siluf_(g0) : sigmoidf_(g0), a1 = KIND == 0 ? siluf_(g1) : sigmoidf_(g1), a2 = KIND == 0 ? siluf_(g2f) : sigmoidf_(g2f), a3 = KIND == 0 ? siluf_(g3) : sigmoidf_(g3);
    const float y0 = acc[xt][0] * rs * gn.x * a0, y1 = acc[xt][1] * rs * gn.y * a1, y2 = acc[xt][2] * rs * gn.z * a2, y3 = acc[xt][3] * rs * gn.w * a3;
    const size_t yo = (tb + i) * D + KIND * 1024 + h * 256 + xt * 16 + 4 * fq;
#if F8_OUT
    *(unsigned*)(w.yq + yo) = pack4_fp8(y0, y1, y2, y3);
#else
    *(uint2*)(w.y + yo) = make_uint2(pack2(y0, y1), pack2(y2, y3));
#endif
  }
}
__device__ void mix_out2(const Params& p, const WS& w, int bid, int nb) {
  const int tid = tidx(), wave = tid >> 6, lane = tid & 63, fr = lane & 15, fq = lane >> 4;
  for (int task = bid * 8 + wave; task < 16384; task += nb * 8) {
    const int item = task >> 2, it = __builtin_amdgcn_readfirstlane(task & 3);
    if (item < 2048) mix_out2_task<0>(p, w, item, it, fr, fq); else mix_out2_task<1>(p, w, item, it, fr, fq);
  }
}

__device__ __forceinline__ unsigned sort16(unsigned b) { return (b & 0x8000u) ? (~b & 0xffffu) : (b | 0x8000u); }
__device__ __forceinline__ float unsort16(unsigned k) { const unsigned b = (k & 0x8000u) ? (k & 0x7fffu) : (~k & 0xffffu); return __uint_as_float(b << 16); }
__device__ __forceinline__ unsigned sort32(float f) { const unsigned u = __float_as_uint(f); return (u & 0x80000000u) ? ~u : (u | 0x80000000u); }
__device__ __forceinline__ float unsort32(unsigned k) { const unsigned u = (k & 0x80000000u) ? (k & 0x7fffffffu) : ~k; return __uint_as_float(u); }
__device__ __forceinline__ void ce_desc(unsigned& a, unsigned& b) { const unsigned hi = max(a, b), lo = min(a, b); a = hi; b = lo; }
__device__ __forceinline__ void sort16_desc(unsigned* k) {
#pragma unroll
  for (int sz = 2; sz <= 16; sz <<= 1)
#pragma unroll
    for (int j = sz >> 1; j > 0; j >>= 1)
#pragma unroll
      for (int i = 0; i < 16; ++i) { const int l = i ^ j; if (l > i) { if ((i & sz) == 0) ce_desc(k[i], k[l]); else ce_desc(k[l], k[i]); } }
}
__device__ __forceinline__ void merge16_desc(unsigned* L, const unsigned* B) {
#pragma unroll
  for (int i = 0; i < 16; ++i) L[i] = max(L[i], B[15 - i]);
#pragma unroll
  for (int j = 8; j > 0; j >>= 1)
#pragma unroll
    for (int i = 0; i < 16; ++i) { const int l = i ^ j; if (l > i) ce_desc(L[i], L[l]); }
}
__device__ void phase_topk(const Params& p, const WS& w, unsigned char* ldsb, int bid, int nb) {
  const int tid = tidx();
  unsigned char* mytab = ldsb + tid * 36;
  for (int th = bid * 512 + tid; th < T * 8; th += nb * 512) {
    const int t = th >> 3, h = th & 7;
    const uint4* sp = (const uint4*)(w.sc + (size_t)t * D + h * 256);
    unsigned L[2][16];
#pragma unroll
    for (int pp = 0; pp < 2; ++pp) {
#pragma unroll
      for (int blk = 0; blk < 8; ++blk) {
        const uint4 v0 = sp[pp * 16 + blk * 2], v1 = sp[pp * 16 + blk * 2 + 1]; const unsigned wds[8] = {v0.x, v0.y, v0.z, v0.w, v1.x, v1.y, v1.z, v1.w};
        unsigned B[16];
#pragma unroll
        for (int e2 = 0; e2 < 8; ++e2) {
          typedef short s16x2 __attribute__((ext_vector_type(2)));
          const unsigned wv = wds[e2]; const s16x2 sg = __builtin_bit_cast(s16x2, wv) >> (s16x2){15, 15};
          const unsigned tk = wv ^ (__builtin_bit_cast(unsigned, sg) | 0x80008000u);
          B[2 * e2] = (tk << 16) | (unsigned)(blk * 16 + 2 * e2); B[2 * e2 + 1] = (tk & 0xffff0000u) | (unsigned)(blk * 16 + 2 * e2 + 1); }
        sort16_desc(B);
        if (blk == 0) {
#pragma unroll
          for (int i = 0; i < 16; ++i) L[pp][i] = B[i]; }
        else merge16_desc(L[pp], B);
      }
    }
    float v0f[16], v1f[16];
#pragma unroll
    for (int i = 0; i < 16; ++i) { v0f[i] = unsort16(L[0][i] >> 16); v1f[i] = unsort16(L[1][i] >> 16); }
    unsigned C[16], B[16];
#pragma unroll
    for (int j = 0; j < 16; ++j) C[j] = (sort32(v0f[0] + v1f[j]) & 0xffffff00u) | (unsigned)j;
    { int n = 0;
#pragma unroll
      for (int i = 1; i < 16; ++i)
#pragma unroll
        for (int j = 0; j < 16; ++j) if ((i + 1) * (j + 1) <= 16) { B[n & 15] = (sort32(v0f[i] + v1f[j]) & 0xffffff00u) | (unsigned)(i * 16 + j); ++n;
          if ((n & 15) == 0) { sort16_desc(B); merge16_desc(C, B); } }
#pragma unroll
      for (int e = 2; e < 16; ++e) B[e] = 0u;
      sort16_desc(B); merge16_desc(C, B); }
    { unsigned pw[8];
#pragma unroll
      for (int q4 = 0; q4 < 4; ++q4) { pw[q4] = (L[0][q4 * 4] & 0xffu) | ((L[0][q4 * 4 + 1] & 0xffu) << 8) | ((L[0][q4 * 4 + 2] & 0xffu) << 16) | (L[0][q4 * 4 + 3] << 24);
        pw[4 + q4] = (L[1][q4 * 4] & 0xffu) | ((L[1][q4 * 4 + 1] & 0xffu) << 8) | ((L[1][q4 * 4 + 2] & 0xffu) << 16) | (L[1][q4 * 4 + 3] << 24); }
#pragma unroll
      for (int q4 = 0; q4 < 8; ++q4) *(unsigned*)(mytab + q4 * 4) = pw[q4]; }
    const float mx = unsort32(C[0] & 0xffffff00u);
    float e[16], sum = 0.f; int eid[16];
#pragma unroll
    for (int k = 0; k < 16; ++k) { e[k] = __expf(unsort32(C[k] & 0xffffff00u) - mx); sum += e[k];
      eid[k] = (int)mytab[(C[k] >> 4) & 15] * 128 + (int)mytab[16 + (C[k] & 15)]; }
    const float inv = 1.f / sum;
    bf16_t* ei = w.eidx + (size_t)t * 128 + h * 16; bf16_t* eg = w.eg + (size_t)t * 128 + h * 16; bf16_t* es = w.esu + (size_t)t * 128 + h * 16;
#pragma unroll
    for (int k8 = 0; k8 < 2; ++k8) { float gsv[8], su[8]; unsigned idp[4];
#pragma unroll
      for (int k = 0; k < 8; ++k) { const int ex = eid[k8 * 8 + k]; gsv[k] = e[k8 * 8 + k] * inv * w.vsc[ex]; su[k] = w.usc[ex]; }
#pragma unroll
      for (int k = 0; k < 4; ++k) idp[k] = (unsigned)eid[k8 * 8 + 2 * k] | ((unsigned)eid[k8 * 8 + 2 * k + 1] << 16);
      *(uint4*)(eg + k8 * 8) = pack8(gsv); *(uint4*)(es + k8 * 8) = pack8(su); }
#pragma unroll
    for (int qq = 0; qq < 4; ++qq) *(uint2*)(w.eidx + (size_t)t * 128 + qq * 32 + h * 4) = make_uint2((unsigned)eid[qq] | ((unsigned)eid[4 + qq] << 16), (unsigned)eid[8 + qq] | ((unsigned)eid[12 + qq] << 16));
  }
}
__device__ __forceinline__ void ub16(const uint4 q, float* f) {
  const unsigned wd[4] = {q.x, q.y, q.z, q.w};
#pragma unroll
  for (int k = 0; k < 4; ++k) { f[k * 4] = (float)(wd[k] & 0xffu); f[k * 4 + 1] = (float)((wd[k] >> 8) & 0xffu); f[k * 4 + 2] = (float)((wd[k] >> 16) & 0xffu); f[k * 4 + 3] = (float)(wd[k] >> 24); }
}
__device__ __forceinline__ int row_transpose_sum16(const int* a, int r) {
  int b[8], c[4], d[2];
#pragma unroll
  for (int i = 0; i < 8; ++i) { const int keep = (r & 1) ? a[2 * i + 1] : a[2 * i], send = (r & 1) ? a[2 * i] : a[2 * i + 1]; b[i] = keep + __builtin_amdgcn_update_dpp(0, send, 0xB1, 0xF, 0xF, true); }
#pragma unroll
  for (int i = 0; i < 4; ++i) { const int keep = (r & 2) ? b[2 * i + 1] : b[2 * i], send = (r & 2) ? b[2 * i] : b[2 * i + 1]; c[i] = keep + __builtin_amdgcn_update_dpp(0, send, 0x4E, 0xF, 0xF, true); }
#pragma unroll
  for (int i = 0; i < 2; ++i) { const int keep = (r & 4) ? c[2 * i + 1] : c[2 * i], send = (r & 4) ? c[2 * i] : c[2 * i + 1]; d[i] = keep + sxor<4>(send); }
  const int keep = (r & 8) ? d[1] : d[0], send = (r & 8) ? d[0] : d[1];
  return keep + sxor<8>(send);
}
__device__ __forceinline__ unsigned u16_of(const uint4& a, const uint4& b, int j) {
  const uint4& v = j < 8 ? a : b; const int c = (j >> 1) & 3; const unsigned wd = c == 0 ? v.x : c == 1 ? v.y : c == 2 ? v.z : v.w; return (j & 1) ? (wd >> 16) : (wd & 0xffffu); }
template <int EM = 0xFFFF>
__device__ void peer_dots(const Params& p, const WS& w, int bid, int nb) {
  const int tid = tidx(), wave = tid >> 6, lane = tid & 63, r = lane % LPR, q = lane / LPR;
  const int x = bid & 7, nwl = (nb >> 3) * 8, wl = (bid >> 3) * 8 + wave;
  constexpr int HB = NIT / 2;
  static_assert(HB == 16 && LPR == 16, "row_transpose_sum16: one half batch = 16 gathers, 16 lanes per row");
  for (int sp = 0; sp < SPL; ++sp) {
    const int s = x * SPL + sp;
    const unsigned char* tab = w.u8 + (size_t)s * 16384 * SLW; const unsigned r16 = (unsigned)r * 16u;
    const uint4* ip0 = (const uint4*)(w.eidx + (size_t)wl * 128 + q * 32);
    uint4 ia = ip0[0], ib = ip0[1], ic = ip0[2], id = ip0[3];
    uint4 ha = *(const uint4*)(w.h1b + (size_t)wl * D + s * SLW + r * 16), hb = *(const uint4*)(w.h1b + (size_t)wl * D + s * SLW + r * 16 + 8);
    uint4 bA[HB], bB[HB];
#define PD_GATHER(buf, half, i0_, i1_) do { _Pragma("unroll") for (int i = 0; i < HB; ++i) { const unsigned e_ = u16_of(i0_, i1_, i), e = (EM == 0xFFFF) ? e_ : (e_ & (unsigned)EM); buf[i] = *(const uint4*)(tab + (e * (unsigned)SLW + r16)); } } while (0)
#define PD_DOTS(buf, half) do { int a_[HB]; _Pragma("unroll") for (int i = 0; i < HB; ++i) { int a = __builtin_amdgcn_sdot4((int)buf[i].x, hq[0], 0, false); a = __builtin_amdgcn_sdot4((int)buf[i].y, hq[1], a, false); \
      a = __builtin_amdgcn_sdot4((int)buf[i].z, hq[2], a, false); a_[i] = __builtin_amdgcn_sdot4((int)buf[i].w, hq[3], a, false); } \
      res[half] = (float)row_transpose_sum16(a_, r) * sh; } while (0)
    PD_GATHER(bA, 0, ia, ib);
    for (int t = wl; t < T; t += nwl) {
      PD_GATHER(bB, 1, ic, id);
      const int tn = (t + nwl < T) ? t + nwl : t;
      const uint4* ipn = (const uint4*)(w.eidx + (size_t)tn * 128 + q * 32); const uint4 ian = ipn[0], ibn = ipn[1], icn = ipn[2], idn = ipn[3];
      const uint4 han = *(const uint4*)(w.h1b + (size_t)tn * D + s * SLW + r * 16), hbn = *(const uint4*)(w.h1b + (size_t)tn * D + s * SLW + r * 16 + 8);
      float hf[16];
      unpack8(ha, hf); unpack8(hb, hf + 8);
      float am = 0.f;
#pragma unroll
      for (int j = 0; j < 16; ++j) am = fmaxf(am, fabsf(hf[j]));
      am = gmax<LPR>(am);
      const float sh = fmaxf(am, 1e-30f) * (1.f / 127.f), inv = 1.f / sh;
      int hq[4];
#pragma unroll
      for (int k = 0; k < 4; ++k) { unsigned xw = 0;
#pragma unroll
        for (int j = 0; j < 4; ++j) xw |= ((unsigned)(int)rintf(hf[k * 4 + j] * inv) & 0xffu) << (8 * j);
        hq[k] = (int)xw; }
      float res[2] = {0.f, 0.f};
      PD_DOTS(bA, 0);
      PD_GATHER(bA, 0, ian, ibn);
      PD_DOTS(bB, 1);
#pragma unroll
      for (int rho = 0; rho < 2; ++rho) ((bf16_t*)w.pd)[((size_t)t * 128 + (rho * LPR + r) * EPI + q) * NSL + s] = f2bf(res[rho]);
      ic = icn; id = idn; ha = han; hb = hbn;
    }
#undef PD_GATHER
#undef PD_DOTS
  }
}
__device__ __forceinline__ void peer_token_w(const WS& w, int t, int lane, int idx0, int idx1, float& w0, float& w1) {
  static_assert(NSL == 8, "one 16-byte load per (token, expert) holds the 8 slices' partial dots");
  const float rs2 = rsqrtf(w.ssq2[t] * (1.f / D) + EPS);
  float f0[8], f1[8];
  unpack8(*(const uint4*)((const bf16_t*)w.pd + ((size_t)t * 128 + lane) * 8), f0); unpack8(*(const uint4*)((const bf16_t*)w.pd + ((size_t)t * 128 + 64 + lane) * 8), f1);
  const float z0 = ((f0[0] + f0[1]) + (f0[2] + f0[3])) + ((f0[4] + f0[5]) + (f0[6] + f0[7])), z1 = ((f1[0] + f1[1]) + (f1[2] + f1[3])) + ((f1[4] + f1[5]) + (f1[6] + f1[7]));
  w0 = bf2f(w.eg[(size_t)t * 128 + lane]) * gelu_tanh(z0 * bf2f(w.esu[(size_t)t * 128 + lane]) * rs2);
  w1 = bf2f(w.eg[(size_t)t * 128 + 64 + lane]) * gelu_tanh(z1 * bf2f(w.esu[(size_t)t * 128 + 64 + lane]) * rs2);
}
#ifndef PEER_WGT
#define PEER_WGT 1
#endif
__device__ void peer_wgt(const Params& p, const WS& w, int bid, int nb) {
  const int tid = tidx(), wave = tid >> 6, lane = tid & 63;
  unsigned* wq8 = (unsigned*)w.pb; float* wsc = (float*)((unsigned char*)w.pb + 8 * MiB);
  for (int t0 = (bid * 8 + wave) * 4; t0 < T; t0 += nb * 32) {
    float w0[4], w1[4];
#pragma unroll
    for (int u = 0; u < 4; ++u) peer_token_w(w, t0 + u, lane, 0, 0, w0[u], w1[u]);
#pragma unroll
    for (int u = 0; u < 4; ++u) { const int t = t0 + u;
      const float wmx = gmax<64>(fmaxf(fabsf(w0[u]), fabsf(w1[u]))), sw = fmaxf(wmx, 1e-30f) * (1.f / 127.f), isw = 1.f / sw;
      const int wq0 = (int)rintf(w0[u] * isw), wq1 = (int)rintf(w1[u] * isw);
      const int l0 = lane & ~12;
      const int pk0 = (bperm(wq0, l0) & 0xff) | ((bperm(wq0, l0 | 4) & 0xff) << 8) | ((bperm(wq0, l0 | 8) & 0xff) << 16) | (bperm(wq0, l0 | 12) << 24);
      const int pk1 = (bperm(wq1, l0) & 0xff) | ((bperm(wq1, l0 | 4) & 0xff) << 8) | ((bperm(wq1, l0 | 8) & 0xff) << 16) | (bperm(wq1, l0 | 12) << 24);
      if ((lane & 12) == 0) { const int qq = lane & 3, g = lane >> 4; wq8[(size_t)t * 32 + qq * 8 + g] = (unsigned)pk0; wq8[(size_t)t * 32 + qq * 8 + 4 + g] = (unsigned)pk1; }
      if (lane == 0) wsc[t] = sw; }
  }
}
__device__ void peer_vals(const Params& p, const WS& w, int bid, int nb) {
  static_assert(EPI == 4 && LPR == 16, "peer_vals' weight packing assumes 256-byte slices");
  const int tid = tidx(), wave = tid >> 6, lane = tid & 63, r = lane % LPR, q = lane / LPR;
  const int x = bid & 7, nwl = (nb >> 3) * 8, wl = (bid >> 3) * 8 + wave;
  constexpr int HB = NIT / 2;
  for (int sp = 0; sp < SPL; ++sp) {
    const int s = x * SPL + sp;
    const unsigned char* tab = w.v8 + (size_t)s * 16384 * SLW; const unsigned r16 = (unsigned)r * 16u;
    const uint4* ip0 = (const uint4*)(w.eidx + (size_t)wl * 128 + q * 32);
    uint4 ia = ip0[0], ib = ip0[1], ic = ip0[2], id = ip0[3];
#if PEER_WGT
    const unsigned* wq8 = (const unsigned*)w.pb; const float* wsc = (const float*)((const unsigned char*)w.pb + 8 * MiB);
    uint4 pwa = *(const uint4*)(wq8 + (size_t)wl * 32 + q * 8), pwb = *(const uint4*)(wq8 + (size_t)wl * 32 + q * 8 + 4); float sw = wsc[wl];
#else
    float w0, w1; peer_token_w(w, wl, lane, 0, 0, w0, w1);
#endif
    uint4 bA[HB], bB[HB];
#define PV_GATHER(buf, half, i0_, i1_) do { _Pragma("unroll") for (int i = 0; i < HB; ++i) { const unsigned e = u16_of(i0_, i1_, i); buf[i] = *(const uint4*)(tab + (e * (unsigned)SLW + r16)); } } while (0)
#define PV_DOT4(buf, half) do { _Pragma("unroll") for (int g4 = 0; g4 < HB / 4; ++g4) { const int gg = (half) * (HB / 4) + g4; const int pw = PV_PW(gg); \
      _Pragma("unroll") for (int dd = 0; dd < 4; ++dd) { const unsigned b0 = ((const unsigned*)&buf[g4 * 4])[dd], b1 = ((const unsigned*)&buf[g4 * 4 + 1])[dd], b2 = ((const unsigned*)&buf[g4 * 4 + 2])[dd], b3 = ((const unsigned*)&buf[g4 * 4 + 3])[dd]; \
        const unsigned p0 = __builtin_amdgcn_perm(b1, b0, 0x05010400u), p1 = __builtin_amdgcn_perm(b1, b0, 0x07030602u), p2 = __builtin_amdgcn_perm(b3, b2, 0x05010400u), p3 = __builtin_amdgcn_perm(b3, b2, 0x07030602u); \
        acc[dd * 4 + 0] = __builtin_amdgcn_sdot4((int)__builtin_amdgcn_perm(p2, p0, 0x05040100u), pw, acc[dd * 4 + 0], false); acc[dd * 4 + 1] = __builtin_amdgcn_sdot4((int)__builtin_amdgcn_perm(p2, p0, 0x07060302u), pw, acc[dd * 4 + 1], false); \
        acc[dd * 4 + 2] = __builtin_amdgcn_sdot4((int)__builtin_amdgcn_perm(p3, p1, 0x05040100u), pw, acc[dd * 4 + 2], false); acc[dd * 4 + 3] = __builtin_amdgcn_sdot4((int)__builtin_amdgcn_perm(p3, p1, 0x07060302u), pw, acc[dd * 4 + 3], false); } } } while (0)
#if PEER_WGT
#define PV_PW(gg) ((int)(((gg) & 4) ? (((gg) & 3) == 0 ? pwb.x : ((gg) & 3) == 1 ? pwb.y : ((gg) & 3) == 2 ? pwb.z : pwb.w) : (((gg) & 3) == 0 ? pwa.x : ((gg) & 3) == 1 ? pwa.y : ((gg) & 3) == 2 ? pwa.z : pwa.w)))
#else
#define PV_PW(gg) bperm(((gg) & 4) ? pk1 : pk0, 16 * ((gg) & 3) + q)
#endif
    PV_GATHER(bA, 0, ia, ib);
    for (int t = wl; t < T; t += nwl) {
      PV_GATHER(bB, 1, ic, id);
      const int tn = (t + nwl < T) ? t + nwl : t;
      const uint4* ipn = (const uint4*)(w.eidx + (size_t)tn * 128 + q * 32); const uint4 ian = ipn[0], ibn = ipn[1], icn = ipn[2], idn = ipn[3];
#if PEER_WGT
      const uint4 pwan = *(const uint4*)(wq8 + (size_t)tn * 32 + q * 8), pwbn = *(const uint4*)(wq8 + (size_t)tn * 32 + q * 8 + 4); const float swn = wsc[tn];
#else
      float w0n, w1n; peer_token_w(w, tn, lane, 0, 0, w0n, w1n);
      const float wmx = gmax<64>(fmaxf(fabsf(w0), fabsf(w1))), sw = fmaxf(wmx, 1e-30f) * (1.f / 127.f), isw = 1.f / sw;
      const int wq0 = (int)rintf(w0 * isw), wq1 = (int)rintf(w1 * isw);
      int pk0, pk1;
      { const int l0 = lane & ~12;
        pk0 = (bperm(wq0, l0) & 0xff) | ((bperm(wq0, l0 | 4) & 0xff) << 8) | ((bperm(wq0, l0 | 8) & 0xff) << 16) | (bperm(wq0, l0 | 12) << 24);
        pk1 = (bperm(wq1, l0) & 0xff) | ((bperm(wq1, l0 | 4) & 0xff) << 8) | ((bperm(wq1, l0 | 8) & 0xff) << 16) | (bperm(wq1, l0 | 12) << 24); }
#endif
      int acc[16];
#pragma unroll
      for (int j = 0; j < 16; ++j) acc[j] = 0;
      PV_DOT4(bA, 0);
      PV_GATHER(bA, 0, ian, ibn);
      const uint2 hq4 = *(const uint2*)(w.h1b + (size_t)t * D + s * SLW + r * 16 + 4 * q);
      const float ssq2t = w.ssq2[t];
      PV_DOT4(bB, 1);
      int red[4];
#pragma unroll
      for (int k = 0; k < 4; ++k) { const auto r1 = __builtin_amdgcn_permlane16_swap(acc[k], acc[4 + k], false, false); const int s01 = (int)r1[0] + (int)r1[1];
        const auto r2 = __builtin_amdgcn_permlane16_swap(acc[8 + k], acc[12 + k], false, false); const int s23 = (int)r2[0] + (int)r2[1];
        const auto r3 = __builtin_amdgcn_permlane32_swap(s01, s23, false, false); red[k] = (int)r3[0] + (int)r3[1]; }
      float o[4]; float ss = 0.f;
      { const float hf0 = lo_f(hq4.x), hf1 = hi_f(hq4.x), hf2 = lo_f(hq4.y), hf3 = hi_f(hq4.y);
        o[0] = hf0 + sw * (float)red[0]; o[1] = hf1 + sw * (float)red[1]; o[2] = hf2 + sw * (float)red[2]; o[3] = hf3 + sw * (float)red[3]; }
      ss = (o[0] * o[0] + o[1] * o[1]) + (o[2] * o[2] + o[3] * o[3]);
      *(uint2*)(w.h2b + (size_t)t * D + s * SLW + r * 16 + 4 * q) = make_uint2(pack2(o[0], o[1]), pack2(o[2], o[3]));
#if F8_GATE
      { const float rs2 = rsqrtf(ssq2t * (1.f / D) + EPS);
        *(unsigned*)(w.h2q + (size_t)t * D + s * SLW + r * 16 + 4 * q) = pack4_fp8(o[0] * rs2, o[1] * rs2, o[2] * rs2, o[3] * rs2); }
#endif
      ss = wave_sum(ss);
      if (lane == 0) atomicAdd(w.ssq3 + t, ss);
#if PEER_WGT
      ic = icn; id = idn; pwa = pwan; pwb = pwbn; sw = swn;
#else
      ic = icn; id = idn; w0 = w0n; w1 = w1n;
#endif
    }
#undef PV_GATHER
#undef PV_PW
#undef PV_DOT4
  }
}
#ifndef TPROBE_A
#define TPROBE_A -1
#endif
#ifndef TPROBE_B
#define TPROBE_B -1
#endif
__device__ void phase_final(const Params& p, const WS& w, int bid, int nb) {
  const int wave = tidx() >> 6, lane = tidx() & 63;
  float tscale = 1.f, tspike = 0.f;
  if (TPROBE_A >= 0) { const unsigned long long* ts = (const unsigned long long*)(w.ctlf + 16384); tscale = 1.f + sqrtf((float)(ts[TPROBE_A + 1] - ts[TPROBE_A]) * 1e-7f); }
  if (TPROBE_B >= 0) { const unsigned long long* ts = (const unsigned long long*)(w.ctlf + 16384); tspike = (float)(ts[TPROBE_B + 1] - ts[TPROBE_B]) * 1e-3f; }
  for (int row = bid * 8 + wave; row < T; row += nb * 8) {
    float4* o = (float4*)(p.out + (size_t)row * D);
    const float rs = rsqrtf(w.ssq4[row] * (1.f / D) + EPS) * tscale;
    uint2 hv[8];
#pragma unroll
    for (int i = 0; i < 8; ++i) hv[i] = *(const uint2*)(w.h1b + (size_t)row * D + (i * 64 + lane) * 4);
#pragma unroll
    for (int i = 0; i < 8; ++i) { const float4 g = *(const float4*)(p.norm_final + (i * 64 + lane) * 4);
      float4 v = make_float4(lo_f(hv[i].x) * rs * g.x, hi_f(hv[i].x) * rs * g.y, lo_f(hv[i].y) * rs * g.z, hi_f(hv[i].y) * rs * g.w);
      if (TPROBE_B >= 0 && row == 0 && i == 0 && lane == 0) v.x += tspike; o[i * 64 + lane] = v; }
  }
}

constexpr int NPHASE = 10;
#ifndef MIX_OUT3
#define MIX_OUT3 1
#endif
#ifndef FAST_MIX
#define FAST_MIX 2
#endif
__device__ __forceinline__ void side_arrive(unsigned* bar);
__device__ __forceinline__ void side_wait(unsigned* bar, unsigned n);
template <int PH>
__device__ __forceinline__ void run_phase(const Params& p, float* lds, int bid, int nb) {
  const WS w = make_ws(p.ws, p.out);
  if (PH == 0) phase_prep(p, w, lds, bid, nb);
  const float s_in = __uint_as_float(__builtin_amdgcn_readfirstlane((F8_IN && PH == 1) ? __float_as_uint(w.ctlf[0]) : 0u)) * (1.f / 256.f);
  const float s_out = F8_OUT ? __uint_as_float(__builtin_amdgcn_readfirstlane((PH == 5) ? __float_as_uint(w.ctlf[1]) : 0u)) * (1.f / 256.f) : 1.f;
  const float s_g = __uint_as_float(__builtin_amdgcn_readfirstlane((F8_GATE && PH == 11) ? __float_as_uint(w.ctlf[2]) : 0u)) * (1.f / 256.f);
#if F8_IN
  if (PH == 1) { gemm_any<true>(w.xq, w.winq, T, NPROJ, D, EpiProjN{w.proj, w.rstd1, s_in}, lds, bid, nb);
                 gemm_any<true>(w.winq + (size_t)NPROJ * D, w.xq, 2048, T, D, EpiProjT{w.vT, w.rstd1, s_in}, lds, bid, nb); }
#else
#if F8_V
  if (PH == 1) { cvt_wv(w, bid, nb); if (ONE_LAUNCH) side_arrive((unsigned*)(p.ws + OFF_BAR)); gemm_any(w.xb, w.win, T, NB16, D, EpiProjN{w.proj, w.rstd1, 1.f}, lds, bid, nb); }
#if F8_GO
  if (PH == 15) { if (ONE_LAUNCH) side_wait((unsigned*)(p.ws + OFF_BAR), (unsigned)nb);
                  gemm_bal<true>(w.xq8, w.wvq, T, NPROJ - NB16, D, EpiProjN8{w.proj + NB16, w.wvs}, lds, bid, nb);
                  gemm_any<true>(w.wvq + (size_t)(NPROJ - NB16) * D, w.xq8, 2048, T, D, EpiProjT{w.vT, w.wvs + (NPROJ - NB16), 1.f}, lds, bid, nb); }
#else
  if (PH == 15) gemm_bal<true>(w.wvq, w.xq8, 2048, T, D, EpiProjT{w.vT, w.wvs, 1.f}, lds, bid, nb);
#endif
#else
  if (PH == 1) { gemm_any(w.xb, w.win, T, NPROJ, D, EpiProjN{w.proj, w.rstd1, 1.f}, lds, bid, nb);
                 gemm_any(w.win + (size_t)NPROJ * D, w.xb, 2048, T, D, EpiProjT{w.vT, w.rstd1, 1.f}, lds, bid, nb); }
#endif
#endif
#if F8_OUT
  if (PH == 5) gemm_any<true>(w.yq, w.woutq, T, D, D, EpiOut{w.xb, w.h1b, w.ssq2, s_out}, lds, bid, nb);
#else
  if (PH == 5) gemm_any(w.y, w.wout, T, D, D, EpiOut{w.xb, w.h1b, w.ssq2, 1.f}, lds, bid, nb);
#endif
#if F8_GATE
  if (PH == 11) gemm_any<true>(w.h2q, w.wgq, T, D, D, EpiGate{w.h2b, w.pl, w.ssq3, w.h1b, w.ssq4, w.ssq2, s_g}, lds, bid, nb);
#else
  if (PH == 11) gemm_any(w.h2b, w.wg, T, D, D, EpiGate{w.h2b, w.pl, w.ssq3, w.h1b, w.ssq4, w.ssq2, 1.f}, lds, bid, nb);
#endif
#if FAST_MIX == 2
  if (PH == 14) { if (!(U_FP8 && nb == 256)) phase_prep2(p, w, lds, bid, nb);
                  if (GATE_LOCAL) mix_gate_local(p, w, (unsigned char*)lds, bid, nb); else mix_gate_pass(p, w, (unsigned char*)lds, bid, nb); }
  if (PH == 2 && !GATE_LOCAL) mix_local2(p, w, bid, nb);
#if U_FP8
  if (PH == 3) { if (nb == 256 && bid >= 128 && bid < 254) phase_prep2(p, w, lds, bid - 128, 126, nb); else mix_scan(p, w, lds, bid, nb); }
#else
  if (PH == 3) mix_scan(p, w, lds, bid, nb);
#endif
#if MIX_OUT3
  if (PH == 4) { if (SCAN_GROUPS) phase_mix_out4(p, w, (unsigned char*)lds, bid, nb); else phase_mix_out3(p, w, (unsigned char*)lds, bid, nb); }
#else
  if (PH == 4) mix_out2(p, w, bid, nb);
#endif
#elif FAST_MIX
  if (PH == 2) phase_mix_items<0>(p, w, (unsigned char*)lds, bid, nb);
  if (PH == 3) mix_scan(p, w, lds, bid, nb);
  if (PH == 4) phase_mix_items<1>(p, w, (unsigned char*)lds, bid, nb);
#else
  if (PH == 2) phase_mixer_naive(p, w, lds, bid, nb);
#endif
  if (PH == 6) gemm_any(w.h1b, w.wq, T, D, D, EpiScore{w.sc, w.ssq2}, lds, bid, nb);
  if (PH == 7) { phase_topk(p, w, (unsigned char*)lds, bid, nb); __syncthreads(); gemm_any(w.pb, w.wple, T, D, 256, EpiPl{w.pl}, lds, bid, nb); }
  if (PH == 8) peer_dots(p, w, bid, nb);
#ifdef PROBE_DOTS_MASK
  if (PH == 80) peer_dots<PROBE_DOTS_MASK>(p, w, bid, nb);
#endif
  if (PH == 9) peer_wgt(p, w, bid, nb);
  if (PH == 10) peer_vals(p, w, bid, nb);
  if (PH == 12) phase_final(p, w, bid, nb);
}


#define XB_LAS __attribute__((address_space(3)))
#define XB_TMO      128
#define XB_XCNT(j)  (256  + 64 * (j))
#define XB_XSUB(j)  (1280 + 64 * (j))
#define XB_XGEN(j)  (2304 + 64 * (j))
#define XB_TOP      3328
#define XB_TOPGEN   3392
#define XCD_BAR_WORDS 3456
#define XB_SPIN_CAP (1u << 18)
__device__ __forceinline__ unsigned xb_ld(unsigned* p)              { return __hip_atomic_load(p, __ATOMIC_RELAXED, __HIP_MEMORY_SCOPE_AGENT); }
__device__ __forceinline__ unsigned xb_add(unsigned* p, unsigned v) { return __hip_atomic_fetch_add(p, v, __ATOMIC_RELAXED, __HIP_MEMORY_SCOPE_AGENT); }
__device__ __forceinline__ unsigned xb_xcc_id() { return (unsigned)__builtin_amdgcn_s_getreg((3 << 11) | 20) & 0xFu; }
#define XB_SPIN(cond, bar) do { unsigned _sp = 0; while (cond) { __builtin_amdgcn_s_sleep(1); \
    if ((++_sp & 255u) == 0u) { if (xb_ld(&(bar)[XB_TMO])) break; if (_sp > XB_SPIN_CAP) { atomicAdd(&(bar)[XB_TMO], 1u); break; } } } } while (0)
struct XcdBarrier {
    unsigned* bar; unsigned x;
    volatile XB_LAS unsigned* st;
};
__device__ __forceinline__ XcdBarrier xcd_barrier_post(unsigned* bar, volatile XB_LAS unsigned* st) {
    XcdBarrier b; b.bar = bar; b.x = xb_xcc_id(); b.st = st;
    if (threadIdx.x == 0) (void)xb_add(&bar[XB_XCNT(b.x)], 1u);
    return b;
}
__device__ __forceinline__ void xcd_barrier_complete(unsigned* bar, unsigned x, unsigned& nloc, unsigned& nx) {
    const unsigned G = gridDim.x * gridDim.y * gridDim.z;
    unsigned sum, cnt, mine, sp = 0u;
    for (;;) {
        sum = 0u; cnt = 0u; mine = 0u;
#pragma unroll
        for (unsigned j = 0; j < 16; ++j) { const unsigned c = xb_ld(&bar[XB_XCNT(j)]); sum += c; cnt += (c > 0u) ? 1u : 0u; mine = (j == x) ? c : mine; }
        if (sum == G) break;
        __builtin_amdgcn_s_sleep(1);
        if ((++sp & 255u) == 0u) { if (xb_ld(&bar[XB_TMO])) break; if (sp > XB_SPIN_CAP) { atomicAdd(&bar[XB_TMO], 1u); break; } }
    }
    nloc = mine > 0u ? mine : 1u; nx = cnt > 0u ? cnt : 1u;
}
__device__ __forceinline__ void xcd_barrier(const XcdBarrier& b) {
    asm volatile("s_waitcnt vmcnt(0)" ::: "memory");
    __syncthreads();
    if (threadIdx.x == 0) {
        unsigned* bar = b.bar;
        __builtin_amdgcn_s_waitcnt(0);
        unsigned nloc = b.st[0], nx = b.st[1];
        if (nloc == 0u) { xcd_barrier_complete(bar, b.x, nloc, nx); b.st[0] = nloc; b.st[1] = nx; }
        const unsigned old = xb_add(&bar[XB_XSUB(b.x)], 1u);
        const unsigned gen = old / nloc;
        if (old + 1u == (gen + 1u) * nloc) {
            __builtin_amdgcn_fence(__ATOMIC_RELEASE, "agent");
            asm volatile("s_waitcnt vmcnt(0)" ::: "memory");
            const unsigned og = xb_add(&bar[XB_TOP], 1u);
            const unsigned tg = og / nx;
            if (og + 1u == (tg + 1u) * nx) xb_add(&bar[XB_TOPGEN], 1u);
            else XB_SPIN(xb_ld(&bar[XB_TOPGEN]) == tg, bar);
            __builtin_amdgcn_fence(__ATOMIC_ACQUIRE, "agent");
            xb_add(&bar[XB_XGEN(b.x)], 1u);
            asm volatile("s_waitcnt vmcnt(0)" ::: "memory");
        } else {
            XB_SPIN(xb_ld(&bar[XB_XGEN(b.x)]) == gen, bar);
            __builtin_amdgcn_fence(__ATOMIC_ACQUIRE, "agent");
            asm volatile("s_waitcnt vmcnt(0)" ::: "memory");
        }
    }
    __syncthreads();
}

#define XB_SIDE (XCD_BAR_WORDS + 16)
__device__ __forceinline__ void side_arrive(unsigned* bar) {
    asm volatile("s_waitcnt vmcnt(0)" ::: "memory");
    __syncthreads();
    if (threadIdx.x == 0) { __builtin_amdgcn_fence(__ATOMIC_RELEASE, "agent"); asm volatile("s_waitcnt vmcnt(0)" ::: "memory"); (void)xb_add(&bar[XB_SIDE], 1u); }
}
__device__ __forceinline__ void side_wait(unsigned* bar, unsigned n) {
    if (threadIdx.x == 0) { XB_SPIN(xb_ld(&bar[XB_SIDE]) < n, bar); __builtin_amdgcn_fence(__ATOMIC_ACQUIRE, "agent"); asm volatile("s_waitcnt vmcnt(0)" ::: "memory"); }
    __syncthreads();
}

constexpr size_t kDynLds = 143360;
extern __shared__ __attribute__((aligned(16))) unsigned char dyn_lds[];

#if ONE_LAUNCH
__global__ void __launch_bounds__(512, 2) mega(Params p) {
  float* lds = (float*)dyn_lds; const int bid = blockIdx.x, nb = gridDim.x;
#ifndef DUP_PHASE
#define DUP_PHASE -1
#endif
#define RUNP(k) do { run_phase<k>(p, lds, bid, nb); } while (0)
  int nstamp = 0;
#define STAMP() do { if ((TPROBE_A >= 0 || TPROBE_B >= 0) && bid == 0 && threadIdx.x == 0) ((unsigned long long*)(p.ws + OFF_CTL + 65536))[nstamp] = __builtin_amdgcn_s_memrealtime(); ++nstamp; } while (0)
  STAMP();
  unsigned* barw = (unsigned*)(p.ws + OFF_BAR);
  volatile XB_LAS unsigned* bst = (volatile XB_LAS unsigned*)(dyn_lds + kDynLds - 16);
  if (threadIdx.x == 0) { bst[0] = 0u; bst[1] = 0u; }
  const XcdBarrier xbar = xcd_barrier_post(barw, bst);
#define GSYNC() xcd_barrier(xbar)
  RUNP(0); GSYNC(); STAMP();
#ifdef EXTRA_SYNCS
  for (int i = 0; i < EXTRA_SYNCS; ++i) GSYNC();
#endif
#if F8_V && F8_GO
  RUNP(1); STAMP();
#else
  RUNP(1); GSYNC(); STAMP();
#endif
#if F8_V
  RUNP(15); GSYNC();
#endif
#if FAST_MIX == 2
  RUNP(14); GSYNC(); STAMP();
#endif
  if (!(FAST_MIX == 2 && GATE_LOCAL)) { RUNP(2); GSYNC(); } STAMP();
#if FAST_MIX
  RUNP(3); GSYNC(); STAMP();
  RUNP(4); GSYNC(); STAMP();
#endif
  RUNP(5); GSYNC(); STAMP();
  RUNP(6); GSYNC(); STAMP();
  RUNP(7); GSYNC(); STAMP();
#ifdef PROBE_DOTS_MASK
  RUNP(80); GSYNC();
#endif
  RUNP(8); GSYNC(); STAMP();
#if PEER_WGT
  RUNP(9); GSYNC();
#endif
  RUNP(10); GSYNC(); STAMP();
  RUNP(11); GSYNC(); STAMP();
  RUNP(12);
#undef RUNP
#undef STAMP
#undef GSYNC
}
#else
template <int PH> __global__ void __launch_bounds__(512, 2) k_phase(Params p) { run_phase<PH>(p, (float*)dyn_lds, blockIdx.x, gridDim.x); }
#endif


extern "C" void kernel_launch(void* const* d_in, const int* in_sizes, int n_in, void* d_out, int out_size, void* d_ws, size_t ws_size, hipStream_t stream) {
  if (n_in != 22 || out_size != T * D || ws_size < WS_NEED) { fprintf(stderr, "kernel_launch: unexpected shapes (n_in %d out %d ws %zu)\n", n_in, out_size, ws_size); return; }
  Params p{};
  const float** f = (const float**)&p;
  for (int i = 0; i < 22; ++i) f[i] = (const float*)d_in[i];
  p.out = (float*)d_out; p.ws = (unsigned char*)d_ws;
#if ONE_LAUNCH
  static int grid_blocks = 0;
  if (!grid_blocks) {
    int dev = 0, cus = 0, per_cu = 0;
    (void)hipGetDevice(&dev); (void)hipDeviceGetAttribute(&cus, hipDeviceAttributeMultiprocessorCount, dev);
    (void)hipFuncSetAttribute((const void*)mega, hipFuncAttributeMaxDynamicSharedMemorySize, (int)kDynLds);
    (void)hipOccupancyMaxActiveBlocksPerMultiprocessor(&per_cu, mega, 512, kDynLds);
    if (per_cu < 1) { fprintf(stderr, "occupancy query says 0 blocks/CU\n"); per_cu = 1; }
    grid_blocks = cus;
  }
  void* args[] = {&p};
  (void)hipMemsetAsync((unsigned char*)d_ws + OFF_BAR, 0, (XCD_BAR_WORDS + 64) * sizeof(unsigned), stream);
  hipError_t e = hipLaunchCooperativeKernel((void*)mega, dim3(grid_blocks), dim3(512), args, kDynLds, stream);
  if (e != hipSuccess) fprintf(stderr, "cooperative launch failed: %s (grid %d)\n", hipGetErrorString(e), grid_blocks);
#else
  static bool attr = false;
  const int G = 256;
#define LAUNCH(PH) do { if (!attr) (void)hipFuncSetAttribute((const void*)k_phase<PH>, hipFuncAttributeMaxDynamicSharedMemorySize, (int)kDynLds); \
    hipLaunchKernelGGL(k_phase<PH>, dim3(G), dim3(512), kDynLds, stream, p); } while (0)
  LAUNCH(0); LAUNCH(1); LAUNCH(14); LAUNCH(2); LAUNCH(3); LAUNCH(4); LAUNCH(5); LAUNCH(6); LAUNCH(7); LAUNCH(8); LAUNCH(10); LAUNCH(11); LAUNCH(12);
  attr = true;
#undef LAUNCH
#endif
}
```
